# Optimizing an MI355X kernel written in HIP

```python
import math
import jax, jax.numpy as jnp
from jax import lax
import numpy as np

D_MODEL = 1024
BATCH = 32
SEQ = 2048
DEPTH = 1

CTX_LEN = 256
GRID_W = 64
ATTN_HEADS = 4
ATTN_HEAD_DIM = 64
ATTN_V_DIM = 2 * ATTN_HEAD_DIM
ATTN_QK_W = ATTN_HEADS * 2 * ATTN_HEAD_DIM
ATTN_V_W = ATTN_HEADS * ATTN_V_DIM
CONV_W = 512
CONV_K = 3
MIX_W = ATTN_V_W + CONV_W
PROJ_W = 2 * ATTN_QK_W + ATTN_V_W + 3 * CONV_W
Q_BLOCK = 128
ROPE_BASE = 10000.0
ROT_AXIS = ATTN_HEAD_DIM // 2
N_EXPERTS = 16
CAP_FACTOR = 2
D_EXPERT = 1024
EPS = 1e-6

kernel_name = "hybrid_diffattn_shortconv_ecmoe_dit"


def rmsnorm(x, g):
    xf = x.astype(jnp.float32)
    y = xf * lax.rsqrt(jnp.mean(xf * xf, axis=-1, keepdims=True) + EPS)
    return (y * g.astype(jnp.float32)).astype(x.dtype)


def modulate(x, shift, scale):
    return x * (1 + scale) + shift


def axial_rope_tables(n_tok):
    rows = n_tok // GRID_W
    row = jnp.repeat(jnp.arange(rows, dtype=jnp.float32), GRID_W)
    col = jnp.tile(jnp.arange(GRID_W, dtype=jnp.float32), rows)
    inv = ROPE_BASE ** (-jnp.arange(0, ROT_AXIS, 2, dtype=jnp.float32) / ROT_AXIS)
    ang_r = row[:, None] * inv[None, :]
    ang_c = col[:, None] * inv[None, :]
    ang = jnp.concatenate([ang_r, ang_r, ang_c, ang_c], axis=-1)
    return jnp.cos(ang), jnp.sin(ang)


def apply_rope(x, cos, sin):
    q = ROT_AXIS // 2
    a, b, c2, d2 = x[..., :q], x[..., q:2 * q], x[..., 2 * q:3 * q], x[..., 3 * q:]
    rot = jnp.concatenate([-b, a, -d2, c2], axis=-1)
    cs = cos[None, :, None, None, :].astype(x.dtype)
    sn = sin[None, :, None, None, :].astype(x.dtype)
    return x * cs + rot * sn


def diff_attend(q, k, v, lam):
    s = jnp.einsum('bqhmd,bkhmd->bhmqk', q, k, preferred_element_type=jnp.float32)
    a = jax.nn.softmax(s * (1.0 / math.sqrt(ATTN_HEAD_DIM)), axis=-1)
    a = a[:, :, 0] - lam * a[:, :, 1]
    return jnp.einsum('bhqk,bkhe->bqhe', a.astype(v.dtype), v)


def latent_diff_attention(q, k_all, v_all, lam):
    b, t, h, _, d = q.shape
    nblk = t // Q_BLOCK
    qb = q.reshape(b, nblk, Q_BLOCK, h, 2, d).transpose(1, 0, 2, 3, 4, 5)
    o = lax.map(lambda qblk: diff_attend(qblk, k_all, v_all, lam), qb)
    return o.transpose(1, 0, 2, 3, 4).reshape(b, t, h, ATTN_V_DIM)


def split_proj(p):
    b, t, _ = p.shape
    i0 = ATTN_QK_W
    i1 = i0 + ATTN_QK_W
    i2 = i1 + ATTN_V_W
    i3 = i2 + CONV_W
    i4 = i3 + CONV_W
    q = p[..., :i0].reshape(b, t, ATTN_HEADS, 2, ATTN_HEAD_DIM)
    k = p[..., i0:i1].reshape(b, t, ATTN_HEADS, 2, ATTN_HEAD_DIM)
    v = p[..., i1:i2].reshape(b, t, ATTN_HEADS, ATTN_V_DIM)
    return q, k, v, p[..., i2:i3], p[..., i3:i4], p[..., i4:]


def short_conv(gb, gc, xc, conv_w):
    u = gc * xc
    y = lax.conv_general_dilated(u, conv_w[:, None, :].astype(u.dtype), window_strides=(1,),
                                 padding=((CONV_K // 2, CONV_K // 2),),
                                 dimension_numbers=('NWC', 'WIO', 'NWC'),
                                 feature_group_count=CONV_W)
    return gb * y


def head_out(o, subln_g, lam_init):
    b, t = o.shape[:2]
    return (rmsnorm(o, subln_g) * (1.0 - lam_init)).reshape(b, t, ATTN_V_W)


def hybrid_mixer(xn, xn_c, w_in, conv_w, lq1, lk1, lq2, lk2, subln_g, w_out, layer, need_ctx):
    lam_init = 0.8 - 0.6 * math.exp(-0.3 * layer)
    lam = (jnp.exp(jnp.sum(lq1.astype(jnp.float32) * lk1.astype(jnp.float32)))
           - jnp.exp(jnp.sum(lq2.astype(jnp.float32) * lk2.astype(jnp.float32))) + lam_init)
    t = xn.shape[1]
    cos, sin = axial_rope_tables(t)
    q, k, v, gb, gc, xc = split_proj(jnp.einsum('btd,dn->btn', xn, w_in))
    qc, kc, vc, gbc, gcc, xcc = split_proj(jnp.einsum('btd,dn->btn', xn_c, w_in))
    q = apply_rope(q, cos, sin)
    k = apply_rope(k, cos, sin)
    k_all = jnp.concatenate([kc, k], axis=1)
    v_all = jnp.concatenate([vc, v], axis=1)
    attn = head_out(latent_diff_attention(q, k_all, v_all, lam), subln_g, lam_init)
    conv = short_conv(gb, gc, xc, conv_w)
    out = jnp.einsum('btn,nd->btd', jnp.concatenate([attn, conv], axis=-1), w_out)
    out_c = None
    if need_ctx:
        attn_c = head_out(diff_attend(qc, kc, vc, lam), subln_g, lam_init)
        conv_c = short_conv(gbc, gcc, xcc, conv_w)
        out_c = jnp.einsum('btn,nd->btd', jnp.concatenate([attn_c, conv_c], axis=-1), w_out)
    return out, out_c


def ec_moe(x_tok, w_router, w_gate, w_up, w_down):
    t = x_tok.shape[1]
    cap = CAP_FACTOR * t // N_EXPERTS
    logits = jnp.einsum('btd,de->bte', x_tok, w_router, preferred_element_type=jnp.float32)
    aff = jax.nn.softmax(logits, axis=-1)
    g, idx = lax.top_k(jnp.swapaxes(aff, 1, 2), cap)
    xs = jax.vmap(lambda xt, ix: xt[ix])(x_tok, idx)
    hg = jnp.einsum('becd,edf->becf', xs, w_gate)
    hu = jnp.einsum('becd,edf->becf', xs, w_up)
    y = jnp.einsum('becf,efd->becd', jax.nn.silu(hg) * hu, w_down) * g[..., None].astype(xs.dtype)
    return jax.vmap(lambda ix, val: jnp.zeros((t, D_MODEL), val.dtype)
                    .at[ix.reshape(-1)].add(val.reshape(-1, D_MODEL)))(idx, y)


def setup_inputs(seed: int = 0) -> dict:
    key = jax.random.key(seed)
    ks = jax.random.split(key, 24)
    f32 = jnp.float32
    nrm = lambda k, shape, s: jax.random.normal(k, shape, f32) * s
    gain = lambda k: 1.0 + 0.05 * jax.random.normal(k, (DEPTH, D_MODEL), f32)
    return {
        "x": nrm(ks[0], (BATCH, SEQ, D_MODEL), 1.0),
        "c": nrm(ks[1], (BATCH, D_MODEL), 1.0),
        "ctx": nrm(ks[2], (BATCH, CTX_LEN, D_MODEL), 1.0),
        "c_ctx": nrm(ks[3], (D_MODEL,), 1.0),
        "w_ada": nrm(ks[4], (DEPTH, D_MODEL, 6 * D_MODEL), 0.5 * D_MODEL ** -0.5),
        "b_ada": nrm(ks[5], (DEPTH, 6 * D_MODEL), 0.01),
        "norm_pre_mix": gain(ks[6]),
        "norm_post_mix": gain(ks[7]),
        "norm_pre_ffn": gain(ks[8]),
        "norm_post_ffn": gain(ks[9]),
        "w_in": nrm(ks[10], (DEPTH, D_MODEL, PROJ_W), D_MODEL ** -0.5),
        "conv_w": nrm(ks[11], (DEPTH, CONV_K, CONV_W), CONV_K ** -0.5),
        "lambda_q1": nrm(ks[12], (DEPTH, ATTN_HEAD_DIM), 0.1),
        "lambda_k1": nrm(ks[13], (DEPTH, ATTN_HEAD_DIM), 0.1),
        "lambda_q2": nrm(ks[14], (DEPTH, ATTN_HEAD_DIM), 0.1),
        "lambda_k2": nrm(ks[15], (DEPTH, ATTN_HEAD_DIM), 0.1),
        "subln_g": 1.0 + 0.05 * jax.random.normal(ks[16], (DEPTH, ATTN_V_DIM), f32),
        "w_out": nrm(ks[17], (DEPTH, MIX_W, D_MODEL), MIX_W ** -0.5),
        "w_router": nrm(ks[18], (DEPTH, D_MODEL, N_EXPERTS), D_MODEL ** -0.5),
        "w_gate": nrm(ks[19], (DEPTH, N_EXPERTS, D_MODEL, D_EXPERT), D_MODEL ** -0.5),
        "w_up": nrm(ks[20], (DEPTH, N_EXPERTS, D_MODEL, D_EXPERT), D_MODEL ** -0.5),
        "w_down": nrm(ks[21], (DEPTH, N_EXPERTS, D_EXPERT, D_MODEL), D_EXPERT ** -0.5),
    }


def reference(x, c, ctx, c_ctx, w_ada, b_ada, norm_pre_mix, norm_post_mix, norm_pre_ffn,
              norm_post_ffn, w_in, conv_w, lambda_q1, lambda_k1, lambda_q2, lambda_k2,
              subln_g, w_out, w_router, w_gate, w_up, w_down):
    h = x
    hc = ctx
    for layer in range(DEPTH):
        need_ctx = layer < DEPTH - 1
        mod = jnp.einsum('bd,dn->bn', jax.nn.silu(c), w_ada[layer]) + b_ada[layer]
        mod_c = jnp.einsum('d,dn->n', jax.nn.silu(c_ctx), w_ada[layer]) + b_ada[layer]
        sh1, sc1, g1, sh2, sc2, g2 = [m[:, None, :] for m in jnp.split(mod, 6, axis=-1)]
        csh1, csc1, cg1, csh2, csc2, cg2 = jnp.split(mod_c, 6, axis=-1)
        xn = modulate(rmsnorm(h, norm_pre_mix[layer]), sh1, sc1)
        xn_c = modulate(rmsnorm(hc, norm_pre_mix[layer]), csh1, csc1)
        mix, mix_c = hybrid_mixer(xn, xn_c, w_in[layer], conv_w[layer], lambda_q1[layer],
                                  lambda_k1[layer], lambda_q2[layer], lambda_k2[layer],
                                  subln_g[layer], w_out[layer], layer, need_ctx)
        h = h + g1 * rmsnorm(mix, norm_post_mix[layer])
        if need_ctx:
            hc = hc + cg1 * rmsnorm(mix_c, norm_post_mix[layer])
        xn = modulate(rmsnorm(h, norm_pre_ffn[layer]), sh2, sc2)
        ff = ec_moe(xn, w_router[layer], w_gate[layer], w_up[layer], w_down[layer])
        h = h + g2 * rmsnorm(ff, norm_post_ffn[layer])
        if need_ctx:
            xn_c = modulate(rmsnorm(hc, norm_pre_ffn[layer]), csh2, csc2)
            ff_c = ec_moe(xn_c, w_router[layer], w_gate[layer], w_up[layer], w_down[layer])
            hc = hc + cg2 * rmsnorm(ff_c, norm_post_ffn[layer])
    return h
```

```cpp
#include <hip/hip_runtime.h>
#include <cstdio>
#include <cstdint>

#ifndef MK_N_LAUNCHES
#define MK_N_LAUNCHES 8
#endif

#define LAS __attribute__((address_space(3)))
#define GAS __attribute__((address_space(1)))
typedef unsigned short bf16_t;
typedef short bf16x8 __attribute__((ext_vector_type(8)));
typedef short s16x4 __attribute__((ext_vector_type(4)));
typedef float f32x4 __attribute__((ext_vector_type(4)));
typedef float f32x16 __attribute__((ext_vector_type(16)));
typedef unsigned u32x4 __attribute__((ext_vector_type(4)));
typedef unsigned u32x2 __attribute__((ext_vector_type(2)));

constexpr int NB = 32, T = 2048, D = 1024, TC = 256, M = NB * T, MC = NB * TC, MA = M + MC, TK = TC + T;
constexpr int NE = 16, CAP = 256, NITEM = NB * NE, NPROJ = 3072, NMOD = 6 * D;
constexpr float EPS = 1e-6f;
constexpr float C2 = 0.125f * 1.4426950408889634f;
constexpr float LAM_INIT = 0.2f;
constexpr int NWAVES = 8, NTHREADS = 512;

constexpr size_t MiB = 1u << 20;
constexpr size_t WS_CTL = 0, CTL_ZERO_BYTES = 1 * MiB;
constexpr size_t WS_MODP = 2 * MiB;
constexpr size_t WS_MOD = 16 * MiB;
constexpr size_t WS_TAB = 17 * MiB;
constexpr size_t WS_WIN = 18 * MiB;
constexpr size_t WS_WOUT = 24 * MiB;
constexpr size_t WS_WGU = 26 * MiB;
constexpr size_t WS_WDN = 90 * MiB;
constexpr size_t WS_AFFT = 122 * MiB;
constexpr size_t WS_SLOT = 126 * MiB;
constexpr size_t WS_IDX = 128 * MiB;
constexpr size_t WS_GATE = 129 * MiB;
constexpr size_t WS_XN = 130 * MiB;
constexpr size_t WS_Q = 274 * MiB;
constexpr size_t WS_K = 338 * MiB;
constexpr size_t WS_V = 410 * MiB;
constexpr size_t WS_GB = 482 * MiB;
constexpr size_t WS_U = 546 * MiB;
constexpr size_t WS_MIXIN = 610 * MiB;
constexpr size_t WS_MIX = 738 * MiB;
constexpr size_t WS_HMID = 274 * MiB;
constexpr size_t WS_Y = 610 * MiB;
constexpr size_t WS_END = 866 * MiB;

namespace pg8 {
constexpr int BM = 256, BK = 64, HALF = 128, HTB = HALF * BK * 2, STAGE_BYTES = 8 * HTB;
__host__ __device__ __forceinline__ int lds_byte(int r, int c) { const int st = (r >> 4) * 2 + (c >> 5), rr = r & 15, cc = c & 31, ob = rr * 64 + cc * 2; return st * 1024 + (ob ^ (((ob >> 9) & 1) << 5)); }
__host__ __device__ __forceinline__ void stage_rc(int b, int& R, int& C) { const int st = b / 1024, sb = b % 1024, swz = sb ^ (((sb >> 9) & 1) << 5); R = (st >> 1) * 16 + swz / 64; C = (st & 1) * 32 + (swz % 64) / 2; }
__host__ __device__ __forceinline__ int perm32(int rho) { const int n = rho >> 4, i = rho & 15; return 8 * (i >> 2) + 4 * n + (i & 3); }

struct Unit { int pm, pn; };
struct Gemm { const bf16_t* A; const bf16_t* Bt; int K; const int* gidx; };

__device__ __forceinline__ unsigned cvt_pk_bf16(float lo, float hi) { unsigned r; asm volatile("v_cvt_pk_bf16_f32 %0, %1, %2" : "=v"(r) : "v"(lo), "v"(hi)); return r; }

struct EpiBf16 {
    static constexpr bool PERM = true, AFTER_DRAIN = false;
    bf16_t* O; int ldc;
    __device__ __forceinline__ void operator()(const f32x4 (&acc)[2][2][4][2], const Unit& u, int wr, int wc, int fr, int fq) const {
        const int row0 = u.pm * BM + wr * 64 + fr; const int col0 = u.pn * BM + wc * 32 + 8 * fq;
#pragma unroll
        for (int ai = 0; ai < 2; ++ai)
#pragma unroll
            for (int m = 0; m < 4; ++m) { bf16_t* rowp = O + (size_t)(row0 + ai * HALF + m * 16) * ldc + col0;
#pragma unroll
                for (int bj = 0; bj < 2; ++bj) { const f32x4 v0 = acc[ai][bj][m][0], v1 = acc[ai][bj][m][1];
                    u32x4 w; w.x = cvt_pk_bf16(v0[0], v0[1]); w.y = cvt_pk_bf16(v0[2], v0[3]); w.z = cvt_pk_bf16(v1[0], v1[1]); w.w = cvt_pk_bf16(v1[2], v1[3]);
                    *(u32x4*)(rowp + bj * HALF) = w; } }
    }
};

struct EpiProj {
    static constexpr bool PERM = true, AFTER_DRAIN = false;
    bf16_t *Q, *KA, *VA, *GB, *U; const float* tab;
    __device__ __forceinline__ void operator()(const f32x4 (&acc)[2][2][4][2], const Unit& u, int wr, int wc, int fr, int fq) const {
        const int pn = u.pn; const bool ctx = u.pm >= 256;
#pragma unroll
        for (int ai = 0; ai < 2; ++ai)
#pragma unroll
            for (int m = 0; m < 4; ++m) {
                const int row = u.pm * BM + ai * HALF + wr * 64 + m * 16 + fr;
                int t, kvrow;
                if (!ctx) { const int b = row >> 11; t = row & 2047; kvrow = b * TK + TC + t; }
                else { const int rc = row - M; const int b = rc >> 8; t = 0; kvrow = b * TK + (rc & 255); }
                if (pn < 4) {
                    f32x4 cs0 = {1.f, 0.f, 1.f, 0.f}, cs1 = cs0, cs2 = cs0, cs3 = cs0;
                    if (!ctx) { const float* tp = tab + ((size_t)t * 32 + 16 * (wc & 1) + 4 * fq) * 2;
                        cs0 = *(const f32x4*)(tp); cs1 = *(const f32x4*)(tp + 4); }
                    (void)cs2; (void)cs3;
#pragma unroll
                    for (int bj = 0; bj < 2; ++bj) {
                        const f32x4 v0 = acc[ai][bj][m][0], v1 = acc[ai][bj][m][1];
                        float e0 = v0[0], o0 = v0[1], e1 = v0[2], o1 = v0[3], e2 = v1[0], o2 = v1[1], e3 = v1[2], o3 = v1[3];
                        float r0 = e0 * cs0[0] - o0 * cs0[1], s0 = o0 * cs0[0] + e0 * cs0[1];
                        float r1 = e1 * cs0[2] - o1 * cs0[3], s1 = o1 * cs0[2] + e1 * cs0[3];
                        float r2 = e2 * cs1[0] - o2 * cs1[1], s2 = o2 * cs1[0] + e2 * cs1[1];
                        float r3 = e3 * cs1[2] - o3 * cs1[3], s3 = o3 * cs1[2] + e3 * cs1[3];
                        const float sc = (pn < 2) ? C2 : 1.f;
                        u32x4 w; w.x = cvt_pk_bf16(r0 * sc, s0 * sc); w.y = cvt_pk_bf16(r1 * sc, s1 * sc); w.z = cvt_pk_bf16(r2 * sc, s2 * sc); w.w = cvt_pk_bf16(r3 * sc, s3 * sc);
                        const int col = (pn & 1) * 256 + bj * HALF + wc * 32 + 8 * fq;
                        bf16_t* dst = (pn < 2) ? (Q + (size_t)row * 512 + col) : (KA + (size_t)kvrow * 512 + col);
                        *(u32x4*)dst = w;
                    }
                } else if (pn < 8) {
#pragma unroll
                    for (int bj = 0; bj < 2; ++bj) {
                        const f32x4 v0 = acc[ai][bj][m][0], v1 = acc[ai][bj][m][1];
                        u32x4 w; w.x = cvt_pk_bf16(v0[0], v0[1]); w.y = cvt_pk_bf16(v0[2], v0[3]); w.z = cvt_pk_bf16(v1[0], v1[1]); w.w = cvt_pk_bf16(v1[2], v1[3]);
                        const int col = (pn & 1) * 256 + bj * HALF + wc * 32 + 8 * fq;
                        bf16_t* dst = (pn < 6) ? (VA + (size_t)kvrow * 512 + col) : (GB + (size_t)row * 512 + col);
                        *(u32x4*)dst = w;
                    }
                } else {
                    const f32x4 a0 = acc[ai][0][m][0], a1 = acc[ai][0][m][1], b0 = acc[ai][1][m][0], b1 = acc[ai][1][m][1];
                    u32x4 w; w.x = cvt_pk_bf16(a0[0] * b0[0], a0[1] * b0[1]); w.y = cvt_pk_bf16(a0[2] * b0[2], a0[3] * b0[3]);
                    w.z = cvt_pk_bf16(a1[0] * b1[0], a1[1] * b1[1]); w.w = cvt_pk_bf16(a1[2] * b1[2], a1[3] * b1[3]);
                    const int col = (pn - 8) * 128 + wc * 32 + 8 * fq;
                    *(u32x4*)(U + (size_t)row * 512 + col) = w;
                }
            }
    }
};

struct EpiGU {
    static constexpr bool PERM = true, AFTER_DRAIN = false;
    bf16_t* H;
    __device__ __forceinline__ float silu(float x) const { return x * __builtin_amdgcn_rcpf(1.f + __expf(-x)); }
    __device__ __forceinline__ void operator()(const f32x4 (&acc)[2][2][4][2], const Unit& u, int wr, int wc, int fr, int fq) const {
#pragma unroll
        for (int ai = 0; ai < 2; ++ai)
#pragma unroll
            for (int m = 0; m < 4; ++m) {
                const int row = ai * HALF + wr * 64 + m * 16 + fr;
                const f32x4 a0 = acc[ai][0][m][0], a1 = acc[ai][0][m][1], b0 = acc[ai][1][m][0], b1 = acc[ai][1][m][1];
                u32x4 w; w.x = cvt_pk_bf16(silu(a0[0]) * b0[0], silu(a0[1]) * b0[1]); w.y = cvt_pk_bf16(silu(a0[2]) * b0[2], silu(a0[3]) * b0[3]);
                w.z = cvt_pk_bf16(silu(a1[0]) * b1[0], silu(a1[1]) * b1[1]); w.w = cvt_pk_bf16(silu(a1[2]) * b1[2], silu(a1[3]) * b1[3]);
                *(u32x4*)(H + (size_t)row * 1024 + u.pn * 128 + wc * 32 + 8 * fq) = w;
            }
    }
};
struct EpiDown {
    static constexpr bool PERM = true, AFTER_DRAIN = false;
    bf16_t* Y; const float* gate;
    __device__ __forceinline__ void operator()(const f32x4 (&acc)[2][2][4][2], const Unit& u, int wr, int wc, int fr, int fq) const {
#pragma unroll
        for (int ai = 0; ai < 2; ++ai)
#pragma unroll
            for (int m = 0; m < 4; ++m) {
                const int row = ai * HALF + wr * 64 + m * 16 + fr; const float g = gate[row];
#pragma unroll
                for (int bj = 0; bj < 2; ++bj) { const f32x4 v0 = acc[ai][bj][m][0] * g, v1 = acc[ai][bj][m][1] * g;
                    u32x4 w; w.x = cvt_pk_bf16(v0[0], v0[1]); w.y = cvt_pk_bf16(v0[2], v0[3]); w.z = cvt_pk_bf16(v1[0], v1[1]); w.w = cvt_pk_bf16(v1[2], v1[3]);
                    *(u32x4*)(Y + (size_t)row * 1024 + u.pn * BM + bj * HALF + wc * 32 + 8 * fq) = w; }
            }
    }
};

struct SchedProj {
    int G, c;
    __device__ __forceinline__ bool next(int i, Unit& u) const {
        const int L = i * G + c;
        if (L < 3072) { u.pm = L & 255; u.pn = L >> 8; return true; }
        const int j = L - 3072; if (j >= 128) return false;
        u.pm = 256 + (j >> 2); u.pn = 2 + (j & 3); return true;
    }
    __device__ __forceinline__ void a_ready(const Unit&) const {}
    __device__ __forceinline__ void done(const Unit&) const {}
};
struct SchedPanel {
    int pm, ntn;
    __device__ __forceinline__ bool next(int i, Unit& u) const { if (i >= ntn) return false; u.pm = pm; u.pn = i; return true; }
    __device__ __forceinline__ void a_ready(const Unit&) const {}
    __device__ __forceinline__ void done(const Unit&) const {}
};

template <class Epi, class Sched, bool ALIGN_EPI, bool SP2, bool GATHER = false>
__device__ __forceinline__ void gemm_phase(LAS unsigned char* lds, const Gemm g, const Sched& S, const Epi& E) {
    const int tid = threadIdx.x, wid = __builtin_amdgcn_readfirstlane(tid >> 6), lane = tid & 63, wr = wid >> 2, wc = wid & 3, fr = lane & 15, fq = lane >> 4;
    const int K = g.K, nt = K / BK;
    unsigned voffA[2][2], voffB[2];
#pragma unroll
    for (int i = 0; i < 2; ++i) { int R, C; stage_rc(tid * 16 + i * 8192, R, C); const int Rb = Epi::PERM ? ((R & ~31) + perm32(R & 31)) : R;
        if constexpr (GATHER) { voffA[0][i] = (unsigned)(g.gidx[R] * K + C) * 2u; voffA[1][i] = (unsigned)(g.gidx[HALF + R] * K + C) * 2u; }
        else { voffA[0][i] = (unsigned)(R * K + C) * 2u; voffA[1][i] = voffA[0][i]; }
        voffB[i] = (unsigned)(Rb * K + C) * 2u; }
    const size_t kstep = (size_t)(BK * 2);
    const size_t hstep = (size_t)HALF * K * 2;
    const size_t hstepA = GATHER ? (size_t)0 : hstep;
    const size_t tstep = 2 * hstep;
    const unsigned ldsw = (unsigned)wid * 1024u;
    const int aoff = lds_byte(wr * 64 + fr, fq * 8), boff = lds_byte(wc * 32 + fr, fq * 8);
#define PG8_SA(b, h) (((b) * 2 + (h)) * HTB)
#define PG8_SB(b, h) ((4 + (b) * 2 + (h)) * HTB)
#define PG8_STAGE(bufoff, gbase, voff) do { _Pragma("unroll") for (int _i = 0; _i < 2; ++_i) \
        __builtin_amdgcn_global_load_lds((const unsigned*)((const char*)(gbase) + (voff)[_i]), (LAS unsigned*)(lds + (bufoff) + ldsw + _i * 8192), 16, 0, 0); } while (0)
#define PG8_LDA(dst, b, h) do { _Pragma("unroll") for (int m = 0; m < 4; ++m) _Pragma("unroll") for (int k = 0; k < 2; ++k) dst[m][k] = *(const LAS bf16x8*)(lds + PG8_SA(b, h) + aoff + m * 2048 + k * 1024); } while (0)
#define PG8_LDB(dst, b, h) do { _Pragma("unroll") for (int n = 0; n < 2; ++n) _Pragma("unroll") for (int k = 0; k < 2; ++k) dst[n][k] = *(const LAS bf16x8*)(lds + PG8_SB(b, h) + boff + n * 2048 + k * 1024); } while (0)
#define PG8_MMA(ai, bj, At, Bt) do { __builtin_amdgcn_s_setprio(1); _Pragma("unroll") for (int m = 0; m < 4; ++m) _Pragma("unroll") for (int n = 0; n < 2; ++n) _Pragma("unroll") for (int k = 0; k < 2; ++k) \
        acc[ai][bj][m][n] = __builtin_amdgcn_mfma_f32_16x16x32_bf16(Bt[n][k], At[m][k], acc[ai][bj][m][n], 0, 0, 0); __builtin_amdgcn_s_setprio(0); } while (0)
#define PG8_WAIT_V(n) asm volatile("s_waitcnt vmcnt(" #n ")" ::: "memory")
#define PG8_WAIT_L(n) asm volatile("s_waitcnt lgkmcnt(" #n ")" ::: "memory")
#define PG8_BAR __builtin_amdgcn_s_barrier()
#define PG8_SCHED __builtin_amdgcn_sched_barrier(0)
    Unit cur, nxt; int ui = 0;
    if (!S.next(0, cur)) return;
    f32x4 acc[2][2][4][2];
#pragma unroll
    for (int a = 0; a < 2; ++a)
#pragma unroll
        for (int b = 0; b < 2; ++b)
#pragma unroll
            for (int m = 0; m < 4; ++m)
#pragma unroll
                for (int n = 0; n < 2; ++n) acc[a][b][m][n] = (f32x4){0.f, 0.f, 0.f, 0.f};
    bf16x8 At[4][2], B0[2][2], B1[2][2];
    const char* cA = (const char*)g.A + (size_t)cur.pm * tstep; const char* cB = (const char*)g.Bt + (size_t)cur.pn * tstep;
    S.a_ready(cur);
    if constexpr (SP2) {
        PG8_STAGE(PG8_SB(0, 0), cB, voffB); PG8_STAGE(PG8_SB(0, 1), cB + hstep, voffB); PG8_STAGE(PG8_SA(0, 0), cA, voffA[0]); PG8_STAGE(PG8_SA(0, 1), cA + hstepA, voffA[1]);
        if (wr == 1) PG8_BAR;
        PG8_WAIT_V(2); PG8_BAR;
        PG8_STAGE(PG8_SB(1, 0), cB + kstep, voffB); PG8_STAGE(PG8_SA(1, 0), cA + kstep, voffA[0]); PG8_STAGE(PG8_SB(1, 1), cB + hstep + kstep, voffB);
        PG8_WAIT_V(6); PG8_BAR;
    } else {
        PG8_STAGE(PG8_SB(0, 0), cB, voffB); PG8_STAGE(PG8_SA(0, 0), cA, voffA[0]); PG8_STAGE(PG8_SB(0, 1), cB + hstep, voffB); PG8_STAGE(PG8_SA(0, 1), cA + hstepA, voffA[1]);
        if (wr == 1) PG8_BAR;
        PG8_WAIT_V(4); PG8_BAR;
        PG8_STAGE(PG8_SB(1, 0), cB + kstep, voffB); PG8_STAGE(PG8_SA(1, 0), cA + kstep, voffA[0]); PG8_STAGE(PG8_SB(1, 1), cB + hstep + kstep, voffB);
        PG8_WAIT_V(6); PG8_BAR;
    }
    for (;;) {
        const bool has_next = S.next(ui + 1, nxt);
        const char* nA = has_next ? (const char*)g.A + (size_t)nxt.pm * tstep : cA; const char* nB = has_next ? (const char*)g.Bt + (size_t)nxt.pn * tstep : cB;
        for (int t = 0; t < nt; t += 2) {
            const bool last = (t == nt - 2);
            const char* a1 = cA + (size_t)(t + 1) * kstep;
            const char* a2 = last ? nA : cA + (size_t)(t + 2) * kstep; const char* b2 = last ? nB : cB + (size_t)(t + 2) * kstep;
            const char* a3 = a2 + kstep; const char* b3 = b2 + kstep;
            if (last && has_next) S.a_ready(nxt);
            if constexpr (SP2) {
            PG8_LDB(B0, 0, 0); PG8_LDB(B1, 0, 1); PG8_SCHED; PG8_LDA(At, 0, 0); PG8_STAGE(PG8_SA(1, 1), a1 + hstepA, voffA[1]);
            PG8_WAIT_V(8); PG8_WAIT_L(0); PG8_BAR; PG8_MMA(0, 0, At, B0); PG8_MMA(0, 1, At, B1); PG8_BAR; PG8_SCHED;
            PG8_LDA(At, 0, 1); PG8_STAGE(PG8_SB(0, 0), b2, voffB); PG8_STAGE(PG8_SB(0, 1), b2 + hstep, voffB); PG8_STAGE(PG8_SA(0, 0), a2, voffA[0]);
            PG8_WAIT_V(8); PG8_WAIT_L(0); PG8_BAR; PG8_MMA(1, 0, At, B0); PG8_MMA(1, 1, At, B1); PG8_BAR; PG8_SCHED;
            PG8_LDB(B0, 1, 0); PG8_LDB(B1, 1, 1); PG8_SCHED; PG8_LDA(At, 1, 0); PG8_STAGE(PG8_SA(0, 1), a2 + hstepA, voffA[1]);
            PG8_WAIT_V(8); PG8_WAIT_L(0); PG8_BAR; PG8_MMA(0, 0, At, B0); PG8_MMA(0, 1, At, B1); PG8_BAR; PG8_SCHED;
            PG8_LDA(At, 1, 1); PG8_STAGE(PG8_SB(1, 0), b3, voffB); PG8_STAGE(PG8_SB(1, 1), b3 + hstep, voffB); PG8_STAGE(PG8_SA(1, 0), a3, voffA[0]);
            PG8_WAIT_V(8); PG8_WAIT_L(0); PG8_BAR; PG8_MMA(1, 0, At, B0); PG8_MMA(1, 1, At, B1); PG8_BAR; PG8_SCHED;
            } else {
            PG8_LDB(B0, 0, 0); PG8_SCHED; PG8_LDA(At, 0, 0); PG8_STAGE(PG8_SA(1, 1), a1 + hstepA, voffA[1]);
            PG8_WAIT_L(8); PG8_BAR; PG8_WAIT_L(0); PG8_MMA(0, 0, At, B0); PG8_BAR; PG8_SCHED;
            PG8_LDB(B1, 0, 1); PG8_STAGE(PG8_SB(0, 0), b2, voffB);
            PG8_BAR; PG8_WAIT_L(0); PG8_MMA(0, 1, At, B1); PG8_BAR;
            PG8_LDA(At, 0, 1); PG8_STAGE(PG8_SA(0, 0), a2, voffA[0]);
            PG8_BAR; PG8_WAIT_L(0); PG8_MMA(1, 0, At, B0); PG8_BAR; PG8_SCHED;
            PG8_STAGE(PG8_SB(0, 1), b2 + hstep, voffB);
            PG8_WAIT_V(6); PG8_BAR; PG8_MMA(1, 1, At, B1); PG8_BAR;
            PG8_LDB(B0, 1, 0); PG8_SCHED; PG8_LDA(At, 1, 0); PG8_STAGE(PG8_SA(0, 1), a2 + hstepA, voffA[1]);
            PG8_WAIT_L(8); PG8_BAR; PG8_WAIT_L(0); PG8_MMA(0, 0, At, B0); PG8_BAR; PG8_SCHED;
            PG8_LDB(B1, 1, 1); PG8_STAGE(PG8_SB(1, 0), b3, voffB);
            PG8_BAR; PG8_WAIT_L(0); PG8_MMA(0, 1, At, B1); PG8_BAR;
            PG8_LDA(At, 1, 1); PG8_STAGE(PG8_SA(1, 0), a3, voffA[0]);
            PG8_BAR; PG8_WAIT_L(0); PG8_MMA(1, 0, At, B0); PG8_BAR; PG8_SCHED;
            PG8_STAGE(PG8_SB(1, 1), b3 + hstep, voffB);
            PG8_WAIT_V(6); PG8_BAR; PG8_MMA(1, 1, At, B1); PG8_BAR;
            }
        }
        if constexpr (ALIGN_EPI) { if (wr == 0) PG8_BAR; }
        E(acc, cur, wr, wc, fr, fq); S.done(cur);
        if (!has_next) break;
#pragma unroll
        for (int a = 0; a < 2; ++a)
#pragma unroll
            for (int b = 0; b < 2; ++b)
#pragma unroll
                for (int m = 0; m < 4; ++m)
#pragma unroll
                    for (int n = 0; n < 2; ++n) acc[a][b][m][n] = (f32x4){0.f, 0.f, 0.f, 0.f};
        cur = nxt; cA = nA; cB = nB; ++ui;
        if constexpr (ALIGN_EPI) { if (wr == 1) PG8_BAR; }
    }
    PG8_WAIT_V(0);
    if constexpr (!ALIGN_EPI) { if (wr == 0) PG8_BAR; }
    PG8_BAR;
#undef PG8_SA
#undef PG8_SB
#undef PG8_STAGE
#undef PG8_LDA
#undef PG8_LDB
#undef PG8_MMA
#undef PG8_WAIT_V
#undef PG8_WAIT_L
#undef PG8_BAR
#undef PG8_SCHED
}
}

typedef GAS unsigned gu32;
#define RLX_AGENT __ATOMIC_RELAXED, __HIP_MEMORY_SCOPE_AGENT
#define LDS_WAIT() asm volatile("s_waitcnt lgkmcnt(0)" ::: "memory")
#define VM_WAIT() asm volatile("s_waitcnt vmcnt(0)" ::: "memory")
__device__ __forceinline__ unsigned pk2(float lo, float hi) { return pg8::cvt_pk_bf16(lo, hi); }
__device__ __forceinline__ float bf2f(unsigned short h) { return __uint_as_float((unsigned)h << 16); }
__device__ __forceinline__ float bflo(unsigned w) { return __uint_as_float(w << 16); }
__device__ __forceinline__ float bfhi(unsigned w) { return __uint_as_float(w & 0xffff0000u); }
__device__ __forceinline__ float wave_sum(float v) {
#pragma unroll
    for (int o = 1; o < 64; o <<= 1) v += __shfl_xor(v, o);
    return v;
}

#define XB_TMO      128
#define XB_XCNT(j)  (256  + 64 * (j))
#define XB_XSUB(j)  (1280 + 64 * (j))
#define XB_XGEN(j)  (2304 + 64 * (j))
#define XB_TOP      3328
#define XB_TOPGEN   3392
#define XCD_BAR_WORDS 3456
#define XB_SPIN_CAP (1u << 18)
__device__ __forceinline__ unsigned xb_ld(unsigned* p)              { return __hip_atomic_load(p, __ATOMIC_RELAXED, __HIP_MEMORY_SCOPE_AGENT); }
__device__ __forceinline__ unsigned xb_add(unsigned* p, unsigned v) { return __hip_atomic_fetch_add(p, v, __ATOMIC_RELAXED, __HIP_MEMORY_SCOPE_AGENT); }
__device__ __forceinline__ unsigned xb_xcc_id() { return (unsigned)__builtin_amdgcn_s_getreg((3 << 11) | 20) & 0xFu; }
#define XB_SPIN(cond, bar) do { unsigned _sp = 0; while (cond) { __builtin_amdgcn_s_sleep(1); \
    if ((++_sp & 255u) == 0u) { if (xb_ld(&(bar)[XB_TMO])) break; if (_sp > XB_SPIN_CAP) { atomicAdd(&(bar)[XB_TMO], 1u); break; } } } } while (0)
struct XcdBarrier { unsigned* bar; unsigned x; volatile LAS unsigned* st; };
__device__ __forceinline__ XcdBarrier xcd_barrier_post(unsigned* bar, volatile LAS unsigned* st) {
    XcdBarrier b; b.bar = bar; b.x = xb_xcc_id(); b.st = st;
    if (threadIdx.x == 0) (void)xb_add(&bar[XB_XCNT(b.x)], 1u);
    return b;
}
__device__ __forceinline__ void xcd_barrier_complete(unsigned* bar, unsigned x, unsigned& nloc, unsigned& nx) {
    const unsigned G = gridDim.x * gridDim.y * gridDim.z;
    unsigned sum, cnt, mine, sp = 0u;
    for (;;) {
        sum = 0u; cnt = 0u; mine = 0u;
#pragma unroll
        for (unsigned j = 0; j < 16; ++j) { const unsigned c = xb_ld(&bar[XB_XCNT(j)]); sum += c; cnt += (c > 0u) ? 1u : 0u; mine = (j == x) ? c : mine; }
        if (sum == G) break;
        __builtin_amdgcn_s_sleep(1);
        if ((++sp & 255u) == 0u) { if (xb_ld(&bar[XB_TMO])) break; if (sp > XB_SPIN_CAP) { atomicAdd(&bar[XB_TMO], 1u); break; } }
    }
    nloc = mine > 0u ? mine : 1u; nx = cnt > 0u ? cnt : 1u;
}
__device__ __forceinline__ void xcd_barrier(const XcdBarrier& b) {
    asm volatile("s_waitcnt vmcnt(0)" ::: "memory");
    __syncthreads();
    if (threadIdx.x == 0) {
        unsigned* bar = b.bar;
        __builtin_amdgcn_s_waitcnt(0);
        unsigned nloc = b.st[0], nx = b.st[1];
        if (nloc == 0u) { xcd_barrier_complete(bar, b.x, nloc, nx); b.st[0] = nloc; b.st[1] = nx; }
        const unsigned old = xb_add(&bar[XB_XSUB(b.x)], 1u);
        const unsigned gen = old / nloc;
        if (old + 1u == (gen + 1u) * nloc) {
            __builtin_amdgcn_fence(__ATOMIC_RELEASE, "agent");
            asm volatile("s_waitcnt vmcnt(0)" ::: "memory");
            const unsigned og = xb_add(&bar[XB_TOP], 1u);
            const unsigned tg = og / nx;
            if (og + 1u == (tg + 1u) * nx) xb_add(&bar[XB_TOPGEN], 1u);
            else XB_SPIN(xb_ld(&bar[XB_TOPGEN]) == tg, bar);
            __builtin_amdgcn_fence(__ATOMIC_ACQUIRE, "agent");
            xb_add(&bar[XB_XGEN(b.x)], 1u);
            asm volatile("s_waitcnt vmcnt(0)" ::: "memory");
        } else {
            XB_SPIN(xb_ld(&bar[XB_XGEN(b.x)]) == gen, bar);
            __builtin_amdgcn_fence(__ATOMIC_ACQUIRE, "agent");
            asm volatile("s_waitcnt vmcnt(0)" ::: "memory");
        }
    }
    __syncthreads();
}

constexpr int RING_BYTES = 131072;
constexpr int LDSCTL_OFF = RING_BYTES, MISC_OFF = LDSCTL_OFF + 320;
constexpr int LDS_BYTES = 147456;
constexpr int CW_BAR = 4096;

struct Args { const float* in[22]; float* out; unsigned char* ws; int ph_lo, ph_hi; };
enum { I_X = 0, I_C, I_CTX, I_CCTX, I_WADA, I_BADA, I_NPRE_MIX, I_NPOST_MIX, I_NPRE_FFN, I_NPOST_FFN, I_WIN, I_CONVW, I_LQ1, I_LK1, I_LQ2, I_LK2, I_SUBLN, I_WOUT, I_WROUTER, I_WGATE, I_WUP, I_WDOWN };

__device__ __forceinline__ int win_dest(int n) {
    if (n < 1024) { const int j = n & 63; const int p = ((j >> 5) << 5) + ((j & 15) << 1) + ((j >> 4) & 1); return (n & ~63) + p; }
    if (n < 2048) return n;
    int c = n - 2048; const int isx = c >= 512; c &= 511; return 2048 + ((c >> 7) << 8) + (isx << 7) + (c & 127);
}
template <int MODE>
__device__ __forceinline__ int tr_dest(int n) {
    if (MODE == 0) return n;
    if (MODE == 1) return win_dest(n);
    if (MODE == 2) return ((n >> 7) << 8) + (n & 127);
    return ((n >> 7) << 8) + 128 + (n & 127);
}
template <int MODE>
__device__ __forceinline__ void p0_transpose_item(const float* W, int K, int N, bf16_t* WT, LAS float* scr, int item, int lane) {
    const int nblk = N / 32, kb = item / nblk, nb = item % nblk, k0 = 64 * kb, n0 = 32 * nb;
#pragma unroll 8
    for (int i = 0; i < 32; ++i) { const int kk = 2 * i + (lane >> 5); scr[kk * 33 + (lane & 31)] = W[(size_t)(k0 + kk) * N + n0 + (lane & 31)]; }
    LDS_WAIT(); asm volatile("" ::: "memory");
    const int c = lane & 7;
#pragma unroll
    for (int j = 0; j < 4; ++j) { const int n = (lane >> 3) + 8 * j; const LAS float* s = scr + (8 * c) * 33 + n;
        u32x4 o; o.x = pk2(s[0 * 33], s[1 * 33]); o.y = pk2(s[2 * 33], s[3 * 33]); o.z = pk2(s[4 * 33], s[5 * 33]); o.w = pk2(s[6 * 33], s[7 * 33]);
        *(GAS u32x4*)(WT + (size_t)tr_dest<MODE>(n0 + n) * K + k0 + 8 * c) = o; }
    LDS_WAIT(); asm volatile("" ::: "memory");
}

__device__ __forceinline__ void p0_prologue(const Args& a, LAS unsigned char* lds, int vcu, int G) {
    const int tid = threadIdx.x, lane = tid & 63, wave = __builtin_amdgcn_readfirstlane(tid >> 6);
    LAS float* scr = (LAS float*)(lds + wave * 16384);
    const int gw = vcu * NWAVES + wave, NGW = G * NWAVES;
    unsigned char* ws = a.ws;
    {
        float* MODP = (float*)(ws + WS_MODP);
        const float* wada = a.in[I_WADA];
        for (int it = gw; it < 96 * 16; it += NGW) {
            const int cg = it % 96, kc = it / 96;
            for (int b = 0; b < 33; ++b) { const float v = (b < 32) ? a.in[I_C][b * D + kc * 64 + lane] : a.in[I_CCTX][kc * 64 + lane]; scr[b * 64 + lane] = v / (1.f + __expf(-v)); }
            LDS_WAIT(); asm volatile("" ::: "memory");
            float acc[33];
#pragma unroll
            for (int b = 0; b < 33; ++b) acc[b] = 0.f;
            for (int k = 0; k < 64; ++k) {
                const float w = wada[(size_t)(kc * 64 + k) * NMOD + cg * 64 + lane];
#pragma unroll
                for (int b = 0; b < 33; ++b) acc[b] += scr[b * 64 + k] * w;
            }
#pragma unroll
            for (int b = 0; b < 33; ++b) MODP[((size_t)kc * 33 + b) * NMOD + cg * 64 + lane] = acc[b];
            LDS_WAIT(); asm volatile("" ::: "memory");
        }
    }
    {
        float* tab = (float*)(ws + WS_TAB);
        for (int e = gw * 64 + lane; e < T * 32; e += NGW * 64) {
            const int t = e >> 5, i = e & 31;
            const float inv = powf(10000.0f, -(float)(2 * (i & 15)) / 32.0f);
            const float pos = (i < 16) ? (float)(t >> 6) : (float)(t & 63);
            const float ang = pos * inv;
            tab[2 * e] = cosf(ang); tab[2 * e + 1] = sinf(ang);
        }
    }
    constexpr int I_IN = (D / 64) * (NPROJ / 32), I_OUT = (D / 64) * (D / 32), I_EXP = (D / 64) * (D / 32);
    constexpr int NITEMS = I_IN + I_OUT + NE * 3 * I_EXP;
    bf16_t* Win_t = (bf16_t*)(ws + WS_WIN); bf16_t* Wout_t = (bf16_t*)(ws + WS_WOUT); bf16_t* Wgu_t = (bf16_t*)(ws + WS_WGU); bf16_t* Wdn_t = (bf16_t*)(ws + WS_WDN);
    for (int it = gw; it < NITEMS; it += NGW) {
        int r = it;
        if (r < I_IN) { p0_transpose_item<1>(a.in[I_WIN], D, NPROJ, Win_t, scr, r, lane); continue; } r -= I_IN;
        if (r < I_OUT) { p0_transpose_item<0>(a.in[I_WOUT], D, D, Wout_t, scr, r, lane); continue; } r -= I_OUT;
        const int e = r / (3 * I_EXP), q = (r % (3 * I_EXP)) / I_EXP, rr = r % I_EXP;
        if (q == 0) p0_transpose_item<2>(a.in[I_WGATE] + (size_t)e * D * D, D, D, Wgu_t + (size_t)e * 2048 * D, scr, rr, lane);
        else if (q == 1) p0_transpose_item<3>(a.in[I_WUP] + (size_t)e * D * D, D, D, Wgu_t + (size_t)e * 2048 * D, scr, rr, lane);
        else p0_transpose_item<0>(a.in[I_WDOWN] + (size_t)e * D * D, D, D, Wdn_t + (size_t)e * D * D, scr, rr, lane);
    }
}

__device__ __forceinline__ void norm_mod_row(const float* xrow, bf16_t* orow, const float* gain, const LAS float* sc, const LAS float* sh, int lane) {
    const f32x4* xr = (const f32x4*)xrow + lane; const f32x4* gr = (const f32x4*)gain + lane;
    f32x4 v[4]; float s = 0.f;
#pragma unroll
    for (int j = 0; j < 4; ++j) { v[j] = xr[64 * j]; s += (v[j].x * v[j].x + v[j].y * v[j].y) + (v[j].z * v[j].z + v[j].w * v[j].w); }
    const float rstd = 1.0f / sqrtf(wave_sum(s) * (1.f / D) + EPS);
    u32x2* o8 = (u32x2*)orow + lane;
#pragma unroll
    for (int j = 0; j < 4; ++j) { const f32x4 g = gr[64 * j]; const f32x4 c1 = *(const LAS f32x4*)(sc + 4 * lane + 256 * j), h1 = *(const LAS f32x4*)(sh + 4 * lane + 256 * j);
        const f32x4 y = (v[j] * rstd) * g; const f32x4 z = y * (c1 + 1.0f) + h1;
        u32x2 w; w.x = pk2(z.x, z.y); w.y = pk2(z.z, z.w); o8[64 * j] = w; }
}
__device__ __forceinline__ void p1_xn(const Args& a, LAS unsigned char* lds, int c, int G) {
    const int tid = threadIdx.x, lane = tid & 63, wave = __builtin_amdgcn_readfirstlane(tid >> 6);
    unsigned char* ws = a.ws;
    const float* MODP = (const float*)(ws + WS_MODP); float* MOD = (float*)(ws + WS_MOD); const float* bada = a.in[I_BADA];
    for (int r = c; r < 33; r += G)
        for (int n = tid; n < NMOD; n += NTHREADS) { float s = bada[n];
#pragma unroll
            for (int kc = 0; kc < 16; ++kc) s += MODP[((size_t)kc * 33 + r) * NMOD + n];
            MOD[(size_t)r * NMOD + n] = s; }
    LAS float* sv = (LAS float*)lds;
    bf16_t* XN = (bf16_t*)(ws + WS_XN);
    for (int p = c; p < 256; p += G) {
        const int b = p >> 3;
        __syncthreads();
        for (int n = tid; n < 4096; n += NTHREADS) { const int r = (n < 2048) ? b : 32; const int col = n & 2047; float s = bada[col];
#pragma unroll
            for (int kc = 0; kc < 16; ++kc) s += MODP[((size_t)kc * 33 + r) * NMOD + col];
            sv[n] = s; }
        __syncthreads();
        for (int i = 0; i < 32; ++i) { const int row = p * 256 + wave * 32 + i;
            norm_mod_row(a.in[I_X] + (size_t)row * D, XN + (size_t)row * D, a.in[I_NPRE_MIX], sv + 1024, sv, lane); }
        for (int i = 0; i < 4; ++i) { const int row = p * 32 + wave * 4 + i;
            norm_mod_row(a.in[I_CTX] + (size_t)row * D, XN + (size_t)(M + row) * D, a.in[I_NPRE_MIX], sv + 3072, sv + 2048, lane); }
    }
}

namespace att {
constexpr int KP = 272, KBUF = 64 * KP, VBUF = 16384;
constexpr int OFF_K = 0, OFF_V = 2 * KBUF, OFF_WSF = OFF_V + 2 * VBUF, OFF_END = OFF_WSF + NWAVES * 256;
static_assert(OFF_WSF >= 65536 && OFF_END <= RING_BYTES, "attention LDS map");
constexpr int NT = TK / 64;
constexpr float THR = 8.0f;
__device__ __forceinline__ int crow(int r, int hi) { return (r & 3) + 8 * (r >> 2) + 4 * hi; }
__device__ __forceinline__ s16x4 vtr(const LAS unsigned char* p) { return __builtin_bit_cast(s16x4, __builtin_amdgcn_ds_read_tr16_b64_v4i16((LAS s16x4*)p)); }

__device__ __forceinline__ void unit(LAS unsigned char* lds, int b, int h, int qb, const bf16_t* Q, const bf16_t* KA, const bf16_t* VA, bf16_t* MIXIN, const float* subg, float lam) {
    const int tid = threadIdx.x, lane = tid & 63, r32 = lane & 31, hi = lane >> 5;
    const int wid = __builtin_amdgcn_readfirstlane(tid >> 6), w = wid & 3, m = wid >> 2;
    LAS float* wsf = (LAS float*)(lds + OFF_WSF) + wid * 64;
    const int rowQ = b * T + qb * 128 + w * 32;
    bf16x8 qr[4];
#pragma unroll
    for (int d0 = 0; d0 < 4; ++d0) qr[d0] = *(const bf16x8*)(Q + (size_t)(rowQ + r32) * 512 + h * 128 + m * 64 + d0 * 16 + hi * 8);
    const bf16_t* Kb = KA + (size_t)b * TK * 512 + h * 128; const bf16_t* Vb = VA + (size_t)b * TK * 512 + h * 128;
    int gsrc[2], kdst[2], vdst[2];
#pragma unroll
    for (int i = 0; i < 2; ++i) { const int cid = tid + 512 * i, kv = cid >> 4, c16 = cid & 15;
        gsrc[i] = kv * 512 + c16 * 8; kdst[i] = kv * KP + c16 * 16; vdst[i] = (c16 >> 2) * 4096 + (kv >> 4) * 1024 + (kv & 15) * 64 + (c16 & 3) * 16; }
    u32x4 kr[2], vr[2];
#pragma unroll
    for (int i = 0; i < 2; ++i) { kr[i] = *(const u32x4*)(Kb + gsrc[i]); vr[i] = *(const u32x4*)(Vb + gsrc[i]); }
#pragma unroll
    for (int i = 0; i < 2; ++i) { *(LAS u32x4*)(lds + OFF_K + kdst[i]) = kr[i]; *(LAS u32x4*)(lds + OFF_V + vdst[i]) = vr[i]; }
    __syncthreads();
    f32x16 o[4];
#pragma unroll
    for (int d0 = 0; d0 < 4; ++d0) o[d0] = (f32x16){};
    float mhat = -1e30f, l_reg = 0.f;
    const int koff = r32 * KP + m * 128 + hi * 16;
    const int voff = ((lane >> 4) & 1) * 32 + (lane & 3) * 8 + (4 * hi + ((lane & 15) >> 2)) * 64;
    for (int j = 0; j < NT; ++j) {
        const int cur = j & 1;
        if (j + 1 < NT) {
#pragma unroll
            for (int i = 0; i < 2; ++i) { kr[i] = *(const u32x4*)(Kb + (size_t)(j + 1) * 64 * 512 + gsrc[i]); vr[i] = *(const u32x4*)(Vb + (size_t)(j + 1) * 64 * 512 + gsrc[i]); }
        }
        const LAS unsigned char* kb = lds + OFF_K + cur * KBUF + koff;
        const LAS unsigned char* vb = lds + OFF_V + cur * VBUF + voff;
        f32x16 p0 = (f32x16){}, p1 = (f32x16){};
#pragma unroll
        for (int d0 = 0; d0 < 4; ++d0) {
            const bf16x8 k0 = *(const LAS bf16x8*)(kb + d0 * 32);
            const bf16x8 k1 = *(const LAS bf16x8*)(kb + 32 * KP + d0 * 32);
            p0 = __builtin_amdgcn_mfma_f32_32x32x16_bf16(k0, qr[d0], p0, 0, 0, 0);
            p1 = __builtin_amdgcn_mfma_f32_32x32x16_bf16(k1, qr[d0], p1, 0, 0, 0);
        }
        float rm = fmaxf(p0[0], p1[0]);
#pragma unroll
        for (int r = 1; r < 16; ++r) rm = fmaxf(rm, fmaxf(p0[r], p1[r]));
        rm = fmaxf(rm, __shfl_xor(rm, 32));
        if (__any(rm > mhat + THR)) {
            const float mn = fmaxf(mhat, rm); const float f = __builtin_amdgcn_exp2f(mhat - mn); mhat = mn; l_reg *= f;
            if (hi == 0) wsf[r32] = f;
            LDS_WAIT();
#pragma unroll
            for (int r = 0; r < 16; ++r) { const float fr_ = wsf[crow(r, hi)];
#pragma unroll
                for (int d0 = 0; d0 < 4; ++d0) o[d0][r] *= fr_; }
            LDS_WAIT();
        }
        float sacc = 0.f;
#pragma unroll
        for (int r = 0; r < 16; ++r) { p0[r] = __builtin_amdgcn_exp2f(p0[r] - mhat); p1[r] = __builtin_amdgcn_exp2f(p1[r] - mhat); sacc += p0[r] + p1[r]; }
        l_reg += sacc;
        u32x4 pw[4];
#pragma unroll
        for (int q = 0; q < 4; ++q) { pw[0][q] = pk2(p0[2 * q], p0[2 * q + 1]); pw[1][q] = pk2(p0[8 + 2 * q], p0[8 + 2 * q + 1]); pw[2][q] = pk2(p1[2 * q], p1[2 * q + 1]); pw[3][q] = pk2(p1[8 + 2 * q], p1[8 + 2 * q + 1]); }
#pragma unroll
        for (int d0 = 0; d0 < 4; ++d0) {
#pragma unroll
            for (int ks = 0; ks < 4; ++ks) {
                const s16x4 lo = vtr(vb + d0 * 4096 + ks * 1024), hh = vtr(vb + d0 * 4096 + ks * 1024 + 512);
                const bf16x8 vf = (bf16x8){lo[0], lo[1], lo[2], lo[3], hh[0], hh[1], hh[2], hh[3]};
                o[d0] = __builtin_amdgcn_mfma_f32_32x32x16_bf16(__builtin_bit_cast(bf16x8, pw[ks]), vf, o[d0], 0, 0, 0);
            }
        }
        if (j + 1 < NT) {
#pragma unroll
            for (int i = 0; i < 2; ++i) { *(LAS u32x4*)(lds + OFF_K + (cur ^ 1) * KBUF + kdst[i]) = kr[i]; *(LAS u32x4*)(lds + OFF_V + (cur ^ 1) * VBUF + vdst[i]) = vr[i]; }
        }
        __syncthreads();
    }
    l_reg += __shfl_xor(l_reg, 32);
    if (hi == 0) wsf[32 + r32] = l_reg;
    LDS_WAIT();
    float rli[16];
#pragma unroll
    for (int r = 0; r < 16; ++r) rli[r] = 1.0f / wsf[32 + crow(r, hi)];
    LDS_WAIT();
    LAS float* ex = (LAS float*)lds + w * 4096;
    if (m == 1) {
#pragma unroll
        for (int r = 0; r < 16; ++r)
#pragma unroll
            for (int d0 = 0; d0 < 4; ++d0) ex[crow(r, hi) * 128 + d0 * 32 + r32] = o[d0][r] * rli[r];
    }
    __syncthreads();
    if (m == 0) {
        float g4[4];
#pragma unroll
        for (int d0 = 0; d0 < 4; ++d0) g4[d0] = subg[d0 * 32 + r32] * (1.0f - LAM_INIT);
#pragma unroll
        for (int r = 0; r < 16; ++r) {
            const int q = crow(r, hi); float x[4]; float ss = 0.f;
#pragma unroll
            for (int d0 = 0; d0 < 4; ++d0) { x[d0] = o[d0][r] * rli[r] - lam * ex[q * 128 + d0 * 32 + r32]; ss += x[d0] * x[d0]; }
#pragma unroll
            for (int off = 1; off < 32; off <<= 1) ss += __shfl_xor(ss, off);
            const float rstd = 1.0f / sqrtf(ss * (1.f / 128.f) + EPS);
            bf16_t* dst = MIXIN + (size_t)(rowQ + q) * 1024 + h * 128 + r32;
#pragma unroll
            for (int d0 = 0; d0 < 4; ++d0) dst[d0 * 32] = (bf16_t)(pk2(x[d0] * rstd * g4[d0], 0.f) & 0xffffu);
        }
    }
    __syncthreads();
}
}

__device__ __forceinline__ void p3_conv_attn(const Args& a, LAS unsigned char* lds, int c, int vcu, int G) {
    const int tid = threadIdx.x, lane = tid & 63, wave = __builtin_amdgcn_readfirstlane(tid >> 6);
    unsigned char* ws = a.ws;
    const bf16_t* GB = (const bf16_t*)(ws + WS_GB); const bf16_t* U = (const bf16_t*)(ws + WS_U); bf16_t* MIXIN = (bf16_t*)(ws + WS_MIXIN);
    {
        const float* cw = a.in[I_CONVW]; float w0[8], w1[8], w2[8];
#pragma unroll
        for (int i = 0; i < 8; ++i) { w0[i] = cw[lane * 8 + i]; w1[i] = cw[512 + lane * 8 + i]; w2[i] = cw[1024 + lane * 8 + i]; }
        const int gw = vcu * NWAVES + wave, NGW = G * NWAVES;
        for (int row = gw; row < M; row += NGW) {
            const int t = row & (T - 1);
            const u32x4 z = {0u, 0u, 0u, 0u};
            const u32x4 uc = *(const u32x4*)(U + (size_t)row * 512 + lane * 8);
            const u32x4 up = (t > 0) ? *(const u32x4*)(U + (size_t)(row - 1) * 512 + lane * 8) : z;
            const u32x4 un = (t < T - 1) ? *(const u32x4*)(U + (size_t)(row + 1) * 512 + lane * 8) : z;
            const u32x4 gb = *(const u32x4*)(GB + (size_t)row * 512 + lane * 8);
            u32x4 o;
#pragma unroll
            for (int q = 0; q < 4; ++q) {
                const float y0 = w0[2 * q] * bflo(up[q]) + w1[2 * q] * bflo(uc[q]) + w2[2 * q] * bflo(un[q]);
                const float y1 = w0[2 * q + 1] * bfhi(up[q]) + w1[2 * q + 1] * bfhi(uc[q]) + w2[2 * q + 1] * bfhi(un[q]);
                o[q] = pk2(bflo(gb[q]) * y0, bfhi(gb[q]) * y1);
            }
            *(u32x4*)(MIXIN + (size_t)row * 1024 + 512 + lane * 8) = o;
        }
    }
    float lam;
    { const float p1 = a.in[I_LQ1][lane] * a.in[I_LK1][lane], p2 = a.in[I_LQ2][lane] * a.in[I_LK2][lane];
      lam = __expf(wave_sum(p1)) - __expf(wave_sum(p2)) + LAM_INIT; }
    const bf16_t* Q = (const bf16_t*)(ws + WS_Q); const bf16_t* KA = (const bf16_t*)(ws + WS_K); const bf16_t* VA = (const bf16_t*)(ws + WS_V);
    __syncthreads();
    for (int u = vcu * 8; u < 2048; u += G * 8) {
        const int x = (u >> 3) / 32, jj = (u >> 3) % 32;
        for (int i = 0; i < 8; ++i) {
            const int bh = 16 * x + 2 * i + (jj >> 4), qb = jj & 15;
            att::unit(lds, bh >> 2, bh & 3, qb, Q, KA, VA, MIXIN, a.in[I_SUBLN], lam);
        }
    }
}

__device__ __forceinline__ void p5_rows(const Args& a, LAS unsigned char* lds, int p  ) {
    const int tid = threadIdx.x, lane = tid & 63, wave = __builtin_amdgcn_readfirstlane(tid >> 6);
    unsigned char* ws = a.ws;
    const int b = p >> 3;
    LAS float* wrt = (LAS float*)lds;
    LAS float* mv = (LAS float*)(lds + 65536);
    const float* wr = a.in[I_WROUTER];
    for (int n = tid; n < D * NE; n += NTHREADS) { const int k = n >> 4, e = n & 15; wrt[e * D + k] = wr[n]; }
    const float* MOD = (const float*)(ws + WS_MOD) + (size_t)b * NMOD;
    for (int n = tid; n < 3 * D; n += NTHREADS) mv[n] = MOD[2 * D + n];
    __syncthreads();
    const bf16_t* MIX = (const bf16_t*)(ws + WS_MIX); bf16_t* XN2 = (bf16_t*)(ws + WS_XN); float* AFFT = (float*)(ws + WS_AFFT);
    const f32x4* npm = (const f32x4*)a.in[I_NPOST_MIX] + lane; const f32x4* npf = (const f32x4*)a.in[I_NPRE_FFN] + lane;
    for (int i = 0; i < 32; ++i) {
        const int row = p * 256 + wave * 32 + i, t = row & (T - 1);
        const u32x2* mr = (const u32x2*)(MIX + (size_t)row * D) + lane;
        f32x4 mx[4]; float s = 0.f;
#pragma unroll
        for (int j = 0; j < 4; ++j) { const u32x2 wv = mr[64 * j]; mx[j] = (f32x4){bflo(wv.x), bfhi(wv.x), bflo(wv.y), bfhi(wv.y)};
            s += (mx[j].x * mx[j].x + mx[j].y * mx[j].y) + (mx[j].z * mx[j].z + mx[j].w * mx[j].w); }
        const float rstd1 = 1.0f / sqrtf(wave_sum(s) * (1.f / D) + EPS);
        const f32x4* xr = (const f32x4*)(a.in[I_X] + (size_t)row * D) + lane; f32x4* hr = (f32x4*)(a.out + (size_t)row * D) + lane;
        f32x4 h[4]; float s2 = 0.f;
#pragma unroll
        for (int j = 0; j < 4; ++j) { const f32x4 g1 = *(const LAS f32x4*)(mv + 4 * lane + 256 * j);
            h[j] = xr[64 * j] + g1 * ((mx[j] * rstd1) * npm[64 * j]); hr[64 * j] = h[j];
            s2 += (h[j].x * h[j].x + h[j].y * h[j].y) + (h[j].z * h[j].z + h[j].w * h[j].w); }
        const float rstd2 = 1.0f / sqrtf(wave_sum(s2) * (1.f / D) + EPS);
        u32x2* o8 = (u32x2*)(XN2 + (size_t)row * D) + lane;
        float lg[16];
#pragma unroll
        for (int e = 0; e < 16; ++e) lg[e] = 0.f;
#pragma unroll
        for (int j = 0; j < 4; ++j) { const f32x4 sh2 = *(const LAS f32x4*)(mv + 1024 + 4 * lane + 256 * j), sc2 = *(const LAS f32x4*)(mv + 2048 + 4 * lane + 256 * j);
            const f32x4 z = ((h[j] * rstd2) * npf[64 * j]) * (sc2 + 1.0f) + sh2;
            u32x2 wv; wv.x = pk2(z.x, z.y); wv.y = pk2(z.z, z.w); o8[64 * j] = wv;
#pragma unroll
            for (int e = 0; e < 16; ++e) { const f32x4 wq = *(const LAS f32x4*)(wrt + e * D + 4 * lane + 256 * j); lg[e] += (z.x * wq.x + z.y * wq.y) + (z.z * wq.z + z.w * wq.w); } }
        float mxl = -1e30f;
#pragma unroll
        for (int e = 0; e < 16; ++e) { lg[e] = wave_sum(lg[e]); mxl = fmaxf(mxl, lg[e]); }
        float se = 0.f;
#pragma unroll
        for (int e = 0; e < 16; ++e) { lg[e] = __expf(lg[e] - mxl); se += lg[e]; }
        const float inv = 1.0f / se;
        float mine = 0.f;
#pragma unroll
        for (int e = 0; e < 16; ++e) mine = (lane == e) ? lg[e] * inv : mine;
        if (lane < 16) AFFT[((size_t)b * NE + lane) * T + t] = mine;
    }
}

__device__ __forceinline__ void p6_topk(const Args& a, LAS unsigned char* lds, int c, int G) {
    const int tid = threadIdx.x;
    unsigned char* ws = a.ws;
    const float* AFFT = (const float*)(ws + WS_AFFT); short* SLOT = (short*)(ws + WS_SLOT); int* IDX = (int*)(ws + WS_IDX); float* GATE = (float*)(ws + WS_GATE);
    LAS float* av = (LAS float*)lds;
    for (int item = c; item < NITEM; item += G) {
        const int b = item >> 4, e = item & 15;
        __syncthreads();
        for (int n = tid; n < T; n += NTHREADS) av[n] = AFFT[(size_t)item * T + n];
        __syncthreads();
        float mv[4]; int cnt[4];
#pragma unroll
        for (int k = 0; k < 4; ++k) { mv[k] = av[tid + NTHREADS * k]; cnt[k] = 0; }
        for (int t2 = 0; t2 < T; t2 += 4) {
            const f32x4 v = *(const LAS f32x4*)(av + t2);
#pragma unroll
            for (int q = 0; q < 4; ++q) {
                const float vv = v[q]; const int tt = t2 + q;
#pragma unroll
                for (int k = 0; k < 4; ++k) cnt[k] += (vv > mv[k] || (vv == mv[k] && tt < tid + NTHREADS * k)) ? 1 : 0;
            }
        }
#pragma unroll
        for (int k = 0; k < 4; ++k) { const int t = tid + NTHREADS * k; const int sl = cnt[k] < CAP ? cnt[k] : -1;
            SLOT[((size_t)b * T + t) * NE + e] = (short)sl;
            if (sl >= 0) { IDX[item * CAP + sl] = t; GATE[item * CAP + sl] = mv[k]; } }
    }
}

__device__ __forceinline__ void p8_final(const Args& a, LAS unsigned char* lds, int vcu, int G) {
    const int tid = threadIdx.x, lane = tid & 63, wave = __builtin_amdgcn_readfirstlane(tid >> 6);
    unsigned char* ws = a.ws;
    const short* SLOT = (const short*)(ws + WS_SLOT); const bf16_t* Y = (const bf16_t*)(ws + WS_Y); const float* MOD = (const float*)(ws + WS_MOD);
    const f32x4* npo = (const f32x4*)a.in[I_NPOST_FFN] + lane;
    const int gw = vcu * NWAVES + wave, NGW = G * NWAVES;
    for (int row = gw; row < M; row += NGW) {
        const int b = row >> 11;
        f32x4 ff[4];
#pragma unroll
        for (int j = 0; j < 4; ++j) ff[j] = (f32x4){0.f, 0.f, 0.f, 0.f};
        const short* sl = SLOT + (size_t)row * NE;
        for (int e = 0; e < NE; ++e) {
            const int s = __builtin_amdgcn_readfirstlane((int)sl[e]);
            if (s >= 0) {
                const u32x2* yr = (const u32x2*)(Y + ((size_t)(b * NE + e) * CAP + s) * D) + lane;
#pragma unroll
                for (int j = 0; j < 4; ++j) { const u32x2 wv = yr[64 * j]; ff[j] += (f32x4){bflo(wv.x), bfhi(wv.x), bflo(wv.y), bfhi(wv.y)}; }
            }
        }
        float s2 = 0.f;
#pragma unroll
        for (int j = 0; j < 4; ++j) s2 += (ff[j].x * ff[j].x + ff[j].y * ff[j].y) + (ff[j].z * ff[j].z + ff[j].w * ff[j].w);
        const float rstd = 1.0f / sqrtf(wave_sum(s2) * (1.f / D) + EPS);
        f32x4* hr = (f32x4*)(a.out + (size_t)row * D) + lane; const f32x4* g2 = (const f32x4*)(MOD + (size_t)b * NMOD + 5 * D) + lane;
#pragma unroll
        for (int j = 0; j < 4; ++j) hr[64 * j] = hr[64 * j] + g2[64 * j] * ((ff[j] * rstd) * npo[64 * j]);
    }
}

__global__ void __launch_bounds__(NTHREADS, 2) fwd_kernel(Args args) {
    extern __shared__ __attribute__((aligned(16))) unsigned char lds_raw[];
    LAS unsigned char* lds = (LAS unsigned char*)lds_raw;
    volatile LAS unsigned* MISC = (volatile LAS unsigned*)(lds + MISC_OFF);
    const int tid = threadIdx.x;
    const int G = gridDim.x, c = blockIdx.x;
    const int vcu = (G % 8 == 0) ? (c % 8) * (G / 8) + c / 8 : c;
    unsigned char* ws = args.ws;
    gu32* ctl = (gu32*)(ws + WS_CTL);
    for (int u = tid; u < (LDS_BYTES - LDSCTL_OFF) / 4; u += NTHREADS) ((LAS unsigned*)(lds + LDSCTL_OFF))[u] = 0u;
    __syncthreads();
    XcdBarrier bar; bar.bar = (unsigned*)(ctl + CW_BAR); bar.x = 0; bar.st = nullptr;
    const int lo = args.ph_lo, hi = args.ph_hi;
    if (hi - lo > 1) bar = xcd_barrier_post((unsigned*)(ctl + CW_BAR), MISC + 8);
#ifndef PHMASK
#define PHMASK 0xff
#endif
#define IN(k) (((PHMASK >> (k)) & 1) && lo <= (k) && (k) < hi)
#define SEAM(k) do { if (IN(k) && IN((k) + 1)) xcd_barrier(bar); } while (0)

    if (IN(0)) { p0_prologue(args, lds, vcu, G); } SEAM(0);
    if (IN(1)) { p1_xn(args, lds, c, G); } SEAM(1);
    if (IN(2)) {
        pg8::Gemm g{(const bf16_t*)(ws + WS_XN), (const bf16_t*)(ws + WS_WIN), D, nullptr};
        pg8::SchedProj S{G, c};
        pg8::EpiProj E{(bf16_t*)(ws + WS_Q), (bf16_t*)(ws + WS_K), (bf16_t*)(ws + WS_V), (bf16_t*)(ws + WS_GB), (bf16_t*)(ws + WS_U), (const float*)(ws + WS_TAB)};
        pg8::gemm_phase<pg8::EpiProj, pg8::SchedProj, true, true>(lds, g, S, E);
    } SEAM(2);
    if (IN(3)) { p3_conv_attn(args, lds, c, vcu, G); } SEAM(3);
    if (IN(4)) {
        {
            const int p = c;
#ifndef NO_P4
            pg8::Gemm g{(const bf16_t*)(ws + WS_MIXIN), (const bf16_t*)(ws + WS_WOUT), D, nullptr};
            pg8::SchedPanel S{p, 4};
            pg8::EpiBf16 E{(bf16_t*)(ws + WS_MIX), D};
            pg8::gemm_phase<pg8::EpiBf16, pg8::SchedPanel, true, true>(lds, g, S, E);
#endif
            VM_WAIT(); __syncthreads();
#ifndef NO_P5
            p5_rows(args, lds, p);
#endif
            __syncthreads();
        }
    } SEAM(4);
    if (IN(5)) { p6_topk(args, lds, c, G); } SEAM(5);
    if (IN(6)) {
#pragma unroll 1
        for (int it = 0; it < 2; ++it) {
            {
                const int item = 2 * c + it;
                const int b = item >> 4, e = item & 15;
#ifndef NO_G1
                {
                    pg8::Gemm g{(const bf16_t*)(ws + WS_XN) + (size_t)b * T * D, (const bf16_t*)(ws + WS_WGU) + (size_t)e * 2048 * D, D, (const int*)(ws + WS_IDX) + item * CAP};
                    pg8::SchedPanel S{0, 8};
                    pg8::EpiGU E{(bf16_t*)(ws + WS_HMID) + (size_t)item * CAP * D};
                    pg8::gemm_phase<pg8::EpiGU, pg8::SchedPanel, true, true, true>(lds, g, S, E);
                }
#endif
                VM_WAIT(); __syncthreads();
#ifndef NO_G2
                {
                    pg8::Gemm g{(const bf16_t*)(ws + WS_HMID) + (size_t)item * CAP * D, (const bf16_t*)(ws + WS_WDN) + (size_t)e * D * D, D, nullptr};
                    pg8::SchedPanel S{0, 4};
                    pg8::EpiDown E{(bf16_t*)(ws + WS_Y) + (size_t)item * CAP * D, (const float*)(ws + WS_GATE) + item * CAP};
                    pg8::gemm_phase<pg8::EpiDown, pg8::SchedPanel, true, true>(lds, g, S, E);
                }
#endif
                VM_WAIT(); __syncthreads();
            }
        }
    } SEAM(6);
    if (IN(7)) { p8_final(args, lds, vcu, G); }
#undef IN
#undef SEAM
}

extern "C" void kernel_launch(void* const* d_in, const int* in_sizes, int n_in, void* d_out, int out_size, void* d_ws, size_t ws_size, hipStream_t stream) {
    static int grid = 0;
    if (grid == 0) {
        if (n_in != 22 || in_sizes[0] != M * D || out_size != M * D || ws_size < WS_END) { fprintf(stderr, "kernel_launch: unexpected shapes (n_in %d, in0 %d, out %d, ws %zu)\n", n_in, n_in > 0 ? in_sizes[0] : -1, out_size, ws_size); grid = -1; return; }
        int dev = 0, cus = 0;
        if (hipGetDevice(&dev) != hipSuccess || hipDeviceGetAttribute(&cus, hipDeviceAttributeMultiprocessorCount, dev) != hipSuccess) { grid = -1; return; }
        if (hipFuncSetAttribute((const void*)fwd_kernel, hipFuncAttributeMaxDynamicSharedMemorySize, LDS_BYTES) != hipSuccess) { fprintf(stderr, "kernel_launch: hipFuncSetAttribute failed\n"); grid = -1; return; }
        (void)hipGetLastError();
        grid = cus;
        if (grid != 256) { fprintf(stderr, "kernel_launch: this kernel needs a 256-CU device (got %d)\n", cus); grid = -1; return; }
    }
    if (grid < 0) return;
    (void)hipMemsetAsync((char*)d_ws + WS_CTL, 0, CTL_ZERO_BYTES, stream);
    Args a{};
    for (int i = 0; i < 22; ++i) a.in[i] = (const float*)d_in[i];
    a.out = (float*)d_out; a.ws = (unsigned char*)d_ws;
    constexpr int NPH = 8;
    if (MK_N_LAUNCHES == 1) { a.ph_lo = 0; a.ph_hi = NPH; hipLaunchKernelGGL(fwd_kernel, dim3(grid), dim3(NTHREADS), LDS_BYTES, stream, a); }
    else { for (int k = 0; k < NPH; ++k) { a.ph_lo = k; a.ph_hi = k + 1; hipLaunchKernelGGL(fwd_kernel, dim3(grid), dim3(NTHREADS), LDS_BYTES, stream, a); } }
}
```

```cpp
#include <hip/hip_runtime.h>
#include <cstdio>
#include <cstdint>

#ifndef MK_N_LAUNCHES
#define MK_N_LAUNCHES 1
#endif

#define LAS __attribute__((address_space(3)))
#define GAS __attribute__((address_space(1)))
typedef unsigned short bf16_t;
typedef short bf16x8 __attribute__((ext_vector_type(8)));
typedef short s16x4 __attribute__((ext_vector_type(4)));
typedef float f32x4 __attribute__((ext_vector_type(4)));
typedef float f32x16 __attribute__((ext_vector_type(16)));
typedef unsigned u32x4 __attribute__((ext_vector_type(4)));
typedef unsigned u32x2 __attribute__((ext_vector_type(2)));

constexpr int NB = 32, T = 2048, D = 1024, TC = 256, M = NB * T, MC = NB * TC, MA = M + MC, TK = TC + T;
constexpr int NE = 16, CAP = 256, NITEM = NB * NE, NPROJ = 3072, NMOD = 6 * D;
constexpr float EPS = 1e-6f;
constexpr float C2 = 0.125f * 1.4426950408889634f;
constexpr float LAM_INIT = 0.2f;
constexpr int NWAVES = 8, NTHREADS = 512;

constexpr size_t MiB = 1u << 20;
constexpr size_t WS_CTL = 0, CTL_ZERO_BYTES = 1 * MiB;
constexpr size_t WS_MODP = 2 * MiB;
constexpr size_t WS_MOD = 16 * MiB;
constexpr size_t WS_TAB = 17 * MiB;
constexpr size_t WS_WIN = 18 * MiB;
constexpr size_t WS_WOUT = 24 * MiB;
constexpr size_t WS_WGU = 26 * MiB;
constexpr size_t WS_WDN = 90 * MiB;
constexpr size_t WS_AFFT = 122 * MiB;
constexpr size_t WS_SLOT = 126 * MiB;
constexpr size_t WS_IDX = 128 * MiB;
constexpr size_t WS_GATE = 129 * MiB;
constexpr size_t WS_XN = 130 * MiB;
constexpr size_t WS_Q = 274 * MiB;
constexpr size_t WS_K = 338 * MiB;
constexpr size_t WS_V = 410 * MiB;
constexpr size_t WS_GB = 482 * MiB;
constexpr size_t WS_U = 546 * MiB;
constexpr size_t WS_MIXIN = 610 * MiB;
constexpr size_t WS_MIX = 738 * MiB;
constexpr size_t WS_HMID = 274 * MiB;
constexpr size_t WS_Y = 610 * MiB;
constexpr size_t WS_END = 866 * MiB;

namespace pg8 {
constexpr int BM = 256, BK = 64, HALF = 128, HTB = HALF * BK * 2, STAGE_BYTES = 8 * HTB;
__host__ __device__ __forceinline__ int lds_byte(int r, int c) { const int st = (r >> 4) * 2 + (c >> 5), rr = r & 15, cc = c & 31, ob = rr * 64 + cc * 2; return st * 1024 + (ob ^ (((ob >> 9) & 1) << 5)); }
__host__ __device__ __forceinline__ void stage_rc(int b, int& R, int& C) { const int st = b / 1024, sb = b % 1024, swz = sb ^ (((sb >> 9) & 1) << 5); R = (st >> 1) * 16 + swz / 64; C = (st & 1) * 32 + (swz % 64) / 2; }
__host__ __device__ __forceinline__ int perm32(int rho) { const int n = rho >> 4, i = rho & 15; return 8 * (i >> 2) + 4 * n + (i & 3); }

struct Unit { int pm, pn; };
struct Gemm { const bf16_t* A; const bf16_t* Bt; int K; const int* gidx; };

__device__ __forceinline__ unsigned cvt_pk_bf16(float lo, float hi) { unsigned r; asm volatile("v_cvt_pk_bf16_f32 %0, %1, %2" : "=v"(r) : "v"(lo), "v"(hi)); return r; }

struct EpiBf16 {
    static constexpr bool PERM = true, AFTER_DRAIN = false;
    bf16_t* O; int ldc;
    __device__ __forceinline__ void operator()(const f32x4 (&acc)[2][2][4][2], const Unit& u, int wr, int wc, int fr, int fq) const {
        const int row0 = u.pm * BM + wr * 64 + fr; const int col0 = u.pn * BM + wc * 32 + 8 * fq;
#pragma unroll
        for (int ai = 0; ai < 2; ++ai)
#pragma unroll
            for (int m = 0; m < 4; ++m) { bf16_t* rowp = O + (size_t)(row0 + ai * HALF + m * 16) * ldc + col0;
#pragma unroll
                for (int bj = 0; bj < 2; ++bj) { const f32x4 v0 = acc[ai][bj][m][0], v1 = acc[ai][bj][m][1];
                    u32x4 w; w.x = cvt_pk_bf16(v0[0], v0[1]); w.y = cvt_pk_bf16(v0[2], v0[3]); w.z = cvt_pk_bf16(v1[0], v1[1]); w.w = cvt_pk_bf16(v1[2], v1[3]);
                    *(u32x4*)(rowp + bj * HALF) = w; } }
    }
};

struct EpiProj {
    static constexpr bool PERM = true, AFTER_DRAIN = false;
    bf16_t *Q, *KA, *VA, *GB, *U; const float* tab;
    __device__ __forceinline__ void operator()(const f32x4 (&acc)[2][2][4][2], const Unit& u, int wr, int wc, int fr, int fq) const {
        const int pn = u.pn; const bool ctx = u.pm >= 256;
#pragma unroll
        for (int ai = 0; ai < 2; ++ai)
#pragma unroll
            for (int m = 0; m < 4; ++m) {
                const int row = u.pm * BM + ai * HALF + wr * 64 + m * 16 + fr;
                int t, kvrow;
                if (!ctx) { const int b = row >> 11; t = row & 2047; kvrow = b * TK + TC + t; }
                else { const int rc = row - M; const int b = rc >> 8; t = 0; kvrow = b * TK + (rc & 255); }
                if (pn < 4) {
                    f32x4 cs0 = {1.f, 0.f, 1.f, 0.f}, cs1 = cs0, cs2 = cs0, cs3 = cs0;
                    if (!ctx) { const float* tp = tab + ((size_t)t * 32 + 16 * (wc & 1) + 4 * fq) * 2;
                        cs0 = *(const f32x4*)(tp); cs1 = *(const f32x4*)(tp + 4); }
                    (void)cs2; (void)cs3;
#pragma unroll
                    for (int bj = 0; bj < 2; ++bj) {
                        const f32x4 v0 = acc[ai][bj][m][0], v1 = acc[ai][bj][m][1];
                        float e0 = v0[0], o0 = v0[1], e1 = v0[2], o1 = v0[3], e2 = v1[0], o2 = v1[1], e3 = v1[2], o3 = v1[3];
                        float r0 = e0 * cs0[0] - o0 * cs0[1], s0 = o0 * cs0[0] + e0 * cs0[1];
                        float r1 = e1 * cs0[2] - o1 * cs0[3], s1 = o1 * cs0[2] + e1 * cs0[3];
                        float r2 = e2 * cs1[0] - o2 * cs1[1], s2 = o2 * cs1[0] + e2 * cs1[1];
                        float r3 = e3 * cs1[2] - o3 * cs1[3], s3 = o3 * cs1[2] + e3 * cs1[3];
                        const float sc = (pn < 2) ? C2 : 1.f;
                        u32x4 w; w.x = cvt_pk_bf16(r0 * sc, s0 * sc); w.y = cvt_pk_bf16(r1 * sc, s1 * sc); w.z = cvt_pk_bf16(r2 * sc, s2 * sc); w.w = cvt_pk_bf16(r3 * sc, s3 * sc);
                        const int col = (pn & 1) * 256 + bj * HALF + wc * 32 + 8 * fq;
                        bf16_t* dst = (pn < 2) ? (Q + (size_t)row * 512 + col) : (KA + (size_t)kvrow * 512 + col);
                        *(u32x4*)dst = w;
                    }
                } else if (pn < 8) {
#pragma unroll
                    for (int bj = 0; bj < 2; ++bj) {
                        const f32x4 v0 = acc[ai][bj][m][0], v1 = acc[ai][bj][m][1];
                        u32x4 w; w.x = cvt_pk_bf16(v0[0], v0[1]); w.y = cvt_pk_bf16(v0[2], v0[3]); w.z = cvt_pk_bf16(v1[0], v1[1]); w.w = cvt_pk_bf16(v1[2], v1[3]);
                        const int col = (pn & 1) * 256 + bj * HALF + wc * 32 + 8 * fq;
                        bf16_t* dst = (pn < 6) ? (VA + (size_t)kvrow * 512 + col) : (GB + (size_t)row * 512 + col);
                        *(u32x4*)dst = w;
                    }
                } else {
                    const f32x4 a0 = acc[ai][0][m][0], a1 = acc[ai][0][m][1], b0 = acc[ai][1][m][0], b1 = acc[ai][1][m][1];
                    u32x4 w; w.x = cvt_pk_bf16(a0[0] * b0[0], a0[1] * b0[1]); w.y = cvt_pk_bf16(a0[2] * b0[2], a0[3] * b0[3]);
                    w.z = cvt_pk_bf16(a1[0] * b1[0], a1[1] * b1[1]); w.w = cvt_pk_bf16(a1[2] * b1[2], a1[3] * b1[3]);
                    const int col = (pn - 8) * 128 + wc * 32 + 8 * fq;
                    *(u32x4*)(U + (size_t)row * 512 + col) = w;
                }
            }
    }
};

struct EpiGU {
    static constexpr bool PERM = true, AFTER_DRAIN = false;
    bf16_t* H;
    __device__ __forceinline__ float silu(float x) const { return x * __builtin_amdgcn_rcpf(1.f + __expf(-x)); }
    __device__ __forceinline__ void operator()(const f32x4 (&acc)[2][2][4][2], const Unit& u, int wr, int wc, int fr, int fq) const {
#pragma unroll
        for (int ai = 0; ai < 2; ++ai)
#pragma unroll
            for (int m = 0; m < 4; ++m) {
                const int row = ai * HALF + wr * 64 + m * 16 + fr;
                const f32x4 a0 = acc[ai][0][m][0], a1 = acc[ai][0][m][1], b0 = acc[ai][1][m][0], b1 = acc[ai][1][m][1];
                u32x4 w; w.x = cvt_pk_bf16(silu(a0[0]) * b0[0], silu(a0[1]) * b0[1]); w.y = cvt_pk_bf16(silu(a0[2]) * b0[2], silu(a0[3]) * b0[3]);
                w.z = cvt_pk_bf16(silu(a1[0]) * b1[0], silu(a1[1]) * b1[1]); w.w = cvt_pk_bf16(silu(a1[2]) * b1[2], silu(a1[3]) * b1[3]);
                *(u32x4*)(H + (size_t)row * 1024 + u.pn * 128 + wc * 32 + 8 * fq) = w;
            }
    }
};
struct EpiDown {
    static constexpr bool PERM = true, AFTER_DRAIN = false;
    bf16_t* Y; const float* gate;
    __device__ __forceinline__ void operator()(const f32x4 (&acc)[2][2][4][2], const Unit& u, int wr, int wc, int fr, int fq) const {
#pragma unroll
        for (int ai = 0; ai < 2; ++ai)
#pragma unroll
            for (int m = 0; m < 4; ++m) {
                const int row = ai * HALF + wr * 64 + m * 16 + fr; const float g = gate[row];
#pragma unroll
                for (int bj = 0; bj < 2; ++bj) { const f32x4 v0 = acc[ai][bj][m][0] * g, v1 = acc[ai][bj][m][1] * g;
                    u32x4 w; w.x = cvt_pk_bf16(v0[0], v0[1]); w.y = cvt_pk_bf16(v0[2], v0[3]); w.z = cvt_pk_bf16(v1[0], v1[1]); w.w = cvt_pk_bf16(v1[2], v1[3]);
                    *(u32x4*)(Y + (size_t)row * 1024 + u.pn * BM + bj * HALF + wc * 32 + 8 * fq) = w; }
            }
    }
};

struct SchedProj {
    int G, c;
    __device__ __forceinline__ bool next(int i, Unit& u) const {
        const int L = i * G + c;
        if (L < 3072) { u.pm = L & 255; u.pn = L >> 8; return true; }
        const int j = L - 3072; if (j >= 128) return false;
        u.pm = 256 + (j >> 2); u.pn = 2 + (j & 3); return true;
    }
    __device__ __forceinline__ void a_ready(const Unit&) const {}
    __device__ __forceinline__ void done(const Unit&) const {}
};
struct SchedPanel {
    int pm, ntn;
    __device__ __forceinline__ bool next(int i, Unit& u) const { if (i >= ntn) return false; u.pm = pm; u.pn = i; return true; }
    __device__ __forceinline__ void a_ready(const Unit&) const {}
    __device__ __forceinline__ void done(const Unit&) const {}
};

template <class Epi, class Sched, bool ALIGN_EPI, bool SP2, bool GATHER = false>
__device__ __forceinline__ void gemm_phase(LAS unsigned char* lds, const Gemm g, const Sched& S, const Epi& E) {
    const int tid = threadIdx.x, wid = __builtin_amdgcn_readfirstlane(tid >> 6), lane = tid & 63, wr = wid >> 2, wc = wid & 3, fr = lane & 15, fq = lane >> 4;
    const int K = g.K, nt = K / BK;
    unsigned voffA[2][2], voffB[2];
#pragma unroll
    for (int i = 0; i < 2; ++i) { int R, C; stage_rc(tid * 16 + i * 8192, R, C); const int Rb = Epi::PERM ? ((R & ~31) + perm32(R & 31)) : R;
        if constexpr (GATHER) { voffA[0][i] = (unsigned)(g.gidx[R] * K + C) * 2u; voffA[1][i] = (unsigned)(g.gidx[HALF + R] * K + C) * 2u; }
        else { voffA[0][i] = (unsigned)(R * K + C) * 2u; voffA[1][i] = voffA[0][i]; }
        voffB[i] = (unsigned)(Rb * K + C) * 2u; }
    const size_t kstep = (size_t)(BK * 2);
    const size_t hstep = (size_t)HALF * K * 2;
    const size_t hstepA = GATHER ? (size_t)0 : hstep;
    const size_t tstep = 2 * hstep;
    const unsigned ldsw = (unsigned)wid * 1024u;
    const int aoff = lds_byte(wr * 64 + fr, fq * 8), boff = lds_byte(wc * 32 + fr, fq * 8);
#define PG8_SA(b, h) (((b) * 2 + (h)) * HTB)
#define PG8_SB(b, h) ((4 + (b) * 2 + (h)) * HTB)
#define PG8_STAGE(bufoff, gbase, voff) do { _Pragma("unroll") for (int _i = 0; _i < 2; ++_i) \
        __builtin_amdgcn_global_load_lds((const unsigned*)((const char*)(gbase) + (voff)[_i]), (LAS unsigned*)(lds + (bufoff) + ldsw + _i * 8192), 16, 0, 0); } while (0)
#define PG8_LDA(dst, b, h) do { _Pragma("unroll") for (int m = 0; m < 4; ++m) _Pragma("unroll") for (int k = 0; k < 2; ++k) dst[m][k] = *(const LAS bf16x8*)(lds + PG8_SA(b, h) + aoff + m * 2048 + k * 1024); } while (0)
#define PG8_LDB(dst, b, h) do { _Pragma("unroll") for (int n = 0; n < 2; ++n) _Pragma("unroll") for (int k = 0; k < 2; ++k) dst[n][k] = *(const LAS bf16x8*)(lds + PG8_SB(b, h) + boff + n * 2048 + k * 1024); } while (0)
#define PG8_MMA(ai, bj, At, Bt) do { __builtin_amdgcn_s_setprio(1); _Pragma("unroll") for (int m = 0; m < 4; ++m) _Pragma("unroll") for (int n = 0; n < 2; ++n) _Pragma("unroll") for (int k = 0; k < 2; ++k) \
        acc[ai][bj][m][n] = __builtin_amdgcn_mfma_f32_16x16x32_bf16(Bt[n][k], At[m][k], acc[ai][bj][m][n], 0, 0, 0); __builtin_amdgcn_s_setprio(0); } while (0)
#define PG8_WAIT_V(n) asm volatile("s_waitcnt vmcnt(" #n ")" ::: "memory")
#define PG8_WAIT_L(n) asm volatile("s_waitcnt lgkmcnt(" #n ")" ::: "memory")
#define PG8_BAR __builtin_amdgcn_s_barrier()
#define PG8_SCHED __builtin_amdgcn_sched_barrier(0)
    Unit cur, nxt; int ui = 0;
    if (!S.next(0, cur)) return;
    f32x4 acc[2][2][4][2];
#pragma unroll
    for (int a = 0; a < 2; ++a)
#pragma unroll
        for (int b = 0; b < 2; ++b)
#pragma unroll
            for (int m = 0; m < 4; ++m)
#pragma unroll
                for (int n = 0; n < 2; ++n) acc[a][b][m][n] = (f32x4){0.f, 0.f, 0.f, 0.f};
    bf16x8 At[4][2], B0[2][2], B1[2][2];
    const char* cA = (const char*)g.A + (size_t)cur.pm * tstep; const char* cB = (const char*)g.Bt + (size_t)cur.pn * tstep;
    S.a_ready(cur);
    if constexpr (SP2) {
        PG8_STAGE(PG8_SB(0, 0), cB, voffB); PG8_STAGE(PG8_SB(0, 1), cB + hstep, voffB); PG8_STAGE(PG8_SA(0, 0), cA, voffA[0]); PG8_STAGE(PG8_SA(0, 1), cA + hstepA, voffA[1]);
        if (wr == 1) PG8_BAR;
        PG8_WAIT_V(2); PG8_BAR;
        PG8_STAGE(PG8_SB(1, 0), cB + kstep, voffB); PG8_STAGE(PG8_SA(1, 0), cA + kstep, voffA[0]); PG8_STAGE(PG8_SB(1, 1), cB + hstep + kstep, voffB);
        PG8_WAIT_V(6); PG8_BAR;
    } else {
        PG8_STAGE(PG8_SB(0, 0), cB, voffB); PG8_STAGE(PG8_SA(0, 0), cA, voffA[0]); PG8_STAGE(PG8_SB(0, 1), cB + hstep, voffB); PG8_STAGE(PG8_SA(0, 1), cA + hstepA, voffA[1]);
        if (wr == 1) PG8_BAR;
        PG8_WAIT_V(4); PG8_BAR;
        PG8_STAGE(PG8_SB(1, 0), cB + kstep, voffB); PG8_STAGE(PG8_SA(1, 0), cA + kstep, voffA[0]); PG8_STAGE(PG8_SB(1, 1), cB + hstep + kstep, voffB);
        PG8_WAIT_V(6); PG8_BAR;
    }
    for (;;) {
        const bool has_next = S.next(ui + 1, nxt);
        const char* nA = has_next ? (const char*)g.A + (size_t)nxt.pm * tstep : cA; const char* nB = has_next ? (const char*)g.Bt + (size_t)nxt.pn * tstep : cB;
        for (int t = 0; t < nt; t += 2) {
            const bool last = (t == nt - 2);
            const char* a1 = cA + (size_t)(t + 1) * kstep;
            const char* a2 = last ? nA : cA + (size_t)(t + 2) * kstep; const char* b2 = last ? nB : cB + (size_t)(t + 2) * kstep;
            const char* a3 = a2 + kstep; const char* b3 = b2 + kstep;
            if (last && has_next) S.a_ready(nxt);
            if constexpr (SP2) {
            PG8_LDB(B0, 0, 0); PG8_LDB(B1, 0, 1); PG8_SCHED; PG8_LDA(At, 0, 0); PG8_STAGE(PG8_SA(1, 1), a1 + hstepA, voffA[1]);
            PG8_WAIT_V(8); PG8_WAIT_L(0); PG8_BAR; PG8_MMA(0, 0, At, B0); PG8_MMA(0, 1, At, B1); PG8_BAR; PG8_SCHED;
            PG8_LDA(At, 0, 1); PG8_STAGE(PG8_SB(0, 0), b2, voffB); PG8_STAGE(PG8_SB(0, 1), b2 + hstep, voffB); PG8_STAGE(PG8_SA(0, 0), a2, voffA[0]);
            PG8_WAIT_V(8); PG8_WAIT_L(0); PG8_BAR; PG8_MMA(1, 0, At, B0); PG8_MMA(1, 1, At, B1); PG8_BAR; PG8_SCHED;
            PG8_LDB(B0, 1, 0); PG8_LDB(B1, 1, 1); PG8_SCHED; PG8_LDA(At, 1, 0); PG8_STAGE(PG8_SA(0, 1), a2 + hstepA, voffA[1]);
            PG8_WAIT_V(8); PG8_WAIT_L(0); PG8_BAR; PG8_MMA(0, 0, At, B0); PG8_MMA(0, 1, At, B1); PG8_BAR; PG8_SCHED;
            PG8_LDA(At, 1, 1); PG8_STAGE(PG8_SB(1, 0), b3, voffB); PG8_STAGE(PG8_SB(1, 1), b3 + hstep, voffB); PG8_STAGE(PG8_SA(1, 0), a3, voffA[0]);
            PG8_WAIT_V(8); PG8_WAIT_L(0); PG8_BAR; PG8_MMA(1, 0, At, B0); PG8_MMA(1, 1, At, B1); PG8_BAR; PG8_SCHED;
            } else {
            PG8_LDB(B0, 0, 0); PG8_SCHED; PG8_LDA(At, 0, 0); PG8_STAGE(PG8_SA(1, 1), a1 + hstepA, voffA[1]);
            PG8_WAIT_L(8); PG8_BAR; PG8_WAIT_L(0); PG8_MMA(0, 0, At, B0); PG8_BAR; PG8_SCHED;
            PG8_LDB(B1, 0, 1); PG8_STAGE(PG8_SB(0, 0), b2, voffB);
            PG8_BAR; PG8_WAIT_L(0); PG8_MMA(0, 1, At, B1); PG8_BAR;
            PG8_LDA(At, 0, 1); PG8_STAGE(PG8_SA(0, 0), a2, voffA[0]);
            PG8_BAR; PG8_WAIT_L(0); PG8_MMA(1, 0, At, B0); PG8_BAR; PG8_SCHED;
            PG8_STAGE(PG8_SB(0, 1), b2 + hstep, voffB);
            PG8_WAIT_V(6); PG8_BAR; PG8_MMA(1, 1, At, B1); PG8_BAR;
            PG8_LDB(B0, 1, 0); PG8_SCHED; PG8_LDA(At, 1, 0); PG8_STAGE(PG8_SA(0, 1), a2 + hstepA, voffA[1]);
            PG8_WAIT_L(8); PG8_BAR; PG8_WAIT_L(0); PG8_MMA(0, 0, At, B0); PG8_BAR; PG8_SCHED;
            PG8_LDB(B1, 1, 1); PG8_STAGE(PG8_SB(1, 0), b3, voffB);
            PG8_BAR; PG8_WAIT_L(0); PG8_MMA(0, 1, At, B1); PG8_BAR;
            PG8_LDA(At, 1, 1); PG8_STAGE(PG8_SA(1, 0), a3, voffA[0]);
            PG8_BAR; PG8_WAIT_L(0); PG8_MMA(1, 0, At, B0); PG8_BAR; PG8_SCHED;
            PG8_STAGE(PG8_SB(1, 1), b3 + hstep, voffB);
            PG8_WAIT_V(6); PG8_BAR; PG8_MMA(1, 1, At, B1); PG8_BAR;
            }
        }
        if constexpr (ALIGN_EPI) { if (wr == 0) PG8_BAR; }
        E(acc, cur, wr, wc, fr, fq); S.done(cur);
        if (!has_next) break;
#pragma unroll
        for (int a = 0; a < 2; ++a)
#pragma unroll
            for (int b = 0; b < 2; ++b)
#pragma unroll
                for (int m = 0; m < 4; ++m)
#pragma unroll
                    for (int n = 0; n < 2; ++n) acc[a][b][m][n] = (f32x4){0.f, 0.f, 0.f, 0.f};
        cur = nxt; cA = nA; cB = nB; ++ui;
        if constexpr (ALIGN_EPI) { if (wr == 1) PG8_BAR; }
    }
    PG8_WAIT_V(0);
    if constexpr (!ALIGN_EPI) { if (wr == 0) PG8_BAR; }
    PG8_BAR;
#undef PG8_SA
#undef PG8_SB
#undef PG8_STAGE
#undef PG8_LDA
#undef PG8_LDB
#undef PG8_MMA
#undef PG8_WAIT_V
#undef PG8_WAIT_L
#undef PG8_BAR
#undef PG8_SCHED
}
}

typedef GAS unsigned gu32;
#define RLX_AGENT __ATOMIC_RELAXED, __HIP_MEMORY_SCOPE_AGENT
#define LDS_WAIT() asm volatile("s_waitcnt lgkmcnt(0)" ::: "memory")
#define VM_WAIT() asm volatile("s_waitcnt vmcnt(0)" ::: "memory")
__device__ __forceinline__ unsigned pk2(float lo, float hi) { return pg8::cvt_pk_bf16(lo, hi); }
__device__ __forceinline__ float bf2f(unsigned short h) { return __uint_as_float((unsigned)h << 16); }
__device__ __forceinline__ float bflo(unsigned w) { return __uint_as_float(w << 16); }
__device__ __forceinline__ float bfhi(unsigned w) { return __uint_as_float(w & 0xffff0000u); }
__device__ __forceinline__ float wave_sum(float v) {
#pragma unroll
    for (int o = 1; o < 64; o <<= 1) v += __shfl_xor(v, o);
    return v;
}

#define XB_TMO      128
#define XB_XCNT(j)  (256  + 64 * (j))
#define XB_XSUB(j)  (1280 + 64 * (j))
#define XB_XGEN(j)  (2304 + 64 * (j))
#define XB_TOP      3328
#define XB_TOPGEN   3392
#define XCD_BAR_WORDS 3456
#define XB_SPIN_CAP (1u << 18)
__device__ __forceinline__ unsigned xb_ld(unsigned* p)              { return __hip_atomic_load(p, __ATOMIC_RELAXED, __HIP_MEMORY_SCOPE_AGENT); }
__device__ __forceinline__ unsigned xb_add(unsigned* p, unsigned v) { return __hip_atomic_fetch_add(p, v, __ATOMIC_RELAXED, __HIP_MEMORY_SCOPE_AGENT); }
__device__ __forceinline__ unsigned xb_xcc_id() { return (unsigned)__builtin_amdgcn_s_getreg((3 << 11) | 20) & 0xFu; }
#define XB_SPIN(cond, bar) do { unsigned _sp = 0; while (cond) { __builtin_amdgcn_s_sleep(1); \
    if ((++_sp & 255u) == 0u) { if (xb_ld(&(bar)[XB_TMO])) break; if (_sp > XB_SPIN_CAP) { atomicAdd(&(bar)[XB_TMO], 1u); break; } } } } while (0)
struct XcdBarrier { unsigned* bar; unsigned x; volatile LAS unsigned* st; };
__device__ __forceinline__ XcdBarrier xcd_barrier_post(unsigned* bar, volatile LAS unsigned* st) {
    XcdBarrier b; b.bar = bar; b.x = xb_xcc_id(); b.st = st;
    if (threadIdx.x == 0) (void)xb_add(&bar[XB_XCNT(b.x)], 1u);
    return b;
}
__device__ __forceinline__ void xcd_barrier_complete(unsigned* bar, unsigned x, unsigned& nloc, unsigned& nx) {
    const unsigned G = gridDim.x * gridDim.y * gridDim.z;
    unsigned sum, cnt, mine, sp = 0u;
    for (;;) {
        sum = 0u; cnt = 0u; mine = 0u;
#pragma unroll
        for (unsigned j = 0; j < 16; ++j) { const unsigned c = xb_ld(&bar[XB_XCNT(j)]); sum += c; cnt += (c > 0u) ? 1u : 0u; mine = (j == x) ? c : mine; }
        if (sum == G) break;
        __builtin_amdgcn_s_sleep(1);
        if ((++sp & 255u) == 0u) { if (xb_ld(&bar[XB_TMO])) break; if (sp > XB_SPIN_CAP) { atomicAdd(&bar[XB_TMO], 1u); break; } }
    }
    nloc = mine > 0u ? mine : 1u; nx = cnt > 0u ? cnt : 1u;
}
__device__ __forceinline__ void xcd_barrier(const XcdBarrier& b) {
    asm volatile("s_waitcnt vmcnt(0)" ::: "memory");
    __syncthreads();
    if (threadIdx.x == 0) {
        unsigned* bar = b.bar;
        __builtin_amdgcn_s_waitcnt(0);
        unsigned nloc = b.st[0], nx = b.st[1];
        if (nloc == 0u) { xcd_barrier_complete(bar, b.x, nloc, nx); b.st[0] = nloc; b.st[1] = nx; }
        const unsigned old = xb_add(&bar[XB_XSUB(b.x)], 1u);
        const unsigned gen = old / nloc;
        if (old + 1u == (gen + 1u) * nloc) {
            __builtin_amdgcn_fence(__ATOMIC_RELEASE, "agent");
            asm volatile("s_waitcnt vmcnt(0)" ::: "memory");
            const unsigned og = xb_add(&bar[XB_TOP], 1u);
            const unsigned tg = og / nx;
            if (og + 1u == (tg + 1u) * nx) xb_add(&bar[XB_TOPGEN], 1u);
            else XB_SPIN(xb_ld(&bar[XB_TOPGEN]) == tg, bar);
            __builtin_amdgcn_fence(__ATOMIC_ACQUIRE, "agent");
            xb_add(&bar[XB_XGEN(b.x)], 1u);
            asm volatile("s_waitcnt vmcnt(0)" ::: "memory");
        } else {
            XB_SPIN(xb_ld(&bar[XB_XGEN(b.x)]) == gen, bar);
            __builtin_amdgcn_fence(__ATOMIC_ACQUIRE, "agent");
            asm volatile("s_waitcnt vmcnt(0)" ::: "memory");
        }
    }
    __syncthreads();
}

constexpr int RING_BYTES = 131072;
constexpr int LDSCTL_OFF = RING_BYTES, MISC_OFF = LDSCTL_OFF + 320;
constexpr int LDS_BYTES = 147456;
constexpr int CW_BAR = 4096;

struct Args { const float* in[22]; float* out; unsigned char* ws; int ph_lo, ph_hi; };
enum { I_X = 0, I_C, I_CTX, I_CCTX, I_WADA, I_BADA, I_NPRE_MIX, I_NPOST_MIX, I_NPRE_FFN, I_NPOST_FFN, I_WIN, I_CONVW, I_LQ1, I_LK1, I_LQ2, I_LK2, I_SUBLN, I_WOUT, I_WROUTER, I_WGATE, I_WUP, I_WDOWN };

__device__ __forceinline__ int win_dest(int n) {
    if (n < 1024) { const int j = n & 63; const int p = ((j >> 5) << 5) + ((j & 15) << 1) + ((j >> 4) & 1); return (n & ~63) + p; }
    if (n < 2048) return n;
    int c = n - 2048; const int isx = c >= 512; c &= 511; return 2048 + ((c >> 7) << 8) + (isx << 7) + (c & 127);
}
template <int MODE>
__device__ __forceinline__ int tr_dest(int n) {
    if (MODE == 0) return n;
    if (MODE == 1) return win_dest(n);
    if (MODE == 2) return ((n >> 7) << 8) + (n & 127);
    return ((n >> 7) << 8) + 128 + (n & 127);
}
template <int MODE>
__device__ __forceinline__ void p0_transpose_item(const float* W, int K, int N, bf16_t* WT, LAS float* scr, int item, int lane) {
    const int nblk = N / 32, kb = item / nblk, nb = item % nblk, k0 = 64 * kb, n0 = 32 * nb;
#pragma unroll 8
    for (int i = 0; i < 32; ++i) { const int kk = 2 * i + (lane >> 5); scr[kk * 33 + (lane & 31)] = W[(size_t)(k0 + kk) * N + n0 + (lane & 31)]; }
    LDS_WAIT(); asm volatile("" ::: "memory");
    const int c = lane & 7;
#pragma unroll
    for (int j = 0; j < 4; ++j) { const int n = (lane >> 3) + 8 * j; const LAS float* s = scr + (8 * c) * 33 + n;
        u32x4 o; o.x = pk2(s[0 * 33], s[1 * 33]); o.y = pk2(s[2 * 33], s[3 * 33]); o.z = pk2(s[4 * 33], s[5 * 33]); o.w = pk2(s[6 * 33], s[7 * 33]);
        *(GAS u32x4*)(WT + (size_t)tr_dest<MODE>(n0 + n) * K + k0 + 8 * c) = o; }
    LDS_WAIT(); asm volatile("" ::: "memory");
}

__device__ __forceinline__ void p0_prologue(const Args& a, LAS unsigned char* lds, int vcu, int G) {
    const int tid = threadIdx.x, lane = tid & 63, wave = __builtin_amdgcn_readfirstlane(tid >> 6);
    LAS float* scr = (LAS float*)(lds + wave * 16384);
    const int gw = vcu * NWAVES + wave, NGW = G * NWAVES;
    unsigned char* ws = a.ws;
    {
        float* MODP = (float*)(ws + WS_MODP);
        const float* wada = a.in[I_WADA];
        for (int it = gw; it < 96 * 16; it += NGW) {
            const int cg = it % 96, kc = it / 96;
            for (int b = 0; b < 33; ++b) { const float v = (b < 32) ? a.in[I_C][b * D + kc * 64 + lane] : a.in[I_CCTX][kc * 64 + lane]; scr[b * 64 + lane] = v / (1.f + __expf(-v)); }
            LDS_WAIT(); asm volatile("" ::: "memory");
            float acc[33];
#pragma unroll
            for (int b = 0; b < 33; ++b) acc[b] = 0.f;
            for (int k = 0; k < 64; ++k) {
                const float w = wada[(size_t)(kc * 64 + k) * NMOD + cg * 64 + lane];
#pragma unroll
                for (int b = 0; b < 33; ++b) acc[b] += scr[b * 64 + k] * w;
            }
#pragma unroll
            for (int b = 0; b < 33; ++b) MODP[((size_t)kc * 33 + b) * NMOD + cg * 64 + lane] = acc[b];
            LDS_WAIT(); asm volatile("" ::: "memory");
        }
    }
    {
        float* tab = (float*)(ws + WS_TAB);
        for (int e = gw * 64 + lane; e < T * 32; e += NGW * 64) {
            const int t = e >> 5, i = e & 31;
            const float inv = powf(10000.0f, -(float)(2 * (i & 15)) / 32.0f);
            const float pos = (i < 16) ? (float)(t >> 6) : (float)(t & 63);
            const float ang = pos * inv;
            tab[2 * e] = cosf(ang); tab[2 * e + 1] = sinf(ang);
        }
    }
    constexpr int I_IN = (D / 64) * (NPROJ / 32), I_OUT = (D / 64) * (D / 32), I_EXP = (D / 64) * (D / 32);
    constexpr int NITEMS = I_IN + I_OUT + NE * 3 * I_EXP;
    bf16_t* Win_t = (bf16_t*)(ws + WS_WIN); bf16_t* Wout_t = (bf16_t*)(ws + WS_WOUT); bf16_t* Wgu_t = (bf16_t*)(ws + WS_WGU); bf16_t* Wdn_t = (bf16_t*)(ws + WS_WDN);
    for (int it = gw; it < NITEMS; it += NGW) {
        int r = it;
        if (r < I_IN) { p0_transpose_item<1>(a.in[I_WIN], D, NPROJ, Win_t, scr, r, lane); continue; } r -= I_IN;
        if (r < I_OUT) { p0_transpose_item<0>(a.in[I_WOUT], D, D, Wout_t, scr, r, lane); continue; } r -= I_OUT;
        const int e = r / (3 * I_EXP), q = (r % (3 * I_EXP)) / I_EXP, rr = r % I_EXP;
        if (q == 0) p0_transpose_item<2>(a.in[I_WGATE] + (size_t)e * D * D, D, D, Wgu_t + (size_t)e * 2048 * D, scr, rr, lane);
        else if (q == 1) p0_transpose_item<3>(a.in[I_WUP] + (size_t)e * D * D, D, D, Wgu_t + (size_t)e * 2048 * D, scr, rr, lane);
        else p0_transpose_item<0>(a.in[I_WDOWN] + (size_t)e * D * D, D, D, Wdn_t + (size_t)e * D * D, scr, rr, lane);
    }
}

__device__ __forceinline__ void norm_mod_row(const float* xrow, bf16_t* orow, const float* gain, const LAS float* sc, const LAS float* sh, int lane) {
    const f32x4* xr = (const f32x4*)xrow + lane; const f32x4* gr = (const f32x4*)gain + lane;
    f32x4 v[4]; float s = 0.f;
#pragma unroll
    for (int j = 0; j < 4; ++j) { v[j] = xr[64 * j]; s += (v[j].x * v[j].x + v[j].y * v[j].y) + (v[j].z * v[j].z + v[j].w * v[j].w); }
    const float rstd = 1.0f / sqrtf(wave_sum(s) * (1.f / D) + EPS);
    u32x2* o8 = (u32x2*)orow + lane;
#pragma unroll
    for (int j = 0; j < 4; ++j) { const f32x4 g = gr[64 * j]; const f32x4 c1 = *(const LAS f32x4*)(sc + 4 * lane + 256 * j), h1 = *(const LAS f32x4*)(sh + 4 * lane + 256 * j);
        const f32x4 y = (v[j] * rstd) * g; const f32x4 z = y * (c1 + 1.0f) + h1;
        u32x2 w; w.x = pk2(z.x, z.y); w.y = pk2(z.z, z.w); o8[64 * j] = w; }
}
__device__ __forceinline__ void p1_xn(const Args& a, LAS unsigned char* lds, int c, int G) {
    const int tid = threadIdx.x, lane = tid & 63, wave = __builtin_amdgcn_readfirstlane(tid >> 6);
    unsigned char* ws = a.ws;
    const float* MODP = (const float*)(ws + WS_MODP); float* MOD = (float*)(ws + WS_MOD); const float* bada = a.in[I_BADA];
    for (int r = c; r < 33; r += G)
        for (int n = tid; n < NMOD; n += NTHREADS) { float s = bada[n];
#pragma unroll
            for (int kc = 0; kc < 16; ++kc) s += MODP[((size_t)kc * 33 + r) * NMOD + n];
            MOD[(size_t)r * NMOD + n] = s; }
    LAS float* sv = (LAS float*)lds;
    bf16_t* XN = (bf16_t*)(ws + WS_XN);
    for (int p = c; p < 256; p += G) {
        const int b = p >> 3;
        __syncthreads();
        for (int n = tid; n < 4096; n += NTHREADS) { const int r = (n < 2048) ? b : 32; const int col = n & 2047; float s = bada[col];
#pragma unroll
            for (int kc = 0; kc < 16; ++kc) s += MODP[((size_t)kc * 33 + r) * NMOD + col];
            sv[n] = s; }
        __syncthreads();
        for (int i = 0; i < 32; ++i) { const int row = p * 256 + wave * 32 + i;
            norm_mod_row(a.in[I_X] + (size_t)row * D, XN + (size_t)row * D, a.in[I_NPRE_MIX], sv + 1024, sv, lane); }
        for (int i = 0; i < 4; ++i) { const int row = p * 32 + wave * 4 + i;
            norm_mod_row(a.in[I_CTX] + (size_t)row * D, XN + (size_t)(M + row) * D, a.in[I_NPRE_MIX], sv + 3072, sv + 2048, lane); }
    }
}

namespace att {
constexpr int KP = 272, KBUF = 64 * KP, VBUF = 16384;
constexpr int OFF_K = 0, OFF_V = 2 * KBUF, OFF_WSF = OFF_V + 2 * VBUF, OFF_END = OFF_WSF + NWAVES * 256;
static_assert(OFF_WSF >= 65536 && OFF_END <= RING_BYTES, "attention LDS map");
constexpr int NT = TK / 64;
constexpr float THR = 8.0f;
__device__ __forceinline__ int crow(int r, int hi) { return (r & 3) + 8 * (r >> 2) + 4 * hi; }
__device__ __forceinline__ s16x4 vtr(const LAS unsigned char* p) { return __builtin_bit_cast(s16x4, __builtin_amdgcn_ds_read_tr16_b64_v4i16((LAS s16x4*)p)); }

__device__ __forceinline__ void unit(LAS unsigned char* lds, int b, int h, int qb, const bf16_t* Q, const bf16_t* KA, const bf16_t* VA, bf16_t* MIXIN, const float* subg, float lam) {
    const int tid = threadIdx.x, lane = tid & 63, r32 = lane & 31, hi = lane >> 5;
    const int wid = __builtin_amdgcn_readfirstlane(tid >> 6), w = wid & 3, m = wid >> 2;
    LAS float* wsf = (LAS float*)(lds + OFF_WSF) + wid * 64;
    const int rowQ = b * T + qb * 128 + w * 32;
    bf16x8 qr[4];
#pragma unroll
    for (int d0 = 0; d0 < 4; ++d0) qr[d0] = *(const bf16x8*)(Q + (size_t)(rowQ + r32) * 512 + h * 128 + m * 64 + d0 * 16 + hi * 8);
    const bf16_t* Kb = KA + (size_t)b * TK * 512 + h * 128; const bf16_t* Vb = VA + (size_t)b * TK * 512 + h * 128;
    int gsrc[2], kdst[2], vdst[2];
#pragma unroll
    for (int i = 0; i < 2; ++i) { const int cid = tid + 512 * i, kv = cid >> 4, c16 = cid & 15;
        gsrc[i] = kv * 512 + c16 * 8; kdst[i] = kv * KP + c16 * 16; vdst[i] = (c16 >> 2) * 4096 + (kv >> 4) * 1024 + (kv & 15) * 64 + (c16 & 3) * 16; }
    u32x4 kr[2], vr[2];
#pragma unroll
    for (int i = 0; i < 2; ++i) { kr[i] = *(const u32x4*)(Kb + gsrc[i]); vr[i] = *(const u32x4*)(Vb + gsrc[i]); }
#pragma unroll
    for (int i = 0; i < 2; ++i) { *(LAS u32x4*)(lds + OFF_K + kdst[i]) = kr[i]; *(LAS u32x4*)(lds + OFF_V + vdst[i]) = vr[i]; }
    __syncthreads();
    f32x16 o[4];
#pragma unroll
    for (int d0 = 0; d0 < 4; ++d0) o[d0] = (f32x16){};
    float mhat = -1e30f, l_reg = 0.f;
    const int koff = r32 * KP + m * 128 + hi * 16;
    const int voff = ((lane >> 4) & 1) * 32 + (lane & 3) * 8 + (4 * hi + ((lane & 15) >> 2)) * 64;
    for (int j = 0; j < NT; ++j) {
        const int cur = j & 1;
        if (j + 1 < NT) {
#pragma unroll
            for (int i = 0; i < 2; ++i) { kr[i] = *(const u32x4*)(Kb + (size_t)(j + 1) * 64 * 512 + gsrc[i]); vr[i] = *(const u32x4*)(Vb + (size_t)(j + 1) * 64 * 512 + gsrc[i]); }
        }
        const LAS unsigned char* kb = lds + OFF_K + cur * KBUF + koff;
        const LAS unsigned char* vb = lds + OFF_V + cur * VBUF + voff;
        f32x16 p0 = (f32x16){}, p1 = (f32x16){};
#pragma unroll
        for (int d0 = 0; d0 < 4; ++d0) {
            const bf16x8 k0 = *(const LAS bf16x8*)(kb + d0 * 32);
            const bf16x8 k1 = *(const LAS bf16x8*)(kb + 32 * KP + d0 * 32);
            p0 = __builtin_amdgcn_mfma_f32_32x32x16_bf16(k0, qr[d0], p0, 0, 0, 0);
            p1 = __builtin_amdgcn_mfma_f32_32x32x16_bf16(k1, qr[d0], p1, 0, 0, 0);
        }
        float rm = fmaxf(p0[0], p1[0]);
#pragma unroll
        for (int r = 1; r < 16; ++r) rm = fmaxf(rm, fmaxf(p0[r], p1[r]));
        rm = fmaxf(rm, __shfl_xor(rm, 32));
        if (__any(rm > mhat + THR)) {
            const float mn = fmaxf(mhat, rm); const float f = __builtin_amdgcn_exp2f(mhat - mn); mhat = mn; l_reg *= f;
            if (hi == 0) wsf[r32] = f;
            LDS_WAIT();
#pragma unroll
            for (int r = 0; r < 16; ++r) { const float fr_ = wsf[crow(r, hi)];
#pragma unroll
                for (int d0 = 0; d0 < 4; ++d0) o[d0][r] *= fr_; }
            LDS_WAIT();
        }
        float sacc = 0.f;
#pragma unroll
        for (int r = 0; r < 16; ++r) { p0[r] = __builtin_amdgcn_exp2f(p0[r] - mhat); p1[r] = __builtin_amdgcn_exp2f(p1[r] - mhat); sacc += p0[r] + p1[r]; }
        l_reg += sacc;
        u32x4 pw[4];
#pragma unroll
        for (int q = 0; q < 4; ++q) { pw[0][q] = pk2(p0[2 * q], p0[2 * q + 1]); pw[1][q] = pk2(p0[8 + 2 * q], p0[8 + 2 * q + 1]); pw[2][q] = pk2(p1[2 * q], p1[2 * q + 1]); pw[3][q] = pk2(p1[8 + 2 * q], p1[8 + 2 * q + 1]); }
#pragma unroll
        for (int d0 = 0; d0 < 4; ++d0) {
#pragma unroll
            for (int ks = 0; ks < 4; ++ks) {
                const s16x4 lo = vtr(vb + d0 * 4096 + ks * 1024), hh = vtr(vb + d0 * 4096 + ks * 1024 + 512);
                const bf16x8 vf = (bf16x8){lo[0], lo[1], lo[2], lo[3], hh[0], hh[1], hh[2], hh[3]};
                o[d0] = __builtin_amdgcn_mfma_f32_32x32x16_bf16(__builtin_bit_cast(bf16x8, pw[ks]), vf, o[d0], 0, 0, 0);
            }
        }
        if (j + 1 < NT) {
#pragma unroll
            for (int i = 0; i < 2; ++i) { *(LAS u32x4*)(lds + OFF_K + (cur ^ 1) * KBUF + kdst[i]) = kr[i]; *(LAS u32x4*)(lds + OFF_V + (cur ^ 1) * VBUF + vdst[i]) = vr[i]; }
        }
        __syncthreads();
    }
    l_reg += __shfl_xor(l_reg, 32);
    if (hi == 0) wsf[32 + r32] = l_reg;
    LDS_WAIT();
    float rli[16];
#pragma unroll
    for (int r = 0; r < 16; ++r) rli[r] = 1.0f / wsf[32 + crow(r, hi)];
    LDS_WAIT();
    LAS float* ex = (LAS float*)lds + w * 4096;
    if (m == 1) {
#pragma unroll
        for (int r = 0; r < 16; ++r)
#pragma unroll
            for (int d0 = 0; d0 < 4; ++d0) ex[crow(r, hi) * 128 + d0 * 32 + r32] = o[d0][r] * rli[r];
    }
    __syncthreads();
    if (m == 0) {
        float g4[4];
#pragma unroll
        for (int d0 = 0; d0 < 4; ++d0) g4[d0] = subg[d0 * 32 + r32] * (1.0f - LAM_INIT);
#pragma unroll
        for (int r = 0; r < 16; ++r) {
            const int q = crow(r, hi); float x[4]; float ss = 0.f;
#pragma unroll
            for (int d0 = 0; d0 < 4; ++d0) { x[d0] = o[d0][r] * rli[r] - lam * ex[q * 128 + d0 * 32 + r32]; ss += x[d0] * x[d0]; }
#pragma unroll
            for (int off = 1; off < 32; off <<= 1) ss += __shfl_xor(ss, off);
            const float rstd = 1.0f / sqrtf(ss * (1.f / 128.f) + EPS);
            bf16_t* dst = MIXIN + (size_t)(rowQ + q) * 1024 + h * 128 + r32;
#pragma unroll
            for (int d0 = 0; d0 < 4; ++d0) dst[d0 * 32] = (bf16_t)(pk2(x[d0] * rstd * g4[d0], 0.f) & 0xffffu);
        }
    }
    __syncthreads();
}
}

__device__ __forceinline__ void p3_conv_attn(const Args& a, LAS unsigned char* lds, int c, int vcu, int G) {
    const int tid = threadIdx.x, lane = tid & 63, wave = __builtin_amdgcn_readfirstlane(tid >> 6);
    unsigned char* ws = a.ws;
    const bf16_t* GB = (const bf16_t*)(ws + WS_GB); const bf16_t* U = (const bf16_t*)(ws + WS_U); bf16_t* MIXIN = (bf16_t*)(ws + WS_MIXIN);
    {
        const float* cw = a.in[I_CONVW]; float w0[8], w1[8], w2[8];
#pragma unroll
        for (int i = 0; i < 8; ++i) { w0[i] = cw[lane * 8 + i]; w1[i] = cw[512 + lane * 8 + i]; w2[i] = cw[1024 + lane * 8 + i]; }
        const int gw = vcu * NWAVES + wave, NGW = G * NWAVES;
        for (int row = gw; row < M; row += NGW) {
            const int t = row & (T - 1);
            const u32x4 z = {0u, 0u, 0u, 0u};
            const u32x4 uc = *(const u32x4*)(U + (size_t)row * 512 + lane * 8);
            const u32x4 up = (t > 0) ? *(const u32x4*)(U + (size_t)(row - 1) * 512 + lane * 8) : z;
            const u32x4 un = (t < T - 1) ? *(const u32x4*)(U + (size_t)(row + 1) * 512 + lane * 8) : z;
            const u32x4 gb = *(const u32x4*)(GB + (size_t)row * 512 + lane * 8);
            u32x4 o;
#pragma unroll
            for (int q = 0; q < 4; ++q) {
                const float y0 = w0[2 * q] * bflo(up[q]) + w1[2 * q] * bflo(uc[q]) + w2[2 * q] * bflo(un[q]);
                const float y1 = w0[2 * q + 1] * bfhi(up[q]) + w1[2 * q + 1] * bfhi(uc[q]) + w2[2 * q + 1] * bfhi(un[q]);
                o[q] = pk2(bflo(gb[q]) * y0, bfhi(gb[q]) * y1);
            }
            *(u32x4*)(MIXIN + (size_t)row * 1024 + 512 + lane * 8) = o;
        }
    }
    float lam;
    { const float p1 = a.in[I_LQ1][lane] * a.in[I_LK1][lane], p2 = a.in[I_LQ2][lane] * a.in[I_LK2][lane];
      lam = __expf(wave_sum(p1)) - __expf(wave_sum(p2)) + LAM_INIT; }
    const bf16_t* Q = (const bf16_t*)(ws + WS_Q); const bf16_t* KA = (const bf16_t*)(ws + WS_K); const bf16_t* VA = (const bf16_t*)(ws + WS_V);
    __syncthreads();
    for (int u = vcu * 8; u < 2048; u += G * 8) {
        const int x = (u >> 3) / 32, jj = (u >> 3) % 32;
        for (int i = 0; i < 8; ++i) {
            const int bh = 16 * x + 2 * i + (jj >> 4), qb = jj & 15;
            att::unit(lds, bh >> 2, bh & 3, qb, Q, KA, VA, MIXIN, a.in[I_SUBLN], lam);
        }
    }
}

__device__ __forceinline__ void p5_rows(const Args& a, LAS unsigned char* lds, int p  ) {
    const int tid = threadIdx.x, lane = tid & 63, wave = __builtin_amdgcn_readfirstlane(tid >> 6);
    unsigned char* ws = a.ws;
    const int b = p >> 3;
    LAS float* wrt = (LAS float*)lds;
    LAS float* mv = (LAS float*)(lds + 65536);
    const float* wr = a.in[I_WROUTER];
    for (int n = tid; n < D * NE; n += NTHREADS) { const int k = n >> 4, e = n & 15; wrt[e * D + k] = wr[n]; }
    const float* MOD = (const float*)(ws + WS_MOD) + (size_t)b * NMOD;
    for (int n = tid; n < 3 * D; n += NTHREADS) mv[n] = MOD[2 * D + n];
    __syncthreads();
    const bf16_t* MIX = (const bf16_t*)(ws + WS_MIX); bf16_t* XN2 = (bf16_t*)(ws + WS_XN); float* AFFT = (float*)(ws + WS_AFFT);
    const f32x4* npm = (const f32x4*)a.in[I_NPOST_MIX] + lane; const f32x4* npf = (const f32x4*)a.in[I_NPRE_FFN] + lane;
    for (int i = 0; i < 32; ++i) {
        const int row = p * 256 + wave * 32 + i, t = row & (T - 1);
        const u32x2* mr = (const u32x2*)(MIX + (size_t)row * D) + lane;
        f32x4 mx[4]; float s = 0.f;
#pragma unroll
        for (int j = 0; j < 4; ++j) { const u32x2 wv = mr[64 * j]; mx[j] = (f32x4){bflo(wv.x), bfhi(wv.x), bflo(wv.y), bfhi(wv.y)};
            s += (mx[j].x * mx[j].x + mx[j].y * mx[j].y) + (mx[j].z * mx[j].z + mx[j].w * mx[j].w); }
        const float rstd1 = 1.0f / sqrtf(wave_sum(s) * (1.f / D) + EPS);
        const f32x4* xr = (const f32x4*)(a.in[I_X] + (size_t)row * D) + lane; f32x4* hr = (f32x4*)(a.out + (size_t)row * D) + lane;
        f32x4 h[4]; float s2 = 0.f;
#pragma unroll
        for (int j = 0; j < 4; ++j) { const f32x4 g1 = *(const LAS f32x4*)(mv + 4 * lane + 256 * j);
            h[j] = xr[64 * j] + g1 * ((mx[j] * rstd1) * npm[64 * j]); hr[64 * j] = h[j];
            s2 += (h[j].x * h[j].x + h[j].y * h[j].y) + (h[j].z * h[j].z + h[j].w * h[j].w); }
        const float rstd2 = 1.0f / sqrtf(wave_sum(s2) * (1.f / D) + EPS);
        u32x2* o8 = (u32x2*)(XN2 + (size_t)row * D) + lane;
        float lg[16];
#pragma unroll
        for (int e = 0; e < 16; ++e) lg[e] = 0.f;
#pragma unroll
        for (int j = 0; j < 4; ++j) { const f32x4 sh2 = *(const LAS f32x4*)(mv + 1024 + 4 * lane + 256 * j), sc2 = *(const LAS f32x4*)(mv + 2048 + 4 * lane + 256 * j);
            const f32x4 z = ((h[j] * rstd2) * npf[64 * j]) * (sc2 + 1.0f) + sh2;
            u32x2 wv; wv.x = pk2(z.x, z.y); wv.y = pk2(z.z, z.w); o8[64 * j] = wv;
#pragma unroll
            for (int e = 0; e < 16; ++e) { const f32x4 wq = *(const LAS f32x4*)(wrt + e * D + 4 * lane + 256 * j); lg[e] += (z.x * wq.x + z.y * wq.y) + (z.z * wq.z + z.w * wq.w); } }
        float mxl = -1e30f;
#pragma unroll
        for (int e = 0; e < 16; ++e) { lg[e] = wave_sum(lg[e]); mxl = fmaxf(mxl, lg[e]); }
        float se = 0.f;
#pragma unroll
        for (int e = 0; e < 16; ++e) { lg[e] = __expf(lg[e] - mxl); se += lg[e]; }
        const float inv = 1.0f / se;
        float mine = 0.f;
#pragma unroll
        for (int e = 0; e < 16; ++e) mine = (lane == e) ? lg[e] * inv : mine;
        if (lane < 16) AFFT[((size_t)b * NE + lane) * T + t] = mine;
    }
}

__device__ __forceinline__ void p6_topk(const Args& a, LAS unsigned char* lds, int c, int G) {
    const int tid = threadIdx.x;
    unsigned char* ws = a.ws;
    const float* AFFT = (const float*)(ws + WS_AFFT); short* SLOT = (short*)(ws + WS_SLOT); int* IDX = (int*)(ws + WS_IDX); float* GATE = (float*)(ws + WS_GATE);
    LAS float* av = (LAS float*)lds;
    for (int item = c; item < NITEM; item += G) {
        const int b = item >> 4, e = item & 15;
        __syncthreads();
        for (int n = tid; n < T; n += NTHREADS) av[n] = AFFT[(size_t)item * T + n];
        __syncthreads();
        float mv[4]; int cnt[4];
#pragma unroll
        for (int k = 0; k < 4; ++k) { mv[k] = av[tid + NTHREADS * k]; cnt[k] = 0; }
        for (int t2 = 0; t2 < T; t2 += 4) {
            const f32x4 v = *(const LAS f32x4*)(av + t2);
#pragma unroll
            for (int q = 0; q < 4; ++q) {
                const float vv = v[q]; const int tt = t2 + q;
#pragma unroll
                for (int k = 0; k < 4; ++k) cnt[k] += (vv > mv[k] || (vv == mv[k] && tt < tid + NTHREADS * k)) ? 1 : 0;
            }
        }
#pragma unroll
        for (int k = 0; k < 4; ++k) { const int t = tid + NTHREADS * k; const int sl = cnt[k] < CAP ? cnt[k] : -1;
            SLOT[((size_t)b * T + t) * NE + e] = (short)sl;
            if (sl >= 0) { IDX[item * CAP + sl] = t; GATE[item * CAP + sl] = mv[k]; } }
    }
}

__device__ __forceinline__ void p8_final(const Args& a, LAS unsigned char* lds, int vcu, int G) {
    const int tid = threadIdx.x, lane = tid & 63, wave = __builtin_amdgcn_readfirstlane(tid >> 6);
    unsigned char* ws = a.ws;
    const short* SLOT = (const short*)(ws + WS_SLOT); const bf16_t* Y = (const bf16_t*)(ws + WS_Y); const float* MOD = (const float*)(ws + WS_MOD);
    const f32x4* npo = (const f32x4*)a.in[I_NPOST_FFN] + lane;
    const int gw = vcu * NWAVES + wave, NGW = G * NWAVES;
    for (int row = gw; row < M; row += NGW) {
        const int b = row >> 11;
        f32x4 ff[4];
#pragma unroll
        for (int j = 0; j < 4; ++j) ff[j] = (f32x4){0.f, 0.f, 0.f, 0.f};
        const short* sl = SLOT + (size_t)row * NE;
        for (int e = 0; e < NE; ++e) {
            const int s = __builtin_amdgcn_readfirstlane((int)sl[e]);
            if (s >= 0) {
                const u32x2* yr = (const u32x2*)(Y + ((size_t)(b * NE + e) * CAP + s) * D) + lane;
#pragma unroll
                for (int j = 0; j < 4; ++j) { const u32x2 wv = yr[64 * j]; ff[j] += (f32x4){bflo(wv.x), bfhi(wv.x), bflo(wv.y), bfhi(wv.y)}; }
            }
        }
        float s2 = 0.f;
#pragma unroll
        for (int j = 0; j < 4; ++j) s2 += (ff[j].x * ff[j].x + ff[j].y * ff[j].y) + (ff[j].z * ff[j].z + ff[j].w * ff[j].w);
        const float rstd = 1.0f / sqrtf(wave_sum(s2) * (1.f / D) + EPS);
        f32x4* hr = (f32x4*)(a.out + (size_t)row * D) + lane; const f32x4* g2 = (const f32x4*)(MOD + (size_t)b * NMOD + 5 * D) + lane;
#pragma unroll
        for (int j = 0; j < 4; ++j) hr[64 * j] = hr[64 * j] + g2[64 * j] * ((ff[j] * rstd) * npo[64 * j]);
    }
}

__global__ void __launch_bounds__(NTHREADS, 2) fwd_kernel(Args args) {
    extern __shared__ __attribute__((aligned(16))) unsigned char lds_raw[];
    LAS unsigned char* lds = (LAS unsigned char*)lds_raw;
    volatile LAS unsigned* MISC = (volatile LAS unsigned*)(lds + MISC_OFF);
    const int tid = threadIdx.x;
    const int G = gridDim.x, c = blockIdx.x;
    const int vcu = (G % 8 == 0) ? (c % 8) * (G / 8) + c / 8 : c;
    unsigned char* ws = args.ws;
    gu32* ctl = (gu32*)(ws + WS_CTL);
    for (int u = tid; u < (LDS_BYTES - LDSCTL_OFF) / 4; u += NTHREADS) ((LAS unsigned*)(lds + LDSCTL_OFF))[u] = 0u;
    __syncthreads();
    XcdBarrier bar; bar.bar = (unsigned*)(ctl + CW_BAR); bar.x = 0; bar.st = nullptr;
    const int lo = args.ph_lo, hi = args.ph_hi;
    if (hi - lo > 1) bar = xcd_barrier_post((unsigned*)(ctl + CW_BAR), MISC + 8);
#ifndef PHMASK
#define PHMASK 0xff
#endif
#define IN(k) (((PHMASK >> (k)) & 1) && lo <= (k) && (k) < hi)
#define SEAM(k) do { if (IN(k) && IN((k) + 1)) xcd_barrier(bar); } while (0)

    if (IN(0)) { p0_prologue(args, lds, vcu, G); } SEAM(0);
    if (IN(1)) { p1_xn(args, lds, c, G); } SEAM(1);
    if (IN(2)) {
        pg8::Gemm g{(const bf16_t*)(ws + WS_XN), (const bf16_t*)(ws + WS_WIN), D, nullptr};
        pg8::SchedProj S{G, c};
        pg8::EpiProj E{(bf16_t*)(ws + WS_Q), (bf16_t*)(ws + WS_K), (bf16_t*)(ws + WS_V), (bf16_t*)(ws + WS_GB), (bf16_t*)(ws + WS_U), (const float*)(ws + WS_TAB)};
        pg8::gemm_phase<pg8::EpiProj, pg8::SchedProj, true, true>(lds, g, S, E);
    } SEAM(2);
    if (IN(3)) { p3_conv_attn(args, lds, c, vcu, G); } SEAM(3);
    if (IN(4)) {
        {
            const int p = c;
#ifndef NO_P4
            pg8::Gemm g{(const bf16_t*)(ws + WS_MIXIN), (const bf16_t*)(ws + WS_WOUT), D, nullptr};
            pg8::SchedPanel S{p, 4};
            pg8::EpiBf16 E{(bf16_t*)(ws + WS_MIX), D};
            pg8::gemm_phase<pg8::EpiBf16, pg8::SchedPanel, true, true>(lds, g, S, E);
#endif
            VM_WAIT(); __syncthreads();
#ifndef NO_P5
            p5_rows(args, lds, p);
#endif
            __syncthreads();
        }
    } SEAM(4);
    if (IN(5)) { p6_topk(args, lds, c, G); } SEAM(5);
    if (IN(6)) {
#pragma unroll 1
        for (int it = 0; it < 2; ++it) {
            {
                const int item = 2 * c + it;
                const int b = item >> 4, e = item & 15;
#ifndef NO_G1
                {
                    pg8::Gemm g{(const bf16_t*)(ws + WS_XN) + (size_t)b * T * D, (const bf16_t*)(ws + WS_WGU) + (size_t)e * 2048 * D, D, (const int*)(ws + WS_IDX) + item * CAP};
                    pg8::SchedPanel S{0, 8};
                    pg8::EpiGU E{(bf16_t*)(ws + WS_HMID) + (size_t)item * CAP * D};
                    pg8::gemm_phase<pg8::EpiGU, pg8::SchedPanel, true, true, true>(lds, g, S, E);
                }
#endif
                VM_WAIT(); __syncthreads();
#ifndef NO_G2
                {
                    pg8::Gemm g{(const bf16_t*)(ws + WS_HMID) + (size_t)item * CAP * D, (const bf16_t*)(ws + WS_WDN) + (size_t)e * D * D, D, nullptr};
                    pg8::SchedPanel S{0, 4};
                    pg8::EpiDown E{(bf16_t*)(ws + WS_Y) + (size_t)item * CAP * D, (const float*)(ws + WS_GATE) + item * CAP};
                    pg8::gemm_phase<pg8::EpiDown, pg8::SchedPanel, true, true>(lds, g, S, E);
                }
#endif
                VM_WAIT(); __syncthreads();
            }
        }
    } SEAM(6);
    if (IN(7)) { p8_final(args, lds, vcu, G); }
#undef IN
#undef SEAM
}

extern "C" void kernel_launch(void* const* d_in, const int* in_sizes, int n_in, void* d_out, int out_size, void* d_ws, size_t ws_size, hipStream_t stream) {
    static int grid = 0;
    if (grid == 0) {
        if (n_in != 22 || in_sizes[0] != M * D || out_size != M * D || ws_size < WS_END) { fprintf(stderr, "kernel_launch: unexpected shapes (n_in %d, in0 %d, out %d, ws %zu)\n", n_in, n_in > 0 ? in_sizes[0] : -1, out_size, ws_size); grid = -1; return; }
        int dev = 0, cus = 0;
        if (hipGetDevice(&dev) != hipSuccess || hipDeviceGetAttribute(&cus, hipDeviceAttributeMultiprocessorCount, dev) != hipSuccess) { grid = -1; return; }
        if (hipFuncSetAttribute((const void*)fwd_kernel, hipFuncAttributeMaxDynamicSharedMemorySize, LDS_BYTES) != hipSuccess) { fprintf(stderr, "kernel_launch: hipFuncSetAttribute failed\n"); grid = -1; return; }
        (void)hipGetLastError();
        grid = cus;
        if (grid != 256) { fprintf(stderr, "kernel_launch: this kernel needs a 256-CU device (got %d)\n", cus); grid = -1; return; }
    }
    if (grid < 0) return;
    (void)hipMemsetAsync((char*)d_ws + WS_CTL, 0, CTL_ZERO_BYTES, stream);
    Args a{};
    for (int i = 0; i < 22; ++i) a.in[i] = (const float*)d_in[i];
    a.out = (float*)d_out; a.ws = (unsigned char*)d_ws;
    constexpr int NPH = 8;
    if (MK_N_LAUNCHES == 1) { a.ph_lo = 0; a.ph_hi = NPH; hipLaunchKernelGGL(fwd_kernel, dim3(grid), dim3(NTHREADS), LDS_BYTES, stream, a); }
    else { for (int k = 0; k < NPH; ++k) { a.ph_lo = k; a.ph_hi = k + 1; hipLaunchKernelGGL(fwd_kernel, dim3(grid), dim3(NTHREADS), LDS_BYTES, stream, a); } }
}
```

```cpp
#include <hip/hip_runtime.h>
#include <cstdio>
#include <cstdint>

#ifndef MK_N_LAUNCHES
#define MK_N_LAUNCHES 1
#endif

#define LAS __attribute__((address_space(3)))
#define GAS __attribute__((address_space(1)))
typedef unsigned short bf16_t;
typedef short bf16x8 __attribute__((ext_vector_type(8)));
typedef short s16x4 __attribute__((ext_vector_type(4)));
typedef float f32x4 __attribute__((ext_vector_type(4)));
typedef float f32x16 __attribute__((ext_vector_type(16)));
typedef unsigned u32x4 __attribute__((ext_vector_type(4)));
typedef unsigned u32x2 __attribute__((ext_vector_type(2)));

constexpr int NB = 32, T = 2048, D = 1024, TC = 256, M = NB * T, MC = NB * TC, MA = M + MC, TK = TC + T;
constexpr int NE = 16, CAP = 256, NITEM = NB * NE, NPROJ = 3072, NMOD = 6 * D;
constexpr float EPS = 1e-6f;
constexpr float C2 = 0.125f * 1.4426950408889634f;
constexpr float LAM_INIT = 0.2f;
constexpr int NWAVES = 8, NTHREADS = 512;

constexpr size_t MiB = 1u << 20;
constexpr size_t WS_CTL = 0, CTL_ZERO_BYTES = 1 * MiB;
constexpr size_t WS_MODP = 2 * MiB;
constexpr size_t WS_MOD = 16 * MiB;
constexpr size_t WS_TAB = 17 * MiB;
constexpr size_t WS_WIN = 18 * MiB;
constexpr size_t WS_WOUT = 24 * MiB;
constexpr size_t WS_WGU = 26 * MiB;
constexpr size_t WS_WDN = 90 * MiB;
constexpr size_t WS_AFFT = 122 * MiB;
constexpr size_t WS_SLOT = 126 * MiB;
constexpr size_t WS_IDX = 128 * MiB;
constexpr size_t WS_GATE = 129 * MiB;
constexpr size_t WS_XN = 130 * MiB;
constexpr size_t WS_Q = 274 * MiB;
constexpr size_t WS_K = 338 * MiB;
constexpr size_t WS_V = 410 * MiB;
constexpr size_t WS_GB = 482 * MiB;
constexpr size_t WS_U = 546 * MiB;
constexpr size_t WS_MIXIN = 610 * MiB;
constexpr size_t WS_MIX = 738 * MiB;
constexpr size_t WS_HMID = 274 * MiB;
constexpr size_t WS_Y = 610 * MiB;
constexpr size_t WS_H1 = 866 * MiB;
constexpr size_t WS_END = 994 * MiB;

namespace pg8 {
constexpr int BM = 256, BK = 64, HALF = 128, HTB = HALF * BK * 2, STAGE_BYTES = 8 * HTB;
__host__ __device__ __forceinline__ int lds_byte(int r, int c) { const int st = (r >> 4) * 2 + (c >> 5), rr = r & 15, cc = c & 31, ob = rr * 64 + cc * 2; return st * 1024 + (ob ^ (((ob >> 9) & 1) << 5)); }
__host__ __device__ __forceinline__ void stage_rc(int b, int& R, int& C) { const int st = b / 1024, sb = b % 1024, swz = sb ^ (((sb >> 9) & 1) << 5); R = (st >> 1) * 16 + swz / 64; C = (st & 1) * 32 + (swz % 64) / 2; }
__host__ __device__ __forceinline__ int perm32(int rho) { const int n = rho >> 4, i = rho & 15; return 8 * (i >> 2) + 4 * n + (i & 3); }

struct Unit { int pm, pn; };
struct Gemm { const bf16_t* A; const bf16_t* Bt; int K; const int* gidx; };

__device__ __forceinline__ unsigned cvt_pk_bf16(float lo, float hi) { unsigned r; asm volatile("v_cvt_pk_bf16_f32 %0, %1, %2" : "=v"(r) : "v"(lo), "v"(hi)); return r; }

struct EpiBf16 {
    static constexpr bool PERM = true, AFTER_DRAIN = false;
    bf16_t* O; int ldc;
    __device__ __forceinline__ void operator()(const f32x4 (&acc)[2][2][4][2], const Unit& u, int wr, int wc, int fr, int fq) const {
        const int row0 = u.pm * BM + wr * 64 + fr; const int col0 = u.pn * BM + wc * 32 + 8 * fq;
#pragma unroll
        for (int ai = 0; ai < 2; ++ai)
#pragma unroll
            for (int m = 0; m < 4; ++m) { bf16_t* rowp = O + (size_t)(row0 + ai * HALF + m * 16) * ldc + col0;
#pragma unroll
                for (int bj = 0; bj < 2; ++bj) { const f32x4 v0 = acc[ai][bj][m][0], v1 = acc[ai][bj][m][1];
                    u32x4 w; w.x = cvt_pk_bf16(v0[0], v0[1]); w.y = cvt_pk_bf16(v0[2], v0[3]); w.z = cvt_pk_bf16(v1[0], v1[1]); w.w = cvt_pk_bf16(v1[2], v1[3]);
                    *(u32x4*)(rowp + bj * HALF) = w; } }
    }
};

struct EpiProj {
    static constexpr bool PERM = true, AFTER_DRAIN = false;
    bf16_t *Q, *KA, *VA, *GB, *U; const float* tab;
    __device__ __forceinline__ void operator()(const f32x4 (&acc)[2][2][4][2], const Unit& u, int wr, int wc, int fr, int fq) const {
        const int pn = u.pn; const bool ctx = u.pm >= 256;
#pragma unroll
        for (int ai = 0; ai < 2; ++ai)
#pragma unroll
            for (int m = 0; m < 4; ++m) {
                const int row = u.pm * BM + ai * HALF + wr * 64 + m * 16 + fr;
                int t, kvrow;
                if (!ctx) { const int b = row >> 11; t = row & 2047; kvrow = b * TK + TC + t; }
                else { const int rc = row - M; const int b = rc >> 8; t = 0; kvrow = b * TK + (rc & 255); }
                if (pn < 4) {
                    f32x4 cs0 = {1.f, 0.f, 1.f, 0.f}, cs1 = cs0, cs2 = cs0, cs3 = cs0;
                    if (!ctx) { const float* tp = tab + ((size_t)t * 32 + 16 * (wc & 1) + 4 * fq) * 2;
                        cs0 = *(const f32x4*)(tp); cs1 = *(const f32x4*)(tp + 4); }
                    (void)cs2; (void)cs3;
#pragma unroll
                    for (int bj = 0; bj < 2; ++bj) {
                        const f32x4 v0 = acc[ai][bj][m][0], v1 = acc[ai][bj][m][1];
                        float e0 = v0[0], o0 = v0[1], e1 = v0[2], o1 = v0[3], e2 = v1[0], o2 = v1[1], e3 = v1[2], o3 = v1[3];
                        float r0 = e0 * cs0[0] - o0 * cs0[1], s0 = o0 * cs0[0] + e0 * cs0[1];
                        float r1 = e1 * cs0[2] - o1 * cs0[3], s1 = o1 * cs0[2] + e1 * cs0[3];
                        float r2 = e2 * cs1[0] - o2 * cs1[1], s2 = o2 * cs1[0] + e2 * cs1[1];
                        float r3 = e3 * cs1[2] - o3 * cs1[3], s3 = o3 * cs1[2] + e3 * cs1[3];
                        const float sc = (pn < 2) ? C2 : 1.f;
                        u32x4 w; w.x = cvt_pk_bf16(r0 * sc, s0 * sc); w.y = cvt_pk_bf16(r1 * sc, s1 * sc); w.z = cvt_pk_bf16(r2 * sc, s2 * sc); w.w = cvt_pk_bf16(r3 * sc, s3 * sc);
                        const int col = (pn & 1) * 256 + bj * HALF + wc * 32 + 8 * fq;
                        bf16_t* dst = (pn < 2) ? (Q + (size_t)row * 512 + col) : (KA + (size_t)kvrow * 512 + col);
                        *(u32x4*)dst = w;
                    }
                } else if (pn < 8) {
#pragma unroll
                    for (int bj = 0; bj < 2; ++bj) {
                        const f32x4 v0 = acc[ai][bj][m][0], v1 = acc[ai][bj][m][1];
                        u32x4 w; w.x = cvt_pk_bf16(v0[0], v0[1]); w.y = cvt_pk_bf16(v0[2], v0[3]); w.z = cvt_pk_bf16(v1[0], v1[1]); w.w = cvt_pk_bf16(v1[2], v1[3]);
                        const int col = (pn & 1) * 256 + bj * HALF + wc * 32 + 8 * fq;
                        bf16_t* dst = (pn < 6) ? (VA + (size_t)kvrow * 512 + col) : (GB + (size_t)row * 512 + col);
                        *(u32x4*)dst = w;
                    }
                } else {
                    const f32x4 a0 = acc[ai][0][m][0], a1 = acc[ai][0][m][1], b0 = acc[ai][1][m][0], b1 = acc[ai][1][m][1];
                    u32x4 w; w.x = cvt_pk_bf16(a0[0] * b0[0], a0[1] * b0[1]); w.y = cvt_pk_bf16(a0[2] * b0[2], a0[3] * b0[3]);
                    w.z = cvt_pk_bf16(a1[0] * b1[0], a1[1] * b1[1]); w.w = cvt_pk_bf16(a1[2] * b1[2], a1[3] * b1[3]);
                    const int col = (pn - 8) * 128 + wc * 32 + 8 * fq;
                    *(u32x4*)(U + (size_t)row * 512 + col) = w;
                }
            }
    }
};

struct EpiGU {
    static constexpr bool PERM = true, AFTER_DRAIN = false;
    bf16_t* H;
    __device__ __forceinline__ float silu(float x) const { return x * __builtin_amdgcn_rcpf(1.f + __expf(-x)); }
    __device__ __forceinline__ void operator()(const f32x4 (&acc)[2][2][4][2], const Unit& u, int wr, int wc, int fr, int fq) const {
#pragma unroll
        for (int ai = 0; ai < 2; ++ai)
#pragma unroll
            for (int m = 0; m < 4; ++m) {
                const int row = ai * HALF + wr * 64 + m * 16 + fr;
                const f32x4 a0 = acc[ai][0][m][0], a1 = acc[ai][0][m][1], b0 = acc[ai][1][m][0], b1 = acc[ai][1][m][1];
                u32x4 w; w.x = cvt_pk_bf16(silu(a0[0]) * b0[0], silu(a0[1]) * b0[1]); w.y = cvt_pk_bf16(silu(a0[2]) * b0[2], silu(a0[3]) * b0[3]);
                w.z = cvt_pk_bf16(silu(a1[0]) * b1[0], silu(a1[1]) * b1[1]); w.w = cvt_pk_bf16(silu(a1[2]) * b1[2], silu(a1[3]) * b1[3]);
                *(u32x4*)(H + (size_t)row * 1024 + u.pn * 128 + wc * 32 + 8 * fq) = w;
            }
    }
};
struct EpiDown {
    static constexpr bool PERM = true, AFTER_DRAIN = false;
    bf16_t* Y; const float* gate;
    __device__ __forceinline__ void operator()(const f32x4 (&acc)[2][2][4][2], const Unit& u, int wr, int wc, int fr, int fq) const {
#pragma unroll
        for (int ai = 0; ai < 2; ++ai)
#pragma unroll
            for (int m = 0; m < 4; ++m) {
                const int row = ai * HALF + wr * 64 + m * 16 + fr; const float g = gate[row];
#pragma unroll
                for (int bj = 0; bj < 2; ++bj) { const f32x4 v0 = acc[ai][bj][m][0] * g, v1 = acc[ai][bj][m][1] * g;
                    u32x4 w; w.x = cvt_pk_bf16(v0[0], v0[1]); w.y = cvt_pk_bf16(v0[2], v0[3]); w.z = cvt_pk_bf16(v1[0], v1[1]); w.w = cvt_pk_bf16(v1[2], v1[3]);
                    *(u32x4*)(Y + (size_t)row * 1024 + u.pn * BM + bj * HALF + wc * 32 + 8 * fq) = w; }
            }
    }
};

struct SchedProj {
    int G, c;
    __device__ __forceinline__ bool next(int i, Unit& u) const {
        const int L = i * G + c;
        if (L < 3072) { u.pm = L & 255; u.pn = L >> 8; return true; }
        const int j = L - 3072; if (j >= 128) return false;
        u.pm = 256 + (j >> 2); u.pn = 2 + (j & 3); return true;
    }
    __device__ __forceinline__ void a_ready(const Unit&) const {}
    __device__ __forceinline__ void done(const Unit&) const {}
};
struct SchedPanel {
    int pm, ntn;
    __device__ __forceinline__ bool next(int i, Unit& u) const { if (i >= ntn) return false; u.pm = pm; u.pn = i; return true; }
    __device__ __forceinline__ void a_ready(const Unit&) const {}
    __device__ __forceinline__ void done(const Unit&) const {}
};

template <class Epi, class Sched, bool ALIGN_EPI, bool SP2, bool GATHER = false>
__device__ __forceinline__ void gemm_phase(LAS unsigned char* lds, const Gemm g, const Sched& S, const Epi& E) {
    const int tid = threadIdx.x, wid = __builtin_amdgcn_readfirstlane(tid >> 6), lane = tid & 63, wr = wid >> 2, wc = wid & 3, fr = lane & 15, fq = lane >> 4;
    const int K = g.K, nt = K / BK;
    unsigned voffA[2][2], voffB[2];
#pragma unroll
    for (int i = 0; i < 2; ++i) { int R, C; stage_rc(tid * 16 + i * 8192, R, C); const int Rb = Epi::PERM ? ((R & ~31) + perm32(R & 31)) : R;
        if constexpr (GATHER) { voffA[0][i] = (unsigned)(g.gidx[R] * K + C) * 2u; voffA[1][i] = (unsigned)(g.gidx[HALF + R] * K + C) * 2u; }
        else { voffA[0][i] = (unsigned)(R * K + C) * 2u; voffA[1][i] = voffA[0][i]; }
        voffB[i] = (unsigned)(Rb * K + C) * 2u; }
    const size_t kstep = (size_t)(BK * 2);
    const size_t hstep = (size_t)HALF * K * 2;
    const size_t hstepA = GATHER ? (size_t)0 : hstep;
    const size_t tstep = 2 * hstep;
    const unsigned ldsw = (unsigned)wid * 1024u;
    const int aoff = lds_byte(wr * 64 + fr, fq * 8), boff = lds_byte(wc * 32 + fr, fq * 8);
#define PG8_SA(b, h) (((b) * 2 + (h)) * HTB)
#define PG8_SB(b, h) ((4 + (b) * 2 + (h)) * HTB)
#define PG8_STAGE(bufoff, gbase, voff) do { _Pragma("unroll") for (int _i = 0; _i < 2; ++_i) \
        __builtin_amdgcn_global_load_lds((const unsigned*)((const char*)(gbase) + (voff)[_i]), (LAS unsigned*)(lds + (bufoff) + ldsw + _i * 8192), 16, 0, 0); } while (0)
#define PG8_LDA(dst, b, h) do { _Pragma("unroll") for (int m = 0; m < 4; ++m) _Pragma("unroll") for (int k = 0; k < 2; ++k) dst[m][k] = *(const LAS bf16x8*)(lds + PG8_SA(b, h) + aoff + m * 2048 + k * 1024); } while (0)
#define PG8_LDB(dst, b, h) do { _Pragma("unroll") for (int n = 0; n < 2; ++n) _Pragma("unroll") for (int k = 0; k < 2; ++k) dst[n][k] = *(const LAS bf16x8*)(lds + PG8_SB(b, h) + boff + n * 2048 + k * 1024); } while (0)
#define PG8_MMA(ai, bj, At, Bt) do { __builtin_amdgcn_s_setprio(1); _Pragma("unroll") for (int m = 0; m < 4; ++m) _Pragma("unroll") for (int n = 0; n < 2; ++n) _Pragma("unroll") for (int k = 0; k < 2; ++k) \
        acc[ai][bj][m][n] = __builtin_amdgcn_mfma_f32_16x16x32_bf16(Bt[n][k], At[m][k], acc[ai][bj][m][n], 0, 0, 0); __builtin_amdgcn_s_setprio(0); } while (0)
#define PG8_WAIT_V(n) asm volatile("s_waitcnt vmcnt(" #n ")" ::: "memory")
#define PG8_WAIT_L(n) asm volatile("s_waitcnt lgkmcnt(" #n ")" ::: "memory")
#define PG8_BAR __builtin_amdgcn_s_barrier()
#define PG8_SCHED __builtin_amdgcn_sched_barrier(0)
    Unit cur, nxt; int ui = 0;
    if (!S.next(0, cur)) return;
    f32x4 acc[2][2][4][2];
#pragma unroll
    for (int a = 0; a < 2; ++a)
#pragma unroll
        for (int b = 0; b < 2; ++b)
#pragma unroll
            for (int m = 0; m < 4; ++m)
#pragma unroll
                for (int n = 0; n < 2; ++n) acc[a][b][m][n] = (f32x4){0.f, 0.f, 0.f, 0.f};
    bf16x8 At[4][2], B0[2][2], B1[2][2];
    const char* cA = (const char*)g.A + (size_t)cur.pm * tstep; const char* cB = (const char*)g.Bt + (size_t)cur.pn * tstep;
    S.a_ready(cur);
    if constexpr (SP2) {
        PG8_STAGE(PG8_SB(0, 0), cB, voffB); PG8_STAGE(PG8_SB(0, 1), cB + hstep, voffB); PG8_STAGE(PG8_SA(0, 0), cA, voffA[0]); PG8_STAGE(PG8_SA(0, 1), cA + hstepA, voffA[1]);
        if (wr == 1) PG8_BAR;
        PG8_WAIT_V(2); PG8_BAR;
        PG8_STAGE(PG8_SB(1, 0), cB + kstep, voffB); PG8_STAGE(PG8_SA(1, 0), cA + kstep, voffA[0]); PG8_STAGE(PG8_SB(1, 1), cB + hstep + kstep, voffB);
        PG8_WAIT_V(6); PG8_BAR;
    } else {
        PG8_STAGE(PG8_SB(0, 0), cB, voffB); PG8_STAGE(PG8_SA(0, 0), cA, voffA[0]); PG8_STAGE(PG8_SB(0, 1), cB + hstep, voffB); PG8_STAGE(PG8_SA(0, 1), cA + hstepA, voffA[1]);
        if (wr == 1) PG8_BAR;
        PG8_WAIT_V(4); PG8_BAR;
        PG8_STAGE(PG8_SB(1, 0), cB + kstep, voffB); PG8_STAGE(PG8_SA(1, 0), cA + kstep, voffA[0]); PG8_STAGE(PG8_SB(1, 1), cB + hstep + kstep, voffB);
        PG8_WAIT_V(6); PG8_BAR;
    }
    for (;;) {
        const bool has_next = S.next(ui + 1, nxt);
        const char* nA = has_next ? (const char*)g.A + (size_t)nxt.pm * tstep : cA; const char* nB = has_next ? (const char*)g.Bt + (size_t)nxt.pn * tstep : cB;
        for (int t = 0; t < nt; t += 2) {
            const bool last = (t == nt - 2);
            const char* a1 = cA + (size_t)(t + 1) * kstep;
            const char* a2 = last ? nA : cA + (size_t)(t + 2) * kstep; const char* b2 = last ? nB : cB + (size_t)(t + 2) * kstep;
            const char* a3 = a2 + kstep; const char* b3 = b2 + kstep;
            if (last && has_next) S.a_ready(nxt);
            if constexpr (SP2) {
            PG8_LDB(B0, 0, 0); PG8_LDB(B1, 0, 1); PG8_SCHED; PG8_LDA(At, 0, 0); PG8_STAGE(PG8_SA(1, 1), a1 + hstepA, voffA[1]);
            PG8_WAIT_V(8); PG8_WAIT_L(0); PG8_BAR; PG8_MMA(0, 0, At, B0); PG8_MMA(0, 1, At, B1); PG8_BAR; PG8_SCHED;
            PG8_LDA(At, 0, 1); PG8_STAGE(PG8_SB(0, 0), b2, voffB); PG8_STAGE(PG8_SB(0, 1), b2 + hstep, voffB); PG8_STAGE(PG8_SA(0, 0), a2, voffA[0]);
            PG8_WAIT_V(8); PG8_WAIT_L(0); PG8_BAR; PG8_MMA(1, 0, At, B0); PG8_MMA(1, 1, At, B1); PG8_BAR; PG8_SCHED;
            PG8_LDB(B0, 1, 0); PG8_LDB(B1, 1, 1); PG8_SCHED; PG8_LDA(At, 1, 0); PG8_STAGE(PG8_SA(0, 1), a2 + hstepA, voffA[1]);
            PG8_WAIT_V(8); PG8_WAIT_L(0); PG8_BAR; PG8_MMA(0, 0, At, B0); PG8_MMA(0, 1, At, B1); PG8_BAR; PG8_SCHED;
            PG8_LDA(At, 1, 1); PG8_STAGE(PG8_SB(1, 0), b3, voffB); PG8_STAGE(PG8_SB(1, 1), b3 + hstep, voffB); PG8_STAGE(PG8_SA(1, 0), a3, voffA[0]);
            PG8_WAIT_V(8); PG8_WAIT_L(0); PG8_BAR; PG8_MMA(1, 0, At, B0); PG8_MMA(1, 1, At, B1); PG8_BAR; PG8_SCHED;
            } else {
            PG8_LDB(B0, 0, 0); PG8_SCHED; PG8_LDA(At, 0, 0); PG8_STAGE(PG8_SA(1, 1), a1 + hstepA, voffA[1]);
            PG8_WAIT_L(8); PG8_BAR; PG8_WAIT_L(0); PG8_MMA(0, 0, At, B0); PG8_BAR; PG8_SCHED;
            PG8_LDB(B1, 0, 1); PG8_STAGE(PG8_SB(0, 0), b2, voffB);
            PG8_BAR; PG8_WAIT_L(0); PG8_MMA(0, 1, At, B1); PG8_BAR;
            PG8_LDA(At, 0, 1); PG8_STAGE(PG8_SA(0, 0), a2, voffA[0]);
            PG8_BAR; PG8_WAIT_L(0); PG8_MMA(1, 0, At, B0); PG8_BAR; PG8_SCHED;
            PG8_STAGE(PG8_SB(0, 1), b2 + hstep, voffB);
            PG8_WAIT_V(6); PG8_BAR; PG8_MMA(1, 1, At, B1); PG8_BAR;
            PG8_LDB(B0, 1, 0); PG8_SCHED; PG8_LDA(At, 1, 0); PG8_STAGE(PG8_SA(0, 1), a2 + hstepA, voffA[1]);
            PG8_WAIT_L(8); PG8_BAR; PG8_WAIT_L(0); PG8_MMA(0, 0, At, B0); PG8_BAR; PG8_SCHED;
            PG8_LDB(B1, 1, 1); PG8_STAGE(PG8_SB(1, 0), b3, voffB);
            PG8_BAR; PG8_WAIT_L(0); PG8_MMA(0, 1, At, B1); PG8_BAR;
            PG8_LDA(At, 1, 1); PG8_STAGE(PG8_SA(1, 0), a3, voffA[0]);
            PG8_BAR; PG8_WAIT_L(0); PG8_MMA(1, 0, At, B0); PG8_BAR; PG8_SCHED;
            PG8_STAGE(PG8_SB(1, 1), b3 + hstep, voffB);
            PG8_WAIT_V(6); PG8_BAR; PG8_MMA(1, 1, At, B1); PG8_BAR;
            }
        }
        if constexpr (ALIGN_EPI) { if (wr == 0) PG8_BAR; }
        E(acc, cur, wr, wc, fr, fq); S.done(cur);
        if (!has_next) break;
#pragma unroll
        for (int a = 0; a < 2; ++a)
#pragma unroll
            for (int b = 0; b < 2; ++b)
#pragma unroll
                for (int m = 0; m < 4; ++m)
#pragma unroll
                    for (int n = 0; n < 2; ++n) acc[a][b][m][n] = (f32x4){0.f, 0.f, 0.f, 0.f};
        cur = nxt; cA = nA; cB = nB; ++ui;
        if constexpr (ALIGN_EPI) { if (wr == 1) PG8_BAR; }
    }
    PG8_WAIT_V(0);
    if constexpr (!ALIGN_EPI) { if (wr == 0) PG8_BAR; }
    PG8_BAR;
#undef PG8_SA
#undef PG8_SB
#undef PG8_STAGE
#undef PG8_LDA
#undef PG8_LDB
#undef PG8_MMA
#undef PG8_WAIT_V
#undef PG8_WAIT_L
#undef PG8_BAR
#undef PG8_SCHED
}
}

typedef GAS unsigned gu32;
#define RLX_AGENT __ATOMIC_RELAXED, __HIP_MEMORY_SCOPE_AGENT
#define LDS_WAIT() asm volatile("s_waitcnt lgkmcnt(0)" ::: "memory")
#define VM_WAIT() asm volatile("s_waitcnt vmcnt(0)" ::: "memory")
__device__ __forceinline__ unsigned pk2(float lo, float hi) { return pg8::cvt_pk_bf16(lo, hi); }
__device__ __forceinline__ float bf2f(unsigned short h) { return __uint_as_float((unsigned)h << 16); }
__device__ __forceinline__ float bflo(unsigned w) { return __uint_as_float(w << 16); }
__device__ __forceinline__ float bfhi(unsigned w) { return __uint_as_float(w & 0xffff0000u); }
__device__ __forceinline__ float wave_sum(float v) {
#pragma unroll
    for (int o = 1; o < 64; o <<= 1) v += __shfl_xor(v, o);
    return v;
}

#define XB_TMO      128
#define XB_XCNT(j)  (256  + 64 * (j))
#define XB_XSUB(j)  (1280 + 64 * (j))
#define XB_XGEN(j)  (2304 + 64 * (j))
#define XB_TOP      3328
#define XB_TOPGEN   3392
#define XCD_BAR_WORDS 3456
#define XB_SPIN_CAP (1u << 18)
__device__ __forceinline__ unsigned xb_ld(unsigned* p)              { return __hip_atomic_load(p, __ATOMIC_RELAXED, __HIP_MEMORY_SCOPE_AGENT); }
__device__ __forceinline__ unsigned xb_add(unsigned* p, unsigned v) { return __hip_atomic_fetch_add(p, v, __ATOMIC_RELAXED, __HIP_MEMORY_SCOPE_AGENT); }
__device__ __forceinline__ unsigned xb_xcc_id() { return (unsigned)__builtin_amdgcn_s_getreg((3 << 11) | 20) & 0xFu; }
#define XB_SPIN(cond, bar) do { unsigned _sp = 0; while (cond) { __builtin_amdgcn_s_sleep(1); \
    if ((++_sp & 255u) == 0u) { if (xb_ld(&(bar)[XB_TMO])) break; if (_sp > XB_SPIN_CAP) { atomicAdd(&(bar)[XB_TMO], 1u); break; } } } } while (0)
struct XcdBarrier { unsigned* bar; unsigned x; volatile LAS unsigned* st; };
__device__ __forceinline__ XcdBarrier xcd_barrier_post(unsigned* bar, volatile LAS unsigned* st) {
    XcdBarrier b; b.bar = bar; b.x = xb_xcc_id(); b.st = st;
    if (threadIdx.x == 0) (void)xb_add(&bar[XB_XCNT(b.x)], 1u);
    return b;
}
__device__ __forceinline__ void xcd_barrier_complete(unsigned* bar, unsigned x, unsigned& nloc, unsigned& nx) {
    const unsigned G = gridDim.x * gridDim.y * gridDim.z;
    unsigned sum, cnt, mine, sp = 0u;
    for (;;) {
        sum = 0u; cnt = 0u; mine = 0u;
#pragma unroll
        for (unsigned j = 0; j < 16; ++j) { const unsigned c = xb_ld(&bar[XB_XCNT(j)]); sum += c; cnt += (c > 0u) ? 1u : 0u; mine = (j == x) ? c : mine; }
        if (sum == G) break;
        __builtin_amdgcn_s_sleep(1);
        if ((++sp & 255u) == 0u) { if (xb_ld(&bar[XB_TMO])) break; if (sp > XB_SPIN_CAP) { atomicAdd(&bar[XB_TMO], 1u); break; } }
    }
    nloc = mine > 0u ? mine : 1u; nx = cnt > 0u ? cnt : 1u;
}
__device__ __forceinline__ void xcd_barrier(const XcdBarrier& b) {
    asm volatile("s_waitcnt vmcnt(0)" ::: "memory");
    __syncthreads();
    if (threadIdx.x == 0) {
        unsigned* bar = b.bar;
        __builtin_amdgcn_s_waitcnt(0);
        unsigned nloc = b.st[0], nx = b.st[1];
        if (nloc == 0u) { xcd_barrier_complete(bar, b.x, nloc, nx); b.st[0] = nloc; b.st[1] = nx; }
        const unsigned old = xb_add(&bar[XB_XSUB(b.x)], 1u);
        const unsigned gen = old / nloc;
        if (old + 1u == (gen + 1u) * nloc) {
            __builtin_amdgcn_fence(__ATOMIC_RELEASE, "agent");
            asm volatile("s_waitcnt vmcnt(0)" ::: "memory");
            const unsigned og = xb_add(&bar[XB_TOP], 1u);
            const unsigned tg = og / nx;
            if (og + 1u == (tg + 1u) * nx) xb_add(&bar[XB_TOPGEN], 1u);
            else XB_SPIN(xb_ld(&bar[XB_TOPGEN]) == tg, bar);
            __builtin_amdgcn_fence(__ATOMIC_ACQUIRE, "agent");
            xb_add(&bar[XB_XGEN(b.x)], 1u);
            asm volatile("s_waitcnt vmcnt(0)" ::: "memory");
        } else {
            XB_SPIN(xb_ld(&bar[XB_XGEN(b.x)]) == gen, bar);
            __builtin_amdgcn_fence(__ATOMIC_ACQUIRE, "agent");
            asm volatile("s_waitcnt vmcnt(0)" ::: "memory");
        }
    }
    __syncthreads();
}

constexpr int RING_BYTES = 131072;
constexpr int LDSCTL_OFF = RING_BYTES, MISC_OFF = LDSCTL_OFF + 320;
constexpr int LDS_BYTES = 147456;
constexpr int CW_BAR = 4096;

struct Args { const float* in[22]; float* out; unsigned char* ws; int ph_lo, ph_hi; };
enum { I_X = 0, I_C, I_CTX, I_CCTX, I_WADA, I_BADA, I_NPRE_MIX, I_NPOST_MIX, I_NPRE_FFN, I_NPOST_FFN, I_WIN, I_CONVW, I_LQ1, I_LK1, I_LQ2, I_LK2, I_SUBLN, I_WOUT, I_WROUTER, I_WGATE, I_WUP, I_WDOWN };

__device__ __forceinline__ int win_dest(int n) {
    if (n < 1024) { const int j = n & 63; const int p = ((j >> 5) << 5) + ((j & 15) << 1) + ((j >> 4) & 1); return (n & ~63) + p; }
    if (n < 2048) return n;
    int c = n - 2048; const int isx = c >= 512; c &= 511; return 2048 + ((c >> 7) << 8) + (isx << 7) + (c & 127);
}
template <int MODE>
__device__ __forceinline__ int tr_dest(int n) {
    if (MODE == 0) return n;
    if (MODE == 1) return win_dest(n);
    if (MODE == 2) return ((n >> 7) << 8) + (n & 127);
    return ((n >> 7) << 8) + 128 + (n & 127);
}
template <int MODE>
__device__ __forceinline__ void p0_transpose_item(const float* W, int K, int N, bf16_t* WT, LAS float* scr, int item, int lane) {
    const int nblk = N / 32, kb = item / nblk, nb = item % nblk, k0 = 64 * kb, n0 = 32 * nb;
#pragma unroll 8
    for (int i = 0; i < 32; ++i) { const int kk = 2 * i + (lane >> 5); scr[kk * 33 + (lane & 31)] = W[(size_t)(k0 + kk) * N + n0 + (lane & 31)]; }
    LDS_WAIT(); asm volatile("" ::: "memory");
    const int c = lane & 7;
#pragma unroll
    for (int j = 0; j < 4; ++j) { const int n = (lane >> 3) + 8 * j; const LAS float* s = scr + (8 * c) * 33 + n;
        u32x4 o; o.x = pk2(s[0 * 33], s[1 * 33]); o.y = pk2(s[2 * 33], s[3 * 33]); o.z = pk2(s[4 * 33], s[5 * 33]); o.w = pk2(s[6 * 33], s[7 * 33]);
        *(GAS u32x4*)(WT + (size_t)tr_dest<MODE>(n0 + n) * K + k0 + 8 * c) = o; }
    LDS_WAIT(); asm volatile("" ::: "memory");
}

__device__ __forceinline__ void p0_prologue(const Args& a, LAS unsigned char* lds, int vcu, int G) {
    const int tid = threadIdx.x, lane = tid & 63, wave = __builtin_amdgcn_readfirstlane(tid >> 6);
    LAS float* scr = (LAS float*)(lds + wave * 16384);
    const int gw = vcu * NWAVES + wave, NGW = G * NWAVES;
    unsigned char* ws = a.ws;
    {
        float* MODP = (float*)(ws + WS_MODP);
        const float* wada = a.in[I_WADA];
        for (int it = gw; it < 96 * 16; it += NGW) {
            const int cg = it % 96, kc = it / 96;
            for (int b = 0; b < 33; ++b) { const float v = (b < 32) ? a.in[I_C][b * D + kc * 64 + lane] : a.in[I_CCTX][kc * 64 + lane]; scr[b * 64 + lane] = v / (1.f + __expf(-v)); }
            LDS_WAIT(); asm volatile("" ::: "memory");
            float acc[33];
#pragma unroll
            for (int b = 0; b < 33; ++b) acc[b] = 0.f;
            for (int k = 0; k < 64; ++k) {
                const float w = wada[(size_t)(kc * 64 + k) * NMOD + cg * 64 + lane];
#pragma unroll
                for (int b = 0; b < 33; ++b) acc[b] += scr[b * 64 + k] * w;
            }
#pragma unroll
            for (int b = 0; b < 33; ++b) MODP[((size_t)kc * 33 + b) * NMOD + cg * 64 + lane] = acc[b];
            LDS_WAIT(); asm volatile("" ::: "memory");
        }
    }
    {
        float* tab = (float*)(ws + WS_TAB);
        for (int e = gw * 64 + lane; e < T * 32; e += NGW * 64) {
            const int t = e >> 5, i = e & 31;
            const float inv = powf(10000.0f, -(float)(2 * (i & 15)) / 32.0f);
            const float pos = (i < 16) ? (float)(t >> 6) : (float)(t & 63);
            const float ang = pos * inv;
            tab[2 * e] = cosf(ang); tab[2 * e + 1] = sinf(ang);
        }
    }
    constexpr int I_IN = (D / 64) * (NPROJ / 32), I_OUT = (D / 64) * (D / 32), I_EXP = (D / 64) * (D / 32);
    constexpr int NITEMS = I_IN + I_OUT + NE * 3 * I_EXP;
    bf16_t* Win_t = (bf16_t*)(ws + WS_WIN); bf16_t* Wout_t = (bf16_t*)(ws + WS_WOUT); bf16_t* Wgu_t = (bf16_t*)(ws + WS_WGU); bf16_t* Wdn_t = (bf16_t*)(ws + WS_WDN);
    for (int it = gw; it < NITEMS; it += NGW) {
        int r = it;
        if (r < I_IN) { p0_transpose_item<1>(a.in[I_WIN], D, NPROJ, Win_t, scr, r, lane); continue; } r -= I_IN;
        if (r < I_OUT) { p0_transpose_item<0>(a.in[I_WOUT], D, D, Wout_t, scr, r, lane); continue; } r -= I_OUT;
        const int e = r / (3 * I_EXP), q = (r % (3 * I_EXP)) / I_EXP, rr = r % I_EXP;
        if (q == 0) p0_transpose_item<2>(a.in[I_WGATE] + (size_t)e * D * D, D, D, Wgu_t + (size_t)e * 2048 * D, scr, rr, lane);
        else if (q == 1) p0_transpose_item<3>(a.in[I_WUP] + (size_t)e * D * D, D, D, Wgu_t + (size_t)e * 2048 * D, scr, rr, lane);
        else p0_transpose_item<0>(a.in[I_WDOWN] + (size_t)e * D * D, D, D, Wdn_t + (size_t)e * D * D, scr, rr, lane);
    }
}

struct RowF { f32x4 v[4]; };
__device__ __forceinline__ void row_load(RowF& r, const float* xrow, int lane) {
    const f32x4* xr = (const f32x4*)xrow + lane;
#pragma unroll
    for (int j = 0; j < 4; ++j) r.v[j] = xr[64 * j];
}
__device__ __forceinline__ void norm_mod_row(const RowF& r, bf16_t* orow, const float* gain, const LAS float* sc, const LAS float* sh, int lane) {
    const f32x4* gr = (const f32x4*)gain + lane;
    float s = 0.f;
#pragma unroll
    for (int j = 0; j < 4; ++j) s += (r.v[j].x * r.v[j].x + r.v[j].y * r.v[j].y) + (r.v[j].z * r.v[j].z + r.v[j].w * r.v[j].w);
    const float rstd = 1.0f / sqrtf(wave_sum(s) * (1.f / D) + EPS);
    u32x2* o8 = (u32x2*)orow + lane;
#pragma unroll
    for (int j = 0; j < 4; ++j) { const f32x4 g = gr[64 * j]; const f32x4 c1 = *(const LAS f32x4*)(sc + 4 * lane + 256 * j), h1 = *(const LAS f32x4*)(sh + 4 * lane + 256 * j);
        const f32x4 y = (r.v[j] * rstd) * g; const f32x4 z = y * (c1 + 1.0f) + h1;
        u32x2 w; w.x = pk2(z.x, z.y); w.y = pk2(z.z, z.w); o8[64 * j] = w; }
}
__device__ __forceinline__ void p1_xn(const Args& a, LAS unsigned char* lds, int c, int G) {
    const int tid = threadIdx.x, lane = tid & 63, wave = __builtin_amdgcn_readfirstlane(tid >> 6);
    unsigned char* ws = a.ws;
    const float* MODP = (const float*)(ws + WS_MODP); float* MOD = (float*)(ws + WS_MOD); const float* bada = a.in[I_BADA];
    for (int r = c; r < 33; r += G)
        for (int n = tid; n < NMOD; n += NTHREADS) { float s = bada[n];
#pragma unroll
            for (int kc = 0; kc < 16; ++kc) s += MODP[((size_t)kc * 33 + r) * NMOD + n];
            MOD[(size_t)r * NMOD + n] = s; }
    LAS float* sv = (LAS float*)lds;
    bf16_t* XN = (bf16_t*)(ws + WS_XN);
    const float* X = a.in[I_X]; const float* CTX = a.in[I_CTX]; const float* gain = a.in[I_NPRE_MIX];
    for (int p = c; p < 256; p += G) {
        const int b = p >> 3;
        const int rbase = p * 256 + wave * 32;
        RowF a0, a1;
        row_load(a0, X + (size_t)rbase * D, lane); row_load(a1, X + (size_t)(rbase + 16) * D, lane);
        __syncthreads();
        for (int n = tid; n < 4096; n += NTHREADS) { const int r = (n < 2048) ? b : 32; const int col = n & 2047; float s = bada[col];
#pragma unroll
            for (int kc = 0; kc < 16; ++kc) s += MODP[((size_t)kc * 33 + r) * NMOD + col];
            sv[n] = s; }
        __syncthreads();
        for (int i = 0; i < 16; ++i) {
            RowF n0, n1;
            if (i + 1 < 16) { row_load(n0, X + (size_t)(rbase + i + 1) * D, lane); row_load(n1, X + (size_t)(rbase + 16 + i + 1) * D, lane); }
            else { const int crow = p * 32 + wave * 4; row_load(n0, CTX + (size_t)crow * D, lane); row_load(n1, CTX + (size_t)(crow + 1) * D, lane); }
            norm_mod_row(a0, XN + (size_t)(rbase + i) * D, gain, sv + 1024, sv, lane);
            norm_mod_row(a1, XN + (size_t)(rbase + 16 + i) * D, gain, sv + 1024, sv, lane);
            a0 = n0; a1 = n1;
        }
        {
            const int crow = p * 32 + wave * 4;
            RowF n0, n1;
            row_load(n0, CTX + (size_t)(crow + 2) * D, lane); row_load(n1, CTX + (size_t)(crow + 3) * D, lane);
            norm_mod_row(a0, XN + (size_t)(M + crow) * D, gain, sv + 3072, sv + 2048, lane);
            norm_mod_row(a1, XN + (size_t)(M + crow + 1) * D, gain, sv + 3072, sv + 2048, lane);
            norm_mod_row(n0, XN + (size_t)(M + crow + 2) * D, gain, sv + 3072, sv + 2048, lane);
            norm_mod_row(n1, XN + (size_t)(M + crow + 3) * D, gain, sv + 3072, sv + 2048, lane);
        }
    }
}

namespace att {
constexpr int KP = 272, KBUF = 64 * KP, VBUF = 16384;
constexpr int OFF_K = 0, OFF_V = 2 * KBUF, OFF_WSF = OFF_V + 2 * VBUF, OFF_END = OFF_WSF + NWAVES * 256;
static_assert(OFF_WSF >= 65536 && OFF_END <= RING_BYTES, "attention LDS map");
constexpr int NT = TK / 64;
constexpr float THR = 8.0f;
__device__ __forceinline__ int crow(int r, int hi) { return (r & 3) + 8 * (r >> 2) + 4 * hi; }
__device__ __forceinline__ s16x4 vtr(const LAS unsigned char* p) { return __builtin_bit_cast(s16x4, __builtin_amdgcn_ds_read_tr16_b64_v4i16((LAS s16x4*)p)); }

__device__ __forceinline__ void unit(LAS unsigned char* lds, int b, int h, int qb, const bf16_t* Q, const bf16_t* KA, const bf16_t* VA, bf16_t* MIXIN, const float* subg, float lam) {
    const int tid = threadIdx.x, lane = tid & 63, r32 = lane & 31, hi = lane >> 5;
    const int wid = __builtin_amdgcn_readfirstlane(tid >> 6), w = wid & 3, m = wid >> 2;
    LAS float* wsf = (LAS float*)(lds + OFF_WSF) + wid * 64;
    const int rowQ = b * T + qb * 128 + w * 32;
    bf16x8 qr[4];
#pragma unroll
    for (int d0 = 0; d0 < 4; ++d0) qr[d0] = *(const bf16x8*)(Q + (size_t)(rowQ + r32) * 512 + h * 128 + m * 64 + d0 * 16 + hi * 8);
    const bf16_t* Kb = KA + (size_t)b * TK * 512 + h * 128; const bf16_t* Vb = VA + (size_t)b * TK * 512 + h * 128;
    int gsrc[2], kdst[2], vdst[2];
#pragma unroll
    for (int i = 0; i < 2; ++i) { const int cid = tid + 512 * i, kv = cid >> 4, c16 = cid & 15;
        gsrc[i] = kv * 512 + c16 * 8; kdst[i] = kv * KP + c16 * 16; vdst[i] = (c16 >> 2) * 4096 + (kv >> 4) * 1024 + (kv & 15) * 64 + (c16 & 3) * 16; }
    u32x4 kr[2], vr[2];
#pragma unroll
    for (int i = 0; i < 2; ++i) { kr[i] = *(const u32x4*)(Kb + gsrc[i]); vr[i] = *(const u32x4*)(Vb + gsrc[i]); }
#pragma unroll
    for (int i = 0; i < 2; ++i) { *(LAS u32x4*)(lds + OFF_K + kdst[i]) = kr[i]; *(LAS u32x4*)(lds + OFF_V + vdst[i]) = vr[i]; }
    __syncthreads();
    f32x16 o[4];
#pragma unroll
    for (int d0 = 0; d0 < 4; ++d0) o[d0] = (f32x16){};
    float mhat = -1e30f, l_reg = 0.f;
    const int koff = r32 * KP + m * 128 + hi * 16;
    const int voff = ((lane >> 4) & 1) * 32 + (lane & 3) * 8 + (4 * hi + ((lane & 15) >> 2)) * 64;
    for (int j = 0; j < NT; ++j) {
        const int cur = j & 1;
        if (j + 1 < NT) {
#pragma unroll
            for (int i = 0; i < 2; ++i) { kr[i] = *(const u32x4*)(Kb + (size_t)(j + 1) * 64 * 512 + gsrc[i]); vr[i] = *(const u32x4*)(Vb + (size_t)(j + 1) * 64 * 512 + gsrc[i]); }
        }
        const LAS unsigned char* kb = lds + OFF_K + cur * KBUF + koff;
        const LAS unsigned char* vb = lds + OFF_V + cur * VBUF + voff;
        f32x16 p0 = (f32x16){}, p1 = (f32x16){};
#pragma unroll
        for (int d0 = 0; d0 < 4; ++d0) {
            const bf16x8 k0 = *(const LAS bf16x8*)(kb + d0 * 32);
            const bf16x8 k1 = *(const LAS bf16x8*)(kb + 32 * KP + d0 * 32);
            p0 = __builtin_amdgcn_mfma_f32_32x32x16_bf16(k0, qr[d0], p0, 0, 0, 0);
            p1 = __builtin_amdgcn_mfma_f32_32x32x16_bf16(k1, qr[d0], p1, 0, 0, 0);
        }
        float rm = fmaxf(p0[0], p1[0]);
#pragma unroll
        for (int r = 1; r < 16; ++r) rm = fmaxf(rm, fmaxf(p0[r], p1[r]));
        rm = fmaxf(rm, __shfl_xor(rm, 32));
        if (__any(rm > mhat + THR)) {
            const float mn = fmaxf(mhat, rm); const float f = __builtin_amdgcn_exp2f(mhat - mn); mhat = mn; l_reg *= f;
            if (hi == 0) wsf[r32] = f;
            LDS_WAIT();
#pragma unroll
            for (int r = 0; r < 16; ++r) { const float fr_ = wsf[crow(r, hi)];
#pragma unroll
                for (int d0 = 0; d0 < 4; ++d0) o[d0][r] *= fr_; }
            LDS_WAIT();
        }
        float sacc = 0.f;
#pragma unroll
        for (int r = 0; r < 16; ++r) { p0[r] = __builtin_amdgcn_exp2f(p0[r] - mhat); p1[r] = __builtin_amdgcn_exp2f(p1[r] - mhat); sacc += p0[r] + p1[r]; }
        l_reg += sacc;
        u32x4 pw[4];
#pragma unroll
        for (int q = 0; q < 4; ++q) { pw[0][q] = pk2(p0[2 * q], p0[2 * q + 1]); pw[1][q] = pk2(p0[8 + 2 * q], p0[8 + 2 * q + 1]); pw[2][q] = pk2(p1[2 * q], p1[2 * q + 1]); pw[3][q] = pk2(p1[8 + 2 * q], p1[8 + 2 * q + 1]); }
#pragma unroll
        for (int d0 = 0; d0 < 4; ++d0) {
#pragma unroll
            for (int ks = 0; ks < 4; ++ks) {
                const s16x4 lo = vtr(vb + d0 * 4096 + ks * 1024), hh = vtr(vb + d0 * 4096 + ks * 1024 + 512);
                const bf16x8 vf = (bf16x8){lo[0], lo[1], lo[2], lo[3], hh[0], hh[1], hh[2], hh[3]};
                o[d0] = __builtin_amdgcn_mfma_f32_32x32x16_bf16(__builtin_bit_cast(bf16x8, pw[ks]), vf, o[d0], 0, 0, 0);
            }
        }
        if (j + 1 < NT) {
#pragma unroll
            for (int i = 0; i < 2; ++i) { *(LAS u32x4*)(lds + OFF_K + (cur ^ 1) * KBUF + kdst[i]) = kr[i]; *(LAS u32x4*)(lds + OFF_V + (cur ^ 1) * VBUF + vdst[i]) = vr[i]; }
        }
        __syncthreads();
    }
    l_reg += __shfl_xor(l_reg, 32);
    if (hi == 0) wsf[32 + r32] = l_reg;
    LDS_WAIT();
    float rli[16];
#pragma unroll
    for (int r = 0; r < 16; ++r) rli[r] = 1.0f / wsf[32 + crow(r, hi)];
    LDS_WAIT();
    LAS float* ex = (LAS float*)lds + w * 4096;
    if (m == 1) {
#pragma unroll
        for (int r = 0; r < 16; ++r)
#pragma unroll
            for (int d0 = 0; d0 < 4; ++d0) ex[crow(r, hi) * 128 + d0 * 32 + r32] = o[d0][r] * rli[r];
    }
    __syncthreads();
    if (m == 0) {
        float g4[4];
#pragma unroll
        for (int d0 = 0; d0 < 4; ++d0) g4[d0] = subg[d0 * 32 + r32] * (1.0f - LAM_INIT);
#pragma unroll
        for (int r = 0; r < 16; ++r) {
            const int q = crow(r, hi); float x[4]; float ss = 0.f;
#pragma unroll
            for (int d0 = 0; d0 < 4; ++d0) { x[d0] = o[d0][r] * rli[r] - lam * ex[q * 128 + d0 * 32 + r32]; ss += x[d0] * x[d0]; }
#pragma unroll
            for (int off = 1; off < 32; off <<= 1) ss += __shfl_xor(ss, off);
            const float rstd = 1.0f / sqrtf(ss * (1.f / 128.f) + EPS);
            bf16_t* dst = MIXIN + (size_t)(rowQ + q) * 1024 + h * 128 + r32;
#pragma unroll
            for (int d0 = 0; d0 < 4; ++d0) dst[d0 * 32] = (bf16_t)(pk2(x[d0] * rstd * g4[d0], 0.f) & 0xffffu);
        }
    }
    __syncthreads();
}
}

__device__ __forceinline__ void p3_conv_attn(const Args& a, LAS unsigned char* lds, int c, int vcu, int G) {
    const int tid = threadIdx.x, lane = tid & 63, wave = __builtin_amdgcn_readfirstlane(tid >> 6);
    unsigned char* ws = a.ws;
    const bf16_t* GB = (const bf16_t*)(ws + WS_GB); const bf16_t* U = (const bf16_t*)(ws + WS_U); bf16_t* MIXIN = (bf16_t*)(ws + WS_MIXIN);
    {
        const float* cw = a.in[I_CONVW]; float w0[8], w1[8], w2[8];
#pragma unroll
        for (int i = 0; i < 8; ++i) { w0[i] = cw[lane * 8 + i]; w1[i] = cw[512 + lane * 8 + i]; w2[i] = cw[1024 + lane * 8 + i]; }
        const int gw = vcu * NWAVES + wave, NGW = G * NWAVES;
        for (int row = gw; row < M; row += NGW) {
            const int t = row & (T - 1);
            const u32x4 z = {0u, 0u, 0u, 0u};
            const u32x4 uc = *(const u32x4*)(U + (size_t)row * 512 + lane * 8);
            const u32x4 up = (t > 0) ? *(const u32x4*)(U + (size_t)(row - 1) * 512 + lane * 8) : z;
            const u32x4 un = (t < T - 1) ? *(const u32x4*)(U + (size_t)(row + 1) * 512 + lane * 8) : z;
            const u32x4 gb = *(const u32x4*)(GB + (size_t)row * 512 + lane * 8);
            u32x4 o;
#pragma unroll
            for (int q = 0; q < 4; ++q) {
                const float y0 = w0[2 * q] * bflo(up[q]) + w1[2 * q] * bflo(uc[q]) + w2[2 * q] * bflo(un[q]);
                const float y1 = w0[2 * q + 1] * bfhi(up[q]) + w1[2 * q + 1] * bfhi(uc[q]) + w2[2 * q + 1] * bfhi(un[q]);
                o[q] = pk2(bflo(gb[q]) * y0, bfhi(gb[q]) * y1);
            }
            *(u32x4*)(MIXIN + (size_t)row * 1024 + 512 + lane * 8) = o;
        }
    }
    float lam;
    { const float p1 = a.in[I_LQ1][lane] * a.in[I_LK1][lane], p2 = a.in[I_LQ2][lane] * a.in[I_LK2][lane];
      lam = __expf(wave_sum(p1)) - __expf(wave_sum(p2)) + LAM_INIT; }
    const bf16_t* Q = (const bf16_t*)(ws + WS_Q); const bf16_t* KA = (const bf16_t*)(ws + WS_K); const bf16_t* VA = (const bf16_t*)(ws + WS_V);
    __syncthreads();
    for (int u = vcu * 8; u < 2048; u += G * 8) {
        const int x = (u >> 3) / 32, jj = (u >> 3) % 32;
        for (int i = 0; i < 8; ++i) {
            const int bh = 16 * x + 2 * i + (jj >> 4), qb = jj & 15;
            att::unit(lds, bh >> 2, bh & 3, qb, Q, KA, VA, MIXIN, a.in[I_SUBLN], lam);
        }
    }
}

struct P5In { f32x4 x[4]; u32x2 m[4]; };
__device__ __forceinline__ void p5_load(P5In& r, int row, int lane, const float* X, const bf16_t* MIX) {
    const f32x4* xr = (const f32x4*)(X + (size_t)row * D) + lane; const u32x2* mr = (const u32x2*)(MIX + (size_t)row * D) + lane;
#pragma unroll
    for (int j = 0; j < 4; ++j) { r.x[j] = xr[64 * j]; r.m[j] = mr[64 * j]; }
}
__device__ __forceinline__ float p5_resid(const P5In& r, f32x4 (&h)[4], int row, int lane, const LAS float* mv, const f32x4* npm, bf16_t* H1) {
    f32x4 mx[4]; float s = 0.f;
#pragma unroll
    for (int j = 0; j < 4; ++j) { const u32x2 wv = r.m[j]; mx[j] = (f32x4){bflo(wv.x), bfhi(wv.x), bflo(wv.y), bfhi(wv.y)};
        s += (mx[j].x * mx[j].x + mx[j].y * mx[j].y) + (mx[j].z * mx[j].z + mx[j].w * mx[j].w); }
    const float rstd1 = 1.0f / sqrtf(wave_sum(s) * (1.f / D) + EPS);
    u32x2* hr = (u32x2*)(H1 + (size_t)row * D) + lane; float s2 = 0.f;
#pragma unroll
    for (int j = 0; j < 4; ++j) { const f32x4 g1 = *(const LAS f32x4*)(mv + 4 * lane + 256 * j);
        h[j] = r.x[j] + g1 * ((mx[j] * rstd1) * npm[64 * j]);
        u32x2 wv; wv.x = pk2(h[j].x, h[j].y); wv.y = pk2(h[j].z, h[j].w); hr[64 * j] = wv;
        s2 += (h[j].x * h[j].x + h[j].y * h[j].y) + (h[j].z * h[j].z + h[j].w * h[j].w); }
    return 1.0f / sqrtf(wave_sum(s2) * (1.f / D) + EPS);
}
__device__ __forceinline__ void p5_rows(const Args& a, LAS unsigned char* lds, int p  ) {
    const int tid = threadIdx.x, lane = tid & 63, wave = __builtin_amdgcn_readfirstlane(tid >> 6);
    unsigned char* ws = a.ws;
    const int b = p >> 3;
    LAS float* wrt = (LAS float*)lds;
    LAS float* mv = (LAS float*)(lds + 65536);
    const float* wr = a.in[I_WROUTER];
    const bf16_t* MIX = (const bf16_t*)(ws + WS_MIX); bf16_t* XN2 = (bf16_t*)(ws + WS_XN); float* AFFT = (float*)(ws + WS_AFFT); bf16_t* H1 = (bf16_t*)(ws + WS_H1);
    const float* X = a.in[I_X];
    const int rbase = p * 256 + wave * 32;
    P5In cA, cB;
    p5_load(cA, rbase, lane, X, MIX); p5_load(cB, rbase + 16, lane, X, MIX);
    for (int n = tid; n < D * NE; n += NTHREADS) { const int k = n >> 4, e = n & 15; wrt[e * D + k] = wr[n]; }
    const float* MOD = (const float*)(ws + WS_MOD) + (size_t)b * NMOD;
    for (int n = tid; n < 3 * D; n += NTHREADS) mv[n] = MOD[2 * D + n];
    __syncthreads();
    const f32x4* npm = (const f32x4*)a.in[I_NPOST_MIX] + lane; const f32x4* npf = (const f32x4*)a.in[I_NPRE_FFN] + lane;
    for (int i = 0; i < 16; ++i) {
        const int rowA = rbase + i, rowB = rbase + 16 + i;
        P5In nA, nB;
        if (i + 1 < 16) { p5_load(nA, rowA + 1, lane, X, MIX); p5_load(nB, rowB + 1, lane, X, MIX); }
        f32x4 hA[4], hB[4];
        const float rsA = p5_resid(cA, hA, rowA, lane, mv, npm, H1);
        const float rsB = p5_resid(cB, hB, rowB, lane, mv, npm, H1);
        u32x2* oA = (u32x2*)(XN2 + (size_t)rowA * D) + lane; u32x2* oB = (u32x2*)(XN2 + (size_t)rowB * D) + lane;
        float lg[32];
#pragma unroll
        for (int e = 0; e < 32; ++e) lg[e] = 0.f;
#pragma unroll
        for (int j = 0; j < 4; ++j) { const f32x4 sh2 = *(const LAS f32x4*)(mv + 1024 + 4 * lane + 256 * j), sc2 = *(const LAS f32x4*)(mv + 2048 + 4 * lane + 256 * j);
            const f32x4 gn = npf[64 * j];
            const f32x4 zA = ((hA[j] * rsA) * gn) * (sc2 + 1.0f) + sh2, zB = ((hB[j] * rsB) * gn) * (sc2 + 1.0f) + sh2;
            u32x2 wv; wv.x = pk2(zA.x, zA.y); wv.y = pk2(zA.z, zA.w); oA[64 * j] = wv; wv.x = pk2(zB.x, zB.y); wv.y = pk2(zB.z, zB.w); oB[64 * j] = wv;
#pragma unroll
            for (int e = 0; e < 16; ++e) { const f32x4 wq = *(const LAS f32x4*)(wrt + e * D + 4 * lane + 256 * j);
                lg[e] += (zA.x * wq.x + zA.y * wq.y) + (zA.z * wq.z + zA.w * wq.w); lg[16 + e] += (zB.x * wq.x + zB.y * wq.y) + (zB.z * wq.z + zB.w * wq.w); } }
#pragma unroll
        for (int st = 0; st < 5; ++st) { const int d = 1 << st, cntv = 16 >> st; const bool up = (lane & d) != 0;
#pragma unroll
            for (int q = 0; q < 16; ++q) if (q < cntv) { const float send = up ? lg[2 * q] : lg[2 * q + 1], keep = up ? lg[2 * q + 1] : lg[2 * q]; lg[q] = keep + __shfl_xor(send, d); } }
        float lv = lg[0] + __shfl_xor(lg[0], 32);
        float mxl = lv;
#pragma unroll
        for (int d = 1; d < 16; d <<= 1) mxl = fmaxf(mxl, __shfl_xor(mxl, d));
        const float ev = __expf(lv - mxl); float se = ev;
#pragma unroll
        for (int d = 1; d < 16; d <<= 1) se += __shfl_xor(se, d);
        if (lane < 32) { const int row = (lane < 16) ? rowA : rowB; AFFT[((size_t)b * NE + (lane & 15)) * T + (row & (T - 1))] = ev / se; }
        cA = nA; cB = nB;
    }
}

__device__ __forceinline__ void p6_topk(const Args& a, LAS unsigned char* lds, int c, int G) {
    const int tid = threadIdx.x, lane = tid & 63, wave = __builtin_amdgcn_readfirstlane(tid >> 6);
    unsigned char* ws = a.ws;
    const float* AFFT = (const float*)(ws + WS_AFFT); short* SLOT = (short*)(ws + WS_SLOT); int* IDX = (int*)(ws + WS_IDX); float* GATE = (float*)(ws + WS_GATE);
    LAS unsigned* sv = (LAS unsigned*)(lds + wave * 16384);
    for (int item = c + wave * G; item < NITEM; item += G * NWAVES) {
        const int b = item >> 4, e = item & 15;
        const float* src = AFFT + (size_t)item * T;
#pragma unroll 8
        for (int j = 0; j < 32; ++j) sv[j * 64 + lane] = __float_as_uint(src[j * 64 + lane]);
        LDS_WAIT(); asm volatile("" ::: "memory");
        unsigned pre = 0u;
        for (int bit = 30; bit >= 0; --bit) {
            const unsigned cand = pre | (1u << bit);
            int cnt = 0;
#pragma unroll 4
            for (int j = 0; j < 32; ++j) cnt += (int)__popcll(__ballot(sv[j * 64 + lane] >= cand));
            if (cnt >= CAP) pre = cand;
        }
        int ngt = 0;
#pragma unroll 4
        for (int j = 0; j < 32; ++j) ngt += (int)__popcll(__ballot(sv[j * 64 + lane] > pre));
        const int need_eq = CAP - ngt;
        const unsigned long long ltmask = (1ull << lane) - 1ull;
        int base_gt = 0, base_eq = 0;
#pragma unroll 2
        for (int j = 0; j < 32; ++j) {
            const unsigned vj = sv[j * 64 + lane];
            const bool gt = vj > pre, eq = vj == pre;
            const unsigned long long mg = __ballot(gt), me = __ballot(eq);
            const int pg = base_gt + (int)__popcll(mg & ltmask), pe = base_eq + (int)__popcll(me & ltmask);
            int sl = -1; if (gt) sl = pg; else if (eq && pe < need_eq) sl = ngt + pe;
            const int t = j * 64 + lane;
            SLOT[((size_t)b * T + t) * NE + e] = (short)sl;
            if (sl >= 0) { IDX[item * CAP + sl] = t; GATE[item * CAP + sl] = __uint_as_float(vj); }
            base_gt += (int)__popcll(mg); base_eq += (int)__popcll(me);
        }
        LDS_WAIT(); asm volatile("" ::: "memory");
    }
}

struct P8Row { u32x2 h[4]; u32x2 y[4][4]; float wt[4]; unsigned long long rest; int sl; };
__device__ __forceinline__ void p8_issue(P8Row& r, int row, int lane, const short* SLOT, const bf16_t* Y, const bf16_t* H1) {
    const int b = row >> 11;
    const int s_e = (lane < NE) ? (int)SLOT[(size_t)row * NE + lane] : -1;
    unsigned long long mask = __ballot(s_e >= 0);
    const u32x2* hr = (const u32x2*)(H1 + (size_t)row * D) + lane;
#pragma unroll
    for (int j = 0; j < 4; ++j) r.h[j] = hr[64 * j];
#pragma unroll
    for (int q = 0; q < 4; ++q) {
        int e = 0, s = 0; r.wt[q] = 0.f;
        if (mask) { e = (int)__builtin_ctzll(mask); mask &= mask - 1ull; s = __builtin_amdgcn_readlane(s_e, e); r.wt[q] = 1.f; }
        const u32x2* yr = (const u32x2*)(Y + ((size_t)(b * NE + e) * CAP + s) * D) + lane;
#pragma unroll
        for (int j = 0; j < 4; ++j) r.y[q][j] = yr[64 * j];
    }
    r.rest = mask; r.sl = s_e;
}
__device__ __forceinline__ void p8_finish(P8Row& r, int row, int lane, const bf16_t* Y, const float* MOD, const f32x4* npo, float* out) {
    const int b = row >> 11;
    f32x4 ff[4];
#pragma unroll
    for (int j = 0; j < 4; ++j) ff[j] = (f32x4){0.f, 0.f, 0.f, 0.f};
#pragma unroll
    for (int q = 0; q < 4; ++q)
#pragma unroll
        for (int j = 0; j < 4; ++j) { const u32x2 wv = r.y[q][j]; ff[j] += (f32x4){bflo(wv.x), bfhi(wv.x), bflo(wv.y), bfhi(wv.y)} * r.wt[q]; }
    unsigned long long mask = r.rest;
    while (mask) {
        const int e = (int)__builtin_ctzll(mask); mask &= mask - 1ull; const int s = __builtin_amdgcn_readlane(r.sl, e);
        const u32x2* yr = (const u32x2*)(Y + ((size_t)(b * NE + e) * CAP + s) * D) + lane;
#pragma unroll
        for (int j = 0; j < 4; ++j) { const u32x2 wv = yr[64 * j]; ff[j] += (f32x4){bflo(wv.x), bfhi(wv.x), bflo(wv.y), bfhi(wv.y)}; }
    }
    float s2 = 0.f;
#pragma unroll
    for (int j = 0; j < 4; ++j) s2 += (ff[j].x * ff[j].x + ff[j].y * ff[j].y) + (ff[j].z * ff[j].z + ff[j].w * ff[j].w);
    const float rstd = 1.0f / sqrtf(wave_sum(s2) * (1.f / D) + EPS);
    f32x4* orow = (f32x4*)(out + (size_t)row * D) + lane; const f32x4* g2 = (const f32x4*)(MOD + (size_t)b * NMOD + 5 * D) + lane;
#pragma unroll
    for (int j = 0; j < 4; ++j) { const u32x2 hv = r.h[j]; const f32x4 h = (f32x4){bflo(hv.x), bfhi(hv.x), bflo(hv.y), bfhi(hv.y)};
        orow[64 * j] = h + g2[64 * j] * ((ff[j] * rstd) * npo[64 * j]); }
}
__device__ __forceinline__ void p8_final(const Args& a, int vcu, int G) {
    const int tid = threadIdx.x, lane = tid & 63, wave = __builtin_amdgcn_readfirstlane(tid >> 6);
    unsigned char* ws = a.ws;
    const short* SLOT = (const short*)(ws + WS_SLOT); const bf16_t* Y = (const bf16_t*)(ws + WS_Y); const float* MOD = (const float*)(ws + WS_MOD); const bf16_t* H1 = (const bf16_t*)(ws + WS_H1);
    const f32x4* npo = (const f32x4*)a.in[I_NPOST_FFN] + lane;
    const int gw = vcu * NWAVES + wave, NGW = G * NWAVES;
    for (int row = gw; row < M; row += 2 * NGW) {
        P8Row r0, r1;
        p8_issue(r0, row, lane, SLOT, Y, H1);
        const bool two = row + NGW < M;
        if (two) p8_issue(r1, row + NGW, lane, SLOT, Y, H1);
        p8_finish(r0, row, lane, Y, MOD, npo, a.out);
        if (two) p8_finish(r1, row + NGW, lane, Y, MOD, npo, a.out);
    }
}

__global__ void __launch_bounds__(NTHREADS, 2) fwd_kernel(Args args) {
    extern __shared__ __attribute__((aligned(16))) unsigned char lds_raw[];
    LAS unsigned char* lds = (LAS unsigned char*)lds_raw;
    volatile LAS unsigned* MISC = (volatile LAS unsigned*)(lds + MISC_OFF);
    const int tid = threadIdx.x;
    const int G = gridDim.x, c = blockIdx.x;
    const int vcu = (G % 8 == 0) ? (c % 8) * (G / 8) + c / 8 : c;
    unsigned char* ws = args.ws;
    gu32* ctl = (gu32*)(ws + WS_CTL);
    for (int u = tid; u < (LDS_BYTES - LDSCTL_OFF) / 4; u += NTHREADS) ((LAS unsigned*)(lds + LDSCTL_OFF))[u] = 0u;
    __syncthreads();
    XcdBarrier bar; bar.bar = (unsigned*)(ctl + CW_BAR); bar.x = 0; bar.st = nullptr;
    const int lo = args.ph_lo, hi = args.ph_hi;
    if (hi - lo > 1) bar = xcd_barrier_post((unsigned*)(ctl + CW_BAR), MISC + 8);
#ifndef PHMASK
#define PHMASK 0xff
#endif
#define IN(k) (((PHMASK >> (k)) & 1) && lo <= (k) && (k) < hi)
#define SEAM(k) do { if (IN(k) && IN((k) + 1)) xcd_barrier(bar); } while (0)
#ifndef PROBE_PHASE
#define PROBE_PHASE -1
#endif
#define PB(k) do { if (PROBE_PHASE == (k)) { if (tid == 0) { const unsigned long long t0_ = __builtin_amdgcn_s_memrealtime(); MISC[16] = (unsigned)t0_; MISC[17] = (unsigned)(t0_ >> 32); } } } while (0)
#define PE(k) do { if (PROBE_PHASE == (k)) { if (tid == 0) { const unsigned long long t0_ = ((unsigned long long)MISC[17] << 32) | MISC[16]; const unsigned long long t1_ = __builtin_amdgcn_s_memrealtime(); \
      while (__builtin_amdgcn_s_memrealtime() - t1_ < t1_ - t0_) __builtin_amdgcn_s_sleep(8); } __syncthreads(); } } while (0)

    PB(0); if (IN(0)) { p0_prologue(args, lds, vcu, G); } SEAM(0); PE(0);
    PB(1); if (IN(1)) { p1_xn(args, lds, c, G); } SEAM(1); PE(1);
    PB(2); if (IN(2)) {
        pg8::Gemm g{(const bf16_t*)(ws + WS_XN), (const bf16_t*)(ws + WS_WIN), D, nullptr};
        pg8::SchedProj S{G, c};
        pg8::EpiProj E{(bf16_t*)(ws + WS_Q), (bf16_t*)(ws + WS_K), (bf16_t*)(ws + WS_V), (bf16_t*)(ws + WS_GB), (bf16_t*)(ws + WS_U), (const float*)(ws + WS_TAB)};
        pg8::gemm_phase<pg8::EpiProj, pg8::SchedProj, true, true>(lds, g, S, E);
    } SEAM(2); PE(2);
    PB(3); if (IN(3)) { p3_conv_attn(args, lds, c, vcu, G); } SEAM(3); PE(3);
    PB(4); if (IN(4)) {
        {
            const int p = c;
#ifndef NO_P4
            pg8::Gemm g{(const bf16_t*)(ws + WS_MIXIN), (const bf16_t*)(ws + WS_WOUT), D, nullptr};
            pg8::SchedPanel S{p, 4};
            pg8::EpiBf16 E{(bf16_t*)(ws + WS_MIX), D};
            pg8::gemm_phase<pg8::EpiBf16, pg8::SchedPanel, true, true>(lds, g, S, E);
#endif
            VM_WAIT(); __syncthreads();
#ifndef NO_P5
            p5_rows(args, lds, p);
#endif
            __syncthreads();
        }
    } SEAM(4); PE(4);
    PB(5); if (IN(5)) { p6_topk(args, lds, c, G); } SEAM(5); PE(5);
    PB(6); if (IN(6)) {
#pragma unroll 1
        for (int it = 0; it < 2; ++it) {
            {
                const int item = 2 * c + it;
                const int b = item >> 4, e = item & 15;
#ifndef NO_G1
                {
                    pg8::Gemm g{(const bf16_t*)(ws + WS_XN) + (size_t)b * T * D, (const bf16_t*)(ws + WS_WGU) + (size_t)e * 2048 * D, D, (const int*)(ws + WS_IDX) + item * CAP};
                    pg8::SchedPanel S{0, 8};
                    pg8::EpiGU E{(bf16_t*)(ws + WS_HMID) + (size_t)item * CAP * D};
                    pg8::gemm_phase<pg8::EpiGU, pg8::SchedPanel, true, true, true>(lds, g, S, E);
                }
#endif
                VM_WAIT(); __syncthreads();
#ifndef NO_G2
                {
                    pg8::Gemm g{(const bf16_t*)(ws + WS_HMID) + (size_t)item * CAP * D, (const bf16_t*)(ws + WS_WDN) + (size_t)e * D * D, D, nullptr};
                    pg8::SchedPanel S{0, 4};
                    pg8::EpiDown E{(bf16_t*)(ws + WS_Y) + (size_t)item * CAP * D, (const float*)(ws + WS_GATE) + item * CAP};
                    pg8::gemm_phase<pg8::EpiDown, pg8::SchedPanel, true, true>(lds, g, S, E);
                }
#endif
                VM_WAIT(); __syncthreads();
            }
        }
    } SEAM(6); PE(6);
    PB(7); if (IN(7)) { p8_final(args, vcu, G); } PE(7);
#undef IN
#undef SEAM
}

extern "C" void kernel_launch(void* const* d_in, const int* in_sizes, int n_in, void* d_out, int out_size, void* d_ws, size_t ws_size, hipStream_t stream) {
    static int grid = 0;
    if (grid == 0) {
        if (n_in != 22 || in_sizes[0] != M * D || out_size != M * D || ws_size < WS_END) { fprintf(stderr, "kernel_launch: unexpected shapes (n_in %d, in0 %d, out %d, ws %zu)\n", n_in, n_in > 0 ? in_sizes[0] : -1, out_size, ws_size); grid = -1; return; }
        int dev = 0, cus = 0;
        if (hipGetDevice(&dev) != hipSuccess || hipDeviceGetAttribute(&cus, hipDeviceAttributeMultiprocessorCount, dev) != hipSuccess) { grid = -1; return; }
        if (hipFuncSetAttribute((const void*)fwd_kernel, hipFuncAttributeMaxDynamicSharedMemorySize, LDS_BYTES) != hipSuccess) { fprintf(stderr, "kernel_launch: hipFuncSetAttribute failed\n"); grid = -1; return; }
        (void)hipGetLastError();
        grid = cus;
        if (grid != 256) { fprintf(stderr, "kernel_launch: this kernel needs a 256-CU device (got %d)\n", cus); grid = -1; return; }
    }
    if (grid < 0) return;
    (void)hipMemsetAsync((char*)d_ws + WS_CTL, 0, CTL_ZERO_BYTES, stream);
    Args a{};
    for (int i = 0; i < 22; ++i) a.in[i] = (const float*)d_in[i];
    a.out = (float*)d_out; a.ws = (unsigned char*)d_ws;
    constexpr int NPH = 8;
    if (MK_N_LAUNCHES == 1) { a.ph_lo = 0; a.ph_hi = NPH; hipLaunchKernelGGL(fwd_kernel, dim3(grid), dim3(NTHREADS), LDS_BYTES, stream, a); }
    else { for (int k = 0; k < NPH; ++k) { a.ph_lo = k; a.ph_hi = k + 1; hipLaunchKernelGGL(fwd_kernel, dim3(grid), dim3(NTHREADS), LDS_BYTES, stream, a); } }
}
```

```cpp
#include <hip/hip_runtime.h>
#include <cstdio>
#include <cstdint>

#ifndef MK_N_LAUNCHES
#define MK_N_LAUNCHES 1
#endif

#define LAS __attribute__((address_space(3)))
#define GAS __attribute__((address_space(1)))
typedef unsigned short bf16_t;
typedef short bf16x8 __attribute__((ext_vector_type(8)));
typedef short s16x4 __attribute__((ext_vector_type(4)));
typedef float f32x4 __attribute__((ext_vector_type(4)));
typedef float f32x16 __attribute__((ext_vector_type(16)));
typedef unsigned u32x4 __attribute__((ext_vector_type(4)));
typedef unsigned u32x2 __attribute__((ext_vector_type(2)));

constexpr int NB = 32, T = 2048, D = 1024, TC = 256, M = NB * T, MC = NB * TC, MA = M + MC, TK = TC + T;
constexpr int NE = 16, CAP = 256, NITEM = NB * NE, NPROJ = 3072, NMOD = 6 * D;
constexpr float EPS = 1e-6f;
constexpr float C2 = 0.125f * 1.4426950408889634f;
constexpr float LAM_INIT = 0.2f;
constexpr int NWAVES = 8, NTHREADS = 512;

constexpr size_t MiB = 1u << 20;
constexpr size_t WS_CTL = 0, CTL_ZERO_BYTES = 1 * MiB;
constexpr size_t WS_MODP = 2 * MiB;
constexpr size_t WS_MOD = 16 * MiB;
constexpr size_t WS_TAB = 17 * MiB;
constexpr size_t WS_WIN = 18 * MiB;
constexpr size_t WS_WOUT = 24 * MiB;
constexpr size_t WS_WGU = 26 * MiB;
constexpr size_t WS_WDN = 90 * MiB;
constexpr size_t WS_AFFT = 122 * MiB;
constexpr size_t WS_SLOT = 126 * MiB;
constexpr size_t WS_IDX = 128 * MiB;
constexpr size_t WS_GATE = 129 * MiB;
constexpr size_t WS_XN = 130 * MiB;
constexpr size_t WS_Q = 274 * MiB;
constexpr size_t WS_K = 338 * MiB;
constexpr size_t WS_V = 410 * MiB;
constexpr size_t WS_GB = 482 * MiB;
constexpr size_t WS_U = 546 * MiB;
constexpr size_t WS_MIXIN = 610 * MiB;
constexpr size_t WS_MIX = 738 * MiB;
constexpr size_t WS_HMID = 274 * MiB;
constexpr size_t WS_Y = 610 * MiB;
constexpr size_t WS_H1 = 866 * MiB;
constexpr size_t WS_END = 994 * MiB;

__device__ __forceinline__ int opaque_tid() { int t = threadIdx.x; asm volatile("" : "+v"(t)); return t; }

namespace pg8 {
constexpr int BM = 256, BK = 64, HALF = 128, HTB = HALF * BK * 2, STAGE_BYTES = 8 * HTB;
__host__ __device__ __forceinline__ int lds_byte(int r, int c) { const int st = (r >> 4) * 2 + (c >> 5), rr = r & 15, cc = c & 31, ob = rr * 64 + cc * 2; return st * 1024 + (ob ^ (((ob >> 9) & 1) << 5)); }
__host__ __device__ __forceinline__ void stage_rc(int b, int& R, int& C) { const int st = b / 1024, sb = b % 1024, swz = sb ^ (((sb >> 9) & 1) << 5); R = (st >> 1) * 16 + swz / 64; C = (st & 1) * 32 + (swz % 64) / 2; }
__host__ __device__ __forceinline__ int perm32(int rho) { const int n = rho >> 4, i = rho & 15; return 8 * (i >> 2) + 4 * n + (i & 3); }

struct Unit { int pm, pn; };
struct Gemm { const bf16_t* A; const bf16_t* Bt; int K; const int* gidx; };

typedef float f32x2_t __attribute__((ext_vector_type(2))); typedef __bf16 bf16x2_t __attribute__((ext_vector_type(2)));
__device__ __forceinline__ unsigned cvt_pk_bf16(float lo, float hi) { const f32x2_t v = {lo, hi}; const bf16x2_t b = __builtin_convertvector(v, bf16x2_t); return __builtin_bit_cast(unsigned, b); }

struct EpiBf16 {
    static constexpr bool PERM = true, AFTER_DRAIN = false;
    bf16_t* O; int ldc;
    __device__ __forceinline__ void operator()(const f32x4 (&acc)[2][2][4][2], const Unit& u, int wr, int wc, int fr, int fq) const {
        const int row0 = u.pm * BM + wr * 64 + fr; const int col0 = u.pn * BM + wc * 32 + 8 * fq;
#pragma unroll
        for (int ai = 0; ai < 2; ++ai)
#pragma unroll
            for (int m = 0; m < 4; ++m) { bf16_t* rowp = O + (size_t)(row0 + ai * HALF + m * 16) * ldc + col0;
#pragma unroll
                for (int bj = 0; bj < 2; ++bj) { const f32x4 v0 = acc[ai][bj][m][0], v1 = acc[ai][bj][m][1];
                    u32x4 w; w.x = cvt_pk_bf16(v0[0], v0[1]); w.y = cvt_pk_bf16(v0[2], v0[3]); w.z = cvt_pk_bf16(v1[0], v1[1]); w.w = cvt_pk_bf16(v1[2], v1[3]);
                    *(u32x4*)(rowp + bj * HALF) = w; } }
    }
};

struct EpiProj {
    static constexpr bool PERM = true, AFTER_DRAIN = false;
    bf16_t *Q, *KA, *VA, *GB, *U; const float* tab;
    __device__ __forceinline__ void operator()(const f32x4 (&acc)[2][2][4][2], const Unit& u, int wr, int wc, int fr, int fq) const {
        const int pn = u.pn; const bool ctx = u.pm >= 256;
#pragma unroll
        for (int ai = 0; ai < 2; ++ai)
#pragma unroll
            for (int m = 0; m < 4; ++m) {
                const int row = u.pm * BM + ai * HALF + wr * 64 + m * 16 + fr;
                int t, kvrow;
                if (!ctx) { const int b = row >> 11; t = row & 2047; kvrow = b * TK + TC + t; }
                else { const int rc = row - M; const int b = rc >> 8; t = 0; kvrow = b * TK + (rc & 255); }
                if (pn < 4) {
                    f32x4 cs0 = {1.f, 0.f, 1.f, 0.f}, cs1 = cs0, cs2 = cs0, cs3 = cs0;
                    if (!ctx) { const float* tp = tab + ((size_t)t * 32 + 16 * (wc & 1) + 4 * fq) * 2;
                        cs0 = *(const f32x4*)(tp); cs1 = *(const f32x4*)(tp + 4); }
                    (void)cs2; (void)cs3;
#pragma unroll
                    for (int bj = 0; bj < 2; ++bj) {
                        const f32x4 v0 = acc[ai][bj][m][0], v1 = acc[ai][bj][m][1];
                        float e0 = v0[0], o0 = v0[1], e1 = v0[2], o1 = v0[3], e2 = v1[0], o2 = v1[1], e3 = v1[2], o3 = v1[3];
                        float r0 = e0 * cs0[0] - o0 * cs0[1], s0 = o0 * cs0[0] + e0 * cs0[1];
                        float r1 = e1 * cs0[2] - o1 * cs0[3], s1 = o1 * cs0[2] + e1 * cs0[3];
                        float r2 = e2 * cs1[0] - o2 * cs1[1], s2 = o2 * cs1[0] + e2 * cs1[1];
                        float r3 = e3 * cs1[2] - o3 * cs1[3], s3 = o3 * cs1[2] + e3 * cs1[3];
                        const float sc = (pn < 2) ? C2 : 1.f;
                        u32x4 w; w.x = cvt_pk_bf16(r0 * sc, s0 * sc); w.y = cvt_pk_bf16(r1 * sc, s1 * sc); w.z = cvt_pk_bf16(r2 * sc, s2 * sc); w.w = cvt_pk_bf16(r3 * sc, s3 * sc);
                        const int col = (pn & 1) * 256 + bj * HALF + wc * 32 + 8 * fq;
                        bf16_t* dst = (pn < 2) ? (Q + (size_t)row * 512 + col) : (KA + (size_t)kvrow * 512 + col);
                        *(u32x4*)dst = w;
                    }
                } else if (pn < 8) {
#pragma unroll
                    for (int bj = 0; bj < 2; ++bj) {
                        const f32x4 v0 = acc[ai][bj][m][0], v1 = acc[ai][bj][m][1];
                        u32x4 w; w.x = cvt_pk_bf16(v0[0], v0[1]); w.y = cvt_pk_bf16(v0[2], v0[3]); w.z = cvt_pk_bf16(v1[0], v1[1]); w.w = cvt_pk_bf16(v1[2], v1[3]);
                        const int col = (pn & 1) * 256 + bj * HALF + wc * 32 + 8 * fq;
                        bf16_t* dst = (pn < 6) ? (VA + (size_t)kvrow * 512 + col) : (GB + (size_t)row * 512 + col);
                        *(u32x4*)dst = w;
                    }
                } else {
                    const f32x4 a0 = acc[ai][0][m][0], a1 = acc[ai][0][m][1], b0 = acc[ai][1][m][0], b1 = acc[ai][1][m][1];
                    u32x4 w; w.x = cvt_pk_bf16(a0[0] * b0[0], a0[1] * b0[1]); w.y = cvt_pk_bf16(a0[2] * b0[2], a0[3] * b0[3]);
                    w.z = cvt_pk_bf16(a1[0] * b1[0], a1[1] * b1[1]); w.w = cvt_pk_bf16(a1[2] * b1[2], a1[3] * b1[3]);
                    const int col = (pn - 8) * 128 + wc * 32 + 8 * fq;
                    *(u32x4*)(U + (size_t)row * 512 + col) = w;
                }
            }
    }
};

struct EpiGU {
    static constexpr bool PERM = true, AFTER_DRAIN = false;
    bf16_t* H;
    __device__ __forceinline__ float silu(float x) const { return x * __builtin_amdgcn_rcpf(1.f + __expf(-x)); }
    __device__ __forceinline__ void operator()(const f32x4 (&acc)[2][2][4][2], const Unit& u, int wr, int wc, int fr, int fq) const {
#pragma unroll
        for (int ai = 0; ai < 2; ++ai)
#pragma unroll
            for (int m = 0; m < 4; ++m) {
                const int row = ai * HALF + wr * 64 + m * 16 + fr;
                const f32x4 a0 = acc[ai][0][m][0], a1 = acc[ai][0][m][1], b0 = acc[ai][1][m][0], b1 = acc[ai][1][m][1];
                u32x4 w; w.x = cvt_pk_bf16(silu(a0[0]) * b0[0], silu(a0[1]) * b0[1]); w.y = cvt_pk_bf16(silu(a0[2]) * b0[2], silu(a0[3]) * b0[3]);
                w.z = cvt_pk_bf16(silu(a1[0]) * b1[0], silu(a1[1]) * b1[1]); w.w = cvt_pk_bf16(silu(a1[2]) * b1[2], silu(a1[3]) * b1[3]);
                *(u32x4*)(H + (size_t)row * 1024 + u.pn * 128 + wc * 32 + 8 * fq) = w;
            }
    }
};
struct EpiDown {
    static constexpr bool PERM = true, AFTER_DRAIN = false;
    bf16_t* Y; const float* gate;
    __device__ __forceinline__ void operator()(const f32x4 (&acc)[2][2][4][2], const Unit& u, int wr, int wc, int fr, int fq) const {
#pragma unroll
        for (int ai = 0; ai < 2; ++ai)
#pragma unroll
            for (int m = 0; m < 4; ++m) {
                const int row = ai * HALF + wr * 64 + m * 16 + fr; const float g = gate[row];
#pragma unroll
                for (int bj = 0; bj < 2; ++bj) { const f32x4 v0 = acc[ai][bj][m][0] * g, v1 = acc[ai][bj][m][1] * g;
                    u32x4 w; w.x = cvt_pk_bf16(v0[0], v0[1]); w.y = cvt_pk_bf16(v0[2], v0[3]); w.z = cvt_pk_bf16(v1[0], v1[1]); w.w = cvt_pk_bf16(v1[2], v1[3]);
                    *(u32x4*)(Y + (size_t)row * 1024 + u.pn * BM + bj * HALF + wc * 32 + 8 * fq) = w; }
            }
    }
};

struct SchedProj {
    int G, c;
    __device__ __forceinline__ bool next(int i, Unit& u) const {
        const int L = i * G + c;
        if (L < 3072) { u.pm = L & 255; u.pn = L >> 8; return true; }
        const int j = L - 3072; if (j >= 128) return false;
        u.pm = 256 + (j >> 2); u.pn = 2 + (j & 3); return true;
    }
    __device__ __forceinline__ void a_ready(const Unit&) const {}
    __device__ __forceinline__ void done(const Unit&) const {}
};
struct SchedPanel {
    int pm, ntn;
    __device__ __forceinline__ bool next(int i, Unit& u) const { if (i >= ntn) return false; u.pm = pm; u.pn = i; return true; }
    __device__ __forceinline__ void a_ready(const Unit&) const {}
    __device__ __forceinline__ void done(const Unit&) const {}
};

template <class Epi, class Sched, bool ALIGN_EPI, bool SP2, bool GATHER = false>
__device__ __forceinline__ void gemm_phase(LAS unsigned char* lds, const Gemm g, const Sched& S, const Epi& E) {
    const int tid = opaque_tid(), wid = __builtin_amdgcn_readfirstlane(tid >> 6), lane = tid & 63, wr = wid >> 2, wc = wid & 3, fr = lane & 15, fq = lane >> 4;
    const int K = g.K, nt = K / BK;
    unsigned voffA[2][2], voffB[2];
#pragma unroll
    for (int i = 0; i < 2; ++i) { int R, C; stage_rc(tid * 16 + i * 8192, R, C); const int Rb = Epi::PERM ? ((R & ~31) + perm32(R & 31)) : R;
        if constexpr (GATHER) { voffA[0][i] = (unsigned)(g.gidx[R] * K + C) * 2u; voffA[1][i] = (unsigned)(g.gidx[HALF + R] * K + C) * 2u; }
        else { voffA[0][i] = (unsigned)(R * K + C) * 2u; voffA[1][i] = voffA[0][i]; }
        voffB[i] = (unsigned)(Rb * K + C) * 2u; }
    const size_t kstep = (size_t)(BK * 2);
    const size_t hstep = (size_t)HALF * K * 2;
    const size_t hstepA = GATHER ? (size_t)0 : hstep;
    const size_t tstep = 2 * hstep;
    const unsigned ldsw = (unsigned)wid * 1024u;
    const int aoff = lds_byte(wr * 64 + fr, fq * 8), boff = lds_byte(wc * 32 + fr, fq * 8);
#define PG8_SA(b, h) (((b) * 2 + (h)) * HTB)
#define PG8_SB(b, h) ((4 + (b) * 2 + (h)) * HTB)
#define PG8_STAGE(bufoff, gbase, voff) do { _Pragma("unroll") for (int _i = 0; _i < 2; ++_i) \
        __builtin_amdgcn_global_load_lds((const unsigned*)((const char*)(gbase) + (voff)[_i]), (LAS unsigned*)(lds + (bufoff) + ldsw + _i * 8192), 16, 0, 0); } while (0)
#define PG8_LDA(dst, b, h) do { _Pragma("unroll") for (int m = 0; m < 4; ++m) _Pragma("unroll") for (int k = 0; k < 2; ++k) dst[m][k] = *(const LAS bf16x8*)(lds + PG8_SA(b, h) + aoff + m * 2048 + k * 1024); } while (0)
#define PG8_LDB(dst, b, h) do { _Pragma("unroll") for (int n = 0; n < 2; ++n) _Pragma("unroll") for (int k = 0; k < 2; ++k) dst[n][k] = *(const LAS bf16x8*)(lds + PG8_SB(b, h) + boff + n * 2048 + k * 1024); } while (0)
#define PG8_MMA(ai, bj, At, Bt) do { __builtin_amdgcn_s_setprio(1); _Pragma("unroll") for (int m = 0; m < 4; ++m) _Pragma("unroll") for (int n = 0; n < 2; ++n) _Pragma("unroll") for (int k = 0; k < 2; ++k) \
        acc[ai][bj][m][n] = __builtin_amdgcn_mfma_f32_16x16x32_bf16(Bt[n][k], At[m][k], acc[ai][bj][m][n], 0, 0, 0); __builtin_amdgcn_s_setprio(0); } while (0)
#define PG8_WAIT_V(n) asm volatile("s_waitcnt vmcnt(" #n ")" ::: "memory")
#define PG8_WAIT_L(n) asm volatile("s_waitcnt lgkmcnt(" #n ")" ::: "memory")
#define PG8_BAR __builtin_amdgcn_s_barrier()
#define PG8_SCHED __builtin_amdgcn_sched_barrier(0)
    Unit cur, nxt; int ui = 0;
    if (!S.next(0, cur)) return;
    f32x4 acc[2][2][4][2];
#pragma unroll
    for (int a = 0; a < 2; ++a)
#pragma unroll
        for (int b = 0; b < 2; ++b)
#pragma unroll
            for (int m = 0; m < 4; ++m)
#pragma unroll
                for (int n = 0; n < 2; ++n) acc[a][b][m][n] = (f32x4){0.f, 0.f, 0.f, 0.f};
    bf16x8 At[4][2], B0[2][2], B1[2][2];
    const char* cA = (const char*)g.A + (size_t)cur.pm * tstep; const char* cB = (const char*)g.Bt + (size_t)cur.pn * tstep;
    S.a_ready(cur);
    if constexpr (SP2) {
        PG8_STAGE(PG8_SB(0, 0), cB, voffB); PG8_STAGE(PG8_SB(0, 1), cB + hstep, voffB); PG8_STAGE(PG8_SA(0, 0), cA, voffA[0]); PG8_STAGE(PG8_SA(0, 1), cA + hstepA, voffA[1]);
        if (wr == 1) PG8_BAR;
        PG8_WAIT_V(2); PG8_BAR;
        PG8_STAGE(PG8_SB(1, 0), cB + kstep, voffB); PG8_STAGE(PG8_SA(1, 0), cA + kstep, voffA[0]); PG8_STAGE(PG8_SB(1, 1), cB + hstep + kstep, voffB);
        PG8_WAIT_V(6); PG8_BAR;
    } else {
        PG8_STAGE(PG8_SB(0, 0), cB, voffB); PG8_STAGE(PG8_SA(0, 0), cA, voffA[0]); PG8_STAGE(PG8_SB(0, 1), cB + hstep, voffB); PG8_STAGE(PG8_SA(0, 1), cA + hstepA, voffA[1]);
        if (wr == 1) PG8_BAR;
        PG8_WAIT_V(4); PG8_BAR;
        PG8_STAGE(PG8_SB(1, 0), cB + kstep, voffB); PG8_STAGE(PG8_SA(1, 0), cA + kstep, voffA[0]); PG8_STAGE(PG8_SB(1, 1), cB + hstep + kstep, voffB);
        PG8_WAIT_V(6); PG8_BAR;
    }
    for (;;) {
        const bool has_next = S.next(ui + 1, nxt);
        const char* nA = has_next ? (const char*)g.A + (size_t)nxt.pm * tstep : cA; const char* nB = has_next ? (const char*)g.Bt + (size_t)nxt.pn * tstep : cB;
        for (int t = 0; t < nt; t += 2) {
            const bool last = (t == nt - 2);
            const char* a1 = cA + (size_t)(t + 1) * kstep;
            const char* a2 = last ? nA : cA + (size_t)(t + 2) * kstep; const char* b2 = last ? nB : cB + (size_t)(t + 2) * kstep;
            const char* a3 = a2 + kstep; const char* b3 = b2 + kstep;
            if (last && has_next) S.a_ready(nxt);
            if constexpr (SP2) {
            PG8_LDB(B0, 0, 0); PG8_LDB(B1, 0, 1); PG8_SCHED; PG8_LDA(At, 0, 0); PG8_STAGE(PG8_SA(1, 1), a1 + hstepA, voffA[1]);
            PG8_WAIT_V(8); PG8_WAIT_L(0); PG8_BAR; PG8_MMA(0, 0, At, B0); PG8_MMA(0, 1, At, B1); PG8_BAR; PG8_SCHED;
            PG8_LDA(At, 0, 1); PG8_STAGE(PG8_SB(0, 0), b2, voffB); PG8_STAGE(PG8_SB(0, 1), b2 + hstep, voffB); PG8_STAGE(PG8_SA(0, 0), a2, voffA[0]);
            PG8_WAIT_V(8); PG8_WAIT_L(0); PG8_BAR; PG8_MMA(1, 0, At, B0); PG8_MMA(1, 1, At, B1); PG8_BAR; PG8_SCHED;
            PG8_LDB(B0, 1, 0); PG8_LDB(B1, 1, 1); PG8_SCHED; PG8_LDA(At, 1, 0); PG8_STAGE(PG8_SA(0, 1), a2 + hstepA, voffA[1]);
            PG8_WAIT_V(8); PG8_WAIT_L(0); PG8_BAR; PG8_MMA(0, 0, At, B0); PG8_MMA(0, 1, At, B1); PG8_BAR; PG8_SCHED;
            PG8_LDA(At, 1, 1); PG8_STAGE(PG8_SB(1, 0), b3, voffB); PG8_STAGE(PG8_SB(1, 1), b3 + hstep, voffB); PG8_STAGE(PG8_SA(1, 0), a3, voffA[0]);
            PG8_WAIT_V(8); PG8_WAIT_L(0); PG8_BAR; PG8_MMA(1, 0, At, B0); PG8_MMA(1, 1, At, B1); PG8_BAR; PG8_SCHED;
            } else {
            PG8_LDB(B0, 0, 0); PG8_SCHED; PG8_LDA(At, 0, 0); PG8_STAGE(PG8_SA(1, 1), a1 + hstepA, voffA[1]);
            PG8_WAIT_L(8); PG8_BAR; PG8_WAIT_L(0); PG8_MMA(0, 0, At, B0); PG8_BAR; PG8_SCHED;
            PG8_LDB(B1, 0, 1); PG8_STAGE(PG8_SB(0, 0), b2, voffB);
            PG8_BAR; PG8_WAIT_L(0); PG8_MMA(0, 1, At, B1); PG8_BAR;
            PG8_LDA(At, 0, 1); PG8_STAGE(PG8_SA(0, 0), a2, voffA[0]);
            PG8_BAR; PG8_WAIT_L(0); PG8_MMA(1, 0, At, B0); PG8_BAR; PG8_SCHED;
            PG8_STAGE(PG8_SB(0, 1), b2 + hstep, voffB);
            PG8_WAIT_V(6); PG8_BAR; PG8_MMA(1, 1, At, B1); PG8_BAR;
            PG8_LDB(B0, 1, 0); PG8_SCHED; PG8_LDA(At, 1, 0); PG8_STAGE(PG8_SA(0, 1), a2 + hstepA, voffA[1]);
            PG8_WAIT_L(8); PG8_BAR; PG8_WAIT_L(0); PG8_MMA(0, 0, At, B0); PG8_BAR; PG8_SCHED;
            PG8_LDB(B1, 1, 1); PG8_STAGE(PG8_SB(1, 0), b3, voffB);
            PG8_BAR; PG8_WAIT_L(0); PG8_MMA(0, 1, At, B1); PG8_BAR;
            PG8_LDA(At, 1, 1); PG8_STAGE(PG8_SA(1, 0), a3, voffA[0]);
            PG8_BAR; PG8_WAIT_L(0); PG8_MMA(1, 0, At, B0); PG8_BAR; PG8_SCHED;
            PG8_STAGE(PG8_SB(1, 1), b3 + hstep, voffB);
            PG8_WAIT_V(6); PG8_BAR; PG8_MMA(1, 1, At, B1); PG8_BAR;
            }
        }
        if constexpr (ALIGN_EPI) { if (wr == 0) PG8_BAR; }
        E(acc, cur, wr, wc, fr, fq); S.done(cur);
        if (!has_next) break;
#pragma unroll
        for (int a = 0; a < 2; ++a)
#pragma unroll
            for (int b = 0; b < 2; ++b)
#pragma unroll
                for (int m = 0; m < 4; ++m)
#pragma unroll
                    for (int n = 0; n < 2; ++n) acc[a][b][m][n] = (f32x4){0.f, 0.f, 0.f, 0.f};
        cur = nxt; cA = nA; cB = nB; ++ui;
        if constexpr (ALIGN_EPI) { if (wr == 1) PG8_BAR; }
    }
    PG8_WAIT_V(0);
    if constexpr (!ALIGN_EPI) { if (wr == 0) PG8_BAR; }
    PG8_BAR;
#undef PG8_SA
#undef PG8_SB
#undef PG8_STAGE
#undef PG8_LDA
#undef PG8_LDB
#undef PG8_MMA
#undef PG8_WAIT_V
#undef PG8_WAIT_L
#undef PG8_BAR
#undef PG8_SCHED
}
}

typedef GAS unsigned gu32;
#define RLX_AGENT __ATOMIC_RELAXED, __HIP_MEMORY_SCOPE_AGENT
#define LDS_WAIT() asm volatile("s_waitcnt lgkmcnt(0)" ::: "memory")
#define VM_WAIT() asm volatile("s_waitcnt vmcnt(0)" ::: "memory")
__device__ __forceinline__ unsigned pk2(float lo, float hi) { return pg8::cvt_pk_bf16(lo, hi); }
__device__ __forceinline__ float bf2f(unsigned short h) { return __uint_as_float((unsigned)h << 16); }
__device__ __forceinline__ float bflo(unsigned w) { return __uint_as_float(w << 16); }
__device__ __forceinline__ float bfhi(unsigned w) { return __uint_as_float(w & 0xffff0000u); }
__device__ __forceinline__ float wave_sum(float v) {
#pragma unroll
    for (int o = 1; o < 64; o <<= 1) v += __shfl_xor(v, o);
    return v;
}

#define XB_TMO      128
#define XB_XCNT(j)  (256  + 64 * (j))
#define XB_XSUB(j)  (1280 + 64 * (j))
#define XB_XGEN(j)  (2304 + 64 * (j))
#define XB_TOP      3328
#define XB_TOPGEN   3392
#define XCD_BAR_WORDS 3456
#define XB_SPIN_CAP (1u << 18)
__device__ __forceinline__ unsigned xb_ld(unsigned* p)              { return __hip_atomic_load(p, __ATOMIC_RELAXED, __HIP_MEMORY_SCOPE_AGENT); }
__device__ __forceinline__ unsigned xb_add(unsigned* p, unsigned v) { return __hip_atomic_fetch_add(p, v, __ATOMIC_RELAXED, __HIP_MEMORY_SCOPE_AGENT); }
__device__ __forceinline__ unsigned xb_xcc_id() { return (unsigned)__builtin_amdgcn_s_getreg((3 << 11) | 20) & 0xFu; }
#define XB_SPIN(cond, bar) do { unsigned _sp = 0; while (cond) { __builtin_amdgcn_s_sleep(1); \
    if ((++_sp & 255u) == 0u) { if (xb_ld(&(bar)[XB_TMO])) break; if (_sp > XB_SPIN_CAP) { atomicAdd(&(bar)[XB_TMO], 1u); break; } } } } while (0)
struct XcdBarrier { unsigned* bar; unsigned x; volatile LAS unsigned* st; };
__device__ __forceinline__ XcdBarrier xcd_barrier_post(unsigned* bar, volatile LAS unsigned* st) {
    XcdBarrier b; b.bar = bar; b.x = xb_xcc_id(); b.st = st;
    if (threadIdx.x == 0) (void)xb_add(&bar[XB_XCNT(b.x)], 1u);
    return b;
}
__device__ __forceinline__ void xcd_barrier_complete(unsigned* bar, unsigned x, unsigned& nloc, unsigned& nx) {
    const unsigned G = gridDim.x * gridDim.y * gridDim.z;
    unsigned sum, cnt, mine, sp = 0u;
    for (;;) {
        sum = 0u; cnt = 0u; mine = 0u;
#pragma unroll
        for (unsigned j = 0; j < 16; ++j) { const unsigned c = xb_ld(&bar[XB_XCNT(j)]); sum += c; cnt += (c > 0u) ? 1u : 0u; mine = (j == x) ? c : mine; }
        if (sum == G) break;
        __builtin_amdgcn_s_sleep(1);
        if ((++sp & 255u) == 0u) { if (xb_ld(&bar[XB_TMO])) break; if (sp > XB_SPIN_CAP) { atomicAdd(&bar[XB_TMO], 1u); break; } }
    }
    nloc = mine > 0u ? mine : 1u; nx = cnt > 0u ? cnt : 1u;
}
__device__ __forceinline__ void xcd_barrier(const XcdBarrier& b) {
    asm volatile("s_waitcnt vmcnt(0)" ::: "memory");
    __syncthreads();
    if (threadIdx.x == 0) {
        unsigned* bar = b.bar;
        __builtin_amdgcn_s_waitcnt(0);
        unsigned nloc = b.st[0], nx = b.st[1];
        if (nloc == 0u) { xcd_barrier_complete(bar, b.x, nloc, nx); b.st[0] = nloc; b.st[1] = nx; }
        const unsigned old = xb_add(&bar[XB_XSUB(b.x)], 1u);
        const unsigned gen = old / nloc;
        if (old + 1u == (gen + 1u) * nloc) {
            __builtin_amdgcn_fence(__ATOMIC_RELEASE, "agent");
            asm volatile("s_waitcnt vmcnt(0)" ::: "memory");
            const unsigned og = xb_add(&bar[XB_TOP], 1u);
            const unsigned tg = og / nx;
            if (og + 1u == (tg + 1u) * nx) xb_add(&bar[XB_TOPGEN], 1u);
            else XB_SPIN(xb_ld(&bar[XB_TOPGEN]) == tg, bar);
            __builtin_amdgcn_fence(__ATOMIC_ACQUIRE, "agent");
            xb_add(&bar[XB_XGEN(b.x)], 1u);
            asm volatile("s_waitcnt vmcnt(0)" ::: "memory");
        } else {
            XB_SPIN(xb_ld(&bar[XB_XGEN(b.x)]) == gen, bar);
            __builtin_amdgcn_fence(__ATOMIC_ACQUIRE, "agent");
            asm volatile("s_waitcnt vmcnt(0)" ::: "memory");
        }
    }
    __syncthreads();
}

constexpr int RING_BYTES = 131072;
constexpr int LDSCTL_OFF = RING_BYTES, MISC_OFF = LDSCTL_OFF + 320;
constexpr int LDS_BYTES = 147456;
constexpr int CW_BAR = 4096;

struct Args { const float* in[22]; float* out; unsigned char* ws; int ph_lo, ph_hi; };
enum { I_X = 0, I_C, I_CTX, I_CCTX, I_WADA, I_BADA, I_NPRE_MIX, I_NPOST_MIX, I_NPRE_FFN, I_NPOST_FFN, I_WIN, I_CONVW, I_LQ1, I_LK1, I_LQ2, I_LK2, I_SUBLN, I_WOUT, I_WROUTER, I_WGATE, I_WUP, I_WDOWN };

__device__ __forceinline__ void prefetch_slice(const unsigned char* base, int bytes_per_wave, LAS unsigned char* scr, int lane) {
    for (int i = 0; i < bytes_per_wave; i += 1024)
        __builtin_amdgcn_global_load_lds((const unsigned*)(base + i + lane * 16), (LAS unsigned*)scr, 16, 0, 0);
}

__device__ __forceinline__ int win_dest(int n) {
    if (n < 1024) { const int j = n & 63; const int p = ((j >> 5) << 5) + ((j & 15) << 1) + ((j >> 4) & 1); return (n & ~63) + p; }
    if (n < 2048) return n;
    int c = n - 2048; const int isx = c >= 512; c &= 511; return 2048 + ((c >> 7) << 8) + (isx << 7) + (c & 127);
}
template <int MODE>
__device__ __forceinline__ int tr_dest(int n) {
    if (MODE == 0) return n;
    if (MODE == 1) return win_dest(n);
    if (MODE == 2) return ((n >> 7) << 8) + (n & 127);
    return ((n >> 7) << 8) + 128 + (n & 127);
}
template <int MODE>
__device__ __forceinline__ void p0_transpose_item(const float* W, int K, int N, bf16_t* WT, LAS float* scr, int item, int lane) {
    const int nblk = N / 32, kb = item / nblk, nb = item % nblk, k0 = 64 * kb, n0 = 32 * nb;
#pragma unroll 8
    for (int i = 0; i < 32; ++i) { const int kk = 2 * i + (lane >> 5); scr[kk * 33 + (lane & 31)] = W[(size_t)(k0 + kk) * N + n0 + (lane & 31)]; }
    LDS_WAIT(); asm volatile("" ::: "memory");
    const int c = lane & 7;
#pragma unroll
    for (int j = 0; j < 4; ++j) { const int n = (lane >> 3) + 8 * j; const LAS float* s = scr + (8 * c) * 33 + n;
        u32x4 o; o.x = pk2(s[0 * 33], s[1 * 33]); o.y = pk2(s[2 * 33], s[3 * 33]); o.z = pk2(s[4 * 33], s[5 * 33]); o.w = pk2(s[6 * 33], s[7 * 33]);
        *(GAS u32x4*)(WT + (size_t)tr_dest<MODE>(n0 + n) * K + k0 + 8 * c) = o; }
    LDS_WAIT(); asm volatile("" ::: "memory");
}

__device__ __forceinline__ void p0_prologue(const Args& a, LAS unsigned char* lds, int vcu, int G) {
    const int tid = opaque_tid(), lane = tid & 63, wave = __builtin_amdgcn_readfirstlane(tid >> 6);
    LAS float* scr = (LAS float*)(lds + wave * 16384);
    const int gw = vcu * NWAVES + wave, NGW = G * NWAVES;
    unsigned char* ws = a.ws;
    {
        float* MODP = (float*)(ws + WS_MODP);
        const float* wada = a.in[I_WADA];
        for (int it = gw; it < 96 * 16; it += NGW) {
            const int cg = it % 96, kc = it / 96;
            for (int b = 0; b < 33; ++b) { const float v = (b < 32) ? a.in[I_C][b * D + kc * 64 + lane] : a.in[I_CCTX][kc * 64 + lane]; scr[b * 64 + lane] = v / (1.f + __expf(-v)); }
            LDS_WAIT(); asm volatile("" ::: "memory");
            float acc[33];
#pragma unroll
            for (int b = 0; b < 33; ++b) acc[b] = 0.f;
            for (int k = 0; k < 64; ++k) {
                const float w = wada[(size_t)(kc * 64 + k) * NMOD + cg * 64 + lane];
#pragma unroll
                for (int b = 0; b < 33; ++b) acc[b] += scr[b * 64 + k] * w;
            }
#pragma unroll
            for (int b = 0; b < 33; ++b) MODP[((size_t)kc * 33 + b) * NMOD + cg * 64 + lane] = acc[b];
            LDS_WAIT(); asm volatile("" ::: "memory");
        }
    }
    {
        float* tab = (float*)(ws + WS_TAB);
        for (int e = gw * 64 + lane; e < T * 32; e += NGW * 64) {
            const int t = e >> 5, i = e & 31;
            const float inv = powf(10000.0f, -(float)(2 * (i & 15)) / 32.0f);
            const float pos = (i < 16) ? (float)(t >> 6) : (float)(t & 63);
            const float ang = pos * inv;
            tab[2 * e] = cosf(ang); tab[2 * e + 1] = sinf(ang);
        }
    }
    constexpr int I_IN = (D / 64) * (NPROJ / 32), I_OUT = (D / 64) * (D / 32);
    constexpr int NITEMS = I_IN + I_OUT;
    bf16_t* Win_t = (bf16_t*)(ws + WS_WIN); bf16_t* Wout_t = (bf16_t*)(ws + WS_WOUT);
    for (int it = gw; it < NITEMS; it += NGW) {
        int r = it;
        if (r < I_IN) { p0_transpose_item<1>(a.in[I_WIN], D, NPROJ, Win_t, scr, r, lane); continue; } r -= I_IN;
        p0_transpose_item<0>(a.in[I_WOUT], D, D, Wout_t, scr, r, lane);
    }
}
__device__ __forceinline__ void expert_weight_copies(const Args& a, LAS unsigned char* lds, int vcu, int G) {
    const int tid = opaque_tid(), lane = tid & 63, wave = __builtin_amdgcn_readfirstlane(tid >> 6);
    LAS float* scr = (LAS float*)(lds + wave * 16384);
    const int gw = vcu * NWAVES + wave, NGW = G * NWAVES;
    unsigned char* ws = a.ws;
    constexpr int I_EXP = (D / 64) * (D / 32);
    bf16_t* Wgu_t = (bf16_t*)(ws + WS_WGU); bf16_t* Wdn_t = (bf16_t*)(ws + WS_WDN);
    for (int r = gw; r < NE * 3 * I_EXP; r += NGW) {
        const int e = r / (3 * I_EXP), q = (r % (3 * I_EXP)) / I_EXP, rr = r % I_EXP;
        if (q == 0) p0_transpose_item<2>(a.in[I_WGATE] + (size_t)e * D * D, D, D, Wgu_t + (size_t)e * 2048 * D, scr, rr, lane);
        else if (q == 1) p0_transpose_item<3>(a.in[I_WUP] + (size_t)e * D * D, D, D, Wgu_t + (size_t)e * 2048 * D, scr, rr, lane);
        else p0_transpose_item<0>(a.in[I_WDOWN] + (size_t)e * D * D, D, D, Wdn_t + (size_t)e * D * D, scr, rr, lane);
    }
    __syncthreads();
}

struct RowF { f32x4 v[4]; };
__device__ __forceinline__ void row_load(RowF& r, const float* xrow, int lane) {
    const f32x4* xr = (const f32x4*)xrow + lane;
#pragma unroll
    for (int j = 0; j < 4; ++j) r.v[j] = xr[64 * j];
}
__device__ __forceinline__ void norm_mod_row(const RowF& r, bf16_t* orow, const float* gain, const LAS float* sc, const LAS float* sh, int lane) {
    const f32x4* gr = (const f32x4*)gain + lane;
    float s = 0.f;
#pragma unroll
    for (int j = 0; j < 4; ++j) s += (r.v[j].x * r.v[j].x + r.v[j].y * r.v[j].y) + (r.v[j].z * r.v[j].z + r.v[j].w * r.v[j].w);
    const float rstd = 1.0f / sqrtf(wave_sum(s) * (1.f / D) + EPS);
    u32x2* o8 = (u32x2*)orow + lane;
#pragma unroll
    for (int j = 0; j < 4; ++j) { const f32x4 g = gr[64 * j]; const f32x4 c1 = *(const LAS f32x4*)(sc + 4 * lane + 256 * j), h1 = *(const LAS f32x4*)(sh + 4 * lane + 256 * j);
        const f32x4 y = (r.v[j] * rstd) * g; const f32x4 z = y * (c1 + 1.0f) + h1;
        u32x2 w; w.x = pk2(z.x, z.y); w.y = pk2(z.z, z.w); o8[64 * j] = w; }
}
__device__ __forceinline__ void p1_xn(const Args& a, LAS unsigned char* lds, int c, int G) {
    const int tid = opaque_tid(), lane = tid & 63, wave = __builtin_amdgcn_readfirstlane(tid >> 6);
    unsigned char* ws = a.ws;
    const float* MODP = (const float*)(ws + WS_MODP); float* MOD = (float*)(ws + WS_MOD); const float* bada = a.in[I_BADA];
    for (int r = c; r < 33; r += G)
        for (int n = tid; n < NMOD; n += NTHREADS) { float s = bada[n];
#pragma unroll
            for (int kc = 0; kc < 16; ++kc) s += MODP[((size_t)kc * 33 + r) * NMOD + n];
            MOD[(size_t)r * NMOD + n] = s; }
    LAS float* sv = (LAS float*)lds;
    bf16_t* XN = (bf16_t*)(ws + WS_XN);
    const float* X = a.in[I_X]; const float* CTX = a.in[I_CTX]; const float* gain = a.in[I_NPRE_MIX];
    for (int p = c; p < 256; p += G) {
        const int b = p >> 3;
        const int rbase = p * 256 + wave * 32;
        RowF a0, a1;
        row_load(a0, X + (size_t)rbase * D, lane); row_load(a1, X + (size_t)(rbase + 16) * D, lane);
        __syncthreads();
        for (int n = tid; n < 4096; n += NTHREADS) { const int r = (n < 2048) ? b : 32; const int col = n & 2047; float s = bada[col];
#pragma unroll
            for (int kc = 0; kc < 16; ++kc) s += MODP[((size_t)kc * 33 + r) * NMOD + col];
            sv[n] = s; }
        __syncthreads();
        for (int i = 0; i < 16; ++i) {
            RowF n0, n1;
            if (i + 1 < 16) { row_load(n0, X + (size_t)(rbase + i + 1) * D, lane); row_load(n1, X + (size_t)(rbase + 16 + i + 1) * D, lane); }
            else { const int crow = p * 32 + wave * 4; row_load(n0, CTX + (size_t)crow * D, lane); row_load(n1, CTX + (size_t)(crow + 1) * D, lane); }
            norm_mod_row(a0, XN + (size_t)(rbase + i) * D, gain, sv + 1024, sv, lane);
            norm_mod_row(a1, XN + (size_t)(rbase + 16 + i) * D, gain, sv + 1024, sv, lane);
            a0 = n0; a1 = n1;
        }
        {
            const int crow = p * 32 + wave * 4;
            RowF n0, n1;
            row_load(n0, CTX + (size_t)(crow + 2) * D, lane); row_load(n1, CTX + (size_t)(crow + 3) * D, lane);
            norm_mod_row(a0, XN + (size_t)(M + crow) * D, gain, sv + 3072, sv + 2048, lane);
            norm_mod_row(a1, XN + (size_t)(M + crow + 1) * D, gain, sv + 3072, sv + 2048, lane);
            norm_mod_row(n0, XN + (size_t)(M + crow + 2) * D, gain, sv + 3072, sv + 2048, lane);
            norm_mod_row(n1, XN + (size_t)(M + crow + 3) * D, gain, sv + 3072, sv + 2048, lane);
        }
    }
}

namespace att {
constexpr int KP = 272, KBUF = 64 * KP, VBUF = 16384;
constexpr int OFF_K = 0, OFF_V = 2 * KBUF, OFF_WSF = OFF_V + 2 * VBUF, OFF_END = OFF_WSF + NWAVES * 256;
static_assert(OFF_WSF >= 65536 && OFF_END <= RING_BYTES, "attention LDS map");
constexpr int NT = TK / 64;
constexpr float THR = 8.0f;
__device__ __forceinline__ int crow(int r, int hi) { return (r & 3) + 8 * (r >> 2) + 4 * hi; }
__device__ __forceinline__ float max3f(float a, float b, float c) { float r; asm("v_max3_f32 %0, %1, %2, %3" : "=v"(r) : "v"(a), "v"(b), "v"(c)); return r; }
__device__ __forceinline__ float max2f(float a, float b) { float r; asm("v_max_f32_e32 %0, %1, %2" : "=v"(r) : "v"(a), "v"(b)); return r; }
__device__ __forceinline__ s16x4 vtr(const LAS unsigned char* p) { return __builtin_bit_cast(s16x4, __builtin_amdgcn_ds_read_tr16_b64_v4i16((LAS s16x4*)p)); }

#define ATT_BAR() asm volatile("s_waitcnt lgkmcnt(0)\n\ts_barrier" ::: "memory")
#define ATT_SB() __builtin_amdgcn_sched_barrier(0)
#define ATT_KLD(i, KF) KF = *(const LAS bf16x8*)(kb_ + ((i) & 1) * (32 * KP) + ((i) >> 1) * 32)
#define ATT_XSTEP(i, KC, KN) do { if ((i) + 2 < 8) { ATT_KLD((i) + 2, KN); } \
    if (((i) & 1) == 0) p0 = __builtin_amdgcn_mfma_f32_32x32x16_bf16(KC, qr[(i) >> 1], p0, 0, 0, 0); else p1 = __builtin_amdgcn_mfma_f32_32x32x16_bf16(KC, qr[(i) >> 1], p1, 0, 0, 0); ATT_SB(); } while (0)
#define ATT_X(kcur, first) do { \
    const LAS unsigned char* kb_ = lds + OFF_K + (kcur) * KBUF + koff; \
    bf16x8 ka_, kb2_, kc_; \
    ATT_KLD(0, ka_); ATT_KLD(1, kb2_); \
    _Pragma("unroll") for (int r = 0; r < 16; ++r) { p0[r] = -mhat; p1[r] = -mhat; } \
    ATT_SB(); \
    ATT_XSTEP(0, ka_, kc_); ATT_XSTEP(1, kb2_, ka_); ATT_XSTEP(2, kc_, kb2_); ATT_XSTEP(3, ka_, kc_); \
    ATT_XSTEP(4, kb2_, ka_); ATT_XSTEP(5, kc_, kb2_); ATT_XSTEP(6, ka_, kc_); ATT_XSTEP(7, kb2_, ka_); \
    asm volatile("s_nop 15\n\ts_nop 7" : "+v"(p0), "+v"(p1));     \
    float rm; { float a_ = max3f(p0[0], p0[1], p1[0]), b_ = max3f(p0[2], p0[3], p1[1]); a_ = max3f(a_, p1[2], p1[3]); \
        _Pragma("unroll") for (int r = 4; r < 16; r += 4) { a_ = max3f(a_, p0[r], p0[r + 1]); b_ = max3f(b_, p0[r + 2], p0[r + 3]); a_ = max3f(a_, p1[r], p1[r + 1]); b_ = max3f(b_, p1[r + 2], p1[r + 3]); } \
        rm = max2f(a_, b_); rm = max2f(rm, __shfl_xor(rm, 32)); } \
    if (first) { mhat += rm; _Pragma("unroll") for (int r = 0; r < 16; ++r) { p0[r] -= rm; p1[r] -= rm; } } \
    else if (__any(rm > THR)) { \
        const float dl = fmaxf(rm, 0.f); mhat += dl; const float f = __builtin_amdgcn_exp2f(-dl); l_reg *= f; \
        _Pragma("unroll") for (int r = 0; r < 16; ++r) { p0[r] -= dl; p1[r] -= dl; } \
        if (hi == 0) wsf[r32] = f; \
        resc = true; } \
} while (0)
#define ATT_EXP2(i, PWN) do { \
    const float e0_ = __builtin_amdgcn_exp2f((i) < 8 ? p0[2 * ((i) & 7)] : p1[2 * ((i) & 7)]), e1_ = __builtin_amdgcn_exp2f((i) < 8 ? p0[2 * ((i) & 7) + 1] : p1[2 * ((i) & 7) + 1]); \
    sacc_ += e0_ + e1_; PWN[(i) >> 2][(i) & 3] = pk2(e0_, e1_); } while (0)
#define ATT_VLD(i, LO, HI) do { LO = vtr(vb_ + ((i) & 3) * 4096 + ((i) >> 2) * 1024); HI = vtr(vb_ + ((i) & 3) * 4096 + ((i) >> 2) * 1024 + 512); } while (0)
#define ATT_VF(LO, HI) ((bf16x8){LO[0], LO[1], LO[2], LO[3], HI[0], HI[1], HI[2], HI[3]})
#define ATT_YSTEP(i, PWC, PWN, LC, HC, LN, HN) do { if ((i) + 2 < 16) { ATT_VLD((i) + 2, LN, HN); } \
    o[(i) & 3] = __builtin_amdgcn_mfma_f32_32x32x16_bf16(__builtin_bit_cast(bf16x8, PWC[(i) >> 2]), ATT_VF(LC, HC), o[(i) & 3], 0, 0, 0); \
    ATT_EXP2(i, PWN); ATT_SB(); } while (0)
#define ATT_Y(vcur, PWC, PWN) do { \
    const LAS unsigned char* vb_ = lds + OFF_V + (vcur) * VBUF + voff; \
    float sacc_ = 0.f; s16x4 la_, ha_, lb_, hb_, lc_, hc_; \
    ATT_VLD(0, la_, ha_); ATT_VLD(1, lb_, hb_); ATT_SB(); \
    ATT_YSTEP(0, PWC, PWN, la_, ha_, lc_, hc_); ATT_YSTEP(1, PWC, PWN, lb_, hb_, la_, ha_); ATT_YSTEP(2, PWC, PWN, lc_, hc_, lb_, hb_); \
    ATT_YSTEP(3, PWC, PWN, la_, ha_, lc_, hc_); ATT_YSTEP(4, PWC, PWN, lb_, hb_, la_, ha_); ATT_YSTEP(5, PWC, PWN, lc_, hc_, lb_, hb_); \
    ATT_YSTEP(6, PWC, PWN, la_, ha_, lc_, hc_); ATT_YSTEP(7, PWC, PWN, lb_, hb_, la_, ha_); ATT_YSTEP(8, PWC, PWN, lc_, hc_, lb_, hb_); \
    ATT_YSTEP(9, PWC, PWN, la_, ha_, lc_, hc_); ATT_YSTEP(10, PWC, PWN, lb_, hb_, la_, ha_); ATT_YSTEP(11, PWC, PWN, lc_, hc_, lb_, hb_); \
    ATT_YSTEP(12, PWC, PWN, la_, ha_, lc_, hc_); ATT_YSTEP(13, PWC, PWN, lb_, hb_, la_, ha_); ATT_YSTEP(14, PWC, PWN, lc_, hc_, lb_, hb_); \
    ATT_YSTEP(15, PWC, PWN, la_, ha_, lc_, hc_); \
    l_reg += sacc_; \
    if (resc) { LDS_WAIT(); \
        _Pragma("unroll") for (int r = 0; r < 16; ++r) { const float fr_ = wsf[crow(r, hi)]; \
            _Pragma("unroll") for (int d0 = 0; d0 < 4; ++d0) o[d0][r] *= fr_; } \
        LDS_WAIT(); resc = false; } \
} while (0)
#define ATT_Y0(PWN) do { float sacc_ = 0.f; _Pragma("unroll") for (int i = 0; i < 16; ++i) ATT_EXP2(i, PWN); l_reg += sacc_; } while (0)
#define ATT_ZSTEP(i, PWC, LC, HC, LN, HN) do { if ((i) + 2 < 16) { ATT_VLD((i) + 2, LN, HN); } \
    o[(i) & 3] = __builtin_amdgcn_mfma_f32_32x32x16_bf16(__builtin_bit_cast(bf16x8, PWC[(i) >> 2]), ATT_VF(LC, HC), o[(i) & 3], 0, 0, 0); ATT_SB(); } while (0)
#define ATT_Z(vcur, PWC) do { \
    const LAS unsigned char* vb_ = lds + OFF_V + (vcur) * VBUF + voff; \
    s16x4 la_, ha_, lb_, hb_, lc_, hc_; \
    ATT_VLD(0, la_, ha_); ATT_VLD(1, lb_, hb_); ATT_SB(); \
    ATT_ZSTEP(0, PWC, la_, ha_, lc_, hc_); ATT_ZSTEP(1, PWC, lb_, hb_, la_, ha_); ATT_ZSTEP(2, PWC, lc_, hc_, lb_, hb_); \
    ATT_ZSTEP(3, PWC, la_, ha_, lc_, hc_); ATT_ZSTEP(4, PWC, lb_, hb_, la_, ha_); ATT_ZSTEP(5, PWC, lc_, hc_, lb_, hb_); \
    ATT_ZSTEP(6, PWC, la_, ha_, lc_, hc_); ATT_ZSTEP(7, PWC, lb_, hb_, la_, ha_); ATT_ZSTEP(8, PWC, lc_, hc_, lb_, hb_); \
    ATT_ZSTEP(9, PWC, la_, ha_, lc_, hc_); ATT_ZSTEP(10, PWC, lb_, hb_, la_, ha_); ATT_ZSTEP(11, PWC, lc_, hc_, lb_, hb_); \
    ATT_ZSTEP(12, PWC, la_, ha_, lc_, hc_); ATT_ZSTEP(13, PWC, lb_, hb_, la_, ha_); ATT_ZSTEP(14, PWC, lc_, hc_, lb_, hb_); \
    ATT_ZSTEP(15, PWC, la_, ha_, lc_, hc_); \
} while (0)
#define ATT_STAGE(j) do { \
    if ((j) + 1 < NT) { _Pragma("unroll") for (int i = 0; i < 2; ++i) *(LAS u32x4*)(lds + OFF_K + (((j) + 1) & 1) * KBUF + kdst[i]) = kr[i]; } \
    _Pragma("unroll") for (int i = 0; i < 2; ++i) *(LAS u32x4*)(lds + OFF_V + ((j) & 1) * VBUF + vdst[i]) = vr[i]; \
    if ((j) + 2 < NT) { _Pragma("unroll") for (int i = 0; i < 2; ++i) kr[i] = *(const u32x4*)(Kb + (size_t)((j) + 2) * 64 * 512 + gsrc[i]); } \
    if ((j) + 1 < NT) { _Pragma("unroll") for (int i = 0; i < 2; ++i) vr[i] = *(const u32x4*)(Vb + (size_t)((j) + 1) * 64 * 512 + gsrc[i]); } } while (0)

__device__ __forceinline__ void unit(LAS unsigned char* lds, int b, int h, int qb, const bf16_t* Q, const bf16_t* KA, const bf16_t* VA, bf16_t* MIXIN, const float* subg, float lam) {
    const int tid = opaque_tid(), lane = tid & 63, r32 = lane & 31, hi = lane >> 5;
    const int wid = __builtin_amdgcn_readfirstlane(tid >> 6), w = wid & 3, m = wid >> 2;
    LAS float* wsf = (LAS float*)(lds + OFF_WSF) + wid * 64;
    const int rowQ = b * T + qb * 128 + w * 32;
    bf16x8 qr[4];
#pragma unroll
    for (int d0 = 0; d0 < 4; ++d0) qr[d0] = *(const bf16x8*)(Q + (size_t)(rowQ + r32) * 512 + h * 128 + m * 64 + d0 * 16 + hi * 8);
    const bf16_t* Kb = KA + (size_t)b * TK * 512 + h * 128; const bf16_t* Vb = VA + (size_t)b * TK * 512 + h * 128;
    int gsrc[2], kdst[2], vdst[2];
#pragma unroll
    for (int i = 0; i < 2; ++i) { const int cid = tid + 512 * i, kv = cid >> 4, c16 = cid & 15;
        gsrc[i] = kv * 512 + c16 * 8; kdst[i] = kv * KP + c16 * 16; vdst[i] = (c16 >> 2) * 4096 + (kv >> 4) * 1024 + (kv & 15) * 64 + (c16 & 3) * 16; }
    u32x4 kr[2], vr[2];
#pragma unroll
    for (int i = 0; i < 2; ++i) { kr[i] = *(const u32x4*)(Kb + gsrc[i]); vr[i] = *(const u32x4*)(Vb + gsrc[i]); }
#pragma unroll
    for (int i = 0; i < 2; ++i) *(LAS u32x4*)(lds + OFF_K + kdst[i]) = kr[i];
#pragma unroll
    for (int i = 0; i < 2; ++i) kr[i] = *(const u32x4*)(Kb + (size_t)64 * 512 + gsrc[i]);
    ATT_BAR();
    f32x16 o[4];
#pragma unroll
    for (int d0 = 0; d0 < 4; ++d0) o[d0] = (f32x16){};
    float mhat = 0.f, l_reg = 0.f; bool resc = false;
    f32x16 p0, p1;
    u32x4 pwA[4], pwB[4];
    const int koff = r32 * KP + m * 128 + hi * 16;
    const int voff = ((lane >> 4) & 1) * 32 + (lane & 3) * 8 + (4 * hi + ((lane & 15) >> 2)) * 64;
    ATT_X(0, true); ATT_STAGE(0); ATT_Y0(pwA); ATT_BAR();
    ATT_X(1, false); ATT_STAGE(1); ATT_Y(0, pwA, pwB); ATT_BAR();
    for (int j = 2; j < NT; j += 2) {
        ATT_X(0, false); ATT_STAGE(j); ATT_Y(1, pwB, pwA); ATT_BAR();
        ATT_X(1, false); ATT_STAGE(j + 1); ATT_Y(0, pwA, pwB); ATT_BAR();
    }
    ATT_Z(1, pwB); ATT_BAR();
    l_reg += __shfl_xor(l_reg, 32);
    if (hi == 0) wsf[32 + r32] = l_reg;
    LDS_WAIT();
    float rli[16];
#pragma unroll
    for (int r = 0; r < 16; ++r) rli[r] = 1.0f / wsf[32 + crow(r, hi)];
    LDS_WAIT();
    LAS float* ex = (LAS float*)lds + w * 4096;
    if (m == 1) {
#pragma unroll
        for (int r = 0; r < 16; ++r)
#pragma unroll
            for (int d0 = 0; d0 < 4; ++d0) ex[crow(r, hi) * 128 + d0 * 32 + r32] = o[d0][r] * rli[r];
    }
    ATT_BAR();
    if (m == 0) {
        float g4[4];
#pragma unroll
        for (int d0 = 0; d0 < 4; ++d0) g4[d0] = subg[d0 * 32 + r32] * (1.0f - LAM_INIT);
#pragma unroll
        for (int r = 0; r < 16; ++r) {
            const int q = crow(r, hi); float x[4]; float ss = 0.f;
#pragma unroll
            for (int d0 = 0; d0 < 4; ++d0) { x[d0] = o[d0][r] * rli[r] - lam * ex[q * 128 + d0 * 32 + r32]; ss += x[d0] * x[d0]; }
#pragma unroll
            for (int off = 1; off < 32; off <<= 1) ss += __shfl_xor(ss, off);
            const float rstd = 1.0f / sqrtf(ss * (1.f / 128.f) + EPS);
            bf16_t* dst = MIXIN + (size_t)(rowQ + q) * 1024 + h * 128 + r32;
#pragma unroll
            for (int d0 = 0; d0 < 4; ++d0) dst[d0 * 32] = (bf16_t)(pk2(x[d0] * rstd * g4[d0], 0.f) & 0xffffu);
        }
    }
    ATT_BAR();
}
#undef ATT_BAR
#undef ATT_X
#undef ATT_EXP2
#undef ATT_Y
#undef ATT_Y0
#undef ATT_Z
#undef ATT_STAGE
#undef ATT_SB
#undef ATT_KLD
#undef ATT_XSTEP
#undef ATT_VLD
#undef ATT_VF
#undef ATT_YSTEP
#undef ATT_ZSTEP
}

__device__ __forceinline__ void p3_conv_attn(const Args& a, LAS unsigned char* lds, int c, int vcu, int G) {
    const int tid = opaque_tid(), lane = tid & 63, wave = __builtin_amdgcn_readfirstlane(tid >> 6);
    unsigned char* ws = a.ws;
    const bf16_t* GB = (const bf16_t*)(ws + WS_GB); const bf16_t* U = (const bf16_t*)(ws + WS_U); bf16_t* MIXIN = (bf16_t*)(ws + WS_MIXIN);
    {
        const float* cw = a.in[I_CONVW]; float w0[8], w1[8], w2[8];
#pragma unroll
        for (int i = 0; i < 8; ++i) { w0[i] = cw[lane * 8 + i]; w1[i] = cw[512 + lane * 8 + i]; w2[i] = cw[1024 + lane * 8 + i]; }
        const int gw = vcu * NWAVES + wave, NGW = G * NWAVES;
        for (int row = gw; row < M; row += NGW) {
            const int t = row & (T - 1);
            const u32x4 z = {0u, 0u, 0u, 0u};
            const u32x4 uc = *(const u32x4*)(U + (size_t)row * 512 + lane * 8);
            const u32x4 up = (t > 0) ? *(const u32x4*)(U + (size_t)(row - 1) * 512 + lane * 8) : z;
            const u32x4 un = (t < T - 1) ? *(const u32x4*)(U + (size_t)(row + 1) * 512 + lane * 8) : z;
            const u32x4 gb = *(const u32x4*)(GB + (size_t)row * 512 + lane * 8);
            u32x4 o;
#pragma unroll
            for (int q = 0; q < 4; ++q) {
                const float y0 = w0[2 * q] * bflo(up[q]) + w1[2 * q] * bflo(uc[q]) + w2[2 * q] * bflo(un[q]);
                const float y1 = w0[2 * q + 1] * bfhi(up[q]) + w1[2 * q + 1] * bfhi(uc[q]) + w2[2 * q + 1] * bfhi(un[q]);
                o[q] = pk2(bflo(gb[q]) * y0, bfhi(gb[q]) * y1);
            }
            *(u32x4*)(MIXIN + (size_t)row * 1024 + 512 + lane * 8) = o;
        }
    }
    float lam;
    { const float p1 = a.in[I_LQ1][lane] * a.in[I_LK1][lane], p2 = a.in[I_LQ2][lane] * a.in[I_LK2][lane];
      lam = __expf(wave_sum(p1)) - __expf(wave_sum(p2)) + LAM_INIT; }
    const bf16_t* Q = (const bf16_t*)(ws + WS_Q); const bf16_t* KA = (const bf16_t*)(ws + WS_K); const bf16_t* VA = (const bf16_t*)(ws + WS_V);
    __syncthreads();
    for (int u = vcu * 8; u < 2048; u += G * 8) {
        const int x = (u >> 3) / 32, jj = (u >> 3) % 32;
        for (int i = 0; i < 8; ++i) {
            const int bh = 16 * x + 2 * i + (jj >> 4), qb = jj & 15;
            att::unit(lds, bh >> 2, bh & 3, qb, Q, KA, VA, MIXIN, a.in[I_SUBLN], lam);
        }
    }
}

struct P5In { f32x4 x[4]; u32x2 m[4]; };
__device__ __forceinline__ void p5_load(P5In& r, int row, int lane, const float* X, const bf16_t* MIX) {
    const f32x4* xr = (const f32x4*)(X + (size_t)row * D) + lane; const u32x2* mr = (const u32x2*)(MIX + (size_t)row * D) + lane;
#pragma unroll
    for (int j = 0; j < 4; ++j) { r.x[j] = xr[64 * j]; r.m[j] = mr[64 * j]; }
}
__device__ __forceinline__ float p5_resid(const P5In& r, f32x4 (&h)[4], int row, int lane, const LAS float* mv, const f32x4* npm, bf16_t* H1) {
    f32x4 mx[4]; float s = 0.f;
#pragma unroll
    for (int j = 0; j < 4; ++j) { const u32x2 wv = r.m[j]; mx[j] = (f32x4){bflo(wv.x), bfhi(wv.x), bflo(wv.y), bfhi(wv.y)};
        s += (mx[j].x * mx[j].x + mx[j].y * mx[j].y) + (mx[j].z * mx[j].z + mx[j].w * mx[j].w); }
    const float rstd1 = 1.0f / sqrtf(wave_sum(s) * (1.f / D) + EPS);
    u32x2* hr = (u32x2*)(H1 + (size_t)row * D) + lane; float s2 = 0.f;
#pragma unroll
    for (int j = 0; j < 4; ++j) { const f32x4 g1 = *(const LAS f32x4*)(mv + 4 * lane + 256 * j);
        h[j] = r.x[j] + g1 * ((mx[j] * rstd1) * npm[64 * j]);
        u32x2 wv; wv.x = pk2(h[j].x, h[j].y); wv.y = pk2(h[j].z, h[j].w); hr[64 * j] = wv;
        s2 += (h[j].x * h[j].x + h[j].y * h[j].y) + (h[j].z * h[j].z + h[j].w * h[j].w); }
    return 1.0f / sqrtf(wave_sum(s2) * (1.f / D) + EPS);
}
__device__ __forceinline__ void p5_rows(const Args& a, LAS unsigned char* lds, int p  ) {
    const int tid = opaque_tid(), lane = tid & 63, wave = __builtin_amdgcn_readfirstlane(tid >> 6);
    unsigned char* ws = a.ws;
    const int b = p >> 3;
    LAS float* wrt = (LAS float*)lds;
    LAS float* mv = (LAS float*)(lds + 65536);
    const float* wr = a.in[I_WROUTER];
    const bf16_t* MIX = (const bf16_t*)(ws + WS_MIX); bf16_t* XN2 = (bf16_t*)(ws + WS_XN); float* AFFT = (float*)(ws + WS_AFFT); bf16_t* H1 = (bf16_t*)(ws + WS_H1);
    const float* X = a.in[I_X];
    const int rbase = p * 256 + wave * 32;
    P5In cA, cB;
    p5_load(cA, rbase, lane, X, MIX); p5_load(cB, rbase + 16, lane, X, MIX);
    for (int n = tid; n < D * NE; n += NTHREADS) { const int k = n >> 4, e = n & 15; wrt[e * D + k] = wr[n]; }
    const float* MOD = (const float*)(ws + WS_MOD) + (size_t)b * NMOD;
    for (int n = tid; n < 3 * D; n += NTHREADS) mv[n] = MOD[2 * D + n];
    __syncthreads();
    const f32x4* npm = (const f32x4*)a.in[I_NPOST_MIX] + lane; const f32x4* npf = (const f32x4*)a.in[I_NPRE_FFN] + lane;
    for (int i = 0; i < 16; ++i) {
        const int rowA = rbase + i, rowB = rbase + 16 + i;
        P5In nA, nB;
        if (i + 1 < 16) { p5_load(nA, rowA + 1, lane, X, MIX); p5_load(nB, rowB + 1, lane, X, MIX); }
        f32x4 hA[4], hB[4];
        const float rsA = p5_resid(cA, hA, rowA, lane, mv, npm, H1);
        const float rsB = p5_resid(cB, hB, rowB, lane, mv, npm, H1);
        u32x2* oA = (u32x2*)(XN2 + (size_t)rowA * D) + lane; u32x2* oB = (u32x2*)(XN2 + (size_t)rowB * D) + lane;
        float lg[32];
#pragma unroll
        for (int e = 0; e < 32; ++e) lg[e] = 0.f;
#pragma unroll
        for (int j = 0; j < 4; ++j) { const f32x4 sh2 = *(const LAS f32x4*)(mv + 1024 + 4 * lane + 256 * j), sc2 = *(const LAS f32x4*)(mv + 2048 + 4 * lane + 256 * j);
            const f32x4 gn = npf[64 * j];
            const f32x4 zA = ((hA[j] * rsA) * gn) * (sc2 + 1.0f) + sh2, zB = ((hB[j] * rsB) * gn) * (sc2 + 1.0f) + sh2;
            u32x2 wv; wv.x = pk2(zA.x, zA.y); wv.y = pk2(zA.z, zA.w); oA[64 * j] = wv; wv.x = pk2(zB.x, zB.y); wv.y = pk2(zB.z, zB.w); oB[64 * j] = wv;
#pragma unroll
            for (int e = 0; e < 16; ++e) { const f32x4 wq = *(const LAS f32x4*)(wrt + e * D + 4 * lane + 256 * j);
                lg[e] += (zA.x * wq.x + zA.y * wq.y) + (zA.z * wq.z + zA.w * wq.w); lg[16 + e] += (zB.x * wq.x + zB.y * wq.y) + (zB.z * wq.z + zB.w * wq.w);
                if ((e & 3) == 3) __builtin_amdgcn_sched_barrier(0); } }
#pragma unroll
        for (int st = 0; st < 5; ++st) { const int d = 1 << st, cntv = 16 >> st; const bool up = (lane & d) != 0;
#pragma unroll
            for (int q = 0; q < 16; ++q) if (q < cntv) { const float send = up ? lg[2 * q] : lg[2 * q + 1], keep = up ? lg[2 * q + 1] : lg[2 * q]; lg[q] = keep + __shfl_xor(send, d); } }
        float lv = lg[0] + __shfl_xor(lg[0], 32);
        float mxl = lv;
#pragma unroll
        for (int d = 1; d < 16; d <<= 1) mxl = fmaxf(mxl, __shfl_xor(mxl, d));
        const float ev = __expf(lv - mxl); float se = ev;
#pragma unroll
        for (int d = 1; d < 16; d <<= 1) se += __shfl_xor(se, d);
        if (lane < 32) { const int row = (lane < 16) ? rowA : rowB; AFFT[((size_t)b * NE + (lane & 15)) * T + (row & (T - 1))] = ev / se; }
        cA = nA; cB = nB;
    }
}

__device__ __forceinline__ void p6_topk(const Args& a, LAS unsigned char* lds, int c, int G) {
    const int tid = opaque_tid(), lane = tid & 63, wave = __builtin_amdgcn_readfirstlane(tid >> 6);
    unsigned char* ws = a.ws;
    const float* AFFT = (const float*)(ws + WS_AFFT); short* SLOT = (short*)(ws + WS_SLOT); int* IDX = (int*)(ws + WS_IDX); float* GATE = (float*)(ws + WS_GATE);
    LAS unsigned* sv = (LAS unsigned*)(lds + wave * 16384);
    for (int item = c + wave * G; item < NITEM; item += G * NWAVES) {
        const int b = item >> 4, e = item & 15;
        const float* src = AFFT + (size_t)item * T;
#pragma unroll 8
        for (int j = 0; j < 32; ++j) sv[j * 64 + lane] = __float_as_uint(src[j * 64 + lane]);
        LDS_WAIT(); asm volatile("" ::: "memory");
        unsigned pre = 0u;
        for (int bit = 30; bit >= 0; --bit) {
            const unsigned cand = pre | (1u << bit);
            int cnt = 0;
#pragma unroll 4
            for (int j = 0; j < 32; ++j) cnt += (int)__popcll(__ballot(sv[j * 64 + lane] >= cand));
            if (cnt >= CAP) pre = cand;
        }
        int ngt = 0;
#pragma unroll 4
        for (int j = 0; j < 32; ++j) ngt += (int)__popcll(__ballot(sv[j * 64 + lane] > pre));
        const int need_eq = CAP - ngt;
        const unsigned long long ltmask = (1ull << lane) - 1ull;
        int base_gt = 0, base_eq = 0;
#pragma unroll 2
        for (int j = 0; j < 32; ++j) {
            const unsigned vj = sv[j * 64 + lane];
            const bool gt = vj > pre, eq = vj == pre;
            const unsigned long long mg = __ballot(gt), me = __ballot(eq);
            const int pg = base_gt + (int)__popcll(mg & ltmask), pe = base_eq + (int)__popcll(me & ltmask);
            int sl = -1; if (gt) sl = pg; else if (eq && pe < need_eq) sl = ngt + pe;
            const int t = j * 64 + lane;
            SLOT[((size_t)b * T + t) * NE + e] = (short)sl;
            if (sl >= 0) { IDX[item * CAP + sl] = t; GATE[item * CAP + sl] = __uint_as_float(vj); }
            base_gt += (int)__popcll(mg); base_eq += (int)__popcll(me);
        }
        LDS_WAIT(); asm volatile("" ::: "memory");
    }
}

struct P8Row { u32x2 h[4]; u32x2 y[4][4]; float wt[4]; unsigned long long rest; int sl; };
__device__ __forceinline__ void p8_issue(P8Row& r, int row, int lane, const short* SLOT, const bf16_t* Y, const bf16_t* H1) {
    const int b = row >> 11;
    const int s_e = (lane < NE) ? (int)SLOT[(size_t)row * NE + lane] : -1;
    unsigned long long mask = __ballot(s_e >= 0);
    const u32x2* hr = (const u32x2*)(H1 + (size_t)row * D) + lane;
#pragma unroll
    for (int j = 0; j < 4; ++j) r.h[j] = hr[64 * j];
#pragma unroll
    for (int q = 0; q < 4; ++q) {
        int e = 0, s = 0; r.wt[q] = 0.f;
        if (mask) { e = (int)__builtin_ctzll(mask); mask &= mask - 1ull; s = __builtin_amdgcn_readlane(s_e, e); r.wt[q] = 1.f; }
        const u32x2* yr = (const u32x2*)(Y + ((size_t)(b * NE + e) * CAP + s) * D) + lane;
#pragma unroll
        for (int j = 0; j < 4; ++j) r.y[q][j] = yr[64 * j];
    }
    r.rest = mask; r.sl = s_e;
}
__device__ __forceinline__ void p8_finish(P8Row& r, int row, int lane, const bf16_t* Y, const float* MOD, const f32x4* npo, float* out) {
    const int b = row >> 11;
    f32x4 ff[4];
#pragma unroll
    for (int j = 0; j < 4; ++j) ff[j] = (f32x4){0.f, 0.f, 0.f, 0.f};
#pragma unroll
    for (int q = 0; q < 4; ++q)
#pragma unroll
        for (int j = 0; j < 4; ++j) { const u32x2 wv = r.y[q][j]; ff[j] += (f32x4){bflo(wv.x), bfhi(wv.x), bflo(wv.y), bfhi(wv.y)} * r.wt[q]; }
    unsigned long long mask = r.rest;
    while (mask) {
        const int e = (int)__builtin_ctzll(mask); mask &= mask - 1ull; const int s = __builtin_amdgcn_readlane(r.sl, e);
        const u32x2* yr = (const u32x2*)(Y + ((size_t)(b * NE + e) * CAP + s) * D) + lane;
#pragma unroll
        for (int j = 0; j < 4; ++j) { const u32x2 wv = yr[64 * j]; ff[j] += (f32x4){bflo(wv.x), bfhi(wv.x), bflo(wv.y), bfhi(wv.y)}; }
    }
    float s2 = 0.f;
#pragma unroll
    for (int j = 0; j < 4; ++j) s2 += (ff[j].x * ff[j].x + ff[j].y * ff[j].y) + (ff[j].z * ff[j].z + ff[j].w * ff[j].w);
    const float rstd = 1.0f / sqrtf(wave_sum(s2) * (1.f / D) + EPS);
    f32x4* orow = (f32x4*)(out + (size_t)row * D) + lane; const f32x4* g2 = (const f32x4*)(MOD + (size_t)b * NMOD + 5 * D) + lane;
#pragma unroll
    for (int j = 0; j < 4; ++j) { const u32x2 hv = r.h[j]; const f32x4 h = (f32x4){bflo(hv.x), bfhi(hv.x), bflo(hv.y), bfhi(hv.y)};
        orow[64 * j] = h + g2[64 * j] * ((ff[j] * rstd) * npo[64 * j]); }
}
__device__ __forceinline__ void p8_final(const Args& a, int vcu, int G) {
    const int tid = opaque_tid(), lane = tid & 63, wave = __builtin_amdgcn_readfirstlane(tid >> 6);
    unsigned char* ws = a.ws;
    const short* SLOT = (const short*)(ws + WS_SLOT); const bf16_t* Y = (const bf16_t*)(ws + WS_Y); const float* MOD = (const float*)(ws + WS_MOD); const bf16_t* H1 = (const bf16_t*)(ws + WS_H1);
    const f32x4* npo = (const f32x4*)a.in[I_NPOST_FFN] + lane;
    const int gw = vcu * NWAVES + wave, NGW = G * NWAVES;
    for (int row = gw; row < M; row += 2 * NGW) {
        P8Row r0, r1;
        p8_issue(r0, row, lane, SLOT, Y, H1);
        const bool two = row + NGW < M;
        if (two) p8_issue(r1, row + NGW, lane, SLOT, Y, H1);
        p8_finish(r0, row, lane, Y, MOD, npo, a.out);
        if (two) p8_finish(r1, row + NGW, lane, Y, MOD, npo, a.out);
    }
}

__global__ void __launch_bounds__(NTHREADS, 2) fwd_kernel(Args args) {
    extern __shared__ __attribute__((aligned(16))) unsigned char lds_raw[];
    LAS unsigned char* lds = (LAS unsigned char*)lds_raw;
    volatile LAS unsigned* MISC = (volatile LAS unsigned*)(lds + MISC_OFF);
    const int tid = threadIdx.x;
    const int G = gridDim.x, c = blockIdx.x;
    const int vcu = (G % 8 == 0) ? (c % 8) * (G / 8) + c / 8 : c;
    unsigned char* ws = args.ws;
    gu32* ctl = (gu32*)(ws + WS_CTL);
    for (int u = tid; u < (LDS_BYTES - LDSCTL_OFF) / 4; u += NTHREADS) ((LAS unsigned*)(lds + LDSCTL_OFF))[u] = 0u;
    __syncthreads();
    XcdBarrier bar; bar.bar = (unsigned*)(ctl + CW_BAR); bar.x = 0; bar.st = nullptr;
    const int lo = args.ph_lo, hi = args.ph_hi;
    if (hi - lo > 1) bar = xcd_barrier_post((unsigned*)(ctl + CW_BAR), MISC + 8);
#ifndef PHMASK
#define PHMASK 0xff
#endif
#define IN(k) (((PHMASK >> (k)) & 1) && lo <= (k) && (k) < hi)
#define SEAM(k) do { if (IN(k) && IN((k) + 1)) xcd_barrier(bar); } while (0)
#ifndef PROBE_PHASE
#define PROBE_PHASE -1
#endif
#define PB(k) do { if (PROBE_PHASE == (k)) { if (tid == 0) { const unsigned long long t0_ = __builtin_amdgcn_s_memrealtime(); MISC[16] = (unsigned)t0_; MISC[17] = (unsigned)(t0_ >> 32); } } } while (0)
#define PE(k) do { if (PROBE_PHASE == (k)) { if (tid == 0) { const unsigned long long t0_ = ((unsigned long long)MISC[17] << 32) | MISC[16]; const unsigned long long t1_ = __builtin_amdgcn_s_memrealtime(); \
      while (__builtin_amdgcn_s_memrealtime() - t1_ < t1_ - t0_) __builtin_amdgcn_s_sleep(8); } __syncthreads(); } } while (0)

    PB(0); if (IN(0)) { p0_prologue(args, lds, vcu, G); } SEAM(0); PE(0);
    PB(1); if (IN(1)) { p1_xn(args, lds, c, G); } SEAM(1); PE(1);
    PB(2); if (IN(2)) {
        pg8::Gemm g{(const bf16_t*)(ws + WS_XN), (const bf16_t*)(ws + WS_WIN), D, nullptr};
        pg8::SchedProj S{G, c};
        pg8::EpiProj E{(bf16_t*)(ws + WS_Q), (bf16_t*)(ws + WS_K), (bf16_t*)(ws + WS_V), (bf16_t*)(ws + WS_GB), (bf16_t*)(ws + WS_U), (const float*)(ws + WS_TAB)};
        pg8::gemm_phase<pg8::EpiProj, pg8::SchedProj, true, true>(lds, g, S, E);
    } SEAM(2); PE(2);
    PB(3); if (IN(3)) { if (c & 1) expert_weight_copies(args, lds, vcu, G); p3_conv_attn(args, lds, c, vcu, G); if (!(c & 1)) expert_weight_copies(args, lds, vcu, G); } SEAM(3); PE(3);
    PB(4); if (IN(4)) {
        {
            const int p = c;
#ifndef NO_P4
            pg8::Gemm g{(const bf16_t*)(ws + WS_MIXIN), (const bf16_t*)(ws + WS_WOUT), D, nullptr};
            pg8::SchedPanel S{p, 4};
            pg8::EpiBf16 E{(bf16_t*)(ws + WS_MIX), D};
            pg8::gemm_phase<pg8::EpiBf16, pg8::SchedPanel, true, true>(lds, g, S, E);
#endif
            VM_WAIT(); __syncthreads();
#ifndef NO_P5
            p5_rows(args, lds, p);
#endif
            __syncthreads();
        }
    } SEAM(4); PE(4);
    PB(5); if (IN(5)) { p6_topk(args, lds, c, G); } SEAM(5); PE(5);
    PB(6); if (IN(6)) {
#pragma unroll 1
        for (int it = 0; it < 2; ++it) {
            {
                const int item = 2 * c + it;
                const int b = item >> 4, e = item & 15;
                {
                    const int lane_ = opaque_tid() & 63, wave_ = __builtin_amdgcn_readfirstlane(opaque_tid() >> 6), j_ = (c >> 3) & 31;
                    LAS unsigned char* scr_ = lds + LDSCTL_OFF + 2048 + wave_ * 1024;
                    prefetch_slice(ws + WS_WGU + (size_t)e * 2048 * D * 2 + (size_t)j_ * 131072 + wave_ * 16384, 16384, scr_, lane_);
                    prefetch_slice(ws + WS_WDN + (size_t)e * D * D * 2 + (size_t)j_ * 65536 + wave_ * 8192, 8192, scr_, lane_);
                }
#ifndef NO_G1
                if (it == 0) PB(8);
                {
                    pg8::Gemm g{(const bf16_t*)(ws + WS_XN) + (size_t)b * T * D, (const bf16_t*)(ws + WS_WGU) + (size_t)e * 2048 * D, D, (const int*)(ws + WS_IDX) + item * CAP};
                    pg8::SchedPanel S{0, 8};
                    pg8::EpiGU E{(bf16_t*)(ws + WS_HMID) + (size_t)item * CAP * D};
                    pg8::gemm_phase<pg8::EpiGU, pg8::SchedPanel, true, true, true>(lds, g, S, E);
                }
#endif
                VM_WAIT(); __syncthreads();
                if (it == 0) { PE(8); PB(9); }
#ifndef NO_G2
                {
                    pg8::Gemm g{(const bf16_t*)(ws + WS_HMID) + (size_t)item * CAP * D, (const bf16_t*)(ws + WS_WDN) + (size_t)e * D * D, D, nullptr};
                    pg8::SchedPanel S{0, 4};
                    pg8::EpiDown E{(bf16_t*)(ws + WS_Y) + (size_t)item * CAP * D, (const float*)(ws + WS_GATE) + item * CAP};
                    pg8::gemm_phase<pg8::EpiDown, pg8::SchedPanel, true, true>(lds, g, S, E);
                }
#endif
                VM_WAIT(); __syncthreads();
                if (it == 0) PE(9);
            }
        }
    } SEAM(6); PE(6);
    PB(7); if (IN(7)) { p8_final(args, vcu, G); } PE(7);
#undef IN
#undef SEAM
}

extern "C" void kernel_launch(void* const* d_in, const int* in_sizes, int n_in, void* d_out, int out_size, void* d_ws, size_t ws_size, hipStream_t stream) {
    static int grid = 0;
    if (grid == 0) {
        if (n_in != 22 || in_sizes[0] != M * D || out_size != M * D || ws_size < WS_END) { fprintf(stderr, "kernel_launch: unexpected shapes (n_in %d, in0 %d, out %d, ws %zu)\n", n_in, n_in > 0 ? in_sizes[0] : -1, out_size, ws_size); grid = -1; return; }
        int dev = 0, cus = 0;
        if (hipGetDevice(&dev) != hipSuccess || hipDeviceGetAttribute(&cus, hipDeviceAttributeMultiprocessorCount, dev) != hipSuccess) { grid = -1; return; }
        if (hipFuncSetAttribute((const void*)fwd_kernel, hipFuncAttributeMaxDynamicSharedMemorySize, LDS_BYTES) != hipSuccess) { fprintf(stderr, "kernel_launch: hipFuncSetAttribute failed\n"); grid = -1; return; }
        (void)hipGetLastError();
        grid = cus;
        if (grid != 256) { fprintf(stderr, "kernel_launch: this kernel needs a 256-CU device (got %d)\n", cus); grid = -1; return; }
    }
    if (grid < 0) return;
    (void)hipMemsetAsync((char*)d_ws + WS_CTL, 0, CTL_ZERO_BYTES, stream);
    Args a{};
    for (int i = 0; i < 22; ++i) a.in[i] = (const float*)d_in[i];
    a.out = (float*)d_out; a.ws = (unsigned char*)d_ws;
    constexpr int NPH = 8;
    if (MK_N_LAUNCHES == 1) { a.ph_lo = 0; a.ph_hi = NPH; hipLaunchKernelGGL(fwd_kernel, dim3(grid), dim3(NTHREADS), LDS_BYTES, stream, a); }
    else { for (int k = 0; k < NPH; ++k) { a.ph_lo = k; a.ph_hi = k + 1; hipLaunchKernelGGL(fwd_kernel, dim3(grid), dim3(NTHREADS), LDS_BYTES, stream, a); } }
}
```

```cpp
#include <hip/hip_runtime.h>
#include <cstdio>
#include <cstdint>

#ifndef MK_N_LAUNCHES
#define MK_N_LAUNCHES 1
#endif

#define LAS __attribute__((address_space(3)))
#define GAS __attribute__((address_space(1)))
typedef unsigned short bf16_t;
typedef short bf16x8 __attribute__((ext_vector_type(8)));
typedef short s16x4 __attribute__((ext_vector_type(4)));
typedef float f32x4 __attribute__((ext_vector_type(4)));
typedef float f32x16 __attribute__((ext_vector_type(16)));
typedef unsigned u32x4 __attribute__((ext_vector_type(4)));
typedef unsigned u32x2 __attribute__((ext_vector_type(2)));

constexpr int NB = 32, T = 2048, D = 1024, TC = 256, M = NB * T, MC = NB * TC, MA = M + MC, TK = TC + T;
constexpr int NE = 16, CAP = 256, NITEM = NB * NE, NPROJ = 3072, NMOD = 6 * D;
constexpr float EPS = 1e-6f;
constexpr float C2 = 0.125f * 1.4426950408889634f;
constexpr float LAM_INIT = 0.2f;
constexpr int NWAVES = 8, NTHREADS = 512;

constexpr size_t MiB = 1u << 20;
constexpr size_t WS_CTL = 0, CTL_ZERO_BYTES = 1 * MiB;
constexpr size_t WS_MODP = 2 * MiB;
constexpr size_t WS_MOD = 16 * MiB;
constexpr size_t WS_TAB = 17 * MiB;
constexpr size_t WS_WIN = 18 * MiB;
constexpr size_t WS_WOUT = 24 * MiB;
constexpr size_t WS_WGU = 26 * MiB;
constexpr size_t WS_WDN = 90 * MiB;
constexpr size_t WS_AFFT = 122 * MiB;
constexpr size_t WS_SLOT = 126 * MiB;
constexpr size_t WS_IDX = 128 * MiB;
constexpr size_t WS_GATE = 129 * MiB;
constexpr size_t WS_XN = 130 * MiB;
constexpr size_t WS_Q = 274 * MiB;
constexpr size_t WS_K = 338 * MiB;
constexpr size_t WS_V = 410 * MiB;
constexpr size_t WS_GB = 482 * MiB;
constexpr size_t WS_U = 546 * MiB;
constexpr size_t WS_MIXIN = 610 * MiB;
constexpr size_t WS_MIX = 738 * MiB;
constexpr size_t WS_HMID = 274 * MiB;
constexpr size_t WS_Y = 610 * MiB;
constexpr size_t WS_H1 = 866 * MiB;
constexpr size_t WS_END = 994 * MiB;

__device__ __forceinline__ int opaque_tid() { int t = threadIdx.x; asm volatile("" : "+v"(t)); return t; }

namespace pg8 {
constexpr int BM = 256, BK = 64, HALF = 128, HTB = HALF * BK * 2, STAGE_BYTES = 8 * HTB;
__host__ __device__ __forceinline__ int lds_byte(int r, int c) { const int st = (r >> 4) * 2 + (c >> 5), rr = r & 15, cc = c & 31, ob = rr * 64 + cc * 2; return st * 1024 + (ob ^ (((ob >> 9) & 1) << 5)); }
__host__ __device__ __forceinline__ void stage_rc(int b, int& R, int& C) { const int st = b / 1024, sb = b % 1024, swz = sb ^ (((sb >> 9) & 1) << 5); R = (st >> 1) * 16 + swz / 64; C = (st & 1) * 32 + (swz % 64) / 2; }
__host__ __device__ __forceinline__ int perm32(int rho) { const int n = rho >> 4, i = rho & 15; return 8 * (i >> 2) + 4 * n + (i & 3); }

struct Unit { int pm, pn; };
struct Gemm { const bf16_t* A; const bf16_t* Bt; int K; const int* gidx; };

typedef float f32x2_t __attribute__((ext_vector_type(2))); typedef __bf16 bf16x2_t __attribute__((ext_vector_type(2)));
__device__ __forceinline__ unsigned cvt_pk_bf16(float lo, float hi) { const f32x2_t v = {lo, hi}; const bf16x2_t b = __builtin_convertvector(v, bf16x2_t); return __builtin_bit_cast(unsigned, b); }

struct EpiBf16 {
    static constexpr bool PERM = true, AFTER_DRAIN = false;
    bf16_t* O; int ldc;
    __device__ __forceinline__ void operator()(const f32x4 (&acc)[2][2][4][2], const Unit& u, int wr, int wc, int fr, int fq) const {
        const int row0 = u.pm * BM + wr * 64 + fr; const int col0 = u.pn * BM + wc * 32 + 8 * fq;
#pragma unroll
        for (int ai = 0; ai < 2; ++ai)
#pragma unroll
            for (int m = 0; m < 4; ++m) { bf16_t* rowp = O + (size_t)(row0 + ai * HALF + m * 16) * ldc + col0;
#pragma unroll
                for (int bj = 0; bj < 2; ++bj) { const f32x4 v0 = acc[ai][bj][m][0], v1 = acc[ai][bj][m][1];
                    u32x4 w; w.x = cvt_pk_bf16(v0[0], v0[1]); w.y = cvt_pk_bf16(v0[2], v0[3]); w.z = cvt_pk_bf16(v1[0], v1[1]); w.w = cvt_pk_bf16(v1[2], v1[3]);
                    *(u32x4*)(rowp + bj * HALF) = w; } }
    }
};

struct EpiProj {
    static constexpr bool PERM = true, AFTER_DRAIN = false;
    bf16_t *Q, *KA, *VA, *GB, *U; const float* tab;
    unsigned* kmaxh;
    __device__ __forceinline__ void operator()(const f32x4 (&acc)[2][2][4][2], const Unit& u, int wr, int wc, int fr, int fq) const {
        const int pn = u.pn; const bool ctx = u.pm >= 256;
        float km[2] = {0.f, 0.f};
#pragma unroll
        for (int ai = 0; ai < 2; ++ai)
#pragma unroll
            for (int m = 0; m < 4; ++m) {
                const int row = u.pm * BM + ai * HALF + wr * 64 + m * 16 + fr;
                int t, kvrow;
                if (!ctx) { const int b = row >> 11; t = row & 2047; kvrow = b * TK + TC + t; }
                else { const int rc = row - M; const int b = rc >> 8; t = 0; kvrow = b * TK + (rc & 255); }
                if (pn < 4) {
                    f32x4 cs0 = {1.f, 0.f, 1.f, 0.f}, cs1 = cs0, cs2 = cs0, cs3 = cs0;
                    if (!ctx) { const float* tp = tab + ((size_t)t * 32 + 16 * (wc & 1) + 4 * fq) * 2;
                        cs0 = *(const f32x4*)(tp); cs1 = *(const f32x4*)(tp + 4); }
                    (void)cs2; (void)cs3;
#pragma unroll
                    for (int bj = 0; bj < 2; ++bj) {
                        const f32x4 v0 = acc[ai][bj][m][0], v1 = acc[ai][bj][m][1];
                        float e0 = v0[0], o0 = v0[1], e1 = v0[2], o1 = v0[3], e2 = v1[0], o2 = v1[1], e3 = v1[2], o3 = v1[3];
                        if (pn >= 2) {
                            float ss = ((e0 * e0 + o0 * o0) + (e1 * e1 + o1 * o1)) + ((e2 * e2 + o2 * o2) + (e3 * e3 + o3 * o3));
                            ss += __shfl_xor(ss, 16); ss += __shfl_xor(ss, 32); km[bj] = fmaxf(km[bj], ss); }
                        float r0 = e0 * cs0[0] - o0 * cs0[1], s0 = o0 * cs0[0] + e0 * cs0[1];
                        float r1 = e1 * cs0[2] - o1 * cs0[3], s1 = o1 * cs0[2] + e1 * cs0[3];
                        float r2 = e2 * cs1[0] - o2 * cs1[1], s2 = o2 * cs1[0] + e2 * cs1[1];
                        float r3 = e3 * cs1[2] - o3 * cs1[3], s3 = o3 * cs1[2] + e3 * cs1[3];
                        const float sc = (pn < 2) ? C2 : 1.f;
                        u32x4 w; w.x = cvt_pk_bf16(r0 * sc, s0 * sc); w.y = cvt_pk_bf16(r1 * sc, s1 * sc); w.z = cvt_pk_bf16(r2 * sc, s2 * sc); w.w = cvt_pk_bf16(r3 * sc, s3 * sc);
                        const int col = (pn & 1) * 256 + bj * HALF + wc * 32 + 8 * fq;
                        bf16_t* dst = (pn < 2) ? (Q + (size_t)row * 512 + col) : (KA + (size_t)kvrow * 512 + col);
                        *(u32x4*)dst = w;
                    }
                } else if (pn < 8) {
#pragma unroll
                    for (int bj = 0; bj < 2; ++bj) {
                        const f32x4 v0 = acc[ai][bj][m][0], v1 = acc[ai][bj][m][1];
                        u32x4 w; w.x = cvt_pk_bf16(v0[0], v0[1]); w.y = cvt_pk_bf16(v0[2], v0[3]); w.z = cvt_pk_bf16(v1[0], v1[1]); w.w = cvt_pk_bf16(v1[2], v1[3]);
                        const int col = (pn & 1) * 256 + bj * HALF + wc * 32 + 8 * fq;
                        bf16_t* dst = (pn < 6) ? (VA + (size_t)kvrow * 512 + col) : (GB + (size_t)row * 512 + col);
                        *(u32x4*)dst = w;
                    }
                } else {
                    const f32x4 a0 = acc[ai][0][m][0], a1 = acc[ai][0][m][1], b0 = acc[ai][1][m][0], b1 = acc[ai][1][m][1];
                    u32x4 w; w.x = cvt_pk_bf16(a0[0] * b0[0], a0[1] * b0[1]); w.y = cvt_pk_bf16(a0[2] * b0[2], a0[3] * b0[3]);
                    w.z = cvt_pk_bf16(a1[0] * b1[0], a1[1] * b1[1]); w.w = cvt_pk_bf16(a1[2] * b1[2], a1[3] * b1[3]);
                    const int col = (pn - 8) * 128 + wc * 32 + 8 * fq;
                    *(u32x4*)(U + (size_t)row * 512 + col) = w;
                }
            }
        if (pn == 2 || pn == 3) {
            const int b = ctx ? (u.pm - 256) : (u.pm >> 3);
#pragma unroll
            for (int bj = 0; bj < 2; ++bj) { float v = km[bj];
#pragma unroll
                for (int d = 1; d < 16; d <<= 1) v = fmaxf(v, __shfl_xor(v, d));
                if (fr == 0 && fq == 0) atomicMax(kmaxh + ((b * 8 + (pn & 1) * 4 + bj * 2 + (wc >> 1)) * 2 + (wc & 1)), __float_as_uint(v)); }
        }
    }
};

struct EpiGU {
    static constexpr bool PERM = true, AFTER_DRAIN = false;
    bf16_t* H;
    __device__ __forceinline__ float silu(float x) const { return x * __builtin_amdgcn_rcpf(1.f + __expf(-x)); }
    __device__ __forceinline__ void operator()(const f32x4 (&acc)[2][2][4][2], const Unit& u, int wr, int wc, int fr, int fq) const {
#pragma unroll
        for (int ai = 0; ai < 2; ++ai)
#pragma unroll
            for (int m = 0; m < 4; ++m) {
                const int row = ai * HALF + wr * 64 + m * 16 + fr;
                const f32x4 a0 = acc[ai][0][m][0], a1 = acc[ai][0][m][1], b0 = acc[ai][1][m][0], b1 = acc[ai][1][m][1];
                u32x4 w; w.x = cvt_pk_bf16(silu(a0[0]) * b0[0], silu(a0[1]) * b0[1]); w.y = cvt_pk_bf16(silu(a0[2]) * b0[2], silu(a0[3]) * b0[3]);
                w.z = cvt_pk_bf16(silu(a1[0]) * b1[0], silu(a1[1]) * b1[1]); w.w = cvt_pk_bf16(silu(a1[2]) * b1[2], silu(a1[3]) * b1[3]);
                *(u32x4*)(H + (size_t)row * 1024 + u.pn * 128 + wc * 32 + 8 * fq) = w;
            }
    }
};
struct EpiDown {
    static constexpr bool PERM = true, AFTER_DRAIN = false;
    bf16_t* Y; const float* gate;
    __device__ __forceinline__ void operator()(const f32x4 (&acc)[2][2][4][2], const Unit& u, int wr, int wc, int fr, int fq) const {
#pragma unroll
        for (int ai = 0; ai < 2; ++ai)
#pragma unroll
            for (int m = 0; m < 4; ++m) {
                const int row = ai * HALF + wr * 64 + m * 16 + fr; const float g = gate[row];
#pragma unroll
                for (int bj = 0; bj < 2; ++bj) { const f32x4 v0 = acc[ai][bj][m][0] * g, v1 = acc[ai][bj][m][1] * g;
                    u32x4 w; w.x = cvt_pk_bf16(v0[0], v0[1]); w.y = cvt_pk_bf16(v0[2], v0[3]); w.z = cvt_pk_bf16(v1[0], v1[1]); w.w = cvt_pk_bf16(v1[2], v1[3]);
                    *(u32x4*)(Y + (size_t)row * 1024 + u.pn * BM + bj * HALF + wc * 32 + 8 * fq) = w; }
            }
    }
};

struct SchedProj {
    int G, c;
    __device__ __forceinline__ bool next(int i, Unit& u) const {
        const int L = i * G + c;
        if (L < 3072) { u.pm = L & 255; u.pn = L >> 8; return true; }
        const int j = L - 3072; if (j >= 128) return false;
        u.pm = 256 + (j >> 2); u.pn = 2 + (j & 3); return true;
    }
    __device__ __forceinline__ void a_ready(const Unit&) const {}
    __device__ __forceinline__ void done(const Unit&) const {}
};
struct SchedPanel {
    int pm, ntn;
    __device__ __forceinline__ bool next(int i, Unit& u) const { if (i >= ntn) return false; u.pm = pm; u.pn = i; return true; }
    __device__ __forceinline__ void a_ready(const Unit&) const {}
    __device__ __forceinline__ void done(const Unit&) const {}
};

template <class Epi, class Sched, bool ALIGN_EPI, bool SP2, bool GATHER = false>
__device__ __forceinline__ void gemm_phase(LAS unsigned char* lds, const Gemm g, const Sched& S, const Epi& E) {
    const int tid = opaque_tid(), wid = __builtin_amdgcn_readfirstlane(tid >> 6), lane = tid & 63, wr = wid >> 2, wc = wid & 3, fr = lane & 15, fq = lane >> 4;
    const int K = g.K, nt = K / BK;
    unsigned voffA[2][2], voffB[2];
#pragma unroll
    for (int i = 0; i < 2; ++i) { int R, C; stage_rc(tid * 16 + i * 8192, R, C); const int Rb = Epi::PERM ? ((R & ~31) + perm32(R & 31)) : R;
        if constexpr (GATHER) { voffA[0][i] = (unsigned)(g.gidx[R] * K + C) * 2u; voffA[1][i] = (unsigned)(g.gidx[HALF + R] * K + C) * 2u; }
        else { voffA[0][i] = (unsigned)(R * K + C) * 2u; voffA[1][i] = voffA[0][i]; }
        voffB[i] = (unsigned)(Rb * K + C) * 2u; }
    const size_t kstep = (size_t)(BK * 2);
    const size_t hstep = (size_t)HALF * K * 2;
    const size_t hstepA = GATHER ? (size_t)0 : hstep;
    const size_t tstep = 2 * hstep;
    const unsigned ldsw = (unsigned)wid * 1024u;
    const int aoff = lds_byte(wr * 64 + fr, fq * 8), boff = lds_byte(wc * 32 + fr, fq * 8);
#define PG8_SA(b, h) (((b) * 2 + (h)) * HTB)
#define PG8_SB(b, h) ((4 + (b) * 2 + (h)) * HTB)
#define PG8_STAGE(bufoff, gbase, voff) do { _Pragma("unroll") for (int _i = 0; _i < 2; ++_i) \
        __builtin_amdgcn_global_load_lds((const unsigned*)((const char*)(gbase) + (voff)[_i]), (LAS unsigned*)(lds + (bufoff) + ldsw + _i * 8192), 16, 0, 0); } while (0)
#define PG8_LDA(dst, b, h) do { _Pragma("unroll") for (int m = 0; m < 4; ++m) _Pragma("unroll") for (int k = 0; k < 2; ++k) dst[m][k] = *(const LAS bf16x8*)(lds + PG8_SA(b, h) + aoff + m * 2048 + k * 1024); } while (0)
#define PG8_LDB(dst, b, h) do { _Pragma("unroll") for (int n = 0; n < 2; ++n) _Pragma("unroll") for (int k = 0; k < 2; ++k) dst[n][k] = *(const LAS bf16x8*)(lds + PG8_SB(b, h) + boff + n * 2048 + k * 1024); } while (0)
#define PG8_MMA(ai, bj, At, Bt) do { __builtin_amdgcn_s_setprio(1); _Pragma("unroll") for (int m = 0; m < 4; ++m) _Pragma("unroll") for (int n = 0; n < 2; ++n) _Pragma("unroll") for (int k = 0; k < 2; ++k) \
        acc[ai][bj][m][n] = __builtin_amdgcn_mfma_f32_16x16x32_bf16(Bt[n][k], At[m][k], acc[ai][bj][m][n], 0, 0, 0); __builtin_amdgcn_s_setprio(0); } while (0)
#define PG8_WAIT_V(n) asm volatile("s_waitcnt vmcnt(" #n ")" ::: "memory")
#define PG8_WAIT_L(n) asm volatile("s_waitcnt lgkmcnt(" #n ")" ::: "memory")
#define PG8_BAR __builtin_amdgcn_s_barrier()
#define PG8_SCHED __builtin_amdgcn_sched_barrier(0)
    Unit cur, nxt; int ui = 0;
    if (!S.next(0, cur)) return;
    f32x4 acc[2][2][4][2];
#pragma unroll
    for (int a = 0; a < 2; ++a)
#pragma unroll
        for (int b = 0; b < 2; ++b)
#pragma unroll
            for (int m = 0; m < 4; ++m)
#pragma unroll
                for (int n = 0; n < 2; ++n) acc[a][b][m][n] = (f32x4){0.f, 0.f, 0.f, 0.f};
    bf16x8 At[4][2], B0[2][2], B1[2][2];
    const char* cA = (const char*)g.A + (size_t)cur.pm * tstep; const char* cB = (const char*)g.Bt + (size_t)cur.pn * tstep;
    S.a_ready(cur);
    if constexpr (SP2) {
        PG8_STAGE(PG8_SB(0, 0), cB, voffB); PG8_STAGE(PG8_SB(0, 1), cB + hstep, voffB); PG8_STAGE(PG8_SA(0, 0), cA, voffA[0]); PG8_STAGE(PG8_SA(0, 1), cA + hstepA, voffA[1]);
        if (wr == 1) PG8_BAR;
        PG8_WAIT_V(2); PG8_BAR;
        PG8_STAGE(PG8_SB(1, 0), cB + kstep, voffB); PG8_STAGE(PG8_SA(1, 0), cA + kstep, voffA[0]); PG8_STAGE(PG8_SB(1, 1), cB + hstep + kstep, voffB);
        PG8_WAIT_V(6); PG8_BAR;
    } else {
        PG8_STAGE(PG8_SB(0, 0), cB, voffB); PG8_STAGE(PG8_SA(0, 0), cA, voffA[0]); PG8_STAGE(PG8_SB(0, 1), cB + hstep, voffB); PG8_STAGE(PG8_SA(0, 1), cA + hstepA, voffA[1]);
        if (wr == 1) PG8_BAR;
        PG8_WAIT_V(4); PG8_BAR;
        PG8_STAGE(PG8_SB(1, 0), cB + kstep, voffB); PG8_STAGE(PG8_SA(1, 0), cA + kstep, voffA[0]); PG8_STAGE(PG8_SB(1, 1), cB + hstep + kstep, voffB);
        PG8_WAIT_V(6); PG8_BAR;
    }
    for (;;) {
        const bool has_next = S.next(ui + 1, nxt);
        const char* nA = has_next ? (const char*)g.A + (size_t)nxt.pm * tstep : cA; const char* nB = has_next ? (const char*)g.Bt + (size_t)nxt.pn * tstep : cB;
        for (int t = 0; t < nt; t += 2) {
            const bool last = (t == nt - 2);
            const char* a1 = cA + (size_t)(t + 1) * kstep;
            const char* a2 = last ? nA : cA + (size_t)(t + 2) * kstep; const char* b2 = last ? nB : cB + (size_t)(t + 2) * kstep;
            const char* a3 = a2 + kstep; const char* b3 = b2 + kstep;
            if (last && has_next) S.a_ready(nxt);
            if constexpr (SP2) {
            PG8_LDB(B0, 0, 0); PG8_LDB(B1, 0, 1); PG8_SCHED; PG8_LDA(At, 0, 0); PG8_STAGE(PG8_SA(1, 1), a1 + hstepA, voffA[1]);
            PG8_WAIT_V(8); PG8_WAIT_L(0); PG8_BAR; PG8_MMA(0, 0, At, B0); PG8_MMA(0, 1, At, B1); PG8_BAR; PG8_SCHED;
            PG8_LDA(At, 0, 1); PG8_STAGE(PG8_SB(0, 0), b2, voffB); PG8_STAGE(PG8_SB(0, 1), b2 + hstep, voffB); PG8_STAGE(PG8_SA(0, 0), a2, voffA[0]);
            PG8_WAIT_V(8); PG8_WAIT_L(0); PG8_BAR; PG8_MMA(1, 0, At, B0); PG8_MMA(1, 1, At, B1); PG8_BAR; PG8_SCHED;
            PG8_LDB(B0, 1, 0); PG8_LDB(B1, 1, 1); PG8_SCHED; PG8_LDA(At, 1, 0); PG8_STAGE(PG8_SA(0, 1), a2 + hstepA, voffA[1]);
            PG8_WAIT_V(8); PG8_WAIT_L(0); PG8_BAR; PG8_MMA(0, 0, At, B0); PG8_MMA(0, 1, At, B1); PG8_BAR; PG8_SCHED;
            PG8_LDA(At, 1, 1); PG8_STAGE(PG8_SB(1, 0), b3, voffB); PG8_STAGE(PG8_SB(1, 1), b3 + hstep, voffB); PG8_STAGE(PG8_SA(1, 0), a3, voffA[0]);
            PG8_WAIT_V(8); PG8_WAIT_L(0); PG8_BAR; PG8_MMA(1, 0, At, B0); PG8_MMA(1, 1, At, B1); PG8_BAR; PG8_SCHED;
            } else {
            PG8_LDB(B0, 0, 0); PG8_SCHED; PG8_LDA(At, 0, 0); PG8_STAGE(PG8_SA(1, 1), a1 + hstepA, voffA[1]);
            PG8_WAIT_L(8); PG8_BAR; PG8_WAIT_L(0); PG8_MMA(0, 0, At, B0); PG8_BAR; PG8_SCHED;
            PG8_LDB(B1, 0, 1); PG8_STAGE(PG8_SB(0, 0), b2, voffB);
            PG8_BAR; PG8_WAIT_L(0); PG8_MMA(0, 1, At, B1); PG8_BAR;
            PG8_LDA(At, 0, 1); PG8_STAGE(PG8_SA(0, 0), a2, voffA[0]);
            PG8_BAR; PG8_WAIT_L(0); PG8_MMA(1, 0, At, B0); PG8_BAR; PG8_SCHED;
            PG8_STAGE(PG8_SB(0, 1), b2 + hstep, voffB);
            PG8_WAIT_V(6); PG8_BAR; PG8_MMA(1, 1, At, B1); PG8_BAR;
            PG8_LDB(B0, 1, 0); PG8_SCHED; PG8_LDA(At, 1, 0); PG8_STAGE(PG8_SA(0, 1), a2 + hstepA, voffA[1]);
            PG8_WAIT_L(8); PG8_BAR; PG8_WAIT_L(0); PG8_MMA(0, 0, At, B0); PG8_BAR; PG8_SCHED;
            PG8_LDB(B1, 1, 1); PG8_STAGE(PG8_SB(1, 0), b3, voffB);
            PG8_BAR; PG8_WAIT_L(0); PG8_MMA(0, 1, At, B1); PG8_BAR;
            PG8_LDA(At, 1, 1); PG8_STAGE(PG8_SA(1, 0), a3, voffA[0]);
            PG8_BAR; PG8_WAIT_L(0); PG8_MMA(1, 0, At, B0); PG8_BAR; PG8_SCHED;
            PG8_STAGE(PG8_SB(1, 1), b3 + hstep, voffB);
            PG8_WAIT_V(6); PG8_BAR; PG8_MMA(1, 1, At, B1); PG8_BAR;
            }
        }
        if constexpr (ALIGN_EPI) { if (wr == 0) PG8_BAR; }
        E(acc, cur, wr, wc, fr, fq); S.done(cur);
        if (!has_next) break;
#pragma unroll
        for (int a = 0; a < 2; ++a)
#pragma unroll
            for (int b = 0; b < 2; ++b)
#pragma unroll
                for (int m = 0; m < 4; ++m)
#pragma unroll
                    for (int n = 0; n < 2; ++n) acc[a][b][m][n] = (f32x4){0.f, 0.f, 0.f, 0.f};
        cur = nxt; cA = nA; cB = nB; ++ui;
        if constexpr (ALIGN_EPI) { if (wr == 1) PG8_BAR; }
    }
    PG8_WAIT_V(0);
    if constexpr (!ALIGN_EPI) { if (wr == 0) PG8_BAR; }
    PG8_BAR;
#undef PG8_SA
#undef PG8_SB
#undef PG8_STAGE
#undef PG8_LDA
#undef PG8_LDB
#undef PG8_MMA
#undef PG8_WAIT_V
#undef PG8_WAIT_L
#undef PG8_BAR
#undef PG8_SCHED
}
}

typedef GAS unsigned gu32;
#define RLX_AGENT __ATOMIC_RELAXED, __HIP_MEMORY_SCOPE_AGENT
#define LDS_WAIT() asm volatile("s_waitcnt lgkmcnt(0)" ::: "memory")
#define VM_WAIT() asm volatile("s_waitcnt vmcnt(0)" ::: "memory")
__device__ __forceinline__ unsigned pk2(float lo, float hi) { return pg8::cvt_pk_bf16(lo, hi); }
__device__ __forceinline__ float bf2f(unsigned short h) { return __uint_as_float((unsigned)h << 16); }
__device__ __forceinline__ float bflo(unsigned w) { return __uint_as_float(w << 16); }
__device__ __forceinline__ float bfhi(unsigned w) { return __uint_as_float(w & 0xffff0000u); }
__device__ __forceinline__ float wave_sum(float v) {
#pragma unroll
    for (int o = 1; o < 64; o <<= 1) v += __shfl_xor(v, o);
    return v;
}

#define XB_TMO      128
#define XB_XCNT(j)  (256  + 64 * (j))
#define XB_XSUB(j)  (1280 + 64 * (j))
#define XB_XGEN(j)  (2304 + 64 * (j))
#define XB_TOP      3328
#define XB_TOPGEN   3392
#define XCD_BAR_WORDS 3456
#define XB_SPIN_CAP (1u << 18)
__device__ __forceinline__ unsigned xb_ld(unsigned* p)              { return __hip_atomic_load(p, __ATOMIC_RELAXED, __HIP_MEMORY_SCOPE_AGENT); }
__device__ __forceinline__ unsigned xb_add(unsigned* p, unsigned v) { return __hip_atomic_fetch_add(p, v, __ATOMIC_RELAXED, __HIP_MEMORY_SCOPE_AGENT); }
__device__ __forceinline__ unsigned xb_xcc_id() { return (unsigned)__builtin_amdgcn_s_getreg((3 << 11) | 20) & 0xFu; }
#define XB_SPIN(cond, bar) do { unsigned _sp = 0; while (cond) { __builtin_amdgcn_s_sleep(1); \
    if ((++_sp & 255u) == 0u) { if (xb_ld(&(bar)[XB_TMO])) break; if (_sp > XB_SPIN_CAP) { atomicAdd(&(bar)[XB_TMO], 1u); break; } } } } while (0)
struct XcdBarrier { unsigned* bar; unsigned x; volatile LAS unsigned* st; };
__device__ __forceinline__ XcdBarrier xcd_barrier_post(unsigned* bar, volatile LAS unsigned* st) {
    XcdBarrier b; b.bar = bar; b.x = xb_xcc_id(); b.st = st;
    if (threadIdx.x == 0) (void)xb_add(&bar[XB_XCNT(b.x)], 1u);
    return b;
}
__device__ __forceinline__ void xcd_barrier_complete(unsigned* bar, unsigned x, unsigned& nloc, unsigned& nx) {
    const unsigned G = gridDim.x * gridDim.y * gridDim.z;
    unsigned sum, cnt, mine, sp = 0u;
    for (;;) {
        sum = 0u; cnt = 0u; mine = 0u;
#pragma unroll
        for (unsigned j = 0; j < 16; ++j) { const unsigned c = xb_ld(&bar[XB_XCNT(j)]); sum += c; cnt += (c > 0u) ? 1u : 0u; mine = (j == x) ? c : mine; }
        if (sum == G) break;
        __builtin_amdgcn_s_sleep(1);
        if ((++sp & 255u) == 0u) { if (xb_ld(&bar[XB_TMO])) break; if (sp > XB_SPIN_CAP) { atomicAdd(&bar[XB_TMO], 1u); break; } }
    }
    nloc = mine > 0u ? mine : 1u; nx = cnt > 0u ? cnt : 1u;
}
__device__ __forceinline__ void xcd_barrier(const XcdBarrier& b) {
    asm volatile("s_waitcnt vmcnt(0)" ::: "memory");
    __syncthreads();
    if (threadIdx.x == 0) {
        unsigned* bar = b.bar;
        __builtin_amdgcn_s_waitcnt(0);
        unsigned nloc = b.st[0], nx = b.st[1];
        if (nloc == 0u) { xcd_barrier_complete(bar, b.x, nloc, nx); b.st[0] = nloc; b.st[1] = nx; }
        const unsigned old = xb_add(&bar[XB_XSUB(b.x)], 1u);
        const unsigned gen = old / nloc;
        if (old + 1u == (gen + 1u) * nloc) {
            __builtin_amdgcn_fence(__ATOMIC_RELEASE, "agent");
            asm volatile("s_waitcnt vmcnt(0)" ::: "memory");
            const unsigned og = xb_add(&bar[XB_TOP], 1u);
            const unsigned tg = og / nx;
            if (og + 1u == (tg + 1u) * nx) xb_add(&bar[XB_TOPGEN], 1u);
            else XB_SPIN(xb_ld(&bar[XB_TOPGEN]) == tg, bar);
            __builtin_amdgcn_fence(__ATOMIC_ACQUIRE, "agent");
            xb_add(&bar[XB_XGEN(b.x)], 1u);
            asm volatile("s_waitcnt vmcnt(0)" ::: "memory");
        } else {
            XB_SPIN(xb_ld(&bar[XB_XGEN(b.x)]) == gen, bar);
            __builtin_amdgcn_fence(__ATOMIC_ACQUIRE, "agent");
            asm volatile("s_waitcnt vmcnt(0)" ::: "memory");
        }
    }
    __syncthreads();
}

constexpr int RING_BYTES = 131072;
constexpr int LDSCTL_OFF = RING_BYTES, MISC_OFF = LDSCTL_OFF + 320;
constexpr int LDS_BYTES = 147456;
constexpr int CW_BAR = 4096;
constexpr int CW_KMAX = 65536;

struct Args { const float* in[22]; float* out; unsigned char* ws; int ph_lo, ph_hi; };
enum { I_X = 0, I_C, I_CTX, I_CCTX, I_WADA, I_BADA, I_NPRE_MIX, I_NPOST_MIX, I_NPRE_FFN, I_NPOST_FFN, I_WIN, I_CONVW, I_LQ1, I_LK1, I_LQ2, I_LK2, I_SUBLN, I_WOUT, I_WROUTER, I_WGATE, I_WUP, I_WDOWN };

__device__ __forceinline__ void prefetch_slice(const unsigned char* base, int bytes_per_wave, LAS unsigned char* scr, int lane) {
    for (int i = 0; i < bytes_per_wave; i += 1024)
        __builtin_amdgcn_global_load_lds((const unsigned*)(base + i + lane * 16), (LAS unsigned*)scr, 16, 0, 0);
}

__device__ __forceinline__ int win_dest(int n) {
    if (n < 1024) { const int j = n & 63; const int p = ((j >> 5) << 5) + ((j & 15) << 1) + ((j >> 4) & 1); return (n & ~63) + p; }
    if (n < 2048) return n;
    int c = n - 2048; const int isx = c >= 512; c &= 511; return 2048 + ((c >> 7) << 8) + (isx << 7) + (c & 127);
}
template <int MODE>
__device__ __forceinline__ int tr_dest(int n) {
    if (MODE == 0) return n;
    if (MODE == 1) return win_dest(n);
    if (MODE == 2) return ((n >> 7) << 8) + (n & 127);
    return ((n >> 7) << 8) + 128 + (n & 127);
}
template <int MODE>
__device__ __forceinline__ void p0_transpose_item(const float* W, int K, int N, bf16_t* WT, LAS float* scr, int item, int lane) {
    const int nblk = N / 32, kb = item / nblk, nb = item % nblk, k0 = 64 * kb, n0 = 32 * nb;
#pragma unroll 8
    for (int i = 0; i < 32; ++i) { const int kk = 2 * i + (lane >> 5); scr[kk * 33 + (lane & 31)] = W[(size_t)(k0 + kk) * N + n0 + (lane & 31)]; }
    LDS_WAIT(); asm volatile("" ::: "memory");
    const int c = lane & 7;
#pragma unroll
    for (int j = 0; j < 4; ++j) { const int n = (lane >> 3) + 8 * j; const LAS float* s = scr + (8 * c) * 33 + n;
        u32x4 o; o.x = pk2(s[0 * 33], s[1 * 33]); o.y = pk2(s[2 * 33], s[3 * 33]); o.z = pk2(s[4 * 33], s[5 * 33]); o.w = pk2(s[6 * 33], s[7 * 33]);
        *(GAS u32x4*)(WT + (size_t)tr_dest<MODE>(n0 + n) * K + k0 + 8 * c) = o; }
    LDS_WAIT(); asm volatile("" ::: "memory");
}

__device__ __forceinline__ void p0_prologue(const Args& a, LAS unsigned char* lds, int vcu, int G) {
    const int tid = opaque_tid(), lane = tid & 63, wave = __builtin_amdgcn_readfirstlane(tid >> 6);
    LAS float* scr = (LAS float*)(lds + wave * 16384);
    const int gw = vcu * NWAVES + wave, NGW = G * NWAVES;
    unsigned char* ws = a.ws;
    {
        float* MODP = (float*)(ws + WS_MODP);
        const float* wada = a.in[I_WADA];
        for (int it = gw; it < 96 * 16; it += NGW) {
            const int cg = it % 96, kc = it / 96;
            for (int b = 0; b < 33; ++b) { const float v = (b < 32) ? a.in[I_C][b * D + kc * 64 + lane] : a.in[I_CCTX][kc * 64 + lane]; scr[b * 64 + lane] = v / (1.f + __expf(-v)); }
            LDS_WAIT(); asm volatile("" ::: "memory");
            float acc[33];
#pragma unroll
            for (int b = 0; b < 33; ++b) acc[b] = 0.f;
            for (int k = 0; k < 64; ++k) {
                const float w = wada[(size_t)(kc * 64 + k) * NMOD + cg * 64 + lane];
#pragma unroll
                for (int b = 0; b < 33; ++b) acc[b] += scr[b * 64 + k] * w;
            }
#pragma unroll
            for (int b = 0; b < 33; ++b) MODP[((size_t)kc * 33 + b) * NMOD + cg * 64 + lane] = acc[b];
            LDS_WAIT(); asm volatile("" ::: "memory");
        }
    }
    {
        float* tab = (float*)(ws + WS_TAB);
        for (int e = gw * 64 + lane; e < T * 32; e += NGW * 64) {
            const int t = e >> 5, i = e & 31;
            const float inv = powf(10000.0f, -(float)(2 * (i & 15)) / 32.0f);
            const float pos = (i < 16) ? (float)(t >> 6) : (float)(t & 63);
            const float ang = pos * inv;
            tab[2 * e] = cosf(ang); tab[2 * e + 1] = sinf(ang);
        }
    }
    constexpr int I_IN = (D / 64) * (NPROJ / 32), I_OUT = (D / 64) * (D / 32);
    constexpr int NITEMS = I_IN + I_OUT;
    bf16_t* Win_t = (bf16_t*)(ws + WS_WIN); bf16_t* Wout_t = (bf16_t*)(ws + WS_WOUT);
    for (int it = gw; it < NITEMS; it += NGW) {
        int r = it;
        if (r < I_IN) { p0_transpose_item<1>(a.in[I_WIN], D, NPROJ, Win_t, scr, r, lane); continue; } r -= I_IN;
        p0_transpose_item<0>(a.in[I_WOUT], D, D, Wout_t, scr, r, lane);
    }
}
__device__ __forceinline__ void expert_weight_copies(const Args& a, LAS unsigned char* lds, int vcu, int G) {
    const int tid = opaque_tid(), lane = tid & 63, wave = __builtin_amdgcn_readfirstlane(tid >> 6);
    LAS float* scr = (LAS float*)(lds + wave * 16384);
    const int gw = vcu * NWAVES + wave, NGW = G * NWAVES;
    unsigned char* ws = a.ws;
    constexpr int I_EXP = (D / 64) * (D / 32);
    bf16_t* Wgu_t = (bf16_t*)(ws + WS_WGU); bf16_t* Wdn_t = (bf16_t*)(ws + WS_WDN);
    for (int r = gw; r < NE * 3 * I_EXP; r += NGW) {
        const int e = r / (3 * I_EXP), q = (r % (3 * I_EXP)) / I_EXP, rr = r % I_EXP;
        if (q == 0) p0_transpose_item<2>(a.in[I_WGATE] + (size_t)e * D * D, D, D, Wgu_t + (size_t)e * 2048 * D, scr, rr, lane);
        else if (q == 1) p0_transpose_item<3>(a.in[I_WUP] + (size_t)e * D * D, D, D, Wgu_t + (size_t)e * 2048 * D, scr, rr, lane);
        else p0_transpose_item<0>(a.in[I_WDOWN] + (size_t)e * D * D, D, D, Wdn_t + (size_t)e * D * D, scr, rr, lane);
    }
    __syncthreads();
}

struct RowF { f32x4 v[4]; };
__device__ __forceinline__ void row_load(RowF& r, const float* xrow, int lane) {
    const f32x4* xr = (const f32x4*)xrow + lane;
#pragma unroll
    for (int j = 0; j < 4; ++j) r.v[j] = __builtin_nontemporal_load(xr + 64 * j);
}
__device__ __forceinline__ void norm_mod_row(const RowF& r, bf16_t* orow, const float* gain, const LAS float* sc, const LAS float* sh, int lane) {
    const f32x4* gr = (const f32x4*)gain + lane;
    float s = 0.f;
#pragma unroll
    for (int j = 0; j < 4; ++j) s += (r.v[j].x * r.v[j].x + r.v[j].y * r.v[j].y) + (r.v[j].z * r.v[j].z + r.v[j].w * r.v[j].w);
    const float rstd = 1.0f / sqrtf(wave_sum(s) * (1.f / D) + EPS);
    u32x2* o8 = (u32x2*)orow + lane;
#pragma unroll
    for (int j = 0; j < 4; ++j) { const f32x4 g = gr[64 * j]; const f32x4 c1 = *(const LAS f32x4*)(sc + 4 * lane + 256 * j), h1 = *(const LAS f32x4*)(sh + 4 * lane + 256 * j);
        const f32x4 y = (r.v[j] * rstd) * g; const f32x4 z = y * (c1 + 1.0f) + h1;
        u32x2 w; w.x = pk2(z.x, z.y); w.y = pk2(z.z, z.w); o8[64 * j] = w; }
}
__device__ __forceinline__ void p1_xn(const Args& a, LAS unsigned char* lds, int c, int G) {
    const int tid = opaque_tid(), lane = tid & 63, wave = __builtin_amdgcn_readfirstlane(tid >> 6);
    unsigned char* ws = a.ws;
    const float* MODP = (const float*)(ws + WS_MODP); float* MOD = (float*)(ws + WS_MOD); const float* bada = a.in[I_BADA];
    for (int r = c; r < 33; r += G)
        for (int n = tid; n < NMOD; n += NTHREADS) { float s = bada[n];
#pragma unroll
            for (int kc = 0; kc < 16; ++kc) s += MODP[((size_t)kc * 33 + r) * NMOD + n];
            MOD[(size_t)r * NMOD + n] = s; }
    LAS float* sv = (LAS float*)lds;
    bf16_t* XN = (bf16_t*)(ws + WS_XN);
    const float* X = a.in[I_X]; const float* CTX = a.in[I_CTX]; const float* gain = a.in[I_NPRE_MIX];
    for (int p = c; p < 256; p += G) {
        const int b = p >> 3;
        const int rbase = p * 256 + wave * 32;
        RowF a0, a1;
        row_load(a0, X + (size_t)rbase * D, lane); row_load(a1, X + (size_t)(rbase + 16) * D, lane);
        __syncthreads();
        for (int n = tid; n < 4096; n += NTHREADS) { const int r = (n < 2048) ? b : 32; const int col = n & 2047; float s = bada[col];
#pragma unroll
            for (int kc = 0; kc < 16; ++kc) s += MODP[((size_t)kc * 33 + r) * NMOD + col];
            sv[n] = s; }
        __syncthreads();
        for (int i = 0; i < 16; ++i) {
            RowF n0, n1;
            if (i + 1 < 16) { row_load(n0, X + (size_t)(rbase + i + 1) * D, lane); row_load(n1, X + (size_t)(rbase + 16 + i + 1) * D, lane); }
            else { const int crow = p * 32 + wave * 4; row_load(n0, CTX + (size_t)crow * D, lane); row_load(n1, CTX + (size_t)(crow + 1) * D, lane); }
            norm_mod_row(a0, XN + (size_t)(rbase + i) * D, gain, sv + 1024, sv, lane);
            norm_mod_row(a1, XN + (size_t)(rbase + 16 + i) * D, gain, sv + 1024, sv, lane);
            a0 = n0; a1 = n1;
        }
        {
            const int crow = p * 32 + wave * 4;
            RowF n0, n1;
            row_load(n0, CTX + (size_t)(crow + 2) * D, lane); row_load(n1, CTX + (size_t)(crow + 3) * D, lane);
            norm_mod_row(a0, XN + (size_t)(M + crow) * D, gain, sv + 3072, sv + 2048, lane);
            norm_mod_row(a1, XN + (size_t)(M + crow + 1) * D, gain, sv + 3072, sv + 2048, lane);
            norm_mod_row(n0, XN + (size_t)(M + crow + 2) * D, gain, sv + 3072, sv + 2048, lane);
            norm_mod_row(n1, XN + (size_t)(M + crow + 3) * D, gain, sv + 3072, sv + 2048, lane);
        }
    }
}

namespace att {
constexpr int KP = 272, KBUF = 64 * KP, VBUF = 16384;
constexpr int OFF_K = 0, OFF_V = 2 * KBUF, OFF_WSF = OFF_V + 2 * VBUF, OFF_END = OFF_WSF + NWAVES * 256;
static_assert(OFF_WSF >= 65536 && OFF_END <= RING_BYTES, "attention LDS map");
constexpr int NT = TK / 64;
constexpr float THR = 8.0f;
__device__ __forceinline__ int crow(int r, int hi) { return (r & 3) + 8 * (r >> 2) + 4 * hi; }
__device__ __forceinline__ float max3f(float a, float b, float c) { float r; asm("v_max3_f32 %0, %1, %2, %3" : "=v"(r) : "v"(a), "v"(b), "v"(c)); return r; }
__device__ __forceinline__ float max2f(float a, float b) { float r; asm("v_max_f32_e32 %0, %1, %2" : "=v"(r) : "v"(a), "v"(b)); return r; }
__device__ __forceinline__ s16x4 vtr(const LAS unsigned char* p) { return __builtin_bit_cast(s16x4, __builtin_amdgcn_ds_read_tr16_b64_v4i16((LAS s16x4*)p)); }

#define ATT_BAR() asm volatile("s_waitcnt lgkmcnt(0)\n\ts_barrier" ::: "memory")
#define ATT_SB() __builtin_amdgcn_sched_barrier(0)
#define ATT_KLD(i, KF) KF = *(const LAS bf16x8*)(kb_ + ((i) & 1) * (32 * KP) + ((i) >> 1) * 32)
#define ATT_XSTEP(i, KC, KN) do { if ((i) + 2 < 8) { ATT_KLD((i) + 2, KN); } \
    if ((i) == 0) p0 = __builtin_amdgcn_mfma_f32_32x32x16_bf16(KC, qr[0], negref, 0, 0, 0); \
    else if ((i) == 1) p1 = __builtin_amdgcn_mfma_f32_32x32x16_bf16(KC, qr[0], negref, 0, 0, 0); \
    else if (((i) & 1) == 0) p0 = __builtin_amdgcn_mfma_f32_32x32x16_bf16(KC, qr[(i) >> 1], p0, 0, 0, 0); else p1 = __builtin_amdgcn_mfma_f32_32x32x16_bf16(KC, qr[(i) >> 1], p1, 0, 0, 0); ATT_SB(); } while (0)
#define ATT_X(kcur) do { \
    const LAS unsigned char* kb_ = lds + OFF_K + (kcur) * KBUF + koff; \
    bf16x8 ka_, kb2_, kc_; \
    ATT_KLD(0, ka_); ATT_KLD(1, kb2_); \
    ATT_SB(); \
    ATT_XSTEP(0, ka_, kc_); ATT_XSTEP(1, kb2_, ka_); ATT_XSTEP(2, kc_, kb2_); ATT_XSTEP(3, ka_, kc_); \
    ATT_XSTEP(4, kb2_, ka_); ATT_XSTEP(5, kc_, kb2_); ATT_XSTEP(6, ka_, kc_); ATT_XSTEP(7, kb2_, ka_); \
} while (0)
#define ATT_EXP2(i, PWN) do { \
    const float e0_ = __builtin_amdgcn_exp2f((i) < 8 ? p0[2 * ((i) & 7)] : p1[2 * ((i) & 7)]), e1_ = __builtin_amdgcn_exp2f((i) < 8 ? p0[2 * ((i) & 7) + 1] : p1[2 * ((i) & 7) + 1]); \
    sacc_ += e0_ + e1_; PWN[(i) >> 2][(i) & 3] = pk2(e0_, e1_); asm volatile("" : "+v"(PWN[(i) >> 2]), "+v"(sacc_)); } while (0)
#define ATT_VLD(i, LO, HI) do { LO = vtr(vb_ + ((i) & 3) * 4096 + ((i) >> 2) * 1024); HI = vtr(vb_ + ((i) & 3) * 4096 + ((i) >> 2) * 1024 + 512); } while (0)
#define ATT_VF(LO, HI) ((bf16x8){LO[0], LO[1], LO[2], LO[3], HI[0], HI[1], HI[2], HI[3]})
#define ATT_YSTEP(i, PWC, PWN, LC, HC, LN, HN) do { if ((i) + 2 < 16) { ATT_VLD((i) + 2, LN, HN); } \
    o[(i) & 3] = __builtin_amdgcn_mfma_f32_32x32x16_bf16(__builtin_bit_cast(bf16x8, PWC[(i) >> 2]), ATT_VF(LC, HC), o[(i) & 3], 0, 0, 0); \
    ATT_EXP2(i, PWN); ATT_SB(); } while (0)
#define ATT_Y(vcur, PWC, PWN) do { \
    const LAS unsigned char* vb_ = lds + OFF_V + (vcur) * VBUF + voff; \
    float sacc_ = 0.f; s16x4 la_, ha_, lb_, hb_, lc_, hc_; \
    ATT_VLD(0, la_, ha_); ATT_VLD(1, lb_, hb_); ATT_SB(); \
    ATT_YSTEP(0, PWC, PWN, la_, ha_, lc_, hc_); ATT_YSTEP(1, PWC, PWN, lb_, hb_, la_, ha_); ATT_YSTEP(2, PWC, PWN, lc_, hc_, lb_, hb_); \
    ATT_YSTEP(3, PWC, PWN, la_, ha_, lc_, hc_); ATT_YSTEP(4, PWC, PWN, lb_, hb_, la_, ha_); ATT_YSTEP(5, PWC, PWN, lc_, hc_, lb_, hb_); \
    ATT_YSTEP(6, PWC, PWN, la_, ha_, lc_, hc_); ATT_YSTEP(7, PWC, PWN, lb_, hb_, la_, ha_); ATT_YSTEP(8, PWC, PWN, lc_, hc_, lb_, hb_); \
    ATT_YSTEP(9, PWC, PWN, la_, ha_, lc_, hc_); ATT_YSTEP(10, PWC, PWN, lb_, hb_, la_, ha_); ATT_YSTEP(11, PWC, PWN, lc_, hc_, lb_, hb_); \
    ATT_YSTEP(12, PWC, PWN, la_, ha_, lc_, hc_); ATT_YSTEP(13, PWC, PWN, lb_, hb_, la_, ha_); ATT_YSTEP(14, PWC, PWN, lc_, hc_, lb_, hb_); \
    ATT_YSTEP(15, PWC, PWN, la_, ha_, lc_, hc_); \
    l_reg += sacc_; \
} while (0)
#define ATT_Y0(PWN) do { float sacc_ = 0.f; _Pragma("unroll") for (int i = 0; i < 16; ++i) ATT_EXP2(i, PWN); l_reg += sacc_; } while (0)
#define ATT_ZSTEP(i, PWC, LC, HC, LN, HN) do { if ((i) + 2 < 16) { ATT_VLD((i) + 2, LN, HN); } \
    o[(i) & 3] = __builtin_amdgcn_mfma_f32_32x32x16_bf16(__builtin_bit_cast(bf16x8, PWC[(i) >> 2]), ATT_VF(LC, HC), o[(i) & 3], 0, 0, 0); ATT_SB(); } while (0)
#define ATT_Z(vcur, PWC) do { \
    const LAS unsigned char* vb_ = lds + OFF_V + (vcur) * VBUF + voff; \
    s16x4 la_, ha_, lb_, hb_, lc_, hc_; \
    ATT_VLD(0, la_, ha_); ATT_VLD(1, lb_, hb_); ATT_SB(); \
    ATT_ZSTEP(0, PWC, la_, ha_, lc_, hc_); ATT_ZSTEP(1, PWC, lb_, hb_, la_, ha_); ATT_ZSTEP(2, PWC, lc_, hc_, lb_, hb_); \
    ATT_ZSTEP(3, PWC, la_, ha_, lc_, hc_); ATT_ZSTEP(4, PWC, lb_, hb_, la_, ha_); ATT_ZSTEP(5, PWC, lc_, hc_, lb_, hb_); \
    ATT_ZSTEP(6, PWC, la_, ha_, lc_, hc_); ATT_ZSTEP(7, PWC, lb_, hb_, la_, ha_); ATT_ZSTEP(8, PWC, lc_, hc_, lb_, hb_); \
    ATT_ZSTEP(9, PWC, la_, ha_, lc_, hc_); ATT_ZSTEP(10, PWC, lb_, hb_, la_, ha_); ATT_ZSTEP(11, PWC, lc_, hc_, lb_, hb_); \
    ATT_ZSTEP(12, PWC, la_, ha_, lc_, hc_); ATT_ZSTEP(13, PWC, lb_, hb_, la_, ha_); ATT_ZSTEP(14, PWC, lc_, hc_, lb_, hb_); \
    ATT_ZSTEP(15, PWC, la_, ha_, lc_, hc_); \
} while (0)
#define ATT_STAGE(j) do { \
    if ((j) + 1 < NT) { _Pragma("unroll") for (int i = 0; i < 2; ++i) *(LAS u32x4*)(lds + OFF_K + (((j) + 1) & 1) * KBUF + kdst[i]) = kr[i]; } \
    _Pragma("unroll") for (int i = 0; i < 2; ++i) *(LAS u32x4*)(lds + OFF_V + ((j) & 1) * VBUF + vdst[i]) = vr[i]; \
    if ((j) + 2 < NT) { _Pragma("unroll") for (int i = 0; i < 2; ++i) kr[i] = *(const u32x4*)(Kb + (size_t)((j) + 2) * 64 * 512 + gsrc[i]); } \
    if ((j) + 1 < NT) { _Pragma("unroll") for (int i = 0; i < 2; ++i) vr[i] = *(const u32x4*)(Vb + (size_t)((j) + 1) * 64 * 512 + gsrc[i]); } } while (0)

__device__ __forceinline__ void unit(LAS unsigned char* lds, int b, int h, int qb, const bf16_t* Q, const bf16_t* KA, const bf16_t* VA, bf16_t* MIXIN, const float* subg, float lam, const unsigned* KM) {
    const int tid = opaque_tid(), lane = tid & 63, r32 = lane & 31, hi = lane >> 5;
    const int wid = __builtin_amdgcn_readfirstlane(tid >> 6), w = wid & 3, m = wid >> 2;
    LAS float* wsf = (LAS float*)(lds + OFF_WSF) + wid * 64;
    const int rowQ = b * T + qb * 128 + w * 32;
    bf16x8 qr[4];
#pragma unroll
    for (int d0 = 0; d0 < 4; ++d0) qr[d0] = *(const bf16x8*)(Q + (size_t)(rowQ + r32) * 512 + h * 128 + m * 64 + d0 * 16 + hi * 8);
    const bf16_t* Kb = KA + (size_t)b * TK * 512 + h * 128; const bf16_t* Vb = VA + (size_t)b * TK * 512 + h * 128;
    int gsrc[2], kdst[2], vdst[2];
#pragma unroll
    for (int i = 0; i < 2; ++i) { const int cid = tid + 512 * i, kv = cid >> 4, c16 = cid & 15;
        gsrc[i] = kv * 512 + c16 * 8; kdst[i] = kv * KP + c16 * 16; vdst[i] = (c16 >> 2) * 4096 + (kv >> 4) * 1024 + (kv & 15) * 64 + (c16 & 3) * 16; }
    u32x4 kr[2], vr[2];
#pragma unroll
    for (int i = 0; i < 2; ++i) { kr[i] = *(const u32x4*)(Kb + gsrc[i]); vr[i] = *(const u32x4*)(Vb + gsrc[i]); }
#pragma unroll
    for (int i = 0; i < 2; ++i) *(LAS u32x4*)(lds + OFF_K + kdst[i]) = kr[i];
#pragma unroll
    for (int i = 0; i < 2; ++i) kr[i] = *(const u32x4*)(Kb + (size_t)64 * 512 + gsrc[i]);
    ATT_BAR();
    f32x16 o[4];
#pragma unroll
    for (int d0 = 0; d0 < 4; ++d0) o[d0] = (f32x16){};
    float l_reg = 0.f;
    f32x16 p0, p1, negref;
    {
        const unsigned* km = KM + (b * 8 + h * 2 + m) * 2;
        const float kmax2 = __uint_as_float(km[0]) + __uint_as_float(km[1]);
        float ss = 0.f;
#pragma unroll
        for (int d0 = 0; d0 < 4; ++d0)
#pragma unroll
            for (int i = 0; i < 8; ++i) { const float v = bf2f((unsigned short)qr[d0][i]); ss += v * v; }
        ss += __shfl_xor(ss, 32);
        const float ref = sqrtf(ss * kmax2) * 1.02f;
#pragma unroll
        for (int r = 0; r < 16; ++r) negref[r] = -ref;
    }
    u32x4 pwA[4], pwB[4];
    const int koff = r32 * KP + m * 128 + hi * 16;
    const int voff = ((lane >> 4) & 1) * 32 + (lane & 3) * 8 + (4 * hi + ((lane & 15) >> 2)) * 64;
    ATT_X(0); ATT_STAGE(0); ATT_Y0(pwA); ATT_BAR();
    ATT_X(1); ATT_STAGE(1); ATT_Y(0, pwA, pwB); ATT_BAR();
    for (int j = 2; j < NT; j += 2) {
        ATT_X(0); ATT_STAGE(j); ATT_Y(1, pwB, pwA); ATT_BAR();
        ATT_X(1); ATT_STAGE(j + 1); ATT_Y(0, pwA, pwB); ATT_BAR();
    }
    ATT_Z(1, pwB); ATT_BAR();
    l_reg += __shfl_xor(l_reg, 32);
    if (hi == 0) wsf[32 + r32] = l_reg;
    LDS_WAIT();
    float rli[16];
#pragma unroll
    for (int r = 0; r < 16; ++r) rli[r] = 1.0f / wsf[32 + crow(r, hi)];
    LDS_WAIT();
    LAS float* ex = (LAS float*)lds + w * 4096;
    if (m == 1) {
#pragma unroll
        for (int r = 0; r < 16; ++r)
#pragma unroll
            for (int d0 = 0; d0 < 4; ++d0) ex[crow(r, hi) * 128 + d0 * 32 + r32] = o[d0][r] * rli[r];
    }
    ATT_BAR();
    if (m == 0) {
        float g4[4];
#pragma unroll
        for (int d0 = 0; d0 < 4; ++d0) g4[d0] = subg[d0 * 32 + r32] * (1.0f - LAM_INIT);
#pragma unroll
        for (int r = 0; r < 16; ++r) {
            const int q = crow(r, hi); float x[4]; float ss = 0.f;
#pragma unroll
            for (int d0 = 0; d0 < 4; ++d0) { x[d0] = o[d0][r] * rli[r] - lam * ex[q * 128 + d0 * 32 + r32]; ss += x[d0] * x[d0]; }
#pragma unroll
            for (int off = 1; off < 32; off <<= 1) ss += __shfl_xor(ss, off);
            const float rstd = 1.0f / sqrtf(ss * (1.f / 128.f) + EPS);
            bf16_t* dst = MIXIN + (size_t)(rowQ + q) * 1024 + h * 128 + r32;
#pragma unroll
            for (int d0 = 0; d0 < 4; ++d0) dst[d0 * 32] = (bf16_t)(pk2(x[d0] * rstd * g4[d0], 0.f) & 0xffffu);
        }
    }
    ATT_BAR();
}
#undef ATT_BAR
#undef ATT_X
#undef ATT_EXP2
#undef ATT_Y
#undef ATT_Y0
#undef ATT_Z
#undef ATT_STAGE
#undef ATT_SB
#undef ATT_KLD
#undef ATT_XSTEP
#undef ATT_VLD
#undef ATT_VF
#undef ATT_YSTEP
#undef ATT_ZSTEP
}

__device__ __forceinline__ void p3_conv_attn(const Args& a, LAS unsigned char* lds, int c, int vcu, int G) {
    const int tid = opaque_tid(), lane = tid & 63, wave = __builtin_amdgcn_readfirstlane(tid >> 6);
    unsigned char* ws = a.ws;
    const bf16_t* GB = (const bf16_t*)(ws + WS_GB); const bf16_t* U = (const bf16_t*)(ws + WS_U); bf16_t* MIXIN = (bf16_t*)(ws + WS_MIXIN);
    {
        const float* cw = a.in[I_CONVW]; float w0[8], w1[8], w2[8];
#pragma unroll
        for (int i = 0; i < 8; ++i) { w0[i] = cw[lane * 8 + i]; w1[i] = cw[512 + lane * 8 + i]; w2[i] = cw[1024 + lane * 8 + i]; }
        const int gw = vcu * NWAVES + wave, NGW = G * NWAVES;
        for (int row = gw; row < M; row += NGW) {
            const int t = row & (T - 1);
            const u32x4 z = {0u, 0u, 0u, 0u};
            const u32x4 uc = *(const u32x4*)(U + (size_t)row * 512 + lane * 8);
            const u32x4 up = (t > 0) ? *(const u32x4*)(U + (size_t)(row - 1) * 512 + lane * 8) : z;
            const u32x4 un = (t < T - 1) ? *(const u32x4*)(U + (size_t)(row + 1) * 512 + lane * 8) : z;
            const u32x4 gb = *(const u32x4*)(GB + (size_t)row * 512 + lane * 8);
            u32x4 o;
#pragma unroll
            for (int q = 0; q < 4; ++q) {
                const float y0 = w0[2 * q] * bflo(up[q]) + w1[2 * q] * bflo(uc[q]) + w2[2 * q] * bflo(un[q]);
                const float y1 = w0[2 * q + 1] * bfhi(up[q]) + w1[2 * q + 1] * bfhi(uc[q]) + w2[2 * q + 1] * bfhi(un[q]);
                o[q] = pk2(bflo(gb[q]) * y0, bfhi(gb[q]) * y1);
            }
            *(u32x4*)(MIXIN + (size_t)row * 1024 + 512 + lane * 8) = o;
        }
    }
    float lam;
    { const float p1 = a.in[I_LQ1][lane] * a.in[I_LK1][lane], p2 = a.in[I_LQ2][lane] * a.in[I_LK2][lane];
      lam = __expf(wave_sum(p1)) - __expf(wave_sum(p2)) + LAM_INIT; }
    const bf16_t* Q = (const bf16_t*)(ws + WS_Q); const bf16_t* KA = (const bf16_t*)(ws + WS_K); const bf16_t* VA = (const bf16_t*)(ws + WS_V);
    __syncthreads();
    for (int u = vcu * 8; u < 2048; u += G * 8) {
        const int x = (u >> 3) / 32, jj = (u >> 3) % 32;
        for (int i = 0; i < 8; ++i) {
            const int bh = 16 * x + 2 * i + (jj >> 4), qb = jj & 15;
            att::unit(lds, bh >> 2, bh & 3, qb, Q, KA, VA, MIXIN, a.in[I_SUBLN], lam, (const unsigned*)(ws + WS_CTL) + CW_KMAX);
        }
    }
}

struct P5In { f32x4 x[4]; u32x2 m[4]; };
__device__ __forceinline__ void p5_load(P5In& r, int row, int lane, const float* X, const bf16_t* MIX) {
    const f32x4* xr = (const f32x4*)(X + (size_t)row * D) + lane; const u32x2* mr = (const u32x2*)(MIX + (size_t)row * D) + lane;
#pragma unroll
    for (int j = 0; j < 4; ++j) { r.x[j] = __builtin_nontemporal_load(xr + 64 * j); r.m[j] = __builtin_nontemporal_load(mr + 64 * j); }
}
__device__ __forceinline__ float p5_resid(const P5In& r, f32x4 (&h)[4], int row, int lane, const LAS float* mv, const f32x4* npm, bf16_t* H1) {
    f32x4 mx[4]; float s = 0.f;
#pragma unroll
    for (int j = 0; j < 4; ++j) { const u32x2 wv = r.m[j]; mx[j] = (f32x4){bflo(wv.x), bfhi(wv.x), bflo(wv.y), bfhi(wv.y)};
        s += (mx[j].x * mx[j].x + mx[j].y * mx[j].y) + (mx[j].z * mx[j].z + mx[j].w * mx[j].w); }
    const float rstd1 = 1.0f / sqrtf(wave_sum(s) * (1.f / D) + EPS);
    u32x2* hr = (u32x2*)(H1 + (size_t)row * D) + lane; float s2 = 0.f;
#pragma unroll
    for (int j = 0; j < 4; ++j) { const f32x4 g1 = *(const LAS f32x4*)(mv + 4 * lane + 256 * j);
        h[j] = r.x[j] + g1 * ((mx[j] * rstd1) * npm[64 * j]);
        u32x2 wv; wv.x = pk2(h[j].x, h[j].y); wv.y = pk2(h[j].z, h[j].w); __builtin_nontemporal_store(wv, hr + 64 * j);
        s2 += (h[j].x * h[j].x + h[j].y * h[j].y) + (h[j].z * h[j].z + h[j].w * h[j].w); }
    return 1.0f / sqrtf(wave_sum(s2) * (1.f / D) + EPS);
}
__device__ __forceinline__ void p5_rows(const Args& a, LAS unsigned char* lds, int p  ) {
    const int tid = opaque_tid(), lane = tid & 63, wave = __builtin_amdgcn_readfirstlane(tid >> 6);
    unsigned char* ws = a.ws;
    const int b = p >> 3;
    LAS float* wrt = (LAS float*)lds;
    LAS float* mv = (LAS float*)(lds + 65536);
    const float* wr = a.in[I_WROUTER];
    const bf16_t* MIX = (const bf16_t*)(ws + WS_MIX); bf16_t* XN2 = (bf16_t*)(ws + WS_XN); float* AFFT = (float*)(ws + WS_AFFT); bf16_t* H1 = (bf16_t*)(ws + WS_H1);
    const float* X = a.in[I_X];
    const int rbase = p * 256 + wave * 32;
    P5In cA, cB;
    p5_load(cA, rbase, lane, X, MIX); p5_load(cB, rbase + 16, lane, X, MIX);
    for (int n = tid; n < D * NE; n += NTHREADS) { const int k = n >> 4, e = n & 15; wrt[e * D + k] = wr[n]; }
    const float* MOD = (const float*)(ws + WS_MOD) + (size_t)b * NMOD;
    for (int n = tid; n < 3 * D; n += NTHREADS) mv[n] = MOD[2 * D + n];
    __syncthreads();
    const f32x4* npm = (const f32x4*)a.in[I_NPOST_MIX] + lane; const f32x4* npf = (const f32x4*)a.in[I_NPRE_FFN] + lane;
    for (int i = 0; i < 16; ++i) {
        const int rowA = rbase + i, rowB = rbase + 16 + i;
        P5In nA, nB;
        if (i + 1 < 16) { p5_load(nA, rowA + 1, lane, X, MIX); p5_load(nB, rowB + 1, lane, X, MIX); }
        f32x4 hA[4], hB[4];
        const float rsA = p5_resid(cA, hA, rowA, lane, mv, npm, H1);
        const float rsB = p5_resid(cB, hB, rowB, lane, mv, npm, H1);
        u32x2* oA = (u32x2*)(XN2 + (size_t)rowA * D) + lane; u32x2* oB = (u32x2*)(XN2 + (size_t)rowB * D) + lane;
        float lg[32];
#pragma unroll
        for (int e = 0; e < 32; ++e) lg[e] = 0.f;
#pragma unroll
        for (int j = 0; j < 4; ++j) { const f32x4 sh2 = *(const LAS f32x4*)(mv + 1024 + 4 * lane + 256 * j), sc2 = *(const LAS f32x4*)(mv + 2048 + 4 * lane + 256 * j);
            const f32x4 gn = npf[64 * j];
            const f32x4 zA = ((hA[j] * rsA) * gn) * (sc2 + 1.0f) + sh2, zB = ((hB[j] * rsB) * gn) * (sc2 + 1.0f) + sh2;
            u32x2 wv; wv.x = pk2(zA.x, zA.y); wv.y = pk2(zA.z, zA.w); oA[64 * j] = wv; wv.x = pk2(zB.x, zB.y); wv.y = pk2(zB.z, zB.w); oB[64 * j] = wv;
#pragma unroll
            for (int e = 0; e < 16; ++e) { const f32x4 wq = *(const LAS f32x4*)(wrt + e * D + 4 * lane + 256 * j);
                lg[e] += (zA.x * wq.x + zA.y * wq.y) + (zA.z * wq.z + zA.w * wq.w); lg[16 + e] += (zB.x * wq.x + zB.y * wq.y) + (zB.z * wq.z + zB.w * wq.w);
                if ((e & 3) == 3) __builtin_amdgcn_sched_barrier(0); } }
#pragma unroll
        for (int st = 0; st < 5; ++st) { const int d = 1 << st, cntv = 16 >> st; const bool up = (lane & d) != 0;
#pragma unroll
            for (int q = 0; q < 16; ++q) if (q < cntv) { const float send = up ? lg[2 * q] : lg[2 * q + 1], keep = up ? lg[2 * q + 1] : lg[2 * q]; lg[q] = keep + __shfl_xor(send, d); } }
        float lv = lg[0] + __shfl_xor(lg[0], 32);
        float mxl = lv;
#pragma unroll
        for (int d = 1; d < 16; d <<= 1) mxl = fmaxf(mxl, __shfl_xor(mxl, d));
        const float ev = __expf(lv - mxl); float se = ev;
#pragma unroll
        for (int d = 1; d < 16; d <<= 1) se += __shfl_xor(se, d);
        if (lane < 32) { const int row = (lane < 16) ? rowA : rowB; AFFT[((size_t)b * NE + (lane & 15)) * T + (row & (T - 1))] = ev / se; }
        cA = nA; cB = nB;
    }
}

__device__ __forceinline__ void p6_topk(const Args& a, LAS unsigned char* lds, int c, int G) {
    const int tid = opaque_tid(), lane = tid & 63, wave = __builtin_amdgcn_readfirstlane(tid >> 6);
    unsigned char* ws = a.ws;
    const float* AFFT = (const float*)(ws + WS_AFFT); short* SLOT = (short*)(ws + WS_SLOT); int* IDX = (int*)(ws + WS_IDX); float* GATE = (float*)(ws + WS_GATE);
    LAS unsigned* sv = (LAS unsigned*)(lds + wave * 16384);
    for (int item = c + wave * G; item < NITEM; item += G * NWAVES) {
        const int b = item >> 4, e = item & 15;
        const float* src = AFFT + (size_t)item * T;
#pragma unroll 8
        for (int j = 0; j < 32; ++j) sv[j * 64 + lane] = __float_as_uint(src[j * 64 + lane]);
        LDS_WAIT(); asm volatile("" ::: "memory");
        unsigned pre = 0u;
        for (int bit = 30; bit >= 0; --bit) {
            const unsigned cand = pre | (1u << bit);
            int cnt = 0;
#pragma unroll 4
            for (int j = 0; j < 32; ++j) cnt += (int)__popcll(__ballot(sv[j * 64 + lane] >= cand));
            if (cnt >= CAP) pre = cand;
        }
        int ngt = 0;
#pragma unroll 4
        for (int j = 0; j < 32; ++j) ngt += (int)__popcll(__ballot(sv[j * 64 + lane] > pre));
        const int need_eq = CAP - ngt;
        const unsigned long long ltmask = (1ull << lane) - 1ull;
        int base_gt = 0, base_eq = 0;
#pragma unroll 2
        for (int j = 0; j < 32; ++j) {
            const unsigned vj = sv[j * 64 + lane];
            const bool gt = vj > pre, eq = vj == pre;
            const unsigned long long mg = __ballot(gt), me = __ballot(eq);
            const int pg = base_gt + (int)__popcll(mg & ltmask), pe = base_eq + (int)__popcll(me & ltmask);
            int sl = -1; if (gt) sl = pg; else if (eq && pe < need_eq) sl = ngt + pe;
            const int t = j * 64 + lane;
            SLOT[((size_t)b * T + t) * NE + e] = (short)sl;
            if (sl >= 0) { IDX[item * CAP + sl] = t; GATE[item * CAP + sl] = __uint_as_float(vj); }
            base_gt += (int)__popcll(mg); base_eq += (int)__popcll(me);
        }
        LDS_WAIT(); asm volatile("" ::: "memory");
    }
}

struct P8Row { u32x2 h[4]; u32x2 y[4][4]; float wt[4]; unsigned long long rest; int sl; };
__device__ __forceinline__ void p8_issue(P8Row& r, int row, int lane, const short* SLOT, const bf16_t* Y, const bf16_t* H1) {
    const int b = row >> 11;
    const int s_e = (lane < NE) ? (int)SLOT[(size_t)row * NE + lane] : -1;
    unsigned long long mask = __ballot(s_e >= 0);
    const u32x2* hr = (const u32x2*)(H1 + (size_t)row * D) + lane;
#pragma unroll
    for (int j = 0; j < 4; ++j) r.h[j] = __builtin_nontemporal_load(hr + 64 * j);
#pragma unroll
    for (int q = 0; q < 4; ++q) {
        int e = 0, s = 0; r.wt[q] = 0.f;
        if (mask) { e = (int)__builtin_ctzll(mask); mask &= mask - 1ull; s = __builtin_amdgcn_readlane(s_e, e); r.wt[q] = 1.f; }
        const u32x2* yr = (const u32x2*)(Y + ((size_t)(b * NE + e) * CAP + s) * D) + lane;
#pragma unroll
        for (int j = 0; j < 4; ++j) r.y[q][j] = __builtin_nontemporal_load(yr + 64 * j);
    }
    r.rest = mask; r.sl = s_e;
}
__device__ __forceinline__ void p8_finish(P8Row& r, int row, int lane, const bf16_t* Y, const float* MOD, const f32x4* npo, float* out) {
    const int b = row >> 11;
    f32x4 ff[4];
#pragma unroll
    for (int j = 0; j < 4; ++j) ff[j] = (f32x4){0.f, 0.f, 0.f, 0.f};
#pragma unroll
    for (int q = 0; q < 4; ++q)
#pragma unroll
        for (int j = 0; j < 4; ++j) { const u32x2 wv = r.y[q][j]; ff[j] += (f32x4){bflo(wv.x), bfhi(wv.x), bflo(wv.y), bfhi(wv.y)} * r.wt[q]; }
    unsigned long long mask = r.rest;
    while (mask) {
        const int e = (int)__builtin_ctzll(mask); mask &= mask - 1ull; const int s = __builtin_amdgcn_readlane(r.sl, e);
        const u32x2* yr = (const u32x2*)(Y + ((size_t)(b * NE + e) * CAP + s) * D) + lane;
#pragma unroll
        for (int j = 0; j < 4; ++j) { const u32x2 wv = yr[64 * j]; ff[j] += (f32x4){bflo(wv.x), bfhi(wv.x), bflo(wv.y), bfhi(wv.y)}; }
    }
    float s2 = 0.f;
#pragma unroll
    for (int j = 0; j < 4; ++j) s2 += (ff[j].x * ff[j].x + ff[j].y * ff[j].y) + (ff[j].z * ff[j].z + ff[j].w * ff[j].w);
    const float rstd = 1.0f / sqrtf(wave_sum(s2) * (1.f / D) + EPS);
    f32x4* orow = (f32x4*)(out + (size_t)row * D) + lane; const f32x4* g2 = (const f32x4*)(MOD + (size_t)b * NMOD + 5 * D) + lane;
#pragma unroll
    for (int j = 0; j < 4; ++j) { const u32x2 hv = r.h[j]; const f32x4 h = (f32x4){bflo(hv.x), bfhi(hv.x), bflo(hv.y), bfhi(hv.y)};
        __builtin_nontemporal_store(h + g2[64 * j] * ((ff[j] * rstd) * npo[64 * j]), orow + 64 * j); }
}
__device__ __forceinline__ void p8_final(const Args& a, int vcu, int G) {
    const int tid = opaque_tid(), lane = tid & 63, wave = __builtin_amdgcn_readfirstlane(tid >> 6);
    unsigned char* ws = a.ws;
    const short* SLOT = (const short*)(ws + WS_SLOT); const bf16_t* Y = (const bf16_t*)(ws + WS_Y); const float* MOD = (const float*)(ws + WS_MOD); const bf16_t* H1 = (const bf16_t*)(ws + WS_H1);
    const f32x4* npo = (const f32x4*)a.in[I_NPOST_FFN] + lane;
    const int gw = vcu * NWAVES + wave, NGW = G * NWAVES;
    for (int row = gw; row < M; row += 2 * NGW) {
        P8Row r0, r1;
        p8_issue(r0, row, lane, SLOT, Y, H1);
        const bool two = row + NGW < M;
        if (two) p8_issue(r1, row + NGW, lane, SLOT, Y, H1);
        p8_finish(r0, row, lane, Y, MOD, npo, a.out);
        if (two) p8_finish(r1, row + NGW, lane, Y, MOD, npo, a.out);
    }
}

__global__ void __launch_bounds__(NTHREADS, 2) fwd_kernel(Args args) {
    extern __shared__ __attribute__((aligned(16))) unsigned char lds_raw[];
    LAS unsigned char* lds = (LAS unsigned char*)lds_raw;
    volatile LAS unsigned* MISC = (volatile LAS unsigned*)(lds + MISC_OFF);
    const int tid = threadIdx.x;
    const int G = gridDim.x, c = blockIdx.x;
    const int vcu = (G % 8 == 0) ? (c % 8) * (G / 8) + c / 8 : c;
    unsigned char* ws = args.ws;
    gu32* ctl = (gu32*)(ws + WS_CTL);
    for (int u = tid; u < (LDS_BYTES - LDSCTL_OFF) / 4; u += NTHREADS) ((LAS unsigned*)(lds + LDSCTL_OFF))[u] = 0u;
    __syncthreads();
    XcdBarrier bar; bar.bar = (unsigned*)(ctl + CW_BAR); bar.x = 0; bar.st = nullptr;
    const int lo = args.ph_lo, hi = args.ph_hi;
    if (hi - lo > 1) bar = xcd_barrier_post((unsigned*)(ctl + CW_BAR), MISC + 8);
#ifndef PHMASK
#define PHMASK 0xff
#endif
#define IN(k) (((PHMASK >> (k)) & 1) && lo <= (k) && (k) < hi)
#define SEAM(k) do { if (IN(k) && IN((k) + 1)) xcd_barrier(bar); } while (0)
#ifndef PROBE_PHASE
#define PROBE_PHASE -1
#endif
#define PB(k) do { if (PROBE_PHASE == (k)) { if (tid == 0) { const unsigned long long t0_ = __builtin_amdgcn_s_memrealtime(); MISC[16] = (unsigned)t0_; MISC[17] = (unsigned)(t0_ >> 32); } } } while (0)
#define PE(k) do { if (PROBE_PHASE == (k)) { if (tid == 0) { const unsigned long long t0_ = ((unsigned long long)MISC[17] << 32) | MISC[16]; const unsigned long long t1_ = __builtin_amdgcn_s_memrealtime(); \
      while (__builtin_amdgcn_s_memrealtime() - t1_ < t1_ - t0_) __builtin_amdgcn_s_sleep(8); } __syncthreads(); } } while (0)

    PB(0); if (IN(0)) { p0_prologue(args, lds, vcu, G); } SEAM(0); PE(0);
    PB(1); if (IN(1)) { p1_xn(args, lds, c, G); } SEAM(1); PE(1);
    PB(2); if (IN(2)) {
        pg8::Gemm g{(const bf16_t*)(ws + WS_XN), (const bf16_t*)(ws + WS_WIN), D, nullptr};
        pg8::SchedProj S{G, c};
        pg8::EpiProj E{(bf16_t*)(ws + WS_Q), (bf16_t*)(ws + WS_K), (bf16_t*)(ws + WS_V), (bf16_t*)(ws + WS_GB), (bf16_t*)(ws + WS_U), (const float*)(ws + WS_TAB), (unsigned*)(ws + WS_CTL) + CW_KMAX};
        pg8::gemm_phase<pg8::EpiProj, pg8::SchedProj, true, true>(lds, g, S, E);
    } SEAM(2); PE(2);
    PB(3); if (IN(3)) { if (c & 1) expert_weight_copies(args, lds, vcu, G); p3_conv_attn(args, lds, c, vcu, G); if (!(c & 1)) expert_weight_copies(args, lds, vcu, G); } SEAM(3); PE(3);
    PB(4); if (IN(4)) {
        {
            const int p = c;
#ifndef NO_P4
            pg8::Gemm g{(const bf16_t*)(ws + WS_MIXIN), (const bf16_t*)(ws + WS_WOUT), D, nullptr};
            pg8::SchedPanel S{p, 4};
            pg8::EpiBf16 E{(bf16_t*)(ws + WS_MIX), D};
            pg8::gemm_phase<pg8::EpiBf16, pg8::SchedPanel, true, true>(lds, g, S, E);
#endif
            VM_WAIT(); __syncthreads();
#ifndef NO_P5
            p5_rows(args, lds, p);
#endif
            __syncthreads();
        }
    } SEAM(4); PE(4);
    PB(5); if (IN(5)) { p6_topk(args, lds, c, G); } SEAM(5); PE(5);
    PB(6); if (IN(6)) {
#pragma unroll 1
        for (int it = 0; it < 2; ++it) {
            {
                const int item = 2 * c + it;
                const int b = item >> 4, e = item & 15;
                {
                    const int lane_ = opaque_tid() & 63, wave_ = __builtin_amdgcn_readfirstlane(opaque_tid() >> 6), j_ = (c >> 3) & 31;
                    LAS unsigned char* scr_ = lds + LDSCTL_OFF + 2048 + wave_ * 1024;
                    prefetch_slice(ws + WS_WGU + (size_t)e * 2048 * D * 2 + (size_t)j_ * 131072 + wave_ * 16384, 16384, scr_, lane_);
                    prefetch_slice(ws + WS_WDN + (size_t)e * D * D * 2 + (size_t)j_ * 65536 + wave_ * 8192, 8192, scr_, lane_);
                }
#ifndef NO_G1
                if (it == 0) PB(8);
                {
                    pg8::Gemm g{(const bf16_t*)(ws + WS_XN) + (size_t)b * T * D, (const bf16_t*)(ws + WS_WGU) + (size_t)e * 2048 * D, D, (const int*)(ws + WS_IDX) + item * CAP};
                    pg8::SchedPanel S{0, 8};
                    pg8::EpiGU E{(bf16_t*)(ws + WS_HMID) + (size_t)item * CAP * D};
                    pg8::gemm_phase<pg8::EpiGU, pg8::SchedPanel, true, true, true>(lds, g, S, E);
                }
#endif
                VM_WAIT(); __syncthreads();
                if (it == 0) { PE(8); PB(9); }
#ifndef NO_G2
                {
                    pg8::Gemm g{(const bf16_t*)(ws + WS_HMID) + (size_t)item * CAP * D, (const bf16_t*)(ws + WS_WDN) + (size_t)e * D * D, D, nullptr};
                    pg8::SchedPanel S{0, 4};
                    pg8::EpiDown E{(bf16_t*)(ws + WS_Y) + (size_t)item * CAP * D, (const float*)(ws + WS_GATE) + item * CAP};
                    pg8::gemm_phase<pg8::EpiDown, pg8::SchedPanel, true, true>(lds, g, S, E);
                }
#endif
                VM_WAIT(); __syncthreads();
                if (it == 0) PE(9);
            }
        }
    } SEAM(6); PE(6);
    PB(7); if (IN(7)) { p8_final(args, vcu, G); } PE(7);
#undef IN
#undef SEAM
}

extern "C" void kernel_launch(void* const* d_in, const int* in_sizes, int n_in, void* d_out, int out_size, void* d_ws, size_t ws_size, hipStream_t stream) {
    static int grid = 0;
    if (grid == 0) {
        if (n_in != 22 || in_sizes[0] != M * D || out_size != M * D || ws_size < WS_END) { fprintf(stderr, "kernel_launch: unexpected shapes (n_in %d, in0 %d, out %d, ws %zu)\n", n_in, n_in > 0 ? in_sizes[0] : -1, out_size, ws_size); grid = -1; return; }
        int dev = 0, cus = 0;
        if (hipGetDevice(&dev) != hipSuccess || hipDeviceGetAttribute(&cus, hipDeviceAttributeMultiprocessorCount, dev) != hipSuccess) { grid = -1; return; }
        if (hipFuncSetAttribute((const void*)fwd_kernel, hipFuncAttributeMaxDynamicSharedMemorySize, LDS_BYTES) != hipSuccess) { fprintf(stderr, "kernel_launch: hipFuncSetAttribute failed\n"); grid = -1; return; }
        (void)hipGetLastError();
        grid = cus;
        if (grid != 256) { fprintf(stderr, "kernel_launch: this kernel needs a 256-CU device (got %d)\n", cus); grid = -1; return; }
    }
    if (grid < 0) return;
    (void)hipMemsetAsync((char*)d_ws + WS_CTL, 0, CTL_ZERO_BYTES, stream);
    Args a{};
    for (int i = 0; i < 22; ++i) a.in[i] = (const float*)d_in[i];
    a.out = (float*)d_out; a.ws = (unsigned char*)d_ws;
    constexpr int NPH = 8;
    if (MK_N_LAUNCHES == 1) { a.ph_lo = 0; a.ph_hi = NPH; hipLaunchKernelGGL(fwd_kernel, dim3(grid), dim3(NTHREADS), LDS_BYTES, stream, a); }
    else { for (int k = 0; k < NPH; ++k) { a.ph_lo = k; a.ph_hi = k + 1; hipLaunchKernelGGL(fwd_kernel, dim3(grid), dim3(NTHREADS), LDS_BYTES, stream, a); } }
}
```

```cpp
#include <hip/hip_runtime.h>
#include <cstdio>
#include <cstdint>

#ifndef MK_N_LAUNCHES
#define MK_N_LAUNCHES 1
#endif

#define LAS __attribute__((address_space(3)))
#define GAS __attribute__((address_space(1)))
typedef unsigned short bf16_t;
typedef short bf16x8 __attribute__((ext_vector_type(8)));
typedef short s16x4 __attribute__((ext_vector_type(4)));
typedef float f32x4 __attribute__((ext_vector_type(4)));
typedef float f32x16 __attribute__((ext_vector_type(16)));
typedef unsigned u32x4 __attribute__((ext_vector_type(4)));
typedef unsigned u32x2 __attribute__((ext_vector_type(2)));

constexpr int NB = 32, T = 2048, D = 1024, TC = 256, M = NB * T, MC = NB * TC, MA = M + MC, TK = TC + T;
constexpr int NE = 16, CAP = 256, NITEM = NB * NE, NPROJ = 3072, NMOD = 6 * D;
constexpr float EPS = 1e-6f;
constexpr float C2 = 0.125f * 1.4426950408889634f;
constexpr float LAM_INIT = 0.2f;
constexpr int NWAVES = 8, NTHREADS = 512;

constexpr size_t MiB = 1u << 20;
constexpr size_t WS_CTL = 0, CTL_ZERO_BYTES = 1 * MiB;
constexpr size_t WS_MODP = 2 * MiB;
constexpr size_t WS_MOD = 16 * MiB;
constexpr size_t WS_TAB = 17 * MiB;
constexpr size_t WS_WIN = 18 * MiB;
constexpr size_t WS_WOUT = 24 * MiB;
constexpr size_t WS_WGU = 26 * MiB;
constexpr size_t WS_WDN = 90 * MiB;
constexpr size_t WS_AFFT = 122 * MiB;
constexpr size_t WS_SLOT = 126 * MiB;
constexpr size_t WS_IDX = 128 * MiB;
constexpr size_t WS_GATE = 129 * MiB;
constexpr size_t WS_XN = 130 * MiB;
constexpr size_t WS_Q = 274 * MiB;
constexpr size_t WS_K = 338 * MiB;
constexpr size_t WS_V = 410 * MiB;
constexpr size_t WS_GB = 482 * MiB;
constexpr size_t WS_U = 546 * MiB;
constexpr size_t WS_MIXIN = 610 * MiB;
constexpr size_t WS_MIX = 738 * MiB;
constexpr size_t WS_HMID = 274 * MiB;
constexpr size_t WS_Y = 610 * MiB;
constexpr size_t WS_H1 = 866 * MiB;
constexpr size_t WS_END = 994 * MiB;

__device__ __forceinline__ int opaque_tid() { int t = threadIdx.x; asm volatile("" : "+v"(t)); return t; }

namespace pg8 {
constexpr int BM = 256, BK = 64, HALF = 128, HTB = HALF * BK * 2, STAGE_BYTES = 8 * HTB;
__host__ __device__ __forceinline__ int lds_byte(int r, int c) { const int st = (r >> 4) * 2 + (c >> 5), rr = r & 15, cc = c & 31, ob = rr * 64 + cc * 2; return st * 1024 + (ob ^ (((ob >> 9) & 1) << 5)); }
__host__ __device__ __forceinline__ void stage_rc(int b, int& R, int& C) { const int st = b / 1024, sb = b % 1024, swz = sb ^ (((sb >> 9) & 1) << 5); R = (st >> 1) * 16 + swz / 64; C = (st & 1) * 32 + (swz % 64) / 2; }
__host__ __device__ __forceinline__ int perm32(int rho) { const int n = rho >> 4, i = rho & 15; return 8 * (i >> 2) + 4 * n + (i & 3); }

struct Unit { int pm, pn; };
struct Gemm { const bf16_t* A; const bf16_t* Bt; int K; const int* gidx; };

typedef float f32x2_t __attribute__((ext_vector_type(2))); typedef __bf16 bf16x2_t __attribute__((ext_vector_type(2)));
__device__ __forceinline__ unsigned cvt_pk_bf16(float lo, float hi) { const f32x2_t v = {lo, hi}; const bf16x2_t b = __builtin_convertvector(v, bf16x2_t); return __builtin_bit_cast(unsigned, b); }

struct EpiBf16 {
    static constexpr bool PERM = true, AFTER_DRAIN = false;
    bf16_t* O; int ldc;
    __device__ __forceinline__ void operator()(const f32x4 (&acc)[2][2][4][2], const Unit& u, int wr, int wc, int fr, int fq) const {
        const int row0 = u.pm * BM + wr * 64 + fr; const int col0 = u.pn * BM + wc * 32 + 8 * fq;
#pragma unroll
        for (int ai = 0; ai < 2; ++ai)
#pragma unroll
            for (int m = 0; m < 4; ++m) { bf16_t* rowp = O + (size_t)(row0 + ai * HALF + m * 16) * ldc + col0;
#pragma unroll
                for (int bj = 0; bj < 2; ++bj) { const f32x4 v0 = acc[ai][bj][m][0], v1 = acc[ai][bj][m][1];
                    u32x4 w; w.x = cvt_pk_bf16(v0[0], v0[1]); w.y = cvt_pk_bf16(v0[2], v0[3]); w.z = cvt_pk_bf16(v1[0], v1[1]); w.w = cvt_pk_bf16(v1[2], v1[3]);
                    *(u32x4*)(rowp + bj * HALF) = w; } }
    }
};

struct EpiProj {
    static constexpr bool PERM = true, AFTER_DRAIN = false;
    bf16_t *Q, *KA, *VA, *GB, *U; const float* tab;
    unsigned* kmaxh;
    __device__ __forceinline__ void operator()(const f32x4 (&acc)[2][2][4][2], const Unit& u, int wr, int wc, int fr, int fq) const {
        const int pn = u.pn; const bool ctx = u.pm >= 256;
        float km[2] = {0.f, 0.f};
#pragma unroll
        for (int ai = 0; ai < 2; ++ai)
#pragma unroll
            for (int m = 0; m < 4; ++m) {
                const int row = u.pm * BM + ai * HALF + wr * 64 + m * 16 + fr;
                int t, kvrow;
                if (!ctx) { const int b = row >> 11; t = row & 2047; kvrow = b * TK + TC + t; }
                else { const int rc = row - M; const int b = rc >> 8; t = 0; kvrow = b * TK + (rc & 255); }
                if (pn < 4) {
                    f32x4 cs0 = {1.f, 0.f, 1.f, 0.f}, cs1 = cs0, cs2 = cs0, cs3 = cs0;
                    if (!ctx) { const float* tp = tab + ((size_t)t * 32 + 16 * (wc & 1) + 4 * fq) * 2;
                        cs0 = *(const f32x4*)(tp); cs1 = *(const f32x4*)(tp + 4); }
                    (void)cs2; (void)cs3;
#pragma unroll
                    for (int bj = 0; bj < 2; ++bj) {
                        const f32x4 v0 = acc[ai][bj][m][0], v1 = acc[ai][bj][m][1];
                        float e0 = v0[0], o0 = v0[1], e1 = v0[2], o1 = v0[3], e2 = v1[0], o2 = v1[1], e3 = v1[2], o3 = v1[3];
                        if (pn >= 2) {
                            float ss = ((e0 * e0 + o0 * o0) + (e1 * e1 + o1 * o1)) + ((e2 * e2 + o2 * o2) + (e3 * e3 + o3 * o3));
                            ss += __shfl_xor(ss, 16); ss += __shfl_xor(ss, 32); km[bj] = fmaxf(km[bj], ss); }
                        float r0 = e0 * cs0[0] - o0 * cs0[1], s0 = o0 * cs0[0] + e0 * cs0[1];
                        float r1 = e1 * cs0[2] - o1 * cs0[3], s1 = o1 * cs0[2] + e1 * cs0[3];
                        float r2 = e2 * cs1[0] - o2 * cs1[1], s2 = o2 * cs1[0] + e2 * cs1[1];
                        float r3 = e3 * cs1[2] - o3 * cs1[3], s3 = o3 * cs1[2] + e3 * cs1[3];
                        const float sc = (pn < 2) ? C2 : 1.f;
                        u32x4 w; w.x = cvt_pk_bf16(r0 * sc, s0 * sc); w.y = cvt_pk_bf16(r1 * sc, s1 * sc); w.z = cvt_pk_bf16(r2 * sc, s2 * sc); w.w = cvt_pk_bf16(r3 * sc, s3 * sc);
                        const int col = (pn & 1) * 256 + bj * HALF + wc * 32 + 8 * fq;
                        bf16_t* dst = (pn < 2) ? (Q + (size_t)row * 512 + col) : (KA + (size_t)kvrow * 512 + col);
                        *(u32x4*)dst = w;
                    }
                } else if (pn < 8) {
#pragma unroll
                    for (int bj = 0; bj < 2; ++bj) {
                        const f32x4 v0 = acc[ai][bj][m][0], v1 = acc[ai][bj][m][1];
                        u32x4 w; w.x = cvt_pk_bf16(v0[0], v0[1]); w.y = cvt_pk_bf16(v0[2], v0[3]); w.z = cvt_pk_bf16(v1[0], v1[1]); w.w = cvt_pk_bf16(v1[2], v1[3]);
                        const int col = (pn & 1) * 256 + bj * HALF + wc * 32 + 8 * fq;
                        bf16_t* dst = (pn < 6) ? (VA + (size_t)kvrow * 512 + col) : (GB + (size_t)row * 512 + col);
                        *(u32x4*)dst = w;
                    }
                } else {
                    const f32x4 a0 = acc[ai][0][m][0], a1 = acc[ai][0][m][1], b0 = acc[ai][1][m][0], b1 = acc[ai][1][m][1];
                    u32x4 w; w.x = cvt_pk_bf16(a0[0] * b0[0], a0[1] * b0[1]); w.y = cvt_pk_bf16(a0[2] * b0[2], a0[3] * b0[3]);
                    w.z = cvt_pk_bf16(a1[0] * b1[0], a1[1] * b1[1]); w.w = cvt_pk_bf16(a1[2] * b1[2], a1[3] * b1[3]);
                    const int col = (pn - 8) * 128 + wc * 32 + 8 * fq;
                    *(u32x4*)(U + (size_t)row * 512 + col) = w;
                }
            }
        if (pn == 2 || pn == 3) {
            const int b = ctx ? (u.pm - 256) : (u.pm >> 3);
#pragma unroll
            for (int bj = 0; bj < 2; ++bj) { float v = km[bj];
#pragma unroll
                for (int d = 1; d < 16; d <<= 1) v = fmaxf(v, __shfl_xor(v, d));
                if (fr == 0 && fq == 0) atomicMax(kmaxh + ((b * 8 + (pn & 1) * 4 + bj * 2 + (wc >> 1)) * 2 + (wc & 1)), __float_as_uint(v)); }
        }
    }
};

struct EpiGU {
    static constexpr bool PERM = true, AFTER_DRAIN = false;
    bf16_t* H;
    __device__ __forceinline__ float silu(float x) const { return x * __builtin_amdgcn_rcpf(1.f + __expf(-x)); }
    __device__ __forceinline__ void operator()(const f32x4 (&acc)[2][2][4][2], const Unit& u, int wr, int wc, int fr, int fq) const {
#pragma unroll
        for (int ai = 0; ai < 2; ++ai)
#pragma unroll
            for (int m = 0; m < 4; ++m) {
                const int row = ai * HALF + wr * 64 + m * 16 + fr;
                const f32x4 a0 = acc[ai][0][m][0], a1 = acc[ai][0][m][1], b0 = acc[ai][1][m][0], b1 = acc[ai][1][m][1];
                u32x4 w; w.x = cvt_pk_bf16(silu(a0[0]) * b0[0], silu(a0[1]) * b0[1]); w.y = cvt_pk_bf16(silu(a0[2]) * b0[2], silu(a0[3]) * b0[3]);
                w.z = cvt_pk_bf16(silu(a1[0]) * b1[0], silu(a1[1]) * b1[1]); w.w = cvt_pk_bf16(silu(a1[2]) * b1[2], silu(a1[3]) * b1[3]);
                *(u32x4*)(H + (size_t)row * 1024 + u.pn * 128 + wc * 32 + 8 * fq) = w;
            }
    }
};
struct EpiDown {
    static constexpr bool PERM = true, AFTER_DRAIN = false;
    bf16_t* Y; const float* gate;
    __device__ __forceinline__ void operator()(const f32x4 (&acc)[2][2][4][2], const Unit& u, int wr, int wc, int fr, int fq) const {
#pragma unroll
        for (int ai = 0; ai < 2; ++ai)
#pragma unroll
            for (int m = 0; m < 4; ++m) {
                const int row = ai * HALF + wr * 64 + m * 16 + fr; const float g = gate[row];
#pragma unroll
                for (int bj = 0; bj < 2; ++bj) { const f32x4 v0 = acc[ai][bj][m][0] * g, v1 = acc[ai][bj][m][1] * g;
                    u32x4 w; w.x = cvt_pk_bf16(v0[0], v0[1]); w.y = cvt_pk_bf16(v0[2], v0[3]); w.z = cvt_pk_bf16(v1[0], v1[1]); w.w = cvt_pk_bf16(v1[2], v1[3]);
                    *(u32x4*)(Y + (size_t)row * 1024 + u.pn * BM + bj * HALF + wc * 32 + 8 * fq) = w; }
            }
    }
};

struct SchedProj {
    int G, c;
    __device__ __forceinline__ bool next(int i, Unit& u) const {
        const int L = i * G + c;
        if (L < 3072) { u.pm = L & 255; u.pn = L >> 8; return true; }
        const int j = L - 3072; if (j >= 128) return false;
        u.pm = 256 + (j >> 2); u.pn = 2 + (j & 3); return true;
    }
    __device__ __forceinline__ void a_ready(const Unit&) const {}
    __device__ __forceinline__ void done(const Unit&) const {}
};
struct SchedPanel {
    int pm, ntn;
    __device__ __forceinline__ bool next(int i, Unit& u) const { if (i >= ntn) return false; u.pm = pm; u.pn = i; return true; }
    __device__ __forceinline__ void a_ready(const Unit&) const {}
    __device__ __forceinline__ void done(const Unit&) const {}
};

template <class Epi, class Sched, bool ALIGN_EPI, bool SP2, bool GATHER = false>
__device__ __forceinline__ void gemm_phase(LAS unsigned char* lds, const Gemm g, const Sched& S, const Epi& E) {
    const int tid = opaque_tid(), wid = __builtin_amdgcn_readfirstlane(tid >> 6), lane = tid & 63, wr = wid >> 2, wc = wid & 3, fr = lane & 15, fq = lane >> 4;
    const int K = g.K, nt = K / BK;
    unsigned voffA[2][2], voffB[2];
#pragma unroll
    for (int i = 0; i < 2; ++i) { int R, C; stage_rc(tid * 16 + i * 8192, R, C); const int Rb = Epi::PERM ? ((R & ~31) + perm32(R & 31)) : R;
        if constexpr (GATHER) { voffA[0][i] = (unsigned)(g.gidx[R] * K + C) * 2u; voffA[1][i] = (unsigned)(g.gidx[HALF + R] * K + C) * 2u; }
        else { voffA[0][i] = (unsigned)(R * K + C) * 2u; voffA[1][i] = voffA[0][i]; }
        voffB[i] = (unsigned)(Rb * K + C) * 2u; }
    const size_t kstep = (size_t)(BK * 2);
    const size_t hstep = (size_t)HALF * K * 2;
    const size_t hstepA = GATHER ? (size_t)0 : hstep;
    const size_t tstep = 2 * hstep;
    const unsigned ldsw = (unsigned)wid * 1024u;
    const int aoff = lds_byte(wr * 64 + fr, fq * 8), boff = lds_byte(wc * 32 + fr, fq * 8);
#define PG8_SA(b, h) (((b) * 2 + (h)) * HTB)
#define PG8_SB(b, h) ((4 + (b) * 2 + (h)) * HTB)
#define PG8_STAGE(bufoff, gbase, voff) do { _Pragma("unroll") for (int _i = 0; _i < 2; ++_i) \
        __builtin_amdgcn_global_load_lds((const unsigned*)((const char*)(gbase) + (voff)[_i]), (LAS unsigned*)(lds + (bufoff) + ldsw + _i * 8192), 16, 0, 0); } while (0)
#define PG8_LDA(dst, b, h) do { _Pragma("unroll") for (int m = 0; m < 4; ++m) _Pragma("unroll") for (int k = 0; k < 2; ++k) dst[m][k] = *(const LAS bf16x8*)(lds + PG8_SA(b, h) + aoff + m * 2048 + k * 1024); } while (0)
#define PG8_LDB(dst, b, h) do { _Pragma("unroll") for (int n = 0; n < 2; ++n) _Pragma("unroll") for (int k = 0; k < 2; ++k) dst[n][k] = *(const LAS bf16x8*)(lds + PG8_SB(b, h) + boff + n * 2048 + k * 1024); } while (0)
#define PG8_MMA(ai, bj, At, Bt) do { __builtin_amdgcn_s_setprio(1); _Pragma("unroll") for (int m = 0; m < 4; ++m) _Pragma("unroll") for (int n = 0; n < 2; ++n) _Pragma("unroll") for (int k = 0; k < 2; ++k) \
        acc[ai][bj][m][n] = __builtin_amdgcn_mfma_f32_16x16x32_bf16(Bt[n][k], At[m][k], acc[ai][bj][m][n], 0, 0, 0); __builtin_amdgcn_s_setprio(0); } while (0)
#define PG8_WAIT_V(n) asm volatile("s_waitcnt vmcnt(" #n ")" ::: "memory")
#define PG8_WAIT_L(n) asm volatile("s_waitcnt lgkmcnt(" #n ")" ::: "memory")
#define PG8_BAR __builtin_amdgcn_s_barrier()
#define PG8_SCHED __builtin_amdgcn_sched_barrier(0)
    Unit cur, nxt; int ui = 0;
    if (!S.next(0, cur)) return;
    f32x4 acc[2][2][4][2];
#pragma unroll
    for (int a = 0; a < 2; ++a)
#pragma unroll
        for (int b = 0; b < 2; ++b)
#pragma unroll
            for (int m = 0; m < 4; ++m)
#pragma unroll
                for (int n = 0; n < 2; ++n) acc[a][b][m][n] = (f32x4){0.f, 0.f, 0.f, 0.f};
    bf16x8 At[4][2], B0[2][2], B1[2][2];
    const char* cA = (const char*)g.A + (size_t)cur.pm * tstep; const char* cB = (const char*)g.Bt + (size_t)cur.pn * tstep;
    S.a_ready(cur);
    if constexpr (SP2) {
        PG8_STAGE(PG8_SB(0, 0), cB, voffB); PG8_STAGE(PG8_SB(0, 1), cB + hstep, voffB); PG8_STAGE(PG8_SA(0, 0), cA, voffA[0]); PG8_STAGE(PG8_SA(0, 1), cA + hstepA, voffA[1]);
        if (wr == 1) PG8_BAR;
        PG8_WAIT_V(2); PG8_BAR;
        PG8_STAGE(PG8_SB(1, 0), cB + kstep, voffB); PG8_STAGE(PG8_SA(1, 0), cA + kstep, voffA[0]); PG8_STAGE(PG8_SB(1, 1), cB + hstep + kstep, voffB);
        PG8_WAIT_V(6); PG8_BAR;
    } else {
        PG8_STAGE(PG8_SB(0, 0), cB, voffB); PG8_STAGE(PG8_SA(0, 0), cA, voffA[0]); PG8_STAGE(PG8_SB(0, 1), cB + hstep, voffB); PG8_STAGE(PG8_SA(0, 1), cA + hstepA, voffA[1]);
        if (wr == 1) PG8_BAR;
        PG8_WAIT_V(4); PG8_BAR;
        PG8_STAGE(PG8_SB(1, 0), cB + kstep, voffB); PG8_STAGE(PG8_SA(1, 0), cA + kstep, voffA[0]); PG8_STAGE(PG8_SB(1, 1), cB + hstep + kstep, voffB);
        PG8_WAIT_V(6); PG8_BAR;
    }
    for (;;) {
        const bool has_next = S.next(ui + 1, nxt);
        const char* nA = has_next ? (const char*)g.A + (size_t)nxt.pm * tstep : cA; const char* nB = has_next ? (const char*)g.Bt + (size_t)nxt.pn * tstep : cB;
        for (int t = 0; t < nt; t += 2) {
            const bool last = (t == nt - 2);
            const char* a1 = cA + (size_t)(t + 1) * kstep;
            const char* a2 = last ? nA : cA + (size_t)(t + 2) * kstep; const char* b2 = last ? nB : cB + (size_t)(t + 2) * kstep;
            const char* a3 = a2 + kstep; const char* b3 = b2 + kstep;
            if (last && has_next) S.a_ready(nxt);
            if constexpr (SP2) {
            PG8_LDB(B0, 0, 0); PG8_LDB(B1, 0, 1); PG8_SCHED; PG8_LDA(At, 0, 0); PG8_STAGE(PG8_SA(1, 1), a1 + hstepA, voffA[1]);
            PG8_WAIT_V(8); PG8_WAIT_L(0); PG8_BAR; PG8_MMA(0, 0, At, B0); PG8_MMA(0, 1, At, B1); PG8_BAR; PG8_SCHED;
            PG8_LDA(At, 0, 1); PG8_STAGE(PG8_SB(0, 0), b2, voffB); PG8_STAGE(PG8_SB(0, 1), b2 + hstep, voffB); PG8_STAGE(PG8_SA(0, 0), a2, voffA[0]);
            PG8_WAIT_V(8); PG8_WAIT_L(0); PG8_BAR; PG8_MMA(1, 0, At, B0); PG8_MMA(1, 1, At, B1); PG8_BAR; PG8_SCHED;
            PG8_LDB(B0, 1, 0); PG8_LDB(B1, 1, 1); PG8_SCHED; PG8_LDA(At, 1, 0); PG8_STAGE(PG8_SA(0, 1), a2 + hstepA, voffA[1]);
            PG8_WAIT_V(8); PG8_WAIT_L(0); PG8_BAR; PG8_MMA(0, 0, At, B0); PG8_MMA(0, 1, At, B1); PG8_BAR; PG8_SCHED;
            PG8_LDA(At, 1, 1); PG8_STAGE(PG8_SB(1, 0), b3, voffB); PG8_STAGE(PG8_SB(1, 1), b3 + hstep, voffB); PG8_STAGE(PG8_SA(1, 0), a3, voffA[0]);
            PG8_WAIT_V(8); PG8_WAIT_L(0); PG8_BAR; PG8_MMA(1, 0, At, B0); PG8_MMA(1, 1, At, B1); PG8_BAR; PG8_SCHED;
            } else {
            PG8_LDB(B0, 0, 0); PG8_SCHED; PG8_LDA(At, 0, 0); PG8_STAGE(PG8_SA(1, 1), a1 + hstepA, voffA[1]);
            PG8_WAIT_L(8); PG8_BAR; PG8_WAIT_L(0); PG8_MMA(0, 0, At, B0); PG8_BAR; PG8_SCHED;
            PG8_LDB(B1, 0, 1); PG8_STAGE(PG8_SB(0, 0), b2, voffB);
            PG8_BAR; PG8_WAIT_L(0); PG8_MMA(0, 1, At, B1); PG8_BAR;
            PG8_LDA(At, 0, 1); PG8_STAGE(PG8_SA(0, 0), a2, voffA[0]);
            PG8_BAR; PG8_WAIT_L(0); PG8_MMA(1, 0, At, B0); PG8_BAR; PG8_SCHED;
            PG8_STAGE(PG8_SB(0, 1), b2 + hstep, voffB);
            PG8_WAIT_V(6); PG8_BAR; PG8_MMA(1, 1, At, B1); PG8_BAR;
            PG8_LDB(B0, 1, 0); PG8_SCHED; PG8_LDA(At, 1, 0); PG8_STAGE(PG8_SA(0, 1), a2 + hstepA, voffA[1]);
            PG8_WAIT_L(8); PG8_BAR; PG8_WAIT_L(0); PG8_MMA(0, 0, At, B0); PG8_BAR; PG8_SCHED;
            PG8_LDB(B1, 1, 1); PG8_STAGE(PG8_SB(1, 0), b3, voffB);
            PG8_BAR; PG8_WAIT_L(0); PG8_MMA(0, 1, At, B1); PG8_BAR;
            PG8_LDA(At, 1, 1); PG8_STAGE(PG8_SA(1, 0), a3, voffA[0]);
            PG8_BAR; PG8_WAIT_L(0); PG8_MMA(1, 0, At, B0); PG8_BAR; PG8_SCHED;
            PG8_STAGE(PG8_SB(1, 1), b3 + hstep, voffB);
            PG8_WAIT_V(6); PG8_BAR; PG8_MMA(1, 1, At, B1); PG8_BAR;
            }
        }
        if constexpr (ALIGN_EPI) { if (wr == 0) PG8_BAR; }
        E(acc, cur, wr, wc, fr, fq); S.done(cur);
        if (!has_next) break;
#pragma unroll
        for (int a = 0; a < 2; ++a)
#pragma unroll
            for (int b = 0; b < 2; ++b)
#pragma unroll
                for (int m = 0; m < 4; ++m)
#pragma unroll
                    for (int n = 0; n < 2; ++n) acc[a][b][m][n] = (f32x4){0.f, 0.f, 0.f, 0.f};
        cur = nxt; cA = nA; cB = nB; ++ui;
        if constexpr (ALIGN_EPI) { if (wr == 1) PG8_BAR; }
    }
    PG8_WAIT_V(0);
    if constexpr (!ALIGN_EPI) { if (wr == 0) PG8_BAR; }
    PG8_BAR;
#undef PG8_SA
#undef PG8_SB
#undef PG8_STAGE
#undef PG8_LDA
#undef PG8_LDB
#undef PG8_MMA
#undef PG8_WAIT_V
#undef PG8_WAIT_L
#undef PG8_BAR
#undef PG8_SCHED
}
}

typedef GAS unsigned gu32;
#define RLX_AGENT __ATOMIC_RELAXED, __HIP_MEMORY_SCOPE_AGENT
#define LDS_WAIT() asm volatile("s_waitcnt lgkmcnt(0)" ::: "memory")
#define VM_WAIT() asm volatile("s_waitcnt vmcnt(0)" ::: "memory")
__device__ __forceinline__ unsigned pk2(float lo, float hi) { return pg8::cvt_pk_bf16(lo, hi); }
__device__ __forceinline__ float bf2f(unsigned short h) { return __uint_as_float((unsigned)h << 16); }
__device__ __forceinline__ float bflo(unsigned w) { return __uint_as_float(w << 16); }
__device__ __forceinline__ float bfhi(unsigned w) { return __uint_as_float(w & 0xffff0000u); }
__device__ __forceinline__ float wave_sum(float v) {
#pragma unroll
    for (int o = 1; o < 64; o <<= 1) v += __shfl_xor(v, o);
    return v;
}

#define XB_TMO      128
#define XB_XCNT(j)  (256  + 64 * (j))
#define XB_XSUB(j)  (1280 + 64 * (j))
#define XB_XGEN(j)  (2304 + 64 * (j))
#define XB_TOP      3328
#define XB_TOPGEN   3392
#define XCD_BAR_WORDS 3456
#define XB_SPIN_CAP (1u << 18)
__device__ __forceinline__ unsigned xb_ld(unsigned* p)              { return __hip_atomic_load(p, __ATOMIC_RELAXED, __HIP_MEMORY_SCOPE_AGENT); }
__device__ __forceinline__ unsigned xb_add(unsigned* p, unsigned v) { return __hip_atomic_fetch_add(p, v, __ATOMIC_RELAXED, __HIP_MEMORY_SCOPE_AGENT); }
__device__ __forceinline__ unsigned xb_xcc_id() { return (unsigned)__builtin_amdgcn_s_getreg((3 << 11) | 20) & 0xFu; }
#define XB_SPIN(cond, bar) do { unsigned _sp = 0; while (cond) { __builtin_amdgcn_s_sleep(1); \
    if ((++_sp & 255u) == 0u) { if (xb_ld(&(bar)[XB_TMO])) break; if (_sp > XB_SPIN_CAP) { atomicAdd(&(bar)[XB_TMO], 1u); break; } } } } while (0)
struct XcdBarrier { unsigned* bar; unsigned x; volatile LAS unsigned* st; };
__device__ __forceinline__ XcdBarrier xcd_barrier_post(unsigned* bar, volatile LAS unsigned* st) {
    XcdBarrier b; b.bar = bar; b.x = xb_xcc_id(); b.st = st;
    if (threadIdx.x == 0) (void)xb_add(&bar[XB_XCNT(b.x)], 1u);
    return b;
}
__device__ __forceinline__ void xcd_barrier_complete(unsigned* bar, unsigned x, unsigned& nloc, unsigned& nx) {
    const unsigned G = gridDim.x * gridDim.y * gridDim.z;
    unsigned sum, cnt, mine, sp = 0u;
    for (;;) {
        sum = 0u; cnt = 0u; mine = 0u;
#pragma unroll
        for (unsigned j = 0; j < 16; ++j) { const unsigned c = xb_ld(&bar[XB_XCNT(j)]); sum += c; cnt += (c > 0u) ? 1u : 0u; mine = (j == x) ? c : mine; }
        if (sum == G) break;
        __builtin_amdgcn_s_sleep(1);
        if ((++sp & 255u) == 0u) { if (xb_ld(&bar[XB_TMO])) break; if (sp > XB_SPIN_CAP) { atomicAdd(&bar[XB_TMO], 1u); break; } }
    }
    nloc = mine > 0u ? mine : 1u; nx = cnt > 0u ? cnt : 1u;
}
__device__ __forceinline__ void xcd_barrier(const XcdBarrier& b) {
    asm volatile("s_waitcnt vmcnt(0)" ::: "memory");
    __syncthreads();
    if (threadIdx.x == 0) {
        unsigned* bar = b.bar;
        __builtin_amdgcn_s_waitcnt(0);
        unsigned nloc = b.st[0], nx = b.st[1];
        if (nloc == 0u) { xcd_barrier_complete(bar, b.x, nloc, nx); b.st[0] = nloc; b.st[1] = nx; }
        const unsigned old = xb_add(&bar[XB_XSUB(b.x)], 1u);
        const unsigned gen = old / nloc;
        if (old + 1u == (gen + 1u) * nloc) {
            __builtin_amdgcn_fence(__ATOMIC_RELEASE, "agent");
            asm volatile("s_waitcnt vmcnt(0)" ::: "memory");
            const unsigned og = xb_add(&bar[XB_TOP], 1u);
            const unsigned tg = og / nx;
            if (og + 1u == (tg + 1u) * nx) xb_add(&bar[XB_TOPGEN], 1u);
            else XB_SPIN(xb_ld(&bar[XB_TOPGEN]) == tg, bar);
            __builtin_amdgcn_fence(__ATOMIC_ACQUIRE, "agent");
            xb_add(&bar[XB_XGEN(b.x)], 1u);
            asm volatile("s_waitcnt vmcnt(0)" ::: "memory");
        } else {
            XB_SPIN(xb_ld(&bar[XB_XGEN(b.x)]) == gen, bar);
            __builtin_amdgcn_fence(__ATOMIC_ACQUIRE, "agent");
            asm volatile("s_waitcnt vmcnt(0)" ::: "memory");
        }
    }
    __syncthreads();
}

constexpr int RING_BYTES = 131072;
constexpr int LDSCTL_OFF = RING_BYTES, MISC_OFF = LDSCTL_OFF + 320;
constexpr int LDS_BYTES = 147456;
constexpr int CW_BAR = 4096;
constexpr int CW_KMAX = 65536;

struct Args { const float* in[22]; float* out; unsigned char* ws; int ph_lo, ph_hi; };
enum { I_X = 0, I_C, I_CTX, I_CCTX, I_WADA, I_BADA, I_NPRE_MIX, I_NPOST_MIX, I_NPRE_FFN, I_NPOST_FFN, I_WIN, I_CONVW, I_LQ1, I_LK1, I_LQ2, I_LK2, I_SUBLN, I_WOUT, I_WROUTER, I_WGATE, I_WUP, I_WDOWN };

__device__ __forceinline__ void prefetch_slice(const unsigned char* base, int bytes_per_wave, LAS unsigned char* scr, int lane) {
    for (int i = 0; i < bytes_per_wave; i += 1024)
        __builtin_amdgcn_global_load_lds((const unsigned*)(base + i + lane * 16), (LAS unsigned*)scr, 16, 0, 0);
}

__device__ __forceinline__ int win_dest(int n) {
    if (n < 1024) { const int j = n & 63; const int p = ((j >> 5) << 5) + ((j & 15) << 1) + ((j >> 4) & 1); return (n & ~63) + p; }
    if (n < 2048) return n;
    int c = n - 2048; const int isx = c >= 512; c &= 511; return 2048 + ((c >> 7) << 8) + (isx << 7) + (c & 127);
}
template <int MODE>
__device__ __forceinline__ int tr_dest(int n) {
    if (MODE == 0) return n;
    if (MODE == 1) return win_dest(n);
    if (MODE == 2) return ((n >> 7) << 8) + (n & 127);
    return ((n >> 7) << 8) + 128 + (n & 127);
}
template <int MODE>
__device__ __forceinline__ void p0_transpose_item(const float* W, int K, int N, bf16_t* WT, LAS float* scr, int item, int lane) {
    const int nblk = N / 32, kb = item / nblk, nb = item % nblk, k0 = 64 * kb, n0 = 32 * nb;
#pragma unroll 8
    for (int i = 0; i < 32; ++i) { const int kk = 2 * i + (lane >> 5); scr[kk * 33 + (lane & 31)] = W[(size_t)(k0 + kk) * N + n0 + (lane & 31)]; }
    LDS_WAIT(); asm volatile("" ::: "memory");
    const int c = lane & 7;
#pragma unroll
    for (int j = 0; j < 4; ++j) { const int n = (lane >> 3) + 8 * j; const LAS float* s = scr + (8 * c) * 33 + n;
        u32x4 o; o.x = pk2(s[0 * 33], s[1 * 33]); o.y = pk2(s[2 * 33], s[3 * 33]); o.z = pk2(s[4 * 33], s[5 * 33]); o.w = pk2(s[6 * 33], s[7 * 33]);
        *(GAS u32x4*)(WT + (size_t)tr_dest<MODE>(n0 + n) * K + k0 + 8 * c) = o; }
    LDS_WAIT(); asm volatile("" ::: "memory");
}

__device__ __forceinline__ void p0_prologue(const Args& a, LAS unsigned char* lds, int vcu, int G) {
    const int tid = opaque_tid(), lane = tid & 63, wave = __builtin_amdgcn_readfirstlane(tid >> 6);
    LAS float* scr = (LAS float*)(lds + wave * 16384);
    const int gw = vcu * NWAVES + wave, NGW = G * NWAVES;
    unsigned char* ws = a.ws;
    {
        float* MODP = (float*)(ws + WS_MODP);
        const float* wada = a.in[I_WADA];
        for (int it = gw; it < 96 * 16; it += NGW) {
            const int cg = it % 96, kc = it / 96;
            for (int b = 0; b < 33; ++b) { const float v = (b < 32) ? a.in[I_C][b * D + kc * 64 + lane] : a.in[I_CCTX][kc * 64 + lane]; scr[b * 64 + lane] = v / (1.f + __expf(-v)); }
            LDS_WAIT(); asm volatile("" ::: "memory");
            float acc[33];
#pragma unroll
            for (int b = 0; b < 33; ++b) acc[b] = 0.f;
            for (int k = 0; k < 64; ++k) {
                const float w = wada[(size_t)(kc * 64 + k) * NMOD + cg * 64 + lane];
#pragma unroll
                for (int b = 0; b < 33; ++b) acc[b] += scr[b * 64 + k] * w;
            }
#pragma unroll
            for (int b = 0; b < 33; ++b) MODP[((size_t)kc * 33 + b) * NMOD + cg * 64 + lane] = acc[b];
            LDS_WAIT(); asm volatile("" ::: "memory");
        }
    }
    {
        float* tab = (float*)(ws + WS_TAB);
        for (int e = gw * 64 + lane; e < T * 32; e += NGW * 64) {
            const int t = e >> 5, i = e & 31;
            const float inv = powf(10000.0f, -(float)(2 * (i & 15)) / 32.0f);
            const float pos = (i < 16) ? (float)(t >> 6) : (float)(t & 63);
            const float ang = pos * inv;
            tab[2 * e] = cosf(ang); tab[2 * e + 1] = sinf(ang);
        }
    }
    constexpr int I_IN = (D / 64) * (NPROJ / 32), I_OUT = (D / 64) * (D / 32);
    constexpr int NITEMS = I_IN + I_OUT;
    bf16_t* Win_t = (bf16_t*)(ws + WS_WIN); bf16_t* Wout_t = (bf16_t*)(ws + WS_WOUT);
    for (int it = gw; it < NITEMS; it += NGW) {
        int r = it;
        if (r < I_IN) { p0_transpose_item<1>(a.in[I_WIN], D, NPROJ, Win_t, scr, r, lane); continue; } r -= I_IN;
        p0_transpose_item<0>(a.in[I_WOUT], D, D, Wout_t, scr, r, lane);
    }
}
__device__ __forceinline__ void expert_weight_copies(const Args& a, LAS unsigned char* lds, int vcu, int G) {
    const int tid = opaque_tid(), lane = tid & 63, wave = __builtin_amdgcn_readfirstlane(tid >> 6);
    LAS float* scr = (LAS float*)(lds + wave * 16384);
    const int gw = vcu * NWAVES + wave, NGW = G * NWAVES;
    unsigned char* ws = a.ws;
    constexpr int I_EXP = (D / 64) * (D / 32);
    bf16_t* Wgu_t = (bf16_t*)(ws + WS_WGU); bf16_t* Wdn_t = (bf16_t*)(ws + WS_WDN);
    for (int r = gw; r < NE * 3 * I_EXP; r += NGW) {
        const int e = r / (3 * I_EXP), q = (r % (3 * I_EXP)) / I_EXP, rr = r % I_EXP;
        if (q == 0) p0_transpose_item<2>(a.in[I_WGATE] + (size_t)e * D * D, D, D, Wgu_t + (size_t)e * 2048 * D, scr, rr, lane);
        else if (q == 1) p0_transpose_item<3>(a.in[I_WUP] + (size_t)e * D * D, D, D, Wgu_t + (size_t)e * 2048 * D, scr, rr, lane);
        else p0_transpose_item<0>(a.in[I_WDOWN] + (size_t)e * D * D, D, D, Wdn_t + (size_t)e * D * D, scr, rr, lane);
    }
    __syncthreads();
}

struct RowF { f32x4 v[4]; };
__device__ __forceinline__ void row_load(RowF& r, const float* xrow, int lane) {
    const f32x4* xr = (const f32x4*)xrow + lane;
#pragma unroll
    for (int j = 0; j < 4; ++j) r.v[j] = __builtin_nontemporal_load(xr + 64 * j);
}
__device__ __forceinline__ void norm_mod_row(const RowF& r, bf16_t* orow, const float* gain, const LAS float* sc, const LAS float* sh, int lane) {
    const f32x4* gr = (const f32x4*)gain + lane;
    float s = 0.f;
#pragma unroll
    for (int j = 0; j < 4; ++j) s += (r.v[j].x * r.v[j].x + r.v[j].y * r.v[j].y) + (r.v[j].z * r.v[j].z + r.v[j].w * r.v[j].w);
    const float rstd = 1.0f / sqrtf(wave_sum(s) * (1.f / D) + EPS);
    u32x2* o8 = (u32x2*)orow + lane;
#pragma unroll
    for (int j = 0; j < 4; ++j) { const f32x4 g = gr[64 * j]; const f32x4 c1 = *(const LAS f32x4*)(sc + 4 * lane + 256 * j), h1 = *(const LAS f32x4*)(sh + 4 * lane + 256 * j);
        const f32x4 y = (r.v[j] * rstd) * g; const f32x4 z = y * (c1 + 1.0f) + h1;
        u32x2 w; w.x = pk2(z.x, z.y); w.y = pk2(z.z, z.w); o8[64 * j] = w; }
}
__device__ __forceinline__ void p1_xn(const Args& a, LAS unsigned char* lds, int c, int G) {
    const int tid = opaque_tid(), lane = tid & 63, wave = __builtin_amdgcn_readfirstlane(tid >> 6);
    unsigned char* ws = a.ws;
    const float* MODP = (const float*)(ws + WS_MODP); float* MOD = (float*)(ws + WS_MOD); const float* bada = a.in[I_BADA];
    for (int r = c; r < 33; r += G)
        for (int n = tid; n < NMOD; n += NTHREADS) { float s = bada[n];
#pragma unroll
            for (int kc = 0; kc < 16; ++kc) s += MODP[((size_t)kc * 33 + r) * NMOD + n];
            MOD[(size_t)r * NMOD + n] = s; }
    LAS float* sv = (LAS float*)lds;
    bf16_t* XN = (bf16_t*)(ws + WS_XN);
    const float* X = a.in[I_X]; const float* CTX = a.in[I_CTX]; const float* gain = a.in[I_NPRE_MIX];
    for (int p = c; p < 256; p += G) {
        const int b = p >> 3;
        const int rbase = p * 256 + wave * 32;
        RowF a0, a1;
        row_load(a0, X + (size_t)rbase * D, lane); row_load(a1, X + (size_t)(rbase + 16) * D, lane);
        __syncthreads();
        for (int n = tid; n < 4096; n += NTHREADS) { const int r = (n < 2048) ? b : 32; const int col = n & 2047; float s = bada[col];
#pragma unroll
            for (int kc = 0; kc < 16; ++kc) s += MODP[((size_t)kc * 33 + r) * NMOD + col];
            sv[n] = s; }
        __syncthreads();
        for (int i = 0; i < 16; ++i) {
            RowF n0, n1;
            if (i + 1 < 16) { row_load(n0, X + (size_t)(rbase + i + 1) * D, lane); row_load(n1, X + (size_t)(rbase + 16 + i + 1) * D, lane); }
            else { const int crow = p * 32 + wave * 4; row_load(n0, CTX + (size_t)crow * D, lane); row_load(n1, CTX + (size_t)(crow + 1) * D, lane); }
            norm_mod_row(a0, XN + (size_t)(rbase + i) * D, gain, sv + 1024, sv, lane);
            norm_mod_row(a1, XN + (size_t)(rbase + 16 + i) * D, gain, sv + 1024, sv, lane);
            a0 = n0; a1 = n1;
        }
        {
            const int crow = p * 32 + wave * 4;
            RowF n0, n1;
            row_load(n0, CTX + (size_t)(crow + 2) * D, lane); row_load(n1, CTX + (size_t)(crow + 3) * D, lane);
            norm_mod_row(a0, XN + (size_t)(M + crow) * D, gain, sv + 3072, sv + 2048, lane);
            norm_mod_row(a1, XN + (size_t)(M + crow + 1) * D, gain, sv + 3072, sv + 2048, lane);
            norm_mod_row(n0, XN + (size_t)(M + crow + 2) * D, gain, sv + 3072, sv + 2048, lane);
            norm_mod_row(n1, XN + (size_t)(M + crow + 3) * D, gain, sv + 3072, sv + 2048, lane);
        }
    }
}

namespace att {
constexpr int KP = 272, KBUF = 64 * KP, VBUF = 16384;
constexpr int OFF_K = 0, OFF_V = 2 * KBUF, OFF_WSF = OFF_V + 2 * VBUF, OFF_END = OFF_WSF + NWAVES * 256;
static_assert(OFF_WSF >= 65536 && OFF_END <= RING_BYTES, "attention LDS map");
constexpr int NT = TK / 64;
constexpr float THR = 8.0f;
__device__ __forceinline__ int crow(int r, int hi) { return (r & 3) + 8 * (r >> 2) + 4 * hi; }
__device__ __forceinline__ float max3f(float a, float b, float c) { float r; asm("v_max3_f32 %0, %1, %2, %3" : "=v"(r) : "v"(a), "v"(b), "v"(c)); return r; }
__device__ __forceinline__ float max2f(float a, float b) { float r; asm("v_max_f32_e32 %0, %1, %2" : "=v"(r) : "v"(a), "v"(b)); return r; }
__device__ __forceinline__ s16x4 vtr(const LAS unsigned char* p) { return __builtin_bit_cast(s16x4, __builtin_amdgcn_ds_read_tr16_b64_v4i16((LAS s16x4*)p)); }

#define ATT_BAR() asm volatile("s_waitcnt lgkmcnt(0)\n\ts_barrier" ::: "memory")
#define ATT_SB() __builtin_amdgcn_sched_barrier(0)
#define ATT_KLD(i, KF) KF = *(const LAS bf16x8*)(kb_ + ((i) & 1) * (32 * KP) + ((i) >> 1) * 32)
#define ATT_XSTEP(i, KC, KN) do { if ((i) + 2 < 8) { ATT_KLD((i) + 2, KN); } \
    if ((i) == 0) p0 = __builtin_amdgcn_mfma_f32_32x32x16_bf16(KC, qr[0], negref, 0, 0, 0); \
    else if ((i) == 1) p1 = __builtin_amdgcn_mfma_f32_32x32x16_bf16(KC, qr[0], negref, 0, 0, 0); \
    else if (((i) & 1) == 0) p0 = __builtin_amdgcn_mfma_f32_32x32x16_bf16(KC, qr[(i) >> 1], p0, 0, 0, 0); else p1 = __builtin_amdgcn_mfma_f32_32x32x16_bf16(KC, qr[(i) >> 1], p1, 0, 0, 0); ATT_SB(); } while (0)
#define ATT_X(kcur) do { \
    const LAS unsigned char* kb_ = lds + OFF_K + (kcur) * KBUF + koff; \
    bf16x8 ka_, kb2_, kc_; \
    ATT_KLD(0, ka_); ATT_KLD(1, kb2_); \
    ATT_SB(); \
    ATT_XSTEP(0, ka_, kc_); ATT_XSTEP(1, kb2_, ka_); ATT_XSTEP(2, kc_, kb2_); ATT_XSTEP(3, ka_, kc_); \
    ATT_XSTEP(4, kb2_, ka_); ATT_XSTEP(5, kc_, kb2_); ATT_XSTEP(6, ka_, kc_); ATT_XSTEP(7, kb2_, ka_); \
} while (0)
#define ATT_EXP2(i, PWN) do { \
    const float e0_ = __builtin_amdgcn_exp2f((i) < 8 ? p0[2 * ((i) & 7)] : p1[2 * ((i) & 7)]), e1_ = __builtin_amdgcn_exp2f((i) < 8 ? p0[2 * ((i) & 7) + 1] : p1[2 * ((i) & 7) + 1]); \
    sacc_ += e0_ + e1_; PWN[(i) >> 2][(i) & 3] = pk2(e0_, e1_); asm volatile("" : "+v"(PWN[(i) >> 2]), "+v"(sacc_)); } while (0)
#define ATT_VLD(i, LO, HI) do { LO = vtr(vb_ + ((i) & 3) * 4096 + ((i) >> 2) * 1024); HI = vtr(vb_ + ((i) & 3) * 4096 + ((i) >> 2) * 1024 + 512); } while (0)
#define ATT_VF(LO, HI) ((bf16x8){LO[0], LO[1], LO[2], LO[3], HI[0], HI[1], HI[2], HI[3]})
#define ATT_YSTEP(i, PWC, PWN, LC, HC, LN, HN) do { if ((i) + 2 < 16) { ATT_VLD((i) + 2, LN, HN); } \
    o[(i) & 3] = __builtin_amdgcn_mfma_f32_32x32x16_bf16(__builtin_bit_cast(bf16x8, PWC[(i) >> 2]), ATT_VF(LC, HC), o[(i) & 3], 0, 0, 0); \
    ATT_EXP2(i, PWN); ATT_SB(); } while (0)
#define ATT_Y(vcur, PWC, PWN) do { \
    const LAS unsigned char* vb_ = lds + OFF_V + (vcur) * VBUF + voff; \
    float sacc_ = 0.f; s16x4 la_, ha_, lb_, hb_, lc_, hc_; \
    ATT_VLD(0, la_, ha_); ATT_VLD(1, lb_, hb_); ATT_SB(); \
    ATT_YSTEP(0, PWC, PWN, la_, ha_, lc_, hc_); ATT_YSTEP(1, PWC, PWN, lb_, hb_, la_, ha_); ATT_YSTEP(2, PWC, PWN, lc_, hc_, lb_, hb_); \
    ATT_YSTEP(3, PWC, PWN, la_, ha_, lc_, hc_); ATT_YSTEP(4, PWC, PWN, lb_, hb_, la_, ha_); ATT_YSTEP(5, PWC, PWN, lc_, hc_, lb_, hb_); \
    ATT_YSTEP(6, PWC, PWN, la_, ha_, lc_, hc_); ATT_YSTEP(7, PWC, PWN, lb_, hb_, la_, ha_); ATT_YSTEP(8, PWC, PWN, lc_, hc_, lb_, hb_); \
    ATT_YSTEP(9, PWC, PWN, la_, ha_, lc_, hc_); ATT_YSTEP(10, PWC, PWN, lb_, hb_, la_, ha_); ATT_YSTEP(11, PWC, PWN, lc_, hc_, lb_, hb_); \
    ATT_YSTEP(12, PWC, PWN, la_, ha_, lc_, hc_); ATT_YSTEP(13, PWC, PWN, lb_, hb_, la_, ha_); ATT_YSTEP(14, PWC, PWN, lc_, hc_, lb_, hb_); \
    ATT_YSTEP(15, PWC, PWN, la_, ha_, lc_, hc_); \
    l_reg += sacc_; \
} while (0)
#define ATT_Y0(PWN) do { float sacc_ = 0.f; _Pragma("unroll") for (int i = 0; i < 16; ++i) ATT_EXP2(i, PWN); l_reg += sacc_; } while (0)
#define ATT_ZSTEP(i, PWC, LC, HC, LN, HN) do { if ((i) + 2 < 16) { ATT_VLD((i) + 2, LN, HN); } \
    o[(i) & 3] = __builtin_amdgcn_mfma_f32_32x32x16_bf16(__builtin_bit_cast(bf16x8, PWC[(i) >> 2]), ATT_VF(LC, HC), o[(i) & 3], 0, 0, 0); ATT_SB(); } while (0)
#define ATT_Z(vcur, PWC) do { \
    const LAS unsigned char* vb_ = lds + OFF_V + (vcur) * VBUF + voff; \
    s16x4 la_, ha_, lb_, hb_, lc_, hc_; \
    ATT_VLD(0, la_, ha_); ATT_VLD(1, lb_, hb_); ATT_SB(); \
    ATT_ZSTEP(0, PWC, la_, ha_, lc_, hc_); ATT_ZSTEP(1, PWC, lb_, hb_, la_, ha_); ATT_ZSTEP(2, PWC, lc_, hc_, lb_, hb_); \
    ATT_ZSTEP(3, PWC, la_, ha_, lc_, hc_); ATT_ZSTEP(4, PWC, lb_, hb_, la_, ha_); ATT_ZSTEP(5, PWC, lc_, hc_, lb_, hb_); \
    ATT_ZSTEP(6, PWC, la_, ha_, lc_, hc_); ATT_ZSTEP(7, PWC, lb_, hb_, la_, ha_); ATT_ZSTEP(8, PWC, lc_, hc_, lb_, hb_); \
    ATT_ZSTEP(9, PWC, la_, ha_, lc_, hc_); ATT_ZSTEP(10, PWC, lb_, hb_, la_, ha_); ATT_ZSTEP(11, PWC, lc_, hc_, lb_, hb_); \
    ATT_ZSTEP(12, PWC, la_, ha_, lc_, hc_); ATT_ZSTEP(13, PWC, lb_, hb_, la_, ha_); ATT_ZSTEP(14, PWC, lc_, hc_, lb_, hb_); \
    ATT_ZSTEP(15, PWC, la_, ha_, lc_, hc_); \
} while (0)
#define ATT_STAGE(j) do { \
    if ((j) + 1 < NT) { _Pragma("unroll") for (int i = 0; i < 2; ++i) *(LAS u32x4*)(lds + OFF_K + (((j) + 1) & 1) * KBUF + kdst[i]) = kr[i]; } \
    _Pragma("unroll") for (int i = 0; i < 2; ++i) *(LAS u32x4*)(lds + OFF_V + ((j) & 1) * VBUF + vdst[i]) = vr[i]; \
    if ((j) + 2 < NT) { _Pragma("unroll") for (int i = 0; i < 2; ++i) kr[i] = *(const u32x4*)(Kb + (size_t)((j) + 2) * 64 * 512 + gsrc[i]); } \
    if ((j) + 1 < NT) { _Pragma("unroll") for (int i = 0; i < 2; ++i) vr[i] = *(const u32x4*)(Vb + (size_t)((j) + 1) * 64 * 512 + gsrc[i]); } } while (0)

__device__ __forceinline__ void unit(LAS unsigned char* lds, int b, int h, int qb, const bf16_t* Q, const bf16_t* KA, const bf16_t* VA, bf16_t* MIXIN, const float* subg, float lam, const unsigned* KM) {
    const int tid = opaque_tid(), lane = tid & 63, r32 = lane & 31, hi = lane >> 5;
    const int wid = __builtin_amdgcn_readfirstlane(tid >> 6), w = wid & 3, m = wid >> 2;
    LAS float* wsf = (LAS float*)(lds + OFF_WSF) + wid * 64;
    const int rowQ = b * T + qb * 128 + w * 32;
    bf16x8 qr[4];
#pragma unroll
    for (int d0 = 0; d0 < 4; ++d0) qr[d0] = *(const bf16x8*)(Q + (size_t)(rowQ + r32) * 512 + h * 128 + m * 64 + d0 * 16 + hi * 8);
    const bf16_t* Kb = KA + (size_t)b * TK * 512 + h * 128; const bf16_t* Vb = VA + (size_t)b * TK * 512 + h * 128;
    int gsrc[2], kdst[2], vdst[2];
#pragma unroll
    for (int i = 0; i < 2; ++i) { const int cid = tid + 512 * i, kv = cid >> 4, c16 = cid & 15;
        gsrc[i] = kv * 512 + c16 * 8; kdst[i] = kv * KP + c16 * 16; vdst[i] = (c16 >> 2) * 4096 + (kv >> 4) * 1024 + (kv & 15) * 64 + (c16 & 3) * 16; }
    u32x4 kr[2], vr[2];
#pragma unroll
    for (int i = 0; i < 2; ++i) { kr[i] = *(const u32x4*)(Kb + gsrc[i]); vr[i] = *(const u32x4*)(Vb + gsrc[i]); }
#pragma unroll
    for (int i = 0; i < 2; ++i) *(LAS u32x4*)(lds + OFF_K + kdst[i]) = kr[i];
#pragma unroll
    for (int i = 0; i < 2; ++i) kr[i] = *(const u32x4*)(Kb + (size_t)64 * 512 + gsrc[i]);
    ATT_BAR();
    f32x16 o[4];
#pragma unroll
    for (int d0 = 0; d0 < 4; ++d0) o[d0] = (f32x16){};
    float l_reg = 0.f;
    f32x16 p0, p1, negref;
    {
        const unsigned* km = KM + (b * 8 + h * 2 + m) * 2;
        const float kmax2 = __uint_as_float(km[0]) + __uint_as_float(km[1]);
        float ss = 0.f;
#pragma unroll
        for (int d0 = 0; d0 < 4; ++d0)
#pragma unroll
            for (int i = 0; i < 8; ++i) { const float v = bf2f((unsigned short)qr[d0][i]); ss += v * v; }
        ss += __shfl_xor(ss, 32);
        const float ref = sqrtf(ss * kmax2) * 1.02f;
#pragma unroll
        for (int r = 0; r < 16; ++r) negref[r] = -ref;
    }
    u32x4 pwA[4], pwB[4];
    const int koff = r32 * KP + m * 128 + hi * 16;
    const int voff = ((lane >> 4) & 1) * 32 + (lane & 3) * 8 + (4 * hi + ((lane & 15) >> 2)) * 64;
    ATT_X(0); ATT_STAGE(0); ATT_Y0(pwA); ATT_BAR();
    ATT_X(1); ATT_STAGE(1); ATT_Y(0, pwA, pwB); ATT_BAR();
    for (int j = 2; j < NT; j += 2) {
        ATT_X(0); ATT_STAGE(j); ATT_Y(1, pwB, pwA); ATT_BAR();
        ATT_X(1); ATT_STAGE(j + 1); ATT_Y(0, pwA, pwB); ATT_BAR();
    }
    ATT_Z(1, pwB); ATT_BAR();
    l_reg += __shfl_xor(l_reg, 32);
    if (hi == 0) wsf[32 + r32] = l_reg;
    LDS_WAIT();
    float rli[16];
#pragma unroll
    for (int r = 0; r < 16; ++r) rli[r] = 1.0f / wsf[32 + crow(r, hi)];
    LDS_WAIT();
    LAS float* ex = (LAS float*)lds + w * 4096;
    if (m == 1) {
#pragma unroll
        for (int r = 0; r < 16; ++r)
#pragma unroll
            for (int d0 = 0; d0 < 4; ++d0) ex[crow(r, hi) * 128 + d0 * 32 + r32] = o[d0][r] * rli[r];
    }
    ATT_BAR();
    if (m == 0) {
        float g4[4];
#pragma unroll
        for (int d0 = 0; d0 < 4; ++d0) g4[d0] = subg[d0 * 32 + r32] * (1.0f - LAM_INIT);
#pragma unroll
        for (int r = 0; r < 16; ++r) {
            const int q = crow(r, hi); float x[4]; float ss = 0.f;
#pragma unroll
            for (int d0 = 0; d0 < 4; ++d0) { x[d0] = o[d0][r] * rli[r] - lam * ex[q * 128 + d0 * 32 + r32]; ss += x[d0] * x[d0]; }
#pragma unroll
            for (int off = 1; off < 32; off <<= 1) ss += __shfl_xor(ss, off);
            const float rstd = 1.0f / sqrtf(ss * (1.f / 128.f) + EPS);
            bf16_t* dst = MIXIN + (size_t)(rowQ + q) * 1024 + h * 128 + r32;
#pragma unroll
            for (int d0 = 0; d0 < 4; ++d0) dst[d0 * 32] = (bf16_t)(pk2(x[d0] * rstd * g4[d0], 0.f) & 0xffffu);
        }
    }
    ATT_BAR();
}
#undef ATT_BAR
#undef ATT_X
#undef ATT_EXP2
#undef ATT_Y
#undef ATT_Y0
#undef ATT_Z
#undef ATT_STAGE
#undef ATT_SB
#undef ATT_KLD
#undef ATT_XSTEP
#undef ATT_VLD
#undef ATT_VF
#undef ATT_YSTEP
#undef ATT_ZSTEP
}

__device__ __forceinline__ void p3_conv_attn(const Args& a, LAS unsigned char* lds, int c, int vcu, int G) {
    const int tid = opaque_tid(), lane = tid & 63, wave = __builtin_amdgcn_readfirstlane(tid >> 6);
    unsigned char* ws = a.ws;
    const bf16_t* GB = (const bf16_t*)(ws + WS_GB); const bf16_t* U = (const bf16_t*)(ws + WS_U); bf16_t* MIXIN = (bf16_t*)(ws + WS_MIXIN);
    {
        const float* cw = a.in[I_CONVW]; float w0[8], w1[8], w2[8];
#pragma unroll
        for (int i = 0; i < 8; ++i) { w0[i] = cw[lane * 8 + i]; w1[i] = cw[512 + lane * 8 + i]; w2[i] = cw[1024 + lane * 8 + i]; }
        const int gw = vcu * NWAVES + wave, NGW = G * NWAVES;
        for (int row = gw; row < M; row += NGW) {
            const int t = row & (T - 1);
            const u32x4 z = {0u, 0u, 0u, 0u};
            const u32x4 uc = *(const u32x4*)(U + (size_t)row * 512 + lane * 8);
            const u32x4 up = (t > 0) ? *(const u32x4*)(U + (size_t)(row - 1) * 512 + lane * 8) : z;
            const u32x4 un = (t < T - 1) ? *(const u32x4*)(U + (size_t)(row + 1) * 512 + lane * 8) : z;
            const u32x4 gb = *(const u32x4*)(GB + (size_t)row * 512 + lane * 8);
            u32x4 o;
#pragma unroll
            for (int q = 0; q < 4; ++q) {
                const float y0 = w0[2 * q] * bflo(up[q]) + w1[2 * q] * bflo(uc[q]) + w2[2 * q] * bflo(un[q]);
                const float y1 = w0[2 * q + 1] * bfhi(up[q]) + w1[2 * q + 1] * bfhi(uc[q]) + w2[2 * q + 1] * bfhi(un[q]);
                o[q] = pk2(bflo(gb[q]) * y0, bfhi(gb[q]) * y1);
            }
            *(u32x4*)(MIXIN + (size_t)row * 1024 + 512 + lane * 8) = o;
        }
    }
    float lam;
    { const float p1 = a.in[I_LQ1][lane] * a.in[I_LK1][lane], p2 = a.in[I_LQ2][lane] * a.in[I_LK2][lane];
      lam = __expf(wave_sum(p1)) - __expf(wave_sum(p2)) + LAM_INIT; }
    const bf16_t* Q = (const bf16_t*)(ws + WS_Q); const bf16_t* KA = (const bf16_t*)(ws + WS_K); const bf16_t* VA = (const bf16_t*)(ws + WS_V);
    __syncthreads();
    for (int u = vcu * 8; u < 2048; u += G * 8) {
        const int x = (u >> 3) / 32, jj = (u >> 3) % 32;
        for (int i = 0; i < 8; ++i) {
            const int bh = 16 * x + 2 * i + (jj >> 4), qb = jj & 15;
            att::unit(lds, bh >> 2, bh & 3, qb, Q, KA, VA, MIXIN, a.in[I_SUBLN], lam, (const unsigned*)(ws + WS_CTL) + CW_KMAX);
        }
    }
}

struct P5In { f32x4 x[4]; u32x2 m[4]; };
__device__ __forceinline__ void p5_load(P5In& r, int row, int lane, const float* X, const bf16_t* MIX) {
    const f32x4* xr = (const f32x4*)(X + (size_t)row * D) + lane; const u32x2* mr = (const u32x2*)(MIX + (size_t)row * D) + lane;
#pragma unroll
    for (int j = 0; j < 4; ++j) { r.x[j] = __builtin_nontemporal_load(xr + 64 * j); r.m[j] = __builtin_nontemporal_load(mr + 64 * j); }
}
__device__ __forceinline__ float p5_resid(const P5In& r, f32x4 (&h)[4], int row, int lane, const LAS float* mv, const f32x4* npm, bf16_t* H1) {
    f32x4 mx[4]; float s = 0.f;
#pragma unroll
    for (int j = 0; j < 4; ++j) { const u32x2 wv = r.m[j]; mx[j] = (f32x4){bflo(wv.x), bfhi(wv.x), bflo(wv.y), bfhi(wv.y)};
        s += (mx[j].x * mx[j].x + mx[j].y * mx[j].y) + (mx[j].z * mx[j].z + mx[j].w * mx[j].w); }
    const float rstd1 = 1.0f / sqrtf(wave_sum(s) * (1.f / D) + EPS);
    u32x2* hr = (u32x2*)(H1 + (size_t)row * D) + lane; float s2 = 0.f;
#pragma unroll
    for (int j = 0; j < 4; ++j) { const f32x4 g1 = *(const LAS f32x4*)(mv + 4 * lane + 256 * j);
        h[j] = r.x[j] + g1 * ((mx[j] * rstd1) * npm[64 * j]);
        u32x2 wv; wv.x = pk2(h[j].x, h[j].y); wv.y = pk2(h[j].z, h[j].w); __builtin_nontemporal_store(wv, hr + 64 * j);
        s2 += (h[j].x * h[j].x + h[j].y * h[j].y) + (h[j].z * h[j].z + h[j].w * h[j].w); }
    return 1.0f / sqrtf(wave_sum(s2) * (1.f / D) + EPS);
}
__device__ __forceinline__ void p5_rows(const Args& a, LAS unsigned char* lds, int p  ) {
    const int tid = opaque_tid(), lane = tid & 63, wave = __builtin_amdgcn_readfirstlane(tid >> 6);
    unsigned char* ws = a.ws;
    const int b = p >> 3;
    LAS float* wrt = (LAS float*)lds;
    LAS float* mv = (LAS float*)(lds + 65536);
    const float* wr = a.in[I_WROUTER];
    const bf16_t* MIX = (const bf16_t*)(ws + WS_MIX); bf16_t* XN2 = (bf16_t*)(ws + WS_XN); float* AFFT = (float*)(ws + WS_AFFT); bf16_t* H1 = (bf16_t*)(ws + WS_H1);
    const float* X = a.in[I_X];
    const int rbase = p * 256 + wave * 32;
    P5In cA, cB;
    p5_load(cA, rbase, lane, X, MIX); p5_load(cB, rbase + 16, lane, X, MIX);
    for (int n = tid; n < D * NE; n += NTHREADS) { const int k = n >> 4, e = n & 15; wrt[e * D + k] = wr[n]; }
    const float* MOD = (const float*)(ws + WS_MOD) + (size_t)b * NMOD;
    for (int n = tid; n < 3 * D; n += NTHREADS) mv[n] = MOD[2 * D + n];
    __syncthreads();
    const f32x4* npm = (const f32x4*)a.in[I_NPOST_MIX] + lane; const f32x4* npf = (const f32x4*)a.in[I_NPRE_FFN] + lane;
    for (int i = 0; i < 16; ++i) {
        const int rowA = rbase + i, rowB = rbase + 16 + i;
        P5In nA, nB;
        if (i + 1 < 16) { p5_load(nA, rowA + 1, lane, X, MIX); p5_load(nB, rowB + 1, lane, X, MIX); }
        f32x4 hA[4], hB[4];
        const float rsA = p5_resid(cA, hA, rowA, lane, mv, npm, H1);
        const float rsB = p5_resid(cB, hB, rowB, lane, mv, npm, H1);
        u32x2* oA = (u32x2*)(XN2 + (size_t)rowA * D) + lane; u32x2* oB = (u32x2*)(XN2 + (size_t)rowB * D) + lane;
        typedef float f32x2v __attribute__((ext_vector_type(2)));
        f32x2v lg2[16];
#pragma unroll
        for (int e = 0; e < 16; ++e) lg2[e] = (f32x2v){0.f, 0.f};
#pragma unroll
        for (int j = 0; j < 4; ++j) { const f32x4 sh2 = *(const LAS f32x4*)(mv + 1024 + 4 * lane + 256 * j), sc2 = *(const LAS f32x4*)(mv + 2048 + 4 * lane + 256 * j);
            const f32x4 gn = npf[64 * j];
            const f32x4 zA = ((hA[j] * rsA) * gn) * (sc2 + 1.0f) + sh2, zB = ((hB[j] * rsB) * gn) * (sc2 + 1.0f) + sh2;
            u32x2 wv; wv.x = pk2(zA.x, zA.y); wv.y = pk2(zA.z, zA.w); oA[64 * j] = wv; wv.x = pk2(zB.x, zB.y); wv.y = pk2(zB.z, zB.w); oB[64 * j] = wv;
            const f32x2v zx = {zA.x, zB.x}, zy = {zA.y, zB.y}, zz = {zA.z, zB.z}, zw = {zA.w, zB.w};
#pragma unroll
            for (int e = 0; e < 16; ++e) { const f32x4 wq = *(const LAS f32x4*)(wrt + e * D + 4 * lane + 256 * j);
                lg2[e] = __builtin_elementwise_fma(zx, (f32x2v){wq.x, wq.x}, lg2[e]); lg2[e] = __builtin_elementwise_fma(zy, (f32x2v){wq.y, wq.y}, lg2[e]);
                lg2[e] = __builtin_elementwise_fma(zz, (f32x2v){wq.z, wq.z}, lg2[e]); lg2[e] = __builtin_elementwise_fma(zw, (f32x2v){wq.w, wq.w}, lg2[e]);
                if ((e & 3) == 3) __builtin_amdgcn_sched_barrier(0); } }
        float lg[32];
#pragma unroll
        for (int e = 0; e < 16; ++e) { lg[e] = lg2[e].x; lg[16 + e] = lg2[e].y; }
#pragma unroll
        for (int st = 0; st < 5; ++st) { const int d = 1 << st, cntv = 16 >> st; const bool up = (lane & d) != 0;
#pragma unroll
            for (int q = 0; q < 16; ++q) if (q < cntv) { const float send = up ? lg[2 * q] : lg[2 * q + 1], keep = up ? lg[2 * q + 1] : lg[2 * q]; lg[q] = keep + __shfl_xor(send, d); } }
        float lv = lg[0] + __shfl_xor(lg[0], 32);
        float mxl = lv;
#pragma unroll
        for (int d = 1; d < 16; d <<= 1) mxl = fmaxf(mxl, __shfl_xor(mxl, d));
        const float ev = __expf(lv - mxl); float se = ev;
#pragma unroll
        for (int d = 1; d < 16; d <<= 1) se += __shfl_xor(se, d);
        if (lane < 32) { const int row = (lane < 16) ? rowA : rowB; AFFT[((size_t)b * NE + (lane & 15)) * T + (row & (T - 1))] = ev / se; }
        cA = nA; cB = nB;
    }
}

__device__ __forceinline__ void p6_topk(const Args& a, LAS unsigned char* lds, int c, int G) {
    const int tid = opaque_tid(), lane = tid & 63, wave = __builtin_amdgcn_readfirstlane(tid >> 6);
    unsigned char* ws = a.ws;
    const float* AFFT = (const float*)(ws + WS_AFFT); short* SLOT = (short*)(ws + WS_SLOT); int* IDX = (int*)(ws + WS_IDX); float* GATE = (float*)(ws + WS_GATE);
    LAS unsigned* sv = (LAS unsigned*)(lds + wave * 16384);
    for (int item = c + wave * G; item < NITEM; item += G * NWAVES) {
        const int b = item >> 4, e = item & 15;
        const float* src = AFFT + (size_t)item * T;
#pragma unroll 8
        for (int j = 0; j < 32; ++j) sv[j * 64 + lane] = __float_as_uint(src[j * 64 + lane]);
        LDS_WAIT(); asm volatile("" ::: "memory");
        unsigned pre = 0u;
        for (int bit = 30; bit >= 0; --bit) {
            const unsigned cand = pre | (1u << bit);
            int cnt = 0;
#pragma unroll 4
            for (int j = 0; j < 32; ++j) cnt += (int)__popcll(__ballot(sv[j * 64 + lane] >= cand));
            if (cnt >= CAP) pre = cand;
        }
        int ngt = 0;
#pragma unroll 4
        for (int j = 0; j < 32; ++j) ngt += (int)__popcll(__ballot(sv[j * 64 + lane] > pre));
        const int need_eq = CAP - ngt;
        const unsigned long long ltmask = (1ull << lane) - 1ull;
        int base_gt = 0, base_eq = 0;
#pragma unroll 2
        for (int j = 0; j < 32; ++j) {
            const unsigned vj = sv[j * 64 + lane];
            const bool gt = vj > pre, eq = vj == pre;
            const unsigned long long mg = __ballot(gt), me = __ballot(eq);
            const int pg = base_gt + (int)__popcll(mg & ltmask), pe = base_eq + (int)__popcll(me & ltmask);
            int sl = -1; if (gt) sl = pg; else if (eq && pe < need_eq) sl = ngt + pe;
            const int t = j * 64 + lane;
            SLOT[((size_t)b * T + t) * NE + e] = (short)sl;
            if (sl >= 0) { IDX[item * CAP + sl] = t; GATE[item * CAP + sl] = __uint_as_float(vj); }
            base_gt += (int)__popcll(mg); base_eq += (int)__popcll(me);
        }
        LDS_WAIT(); asm volatile("" ::: "memory");
    }
}

struct P8Row { u32x2 h[4]; u32x2 y[4][4]; float wt[4]; unsigned long long rest; int sl; };
__device__ __forceinline__ void p8_issue(P8Row& r, int row, int lane, const short* SLOT, const bf16_t* Y, const bf16_t* H1) {
    const int b = row >> 11;
    const int s_e = (lane < NE) ? (int)SLOT[(size_t)row * NE + lane] : -1;
    unsigned long long mask = __ballot(s_e >= 0);
    const u32x2* hr = (const u32x2*)(H1 + (size_t)row * D) + lane;
#pragma unroll
    for (int j = 0; j < 4; ++j) r.h[j] = __builtin_nontemporal_load(hr + 64 * j);
#pragma unroll
    for (int q = 0; q < 4; ++q) {
        int e = 0, s = 0; r.wt[q] = 0.f;
        if (mask) { e = (int)__builtin_ctzll(mask); mask &= mask - 1ull; s = __builtin_amdgcn_readlane(s_e, e); r.wt[q] = 1.f; }
        const u32x2* yr = (const u32x2*)(Y + ((size_t)(b * NE + e) * CAP + s) * D) + lane;
#pragma unroll
        for (int j = 0; j < 4; ++j) r.y[q][j] = __builtin_nontemporal_load(yr + 64 * j);
    }
    r.rest = mask; r.sl = s_e;
}
__device__ __forceinline__ void p8_finish(P8Row& r, int row, int lane, const bf16_t* Y, const float* MOD, const f32x4* npo, float* out) {
    const int b = row >> 11;
    f32x4 ff[4];
#pragma unroll
    for (int j = 0; j < 4; ++j) ff[j] = (f32x4){0.f, 0.f, 0.f, 0.f};
#pragma unroll
    for (int q = 0; q < 4; ++q)
#pragma unroll
        for (int j = 0; j < 4; ++j) { const u32x2 wv = r.y[q][j]; ff[j] += (f32x4){bflo(wv.x), bfhi(wv.x), bflo(wv.y), bfhi(wv.y)} * r.wt[q]; }
    unsigned long long mask = r.rest;
    while (mask) {
        const int e = (int)__builtin_ctzll(mask); mask &= mask - 1ull; const int s = __builtin_amdgcn_readlane(r.sl, e);
        const u32x2* yr = (const u32x2*)(Y + ((size_t)(b * NE + e) * CAP + s) * D) + lane;
#pragma unroll
        for (int j = 0; j < 4; ++j) { const u32x2 wv = yr[64 * j]; ff[j] += (f32x4){bflo(wv.x), bfhi(wv.x), bflo(wv.y), bfhi(wv.y)}; }
    }
    float s2 = 0.f;
#pragma unroll
    for (int j = 0; j < 4; ++j) s2 += (ff[j].x * ff[j].x + ff[j].y * ff[j].y) + (ff[j].z * ff[j].z + ff[j].w * ff[j].w);
    const float rstd = 1.0f / sqrtf(wave_sum(s2) * (1.f / D) + EPS);
    f32x4* orow = (f32x4*)(out + (size_t)row * D) + lane; const f32x4* g2 = (const f32x4*)(MOD + (size_t)b * NMOD + 5 * D) + lane;
#pragma unroll
    for (int j = 0; j < 4; ++j) { const u32x2 hv = r.h[j]; const f32x4 h = (f32x4){bflo(hv.x), bfhi(hv.x), bflo(hv.y), bfhi(hv.y)};
        __builtin_nontemporal_store(h + g2[64 * j] * ((ff[j] * rstd) * npo[64 * j]), orow + 64 * j); }
}
__device__ __forceinline__ void p8_final(const Args& a, int vcu, int G) {
    const int tid = opaque_tid(), lane = tid & 63, wave = __builtin_amdgcn_readfirstlane(tid >> 6);
    unsigned char* ws = a.ws;
    const short* SLOT = (const short*)(ws + WS_SLOT); const bf16_t* Y = (const bf16_t*)(ws + WS_Y); const float* MOD = (const float*)(ws + WS_MOD); const bf16_t* H1 = (const bf16_t*)(ws + WS_H1);
    const f32x4* npo = (const f32x4*)a.in[I_NPOST_FFN] + lane;
    const int gw = vcu * NWAVES + wave, NGW = G * NWAVES;
    for (int row = gw; row < M; row += 2 * NGW) {
        P8Row r0, r1;
        p8_issue(r0, row, lane, SLOT, Y, H1);
        const bool two = row + NGW < M;
        if (two) p8_issue(r1, row + NGW, lane, SLOT, Y, H1);
        p8_finish(r0, row, lane, Y, MOD, npo, a.out);
        if (two) p8_finish(r1, row + NGW, lane, Y, MOD, npo, a.out);
    }
}

__global__ void __launch_bounds__(NTHREADS, 2) fwd_kernel(Args args) {
    extern __shared__ __attribute__((aligned(16))) unsigned char lds_raw[];
    LAS unsigned char* lds = (LAS unsigned char*)lds_raw;
    volatile LAS unsigned* MISC = (volatile LAS unsigned*)(lds + MISC_OFF);
    const int tid = threadIdx.x;
    const int G = gridDim.x, c = blockIdx.x;
    const int vcu = (G % 8 == 0) ? (c % 8) * (G / 8) + c / 8 : c;
    unsigned char* ws = args.ws;
    gu32* ctl = (gu32*)(ws + WS_CTL);
    for (int u = tid; u < (LDS_BYTES - LDSCTL_OFF) / 4; u += NTHREADS) ((LAS unsigned*)(lds + LDSCTL_OFF))[u] = 0u;
    __syncthreads();
    XcdBarrier bar; bar.bar = (unsigned*)(ctl + CW_BAR); bar.x = 0; bar.st = nullptr;
    const int lo = args.ph_lo, hi = args.ph_hi;
    if (hi - lo > 1) bar = xcd_barrier_post((unsigned*)(ctl + CW_BAR), MISC + 8);
#ifndef PHMASK
#define PHMASK 0xff
#endif
#define IN(k) (((PHMASK >> (k)) & 1) && lo <= (k) && (k) < hi)
#define SEAM(k) do { if (IN(k) && IN((k) + 1)) xcd_barrier(bar); } while (0)
#ifndef PROBE_PHASE
#define PROBE_PHASE -1
#endif
#define PB(k) do { if (PROBE_PHASE == (k)) { if (tid == 0) { const unsigned long long t0_ = __builtin_amdgcn_s_memrealtime(); MISC[16] = (unsigned)t0_; MISC[17] = (unsigned)(t0_ >> 32); } } } while (0)
#define PE(k) do { if (PROBE_PHASE == (k)) { if (tid == 0) { const unsigned long long t0_ = ((unsigned long long)MISC[17] << 32) | MISC[16]; const unsigned long long t1_ = __builtin_amdgcn_s_memrealtime(); \
      while (__builtin_amdgcn_s_memrealtime() - t1_ < t1_ - t0_) __builtin_amdgcn_s_sleep(8); } __syncthreads(); } } while (0)

    PB(0); if (IN(0)) { p0_prologue(args, lds, vcu, G); } SEAM(0); PE(0);
    PB(1); if (IN(1)) { p1_xn(args, lds, c, G); } SEAM(1); PE(1);
    PB(2); if (IN(2)) {
        pg8::Gemm g{(const bf16_t*)(ws + WS_XN), (const bf16_t*)(ws + WS_WIN), D, nullptr};
        pg8::SchedProj S{G, c};
        pg8::EpiProj E{(bf16_t*)(ws + WS_Q), (bf16_t*)(ws + WS_K), (bf16_t*)(ws + WS_V), (bf16_t*)(ws + WS_GB), (bf16_t*)(ws + WS_U), (const float*)(ws + WS_TAB), (unsigned*)(ws + WS_CTL) + CW_KMAX};
        pg8::gemm_phase<pg8::EpiProj, pg8::SchedProj, true, true>(lds, g, S, E);
    } SEAM(2); PE(2);
    PB(3); if (IN(3)) { if (c & 1) expert_weight_copies(args, lds, vcu, G); p3_conv_attn(args, lds, c, vcu, G); if (!(c & 1)) expert_weight_copies(args, lds, vcu, G); } SEAM(3); PE(3);
    PB(4); if (IN(4)) {
        {
            const int p = c;
#ifndef NO_P4
            pg8::Gemm g{(const bf16_t*)(ws + WS_MIXIN), (const bf16_t*)(ws + WS_WOUT), D, nullptr};
            pg8::SchedPanel S{p, 4};
            pg8::EpiBf16 E{(bf16_t*)(ws + WS_MIX), D};
            pg8::gemm_phase<pg8::EpiBf16, pg8::SchedPanel, true, true>(lds, g, S, E);
#endif
            VM_WAIT(); __syncthreads();
#ifndef NO_P5
            p5_rows(args, lds, p);
#endif
            __syncthreads();
        }
    } SEAM(4); PE(4);
    PB(5); if (IN(5)) { p6_topk(args, lds, c, G); } SEAM(5); PE(5);
    PB(6); if (IN(6)) {
#pragma unroll 1
        for (int it = 0; it < 2; ++it) {
            {
                const int item = 2 * c + it;
                const int b = item >> 4, e = item & 15;
                {
                    const int lane_ = opaque_tid() & 63, wave_ = __builtin_amdgcn_readfirstlane(opaque_tid() >> 6), j_ = (c >> 3) & 31;
                    LAS unsigned char* scr_ = lds + LDSCTL_OFF + 2048 + wave_ * 1024;
                    prefetch_slice(ws + WS_WGU + (size_t)e * 2048 * D * 2 + (size_t)j_ * 131072 + wave_ * 16384, 16384, scr_, lane_);
                    prefetch_slice(ws + WS_WDN + (size_t)e * D * D * 2 + (size_t)j_ * 65536 + wave_ * 8192, 8192, scr_, lane_);
                }
#ifndef NO_G1
                if (it == 0) PB(8);
                {
                    pg8::Gemm g{(const bf16_t*)(ws + WS_XN) + (size_t)b * T * D, (const bf16_t*)(ws + WS_WGU) + (size_t)e * 2048 * D, D, (const int*)(ws + WS_IDX) + item * CAP};
                    pg8::SchedPanel S{0, 8};
                    pg8::EpiGU E{(bf16_t*)(ws + WS_HMID) + (size_t)item * CAP * D};
                    pg8::gemm_phase<pg8::EpiGU, pg8::SchedPanel, true, true, true>(lds, g, S, E);
                }
#endif
                VM_WAIT(); __syncthreads();
                if (it == 0) { PE(8); PB(9); }
#ifndef NO_G2
                {
                    pg8::Gemm g{(const bf16_t*)(ws + WS_HMID) + (size_t)item * CAP * D, (const bf16_t*)(ws + WS_WDN) + (size_t)e * D * D, D, nullptr};
                    pg8::SchedPanel S{0, 4};
                    pg8::EpiDown E{(bf16_t*)(ws + WS_Y) + (size_t)item * CAP * D, (const float*)(ws + WS_GATE) + item * CAP};
                    pg8::gemm_phase<pg8::EpiDown, pg8::SchedPanel, true, true>(lds, g, S, E);
                }
#endif
                VM_WAIT(); __syncthreads();
                if (it == 0) PE(9);
            }
        }
    } SEAM(6); PE(6);
    PB(7); if (IN(7)) { p8_final(args, vcu, G); } PE(7);
#undef IN
#undef SEAM
}

extern "C" void kernel_launch(void* const* d_in, const int* in_sizes, int n_in, void* d_out, int out_size, void* d_ws, size_t ws_size, hipStream_t stream) {
    static int grid = 0;
    if (grid == 0) {
        if (n_in != 22 || in_sizes[0] != M * D || out_size != M * D || ws_size < WS_END) { fprintf(stderr, "kernel_launch: unexpected shapes (n_in %d, in0 %d, out %d, ws %zu)\n", n_in, n_in > 0 ? in_sizes[0] : -1, out_size, ws_size); grid = -1; return; }
        int dev = 0, cus = 0;
        if (hipGetDevice(&dev) != hipSuccess || hipDeviceGetAttribute(&cus, hipDeviceAttributeMultiprocessorCount, dev) != hipSuccess) { grid = -1; return; }
        if (hipFuncSetAttribute((const void*)fwd_kernel, hipFuncAttributeMaxDynamicSharedMemorySize, LDS_BYTES) != hipSuccess) { fprintf(stderr, "kernel_launch: hipFuncSetAttribute failed\n"); grid = -1; return; }
        (void)hipGetLastError();
        grid = cus;
        if (grid != 256) { fprintf(stderr, "kernel_launch: this kernel needs a 256-CU device (got %d)\n", cus); grid = -1; return; }
    }
    if (grid < 0) return;
    (void)hipMemsetAsync((char*)d_ws + WS_CTL, 0, CTL_ZERO_BYTES, stream);
    Args a{};
    for (int i = 0; i < 22; ++i) a.in[i] = (const float*)d_in[i];
    a.out = (float*)d_out; a.ws = (unsigned char*)d_ws;
    constexpr int NPH = 8;
    if (MK_N_LAUNCHES == 1) { a.ph_lo = 0; a.ph_hi = NPH; hipLaunchKernelGGL(fwd_kernel, dim3(grid), dim3(NTHREADS), LDS_BYTES, stream, a); }
    else { for (int k = 0; k < NPH; ++k) { a.ph_lo = k; a.ph_hi = k + 1; hipLaunchKernelGGL(fwd_kernel, dim3(grid), dim3(NTHREADS), LDS_BYTES, stream, a); } }
}
```

```cpp
#include <hip/hip_runtime.h>
#include <cstdio>
#include <cstdint>

#ifndef MK_N_LAUNCHES
#define MK_N_LAUNCHES 1
#endif

#define LAS __attribute__((address_space(3)))
#define GAS __attribute__((address_space(1)))
typedef unsigned short bf16_t;
typedef short bf16x8 __attribute__((ext_vector_type(8)));
typedef short s16x4 __attribute__((ext_vector_type(4)));
typedef float f32x4 __attribute__((ext_vector_type(4)));
typedef float f32x16 __attribute__((ext_vector_type(16)));
typedef unsigned u32x4 __attribute__((ext_vector_type(4)));
typedef unsigned u32x2 __attribute__((ext_vector_type(2)));

constexpr int NB = 32, T = 2048, D = 1024, TC = 256, M = NB * T, MC = NB * TC, MA = M + MC, TK = TC + T;
constexpr int NE = 16, CAP = 256, NITEM = NB * NE, NPROJ = 3072, NMOD = 6 * D;
constexpr float EPS = 1e-6f;
constexpr float C2 = 0.125f * 1.4426950408889634f;
constexpr float LAM_INIT = 0.2f;
constexpr int NWAVES = 8, NTHREADS = 512;

constexpr size_t MiB = 1u << 20;
constexpr size_t WS_CTL = 0, CTL_ZERO_BYTES = 1 * MiB;
constexpr size_t WS_MODP = 2 * MiB;
constexpr size_t WS_MOD = 16 * MiB;
constexpr size_t WS_TAB = 17 * MiB;
constexpr size_t WS_WIN = 18 * MiB;
constexpr size_t WS_WOUT = 24 * MiB;
constexpr size_t WS_WGU = 26 * MiB;
constexpr size_t WS_WDN = 90 * MiB;
constexpr size_t WS_AFFT = 122 * MiB;
constexpr size_t WS_SLOT = 126 * MiB;
constexpr size_t WS_IDX = 128 * MiB;
constexpr size_t WS_GATE = 129 * MiB;
constexpr size_t WS_XN = 130 * MiB;
constexpr size_t WS_Q = 274 * MiB;
constexpr size_t WS_K = 338 * MiB;
constexpr size_t WS_V = 410 * MiB;
constexpr size_t WS_GB = 482 * MiB;
constexpr size_t WS_U = 546 * MiB;
constexpr size_t WS_MIXIN = 610 * MiB;
constexpr size_t WS_MIX = 738 * MiB;
constexpr size_t WS_HMID = 274 * MiB;
constexpr size_t WS_Y = 610 * MiB;
constexpr size_t WS_H1 = 866 * MiB;
constexpr size_t WS_END = 994 * MiB;

__device__ __forceinline__ int opaque_tid() { int t = threadIdx.x; asm volatile("" : "+v"(t)); return t; }

namespace pg8 {
constexpr int BM = 256, BK = 64, HALF = 128, HTB = HALF * BK * 2, STAGE_BYTES = 8 * HTB;
__host__ __device__ __forceinline__ int lds_byte(int r, int c) { const int st = (r >> 4) * 2 + (c >> 5), rr = r & 15, cc = c & 31, ob = rr * 64 + cc * 2; return st * 1024 + (ob ^ (((ob >> 9) & 1) << 5)); }
__host__ __device__ __forceinline__ void stage_rc(int b, int& R, int& C) { const int st = b / 1024, sb = b % 1024, swz = sb ^ (((sb >> 9) & 1) << 5); R = (st >> 1) * 16 + swz / 64; C = (st & 1) * 32 + (swz % 64) / 2; }
__host__ __device__ __forceinline__ int perm32(int rho) { const int n = rho >> 4, i = rho & 15; return 8 * (i >> 2) + 4 * n + (i & 3); }

struct Unit { int pm, pn; };
struct Gemm { const bf16_t* A; const bf16_t* Bt; int K; const int* gidx; };

typedef float f32x2_t __attribute__((ext_vector_type(2))); typedef __bf16 bf16x2_t __attribute__((ext_vector_type(2)));
__device__ __forceinline__ unsigned cvt_pk_bf16(float lo, float hi) { const f32x2_t v = {lo, hi}; const bf16x2_t b = __builtin_convertvector(v, bf16x2_t); return __builtin_bit_cast(unsigned, b); }

struct EpiBf16 {
    static constexpr bool PERM = true, AFTER_DRAIN = false;
    bf16_t* O; int ldc;
    __device__ __forceinline__ void operator()(const f32x4 (&acc)[2][2][4][2], const Unit& u, int wr, int wc, int fr, int fq) const {
        const int row0 = u.pm * BM + wr * 64 + fr; const int col0 = u.pn * BM + wc * 32 + 8 * fq;
#pragma unroll
        for (int ai = 0; ai < 2; ++ai)
#pragma unroll
            for (int m = 0; m < 4; ++m) { bf16_t* rowp = O + (size_t)(row0 + ai * HALF + m * 16) * ldc + col0;
#pragma unroll
                for (int bj = 0; bj < 2; ++bj) { const f32x4 v0 = acc[ai][bj][m][0], v1 = acc[ai][bj][m][1];
                    u32x4 w; w.x = cvt_pk_bf16(v0[0], v0[1]); w.y = cvt_pk_bf16(v0[2], v0[3]); w.z = cvt_pk_bf16(v1[0], v1[1]); w.w = cvt_pk_bf16(v1[2], v1[3]);
                    *(u32x4*)(rowp + bj * HALF) = w; } }
    }
};

struct EpiProj {
    static constexpr bool PERM = true, AFTER_DRAIN = false;
    bf16_t *Q, *KA, *VA, *GB, *U; const float* tab;
    unsigned* kmaxh;
    __device__ __forceinline__ void operator()(const f32x4 (&acc)[2][2][4][2], const Unit& u, int wr, int wc, int fr, int fq) const {
        const int pn = u.pn; const bool ctx = u.pm >= 256;
        float km[2] = {0.f, 0.f};
#pragma unroll
        for (int ai = 0; ai < 2; ++ai)
#pragma unroll
            for (int m = 0; m < 4; ++m) {
                const int row = u.pm * BM + ai * HALF + wr * 64 + m * 16 + fr;
                int t, kvrow;
                if (!ctx) { const int b = row >> 11; t = row & 2047; kvrow = b * TK + TC + t; }
                else { const int rc = row - M; const int b = rc >> 8; t = 0; kvrow = b * TK + (rc & 255); }
                if (pn < 4) {
                    f32x4 cs0 = {1.f, 0.f, 1.f, 0.f}, cs1 = cs0, cs2 = cs0, cs3 = cs0;
                    if (!ctx) { const float* tp = tab + ((size_t)t * 32 + 16 * (wc & 1) + 4 * fq) * 2;
                        cs0 = *(const f32x4*)(tp); cs1 = *(const f32x4*)(tp + 4); }
                    (void)cs2; (void)cs3;
#pragma unroll
                    for (int bj = 0; bj < 2; ++bj) {
                        const f32x4 v0 = acc[ai][bj][m][0], v1 = acc[ai][bj][m][1];
                        float e0 = v0[0], o0 = v0[1], e1 = v0[2], o1 = v0[3], e2 = v1[0], o2 = v1[1], e3 = v1[2], o3 = v1[3];
                        if (pn >= 2) {
                            float ss = ((e0 * e0 + o0 * o0) + (e1 * e1 + o1 * o1)) + ((e2 * e2 + o2 * o2) + (e3 * e3 + o3 * o3));
                            ss += __shfl_xor(ss, 16); ss += __shfl_xor(ss, 32); km[bj] = fmaxf(km[bj], ss); }
                        float r0 = e0 * cs0[0] - o0 * cs0[1], s0 = o0 * cs0[0] + e0 * cs0[1];
                        float r1 = e1 * cs0[2] - o1 * cs0[3], s1 = o1 * cs0[2] + e1 * cs0[3];
                        float r2 = e2 * cs1[0] - o2 * cs1[1], s2 = o2 * cs1[0] + e2 * cs1[1];
                        float r3 = e3 * cs1[2] - o3 * cs1[3], s3 = o3 * cs1[2] + e3 * cs1[3];
                        const float sc = (pn < 2) ? C2 : 1.f;
                        u32x4 w; w.x = cvt_pk_bf16(r0 * sc, s0 * sc); w.y = cvt_pk_bf16(r1 * sc, s1 * sc); w.z = cvt_pk_bf16(r2 * sc, s2 * sc); w.w = cvt_pk_bf16(r3 * sc, s3 * sc);
                        const int col = (pn & 1) * 256 + bj * HALF + wc * 32 + 8 * fq;
                        bf16_t* dst = (pn < 2) ? (Q + (size_t)row * 512 + col) : (KA + (size_t)kvrow * 512 + col);
                        *(u32x4*)dst = w;
                    }
                } else if (pn < 8) {
#pragma unroll
                    for (int bj = 0; bj < 2; ++bj) {
                        const f32x4 v0 = acc[ai][bj][m][0], v1 = acc[ai][bj][m][1];
                        u32x4 w; w.x = cvt_pk_bf16(v0[0], v0[1]); w.y = cvt_pk_bf16(v0[2], v0[3]); w.z = cvt_pk_bf16(v1[0], v1[1]); w.w = cvt_pk_bf16(v1[2], v1[3]);
                        const int col = (pn & 1) * 256 + bj * HALF + wc * 32 + 8 * fq;
                        bf16_t* dst = (pn < 6) ? (VA + (size_t)kvrow * 512 + col) : (GB + (size_t)row * 512 + col);
                        *(u32x4*)dst = w;
                    }
                } else {
                    const f32x4 a0 = acc[ai][0][m][0], a1 = acc[ai][0][m][1], b0 = acc[ai][1][m][0], b1 = acc[ai][1][m][1];
                    u32x4 w; w.x = cvt_pk_bf16(a0[0] * b0[0], a0[1] * b0[1]); w.y = cvt_pk_bf16(a0[2] * b0[2], a0[3] * b0[3]);
                    w.z = cvt_pk_bf16(a1[0] * b1[0], a1[1] * b1[1]); w.w = cvt_pk_bf16(a1[2] * b1[2], a1[3] * b1[3]);
                    const int col = (pn - 8) * 128 + wc * 32 + 8 * fq;
                    *(u32x4*)(U + (size_t)row * 512 + col) = w;
                }
            }
        if (pn == 2 || pn == 3) {
            const int b = ctx ? (u.pm - 256) : (u.pm >> 3);
#pragma unroll
            for (int bj = 0; bj < 2; ++bj) { float v = km[bj];
#pragma unroll
                for (int d = 1; d < 16; d <<= 1) v = fmaxf(v, __shfl_xor(v, d));
                if (fr == 0 && fq == 0) atomicMax(kmaxh + ((b * 8 + (pn & 1) * 4 + bj * 2 + (wc >> 1)) * 2 + (wc & 1)), __float_as_uint(v)); }
        }
    }
};

struct EpiGU {
    static constexpr bool PERM = true, AFTER_DRAIN = false;
    bf16_t* H;
    __device__ __forceinline__ float silu(float x) const { return x * __builtin_amdgcn_rcpf(1.f + __expf(-x)); }
    __device__ __forceinline__ void operator()(const f32x4 (&acc)[2][2][4][2], const Unit& u, int wr, int wc, int fr, int fq) const {
#pragma unroll
        for (int ai = 0; ai < 2; ++ai)
#pragma unroll
            for (int m = 0; m < 4; ++m) {
                const int row = ai * HALF + wr * 64 + m * 16 + fr;
                const f32x4 a0 = acc[ai][0][m][0], a1 = acc[ai][0][m][1], b0 = acc[ai][1][m][0], b1 = acc[ai][1][m][1];
                u32x4 w; w.x = cvt_pk_bf16(silu(a0[0]) * b0[0], silu(a0[1]) * b0[1]); w.y = cvt_pk_bf16(silu(a0[2]) * b0[2], silu(a0[3]) * b0[3]);
                w.z = cvt_pk_bf16(silu(a1[0]) * b1[0], silu(a1[1]) * b1[1]); w.w = cvt_pk_bf16(silu(a1[2]) * b1[2], silu(a1[3]) * b1[3]);
                *(u32x4*)(H + (size_t)row * 1024 + u.pn * 128 + wc * 32 + 8 * fq) = w;
            }
    }
};
__device__ __forceinline__ unsigned pk4_fp8(float a, float b, float c, float d) { int w = 0; w = __builtin_amdgcn_cvt_pk_fp8_f32(a, b, w, false); w = __builtin_amdgcn_cvt_pk_fp8_f32(c, d, w, true); return (unsigned)w; }
constexpr float F8_ACT = 4.0f, F8_WGT = 64.0f, F8_INV = 1.0f / (4.0f * 64.0f);
struct EpiGU8 {
    static constexpr bool PERM = true, AFTER_DRAIN = false;
    unsigned char* H;
    __device__ __forceinline__ float hval(float g, float u) const { g *= F8_INV; u *= F8_INV; const float h = g * __builtin_amdgcn_rcpf(1.f + __expf(-g)) * u * F8_ACT; return __builtin_fminf(__builtin_fmaxf(h, -448.f), 448.f); }
    __device__ __forceinline__ void operator()(const f32x4 (&acc)[2][2][4][2], const Unit& u, int wr, int wc, int fr, int fq) const {
        asm volatile("" : "+v"(fr));
#pragma unroll
        for (int ai = 0; ai < 2; ++ai)
#pragma unroll
            for (int m = 0; m < 4; ++m) {
                const int row = ai * HALF + wr * 64 + m * 16 + fr;
                const f32x4 a0 = acc[ai][0][m][0], a1 = acc[ai][0][m][1], b0 = acc[ai][1][m][0], b1 = acc[ai][1][m][1];
                u32x2 w; w.x = pk4_fp8(hval(a0[0], b0[0]), hval(a0[1], b0[1]), hval(a0[2], b0[2]), hval(a0[3], b0[3]));
                w.y = pk4_fp8(hval(a1[0], b1[0]), hval(a1[1], b1[1]), hval(a1[2], b1[2]), hval(a1[3], b1[3]));
                *(u32x2*)(H + (size_t)row * 1024 + u.pn * 128 + wc * 32 + 8 * fq) = w;
            }
    }
};
struct EpiDown {
    static constexpr bool PERM = true, AFTER_DRAIN = false;
    bf16_t* Y; const float* gate; float scale;
    __device__ __forceinline__ void operator()(const f32x4 (&acc)[2][2][4][2], const Unit& u, int wr, int wc, int fr, int fq) const {
        asm volatile("" : "+v"(fr));
#pragma unroll
        for (int ai = 0; ai < 2; ++ai)
#pragma unroll
            for (int m = 0; m < 4; ++m) {
                const int row = ai * HALF + wr * 64 + m * 16 + fr; const float g = gate[row] * scale;
#pragma unroll
                for (int bj = 0; bj < 2; ++bj) { const f32x4 v0 = acc[ai][bj][m][0] * g, v1 = acc[ai][bj][m][1] * g;
                    u32x4 w; w.x = cvt_pk_bf16(v0[0], v0[1]); w.y = cvt_pk_bf16(v0[2], v0[3]); w.z = cvt_pk_bf16(v1[0], v1[1]); w.w = cvt_pk_bf16(v1[2], v1[3]);
                    *(u32x4*)(Y + (size_t)row * 1024 + u.pn * BM + bj * HALF + wc * 32 + 8 * fq) = w; }
            }
    }
};

struct SchedProj {
    int G, c;
    __device__ __forceinline__ bool next(int i, Unit& u) const {
        const int L = i * G + c;
        if (L < 3072) { u.pm = L & 255; u.pn = L >> 8; return true; }
        const int j = L - 3072; if (j >= 128) return false;
        u.pm = 256 + (j >> 2); u.pn = 2 + (j & 3); return true;
    }
    __device__ __forceinline__ void a_ready(const Unit&) const {}
    __device__ __forceinline__ void done(const Unit&) const {}
};
struct SchedPanel {
    int pm, ntn;
    __device__ __forceinline__ bool next(int i, Unit& u) const { if (i >= ntn) return false; u.pm = pm; u.pn = i; return true; }
    __device__ __forceinline__ void a_ready(const Unit&) const {}
    __device__ __forceinline__ void done(const Unit&) const {}
};

typedef int i32x4v __attribute__((ext_vector_type(4)));
typedef int i32x8v __attribute__((ext_vector_type(8)));
__device__ __forceinline__ i32x8v cat8(bf16x8 a, bf16x8 b) { const i32x4v x = __builtin_bit_cast(i32x4v, a), y = __builtin_bit_cast(i32x4v, b); return __builtin_shufflevector(x, y, 0, 1, 2, 3, 4, 5, 6, 7); }
template <bool F8> struct Frag;
template <> struct Frag<false> { bf16x8 v[2]; __device__ __forceinline__ void set(bf16x8 a, bf16x8 b) { v[0] = a; v[1] = b; } };
template <> struct Frag<true> { i32x8v v; __device__ __forceinline__ void set(bf16x8 a, bf16x8 b) { v = cat8(a, b); } };
__device__ __forceinline__ f32x4 frag_mma(const Frag<false>& b, const Frag<false>& a, f32x4 c) { c = __builtin_amdgcn_mfma_f32_16x16x32_bf16(b.v[0], a.v[0], c, 0, 0, 0); return __builtin_amdgcn_mfma_f32_16x16x32_bf16(b.v[1], a.v[1], c, 0, 0, 0); }
__device__ __forceinline__ f32x4 frag_mma(const Frag<true>& b, const Frag<true>& a, f32x4 c) {
    const int sc1 = 0x7f7f7f7f;
    asm volatile("v_mfma_scale_f32_16x16x128_f8f6f4 %0, %1, %2, %0, %3, %3 op_sel_hi:[0,0,0]" : "+v"(c) : "v"(b.v), "v"(a.v), "v"(sc1));
    return c; }
template <class Epi, class Sched, bool ALIGN_EPI, bool SP2, bool GATHER = false, bool F8 = false>
__device__ __forceinline__ void gemm_phase(LAS unsigned char* lds, const Gemm g, const Sched& S, const Epi& E) {
    const int tid = opaque_tid(), wid = __builtin_amdgcn_readfirstlane(tid >> 6), lane = tid & 63, wr = wid >> 2, wc = wid & 3, fr = lane & 15, fq = lane >> 4;
    const int K = g.K * (F8 ? 1 : 2), nt = K / 128;
    unsigned voffA[2][2], voffB[2];
#pragma unroll
    for (int i = 0; i < 2; ++i) { int R, C; stage_rc(tid * 16 + i * 8192, R, C); const int Rb = Epi::PERM ? ((R & ~31) + perm32(R & 31)) : R;
        if constexpr (GATHER) { voffA[0][i] = (unsigned)(g.gidx[R] * K + C * 2); voffA[1][i] = (unsigned)(g.gidx[HALF + R] * K + C * 2); }
        else { voffA[0][i] = (unsigned)(R * K + C * 2); voffA[1][i] = voffA[0][i]; }
        voffB[i] = (unsigned)(Rb * K + C * 2); }
    const size_t kstep = (size_t)(BK * 2);
    const size_t hstep = (size_t)HALF * K;
    const size_t hstepA = GATHER ? (size_t)0 : hstep;
    const size_t tstep = 2 * hstep;
    const unsigned ldsw = (unsigned)wid * 1024u;
    const int aoff = F8 ? lds_byte(wr * 64 + fr, (fq >> 1) * 32 + (fq & 1) * 16) : lds_byte(wr * 64 + fr, fq * 8), boff = F8 ? lds_byte(wc * 32 + fr, (fq >> 1) * 32 + (fq & 1) * 16) : lds_byte(wc * 32 + fr, fq * 8);
    const int aoff1 = F8 ? aoff + 16 : aoff + 1024, boff1 = F8 ? boff + 16 : boff + 1024;
#define PG8_SA(b, h) (((b) * 2 + (h)) * HTB)
#define PG8_SB(b, h) ((4 + (b) * 2 + (h)) * HTB)
#define PG8_STAGE(bufoff, gbase, voff) do { _Pragma("unroll") for (int _i = 0; _i < 2; ++_i) \
        __builtin_amdgcn_global_load_lds((const unsigned*)((const char*)(gbase) + (voff)[_i]), (LAS unsigned*)(lds + (bufoff) + ldsw + _i * 8192), 16, 0, 0); } while (0)
#define PG8_LDA(dst, b, h) do { _Pragma("unroll") for (int m = 0; m < 4; ++m) dst[m].set(*(const LAS bf16x8*)(lds + PG8_SA(b, h) + aoff + m * 2048), *(const LAS bf16x8*)(lds + PG8_SA(b, h) + aoff1 + m * 2048)); } while (0)
#define PG8_LDB(dst, b, h) do { _Pragma("unroll") for (int n = 0; n < 2; ++n) dst[n].set(*(const LAS bf16x8*)(lds + PG8_SB(b, h) + boff + n * 2048), *(const LAS bf16x8*)(lds + PG8_SB(b, h) + boff1 + n * 2048)); } while (0)
#define PG8_MMA(ai, bj, At, Bt) do { __builtin_amdgcn_s_setprio(1); _Pragma("unroll") for (int m = 0; m < 4; ++m) _Pragma("unroll") for (int n = 0; n < 2; ++n) \
        acc[ai][bj][m][n] = frag_mma(Bt[n], At[m], acc[ai][bj][m][n]); __builtin_amdgcn_s_setprio(0); } while (0)
#define PG8_WAIT_V(n) asm volatile("s_waitcnt vmcnt(" #n ")" ::: "memory")
#define PG8_WAIT_L(n) asm volatile("s_waitcnt lgkmcnt(" #n ")" ::: "memory")
#define PG8_BAR __builtin_amdgcn_s_barrier()
#define PG8_SCHED __builtin_amdgcn_sched_barrier(0)
    Unit cur, nxt; int ui = 0;
    if (!S.next(0, cur)) return;
    f32x4 acc[2][2][4][2];
#pragma unroll
    for (int a = 0; a < 2; ++a)
#pragma unroll
        for (int b = 0; b < 2; ++b)
#pragma unroll
            for (int m = 0; m < 4; ++m)
#pragma unroll
                for (int n = 0; n < 2; ++n) acc[a][b][m][n] = (f32x4){0.f, 0.f, 0.f, 0.f};
    Frag<F8> At[4], B0[2], B1[2];
    const char* cA = (const char*)g.A + (size_t)cur.pm * tstep; const char* cB = (const char*)g.Bt + (size_t)cur.pn * tstep;
    S.a_ready(cur);
    if constexpr (SP2) {
        PG8_STAGE(PG8_SB(0, 0), cB, voffB); PG8_STAGE(PG8_SB(0, 1), cB + hstep, voffB); PG8_STAGE(PG8_SA(0, 0), cA, voffA[0]); PG8_STAGE(PG8_SA(0, 1), cA + hstepA, voffA[GATHER ? 1 : 0]);
        if (wr == 1) PG8_BAR;
        PG8_WAIT_V(2); PG8_BAR;
        PG8_STAGE(PG8_SB(1, 0), cB + kstep, voffB); PG8_STAGE(PG8_SA(1, 0), cA + kstep, voffA[0]); PG8_STAGE(PG8_SB(1, 1), cB + hstep + kstep, voffB);
        PG8_WAIT_V(6); PG8_BAR;
    } else {
        PG8_STAGE(PG8_SB(0, 0), cB, voffB); PG8_STAGE(PG8_SA(0, 0), cA, voffA[0]); PG8_STAGE(PG8_SB(0, 1), cB + hstep, voffB); PG8_STAGE(PG8_SA(0, 1), cA + hstepA, voffA[GATHER ? 1 : 0]);
        if (wr == 1) PG8_BAR;
        PG8_WAIT_V(4); PG8_BAR;
        PG8_STAGE(PG8_SB(1, 0), cB + kstep, voffB); PG8_STAGE(PG8_SA(1, 0), cA + kstep, voffA[0]); PG8_STAGE(PG8_SB(1, 1), cB + hstep + kstep, voffB);
        PG8_WAIT_V(6); PG8_BAR;
    }
    for (;;) {
        const bool has_next = S.next(ui + 1, nxt);
        const char* nA = has_next ? (const char*)g.A + (size_t)nxt.pm * tstep : cA; const char* nB = has_next ? (const char*)g.Bt + (size_t)nxt.pn * tstep : cB;
#pragma unroll 1
        for (int t = 0; t < nt; t += 2) {
            const bool last = (t == nt - 2);
            if constexpr (F8) { asm volatile("" : "+v"(voffA[0][0]), "+v"(voffA[0][1]), "+v"(voffB[0]), "+v"(voffB[1])); if constexpr (GATHER) asm volatile("" : "+v"(voffA[1][0]), "+v"(voffA[1][1])); }
            const char* a1 = cA + (size_t)(t + 1) * kstep;
            const char* a2 = last ? nA : cA + (size_t)(t + 2) * kstep; const char* b2 = last ? nB : cB + (size_t)(t + 2) * kstep;
            const char* a3 = a2 + kstep; const char* b3 = b2 + kstep;
            if (last && has_next) S.a_ready(nxt);
            if constexpr (SP2) {
            PG8_LDB(B0, 0, 0); PG8_LDB(B1, 0, 1); PG8_SCHED; PG8_LDA(At, 0, 0); PG8_STAGE(PG8_SA(1, 1), a1 + hstepA, voffA[GATHER ? 1 : 0]);
            PG8_WAIT_V(8); PG8_WAIT_L(0); PG8_BAR; PG8_MMA(0, 0, At, B0); PG8_MMA(0, 1, At, B1); PG8_BAR; PG8_SCHED;
            PG8_LDA(At, 0, 1); PG8_STAGE(PG8_SB(0, 0), b2, voffB); PG8_STAGE(PG8_SB(0, 1), b2 + hstep, voffB); PG8_STAGE(PG8_SA(0, 0), a2, voffA[0]);
            PG8_WAIT_V(8); PG8_WAIT_L(0); PG8_BAR; PG8_MMA(1, 0, At, B0); PG8_MMA(1, 1, At, B1); PG8_BAR; PG8_SCHED;
            PG8_LDB(B0, 1, 0); PG8_LDB(B1, 1, 1); PG8_SCHED; PG8_LDA(At, 1, 0); PG8_STAGE(PG8_SA(0, 1), a2 + hstepA, voffA[GATHER ? 1 : 0]);
            PG8_WAIT_V(8); PG8_WAIT_L(0); PG8_BAR; PG8_MMA(0, 0, At, B0); PG8_MMA(0, 1, At, B1); PG8_BAR; PG8_SCHED;
            PG8_LDA(At, 1, 1); PG8_STAGE(PG8_SB(1, 0), b3, voffB); PG8_STAGE(PG8_SB(1, 1), b3 + hstep, voffB); PG8_STAGE(PG8_SA(1, 0), a3, voffA[0]);
            PG8_WAIT_V(8); PG8_WAIT_L(0); PG8_BAR; PG8_MMA(1, 0, At, B0); PG8_MMA(1, 1, At, B1); PG8_BAR; PG8_SCHED;
            } else {
            PG8_LDB(B0, 0, 0); PG8_SCHED; PG8_LDA(At, 0, 0); PG8_STAGE(PG8_SA(1, 1), a1 + hstepA, voffA[GATHER ? 1 : 0]);
            PG8_WAIT_L(8); PG8_BAR; PG8_WAIT_L(0); PG8_MMA(0, 0, At, B0); PG8_BAR; PG8_SCHED;
            PG8_LDB(B1, 0, 1); PG8_STAGE(PG8_SB(0, 0), b2, voffB);
            PG8_BAR; PG8_WAIT_L(0); PG8_MMA(0, 1, At, B1); PG8_BAR;
            PG8_LDA(At, 0, 1); PG8_STAGE(PG8_SA(0, 0), a2, voffA[0]);
            PG8_BAR; PG8_WAIT_L(0); PG8_MMA(1, 0, At, B0); PG8_BAR; PG8_SCHED;
            PG8_STAGE(PG8_SB(0, 1), b2 + hstep, voffB);
            PG8_WAIT_V(6); PG8_BAR; PG8_MMA(1, 1, At, B1); PG8_BAR;
            PG8_LDB(B0, 1, 0); PG8_SCHED; PG8_LDA(At, 1, 0); PG8_STAGE(PG8_SA(0, 1), a2 + hstepA, voffA[GATHER ? 1 : 0]);
            PG8_WAIT_L(8); PG8_BAR; PG8_WAIT_L(0); PG8_MMA(0, 0, At, B0); PG8_BAR; PG8_SCHED;
            PG8_LDB(B1, 1, 1); PG8_STAGE(PG8_SB(1, 0), b3, voffB);
            PG8_BAR; PG8_WAIT_L(0); PG8_MMA(0, 1, At, B1); PG8_BAR;
            PG8_LDA(At, 1, 1); PG8_STAGE(PG8_SA(1, 0), a3, voffA[0]);
            PG8_BAR; PG8_WAIT_L(0); PG8_MMA(1, 0, At, B0); PG8_BAR; PG8_SCHED;
            PG8_STAGE(PG8_SB(1, 1), b3 + hstep, voffB);
            PG8_WAIT_V(6); PG8_BAR; PG8_MMA(1, 1, At, B1); PG8_BAR;
            }
        }
        if constexpr (ALIGN_EPI) { if (wr == 0) PG8_BAR; }
        if constexpr (F8) asm volatile("s_nop 15\n\ts_nop 7" ::: "memory");
        E(acc, cur, wr, wc, fr, fq); S.done(cur);
        if (!has_next) break;
#pragma unroll
        for (int a = 0; a < 2; ++a)
#pragma unroll
            for (int b = 0; b < 2; ++b)
#pragma unroll
                for (int m = 0; m < 4; ++m)
#pragma unroll
                    for (int n = 0; n < 2; ++n) acc[a][b][m][n] = (f32x4){0.f, 0.f, 0.f, 0.f};
        cur = nxt; cA = nA; cB = nB; ++ui;
        if constexpr (ALIGN_EPI) { if (wr == 1) PG8_BAR; }
    }
    PG8_WAIT_V(0);
    if constexpr (!ALIGN_EPI) { if (wr == 0) PG8_BAR; }
    PG8_BAR;
#undef PG8_SA
#undef PG8_SB
#undef PG8_STAGE
#undef PG8_LDA
#undef PG8_LDB
#undef PG8_MMA
#undef PG8_WAIT_V
#undef PG8_WAIT_L
#undef PG8_BAR
#undef PG8_SCHED
}
}

typedef GAS unsigned gu32;
#define RLX_AGENT __ATOMIC_RELAXED, __HIP_MEMORY_SCOPE_AGENT
#define LDS_WAIT() asm volatile("s_waitcnt lgkmcnt(0)" ::: "memory")
#define VM_WAIT() asm volatile("s_waitcnt vmcnt(0)" ::: "memory")
__device__ __forceinline__ unsigned pk2(float lo, float hi) { return pg8::cvt_pk_bf16(lo, hi); }
__device__ __forceinline__ float bf2f(unsigned short h) { return __uint_as_float((unsigned)h << 16); }
__device__ __forceinline__ float bflo(unsigned w) { return __uint_as_float(w << 16); }
__device__ __forceinline__ float bfhi(unsigned w) { return __uint_as_float(w & 0xffff0000u); }
__device__ __forceinline__ float wave_sum(float v) {
#pragma unroll
    for (int o = 1; o < 64; o <<= 1) v += __shfl_xor(v, o);
    return v;
}

#define XB_TMO      128
#define XB_XCNT(j)  (256  + 64 * (j))
#define XB_XSUB(j)  (1280 + 64 * (j))
#define XB_XGEN(j)  (2304 + 64 * (j))
#define XB_TOP      3328
#define XB_TOPGEN   3392
#define XCD_BAR_WORDS 3456
#define XB_SPIN_CAP (1u << 18)
__device__ __forceinline__ unsigned xb_ld(unsigned* p)              { return __hip_atomic_load(p, __ATOMIC_RELAXED, __HIP_MEMORY_SCOPE_AGENT); }
__device__ __forceinline__ unsigned xb_add(unsigned* p, unsigned v) { return __hip_atomic_fetch_add(p, v, __ATOMIC_RELAXED, __HIP_MEMORY_SCOPE_AGENT); }
__device__ __forceinline__ unsigned xb_xcc_id() { return (unsigned)__builtin_amdgcn_s_getreg((3 << 11) | 20) & 0xFu; }
#define XB_SPIN(cond, bar) do { unsigned _sp = 0; while (cond) { __builtin_amdgcn_s_sleep(1); \
    if ((++_sp & 255u) == 0u) { if (xb_ld(&(bar)[XB_TMO])) break; if (_sp > XB_SPIN_CAP) { atomicAdd(&(bar)[XB_TMO], 1u); break; } } } } while (0)
struct XcdBarrier { unsigned* bar; unsigned x; volatile LAS unsigned* st; };
__device__ __forceinline__ XcdBarrier xcd_barrier_post(unsigned* bar, volatile LAS unsigned* st) {
    XcdBarrier b; b.bar = bar; b.x = xb_xcc_id(); b.st = st;
    if (threadIdx.x == 0) (void)xb_add(&bar[XB_XCNT(b.x)], 1u);
    return b;
}
__device__ __forceinline__ void xcd_barrier_complete(unsigned* bar, unsigned x, unsigned& nloc, unsigned& nx) {
    const unsigned G = gridDim.x * gridDim.y * gridDim.z;
    unsigned sum, cnt, mine, sp = 0u;
    for (;;) {
        sum = 0u; cnt = 0u; mine = 0u;
#pragma unroll
        for (unsigned j = 0; j < 16; ++j) { const unsigned c = xb_ld(&bar[XB_XCNT(j)]); sum += c; cnt += (c > 0u) ? 1u : 0u; mine = (j == x) ? c : mine; }
        if (sum == G) break;
        __builtin_amdgcn_s_sleep(1);
        if ((++sp & 255u) == 0u) { if (xb_ld(&bar[XB_TMO])) break; if (sp > XB_SPIN_CAP) { atomicAdd(&bar[XB_TMO], 1u); break; } }
    }
    nloc = mine > 0u ? mine : 1u; nx = cnt > 0u ? cnt : 1u;
}
__device__ __forceinline__ void xcd_barrier(const XcdBarrier& b) {
    asm volatile("s_waitcnt vmcnt(0)" ::: "memory");
    __syncthreads();
    if (threadIdx.x == 0) {
        unsigned* bar = b.bar;
        __builtin_amdgcn_s_waitcnt(0);
        unsigned nloc = b.st[0], nx = b.st[1];
        if (nloc == 0u) { xcd_barrier_complete(bar, b.x, nloc, nx); b.st[0] = nloc; b.st[1] = nx; }
        const unsigned old = xb_add(&bar[XB_XSUB(b.x)], 1u);
        const unsigned gen = old / nloc;
        if (old + 1u == (gen + 1u) * nloc) {
            __builtin_amdgcn_fence(__ATOMIC_RELEASE, "agent");
            asm volatile("s_waitcnt vmcnt(0)" ::: "memory");
            const unsigned og = xb_add(&bar[XB_TOP], 1u);
            const unsigned tg = og / nx;
            if (og + 1u == (tg + 1u) * nx) xb_add(&bar[XB_TOPGEN], 1u);
            else XB_SPIN(xb_ld(&bar[XB_TOPGEN]) == tg, bar);
            __builtin_amdgcn_fence(__ATOMIC_ACQUIRE, "agent");
            xb_add(&bar[XB_XGEN(b.x)], 1u);
            asm volatile("s_waitcnt vmcnt(0)" ::: "memory");
        } else {
            XB_SPIN(xb_ld(&bar[XB_XGEN(b.x)]) == gen, bar);
            __builtin_amdgcn_fence(__ATOMIC_ACQUIRE, "agent");
            asm volatile("s_waitcnt vmcnt(0)" ::: "memory");
        }
    }
    __syncthreads();
}

constexpr int RING_BYTES = 131072;
constexpr int LDSCTL_OFF = RING_BYTES, MISC_OFF = LDSCTL_OFF + 320;
constexpr int LDS_BYTES = 147456;
constexpr int CW_BAR = 4096;
constexpr int CW_KMAX = 65536;

struct Args { const float* in[22]; float* out; unsigned char* ws; int ph_lo, ph_hi; };
enum { I_X = 0, I_C, I_CTX, I_CCTX, I_WADA, I_BADA, I_NPRE_MIX, I_NPOST_MIX, I_NPRE_FFN, I_NPOST_FFN, I_WIN, I_CONVW, I_LQ1, I_LK1, I_LQ2, I_LK2, I_SUBLN, I_WOUT, I_WROUTER, I_WGATE, I_WUP, I_WDOWN };

__device__ __forceinline__ void prefetch_slice(const unsigned char* base, int bytes_per_wave, LAS unsigned char* scr, int lane) {
    for (int i = 0; i < bytes_per_wave; i += 1024)
        __builtin_amdgcn_global_load_lds((const unsigned*)(base + i + lane * 16), (LAS unsigned*)scr, 16, 0, 0);
}

__device__ __forceinline__ int win_dest(int n) {
    if (n < 1024) { const int j = n & 63; const int p = ((j >> 5) << 5) + ((j & 15) << 1) + ((j >> 4) & 1); return (n & ~63) + p; }
    if (n < 2048) return n;
    int c = n - 2048; const int isx = c >= 512; c &= 511; return 2048 + ((c >> 7) << 8) + (isx << 7) + (c & 127);
}
template <int MODE>
__device__ __forceinline__ int tr_dest(int n) {
    if (MODE == 0) return n;
    if (MODE == 1) return win_dest(n);
    if (MODE == 2) return ((n >> 7) << 8) + (n & 127);
    return ((n >> 7) << 8) + 128 + (n & 127);
}
template <int MODE>
__device__ __forceinline__ void p0_transpose_item_f8(const float* W, int K, int N, unsigned char* WT, LAS float* scr, int item, int lane) {
    const int nblk = N / 32, kb = item / nblk, nb = item % nblk, k0 = 64 * kb, n0 = 32 * nb;
#pragma unroll 8
    for (int i = 0; i < 32; ++i) { const int kk = 2 * i + (lane >> 5); scr[kk * 33 + (lane & 31)] = __builtin_nontemporal_load(W + (size_t)(k0 + kk) * N + n0 + (lane & 31)) * pg8::F8_WGT; }
    LDS_WAIT(); asm volatile("" ::: "memory");
    const int c = lane & 7;
#pragma unroll
    for (int j = 0; j < 4; ++j) { const int n = (lane >> 3) + 8 * j; const LAS float* s = scr + (8 * c) * 33 + n;
        u32x2 o; o.x = pg8::pk4_fp8(s[0 * 33], s[1 * 33], s[2 * 33], s[3 * 33]); o.y = pg8::pk4_fp8(s[4 * 33], s[5 * 33], s[6 * 33], s[7 * 33]);
        *(GAS u32x2*)(WT + (size_t)tr_dest<MODE>(n0 + n) * K + k0 + 8 * c) = o; }
    LDS_WAIT(); asm volatile("" ::: "memory");
}
template <int MODE>
__device__ __forceinline__ void p0_transpose_item(const float* W, int K, int N, bf16_t* WT, LAS float* scr, int item, int lane) {
    const int nblk = N / 32, kb = item / nblk, nb = item % nblk, k0 = 64 * kb, n0 = 32 * nb;
#pragma unroll 8
    for (int i = 0; i < 32; ++i) { const int kk = 2 * i + (lane >> 5); scr[kk * 33 + (lane & 31)] = W[(size_t)(k0 + kk) * N + n0 + (lane & 31)]; }
    LDS_WAIT(); asm volatile("" ::: "memory");
    const int c = lane & 7;
#pragma unroll
    for (int j = 0; j < 4; ++j) { const int n = (lane >> 3) + 8 * j; const LAS float* s = scr + (8 * c) * 33 + n;
        u32x4 o; o.x = pk2(s[0 * 33], s[1 * 33]); o.y = pk2(s[2 * 33], s[3 * 33]); o.z = pk2(s[4 * 33], s[5 * 33]); o.w = pk2(s[6 * 33], s[7 * 33]);
        *(GAS u32x4*)(WT + (size_t)tr_dest<MODE>(n0 + n) * K + k0 + 8 * c) = o; }
    LDS_WAIT(); asm volatile("" ::: "memory");
}

__device__ __forceinline__ void p0_prologue(const Args& a, LAS unsigned char* lds, int vcu, int G) {
    const int tid = opaque_tid(), lane = tid & 63, wave = __builtin_amdgcn_readfirstlane(tid >> 6);
    LAS float* scr = (LAS float*)(lds + wave * 16384);
    const int gw = vcu * NWAVES + wave, NGW = G * NWAVES;
    unsigned char* ws = a.ws;
    {
        float* MODP = (float*)(ws + WS_MODP);
        const float* wada = a.in[I_WADA];
        for (int it = gw; it < 96 * 16; it += NGW) {
            const int cg = it % 96, kc = it / 96;
            for (int b = 0; b < 33; ++b) { const float v = (b < 32) ? a.in[I_C][b * D + kc * 64 + lane] : a.in[I_CCTX][kc * 64 + lane]; scr[b * 64 + lane] = v / (1.f + __expf(-v)); }
            LDS_WAIT(); asm volatile("" ::: "memory");
            float acc[33];
#pragma unroll
            for (int b = 0; b < 33; ++b) acc[b] = 0.f;
            for (int k = 0; k < 64; ++k) {
                const float w = wada[(size_t)(kc * 64 + k) * NMOD + cg * 64 + lane];
#pragma unroll
                for (int b = 0; b < 33; ++b) acc[b] += scr[b * 64 + k] * w;
            }
#pragma unroll
            for (int b = 0; b < 33; ++b) MODP[((size_t)kc * 33 + b) * NMOD + cg * 64 + lane] = acc[b];
            LDS_WAIT(); asm volatile("" ::: "memory");
        }
    }
    {
        float* tab = (float*)(ws + WS_TAB);
        for (int e = gw * 64 + lane; e < T * 32; e += NGW * 64) {
            const int t = e >> 5, i = e & 31;
            const float inv = powf(10000.0f, -(float)(2 * (i & 15)) / 32.0f);
            const float pos = (i < 16) ? (float)(t >> 6) : (float)(t & 63);
            const float ang = pos * inv;
            tab[2 * e] = cosf(ang); tab[2 * e + 1] = sinf(ang);
        }
    }
    constexpr int I_IN = (D / 64) * (NPROJ / 32), I_OUT = (D / 64) * (D / 32);
    constexpr int NITEMS = I_IN + I_OUT;
    bf16_t* Win_t = (bf16_t*)(ws + WS_WIN); bf16_t* Wout_t = (bf16_t*)(ws + WS_WOUT);
    for (int it = gw; it < NITEMS; it += NGW) {
        int r = it;
        if (r < I_IN) { p0_transpose_item<1>(a.in[I_WIN], D, NPROJ, Win_t, scr, r, lane); continue; } r -= I_IN;
        p0_transpose_item<0>(a.in[I_WOUT], D, D, Wout_t, scr, r, lane);
    }
}
__device__ __forceinline__ void expert_weight_copies(const Args& a, LAS unsigned char* lds, int vcu, int G) {
    const int tid = opaque_tid(), lane = tid & 63, wave = __builtin_amdgcn_readfirstlane(tid >> 6);
    LAS float* scr = (LAS float*)(lds + wave * 16384);
    const int gw = vcu * NWAVES + wave, NGW = G * NWAVES;
    unsigned char* ws = a.ws;
    constexpr int I_EXP = (D / 64) * (D / 32);
    unsigned char* Wgu_t = ws + WS_WGU; unsigned char* Wdn_t = ws + WS_WDN;
    for (int r = gw; r < NE * 3 * I_EXP; r += NGW) {
        const int e = r / (3 * I_EXP), q = (r % (3 * I_EXP)) / I_EXP, rr = r % I_EXP;
        if (q == 0) p0_transpose_item_f8<2>(a.in[I_WGATE] + (size_t)e * D * D, D, D, Wgu_t + (size_t)e * 2048 * D, scr, rr, lane);
        else if (q == 1) p0_transpose_item_f8<3>(a.in[I_WUP] + (size_t)e * D * D, D, D, Wgu_t + (size_t)e * 2048 * D, scr, rr, lane);
        else p0_transpose_item_f8<0>(a.in[I_WDOWN] + (size_t)e * D * D, D, D, Wdn_t + (size_t)e * D * D, scr, rr, lane);
    }
    __syncthreads();
}

struct RowF { f32x4 v[4]; };
__device__ __forceinline__ void row_load(RowF& r, const float* xrow, int lane) {
    const f32x4* xr = (const f32x4*)xrow + lane;
#pragma unroll
    for (int j = 0; j < 4; ++j) r.v[j] = __builtin_nontemporal_load(xr + 64 * j);
}
__device__ __forceinline__ void norm_mod_row(const RowF& r, bf16_t* orow, const float* gain, const LAS float* sc, const LAS float* sh, int lane) {
    const f32x4* gr = (const f32x4*)gain + lane;
    float s = 0.f;
#pragma unroll
    for (int j = 0; j < 4; ++j) s += (r.v[j].x * r.v[j].x + r.v[j].y * r.v[j].y) + (r.v[j].z * r.v[j].z + r.v[j].w * r.v[j].w);
    const float rstd = 1.0f / sqrtf(wave_sum(s) * (1.f / D) + EPS);
    u32x2* o8 = (u32x2*)orow + lane;
#pragma unroll
    for (int j = 0; j < 4; ++j) { const f32x4 g = gr[64 * j]; const f32x4 c1 = *(const LAS f32x4*)(sc + 4 * lane + 256 * j), h1 = *(const LAS f32x4*)(sh + 4 * lane + 256 * j);
        const f32x4 y = (r.v[j] * rstd) * g; const f32x4 z = y * (c1 + 1.0f) + h1;
        u32x2 w; w.x = pk2(z.x, z.y); w.y = pk2(z.z, z.w); o8[64 * j] = w; }
}
__device__ __forceinline__ void p1_xn(const Args& a, LAS unsigned char* lds, int c, int G) {
    const int tid = opaque_tid(), lane = tid & 63, wave = __builtin_amdgcn_readfirstlane(tid >> 6);
    unsigned char* ws = a.ws;
    const float* MODP = (const float*)(ws + WS_MODP); float* MOD = (float*)(ws + WS_MOD); const float* bada = a.in[I_BADA];
    for (int r = c; r < 33; r += G)
        for (int n = tid; n < NMOD; n += NTHREADS) { float s = bada[n];
#pragma unroll
            for (int kc = 0; kc < 16; ++kc) s += MODP[((size_t)kc * 33 + r) * NMOD + n];
            MOD[(size_t)r * NMOD + n] = s; }
    LAS float* sv = (LAS float*)lds;
    bf16_t* XN = (bf16_t*)(ws + WS_XN);
    const float* X = a.in[I_X]; const float* CTX = a.in[I_CTX]; const float* gain = a.in[I_NPRE_MIX];
    for (int p = c; p < 256; p += G) {
        const int b = p >> 3;
        const int rbase = p * 256 + wave * 32;
        RowF a0, a1;
        row_load(a0, X + (size_t)rbase * D, lane); row_load(a1, X + (size_t)(rbase + 16) * D, lane);
        __syncthreads();
        for (int n = tid; n < 4096; n += NTHREADS) { const int r = (n < 2048) ? b : 32; const int col = n & 2047; float s = bada[col];
#pragma unroll
            for (int kc = 0; kc < 16; ++kc) s += MODP[((size_t)kc * 33 + r) * NMOD + col];
            sv[n] = s; }
        __syncthreads();
        for (int i = 0; i < 16; ++i) {
            RowF n0, n1;
            if (i + 1 < 16) { row_load(n0, X + (size_t)(rbase + i + 1) * D, lane); row_load(n1, X + (size_t)(rbase + 16 + i + 1) * D, lane); }
            else { const int crow = p * 32 + wave * 4; row_load(n0, CTX + (size_t)crow * D, lane); row_load(n1, CTX + (size_t)(crow + 1) * D, lane); }
            norm_mod_row(a0, XN + (size_t)(rbase + i) * D, gain, sv + 1024, sv, lane);
            norm_mod_row(a1, XN + (size_t)(rbase + 16 + i) * D, gain, sv + 1024, sv, lane);
            a0 = n0; a1 = n1;
        }
        {
            const int crow = p * 32 + wave * 4;
            RowF n0, n1;
            row_load(n0, CTX + (size_t)(crow + 2) * D, lane); row_load(n1, CTX + (size_t)(crow + 3) * D, lane);
            norm_mod_row(a0, XN + (size_t)(M + crow) * D, gain, sv + 3072, sv + 2048, lane);
            norm_mod_row(a1, XN + (size_t)(M + crow + 1) * D, gain, sv + 3072, sv + 2048, lane);
            norm_mod_row(n0, XN + (size_t)(M + crow + 2) * D, gain, sv + 3072, sv + 2048, lane);
            norm_mod_row(n1, XN + (size_t)(M + crow + 3) * D, gain, sv + 3072, sv + 2048, lane);
        }
    }
}

namespace att {
constexpr int KP = 272, KBUF = 64 * KP, VBUF = 16384;
constexpr int OFF_K = 0, OFF_V = 2 * KBUF, OFF_WSF = OFF_V + 2 * VBUF, OFF_END = OFF_WSF + NWAVES * 256;
static_assert(OFF_WSF >= 65536 && OFF_END <= RING_BYTES, "attention LDS map");
constexpr int NT = TK / 64;
constexpr float THR = 8.0f;
__device__ __forceinline__ int crow(int r, int hi) { return (r & 3) + 8 * (r >> 2) + 4 * hi; }
__device__ __forceinline__ float max3f(float a, float b, float c) { float r; asm("v_max3_f32 %0, %1, %2, %3" : "=v"(r) : "v"(a), "v"(b), "v"(c)); return r; }
__device__ __forceinline__ float max2f(float a, float b) { float r; asm("v_max_f32_e32 %0, %1, %2" : "=v"(r) : "v"(a), "v"(b)); return r; }
__device__ __forceinline__ s16x4 vtr(const LAS unsigned char* p) { return __builtin_bit_cast(s16x4, __builtin_amdgcn_ds_read_tr16_b64_v4i16((LAS s16x4*)p)); }

#define ATT_BAR() asm volatile("s_waitcnt lgkmcnt(0)\n\ts_barrier" ::: "memory")
#define ATT_SB() __builtin_amdgcn_sched_barrier(0)
#define ATT_KLD(i, KF) KF = *(const LAS bf16x8*)(kb_ + ((i) & 1) * (32 * KP) + ((i) >> 1) * 32)
#define ATT_XSTEP(i, KC, KN) do { if ((i) + 2 < 8) { ATT_KLD((i) + 2, KN); } \
    if ((i) == 0) p0 = __builtin_amdgcn_mfma_f32_32x32x16_bf16(KC, qr[0], negref, 0, 0, 0); \
    else if ((i) == 1) p1 = __builtin_amdgcn_mfma_f32_32x32x16_bf16(KC, qr[0], negref, 0, 0, 0); \
    else if (((i) & 1) == 0) p0 = __builtin_amdgcn_mfma_f32_32x32x16_bf16(KC, qr[(i) >> 1], p0, 0, 0, 0); else p1 = __builtin_amdgcn_mfma_f32_32x32x16_bf16(KC, qr[(i) >> 1], p1, 0, 0, 0); ATT_SB(); } while (0)
#define ATT_X(kcur) do { \
    const LAS unsigned char* kb_ = lds + OFF_K + (kcur) * KBUF + koff; \
    bf16x8 ka_, kb2_, kc_; \
    ATT_KLD(0, ka_); ATT_KLD(1, kb2_); \
    ATT_SB(); \
    ATT_XSTEP(0, ka_, kc_); ATT_XSTEP(1, kb2_, ka_); ATT_XSTEP(2, kc_, kb2_); ATT_XSTEP(3, ka_, kc_); \
    ATT_XSTEP(4, kb2_, ka_); ATT_XSTEP(5, kc_, kb2_); ATT_XSTEP(6, ka_, kc_); ATT_XSTEP(7, kb2_, ka_); \
} while (0)
#define ATT_EXP2(i, PWN) do { \
    const float e0_ = __builtin_amdgcn_exp2f((i) < 8 ? p0[2 * ((i) & 7)] : p1[2 * ((i) & 7)]), e1_ = __builtin_amdgcn_exp2f((i) < 8 ? p0[2 * ((i) & 7) + 1] : p1[2 * ((i) & 7) + 1]); \
    sacc_ += e0_ + e1_; PWN[(i) >> 2][(i) & 3] = pk2(e0_, e1_); asm volatile("" : "+v"(PWN[(i) >> 2]), "+v"(sacc_)); } while (0)
#define ATT_VLD(i, LO, HI) do { LO = vtr(vb_ + ((i) & 3) * 4096 + ((i) >> 2) * 1024); HI = vtr(vb_ + ((i) & 3) * 4096 + ((i) >> 2) * 1024 + 512); } while (0)
#define ATT_VF(LO, HI) ((bf16x8){LO[0], LO[1], LO[2], LO[3], HI[0], HI[1], HI[2], HI[3]})
#define ATT_YSTEP(i, PWC, PWN, LC, HC, LN, HN) do { if ((i) + 2 < 16) { ATT_VLD((i) + 2, LN, HN); } \
    o[(i) & 3] = __builtin_amdgcn_mfma_f32_32x32x16_bf16(__builtin_bit_cast(bf16x8, PWC[(i) >> 2]), ATT_VF(LC, HC), o[(i) & 3], 0, 0, 0); \
    ATT_EXP2(i, PWN); ATT_SB(); } while (0)
#define ATT_Y(vcur, PWC, PWN) do { \
    const LAS unsigned char* vb_ = lds + OFF_V + (vcur) * VBUF + voff; \
    float sacc_ = 0.f; s16x4 la_, ha_, lb_, hb_, lc_, hc_; \
    ATT_VLD(0, la_, ha_); ATT_VLD(1, lb_, hb_); ATT_SB(); \
    ATT_YSTEP(0, PWC, PWN, la_, ha_, lc_, hc_); ATT_YSTEP(1, PWC, PWN, lb_, hb_, la_, ha_); ATT_YSTEP(2, PWC, PWN, lc_, hc_, lb_, hb_); \
    ATT_YSTEP(3, PWC, PWN, la_, ha_, lc_, hc_); ATT_YSTEP(4, PWC, PWN, lb_, hb_, la_, ha_); ATT_YSTEP(5, PWC, PWN, lc_, hc_, lb_, hb_); \
    ATT_YSTEP(6, PWC, PWN, la_, ha_, lc_, hc_); ATT_YSTEP(7, PWC, PWN, lb_, hb_, la_, ha_); ATT_YSTEP(8, PWC, PWN, lc_, hc_, lb_, hb_); \
    ATT_YSTEP(9, PWC, PWN, la_, ha_, lc_, hc_); ATT_YSTEP(10, PWC, PWN, lb_, hb_, la_, ha_); ATT_YSTEP(11, PWC, PWN, lc_, hc_, lb_, hb_); \
    ATT_YSTEP(12, PWC, PWN, la_, ha_, lc_, hc_); ATT_YSTEP(13, PWC, PWN, lb_, hb_, la_, ha_); ATT_YSTEP(14, PWC, PWN, lc_, hc_, lb_, hb_); \
    ATT_YSTEP(15, PWC, PWN, la_, ha_, lc_, hc_); \
    l_reg += sacc_; \
} while (0)
#define ATT_Y0(PWN) do { float sacc_ = 0.f; _Pragma("unroll") for (int i = 0; i < 16; ++i) ATT_EXP2(i, PWN); l_reg += sacc_; } while (0)
#define ATT_ZSTEP(i, PWC, LC, HC, LN, HN) do { if ((i) + 2 < 16) { ATT_VLD((i) + 2, LN, HN); } \
    o[(i) & 3] = __builtin_amdgcn_mfma_f32_32x32x16_bf16(__builtin_bit_cast(bf16x8, PWC[(i) >> 2]), ATT_VF(LC, HC), o[(i) & 3], 0, 0, 0); ATT_SB(); } while (0)
#define ATT_Z(vcur, PWC) do { \
    const LAS unsigned char* vb_ = lds + OFF_V + (vcur) * VBUF + voff; \
    s16x4 la_, ha_, lb_, hb_, lc_, hc_; \
    ATT_VLD(0, la_, ha_); ATT_VLD(1, lb_, hb_); ATT_SB(); \
    ATT_ZSTEP(0, PWC, la_, ha_, lc_, hc_); ATT_ZSTEP(1, PWC, lb_, hb_, la_, ha_); ATT_ZSTEP(2, PWC, lc_, hc_, lb_, hb_); \
    ATT_ZSTEP(3, PWC, la_, ha_, lc_, hc_); ATT_ZSTEP(4, PWC, lb_, hb_, la_, ha_); ATT_ZSTEP(5, PWC, lc_, hc_, lb_, hb_); \
    ATT_ZSTEP(6, PWC, la_, ha_, lc_, hc_); ATT_ZSTEP(7, PWC, lb_, hb_, la_, ha_); ATT_ZSTEP(8, PWC, lc_, hc_, lb_, hb_); \
    ATT_ZSTEP(9, PWC, la_, ha_, lc_, hc_); ATT_ZSTEP(10, PWC, lb_, hb_, la_, ha_); ATT_ZSTEP(11, PWC, lc_, hc_, lb_, hb_); \
    ATT_ZSTEP(12, PWC, la_, ha_, lc_, hc_); ATT_ZSTEP(13, PWC, lb_, hb_, la_, ha_); ATT_ZSTEP(14, PWC, lc_, hc_, lb_, hb_); \
    ATT_ZSTEP(15, PWC, la_, ha_, lc_, hc_); \
} while (0)
#define ATT_STAGE(j) do { \
    if ((j) + 1 < NT) { _Pragma("unroll") for (int i = 0; i < 2; ++i) *(LAS u32x4*)(lds + OFF_K + (((j) + 1) & 1) * KBUF + kdst[i]) = kr[i]; } \
    _Pragma("unroll") for (int i = 0; i < 2; ++i) *(LAS u32x4*)(lds + OFF_V + ((j) & 1) * VBUF + vdst[i]) = vr[i]; \
    if ((j) + 2 < NT) { _Pragma("unroll") for (int i = 0; i < 2; ++i) kr[i] = *(const u32x4*)(Kb + (size_t)((j) + 2) * 64 * 512 + gsrc[i]); } \
    if ((j) + 1 < NT) { _Pragma("unroll") for (int i = 0; i < 2; ++i) vr[i] = *(const u32x4*)(Vb + (size_t)((j) + 1) * 64 * 512 + gsrc[i]); } } while (0)

__device__ __forceinline__ void unit(LAS unsigned char* lds, int b, int h, int qb, const bf16_t* Q, const bf16_t* KA, const bf16_t* VA, bf16_t* MIXIN, const float* subg, float lam, const unsigned* KM) {
    const int tid = opaque_tid(), lane = tid & 63, r32 = lane & 31, hi = lane >> 5;
    const int wid = __builtin_amdgcn_readfirstlane(tid >> 6), w = wid & 3, m = wid >> 2;
    LAS float* wsf = (LAS float*)(lds + OFF_WSF) + wid * 64;
    const int rowQ = b * T + qb * 128 + w * 32;
    bf16x8 qr[4];
#pragma unroll
    for (int d0 = 0; d0 < 4; ++d0) qr[d0] = *(const bf16x8*)(Q + (size_t)(rowQ + r32) * 512 + h * 128 + m * 64 + d0 * 16 + hi * 8);
    const bf16_t* Kb = KA + (size_t)b * TK * 512 + h * 128; const bf16_t* Vb = VA + (size_t)b * TK * 512 + h * 128;
    int gsrc[2], kdst[2], vdst[2];
#pragma unroll
    for (int i = 0; i < 2; ++i) { const int cid = tid + 512 * i, kv = cid >> 4, c16 = cid & 15;
        gsrc[i] = kv * 512 + c16 * 8; kdst[i] = kv * KP + c16 * 16; vdst[i] = (c16 >> 2) * 4096 + (kv >> 4) * 1024 + (kv & 15) * 64 + (c16 & 3) * 16; }
    u32x4 kr[2], vr[2];
#pragma unroll
    for (int i = 0; i < 2; ++i) { kr[i] = *(const u32x4*)(Kb + gsrc[i]); vr[i] = *(const u32x4*)(Vb + gsrc[i]); }
#pragma unroll
    for (int i = 0; i < 2; ++i) *(LAS u32x4*)(lds + OFF_K + kdst[i]) = kr[i];
#pragma unroll
    for (int i = 0; i < 2; ++i) kr[i] = *(const u32x4*)(Kb + (size_t)64 * 512 + gsrc[i]);
    ATT_BAR();
    f32x16 o[4];
#pragma unroll
    for (int d0 = 0; d0 < 4; ++d0) o[d0] = (f32x16){};
    float l_reg = 0.f;
    f32x16 p0, p1, negref;
    {
        const unsigned* km = KM + (b * 8 + h * 2 + m) * 2;
        const float kmax2 = __uint_as_float(km[0]) + __uint_as_float(km[1]);
        float ss = 0.f;
#pragma unroll
        for (int d0 = 0; d0 < 4; ++d0)
#pragma unroll
            for (int i = 0; i < 8; ++i) { const float v = bf2f((unsigned short)qr[d0][i]); ss += v * v; }
        ss += __shfl_xor(ss, 32);
        const float ref = sqrtf(ss * kmax2) * 1.02f;
#pragma unroll
        for (int r = 0; r < 16; ++r) negref[r] = -ref;
    }
    u32x4 pwA[4], pwB[4];
    const int koff = r32 * KP + m * 128 + hi * 16;
    const int voff = ((lane >> 4) & 1) * 32 + (lane & 3) * 8 + (4 * hi + ((lane & 15) >> 2)) * 64;
    ATT_X(0); ATT_STAGE(0); ATT_Y0(pwA); ATT_BAR();
    ATT_X(1); ATT_STAGE(1); ATT_Y(0, pwA, pwB); ATT_BAR();
    for (int j = 2; j < NT; j += 2) {
        ATT_X(0); ATT_STAGE(j); ATT_Y(1, pwB, pwA); ATT_BAR();
        ATT_X(1); ATT_STAGE(j + 1); ATT_Y(0, pwA, pwB); ATT_BAR();
    }
    ATT_Z(1, pwB); ATT_BAR();
    l_reg += __shfl_xor(l_reg, 32);
    if (hi == 0) wsf[32 + r32] = l_reg;
    LDS_WAIT();
    float rli[16];
#pragma unroll
    for (int r = 0; r < 16; ++r) rli[r] = 1.0f / wsf[32 + crow(r, hi)];
    LDS_WAIT();
    LAS float* ex = (LAS float*)lds + w * 4096;
    if (m == 1) {
#pragma unroll
        for (int r = 0; r < 16; ++r)
#pragma unroll
            for (int d0 = 0; d0 < 4; ++d0) ex[crow(r, hi) * 128 + d0 * 32 + r32] = o[d0][r] * rli[r];
    }
    ATT_BAR();
    if (m == 0) {
        float g4[4];
#pragma unroll
        for (int d0 = 0; d0 < 4; ++d0) g4[d0] = subg[d0 * 32 + r32] * (1.0f - LAM_INIT);
#pragma unroll
        for (int r = 0; r < 16; ++r) {
            const int q = crow(r, hi); float x[4]; float ss = 0.f;
#pragma unroll
            for (int d0 = 0; d0 < 4; ++d0) { x[d0] = o[d0][r] * rli[r] - lam * ex[q * 128 + d0 * 32 + r32]; ss += x[d0] * x[d0]; }
#pragma unroll
            for (int off = 1; off < 32; off <<= 1) ss += __shfl_xor(ss, off);
            const float rstd = 1.0f / sqrtf(ss * (1.f / 128.f) + EPS);
            bf16_t* dst = MIXIN + (size_t)(rowQ + q) * 1024 + h * 128 + r32;
#pragma unroll
            for (int d0 = 0; d0 < 4; ++d0) dst[d0 * 32] = (bf16_t)(pk2(x[d0] * rstd * g4[d0], 0.f) & 0xffffu);
        }
    }
    ATT_BAR();
}
#undef ATT_BAR
#undef ATT_X
#undef ATT_EXP2
#undef ATT_Y
#undef ATT_Y0
#undef ATT_Z
#undef ATT_STAGE
#undef ATT_SB
#undef ATT_KLD
#undef ATT_XSTEP
#undef ATT_VLD
#undef ATT_VF
#undef ATT_YSTEP
#undef ATT_ZSTEP
}

__device__ __forceinline__ void p3_conv_attn(const Args& a, LAS unsigned char* lds, int c, int vcu, int G) {
    const int tid = opaque_tid(), lane = tid & 63, wave = __builtin_amdgcn_readfirstlane(tid >> 6);
    unsigned char* ws = a.ws;
    const bf16_t* GB = (const bf16_t*)(ws + WS_GB); const bf16_t* U = (const bf16_t*)(ws + WS_U); bf16_t* MIXIN = (bf16_t*)(ws + WS_MIXIN);
    {
        const float* cw = a.in[I_CONVW]; float w0[8], w1[8], w2[8];
#pragma unroll
        for (int i = 0; i < 8; ++i) { w0[i] = cw[lane * 8 + i]; w1[i] = cw[512 + lane * 8 + i]; w2[i] = cw[1024 + lane * 8 + i]; }
        const int gw = vcu * NWAVES + wave, NGW = G * NWAVES;
        for (int row = gw; row < M; row += NGW) {
            const int t = row & (T - 1);
            const u32x4 z = {0u, 0u, 0u, 0u};
            const u32x4 uc = *(const u32x4*)(U + (size_t)row * 512 + lane * 8);
            const u32x4 up = (t > 0) ? *(const u32x4*)(U + (size_t)(row - 1) * 512 + lane * 8) : z;
            const u32x4 un = (t < T - 1) ? *(const u32x4*)(U + (size_t)(row + 1) * 512 + lane * 8) : z;
            const u32x4 gb = *(const u32x4*)(GB + (size_t)row * 512 + lane * 8);
            u32x4 o;
#pragma unroll
            for (int q = 0; q < 4; ++q) {
                const float y0 = w0[2 * q] * bflo(up[q]) + w1[2 * q] * bflo(uc[q]) + w2[2 * q] * bflo(un[q]);
                const float y1 = w0[2 * q + 1] * bfhi(up[q]) + w1[2 * q + 1] * bfhi(uc[q]) + w2[2 * q + 1] * bfhi(un[q]);
                o[q] = pk2(bflo(gb[q]) * y0, bfhi(gb[q]) * y1);
            }
            *(u32x4*)(MIXIN + (size_t)row * 1024 + 512 + lane * 8) = o;
        }
    }
    float lam;
    { const float p1 = a.in[I_LQ1][lane] * a.in[I_LK1][lane], p2 = a.in[I_LQ2][lane] * a.in[I_LK2][lane];
      lam = __expf(wave_sum(p1)) - __expf(wave_sum(p2)) + LAM_INIT; }
    const bf16_t* Q = (const bf16_t*)(ws + WS_Q); const bf16_t* KA = (const bf16_t*)(ws + WS_K); const bf16_t* VA = (const bf16_t*)(ws + WS_V);
    __syncthreads();
    for (int u = vcu * 8; u < 2048; u += G * 8) {
        const int x = (u >> 3) / 32, jj = (u >> 3) % 32;
        for (int i = 0; i < 8; ++i) {
            const int bh = 16 * x + 2 * i + (jj >> 4), qb = jj & 15;
            att::unit(lds, bh >> 2, bh & 3, qb, Q, KA, VA, MIXIN, a.in[I_SUBLN], lam, (const unsigned*)(ws + WS_CTL) + CW_KMAX);
        }
    }
}

struct P5In { f32x4 x[4]; u32x2 m[4]; };
__device__ __forceinline__ void p5_load(P5In& r, int row, int lane, const float* X, const bf16_t* MIX) {
    const f32x4* xr = (const f32x4*)(X + (size_t)row * D) + lane; const u32x2* mr = (const u32x2*)(MIX + (size_t)row * D) + lane;
#pragma unroll
    for (int j = 0; j < 4; ++j) { r.x[j] = __builtin_nontemporal_load(xr + 64 * j); r.m[j] = __builtin_nontemporal_load(mr + 64 * j); }
}
__device__ __forceinline__ float p5_resid(const P5In& r, f32x4 (&h)[4], int row, int lane, const LAS float* mv, const f32x4* npm, bf16_t* H1) {
    f32x4 mx[4]; float s = 0.f;
#pragma unroll
    for (int j = 0; j < 4; ++j) { const u32x2 wv = r.m[j]; mx[j] = (f32x4){bflo(wv.x), bfhi(wv.x), bflo(wv.y), bfhi(wv.y)};
        s += (mx[j].x * mx[j].x + mx[j].y * mx[j].y) + (mx[j].z * mx[j].z + mx[j].w * mx[j].w); }
    const float rstd1 = 1.0f / sqrtf(wave_sum(s) * (1.f / D) + EPS);
    u32x2* hr = (u32x2*)(H1 + (size_t)row * D) + lane; float s2 = 0.f;
#pragma unroll
    for (int j = 0; j < 4; ++j) { const f32x4 g1 = *(const LAS f32x4*)(mv + 4 * lane + 256 * j);
        h[j] = r.x[j] + g1 * ((mx[j] * rstd1) * npm[64 * j]);
        u32x2 wv; wv.x = pk2(h[j].x, h[j].y); wv.y = pk2(h[j].z, h[j].w); __builtin_nontemporal_store(wv, hr + 64 * j);
        s2 += (h[j].x * h[j].x + h[j].y * h[j].y) + (h[j].z * h[j].z + h[j].w * h[j].w); }
    return 1.0f / sqrtf(wave_sum(s2) * (1.f / D) + EPS);
}
__device__ __forceinline__ void p5_rows(const Args& a, LAS unsigned char* lds, int p  ) {
    const int tid = opaque_tid(), lane = tid & 63, wave = __builtin_amdgcn_readfirstlane(tid >> 6);
    unsigned char* ws = a.ws;
    const int b = p >> 3;
    LAS float* wrt = (LAS float*)lds;
    LAS float* mv = (LAS float*)(lds + 65536);
    const float* wr = a.in[I_WROUTER];
    const bf16_t* MIX = (const bf16_t*)(ws + WS_MIX); unsigned char* XN2 = ws + WS_XN; float* AFFT = (float*)(ws + WS_AFFT); bf16_t* H1 = (bf16_t*)(ws + WS_H1);
    const float* X = a.in[I_X];
    const int rbase = p * 256 + wave * 32;
    P5In cA, cB;
    p5_load(cA, rbase, lane, X, MIX); p5_load(cB, rbase + 16, lane, X, MIX);
    for (int n = tid; n < D * NE; n += NTHREADS) { const int k = n >> 4, e = n & 15; wrt[e * D + k] = wr[n]; }
    const float* MOD = (const float*)(ws + WS_MOD) + (size_t)b * NMOD;
    for (int n = tid; n < 3 * D; n += NTHREADS) mv[n] = MOD[2 * D + n];
    __syncthreads();
    const f32x4* npm = (const f32x4*)a.in[I_NPOST_MIX] + lane; const f32x4* npf = (const f32x4*)a.in[I_NPRE_FFN] + lane;
    for (int i = 0; i < 16; ++i) {
        const int rowA = rbase + i, rowB = rbase + 16 + i;
        P5In nA, nB;
        if (i + 1 < 16) { p5_load(nA, rowA + 1, lane, X, MIX); p5_load(nB, rowB + 1, lane, X, MIX); }
        f32x4 hA[4], hB[4];
        const float rsA = p5_resid(cA, hA, rowA, lane, mv, npm, H1);
        const float rsB = p5_resid(cB, hB, rowB, lane, mv, npm, H1);
        unsigned* oA = (unsigned*)(XN2 + (size_t)rowA * D) + lane; unsigned* oB = (unsigned*)(XN2 + (size_t)rowB * D) + lane;
        typedef float f32x2v __attribute__((ext_vector_type(2)));
        f32x2v lg2[16];
#pragma unroll
        for (int e = 0; e < 16; ++e) lg2[e] = (f32x2v){0.f, 0.f};
#pragma unroll
        for (int j = 0; j < 4; ++j) { const f32x4 sh2 = *(const LAS f32x4*)(mv + 1024 + 4 * lane + 256 * j), sc2 = *(const LAS f32x4*)(mv + 2048 + 4 * lane + 256 * j);
            const f32x4 gn = npf[64 * j];
            const f32x4 zA = ((hA[j] * rsA) * gn) * (sc2 + 1.0f) + sh2, zB = ((hB[j] * rsB) * gn) * (sc2 + 1.0f) + sh2;
            { const f32x4 qa = zA * pg8::F8_ACT, qb = zB * pg8::F8_ACT; oA[64 * j] = pg8::pk4_fp8(qa.x, qa.y, qa.z, qa.w); oB[64 * j] = pg8::pk4_fp8(qb.x, qb.y, qb.z, qb.w); }
            const f32x2v zx = {zA.x, zB.x}, zy = {zA.y, zB.y}, zz = {zA.z, zB.z}, zw = {zA.w, zB.w};
#pragma unroll
            for (int e = 0; e < 16; ++e) { const f32x4 wq = *(const LAS f32x4*)(wrt + e * D + 4 * lane + 256 * j);
                lg2[e] = __builtin_elementwise_fma(zx, (f32x2v){wq.x, wq.x}, lg2[e]); lg2[e] = __builtin_elementwise_fma(zy, (f32x2v){wq.y, wq.y}, lg2[e]);
                lg2[e] = __builtin_elementwise_fma(zz, (f32x2v){wq.z, wq.z}, lg2[e]); lg2[e] = __builtin_elementwise_fma(zw, (f32x2v){wq.w, wq.w}, lg2[e]);
                if ((e & 3) == 3) __builtin_amdgcn_sched_barrier(0); } }
        float lg[32];
#pragma unroll
        for (int e = 0; e < 16; ++e) { lg[e] = lg2[e].x; lg[16 + e] = lg2[e].y; }
#pragma unroll
        for (int st = 0; st < 5; ++st) { const int d = 1 << st, cntv = 16 >> st; const bool up = (lane & d) != 0;
#pragma unroll
            for (int q = 0; q < 16; ++q) if (q < cntv) { const float send = up ? lg[2 * q] : lg[2 * q + 1], keep = up ? lg[2 * q + 1] : lg[2 * q]; lg[q] = keep + __shfl_xor(send, d); } }
        float lv = lg[0] + __shfl_xor(lg[0], 32);
        float mxl = lv;
#pragma unroll
        for (int d = 1; d < 16; d <<= 1) mxl = fmaxf(mxl, __shfl_xor(mxl, d));
        const float ev = __expf(lv - mxl); float se = ev;
#pragma unroll
        for (int d = 1; d < 16; d <<= 1) se += __shfl_xor(se, d);
        if (lane < 32) { const int row = (lane < 16) ? rowA : rowB; AFFT[((size_t)b * NE + (lane & 15)) * T + (row & (T - 1))] = ev / se; }
        cA = nA; cB = nB;
    }
}

__device__ __forceinline__ void p6_topk(const Args& a, LAS unsigned char* lds, int c, int G) {
    const int tid = opaque_tid(), lane = tid & 63, wave = __builtin_amdgcn_readfirstlane(tid >> 6);
    unsigned char* ws = a.ws;
    const float* AFFT = (const float*)(ws + WS_AFFT); short* SLOT = (short*)(ws + WS_SLOT); int* IDX = (int*)(ws + WS_IDX); float* GATE = (float*)(ws + WS_GATE);
    LAS unsigned* sv = (LAS unsigned*)(lds + wave * 16384);
    for (int item = c + wave * G; item < NITEM; item += G * NWAVES) {
        const int b = item >> 4, e = item & 15;
        const float* src = AFFT + (size_t)item * T;
#pragma unroll 8
        for (int j = 0; j < 32; ++j) sv[j * 64 + lane] = __float_as_uint(src[j * 64 + lane]);
        LDS_WAIT(); asm volatile("" ::: "memory");
        unsigned pre = 0u;
        for (int bit = 30; bit >= 0; --bit) {
            const unsigned cand = pre | (1u << bit);
            int cnt = 0;
#pragma unroll 4
            for (int j = 0; j < 32; ++j) cnt += (int)__popcll(__ballot(sv[j * 64 + lane] >= cand));
            if (cnt >= CAP) pre = cand;
        }
        int ngt = 0;
#pragma unroll 4
        for (int j = 0; j < 32; ++j) ngt += (int)__popcll(__ballot(sv[j * 64 + lane] > pre));
        const int need_eq = CAP - ngt;
        const unsigned long long ltmask = (1ull << lane) - 1ull;
        int base_gt = 0, base_eq = 0;
#pragma unroll 2
        for (int j = 0; j < 32; ++j) {
            const unsigned vj = sv[j * 64 + lane];
            const bool gt = vj > pre, eq = vj == pre;
            const unsigned long long mg = __ballot(gt), me = __ballot(eq);
            const int pg = base_gt + (int)__popcll(mg & ltmask), pe = base_eq + (int)__popcll(me & ltmask);
            int sl = -1; if (gt) sl = pg; else if (eq && pe < need_eq) sl = ngt + pe;
            const int t = j * 64 + lane;
            SLOT[((size_t)b * T + t) * NE + e] = (short)sl;
            if (sl >= 0) { IDX[item * CAP + sl] = t; GATE[item * CAP + sl] = __uint_as_float(vj); }
            base_gt += (int)__popcll(mg); base_eq += (int)__popcll(me);
        }
        LDS_WAIT(); asm volatile("" ::: "memory");
    }
}

struct P8Row { u32x2 h[4]; u32x2 y[4][4]; float wt[4]; unsigned long long rest; int sl; };
__device__ __forceinline__ void p8_issue(P8Row& r, int row, int lane, const short* SLOT, const bf16_t* Y, const bf16_t* H1) {
    const int b = row >> 11;
    const int s_e = (lane < NE) ? (int)SLOT[(size_t)row * NE + lane] : -1;
    unsigned long long mask = __ballot(s_e >= 0);
    const u32x2* hr = (const u32x2*)(H1 + (size_t)row * D) + lane;
#pragma unroll
    for (int j = 0; j < 4; ++j) r.h[j] = __builtin_nontemporal_load(hr + 64 * j);
#pragma unroll
    for (int q = 0; q < 4; ++q) {
        int e = 0, s = 0; r.wt[q] = 0.f;
        if (mask) { e = (int)__builtin_ctzll(mask); mask &= mask - 1ull; s = __builtin_amdgcn_readlane(s_e, e); r.wt[q] = 1.f; }
        const u32x2* yr = (const u32x2*)(Y + ((size_t)(b * NE + e) * CAP + s) * D) + lane;
#pragma unroll
        for (int j = 0; j < 4; ++j) r.y[q][j] = __builtin_nontemporal_load(yr + 64 * j);
    }
    r.rest = mask; r.sl = s_e;
}
__device__ __forceinline__ void p8_finish(P8Row& r, int row, int lane, const bf16_t* Y, const float* MOD, const f32x4* npo, float* out) {
    const int b = row >> 11;
    f32x4 ff[4];
#pragma unroll
    for (int j = 0; j < 4; ++j) ff[j] = (f32x4){0.f, 0.f, 0.f, 0.f};
#pragma unroll
    for (int q = 0; q < 4; ++q)
#pragma unroll
        for (int j = 0; j < 4; ++j) { const u32x2 wv = r.y[q][j]; ff[j] += (f32x4){bflo(wv.x), bfhi(wv.x), bflo(wv.y), bfhi(wv.y)} * r.wt[q]; }
    unsigned long long mask = r.rest;
    while (mask) {
        const int e = (int)__builtin_ctzll(mask); mask &= mask - 1ull; const int s = __builtin_amdgcn_readlane(r.sl, e);
        const u32x2* yr = (const u32x2*)(Y + ((size_t)(b * NE + e) * CAP + s) * D) + lane;
#pragma unroll
        for (int j = 0; j < 4; ++j) { const u32x2 wv = yr[64 * j]; ff[j] += (f32x4){bflo(wv.x), bfhi(wv.x), bflo(wv.y), bfhi(wv.y)}; }
    }
    float s2 = 0.f;
#pragma unroll
    for (int j = 0; j < 4; ++j) s2 += (ff[j].x * ff[j].x + ff[j].y * ff[j].y) + (ff[j].z * ff[j].z + ff[j].w * ff[j].w);
    const float rstd = 1.0f / sqrtf(wave_sum(s2) * (1.f / D) + EPS);
    f32x4* orow = (f32x4*)(out + (size_t)row * D) + lane; const f32x4* g2 = (const f32x4*)(MOD + (size_t)b * NMOD + 5 * D) + lane;
#pragma unroll
    for (int j = 0; j < 4; ++j) { const u32x2 hv = r.h[j]; const f32x4 h = (f32x4){bflo(hv.x), bfhi(hv.x), bflo(hv.y), bfhi(hv.y)};
        __builtin_nontemporal_store(h + g2[64 * j] * ((ff[j] * rstd) * npo[64 * j]), orow + 64 * j); }
}
__device__ __forceinline__ void p8_final(const Args& a, int vcu, int G) {
    const int tid = opaque_tid(), lane = tid & 63, wave = __builtin_amdgcn_readfirstlane(tid >> 6);
    unsigned char* ws = a.ws;
    const short* SLOT = (const short*)(ws + WS_SLOT); const bf16_t* Y = (const bf16_t*)(ws + WS_Y); const float* MOD = (const float*)(ws + WS_MOD); const bf16_t* H1 = (const bf16_t*)(ws + WS_H1);
    const f32x4* npo = (const f32x4*)a.in[I_NPOST_FFN] + lane;
    const int gw = vcu * NWAVES + wave, NGW = G * NWAVES;
    for (int row = gw; row < M; row += 2 * NGW) {
        P8Row r0, r1;
        p8_issue(r0, row, lane, SLOT, Y, H1);
        const bool two = row + NGW < M;
        if (two) p8_issue(r1, row + NGW, lane, SLOT, Y, H1);
        p8_finish(r0, row, lane, Y, MOD, npo, a.out);
        if (two) p8_finish(r1, row + NGW, lane, Y, MOD, npo, a.out);
    }
}

__global__ void __launch_bounds__(NTHREADS, 2) fwd_kernel(Args args) {
    extern __shared__ __attribute__((aligned(16))) unsigned char lds_raw[];
    LAS unsigned char* lds = (LAS unsigned char*)lds_raw;
    volatile LAS unsigned* MISC = (volatile LAS unsigned*)(lds + MISC_OFF);
    const int tid = threadIdx.x;
    const int G = gridDim.x, c = blockIdx.x;
    const int vcu = (G % 8 == 0) ? (c % 8) * (G / 8) + c / 8 : c;
    unsigned char* ws = args.ws;
    gu32* ctl = (gu32*)(ws + WS_CTL);
    for (int u = tid; u < (LDS_BYTES - LDSCTL_OFF) / 4; u += NTHREADS) ((LAS unsigned*)(lds + LDSCTL_OFF))[u] = 0u;
    __syncthreads();
    XcdBarrier bar; bar.bar = (unsigned*)(ctl + CW_BAR); bar.x = 0; bar.st = nullptr;
    const int lo = args.ph_lo, hi = args.ph_hi;
    if (hi - lo > 1) bar = xcd_barrier_post((unsigned*)(ctl + CW_BAR), MISC + 8);
#ifndef PHMASK
#define PHMASK 0xff
#endif
#define IN(k) (((PHMASK >> (k)) & 1) && lo <= (k) && (k) < hi)
#define SEAM(k) do { if (IN(k) && IN((k) + 1)) xcd_barrier(bar); } while (0)
#ifndef PROBE_PHASE
#define PROBE_PHASE -1
#endif
#define PB(k) do { if (PROBE_PHASE == (k)) { if (tid == 0) { const unsigned long long t0_ = __builtin_amdgcn_s_memrealtime(); MISC[16] = (unsigned)t0_; MISC[17] = (unsigned)(t0_ >> 32); } } } while (0)
#define PE(k) do { if (PROBE_PHASE == (k)) { if (tid == 0) { const unsigned long long t0_ = ((unsigned long long)MISC[17] << 32) | MISC[16]; const unsigned long long t1_ = __builtin_amdgcn_s_memrealtime(); \
      while (__builtin_amdgcn_s_memrealtime() - t1_ < t1_ - t0_) __builtin_amdgcn_s_sleep(8); } __syncthreads(); } } while (0)

    PB(0); if (IN(0)) { p0_prologue(args, lds, vcu, G); } SEAM(0); PE(0);
    PB(1); if (IN(1)) { p1_xn(args, lds, c, G); } SEAM(1); PE(1);
    PB(2); if (IN(2)) {
        pg8::Gemm g{(const bf16_t*)(ws + WS_XN), (const bf16_t*)(ws + WS_WIN), D, nullptr};
        pg8::SchedProj S{G, c};
        pg8::EpiProj E{(bf16_t*)(ws + WS_Q), (bf16_t*)(ws + WS_K), (bf16_t*)(ws + WS_V), (bf16_t*)(ws + WS_GB), (bf16_t*)(ws + WS_U), (const float*)(ws + WS_TAB), (unsigned*)(ws + WS_CTL) + CW_KMAX};
        pg8::gemm_phase<pg8::EpiProj, pg8::SchedProj, true, true>(lds, g, S, E);
    } SEAM(2); PE(2);
    PB(3); if (IN(3)) { if (c & 1) expert_weight_copies(args, lds, vcu, G); p3_conv_attn(args, lds, c, vcu, G); if (!(c & 1)) expert_weight_copies(args, lds, vcu, G); } SEAM(3); PE(3);
    PB(4); if (IN(4)) {
        {
            const int p = c;
#ifndef NO_P4
            pg8::Gemm g{(const bf16_t*)(ws + WS_MIXIN), (const bf16_t*)(ws + WS_WOUT), D, nullptr};
            pg8::SchedPanel S{p, 4};
            pg8::EpiBf16 E{(bf16_t*)(ws + WS_MIX), D};
            pg8::gemm_phase<pg8::EpiBf16, pg8::SchedPanel, true, true>(lds, g, S, E);
#endif
            VM_WAIT(); __syncthreads();
#ifndef NO_P5
            p5_rows(args, lds, p);
#endif
            __syncthreads();
        }
    } SEAM(4); PE(4);
    PB(5); if (IN(5)) { p6_topk(args, lds, c, G); } SEAM(5); PE(5);
    PB(6); if (IN(6)) {
#pragma unroll 1
        for (int it = 0; it < 2; ++it) {
            {
                const int item = 2 * c + it;
                const int b = item >> 4, e = item & 15;
#ifndef NO_G1
                if (it == 0) PB(8);
                {
                    pg8::Gemm g{(const bf16_t*)(ws + WS_XN + (size_t)b * T * D), (const bf16_t*)(ws + WS_WGU + (size_t)e * 2048 * D), D, (const int*)(ws + WS_IDX) + item * CAP};
                    pg8::SchedPanel S{0, 8};
                    pg8::EpiGU8 E{ws + WS_HMID + (size_t)item * CAP * D};
                    pg8::gemm_phase<pg8::EpiGU8, pg8::SchedPanel, true, true, true, true>(lds, g, S, E);
                }
#endif
                VM_WAIT(); __syncthreads();
                if (it == 0) { PE(8); PB(9); }
#ifndef NO_G2
                {
                    pg8::Gemm g{(const bf16_t*)(ws + WS_HMID + (size_t)item * CAP * D), (const bf16_t*)(ws + WS_WDN + (size_t)e * D * D), D, nullptr};
                    pg8::SchedPanel S{0, 4};
                    pg8::EpiDown E{(bf16_t*)(ws + WS_Y) + (size_t)item * CAP * D, (const float*)(ws + WS_GATE) + item * CAP, pg8::F8_INV};
                    pg8::gemm_phase<pg8::EpiDown, pg8::SchedPanel, true, true, false, true>(lds, g, S, E);
                }
#endif
                VM_WAIT(); __syncthreads();
                if (it == 0) PE(9);
            }
        }
    } SEAM(6); PE(6);
    PB(7); if (IN(7)) { p8_final(args, vcu, G); } PE(7);
#undef IN
#undef SEAM
}

extern "C" void kernel_launch(void* const* d_in, const int* in_sizes, int n_in, void* d_out, int out_size, void* d_ws, size_t ws_size, hipStream_t stream) {
    static int grid = 0;
    if (grid == 0) {
        if (n_in != 22 || in_sizes[0] != M * D || out_size != M * D || ws_size < WS_END) { fprintf(stderr, "kernel_launch: unexpected shapes (n_in %d, in0 %d, out %d, ws %zu)\n", n_in, n_in > 0 ? in_sizes[0] : -1, out_size, ws_size); grid = -1; return; }
        int dev = 0, cus = 0;
        if (hipGetDevice(&dev) != hipSuccess || hipDeviceGetAttribute(&cus, hipDeviceAttributeMultiprocessorCount, dev) != hipSuccess) { grid = -1; return; }
        if (hipFuncSetAttribute((const void*)fwd_kernel, hipFuncAttributeMaxDynamicSharedMemorySize, LDS_BYTES) != hipSuccess) { fprintf(stderr, "kernel_launch: hipFuncSetAttribute failed\n"); grid = -1; return; }
        (void)hipGetLastError();
        grid = cus;
        if (grid != 256) { fprintf(stderr, "kernel_launch: this kernel needs a 256-CU device (got %d)\n", cus); grid = -1; return; }
    }
    if (grid < 0) return;
    (void)hipMemsetAsync((char*)d_ws + WS_CTL, 0, CTL_ZERO_BYTES, stream);
    Args a{};
    for (int i = 0; i < 22; ++i) a.in[i] = (const float*)d_in[i];
    a.out = (float*)d_out; a.ws = (unsigned char*)d_ws;
    constexpr int NPH = 8;
    if (MK_N_LAUNCHES == 1) { a.ph_lo = 0; a.ph_hi = NPH; hipLaunchKernelGGL(fwd_kernel, dim3(grid), dim3(NTHREADS), LDS_BYTES, stream, a); }
    else { for (int k = 0; k < NPH; ++k) { a.ph_lo = k; a.ph_hi = k + 1; hipLaunchKernelGGL(fwd_kernel, dim3(grid), dim3(NTHREADS), LDS_BYTES, stream, a); } }
}
```

```cpp
#include <hip/hip_runtime.h>
#include <cstdio>
#include <cstdint>

#ifndef MK_N_LAUNCHES
#define MK_N_LAUNCHES 1
#endif

#define LAS __attribute__((address_space(3)))
#define GAS __attribute__((address_space(1)))
typedef unsigned short bf16_t;
typedef short bf16x8 __attribute__((ext_vector_type(8)));
typedef short s16x4 __attribute__((ext_vector_type(4)));
typedef float f32x4 __attribute__((ext_vector_type(4)));
typedef float f32x16 __attribute__((ext_vector_type(16)));
typedef unsigned u32x4 __attribute__((ext_vector_type(4)));
typedef unsigned u32x2 __attribute__((ext_vector_type(2)));

constexpr int NB = 32, T = 2048, D = 1024, TC = 256, M = NB * T, MC = NB * TC, MA = M + MC, TK = TC + T;
constexpr int NE = 16, CAP = 256, NITEM = NB * NE, NPROJ = 3072, NMOD = 6 * D;
constexpr float EPS = 1e-6f;
constexpr float C2 = 0.125f * 1.4426950408889634f;
constexpr float LAM_INIT = 0.2f;
constexpr int NWAVES = 8, NTHREADS = 512;

constexpr size_t MiB = 1u << 20;
constexpr size_t WS_CTL = 0, CTL_ZERO_BYTES = 1 * MiB;
constexpr size_t WS_MODP = 2 * MiB;
constexpr size_t WS_MOD = 16 * MiB;
constexpr size_t WS_TAB = 17 * MiB;
constexpr size_t WS_WIN = 18 * MiB;
constexpr size_t WS_WOUT = 24 * MiB;
constexpr size_t WS_WGU = 26 * MiB;
constexpr size_t WS_WDN = 90 * MiB;
constexpr size_t WS_AFFT = 122 * MiB;
constexpr size_t WS_SLOT = 126 * MiB;
constexpr size_t WS_IDX = 128 * MiB;
constexpr size_t WS_GATE = 129 * MiB;
constexpr size_t WS_XN = 130 * MiB;
constexpr size_t WS_Q = 274 * MiB;
constexpr size_t WS_K = 338 * MiB;
constexpr size_t WS_V = 410 * MiB;
constexpr size_t WS_GB = 482 * MiB;
constexpr size_t WS_U = 546 * MiB;
constexpr size_t WS_MIXIN = 610 * MiB;
constexpr size_t WS_MIX = 738 * MiB;
constexpr size_t WS_HMID = 274 * MiB;
constexpr size_t WS_Y = 610 * MiB;
constexpr size_t WS_H1 = 866 * MiB;
constexpr size_t WS_END = 994 * MiB;

__device__ __forceinline__ int opaque_tid() { int t = threadIdx.x; asm volatile("" : "+v"(t)); return t; }

namespace pg8 {
constexpr int BM = 256, BK = 64, HALF = 128, HTB = HALF * BK * 2, STAGE_BYTES = 8 * HTB;
__host__ __device__ __forceinline__ int lds_byte(int r, int c) { const int st = (r >> 4) * 2 + (c >> 5), rr = r & 15, cc = c & 31, ob = rr * 64 + cc * 2; return st * 1024 + (ob ^ (((ob >> 9) & 1) << 5)); }
__host__ __device__ __forceinline__ void stage_rc(int b, int& R, int& C) { const int st = b / 1024, sb = b % 1024, swz = sb ^ (((sb >> 9) & 1) << 5); R = (st >> 1) * 16 + swz / 64; C = (st & 1) * 32 + (swz % 64) / 2; }
__host__ __device__ __forceinline__ int perm32(int rho) { const int n = rho >> 4, i = rho & 15; return 8 * (i >> 2) + 4 * n + (i & 3); }

struct Unit { int pm, pn; };
struct Gemm { const bf16_t* A; const bf16_t* Bt; int K; const int* gidx; };

typedef float f32x2_t __attribute__((ext_vector_type(2))); typedef __bf16 bf16x2_t __attribute__((ext_vector_type(2)));
__device__ __forceinline__ unsigned cvt_pk_bf16(float lo, float hi) { const f32x2_t v = {lo, hi}; const bf16x2_t b = __builtin_convertvector(v, bf16x2_t); return __builtin_bit_cast(unsigned, b); }

struct EpiBf16 {
    static constexpr bool PERM = true, AFTER_DRAIN = false;
    bf16_t* O; int ldc;
    __device__ __forceinline__ void operator()(const f32x4 (&acc)[2][2][4][2], const Unit& u, int wr, int wc, int fr, int fq) const {
        const int row0 = u.pm * BM + wr * 64 + fr; const int col0 = u.pn * BM + wc * 32 + 8 * fq;
#pragma unroll
        for (int ai = 0; ai < 2; ++ai)
#pragma unroll
            for (int m = 0; m < 4; ++m) { bf16_t* rowp = O + (size_t)(row0 + ai * HALF + m * 16) * ldc + col0;
#pragma unroll
                for (int bj = 0; bj < 2; ++bj) { const f32x4 v0 = acc[ai][bj][m][0], v1 = acc[ai][bj][m][1];
                    u32x4 w; w.x = cvt_pk_bf16(v0[0], v0[1]); w.y = cvt_pk_bf16(v0[2], v0[3]); w.z = cvt_pk_bf16(v1[0], v1[1]); w.w = cvt_pk_bf16(v1[2], v1[3]);
                    *(u32x4*)(rowp + bj * HALF) = w; } }
    }
};

struct EpiProj {
    static constexpr bool PERM = true, AFTER_DRAIN = false;
    bf16_t *Q, *KA, *VA, *GB, *U; const float* tab;
    unsigned* kmaxh;
    __device__ __forceinline__ void operator()(const f32x4 (&acc)[2][2][4][2], const Unit& u, int wr, int wc, int fr, int fq) const {
        const int pn = u.pn; const bool ctx = u.pm >= 256;
        float km[2] = {0.f, 0.f};
#pragma unroll
        for (int ai = 0; ai < 2; ++ai)
#pragma unroll
            for (int m = 0; m < 4; ++m) {
                const int row = u.pm * BM + ai * HALF + wr * 64 + m * 16 + fr;
                int t, kvrow;
                if (!ctx) { const int b = row >> 11; t = row & 2047; kvrow = b * TK + TC + t; }
                else { const int rc = row - M; const int b = rc >> 8; t = 0; kvrow = b * TK + (rc & 255); }
                if (pn < 4) {
                    f32x4 cs0 = {1.f, 0.f, 1.f, 0.f}, cs1 = cs0, cs2 = cs0, cs3 = cs0;
                    if (!ctx) { const float* tp = tab + ((size_t)t * 32 + 16 * (wc & 1) + 4 * fq) * 2;
                        cs0 = *(const f32x4*)(tp); cs1 = *(const f32x4*)(tp + 4); }
                    (void)cs2; (void)cs3;
#pragma unroll
                    for (int bj = 0; bj < 2; ++bj) {
                        const f32x4 v0 = acc[ai][bj][m][0], v1 = acc[ai][bj][m][1];
                        float e0 = v0[0], o0 = v0[1], e1 = v0[2], o1 = v0[3], e2 = v1[0], o2 = v1[1], e3 = v1[2], o3 = v1[3];
                        if (pn >= 2) {
                            float ss = ((e0 * e0 + o0 * o0) + (e1 * e1 + o1 * o1)) + ((e2 * e2 + o2 * o2) + (e3 * e3 + o3 * o3));
                            ss += __shfl_xor(ss, 16); ss += __shfl_xor(ss, 32); km[bj] = fmaxf(km[bj], ss); }
                        float r0 = e0 * cs0[0] - o0 * cs0[1], s0 = o0 * cs0[0] + e0 * cs0[1];
                        float r1 = e1 * cs0[2] - o1 * cs0[3], s1 = o1 * cs0[2] + e1 * cs0[3];
                        float r2 = e2 * cs1[0] - o2 * cs1[1], s2 = o2 * cs1[0] + e2 * cs1[1];
                        float r3 = e3 * cs1[2] - o3 * cs1[3], s3 = o3 * cs1[2] + e3 * cs1[3];
                        const float sc = (pn < 2) ? C2 : 1.f;
                        u32x4 w; w.x = cvt_pk_bf16(r0 * sc, s0 * sc); w.y = cvt_pk_bf16(r1 * sc, s1 * sc); w.z = cvt_pk_bf16(r2 * sc, s2 * sc); w.w = cvt_pk_bf16(r3 * sc, s3 * sc);
                        const int col = (pn & 1) * 256 + bj * HALF + wc * 32 + 8 * fq;
                        bf16_t* dst = (pn < 2) ? (Q + (size_t)row * 512 + col) : (KA + (size_t)kvrow * 512 + col);
                        *(u32x4*)dst = w;
                    }
                } else if (pn < 8) {
#pragma unroll
                    for (int bj = 0; bj < 2; ++bj) {
                        const f32x4 v0 = acc[ai][bj][m][0], v1 = acc[ai][bj][m][1];
                        u32x4 w; w.x = cvt_pk_bf16(v0[0], v0[1]); w.y = cvt_pk_bf16(v0[2], v0[3]); w.z = cvt_pk_bf16(v1[0], v1[1]); w.w = cvt_pk_bf16(v1[2], v1[3]);
                        const int col = (pn & 1) * 256 + bj * HALF + wc * 32 + 8 * fq;
                        bf16_t* dst = (pn < 6) ? (VA + (size_t)kvrow * 512 + col) : (GB + (size_t)row * 512 + col);
                        *(u32x4*)dst = w;
                    }
                } else {
                    const f32x4 a0 = acc[ai][0][m][0], a1 = acc[ai][0][m][1], b0 = acc[ai][1][m][0], b1 = acc[ai][1][m][1];
                    u32x4 w; w.x = cvt_pk_bf16(a0[0] * b0[0], a0[1] * b0[1]); w.y = cvt_pk_bf16(a0[2] * b0[2], a0[3] * b0[3]);
                    w.z = cvt_pk_bf16(a1[0] * b1[0], a1[1] * b1[1]); w.w = cvt_pk_bf16(a1[2] * b1[2], a1[3] * b1[3]);
                    const int col = (pn - 8) * 128 + wc * 32 + 8 * fq;
                    *(u32x4*)(U + (size_t)row * 512 + col) = w;
                }
            }
        if (pn == 2 || pn == 3) {
            const int b = ctx ? (u.pm - 256) : (u.pm >> 3);
#pragma unroll
            for (int bj = 0; bj < 2; ++bj) { float v = km[bj];
#pragma unroll
                for (int d = 1; d < 16; d <<= 1) v = fmaxf(v, __shfl_xor(v, d));
                if (fr == 0 && fq == 0) atomicMax(kmaxh + ((b * 8 + (pn & 1) * 4 + bj * 2 + (wc >> 1)) * 2 + (wc & 1)), __float_as_uint(v)); }
        }
    }
};

struct EpiGU {
    static constexpr bool PERM = true, AFTER_DRAIN = false;
    bf16_t* H;
    __device__ __forceinline__ float silu(float x) const { return x * __builtin_amdgcn_rcpf(1.f + __expf(-x)); }
    __device__ __forceinline__ void operator()(const f32x4 (&acc)[2][2][4][2], const Unit& u, int wr, int wc, int fr, int fq) const {
#pragma unroll
        for (int ai = 0; ai < 2; ++ai)
#pragma unroll
            for (int m = 0; m < 4; ++m) {
                const int row = ai * HALF + wr * 64 + m * 16 + fr;
                const f32x4 a0 = acc[ai][0][m][0], a1 = acc[ai][0][m][1], b0 = acc[ai][1][m][0], b1 = acc[ai][1][m][1];
                u32x4 w; w.x = cvt_pk_bf16(silu(a0[0]) * b0[0], silu(a0[1]) * b0[1]); w.y = cvt_pk_bf16(silu(a0[2]) * b0[2], silu(a0[3]) * b0[3]);
                w.z = cvt_pk_bf16(silu(a1[0]) * b1[0], silu(a1[1]) * b1[1]); w.w = cvt_pk_bf16(silu(a1[2]) * b1[2], silu(a1[3]) * b1[3]);
                *(u32x4*)(H + (size_t)row * 1024 + u.pn * 128 + wc * 32 + 8 * fq) = w;
            }
    }
};
__device__ __forceinline__ unsigned pk4_fp8(float a, float b, float c, float d) { int w = 0; w = __builtin_amdgcn_cvt_pk_fp8_f32(a, b, w, false); w = __builtin_amdgcn_cvt_pk_fp8_f32(c, d, w, true); return (unsigned)w; }
constexpr float F8_ACT = 4.0f, F8_WGT = 64.0f, F8_INV = 1.0f / (4.0f * 64.0f);
struct EpiGU8 {
    static constexpr bool PERM = true, AFTER_DRAIN = false;
    unsigned char* H;
    __device__ __forceinline__ float hval(float g, float u) const {
        const float e = __builtin_amdgcn_exp2f(g * (-F8_INV * 1.4426950408889634f));
        const float r = __builtin_amdgcn_rcpf(1.f + e);
        return __builtin_amdgcn_fmed3f((g * u) * (r * (F8_INV * F8_INV * F8_ACT)), -448.f, 448.f); }
    __device__ __forceinline__ void operator()(const f32x4 (&acc)[2][2][4][2], const Unit& u, int wr, int wc, int fr, int fq) const {
        asm volatile("" : "+v"(fr));
#pragma unroll
        for (int ai = 0; ai < 2; ++ai)
#pragma unroll
            for (int m = 0; m < 4; ++m) {
                const int row = ai * HALF + wr * 64 + m * 16 + fr;
                const f32x4 a0 = acc[ai][0][m][0], a1 = acc[ai][0][m][1], b0 = acc[ai][1][m][0], b1 = acc[ai][1][m][1];
                u32x2 w; w.x = pk4_fp8(hval(a0[0], b0[0]), hval(a0[1], b0[1]), hval(a0[2], b0[2]), hval(a0[3], b0[3]));
                w.y = pk4_fp8(hval(a1[0], b1[0]), hval(a1[1], b1[1]), hval(a1[2], b1[2]), hval(a1[3], b1[3]));
                *(u32x2*)(H + (size_t)row * 1024 + u.pn * 128 + wc * 32 + 8 * fq) = w;
            }
    }
};
struct EpiDown {
    static constexpr bool PERM = true, AFTER_DRAIN = false;
    bf16_t* Y; const float* gate; float scale;
    __device__ __forceinline__ void operator()(const f32x4 (&acc)[2][2][4][2], const Unit& u, int wr, int wc, int fr, int fq) const {
        asm volatile("" : "+v"(fr));
#pragma unroll
        for (int ai = 0; ai < 2; ++ai)
#pragma unroll
            for (int m = 0; m < 4; ++m) {
                const int row = ai * HALF + wr * 64 + m * 16 + fr; const float g = gate[row] * scale;
#pragma unroll
                for (int bj = 0; bj < 2; ++bj) { const f32x4 v0 = acc[ai][bj][m][0] * g, v1 = acc[ai][bj][m][1] * g;
                    u32x4 w; w.x = cvt_pk_bf16(v0[0], v0[1]); w.y = cvt_pk_bf16(v0[2], v0[3]); w.z = cvt_pk_bf16(v1[0], v1[1]); w.w = cvt_pk_bf16(v1[2], v1[3]);
                    *(u32x4*)(Y + (size_t)row * 1024 + u.pn * BM + bj * HALF + wc * 32 + 8 * fq) = w; }
            }
    }
};

constexpr float F8_Y = 64.0f;
struct EpiDown8 {
    static constexpr bool PERM = true, AFTER_DRAIN = false;
    unsigned char* Y; const float* gate; float scale;
    __device__ __forceinline__ void operator()(const f32x4 (&acc)[2][2][4][2], const Unit& u, int wr, int wc, int fr, int fq) const {
        asm volatile("" : "+v"(fr));
#pragma unroll
        for (int ai = 0; ai < 2; ++ai)
#pragma unroll
            for (int m = 0; m < 4; ++m) {
                const int row = ai * HALF + wr * 64 + m * 16 + fr; const float g = gate[row] * scale;
#pragma unroll
                for (int bj = 0; bj < 2; ++bj) { f32x4 v0 = acc[ai][bj][m][0] * g, v1 = acc[ai][bj][m][1] * g;
#pragma unroll
                    for (int i = 0; i < 4; ++i) { v0[i] = __builtin_amdgcn_fmed3f(v0[i], -448.f, 448.f); v1[i] = __builtin_amdgcn_fmed3f(v1[i], -448.f, 448.f); }
                    u32x2 w; w.x = pk4_fp8(v0[0], v0[1], v0[2], v0[3]); w.y = pk4_fp8(v1[0], v1[1], v1[2], v1[3]);
                    *(u32x2*)(Y + (size_t)row * 1024 + u.pn * BM + bj * HALF + wc * 32 + 8 * fq) = w; }
            }
    }
};

struct SchedProj {
    int G, c;
    __device__ __forceinline__ bool next(int i, Unit& u) const {
        const int L = i * G + c;
        if (L < 3072) { u.pm = L & 255; u.pn = L >> 8; return true; }
        const int j = L - 3072; if (j >= 128) return false;
        u.pm = 256 + (j >> 2); u.pn = 2 + (j & 3); return true;
    }
    __device__ __forceinline__ void a_ready(const Unit&) const {}
    __device__ __forceinline__ void done(const Unit&) const {}
};
struct SchedPanel {
    int pm, ntn;
    __device__ __forceinline__ bool next(int i, Unit& u) const { if (i >= ntn) return false; u.pm = pm; u.pn = i; return true; }
    __device__ __forceinline__ void a_ready(const Unit&) const {}
    __device__ __forceinline__ void done(const Unit&) const {}
};

typedef int i32x4v __attribute__((ext_vector_type(4)));
typedef int i32x8v __attribute__((ext_vector_type(8)));
__device__ __forceinline__ i32x8v cat8(bf16x8 a, bf16x8 b) { const i32x4v x = __builtin_bit_cast(i32x4v, a), y = __builtin_bit_cast(i32x4v, b); return __builtin_shufflevector(x, y, 0, 1, 2, 3, 4, 5, 6, 7); }
template <bool F8> struct Frag;
template <> struct Frag<false> { bf16x8 v[2]; __device__ __forceinline__ void set(bf16x8 a, bf16x8 b) { v[0] = a; v[1] = b; } };
template <> struct Frag<true> { i32x8v v; __device__ __forceinline__ void set(bf16x8 a, bf16x8 b) { v = cat8(a, b); } };
__device__ __forceinline__ f32x4 frag_mma(const Frag<false>& b, const Frag<false>& a, f32x4 c) { c = __builtin_amdgcn_mfma_f32_16x16x32_bf16(b.v[0], a.v[0], c, 0, 0, 0); return __builtin_amdgcn_mfma_f32_16x16x32_bf16(b.v[1], a.v[1], c, 0, 0, 0); }
__device__ __forceinline__ f32x4 frag_mma(const Frag<true>& b, const Frag<true>& a, f32x4 c) {
    const int sc1 = 0x7f7f7f7f;
    asm volatile("v_mfma_scale_f32_16x16x128_f8f6f4 %0, %1, %2, %0, %3, %3 op_sel_hi:[0,0,0]" : "+v"(c) : "v"(b.v), "v"(a.v), "v"(sc1));
    return c; }
template <class Epi, class Sched, bool ALIGN_EPI, bool SP2, bool GATHER = false, bool F8 = false>
__device__ __forceinline__ void gemm_phase(LAS unsigned char* lds, const Gemm g, const Sched& S, const Epi& E) {
    const int tid = opaque_tid(), wid = __builtin_amdgcn_readfirstlane(tid >> 6), lane = tid & 63, wr = wid >> 2, wc = wid & 3, fr = lane & 15, fq = lane >> 4;
    const int K = g.K * (F8 ? 1 : 2), nt = K / 128;
    unsigned voffA[2][2], voffB[2];
#pragma unroll
    for (int i = 0; i < 2; ++i) { int R, C; stage_rc(tid * 16 + i * 8192, R, C); const int Rb = Epi::PERM ? ((R & ~31) + perm32(R & 31)) : R;
        if constexpr (GATHER) { voffA[0][i] = (unsigned)(g.gidx[R] * K + C * 2); voffA[1][i] = (unsigned)(g.gidx[HALF + R] * K + C * 2); }
        else { voffA[0][i] = (unsigned)(R * K + C * 2); voffA[1][i] = voffA[0][i]; }
        voffB[i] = (unsigned)(Rb * K + C * 2); }
    const size_t kstep = (size_t)(BK * 2);
    const size_t hstep = (size_t)HALF * K;
    const size_t hstepA = GATHER ? (size_t)0 : hstep;
    const size_t tstep = 2 * hstep;
    const unsigned ldsw = (unsigned)wid * 1024u;
    const int aoff = F8 ? lds_byte(wr * 64 + fr, (fq >> 1) * 32 + (fq & 1) * 16) : lds_byte(wr * 64 + fr, fq * 8), boff = F8 ? lds_byte(wc * 32 + fr, (fq >> 1) * 32 + (fq & 1) * 16) : lds_byte(wc * 32 + fr, fq * 8);
    const int aoff1 = F8 ? aoff + 16 : aoff + 1024, boff1 = F8 ? boff + 16 : boff + 1024;
#define PG8_SA(b, h) (((b) * 2 + (h)) * HTB)
#define PG8_SB(b, h) ((4 + (b) * 2 + (h)) * HTB)
#define PG8_STAGE(bufoff, gbase, voff) do { _Pragma("unroll") for (int _i = 0; _i < 2; ++_i) \
        __builtin_amdgcn_global_load_lds((const unsigned*)((const char*)(gbase) + (voff)[_i]), (LAS unsigned*)(lds + (bufoff) + ldsw + _i * 8192), 16, 0, 0); } while (0)
#define PG8_LDA(dst, b, h) do { _Pragma("unroll") for (int m = 0; m < 4; ++m) dst[m].set(*(const LAS bf16x8*)(lds + PG8_SA(b, h) + aoff + m * 2048), *(const LAS bf16x8*)(lds + PG8_SA(b, h) + aoff1 + m * 2048)); } while (0)
#define PG8_LDB(dst, b, h) do { _Pragma("unroll") for (int n = 0; n < 2; ++n) dst[n].set(*(const LAS bf16x8*)(lds + PG8_SB(b, h) + boff + n * 2048), *(const LAS bf16x8*)(lds + PG8_SB(b, h) + boff1 + n * 2048)); } while (0)
#define PG8_MMA(ai, bj, At, Bt) do { __builtin_amdgcn_s_setprio(1); _Pragma("unroll") for (int m = 0; m < 4; ++m) _Pragma("unroll") for (int n = 0; n < 2; ++n) \
        acc[ai][bj][m][n] = frag_mma(Bt[n], At[m], acc[ai][bj][m][n]); __builtin_amdgcn_s_setprio(0); } while (0)
#define PG8_WAIT_V(n) asm volatile("s_waitcnt vmcnt(" #n ")" ::: "memory")
#define PG8_WAIT_L(n) asm volatile("s_waitcnt lgkmcnt(" #n ")" ::: "memory")
#define PG8_BAR __builtin_amdgcn_s_barrier()
#define PG8_SCHED __builtin_amdgcn_sched_barrier(0)
    Unit cur, nxt; int ui = 0;
    if (!S.next(0, cur)) return;
    f32x4 acc[2][2][4][2];
#pragma unroll
    for (int a = 0; a < 2; ++a)
#pragma unroll
        for (int b = 0; b < 2; ++b)
#pragma unroll
            for (int m = 0; m < 4; ++m)
#pragma unroll
                for (int n = 0; n < 2; ++n) acc[a][b][m][n] = (f32x4){0.f, 0.f, 0.f, 0.f};
    Frag<F8> At[4], B0[2], B1[2];
    const char* cA = (const char*)g.A + (size_t)cur.pm * tstep; const char* cB = (const char*)g.Bt + (size_t)cur.pn * tstep;
    S.a_ready(cur);
    if constexpr (SP2) {
        PG8_STAGE(PG8_SB(0, 0), cB, voffB); PG8_STAGE(PG8_SB(0, 1), cB + hstep, voffB); PG8_STAGE(PG8_SA(0, 0), cA, voffA[0]); PG8_STAGE(PG8_SA(0, 1), cA + hstepA, voffA[GATHER ? 1 : 0]);
        if (wr == 1) PG8_BAR;
        PG8_WAIT_V(2); PG8_BAR;
        PG8_STAGE(PG8_SB(1, 0), cB + kstep, voffB); PG8_STAGE(PG8_SA(1, 0), cA + kstep, voffA[0]); PG8_STAGE(PG8_SB(1, 1), cB + hstep + kstep, voffB);
        PG8_WAIT_V(6); PG8_BAR;
    } else {
        PG8_STAGE(PG8_SB(0, 0), cB, voffB); PG8_STAGE(PG8_SA(0, 0), cA, voffA[0]); PG8_STAGE(PG8_SB(0, 1), cB + hstep, voffB); PG8_STAGE(PG8_SA(0, 1), cA + hstepA, voffA[GATHER ? 1 : 0]);
        if (wr == 1) PG8_BAR;
        PG8_WAIT_V(4); PG8_BAR;
        PG8_STAGE(PG8_SB(1, 0), cB + kstep, voffB); PG8_STAGE(PG8_SA(1, 0), cA + kstep, voffA[0]); PG8_STAGE(PG8_SB(1, 1), cB + hstep + kstep, voffB);
        PG8_WAIT_V(6); PG8_BAR;
    }
    for (;;) {
        const bool has_next = S.next(ui + 1, nxt);
        const char* nA = has_next ? (const char*)g.A + (size_t)nxt.pm * tstep : cA; const char* nB = has_next ? (const char*)g.Bt + (size_t)nxt.pn * tstep : cB;
#pragma unroll 1
        for (int t = 0; t < nt; t += 2) {
            const bool last = (t == nt - 2);
            if constexpr (F8) { asm volatile("" : "+v"(voffA[0][0]), "+v"(voffA[0][1]), "+v"(voffB[0]), "+v"(voffB[1])); if constexpr (GATHER) asm volatile("" : "+v"(voffA[1][0]), "+v"(voffA[1][1])); }
            const char* a1 = cA + (size_t)(t + 1) * kstep;
            const char* a2 = last ? nA : cA + (size_t)(t + 2) * kstep; const char* b2 = last ? nB : cB + (size_t)(t + 2) * kstep;
            const char* a3 = a2 + kstep; const char* b3 = b2 + kstep;
            if (last && has_next) S.a_ready(nxt);
            if constexpr (SP2) {
            PG8_LDB(B0, 0, 0); PG8_LDB(B1, 0, 1); PG8_SCHED; PG8_LDA(At, 0, 0); PG8_STAGE(PG8_SA(1, 1), a1 + hstepA, voffA[GATHER ? 1 : 0]);
            PG8_WAIT_V(8); PG8_WAIT_L(0); PG8_BAR; PG8_MMA(0, 0, At, B0); PG8_MMA(0, 1, At, B1); PG8_BAR; PG8_SCHED;
            PG8_LDA(At, 0, 1); PG8_STAGE(PG8_SB(0, 0), b2, voffB); PG8_STAGE(PG8_SB(0, 1), b2 + hstep, voffB); PG8_STAGE(PG8_SA(0, 0), a2, voffA[0]);
            PG8_WAIT_V(8); PG8_WAIT_L(0); PG8_BAR; PG8_MMA(1, 0, At, B0); PG8_MMA(1, 1, At, B1); PG8_BAR; PG8_SCHED;
            PG8_LDB(B0, 1, 0); PG8_LDB(B1, 1, 1); PG8_SCHED; PG8_LDA(At, 1, 0); PG8_STAGE(PG8_SA(0, 1), a2 + hstepA, voffA[GATHER ? 1 : 0]);
            PG8_WAIT_V(8); PG8_WAIT_L(0); PG8_BAR; PG8_MMA(0, 0, At, B0); PG8_MMA(0, 1, At, B1); PG8_BAR; PG8_SCHED;
            PG8_LDA(At, 1, 1); PG8_STAGE(PG8_SB(1, 0), b3, voffB); PG8_STAGE(PG8_SB(1, 1), b3 + hstep, voffB); PG8_STAGE(PG8_SA(1, 0), a3, voffA[0]);
            PG8_WAIT_V(8); PG8_WAIT_L(0); PG8_BAR; PG8_MMA(1, 0, At, B0); PG8_MMA(1, 1, At, B1); PG8_BAR; PG8_SCHED;
            } else {
            PG8_LDB(B0, 0, 0); PG8_SCHED; PG8_LDA(At, 0, 0); PG8_STAGE(PG8_SA(1, 1), a1 + hstepA, voffA[GATHER ? 1 : 0]);
            PG8_WAIT_L(8); PG8_BAR; PG8_WAIT_L(0); PG8_MMA(0, 0, At, B0); PG8_BAR; PG8_SCHED;
            PG8_LDB(B1, 0, 1); PG8_STAGE(PG8_SB(0, 0), b2, voffB);
            PG8_BAR; PG8_WAIT_L(0); PG8_MMA(0, 1, At, B1); PG8_BAR;
            PG8_LDA(At, 0, 1); PG8_STAGE(PG8_SA(0, 0), a2, voffA[0]);
            PG8_BAR; PG8_WAIT_L(0); PG8_MMA(1, 0, At, B0); PG8_BAR; PG8_SCHED;
            PG8_STAGE(PG8_SB(0, 1), b2 + hstep, voffB);
            PG8_WAIT_V(6); PG8_BAR; PG8_MMA(1, 1, At, B1); PG8_BAR;
            PG8_LDB(B0, 1, 0); PG8_SCHED; PG8_LDA(At, 1, 0); PG8_STAGE(PG8_SA(0, 1), a2 + hstepA, voffA[GATHER ? 1 : 0]);
            PG8_WAIT_L(8); PG8_BAR; PG8_WAIT_L(0); PG8_MMA(0, 0, At, B0); PG8_BAR; PG8_SCHED;
            PG8_LDB(B1, 1, 1); PG8_STAGE(PG8_SB(1, 0), b3, voffB);
            PG8_BAR; PG8_WAIT_L(0); PG8_MMA(0, 1, At, B1); PG8_BAR;
            PG8_LDA(At, 1, 1); PG8_STAGE(PG8_SA(1, 0), a3, voffA[0]);
            PG8_BAR; PG8_WAIT_L(0); PG8_MMA(1, 0, At, B0); PG8_BAR; PG8_SCHED;
            PG8_STAGE(PG8_SB(1, 1), b3 + hstep, voffB);
            PG8_WAIT_V(6); PG8_BAR; PG8_MMA(1, 1, At, B1); PG8_BAR;
            }
        }
        if constexpr (ALIGN_EPI) { if (wr == 0) PG8_BAR; }
        if constexpr (F8) asm volatile("s_nop 15\n\ts_nop 7" ::: "memory");
        E(acc, cur, wr, wc, fr, fq); S.done(cur);
        if (!has_next) break;
#pragma unroll
        for (int a = 0; a < 2; ++a)
#pragma unroll
            for (int b = 0; b < 2; ++b)
#pragma unroll
                for (int m = 0; m < 4; ++m)
#pragma unroll
                    for (int n = 0; n < 2; ++n) acc[a][b][m][n] = (f32x4){0.f, 0.f, 0.f, 0.f};
        cur = nxt; cA = nA; cB = nB; ++ui;
        if constexpr (ALIGN_EPI) { if (wr == 1) PG8_BAR; }
    }
    PG8_WAIT_V(0);
    if constexpr (!ALIGN_EPI) { if (wr == 0) PG8_BAR; }
    PG8_BAR;
#undef PG8_SA
#undef PG8_SB
#undef PG8_STAGE
#undef PG8_LDA
#undef PG8_LDB
#undef PG8_MMA
#undef PG8_WAIT_V
#undef PG8_WAIT_L
#undef PG8_BAR
#undef PG8_SCHED
}
}

typedef GAS unsigned gu32;
#define RLX_AGENT __ATOMIC_RELAXED, __HIP_MEMORY_SCOPE_AGENT
#define LDS_WAIT() asm volatile("s_waitcnt lgkmcnt(0)" ::: "memory")
#define VM_WAIT() asm volatile("s_waitcnt vmcnt(0)" ::: "memory")
__device__ __forceinline__ unsigned pk2(float lo, float hi) { return pg8::cvt_pk_bf16(lo, hi); }
__device__ __forceinline__ float bf2f(unsigned short h) { return __uint_as_float((unsigned)h << 16); }
__device__ __forceinline__ float bflo(unsigned w) { return __uint_as_float(w << 16); }
__device__ __forceinline__ float bfhi(unsigned w) { return __uint_as_float(w & 0xffff0000u); }
__device__ __forceinline__ float wave_sum(float v) {
#pragma unroll
    for (int o = 1; o < 64; o <<= 1) v += __shfl_xor(v, o);
    return v;
}

#define XB_TMO      128
#define XB_XCNT(j)  (256  + 64 * (j))
#define XB_XSUB(j)  (1280 + 64 * (j))
#define XB_XGEN(j)  (2304 + 64 * (j))
#define XB_TOP      3328
#define XB_TOPGEN   3392
#define XCD_BAR_WORDS 3456
#define XB_SPIN_CAP (1u << 18)
__device__ __forceinline__ unsigned xb_ld(unsigned* p)              { return __hip_atomic_load(p, __ATOMIC_RELAXED, __HIP_MEMORY_SCOPE_AGENT); }
__device__ __forceinline__ unsigned xb_add(unsigned* p, unsigned v) { return __hip_atomic_fetch_add(p, v, __ATOMIC_RELAXED, __HIP_MEMORY_SCOPE_AGENT); }
__device__ __forceinline__ unsigned xb_xcc_id() { return (unsigned)__builtin_amdgcn_s_getreg((3 << 11) | 20) & 0xFu; }
#define XB_SPIN(cond, bar) do { unsigned _sp = 0; while (cond) { __builtin_amdgcn_s_sleep(1); \
    if ((++_sp & 255u) == 0u) { if (xb_ld(&(bar)[XB_TMO])) break; if (_sp > XB_SPIN_CAP) { atomicAdd(&(bar)[XB_TMO], 1u); break; } } } } while (0)
struct XcdBarrier { unsigned* bar; unsigned x; volatile LAS unsigned* st; };
__device__ __forceinline__ XcdBarrier xcd_barrier_post(unsigned* bar, volatile LAS unsigned* st) {
    XcdBarrier b; b.bar = bar; b.x = xb_xcc_id(); b.st = st;
    if (threadIdx.x == 0) (void)xb_add(&bar[XB_XCNT(b.x)], 1u);
    return b;
}
__device__ __forceinline__ void xcd_barrier_complete(unsigned* bar, unsigned x, unsigned& nloc, unsigned& nx) {
    const unsigned G = gridDim.x * gridDim.y * gridDim.z;
    unsigned sum, cnt, mine, sp = 0u;
    for (;;) {
        sum = 0u; cnt = 0u; mine = 0u;
#pragma unroll
        for (unsigned j = 0; j < 16; ++j) { const unsigned c = xb_ld(&bar[XB_XCNT(j)]); sum += c; cnt += (c > 0u) ? 1u : 0u; mine = (j == x) ? c : mine; }
        if (sum == G) break;
        __builtin_amdgcn_s_sleep(1);
        if ((++sp & 255u) == 0u) { if (xb_ld(&bar[XB_TMO])) break; if (sp > XB_SPIN_CAP) { atomicAdd(&bar[XB_TMO], 1u); break; } }
    }
    nloc = mine > 0u ? mine : 1u; nx = cnt > 0u ? cnt : 1u;
}
__device__ __forceinline__ void xcd_barrier(const XcdBarrier& b) {
    asm volatile("s_waitcnt vmcnt(0)" ::: "memory");
    __syncthreads();
    if (threadIdx.x == 0) {
        unsigned* bar = b.bar;
        __builtin_amdgcn_s_waitcnt(0);
        unsigned nloc = b.st[0], nx = b.st[1];
        if (nloc == 0u) { xcd_barrier_complete(bar, b.x, nloc, nx); b.st[0] = nloc; b.st[1] = nx; }
        const unsigned old = xb_add(&bar[XB_XSUB(b.x)], 1u);
        const unsigned gen = old / nloc;
        if (old + 1u == (gen + 1u) * nloc) {
            __builtin_amdgcn_fence(__ATOMIC_RELEASE, "agent");
            asm volatile("s_waitcnt vmcnt(0)" ::: "memory");
            const unsigned og = xb_add(&bar[XB_TOP], 1u);
            const unsigned tg = og / nx;
            if (og + 1u == (tg + 1u) * nx) xb_add(&bar[XB_TOPGEN], 1u);
            else XB_SPIN(xb_ld(&bar[XB_TOPGEN]) == tg, bar);
            __builtin_amdgcn_fence(__ATOMIC_ACQUIRE, "agent");
            xb_add(&bar[XB_XGEN(b.x)], 1u);
            asm volatile("s_waitcnt vmcnt(0)" ::: "memory");
        } else {
            XB_SPIN(xb_ld(&bar[XB_XGEN(b.x)]) == gen, bar);
            __builtin_amdgcn_fence(__ATOMIC_ACQUIRE, "agent");
            asm volatile("s_waitcnt vmcnt(0)" ::: "memory");
        }
    }
    __syncthreads();
}

constexpr int RING_BYTES = 131072;
constexpr int LDSCTL_OFF = RING_BYTES, MISC_OFF = LDSCTL_OFF + 320;
constexpr int LDS_BYTES = 147456;
constexpr int CW_BAR = 4096;
constexpr int CW_KMAX = 65536;

struct Args { const float* in[22]; float* out; unsigned char* ws; int ph_lo, ph_hi; };
enum { I_X = 0, I_C, I_CTX, I_CCTX, I_WADA, I_BADA, I_NPRE_MIX, I_NPOST_MIX, I_NPRE_FFN, I_NPOST_FFN, I_WIN, I_CONVW, I_LQ1, I_LK1, I_LQ2, I_LK2, I_SUBLN, I_WOUT, I_WROUTER, I_WGATE, I_WUP, I_WDOWN };

__device__ __forceinline__ void prefetch_slice(const unsigned char* base, int bytes_per_wave, LAS unsigned char* scr, int lane) {
    for (int i = 0; i < bytes_per_wave; i += 1024)
        __builtin_amdgcn_global_load_lds((const unsigned*)(base + i + lane * 16), (LAS unsigned*)scr, 16, 0, 0);
}

__device__ __forceinline__ int win_dest(int n) {
    if (n < 1024) { const int j = n & 63; const int p = ((j >> 5) << 5) + ((j & 15) << 1) + ((j >> 4) & 1); return (n & ~63) + p; }
    if (n < 2048) return n;
    int c = n - 2048; const int isx = c >= 512; c &= 511; return 2048 + ((c >> 7) << 8) + (isx << 7) + (c & 127);
}
template <int MODE>
__device__ __forceinline__ int tr_dest(int n) {
    if (MODE == 0) return n;
    if (MODE == 1) return win_dest(n);
    if (MODE == 2) return ((n >> 7) << 8) + (n & 127);
    return ((n >> 7) << 8) + 128 + (n & 127);
}
template <int MODE>
__device__ __forceinline__ void p0_transpose_item_f8(const float* W, int K, int N, unsigned char* WT, LAS float* scr, int item, int lane) {
    const int nblk = N / 32, kb = item / nblk, nb = item % nblk, k0 = 64 * kb, n0 = 32 * nb;
#pragma unroll 8
    for (int i = 0; i < 32; ++i) { const int kk = 2 * i + (lane >> 5); scr[kk * 33 + (lane & 31)] = __builtin_nontemporal_load(W + (size_t)(k0 + kk) * N + n0 + (lane & 31)) * pg8::F8_WGT; }
    LDS_WAIT(); asm volatile("" ::: "memory");
    const int c = lane & 7;
#pragma unroll
    for (int j = 0; j < 4; ++j) { const int n = (lane >> 3) + 8 * j; const LAS float* s = scr + (8 * c) * 33 + n;
        u32x2 o; o.x = pg8::pk4_fp8(s[0 * 33], s[1 * 33], s[2 * 33], s[3 * 33]); o.y = pg8::pk4_fp8(s[4 * 33], s[5 * 33], s[6 * 33], s[7 * 33]);
        *(GAS u32x2*)(WT + (size_t)tr_dest<MODE>(n0 + n) * K + k0 + 8 * c) = o; }
    LDS_WAIT(); asm volatile("" ::: "memory");
}
template <int MODE>
__device__ __forceinline__ void p0_transpose_item(const float* W, int K, int N, bf16_t* WT, LAS float* scr, int item, int lane) {
    const int nblk = N / 32, kb = item / nblk, nb = item % nblk, k0 = 64 * kb, n0 = 32 * nb;
#pragma unroll 8
    for (int i = 0; i < 32; ++i) { const int kk = 2 * i + (lane >> 5); scr[kk * 33 + (lane & 31)] = W[(size_t)(k0 + kk) * N + n0 + (lane & 31)]; }
    LDS_WAIT(); asm volatile("" ::: "memory");
    const int c = lane & 7;
#pragma unroll
    for (int j = 0; j < 4; ++j) { const int n = (lane >> 3) + 8 * j; const LAS float* s = scr + (8 * c) * 33 + n;
        u32x4 o; o.x = pk2(s[0 * 33], s[1 * 33]); o.y = pk2(s[2 * 33], s[3 * 33]); o.z = pk2(s[4 * 33], s[5 * 33]); o.w = pk2(s[6 * 33], s[7 * 33]);
        *(GAS u32x4*)(WT + (size_t)tr_dest<MODE>(n0 + n) * K + k0 + 8 * c) = o; }
    LDS_WAIT(); asm volatile("" ::: "memory");
}

__device__ __forceinline__ void p0_prologue(const Args& a, LAS unsigned char* lds, int vcu, int G) {
    const int tid = opaque_tid(), lane = tid & 63, wave = __builtin_amdgcn_readfirstlane(tid >> 6);
    LAS float* scr = (LAS float*)(lds + wave * 16384);
    const int gw = vcu * NWAVES + wave, NGW = G * NWAVES;
    unsigned char* ws = a.ws;
    {
        float* MODP = (float*)(ws + WS_MODP);
        const float* wada = a.in[I_WADA];
        for (int it = gw; it < 96 * 16; it += NGW) {
            const int cg = it % 96, kc = it / 96;
            for (int b = 0; b < 33; ++b) { const float v = (b < 32) ? a.in[I_C][b * D + kc * 64 + lane] : a.in[I_CCTX][kc * 64 + lane]; scr[b * 64 + lane] = v / (1.f + __expf(-v)); }
            LDS_WAIT(); asm volatile("" ::: "memory");
            float acc[33];
#pragma unroll
            for (int b = 0; b < 33; ++b) acc[b] = 0.f;
            for (int k = 0; k < 64; ++k) {
                const float w = wada[(size_t)(kc * 64 + k) * NMOD + cg * 64 + lane];
#pragma unroll
                for (int b = 0; b < 33; ++b) acc[b] += scr[b * 64 + k] * w;
            }
#pragma unroll
            for (int b = 0; b < 33; ++b) MODP[((size_t)kc * 33 + b) * NMOD + cg * 64 + lane] = acc[b];
            LDS_WAIT(); asm volatile("" ::: "memory");
        }
    }
    {
        float* tab = (float*)(ws + WS_TAB);
        for (int e = gw * 64 + lane; e < T * 32; e += NGW * 64) {
            const int t = e >> 5, i = e & 31;
            const float inv = powf(10000.0f, -(float)(2 * (i & 15)) / 32.0f);
            const float pos = (i < 16) ? (float)(t >> 6) : (float)(t & 63);
            const float ang = pos * inv;
            tab[2 * e] = cosf(ang); tab[2 * e + 1] = sinf(ang);
        }
    }
    constexpr int I_IN = (D / 64) * (NPROJ / 32), I_OUT = (D / 64) * (D / 32);
    constexpr int NITEMS = I_IN + I_OUT;
    bf16_t* Win_t = (bf16_t*)(ws + WS_WIN); bf16_t* Wout_t = (bf16_t*)(ws + WS_WOUT);
    for (int it = gw; it < NITEMS; it += NGW) {
        int r = it;
        if (r < I_IN) { p0_transpose_item<1>(a.in[I_WIN], D, NPROJ, Win_t, scr, r, lane); continue; } r -= I_IN;
        p0_transpose_item<0>(a.in[I_WOUT], D, D, Wout_t, scr, r, lane);
    }
}
__device__ __forceinline__ void expert_weight_copies(const Args& a, LAS unsigned char* lds, int vcu, int G) {
    const int tid = opaque_tid(), lane = tid & 63, wave = __builtin_amdgcn_readfirstlane(tid >> 6);
    LAS float* scr = (LAS float*)(lds + wave * 16384);
    const int gw = vcu * NWAVES + wave, NGW = G * NWAVES;
    unsigned char* ws = a.ws;
    constexpr int I_EXP = (D / 64) * (D / 32);
    unsigned char* Wgu_t = ws + WS_WGU; unsigned char* Wdn_t = ws + WS_WDN;
    for (int r = gw; r < NE * 3 * I_EXP; r += NGW) {
        const int e = r / (3 * I_EXP), q = (r % (3 * I_EXP)) / I_EXP, rr = r % I_EXP;
        if (q == 0) p0_transpose_item_f8<2>(a.in[I_WGATE] + (size_t)e * D * D, D, D, Wgu_t + (size_t)e * 2048 * D, scr, rr, lane);
        else if (q == 1) p0_transpose_item_f8<3>(a.in[I_WUP] + (size_t)e * D * D, D, D, Wgu_t + (size_t)e * 2048 * D, scr, rr, lane);
        else p0_transpose_item_f8<0>(a.in[I_WDOWN] + (size_t)e * D * D, D, D, Wdn_t + (size_t)e * D * D, scr, rr, lane);
    }
    __syncthreads();
}

struct RowF { f32x4 v[4]; };
__device__ __forceinline__ void row_load(RowF& r, const float* xrow, int lane) {
    const f32x4* xr = (const f32x4*)xrow + lane;
#pragma unroll
    for (int j = 0; j < 4; ++j) r.v[j] = __builtin_nontemporal_load(xr + 64 * j);
}
__device__ __forceinline__ void norm_mod_row(const RowF& r, bf16_t* orow, const float* gain, const LAS float* sc, const LAS float* sh, int lane) {
    const f32x4* gr = (const f32x4*)gain + lane;
    float s = 0.f;
#pragma unroll
    for (int j = 0; j < 4; ++j) s += (r.v[j].x * r.v[j].x + r.v[j].y * r.v[j].y) + (r.v[j].z * r.v[j].z + r.v[j].w * r.v[j].w);
    const float rstd = 1.0f / sqrtf(wave_sum(s) * (1.f / D) + EPS);
    u32x2* o8 = (u32x2*)orow + lane;
#pragma unroll
    for (int j = 0; j < 4; ++j) { const f32x4 g = gr[64 * j]; const f32x4 c1 = *(const LAS f32x4*)(sc + 4 * lane + 256 * j), h1 = *(const LAS f32x4*)(sh + 4 * lane + 256 * j);
        const f32x4 y = (r.v[j] * rstd) * g; const f32x4 z = y * (c1 + 1.0f) + h1;
        u32x2 w; w.x = pk2(z.x, z.y); w.y = pk2(z.z, z.w); o8[64 * j] = w; }
}
__device__ __forceinline__ void p1_xn(const Args& a, LAS unsigned char* lds, int c, int G) {
    const int tid = opaque_tid(), lane = tid & 63, wave = __builtin_amdgcn_readfirstlane(tid >> 6);
    unsigned char* ws = a.ws;
    const float* MODP = (const float*)(ws + WS_MODP); float* MOD = (float*)(ws + WS_MOD); const float* bada = a.in[I_BADA];
    for (int r = c; r < 33; r += G)
        for (int n = tid; n < NMOD; n += NTHREADS) { float s = bada[n];
#pragma unroll
            for (int kc = 0; kc < 16; ++kc) s += MODP[((size_t)kc * 33 + r) * NMOD + n];
            MOD[(size_t)r * NMOD + n] = s; }
    LAS float* sv = (LAS float*)lds;
    bf16_t* XN = (bf16_t*)(ws + WS_XN);
    const float* X = a.in[I_X]; const float* CTX = a.in[I_CTX]; const float* gain = a.in[I_NPRE_MIX];
    for (int p = c; p < 256; p += G) {
        const int b = p >> 3;
        const int rbase = p * 256 + wave * 32;
        RowF a0, a1;
        row_load(a0, X + (size_t)rbase * D, lane); row_load(a1, X + (size_t)(rbase + 16) * D, lane);
        __syncthreads();
        for (int n = tid; n < 4096; n += NTHREADS) { const int r = (n < 2048) ? b : 32; const int col = n & 2047; float s = bada[col];
#pragma unroll
            for (int kc = 0; kc < 16; ++kc) s += MODP[((size_t)kc * 33 + r) * NMOD + col];
            sv[n] = s; }
        __syncthreads();
        for (int i = 0; i < 16; ++i) {
            RowF n0, n1;
            if (i + 1 < 16) { row_load(n0, X + (size_t)(rbase + i + 1) * D, lane); row_load(n1, X + (size_t)(rbase + 16 + i + 1) * D, lane); }
            else { const int crow = p * 32 + wave * 4; row_load(n0, CTX + (size_t)crow * D, lane); row_load(n1, CTX + (size_t)(crow + 1) * D, lane); }
            norm_mod_row(a0, XN + (size_t)(rbase + i) * D, gain, sv + 1024, sv, lane);
            norm_mod_row(a1, XN + (size_t)(rbase + 16 + i) * D, gain, sv + 1024, sv, lane);
            a0 = n0; a1 = n1;
        }
        {
            const int crow = p * 32 + wave * 4;
            RowF n0, n1;
            row_load(n0, CTX + (size_t)(crow + 2) * D, lane); row_load(n1, CTX + (size_t)(crow + 3) * D, lane);
            norm_mod_row(a0, XN + (size_t)(M + crow) * D, gain, sv + 3072, sv + 2048, lane);
            norm_mod_row(a1, XN + (size_t)(M + crow + 1) * D, gain, sv + 3072, sv + 2048, lane);
            norm_mod_row(n0, XN + (size_t)(M + crow + 2) * D, gain, sv + 3072, sv + 2048, lane);
            norm_mod_row(n1, XN + (size_t)(M + crow + 3) * D, gain, sv + 3072, sv + 2048, lane);
        }
    }
}

namespace att {
constexpr int KP = 272, KBUF = 64 * KP, VBUF = 16384;
constexpr int OFF_K = 0, OFF_V = 2 * KBUF, OFF_WSF = OFF_V + 2 * VBUF, OFF_END = OFF_WSF + NWAVES * 256;
static_assert(OFF_WSF >= 65536 && OFF_END <= RING_BYTES, "attention LDS map");
constexpr int NT = TK / 64;
constexpr float THR = 8.0f;
__device__ __forceinline__ int crow(int r, int hi) { return (r & 3) + 8 * (r >> 2) + 4 * hi; }
__device__ __forceinline__ float max3f(float a, float b, float c) { float r; asm("v_max3_f32 %0, %1, %2, %3" : "=v"(r) : "v"(a), "v"(b), "v"(c)); return r; }
__device__ __forceinline__ float max2f(float a, float b) { float r; asm("v_max_f32_e32 %0, %1, %2" : "=v"(r) : "v"(a), "v"(b)); return r; }
__device__ __forceinline__ s16x4 vtr(const LAS unsigned char* p) { return __builtin_bit_cast(s16x4, __builtin_amdgcn_ds_read_tr16_b64_v4i16((LAS s16x4*)p)); }

#define ATT_BAR() asm volatile("s_waitcnt lgkmcnt(0)\n\ts_barrier" ::: "memory")
#define ATT_SB() __builtin_amdgcn_sched_barrier(0)
#define ATT_KLD(i, KF) KF = *(const LAS bf16x8*)(kb_ + ((i) & 1) * (32 * KP) + ((i) >> 1) * 32)
#define ATT_XSTEP(i, KC, KN) do { if ((i) + 2 < 8) { ATT_KLD((i) + 2, KN); } \
    if ((i) == 0) p0 = __builtin_amdgcn_mfma_f32_32x32x16_bf16(KC, qr[0], negref, 0, 0, 0); \
    else if ((i) == 1) p1 = __builtin_amdgcn_mfma_f32_32x32x16_bf16(KC, qr[0], negref, 0, 0, 0); \
    else if (((i) & 1) == 0) p0 = __builtin_amdgcn_mfma_f32_32x32x16_bf16(KC, qr[(i) >> 1], p0, 0, 0, 0); else p1 = __builtin_amdgcn_mfma_f32_32x32x16_bf16(KC, qr[(i) >> 1], p1, 0, 0, 0); ATT_SB(); } while (0)
#define ATT_X(kcur) do { \
    const LAS unsigned char* kb_ = lds + OFF_K + (kcur) * KBUF + koff; \
    bf16x8 ka_, kb2_, kc_; \
    ATT_KLD(0, ka_); ATT_KLD(1, kb2_); \
    ATT_SB(); \
    ATT_XSTEP(0, ka_, kc_); ATT_XSTEP(1, kb2_, ka_); ATT_XSTEP(2, kc_, kb2_); ATT_XSTEP(3, ka_, kc_); \
    ATT_XSTEP(4, kb2_, ka_); ATT_XSTEP(5, kc_, kb2_); ATT_XSTEP(6, ka_, kc_); ATT_XSTEP(7, kb2_, ka_); \
} while (0)
#define ATT_EXP2(i, PWN) do { \
    const float e0_ = __builtin_amdgcn_exp2f((i) < 8 ? p0[2 * ((i) & 7)] : p1[2 * ((i) & 7)]), e1_ = __builtin_amdgcn_exp2f((i) < 8 ? p0[2 * ((i) & 7) + 1] : p1[2 * ((i) & 7) + 1]); \
    sacc_ += e0_ + e1_; PWN[(i) >> 2][(i) & 3] = pk2(e0_, e1_); asm volatile("" : "+v"(PWN[(i) >> 2]), "+v"(sacc_)); } while (0)
#define ATT_VLD(i, LO, HI) do { LO = vtr(vb_ + ((i) & 3) * 4096 + ((i) >> 2) * 1024); HI = vtr(vb_ + ((i) & 3) * 4096 + ((i) >> 2) * 1024 + 512); } while (0)
#define ATT_VF(LO, HI) ((bf16x8){LO[0], LO[1], LO[2], LO[3], HI[0], HI[1], HI[2], HI[3]})
#define ATT_YSTEP(i, PWC, PWN, LC, HC, LN, HN) do { if ((i) + 2 < 16) { ATT_VLD((i) + 2, LN, HN); } \
    o[(i) & 3] = __builtin_amdgcn_mfma_f32_32x32x16_bf16(__builtin_bit_cast(bf16x8, PWC[(i) >> 2]), ATT_VF(LC, HC), o[(i) & 3], 0, 0, 0); \
    ATT_EXP2(i, PWN); ATT_SB(); } while (0)
#define ATT_Y(vcur, PWC, PWN) do { \
    const LAS unsigned char* vb_ = lds + OFF_V + (vcur) * VBUF + voff; \
    float sacc_ = 0.f; s16x4 la_, ha_, lb_, hb_, lc_, hc_; \
    ATT_VLD(0, la_, ha_); ATT_VLD(1, lb_, hb_); ATT_SB(); \
    ATT_YSTEP(0, PWC, PWN, la_, ha_, lc_, hc_); ATT_YSTEP(1, PWC, PWN, lb_, hb_, la_, ha_); ATT_YSTEP(2, PWC, PWN, lc_, hc_, lb_, hb_); \
    ATT_YSTEP(3, PWC, PWN, la_, ha_, lc_, hc_); ATT_YSTEP(4, PWC, PWN, lb_, hb_, la_, ha_); ATT_YSTEP(5, PWC, PWN, lc_, hc_, lb_, hb_); \
    ATT_YSTEP(6, PWC, PWN, la_, ha_, lc_, hc_); ATT_YSTEP(7, PWC, PWN, lb_, hb_, la_, ha_); ATT_YSTEP(8, PWC, PWN, lc_, hc_, lb_, hb_); \
    ATT_YSTEP(9, PWC, PWN, la_, ha_, lc_, hc_); ATT_YSTEP(10, PWC, PWN, lb_, hb_, la_, ha_); ATT_YSTEP(11, PWC, PWN, lc_, hc_, lb_, hb_); \
    ATT_YSTEP(12, PWC, PWN, la_, ha_, lc_, hc_); ATT_YSTEP(13, PWC, PWN, lb_, hb_, la_, ha_); ATT_YSTEP(14, PWC, PWN, lc_, hc_, lb_, hb_); \
    ATT_YSTEP(15, PWC, PWN, la_, ha_, lc_, hc_); \
    l_reg += sacc_; \
} while (0)
#define ATT_Y0(PWN) do { float sacc_ = 0.f; _Pragma("unroll") for (int i = 0; i < 16; ++i) ATT_EXP2(i, PWN); l_reg += sacc_; } while (0)
#define ATT_ZSTEP(i, PWC, LC, HC, LN, HN) do { if ((i) + 2 < 16) { ATT_VLD((i) + 2, LN, HN); } \
    o[(i) & 3] = __builtin_amdgcn_mfma_f32_32x32x16_bf16(__builtin_bit_cast(bf16x8, PWC[(i) >> 2]), ATT_VF(LC, HC), o[(i) & 3], 0, 0, 0); ATT_SB(); } while (0)
#define ATT_Z(vcur, PWC) do { \
    const LAS unsigned char* vb_ = lds + OFF_V + (vcur) * VBUF + voff; \
    s16x4 la_, ha_, lb_, hb_, lc_, hc_; \
    ATT_VLD(0, la_, ha_); ATT_VLD(1, lb_, hb_); ATT_SB(); \
    ATT_ZSTEP(0, PWC, la_, ha_, lc_, hc_); ATT_ZSTEP(1, PWC, lb_, hb_, la_, ha_); ATT_ZSTEP(2, PWC, lc_, hc_, lb_, hb_); \
    ATT_ZSTEP(3, PWC, la_, ha_, lc_, hc_); ATT_ZSTEP(4, PWC, lb_, hb_, la_, ha_); ATT_ZSTEP(5, PWC, lc_, hc_, lb_, hb_); \
    ATT_ZSTEP(6, PWC, la_, ha_, lc_, hc_); ATT_ZSTEP(7, PWC, lb_, hb_, la_, ha_); ATT_ZSTEP(8, PWC, lc_, hc_, lb_, hb_); \
    ATT_ZSTEP(9, PWC, la_, ha_, lc_, hc_); ATT_ZSTEP(10, PWC, lb_, hb_, la_, ha_); ATT_ZSTEP(11, PWC, lc_, hc_, lb_, hb_); \
    ATT_ZSTEP(12, PWC, la_, ha_, lc_, hc_); ATT_ZSTEP(13, PWC, lb_, hb_, la_, ha_); ATT_ZSTEP(14, PWC, lc_, hc_, lb_, hb_); \
    ATT_ZSTEP(15, PWC, la_, ha_, lc_, hc_); \
} while (0)
#define ATT_STAGE(j) do { \
    if ((j) + 1 < NT) { _Pragma("unroll") for (int i = 0; i < 2; ++i) *(LAS u32x4*)(lds + OFF_K + (((j) + 1) & 1) * KBUF + kdst[i]) = kr[i]; } \
    _Pragma("unroll") for (int i = 0; i < 2; ++i) *(LAS u32x4*)(lds + OFF_V + ((j) & 1) * VBUF + vdst[i]) = vr[i]; \
    if ((j) + 2 < NT) { _Pragma("unroll") for (int i = 0; i < 2; ++i) kr[i] = *(const u32x4*)(Kb + (size_t)((j) + 2) * 64 * 512 + gsrc[i]); } \
    if ((j) + 1 < NT) { _Pragma("unroll") for (int i = 0; i < 2; ++i) vr[i] = *(const u32x4*)(Vb + (size_t)((j) + 1) * 64 * 512 + gsrc[i]); } } while (0)

__device__ __forceinline__ void unit(LAS unsigned char* lds, int b, int h, int qb, const bf16_t* Q, const bf16_t* KA, const bf16_t* VA, bf16_t* MIXIN, const float* subg, float lam, const unsigned* KM) {
    const int tid = opaque_tid(), lane = tid & 63, r32 = lane & 31, hi = lane >> 5;
    const int wid = __builtin_amdgcn_readfirstlane(tid >> 6), w = wid & 3, m = wid >> 2;
    LAS float* wsf = (LAS float*)(lds + OFF_WSF) + wid * 64;
    const int rowQ = b * T + qb * 128 + w * 32;
    bf16x8 qr[4];
#pragma unroll
    for (int d0 = 0; d0 < 4; ++d0) qr[d0] = *(const bf16x8*)(Q + (size_t)(rowQ + r32) * 512 + h * 128 + m * 64 + d0 * 16 + hi * 8);
    const bf16_t* Kb = KA + (size_t)b * TK * 512 + h * 128; const bf16_t* Vb = VA + (size_t)b * TK * 512 + h * 128;
    int gsrc[2], kdst[2], vdst[2];
#pragma unroll
    for (int i = 0; i < 2; ++i) { const int cid = tid + 512 * i, kv = cid >> 4, c16 = cid & 15;
        gsrc[i] = kv * 512 + c16 * 8; kdst[i] = kv * KP + c16 * 16; vdst[i] = (c16 >> 2) * 4096 + (kv >> 4) * 1024 + (kv & 15) * 64 + (c16 & 3) * 16; }
    u32x4 kr[2], vr[2];
#pragma unroll
    for (int i = 0; i < 2; ++i) { kr[i] = *(const u32x4*)(Kb + gsrc[i]); vr[i] = *(const u32x4*)(Vb + gsrc[i]); }
#pragma unroll
    for (int i = 0; i < 2; ++i) *(LAS u32x4*)(lds + OFF_K + kdst[i]) = kr[i];
#pragma unroll
    for (int i = 0; i < 2; ++i) kr[i] = *(const u32x4*)(Kb + (size_t)64 * 512 + gsrc[i]);
    ATT_BAR();
    f32x16 o[4];
#pragma unroll
    for (int d0 = 0; d0 < 4; ++d0) o[d0] = (f32x16){};
    float l_reg = 0.f;
    f32x16 p0, p1, negref;
    {
        const unsigned* km = KM + (b * 8 + h * 2 + m) * 2;
        const float kmax2 = __uint_as_float(km[0]) + __uint_as_float(km[1]);
        float ss = 0.f;
#pragma unroll
        for (int d0 = 0; d0 < 4; ++d0)
#pragma unroll
            for (int i = 0; i < 8; ++i) { const float v = bf2f((unsigned short)qr[d0][i]); ss += v * v; }
        ss += __shfl_xor(ss, 32);
        const float ref = sqrtf(ss * kmax2) * 1.02f;
#pragma unroll
        for (int r = 0; r < 16; ++r) negref[r] = -ref;
    }
    u32x4 pwA[4], pwB[4];
    const int koff = r32 * KP + m * 128 + hi * 16;
    const int voff = ((lane >> 4) & 1) * 32 + (lane & 3) * 8 + (4 * hi + ((lane & 15) >> 2)) * 64;
    ATT_X(0); ATT_STAGE(0); ATT_Y0(pwA); ATT_BAR();
    ATT_X(1); ATT_STAGE(1); ATT_Y(0, pwA, pwB); ATT_BAR();
    for (int j = 2; j < NT; j += 2) {
        ATT_X(0); ATT_STAGE(j); ATT_Y(1, pwB, pwA); ATT_BAR();
        ATT_X(1); ATT_STAGE(j + 1); ATT_Y(0, pwA, pwB); ATT_BAR();
    }
    ATT_Z(1, pwB); ATT_BAR();
    l_reg += __shfl_xor(l_reg, 32);
    if (hi == 0) wsf[32 + r32] = l_reg;
    LDS_WAIT();
    float rli[16];
#pragma unroll
    for (int r = 0; r < 16; ++r) rli[r] = 1.0f / wsf[32 + crow(r, hi)];
    LDS_WAIT();
    LAS float* ex = (LAS float*)lds + w * 4096;
    if (m == 1) {
#pragma unroll
        for (int r = 0; r < 16; ++r)
#pragma unroll
            for (int d0 = 0; d0 < 4; ++d0) ex[crow(r, hi) * 128 + d0 * 32 + r32] = o[d0][r] * rli[r];
    }
    ATT_BAR();
    if (m == 0) {
        float g4[4];
#pragma unroll
        for (int d0 = 0; d0 < 4; ++d0) g4[d0] = subg[d0 * 32 + r32] * (1.0f - LAM_INIT);
#pragma unroll
        for (int r = 0; r < 16; ++r) {
            const int q = crow(r, hi); float x[4]; float ss = 0.f;
#pragma unroll
            for (int d0 = 0; d0 < 4; ++d0) { x[d0] = o[d0][r] * rli[r] - lam * ex[q * 128 + d0 * 32 + r32]; ss += x[d0] * x[d0]; }
#pragma unroll
            for (int off = 1; off < 32; off <<= 1) ss += __shfl_xor(ss, off);
            const float rstd = 1.0f / sqrtf(ss * (1.f / 128.f) + EPS);
            bf16_t* dst = MIXIN + (size_t)(rowQ + q) * 1024 + h * 128 + r32;
#pragma unroll
            for (int d0 = 0; d0 < 4; ++d0) dst[d0 * 32] = (bf16_t)(pk2(x[d0] * rstd * g4[d0], 0.f) & 0xffffu);
        }
    }
    ATT_BAR();
}
#undef ATT_BAR
#undef ATT_X
#undef ATT_EXP2
#undef ATT_Y
#undef ATT_Y0
#undef ATT_Z
#undef ATT_STAGE
#undef ATT_SB
#undef ATT_KLD
#undef ATT_XSTEP
#undef ATT_VLD
#undef ATT_VF
#undef ATT_YSTEP
#undef ATT_ZSTEP
}

__device__ __forceinline__ void p3_conv_attn(const Args& a, LAS unsigned char* lds, int c, int vcu, int G) {
    const int tid = opaque_tid(), lane = tid & 63, wave = __builtin_amdgcn_readfirstlane(tid >> 6);
    unsigned char* ws = a.ws;
    const bf16_t* GB = (const bf16_t*)(ws + WS_GB); const bf16_t* U = (const bf16_t*)(ws + WS_U); bf16_t* MIXIN = (bf16_t*)(ws + WS_MIXIN);
    {
        const float* cw = a.in[I_CONVW]; float w0[8], w1[8], w2[8];
#pragma unroll
        for (int i = 0; i < 8; ++i) { w0[i] = cw[lane * 8 + i]; w1[i] = cw[512 + lane * 8 + i]; w2[i] = cw[1024 + lane * 8 + i]; }
        const int gw = vcu * NWAVES + wave, NGW = G * NWAVES;
        for (int row = gw; row < M; row += NGW) {
            const int t = row & (T - 1);
            const u32x4 z = {0u, 0u, 0u, 0u};
            const u32x4 uc = *(const u32x4*)(U + (size_t)row * 512 + lane * 8);
            const u32x4 up = (t > 0) ? *(const u32x4*)(U + (size_t)(row - 1) * 512 + lane * 8) : z;
            const u32x4 un = (t < T - 1) ? *(const u32x4*)(U + (size_t)(row + 1) * 512 + lane * 8) : z;
            const u32x4 gb = *(const u32x4*)(GB + (size_t)row * 512 + lane * 8);
            u32x4 o;
#pragma unroll
            for (int q = 0; q < 4; ++q) {
                const float y0 = w0[2 * q] * bflo(up[q]) + w1[2 * q] * bflo(uc[q]) + w2[2 * q] * bflo(un[q]);
                const float y1 = w0[2 * q + 1] * bfhi(up[q]) + w1[2 * q + 1] * bfhi(uc[q]) + w2[2 * q + 1] * bfhi(un[q]);
                o[q] = pk2(bflo(gb[q]) * y0, bfhi(gb[q]) * y1);
            }
            *(u32x4*)(MIXIN + (size_t)row * 1024 + 512 + lane * 8) = o;
        }
    }
    float lam;
    { const float p1 = a.in[I_LQ1][lane] * a.in[I_LK1][lane], p2 = a.in[I_LQ2][lane] * a.in[I_LK2][lane];
      lam = __expf(wave_sum(p1)) - __expf(wave_sum(p2)) + LAM_INIT; }
    const bf16_t* Q = (const bf16_t*)(ws + WS_Q); const bf16_t* KA = (const bf16_t*)(ws + WS_K); const bf16_t* VA = (const bf16_t*)(ws + WS_V);
    __syncthreads();
    for (int u = vcu * 8; u < 2048; u += G * 8) {
        const int x = (u >> 3) / 32, jj = (u >> 3) % 32;
        for (int i = 0; i < 8; ++i) {
            const int bh = 16 * x + 2 * i + (jj >> 4), qb = jj & 15;
            att::unit(lds, bh >> 2, bh & 3, qb, Q, KA, VA, MIXIN, a.in[I_SUBLN], lam, (const unsigned*)(ws + WS_CTL) + CW_KMAX);
        }
    }
}

struct P5In { f32x4 x[4]; u32x2 m[4]; };
__device__ __forceinline__ void p5_load(P5In& r, int row, int lane, const float* X, const bf16_t* MIX) {
    const f32x4* xr = (const f32x4*)(X + (size_t)row * D) + lane; const u32x2* mr = (const u32x2*)(MIX + (size_t)row * D) + lane;
#pragma unroll
    for (int j = 0; j < 4; ++j) { r.x[j] = __builtin_nontemporal_load(xr + 64 * j); r.m[j] = __builtin_nontemporal_load(mr + 64 * j); }
}
__device__ __forceinline__ float p5_resid(const P5In& r, f32x4 (&h)[4], int row, int lane, const LAS float* mv, const f32x4* npm, bf16_t* H1) {
    f32x4 mx[4]; float s = 0.f;
#pragma unroll
    for (int j = 0; j < 4; ++j) { const u32x2 wv = r.m[j]; mx[j] = (f32x4){bflo(wv.x), bfhi(wv.x), bflo(wv.y), bfhi(wv.y)};
        s += (mx[j].x * mx[j].x + mx[j].y * mx[j].y) + (mx[j].z * mx[j].z + mx[j].w * mx[j].w); }
    const float rstd1 = 1.0f / sqrtf(wave_sum(s) * (1.f / D) + EPS);
    u32x2* hr = (u32x2*)(H1 + (size_t)row * D) + lane; float s2 = 0.f;
#pragma unroll
    for (int j = 0; j < 4; ++j) { const f32x4 g1 = *(const LAS f32x4*)(mv + 4 * lane + 256 * j);
        h[j] = r.x[j] + g1 * ((mx[j] * rstd1) * npm[64 * j]);
        u32x2 wv; wv.x = pk2(h[j].x, h[j].y); wv.y = pk2(h[j].z, h[j].w); __builtin_nontemporal_store(wv, hr + 64 * j);
        s2 += (h[j].x * h[j].x + h[j].y * h[j].y) + (h[j].z * h[j].z + h[j].w * h[j].w); }
    return 1.0f / sqrtf(wave_sum(s2) * (1.f / D) + EPS);
}
__device__ __forceinline__ void p5_rows(const Args& a, LAS unsigned char* lds, int p  ) {
    const int tid = opaque_tid(), lane = tid & 63, wave = __builtin_amdgcn_readfirstlane(tid >> 6);
    unsigned char* ws = a.ws;
    const int b = p >> 3;
    LAS float* wrt = (LAS float*)lds;
    LAS float* mv = (LAS float*)(lds + 65536);
    const float* wr = a.in[I_WROUTER];
    const bf16_t* MIX = (const bf16_t*)(ws + WS_MIX); unsigned char* XN2 = ws + WS_XN; float* AFFT = (float*)(ws + WS_AFFT); bf16_t* H1 = (bf16_t*)(ws + WS_H1);
    const float* X = a.in[I_X];
    const int rbase = p * 256 + wave * 32;
    P5In cA, cB;
    p5_load(cA, rbase, lane, X, MIX); p5_load(cB, rbase + 16, lane, X, MIX);
    for (int n = tid; n < D * NE; n += NTHREADS) { const int k = n >> 4, e = n & 15; wrt[e * D + k] = wr[n]; }
    const float* MOD = (const float*)(ws + WS_MOD) + (size_t)b * NMOD;
    for (int n = tid; n < 3 * D; n += NTHREADS) mv[n] = MOD[2 * D + n];
    __syncthreads();
    const f32x4* npm = (const f32x4*)a.in[I_NPOST_MIX] + lane; const f32x4* npf = (const f32x4*)a.in[I_NPRE_FFN] + lane;
    for (int i = 0; i < 16; ++i) {
        const int rowA = rbase + i, rowB = rbase + 16 + i;
        P5In nA, nB;
        if (i + 1 < 16) { p5_load(nA, rowA + 1, lane, X, MIX); p5_load(nB, rowB + 1, lane, X, MIX); }
        f32x4 hA[4], hB[4];
        const float rsA = p5_resid(cA, hA, rowA, lane, mv, npm, H1);
        const float rsB = p5_resid(cB, hB, rowB, lane, mv, npm, H1);
        unsigned* oA = (unsigned*)(XN2 + (size_t)rowA * D) + lane; unsigned* oB = (unsigned*)(XN2 + (size_t)rowB * D) + lane;
        typedef float f32x2v __attribute__((ext_vector_type(2)));
        f32x2v lg2[16];
#pragma unroll
        for (int e = 0; e < 16; ++e) lg2[e] = (f32x2v){0.f, 0.f};
#pragma unroll
        for (int j = 0; j < 4; ++j) { const f32x4 sh2 = *(const LAS f32x4*)(mv + 1024 + 4 * lane + 256 * j), sc2 = *(const LAS f32x4*)(mv + 2048 + 4 * lane + 256 * j);
            const f32x4 gn = npf[64 * j];
            const f32x4 zA = ((hA[j] * rsA) * gn) * (sc2 + 1.0f) + sh2, zB = ((hB[j] * rsB) * gn) * (sc2 + 1.0f) + sh2;
            { const f32x4 qa = zA * pg8::F8_ACT, qb = zB * pg8::F8_ACT; oA[64 * j] = pg8::pk4_fp8(qa.x, qa.y, qa.z, qa.w); oB[64 * j] = pg8::pk4_fp8(qb.x, qb.y, qb.z, qb.w); }
            const f32x2v zx = {zA.x, zB.x}, zy = {zA.y, zB.y}, zz = {zA.z, zB.z}, zw = {zA.w, zB.w};
#pragma unroll
            for (int e = 0; e < 16; ++e) { const f32x4 wq = *(const LAS f32x4*)(wrt + e * D + 4 * lane + 256 * j);
                lg2[e] = __builtin_elementwise_fma(zx, (f32x2v){wq.x, wq.x}, lg2[e]); lg2[e] = __builtin_elementwise_fma(zy, (f32x2v){wq.y, wq.y}, lg2[e]);
                lg2[e] = __builtin_elementwise_fma(zz, (f32x2v){wq.z, wq.z}, lg2[e]); lg2[e] = __builtin_elementwise_fma(zw, (f32x2v){wq.w, wq.w}, lg2[e]);
                if ((e & 3) == 3) __builtin_amdgcn_sched_barrier(0); } }
        float lg[32];
#pragma unroll
        for (int e = 0; e < 16; ++e) { lg[e] = lg2[e].x; lg[16 + e] = lg2[e].y; }
#pragma unroll
        for (int st = 0; st < 5; ++st) { const int d = 1 << st, cntv = 16 >> st; const bool up = (lane & d) != 0;
#pragma unroll
            for (int q = 0; q < 16; ++q) if (q < cntv) { const float send = up ? lg[2 * q] : lg[2 * q + 1], keep = up ? lg[2 * q + 1] : lg[2 * q]; lg[q] = keep + __shfl_xor(send, d); } }
        float lv = lg[0] + __shfl_xor(lg[0], 32);
        float mxl = lv;
#pragma unroll
        for (int d = 1; d < 16; d <<= 1) mxl = fmaxf(mxl, __shfl_xor(mxl, d));
        const float ev = __expf(lv - mxl); float se = ev;
#pragma unroll
        for (int d = 1; d < 16; d <<= 1) se += __shfl_xor(se, d);
        if (lane < 32) { const int row = (lane < 16) ? rowA : rowB; AFFT[((size_t)b * NE + (lane & 15)) * T + (row & (T - 1))] = ev / se; }
        cA = nA; cB = nB;
    }
}

__device__ __forceinline__ void p6_topk(const Args& a, LAS unsigned char* lds, int c, int G) {
    const int tid = opaque_tid(), lane = tid & 63, wave = __builtin_amdgcn_readfirstlane(tid >> 6);
    unsigned char* ws = a.ws;
    const float* AFFT = (const float*)(ws + WS_AFFT); short* SLOT = (short*)(ws + WS_SLOT); int* IDX = (int*)(ws + WS_IDX); float* GATE = (float*)(ws + WS_GATE);
    LAS unsigned* sv = (LAS unsigned*)(lds + wave * 16384);
    for (int item = c + wave * G; item < NITEM; item += G * NWAVES) {
        const int b = item >> 4, e = item & 15;
        const float* src = AFFT + (size_t)item * T;
#pragma unroll 8
        for (int j = 0; j < 32; ++j) sv[j * 64 + lane] = __float_as_uint(src[j * 64 + lane]);
        LDS_WAIT(); asm volatile("" ::: "memory");
        unsigned pre = 0u;
        for (int bit = 30; bit >= 0; --bit) {
            const unsigned cand = pre | (1u << bit);
            int cnt = 0;
#pragma unroll 4
            for (int j = 0; j < 32; ++j) cnt += (int)__popcll(__ballot(sv[j * 64 + lane] >= cand));
            if (cnt >= CAP) pre = cand;
        }
        int ngt = 0;
#pragma unroll 4
        for (int j = 0; j < 32; ++j) ngt += (int)__popcll(__ballot(sv[j * 64 + lane] > pre));
        const int need_eq = CAP - ngt;
        const unsigned long long ltmask = (1ull << lane) - 1ull;
        int base_gt = 0, base_eq = 0;
#pragma unroll 2
        for (int j = 0; j < 32; ++j) {
            const unsigned vj = sv[j * 64 + lane];
            const bool gt = vj > pre, eq = vj == pre;
            const unsigned long long mg = __ballot(gt), me = __ballot(eq);
            const int pg = base_gt + (int)__popcll(mg & ltmask), pe = base_eq + (int)__popcll(me & ltmask);
            int sl = -1; if (gt) sl = pg; else if (eq && pe < need_eq) sl = ngt + pe;
            const int t = j * 64 + lane;
            SLOT[((size_t)b * T + t) * NE + e] = (short)sl;
            if (sl >= 0) { IDX[item * CAP + sl] = t; GATE[item * CAP + sl] = __uint_as_float(vj); }
            base_gt += (int)__popcll(mg); base_eq += (int)__popcll(me);
        }
        LDS_WAIT(); asm volatile("" ::: "memory");
    }
}

struct P8Row { u32x2 h[4]; unsigned y[4][4]; float wt[4]; unsigned long long rest; int sl; };
__device__ __forceinline__ f32x4 fp8x4_to_f32(unsigned w) { typedef float f2 __attribute__((ext_vector_type(2))); const f2 lo = __builtin_amdgcn_cvt_pk_f32_fp8((int)w, false), hi = __builtin_amdgcn_cvt_pk_f32_fp8((int)w, true); return (f32x4){lo.x, lo.y, hi.x, hi.y}; }
__device__ __forceinline__ void p8_issue(P8Row& r, int row, int lane, const short* SLOT, const unsigned char* Y, const bf16_t* H1) {
    const int b = row >> 11;
    const int s_e = (lane < NE) ? (int)SLOT[(size_t)row * NE + lane] : -1;
    unsigned long long mask = __ballot(s_e >= 0);
    const u32x2* hr = (const u32x2*)(H1 + (size_t)row * D) + lane;
#pragma unroll
    for (int j = 0; j < 4; ++j) r.h[j] = __builtin_nontemporal_load(hr + 64 * j);
#pragma unroll
    for (int q = 0; q < 4; ++q) {
        int e = 0, s = 0; r.wt[q] = 0.f;
        if (mask) { e = (int)__builtin_ctzll(mask); mask &= mask - 1ull; s = __builtin_amdgcn_readlane(s_e, e); r.wt[q] = 1.f; }
        const unsigned* yr = (const unsigned*)(Y + ((size_t)(b * NE + e) * CAP + s) * D) + lane;
#pragma unroll
        for (int j = 0; j < 4; ++j) r.y[q][j] = __builtin_nontemporal_load(yr + 64 * j);
    }
    r.rest = mask; r.sl = s_e;
}
__device__ __forceinline__ void p8_finish(P8Row& r, int row, int lane, const unsigned char* Y, const float* MOD, const f32x4* npo, float* out) {
    const int b = row >> 11;
    f32x4 ff[4];
#pragma unroll
    for (int j = 0; j < 4; ++j) ff[j] = (f32x4){0.f, 0.f, 0.f, 0.f};
#pragma unroll
    for (int q = 0; q < 4; ++q)
#pragma unroll
        for (int j = 0; j < 4; ++j) ff[j] += fp8x4_to_f32(r.y[q][j]) * r.wt[q];
    unsigned long long mask = r.rest;
    while (mask) {
        const int e = (int)__builtin_ctzll(mask); mask &= mask - 1ull; const int s = __builtin_amdgcn_readlane(r.sl, e);
        const unsigned* yr = (const unsigned*)(Y + ((size_t)(b * NE + e) * CAP + s) * D) + lane;
#pragma unroll
        for (int j = 0; j < 4; ++j) ff[j] += fp8x4_to_f32(yr[64 * j]);
    }
#pragma unroll
    for (int j = 0; j < 4; ++j) ff[j] = ff[j] * (1.0f / pg8::F8_Y);
    float s2 = 0.f;
#pragma unroll
    for (int j = 0; j < 4; ++j) s2 += (ff[j].x * ff[j].x + ff[j].y * ff[j].y) + (ff[j].z * ff[j].z + ff[j].w * ff[j].w);
    const float rstd = 1.0f / sqrtf(wave_sum(s2) * (1.f / D) + EPS);
    f32x4* orow = (f32x4*)(out + (size_t)row * D) + lane; const f32x4* g2 = (const f32x4*)(MOD + (size_t)b * NMOD + 5 * D) + lane;
#pragma unroll
    for (int j = 0; j < 4; ++j) { const u32x2 hv = r.h[j]; const f32x4 h = (f32x4){bflo(hv.x), bfhi(hv.x), bflo(hv.y), bfhi(hv.y)};
        __builtin_nontemporal_store(h + g2[64 * j] * ((ff[j] * rstd) * npo[64 * j]), orow + 64 * j); }
}
__device__ __forceinline__ void p8_final(const Args& a, int vcu, int G) {
    const int tid = opaque_tid(), lane = tid & 63, wave = __builtin_amdgcn_readfirstlane(tid >> 6);
    unsigned char* ws = a.ws;
    const short* SLOT = (const short*)(ws + WS_SLOT); const unsigned char* Y = ws + WS_Y; const float* MOD = (const float*)(ws + WS_MOD); const bf16_t* H1 = (const bf16_t*)(ws + WS_H1);
    const f32x4* npo = (const f32x4*)a.in[I_NPOST_FFN] + lane;
    const int gw = vcu * NWAVES + wave, NGW = G * NWAVES;
    for (int row = gw; row < M; row += 2 * NGW) {
        P8Row r0, r1;
        p8_issue(r0, row, lane, SLOT, Y, H1);
        const bool two = row + NGW < M;
        if (two) p8_issue(r1, row + NGW, lane, SLOT, Y, H1);
        p8_finish(r0, row, lane, Y, MOD, npo, a.out);
        if (two) p8_finish(r1, row + NGW, lane, Y, MOD, npo, a.out);
    }
}

__global__ void __launch_bounds__(NTHREADS, 2) fwd_kernel(Args args) {
    extern __shared__ __attribute__((aligned(16))) unsigned char lds_raw[];
    LAS unsigned char* lds = (LAS unsigned char*)lds_raw;
    volatile LAS unsigned* MISC = (volatile LAS unsigned*)(lds + MISC_OFF);
    const int tid = threadIdx.x;
    const int G = gridDim.x, c = blockIdx.x;
    const int vcu = (G % 8 == 0) ? (c % 8) * (G / 8) + c / 8 : c;
    unsigned char* ws = args.ws;
    gu32* ctl = (gu32*)(ws + WS_CTL);
    for (int u = tid; u < (LDS_BYTES - LDSCTL_OFF) / 4; u += NTHREADS) ((LAS unsigned*)(lds + LDSCTL_OFF))[u] = 0u;
    __syncthreads();
    XcdBarrier bar; bar.bar = (unsigned*)(ctl + CW_BAR); bar.x = 0; bar.st = nullptr;
    const int lo = args.ph_lo, hi = args.ph_hi;
    if (hi - lo > 1) bar = xcd_barrier_post((unsigned*)(ctl + CW_BAR), MISC + 8);
#ifndef PHMASK
#define PHMASK 0xff
#endif
#define IN(k) (((PHMASK >> (k)) & 1) && lo <= (k) && (k) < hi)
#define SEAM(k) do { if (IN(k) && IN((k) + 1)) xcd_barrier(bar); } while (0)
#ifndef PROBE_PHASE
#define PROBE_PHASE -1
#endif
#define PB(k) do { if (PROBE_PHASE == (k)) { if (tid == 0) { const unsigned long long t0_ = __builtin_amdgcn_s_memrealtime(); MISC[16] = (unsigned)t0_; MISC[17] = (unsigned)(t0_ >> 32); } } } while (0)
#define PE(k) do { if (PROBE_PHASE == (k)) { if (tid == 0) { const unsigned long long t0_ = ((unsigned long long)MISC[17] << 32) | MISC[16]; const unsigned long long t1_ = __builtin_amdgcn_s_memrealtime(); \
      while (__builtin_amdgcn_s_memrealtime() - t1_ < t1_ - t0_) __builtin_amdgcn_s_sleep(8); } __syncthreads(); } } while (0)

    PB(0); if (IN(0)) { p0_prologue(args, lds, vcu, G); } SEAM(0); PE(0);
    PB(1); if (IN(1)) { p1_xn(args, lds, c, G); } SEAM(1); PE(1);
    PB(2); if (IN(2)) {
        pg8::Gemm g{(const bf16_t*)(ws + WS_XN), (const bf16_t*)(ws + WS_WIN), D, nullptr};
        pg8::SchedProj S{G, c};
        pg8::EpiProj E{(bf16_t*)(ws + WS_Q), (bf16_t*)(ws + WS_K), (bf16_t*)(ws + WS_V), (bf16_t*)(ws + WS_GB), (bf16_t*)(ws + WS_U), (const float*)(ws + WS_TAB), (unsigned*)(ws + WS_CTL) + CW_KMAX};
        pg8::gemm_phase<pg8::EpiProj, pg8::SchedProj, true, true>(lds, g, S, E);
    } SEAM(2); PE(2);
    PB(3); if (IN(3)) { if (c & 1) expert_weight_copies(args, lds, vcu, G); p3_conv_attn(args, lds, c, vcu, G); if (!(c & 1)) expert_weight_copies(args, lds, vcu, G); } SEAM(3); PE(3);
    PB(4); if (IN(4)) {
        {
            const int p = c;
#ifndef NO_P4
            pg8::Gemm g{(const bf16_t*)(ws + WS_MIXIN), (const bf16_t*)(ws + WS_WOUT), D, nullptr};
            pg8::SchedPanel S{p, 4};
            pg8::EpiBf16 E{(bf16_t*)(ws + WS_MIX), D};
            pg8::gemm_phase<pg8::EpiBf16, pg8::SchedPanel, true, true>(lds, g, S, E);
#endif
            VM_WAIT(); __syncthreads();
#ifndef NO_P5
            p5_rows(args, lds, p);
#endif
            __syncthreads();
        }
    } SEAM(4); PE(4);
    PB(5); if (IN(5)) { p6_topk(args, lds, c, G); } SEAM(5); PE(5);
    PB(6); if (IN(6)) {
#pragma unroll 1
        for (int it = 0; it < 2; ++it) {
            {
                const int item = 2 * c + it;
                const int b = item >> 4, e = item & 15;
#ifndef NO_G1
                if (it == 0) PB(8);
                {
                    pg8::Gemm g{(const bf16_t*)(ws + WS_XN + (size_t)b * T * D), (const bf16_t*)(ws + WS_WGU + (size_t)e * 2048 * D), D, (const int*)(ws + WS_IDX) + item * CAP};
                    pg8::SchedPanel S{0, 8};
                    pg8::EpiGU8 E{ws + WS_HMID + (size_t)item * CAP * D};
                    pg8::gemm_phase<pg8::EpiGU8, pg8::SchedPanel, true, true, true, true>(lds, g, S, E);
                }
#endif
                VM_WAIT(); __syncthreads();
                if (it == 0) { PE(8); PB(9); }
#ifndef NO_G2
                {
                    pg8::Gemm g{(const bf16_t*)(ws + WS_HMID + (size_t)item * CAP * D), (const bf16_t*)(ws + WS_WDN + (size_t)e * D * D), D, nullptr};
                    pg8::SchedPanel S{0, 4};
                    pg8::EpiDown8 E{ws + WS_Y + (size_t)item * CAP * D, (const float*)(ws + WS_GATE) + item * CAP, pg8::F8_INV * pg8::F8_Y};
                    pg8::gemm_phase<pg8::EpiDown8, pg8::SchedPanel, true, true, false, true>(lds, g, S, E);
                }
#endif
                VM_WAIT(); __syncthreads();
                if (it == 0) PE(9);
            }
        }
    } SEAM(6); PE(6);
    PB(7); if (IN(7)) { p8_final(args, vcu, G); } PE(7);
#undef IN
#undef SEAM
}

extern "C" void kernel_launch(void* const* d_in, const int* in_sizes, int n_in, void* d_out, int out_size, void* d_ws, size_t ws_size, hipStream_t stream) {
    static int grid = 0;
    if (grid == 0) {
        if (n_in != 22 || in_sizes[0] != M * D || out_size != M * D || ws_size < WS_END) { fprintf(stderr, "kernel_launch: unexpected shapes (n_in %d, in0 %d, out %d, ws %zu)\n", n_in, n_in > 0 ? in_sizes[0] : -1, out_size, ws_size); grid = -1; return; }
        int dev = 0, cus = 0;
        if (hipGetDevice(&dev) != hipSuccess || hipDeviceGetAttribute(&cus, hipDeviceAttributeMultiprocessorCount, dev) != hipSuccess) { grid = -1; return; }
        if (hipFuncSetAttribute((const void*)fwd_kernel, hipFuncAttributeMaxDynamicSharedMemorySize, LDS_BYTES) != hipSuccess) { fprintf(stderr, "kernel_launch: hipFuncSetAttribute failed\n"); grid = -1; return; }
        (void)hipGetLastError();
        grid = cus;
        if (grid != 256) { fprintf(stderr, "kernel_launch: this kernel needs a 256-CU device (got %d)\n", cus); grid = -1; return; }
    }
    if (grid < 0) return;
    (void)hipMemsetAsync((char*)d_ws + WS_CTL, 0, CTL_ZERO_BYTES, stream);
    Args a{};
    for (int i = 0; i < 22; ++i) a.in[i] = (const float*)d_in[i];
    a.out = (float*)d_out; a.ws = (unsigned char*)d_ws;
    constexpr int NPH = 8;
    if (MK_N_LAUNCHES == 1) { a.ph_lo = 0; a.ph_hi = NPH; hipLaunchKernelGGL(fwd_kernel, dim3(grid), dim3(NTHREADS), LDS_BYTES, stream, a); }
    else { for (int k = 0; k < NPH; ++k) { a.ph_lo = k; a.ph_hi = k + 1; hipLaunchKernelGGL(fwd_kernel, dim3(grid), dim3(NTHREADS), LDS_BYTES, stream, a); } }
}
```

```cpp
#include <hip/hip_runtime.h>
#include <cstdio>
#include <cstdint>

#ifndef MK_N_LAUNCHES
#define MK_N_LAUNCHES 1
#endif

#define LAS __attribute__((address_space(3)))
#define GAS __attribute__((address_space(1)))
typedef unsigned short bf16_t;
typedef short bf16x8 __attribute__((ext_vector_type(8)));
typedef short s16x4 __attribute__((ext_vector_type(4)));
typedef float f32x4 __attribute__((ext_vector_type(4)));
typedef float f32x16 __attribute__((ext_vector_type(16)));
typedef unsigned u32x4 __attribute__((ext_vector_type(4)));
typedef unsigned u32x2 __attribute__((ext_vector_type(2)));

constexpr int NB = 32, T = 2048, D = 1024, TC = 256, M = NB * T, MC = NB * TC, MA = M + MC, TK = TC + T;
constexpr int NE = 16, CAP = 256, NITEM = NB * NE, NPROJ = 3072, NMOD = 6 * D;
constexpr float EPS = 1e-6f;
constexpr float C2 = 0.125f * 1.4426950408889634f;
constexpr float LAM_INIT = 0.2f;
constexpr int NWAVES = 8, NTHREADS = 512;

constexpr size_t MiB = 1u << 20;
constexpr size_t WS_CTL = 0, CTL_ZERO_BYTES = 1 * MiB;
constexpr size_t WS_MODP = 2 * MiB;
constexpr size_t WS_MOD = 16 * MiB;
constexpr size_t WS_TAB = 17 * MiB;
constexpr size_t WS_WIN = 18 * MiB;
constexpr size_t WS_WOUT = 24 * MiB;
constexpr size_t WS_WGU = 26 * MiB;
constexpr size_t WS_WDN = 90 * MiB;
constexpr size_t WS_AFFT = 122 * MiB;
constexpr size_t WS_SLOT = 126 * MiB;
constexpr size_t WS_IDX = 128 * MiB;
constexpr size_t WS_GATE = 129 * MiB;
constexpr size_t WS_XN = 130 * MiB;
constexpr size_t WS_Q = 274 * MiB;
constexpr size_t WS_K = 338 * MiB;
constexpr size_t WS_V = 410 * MiB;
constexpr size_t WS_GB = 482 * MiB;
constexpr size_t WS_U = 546 * MiB;
constexpr size_t WS_MIXIN = 610 * MiB;
constexpr size_t WS_MIX = 738 * MiB;
constexpr size_t WS_HMID = 274 * MiB;
constexpr size_t WS_Y = 610 * MiB;
constexpr size_t WS_H1 = 866 * MiB;
constexpr size_t WS_END = 994 * MiB;

__device__ __forceinline__ int opaque_tid() { int t = threadIdx.x; asm volatile("" : "+v"(t)); return t; }

namespace pg8 {
constexpr int BM = 256, BK = 64, HALF = 128, HTB = HALF * BK * 2, STAGE_BYTES = 8 * HTB;
__host__ __device__ __forceinline__ int lds_byte(int r, int c) { const int st = (r >> 4) * 2 + (c >> 5), rr = r & 15, cc = c & 31, ob = rr * 64 + cc * 2; return st * 1024 + (ob ^ (((ob >> 9) & 1) << 5)); }
__host__ __device__ __forceinline__ void stage_rc(int b, int& R, int& C) { const int st = b / 1024, sb = b % 1024, swz = sb ^ (((sb >> 9) & 1) << 5); R = (st >> 1) * 16 + swz / 64; C = (st & 1) * 32 + (swz % 64) / 2; }
__host__ __device__ __forceinline__ int perm32(int rho) { const int n = rho >> 4, i = rho & 15; return 8 * (i >> 2) + 4 * n + (i & 3); }

struct Unit { int pm, pn; };
struct Gemm { const bf16_t* A; const bf16_t* Bt; int K; const int* gidx; };

typedef float f32x2_t __attribute__((ext_vector_type(2))); typedef __bf16 bf16x2_t __attribute__((ext_vector_type(2)));
__device__ __forceinline__ unsigned cvt_pk_bf16(float lo, float hi) { const f32x2_t v = {lo, hi}; const bf16x2_t b = __builtin_convertvector(v, bf16x2_t); return __builtin_bit_cast(unsigned, b); }

struct EpiBf16 {
    static constexpr bool PERM = true, AFTER_DRAIN = false;
    bf16_t* O; int ldc;
    __device__ __forceinline__ void operator()(const f32x4 (&acc)[2][2][4][2], const Unit& u, int wr, int wc, int fr, int fq) const {
        const int row0 = u.pm * BM + wr * 64 + fr; const int col0 = u.pn * BM + wc * 32 + 8 * fq;
#pragma unroll
        for (int ai = 0; ai < 2; ++ai)
#pragma unroll
            for (int m = 0; m < 4; ++m) { bf16_t* rowp = O + (size_t)(row0 + ai * HALF + m * 16) * ldc + col0;
#pragma unroll
                for (int bj = 0; bj < 2; ++bj) { const f32x4 v0 = acc[ai][bj][m][0], v1 = acc[ai][bj][m][1];
                    u32x4 w; w.x = cvt_pk_bf16(v0[0], v0[1]); w.y = cvt_pk_bf16(v0[2], v0[3]); w.z = cvt_pk_bf16(v1[0], v1[1]); w.w = cvt_pk_bf16(v1[2], v1[3]);
                    *(u32x4*)(rowp + bj * HALF) = w; } }
    }
};

struct EpiProj {
    static constexpr bool PERM = true, AFTER_DRAIN = false;
    bf16_t *Q, *KA, *VA, *GB, *U; const float* tab;
    unsigned* kmaxh;
    __device__ __forceinline__ void operator()(const f32x4 (&acc)[2][2][4][2], const Unit& u, int wr, int wc, int fr, int fq) const {
        const int pn = u.pn; const bool ctx = u.pm >= 256;
        float km[2] = {0.f, 0.f};
#pragma unroll
        for (int ai = 0; ai < 2; ++ai)
#pragma unroll
            for (int m = 0; m < 4; ++m) {
                const int row = u.pm * BM + ai * HALF + wr * 64 + m * 16 + fr;
                int t, kvrow;
                if (!ctx) { const int b = row >> 11; t = row & 2047; kvrow = b * TK + TC + t; }
                else { const int rc = row - M; const int b = rc >> 8; t = 0; kvrow = b * TK + (rc & 255); }
                if (pn < 4) {
                    f32x4 cs0 = {1.f, 0.f, 1.f, 0.f}, cs1 = cs0, cs2 = cs0, cs3 = cs0;
                    if (!ctx) { const float* tp = tab + ((size_t)t * 32 + 16 * (wc & 1) + 4 * fq) * 2;
                        cs0 = *(const f32x4*)(tp); cs1 = *(const f32x4*)(tp + 4); }
                    (void)cs2; (void)cs3;
#pragma unroll
                    for (int bj = 0; bj < 2; ++bj) {
                        const f32x4 v0 = acc[ai][bj][m][0], v1 = acc[ai][bj][m][1];
                        float e0 = v0[0], o0 = v0[1], e1 = v0[2], o1 = v0[3], e2 = v1[0], o2 = v1[1], e3 = v1[2], o3 = v1[3];
                        if (pn >= 2) {
                            float ss = ((e0 * e0 + o0 * o0) + (e1 * e1 + o1 * o1)) + ((e2 * e2 + o2 * o2) + (e3 * e3 + o3 * o3));
                            ss += __shfl_xor(ss, 16); ss += __shfl_xor(ss, 32); km[bj] = fmaxf(km[bj], ss); }
                        float r0 = e0 * cs0[0] - o0 * cs0[1], s0 = o0 * cs0[0] + e0 * cs0[1];
                        float r1 = e1 * cs0[2] - o1 * cs0[3], s1 = o1 * cs0[2] + e1 * cs0[3];
                        float r2 = e2 * cs1[0] - o2 * cs1[1], s2 = o2 * cs1[0] + e2 * cs1[1];
                        float r3 = e3 * cs1[2] - o3 * cs1[3], s3 = o3 * cs1[2] + e3 * cs1[3];
                        const float sc = (pn < 2) ? C2 : 1.f;
                        u32x4 w; w.x = cvt_pk_bf16(r0 * sc, s0 * sc); w.y = cvt_pk_bf16(r1 * sc, s1 * sc); w.z = cvt_pk_bf16(r2 * sc, s2 * sc); w.w = cvt_pk_bf16(r3 * sc, s3 * sc);
                        const int col = (pn & 1) * 256 + bj * HALF + wc * 32 + 8 * fq;
                        bf16_t* dst = (pn < 2) ? (Q + (size_t)row * 512 + col) : (KA + (size_t)kvrow * 512 + col);
                        *(u32x4*)dst = w;
                    }
                } else if (pn < 8) {
#pragma unroll
                    for (int bj = 0; bj < 2; ++bj) {
                        const f32x4 v0 = acc[ai][bj][m][0], v1 = acc[ai][bj][m][1];
                        u32x4 w; w.x = cvt_pk_bf16(v0[0], v0[1]); w.y = cvt_pk_bf16(v0[2], v0[3]); w.z = cvt_pk_bf16(v1[0], v1[1]); w.w = cvt_pk_bf16(v1[2], v1[3]);
                        const int col = (pn & 1) * 256 + bj * HALF + wc * 32 + 8 * fq;
                        bf16_t* dst = (pn < 6) ? (VA + (size_t)kvrow * 512 + col) : (GB + (size_t)row * 512 + col);
                        *(u32x4*)dst = w;
                    }
                } else {
                    const f32x4 a0 = acc[ai][0][m][0], a1 = acc[ai][0][m][1], b0 = acc[ai][1][m][0], b1 = acc[ai][1][m][1];
                    u32x4 w; w.x = cvt_pk_bf16(a0[0] * b0[0], a0[1] * b0[1]); w.y = cvt_pk_bf16(a0[2] * b0[2], a0[3] * b0[3]);
                    w.z = cvt_pk_bf16(a1[0] * b1[0], a1[1] * b1[1]); w.w = cvt_pk_bf16(a1[2] * b1[2], a1[3] * b1[3]);
                    const int col = (pn - 8) * 128 + wc * 32 + 8 * fq;
                    *(u32x4*)(U + (size_t)row * 512 + col) = w;
                }
            }
        if (pn == 2 || pn == 3) {
            const int b = ctx ? (u.pm - 256) : (u.pm >> 3);
#pragma unroll
            for (int bj = 0; bj < 2; ++bj) { float v = km[bj];
#pragma unroll
                for (int d = 1; d < 16; d <<= 1) v = fmaxf(v, __shfl_xor(v, d));
                if (fr == 0 && fq == 0) atomicMax(kmaxh + ((b * 8 + (pn & 1) * 4 + bj * 2 + (wc >> 1)) * 2 + (wc & 1)), __float_as_uint(v)); }
        }
    }
};

struct EpiGU {
    static constexpr bool PERM = true, AFTER_DRAIN = false;
    bf16_t* H;
    __device__ __forceinline__ float silu(float x) const { return x * __builtin_amdgcn_rcpf(1.f + __expf(-x)); }
    __device__ __forceinline__ void operator()(const f32x4 (&acc)[2][2][4][2], const Unit& u, int wr, int wc, int fr, int fq) const {
#pragma unroll
        for (int ai = 0; ai < 2; ++ai)
#pragma unroll
            for (int m = 0; m < 4; ++m) {
                const int row = ai * HALF + wr * 64 + m * 16 + fr;
                const f32x4 a0 = acc[ai][0][m][0], a1 = acc[ai][0][m][1], b0 = acc[ai][1][m][0], b1 = acc[ai][1][m][1];
                u32x4 w; w.x = cvt_pk_bf16(silu(a0[0]) * b0[0], silu(a0[1]) * b0[1]); w.y = cvt_pk_bf16(silu(a0[2]) * b0[2], silu(a0[3]) * b0[3]);
                w.z = cvt_pk_bf16(silu(a1[0]) * b1[0], silu(a1[1]) * b1[1]); w.w = cvt_pk_bf16(silu(a1[2]) * b1[2], silu(a1[3]) * b1[3]);
                *(u32x4*)(H + (size_t)row * 1024 + u.pn * 128 + wc * 32 + 8 * fq) = w;
            }
    }
};
__device__ __forceinline__ unsigned pk4_fp8(float a, float b, float c, float d) { int w = 0; w = __builtin_amdgcn_cvt_pk_fp8_f32(a, b, w, false); w = __builtin_amdgcn_cvt_pk_fp8_f32(c, d, w, true); return (unsigned)w; }
constexpr float F8_ACT = 4.0f, F8_WGT = 64.0f, F8_INV = 1.0f / (4.0f * 64.0f);
struct EpiGU8 {
    static constexpr bool PERM = true, AFTER_DRAIN = false;
    unsigned char* H;
    __device__ __forceinline__ float hval(float g, float u) const {
        const float e = __builtin_amdgcn_exp2f(g * (-F8_INV * 1.4426950408889634f));
        const float r = __builtin_amdgcn_rcpf(1.f + e);
        return __builtin_amdgcn_fmed3f((g * u) * (r * (F8_INV * F8_INV * F8_ACT)), -448.f, 448.f); }
    __device__ __forceinline__ void operator()(const f32x4 (&acc)[2][2][4][2], const Unit& u, int wr, int wc, int fr, int fq) const {
        asm volatile("" : "+v"(fr));
#pragma unroll
        for (int ai = 0; ai < 2; ++ai)
#pragma unroll
            for (int m = 0; m < 4; ++m) {
                const int row = ai * HALF + wr * 64 + m * 16 + fr;
                const f32x4 a0 = acc[ai][0][m][0], a1 = acc[ai][0][m][1], b0 = acc[ai][1][m][0], b1 = acc[ai][1][m][1];
                u32x2 w; w.x = pk4_fp8(hval(a0[0], b0[0]), hval(a0[1], b0[1]), hval(a0[2], b0[2]), hval(a0[3], b0[3]));
                w.y = pk4_fp8(hval(a1[0], b1[0]), hval(a1[1], b1[1]), hval(a1[2], b1[2]), hval(a1[3], b1[3]));
                *(u32x2*)(H + (size_t)row * 1024 + u.pn * 128 + wc * 32 + 8 * fq) = w;
            }
    }
};
struct EpiDown {
    static constexpr bool PERM = true, AFTER_DRAIN = false;
    bf16_t* Y; const float* gate; float scale;
    __device__ __forceinline__ void operator()(const f32x4 (&acc)[2][2][4][2], const Unit& u, int wr, int wc, int fr, int fq) const {
        asm volatile("" : "+v"(fr));
#pragma unroll
        for (int ai = 0; ai < 2; ++ai)
#pragma unroll
            for (int m = 0; m < 4; ++m) {
                const int row = ai * HALF + wr * 64 + m * 16 + fr; const float g = gate[row] * scale;
#pragma unroll
                for (int bj = 0; bj < 2; ++bj) { const f32x4 v0 = acc[ai][bj][m][0] * g, v1 = acc[ai][bj][m][1] * g;
                    u32x4 w; w.x = cvt_pk_bf16(v0[0], v0[1]); w.y = cvt_pk_bf16(v0[2], v0[3]); w.z = cvt_pk_bf16(v1[0], v1[1]); w.w = cvt_pk_bf16(v1[2], v1[3]);
                    *(u32x4*)(Y + (size_t)row * 1024 + u.pn * BM + bj * HALF + wc * 32 + 8 * fq) = w; }
            }
    }
};

constexpr float F8_Y = 64.0f;
struct EpiDown8 {
    static constexpr bool PERM = true, AFTER_DRAIN = false;
    unsigned char* Y; const float* gate; float scale;
    __device__ __forceinline__ void operator()(const f32x4 (&acc)[2][2][4][2], const Unit& u, int wr, int wc, int fr, int fq) const {
        asm volatile("" : "+v"(fr));
#pragma unroll
        for (int ai = 0; ai < 2; ++ai)
#pragma unroll
            for (int m = 0; m < 4; ++m) {
                const int row = ai * HALF + wr * 64 + m * 16 + fr; const float g = gate[row] * scale;
#pragma unroll
                for (int bj = 0; bj < 2; ++bj) { f32x4 v0 = acc[ai][bj][m][0] * g, v1 = acc[ai][bj][m][1] * g;
#pragma unroll
                    for (int i = 0; i < 4; ++i) { v0[i] = __builtin_amdgcn_fmed3f(v0[i], -448.f, 448.f); v1[i] = __builtin_amdgcn_fmed3f(v1[i], -448.f, 448.f); }
                    u32x2 w; w.x = pk4_fp8(v0[0], v0[1], v0[2], v0[3]); w.y = pk4_fp8(v1[0], v1[1], v1[2], v1[3]);
                    *(u32x2*)(Y + (size_t)row * 1024 + u.pn * BM + bj * HALF + wc * 32 + 8 * fq) = w; }
            }
    }
};

struct SchedProj {
    int G, c;
    __device__ __forceinline__ bool next(int i, Unit& u) const {
        const int L = i * G + c;
        if (L < 3072) { u.pm = L & 255; u.pn = L >> 8; return true; }
        const int j = L - 3072; if (j >= 128) return false;
        u.pm = 256 + (j >> 2); u.pn = 2 + (j & 3); return true;
    }
    __device__ __forceinline__ void a_ready(const Unit&) const {}
    __device__ __forceinline__ void done(const Unit&) const {}
};
struct SchedPanel {
    int pm, ntn;
    __device__ __forceinline__ bool next(int i, Unit& u) const { if (i >= ntn) return false; u.pm = pm; u.pn = i; return true; }
    __device__ __forceinline__ void a_ready(const Unit&) const {}
    __device__ __forceinline__ void done(const Unit&) const {}
};

typedef int i32x4v __attribute__((ext_vector_type(4)));
typedef int i32x8v __attribute__((ext_vector_type(8)));
__device__ __forceinline__ i32x8v cat8(bf16x8 a, bf16x8 b) { const i32x4v x = __builtin_bit_cast(i32x4v, a), y = __builtin_bit_cast(i32x4v, b); return __builtin_shufflevector(x, y, 0, 1, 2, 3, 4, 5, 6, 7); }
template <bool F8> struct Frag;
template <> struct Frag<false> { bf16x8 v[2]; __device__ __forceinline__ void set(bf16x8 a, bf16x8 b) { v[0] = a; v[1] = b; } };
template <> struct Frag<true> { i32x8v v; __device__ __forceinline__ void set(bf16x8 a, bf16x8 b) { v = cat8(a, b); } };
__device__ __forceinline__ f32x4 frag_mma(const Frag<false>& b, const Frag<false>& a, f32x4 c) { c = __builtin_amdgcn_mfma_f32_16x16x32_bf16(b.v[0], a.v[0], c, 0, 0, 0); return __builtin_amdgcn_mfma_f32_16x16x32_bf16(b.v[1], a.v[1], c, 0, 0, 0); }
__device__ __forceinline__ f32x4 frag_mma(const Frag<true>& b, const Frag<true>& a, f32x4 c) {
    const int sc1 = 0x7f7f7f7f;
    asm volatile("v_mfma_scale_f32_16x16x128_f8f6f4 %0, %1, %2, %0, %3, %3 op_sel_hi:[0,0,0]" : "+v"(c) : "v"(b.v), "v"(a.v), "v"(sc1));
    return c; }
template <class Epi, class Sched, bool ALIGN_EPI, bool SP2, bool GATHER = false, bool F8 = false>
__device__ __forceinline__ void gemm_phase(LAS unsigned char* lds, const Gemm g, const Sched& S, const Epi& E) {
    const int tid = opaque_tid(), wid = __builtin_amdgcn_readfirstlane(tid >> 6), lane = tid & 63, wr = wid >> 2, wc = wid & 3, fr = lane & 15, fq = lane >> 4;
    const int K = g.K * (F8 ? 1 : 2), nt = K / 128;
    unsigned voffA[2][2], voffB[2];
#pragma unroll
    for (int i = 0; i < 2; ++i) { int R, C; stage_rc(tid * 16 + i * 8192, R, C); const int Rb = Epi::PERM ? ((R & ~31) + perm32(R & 31)) : R;
        if constexpr (GATHER) { voffA[0][i] = (unsigned)(g.gidx[R] * K + C * 2); voffA[1][i] = (unsigned)(g.gidx[HALF + R] * K + C * 2); }
        else { voffA[0][i] = (unsigned)(R * K + C * 2); voffA[1][i] = voffA[0][i]; }
        voffB[i] = (unsigned)(Rb * K + C * 2); }
    const size_t kstep = (size_t)(BK * 2);
    const size_t hstep = (size_t)HALF * K;
    const size_t hstepA = GATHER ? (size_t)0 : hstep;
    const size_t tstep = 2 * hstep;
    const unsigned ldsw = (unsigned)wid * 1024u;
    const int aoff = F8 ? lds_byte(wr * 64 + fr, (fq >> 1) * 32 + (fq & 1) * 16) : lds_byte(wr * 64 + fr, fq * 8), boff = F8 ? lds_byte(wc * 32 + fr, (fq >> 1) * 32 + (fq & 1) * 16) : lds_byte(wc * 32 + fr, fq * 8);
    const int aoff1 = F8 ? aoff + 16 : aoff + 1024, boff1 = F8 ? boff + 16 : boff + 1024;
#define PG8_SA(b, h) (((b) * 2 + (h)) * HTB)
#define PG8_SB(b, h) ((4 + (b) * 2 + (h)) * HTB)
#define PG8_STAGE(bufoff, gbase, voff) do { _Pragma("unroll") for (int _i = 0; _i < 2; ++_i) \
        __builtin_amdgcn_global_load_lds((const unsigned*)((const char*)(gbase) + (voff)[_i]), (LAS unsigned*)(lds + (bufoff) + ldsw + _i * 8192), 16, 0, 0); } while (0)
#define PG8_LDA(dst, b, h) do { _Pragma("unroll") for (int m = 0; m < 4; ++m) dst[m].set(*(const LAS bf16x8*)(lds + PG8_SA(b, h) + aoff + m * 2048), *(const LAS bf16x8*)(lds + PG8_SA(b, h) + aoff1 + m * 2048)); } while (0)
#define PG8_LDB(dst, b, h) do { _Pragma("unroll") for (int n = 0; n < 2; ++n) dst[n].set(*(const LAS bf16x8*)(lds + PG8_SB(b, h) + boff + n * 2048), *(const LAS bf16x8*)(lds + PG8_SB(b, h) + boff1 + n * 2048)); } while (0)
#define PG8_MMA(ai, bj, At, Bt) do { __builtin_amdgcn_s_setprio(1); _Pragma("unroll") for (int m = 0; m < 4; ++m) _Pragma("unroll") for (int n = 0; n < 2; ++n) \
        acc[ai][bj][m][n] = frag_mma(Bt[n], At[m], acc[ai][bj][m][n]); __builtin_amdgcn_s_setprio(0); } while (0)
#define PG8_WAIT_V(n) asm volatile("s_waitcnt vmcnt(" #n ")" ::: "memory")
#define PG8_WAIT_L(n) asm volatile("s_waitcnt lgkmcnt(" #n ")" ::: "memory")
#define PG8_BAR __builtin_amdgcn_s_barrier()
#define PG8_SCHED __builtin_amdgcn_sched_barrier(0)
    Unit cur, nxt; int ui = 0;
    if (!S.next(0, cur)) return;
    f32x4 acc[2][2][4][2];
#pragma unroll
    for (int a = 0; a < 2; ++a)
#pragma unroll
        for (int b = 0; b < 2; ++b)
#pragma unroll
            for (int m = 0; m < 4; ++m)
#pragma unroll
                for (int n = 0; n < 2; ++n) acc[a][b][m][n] = (f32x4){0.f, 0.f, 0.f, 0.f};
    Frag<F8> At[4], B0[2], B1[2];
    const char* cA = (const char*)g.A + (size_t)cur.pm * tstep; const char* cB = (const char*)g.Bt + (size_t)cur.pn * tstep;
    S.a_ready(cur);
    if constexpr (SP2) {
        PG8_STAGE(PG8_SB(0, 0), cB, voffB); PG8_STAGE(PG8_SB(0, 1), cB + hstep, voffB); PG8_STAGE(PG8_SA(0, 0), cA, voffA[0]); PG8_STAGE(PG8_SA(0, 1), cA + hstepA, voffA[GATHER ? 1 : 0]);
        if (wr == 1) PG8_BAR;
        PG8_WAIT_V(2); PG8_BAR;
        PG8_STAGE(PG8_SB(1, 0), cB + kstep, voffB); PG8_STAGE(PG8_SA(1, 0), cA + kstep, voffA[0]); PG8_STAGE(PG8_SB(1, 1), cB + hstep + kstep, voffB);
        PG8_WAIT_V(6); PG8_BAR;
    } else {
        PG8_STAGE(PG8_SB(0, 0), cB, voffB); PG8_STAGE(PG8_SA(0, 0), cA, voffA[0]); PG8_STAGE(PG8_SB(0, 1), cB + hstep, voffB); PG8_STAGE(PG8_SA(0, 1), cA + hstepA, voffA[GATHER ? 1 : 0]);
        if (wr == 1) PG8_BAR;
        PG8_WAIT_V(4); PG8_BAR;
        PG8_STAGE(PG8_SB(1, 0), cB + kstep, voffB); PG8_STAGE(PG8_SA(1, 0), cA + kstep, voffA[0]); PG8_STAGE(PG8_SB(1, 1), cB + hstep + kstep, voffB);
        PG8_WAIT_V(6); PG8_BAR;
    }
    for (;;) {
        const bool has_next = S.next(ui + 1, nxt);
        const char* nA = has_next ? (const char*)g.A + (size_t)nxt.pm * tstep : cA; const char* nB = has_next ? (const char*)g.Bt + (size_t)nxt.pn * tstep : cB;
#pragma unroll 1
        for (int t = 0; t < nt; t += 2) {
            const bool last = (t == nt - 2);
            if constexpr (F8) { asm volatile("" : "+v"(voffA[0][0]), "+v"(voffA[0][1]), "+v"(voffB[0]), "+v"(voffB[1])); if constexpr (GATHER) asm volatile("" : "+v"(voffA[1][0]), "+v"(voffA[1][1])); }
            const char* a1 = cA + (size_t)(t + 1) * kstep;
            const char* a2 = last ? nA : cA + (size_t)(t + 2) * kstep; const char* b2 = last ? nB : cB + (size_t)(t + 2) * kstep;
            const char* a3 = a2 + kstep; const char* b3 = b2 + kstep;
            if (last && has_next) S.a_ready(nxt);
            if constexpr (SP2) {
            PG8_LDB(B0, 0, 0); PG8_LDB(B1, 0, 1); PG8_SCHED; PG8_LDA(At, 0, 0); PG8_STAGE(PG8_SA(1, 1), a1 + hstepA, voffA[GATHER ? 1 : 0]);
            PG8_WAIT_V(8); PG8_WAIT_L(0); PG8_BAR; PG8_MMA(0, 0, At, B0); PG8_MMA(0, 1, At, B1); PG8_BAR; PG8_SCHED;
            PG8_LDA(At, 0, 1); PG8_STAGE(PG8_SB(0, 0), b2, voffB); PG8_STAGE(PG8_SB(0, 1), b2 + hstep, voffB); PG8_STAGE(PG8_SA(0, 0), a2, voffA[0]);
            PG8_WAIT_V(8); PG8_WAIT_L(0); PG8_BAR; PG8_MMA(1, 0, At, B0); PG8_MMA(1, 1, At, B1); PG8_BAR; PG8_SCHED;
            PG8_LDB(B0, 1, 0); PG8_LDB(B1, 1, 1); PG8_SCHED; PG8_LDA(At, 1, 0); PG8_STAGE(PG8_SA(0, 1), a2 + hstepA, voffA[GATHER ? 1 : 0]);
            PG8_WAIT_V(8); PG8_WAIT_L(0); PG8_BAR; PG8_MMA(0, 0, At, B0); PG8_MMA(0, 1, At, B1); PG8_BAR; PG8_SCHED;
            PG8_LDA(At, 1, 1); PG8_STAGE(PG8_SB(1, 0), b3, voffB); PG8_STAGE(PG8_SB(1, 1), b3 + hstep, voffB); PG8_STAGE(PG8_SA(1, 0), a3, voffA[0]);
            PG8_WAIT_V(8); PG8_WAIT_L(0); PG8_BAR; PG8_MMA(1, 0, At, B0); PG8_MMA(1, 1, At, B1); PG8_BAR; PG8_SCHED;
            } else {
            PG8_LDB(B0, 0, 0); PG8_SCHED; PG8_LDA(At, 0, 0); PG8_STAGE(PG8_SA(1, 1), a1 + hstepA, voffA[GATHER ? 1 : 0]);
            PG8_WAIT_L(8); PG8_BAR; PG8_WAIT_L(0); PG8_MMA(0, 0, At, B0); PG8_BAR; PG8_SCHED;
            PG8_LDB(B1, 0, 1); PG8_STAGE(PG8_SB(0, 0), b2, voffB);
            PG8_BAR; PG8_WAIT_L(0); PG8_MMA(0, 1, At, B1); PG8_BAR;
            PG8_LDA(At, 0, 1); PG8_STAGE(PG8_SA(0, 0), a2, voffA[0]);
            PG8_BAR; PG8_WAIT_L(0); PG8_MMA(1, 0, At, B0); PG8_BAR; PG8_SCHED;
            PG8_STAGE(PG8_SB(0, 1), b2 + hstep, voffB);
            PG8_WAIT_V(6); PG8_BAR; PG8_MMA(1, 1, At, B1); PG8_BAR;
            PG8_LDB(B0, 1, 0); PG8_SCHED; PG8_LDA(At, 1, 0); PG8_STAGE(PG8_SA(0, 1), a2 + hstepA, voffA[GATHER ? 1 : 0]);
            PG8_WAIT_L(8); PG8_BAR; PG8_WAIT_L(0); PG8_MMA(0, 0, At, B0); PG8_BAR; PG8_SCHED;
            PG8_LDB(B1, 1, 1); PG8_STAGE(PG8_SB(1, 0), b3, voffB);
            PG8_BAR; PG8_WAIT_L(0); PG8_MMA(0, 1, At, B1); PG8_BAR;
            PG8_LDA(At, 1, 1); PG8_STAGE(PG8_SA(1, 0), a3, voffA[0]);
            PG8_BAR; PG8_WAIT_L(0); PG8_MMA(1, 0, At, B0); PG8_BAR; PG8_SCHED;
            PG8_STAGE(PG8_SB(1, 1), b3 + hstep, voffB);
            PG8_WAIT_V(6); PG8_BAR; PG8_MMA(1, 1, At, B1); PG8_BAR;
            }
        }
        if constexpr (ALIGN_EPI) { if (wr == 0) PG8_BAR; }
        if constexpr (F8) asm volatile("s_nop 15\n\ts_nop 7" ::: "memory");
        E(acc, cur, wr, wc, fr, fq); S.done(cur);
        if (!has_next) break;
#pragma unroll
        for (int a = 0; a < 2; ++a)
#pragma unroll
            for (int b = 0; b < 2; ++b)
#pragma unroll
                for (int m = 0; m < 4; ++m)
#pragma unroll
                    for (int n = 0; n < 2; ++n) acc[a][b][m][n] = (f32x4){0.f, 0.f, 0.f, 0.f};
        cur = nxt; cA = nA; cB = nB; ++ui;
        if constexpr (ALIGN_EPI) { if (wr == 1) PG8_BAR; }
    }
    PG8_WAIT_V(0);
    if constexpr (!ALIGN_EPI) { if (wr == 0) PG8_BAR; }
    PG8_BAR;
#undef PG8_SA
#undef PG8_SB
#undef PG8_STAGE
#undef PG8_LDA
#undef PG8_LDB
#undef PG8_MMA
#undef PG8_WAIT_V
#undef PG8_WAIT_L
#undef PG8_BAR
#undef PG8_SCHED
}
}

typedef GAS unsigned gu32;
#define RLX_AGENT __ATOMIC_RELAXED, __HIP_MEMORY_SCOPE_AGENT
#define LDS_WAIT() asm volatile("s_waitcnt lgkmcnt(0)" ::: "memory")
#define VM_WAIT() asm volatile("s_waitcnt vmcnt(0)" ::: "memory")
__device__ __forceinline__ unsigned pk2(float lo, float hi) { return pg8::cvt_pk_bf16(lo, hi); }
__device__ __forceinline__ float bf2f(unsigned short h) { return __uint_as_float((unsigned)h << 16); }
__device__ __forceinline__ float bflo(unsigned w) { return __uint_as_float(w << 16); }
__device__ __forceinline__ float bfhi(unsigned w) { return __uint_as_float(w & 0xffff0000u); }
__device__ __forceinline__ float wave_sum(float v) {
#pragma unroll
    for (int o = 1; o < 64; o <<= 1) v += __shfl_xor(v, o);
    return v;
}

#define XB_TMO      128
#define XB_XCNT(j)  (256  + 64 * (j))
#define XB_XSUB(j)  (1280 + 64 * (j))
#define XB_XGEN(j)  (2304 + 64 * (j))
#define XB_TOP      3328
#define XB_TOPGEN   3392
#define XCD_BAR_WORDS 3456
#define XB_SPIN_CAP (1u << 18)
__device__ __forceinline__ unsigned xb_ld(unsigned* p)              { return __hip_atomic_load(p, __ATOMIC_RELAXED, __HIP_MEMORY_SCOPE_AGENT); }
__device__ __forceinline__ unsigned xb_add(unsigned* p, unsigned v) { return __hip_atomic_fetch_add(p, v, __ATOMIC_RELAXED, __HIP_MEMORY_SCOPE_AGENT); }
__device__ __forceinline__ unsigned xb_xcc_id() { return (unsigned)__builtin_amdgcn_s_getreg((3 << 11) | 20) & 0xFu; }
#define XB_SPIN(cond, bar) do { unsigned _sp = 0; while (cond) { __builtin_amdgcn_s_sleep(1); \
    if ((++_sp & 255u) == 0u) { if (xb_ld(&(bar)[XB_TMO])) break; if (_sp > XB_SPIN_CAP) { atomicAdd(&(bar)[XB_TMO], 1u); break; } } } } while (0)
struct XcdBarrier { unsigned* bar; unsigned x; volatile LAS unsigned* st; };
__device__ __forceinline__ XcdBarrier xcd_barrier_post(unsigned* bar, volatile LAS unsigned* st) {
    XcdBarrier b; b.bar = bar; b.x = xb_xcc_id(); b.st = st;
    if (threadIdx.x == 0) (void)xb_add(&bar[XB_XCNT(b.x)], 1u);
    return b;
}
__device__ __forceinline__ void xcd_barrier_complete(unsigned* bar, unsigned x, unsigned& nloc, unsigned& nx) {
    const unsigned G = gridDim.x * gridDim.y * gridDim.z;
    unsigned sum, cnt, mine, sp = 0u;
    for (;;) {
        sum = 0u; cnt = 0u; mine = 0u;
#pragma unroll
        for (unsigned j = 0; j < 16; ++j) { const unsigned c = xb_ld(&bar[XB_XCNT(j)]); sum += c; cnt += (c > 0u) ? 1u : 0u; mine = (j == x) ? c : mine; }
        if (sum == G) break;
        __builtin_amdgcn_s_sleep(1);
        if ((++sp & 255u) == 0u) { if (xb_ld(&bar[XB_TMO])) break; if (sp > XB_SPIN_CAP) { atomicAdd(&bar[XB_TMO], 1u); break; } }
    }
    nloc = mine > 0u ? mine : 1u; nx = cnt > 0u ? cnt : 1u;
}
__device__ __forceinline__ void xcd_barrier(const XcdBarrier& b) {
    asm volatile("s_waitcnt vmcnt(0)" ::: "memory");
    __syncthreads();
    if (threadIdx.x == 0) {
        unsigned* bar = b.bar;
        __builtin_amdgcn_s_waitcnt(0);
        unsigned nloc = b.st[0], nx = b.st[1];
        if (nloc == 0u) { xcd_barrier_complete(bar, b.x, nloc, nx); b.st[0] = nloc; b.st[1] = nx; }
        const unsigned old = xb_add(&bar[XB_XSUB(b.x)], 1u);
        const unsigned gen = old / nloc;
        if (old + 1u == (gen + 1u) * nloc) {
            __builtin_amdgcn_fence(__ATOMIC_RELEASE, "agent");
            asm volatile("s_waitcnt vmcnt(0)" ::: "memory");
            const unsigned og = xb_add(&bar[XB_TOP], 1u);
            const unsigned tg = og / nx;
            if (og + 1u == (tg + 1u) * nx) xb_add(&bar[XB_TOPGEN], 1u);
            else XB_SPIN(xb_ld(&bar[XB_TOPGEN]) == tg, bar);
            __builtin_amdgcn_fence(__ATOMIC_ACQUIRE, "agent");
            xb_add(&bar[XB_XGEN(b.x)], 1u);
            asm volatile("s_waitcnt vmcnt(0)" ::: "memory");
        } else {
            XB_SPIN(xb_ld(&bar[XB_XGEN(b.x)]) == gen, bar);
            __builtin_amdgcn_fence(__ATOMIC_ACQUIRE, "agent");
            asm volatile("s_waitcnt vmcnt(0)" ::: "memory");
        }
    }
    __syncthreads();
}

constexpr int RING_BYTES = 131072;
constexpr int LDSCTL_OFF = RING_BYTES, MISC_OFF = LDSCTL_OFF + 320;
constexpr int LDS_BYTES = 147456;
constexpr int CW_BAR = 4096;
constexpr int CW_KMAX = 65536;

struct Args { const float* in[22]; float* out; unsigned char* ws; int ph_lo, ph_hi; };
enum { I_X = 0, I_C, I_CTX, I_CCTX, I_WADA, I_BADA, I_NPRE_MIX, I_NPOST_MIX, I_NPRE_FFN, I_NPOST_FFN, I_WIN, I_CONVW, I_LQ1, I_LK1, I_LQ2, I_LK2, I_SUBLN, I_WOUT, I_WROUTER, I_WGATE, I_WUP, I_WDOWN };

__device__ __forceinline__ void prefetch_slice(const unsigned char* base, int bytes_per_wave, LAS unsigned char* scr, int lane) {
    for (int i = 0; i < bytes_per_wave; i += 1024)
        __builtin_amdgcn_global_load_lds((const unsigned*)(base + i + lane * 16), (LAS unsigned*)scr, 16, 0, 0);
}

__device__ __forceinline__ int win_dest(int n) {
    if (n < 1024) { const int j = n & 63; const int p = ((j >> 5) << 5) + ((j & 15) << 1) + ((j >> 4) & 1); return (n & ~63) + p; }
    if (n < 2048) return n;
    int c = n - 2048; const int isx = c >= 512; c &= 511; return 2048 + ((c >> 7) << 8) + (isx << 7) + (c & 127);
}
template <int MODE>
__device__ __forceinline__ int tr_dest(int n) {
    if (MODE == 0) return n;
    if (MODE == 1) return win_dest(n);
    if (MODE == 2) return ((n >> 7) << 8) + (n & 127);
    return ((n >> 7) << 8) + 128 + (n & 127);
}
template <int MODE>
__device__ __forceinline__ void p0_transpose_item_f8(const float* W, int K, int N, unsigned char* WT, LAS float* scr, int item, int lane) {
    const int nblk = N / 32, kb = item / nblk, nb = item % nblk, k0 = 64 * kb, n0 = 32 * nb;
#pragma unroll 8
    for (int i = 0; i < 32; ++i) { const int kk = 2 * i + (lane >> 5); scr[kk * 33 + (lane & 31)] = __builtin_nontemporal_load(W + (size_t)(k0 + kk) * N + n0 + (lane & 31)) * pg8::F8_WGT; }
    LDS_WAIT(); asm volatile("" ::: "memory");
    const int c = lane & 7;
#pragma unroll
    for (int j = 0; j < 4; ++j) { const int n = (lane >> 3) + 8 * j; const LAS float* s = scr + (8 * c) * 33 + n;
        u32x2 o; o.x = pg8::pk4_fp8(s[0 * 33], s[1 * 33], s[2 * 33], s[3 * 33]); o.y = pg8::pk4_fp8(s[4 * 33], s[5 * 33], s[6 * 33], s[7 * 33]);
        *(GAS u32x2*)(WT + (size_t)tr_dest<MODE>(n0 + n) * K + k0 + 8 * c) = o; }
    LDS_WAIT(); asm volatile("" ::: "memory");
}
template <int MODE>
__device__ __forceinline__ void p0_transpose_item(const float* W, int K, int N, bf16_t* WT, LAS float* scr, int item, int lane) {
    const int nblk = N / 32, kb = item / nblk, nb = item % nblk, k0 = 64 * kb, n0 = 32 * nb;
#pragma unroll 8
    for (int i = 0; i < 32; ++i) { const int kk = 2 * i + (lane >> 5); scr[kk * 33 + (lane & 31)] = W[(size_t)(k0 + kk) * N + n0 + (lane & 31)]; }
    LDS_WAIT(); asm volatile("" ::: "memory");
    const int c = lane & 7;
#pragma unroll
    for (int j = 0; j < 4; ++j) { const int n = (lane >> 3) + 8 * j; const LAS float* s = scr + (8 * c) * 33 + n;
        u32x4 o; o.x = pk2(s[0 * 33], s[1 * 33]); o.y = pk2(s[2 * 33], s[3 * 33]); o.z = pk2(s[4 * 33], s[5 * 33]); o.w = pk2(s[6 * 33], s[7 * 33]);
        *(GAS u32x4*)(WT + (size_t)tr_dest<MODE>(n0 + n) * K + k0 + 8 * c) = o; }
    LDS_WAIT(); asm volatile("" ::: "memory");
}

__device__ __forceinline__ void p0_prologue(const Args& a, LAS unsigned char* lds, int vcu, int G) {
    const int tid = opaque_tid(), lane = tid & 63, wave = __builtin_amdgcn_readfirstlane(tid >> 6);
    LAS float* scr = (LAS float*)(lds + wave * 16384);
    const int gw = vcu * NWAVES + wave, NGW = G * NWAVES;
    unsigned char* ws = a.ws;
    if (gw < 96 * 16) {
        float* MODP = (float*)(ws + WS_MODP);
        const float* wada = a.in[I_WADA];
        for (int it = gw; it < 96 * 16; it += NGW) {
            const int cg = it % 96, kc = it / 96;
            for (int b = 0; b < 33; ++b) { const float v = (b < 32) ? a.in[I_C][b * D + kc * 64 + lane] : a.in[I_CCTX][kc * 64 + lane]; scr[b * 64 + lane] = v / (1.f + __expf(-v)); }
            LDS_WAIT(); asm volatile("" ::: "memory");
            float acc[33];
#pragma unroll
            for (int b = 0; b < 33; ++b) acc[b] = 0.f;
            const float* wp = wada + (size_t)(kc * 64) * NMOD + cg * 64 + lane;
#pragma unroll 2
            for (int k = 0; k < 64; k += 4) {
                const float w0 = __builtin_nontemporal_load(wp + (size_t)(k + 0) * NMOD), w1 = __builtin_nontemporal_load(wp + (size_t)(k + 1) * NMOD),
                            w2 = __builtin_nontemporal_load(wp + (size_t)(k + 2) * NMOD), w3 = __builtin_nontemporal_load(wp + (size_t)(k + 3) * NMOD);
#pragma unroll
                for (int b = 0; b < 33; ++b) { const f32x4 sv4 = *(const LAS f32x4*)(scr + b * 64 + k); acc[b] += (sv4.x * w0 + sv4.y * w1) + (sv4.z * w2 + sv4.w * w3); }
            }
#pragma unroll
            for (int b = 0; b < 33; ++b) MODP[((size_t)kc * 33 + b) * NMOD + cg * 64 + lane] = acc[b];
            LDS_WAIT(); asm volatile("" ::: "memory");
        }
    } else {
        float* tab = (float*)(ws + WS_TAB);
        const int nw = NGW - 96 * 16;
        for (int e = (gw - 96 * 16) * 64 + lane; e < T * 32; e += nw * 64) {
            const int t = e >> 5, i = e & 31;
            const float inv = powf(10000.0f, -(float)(2 * (i & 15)) / 32.0f);
            const float pos = (i < 16) ? (float)(t >> 6) : (float)(t & 63);
            const float ang = pos * inv;
            tab[2 * e] = cosf(ang); tab[2 * e + 1] = sinf(ang);
        }
    }
}
__device__ __forceinline__ void inout_weight_copies(const Args& a, LAS unsigned char* lds, int vcu, int G) {
    const int tid = opaque_tid(), lane = tid & 63, wave = __builtin_amdgcn_readfirstlane(tid >> 6);
    LAS float* scr = (LAS float*)(lds + 16384 + wave * 12288);
    const int gw = vcu * NWAVES + wave, NGW = G * NWAVES;
    unsigned char* ws = a.ws;
    constexpr int I_IN = (D / 64) * (NPROJ / 32), I_OUT = (D / 64) * (D / 32);
    constexpr int NITEMS = I_IN + I_OUT;
    bf16_t* Win_t = (bf16_t*)(ws + WS_WIN); bf16_t* Wout_t = (bf16_t*)(ws + WS_WOUT);
    for (int it = gw; it < NITEMS; it += NGW) {
        int r = it;
        if (r < I_IN) { p0_transpose_item<1>(a.in[I_WIN], D, NPROJ, Win_t, scr, r, lane); continue; } r -= I_IN;
        p0_transpose_item<0>(a.in[I_WOUT], D, D, Wout_t, scr, r, lane);
    }
}
__device__ __forceinline__ void expert_weight_copies(const Args& a, LAS unsigned char* lds, int gw0  , int ngroups, int r_lo, int r_hi) {
    const int tid = opaque_tid(), lane = tid & 63, wave = __builtin_amdgcn_readfirstlane(tid >> 6);
    LAS float* scr = (LAS float*)(lds + wave * 16384);
    const int gw = gw0 * NWAVES + wave, NGW = ngroups * NWAVES;
    unsigned char* ws = a.ws;
    constexpr int I_EXP = (D / 64) * (D / 32);
    unsigned char* Wgu_t = ws + WS_WGU; unsigned char* Wdn_t = ws + WS_WDN;
    for (int r = r_lo + gw; r < r_hi; r += NGW) {
        const int e = r / (3 * I_EXP), q = (r % (3 * I_EXP)) / I_EXP, rr = r % I_EXP;
        if (q == 0) p0_transpose_item_f8<2>(a.in[I_WGATE] + (size_t)e * D * D, D, D, Wgu_t + (size_t)e * 2048 * D, scr, rr, lane);
        else if (q == 1) p0_transpose_item_f8<3>(a.in[I_WUP] + (size_t)e * D * D, D, D, Wgu_t + (size_t)e * 2048 * D, scr, rr, lane);
        else p0_transpose_item_f8<0>(a.in[I_WDOWN] + (size_t)e * D * D, D, D, Wdn_t + (size_t)e * D * D, scr, rr, lane);
    }
    __syncthreads();
}

struct RowF { f32x4 v[4]; };
__device__ __forceinline__ void row_load(RowF& r, const float* xrow, int lane) {
    const f32x4* xr = (const f32x4*)xrow + lane;
#pragma unroll
    for (int j = 0; j < 4; ++j) r.v[j] = __builtin_nontemporal_load(xr + 64 * j);
}
__device__ __forceinline__ void norm_mod_row(const RowF& r, bf16_t* orow, const float* gain, const LAS float* sc, const LAS float* sh, int lane) {
    const f32x4* gr = (const f32x4*)gain + lane;
    float s = 0.f;
#pragma unroll
    for (int j = 0; j < 4; ++j) s += (r.v[j].x * r.v[j].x + r.v[j].y * r.v[j].y) + (r.v[j].z * r.v[j].z + r.v[j].w * r.v[j].w);
    const float rstd = 1.0f / sqrtf(wave_sum(s) * (1.f / D) + EPS);
    u32x2* o8 = (u32x2*)orow + lane;
#pragma unroll
    for (int j = 0; j < 4; ++j) { const f32x4 g = gr[64 * j]; const f32x4 c1 = *(const LAS f32x4*)(sc + 4 * lane + 256 * j), h1 = *(const LAS f32x4*)(sh + 4 * lane + 256 * j);
        const f32x4 y = (r.v[j] * rstd) * g; const f32x4 z = y * (c1 + 1.0f) + h1;
        u32x2 w; w.x = pk2(z.x, z.y); w.y = pk2(z.z, z.w); o8[64 * j] = w; }
}
__device__ __forceinline__ void p1_xn(const Args& a, LAS unsigned char* lds, int c, int G) {
    const int tid = opaque_tid(), lane = tid & 63, wave = __builtin_amdgcn_readfirstlane(tid >> 6);
    unsigned char* ws = a.ws;
    const float* MODP = (const float*)(ws + WS_MODP); float* MOD = (float*)(ws + WS_MOD); const float* bada = a.in[I_BADA];
    { const int per = (33 * NMOD + G - 1) / G;
      for (int i = c * per + tid; i < (c + 1) * per && i < 33 * NMOD; i += NTHREADS) { const int r = i / NMOD, n = i - r * NMOD; float s = bada[n];
#pragma unroll
            for (int kc = 0; kc < 16; ++kc) s += MODP[((size_t)kc * 33 + r) * NMOD + n];
            MOD[i] = s; } }
    LAS float* sv = (LAS float*)lds;
    bf16_t* XN = (bf16_t*)(ws + WS_XN);
    const float* X = a.in[I_X]; const float* CTX = a.in[I_CTX]; const float* gain = a.in[I_NPRE_MIX];
    for (int p = c; p < 256; p += G) {
        const int b = p >> 3;
        const int rbase = p * 256 + wave * 32;
        RowF a0, a1;
        row_load(a0, X + (size_t)rbase * D, lane); row_load(a1, X + (size_t)(rbase + 16) * D, lane);
        __syncthreads();
        for (int n = tid; n < 4096; n += NTHREADS) { const int r = (n < 2048) ? b : 32; const int col = n & 2047; float s = bada[col];
#pragma unroll
            for (int kc = 0; kc < 16; ++kc) s += MODP[((size_t)kc * 33 + r) * NMOD + col];
            sv[n] = s; }
        __syncthreads();
        for (int i = 0; i < 16; ++i) {
            RowF n0, n1;
            if (i + 1 < 16) { row_load(n0, X + (size_t)(rbase + i + 1) * D, lane); row_load(n1, X + (size_t)(rbase + 16 + i + 1) * D, lane); }
            else { const int crow = p * 32 + wave * 4; row_load(n0, CTX + (size_t)crow * D, lane); row_load(n1, CTX + (size_t)(crow + 1) * D, lane); }
            norm_mod_row(a0, XN + (size_t)(rbase + i) * D, gain, sv + 1024, sv, lane);
            norm_mod_row(a1, XN + (size_t)(rbase + 16 + i) * D, gain, sv + 1024, sv, lane);
            a0 = n0; a1 = n1;
        }
        {
            const int crow = p * 32 + wave * 4;
            RowF n0, n1;
            row_load(n0, CTX + (size_t)(crow + 2) * D, lane); row_load(n1, CTX + (size_t)(crow + 3) * D, lane);
            norm_mod_row(a0, XN + (size_t)(M + crow) * D, gain, sv + 3072, sv + 2048, lane);
            norm_mod_row(a1, XN + (size_t)(M + crow + 1) * D, gain, sv + 3072, sv + 2048, lane);
            norm_mod_row(n0, XN + (size_t)(M + crow + 2) * D, gain, sv + 3072, sv + 2048, lane);
            norm_mod_row(n1, XN + (size_t)(M + crow + 3) * D, gain, sv + 3072, sv + 2048, lane);
        }
    }
}

namespace att {
constexpr int KP = 272, KBUF = 64 * KP, VBUF = 16384;
constexpr int OFF_K = 0, OFF_V = 2 * KBUF, OFF_WSF = OFF_V + 2 * VBUF, OFF_END = OFF_WSF + NWAVES * 256;
static_assert(OFF_WSF >= 65536 && OFF_END <= RING_BYTES, "attention LDS map");
constexpr int NT = TK / 64;
constexpr float THR = 8.0f;
__device__ __forceinline__ int crow(int r, int hi) { return (r & 3) + 8 * (r >> 2) + 4 * hi; }
__device__ __forceinline__ float max3f(float a, float b, float c) { float r; asm("v_max3_f32 %0, %1, %2, %3" : "=v"(r) : "v"(a), "v"(b), "v"(c)); return r; }
__device__ __forceinline__ float max2f(float a, float b) { float r; asm("v_max_f32_e32 %0, %1, %2" : "=v"(r) : "v"(a), "v"(b)); return r; }
__device__ __forceinline__ s16x4 vtr(const LAS unsigned char* p) { return __builtin_bit_cast(s16x4, __builtin_amdgcn_ds_read_tr16_b64_v4i16((LAS s16x4*)p)); }

#define ATT_BAR() asm volatile("s_waitcnt lgkmcnt(0)\n\ts_barrier" ::: "memory")
#define ATT_SB() __builtin_amdgcn_sched_barrier(0)
#define ATT_KLD(i, KF) KF = *(const LAS bf16x8*)(kb_ + ((i) & 1) * (32 * KP) + ((i) >> 1) * 32)
#define ATT_XSTEP(i, KC, KN) do { if ((i) + 2 < 8) { ATT_KLD((i) + 2, KN); } \
    if ((i) == 0) p0 = __builtin_amdgcn_mfma_f32_32x32x16_bf16(KC, qr[0], negref, 0, 0, 0); \
    else if ((i) == 1) p1 = __builtin_amdgcn_mfma_f32_32x32x16_bf16(KC, qr[0], negref, 0, 0, 0); \
    else if (((i) & 1) == 0) p0 = __builtin_amdgcn_mfma_f32_32x32x16_bf16(KC, qr[(i) >> 1], p0, 0, 0, 0); else p1 = __builtin_amdgcn_mfma_f32_32x32x16_bf16(KC, qr[(i) >> 1], p1, 0, 0, 0); ATT_SB(); } while (0)
#define ATT_X(kcur) do { \
    const LAS unsigned char* kb_ = lds + OFF_K + (kcur) * KBUF + koff; \
    bf16x8 ka_, kb2_, kc_; \
    ATT_KLD(0, ka_); ATT_KLD(1, kb2_); \
    ATT_SB(); \
    ATT_XSTEP(0, ka_, kc_); ATT_XSTEP(1, kb2_, ka_); ATT_XSTEP(2, kc_, kb2_); ATT_XSTEP(3, ka_, kc_); \
    ATT_XSTEP(4, kb2_, ka_); ATT_XSTEP(5, kc_, kb2_); ATT_XSTEP(6, ka_, kc_); ATT_XSTEP(7, kb2_, ka_); \
} while (0)
#define ATT_EXP2(i, PWN) do { \
    const float e0_ = __builtin_amdgcn_exp2f((i) < 8 ? p0[2 * ((i) & 7)] : p1[2 * ((i) & 7)]), e1_ = __builtin_amdgcn_exp2f((i) < 8 ? p0[2 * ((i) & 7) + 1] : p1[2 * ((i) & 7) + 1]); \
    sacc_ += e0_ + e1_; PWN[(i) >> 2][(i) & 3] = pk2(e0_, e1_); asm volatile("" : "+v"(PWN[(i) >> 2]), "+v"(sacc_)); } while (0)
#define ATT_VLD(i, LO, HI) do { LO = vtr(vb_ + ((i) & 3) * 4096 + ((i) >> 2) * 1024); HI = vtr(vb_ + ((i) & 3) * 4096 + ((i) >> 2) * 1024 + 512); } while (0)
#define ATT_VF(LO, HI) ((bf16x8){LO[0], LO[1], LO[2], LO[3], HI[0], HI[1], HI[2], HI[3]})
#define ATT_YSTEP(i, PWC, PWN, LC, HC, LN, HN) do { if ((i) + 2 < 16) { ATT_VLD((i) + 2, LN, HN); } \
    o[(i) & 3] = __builtin_amdgcn_mfma_f32_32x32x16_bf16(__builtin_bit_cast(bf16x8, PWC[(i) >> 2]), ATT_VF(LC, HC), o[(i) & 3], 0, 0, 0); \
    ATT_EXP2(i, PWN); ATT_SB(); } while (0)
#define ATT_Y(vcur, PWC, PWN) do { \
    const LAS unsigned char* vb_ = lds + OFF_V + (vcur) * VBUF + voff; \
    float sacc_ = 0.f; s16x4 la_, ha_, lb_, hb_, lc_, hc_; \
    ATT_VLD(0, la_, ha_); ATT_VLD(1, lb_, hb_); ATT_SB(); \
    ATT_YSTEP(0, PWC, PWN, la_, ha_, lc_, hc_); ATT_YSTEP(1, PWC, PWN, lb_, hb_, la_, ha_); ATT_YSTEP(2, PWC, PWN, lc_, hc_, lb_, hb_); \
    ATT_YSTEP(3, PWC, PWN, la_, ha_, lc_, hc_); ATT_YSTEP(4, PWC, PWN, lb_, hb_, la_, ha_); ATT_YSTEP(5, PWC, PWN, lc_, hc_, lb_, hb_); \
    ATT_YSTEP(6, PWC, PWN, la_, ha_, lc_, hc_); ATT_YSTEP(7, PWC, PWN, lb_, hb_, la_, ha_); ATT_YSTEP(8, PWC, PWN, lc_, hc_, lb_, hb_); \
    ATT_YSTEP(9, PWC, PWN, la_, ha_, lc_, hc_); ATT_YSTEP(10, PWC, PWN, lb_, hb_, la_, ha_); ATT_YSTEP(11, PWC, PWN, lc_, hc_, lb_, hb_); \
    ATT_YSTEP(12, PWC, PWN, la_, ha_, lc_, hc_); ATT_YSTEP(13, PWC, PWN, lb_, hb_, la_, ha_); ATT_YSTEP(14, PWC, PWN, lc_, hc_, lb_, hb_); \
    ATT_YSTEP(15, PWC, PWN, la_, ha_, lc_, hc_); \
    l_reg += sacc_; \
} while (0)
#define ATT_Y0(PWN) do { float sacc_ = 0.f; _Pragma("unroll") for (int i = 0; i < 16; ++i) ATT_EXP2(i, PWN); l_reg += sacc_; } while (0)
#define ATT_ZSTEP(i, PWC, LC, HC, LN, HN) do { if ((i) + 2 < 16) { ATT_VLD((i) + 2, LN, HN); } \
    o[(i) & 3] = __builtin_amdgcn_mfma_f32_32x32x16_bf16(__builtin_bit_cast(bf16x8, PWC[(i) >> 2]), ATT_VF(LC, HC), o[(i) & 3], 0, 0, 0); ATT_SB(); } while (0)
#define ATT_Z(vcur, PWC) do { \
    const LAS unsigned char* vb_ = lds + OFF_V + (vcur) * VBUF + voff; \
    s16x4 la_, ha_, lb_, hb_, lc_, hc_; \
    ATT_VLD(0, la_, ha_); ATT_VLD(1, lb_, hb_); ATT_SB(); \
    ATT_ZSTEP(0, PWC, la_, ha_, lc_, hc_); ATT_ZSTEP(1, PWC, lb_, hb_, la_, ha_); ATT_ZSTEP(2, PWC, lc_, hc_, lb_, hb_); \
    ATT_ZSTEP(3, PWC, la_, ha_, lc_, hc_); ATT_ZSTEP(4, PWC, lb_, hb_, la_, ha_); ATT_ZSTEP(5, PWC, lc_, hc_, lb_, hb_); \
    ATT_ZSTEP(6, PWC, la_, ha_, lc_, hc_); ATT_ZSTEP(7, PWC, lb_, hb_, la_, ha_); ATT_ZSTEP(8, PWC, lc_, hc_, lb_, hb_); \
    ATT_ZSTEP(9, PWC, la_, ha_, lc_, hc_); ATT_ZSTEP(10, PWC, lb_, hb_, la_, ha_); ATT_ZSTEP(11, PWC, lc_, hc_, lb_, hb_); \
    ATT_ZSTEP(12, PWC, la_, ha_, lc_, hc_); ATT_ZSTEP(13, PWC, lb_, hb_, la_, ha_); ATT_ZSTEP(14, PWC, lc_, hc_, lb_, hb_); \
    ATT_ZSTEP(15, PWC, la_, ha_, lc_, hc_); \
} while (0)
#define ATT_STAGE(j) do { \
    if ((j) + 1 < NT) { _Pragma("unroll") for (int i = 0; i < 2; ++i) *(LAS u32x4*)(lds + OFF_K + (((j) + 1) & 1) * KBUF + kdst[i]) = kr[i]; } \
    _Pragma("unroll") for (int i = 0; i < 2; ++i) *(LAS u32x4*)(lds + OFF_V + ((j) & 1) * VBUF + vdst[i]) = vr[i]; \
    if ((j) + 2 < NT) { _Pragma("unroll") for (int i = 0; i < 2; ++i) kr[i] = *(const u32x4*)(Kb + (size_t)((j) + 2) * 64 * 512 + gsrc[i]); } \
    if ((j) + 1 < NT) { _Pragma("unroll") for (int i = 0; i < 2; ++i) vr[i] = *(const u32x4*)(Vb + (size_t)((j) + 1) * 64 * 512 + gsrc[i]); } } while (0)

__device__ __forceinline__ void unit(LAS unsigned char* lds, int b, int h, int qb, const bf16_t* Q, const bf16_t* KA, const bf16_t* VA, bf16_t* MIXIN, const float* subg, float lam, const unsigned* KM) {
    const int tid = opaque_tid(), lane = tid & 63, r32 = lane & 31, hi = lane >> 5;
    const int wid = __builtin_amdgcn_readfirstlane(tid >> 6), w = wid & 3, m = wid >> 2;
    LAS float* wsf = (LAS float*)(lds + OFF_WSF) + wid * 64;
    const int rowQ = b * T + qb * 128 + w * 32;
    bf16x8 qr[4];
#pragma unroll
    for (int d0 = 0; d0 < 4; ++d0) qr[d0] = *(const bf16x8*)(Q + (size_t)(rowQ + r32) * 512 + h * 128 + m * 64 + d0 * 16 + hi * 8);
    const bf16_t* Kb = KA + (size_t)b * TK * 512 + h * 128; const bf16_t* Vb = VA + (size_t)b * TK * 512 + h * 128;
    int gsrc[2], kdst[2], vdst[2];
#pragma unroll
    for (int i = 0; i < 2; ++i) { const int cid = tid + 512 * i, kv = cid >> 4, c16 = cid & 15;
        gsrc[i] = kv * 512 + c16 * 8; kdst[i] = kv * KP + c16 * 16; vdst[i] = (c16 >> 2) * 4096 + (kv >> 4) * 1024 + (kv & 15) * 64 + (c16 & 3) * 16; }
    u32x4 kr[2], vr[2];
#pragma unroll
    for (int i = 0; i < 2; ++i) { kr[i] = *(const u32x4*)(Kb + gsrc[i]); vr[i] = *(const u32x4*)(Vb + gsrc[i]); }
#pragma unroll
    for (int i = 0; i < 2; ++i) *(LAS u32x4*)(lds + OFF_K + kdst[i]) = kr[i];
#pragma unroll
    for (int i = 0; i < 2; ++i) kr[i] = *(const u32x4*)(Kb + (size_t)64 * 512 + gsrc[i]);
    ATT_BAR();
    f32x16 o[4];
#pragma unroll
    for (int d0 = 0; d0 < 4; ++d0) o[d0] = (f32x16){};
    float l_reg = 0.f;
    f32x16 p0, p1, negref;
    {
        const unsigned* km = KM + (b * 8 + h * 2 + m) * 2;
        const float kmax2 = __uint_as_float(km[0]) + __uint_as_float(km[1]);
        float ss = 0.f;
#pragma unroll
        for (int d0 = 0; d0 < 4; ++d0)
#pragma unroll
            for (int i = 0; i < 8; ++i) { const float v = bf2f((unsigned short)qr[d0][i]); ss += v * v; }
        ss += __shfl_xor(ss, 32);
        const float ref = sqrtf(ss * kmax2) * 1.02f;
#pragma unroll
        for (int r = 0; r < 16; ++r) negref[r] = -ref;
    }
    u32x4 pwA[4], pwB[4];
    const int koff = r32 * KP + m * 128 + hi * 16;
    const int voff = ((lane >> 4) & 1) * 32 + (lane & 3) * 8 + (4 * hi + ((lane & 15) >> 2)) * 64;
    ATT_X(0); ATT_STAGE(0); ATT_Y0(pwA); ATT_BAR();
    ATT_X(1); ATT_STAGE(1); ATT_Y(0, pwA, pwB); ATT_BAR();
    for (int j = 2; j < NT; j += 2) {
        ATT_X(0); ATT_STAGE(j); ATT_Y(1, pwB, pwA); ATT_BAR();
        ATT_X(1); ATT_STAGE(j + 1); ATT_Y(0, pwA, pwB); ATT_BAR();
    }
    ATT_Z(1, pwB); ATT_BAR();
    l_reg += __shfl_xor(l_reg, 32);
    if (hi == 0) wsf[32 + r32] = l_reg;
    LDS_WAIT();
    float rli[16];
#pragma unroll
    for (int r = 0; r < 16; ++r) rli[r] = 1.0f / wsf[32 + crow(r, hi)];
    LDS_WAIT();
    LAS float* ex = (LAS float*)lds + w * 4096;
    if (m == 1) {
#pragma unroll
        for (int r = 0; r < 16; ++r)
#pragma unroll
            for (int d0 = 0; d0 < 4; ++d0) ex[crow(r, hi) * 128 + d0 * 32 + r32] = o[d0][r] * rli[r];
    }
    ATT_BAR();
    if (m == 0) {
        float g4[4];
#pragma unroll
        for (int d0 = 0; d0 < 4; ++d0) g4[d0] = subg[d0 * 32 + r32] * (1.0f - LAM_INIT);
#pragma unroll
        for (int r = 0; r < 16; ++r) {
            const int q = crow(r, hi); float x[4]; float ss = 0.f;
#pragma unroll
            for (int d0 = 0; d0 < 4; ++d0) { x[d0] = o[d0][r] * rli[r] - lam * ex[q * 128 + d0 * 32 + r32]; ss += x[d0] * x[d0]; }
#pragma unroll
            for (int off = 1; off < 32; off <<= 1) ss += __shfl_xor(ss, off);
            const float rstd = 1.0f / sqrtf(ss * (1.f / 128.f) + EPS);
            bf16_t* dst = MIXIN + (size_t)(rowQ + q) * 1024 + h * 128 + r32;
#pragma unroll
            for (int d0 = 0; d0 < 4; ++d0) dst[d0 * 32] = (bf16_t)(pk2(x[d0] * rstd * g4[d0], 0.f) & 0xffffu);
        }
    }
    ATT_BAR();
}
#undef ATT_BAR
#undef ATT_X
#undef ATT_EXP2
#undef ATT_Y
#undef ATT_Y0
#undef ATT_Z
#undef ATT_STAGE
#undef ATT_SB
#undef ATT_KLD
#undef ATT_XSTEP
#undef ATT_VLD
#undef ATT_VF
#undef ATT_YSTEP
#undef ATT_ZSTEP
}

__device__ __forceinline__ void p3_conv_attn(const Args& a, LAS unsigned char* lds, int c, int vcu, int G) {
    const int tid = opaque_tid(), lane = tid & 63, wave = __builtin_amdgcn_readfirstlane(tid >> 6);
    unsigned char* ws = a.ws;
    const bf16_t* GB = (const bf16_t*)(ws + WS_GB); const bf16_t* U = (const bf16_t*)(ws + WS_U); bf16_t* MIXIN = (bf16_t*)(ws + WS_MIXIN);
    {
        const float* cw = a.in[I_CONVW]; float w0[8], w1[8], w2[8];
#pragma unroll
        for (int i = 0; i < 8; ++i) { w0[i] = cw[lane * 8 + i]; w1[i] = cw[512 + lane * 8 + i]; w2[i] = cw[1024 + lane * 8 + i]; }
        const int gw = vcu * NWAVES + wave, NGW = G * NWAVES;
        for (int row = gw; row < M; row += NGW) {
            const int t = row & (T - 1);
            const u32x4 z = {0u, 0u, 0u, 0u};
            const u32x4 uc = *(const u32x4*)(U + (size_t)row * 512 + lane * 8);
            const u32x4 up = (t > 0) ? *(const u32x4*)(U + (size_t)(row - 1) * 512 + lane * 8) : z;
            const u32x4 un = (t < T - 1) ? *(const u32x4*)(U + (size_t)(row + 1) * 512 + lane * 8) : z;
            const u32x4 gb = *(const u32x4*)(GB + (size_t)row * 512 + lane * 8);
            u32x4 o;
#pragma unroll
            for (int q = 0; q < 4; ++q) {
                const float y0 = w0[2 * q] * bflo(up[q]) + w1[2 * q] * bflo(uc[q]) + w2[2 * q] * bflo(un[q]);
                const float y1 = w0[2 * q + 1] * bfhi(up[q]) + w1[2 * q + 1] * bfhi(uc[q]) + w2[2 * q + 1] * bfhi(un[q]);
                o[q] = pk2(bflo(gb[q]) * y0, bfhi(gb[q]) * y1);
            }
            *(u32x4*)(MIXIN + (size_t)row * 1024 + 512 + lane * 8) = o;
        }
    }
    float lam;
    { const float p1 = a.in[I_LQ1][lane] * a.in[I_LK1][lane], p2 = a.in[I_LQ2][lane] * a.in[I_LK2][lane];
      lam = __expf(wave_sum(p1)) - __expf(wave_sum(p2)) + LAM_INIT; }
    const bf16_t* Q = (const bf16_t*)(ws + WS_Q); const bf16_t* KA = (const bf16_t*)(ws + WS_K); const bf16_t* VA = (const bf16_t*)(ws + WS_V);
    __syncthreads();
    for (int u = vcu * 8; u < 2048; u += G * 8) {
        const int x = (u >> 3) / 32, jj = (u >> 3) % 32;
        for (int i = 0; i < 8; ++i) {
            const int bh = 16 * x + 2 * i + (jj >> 4), qb = jj & 15;
            att::unit(lds, bh >> 2, bh & 3, qb, Q, KA, VA, MIXIN, a.in[I_SUBLN], lam, (const unsigned*)(ws + WS_CTL) + CW_KMAX);
        }
    }
}

struct P5In { f32x4 x[4]; u32x2 m[4]; };
__device__ __forceinline__ void p5_load(P5In& r, int row, int lane, const float* X, const bf16_t* MIX) {
    const f32x4* xr = (const f32x4*)(X + (size_t)row * D) + lane; const u32x2* mr = (const u32x2*)(MIX + (size_t)row * D) + lane;
#pragma unroll
    for (int j = 0; j < 4; ++j) { r.x[j] = __builtin_nontemporal_load(xr + 64 * j); r.m[j] = __builtin_nontemporal_load(mr + 64 * j); }
}
__device__ __forceinline__ float p5_resid(const P5In& r, f32x4 (&h)[4], int row, int lane, const LAS float* mv, const f32x4* npm, bf16_t* H1) {
    f32x4 mx[4]; float s = 0.f;
#pragma unroll
    for (int j = 0; j < 4; ++j) { const u32x2 wv = r.m[j]; mx[j] = (f32x4){bflo(wv.x), bfhi(wv.x), bflo(wv.y), bfhi(wv.y)};
        s += (mx[j].x * mx[j].x + mx[j].y * mx[j].y) + (mx[j].z * mx[j].z + mx[j].w * mx[j].w); }
    const float rstd1 = 1.0f / sqrtf(wave_sum(s) * (1.f / D) + EPS);
    u32x2* hr = (u32x2*)(H1 + (size_t)row * D) + lane; float s2 = 0.f;
#pragma unroll
    for (int j = 0; j < 4; ++j) { const f32x4 g1 = *(const LAS f32x4*)(mv + 4 * lane + 256 * j);
        h[j] = r.x[j] + g1 * ((mx[j] * rstd1) * npm[64 * j]);
        u32x2 wv; wv.x = pk2(h[j].x, h[j].y); wv.y = pk2(h[j].z, h[j].w); __builtin_nontemporal_store(wv, hr + 64 * j);
        s2 += (h[j].x * h[j].x + h[j].y * h[j].y) + (h[j].z * h[j].z + h[j].w * h[j].w); }
    return 1.0f / sqrtf(wave_sum(s2) * (1.f / D) + EPS);
}
__device__ __forceinline__ void p5_rows(const Args& a, LAS unsigned char* lds, int p  ) {
    const int tid = opaque_tid(), lane = tid & 63, wave = __builtin_amdgcn_readfirstlane(tid >> 6);
    unsigned char* ws = a.ws;
    const int b = p >> 3;
    LAS float* wrt = (LAS float*)lds;
    LAS float* mv = (LAS float*)(lds + 65536);
    const float* wr = a.in[I_WROUTER];
    const bf16_t* MIX = (const bf16_t*)(ws + WS_MIX); unsigned char* XN2 = ws + WS_XN; float* AFFT = (float*)(ws + WS_AFFT); bf16_t* H1 = (bf16_t*)(ws + WS_H1);
    const float* X = a.in[I_X];
    const int rbase = p * 256 + wave * 32;
    P5In cA, cB;
    p5_load(cA, rbase, lane, X, MIX); p5_load(cB, rbase + 16, lane, X, MIX);
    for (int n = tid; n < D * NE; n += NTHREADS) { const int k = n >> 4, e = n & 15; wrt[e * D + k] = wr[n]; }
    const float* MOD = (const float*)(ws + WS_MOD) + (size_t)b * NMOD;
    for (int n = tid; n < 3 * D; n += NTHREADS) mv[n] = MOD[2 * D + n];
    __syncthreads();
    const f32x4* npm = (const f32x4*)a.in[I_NPOST_MIX] + lane; const f32x4* npf = (const f32x4*)a.in[I_NPRE_FFN] + lane;
    for (int i = 0; i < 16; ++i) {
        const int rowA = rbase + i, rowB = rbase + 16 + i;
        P5In nA, nB;
        if (i + 1 < 16) { p5_load(nA, rowA + 1, lane, X, MIX); p5_load(nB, rowB + 1, lane, X, MIX); }
        f32x4 hA[4], hB[4];
        const float rsA = p5_resid(cA, hA, rowA, lane, mv, npm, H1);
        const float rsB = p5_resid(cB, hB, rowB, lane, mv, npm, H1);
        unsigned* oA = (unsigned*)(XN2 + (size_t)rowA * D) + lane; unsigned* oB = (unsigned*)(XN2 + (size_t)rowB * D) + lane;
        typedef float f32x2v __attribute__((ext_vector_type(2)));
        f32x2v lg2[16];
#pragma unroll
        for (int e = 0; e < 16; ++e) lg2[e] = (f32x2v){0.f, 0.f};
#pragma unroll
        for (int j = 0; j < 4; ++j) { const f32x4 sh2 = *(const LAS f32x4*)(mv + 1024 + 4 * lane + 256 * j), sc2 = *(const LAS f32x4*)(mv + 2048 + 4 * lane + 256 * j);
            const f32x4 gn = npf[64 * j];
            const f32x4 zA = ((hA[j] * rsA) * gn) * (sc2 + 1.0f) + sh2, zB = ((hB[j] * rsB) * gn) * (sc2 + 1.0f) + sh2;
            { const f32x4 qa = zA * pg8::F8_ACT, qb = zB * pg8::F8_ACT; oA[64 * j] = pg8::pk4_fp8(qa.x, qa.y, qa.z, qa.w); oB[64 * j] = pg8::pk4_fp8(qb.x, qb.y, qb.z, qb.w); }
            const f32x2v zx = {zA.x, zB.x}, zy = {zA.y, zB.y}, zz = {zA.z, zB.z}, zw = {zA.w, zB.w};
#pragma unroll
            for (int e = 0; e < 16; ++e) { const f32x4 wq = *(const LAS f32x4*)(wrt + e * D + 4 * lane + 256 * j);
                lg2[e] = __builtin_elementwise_fma(zx, (f32x2v){wq.x, wq.x}, lg2[e]); lg2[e] = __builtin_elementwise_fma(zy, (f32x2v){wq.y, wq.y}, lg2[e]);
                lg2[e] = __builtin_elementwise_fma(zz, (f32x2v){wq.z, wq.z}, lg2[e]); lg2[e] = __builtin_elementwise_fma(zw, (f32x2v){wq.w, wq.w}, lg2[e]);
                if ((e & 3) == 3) __builtin_amdgcn_sched_barrier(0); } }
        float lg[32];
#pragma unroll
        for (int e = 0; e < 16; ++e) { lg[e] = lg2[e].x; lg[16 + e] = lg2[e].y; }
#pragma unroll
        for (int st = 0; st < 5; ++st) { const int d = 1 << st, cntv = 16 >> st; const bool up = (lane & d) != 0;
#pragma unroll
            for (int q = 0; q < 16; ++q) if (q < cntv) { const float send = up ? lg[2 * q] : lg[2 * q + 1], keep = up ? lg[2 * q + 1] : lg[2 * q]; lg[q] = keep + __shfl_xor(send, d); } }
        float lv = lg[0] + __shfl_xor(lg[0], 32);
        float mxl = lv;
#pragma unroll
        for (int d = 1; d < 16; d <<= 1) mxl = fmaxf(mxl, __shfl_xor(mxl, d));
        const float ev = __expf(lv - mxl); float se = ev;
#pragma unroll
        for (int d = 1; d < 16; d <<= 1) se += __shfl_xor(se, d);
        if (lane < 32) { const int row = (lane < 16) ? rowA : rowB; AFFT[((size_t)b * NE + (lane & 15)) * T + (row & (T - 1))] = ev / se; }
        cA = nA; cB = nB;
    }
}

__device__ __forceinline__ void p6_topk(const Args& a, LAS unsigned char* lds, int c, int G) {
    const int tid = opaque_tid(), lane = tid & 63, wave = __builtin_amdgcn_readfirstlane(tid >> 6);
    unsigned char* ws = a.ws;
    const float* AFFT = (const float*)(ws + WS_AFFT); short* SLOT = (short*)(ws + WS_SLOT); int* IDX = (int*)(ws + WS_IDX); float* GATE = (float*)(ws + WS_GATE);
    LAS unsigned* sv = (LAS unsigned*)(lds + wave * 16384);
    for (int item = c + wave * G; item < NITEM; item += G * NWAVES) {
        const int b = item >> 4, e = item & 15;
        const float* src = AFFT + (size_t)item * T;
#pragma unroll 8
        for (int j = 0; j < 32; ++j) sv[j * 64 + lane] = __float_as_uint(src[j * 64 + lane]);
        LDS_WAIT(); asm volatile("" ::: "memory");
        unsigned pre = 0u;
        for (int bit = 30; bit >= 0; --bit) {
            const unsigned cand = pre | (1u << bit);
            int cnt = 0;
#pragma unroll 4
            for (int j = 0; j < 32; ++j) cnt += (int)__popcll(__ballot(sv[j * 64 + lane] >= cand));
            if (cnt >= CAP) pre = cand;
        }
        int ngt = 0;
#pragma unroll 4
        for (int j = 0; j < 32; ++j) ngt += (int)__popcll(__ballot(sv[j * 64 + lane] > pre));
        const int need_eq = CAP - ngt;
        const unsigned long long ltmask = (1ull << lane) - 1ull;
        int base_gt = 0, base_eq = 0;
#pragma unroll 2
        for (int j = 0; j < 32; ++j) {
            const unsigned vj = sv[j * 64 + lane];
            const bool gt = vj > pre, eq = vj == pre;
            const unsigned long long mg = __ballot(gt), me = __ballot(eq);
            const int pg = base_gt + (int)__popcll(mg & ltmask), pe = base_eq + (int)__popcll(me & ltmask);
            int sl = -1; if (gt) sl = pg; else if (eq && pe < need_eq) sl = ngt + pe;
            const int t = j * 64 + lane;
            SLOT[((size_t)b * T + t) * NE + e] = (short)sl;
            if (sl >= 0) { IDX[item * CAP + sl] = t; GATE[item * CAP + sl] = __uint_as_float(vj); }
            base_gt += (int)__popcll(mg); base_eq += (int)__popcll(me);
        }
        LDS_WAIT(); asm volatile("" ::: "memory");
    }
}

struct P8Row { u32x2 h[4]; unsigned y[4][4]; float wt[4]; unsigned long long rest; int sl; };
__device__ __forceinline__ f32x4 fp8x4_to_f32(unsigned w) { typedef float f2 __attribute__((ext_vector_type(2))); const f2 lo = __builtin_amdgcn_cvt_pk_f32_fp8((int)w, false), hi = __builtin_amdgcn_cvt_pk_f32_fp8((int)w, true); return (f32x4){lo.x, lo.y, hi.x, hi.y}; }
__device__ __forceinline__ void p8_issue(P8Row& r, int row, int lane, const short* SLOT, const unsigned char* Y, const bf16_t* H1) {
    const int b = row >> 11;
    const int s_e = (lane < NE) ? (int)SLOT[(size_t)row * NE + lane] : -1;
    unsigned long long mask = __ballot(s_e >= 0);
    const u32x2* hr = (const u32x2*)(H1 + (size_t)row * D) + lane;
#pragma unroll
    for (int j = 0; j < 4; ++j) r.h[j] = __builtin_nontemporal_load(hr + 64 * j);
#pragma unroll
    for (int q = 0; q < 4; ++q) {
        int e = 0, s = 0; r.wt[q] = 0.f;
        if (mask) { e = (int)__builtin_ctzll(mask); mask &= mask - 1ull; s = __builtin_amdgcn_readlane(s_e, e); r.wt[q] = 1.f; }
        const unsigned* yr = (const unsigned*)(Y + ((size_t)(b * NE + e) * CAP + s) * D) + lane;
#pragma unroll
        for (int j = 0; j < 4; ++j) r.y[q][j] = __builtin_nontemporal_load(yr + 64 * j);
    }
    r.rest = mask; r.sl = s_e;
}
__device__ __forceinline__ void p8_finish(P8Row& r, int row, int lane, const unsigned char* Y, const float* MOD, const f32x4* npo, float* out) {
    const int b = row >> 11;
    f32x4 ff[4];
#pragma unroll
    for (int j = 0; j < 4; ++j) ff[j] = (f32x4){0.f, 0.f, 0.f, 0.f};
#pragma unroll
    for (int q = 0; q < 4; ++q)
#pragma unroll
        for (int j = 0; j < 4; ++j) ff[j] += fp8x4_to_f32(r.y[q][j]) * r.wt[q];
    unsigned long long mask = r.rest;
    while (mask) {
        const int e = (int)__builtin_ctzll(mask); mask &= mask - 1ull; const int s = __builtin_amdgcn_readlane(r.sl, e);
        const unsigned* yr = (const unsigned*)(Y + ((size_t)(b * NE + e) * CAP + s) * D) + lane;
#pragma unroll
        for (int j = 0; j < 4; ++j) ff[j] += fp8x4_to_f32(yr[64 * j]);
    }
#pragma unroll
    for (int j = 0; j < 4; ++j) ff[j] = ff[j] * (1.0f / pg8::F8_Y);
    float s2 = 0.f;
#pragma unroll
    for (int j = 0; j < 4; ++j) s2 += (ff[j].x * ff[j].x + ff[j].y * ff[j].y) + (ff[j].z * ff[j].z + ff[j].w * ff[j].w);
    const float rstd = 1.0f / sqrtf(wave_sum(s2) * (1.f / D) + EPS);
    f32x4* orow = (f32x4*)(out + (size_t)row * D) + lane; const f32x4* g2 = (const f32x4*)(MOD + (size_t)b * NMOD + 5 * D) + lane;
#pragma unroll
    for (int j = 0; j < 4; ++j) { const u32x2 hv = r.h[j]; const f32x4 h = (f32x4){bflo(hv.x), bfhi(hv.x), bflo(hv.y), bfhi(hv.y)};
        __builtin_nontemporal_store(h + g2[64 * j] * ((ff[j] * rstd) * npo[64 * j]), orow + 64 * j); }
}
__device__ __forceinline__ void p8_final(const Args& a, int vcu, int G) {
    const int tid = opaque_tid(), lane = tid & 63, wave = __builtin_amdgcn_readfirstlane(tid >> 6);
    unsigned char* ws = a.ws;
    const short* SLOT = (const short*)(ws + WS_SLOT); const unsigned char* Y = ws + WS_Y; const float* MOD = (const float*)(ws + WS_MOD); const bf16_t* H1 = (const bf16_t*)(ws + WS_H1);
    const f32x4* npo = (const f32x4*)a.in[I_NPOST_FFN] + lane;
    const int gw = vcu * NWAVES + wave, NGW = G * NWAVES;
    for (int row = gw; row < M; row += 2 * NGW) {
        P8Row r0, r1;
        p8_issue(r0, row, lane, SLOT, Y, H1);
        const bool two = row + NGW < M;
        if (two) p8_issue(r1, row + NGW, lane, SLOT, Y, H1);
        p8_finish(r0, row, lane, Y, MOD, npo, a.out);
        if (two) p8_finish(r1, row + NGW, lane, Y, MOD, npo, a.out);
    }
}

__global__ void __launch_bounds__(NTHREADS, 2) fwd_kernel(Args args) {
    extern __shared__ __attribute__((aligned(16))) unsigned char lds_raw[];
    LAS unsigned char* lds = (LAS unsigned char*)lds_raw;
    volatile LAS unsigned* MISC = (volatile LAS unsigned*)(lds + MISC_OFF);
    const int tid = threadIdx.x;
    const int G = gridDim.x, c = blockIdx.x;
    const int vcu = (G % 8 == 0) ? (c % 8) * (G / 8) + c / 8 : c;
    unsigned char* ws = args.ws;
    gu32* ctl = (gu32*)(ws + WS_CTL);
    for (int u = tid; u < (LDS_BYTES - LDSCTL_OFF) / 4; u += NTHREADS) ((LAS unsigned*)(lds + LDSCTL_OFF))[u] = 0u;
    __syncthreads();
    XcdBarrier bar; bar.bar = (unsigned*)(ctl + CW_BAR); bar.x = 0; bar.st = nullptr;
    const int lo = args.ph_lo, hi = args.ph_hi;
    if (hi - lo > 1) bar = xcd_barrier_post((unsigned*)(ctl + CW_BAR), MISC + 8);
#ifndef PHMASK
#define PHMASK 0xff
#endif
#define IN(k) (((PHMASK >> (k)) & 1) && lo <= (k) && (k) < hi)
#define SEAM(k) do { if (IN(k) && IN((k) + 1)) xcd_barrier(bar); } while (0)
#ifndef PROBE_PHASE
#define PROBE_PHASE -1
#endif
#define PB(k) do { if (PROBE_PHASE == (k)) { if (tid == 0) { const unsigned long long t0_ = __builtin_amdgcn_s_memrealtime(); MISC[16] = (unsigned)t0_; MISC[17] = (unsigned)(t0_ >> 32); } } } while (0)
#define PE(k) do { if (PROBE_PHASE == (k)) { if (tid == 0) { const unsigned long long t0_ = ((unsigned long long)MISC[17] << 32) | MISC[16]; const unsigned long long t1_ = __builtin_amdgcn_s_memrealtime(); \
      while (__builtin_amdgcn_s_memrealtime() - t1_ < t1_ - t0_) __builtin_amdgcn_s_sleep(8); } __syncthreads(); } } while (0)

    PB(0); if (IN(0)) { p0_prologue(args, lds, vcu, G); } SEAM(0); PE(0);
    PB(1); if (IN(1)) { p1_xn(args, lds, c, G); inout_weight_copies(args, lds, vcu, G); } SEAM(1); PE(1);
    PB(2); if (IN(2)) {
        pg8::Gemm g{(const bf16_t*)(ws + WS_XN), (const bf16_t*)(ws + WS_WIN), D, nullptr};
        pg8::SchedProj S{G, c};
        pg8::EpiProj E{(bf16_t*)(ws + WS_Q), (bf16_t*)(ws + WS_K), (bf16_t*)(ws + WS_V), (bf16_t*)(ws + WS_GB), (bf16_t*)(ws + WS_U), (const float*)(ws + WS_TAB), (unsigned*)(ws + WS_CTL) + CW_KMAX};
        pg8::gemm_phase<pg8::EpiProj, pg8::SchedProj, true, true>(lds, g, S, E);
        if (c >= 128) expert_weight_copies(args, lds, c - 128, G - 128, 0, 9216);
    } SEAM(2); PE(2);
    PB(3); if (IN(3)) { if (c & 1) expert_weight_copies(args, lds, vcu, G, 9216, 24576); p3_conv_attn(args, lds, c, vcu, G); if (!(c & 1)) expert_weight_copies(args, lds, vcu, G, 9216, 24576); } SEAM(3); PE(3);
    PB(4); if (IN(4)) {
        {
            const int p = c;
#ifndef NO_P4
            pg8::Gemm g{(const bf16_t*)(ws + WS_MIXIN), (const bf16_t*)(ws + WS_WOUT), D, nullptr};
            pg8::SchedPanel S{p, 4};
            pg8::EpiBf16 E{(bf16_t*)(ws + WS_MIX), D};
            pg8::gemm_phase<pg8::EpiBf16, pg8::SchedPanel, true, true>(lds, g, S, E);
#endif
            VM_WAIT(); __syncthreads();
#ifndef NO_P5
            p5_rows(args, lds, p);
#endif
            __syncthreads();
        }
    } SEAM(4); PE(4);
    PB(5); if (IN(5)) { p6_topk(args, lds, c, G); } SEAM(5); PE(5);
    PB(6); if (IN(6)) {
#pragma unroll 1
        for (int it = 0; it < 2; ++it) {
            {
                const int item = 2 * c + it;
                const int b = item >> 4, e = item & 15;
#ifndef NO_G1
                if (it == 0) PB(8);
                {
                    pg8::Gemm g{(const bf16_t*)(ws + WS_XN + (size_t)b * T * D), (const bf16_t*)(ws + WS_WGU + (size_t)e * 2048 * D), D, (const int*)(ws + WS_IDX) + item * CAP};
                    pg8::SchedPanel S{0, 8};
                    pg8::EpiGU8 E{ws + WS_HMID + (size_t)item * CAP * D};
                    pg8::gemm_phase<pg8::EpiGU8, pg8::SchedPanel, true, true, true, true>(lds, g, S, E);
                }
#endif
                VM_WAIT(); __syncthreads();
                if (it == 0) { PE(8); PB(9); }
#ifndef NO_G2
                {
                    pg8::Gemm g{(const bf16_t*)(ws + WS_HMID + (size_t)item * CAP * D), (const bf16_t*)(ws + WS_WDN + (size_t)e * D * D), D, nullptr};
                    pg8::SchedPanel S{0, 4};
                    pg8::EpiDown8 E{ws + WS_Y + (size_t)item * CAP * D, (const float*)(ws + WS_GATE) + item * CAP, pg8::F8_INV * pg8::F8_Y};
                    pg8::gemm_phase<pg8::EpiDown8, pg8::SchedPanel, true, true, false, true>(lds, g, S, E);
                }
#endif
                VM_WAIT(); __syncthreads();
                if (it == 0) PE(9);
            }
        }
    } SEAM(6); PE(6);
    PB(7); if (IN(7)) { p8_final(args, vcu, G); } PE(7);
#undef IN
#undef SEAM
}

extern "C" void kernel_launch(void* const* d_in, const int* in_sizes, int n_in, void* d_out, int out_size, void* d_ws, size_t ws_size, hipStream_t stream) {
    static int grid = 0;
    if (grid == 0) {
        if (n_in != 22 || in_sizes[0] != M * D || out_size != M * D || ws_size < WS_END) { fprintf(stderr, "kernel_launch: unexpected shapes (n_in %d, in0 %d, out %d, ws %zu)\n", n_in, n_in > 0 ? in_sizes[0] : -1, out_size, ws_size); grid = -1; return; }
        int dev = 0, cus = 0;
        if (hipGetDevice(&dev) != hipSuccess || hipDeviceGetAttribute(&cus, hipDeviceAttributeMultiprocessorCount, dev) != hipSuccess) { grid = -1; return; }
        if (hipFuncSetAttribute((const void*)fwd_kernel, hipFuncAttributeMaxDynamicSharedMemorySize, LDS_BYTES) != hipSuccess) { fprintf(stderr, "kernel_launch: hipFuncSetAttribute failed\n"); grid = -1; return; }
        (void)hipGetLastError();
        grid = cus;
        if (grid != 256) { fprintf(stderr, "kernel_launch: this kernel needs a 256-CU device (got %d)\n", cus); grid = -1; return; }
    }
    if (grid < 0) return;
    (void)hipMemsetAsync((char*)d_ws + WS_CTL, 0, CTL_ZERO_BYTES, stream);
    Args a{};
    for (int i = 0; i < 22; ++i) a.in[i] = (const float*)d_in[i];
    a.out = (float*)d_out; a.ws = (unsigned char*)d_ws;
    constexpr int NPH = 8;
    if (MK_N_LAUNCHES == 1) { a.ph_lo = 0; a.ph_hi = NPH; hipLaunchKernelGGL(fwd_kernel, dim3(grid), dim3(NTHREADS), LDS_BYTES, stream, a); }
    else { for (int k = 0; k < NPH; ++k) { a.ph_lo = k; a.ph_hi = k + 1; hipLaunchKernelGGL(fwd_kernel, dim3(grid), dim3(NTHREADS), LDS_BYTES, stream, a); } }
}
```

```cpp
#include <hip/hip_runtime.h>
#include <cstdio>
#include <cstdint>

#ifndef MK_N_LAUNCHES
#define MK_N_LAUNCHES 1
#endif

#define LAS __attribute__((address_space(3)))
#define GAS __attribute__((address_space(1)))
typedef unsigned short bf16_t;
typedef short bf16x8 __attribute__((ext_vector_type(8)));
typedef short s16x4 __attribute__((ext_vector_type(4)));
typedef float f32x4 __attribute__((ext_vector_type(4)));
typedef float f32x16 __attribute__((ext_vector_type(16)));
typedef unsigned u32x4 __attribute__((ext_vector_type(4)));
typedef unsigned u32x2 __attribute__((ext_vector_type(2)));

constexpr int NB = 32, T = 2048, D = 1024, TC = 256, M = NB * T, MC = NB * TC, MA = M + MC, TK = TC + T;
constexpr int NE = 16, CAP = 256, NITEM = NB * NE, NPROJ = 3072, NMOD = 6 * D;
constexpr float EPS = 1e-6f;
constexpr float C2 = 0.125f * 1.4426950408889634f;
constexpr float LAM_INIT = 0.2f;
constexpr int NWAVES = 8, NTHREADS = 512;

constexpr size_t MiB = 1u << 20;
constexpr size_t WS_CTL = 0, CTL_ZERO_BYTES = 1 * MiB;
constexpr size_t WS_MODP = 2 * MiB;
constexpr size_t WS_MOD = 16 * MiB;
constexpr size_t WS_TAB = 17 * MiB;
constexpr size_t WS_WIN = 18 * MiB;
constexpr size_t WS_WOUT = 24 * MiB;
constexpr size_t WS_WGU = 26 * MiB;
constexpr size_t WS_WDN = 90 * MiB;
constexpr size_t WS_AFFT = 122 * MiB;
constexpr size_t WS_SLOT = 126 * MiB;
constexpr size_t WS_IDX = 128 * MiB;
constexpr size_t WS_GATE = 129 * MiB;
constexpr size_t WS_XN = 130 * MiB;
constexpr size_t WS_Q = 274 * MiB;
constexpr size_t WS_K = 338 * MiB;
constexpr size_t WS_V = 410 * MiB;
constexpr size_t WS_GB = 482 * MiB;
constexpr size_t WS_U = 546 * MiB;
constexpr size_t WS_MIXIN = 610 * MiB;
constexpr size_t WS_MIX = 738 * MiB;
constexpr size_t WS_HMID = 274 * MiB;
constexpr size_t WS_Y = 610 * MiB;
constexpr size_t WS_H1 = 866 * MiB;
constexpr size_t WS_END = 994 * MiB;

__device__ __forceinline__ int opaque_tid() { int t = threadIdx.x; asm volatile("" : "+v"(t)); return t; }

namespace pg8 {
constexpr int BM = 256, BK = 64, HALF = 128, HTB = HALF * BK * 2, STAGE_BYTES = 8 * HTB;
__host__ __device__ __forceinline__ int lds_byte(int r, int c) { const int st = (r >> 4) * 2 + (c >> 5), rr = r & 15, cc = c & 31, ob = rr * 64 + cc * 2; return st * 1024 + (ob ^ (((ob >> 9) & 1) << 5)); }
__host__ __device__ __forceinline__ void stage_rc(int b, int& R, int& C) { const int st = b / 1024, sb = b % 1024, swz = sb ^ (((sb >> 9) & 1) << 5); R = (st >> 1) * 16 + swz / 64; C = (st & 1) * 32 + (swz % 64) / 2; }
__host__ __device__ __forceinline__ int perm32(int rho) { const int n = rho >> 4, i = rho & 15; return 8 * (i >> 2) + 4 * n + (i & 3); }

struct Unit { int pm, pn; };
struct Gemm { const bf16_t* A; const bf16_t* Bt; int K; const int* gidx; };

typedef float f32x2_t __attribute__((ext_vector_type(2))); typedef __bf16 bf16x2_t __attribute__((ext_vector_type(2)));
__device__ __forceinline__ unsigned cvt_pk_bf16(float lo, float hi) { const f32x2_t v = {lo, hi}; const bf16x2_t b = __builtin_convertvector(v, bf16x2_t); return __builtin_bit_cast(unsigned, b); }

struct EpiBf16 {
    static constexpr bool PERM = true, AFTER_DRAIN = false;
    bf16_t* O; int ldc;
    __device__ __forceinline__ void operator()(const f32x4 (&acc)[2][2][4][2], const Unit& u, int wr, int wc, int fr, int fq) const {
        const int row0 = u.pm * BM + wr * 64 + fr; const int col0 = u.pn * BM + wc * 32 + 8 * fq;
#pragma unroll
        for (int ai = 0; ai < 2; ++ai)
#pragma unroll
            for (int m = 0; m < 4; ++m) { bf16_t* rowp = O + (size_t)(row0 + ai * HALF + m * 16) * ldc + col0;
#pragma unroll
                for (int bj = 0; bj < 2; ++bj) { const f32x4 v0 = acc[ai][bj][m][0], v1 = acc[ai][bj][m][1];
                    u32x4 w; w.x = cvt_pk_bf16(v0[0], v0[1]); w.y = cvt_pk_bf16(v0[2], v0[3]); w.z = cvt_pk_bf16(v1[0], v1[1]); w.w = cvt_pk_bf16(v1[2], v1[3]);
                    *(u32x4*)(rowp + bj * HALF) = w; } }
    }
};

struct EpiProj {
    static constexpr bool PERM = true, AFTER_DRAIN = false;
    bf16_t *Q, *KA, *VA, *GB, *U; const float* tab;
    unsigned* kmaxh;
    __device__ __forceinline__ void operator()(const f32x4 (&acc)[2][2][4][2], const Unit& u, int wr, int wc, int fr, int fq) const {
        const int pn = u.pn; const bool ctx = u.pm >= 256;
        float km[2] = {0.f, 0.f};
#pragma unroll
        for (int ai = 0; ai < 2; ++ai)
#pragma unroll
            for (int m = 0; m < 4; ++m) {
                const int row = u.pm * BM + ai * HALF + wr * 64 + m * 16 + fr;
                int t, kvrow;
                if (!ctx) { const int b = row >> 11; t = row & 2047; kvrow = b * TK + TC + t; }
                else { const int rc = row - M; const int b = rc >> 8; t = 0; kvrow = b * TK + (rc & 255); }
                if (pn < 4) {
                    f32x4 cs0 = {1.f, 0.f, 1.f, 0.f}, cs1 = cs0, cs2 = cs0, cs3 = cs0;
                    if (!ctx) { const float* tp = tab + ((size_t)t * 32 + 16 * (wc & 1) + 4 * fq) * 2;
                        cs0 = *(const f32x4*)(tp); cs1 = *(const f32x4*)(tp + 4); }
                    (void)cs2; (void)cs3;
#pragma unroll
                    for (int bj = 0; bj < 2; ++bj) {
                        const f32x4 v0 = acc[ai][bj][m][0], v1 = acc[ai][bj][m][1];
                        float e0 = v0[0], o0 = v0[1], e1 = v0[2], o1 = v0[3], e2 = v1[0], o2 = v1[1], e3 = v1[2], o3 = v1[3];
                        if (pn >= 2) {
                            float ss = ((e0 * e0 + o0 * o0) + (e1 * e1 + o1 * o1)) + ((e2 * e2 + o2 * o2) + (e3 * e3 + o3 * o3));
                            ss += __shfl_xor(ss, 16); ss += __shfl_xor(ss, 32); km[bj] = fmaxf(km[bj], ss); }
                        float r0 = e0 * cs0[0] - o0 * cs0[1], s0 = o0 * cs0[0] + e0 * cs0[1];
                        float r1 = e1 * cs0[2] - o1 * cs0[3], s1 = o1 * cs0[2] + e1 * cs0[3];
                        float r2 = e2 * cs1[0] - o2 * cs1[1], s2 = o2 * cs1[0] + e2 * cs1[1];
                        float r3 = e3 * cs1[2] - o3 * cs1[3], s3 = o3 * cs1[2] + e3 * cs1[3];
                        const float sc = (pn < 2) ? C2 : 1.f;
                        u32x4 w; w.x = cvt_pk_bf16(r0 * sc, s0 * sc); w.y = cvt_pk_bf16(r1 * sc, s1 * sc); w.z = cvt_pk_bf16(r2 * sc, s2 * sc); w.w = cvt_pk_bf16(r3 * sc, s3 * sc);
                        const int col = (pn & 1) * 256 + bj * HALF + wc * 32 + 8 * fq;
                        bf16_t* dst = (pn < 2) ? (Q + (size_t)row * 512 + col) : (KA + (size_t)kvrow * 512 + col);
                        *(u32x4*)dst = w;
                    }
                } else if (pn < 8) {
#pragma unroll
                    for (int bj = 0; bj < 2; ++bj) {
                        const f32x4 v0 = acc[ai][bj][m][0], v1 = acc[ai][bj][m][1];
                        u32x4 w; w.x = cvt_pk_bf16(v0[0], v0[1]); w.y = cvt_pk_bf16(v0[2], v0[3]); w.z = cvt_pk_bf16(v1[0], v1[1]); w.w = cvt_pk_bf16(v1[2], v1[3]);
                        const int col = (pn & 1) * 256 + bj * HALF + wc * 32 + 8 * fq;
                        bf16_t* dst = (pn < 6) ? (VA + (size_t)kvrow * 512 + col) : (GB + (size_t)row * 512 + col);
                        *(u32x4*)dst = w;
                    }
                } else {
                    const f32x4 a0 = acc[ai][0][m][0], a1 = acc[ai][0][m][1], b0 = acc[ai][1][m][0], b1 = acc[ai][1][m][1];
                    u32x4 w; w.x = cvt_pk_bf16(a0[0] * b0[0], a0[1] * b0[1]); w.y = cvt_pk_bf16(a0[2] * b0[2], a0[3] * b0[3]);
                    w.z = cvt_pk_bf16(a1[0] * b1[0], a1[1] * b1[1]); w.w = cvt_pk_bf16(a1[2] * b1[2], a1[3] * b1[3]);
                    const int col = (pn - 8) * 128 + wc * 32 + 8 * fq;
                    *(u32x4*)(U + (size_t)row * 512 + col) = w;
                }
            }
        if (pn == 2 || pn == 3) {
            const int b = ctx ? (u.pm - 256) : (u.pm >> 3);
#pragma unroll
            for (int bj = 0; bj < 2; ++bj) { float v = km[bj];
#pragma unroll
                for (int d = 1; d < 16; d <<= 1) v = fmaxf(v, __shfl_xor(v, d));
                if (fr == 0 && fq == 0) atomicMax(kmaxh + ((b * 8 + (pn & 1) * 4 + bj * 2 + (wc >> 1)) * 2 + (wc & 1)), __float_as_uint(v)); }
        }
    }
};

struct EpiGU {
    static constexpr bool PERM = true, AFTER_DRAIN = false;
    bf16_t* H;
    __device__ __forceinline__ float silu(float x) const { return x * __builtin_amdgcn_rcpf(1.f + __expf(-x)); }
    __device__ __forceinline__ void operator()(const f32x4 (&acc)[2][2][4][2], const Unit& u, int wr, int wc, int fr, int fq) const {
#pragma unroll
        for (int ai = 0; ai < 2; ++ai)
#pragma unroll
            for (int m = 0; m < 4; ++m) {
                const int row = ai * HALF + wr * 64 + m * 16 + fr;
                const f32x4 a0 = acc[ai][0][m][0], a1 = acc[ai][0][m][1], b0 = acc[ai][1][m][0], b1 = acc[ai][1][m][1];
                u32x4 w; w.x = cvt_pk_bf16(silu(a0[0]) * b0[0], silu(a0[1]) * b0[1]); w.y = cvt_pk_bf16(silu(a0[2]) * b0[2], silu(a0[3]) * b0[3]);
                w.z = cvt_pk_bf16(silu(a1[0]) * b1[0], silu(a1[1]) * b1[1]); w.w = cvt_pk_bf16(silu(a1[2]) * b1[2], silu(a1[3]) * b1[3]);
                *(u32x4*)(H + (size_t)row * 1024 + u.pn * 128 + wc * 32 + 8 * fq) = w;
            }
    }
};
__device__ __forceinline__ unsigned pk4_fp8(float a, float b, float c, float d) { int w = 0; w = __builtin_amdgcn_cvt_pk_fp8_f32(a, b, w, false); w = __builtin_amdgcn_cvt_pk_fp8_f32(c, d, w, true); return (unsigned)w; }
constexpr float F8_ACT = 4.0f, F8_WGT = 64.0f, F8_INV = 1.0f / (4.0f * 64.0f);
struct EpiGU8 {
    static constexpr bool PERM = true, AFTER_DRAIN = false;
    unsigned char* H;
    __device__ __forceinline__ float hval(float g, float u) const {
        const float e = __builtin_amdgcn_exp2f(g * (-F8_INV * 1.4426950408889634f));
        const float r = __builtin_amdgcn_rcpf(1.f + e);
        return __builtin_amdgcn_fmed3f((g * u) * (r * (F8_INV * F8_INV * F8_ACT)), -448.f, 448.f); }
    __device__ __forceinline__ void operator()(const f32x4 (&acc)[2][2][4][2], const Unit& u, int wr, int wc, int fr, int fq) const {
        asm volatile("" : "+v"(fr));
#pragma unroll
        for (int ai = 0; ai < 2; ++ai)
#pragma unroll
            for (int m = 0; m < 4; ++m) {
                const int row = ai * HALF + wr * 64 + m * 16 + fr;
                const f32x4 a0 = acc[ai][0][m][0], a1 = acc[ai][0][m][1], b0 = acc[ai][1][m][0], b1 = acc[ai][1][m][1];
                u32x2 w; w.x = pk4_fp8(hval(a0[0], b0[0]), hval(a0[1], b0[1]), hval(a0[2], b0[2]), hval(a0[3], b0[3]));
                w.y = pk4_fp8(hval(a1[0], b1[0]), hval(a1[1], b1[1]), hval(a1[2], b1[2]), hval(a1[3], b1[3]));
                *(u32x2*)(H + (size_t)row * 1024 + u.pn * 128 + wc * 32 + 8 * fq) = w;
            }
    }
};
struct EpiDown {
    static constexpr bool PERM = true, AFTER_DRAIN = false;
    bf16_t* Y; const float* gate; float scale;
    __device__ __forceinline__ void operator()(const f32x4 (&acc)[2][2][4][2], const Unit& u, int wr, int wc, int fr, int fq) const {
        asm volatile("" : "+v"(fr));
#pragma unroll
        for (int ai = 0; ai < 2; ++ai)
#pragma unroll
            for (int m = 0; m < 4; ++m) {
                const int row = ai * HALF + wr * 64 + m * 16 + fr; const float g = gate[row] * scale;
#pragma unroll
                for (int bj = 0; bj < 2; ++bj) { const f32x4 v0 = acc[ai][bj][m][0] * g, v1 = acc[ai][bj][m][1] * g;
                    u32x4 w; w.x = cvt_pk_bf16(v0[0], v0[1]); w.y = cvt_pk_bf16(v0[2], v0[3]); w.z = cvt_pk_bf16(v1[0], v1[1]); w.w = cvt_pk_bf16(v1[2], v1[3]);
                    *(u32x4*)(Y + (size_t)row * 1024 + u.pn * BM + bj * HALF + wc * 32 + 8 * fq) = w; }
            }
    }
};

constexpr float F8_Y = 64.0f;
struct EpiDown8 {
    static constexpr bool PERM = true, AFTER_DRAIN = false;
    unsigned char* Y; const float* gate; float scale;
    __device__ __forceinline__ void operator()(const f32x4 (&acc)[2][2][4][2], const Unit& u, int wr, int wc, int fr, int fq) const {
        asm volatile("" : "+v"(fr));
#pragma unroll
        for (int ai = 0; ai < 2; ++ai)
#pragma unroll
            for (int m = 0; m < 4; ++m) {
                const int row = ai * HALF + wr * 64 + m * 16 + fr; const float g = gate[row] * scale;
#pragma unroll
                for (int bj = 0; bj < 2; ++bj) { f32x4 v0 = acc[ai][bj][m][0] * g, v1 = acc[ai][bj][m][1] * g;
#pragma unroll
                    for (int i = 0; i < 4; ++i) { v0[i] = __builtin_amdgcn_fmed3f(v0[i], -448.f, 448.f); v1[i] = __builtin_amdgcn_fmed3f(v1[i], -448.f, 448.f); }
                    u32x2 w; w.x = pk4_fp8(v0[0], v0[1], v0[2], v0[3]); w.y = pk4_fp8(v1[0], v1[1], v1[2], v1[3]);
                    *(u32x2*)(Y + (size_t)row * 1024 + u.pn * BM + bj * HALF + wc * 32 + 8 * fq) = w; }
            }
    }
};

struct SchedProj {
    int G, c;
    __device__ __forceinline__ bool next(int i, Unit& u) const {
        const int L = i * G + c;
        if (L < 3072) { u.pm = L & 255; u.pn = L >> 8; return true; }
        const int j = L - 3072; if (j >= 128) return false;
        u.pm = 256 + (j >> 2); u.pn = 2 + (j & 3); return true;
    }
    __device__ __forceinline__ void a_ready(const Unit&) const {}
    __device__ __forceinline__ void done(const Unit&) const {}
};
struct SchedPanel {
    int pm, ntn;
    __device__ __forceinline__ bool next(int i, Unit& u) const { if (i >= ntn) return false; u.pm = pm; u.pn = i; return true; }
    __device__ __forceinline__ void a_ready(const Unit&) const {}
    __device__ __forceinline__ void done(const Unit&) const {}
};

typedef int i32x4v __attribute__((ext_vector_type(4)));
typedef int i32x8v __attribute__((ext_vector_type(8)));
__device__ __forceinline__ i32x8v cat8(bf16x8 a, bf16x8 b) { const i32x4v x = __builtin_bit_cast(i32x4v, a), y = __builtin_bit_cast(i32x4v, b); return __builtin_shufflevector(x, y, 0, 1, 2, 3, 4, 5, 6, 7); }
template <bool F8> struct Frag;
template <> struct Frag<false> { bf16x8 v[2]; __device__ __forceinline__ void set(bf16x8 a, bf16x8 b) { v[0] = a; v[1] = b; } };
template <> struct Frag<true> { i32x8v v; __device__ __forceinline__ void set(bf16x8 a, bf16x8 b) { v = cat8(a, b); } };
__device__ __forceinline__ f32x4 frag_mma(const Frag<false>& b, const Frag<false>& a, f32x4 c) { c = __builtin_amdgcn_mfma_f32_16x16x32_bf16(b.v[0], a.v[0], c, 0, 0, 0); return __builtin_amdgcn_mfma_f32_16x16x32_bf16(b.v[1], a.v[1], c, 0, 0, 0); }
__device__ __forceinline__ f32x4 frag_mma(const Frag<true>& b, const Frag<true>& a, f32x4 c) {
    const int sc1 = 0x7f7f7f7f;
    asm volatile("v_mfma_scale_f32_16x16x128_f8f6f4 %0, %1, %2, %0, %3, %3 op_sel_hi:[0,0,0]" : "+v"(c) : "v"(b.v), "v"(a.v), "v"(sc1));
    return c; }
template <class Epi, class Sched, bool ALIGN_EPI, bool SP2, bool GATHER = false, bool F8 = false>
__device__ __forceinline__ void gemm_phase(LAS unsigned char* lds, const Gemm g, const Sched& S, const Epi& E) {
    const int tid = opaque_tid(), wid = __builtin_amdgcn_readfirstlane(tid >> 6), lane = tid & 63, wr = wid >> 2, wc = wid & 3, fr = lane & 15, fq = lane >> 4;
    const int K = g.K * (F8 ? 1 : 2), nt = K / 128;
    unsigned voffA[2][2], voffB[2];
#pragma unroll
    for (int i = 0; i < 2; ++i) { int R, C; stage_rc(tid * 16 + i * 8192, R, C); const int Rb = Epi::PERM ? ((R & ~31) + perm32(R & 31)) : R;
        if constexpr (GATHER) { voffA[0][i] = (unsigned)(g.gidx[R] * K + C * 2); voffA[1][i] = (unsigned)(g.gidx[HALF + R] * K + C * 2); }
        else { voffA[0][i] = (unsigned)(R * K + C * 2); voffA[1][i] = voffA[0][i]; }
        voffB[i] = (unsigned)(Rb * K + C * 2); }
    const size_t kstep = (size_t)(BK * 2);
    const size_t hstep = (size_t)HALF * K;
    const size_t hstepA = GATHER ? (size_t)0 : hstep;
    const size_t tstep = 2 * hstep;
    const unsigned ldsw = (unsigned)wid * 1024u;
    const int aoff = F8 ? lds_byte(wr * 64 + fr, (fq >> 1) * 32 + (fq & 1) * 16) : lds_byte(wr * 64 + fr, fq * 8), boff = F8 ? lds_byte(wc * 32 + fr, (fq >> 1) * 32 + (fq & 1) * 16) : lds_byte(wc * 32 + fr, fq * 8);
    const int aoff1 = F8 ? aoff + 16 : aoff + 1024, boff1 = F8 ? boff + 16 : boff + 1024;
#define PG8_SA(b, h) (((b) * 2 + (h)) * HTB)
#define PG8_SB(b, h) ((4 + (b) * 2 + (h)) * HTB)
#define PG8_STAGE(bufoff, gbase, voff) do { _Pragma("unroll") for (int _i = 0; _i < 2; ++_i) \
        __builtin_amdgcn_global_load_lds((const unsigned*)((const char*)(gbase) + (voff)[_i]), (LAS unsigned*)(lds + (bufoff) + ldsw + _i * 8192), 16, 0, 0); } while (0)
#define PG8_LDA(dst, b, h) do { _Pragma("unroll") for (int m = 0; m < 4; ++m) dst[m].set(*(const LAS bf16x8*)(lds + PG8_SA(b, h) + aoff + m * 2048), *(const LAS bf16x8*)(lds + PG8_SA(b, h) + aoff1 + m * 2048)); } while (0)
#define PG8_LDB(dst, b, h) do { _Pragma("unroll") for (int n = 0; n < 2; ++n) dst[n].set(*(const LAS bf16x8*)(lds + PG8_SB(b, h) + boff + n * 2048), *(const LAS bf16x8*)(lds + PG8_SB(b, h) + boff1 + n * 2048)); } while (0)
#define PG8_MMA(ai, bj, At, Bt) do { __builtin_amdgcn_s_setprio(1); _Pragma("unroll") for (int m = 0; m < 4; ++m) _Pragma("unroll") for (int n = 0; n < 2; ++n) \
        acc[ai][bj][m][n] = frag_mma(Bt[n], At[m], acc[ai][bj][m][n]); __builtin_amdgcn_s_setprio(0); } while (0)
#define PG8_WAIT_V(n) asm volatile("s_waitcnt vmcnt(" #n ")" ::: "memory")
#define PG8_WAIT_L(n) asm volatile("s_waitcnt lgkmcnt(" #n ")" ::: "memory")
#define PG8_BAR __builtin_amdgcn_s_barrier()
#define PG8_SCHED __builtin_amdgcn_sched_barrier(0)
    Unit cur, nxt; int ui = 0;
    if (!S.next(0, cur)) return;
    f32x4 acc[2][2][4][2];
#pragma unroll
    for (int a = 0; a < 2; ++a)
#pragma unroll
        for (int b = 0; b < 2; ++b)
#pragma unroll
            for (int m = 0; m < 4; ++m)
#pragma unroll
                for (int n = 0; n < 2; ++n) acc[a][b][m][n] = (f32x4){0.f, 0.f, 0.f, 0.f};
    Frag<F8> At[4], B0[2], B1[2];
    const char* cA = (const char*)g.A + (size_t)cur.pm * tstep; const char* cB = (const char*)g.Bt + (size_t)cur.pn * tstep;
    S.a_ready(cur);
    if constexpr (SP2) {
        PG8_STAGE(PG8_SB(0, 0), cB, voffB); PG8_STAGE(PG8_SB(0, 1), cB + hstep, voffB); PG8_STAGE(PG8_SA(0, 0), cA, voffA[0]); PG8_STAGE(PG8_SA(0, 1), cA + hstepA, voffA[GATHER ? 1 : 0]);
        if (wr == 1) PG8_BAR;
        PG8_WAIT_V(2); PG8_BAR;
        PG8_STAGE(PG8_SB(1, 0), cB + kstep, voffB); PG8_STAGE(PG8_SA(1, 0), cA + kstep, voffA[0]); PG8_STAGE(PG8_SB(1, 1), cB + hstep + kstep, voffB);
        PG8_WAIT_V(6); PG8_BAR;
    } else {
        PG8_STAGE(PG8_SB(0, 0), cB, voffB); PG8_STAGE(PG8_SA(0, 0), cA, voffA[0]); PG8_STAGE(PG8_SB(0, 1), cB + hstep, voffB); PG8_STAGE(PG8_SA(0, 1), cA + hstepA, voffA[GATHER ? 1 : 0]);
        if (wr == 1) PG8_BAR;
        PG8_WAIT_V(4); PG8_BAR;
        PG8_STAGE(PG8_SB(1, 0), cB + kstep, voffB); PG8_STAGE(PG8_SA(1, 0), cA + kstep, voffA[0]); PG8_STAGE(PG8_SB(1, 1), cB + hstep + kstep, voffB);
        PG8_WAIT_V(6); PG8_BAR;
    }
    for (;;) {
        const bool has_next = S.next(ui + 1, nxt);
        const char* nA = has_next ? (const char*)g.A + (size_t)nxt.pm * tstep : cA; const char* nB = has_next ? (const char*)g.Bt + (size_t)nxt.pn * tstep : cB;
#pragma unroll 1
        for (int t = 0; t < nt; t += 2) {
            const bool last = (t == nt - 2);
            if constexpr (F8) { asm volatile("" : "+v"(voffA[0][0]), "+v"(voffA[0][1]), "+v"(voffB[0]), "+v"(voffB[1])); if constexpr (GATHER) asm volatile("" : "+v"(voffA[1][0]), "+v"(voffA[1][1])); }
            const char* a1 = cA + (size_t)(t + 1) * kstep;
            const char* a2 = last ? nA : cA + (size_t)(t + 2) * kstep; const char* b2 = last ? nB : cB + (size_t)(t + 2) * kstep;
            const char* a3 = a2 + kstep; const char* b3 = b2 + kstep;
            if (last && has_next) S.a_ready(nxt);
            if constexpr (SP2) {
            PG8_LDB(B0, 0, 0); PG8_LDB(B1, 0, 1); PG8_SCHED; PG8_LDA(At, 0, 0); PG8_STAGE(PG8_SA(1, 1), a1 + hstepA, voffA[GATHER ? 1 : 0]);
            PG8_WAIT_V(8); PG8_WAIT_L(0); PG8_BAR; PG8_MMA(0, 0, At, B0); PG8_MMA(0, 1, At, B1); PG8_BAR; PG8_SCHED;
            PG8_LDA(At, 0, 1); PG8_STAGE(PG8_SB(0, 0), b2, voffB); PG8_STAGE(PG8_SB(0, 1), b2 + hstep, voffB); PG8_STAGE(PG8_SA(0, 0), a2, voffA[0]);
            PG8_WAIT_V(8); PG8_WAIT_L(0); PG8_BAR; PG8_MMA(1, 0, At, B0); PG8_MMA(1, 1, At, B1); PG8_BAR; PG8_SCHED;
            PG8_LDB(B0, 1, 0); PG8_LDB(B1, 1, 1); PG8_SCHED; PG8_LDA(At, 1, 0); PG8_STAGE(PG8_SA(0, 1), a2 + hstepA, voffA[GATHER ? 1 : 0]);
            PG8_WAIT_V(8); PG8_WAIT_L(0); PG8_BAR; PG8_MMA(0, 0, At, B0); PG8_MMA(0, 1, At, B1); PG8_BAR; PG8_SCHED;
            PG8_LDA(At, 1, 1); PG8_STAGE(PG8_SB(1, 0), b3, voffB); PG8_STAGE(PG8_SB(1, 1), b3 + hstep, voffB); PG8_STAGE(PG8_SA(1, 0), a3, voffA[0]);
            PG8_WAIT_V(8); PG8_WAIT_L(0); PG8_BAR; PG8_MMA(1, 0, At, B0); PG8_MMA(1, 1, At, B1); PG8_BAR; PG8_SCHED;
            } else {
            PG8_LDB(B0, 0, 0); PG8_SCHED; PG8_LDA(At, 0, 0); PG8_STAGE(PG8_SA(1, 1), a1 + hstepA, voffA[GATHER ? 1 : 0]);
            PG8_WAIT_L(8); PG8_BAR; PG8_WAIT_L(0); PG8_MMA(0, 0, At, B0); PG8_BAR; PG8_SCHED;
            PG8_LDB(B1, 0, 1); PG8_STAGE(PG8_SB(0, 0), b2, voffB);
            PG8_BAR; PG8_WAIT_L(0); PG8_MMA(0, 1, At, B1); PG8_BAR;
            PG8_LDA(At, 0, 1); PG8_STAGE(PG8_SA(0, 0), a2, voffA[0]);
            PG8_BAR; PG8_WAIT_L(0); PG8_MMA(1, 0, At, B0); PG8_BAR; PG8_SCHED;
            PG8_STAGE(PG8_SB(0, 1), b2 + hstep, voffB);
            PG8_WAIT_V(6); PG8_BAR; PG8_MMA(1, 1, At, B1); PG8_BAR;
            PG8_LDB(B0, 1, 0); PG8_SCHED; PG8_LDA(At, 1, 0); PG8_STAGE(PG8_SA(0, 1), a2 + hstepA, voffA[GATHER ? 1 : 0]);
            PG8_WAIT_L(8); PG8_BAR; PG8_WAIT_L(0); PG8_MMA(0, 0, At, B0); PG8_BAR; PG8_SCHED;
            PG8_LDB(B1, 1, 1); PG8_STAGE(PG8_SB(1, 0), b3, voffB);
            PG8_BAR; PG8_WAIT_L(0); PG8_MMA(0, 1, At, B1); PG8_BAR;
            PG8_LDA(At, 1, 1); PG8_STAGE(PG8_SA(1, 0), a3, voffA[0]);
            PG8_BAR; PG8_WAIT_L(0); PG8_MMA(1, 0, At, B0); PG8_BAR; PG8_SCHED;
            PG8_STAGE(PG8_SB(1, 1), b3 + hstep, voffB);
            PG8_WAIT_V(6); PG8_BAR; PG8_MMA(1, 1, At, B1); PG8_BAR;
            }
        }
        if constexpr (ALIGN_EPI) { if (wr == 0) PG8_BAR; }
        if constexpr (F8) asm volatile("s_nop 15\n\ts_nop 7" ::: "memory");
        E(acc, cur, wr, wc, fr, fq); S.done(cur);
        if (!has_next) break;
#pragma unroll
        for (int a = 0; a < 2; ++a)
#pragma unroll
            for (int b = 0; b < 2; ++b)
#pragma unroll
                for (int m = 0; m < 4; ++m)
#pragma unroll
                    for (int n = 0; n < 2; ++n) acc[a][b][m][n] = (f32x4){0.f, 0.f, 0.f, 0.f};
        cur = nxt; cA = nA; cB = nB; ++ui;
        if constexpr (ALIGN_EPI) { if (wr == 1) PG8_BAR; }
    }
    PG8_WAIT_V(0);
    if constexpr (!ALIGN_EPI) { if (wr == 0) PG8_BAR; }
    PG8_BAR;
#undef PG8_SA
#undef PG8_SB
#undef PG8_STAGE
#undef PG8_LDA
#undef PG8_LDB
#undef PG8_MMA
#undef PG8_WAIT_V
#undef PG8_WAIT_L
#undef PG8_BAR
#undef PG8_SCHED
}
}

typedef GAS unsigned gu32;
#define RLX_AGENT __ATOMIC_RELAXED, __HIP_MEMORY_SCOPE_AGENT
#define LDS_WAIT() asm volatile("s_waitcnt lgkmcnt(0)" ::: "memory")
#define VM_WAIT() asm volatile("s_waitcnt vmcnt(0)" ::: "memory")
__device__ __forceinline__ unsigned pk2(float lo, float hi) { return pg8::cvt_pk_bf16(lo, hi); }
__device__ __forceinline__ float bf2f(unsigned short h) { return __uint_as_float((unsigned)h << 16); }
__device__ __forceinline__ float bflo(unsigned w) { return __uint_as_float(w << 16); }
__device__ __forceinline__ float bfhi(unsigned w) { return __uint_as_float(w & 0xffff0000u); }
__device__ __forceinline__ float wave_sum(float v) {
    v += __builtin_bit_cast(float, __builtin_amdgcn_update_dpp(0, __builtin_bit_cast(int, v), 0xB1, 0xf, 0xf, true));
    v += __builtin_bit_cast(float, __builtin_amdgcn_update_dpp(0, __builtin_bit_cast(int, v), 0x4E, 0xf, 0xf, true));
    v += __builtin_bit_cast(float, __builtin_amdgcn_update_dpp(0, __builtin_bit_cast(int, v), 0x141, 0xf, 0xf, true));
    v += __builtin_bit_cast(float, __builtin_amdgcn_update_dpp(0, __builtin_bit_cast(int, v), 0x140, 0xf, 0xf, true));
    v += __builtin_bit_cast(float, __builtin_amdgcn_update_dpp(0, __builtin_bit_cast(int, v), 0x142, 0xa, 0xf, false));
    v += __builtin_bit_cast(float, __builtin_amdgcn_update_dpp(0, __builtin_bit_cast(int, v), 0x143, 0xc, 0xf, false));
    return __builtin_bit_cast(float, __builtin_amdgcn_readlane(__builtin_bit_cast(int, v), 63));
}

#define XB_TMO      128
#define XB_XCNT(j)  (256  + 64 * (j))
#define XB_XSUB(j)  (1280 + 64 * (j))
#define XB_XGEN(j)  (2304 + 64 * (j))
#define XB_TOP      3328
#define XB_TOPGEN   3392
#define XCD_BAR_WORDS 3456
#define XB_SPIN_CAP (1u << 18)
__device__ __forceinline__ unsigned xb_ld(unsigned* p)              { return __hip_atomic_load(p, __ATOMIC_RELAXED, __HIP_MEMORY_SCOPE_AGENT); }
__device__ __forceinline__ unsigned xb_add(unsigned* p, unsigned v) { return __hip_atomic_fetch_add(p, v, __ATOMIC_RELAXED, __HIP_MEMORY_SCOPE_AGENT); }
__device__ __forceinline__ unsigned xb_xcc_id() { return (unsigned)__builtin_amdgcn_s_getreg((3 << 11) | 20) & 0xFu; }
#define XB_SPIN(cond, bar) do { unsigned _sp = 0; while (cond) { __builtin_amdgcn_s_sleep(1); \
    if ((++_sp & 255u) == 0u) { if (xb_ld(&(bar)[XB_TMO])) break; if (_sp > XB_SPIN_CAP) { atomicAdd(&(bar)[XB_TMO], 1u); break; } } } } while (0)
struct XcdBarrier { unsigned* bar; unsigned x; volatile LAS unsigned* st; };
__device__ __forceinline__ XcdBarrier xcd_barrier_post(unsigned* bar, volatile LAS unsigned* st) {
    XcdBarrier b; b.bar = bar; b.x = xb_xcc_id(); b.st = st;
    if (threadIdx.x == 0) (void)xb_add(&bar[XB_XCNT(b.x)], 1u);
    return b;
}
__device__ __forceinline__ void xcd_barrier_complete(unsigned* bar, unsigned x, unsigned& nloc, unsigned& nx) {
    const unsigned G = gridDim.x * gridDim.y * gridDim.z;
    unsigned sum, cnt, mine, sp = 0u;
    for (;;) {
        sum = 0u; cnt = 0u; mine = 0u;
#pragma unroll
        for (unsigned j = 0; j < 16; ++j) { const unsigned c = xb_ld(&bar[XB_XCNT(j)]); sum += c; cnt += (c > 0u) ? 1u : 0u; mine = (j == x) ? c : mine; }
        if (sum == G) break;
        __builtin_amdgcn_s_sleep(1);
        if ((++sp & 255u) == 0u) { if (xb_ld(&bar[XB_TMO])) break; if (sp > XB_SPIN_CAP) { atomicAdd(&bar[XB_TMO], 1u); break; } }
    }
    nloc = mine > 0u ? mine : 1u; nx = cnt > 0u ? cnt : 1u;
}
__device__ __forceinline__ void xcd_barrier(const XcdBarrier& b) {
    asm volatile("s_waitcnt vmcnt(0)" ::: "memory");
    __syncthreads();
    if (threadIdx.x == 0) {
        unsigned* bar = b.bar;
        __builtin_amdgcn_s_waitcnt(0);
        unsigned nloc = b.st[0], nx = b.st[1];
        if (nloc == 0u) { xcd_barrier_complete(bar, b.x, nloc, nx); b.st[0] = nloc; b.st[1] = nx; }
        const unsigned old = xb_add(&bar[XB_XSUB(b.x)], 1u);
        const unsigned gen = old / nloc;
        if (old + 1u == (gen + 1u) * nloc) {
            __builtin_amdgcn_fence(__ATOMIC_RELEASE, "agent");
            asm volatile("s_waitcnt vmcnt(0)" ::: "memory");
            const unsigned og = xb_add(&bar[XB_TOP], 1u);
            const unsigned tg = og / nx;
            if (og + 1u == (tg + 1u) * nx) xb_add(&bar[XB_TOPGEN], 1u);
            else XB_SPIN(xb_ld(&bar[XB_TOPGEN]) == tg, bar);
            __builtin_amdgcn_fence(__ATOMIC_ACQUIRE, "agent");
            xb_add(&bar[XB_XGEN(b.x)], 1u);
            asm volatile("s_waitcnt vmcnt(0)" ::: "memory");
        } else {
            XB_SPIN(xb_ld(&bar[XB_XGEN(b.x)]) == gen, bar);
            __builtin_amdgcn_fence(__ATOMIC_ACQUIRE, "agent");
            asm volatile("s_waitcnt vmcnt(0)" ::: "memory");
        }
    }
    __syncthreads();
}

constexpr int RING_BYTES = 131072;
constexpr int LDSCTL_OFF = RING_BYTES, MISC_OFF = LDSCTL_OFF + 320;
constexpr int LDS_BYTES = 147456;
constexpr int CW_BAR = 4096;
constexpr int CW_KMAX = 65536;

struct Args { const float* in[22]; float* out; unsigned char* ws; int ph_lo, ph_hi; };
enum { I_X = 0, I_C, I_CTX, I_CCTX, I_WADA, I_BADA, I_NPRE_MIX, I_NPOST_MIX, I_NPRE_FFN, I_NPOST_FFN, I_WIN, I_CONVW, I_LQ1, I_LK1, I_LQ2, I_LK2, I_SUBLN, I_WOUT, I_WROUTER, I_WGATE, I_WUP, I_WDOWN };

__device__ __forceinline__ void prefetch_slice(const unsigned char* base, int bytes_per_wave, LAS unsigned char* scr, int lane) {
    for (int i = 0; i < bytes_per_wave; i += 1024)
        __builtin_amdgcn_global_load_lds((const unsigned*)(base + i + lane * 16), (LAS unsigned*)scr, 16, 0, 0);
}

__device__ __forceinline__ int win_dest(int n) {
    if (n < 1024) { const int j = n & 63; const int p = ((j >> 5) << 5) + ((j & 15) << 1) + ((j >> 4) & 1); return (n & ~63) + p; }
    if (n < 2048) return n;
    int c = n - 2048; const int isx = c >= 512; c &= 511; return 2048 + ((c >> 7) << 8) + (isx << 7) + (c & 127);
}
template <int MODE>
__device__ __forceinline__ int tr_dest(int n) {
    if (MODE == 0) return n;
    if (MODE == 1) return win_dest(n);
    if (MODE == 2) return ((n >> 7) << 8) + (n & 127);
    return ((n >> 7) << 8) + 128 + (n & 127);
}
template <int MODE>
__device__ __forceinline__ void p0_transpose_item_f8(const float* W, int K, int N, unsigned char* WT, LAS float* scr, int item, int lane) {
    const int nblk = N / 32, kb = item / nblk, nb = item % nblk, k0 = 64 * kb, n0 = 32 * nb;
#pragma unroll 8
    for (int i = 0; i < 32; ++i) { const int kk = 2 * i + (lane >> 5); scr[kk * 33 + (lane & 31)] = __builtin_nontemporal_load(W + (size_t)(k0 + kk) * N + n0 + (lane & 31)) * pg8::F8_WGT; }
    LDS_WAIT(); asm volatile("" ::: "memory");
    const int c = lane & 7;
#pragma unroll
    for (int j = 0; j < 4; ++j) { const int n = (lane >> 3) + 8 * j; const LAS float* s = scr + (8 * c) * 33 + n;
        u32x2 o; o.x = pg8::pk4_fp8(s[0 * 33], s[1 * 33], s[2 * 33], s[3 * 33]); o.y = pg8::pk4_fp8(s[4 * 33], s[5 * 33], s[6 * 33], s[7 * 33]);
        *(GAS u32x2*)(WT + (size_t)tr_dest<MODE>(n0 + n) * K + k0 + 8 * c) = o; }
    LDS_WAIT(); asm volatile("" ::: "memory");
}
template <int MODE>
__device__ __forceinline__ void p0_transpose_item(const float* W, int K, int N, bf16_t* WT, LAS float* scr, int item, int lane) {
    const int nblk = N / 32, kb = item / nblk, nb = item % nblk, k0 = 64 * kb, n0 = 32 * nb;
#pragma unroll 8
    for (int i = 0; i < 32; ++i) { const int kk = 2 * i + (lane >> 5); scr[kk * 33 + (lane & 31)] = W[(size_t)(k0 + kk) * N + n0 + (lane & 31)]; }
    LDS_WAIT(); asm volatile("" ::: "memory");
    const int c = lane & 7;
#pragma unroll
    for (int j = 0; j < 4; ++j) { const int n = (lane >> 3) + 8 * j; const LAS float* s = scr + (8 * c) * 33 + n;
        u32x4 o; o.x = pk2(s[0 * 33], s[1 * 33]); o.y = pk2(s[2 * 33], s[3 * 33]); o.z = pk2(s[4 * 33], s[5 * 33]); o.w = pk2(s[6 * 33], s[7 * 33]);
        *(GAS u32x4*)(WT + (size_t)tr_dest<MODE>(n0 + n) * K + k0 + 8 * c) = o; }
    LDS_WAIT(); asm volatile("" ::: "memory");
}

__device__ __forceinline__ void p0_prologue(const Args& a, LAS unsigned char* lds, int vcu, int G) {
    const int tid = opaque_tid(), lane = tid & 63, wave = __builtin_amdgcn_readfirstlane(tid >> 6);
    LAS float* scr = (LAS float*)(lds + wave * 16384);
    const int gw = vcu * NWAVES + wave, NGW = G * NWAVES;
    unsigned char* ws = a.ws;
    if (gw < 96 * 16) {
        float* MODP = (float*)(ws + WS_MODP);
        const float* wada = a.in[I_WADA];
        for (int it = gw; it < 96 * 16; it += NGW) {
            const int cg = it % 96, kc = it / 96;
            for (int b = 0; b < 33; ++b) { const float v = (b < 32) ? a.in[I_C][b * D + kc * 64 + lane] : a.in[I_CCTX][kc * 64 + lane]; scr[b * 64 + lane] = v / (1.f + __expf(-v)); }
            LDS_WAIT(); asm volatile("" ::: "memory");
            float acc[33];
#pragma unroll
            for (int b = 0; b < 33; ++b) acc[b] = 0.f;
            const float* wp = wada + (size_t)(kc * 64) * NMOD + cg * 64 + lane;
#pragma unroll 2
            for (int k = 0; k < 64; k += 4) {
                const float w0 = __builtin_nontemporal_load(wp + (size_t)(k + 0) * NMOD), w1 = __builtin_nontemporal_load(wp + (size_t)(k + 1) * NMOD),
                            w2 = __builtin_nontemporal_load(wp + (size_t)(k + 2) * NMOD), w3 = __builtin_nontemporal_load(wp + (size_t)(k + 3) * NMOD);
#pragma unroll
                for (int b = 0; b < 33; ++b) { const f32x4 sv4 = *(const LAS f32x4*)(scr + b * 64 + k); acc[b] += (sv4.x * w0 + sv4.y * w1) + (sv4.z * w2 + sv4.w * w3); }
            }
#pragma unroll
            for (int b = 0; b < 33; ++b) MODP[((size_t)kc * 33 + b) * NMOD + cg * 64 + lane] = acc[b];
            LDS_WAIT(); asm volatile("" ::: "memory");
        }
    } else {
        float* tab = (float*)(ws + WS_TAB);
        const int nw = NGW - 96 * 16;
        for (int e = (gw - 96 * 16) * 64 + lane; e < T * 32; e += nw * 64) {
            const int t = e >> 5, i = e & 31;
            const float inv = powf(10000.0f, -(float)(2 * (i & 15)) / 32.0f);
            const float pos = (i < 16) ? (float)(t >> 6) : (float)(t & 63);
            const float ang = pos * inv;
            tab[2 * e] = cosf(ang); tab[2 * e + 1] = sinf(ang);
        }
    }
}
__device__ __forceinline__ void inout_weight_copies(const Args& a, LAS unsigned char* lds, int vcu, int G) {
    const int tid = opaque_tid(), lane = tid & 63, wave = __builtin_amdgcn_readfirstlane(tid >> 6);
    LAS float* scr = (LAS float*)(lds + 16384 + wave * 12288);
    const int gw = vcu * NWAVES + wave, NGW = G * NWAVES;
    unsigned char* ws = a.ws;
    constexpr int I_IN = (D / 64) * (NPROJ / 32), I_OUT = (D / 64) * (D / 32);
    constexpr int NITEMS = I_IN + I_OUT;
    bf16_t* Win_t = (bf16_t*)(ws + WS_WIN); bf16_t* Wout_t = (bf16_t*)(ws + WS_WOUT);
    for (int it = gw; it < NITEMS; it += NGW) {
        int r = it;
        if (r < I_IN) { p0_transpose_item<1>(a.in[I_WIN], D, NPROJ, Win_t, scr, r, lane); continue; } r -= I_IN;
        p0_transpose_item<0>(a.in[I_WOUT], D, D, Wout_t, scr, r, lane);
    }
}
__device__ __forceinline__ void expert_weight_copies(const Args& a, LAS unsigned char* lds, int gw0  , int ngroups, int r_lo, int r_hi) {
    const int tid = opaque_tid(), lane = tid & 63, wave = __builtin_amdgcn_readfirstlane(tid >> 6);
    LAS float* scr = (LAS float*)(lds + wave * 16384);
    const int gw = gw0 * NWAVES + wave, NGW = ngroups * NWAVES;
    unsigned char* ws = a.ws;
    constexpr int I_EXP = (D / 64) * (D / 32);
    unsigned char* Wgu_t = ws + WS_WGU; unsigned char* Wdn_t = ws + WS_WDN;
    for (int r = r_lo + gw; r < r_hi; r += NGW) {
        const int e = r / (3 * I_EXP), q = (r % (3 * I_EXP)) / I_EXP, rr = r % I_EXP;
        if (q == 0) p0_transpose_item_f8<2>(a.in[I_WGATE] + (size_t)e * D * D, D, D, Wgu_t + (size_t)e * 2048 * D, scr, rr, lane);
        else if (q == 1) p0_transpose_item_f8<3>(a.in[I_WUP] + (size_t)e * D * D, D, D, Wgu_t + (size_t)e * 2048 * D, scr, rr, lane);
        else p0_transpose_item_f8<0>(a.in[I_WDOWN] + (size_t)e * D * D, D, D, Wdn_t + (size_t)e * D * D, scr, rr, lane);
    }
    __syncthreads();
}

struct RowF { f32x4 v[4]; };
__device__ __forceinline__ void row_load(RowF& r, const float* xrow, int lane) {
    const f32x4* xr = (const f32x4*)xrow + lane;
#pragma unroll
    for (int j = 0; j < 4; ++j) r.v[j] = __builtin_nontemporal_load(xr + 64 * j);
}
__device__ __forceinline__ void norm_mod_row(const RowF& r, bf16_t* orow, const float* gain, const LAS float* sc, const LAS float* sh, int lane) {
    const f32x4* gr = (const f32x4*)gain + lane;
    float s = 0.f;
#pragma unroll
    for (int j = 0; j < 4; ++j) s += (r.v[j].x * r.v[j].x + r.v[j].y * r.v[j].y) + (r.v[j].z * r.v[j].z + r.v[j].w * r.v[j].w);
    const float rstd = 1.0f / sqrtf(wave_sum(s) * (1.f / D) + EPS);
    u32x2* o8 = (u32x2*)orow + lane;
#pragma unroll
    for (int j = 0; j < 4; ++j) { const f32x4 g = gr[64 * j]; const f32x4 c1 = *(const LAS f32x4*)(sc + 4 * lane + 256 * j), h1 = *(const LAS f32x4*)(sh + 4 * lane + 256 * j);
        const f32x4 y = (r.v[j] * rstd) * g; const f32x4 z = y * (c1 + 1.0f) + h1;
        u32x2 w; w.x = pk2(z.x, z.y); w.y = pk2(z.z, z.w); o8[64 * j] = w; }
}
__device__ __forceinline__ void p1_xn(const Args& a, LAS unsigned char* lds, int c, int G) {
    const int tid = opaque_tid(), lane = tid & 63, wave = __builtin_amdgcn_readfirstlane(tid >> 6);
    unsigned char* ws = a.ws;
    const float* MODP = (const float*)(ws + WS_MODP); float* MOD = (float*)(ws + WS_MOD); const float* bada = a.in[I_BADA];
    { const int per = (33 * NMOD + G - 1) / G;
      for (int i = c * per + tid; i < (c + 1) * per && i < 33 * NMOD; i += NTHREADS) { const int r = i / NMOD, n = i - r * NMOD; float s = bada[n];
#pragma unroll
            for (int kc = 0; kc < 16; ++kc) s += MODP[((size_t)kc * 33 + r) * NMOD + n];
            MOD[i] = s; } }
    LAS float* sv = (LAS float*)lds;
    bf16_t* XN = (bf16_t*)(ws + WS_XN);
    const float* X = a.in[I_X]; const float* CTX = a.in[I_CTX]; const float* gain = a.in[I_NPRE_MIX];
    for (int p = c; p < 256; p += G) {
        const int b = p >> 3;
        const int rbase = p * 256 + wave * 32;
        RowF a0, a1;
        row_load(a0, X + (size_t)rbase * D, lane); row_load(a1, X + (size_t)(rbase + 16) * D, lane);
        __syncthreads();
        for (int n = tid; n < 4096; n += NTHREADS) { const int r = (n < 2048) ? b : 32; const int col = n & 2047; float s = bada[col];
#pragma unroll
            for (int kc = 0; kc < 16; ++kc) s += MODP[((size_t)kc * 33 + r) * NMOD + col];
            sv[n] = s; }
        __syncthreads();
        for (int i = 0; i < 16; ++i) {
            RowF n0, n1;
            if (i + 1 < 16) { row_load(n0, X + (size_t)(rbase + i + 1) * D, lane); row_load(n1, X + (size_t)(rbase + 16 + i + 1) * D, lane); }
            else { const int crow = p * 32 + wave * 4; row_load(n0, CTX + (size_t)crow * D, lane); row_load(n1, CTX + (size_t)(crow + 1) * D, lane); }
            norm_mod_row(a0, XN + (size_t)(rbase + i) * D, gain, sv + 1024, sv, lane);
            norm_mod_row(a1, XN + (size_t)(rbase + 16 + i) * D, gain, sv + 1024, sv, lane);
            a0 = n0; a1 = n1;
        }
        {
            const int crow = p * 32 + wave * 4;
            RowF n0, n1;
            row_load(n0, CTX + (size_t)(crow + 2) * D, lane); row_load(n1, CTX + (size_t)(crow + 3) * D, lane);
            norm_mod_row(a0, XN + (size_t)(M + crow) * D, gain, sv + 3072, sv + 2048, lane);
            norm_mod_row(a1, XN + (size_t)(M + crow + 1) * D, gain, sv + 3072, sv + 2048, lane);
            norm_mod_row(n0, XN + (size_t)(M + crow + 2) * D, gain, sv + 3072, sv + 2048, lane);
            norm_mod_row(n1, XN + (size_t)(M + crow + 3) * D, gain, sv + 3072, sv + 2048, lane);
        }
    }
}

namespace att {
constexpr int KP = 272, KBUF = 64 * KP, VBUF = 16384;
constexpr int OFF_K = 0, OFF_V = 2 * KBUF, OFF_WSF = OFF_V + 2 * VBUF, OFF_END = OFF_WSF + NWAVES * 256;
static_assert(OFF_WSF >= 65536 && OFF_END <= RING_BYTES, "attention LDS map");
constexpr int NT = TK / 64;
constexpr float THR = 8.0f;
__device__ __forceinline__ int crow(int r, int hi) { return (r & 3) + 8 * (r >> 2) + 4 * hi; }
__device__ __forceinline__ float max3f(float a, float b, float c) { float r; asm("v_max3_f32 %0, %1, %2, %3" : "=v"(r) : "v"(a), "v"(b), "v"(c)); return r; }
__device__ __forceinline__ float max2f(float a, float b) { float r; asm("v_max_f32_e32 %0, %1, %2" : "=v"(r) : "v"(a), "v"(b)); return r; }
__device__ __forceinline__ s16x4 vtr(const LAS unsigned char* p) { return __builtin_bit_cast(s16x4, __builtin_amdgcn_ds_read_tr16_b64_v4i16((LAS s16x4*)p)); }

#define ATT_BAR() asm volatile("s_waitcnt lgkmcnt(0)\n\ts_barrier" ::: "memory")
#define ATT_SB() __builtin_amdgcn_sched_barrier(0)
#define ATT_KLD(i, KF) KF = *(const LAS bf16x8*)(kb_ + ((i) & 1) * (32 * KP) + ((i) >> 1) * 32)
#define ATT_XSTEP(i, KC, KN) do { if ((i) + 2 < 8) { ATT_KLD((i) + 2, KN); } \
    if ((i) == 0) p0 = __builtin_amdgcn_mfma_f32_32x32x16_bf16(KC, qr[0], negref, 0, 0, 0); \
    else if ((i) == 1) p1 = __builtin_amdgcn_mfma_f32_32x32x16_bf16(KC, qr[0], negref, 0, 0, 0); \
    else if (((i) & 1) == 0) p0 = __builtin_amdgcn_mfma_f32_32x32x16_bf16(KC, qr[(i) >> 1], p0, 0, 0, 0); else p1 = __builtin_amdgcn_mfma_f32_32x32x16_bf16(KC, qr[(i) >> 1], p1, 0, 0, 0); ATT_SB(); } while (0)
#define ATT_X(kcur) do { \
    const LAS unsigned char* kb_ = lds + OFF_K + (kcur) * KBUF + koff; \
    bf16x8 ka_, kb2_, kc_; \
    ATT_KLD(0, ka_); ATT_KLD(1, kb2_); \
    ATT_SB(); \
    ATT_XSTEP(0, ka_, kc_); ATT_XSTEP(1, kb2_, ka_); ATT_XSTEP(2, kc_, kb2_); ATT_XSTEP(3, ka_, kc_); \
    ATT_XSTEP(4, kb2_, ka_); ATT_XSTEP(5, kc_, kb2_); ATT_XSTEP(6, ka_, kc_); ATT_XSTEP(7, kb2_, ka_); \
} while (0)
#define ATT_EXP2(i, PWN) do { \
    const float e0_ = __builtin_amdgcn_exp2f((i) < 8 ? p0[2 * ((i) & 7)] : p1[2 * ((i) & 7)]), e1_ = __builtin_amdgcn_exp2f((i) < 8 ? p0[2 * ((i) & 7) + 1] : p1[2 * ((i) & 7) + 1]); \
    sacc_ += e0_ + e1_; PWN[(i) >> 2][(i) & 3] = pk2(e0_, e1_); asm volatile("" : "+v"(PWN[(i) >> 2]), "+v"(sacc_)); } while (0)
#define ATT_VLD(i, LO, HI) do { LO = vtr(vb_ + ((i) & 3) * 4096 + ((i) >> 2) * 1024); HI = vtr(vb_ + ((i) & 3) * 4096 + ((i) >> 2) * 1024 + 512); } while (0)
#define ATT_VF(LO, HI) ((bf16x8){LO[0], LO[1], LO[2], LO[3], HI[0], HI[1], HI[2], HI[3]})
#define ATT_YSTEP(i, PWC, PWN, LC, HC, LN, HN) do { if ((i) + 2 < 16) { ATT_VLD((i) + 2, LN, HN); } \
    o[(i) & 3] = __builtin_amdgcn_mfma_f32_32x32x16_bf16(__builtin_bit_cast(bf16x8, PWC[(i) >> 2]), ATT_VF(LC, HC), o[(i) & 3], 0, 0, 0); \
    ATT_EXP2(i, PWN); ATT_SB(); } while (0)
#define ATT_Y(vcur, PWC, PWN) do { \
    const LAS unsigned char* vb_ = lds + OFF_V + (vcur) * VBUF + voff; \
    float sacc_ = 0.f; s16x4 la_, ha_, lb_, hb_, lc_, hc_; \
    ATT_VLD(0, la_, ha_); ATT_VLD(1, lb_, hb_); ATT_SB(); \
    ATT_YSTEP(0, PWC, PWN, la_, ha_, lc_, hc_); ATT_YSTEP(1, PWC, PWN, lb_, hb_, la_, ha_); ATT_YSTEP(2, PWC, PWN, lc_, hc_, lb_, hb_); \
    ATT_YSTEP(3, PWC, PWN, la_, ha_, lc_, hc_); ATT_YSTEP(4, PWC, PWN, lb_, hb_, la_, ha_); ATT_YSTEP(5, PWC, PWN, lc_, hc_, lb_, hb_); \
    ATT_YSTEP(6, PWC, PWN, la_, ha_, lc_, hc_); ATT_YSTEP(7, PWC, PWN, lb_, hb_, la_, ha_); ATT_YSTEP(8, PWC, PWN, lc_, hc_, lb_, hb_); \
    ATT_YSTEP(9, PWC, PWN, la_, ha_, lc_, hc_); ATT_YSTEP(10, PWC, PWN, lb_, hb_, la_, ha_); ATT_YSTEP(11, PWC, PWN, lc_, hc_, lb_, hb_); \
    ATT_YSTEP(12, PWC, PWN, la_, ha_, lc_, hc_); ATT_YSTEP(13, PWC, PWN, lb_, hb_, la_, ha_); ATT_YSTEP(14, PWC, PWN, lc_, hc_, lb_, hb_); \
    ATT_YSTEP(15, PWC, PWN, la_, ha_, lc_, hc_); \
    l_reg += sacc_; \
} while (0)
#define ATT_Y0(PWN) do { float sacc_ = 0.f; _Pragma("unroll") for (int i = 0; i < 16; ++i) ATT_EXP2(i, PWN); l_reg += sacc_; } while (0)
#define ATT_ZSTEP(i, PWC, LC, HC, LN, HN) do { if ((i) + 2 < 16) { ATT_VLD((i) + 2, LN, HN); } \
    o[(i) & 3] = __builtin_amdgcn_mfma_f32_32x32x16_bf16(__builtin_bit_cast(bf16x8, PWC[(i) >> 2]), ATT_VF(LC, HC), o[(i) & 3], 0, 0, 0); ATT_SB(); } while (0)
#define ATT_Z(vcur, PWC) do { \
    const LAS unsigned char* vb_ = lds + OFF_V + (vcur) * VBUF + voff; \
    s16x4 la_, ha_, lb_, hb_, lc_, hc_; \
    ATT_VLD(0, la_, ha_); ATT_VLD(1, lb_, hb_); ATT_SB(); \
    ATT_ZSTEP(0, PWC, la_, ha_, lc_, hc_); ATT_ZSTEP(1, PWC, lb_, hb_, la_, ha_); ATT_ZSTEP(2, PWC, lc_, hc_, lb_, hb_); \
    ATT_ZSTEP(3, PWC, la_, ha_, lc_, hc_); ATT_ZSTEP(4, PWC, lb_, hb_, la_, ha_); ATT_ZSTEP(5, PWC, lc_, hc_, lb_, hb_); \
    ATT_ZSTEP(6, PWC, la_, ha_, lc_, hc_); ATT_ZSTEP(7, PWC, lb_, hb_, la_, ha_); ATT_ZSTEP(8, PWC, lc_, hc_, lb_, hb_); \
    ATT_ZSTEP(9, PWC, la_, ha_, lc_, hc_); ATT_ZSTEP(10, PWC, lb_, hb_, la_, ha_); ATT_ZSTEP(11, PWC, lc_, hc_, lb_, hb_); \
    ATT_ZSTEP(12, PWC, la_, ha_, lc_, hc_); ATT_ZSTEP(13, PWC, lb_, hb_, la_, ha_); ATT_ZSTEP(14, PWC, lc_, hc_, lb_, hb_); \
    ATT_ZSTEP(15, PWC, la_, ha_, lc_, hc_); \
} while (0)
#define ATT_STAGE(j) do { \
    if ((j) + 1 < NT) { _Pragma("unroll") for (int i = 0; i < 2; ++i) *(LAS u32x4*)(lds + OFF_K + (((j) + 1) & 1) * KBUF + kdst[i]) = kr[i]; } \
    _Pragma("unroll") for (int i = 0; i < 2; ++i) *(LAS u32x4*)(lds + OFF_V + ((j) & 1) * VBUF + vdst[i]) = vr[i]; \
    if ((j) + 2 < NT) { _Pragma("unroll") for (int i = 0; i < 2; ++i) kr[i] = *(const u32x4*)(Kb + (size_t)((j) + 2) * 64 * 512 + gsrc[i]); } \
    if ((j) + 1 < NT) { _Pragma("unroll") for (int i = 0; i < 2; ++i) vr[i] = *(const u32x4*)(Vb + (size_t)((j) + 1) * 64 * 512 + gsrc[i]); } } while (0)

__device__ __forceinline__ void unit(LAS unsigned char* lds, int b, int h, int qb, const bf16_t* Q, const bf16_t* KA, const bf16_t* VA, bf16_t* MIXIN, const float* subg, float lam, const unsigned* KM) {
    const int tid = opaque_tid(), lane = tid & 63, r32 = lane & 31, hi = lane >> 5;
    const int wid = __builtin_amdgcn_readfirstlane(tid >> 6), w = wid & 3, m = wid >> 2;
    LAS float* wsf = (LAS float*)(lds + OFF_WSF) + wid * 64;
    const int rowQ = b * T + qb * 128 + w * 32;
    bf16x8 qr[4];
#pragma unroll
    for (int d0 = 0; d0 < 4; ++d0) qr[d0] = *(const bf16x8*)(Q + (size_t)(rowQ + r32) * 512 + h * 128 + m * 64 + d0 * 16 + hi * 8);
    const bf16_t* Kb = KA + (size_t)b * TK * 512 + h * 128; const bf16_t* Vb = VA + (size_t)b * TK * 512 + h * 128;
    int gsrc[2], kdst[2], vdst[2];
#pragma unroll
    for (int i = 0; i < 2; ++i) { const int cid = tid + 512 * i, kv = cid >> 4, c16 = cid & 15;
        gsrc[i] = kv * 512 + c16 * 8; kdst[i] = kv * KP + c16 * 16; vdst[i] = (c16 >> 2) * 4096 + (kv >> 4) * 1024 + (kv & 15) * 64 + (c16 & 3) * 16; }
    u32x4 kr[2], vr[2];
#pragma unroll
    for (int i = 0; i < 2; ++i) { kr[i] = *(const u32x4*)(Kb + gsrc[i]); vr[i] = *(const u32x4*)(Vb + gsrc[i]); }
#pragma unroll
    for (int i = 0; i < 2; ++i) *(LAS u32x4*)(lds + OFF_K + kdst[i]) = kr[i];
#pragma unroll
    for (int i = 0; i < 2; ++i) kr[i] = *(const u32x4*)(Kb + (size_t)64 * 512 + gsrc[i]);
    ATT_BAR();
    f32x16 o[4];
#pragma unroll
    for (int d0 = 0; d0 < 4; ++d0) o[d0] = (f32x16){};
    float l_reg = 0.f;
    f32x16 p0, p1, negref;
    {
        const unsigned* km = KM + (b * 8 + h * 2 + m) * 2;
        const float kmax2 = __uint_as_float(km[0]) + __uint_as_float(km[1]);
        float ss = 0.f;
#pragma unroll
        for (int d0 = 0; d0 < 4; ++d0)
#pragma unroll
            for (int i = 0; i < 8; ++i) { const float v = bf2f((unsigned short)qr[d0][i]); ss += v * v; }
        ss += __shfl_xor(ss, 32);
        const float ref = sqrtf(ss * kmax2) * 1.02f;
#pragma unroll
        for (int r = 0; r < 16; ++r) negref[r] = -ref;
    }
    u32x4 pwA[4], pwB[4];
    const int koff = r32 * KP + m * 128 + hi * 16;
    const int voff = ((lane >> 4) & 1) * 32 + (lane & 3) * 8 + (4 * hi + ((lane & 15) >> 2)) * 64;
    ATT_X(0); ATT_STAGE(0); ATT_Y0(pwA); ATT_BAR();
    ATT_X(1); ATT_STAGE(1); ATT_Y(0, pwA, pwB); ATT_BAR();
    for (int j = 2; j < NT; j += 2) {
        ATT_X(0); ATT_STAGE(j); ATT_Y(1, pwB, pwA); ATT_BAR();
        ATT_X(1); ATT_STAGE(j + 1); ATT_Y(0, pwA, pwB); ATT_BAR();
    }
    ATT_Z(1, pwB); ATT_BAR();
    l_reg += __shfl_xor(l_reg, 32);
    if (hi == 0) wsf[32 + r32] = l_reg;
    LDS_WAIT();
    float rli[16];
#pragma unroll
    for (int r = 0; r < 16; ++r) rli[r] = 1.0f / wsf[32 + crow(r, hi)];
    LDS_WAIT();
    LAS float* ex = (LAS float*)lds + w * 4096;
    if (m == 1) {
#pragma unroll
        for (int r = 0; r < 16; ++r)
#pragma unroll
            for (int d0 = 0; d0 < 4; ++d0) ex[crow(r, hi) * 128 + d0 * 32 + r32] = o[d0][r] * rli[r];
    }
    ATT_BAR();
    if (m == 0) {
        float g4[4];
#pragma unroll
        for (int d0 = 0; d0 < 4; ++d0) g4[d0] = subg[d0 * 32 + r32] * (1.0f - LAM_INIT);
#pragma unroll
        for (int r = 0; r < 16; ++r) {
            const int q = crow(r, hi); float x[4]; float ss = 0.f;
#pragma unroll
            for (int d0 = 0; d0 < 4; ++d0) { x[d0] = o[d0][r] * rli[r] - lam * ex[q * 128 + d0 * 32 + r32]; ss += x[d0] * x[d0]; }
#pragma unroll
            for (int off = 1; off < 32; off <<= 1) ss += __shfl_xor(ss, off);
            const float rstd = 1.0f / sqrtf(ss * (1.f / 128.f) + EPS);
            bf16_t* dst = MIXIN + (size_t)(rowQ + q) * 1024 + h * 128 + r32;
#pragma unroll
            for (int d0 = 0; d0 < 4; ++d0) dst[d0 * 32] = (bf16_t)(pk2(x[d0] * rstd * g4[d0], 0.f) & 0xffffu);
        }
    }
    ATT_BAR();
}
#undef ATT_BAR
#undef ATT_X
#undef ATT_EXP2
#undef ATT_Y
#undef ATT_Y0
#undef ATT_Z
#undef ATT_STAGE
#undef ATT_SB
#undef ATT_KLD
#undef ATT_XSTEP
#undef ATT_VLD
#undef ATT_VF
#undef ATT_YSTEP
#undef ATT_ZSTEP
}

__device__ __forceinline__ void p3_conv_attn(const Args& a, LAS unsigned char* lds, int c, int vcu, int G) {
    const int tid = opaque_tid(), lane = tid & 63, wave = __builtin_amdgcn_readfirstlane(tid >> 6);
    unsigned char* ws = a.ws;
    const bf16_t* GB = (const bf16_t*)(ws + WS_GB); const bf16_t* U = (const bf16_t*)(ws + WS_U); bf16_t* MIXIN = (bf16_t*)(ws + WS_MIXIN);
    {
        const float* cw = a.in[I_CONVW]; float w0[8], w1[8], w2[8];
#pragma unroll
        for (int i = 0; i < 8; ++i) { w0[i] = cw[lane * 8 + i]; w1[i] = cw[512 + lane * 8 + i]; w2[i] = cw[1024 + lane * 8 + i]; }
        const int gw = vcu * NWAVES + wave, NGW = G * NWAVES;
        for (int row = gw; row < M; row += NGW) {
            const int t = row & (T - 1);
            const u32x4 z = {0u, 0u, 0u, 0u};
            const u32x4 uc = *(const u32x4*)(U + (size_t)row * 512 + lane * 8);
            const u32x4 up = (t > 0) ? *(const u32x4*)(U + (size_t)(row - 1) * 512 + lane * 8) : z;
            const u32x4 un = (t < T - 1) ? *(const u32x4*)(U + (size_t)(row + 1) * 512 + lane * 8) : z;
            const u32x4 gb = *(const u32x4*)(GB + (size_t)row * 512 + lane * 8);
            u32x4 o;
#pragma unroll
            for (int q = 0; q < 4; ++q) {
                const float y0 = w0[2 * q] * bflo(up[q]) + w1[2 * q] * bflo(uc[q]) + w2[2 * q] * bflo(un[q]);
                const float y1 = w0[2 * q + 1] * bfhi(up[q]) + w1[2 * q + 1] * bfhi(uc[q]) + w2[2 * q + 1] * bfhi(un[q]);
                o[q] = pk2(bflo(gb[q]) * y0, bfhi(gb[q]) * y1);
            }
            *(u32x4*)(MIXIN + (size_t)row * 1024 + 512 + lane * 8) = o;
        }
    }
    float lam;
    { const float p1 = a.in[I_LQ1][lane] * a.in[I_LK1][lane], p2 = a.in[I_LQ2][lane] * a.in[I_LK2][lane];
      lam = __expf(wave_sum(p1)) - __expf(wave_sum(p2)) + LAM_INIT; }
    const bf16_t* Q = (const bf16_t*)(ws + WS_Q); const bf16_t* KA = (const bf16_t*)(ws + WS_K); const bf16_t* VA = (const bf16_t*)(ws + WS_V);
    __syncthreads();
    for (int u = vcu * 8; u < 2048; u += G * 8) {
        const int x = (u >> 3) / 32, jj = (u >> 3) % 32;
        for (int i = 0; i < 8; ++i) {
            const int bh = 16 * x + 2 * i + (jj >> 4), qb = jj & 15;
            att::unit(lds, bh >> 2, bh & 3, qb, Q, KA, VA, MIXIN, a.in[I_SUBLN], lam, (const unsigned*)(ws + WS_CTL) + CW_KMAX);
        }
    }
}

struct P5In { f32x4 x[4]; u32x2 m[4]; };
__device__ __forceinline__ void p5_load(P5In& r, int row, int lane, const float* X, const bf16_t* MIX) {
    const f32x4* xr = (const f32x4*)(X + (size_t)row * D) + lane; const u32x2* mr = (const u32x2*)(MIX + (size_t)row * D) + lane;
#pragma unroll
    for (int j = 0; j < 4; ++j) { r.x[j] = __builtin_nontemporal_load(xr + 64 * j); r.m[j] = __builtin_nontemporal_load(mr + 64 * j); }
}
__device__ __forceinline__ float p5_resid(const P5In& r, f32x4 (&h)[4], int row, int lane, const LAS float* mv, const f32x4* npm, bf16_t* H1) {
    f32x4 mx[4]; float s = 0.f;
#pragma unroll
    for (int j = 0; j < 4; ++j) { const u32x2 wv = r.m[j]; mx[j] = (f32x4){bflo(wv.x), bfhi(wv.x), bflo(wv.y), bfhi(wv.y)};
        s += (mx[j].x * mx[j].x + mx[j].y * mx[j].y) + (mx[j].z * mx[j].z + mx[j].w * mx[j].w); }
    const float rstd1 = 1.0f / sqrtf(wave_sum(s) * (1.f / D) + EPS);
    u32x2* hr = (u32x2*)(H1 + (size_t)row * D) + lane; float s2 = 0.f;
#pragma unroll
    for (int j = 0; j < 4; ++j) { const f32x4 g1 = *(const LAS f32x4*)(mv + 4 * lane + 256 * j);
        h[j] = r.x[j] + g1 * ((mx[j] * rstd1) * npm[64 * j]);
        u32x2 wv; wv.x = pk2(h[j].x, h[j].y); wv.y = pk2(h[j].z, h[j].w); __builtin_nontemporal_store(wv, hr + 64 * j);
        s2 += (h[j].x * h[j].x + h[j].y * h[j].y) + (h[j].z * h[j].z + h[j].w * h[j].w); }
    return 1.0f / sqrtf(wave_sum(s2) * (1.f / D) + EPS);
}
__device__ __forceinline__ void p5_rows(const Args& a, LAS unsigned char* lds, int p  ) {
    const int tid = opaque_tid(), lane = tid & 63, wave = __builtin_amdgcn_readfirstlane(tid >> 6);
    unsigned char* ws = a.ws;
    const int b = p >> 3;
    LAS float* wrt = (LAS float*)lds;
    LAS float* mv = (LAS float*)(lds + 65536);
    const float* wr = a.in[I_WROUTER];
    const bf16_t* MIX = (const bf16_t*)(ws + WS_MIX); unsigned char* XN2 = ws + WS_XN; float* AFFT = (float*)(ws + WS_AFFT); bf16_t* H1 = (bf16_t*)(ws + WS_H1);
    const float* X = a.in[I_X];
    const int rbase = p * 256 + wave * 32;
    P5In cA, cB;
    p5_load(cA, rbase, lane, X, MIX); p5_load(cB, rbase + 16, lane, X, MIX);
    for (int n = tid; n < D * NE; n += NTHREADS) { const int k = n >> 4, e = n & 15; wrt[e * D + k] = wr[n]; }
    const float* MOD = (const float*)(ws + WS_MOD) + (size_t)b * NMOD;
    for (int n = tid; n < 3 * D; n += NTHREADS) mv[n] = MOD[2 * D + n];
    __syncthreads();
    const f32x4* npm = (const f32x4*)a.in[I_NPOST_MIX] + lane; const f32x4* npf = (const f32x4*)a.in[I_NPRE_FFN] + lane;
    for (int i = 0; i < 16; ++i) {
        const int rowA = rbase + i, rowB = rbase + 16 + i;
        P5In nA, nB;
        if (i + 1 < 16) { p5_load(nA, rowA + 1, lane, X, MIX); p5_load(nB, rowB + 1, lane, X, MIX); }
        f32x4 hA[4], hB[4];
        const float rsA = p5_resid(cA, hA, rowA, lane, mv, npm, H1);
        const float rsB = p5_resid(cB, hB, rowB, lane, mv, npm, H1);
        unsigned* oA = (unsigned*)(XN2 + (size_t)rowA * D) + lane; unsigned* oB = (unsigned*)(XN2 + (size_t)rowB * D) + lane;
        typedef float f32x2v __attribute__((ext_vector_type(2)));
        f32x2v lg2[16];
#pragma unroll
        for (int e = 0; e < 16; ++e) lg2[e] = (f32x2v){0.f, 0.f};
#pragma unroll
        for (int j = 0; j < 4; ++j) { const f32x4 sh2 = *(const LAS f32x4*)(mv + 1024 + 4 * lane + 256 * j), sc2 = *(const LAS f32x4*)(mv + 2048 + 4 * lane + 256 * j);
            const f32x4 gn = npf[64 * j];
            const f32x4 zA = ((hA[j] * rsA) * gn) * (sc2 + 1.0f) + sh2, zB = ((hB[j] * rsB) * gn) * (sc2 + 1.0f) + sh2;
            { const f32x4 qa = zA * pg8::F8_ACT, qb = zB * pg8::F8_ACT; oA[64 * j] = pg8::pk4_fp8(qa.x, qa.y, qa.z, qa.w); oB[64 * j] = pg8::pk4_fp8(qb.x, qb.y, qb.z, qb.w); }
            const f32x2v zx = {zA.x, zB.x}, zy = {zA.y, zB.y}, zz = {zA.z, zB.z}, zw = {zA.w, zB.w};
#pragma unroll
            for (int e = 0; e < 16; ++e) { const f32x4 wq = *(const LAS f32x4*)(wrt + e * D + 4 * lane + 256 * j);
                lg2[e] = __builtin_elementwise_fma(zx, (f32x2v){wq.x, wq.x}, lg2[e]); lg2[e] = __builtin_elementwise_fma(zy, (f32x2v){wq.y, wq.y}, lg2[e]);
                lg2[e] = __builtin_elementwise_fma(zz, (f32x2v){wq.z, wq.z}, lg2[e]); lg2[e] = __builtin_elementwise_fma(zw, (f32x2v){wq.w, wq.w}, lg2[e]);
                if ((e & 3) == 3) __builtin_amdgcn_sched_barrier(0); } }
        float lg[32];
#pragma unroll
        for (int e = 0; e < 16; ++e) { lg[e] = lg2[e].x; lg[16 + e] = lg2[e].y; }
#pragma unroll
        for (int st = 0; st < 5; ++st) { const int d = 1 << st, cntv = 16 >> st; const bool up = (lane & d) != 0;
#pragma unroll
            for (int q = 0; q < 16; ++q) if (q < cntv) { const float send = up ? lg[2 * q] : lg[2 * q + 1], keep = up ? lg[2 * q + 1] : lg[2 * q]; lg[q] = keep + __shfl_xor(send, d); } }
        float lv = lg[0] + __shfl_xor(lg[0], 32);
        float mxl = lv;
#pragma unroll
        for (int d = 1; d < 16; d <<= 1) mxl = fmaxf(mxl, __shfl_xor(mxl, d));
        const float ev = __expf(lv - mxl); float se = ev;
#pragma unroll
        for (int d = 1; d < 16; d <<= 1) se += __shfl_xor(se, d);
        if (lane < 32) { const int row = (lane < 16) ? rowA : rowB; AFFT[((size_t)b * NE + (lane & 15)) * T + (row & (T - 1))] = ev / se; }
        cA = nA; cB = nB;
    }
}

__device__ __forceinline__ void p6_topk(const Args& a, LAS unsigned char* lds, int c, int G) {
    const int tid = opaque_tid(), lane = tid & 63, wave = __builtin_amdgcn_readfirstlane(tid >> 6);
    unsigned char* ws = a.ws;
    const float* AFFT = (const float*)(ws + WS_AFFT); short* SLOT = (short*)(ws + WS_SLOT); int* IDX = (int*)(ws + WS_IDX); float* GATE = (float*)(ws + WS_GATE);
    LAS unsigned* sv = (LAS unsigned*)(lds + wave * 16384);
    for (int item = c + wave * G; item < NITEM; item += G * NWAVES) {
        const int b = item >> 4, e = item & 15;
        const float* src = AFFT + (size_t)item * T;
#pragma unroll 8
        for (int j = 0; j < 32; ++j) sv[j * 64 + lane] = __float_as_uint(src[j * 64 + lane]);
        LDS_WAIT(); asm volatile("" ::: "memory");
        unsigned pre = 0u;
        for (int bit = 30; bit >= 0; --bit) {
            const unsigned cand = pre | (1u << bit);
            int cnt = 0;
#pragma unroll 4
            for (int j = 0; j < 32; ++j) cnt += (int)__popcll(__ballot(sv[j * 64 + lane] >= cand));
            if (cnt >= CAP) pre = cand;
        }
        int ngt = 0;
#pragma unroll 4
        for (int j = 0; j < 32; ++j) ngt += (int)__popcll(__ballot(sv[j * 64 + lane] > pre));
        const int need_eq = CAP - ngt;
        const unsigned long long ltmask = (1ull << lane) - 1ull;
        int base_gt = 0, base_eq = 0;
#pragma unroll 2
        for (int j = 0; j < 32; ++j) {
            const unsigned vj = sv[j * 64 + lane];
            const bool gt = vj > pre, eq = vj == pre;
            const unsigned long long mg = __ballot(gt), me = __ballot(eq);
            const int pg = base_gt + (int)__popcll(mg & ltmask), pe = base_eq + (int)__popcll(me & ltmask);
            int sl = -1; if (gt) sl = pg; else if (eq && pe < need_eq) sl = ngt + pe;
            const int t = j * 64 + lane;
            SLOT[((size_t)b * T + t) * NE + e] = (short)sl;
            if (sl >= 0) { IDX[item * CAP + sl] = t; GATE[item * CAP + sl] = __uint_as_float(vj); }
            base_gt += (int)__popcll(mg); base_eq += (int)__popcll(me);
        }
        LDS_WAIT(); asm volatile("" ::: "memory");
    }
}

struct P8Row { u32x2 h[4]; unsigned y[4][4]; float wt[4]; unsigned long long rest; int sl; };
__device__ __forceinline__ f32x4 fp8x4_to_f32(unsigned w) { typedef float f2 __attribute__((ext_vector_type(2))); const f2 lo = __builtin_amdgcn_cvt_pk_f32_fp8((int)w, false), hi = __builtin_amdgcn_cvt_pk_f32_fp8((int)w, true); return (f32x4){lo.x, lo.y, hi.x, hi.y}; }
__device__ __forceinline__ void p8_issue(P8Row& r, int row, int lane, const short* SLOT, const unsigned char* Y, const bf16_t* H1) {
    const int b = row >> 11;
    const int s_e = (lane < NE) ? (int)SLOT[(size_t)row * NE + lane] : -1;
    unsigned long long mask = __ballot(s_e >= 0);
    const u32x2* hr = (const u32x2*)(H1 + (size_t)row * D) + lane;
#pragma unroll
    for (int j = 0; j < 4; ++j) r.h[j] = __builtin_nontemporal_load(hr + 64 * j);
#pragma unroll
    for (int q = 0; q < 4; ++q) {
        int e = 0, s = 0; r.wt[q] = 0.f;
        if (mask) { e = (int)__builtin_ctzll(mask); mask &= mask - 1ull; s = __builtin_amdgcn_readlane(s_e, e); r.wt[q] = 1.f; }
        const unsigned* yr = (const unsigned*)(Y + ((size_t)(b * NE + e) * CAP + s) * D) + lane;
#pragma unroll
        for (int j = 0; j < 4; ++j) r.y[q][j] = __builtin_nontemporal_load(yr + 64 * j);
    }
    r.rest = mask; r.sl = s_e;
}
__device__ __forceinline__ void p8_finish(P8Row& r, int row, int lane, const unsigned char* Y, const float* MOD, const f32x4* npo, float* out) {
    const int b = row >> 11;
    f32x4 ff[4];
#pragma unroll
    for (int j = 0; j < 4; ++j) ff[j] = (f32x4){0.f, 0.f, 0.f, 0.f};
#pragma unroll
    for (int q = 0; q < 4; ++q)
#pragma unroll
        for (int j = 0; j < 4; ++j) ff[j] += fp8x4_to_f32(r.y[q][j]) * r.wt[q];
    unsigned long long mask = r.rest;
    while (mask) {
        const int e = (int)__builtin_ctzll(mask); mask &= mask - 1ull; const int s = __builtin_amdgcn_readlane(r.sl, e);
        const unsigned* yr = (const unsigned*)(Y + ((size_t)(b * NE + e) * CAP + s) * D) + lane;
#pragma unroll
        for (int j = 0; j < 4; ++j) ff[j] += fp8x4_to_f32(yr[64 * j]);
    }
#pragma unroll
    for (int j = 0; j < 4; ++j) ff[j] = ff[j] * (1.0f / pg8::F8_Y);
    float s2 = 0.f;
#pragma unroll
    for (int j = 0; j < 4; ++j) s2 += (ff[j].x * ff[j].x + ff[j].y * ff[j].y) + (ff[j].z * ff[j].z + ff[j].w * ff[j].w);
    const float rstd = 1.0f / sqrtf(wave_sum(s2) * (1.f / D) + EPS);
    f32x4* orow = (f32x4*)(out + (size_t)row * D) + lane; const f32x4* g2 = (const f32x4*)(MOD + (size_t)b * NMOD + 5 * D) + lane;
#pragma unroll
    for (int j = 0; j < 4; ++j) { const u32x2 hv = r.h[j]; const f32x4 h = (f32x4){bflo(hv.x), bfhi(hv.x), bflo(hv.y), bfhi(hv.y)};
        __builtin_nontemporal_store(h + g2[64 * j] * ((ff[j] * rstd) * npo[64 * j]), orow + 64 * j); }
}
__device__ __forceinline__ void p8_final(const Args& a, int vcu, int G) {
    const int tid = opaque_tid(), lane = tid & 63, wave = __builtin_amdgcn_readfirstlane(tid >> 6);
    unsigned char* ws = a.ws;
    const short* SLOT = (const short*)(ws + WS_SLOT); const unsigned char* Y = ws + WS_Y; const float* MOD = (const float*)(ws + WS_MOD); const bf16_t* H1 = (const bf16_t*)(ws + WS_H1);
    const f32x4* npo = (const f32x4*)a.in[I_NPOST_FFN] + lane;
    const int gw = vcu * NWAVES + wave, NGW = G * NWAVES;
    for (int row = gw; row < M; row += 4 * NGW) {
        P8Row r0, r1, r2, r3;
        p8_issue(r0, row, lane, SLOT, Y, H1);
        p8_issue(r1, row + NGW, lane, SLOT, Y, H1);
        p8_issue(r2, row + 2 * NGW, lane, SLOT, Y, H1);
        p8_issue(r3, row + 3 * NGW, lane, SLOT, Y, H1);
        p8_finish(r0, row, lane, Y, MOD, npo, a.out);
        p8_finish(r1, row + NGW, lane, Y, MOD, npo, a.out);
        p8_finish(r2, row + 2 * NGW, lane, Y, MOD, npo, a.out);
        p8_finish(r3, row + 3 * NGW, lane, Y, MOD, npo, a.out);
    }
}

__global__ void __launch_bounds__(NTHREADS, 2) fwd_kernel(Args args) {
    extern __shared__ __attribute__((aligned(16))) unsigned char lds_raw[];
    LAS unsigned char* lds = (LAS unsigned char*)lds_raw;
    volatile LAS unsigned* MISC = (volatile LAS unsigned*)(lds + MISC_OFF);
    const int tid = threadIdx.x;
    const int G = gridDim.x, c = blockIdx.x;
    const int vcu = (G % 8 == 0) ? (c % 8) * (G / 8) + c / 8 : c;
    unsigned char* ws = args.ws;
    gu32* ctl = (gu32*)(ws + WS_CTL);
    for (int u = tid; u < (LDS_BYTES - LDSCTL_OFF) / 4; u += NTHREADS) ((LAS unsigned*)(lds + LDSCTL_OFF))[u] = 0u;
    __syncthreads();
    XcdBarrier bar; bar.bar = (unsigned*)(ctl + CW_BAR); bar.x = 0; bar.st = nullptr;
    const int lo = args.ph_lo, hi = args.ph_hi;
    if (hi - lo > 1) bar = xcd_barrier_post((unsigned*)(ctl + CW_BAR), MISC + 8);
#ifndef PHMASK
#define PHMASK 0xff
#endif
#define IN(k) (((PHMASK >> (k)) & 1) && lo <= (k) && (k) < hi)
#define SEAM(k) do { if (IN(k) && IN((k) + 1)) xcd_barrier(bar); } while (0)
#ifndef PROBE_PHASE
#define PROBE_PHASE -1
#endif
#define PB(k) do { if (PROBE_PHASE == (k)) { if (tid == 0) { const unsigned long long t0_ = __builtin_amdgcn_s_memrealtime(); MISC[16] = (unsigned)t0_; MISC[17] = (unsigned)(t0_ >> 32); } } } while (0)
#define PE(k) do { if (PROBE_PHASE == (k)) { if (tid == 0) { const unsigned long long t0_ = ((unsigned long long)MISC[17] << 32) | MISC[16]; const unsigned long long t1_ = __builtin_amdgcn_s_memrealtime(); \
      while (__builtin_amdgcn_s_memrealtime() - t1_ < t1_ - t0_) __builtin_amdgcn_s_sleep(8); } __syncthreads(); } } while (0)

    PB(0); if (IN(0)) { p0_prologue(args, lds, vcu, G); } SEAM(0); PE(0);
    PB(1); if (IN(1)) { p1_xn(args, lds, c, G); inout_weight_copies(args, lds, vcu, G); } SEAM(1); PE(1);
    PB(2); if (IN(2)) {
        pg8::Gemm g{(const bf16_t*)(ws + WS_XN), (const bf16_t*)(ws + WS_WIN), D, nullptr};
        pg8::SchedProj S{G, c};
        pg8::EpiProj E{(bf16_t*)(ws + WS_Q), (bf16_t*)(ws + WS_K), (bf16_t*)(ws + WS_V), (bf16_t*)(ws + WS_GB), (bf16_t*)(ws + WS_U), (const float*)(ws + WS_TAB), (unsigned*)(ws + WS_CTL) + CW_KMAX};
        pg8::gemm_phase<pg8::EpiProj, pg8::SchedProj, true, true>(lds, g, S, E);
        if (c >= 128) expert_weight_copies(args, lds, c - 128, G - 128, 0, 9216);
    } SEAM(2); PE(2);
    PB(3); if (IN(3)) { if (c & 1) expert_weight_copies(args, lds, vcu, G, 9216, 24576); p3_conv_attn(args, lds, c, vcu, G); if (!(c & 1)) expert_weight_copies(args, lds, vcu, G, 9216, 24576); } SEAM(3); PE(3);
    PB(4); if (IN(4)) {
        {
            const int p = c;
#ifndef NO_P4
            pg8::Gemm g{(const bf16_t*)(ws + WS_MIXIN), (const bf16_t*)(ws + WS_WOUT), D, nullptr};
            pg8::SchedPanel S{p, 4};
            pg8::EpiBf16 E{(bf16_t*)(ws + WS_MIX), D};
            pg8::gemm_phase<pg8::EpiBf16, pg8::SchedPanel, true, true>(lds, g, S, E);
#endif
            VM_WAIT(); __syncthreads();
#ifndef NO_P5
            p5_rows(args, lds, p);
#endif
            __syncthreads();
        }
    } SEAM(4); PE(4);
    PB(5); if (IN(5)) { p6_topk(args, lds, c, G); } SEAM(5); PE(5);
    PB(6); if (IN(6)) {
#pragma unroll 1
        for (int it = 0; it < 2; ++it) {
            {
                const int item = 2 * c + it;
                const int b = item >> 4, e = item & 15;
#ifndef NO_G1
                if (it == 0) PB(8);
                {
                    pg8::Gemm g{(const bf16_t*)(ws + WS_XN + (size_t)b * T * D), (const bf16_t*)(ws + WS_WGU + (size_t)e * 2048 * D), D, (const int*)(ws + WS_IDX) + item * CAP};
                    pg8::SchedPanel S{0, 8};
                    pg8::EpiGU8 E{ws + WS_HMID + (size_t)item * CAP * D};
                    pg8::gemm_phase<pg8::EpiGU8, pg8::SchedPanel, true, true, true, true>(lds, g, S, E);
                }
#endif
                VM_WAIT(); __syncthreads();
                if (it == 0) { PE(8); PB(9); }
#ifndef NO_G2
                {
                    pg8::Gemm g{(const bf16_t*)(ws + WS_HMID + (size_t)item * CAP * D), (const bf16_t*)(ws + WS_WDN + (size_t)e * D * D), D, nullptr};
                    pg8::SchedPanel S{0, 4};
                    pg8::EpiDown8 E{ws + WS_Y + (size_t)item * CAP * D, (const float*)(ws + WS_GATE) + item * CAP, pg8::F8_INV * pg8::F8_Y};
                    pg8::gemm_phase<pg8::EpiDown8, pg8::SchedPanel, true, true, false, true>(lds, g, S, E);
                }
#endif
                VM_WAIT(); __syncthreads();
                if (it == 0) PE(9);
            }
        }
    } SEAM(6); PE(6);
    PB(7); if (IN(7)) { p8_final(args, vcu, G); } PE(7);
#undef IN
#undef SEAM
}

extern "C" void kernel_launch(void* const* d_in, const int* in_sizes, int n_in, void* d_out, int out_size, void* d_ws, size_t ws_size, hipStream_t stream) {
    static int grid = 0;
    if (grid == 0) {
        if (n_in != 22 || in_sizes[0] != M * D || out_size != M * D || ws_size < WS_END) { fprintf(stderr, "kernel_launch: unexpected shapes (n_in %d, in0 %d, out %d, ws %zu)\n", n_in, n_in > 0 ? in_sizes[0] : -1, out_size, ws_size); grid = -1; return; }
        int dev = 0, cus = 0;
        if (hipGetDevice(&dev) != hipSuccess || hipDeviceGetAttribute(&cus, hipDeviceAttributeMultiprocessorCount, dev) != hipSuccess) { grid = -1; return; }
        if (hipFuncSetAttribute((const void*)fwd_kernel, hipFuncAttributeMaxDynamicSharedMemorySize, LDS_BYTES) != hipSuccess) { fprintf(stderr, "kernel_launch: hipFuncSetAttribute failed\n"); grid = -1; return; }
        (void)hipGetLastError();
        grid = cus;
        if (grid != 256) { fprintf(stderr, "kernel_launch: this kernel needs a 256-CU device (got %d)\n", cus); grid = -1; return; }
    }
    if (grid < 0) return;
    (void)hipMemsetAsync((char*)d_ws + WS_CTL, 0, CTL_ZERO_BYTES, stream);
    Args a{};
    for (int i = 0; i < 22; ++i) a.in[i] = (const float*)d_in[i];
    a.out = (float*)d_out; a.ws = (unsigned char*)d_ws;
    constexpr int NPH = 8;
    if (MK_N_LAUNCHES == 1) { a.ph_lo = 0; a.ph_hi = NPH; hipLaunchKernelGGL(fwd_kernel, dim3(grid), dim3(NTHREADS), LDS_BYTES, stream, a); }
    else { for (int k = 0; k < NPH; ++k) { a.ph_lo = k; a.ph_hi = k + 1; hipLaunchKernelGGL(fwd_kernel, dim3(grid), dim3(NTHREADS), LDS_BYTES, stream, a); } }
}
```

```cpp
#include <hip/hip_runtime.h>
#include <cstdio>
#include <cstdint>

#ifndef MK_N_LAUNCHES
#define MK_N_LAUNCHES 1
#endif

#define LAS __attribute__((address_space(3)))
#define GAS __attribute__((address_space(1)))
typedef unsigned short bf16_t;
typedef short bf16x8 __attribute__((ext_vector_type(8)));
typedef short s16x4 __attribute__((ext_vector_type(4)));
typedef float f32x4 __attribute__((ext_vector_type(4)));
typedef float f32x16 __attribute__((ext_vector_type(16)));
typedef unsigned u32x4 __attribute__((ext_vector_type(4)));
typedef unsigned u32x2 __attribute__((ext_vector_type(2)));

constexpr int NB = 32, T = 2048, D = 1024, TC = 256, M = NB * T, MC = NB * TC, MA = M + MC, TK = TC + T;
constexpr int NE = 16, CAP = 256, NITEM = NB * NE, NPROJ = 3072, NMOD = 6 * D;
constexpr float EPS = 1e-6f;
constexpr float C2 = 0.125f * 1.4426950408889634f;
constexpr float LAM_INIT = 0.2f;
constexpr int NWAVES = 8, NTHREADS = 512;

constexpr size_t MiB = 1u << 20;
constexpr size_t WS_CTL = 0, CTL_ZERO_BYTES = 1 * MiB;
constexpr size_t WS_MODP = 2 * MiB;
constexpr size_t WS_MOD = 16 * MiB;
constexpr size_t WS_TAB = 17 * MiB;
constexpr size_t WS_WIN = 18 * MiB;
constexpr size_t WS_WOUT = 24 * MiB;
constexpr size_t WS_WGU = 26 * MiB;
constexpr size_t WS_WDN = 90 * MiB;
constexpr size_t WS_AFFT = 122 * MiB;
constexpr size_t WS_SLOT = 126 * MiB;
constexpr size_t WS_IDX = 128 * MiB;
constexpr size_t WS_GATE = 129 * MiB;
constexpr size_t WS_XN = 130 * MiB;
constexpr size_t WS_Q = 274 * MiB;
constexpr size_t WS_K = 338 * MiB;
constexpr size_t WS_V = 410 * MiB;
constexpr size_t WS_GB = 482 * MiB;
constexpr size_t WS_U = 546 * MiB;
constexpr size_t WS_MIXIN = 610 * MiB;
constexpr size_t WS_MIX = 738 * MiB;
constexpr size_t WS_HMID = 274 * MiB;
constexpr size_t WS_Y = 610 * MiB;
constexpr size_t WS_H1 = 866 * MiB;
constexpr size_t WS_END = 994 * MiB;

__device__ __forceinline__ int opaque_tid() { int t = threadIdx.x; asm volatile("" : "+v"(t)); return t; }

namespace pg8 {
constexpr int BM = 256, BK = 64, HALF = 128, HTB = HALF * BK * 2, STAGE_BYTES = 8 * HTB;
__host__ __device__ __forceinline__ int lds_byte(int r, int c) { const int st = (r >> 4) * 2 + (c >> 5), rr = r & 15, cc = c & 31, ob = rr * 64 + cc * 2; return st * 1024 + (ob ^ (((ob >> 9) & 1) << 5)); }
__host__ __device__ __forceinline__ void stage_rc(int b, int& R, int& C) { const int st = b / 1024, sb = b % 1024, swz = sb ^ (((sb >> 9) & 1) << 5); R = (st >> 1) * 16 + swz / 64; C = (st & 1) * 32 + (swz % 64) / 2; }
__host__ __device__ __forceinline__ int perm32(int rho) { const int n = rho >> 4, i = rho & 15; return 8 * (i >> 2) + 4 * n + (i & 3); }

struct Unit { int pm, pn; };
struct Gemm { const bf16_t* A; const bf16_t* Bt; int K; const int* gidx; };

typedef float f32x2_t __attribute__((ext_vector_type(2))); typedef __bf16 bf16x2_t __attribute__((ext_vector_type(2)));
__device__ __forceinline__ unsigned cvt_pk_bf16(float lo, float hi) { const f32x2_t v = {lo, hi}; const bf16x2_t b = __builtin_convertvector(v, bf16x2_t); return __builtin_bit_cast(unsigned, b); }

struct EpiBf16 {
    static constexpr bool PERM = true, AFTER_DRAIN = false;
    bf16_t* O; int ldc;
    __device__ __forceinline__ void operator()(const f32x4 (&acc)[2][2][4][2], const Unit& u, int wr, int wc, int fr, int fq) const {
        const int row0 = u.pm * BM + wr * 64 + fr; const int col0 = u.pn * BM + wc * 32 + 8 * fq;
#pragma unroll
        for (int ai = 0; ai < 2; ++ai)
#pragma unroll
            for (int m = 0; m < 4; ++m) { bf16_t* rowp = O + (size_t)(row0 + ai * HALF + m * 16) * ldc + col0;
#pragma unroll
                for (int bj = 0; bj < 2; ++bj) { const f32x4 v0 = acc[ai][bj][m][0], v1 = acc[ai][bj][m][1];
                    u32x4 w; w.x = cvt_pk_bf16(v0[0], v0[1]); w.y = cvt_pk_bf16(v0[2], v0[3]); w.z = cvt_pk_bf16(v1[0], v1[1]); w.w = cvt_pk_bf16(v1[2], v1[3]);
                    *(u32x4*)(rowp + bj * HALF) = w; } }
    }
};

struct EpiProj {
    static constexpr bool PERM = true, AFTER_DRAIN = false;
    bf16_t *Q, *KA, *VA, *GB, *U; const float* tab;
    unsigned* kmaxh;
    __device__ __forceinline__ void operator()(const f32x4 (&acc)[2][2][4][2], const Unit& u, int wr, int wc, int fr, int fq) const {
        const int pn = u.pn; const bool ctx = u.pm >= 256;
        float km[2] = {0.f, 0.f};
#pragma unroll
        for (int ai = 0; ai < 2; ++ai)
#pragma unroll
            for (int m = 0; m < 4; ++m) {
                const int row = u.pm * BM + ai * HALF + wr * 64 + m * 16 + fr;
                int t, kvrow;
                if (!ctx) { const int b = row >> 11; t = row & 2047; kvrow = b * TK + TC + t; }
                else { const int rc = row - M; const int b = rc >> 8; t = 0; kvrow = b * TK + (rc & 255); }
                if (pn < 4) {
                    f32x4 cs0 = {1.f, 0.f, 1.f, 0.f}, cs1 = cs0, cs2 = cs0, cs3 = cs0;
                    if (!ctx) { const float* tp = tab + ((size_t)t * 32 + 16 * (wc & 1) + 4 * fq) * 2;
                        cs0 = *(const f32x4*)(tp); cs1 = *(const f32x4*)(tp + 4); }
                    (void)cs2; (void)cs3;
#pragma unroll
                    for (int bj = 0; bj < 2; ++bj) {
                        const f32x4 v0 = acc[ai][bj][m][0], v1 = acc[ai][bj][m][1];
                        float e0 = v0[0], o0 = v0[1], e1 = v0[2], o1 = v0[3], e2 = v1[0], o2 = v1[1], e3 = v1[2], o3 = v1[3];
                        if (pn >= 2) {
                            float ss = ((e0 * e0 + o0 * o0) + (e1 * e1 + o1 * o1)) + ((e2 * e2 + o2 * o2) + (e3 * e3 + o3 * o3));
                            ss += __shfl_xor(ss, 16); ss += __shfl_xor(ss, 32); km[bj] = fmaxf(km[bj], ss); }
                        float r0 = e0 * cs0[0] - o0 * cs0[1], s0 = o0 * cs0[0] + e0 * cs0[1];
                        float r1 = e1 * cs0[2] - o1 * cs0[3], s1 = o1 * cs0[2] + e1 * cs0[3];
                        float r2 = e2 * cs1[0] - o2 * cs1[1], s2 = o2 * cs1[0] + e2 * cs1[1];
                        float r3 = e3 * cs1[2] - o3 * cs1[3], s3 = o3 * cs1[2] + e3 * cs1[3];
                        const float sc = (pn < 2) ? C2 : 1.f;
                        u32x4 w; w.x = cvt_pk_bf16(r0 * sc, s0 * sc); w.y = cvt_pk_bf16(r1 * sc, s1 * sc); w.z = cvt_pk_bf16(r2 * sc, s2 * sc); w.w = cvt_pk_bf16(r3 * sc, s3 * sc);
                        const int col = (pn & 1) * 256 + bj * HALF + wc * 32 + 8 * fq;
                        bf16_t* dst = (pn < 2) ? (Q + (size_t)row * 512 + col) : (KA + (size_t)kvrow * 512 + col);
                        *(u32x4*)dst = w;
                    }
                } else if (pn < 8) {
#pragma unroll
                    for (int bj = 0; bj < 2; ++bj) {
                        const f32x4 v0 = acc[ai][bj][m][0], v1 = acc[ai][bj][m][1];
                        u32x4 w; w.x = cvt_pk_bf16(v0[0], v0[1]); w.y = cvt_pk_bf16(v0[2], v0[3]); w.z = cvt_pk_bf16(v1[0], v1[1]); w.w = cvt_pk_bf16(v1[2], v1[3]);
                        const int col = (pn & 1) * 256 + bj * HALF + wc * 32 + 8 * fq;
                        bf16_t* dst = (pn < 6) ? (VA + (size_t)kvrow * 512 + col) : (GB + (size_t)row * 512 + col);
                        *(u32x4*)dst = w;
                    }
                } else {
                    const f32x4 a0 = acc[ai][0][m][0], a1 = acc[ai][0][m][1], b0 = acc[ai][1][m][0], b1 = acc[ai][1][m][1];
                    u32x4 w; w.x = cvt_pk_bf16(a0[0] * b0[0], a0[1] * b0[1]); w.y = cvt_pk_bf16(a0[2] * b0[2], a0[3] * b0[3]);
                    w.z = cvt_pk_bf16(a1[0] * b1[0], a1[1] * b1[1]); w.w = cvt_pk_bf16(a1[2] * b1[2], a1[3] * b1[3]);
                    const int col = (pn - 8) * 128 + wc * 32 + 8 * fq;
                    *(u32x4*)(U + (size_t)row * 512 + col) = w;
                }
            }
        if (pn == 2 || pn == 3) {
            const int b = ctx ? (u.pm - 256) : (u.pm >> 3);
#pragma unroll
            for (int bj = 0; bj < 2; ++bj) { float v = km[bj];
#pragma unroll
                for (int d = 1; d < 16; d <<= 1) v = fmaxf(v, __shfl_xor(v, d));
                if (fr == 0 && fq == 0) atomicMax(kmaxh + ((b * 8 + (pn & 1) * 4 + bj * 2 + (wc >> 1)) * 2 + (wc & 1)), __float_as_uint(v)); }
        }
    }
};

struct EpiGU {
    static constexpr bool PERM = true, AFTER_DRAIN = false;
    bf16_t* H;
    __device__ __forceinline__ float silu(float x) const { return x * __builtin_amdgcn_rcpf(1.f + __expf(-x)); }
    __device__ __forceinline__ void operator()(const f32x4 (&acc)[2][2][4][2], const Unit& u, int wr, int wc, int fr, int fq) const {
#pragma unroll
        for (int ai = 0; ai < 2; ++ai)
#pragma unroll
            for (int m = 0; m < 4; ++m) {
                const int row = ai * HALF + wr * 64 + m * 16 + fr;
                const f32x4 a0 = acc[ai][0][m][0], a1 = acc[ai][0][m][1], b0 = acc[ai][1][m][0], b1 = acc[ai][1][m][1];
                u32x4 w; w.x = cvt_pk_bf16(silu(a0[0]) * b0[0], silu(a0[1]) * b0[1]); w.y = cvt_pk_bf16(silu(a0[2]) * b0[2], silu(a0[3]) * b0[3]);
                w.z = cvt_pk_bf16(silu(a1[0]) * b1[0], silu(a1[1]) * b1[1]); w.w = cvt_pk_bf16(silu(a1[2]) * b1[2], silu(a1[3]) * b1[3]);
                *(u32x4*)(H + (size_t)row * 1024 + u.pn * 128 + wc * 32 + 8 * fq) = w;
            }
    }
};
__device__ __forceinline__ unsigned pk4_fp8(float a, float b, float c, float d) { int w = 0; w = __builtin_amdgcn_cvt_pk_fp8_f32(a, b, w, false); w = __builtin_amdgcn_cvt_pk_fp8_f32(c, d, w, true); return (unsigned)w; }
constexpr float F8_ACT = 4.0f, F8_WGT = 64.0f, F8_INV = 1.0f / (4.0f * 64.0f);
struct EpiGU8 {
    static constexpr bool PERM = true, AFTER_DRAIN = false;
    unsigned char* H;
    __device__ __forceinline__ float hval(float g, float u) const {
        const float e = __builtin_amdgcn_exp2f(g * (-F8_INV * 1.4426950408889634f));
        const float r = __builtin_amdgcn_rcpf(1.f + e);
        return __builtin_amdgcn_fmed3f((g * u) * (r * (F8_INV * F8_INV * F8_ACT)), -448.f, 448.f); }
    __device__ __forceinline__ void operator()(const f32x4 (&acc)[2][2][4][2], const Unit& u, int wr, int wc, int fr, int fq) const {
        asm volatile("" : "+v"(fr));
#pragma unroll
        for (int ai = 0; ai < 2; ++ai)
#pragma unroll
            for (int m = 0; m < 4; ++m) {
                const int row = ai * HALF + wr * 64 + m * 16 + fr;
                const f32x4 a0 = acc[ai][0][m][0], a1 = acc[ai][0][m][1], b0 = acc[ai][1][m][0], b1 = acc[ai][1][m][1];
                u32x2 w; w.x = pk4_fp8(hval(a0[0], b0[0]), hval(a0[1], b0[1]), hval(a0[2], b0[2]), hval(a0[3], b0[3]));
                w.y = pk4_fp8(hval(a1[0], b1[0]), hval(a1[1], b1[1]), hval(a1[2], b1[2]), hval(a1[3], b1[3]));
                *(u32x2*)(H + (size_t)row * 1024 + u.pn * 128 + wc * 32 + 8 * fq) = w;
            }
    }
};
struct EpiDown {
    static constexpr bool PERM = true, AFTER_DRAIN = false;
    bf16_t* Y; const float* gate; float scale;
    __device__ __forceinline__ void operator()(const f32x4 (&acc)[2][2][4][2], const Unit& u, int wr, int wc, int fr, int fq) const {
        asm volatile("" : "+v"(fr));
#pragma unroll
        for (int ai = 0; ai < 2; ++ai)
#pragma unroll
            for (int m = 0; m < 4; ++m) {
                const int row = ai * HALF + wr * 64 + m * 16 + fr; const float g = gate[row] * scale;
#pragma unroll
                for (int bj = 0; bj < 2; ++bj) { const f32x4 v0 = acc[ai][bj][m][0] * g, v1 = acc[ai][bj][m][1] * g;
                    u32x4 w; w.x = cvt_pk_bf16(v0[0], v0[1]); w.y = cvt_pk_bf16(v0[2], v0[3]); w.z = cvt_pk_bf16(v1[0], v1[1]); w.w = cvt_pk_bf16(v1[2], v1[3]);
                    *(u32x4*)(Y + (size_t)row * 1024 + u.pn * BM + bj * HALF + wc * 32 + 8 * fq) = w; }
            }
    }
};

constexpr float F8_Y = 64.0f;
struct EpiDown8 {
    static constexpr bool PERM = true, AFTER_DRAIN = false;
    unsigned char* Y; const float* gate; float scale;
    __device__ __forceinline__ void operator()(const f32x4 (&acc)[2][2][4][2], const Unit& u, int wr, int wc, int fr, int fq) const {
        asm volatile("" : "+v"(fr));
#pragma unroll
        for (int ai = 0; ai < 2; ++ai)
#pragma unroll
            for (int m = 0; m < 4; ++m) {
                const int row = ai * HALF + wr * 64 + m * 16 + fr; const float g = gate[row] * scale;
#pragma unroll
                for (int bj = 0; bj < 2; ++bj) { f32x4 v0 = acc[ai][bj][m][0] * g, v1 = acc[ai][bj][m][1] * g;
#pragma unroll
                    for (int i = 0; i < 4; ++i) { v0[i] = __builtin_amdgcn_fmed3f(v0[i], -448.f, 448.f); v1[i] = __builtin_amdgcn_fmed3f(v1[i], -448.f, 448.f); }
                    u32x2 w; w.x = pk4_fp8(v0[0], v0[1], v0[2], v0[3]); w.y = pk4_fp8(v1[0], v1[1], v1[2], v1[3]);
                    *(u32x2*)(Y + (size_t)row * 1024 + u.pn * BM + bj * HALF + wc * 32 + 8 * fq) = w; }
            }
    }
};

struct SchedProj {
    int G, c;
    __device__ __forceinline__ bool next(int i, Unit& u) const {
        const int L = i * G + c;
        if (L < 3072) { u.pm = L & 255; u.pn = L >> 8; return true; }
        const int j = L - 3072; if (j >= 128) return false;
        u.pm = 256 + (j >> 2); u.pn = 2 + (j & 3); return true;
    }
    __device__ __forceinline__ void a_ready(const Unit&) const {}
    __device__ __forceinline__ void done(const Unit&) const {}
};
struct SchedPanel {
    int pm, ntn;
    __device__ __forceinline__ bool next(int i, Unit& u) const { if (i >= ntn) return false; u.pm = pm; u.pn = i; return true; }
    __device__ __forceinline__ void a_ready(const Unit&) const {}
    __device__ __forceinline__ void done(const Unit&) const {}
};

typedef int i32x4v __attribute__((ext_vector_type(4)));
typedef int i32x8v __attribute__((ext_vector_type(8)));
__device__ __forceinline__ i32x8v cat8(bf16x8 a, bf16x8 b) { const i32x4v x = __builtin_bit_cast(i32x4v, a), y = __builtin_bit_cast(i32x4v, b); return __builtin_shufflevector(x, y, 0, 1, 2, 3, 4, 5, 6, 7); }
template <bool F8> struct Frag;
template <> struct Frag<false> { bf16x8 v[2]; __device__ __forceinline__ void set(bf16x8 a, bf16x8 b) { v[0] = a; v[1] = b; } };
template <> struct Frag<true> { i32x8v v; __device__ __forceinline__ void set(bf16x8 a, bf16x8 b) { v = cat8(a, b); } };
__device__ __forceinline__ f32x4 frag_mma(const Frag<false>& b, const Frag<false>& a, f32x4 c) { c = __builtin_amdgcn_mfma_f32_16x16x32_bf16(b.v[0], a.v[0], c, 0, 0, 0); return __builtin_amdgcn_mfma_f32_16x16x32_bf16(b.v[1], a.v[1], c, 0, 0, 0); }
__device__ __forceinline__ f32x4 frag_mma(const Frag<true>& b, const Frag<true>& a, f32x4 c) {
    const int sc1 = 0x7f7f7f7f;
    asm volatile("v_mfma_scale_f32_16x16x128_f8f6f4 %0, %1, %2, %0, %3, %3 op_sel_hi:[0,0,0]" : "+v"(c) : "v"(b.v), "v"(a.v), "v"(sc1));
    return c; }
template <class Epi, class Sched, bool ALIGN_EPI, bool SP2, bool GATHER = false, bool F8 = false>
__device__ __forceinline__ void gemm_phase(LAS unsigned char* lds, const Gemm g, const Sched& S, const Epi& E) {
    const int tid = opaque_tid(), wid = __builtin_amdgcn_readfirstlane(tid >> 6), lane = tid & 63, wr = wid >> 2, wc = wid & 3, fr = lane & 15, fq = lane >> 4;
    const int K = g.K * (F8 ? 1 : 2), nt = K / 128;
    unsigned voffA[2][2], voffB[2];
#pragma unroll
    for (int i = 0; i < 2; ++i) { int R, C; stage_rc(tid * 16 + i * 8192, R, C); const int Rb = Epi::PERM ? ((R & ~31) + perm32(R & 31)) : R;
        if constexpr (GATHER) { voffA[0][i] = (unsigned)(g.gidx[R] * K + C * 2); voffA[1][i] = (unsigned)(g.gidx[HALF + R] * K + C * 2); }
        else { voffA[0][i] = (unsigned)(R * K + C * 2); voffA[1][i] = voffA[0][i]; }
        voffB[i] = (unsigned)(Rb * K + C * 2); }
    const size_t kstep = (size_t)(BK * 2);
    const size_t hstep = (size_t)HALF * K;
    const size_t hstepA = GATHER ? (size_t)0 : hstep;
    const size_t tstep = 2 * hstep;
    const unsigned ldsw = (unsigned)wid * 1024u;
    const int aoff = F8 ? lds_byte(wr * 64 + fr, (fq >> 1) * 32 + (fq & 1) * 16) : lds_byte(wr * 64 + fr, fq * 8), boff = F8 ? lds_byte(wc * 32 + fr, (fq >> 1) * 32 + (fq & 1) * 16) : lds_byte(wc * 32 + fr, fq * 8);
    const int aoff1 = F8 ? aoff + 16 : aoff + 1024, boff1 = F8 ? boff + 16 : boff + 1024;
#define PG8_SA(b, h) (((b) * 2 + (h)) * HTB)
#define PG8_SB(b, h) ((4 + (b) * 2 + (h)) * HTB)
#define PG8_STAGE(bufoff, gbase, voff) do { _Pragma("unroll") for (int _i = 0; _i < 2; ++_i) \
        __builtin_amdgcn_global_load_lds((const unsigned*)((const char*)(gbase) + (voff)[_i]), (LAS unsigned*)(lds + (bufoff) + ldsw + _i * 8192), 16, 0, 0); } while (0)
#define PG8_LDA(dst, b, h) do { _Pragma("unroll") for (int m = 0; m < 4; ++m) dst[m].set(*(const LAS bf16x8*)(lds + PG8_SA(b, h) + aoff + m * 2048), *(const LAS bf16x8*)(lds + PG8_SA(b, h) + aoff1 + m * 2048)); } while (0)
#define PG8_LDB(dst, b, h) do { _Pragma("unroll") for (int n = 0; n < 2; ++n) dst[n].set(*(const LAS bf16x8*)(lds + PG8_SB(b, h) + boff + n * 2048), *(const LAS bf16x8*)(lds + PG8_SB(b, h) + boff1 + n * 2048)); } while (0)
#define PG8_MMA(ai, bj, At, Bt) do { __builtin_amdgcn_s_setprio(1); _Pragma("unroll") for (int m = 0; m < 4; ++m) _Pragma("unroll") for (int n = 0; n < 2; ++n) \
        acc[ai][bj][m][n] = frag_mma(Bt[n], At[m], acc[ai][bj][m][n]); __builtin_amdgcn_s_setprio(0); } while (0)
#define PG8_WAIT_V(n) asm volatile("s_waitcnt vmcnt(" #n ")" ::: "memory")
#define PG8_WAIT_L(n) asm volatile("s_waitcnt lgkmcnt(" #n ")" ::: "memory")
#define PG8_BAR __builtin_amdgcn_s_barrier()
#define PG8_SCHED __builtin_amdgcn_sched_barrier(0)
    Unit cur, nxt; int ui = 0;
    if (!S.next(0, cur)) return;
    f32x4 acc[2][2][4][2];
#pragma unroll
    for (int a = 0; a < 2; ++a)
#pragma unroll
        for (int b = 0; b < 2; ++b)
#pragma unroll
            for (int m = 0; m < 4; ++m)
#pragma unroll
                for (int n = 0; n < 2; ++n) acc[a][b][m][n] = (f32x4){0.f, 0.f, 0.f, 0.f};
    Frag<F8> At[4], B0[2], B1[2];
    const char* cA = (const char*)g.A + (size_t)cur.pm * tstep; const char* cB = (const char*)g.Bt + (size_t)cur.pn * tstep;
    S.a_ready(cur);
    if constexpr (SP2) {
        PG8_STAGE(PG8_SB(0, 0), cB, voffB); PG8_STAGE(PG8_SB(0, 1), cB + hstep, voffB); PG8_STAGE(PG8_SA(0, 0), cA, voffA[0]); PG8_STAGE(PG8_SA(0, 1), cA + hstepA, voffA[GATHER ? 1 : 0]);
        if (wr == 1) PG8_BAR;
        PG8_WAIT_V(2); PG8_BAR;
        PG8_STAGE(PG8_SB(1, 0), cB + kstep, voffB); PG8_STAGE(PG8_SA(1, 0), cA + kstep, voffA[0]); PG8_STAGE(PG8_SB(1, 1), cB + hstep + kstep, voffB);
        PG8_WAIT_V(6); PG8_BAR;
    } else {
        PG8_STAGE(PG8_SB(0, 0), cB, voffB); PG8_STAGE(PG8_SA(0, 0), cA, voffA[0]); PG8_STAGE(PG8_SB(0, 1), cB + hstep, voffB); PG8_STAGE(PG8_SA(0, 1), cA + hstepA, voffA[GATHER ? 1 : 0]);
        if (wr == 1) PG8_BAR;
        PG8_WAIT_V(4); PG8_BAR;
        PG8_STAGE(PG8_SB(1, 0), cB + kstep, voffB); PG8_STAGE(PG8_SA(1, 0), cA + kstep, voffA[0]); PG8_STAGE(PG8_SB(1, 1), cB + hstep + kstep, voffB);
        PG8_WAIT_V(6); PG8_BAR;
    }
    for (;;) {
        const bool has_next = S.next(ui + 1, nxt);
        const char* nA = has_next ? (const char*)g.A + (size_t)nxt.pm * tstep : cA; const char* nB = has_next ? (const char*)g.Bt + (size_t)nxt.pn * tstep : cB;
#pragma unroll 1
        for (int t = 0; t < nt; t += 2) {
            const bool last = (t == nt - 2);
            if constexpr (F8) { asm volatile("" : "+v"(voffA[0][0]), "+v"(voffA[0][1]), "+v"(voffB[0]), "+v"(voffB[1])); if constexpr (GATHER) asm volatile("" : "+v"(voffA[1][0]), "+v"(voffA[1][1])); }
            const char* a1 = cA + (size_t)(t + 1) * kstep;
            const char* a2 = last ? nA : cA + (size_t)(t + 2) * kstep; const char* b2 = last ? nB : cB + (size_t)(t + 2) * kstep;
            const char* a3 = a2 + kstep; const char* b3 = b2 + kstep;
            if (last && has_next) S.a_ready(nxt);
            if constexpr (SP2) {
            PG8_LDB(B0, 0, 0); PG8_LDB(B1, 0, 1); PG8_SCHED; PG8_LDA(At, 0, 0); PG8_STAGE(PG8_SA(1, 1), a1 + hstepA, voffA[GATHER ? 1 : 0]);
            PG8_WAIT_V(8); PG8_WAIT_L(0); PG8_BAR; PG8_MMA(0, 0, At, B0); PG8_MMA(0, 1, At, B1); PG8_BAR; PG8_SCHED;
            PG8_LDA(At, 0, 1); PG8_STAGE(PG8_SB(0, 0), b2, voffB); PG8_STAGE(PG8_SB(0, 1), b2 + hstep, voffB); PG8_STAGE(PG8_SA(0, 0), a2, voffA[0]);
            PG8_WAIT_V(8); PG8_WAIT_L(0); PG8_BAR; PG8_MMA(1, 0, At, B0); PG8_MMA(1, 1, At, B1); PG8_BAR; PG8_SCHED;
            PG8_LDB(B0, 1, 0); PG8_LDB(B1, 1, 1); PG8_SCHED; PG8_LDA(At, 1, 0); PG8_STAGE(PG8_SA(0, 1), a2 + hstepA, voffA[GATHER ? 1 : 0]);
            PG8_WAIT_V(8); PG8_WAIT_L(0); PG8_BAR; PG8_MMA(0, 0, At, B0); PG8_MMA(0, 1, At, B1); PG8_BAR; PG8_SCHED;
            PG8_LDA(At, 1, 1); PG8_STAGE(PG8_SB(1, 0), b3, voffB); PG8_STAGE(PG8_SB(1, 1), b3 + hstep, voffB); PG8_STAGE(PG8_SA(1, 0), a3, voffA[0]);
            PG8_WAIT_V(8); PG8_WAIT_L(0); PG8_BAR; PG8_MMA(1, 0, At, B0); PG8_MMA(1, 1, At, B1); PG8_BAR; PG8_SCHED;
            } else {
            PG8_LDB(B0, 0, 0); PG8_SCHED; PG8_LDA(At, 0, 0); PG8_STAGE(PG8_SA(1, 1), a1 + hstepA, voffA[GATHER ? 1 : 0]);
            PG8_WAIT_L(8); PG8_BAR; PG8_WAIT_L(0); PG8_MMA(0, 0, At, B0); PG8_BAR; PG8_SCHED;
            PG8_LDB(B1, 0, 1); PG8_STAGE(PG8_SB(0, 0), b2, voffB);
            PG8_BAR; PG8_WAIT_L(0); PG8_MMA(0, 1, At, B1); PG8_BAR;
            PG8_LDA(At, 0, 1); PG8_STAGE(PG8_SA(0, 0), a2, voffA[0]);
            PG8_BAR; PG8_WAIT_L(0); PG8_MMA(1, 0, At, B0); PG8_BAR; PG8_SCHED;
            PG8_STAGE(PG8_SB(0, 1), b2 + hstep, voffB);
            PG8_WAIT_V(6); PG8_BAR; PG8_MMA(1, 1, At, B1); PG8_BAR;
            PG8_LDB(B0, 1, 0); PG8_SCHED; PG8_LDA(At, 1, 0); PG8_STAGE(PG8_SA(0, 1), a2 + hstepA, voffA[GATHER ? 1 : 0]);
            PG8_WAIT_L(8); PG8_BAR; PG8_WAIT_L(0); PG8_MMA(0, 0, At, B0); PG8_BAR; PG8_SCHED;
            PG8_LDB(B1, 1, 1); PG8_STAGE(PG8_SB(1, 0), b3, voffB);
            PG8_BAR; PG8_WAIT_L(0); PG8_MMA(0, 1, At, B1); PG8_BAR;
            PG8_LDA(At, 1, 1); PG8_STAGE(PG8_SA(1, 0), a3, voffA[0]);
            PG8_BAR; PG8_WAIT_L(0); PG8_MMA(1, 0, At, B0); PG8_BAR; PG8_SCHED;
            PG8_STAGE(PG8_SB(1, 1), b3 + hstep, voffB);
            PG8_WAIT_V(6); PG8_BAR; PG8_MMA(1, 1, At, B1); PG8_BAR;
            }
        }
        if constexpr (ALIGN_EPI) { if (wr == 0) PG8_BAR; }
        if constexpr (F8) asm volatile("s_nop 15\n\ts_nop 7" ::: "memory");
        E(acc, cur, wr, wc, fr, fq); S.done(cur);
        if (!has_next) break;
#pragma unroll
        for (int a = 0; a < 2; ++a)
#pragma unroll
            for (int b = 0; b < 2; ++b)
#pragma unroll
                for (int m = 0; m < 4; ++m)
#pragma unroll
                    for (int n = 0; n < 2; ++n) acc[a][b][m][n] = (f32x4){0.f, 0.f, 0.f, 0.f};
        cur = nxt; cA = nA; cB = nB; ++ui;
        if constexpr (ALIGN_EPI) { if (wr == 1) PG8_BAR; }
    }
    PG8_WAIT_V(0);
    if constexpr (!ALIGN_EPI) { if (wr == 0) PG8_BAR; }
    PG8_BAR;
#undef PG8_SA
#undef PG8_SB
#undef PG8_STAGE
#undef PG8_LDA
#undef PG8_LDB
#undef PG8_MMA
#undef PG8_WAIT_V
#undef PG8_WAIT_L
#undef PG8_BAR
#undef PG8_SCHED
}
}

typedef GAS unsigned gu32;
#define RLX_AGENT __ATOMIC_RELAXED, __HIP_MEMORY_SCOPE_AGENT
#define LDS_WAIT() asm volatile("s_waitcnt lgkmcnt(0)" ::: "memory")
#define VM_WAIT() asm volatile("s_waitcnt vmcnt(0)" ::: "memory")
__device__ __forceinline__ unsigned pk2(float lo, float hi) { return pg8::cvt_pk_bf16(lo, hi); }
__device__ __forceinline__ float bf2f(unsigned short h) { return __uint_as_float((unsigned)h << 16); }
__device__ __forceinline__ float bflo(unsigned w) { return __uint_as_float(w << 16); }
__device__ __forceinline__ float bfhi(unsigned w) { return __uint_as_float(w & 0xffff0000u); }
__device__ __forceinline__ float wave_sum(float v) {
    v += __builtin_bit_cast(float, __builtin_amdgcn_update_dpp(0, __builtin_bit_cast(int, v), 0xB1, 0xf, 0xf, true));
    v += __builtin_bit_cast(float, __builtin_amdgcn_update_dpp(0, __builtin_bit_cast(int, v), 0x4E, 0xf, 0xf, true));
    v += __builtin_bit_cast(float, __builtin_amdgcn_update_dpp(0, __builtin_bit_cast(int, v), 0x141, 0xf, 0xf, true));
    v += __builtin_bit_cast(float, __builtin_amdgcn_update_dpp(0, __builtin_bit_cast(int, v), 0x140, 0xf, 0xf, true));
    v += __builtin_bit_cast(float, __builtin_amdgcn_update_dpp(0, __builtin_bit_cast(int, v), 0x142, 0xa, 0xf, false));
    v += __builtin_bit_cast(float, __builtin_amdgcn_update_dpp(0, __builtin_bit_cast(int, v), 0x143, 0xc, 0xf, false));
    return __builtin_bit_cast(float, __builtin_amdgcn_readlane(__builtin_bit_cast(int, v), 63));
}

#define XB_TMO      128
#define XB_XCNT(j)  (256  + 64 * (j))
#define XB_XSUB(j)  (1280 + 64 * (j))
#define XB_XGEN(j)  (2304 + 64 * (j))
#define XB_TOP      3328
#define XB_TOPGEN   3392
#define XCD_BAR_WORDS 3456
#define XB_SPIN_CAP (1u << 18)
__device__ __forceinline__ unsigned xb_ld(unsigned* p)              { return __hip_atomic_load(p, __ATOMIC_RELAXED, __HIP_MEMORY_SCOPE_AGENT); }
__device__ __forceinline__ unsigned xb_add(unsigned* p, unsigned v) { return __hip_atomic_fetch_add(p, v, __ATOMIC_RELAXED, __HIP_MEMORY_SCOPE_AGENT); }
__device__ __forceinline__ unsigned xb_xcc_id() { return (unsigned)__builtin_amdgcn_s_getreg((3 << 11) | 20) & 0xFu; }
#define XB_SPIN(cond, bar) do { unsigned _sp = 0; while (cond) { __builtin_amdgcn_s_sleep(1); \
    if ((++_sp & 255u) == 0u) { if (xb_ld(&(bar)[XB_TMO])) break; if (_sp > XB_SPIN_CAP) { atomicAdd(&(bar)[XB_TMO], 1u); break; } } } } while (0)
struct XcdBarrier { unsigned* bar; unsigned x; volatile LAS unsigned* st; };
__device__ __forceinline__ XcdBarrier xcd_barrier_post(unsigned* bar, volatile LAS unsigned* st) {
    XcdBarrier b; b.bar = bar; b.x = xb_xcc_id(); b.st = st;
    if (threadIdx.x == 0) (void)xb_add(&bar[XB_XCNT(b.x)], 1u);
    return b;
}
__device__ __forceinline__ void xcd_barrier_complete(unsigned* bar, unsigned x, unsigned& nloc, unsigned& nx) {
    const unsigned G = gridDim.x * gridDim.y * gridDim.z;
    unsigned sum, cnt, mine, sp = 0u;
    for (;;) {
        sum = 0u; cnt = 0u; mine = 0u;
#pragma unroll
        for (unsigned j = 0; j < 16; ++j) { const unsigned c = xb_ld(&bar[XB_XCNT(j)]); sum += c; cnt += (c > 0u) ? 1u : 0u; mine = (j == x) ? c : mine; }
        if (sum == G) break;
        __builtin_amdgcn_s_sleep(1);
        if ((++sp & 255u) == 0u) { if (xb_ld(&bar[XB_TMO])) break; if (sp > XB_SPIN_CAP) { atomicAdd(&bar[XB_TMO], 1u); break; } }
    }
    nloc = mine > 0u ? mine : 1u; nx = cnt > 0u ? cnt : 1u;
}
__device__ __forceinline__ void xcd_barrier(const XcdBarrier& b) {
    asm volatile("s_waitcnt vmcnt(0)" ::: "memory");
    __syncthreads();
    if (threadIdx.x == 0) {
        unsigned* bar = b.bar;
        __builtin_amdgcn_s_waitcnt(0);
        unsigned nloc = b.st[0], nx = b.st[1];
        if (nloc == 0u) { xcd_barrier_complete(bar, b.x, nloc, nx); b.st[0] = nloc; b.st[1] = nx; }
        const unsigned old = xb_add(&bar[XB_XSUB(b.x)], 1u);
        const unsigned gen = old / nloc;
        if (old + 1u == (gen + 1u) * nloc) {
            __builtin_amdgcn_fence(__ATOMIC_RELEASE, "agent");
            asm volatile("s_waitcnt vmcnt(0)" ::: "memory");
            const unsigned og = xb_add(&bar[XB_TOP], 1u);
            const unsigned tg = og / nx;
            if (og + 1u == (tg + 1u) * nx) xb_add(&bar[XB_TOPGEN], 1u);
            else XB_SPIN(xb_ld(&bar[XB_TOPGEN]) == tg, bar);
            __builtin_amdgcn_fence(__ATOMIC_ACQUIRE, "agent");
            xb_add(&bar[XB_XGEN(b.x)], 1u);
            asm volatile("s_waitcnt vmcnt(0)" ::: "memory");
        } else {
            XB_SPIN(xb_ld(&bar[XB_XGEN(b.x)]) == gen, bar);
            __builtin_amdgcn_fence(__ATOMIC_ACQUIRE, "agent");
            asm volatile("s_waitcnt vmcnt(0)" ::: "memory");
        }
    }
    __syncthreads();
}

constexpr int RING_BYTES = 131072;
constexpr int LDSCTL_OFF = RING_BYTES, MISC_OFF = LDSCTL_OFF + 320;
constexpr int LDS_BYTES = 147456;
constexpr int CW_BAR = 4096;
constexpr int CW_KMAX = 65536;

struct Args { const float* in[22]; float* out; unsigned char* ws; int ph_lo, ph_hi; };
enum { I_X = 0, I_C, I_CTX, I_CCTX, I_WADA, I_BADA, I_NPRE_MIX, I_NPOST_MIX, I_NPRE_FFN, I_NPOST_FFN, I_WIN, I_CONVW, I_LQ1, I_LK1, I_LQ2, I_LK2, I_SUBLN, I_WOUT, I_WROUTER, I_WGATE, I_WUP, I_WDOWN };

__device__ __forceinline__ int win_dest(int n) {
    if (n < 1024) { const int j = n & 63; const int p = ((j >> 5) << 5) + ((j & 15) << 1) + ((j >> 4) & 1); return (n & ~63) + p; }
    if (n < 2048) return n;
    int c = n - 2048; const int isx = c >= 512; c &= 511; return 2048 + ((c >> 7) << 8) + (isx << 7) + (c & 127);
}
template <int MODE>
__device__ __forceinline__ int tr_dest(int n) {
    if (MODE == 0) return n;
    if (MODE == 1) return win_dest(n);
    if (MODE == 2) return ((n >> 7) << 8) + (n & 127);
    return ((n >> 7) << 8) + 128 + (n & 127);
}
template <int MODE>
__device__ __forceinline__ void p0_transpose_item_f8(const float* W, int K, int N, unsigned char* WT, LAS float* scr, int item, int lane) {
    const int nblk = N / 32, kb = item / nblk, nb = item % nblk, k0 = 64 * kb, n0 = 32 * nb;
#pragma unroll 8
    for (int i = 0; i < 32; ++i) { const int kk = 2 * i + (lane >> 5); scr[kk * 33 + (lane & 31)] = __builtin_nontemporal_load(W + (size_t)(k0 + kk) * N + n0 + (lane & 31)) * pg8::F8_WGT; }
    LDS_WAIT(); asm volatile("" ::: "memory");
    const int c = lane & 7;
#pragma unroll
    for (int j = 0; j < 4; ++j) { const int n = (lane >> 3) + 8 * j; const LAS float* s = scr + (8 * c) * 33 + n;
        u32x2 o; o.x = pg8::pk4_fp8(s[0 * 33], s[1 * 33], s[2 * 33], s[3 * 33]); o.y = pg8::pk4_fp8(s[4 * 33], s[5 * 33], s[6 * 33], s[7 * 33]);
        *(GAS u32x2*)(WT + (size_t)tr_dest<MODE>(n0 + n) * K + k0 + 8 * c) = o; }
    LDS_WAIT(); asm volatile("" ::: "memory");
}
template <int MODE>
__device__ __forceinline__ void p0_transpose_item(const float* W, int K, int N, bf16_t* WT, LAS float* scr, int item, int lane) {
    const int nblk = N / 32, kb = item / nblk, nb = item % nblk, k0 = 64 * kb, n0 = 32 * nb;
#pragma unroll 8
    for (int i = 0; i < 32; ++i) { const int kk = 2 * i + (lane >> 5); scr[kk * 33 + (lane & 31)] = W[(size_t)(k0 + kk) * N + n0 + (lane & 31)]; }
    LDS_WAIT(); asm volatile("" ::: "memory");
    const int c = lane & 7;
#pragma unroll
    for (int j = 0; j < 4; ++j) { const int n = (lane >> 3) + 8 * j; const LAS float* s = scr + (8 * c) * 33 + n;
        u32x4 o; o.x = pk2(s[0 * 33], s[1 * 33]); o.y = pk2(s[2 * 33], s[3 * 33]); o.z = pk2(s[4 * 33], s[5 * 33]); o.w = pk2(s[6 * 33], s[7 * 33]);
        *(GAS u32x4*)(WT + (size_t)tr_dest<MODE>(n0 + n) * K + k0 + 8 * c) = o; }
    LDS_WAIT(); asm volatile("" ::: "memory");
}

__device__ __forceinline__ void p0_prologue(const Args& a, LAS unsigned char* lds, int vcu, int G) {
    const int tid = opaque_tid(), lane = tid & 63, wave = __builtin_amdgcn_readfirstlane(tid >> 6);
    LAS float* scr = (LAS float*)(lds + wave * 16384);
    const int gw = vcu * NWAVES + wave, NGW = G * NWAVES;
    unsigned char* ws = a.ws;
    if (gw < 96 * 16) {
        float* MODP = (float*)(ws + WS_MODP);
        const float* wada = a.in[I_WADA];
        for (int it = gw; it < 96 * 16; it += NGW) {
            const int cg = it % 96, kc = it / 96;
            for (int b = 0; b < 33; ++b) { const float v = (b < 32) ? a.in[I_C][b * D + kc * 64 + lane] : a.in[I_CCTX][kc * 64 + lane]; scr[b * 64 + lane] = v / (1.f + __expf(-v)); }
            LDS_WAIT(); asm volatile("" ::: "memory");
            float acc[33];
#pragma unroll
            for (int b = 0; b < 33; ++b) acc[b] = 0.f;
            const float* wp = wada + (size_t)(kc * 64) * NMOD + cg * 64 + lane;
#pragma unroll 2
            for (int k = 0; k < 64; k += 4) {
                const float w0 = __builtin_nontemporal_load(wp + (size_t)(k + 0) * NMOD), w1 = __builtin_nontemporal_load(wp + (size_t)(k + 1) * NMOD),
                            w2 = __builtin_nontemporal_load(wp + (size_t)(k + 2) * NMOD), w3 = __builtin_nontemporal_load(wp + (size_t)(k + 3) * NMOD);
#pragma unroll
                for (int b = 0; b < 33; ++b) { const f32x4 sv4 = *(const LAS f32x4*)(scr + b * 64 + k); acc[b] += (sv4.x * w0 + sv4.y * w1) + (sv4.z * w2 + sv4.w * w3); }
            }
#pragma unroll
            for (int b = 0; b < 33; ++b) MODP[((size_t)kc * 33 + b) * NMOD + cg * 64 + lane] = acc[b];
            LDS_WAIT(); asm volatile("" ::: "memory");
        }
    } else {
        float* tab = (float*)(ws + WS_TAB);
        const int nw = NGW - 96 * 16;
        for (int e = (gw - 96 * 16) * 64 + lane; e < T * 32; e += nw * 64) {
            const int t = e >> 5, i = e & 31;
            const float inv = powf(10000.0f, -(float)(2 * (i & 15)) / 32.0f);
            const float pos = (i < 16) ? (float)(t >> 6) : (float)(t & 63);
            const float ang = pos * inv;
            tab[2 * e] = cosf(ang); tab[2 * e + 1] = sinf(ang);
        }
    }
}
__device__ __forceinline__ void inout_weight_copies(const Args& a, LAS unsigned char* lds, int vcu, int G) {
    const int tid = opaque_tid(), lane = tid & 63, wave = __builtin_amdgcn_readfirstlane(tid >> 6);
    LAS float* scr = (LAS float*)(lds + 16384 + wave * 12288);
    const int gw = vcu * NWAVES + wave, NGW = G * NWAVES;
    unsigned char* ws = a.ws;
    constexpr int I_IN = (D / 64) * (NPROJ / 32), I_OUT = (D / 64) * (D / 32);
    constexpr int NITEMS = I_IN + I_OUT;
    bf16_t* Win_t = (bf16_t*)(ws + WS_WIN); bf16_t* Wout_t = (bf16_t*)(ws + WS_WOUT);
    for (int it = gw; it < NITEMS; it += NGW) {
        int r = it;
        if (r < I_IN) { p0_transpose_item<1>(a.in[I_WIN], D, NPROJ, Win_t, scr, r, lane); continue; } r -= I_IN;
        p0_transpose_item<0>(a.in[I_WOUT], D, D, Wout_t, scr, r, lane);
    }
}
__device__ __forceinline__ void expert_weight_copies(const Args& a, LAS unsigned char* lds, int gw0  , int ngroups, int r_lo, int r_hi) {
    const int tid = opaque_tid(), lane = tid & 63, wave = __builtin_amdgcn_readfirstlane(tid >> 6);
    LAS float* scr = (LAS float*)(lds + wave * 16384);
    const int gw = gw0 * NWAVES + wave, NGW = ngroups * NWAVES;
    unsigned char* ws = a.ws;
    constexpr int I_EXP = (D / 64) * (D / 32);
    unsigned char* Wgu_t = ws + WS_WGU; unsigned char* Wdn_t = ws + WS_WDN;
    for (int r = r_lo + gw; r < r_hi; r += NGW) {
        const int e = r / (3 * I_EXP), q = (r % (3 * I_EXP)) / I_EXP, rr = r % I_EXP;
        if (q == 0) p0_transpose_item_f8<2>(a.in[I_WGATE] + (size_t)e * D * D, D, D, Wgu_t + (size_t)e * 2048 * D, scr, rr, lane);
        else if (q == 1) p0_transpose_item_f8<3>(a.in[I_WUP] + (size_t)e * D * D, D, D, Wgu_t + (size_t)e * 2048 * D, scr, rr, lane);
        else p0_transpose_item_f8<0>(a.in[I_WDOWN] + (size_t)e * D * D, D, D, Wdn_t + (size_t)e * D * D, scr, rr, lane);
    }
    __syncthreads();
}

struct RowF { f32x4 v[4]; };
__device__ __forceinline__ void row_load(RowF& r, const float* xrow, int lane) {
    const f32x4* xr = (const f32x4*)xrow + lane;
#pragma unroll
    for (int j = 0; j < 4; ++j) r.v[j] = __builtin_nontemporal_load(xr + 64 * j);
}
__device__ __forceinline__ void norm_mod_row(const RowF& r, bf16_t* orow, const float* gain, const LAS float* sc, const LAS float* sh, int lane) {
    const f32x4* gr = (const f32x4*)gain + lane;
    float s = 0.f;
#pragma unroll
    for (int j = 0; j < 4; ++j) s += (r.v[j].x * r.v[j].x + r.v[j].y * r.v[j].y) + (r.v[j].z * r.v[j].z + r.v[j].w * r.v[j].w);
    const float rstd = 1.0f / sqrtf(wave_sum(s) * (1.f / D) + EPS);
    u32x2* o8 = (u32x2*)orow + lane;
#pragma unroll
    for (int j = 0; j < 4; ++j) { const f32x4 g = gr[64 * j]; const f32x4 c1 = *(const LAS f32x4*)(sc + 4 * lane + 256 * j), h1 = *(const LAS f32x4*)(sh + 4 * lane + 256 * j);
        const f32x4 y = (r.v[j] * rstd) * g; const f32x4 z = y * (c1 + 1.0f) + h1;
        u32x2 w; w.x = pk2(z.x, z.y); w.y = pk2(z.z, z.w); o8[64 * j] = w; }
}
__device__ __forceinline__ void p1_xn(const Args& a, LAS unsigned char* lds, int c, int G) {
    const int tid = opaque_tid(), lane = tid & 63, wave = __builtin_amdgcn_readfirstlane(tid >> 6);
    unsigned char* ws = a.ws;
    const float* MODP = (const float*)(ws + WS_MODP); float* MOD = (float*)(ws + WS_MOD); const float* bada = a.in[I_BADA];
    { const int per = (33 * NMOD + G - 1) / G;
      for (int i = c * per + tid; i < (c + 1) * per && i < 33 * NMOD; i += NTHREADS) { const int r = i / NMOD, n = i - r * NMOD; float s = bada[n];
#pragma unroll
            for (int kc = 0; kc < 16; ++kc) s += MODP[((size_t)kc * 33 + r) * NMOD + n];
            MOD[i] = s; } }
    LAS float* sv = (LAS float*)lds;
    bf16_t* XN = (bf16_t*)(ws + WS_XN);
    const float* X = a.in[I_X]; const float* CTX = a.in[I_CTX]; const float* gain = a.in[I_NPRE_MIX];
    for (int p = c; p < 256; p += G) {
        const int b = p >> 3;
        const int rbase = p * 256 + wave * 32;
        RowF a0, a1;
        row_load(a0, X + (size_t)rbase * D, lane); row_load(a1, X + (size_t)(rbase + 16) * D, lane);
        __syncthreads();
        for (int n = tid; n < 4096; n += NTHREADS) { const int r = (n < 2048) ? b : 32; const int col = n & 2047; float s = bada[col];
#pragma unroll
            for (int kc = 0; kc < 16; ++kc) s += MODP[((size_t)kc * 33 + r) * NMOD + col];
            sv[n] = s; }
        __syncthreads();
        for (int i = 0; i < 16; ++i) {
            RowF n0, n1;
            if (i + 1 < 16) { row_load(n0, X + (size_t)(rbase + i + 1) * D, lane); row_load(n1, X + (size_t)(rbase + 16 + i + 1) * D, lane); }
            else { const int crow = p * 32 + wave * 4; row_load(n0, CTX + (size_t)crow * D, lane); row_load(n1, CTX + (size_t)(crow + 1) * D, lane); }
            norm_mod_row(a0, XN + (size_t)(rbase + i) * D, gain, sv + 1024, sv, lane);
            norm_mod_row(a1, XN + (size_t)(rbase + 16 + i) * D, gain, sv + 1024, sv, lane);
            a0 = n0; a1 = n1;
        }
        {
            const int crow = p * 32 + wave * 4;
            RowF n0, n1;
            row_load(n0, CTX + (size_t)(crow + 2) * D, lane); row_load(n1, CTX + (size_t)(crow + 3) * D, lane);
            norm_mod_row(a0, XN + (size_t)(M + crow) * D, gain, sv + 3072, sv + 2048, lane);
            norm_mod_row(a1, XN + (size_t)(M + crow + 1) * D, gain, sv + 3072, sv + 2048, lane);
            norm_mod_row(n0, XN + (size_t)(M + crow + 2) * D, gain, sv + 3072, sv + 2048, lane);
            norm_mod_row(n1, XN + (size_t)(M + crow + 3) * D, gain, sv + 3072, sv + 2048, lane);
        }
    }
}

namespace att {
constexpr int KP = 272, KBUF = 64 * KP, VBUF = 16384;
constexpr int OFF_K = 0, OFF_V = 2 * KBUF, OFF_WSF = OFF_V + 2 * VBUF, OFF_END = OFF_WSF + NWAVES * 256;
static_assert(OFF_WSF >= 65536 && OFF_END <= RING_BYTES, "attention LDS map");
constexpr int NT = TK / 64;
constexpr float THR = 8.0f;
__device__ __forceinline__ int crow(int r, int hi) { return (r & 3) + 8 * (r >> 2) + 4 * hi; }
__device__ __forceinline__ float max3f(float a, float b, float c) { float r; asm("v_max3_f32 %0, %1, %2, %3" : "=v"(r) : "v"(a), "v"(b), "v"(c)); return r; }
__device__ __forceinline__ float max2f(float a, float b) { float r; asm("v_max_f32_e32 %0, %1, %2" : "=v"(r) : "v"(a), "v"(b)); return r; }
__device__ __forceinline__ s16x4 vtr(const LAS unsigned char* p) { return __builtin_bit_cast(s16x4, __builtin_amdgcn_ds_read_tr16_b64_v4i16((LAS s16x4*)p)); }

#define ATT_BAR() asm volatile("s_waitcnt lgkmcnt(0)\n\ts_barrier" ::: "memory")
#define ATT_SB() __builtin_amdgcn_sched_barrier(0)
#define ATT_KLD(i, KF) KF = *(const LAS bf16x8*)(kb_ + ((i) & 1) * (32 * KP) + ((i) >> 1) * 32)
#define ATT_XSTEP(i, KC, KN) do { if ((i) + 2 < 8) { ATT_KLD((i) + 2, KN); } \
    if ((i) == 0) p0 = __builtin_amdgcn_mfma_f32_32x32x16_bf16(KC, qr[0], negref, 0, 0, 0); \
    else if ((i) == 1) p1 = __builtin_amdgcn_mfma_f32_32x32x16_bf16(KC, qr[0], negref, 0, 0, 0); \
    else if (((i) & 1) == 0) p0 = __builtin_amdgcn_mfma_f32_32x32x16_bf16(KC, qr[(i) >> 1], p0, 0, 0, 0); else p1 = __builtin_amdgcn_mfma_f32_32x32x16_bf16(KC, qr[(i) >> 1], p1, 0, 0, 0); ATT_SB(); } while (0)
#define ATT_X(kcur) do { \
    const LAS unsigned char* kb_ = lds + OFF_K + (kcur) * KBUF + koff; \
    bf16x8 ka_, kb2_, kc_; \
    ATT_KLD(0, ka_); ATT_KLD(1, kb2_); \
    ATT_SB(); \
    ATT_XSTEP(0, ka_, kc_); ATT_XSTEP(1, kb2_, ka_); ATT_XSTEP(2, kc_, kb2_); ATT_XSTEP(3, ka_, kc_); \
    ATT_XSTEP(4, kb2_, ka_); ATT_XSTEP(5, kc_, kb2_); ATT_XSTEP(6, ka_, kc_); ATT_XSTEP(7, kb2_, ka_); \
} while (0)
#define ATT_EXP2(i, PWN) do { \
    const float e0_ = __builtin_amdgcn_exp2f((i) < 8 ? p0[2 * ((i) & 7)] : p1[2 * ((i) & 7)]), e1_ = __builtin_amdgcn_exp2f((i) < 8 ? p0[2 * ((i) & 7) + 1] : p1[2 * ((i) & 7) + 1]); \
    sacc_ += e0_ + e1_; PWN[(i) >> 2][(i) & 3] = pk2(e0_, e1_); asm volatile("" : "+v"(PWN[(i) >> 2]), "+v"(sacc_)); } while (0)
#define ATT_VLD(i, LO, HI) do { LO = vtr(vb_ + ((i) & 3) * 4096 + ((i) >> 2) * 1024); HI = vtr(vb_ + ((i) & 3) * 4096 + ((i) >> 2) * 1024 + 512); } while (0)
#define ATT_VF(LO, HI) ((bf16x8){LO[0], LO[1], LO[2], LO[3], HI[0], HI[1], HI[2], HI[3]})
#define ATT_YSTEP(i, PWC, PWN, LC, HC, LN, HN) do { if ((i) + 2 < 16) { ATT_VLD((i) + 2, LN, HN); } \
    o[(i) & 3] = __builtin_amdgcn_mfma_f32_32x32x16_bf16(__builtin_bit_cast(bf16x8, PWC[(i) >> 2]), ATT_VF(LC, HC), o[(i) & 3], 0, 0, 0); \
    ATT_EXP2(i, PWN); ATT_SB(); } while (0)
#define ATT_Y(vcur, PWC, PWN) do { \
    const LAS unsigned char* vb_ = lds + OFF_V + (vcur) * VBUF + voff; \
    float sacc_ = 0.f; s16x4 la_, ha_, lb_, hb_, lc_, hc_; \
    ATT_VLD(0, la_, ha_); ATT_VLD(1, lb_, hb_); ATT_SB(); \
    ATT_YSTEP(0, PWC, PWN, la_, ha_, lc_, hc_); ATT_YSTEP(1, PWC, PWN, lb_, hb_, la_, ha_); ATT_YSTEP(2, PWC, PWN, lc_, hc_, lb_, hb_); \
    ATT_YSTEP(3, PWC, PWN, la_, ha_, lc_, hc_); ATT_YSTEP(4, PWC, PWN, lb_, hb_, la_, ha_); ATT_YSTEP(5, PWC, PWN, lc_, hc_, lb_, hb_); \
    ATT_YSTEP(6, PWC, PWN, la_, ha_, lc_, hc_); ATT_YSTEP(7, PWC, PWN, lb_, hb_, la_, ha_); ATT_YSTEP(8, PWC, PWN, lc_, hc_, lb_, hb_); \
    ATT_YSTEP(9, PWC, PWN, la_, ha_, lc_, hc_); ATT_YSTEP(10, PWC, PWN, lb_, hb_, la_, ha_); ATT_YSTEP(11, PWC, PWN, lc_, hc_, lb_, hb_); \
    ATT_YSTEP(12, PWC, PWN, la_, ha_, lc_, hc_); ATT_YSTEP(13, PWC, PWN, lb_, hb_, la_, ha_); ATT_YSTEP(14, PWC, PWN, lc_, hc_, lb_, hb_); \
    ATT_YSTEP(15, PWC, PWN, la_, ha_, lc_, hc_); \
    l_reg += sacc_; \
} while (0)
#define ATT_Y0(PWN) do { float sacc_ = 0.f; _Pragma("unroll") for (int i = 0; i < 16; ++i) ATT_EXP2(i, PWN); l_reg += sacc_; } while (0)
#define ATT_ZSTEP(i, PWC, LC, HC, LN, HN) do { if ((i) + 2 < 16) { ATT_VLD((i) + 2, LN, HN); } \
    o[(i) & 3] = __builtin_amdgcn_mfma_f32_32x32x16_bf16(__builtin_bit_cast(bf16x8, PWC[(i) >> 2]), ATT_VF(LC, HC), o[(i) & 3], 0, 0, 0); ATT_SB(); } while (0)
#define ATT_Z(vcur, PWC) do { \
    const LAS unsigned char* vb_ = lds + OFF_V + (vcur) * VBUF + voff; \
    s16x4 la_, ha_, lb_, hb_, lc_, hc_; \
    ATT_VLD(0, la_, ha_); ATT_VLD(1, lb_, hb_); ATT_SB(); \
    ATT_ZSTEP(0, PWC, la_, ha_, lc_, hc_); ATT_ZSTEP(1, PWC, lb_, hb_, la_, ha_); ATT_ZSTEP(2, PWC, lc_, hc_, lb_, hb_); \
    ATT_ZSTEP(3, PWC, la_, ha_, lc_, hc_); ATT_ZSTEP(4, PWC, lb_, hb_, la_, ha_); ATT_ZSTEP(5, PWC, lc_, hc_, lb_, hb_); \
    ATT_ZSTEP(6, PWC, la_, ha_, lc_, hc_); ATT_ZSTEP(7, PWC, lb_, hb_, la_, ha_); ATT_ZSTEP(8, PWC, lc_, hc_, lb_, hb_); \
    ATT_ZSTEP(9, PWC, la_, ha_, lc_, hc_); ATT_ZSTEP(10, PWC, lb_, hb_, la_, ha_); ATT_ZSTEP(11, PWC, lc_, hc_, lb_, hb_); \
    ATT_ZSTEP(12, PWC, la_, ha_, lc_, hc_); ATT_ZSTEP(13, PWC, lb_, hb_, la_, ha_); ATT_ZSTEP(14, PWC, lc_, hc_, lb_, hb_); \
    ATT_ZSTEP(15, PWC, la_, ha_, lc_, hc_); \
} while (0)
#define ATT_STAGE(j) do { \
    if ((j) + 1 < NT) { _Pragma("unroll") for (int i = 0; i < 2; ++i) *(LAS u32x4*)(lds + OFF_K + (((j) + 1) & 1) * KBUF + kdst[i]) = kr[i]; } \
    _Pragma("unroll") for (int i = 0; i < 2; ++i) *(LAS u32x4*)(lds + OFF_V + ((j) & 1) * VBUF + vdst[i]) = vr[i]; \
    if ((j) + 2 < NT) { _Pragma("unroll") for (int i = 0; i < 2; ++i) kr[i] = *(const u32x4*)(Kb + (size_t)((j) + 2) * 64 * 512 + gsrc[i]); } \
    if ((j) + 1 < NT) { _Pragma("unroll") for (int i = 0; i < 2; ++i) vr[i] = *(const u32x4*)(Vb + (size_t)((j) + 1) * 64 * 512 + gsrc[i]); } } while (0)

__device__ __forceinline__ void unit(LAS unsigned char* lds, int b, int h, int qb, const bf16_t* Q, const bf16_t* KA, const bf16_t* VA, bf16_t* MIXIN, const float* subg, float lam, const unsigned* KM) {
    const int tid = opaque_tid(), lane = tid & 63, r32 = lane & 31, hi = lane >> 5;
    const int wid = __builtin_amdgcn_readfirstlane(tid >> 6), w = wid & 3, m = wid >> 2;
    LAS float* wsf = (LAS float*)(lds + OFF_WSF) + wid * 64;
    const int rowQ = b * T + qb * 128 + w * 32;
    bf16x8 qr[4];
#pragma unroll
    for (int d0 = 0; d0 < 4; ++d0) qr[d0] = *(const bf16x8*)(Q + (size_t)(rowQ + r32) * 512 + h * 128 + m * 64 + d0 * 16 + hi * 8);
    const bf16_t* Kb = KA + (size_t)b * TK * 512 + h * 128; const bf16_t* Vb = VA + (size_t)b * TK * 512 + h * 128;
    int gsrc[2], kdst[2], vdst[2];
#pragma unroll
    for (int i = 0; i < 2; ++i) { const int cid = tid + 512 * i, kv = cid >> 4, c16 = cid & 15;
        gsrc[i] = kv * 512 + c16 * 8; kdst[i] = kv * KP + c16 * 16; vdst[i] = (c16 >> 2) * 4096 + (kv >> 4) * 1024 + (kv & 15) * 64 + (c16 & 3) * 16; }
    u32x4 kr[2], vr[2];
#pragma unroll
    for (int i = 0; i < 2; ++i) { kr[i] = *(const u32x4*)(Kb + gsrc[i]); vr[i] = *(const u32x4*)(Vb + gsrc[i]); }
#pragma unroll
    for (int i = 0; i < 2; ++i) *(LAS u32x4*)(lds + OFF_K + kdst[i]) = kr[i];
#pragma unroll
    for (int i = 0; i < 2; ++i) kr[i] = *(const u32x4*)(Kb + (size_t)64 * 512 + gsrc[i]);
    ATT_BAR();
    f32x16 o[4];
#pragma unroll
    for (int d0 = 0; d0 < 4; ++d0) o[d0] = (f32x16){};
    float l_reg = 0.f;
    f32x16 p0, p1, negref;
    {
        const unsigned* km = KM + (b * 8 + h * 2 + m) * 2;
        const float kmax2 = __uint_as_float(km[0]) + __uint_as_float(km[1]);
        float ss = 0.f;
#pragma unroll
        for (int d0 = 0; d0 < 4; ++d0)
#pragma unroll
            for (int i = 0; i < 8; ++i) { const float v = bf2f((unsigned short)qr[d0][i]); ss += v * v; }
        ss += __shfl_xor(ss, 32);
        const float ref = sqrtf(ss * kmax2) * 1.02f;
#pragma unroll
        for (int r = 0; r < 16; ++r) negref[r] = -ref;
    }
    u32x4 pwA[4], pwB[4];
    const int koff = r32 * KP + m * 128 + hi * 16;
    const int voff = ((lane >> 4) & 1) * 32 + (lane & 3) * 8 + (4 * hi + ((lane & 15) >> 2)) * 64;
    ATT_X(0); ATT_STAGE(0); ATT_Y0(pwA); ATT_BAR();
    ATT_X(1); ATT_STAGE(1); ATT_Y(0, pwA, pwB); ATT_BAR();
    for (int j = 2; j < NT; j += 2) {
        ATT_X(0); ATT_STAGE(j); ATT_Y(1, pwB, pwA); ATT_BAR();
        ATT_X(1); ATT_STAGE(j + 1); ATT_Y(0, pwA, pwB); ATT_BAR();
    }
    ATT_Z(1, pwB); ATT_BAR();
    l_reg += __shfl_xor(l_reg, 32);
    if (hi == 0) wsf[32 + r32] = l_reg;
    LDS_WAIT();
    float rli[16];
#pragma unroll
    for (int r = 0; r < 16; ++r) rli[r] = 1.0f / wsf[32 + crow(r, hi)];
    LDS_WAIT();
    LAS float* ex = (LAS float*)lds + w * 4096;
    if (m == 1) {
#pragma unroll
        for (int r = 0; r < 16; ++r)
#pragma unroll
            for (int d0 = 0; d0 < 4; ++d0) ex[crow(r, hi) * 128 + d0 * 32 + r32] = o[d0][r] * rli[r];
    }
    ATT_BAR();
    if (m == 0) {
        float g4[4];
#pragma unroll
        for (int d0 = 0; d0 < 4; ++d0) g4[d0] = subg[d0 * 32 + r32] * (1.0f - LAM_INIT);
#pragma unroll
        for (int r = 0; r < 16; ++r) {
            const int q = crow(r, hi); float x[4]; float ss = 0.f;
#pragma unroll
            for (int d0 = 0; d0 < 4; ++d0) { x[d0] = o[d0][r] * rli[r] - lam * ex[q * 128 + d0 * 32 + r32]; ss += x[d0] * x[d0]; }
#pragma unroll
            for (int off = 1; off < 32; off <<= 1) ss += __shfl_xor(ss, off);
            const float rstd = 1.0f / sqrtf(ss * (1.f / 128.f) + EPS);
            bf16_t* dst = MIXIN + (size_t)(rowQ + q) * 1024 + h * 128 + r32;
#pragma unroll
            for (int d0 = 0; d0 < 4; ++d0) dst[d0 * 32] = (bf16_t)(pk2(x[d0] * rstd * g4[d0], 0.f) & 0xffffu);
        }
    }
    ATT_BAR();
}
#undef ATT_BAR
#undef ATT_X
#undef ATT_EXP2
#undef ATT_Y
#undef ATT_Y0
#undef ATT_Z
#undef ATT_STAGE
#undef ATT_SB
#undef ATT_KLD
#undef ATT_XSTEP
#undef ATT_VLD
#undef ATT_VF
#undef ATT_YSTEP
#undef ATT_ZSTEP
}

__device__ __forceinline__ void p3_conv_attn(const Args& a, LAS unsigned char* lds, int c, int vcu, int G) {
    const int tid = opaque_tid(), lane = tid & 63, wave = __builtin_amdgcn_readfirstlane(tid >> 6);
    unsigned char* ws = a.ws;
    const bf16_t* GB = (const bf16_t*)(ws + WS_GB); const bf16_t* U = (const bf16_t*)(ws + WS_U); bf16_t* MIXIN = (bf16_t*)(ws + WS_MIXIN);
    {
        const float* cw = a.in[I_CONVW]; float w0[8], w1[8], w2[8];
#pragma unroll
        for (int i = 0; i < 8; ++i) { w0[i] = cw[lane * 8 + i]; w1[i] = cw[512 + lane * 8 + i]; w2[i] = cw[1024 + lane * 8 + i]; }
        const int gw = vcu * NWAVES + wave, NGW = G * NWAVES;
        for (int row = gw; row < M; row += NGW) {
            const int t = row & (T - 1);
            const u32x4 z = {0u, 0u, 0u, 0u};
            const u32x4 uc = *(const u32x4*)(U + (size_t)row * 512 + lane * 8);
            const u32x4 up = (t > 0) ? *(const u32x4*)(U + (size_t)(row - 1) * 512 + lane * 8) : z;
            const u32x4 un = (t < T - 1) ? *(const u32x4*)(U + (size_t)(row + 1) * 512 + lane * 8) : z;
            const u32x4 gb = *(const u32x4*)(GB + (size_t)row * 512 + lane * 8);
            u32x4 o;
#pragma unroll
            for (int q = 0; q < 4; ++q) {
                const float y0 = w0[2 * q] * bflo(up[q]) + w1[2 * q] * bflo(uc[q]) + w2[2 * q] * bflo(un[q]);
                const float y1 = w0[2 * q + 1] * bfhi(up[q]) + w1[2 * q + 1] * bfhi(uc[q]) + w2[2 * q + 1] * bfhi(un[q]);
                o[q] = pk2(bflo(gb[q]) * y0, bfhi(gb[q]) * y1);
            }
            *(u32x4*)(MIXIN + (size_t)row * 1024 + 512 + lane * 8) = o;
        }
    }
    float lam;
    { const float p1 = a.in[I_LQ1][lane] * a.in[I_LK1][lane], p2 = a.in[I_LQ2][lane] * a.in[I_LK2][lane];
      lam = __expf(wave_sum(p1)) - __expf(wave_sum(p2)) + LAM_INIT; }
    const bf16_t* Q = (const bf16_t*)(ws + WS_Q); const bf16_t* KA = (const bf16_t*)(ws + WS_K); const bf16_t* VA = (const bf16_t*)(ws + WS_V);
    __syncthreads();
    for (int u = vcu * 8; u < 2048; u += G * 8) {
        const int x = (u >> 3) / 32, jj = (u >> 3) % 32;
        for (int i = 0; i < 8; ++i) {
            const int bh = 16 * x + 2 * i + (jj >> 4), qb = jj & 15;
            att::unit(lds, bh >> 2, bh & 3, qb, Q, KA, VA, MIXIN, a.in[I_SUBLN], lam, (const unsigned*)(ws + WS_CTL) + CW_KMAX);
        }
    }
}

struct P5In { f32x4 x[4]; u32x2 m[4]; };
__device__ __forceinline__ void p5_load(P5In& r, int row, int lane, const float* X, const bf16_t* MIX) {
    const f32x4* xr = (const f32x4*)(X + (size_t)row * D) + lane; const u32x2* mr = (const u32x2*)(MIX + (size_t)row * D) + lane;
#pragma unroll
    for (int j = 0; j < 4; ++j) { r.x[j] = __builtin_nontemporal_load(xr + 64 * j); r.m[j] = __builtin_nontemporal_load(mr + 64 * j); }
}
__device__ __forceinline__ float p5_resid(const P5In& r, f32x4 (&h)[4], int row, int lane, const LAS float* mv, const f32x4* npm, bf16_t* H1) {
    f32x4 mx[4]; float s = 0.f;
#pragma unroll
    for (int j = 0; j < 4; ++j) { const u32x2 wv = r.m[j]; mx[j] = (f32x4){bflo(wv.x), bfhi(wv.x), bflo(wv.y), bfhi(wv.y)};
        s += (mx[j].x * mx[j].x + mx[j].y * mx[j].y) + (mx[j].z * mx[j].z + mx[j].w * mx[j].w); }
    const float rstd1 = 1.0f / sqrtf(wave_sum(s) * (1.f / D) + EPS);
    u32x2* hr = (u32x2*)(H1 + (size_t)row * D) + lane; float s2 = 0.f;
#pragma unroll
    for (int j = 0; j < 4; ++j) { const f32x4 g1 = *(const LAS f32x4*)(mv + 4 * lane + 256 * j);
        h[j] = r.x[j] + g1 * ((mx[j] * rstd1) * npm[64 * j]);
        u32x2 wv; wv.x = pk2(h[j].x, h[j].y); wv.y = pk2(h[j].z, h[j].w); __builtin_nontemporal_store(wv, hr + 64 * j);
        s2 += (h[j].x * h[j].x + h[j].y * h[j].y) + (h[j].z * h[j].z + h[j].w * h[j].w); }
    return 1.0f / sqrtf(wave_sum(s2) * (1.f / D) + EPS);
}
__device__ __forceinline__ void p5_rows(const Args& a, LAS unsigned char* lds, int p  ) {
    const int tid = opaque_tid(), lane = tid & 63, wave = __builtin_amdgcn_readfirstlane(tid >> 6);
    unsigned char* ws = a.ws;
    const int b = p >> 3;
    LAS float* wrt = (LAS float*)lds;
    LAS float* mv = (LAS float*)(lds + 65536);
    const float* wr = a.in[I_WROUTER];
    const bf16_t* MIX = (const bf16_t*)(ws + WS_MIX); unsigned char* XN2 = ws + WS_XN; float* AFFT = (float*)(ws + WS_AFFT); bf16_t* H1 = (bf16_t*)(ws + WS_H1);
    const float* X = a.in[I_X];
    const int rbase = p * 256 + wave * 32;
    P5In cA, cB;
    p5_load(cA, rbase, lane, X, MIX); p5_load(cB, rbase + 16, lane, X, MIX);
    for (int n = tid; n < D * NE; n += NTHREADS) { const int k = n >> 4, e = n & 15; wrt[e * D + k] = wr[n]; }
    const float* MOD = (const float*)(ws + WS_MOD) + (size_t)b * NMOD;
    for (int n = tid; n < 3 * D; n += NTHREADS) mv[n] = MOD[2 * D + n];
    __syncthreads();
    const f32x4* npm = (const f32x4*)a.in[I_NPOST_MIX] + lane; const f32x4* npf = (const f32x4*)a.in[I_NPRE_FFN] + lane;
    for (int i = 0; i < 16; ++i) {
        const int rowA = rbase + i, rowB = rbase + 16 + i;
        P5In nA, nB;
        if (i + 1 < 16) { p5_load(nA, rowA + 1, lane, X, MIX); p5_load(nB, rowB + 1, lane, X, MIX); }
        f32x4 hA[4], hB[4];
        const float rsA = p5_resid(cA, hA, rowA, lane, mv, npm, H1);
        const float rsB = p5_resid(cB, hB, rowB, lane, mv, npm, H1);
        unsigned* oA = (unsigned*)(XN2 + (size_t)rowA * D) + lane; unsigned* oB = (unsigned*)(XN2 + (size_t)rowB * D) + lane;
        typedef float f32x2v __attribute__((ext_vector_type(2)));
        f32x2v lg2[16];
#pragma unroll
        for (int e = 0; e < 16; ++e) lg2[e] = (f32x2v){0.f, 0.f};
#pragma unroll
        for (int j = 0; j < 4; ++j) { const f32x4 sh2 = *(const LAS f32x4*)(mv + 1024 + 4 * lane + 256 * j), sc2 = *(const LAS f32x4*)(mv + 2048 + 4 * lane + 256 * j);
            const f32x4 gn = npf[64 * j];
            const f32x4 zA = ((hA[j] * rsA) * gn) * (sc2 + 1.0f) + sh2, zB = ((hB[j] * rsB) * gn) * (sc2 + 1.0f) + sh2;
            { const f32x4 qa = zA * pg8::F8_ACT, qb = zB * pg8::F8_ACT; oA[64 * j] = pg8::pk4_fp8(qa.x, qa.y, qa.z, qa.w); oB[64 * j] = pg8::pk4_fp8(qb.x, qb.y, qb.z, qb.w); }
            const f32x2v zx = {zA.x, zB.x}, zy = {zA.y, zB.y}, zz = {zA.z, zB.z}, zw = {zA.w, zB.w};
#pragma unroll
            for (int e = 0; e < 16; ++e) { const f32x4 wq = *(const LAS f32x4*)(wrt + e * D + 4 * lane + 256 * j);
                lg2[e] = __builtin_elementwise_fma(zx, (f32x2v){wq.x, wq.x}, lg2[e]); lg2[e] = __builtin_elementwise_fma(zy, (f32x2v){wq.y, wq.y}, lg2[e]);
                lg2[e] = __builtin_elementwise_fma(zz, (f32x2v){wq.z, wq.z}, lg2[e]); lg2[e] = __builtin_elementwise_fma(zw, (f32x2v){wq.w, wq.w}, lg2[e]);
                if ((e & 3) == 3) __builtin_amdgcn_sched_barrier(0); } }
        float lg[32];
#pragma unroll
        for (int e = 0; e < 16; ++e) { lg[e] = lg2[e].x; lg[16 + e] = lg2[e].y; }
#pragma unroll
        for (int st = 0; st < 5; ++st) { const int d = 1 << st, cntv = 16 >> st; const bool up = (lane & d) != 0;
#pragma unroll
            for (int q = 0; q < 16; ++q) if (q < cntv) { const float send = up ? lg[2 * q] : lg[2 * q + 1], keep = up ? lg[2 * q + 1] : lg[2 * q]; lg[q] = keep + __shfl_xor(send, d); } }
        float lv = lg[0] + __shfl_xor(lg[0], 32);
        float mxl = lv;
#pragma unroll
        for (int d = 1; d < 16; d <<= 1) mxl = fmaxf(mxl, __shfl_xor(mxl, d));
        const float ev = __expf(lv - mxl); float se = ev;
#pragma unroll
        for (int d = 1; d < 16; d <<= 1) se += __shfl_xor(se, d);
        if (lane < 32) { const int row = (lane < 16) ? rowA : rowB; AFFT[((size_t)b * NE + (lane & 15)) * T + (row & (T - 1))] = ev / se; }
        cA = nA; cB = nB;
    }
}

__device__ __forceinline__ void p6_topk(const Args& a, LAS unsigned char* lds, int c, int G) {
    const int tid = opaque_tid(), lane = tid & 63, wave = __builtin_amdgcn_readfirstlane(tid >> 6);
    unsigned char* ws = a.ws;
    const float* AFFT = (const float*)(ws + WS_AFFT); short* SLOT = (short*)(ws + WS_SLOT); int* IDX = (int*)(ws + WS_IDX); float* GATE = (float*)(ws + WS_GATE);
    LAS unsigned* sv = (LAS unsigned*)(lds + wave * 16384);
    for (int item = c + wave * G; item < NITEM; item += G * NWAVES) {
        const int b = item >> 4, e = item & 15;
        const float* src = AFFT + (size_t)item * T;
#pragma unroll 8
        for (int j = 0; j < 32; ++j) sv[j * 64 + lane] = __float_as_uint(src[j * 64 + lane]);
        LDS_WAIT(); asm volatile("" ::: "memory");
        unsigned pre = 0u;
        for (int bit = 30; bit >= 0; --bit) {
            const unsigned cand = pre | (1u << bit);
            int cnt = 0;
#pragma unroll 4
            for (int j = 0; j < 32; ++j) cnt += (int)__popcll(__ballot(sv[j * 64 + lane] >= cand));
            if (cnt >= CAP) pre = cand;
        }
        int ngt = 0;
#pragma unroll 4
        for (int j = 0; j < 32; ++j) ngt += (int)__popcll(__ballot(sv[j * 64 + lane] > pre));
        const int need_eq = CAP - ngt;
        const unsigned long long ltmask = (1ull << lane) - 1ull;
        int base_gt = 0, base_eq = 0;
#pragma unroll 2
        for (int j = 0; j < 32; ++j) {
            const unsigned vj = sv[j * 64 + lane];
            const bool gt = vj > pre, eq = vj == pre;
            const unsigned long long mg = __ballot(gt), me = __ballot(eq);
            const int pg = base_gt + (int)__popcll(mg & ltmask), pe = base_eq + (int)__popcll(me & ltmask);
            int sl = -1; if (gt) sl = pg; else if (eq && pe < need_eq) sl = ngt + pe;
            const int t = j * 64 + lane;
            SLOT[((size_t)b * T + t) * NE + e] = (short)sl;
            if (sl >= 0) { IDX[item * CAP + sl] = t; GATE[item * CAP + sl] = __uint_as_float(vj); }
            base_gt += (int)__popcll(mg); base_eq += (int)__popcll(me);
        }
        LDS_WAIT(); asm volatile("" ::: "memory");
    }
}

struct P8Row { u32x2 h[4]; unsigned y[4][4]; float wt[4]; unsigned long long rest; int sl; };
__device__ __forceinline__ f32x4 fp8x4_to_f32(unsigned w) { typedef float f2 __attribute__((ext_vector_type(2))); const f2 lo = __builtin_amdgcn_cvt_pk_f32_fp8((int)w, false), hi = __builtin_amdgcn_cvt_pk_f32_fp8((int)w, true); return (f32x4){lo.x, lo.y, hi.x, hi.y}; }
__device__ __forceinline__ void p8_issue(P8Row& r, int row, int lane, const short* SLOT, const unsigned char* Y, const bf16_t* H1) {
    const int b = row >> 11;
    const int s_e = (lane < NE) ? (int)SLOT[(size_t)row * NE + lane] : -1;
    unsigned long long mask = __ballot(s_e >= 0);
    const u32x2* hr = (const u32x2*)(H1 + (size_t)row * D) + lane;
#pragma unroll
    for (int j = 0; j < 4; ++j) r.h[j] = __builtin_nontemporal_load(hr + 64 * j);
#pragma unroll
    for (int q = 0; q < 4; ++q) {
        int e = 0, s = 0; r.wt[q] = 0.f;
        if (mask) { e = (int)__builtin_ctzll(mask); mask &= mask - 1ull; s = __builtin_amdgcn_readlane(s_e, e); r.wt[q] = 1.f; }
        const unsigned* yr = (const unsigned*)(Y + ((size_t)(b * NE + e) * CAP + s) * D) + lane;
#pragma unroll
        for (int j = 0; j < 4; ++j) r.y[q][j] = __builtin_nontemporal_load(yr + 64 * j);
    }
    r.rest = mask; r.sl = s_e;
}
__device__ __forceinline__ void p8_finish(P8Row& r, int row, int lane, const unsigned char* Y, const float* MOD, const f32x4* npo, float* out) {
    const int b = row >> 11;
    f32x4 ff[4];
#pragma unroll
    for (int j = 0; j < 4; ++j) ff[j] = (f32x4){0.f, 0.f, 0.f, 0.f};
#pragma unroll
    for (int q = 0; q < 4; ++q)
#pragma unroll
        for (int j = 0; j < 4; ++j) ff[j] += fp8x4_to_f32(r.y[q][j]) * r.wt[q];
    unsigned long long mask = r.rest;
    while (mask) {
        const int e = (int)__builtin_ctzll(mask); mask &= mask - 1ull; const int s = __builtin_amdgcn_readlane(r.sl, e);
        const unsigned* yr = (const unsigned*)(Y + ((size_t)(b * NE + e) * CAP + s) * D) + lane;
#pragma unroll
        for (int j = 0; j < 4; ++j) ff[j] += fp8x4_to_f32(yr[64 * j]);
    }
#pragma unroll
    for (int j = 0; j < 4; ++j) ff[j] = ff[j] * (1.0f / pg8::F8_Y);
    float s2 = 0.f;
#pragma unroll
    for (int j = 0; j < 4; ++j) s2 += (ff[j].x * ff[j].x + ff[j].y * ff[j].y) + (ff[j].z * ff[j].z + ff[j].w * ff[j].w);
    const float rstd = 1.0f / sqrtf(wave_sum(s2) * (1.f / D) + EPS);
    f32x4* orow = (f32x4*)(out + (size_t)row * D) + lane; const f32x4* g2 = (const f32x4*)(MOD + (size_t)b * NMOD + 5 * D) + lane;
#pragma unroll
    for (int j = 0; j < 4; ++j) { const u32x2 hv = r.h[j]; const f32x4 h = (f32x4){bflo(hv.x), bfhi(hv.x), bflo(hv.y), bfhi(hv.y)};
        __builtin_nontemporal_store(h + g2[64 * j] * ((ff[j] * rstd) * npo[64 * j]), orow + 64 * j); }
}
__device__ __forceinline__ void p8_final(const Args& a, int vcu, int G) {
    const int tid = opaque_tid(), lane = tid & 63, wave = __builtin_amdgcn_readfirstlane(tid >> 6);
    unsigned char* ws = a.ws;
    const short* SLOT = (const short*)(ws + WS_SLOT); const unsigned char* Y = ws + WS_Y; const float* MOD = (const float*)(ws + WS_MOD); const bf16_t* H1 = (const bf16_t*)(ws + WS_H1);
    const f32x4* npo = (const f32x4*)a.in[I_NPOST_FFN] + lane;
    const int gw = vcu * NWAVES + wave, NGW = G * NWAVES;
    for (int row = gw; row < M; row += 4 * NGW) {
        P8Row r0, r1, r2, r3;
        p8_issue(r0, row, lane, SLOT, Y, H1);
        p8_issue(r1, row + NGW, lane, SLOT, Y, H1);
        p8_issue(r2, row + 2 * NGW, lane, SLOT, Y, H1);
        p8_issue(r3, row + 3 * NGW, lane, SLOT, Y, H1);
        p8_finish(r0, row, lane, Y, MOD, npo, a.out);
        p8_finish(r1, row + NGW, lane, Y, MOD, npo, a.out);
        p8_finish(r2, row + 2 * NGW, lane, Y, MOD, npo, a.out);
        p8_finish(r3, row + 3 * NGW, lane, Y, MOD, npo, a.out);
    }
}

__global__ void __launch_bounds__(NTHREADS, 2) fwd_kernel(Args args) {
    extern __shared__ __attribute__((aligned(16))) unsigned char lds_raw[];
    LAS unsigned char* lds = (LAS unsigned char*)lds_raw;
    volatile LAS unsigned* MISC = (volatile LAS unsigned*)(lds + MISC_OFF);
    const int tid = threadIdx.x;
    const int G = gridDim.x, c = blockIdx.x;
    const int vcu = (G % 8 == 0) ? (c % 8) * (G / 8) + c / 8 : c;
    unsigned char* ws = args.ws;
    gu32* ctl = (gu32*)(ws + WS_CTL);
    for (int u = tid; u < (LDS_BYTES - LDSCTL_OFF) / 4; u += NTHREADS) ((LAS unsigned*)(lds + LDSCTL_OFF))[u] = 0u;
    __syncthreads();
    XcdBarrier bar; bar.bar = (unsigned*)(ctl + CW_BAR); bar.x = 0; bar.st = nullptr;
    const int lo = args.ph_lo, hi = args.ph_hi;
    if (hi - lo > 1) bar = xcd_barrier_post((unsigned*)(ctl + CW_BAR), MISC + 8);
#ifndef PHMASK
#define PHMASK 0xff
#endif
#define IN(k) (((PHMASK >> (k)) & 1) && lo <= (k) && (k) < hi)
#define SEAM(k) do { if (IN(k) && IN((k) + 1)) xcd_barrier(bar); } while (0)
#ifndef PROBE_PHASE
#define PROBE_PHASE -1
#endif
#define PB(k) do { if (PROBE_PHASE == (k)) { if (tid == 0) { const unsigned long long t0_ = __builtin_amdgcn_s_memrealtime(); MISC[16] = (unsigned)t0_; MISC[17] = (unsigned)(t0_ >> 32); } } } while (0)
#define PE(k) do { if (PROBE_PHASE == (k)) { if (tid == 0) { const unsigned long long t0_ = ((unsigned long long)MISC[17] << 32) | MISC[16]; const unsigned long long t1_ = __builtin_amdgcn_s_memrealtime(); \
      while (__builtin_amdgcn_s_memrealtime() - t1_ < t1_ - t0_) __builtin_amdgcn_s_sleep(8); } __syncthreads(); } } while (0)

    PB(0); if (IN(0)) { p0_prologue(args, lds, vcu, G); } SEAM(0); PE(0);
    PB(1); if (IN(1)) { p1_xn(args, lds, c, G); inout_weight_copies(args, lds, vcu, G); } SEAM(1); PE(1);
    PB(2); if (IN(2)) {
        pg8::Gemm g{(const bf16_t*)(ws + WS_XN), (const bf16_t*)(ws + WS_WIN), D, nullptr};
        pg8::SchedProj S{G, c};
        pg8::EpiProj E{(bf16_t*)(ws + WS_Q), (bf16_t*)(ws + WS_K), (bf16_t*)(ws + WS_V), (bf16_t*)(ws + WS_GB), (bf16_t*)(ws + WS_U), (const float*)(ws + WS_TAB), (unsigned*)(ws + WS_CTL) + CW_KMAX};
        pg8::gemm_phase<pg8::EpiProj, pg8::SchedProj, true, true>(lds, g, S, E);
        if (c >= 128) expert_weight_copies(args, lds, c - 128, G - 128, 0, 9216);
    } SEAM(2); PE(2);
    PB(3); if (IN(3)) { if (c & 1) expert_weight_copies(args, lds, vcu, G, 9216, 24576); p3_conv_attn(args, lds, c, vcu, G); if (!(c & 1)) expert_weight_copies(args, lds, vcu, G, 9216, 24576); } SEAM(3); PE(3);
    PB(4); if (IN(4)) {
        {
            const int p = c;
#ifndef NO_P4
            pg8::Gemm g{(const bf16_t*)(ws + WS_MIXIN), (const bf16_t*)(ws + WS_WOUT), D, nullptr};
            pg8::SchedPanel S{p, 4};
            pg8::EpiBf16 E{(bf16_t*)(ws + WS_MIX), D};
            pg8::gemm_phase<pg8::EpiBf16, pg8::SchedPanel, true, true>(lds, g, S, E);
#endif
            VM_WAIT(); __syncthreads();
#ifndef NO_P5
            p5_rows(args, lds, p);
#endif
            __syncthreads();
        }
    } SEAM(4); PE(4);
    PB(5); if (IN(5)) { p6_topk(args, lds, c, G); } SEAM(5); PE(5);
    PB(6); if (IN(6)) {
#pragma unroll 1
        for (int it = 0; it < 2; ++it) {
            {
                const int item = 2 * c + it;
                const int b = item >> 4, e = item & 15;
#ifndef NO_G1
                if (it == 0) PB(8);
                {
                    pg8::Gemm g{(const bf16_t*)(ws + WS_XN + (size_t)b * T * D), (const bf16_t*)(ws + WS_WGU + (size_t)e * 2048 * D), D, (const int*)(ws + WS_IDX) + item * CAP};
                    pg8::SchedPanel S{0, 8};
                    pg8::EpiGU8 E{ws + WS_HMID + (size_t)item * CAP * D};
                    pg8::gemm_phase<pg8::EpiGU8, pg8::SchedPanel, true, true, true, true>(lds, g, S, E);
                }
#endif
                VM_WAIT(); __syncthreads();
                if (it == 0) { PE(8); PB(9); }
#ifndef NO_G2
                {
                    pg8::Gemm g{(const bf16_t*)(ws + WS_HMID + (size_t)item * CAP * D), (const bf16_t*)(ws + WS_WDN + (size_t)e * D * D), D, nullptr};
                    pg8::SchedPanel S{0, 4};
                    pg8::EpiDown8 E{ws + WS_Y + (size_t)item * CAP * D, (const float*)(ws + WS_GATE) + item * CAP, pg8::F8_INV * pg8::F8_Y};
                    pg8::gemm_phase<pg8::EpiDown8, pg8::SchedPanel, true, true, false, true>(lds, g, S, E);
                }
#endif
                VM_WAIT(); __syncthreads();
                if (it == 0) PE(9);
            }
        }
    } SEAM(6); PE(6);
    PB(7); if (IN(7)) { p8_final(args, vcu, G); } PE(7);
#undef IN
#undef SEAM
}

extern "C" void kernel_launch(void* const* d_in, const int* in_sizes, int n_in, void* d_out, int out_size, void* d_ws, size_t ws_size, hipStream_t stream) {
    static int grid = 0;
    if (grid == 0) {
        if (n_in != 22 || in_sizes[0] != M * D || out_size != M * D || ws_size < WS_END) { fprintf(stderr, "kernel_launch: unexpected shapes (n_in %d, in0 %d, out %d, ws %zu)\n", n_in, n_in > 0 ? in_sizes[0] : -1, out_size, ws_size); grid = -1; return; }
        int dev = 0, cus = 0;
        if (hipGetDevice(&dev) != hipSuccess || hipDeviceGetAttribute(&cus, hipDeviceAttributeMultiprocessorCount, dev) != hipSuccess) { grid = -1; return; }
        if (hipFuncSetAttribute((const void*)fwd_kernel, hipFuncAttributeMaxDynamicSharedMemorySize, LDS_BYTES) != hipSuccess) { fprintf(stderr, "kernel_launch: hipFuncSetAttribute failed\n"); grid = -1; return; }
        (void)hipGetLastError();
        grid = cus;
        if (grid != 256) { fprintf(stderr, "kernel_launch: this kernel needs a 256-CU device (got %d)\n", cus); grid = -1; return; }
    }
    if (grid < 0) return;
    (void)hipMemsetAsync((char*)d_ws + WS_CTL, 0, CTL_ZERO_BYTES, stream);
    Args a{};
    for (int i = 0; i < 22; ++i) a.in[i] = (const float*)d_in[i];
    a.out = (float*)d_out; a.ws = (unsigned char*)d_ws;
    constexpr int NPH = 8;
    if (MK_N_LAUNCHES == 1) { a.ph_lo = 0; a.ph_hi = NPH; hipLaunchKernelGGL(fwd_kernel, dim3(grid), dim3(NTHREADS), LDS_BYTES, stream, a); }
    else { for (int k = 0; k < NPH; ++k) { a.ph_lo = k; a.ph_hi = k + 1; hipLaunchKernelGGL(fwd_kernel, dim3(grid), dim3(NTHREADS), LDS_BYTES, stream, a); } }
}
```

```cpp
#include <hip/hip_runtime.h>
#include <cstdio>
#include <cstdint>

#ifndef MK_N_LAUNCHES
#define MK_N_LAUNCHES 1
#endif

#define LAS __attribute__((address_space(3)))
#define GAS __attribute__((address_space(1)))
typedef unsigned short bf16_t;
typedef short bf16x8 __attribute__((ext_vector_type(8)));
typedef short s16x4 __attribute__((ext_vector_type(4)));
typedef float f32x4 __attribute__((ext_vector_type(4)));
typedef float f32x16 __attribute__((ext_vector_type(16)));
typedef unsigned u32x4 __attribute__((ext_vector_type(4)));
typedef unsigned u32x2 __attribute__((ext_vector_type(2)));

constexpr int NB = 32, T = 2048, D = 1024, TC = 256, M = NB * T, MC = NB * TC, MA = M + MC, TK = TC + T;
constexpr int NE = 16, CAP = 256, NITEM = NB * NE, NPROJ = 3072, NMOD = 6 * D;
constexpr float EPS = 1e-6f;
constexpr float C2 = 0.125f * 1.4426950408889634f;
constexpr float LAM_INIT = 0.2f;
constexpr int NWAVES = 8, NTHREADS = 512;

constexpr size_t MiB = 1u << 20;
constexpr size_t WS_CTL = 0, CTL_ZERO_BYTES = 1 * MiB;
constexpr size_t WS_MODP = 2 * MiB;
constexpr size_t WS_MOD = 16 * MiB;
constexpr size_t WS_TAB = 17 * MiB;
constexpr size_t WS_WIN = 18 * MiB;
constexpr size_t WS_WOUT = 24 * MiB;
constexpr size_t WS_WGU = 26 * MiB;
constexpr size_t WS_WDN = 90 * MiB;
constexpr size_t WS_AFFT = 122 * MiB;
constexpr size_t WS_SLOT = 126 * MiB;
constexpr size_t WS_IDX = 128 * MiB;
constexpr size_t WS_GATE = 129 * MiB;
constexpr size_t WS_XN = 130 * MiB;
constexpr size_t WS_Q = 274 * MiB;
constexpr size_t WS_K = 338 * MiB;
constexpr size_t WS_V = 410 * MiB;
constexpr size_t WS_GB = 482 * MiB;
constexpr size_t WS_U = 546 * MiB;
constexpr size_t WS_MIXIN = 610 * MiB;
constexpr size_t WS_MIX = 738 * MiB;
constexpr size_t WS_HMID = 274 * MiB;
constexpr size_t WS_Y = 610 * MiB;
constexpr size_t WS_H1 = 866 * MiB;
constexpr size_t WS_END = 994 * MiB;

__device__ __forceinline__ int opaque_tid() { int t = threadIdx.x; asm volatile("" : "+v"(t)); return t; }

namespace pg8 {
constexpr int BM = 256, BK = 64, HALF = 128, HTB = HALF * BK * 2, STAGE_BYTES = 8 * HTB;
__host__ __device__ __forceinline__ int lds_byte(int r, int c) { const int st = (r >> 4) * 2 + (c >> 5), rr = r & 15, cc = c & 31, ob = rr * 64 + cc * 2; return st * 1024 + (ob ^ (((ob >> 9) & 1) << 5)); }
__host__ __device__ __forceinline__ void stage_rc(int b, int& R, int& C) { const int st = b / 1024, sb = b % 1024, swz = sb ^ (((sb >> 9) & 1) << 5); R = (st >> 1) * 16 + swz / 64; C = (st & 1) * 32 + (swz % 64) / 2; }
__host__ __device__ __forceinline__ int perm32(int rho) { const int n = rho >> 4, i = rho & 15; return 8 * (i >> 2) + 4 * n + (i & 3); }

struct Unit { int pm, pn; };
struct Gemm { const bf16_t* A; const bf16_t* Bt; int K; const int* gidx; };

typedef float f32x2_t __attribute__((ext_vector_type(2))); typedef __bf16 bf16x2_t __attribute__((ext_vector_type(2)));
__device__ __forceinline__ unsigned cvt_pk_bf16(float lo, float hi) { const f32x2_t v = {lo, hi}; const bf16x2_t b = __builtin_convertvector(v, bf16x2_t); return __builtin_bit_cast(unsigned, b); }

struct EpiBf16 {
    static constexpr bool PERM = true, AFTER_DRAIN = false;
    bf16_t* O; int ldc;
    __device__ __forceinline__ void operator()(const f32x4 (&acc)[2][2][4][2], const Unit& u, int wr, int wc, int fr, int fq) const {
        const int row0 = u.pm * BM + wr * 64 + fr; const int col0 = u.pn * BM + wc * 32 + 8 * fq;
#pragma unroll
        for (int ai = 0; ai < 2; ++ai)
#pragma unroll
            for (int m = 0; m < 4; ++m) { bf16_t* rowp = O + (size_t)(row0 + ai * HALF + m * 16) * ldc + col0;
#pragma unroll
                for (int bj = 0; bj < 2; ++bj) { const f32x4 v0 = acc[ai][bj][m][0], v1 = acc[ai][bj][m][1];
                    u32x4 w; w.x = cvt_pk_bf16(v0[0], v0[1]); w.y = cvt_pk_bf16(v0[2], v0[3]); w.z = cvt_pk_bf16(v1[0], v1[1]); w.w = cvt_pk_bf16(v1[2], v1[3]);
                    *(u32x4*)(rowp + bj * HALF) = w; } }
    }
};

struct EpiProj {
    static constexpr bool PERM = true, AFTER_DRAIN = false;
    bf16_t *Q, *KA, *VA, *GB, *U; const float* tab;
    unsigned* kmaxh;
    __device__ __forceinline__ void operator()(const f32x4 (&acc)[2][2][4][2], const Unit& u, int wr, int wc, int fr, int fq) const {
        const int pn = u.pn; const bool ctx = u.pm >= 256;
        float km[2] = {0.f, 0.f};
#pragma unroll
        for (int ai = 0; ai < 2; ++ai)
#pragma unroll
            for (int m = 0; m < 4; ++m) {
                const int row = u.pm * BM + ai * HALF + wr * 64 + m * 16 + fr;
                int t, kvrow;
                if (!ctx) { const int b = row >> 11; t = row & 2047; kvrow = b * TK + TC + t; }
                else { const int rc = row - M; const int b = rc >> 8; t = 0; kvrow = b * TK + (rc & 255); }
                if (pn < 4) {
                    f32x4 cs0 = {1.f, 0.f, 1.f, 0.f}, cs1 = cs0, cs2 = cs0, cs3 = cs0;
                    if (!ctx) { const float* tp = tab + ((size_t)t * 32 + 16 * (wc & 1) + 4 * fq) * 2;
                        cs0 = *(const f32x4*)(tp); cs1 = *(const f32x4*)(tp + 4); }
                    (void)cs2; (void)cs3;
#pragma unroll
                    for (int bj = 0; bj < 2; ++bj) {
                        const f32x4 v0 = acc[ai][bj][m][0], v1 = acc[ai][bj][m][1];
                        float e0 = v0[0], o0 = v0[1], e1 = v0[2], o1 = v0[3], e2 = v1[0], o2 = v1[1], e3 = v1[2], o3 = v1[3];
                        if (pn >= 2) {
                            float ss = ((e0 * e0 + o0 * o0) + (e1 * e1 + o1 * o1)) + ((e2 * e2 + o2 * o2) + (e3 * e3 + o3 * o3));
                            ss += __shfl_xor(ss, 16); ss += __shfl_xor(ss, 32); km[bj] = fmaxf(km[bj], ss); }
                        float r0 = e0 * cs0[0] - o0 * cs0[1], s0 = o0 * cs0[0] + e0 * cs0[1];
                        float r1 = e1 * cs0[2] - o1 * cs0[3], s1 = o1 * cs0[2] + e1 * cs0[3];
                        float r2 = e2 * cs1[0] - o2 * cs1[1], s2 = o2 * cs1[0] + e2 * cs1[1];
                        float r3 = e3 * cs1[2] - o3 * cs1[3], s3 = o3 * cs1[2] + e3 * cs1[3];
                        const float sc = (pn < 2) ? C2 : 1.f;
                        u32x4 w; w.x = cvt_pk_bf16(r0 * sc, s0 * sc); w.y = cvt_pk_bf16(r1 * sc, s1 * sc); w.z = cvt_pk_bf16(r2 * sc, s2 * sc); w.w = cvt_pk_bf16(r3 * sc, s3 * sc);
                        const int col = (pn & 1) * 256 + bj * HALF + wc * 32 + 8 * fq;
                        bf16_t* dst = (pn < 2) ? (Q + (size_t)row * 512 + col) : (KA + (size_t)kvrow * 512 + col);
                        *(u32x4*)dst = w;
                    }
                } else if (pn < 8) {
#pragma unroll
                    for (int bj = 0; bj < 2; ++bj) {
                        const f32x4 v0 = acc[ai][bj][m][0], v1 = acc[ai][bj][m][1];
                        u32x4 w; w.x = cvt_pk_bf16(v0[0], v0[1]); w.y = cvt_pk_bf16(v0[2], v0[3]); w.z = cvt_pk_bf16(v1[0], v1[1]); w.w = cvt_pk_bf16(v1[2], v1[3]);
                        const int col = (pn & 1) * 256 + bj * HALF + wc * 32 + 8 * fq;
                        bf16_t* dst = (pn < 6) ? (VA + (size_t)kvrow * 512 + col) : (GB + (size_t)row * 512 + col);
                        *(u32x4*)dst = w;
                    }
                } else {
                    const f32x4 a0 = acc[ai][0][m][0], a1 = acc[ai][0][m][1], b0 = acc[ai][1][m][0], b1 = acc[ai][1][m][1];
                    u32x4 w; w.x = cvt_pk_bf16(a0[0] * b0[0], a0[1] * b0[1]); w.y = cvt_pk_bf16(a0[2] * b0[2], a0[3] * b0[3]);
                    w.z = cvt_pk_bf16(a1[0] * b1[0], a1[1] * b1[1]); w.w = cvt_pk_bf16(a1[2] * b1[2], a1[3] * b1[3]);
                    const int col = (pn - 8) * 128 + wc * 32 + 8 * fq;
                    *(u32x4*)(U + (size_t)row * 512 + col) = w;
                }
            }
        if (pn == 2 || pn == 3) {
            const int b = ctx ? (u.pm - 256) : (u.pm >> 3);
#pragma unroll
            for (int bj = 0; bj < 2; ++bj) { float v = km[bj];
#pragma unroll
                for (int d = 1; d < 16; d <<= 1) v = fmaxf(v, __shfl_xor(v, d));
                if (fr == 0 && fq == 0) atomicMax(kmaxh + ((b * 8 + (pn & 1) * 4 + bj * 2 + (wc >> 1)) * 2 + (wc & 1)), __float_as_uint(v)); }
        }
    }
};

struct EpiGU {
    static constexpr bool PERM = true, AFTER_DRAIN = false;
    bf16_t* H;
    __device__ __forceinline__ float silu(float x) const { return x * __builtin_amdgcn_rcpf(1.f + __expf(-x)); }
    __device__ __forceinline__ void operator()(const f32x4 (&acc)[2][2][4][2], const Unit& u, int wr, int wc, int fr, int fq) const {
#pragma unroll
        for (int ai = 0; ai < 2; ++ai)
#pragma unroll
            for (int m = 0; m < 4; ++m) {
                const int row = ai * HALF + wr * 64 + m * 16 + fr;
                const f32x4 a0 = acc[ai][0][m][0], a1 = acc[ai][0][m][1], b0 = acc[ai][1][m][0], b1 = acc[ai][1][m][1];
                u32x4 w; w.x = cvt_pk_bf16(silu(a0[0]) * b0[0], silu(a0[1]) * b0[1]); w.y = cvt_pk_bf16(silu(a0[2]) * b0[2], silu(a0[3]) * b0[3]);
                w.z = cvt_pk_bf16(silu(a1[0]) * b1[0], silu(a1[1]) * b1[1]); w.w = cvt_pk_bf16(silu(a1[2]) * b1[2], silu(a1[3]) * b1[3]);
                *(u32x4*)(H + (size_t)row * 1024 + u.pn * 128 + wc * 32 + 8 * fq) = w;
            }
    }
};
__device__ __forceinline__ unsigned pk4_fp8(float a, float b, float c, float d) { int w = 0; w = __builtin_amdgcn_cvt_pk_fp8_f32(a, b, w, false); w = __builtin_amdgcn_cvt_pk_fp8_f32(c, d, w, true); return (unsigned)w; }
constexpr float F8_ACT = 4.0f, F8_WGT = 64.0f, F8_INV = 1.0f / (4.0f * 64.0f);
struct EpiGU8 {
    static constexpr bool PERM = true, AFTER_DRAIN = false;
    unsigned char* H;
    __device__ __forceinline__ float hval(float g, float u) const {
        const float e = __builtin_amdgcn_exp2f(g * (-F8_INV * 1.4426950408889634f));
        const float r = __builtin_amdgcn_rcpf(1.f + e);
        return __builtin_amdgcn_fmed3f((g * u) * (r * (F8_INV * F8_INV * F8_ACT)), -448.f, 448.f); }
    __device__ __forceinline__ void operator()(const f32x4 (&acc)[2][2][4][2], const Unit& u, int wr, int wc, int fr, int fq) const {
        asm volatile("" : "+v"(fr));
#pragma unroll
        for (int ai = 0; ai < 2; ++ai)
#pragma unroll
            for (int m = 0; m < 4; ++m) {
                const int row = ai * HALF + wr * 64 + m * 16 + fr;
                const f32x4 a0 = acc[ai][0][m][0], a1 = acc[ai][0][m][1], b0 = acc[ai][1][m][0], b1 = acc[ai][1][m][1];
                u32x2 w; w.x = pk4_fp8(hval(a0[0], b0[0]), hval(a0[1], b0[1]), hval(a0[2], b0[2]), hval(a0[3], b0[3]));
                w.y = pk4_fp8(hval(a1[0], b1[0]), hval(a1[1], b1[1]), hval(a1[2], b1[2]), hval(a1[3], b1[3]));
                *(u32x2*)(H + (size_t)row * 1024 + u.pn * 128 + wc * 32 + 8 * fq) = w;
            }
    }
};
struct EpiDown {
    static constexpr bool PERM = true, AFTER_DRAIN = false;
    bf16_t* Y; const float* gate; float scale;
    __device__ __forceinline__ void operator()(const f32x4 (&acc)[2][2][4][2], const Unit& u, int wr, int wc, int fr, int fq) const {
        asm volatile("" : "+v"(fr));
#pragma unroll
        for (int ai = 0; ai < 2; ++ai)
#pragma unroll
            for (int m = 0; m < 4; ++m) {
                const int row = ai * HALF + wr * 64 + m * 16 + fr; const float g = gate[row] * scale;
#pragma unroll
                for (int bj = 0; bj < 2; ++bj) { const f32x4 v0 = acc[ai][bj][m][0] * g, v1 = acc[ai][bj][m][1] * g;
                    u32x4 w; w.x = cvt_pk_bf16(v0[0], v0[1]); w.y = cvt_pk_bf16(v0[2], v0[3]); w.z = cvt_pk_bf16(v1[0], v1[1]); w.w = cvt_pk_bf16(v1[2], v1[3]);
                    *(u32x4*)(Y + (size_t)row * 1024 + u.pn * BM + bj * HALF + wc * 32 + 8 * fq) = w; }
            }
    }
};

constexpr float F8_Y = 64.0f;
struct EpiDown8 {
    static constexpr bool PERM = true, AFTER_DRAIN = false;
    unsigned char* Y; const float* gate; float scale;
    __device__ __forceinline__ void operator()(const f32x4 (&acc)[2][2][4][2], const Unit& u, int wr, int wc, int fr, int fq) const {
        asm volatile("" : "+v"(fr));
#pragma unroll
        for (int ai = 0; ai < 2; ++ai)
#pragma unroll
            for (int m = 0; m < 4; ++m) {
                const int row = ai * HALF + wr * 64 + m * 16 + fr; const float g = gate[row] * scale;
#pragma unroll
                for (int bj = 0; bj < 2; ++bj) { f32x4 v0 = acc[ai][bj][m][0] * g, v1 = acc[ai][bj][m][1] * g;
#pragma unroll
                    for (int i = 0; i < 4; ++i) { v0[i] = __builtin_amdgcn_fmed3f(v0[i], -448.f, 448.f); v1[i] = __builtin_amdgcn_fmed3f(v1[i], -448.f, 448.f); }
                    u32x2 w; w.x = pk4_fp8(v0[0], v0[1], v0[2], v0[3]); w.y = pk4_fp8(v1[0], v1[1], v1[2], v1[3]);
                    *(u32x2*)(Y + (size_t)row * 1024 + u.pn * BM + bj * HALF + wc * 32 + 8 * fq) = w; }
            }
    }
};

struct SchedProj {
    int G, c;
    __device__ __forceinline__ bool next(int i, Unit& u) const {
        if (i < 12) { const int x = c & 7, j = c >> 3, ja = j & 7, jb = j >> 3, r = i / 3, q = i - 3 * r;
            u.pm = x + 8 * (8 * r + ja); u.pn = 4 * q + jb; return true; }
        if (i == 12 && c < 128) { u.pm = 256 + (c >> 2); u.pn = 2 + (c & 3); return true; }
        return false;
    }
    __device__ __forceinline__ void a_ready(const Unit&) const {}
    __device__ __forceinline__ void done(const Unit&) const {}
};
struct SchedPanel {
    int pm, ntn;
    __device__ __forceinline__ bool next(int i, Unit& u) const { if (i >= ntn) return false; u.pm = pm; u.pn = i; return true; }
    __device__ __forceinline__ void a_ready(const Unit&) const {}
    __device__ __forceinline__ void done(const Unit&) const {}
};

typedef int i32x4v __attribute__((ext_vector_type(4)));
typedef int i32x8v __attribute__((ext_vector_type(8)));
__device__ __forceinline__ i32x8v cat8(bf16x8 a, bf16x8 b) { const i32x4v x = __builtin_bit_cast(i32x4v, a), y = __builtin_bit_cast(i32x4v, b); return __builtin_shufflevector(x, y, 0, 1, 2, 3, 4, 5, 6, 7); }
template <bool F8> struct Frag;
template <> struct Frag<false> { bf16x8 v[2]; __device__ __forceinline__ void set(bf16x8 a, bf16x8 b) { v[0] = a; v[1] = b; } };
template <> struct Frag<true> { i32x8v v; __device__ __forceinline__ void set(bf16x8 a, bf16x8 b) { v = cat8(a, b); } };
__device__ __forceinline__ f32x4 frag_mma(const Frag<false>& b, const Frag<false>& a, f32x4 c) { c = __builtin_amdgcn_mfma_f32_16x16x32_bf16(b.v[0], a.v[0], c, 0, 0, 0); return __builtin_amdgcn_mfma_f32_16x16x32_bf16(b.v[1], a.v[1], c, 0, 0, 0); }
__device__ __forceinline__ f32x4 frag_mma(const Frag<true>& b, const Frag<true>& a, f32x4 c) {
    const int sc1 = 0x7f7f7f7f;
    asm volatile("v_mfma_scale_f32_16x16x128_f8f6f4 %0, %1, %2, %0, %3, %3 op_sel_hi:[0,0,0]" : "+v"(c) : "v"(b.v), "v"(a.v), "v"(sc1));
    return c; }
template <class Epi, class Sched, bool ALIGN_EPI, bool SP2, bool GATHER = false, bool F8 = false>
__device__ __forceinline__ void gemm_phase(LAS unsigned char* lds, const Gemm g, const Sched& S, const Epi& E) {
    const int tid = opaque_tid(), wid = __builtin_amdgcn_readfirstlane(tid >> 6), lane = tid & 63, wr = wid >> 2, wc = wid & 3, fr = lane & 15, fq = lane >> 4;
    const int K = g.K * (F8 ? 1 : 2), nt = K / 128;
    unsigned voffA[2][2], voffB[2];
#pragma unroll
    for (int i = 0; i < 2; ++i) { int R, C; stage_rc(tid * 16 + i * 8192, R, C); const int Rb = Epi::PERM ? ((R & ~31) + perm32(R & 31)) : R;
        if constexpr (GATHER) { voffA[0][i] = (unsigned)(g.gidx[R] * K + C * 2); voffA[1][i] = (unsigned)(g.gidx[HALF + R] * K + C * 2); }
        else { voffA[0][i] = (unsigned)(R * K + C * 2); voffA[1][i] = voffA[0][i]; }
        voffB[i] = (unsigned)(Rb * K + C * 2); }
    const size_t kstep = (size_t)(BK * 2);
    const size_t hstep = (size_t)HALF * K;
    const size_t hstepA = GATHER ? (size_t)0 : hstep;
    const size_t tstep = 2 * hstep;
    const unsigned ldsw = (unsigned)wid * 1024u;
    const int aoff = F8 ? lds_byte(wr * 64 + fr, (fq >> 1) * 32 + (fq & 1) * 16) : lds_byte(wr * 64 + fr, fq * 8), boff = F8 ? lds_byte(wc * 32 + fr, (fq >> 1) * 32 + (fq & 1) * 16) : lds_byte(wc * 32 + fr, fq * 8);
    const int aoff1 = F8 ? aoff + 16 : aoff + 1024, boff1 = F8 ? boff + 16 : boff + 1024;
#define PG8_SA(b, h) (((b) * 2 + (h)) * HTB)
#define PG8_SB(b, h) ((4 + (b) * 2 + (h)) * HTB)
#define PG8_STAGE(bufoff, gbase, voff) do { _Pragma("unroll") for (int _i = 0; _i < 2; ++_i) \
        __builtin_amdgcn_global_load_lds((const unsigned*)((const char*)(gbase) + (voff)[_i]), (LAS unsigned*)(lds + (bufoff) + ldsw + _i * 8192), 16, 0, 0); } while (0)
#define PG8_LDA(dst, b, h) do { _Pragma("unroll") for (int m = 0; m < 4; ++m) dst[m].set(*(const LAS bf16x8*)(lds + PG8_SA(b, h) + aoff + m * 2048), *(const LAS bf16x8*)(lds + PG8_SA(b, h) + aoff1 + m * 2048)); } while (0)
#define PG8_LDB(dst, b, h) do { _Pragma("unroll") for (int n = 0; n < 2; ++n) dst[n].set(*(const LAS bf16x8*)(lds + PG8_SB(b, h) + boff + n * 2048), *(const LAS bf16x8*)(lds + PG8_SB(b, h) + boff1 + n * 2048)); } while (0)
#define PG8_MMA(ai, bj, At, Bt) do { __builtin_amdgcn_s_setprio(1); _Pragma("unroll") for (int m = 0; m < 4; ++m) _Pragma("unroll") for (int n = 0; n < 2; ++n) \
        acc[ai][bj][m][n] = frag_mma(Bt[n], At[m], acc[ai][bj][m][n]); __builtin_amdgcn_s_setprio(0); } while (0)
#define PG8_WAIT_V(n) asm volatile("s_waitcnt vmcnt(" #n ")" ::: "memory")
#define PG8_WAIT_L(n) asm volatile("s_waitcnt lgkmcnt(" #n ")" ::: "memory")
#define PG8_BAR __builtin_amdgcn_s_barrier()
#define PG8_SCHED __builtin_amdgcn_sched_barrier(0)
    Unit cur, nxt; int ui = 0;
    if (!S.next(0, cur)) return;
    f32x4 acc[2][2][4][2];
#pragma unroll
    for (int a = 0; a < 2; ++a)
#pragma unroll
        for (int b = 0; b < 2; ++b)
#pragma unroll
            for (int m = 0; m < 4; ++m)
#pragma unroll
                for (int n = 0; n < 2; ++n) acc[a][b][m][n] = (f32x4){0.f, 0.f, 0.f, 0.f};
    Frag<F8> At[4], B0[2], B1[2];
    const char* cA = (const char*)g.A + (size_t)cur.pm * tstep; const char* cB = (const char*)g.Bt + (size_t)cur.pn * tstep;
    S.a_ready(cur);
    if constexpr (SP2) {
        PG8_STAGE(PG8_SB(0, 0), cB, voffB); PG8_STAGE(PG8_SB(0, 1), cB + hstep, voffB); PG8_STAGE(PG8_SA(0, 0), cA, voffA[0]); PG8_STAGE(PG8_SA(0, 1), cA + hstepA, voffA[GATHER ? 1 : 0]);
        if (wr == 1) PG8_BAR;
        PG8_WAIT_V(2); PG8_BAR;
        PG8_STAGE(PG8_SB(1, 0), cB + kstep, voffB); PG8_STAGE(PG8_SA(1, 0), cA + kstep, voffA[0]); PG8_STAGE(PG8_SB(1, 1), cB + hstep + kstep, voffB);
        PG8_WAIT_V(6); PG8_BAR;
    } else {
        PG8_STAGE(PG8_SB(0, 0), cB, voffB); PG8_STAGE(PG8_SA(0, 0), cA, voffA[0]); PG8_STAGE(PG8_SB(0, 1), cB + hstep, voffB); PG8_STAGE(PG8_SA(0, 1), cA + hstepA, voffA[GATHER ? 1 : 0]);
        if (wr == 1) PG8_BAR;
        PG8_WAIT_V(4); PG8_BAR;
        PG8_STAGE(PG8_SB(1, 0), cB + kstep, voffB); PG8_STAGE(PG8_SA(1, 0), cA + kstep, voffA[0]); PG8_STAGE(PG8_SB(1, 1), cB + hstep + kstep, voffB);
        PG8_WAIT_V(6); PG8_BAR;
    }
    for (;;) {
        const bool has_next = S.next(ui + 1, nxt);
        const char* nA = has_next ? (const char*)g.A + (size_t)nxt.pm * tstep : cA; const char* nB = has_next ? (const char*)g.Bt + (size_t)nxt.pn * tstep : cB;
#pragma unroll 1
        for (int t = 0; t < nt; t += 2) {
            const bool last = (t == nt - 2);
            if constexpr (F8) { asm volatile("" : "+v"(voffA[0][0]), "+v"(voffA[0][1]), "+v"(voffB[0]), "+v"(voffB[1])); if constexpr (GATHER) asm volatile("" : "+v"(voffA[1][0]), "+v"(voffA[1][1])); }
            const char* a1 = cA + (size_t)(t + 1) * kstep;
            const char* a2 = last ? nA : cA + (size_t)(t + 2) * kstep; const char* b2 = last ? nB : cB + (size_t)(t + 2) * kstep;
            const char* a3 = a2 + kstep; const char* b3 = b2 + kstep;
            if (last && has_next) S.a_ready(nxt);
            if constexpr (SP2) {
            PG8_LDB(B0, 0, 0); PG8_LDB(B1, 0, 1); PG8_SCHED; PG8_LDA(At, 0, 0); PG8_STAGE(PG8_SA(1, 1), a1 + hstepA, voffA[GATHER ? 1 : 0]);
            PG8_WAIT_V(8); PG8_WAIT_L(0); PG8_BAR; PG8_MMA(0, 0, At, B0); PG8_MMA(0, 1, At, B1); PG8_BAR; PG8_SCHED;
            PG8_LDA(At, 0, 1); PG8_STAGE(PG8_SB(0, 0), b2, voffB); PG8_STAGE(PG8_SB(0, 1), b2 + hstep, voffB); PG8_STAGE(PG8_SA(0, 0), a2, voffA[0]);
            PG8_WAIT_V(8); PG8_WAIT_L(0); PG8_BAR; PG8_MMA(1, 0, At, B0); PG8_MMA(1, 1, At, B1); PG8_BAR; PG8_SCHED;
            PG8_LDB(B0, 1, 0); PG8_LDB(B1, 1, 1); PG8_SCHED; PG8_LDA(At, 1, 0); PG8_STAGE(PG8_SA(0, 1), a2 + hstepA, voffA[GATHER ? 1 : 0]);
            PG8_WAIT_V(8); PG8_WAIT_L(0); PG8_BAR; PG8_MMA(0, 0, At, B0); PG8_MMA(0, 1, At, B1); PG8_BAR; PG8_SCHED;
            PG8_LDA(At, 1, 1); PG8_STAGE(PG8_SB(1, 0), b3, voffB); PG8_STAGE(PG8_SB(1, 1), b3 + hstep, voffB); PG8_STAGE(PG8_SA(1, 0), a3, voffA[0]);
            PG8_WAIT_V(8); PG8_WAIT_L(0); PG8_BAR; PG8_MMA(1, 0, At, B0); PG8_MMA(1, 1, At, B1); PG8_BAR; PG8_SCHED;
            } else {
            PG8_LDB(B0, 0, 0); PG8_SCHED; PG8_LDA(At, 0, 0); PG8_STAGE(PG8_SA(1, 1), a1 + hstepA, voffA[GATHER ? 1 : 0]);
            PG8_WAIT_L(8); PG8_BAR; PG8_WAIT_L(0); PG8_MMA(0, 0, At, B0); PG8_BAR; PG8_SCHED;
            PG8_LDB(B1, 0, 1); PG8_STAGE(PG8_SB(0, 0), b2, voffB);
            PG8_BAR; PG8_WAIT_L(0); PG8_MMA(0, 1, At, B1); PG8_BAR;
            PG8_LDA(At, 0, 1); PG8_STAGE(PG8_SA(0, 0), a2, voffA[0]);
            PG8_BAR; PG8_WAIT_L(0); PG8_MMA(1, 0, At, B0); PG8_BAR; PG8_SCHED;
            PG8_STAGE(PG8_SB(0, 1), b2 + hstep, voffB);
            PG8_WAIT_V(6); PG8_BAR; PG8_MMA(1, 1, At, B1); PG8_BAR;
            PG8_LDB(B0, 1, 0); PG8_SCHED; PG8_LDA(At, 1, 0); PG8_STAGE(PG8_SA(0, 1), a2 + hstepA, voffA[GATHER ? 1 : 0]);
            PG8_WAIT_L(8); PG8_BAR; PG8_WAIT_L(0); PG8_MMA(0, 0, At, B0); PG8_BAR; PG8_SCHED;
            PG8_LDB(B1, 1, 1); PG8_STAGE(PG8_SB(1, 0), b3, voffB);
            PG8_BAR; PG8_WAIT_L(0); PG8_MMA(0, 1, At, B1); PG8_BAR;
            PG8_LDA(At, 1, 1); PG8_STAGE(PG8_SA(1, 0), a3, voffA[0]);
            PG8_BAR; PG8_WAIT_L(0); PG8_MMA(1, 0, At, B0); PG8_BAR; PG8_SCHED;
            PG8_STAGE(PG8_SB(1, 1), b3 + hstep, voffB);
            PG8_WAIT_V(6); PG8_BAR; PG8_MMA(1, 1, At, B1); PG8_BAR;
            }
        }
        if constexpr (ALIGN_EPI) { if (wr == 0) PG8_BAR; }
        if constexpr (F8) asm volatile("s_nop 15\n\ts_nop 7" ::: "memory");
        E(acc, cur, wr, wc, fr, fq); S.done(cur);
        if (!has_next) break;
#pragma unroll
        for (int a = 0; a < 2; ++a)
#pragma unroll
            for (int b = 0; b < 2; ++b)
#pragma unroll
                for (int m = 0; m < 4; ++m)
#pragma unroll
                    for (int n = 0; n < 2; ++n) acc[a][b][m][n] = (f32x4){0.f, 0.f, 0.f, 0.f};
        cur = nxt; cA = nA; cB = nB; ++ui;
        if constexpr (ALIGN_EPI) { if (wr == 1) PG8_BAR; }
    }
    PG8_WAIT_V(0);
    if constexpr (!ALIGN_EPI) { if (wr == 0) PG8_BAR; }
    PG8_BAR;
#undef PG8_SA
#undef PG8_SB
#undef PG8_STAGE
#undef PG8_LDA
#undef PG8_LDB
#undef PG8_MMA
#undef PG8_WAIT_V
#undef PG8_WAIT_L
#undef PG8_BAR
#undef PG8_SCHED
}
}

typedef GAS unsigned gu32;
#define RLX_AGENT __ATOMIC_RELAXED, __HIP_MEMORY_SCOPE_AGENT
#define LDS_WAIT() asm volatile("s_waitcnt lgkmcnt(0)" ::: "memory")
#define VM_WAIT() asm volatile("s_waitcnt vmcnt(0)" ::: "memory")
__device__ __forceinline__ unsigned pk2(float lo, float hi) { return pg8::cvt_pk_bf16(lo, hi); }
__device__ __forceinline__ float bf2f(unsigned short h) { return __uint_as_float((unsigned)h << 16); }
__device__ __forceinline__ float bflo(unsigned w) { return __uint_as_float(w << 16); }
__device__ __forceinline__ float bfhi(unsigned w) { return __uint_as_float(w & 0xffff0000u); }
__device__ __forceinline__ float wave_sum(float v) {
    v += __builtin_bit_cast(float, __builtin_amdgcn_update_dpp(0, __builtin_bit_cast(int, v), 0xB1, 0xf, 0xf, true));
    v += __builtin_bit_cast(float, __builtin_amdgcn_update_dpp(0, __builtin_bit_cast(int, v), 0x4E, 0xf, 0xf, true));
    v += __builtin_bit_cast(float, __builtin_amdgcn_update_dpp(0, __builtin_bit_cast(int, v), 0x141, 0xf, 0xf, true));
    v += __builtin_bit_cast(float, __builtin_amdgcn_update_dpp(0, __builtin_bit_cast(int, v), 0x140, 0xf, 0xf, true));
    v += __builtin_bit_cast(float, __builtin_amdgcn_update_dpp(0, __builtin_bit_cast(int, v), 0x142, 0xa, 0xf, false));
    v += __builtin_bit_cast(float, __builtin_amdgcn_update_dpp(0, __builtin_bit_cast(int, v), 0x143, 0xc, 0xf, false));
    return __builtin_bit_cast(float, __builtin_amdgcn_readlane(__builtin_bit_cast(int, v), 63));
}

#define XB_TMO      128
#define XB_XCNT(j)  (256  + 64 * (j))
#define XB_XSUB(j)  (1280 + 64 * (j))
#define XB_XGEN(j)  (2304 + 64 * (j))
#define XB_TOP      3328
#define XB_TOPGEN   3392
#define XCD_BAR_WORDS 3456
#define XB_SPIN_CAP (1u << 18)
__device__ __forceinline__ unsigned xb_ld(unsigned* p)              { return __hip_atomic_load(p, __ATOMIC_RELAXED, __HIP_MEMORY_SCOPE_AGENT); }
__device__ __forceinline__ unsigned xb_add(unsigned* p, unsigned v) { return __hip_atomic_fetch_add(p, v, __ATOMIC_RELAXED, __HIP_MEMORY_SCOPE_AGENT); }
__device__ __forceinline__ unsigned xb_xcc_id() { return (unsigned)__builtin_amdgcn_s_getreg((3 << 11) | 20) & 0xFu; }
#define XB_SPIN(cond, bar) do { unsigned _sp = 0; while (cond) { __builtin_amdgcn_s_sleep(1); \
    if ((++_sp & 255u) == 0u) { if (xb_ld(&(bar)[XB_TMO])) break; if (_sp > XB_SPIN_CAP) { atomicAdd(&(bar)[XB_TMO], 1u); break; } } } } while (0)
struct XcdBarrier { unsigned* bar; unsigned x; volatile LAS unsigned* st; };
__device__ __forceinline__ XcdBarrier xcd_barrier_post(unsigned* bar, volatile LAS unsigned* st) {
    XcdBarrier b; b.bar = bar; b.x = xb_xcc_id(); b.st = st;
    if (threadIdx.x == 0) (void)xb_add(&bar[XB_XCNT(b.x)], 1u);
    return b;
}
__device__ __forceinline__ void xcd_barrier_complete(unsigned* bar, unsigned x, unsigned& nloc, unsigned& nx) {
    const unsigned G = gridDim.x * gridDim.y * gridDim.z;
    unsigned sum, cnt, mine, sp = 0u;
    for (;;) {
        sum = 0u; cnt = 0u; mine = 0u;
#pragma unroll
        for (unsigned j = 0; j < 16; ++j) { const unsigned c = xb_ld(&bar[XB_XCNT(j)]); sum += c; cnt += (c > 0u) ? 1u : 0u; mine = (j == x) ? c : mine; }
        if (sum == G) break;
        __builtin_amdgcn_s_sleep(1);
        if ((++sp & 255u) == 0u) { if (xb_ld(&bar[XB_TMO])) break; if (sp > XB_SPIN_CAP) { atomicAdd(&bar[XB_TMO], 1u); break; } }
    }
    nloc = mine > 0u ? mine : 1u; nx = cnt > 0u ? cnt : 1u;
}
__device__ __forceinline__ void xcd_barrier(const XcdBarrier& b) {
    asm volatile("s_waitcnt vmcnt(0)" ::: "memory");
    __syncthreads();
    if (threadIdx.x == 0) {
        unsigned* bar = b.bar;
        __builtin_amdgcn_s_waitcnt(0);
        unsigned nloc = b.st[0], nx = b.st[1];
        if (nloc == 0u) { xcd_barrier_complete(bar, b.x, nloc, nx); b.st[0] = nloc; b.st[1] = nx; }
        const unsigned old = xb_add(&bar[XB_XSUB(b.x)], 1u);
        const unsigned gen = old / nloc;
        if (old + 1u == (gen + 1u) * nloc) {
            __builtin_amdgcn_fence(__ATOMIC_RELEASE, "agent");
            asm volatile("s_waitcnt vmcnt(0)" ::: "memory");
            const unsigned og = xb_add(&bar[XB_TOP], 1u);
            const unsigned tg = og / nx;
            if (og + 1u == (tg + 1u) * nx) xb_add(&bar[XB_TOPGEN], 1u);
            else XB_SPIN(xb_ld(&bar[XB_TOPGEN]) == tg, bar);
            __builtin_amdgcn_fence(__ATOMIC_ACQUIRE, "agent");
            xb_add(&bar[XB_XGEN(b.x)], 1u);
            asm volatile("s_waitcnt vmcnt(0)" ::: "memory");
        } else {
            XB_SPIN(xb_ld(&bar[XB_XGEN(b.x)]) == gen, bar);
            __builtin_amdgcn_fence(__ATOMIC_ACQUIRE, "agent");
            asm volatile("s_waitcnt vmcnt(0)" ::: "memory");
        }
    }
    __syncthreads();
}

constexpr int RING_BYTES = 131072;
constexpr int LDSCTL_OFF = RING_BYTES, MISC_OFF = LDSCTL_OFF + 320;
constexpr int LDS_BYTES = 147456;
constexpr int CW_BAR = 4096;
constexpr int CW_KMAX = 65536;

struct Args { const float* in[22]; float* out; unsigned char* ws; int ph_lo, ph_hi; };
enum { I_X = 0, I_C, I_CTX, I_CCTX, I_WADA, I_BADA, I_NPRE_MIX, I_NPOST_MIX, I_NPRE_FFN, I_NPOST_FFN, I_WIN, I_CONVW, I_LQ1, I_LK1, I_LQ2, I_LK2, I_SUBLN, I_WOUT, I_WROUTER, I_WGATE, I_WUP, I_WDOWN };

__device__ __forceinline__ int win_dest(int n) {
    if (n < 1024) { const int j = n & 63; const int p = ((j >> 5) << 5) + ((j & 15) << 1) + ((j >> 4) & 1); return (n & ~63) + p; }
    if (n < 2048) return n;
    int c = n - 2048; const int isx = c >= 512; c &= 511; return 2048 + ((c >> 7) << 8) + (isx << 7) + (c & 127);
}
template <int MODE>
__device__ __forceinline__ int tr_dest(int n) {
    if (MODE == 0) return n;
    if (MODE == 1) return win_dest(n);
    if (MODE == 2) return ((n >> 7) << 8) + (n & 127);
    return ((n >> 7) << 8) + 128 + (n & 127);
}
template <int MODE>
__device__ __forceinline__ void p0_transpose_item_f8(const float* W, int K, int N, unsigned char* WT, LAS float* scr, int item, int lane) {
    const int nblk = N / 32, kb = item / nblk, nb = item % nblk, k0 = 64 * kb, n0 = 32 * nb;
#pragma unroll 8
    for (int i = 0; i < 32; ++i) { const int kk = 2 * i + (lane >> 5); scr[kk * 33 + (lane & 31)] = __builtin_nontemporal_load(W + (size_t)(k0 + kk) * N + n0 + (lane & 31)) * pg8::F8_WGT; }
    LDS_WAIT(); asm volatile("" ::: "memory");
    const int c = lane & 7;
#pragma unroll
    for (int j = 0; j < 4; ++j) { const int n = (lane >> 3) + 8 * j; const LAS float* s = scr + (8 * c) * 33 + n;
        u32x2 o; o.x = pg8::pk4_fp8(s[0 * 33], s[1 * 33], s[2 * 33], s[3 * 33]); o.y = pg8::pk4_fp8(s[4 * 33], s[5 * 33], s[6 * 33], s[7 * 33]);
        *(GAS u32x2*)(WT + (size_t)tr_dest<MODE>(n0 + n) * K + k0 + 8 * c) = o; }
    LDS_WAIT(); asm volatile("" ::: "memory");
}
template <int MODE>
__device__ __forceinline__ void p0_transpose_item(const float* W, int K, int N, bf16_t* WT, LAS float* scr, int item, int lane) {
    const int nblk = N / 32, kb = item / nblk, nb = item % nblk, k0 = 64 * kb, n0 = 32 * nb;
#pragma unroll 8
    for (int i = 0; i < 32; ++i) { const int kk = 2 * i + (lane >> 5); scr[kk * 33 + (lane & 31)] = W[(size_t)(k0 + kk) * N + n0 + (lane & 31)]; }
    LDS_WAIT(); asm volatile("" ::: "memory");
    const int c = lane & 7;
#pragma unroll
    for (int j = 0; j < 4; ++j) { const int n = (lane >> 3) + 8 * j; const LAS float* s = scr + (8 * c) * 33 + n;
        u32x4 o; o.x = pk2(s[0 * 33], s[1 * 33]); o.y = pk2(s[2 * 33], s[3 * 33]); o.z = pk2(s[4 * 33], s[5 * 33]); o.w = pk2(s[6 * 33], s[7 * 33]);
        *(GAS u32x4*)(WT + (size_t)tr_dest<MODE>(n0 + n) * K + k0 + 8 * c) = o; }
    LDS_WAIT(); asm volatile("" ::: "memory");
}

__device__ __forceinline__ void p0_prologue(const Args& a, LAS unsigned char* lds, int vcu, int G) {
    const int tid = opaque_tid(), lane = tid & 63, wave = __builtin_amdgcn_readfirstlane(tid >> 6);
    LAS float* scr = (LAS float*)(lds + wave * 16384);
    const int gw = vcu * NWAVES + wave, NGW = G * NWAVES;
    unsigned char* ws = a.ws;
    if (gw < 96 * 16) {
        float* MODP = (float*)(ws + WS_MODP);
        const float* wada = a.in[I_WADA];
        for (int it = gw; it < 96 * 16; it += NGW) {
            const int cg = it % 96, kc = it / 96;
            for (int b = 0; b < 33; ++b) { const float v = (b < 32) ? a.in[I_C][b * D + kc * 64 + lane] : a.in[I_CCTX][kc * 64 + lane]; scr[b * 64 + lane] = v / (1.f + __expf(-v)); }
            LDS_WAIT(); asm volatile("" ::: "memory");
            float acc[33];
#pragma unroll
            for (int b = 0; b < 33; ++b) acc[b] = 0.f;
            const float* wp = wada + (size_t)(kc * 64) * NMOD + cg * 64 + lane;
#pragma unroll 2
            for (int k = 0; k < 64; k += 4) {
                const float w0 = __builtin_nontemporal_load(wp + (size_t)(k + 0) * NMOD), w1 = __builtin_nontemporal_load(wp + (size_t)(k + 1) * NMOD),
                            w2 = __builtin_nontemporal_load(wp + (size_t)(k + 2) * NMOD), w3 = __builtin_nontemporal_load(wp + (size_t)(k + 3) * NMOD);
#pragma unroll
                for (int b = 0; b < 33; ++b) { const f32x4 sv4 = *(const LAS f32x4*)(scr + b * 64 + k); acc[b] += (sv4.x * w0 + sv4.y * w1) + (sv4.z * w2 + sv4.w * w3); }
            }
#pragma unroll
            for (int b = 0; b < 33; ++b) MODP[((size_t)kc * 33 + b) * NMOD + cg * 64 + lane] = acc[b];
            LDS_WAIT(); asm volatile("" ::: "memory");
        }
    } else {
        float* tab = (float*)(ws + WS_TAB);
        const int nw = NGW - 96 * 16;
        for (int e = (gw - 96 * 16) * 64 + lane; e < T * 32; e += nw * 64) {
            const int t = e >> 5, i = e & 31;
            const float inv = powf(10000.0f, -(float)(2 * (i & 15)) / 32.0f);
            const float pos = (i < 16) ? (float)(t >> 6) : (float)(t & 63);
            const float ang = pos * inv;
            tab[2 * e] = cosf(ang); tab[2 * e + 1] = sinf(ang);
        }
    }
}
__device__ __forceinline__ void inout_weight_copies(const Args& a, LAS unsigned char* lds, int vcu, int G) {
    const int tid = opaque_tid(), lane = tid & 63, wave = __builtin_amdgcn_readfirstlane(tid >> 6);
    LAS float* scr = (LAS float*)(lds + 16384 + wave * 12288);
    const int gw = vcu * NWAVES + wave, NGW = G * NWAVES;
    unsigned char* ws = a.ws;
    constexpr int I_IN = (D / 64) * (NPROJ / 32), I_OUT = (D / 64) * (D / 32);
    constexpr int NITEMS = I_IN + I_OUT;
    bf16_t* Win_t = (bf16_t*)(ws + WS_WIN); bf16_t* Wout_t = (bf16_t*)(ws + WS_WOUT);
    for (int it = gw; it < NITEMS; it += NGW) {
        int r = it;
        if (r < I_IN) { p0_transpose_item<1>(a.in[I_WIN], D, NPROJ, Win_t, scr, r, lane); continue; } r -= I_IN;
        p0_transpose_item<0>(a.in[I_WOUT], D, D, Wout_t, scr, r, lane);
    }
}
__device__ __forceinline__ void expert_weight_copies(const Args& a, LAS unsigned char* lds, int gw0  , int ngroups, int r_lo, int r_hi) {
    const int tid = opaque_tid(), lane = tid & 63, wave = __builtin_amdgcn_readfirstlane(tid >> 6);
    LAS float* scr = (LAS float*)(lds + wave * 16384);
    const int gw = gw0 * NWAVES + wave, NGW = ngroups * NWAVES;
    unsigned char* ws = a.ws;
    constexpr int I_EXP = (D / 64) * (D / 32);
    unsigned char* Wgu_t = ws + WS_WGU; unsigned char* Wdn_t = ws + WS_WDN;
    for (int r = r_lo + gw; r < r_hi; r += NGW) {
        const int e = r / (3 * I_EXP), q = (r % (3 * I_EXP)) / I_EXP, rr = r % I_EXP;
        if (q == 0) p0_transpose_item_f8<2>(a.in[I_WGATE] + (size_t)e * D * D, D, D, Wgu_t + (size_t)e * 2048 * D, scr, rr, lane);
        else if (q == 1) p0_transpose_item_f8<3>(a.in[I_WUP] + (size_t)e * D * D, D, D, Wgu_t + (size_t)e * 2048 * D, scr, rr, lane);
        else p0_transpose_item_f8<0>(a.in[I_WDOWN] + (size_t)e * D * D, D, D, Wdn_t + (size_t)e * D * D, scr, rr, lane);
    }
    __syncthreads();
}

struct RowF { f32x4 v[4]; };
__device__ __forceinline__ void row_load(RowF& r, const float* xrow, int lane) {
    const f32x4* xr = (const f32x4*)xrow + lane;
#pragma unroll
    for (int j = 0; j < 4; ++j) r.v[j] = __builtin_nontemporal_load(xr + 64 * j);
}
__device__ __forceinline__ void norm_mod_row(const RowF& r, bf16_t* orow, const float* gain, const LAS float* sc, const LAS float* sh, int lane) {
    const f32x4* gr = (const f32x4*)gain + lane;
    float s = 0.f;
#pragma unroll
    for (int j = 0; j < 4; ++j) s += (r.v[j].x * r.v[j].x + r.v[j].y * r.v[j].y) + (r.v[j].z * r.v[j].z + r.v[j].w * r.v[j].w);
    const float rstd = 1.0f / sqrtf(wave_sum(s) * (1.f / D) + EPS);
    u32x2* o8 = (u32x2*)orow + lane;
#pragma unroll
    for (int j = 0; j < 4; ++j) { const f32x4 g = gr[64 * j]; const f32x4 c1 = *(const LAS f32x4*)(sc + 4 * lane + 256 * j), h1 = *(const LAS f32x4*)(sh + 4 * lane + 256 * j);
        const f32x4 y = (r.v[j] * rstd) * g; const f32x4 z = y * (c1 + 1.0f) + h1;
        u32x2 w; w.x = pk2(z.x, z.y); w.y = pk2(z.z, z.w); o8[64 * j] = w; }
}
__device__ __forceinline__ void p1_xn(const Args& a, LAS unsigned char* lds, int c, int G) {
    const int tid = opaque_tid(), lane = tid & 63, wave = __builtin_amdgcn_readfirstlane(tid >> 6);
    unsigned char* ws = a.ws;
    const float* MODP = (const float*)(ws + WS_MODP); float* MOD = (float*)(ws + WS_MOD); const float* bada = a.in[I_BADA];
    { const int per = (33 * NMOD + G - 1) / G;
      for (int i = c * per + tid; i < (c + 1) * per && i < 33 * NMOD; i += NTHREADS) { const int r = i / NMOD, n = i - r * NMOD; float s = bada[n];
#pragma unroll
            for (int kc = 0; kc < 16; ++kc) s += MODP[((size_t)kc * 33 + r) * NMOD + n];
            MOD[i] = s; } }
    LAS float* sv = (LAS float*)lds;
    bf16_t* XN = (bf16_t*)(ws + WS_XN);
    const float* X = a.in[I_X]; const float* CTX = a.in[I_CTX]; const float* gain = a.in[I_NPRE_MIX];
    for (int p = c; p < 256; p += G) {
        const int b = p >> 3;
        const int rbase = p * 256 + wave * 32;
        RowF a0, a1;
        row_load(a0, X + (size_t)rbase * D, lane); row_load(a1, X + (size_t)(rbase + 16) * D, lane);
        __syncthreads();
        for (int n = tid; n < 4096; n += NTHREADS) { const int r = (n < 2048) ? b : 32; const int col = n & 2047; float s = bada[col];
#pragma unroll
            for (int kc = 0; kc < 16; ++kc) s += MODP[((size_t)kc * 33 + r) * NMOD + col];
            sv[n] = s; }
        __syncthreads();
        for (int i = 0; i < 16; ++i) {
            RowF n0, n1;
            if (i + 1 < 16) { row_load(n0, X + (size_t)(rbase + i + 1) * D, lane); row_load(n1, X + (size_t)(rbase + 16 + i + 1) * D, lane); }
            else { const int crow = p * 32 + wave * 4; row_load(n0, CTX + (size_t)crow * D, lane); row_load(n1, CTX + (size_t)(crow + 1) * D, lane); }
            norm_mod_row(a0, XN + (size_t)(rbase + i) * D, gain, sv + 1024, sv, lane);
            norm_mod_row(a1, XN + (size_t)(rbase + 16 + i) * D, gain, sv + 1024, sv, lane);
            a0 = n0; a1 = n1;
        }
        {
            const int crow = p * 32 + wave * 4;
            RowF n0, n1;
            row_load(n0, CTX + (size_t)(crow + 2) * D, lane); row_load(n1, CTX + (size_t)(crow + 3) * D, lane);
            norm_mod_row(a0, XN + (size_t)(M + crow) * D, gain, sv + 3072, sv + 2048, lane);
            norm_mod_row(a1, XN + (size_t)(M + crow + 1) * D, gain, sv + 3072, sv + 2048, lane);
            norm_mod_row(n0, XN + (size_t)(M + crow + 2) * D, gain, sv + 3072, sv + 2048, lane);
            norm_mod_row(n1, XN + (size_t)(M + crow + 3) * D, gain, sv + 3072, sv + 2048, lane);
        }
    }
}

namespace att {
constexpr int KP = 272, KBUF = 64 * KP, VBUF = 16384;
constexpr int OFF_K = 0, OFF_V = 2 * KBUF, OFF_WSF = OFF_V + 2 * VBUF, OFF_END = OFF_WSF + NWAVES * 256;
static_assert(OFF_WSF >= 65536 && OFF_END <= RING_BYTES, "attention LDS map");
constexpr int NT = TK / 64;
constexpr float THR = 8.0f;
__device__ __forceinline__ int crow(int r, int hi) { return (r & 3) + 8 * (r >> 2) + 4 * hi; }
__device__ __forceinline__ float max3f(float a, float b, float c) { float r; asm("v_max3_f32 %0, %1, %2, %3" : "=v"(r) : "v"(a), "v"(b), "v"(c)); return r; }
__device__ __forceinline__ float max2f(float a, float b) { float r; asm("v_max_f32_e32 %0, %1, %2" : "=v"(r) : "v"(a), "v"(b)); return r; }
__device__ __forceinline__ s16x4 vtr(const LAS unsigned char* p) { return __builtin_bit_cast(s16x4, __builtin_amdgcn_ds_read_tr16_b64_v4i16((LAS s16x4*)p)); }

#define ATT_BAR() asm volatile("s_waitcnt lgkmcnt(0)\n\ts_barrier" ::: "memory")
#define ATT_SB() __builtin_amdgcn_sched_barrier(0)
#define ATT_KLD(i, KF) KF = *(const LAS bf16x8*)(kb_ + ((i) & 1) * (32 * KP) + ((i) >> 1) * 32)
#define ATT_XSTEP(i, KC, KN) do { if ((i) + 2 < 8) { ATT_KLD((i) + 2, KN); } \
    if ((i) == 0) p0 = __builtin_amdgcn_mfma_f32_32x32x16_bf16(KC, qr[0], negref, 0, 0, 0); \
    else if ((i) == 1) p1 = __builtin_amdgcn_mfma_f32_32x32x16_bf16(KC, qr[0], negref, 0, 0, 0); \
    else if (((i) & 1) == 0) p0 = __builtin_amdgcn_mfma_f32_32x32x16_bf16(KC, qr[(i) >> 1], p0, 0, 0, 0); else p1 = __builtin_amdgcn_mfma_f32_32x32x16_bf16(KC, qr[(i) >> 1], p1, 0, 0, 0); ATT_SB(); } while (0)
#define ATT_X(kcur) do { \
    const LAS unsigned char* kb_ = lds + OFF_K + (kcur) * KBUF + koff; \
    bf16x8 ka_, kb2_, kc_; \
    ATT_KLD(0, ka_); ATT_KLD(1, kb2_); \
    ATT_SB(); \
    ATT_XSTEP(0, ka_, kc_); ATT_XSTEP(1, kb2_, ka_); ATT_XSTEP(2, kc_, kb2_); ATT_XSTEP(3, ka_, kc_); \
    ATT_XSTEP(4, kb2_, ka_); ATT_XSTEP(5, kc_, kb2_); ATT_XSTEP(6, ka_, kc_); ATT_XSTEP(7, kb2_, ka_); \
} while (0)
#define ATT_EXP2(i, PWN) do { \
    const float e0_ = __builtin_amdgcn_exp2f((i) < 8 ? p0[2 * ((i) & 7)] : p1[2 * ((i) & 7)]), e1_ = __builtin_amdgcn_exp2f((i) < 8 ? p0[2 * ((i) & 7) + 1] : p1[2 * ((i) & 7) + 1]); \
    sacc_ += e0_ + e1_; PWN[(i) >> 2][(i) & 3] = pk2(e0_, e1_); asm volatile("" : "+v"(PWN[(i) >> 2]), "+v"(sacc_)); } while (0)
#define ATT_VLD(i, LO, HI) do { LO = vtr(vb_ + ((i) & 3) * 4096 + ((i) >> 2) * 1024); HI = vtr(vb_ + ((i) & 3) * 4096 + ((i) >> 2) * 1024 + 512); } while (0)
#define ATT_VF(LO, HI) ((bf16x8){LO[0], LO[1], LO[2], LO[3], HI[0], HI[1], HI[2], HI[3]})
#define ATT_YSTEP(i, PWC, PWN, LC, HC, LN, HN) do { if ((i) + 2 < 16) { ATT_VLD((i) + 2, LN, HN); } \
    o[(i) & 3] = __builtin_amdgcn_mfma_f32_32x32x16_bf16(__builtin_bit_cast(bf16x8, PWC[(i) >> 2]), ATT_VF(LC, HC), o[(i) & 3], 0, 0, 0); \
    ATT_EXP2(i, PWN); ATT_SB(); } while (0)
#define ATT_Y(vcur, PWC, PWN) do { \
    const LAS unsigned char* vb_ = lds + OFF_V + (vcur) * VBUF + voff; \
    float sacc_ = 0.f; s16x4 la_, ha_, lb_, hb_, lc_, hc_; \
    ATT_VLD(0, la_, ha_); ATT_VLD(1, lb_, hb_); ATT_SB(); \
    ATT_YSTEP(0, PWC, PWN, la_, ha_, lc_, hc_); ATT_YSTEP(1, PWC, PWN, lb_, hb_, la_, ha_); ATT_YSTEP(2, PWC, PWN, lc_, hc_, lb_, hb_); \
    ATT_YSTEP(3, PWC, PWN, la_, ha_, lc_, hc_); ATT_YSTEP(4, PWC, PWN, lb_, hb_, la_, ha_); ATT_YSTEP(5, PWC, PWN, lc_, hc_, lb_, hb_); \
    ATT_YSTEP(6, PWC, PWN, la_, ha_, lc_, hc_); ATT_YSTEP(7, PWC, PWN, lb_, hb_, la_, ha_); ATT_YSTEP(8, PWC, PWN, lc_, hc_, lb_, hb_); \
    ATT_YSTEP(9, PWC, PWN, la_, ha_, lc_, hc_); ATT_YSTEP(10, PWC, PWN, lb_, hb_, la_, ha_); ATT_YSTEP(11, PWC, PWN, lc_, hc_, lb_, hb_); \
    ATT_YSTEP(12, PWC, PWN, la_, ha_, lc_, hc_); ATT_YSTEP(13, PWC, PWN, lb_, hb_, la_, ha_); ATT_YSTEP(14, PWC, PWN, lc_, hc_, lb_, hb_); \
    ATT_YSTEP(15, PWC, PWN, la_, ha_, lc_, hc_); \
    l_reg += sacc_; \
} while (0)
#define ATT_Y0(PWN) do { float sacc_ = 0.f; _Pragma("unroll") for (int i = 0; i < 16; ++i) ATT_EXP2(i, PWN); l_reg += sacc_; } while (0)
#define ATT_ZSTEP(i, PWC, LC, HC, LN, HN) do { if ((i) + 2 < 16) { ATT_VLD((i) + 2, LN, HN); } \
    o[(i) & 3] = __builtin_amdgcn_mfma_f32_32x32x16_bf16(__builtin_bit_cast(bf16x8, PWC[(i) >> 2]), ATT_VF(LC, HC), o[(i) & 3], 0, 0, 0); ATT_SB(); } while (0)
#define ATT_Z(vcur, PWC) do { \
    const LAS unsigned char* vb_ = lds + OFF_V + (vcur) * VBUF + voff; \
    s16x4 la_, ha_, lb_, hb_, lc_, hc_; \
    ATT_VLD(0, la_, ha_); ATT_VLD(1, lb_, hb_); ATT_SB(); \
    ATT_ZSTEP(0, PWC, la_, ha_, lc_, hc_); ATT_ZSTEP(1, PWC, lb_, hb_, la_, ha_); ATT_ZSTEP(2, PWC, lc_, hc_, lb_, hb_); \
    ATT_ZSTEP(3, PWC, la_, ha_, lc_, hc_); ATT_ZSTEP(4, PWC, lb_, hb_, la_, ha_); ATT_ZSTEP(5, PWC, lc_, hc_, lb_, hb_); \
    ATT_ZSTEP(6, PWC, la_, ha_, lc_, hc_); ATT_ZSTEP(7, PWC, lb_, hb_, la_, ha_); ATT_ZSTEP(8, PWC, lc_, hc_, lb_, hb_); \
    ATT_ZSTEP(9, PWC, la_, ha_, lc_, hc_); ATT_ZSTEP(10, PWC, lb_, hb_, la_, ha_); ATT_ZSTEP(11, PWC, lc_, hc_, lb_, hb_); \
    ATT_ZSTEP(12, PWC, la_, ha_, lc_, hc_); ATT_ZSTEP(13, PWC, lb_, hb_, la_, ha_); ATT_ZSTEP(14, PWC, lc_, hc_, lb_, hb_); \
    ATT_ZSTEP(15, PWC, la_, ha_, lc_, hc_); \
} while (0)
#define ATT_STAGE(j) do { \
    if ((j) + 1 < NT) { _Pragma("unroll") for (int i = 0; i < 2; ++i) *(LAS u32x4*)(lds + OFF_K + (((j) + 1) & 1) * KBUF + kdst[i]) = kr[i]; } \
    _Pragma("unroll") for (int i = 0; i < 2; ++i) *(LAS u32x4*)(lds + OFF_V + ((j) & 1) * VBUF + vdst[i]) = vr[i]; \
    if ((j) + 2 < NT) { _Pragma("unroll") for (int i = 0; i < 2; ++i) kr[i] = *(const u32x4*)(Kb + (size_t)((j) + 2) * 64 * 512 + gsrc[i]); } \
    if ((j) + 1 < NT) { _Pragma("unroll") for (int i = 0; i < 2; ++i) vr[i] = *(const u32x4*)(Vb + (size_t)((j) + 1) * 64 * 512 + gsrc[i]); } } while (0)

__device__ __forceinline__ void unit(LAS unsigned char* lds, int b, int h, int qb, const bf16_t* Q, const bf16_t* KA, const bf16_t* VA, bf16_t* MIXIN, const float* subg, float lam, const unsigned* KM) {
    const int tid = opaque_tid(), lane = tid & 63, r32 = lane & 31, hi = lane >> 5;
    const int wid = __builtin_amdgcn_readfirstlane(tid >> 6), w = wid & 3, m = wid >> 2;
    LAS float* wsf = (LAS float*)(lds + OFF_WSF) + wid * 64;
    const int rowQ = b * T + qb * 128 + w * 32;
    bf16x8 qr[4];
#pragma unroll
    for (int d0 = 0; d0 < 4; ++d0) qr[d0] = *(const bf16x8*)(Q + (size_t)(rowQ + r32) * 512 + h * 128 + m * 64 + d0 * 16 + hi * 8);
    const bf16_t* Kb = KA + (size_t)b * TK * 512 + h * 128; const bf16_t* Vb = VA + (size_t)b * TK * 512 + h * 128;
    int gsrc[2], kdst[2], vdst[2];
#pragma unroll
    for (int i = 0; i < 2; ++i) { const int cid = tid + 512 * i, kv = cid >> 4, c16 = cid & 15;
        gsrc[i] = kv * 512 + c16 * 8; kdst[i] = kv * KP + c16 * 16; vdst[i] = (c16 >> 2) * 4096 + (kv >> 4) * 1024 + (kv & 15) * 64 + (c16 & 3) * 16; }
    u32x4 kr[2], vr[2];
#pragma unroll
    for (int i = 0; i < 2; ++i) { kr[i] = *(const u32x4*)(Kb + gsrc[i]); vr[i] = *(const u32x4*)(Vb + gsrc[i]); }
#pragma unroll
    for (int i = 0; i < 2; ++i) *(LAS u32x4*)(lds + OFF_K + kdst[i]) = kr[i];
#pragma unroll
    for (int i = 0; i < 2; ++i) kr[i] = *(const u32x4*)(Kb + (size_t)64 * 512 + gsrc[i]);
    ATT_BAR();
    f32x16 o[4];
#pragma unroll
    for (int d0 = 0; d0 < 4; ++d0) o[d0] = (f32x16){};
    float l_reg = 0.f;
    f32x16 p0, p1, negref;
    {
        const unsigned* km = KM + (b * 8 + h * 2 + m) * 2;
        const float kmax2 = __uint_as_float(km[0]) + __uint_as_float(km[1]);
        float ss = 0.f;
#pragma unroll
        for (int d0 = 0; d0 < 4; ++d0)
#pragma unroll
            for (int i = 0; i < 8; ++i) { const float v = bf2f((unsigned short)qr[d0][i]); ss += v * v; }
        ss += __shfl_xor(ss, 32);
        const float ref = sqrtf(ss * kmax2) * 1.02f;
#pragma unroll
        for (int r = 0; r < 16; ++r) negref[r] = -ref;
    }
    u32x4 pwA[4], pwB[4];
    const int koff = r32 * KP + m * 128 + hi * 16;
    const int voff = ((lane >> 4) & 1) * 32 + (lane & 3) * 8 + (4 * hi + ((lane & 15) >> 2)) * 64;
    ATT_X(0); ATT_STAGE(0); ATT_Y0(pwA); ATT_BAR();
    ATT_X(1); ATT_STAGE(1); ATT_Y(0, pwA, pwB); ATT_BAR();
    for (int j = 2; j < NT; j += 2) {
        ATT_X(0); ATT_STAGE(j); ATT_Y(1, pwB, pwA); ATT_BAR();
        ATT_X(1); ATT_STAGE(j + 1); ATT_Y(0, pwA, pwB); ATT_BAR();
    }
    ATT_Z(1, pwB); ATT_BAR();
    l_reg += __shfl_xor(l_reg, 32);
    if (hi == 0) wsf[32 + r32] = l_reg;
    LDS_WAIT();
    float rli[16];
#pragma unroll
    for (int r = 0; r < 16; ++r) rli[r] = 1.0f / wsf[32 + crow(r, hi)];
    LDS_WAIT();
    LAS float* ex = (LAS float*)lds + w * 4096;
    if (m == 1) {
#pragma unroll
        for (int r = 0; r < 16; ++r)
#pragma unroll
            for (int d0 = 0; d0 < 4; ++d0) ex[crow(r, hi) * 128 + d0 * 32 + r32] = o[d0][r] * rli[r];
    }
    ATT_BAR();
    if (m == 0) {
        float g4[4];
#pragma unroll
        for (int d0 = 0; d0 < 4; ++d0) g4[d0] = subg[d0 * 32 + r32] * (1.0f - LAM_INIT);
#pragma unroll
        for (int r = 0; r < 16; ++r) {
            const int q = crow(r, hi); float x[4]; float ss = 0.f;
#pragma unroll
            for (int d0 = 0; d0 < 4; ++d0) { x[d0] = o[d0][r] * rli[r] - lam * ex[q * 128 + d0 * 32 + r32]; ss += x[d0] * x[d0]; }
#pragma unroll
            for (int off = 1; off < 32; off <<= 1) ss += __shfl_xor(ss, off);
            const float rstd = 1.0f / sqrtf(ss * (1.f / 128.f) + EPS);
            bf16_t* dst = MIXIN + (size_t)(rowQ + q) * 1024 + h * 128 + r32;
#pragma unroll
            for (int d0 = 0; d0 < 4; ++d0) dst[d0 * 32] = (bf16_t)(pk2(x[d0] * rstd * g4[d0], 0.f) & 0xffffu);
        }
    }
    ATT_BAR();
}
#undef ATT_BAR
#undef ATT_X
#undef ATT_EXP2
#undef ATT_Y
#undef ATT_Y0
#undef ATT_Z
#undef ATT_STAGE
#undef ATT_SB
#undef ATT_KLD
#undef ATT_XSTEP
#undef ATT_VLD
#undef ATT_VF
#undef ATT_YSTEP
#undef ATT_ZSTEP
}

__device__ __forceinline__ void p3_conv_attn(const Args& a, LAS unsigned char* lds, int c, int vcu, int G) {
    const int tid = opaque_tid(), lane = tid & 63, wave = __builtin_amdgcn_readfirstlane(tid >> 6);
    unsigned char* ws = a.ws;
    const bf16_t* GB = (const bf16_t*)(ws + WS_GB); const bf16_t* U = (const bf16_t*)(ws + WS_U); bf16_t* MIXIN = (bf16_t*)(ws + WS_MIXIN);
    {
        const float* cw = a.in[I_CONVW]; float w0[8], w1[8], w2[8];
#pragma unroll
        for (int i = 0; i < 8; ++i) { w0[i] = cw[lane * 8 + i]; w1[i] = cw[512 + lane * 8 + i]; w2[i] = cw[1024 + lane * 8 + i]; }
        const int gw = vcu * NWAVES + wave, NGW = G * NWAVES;
        for (int row = gw; row < M; row += NGW) {
            const int t = row & (T - 1);
            const u32x4 z = {0u, 0u, 0u, 0u};
            const u32x4 uc = *(const u32x4*)(U + (size_t)row * 512 + lane * 8);
            const u32x4 up = (t > 0) ? *(const u32x4*)(U + (size_t)(row - 1) * 512 + lane * 8) : z;
            const u32x4 un = (t < T - 1) ? *(const u32x4*)(U + (size_t)(row + 1) * 512 + lane * 8) : z;
            const u32x4 gb = *(const u32x4*)(GB + (size_t)row * 512 + lane * 8);
            u32x4 o;
#pragma unroll
            for (int q = 0; q < 4; ++q) {
                const float y0 = w0[2 * q] * bflo(up[q]) + w1[2 * q] * bflo(uc[q]) + w2[2 * q] * bflo(un[q]);
                const float y1 = w0[2 * q + 1] * bfhi(up[q]) + w1[2 * q + 1] * bfhi(uc[q]) + w2[2 * q + 1] * bfhi(un[q]);
                o[q] = pk2(bflo(gb[q]) * y0, bfhi(gb[q]) * y1);
            }
            *(u32x4*)(MIXIN + (size_t)row * 1024 + 512 + lane * 8) = o;
        }
    }
    float lam;
    { const float p1 = a.in[I_LQ1][lane] * a.in[I_LK1][lane], p2 = a.in[I_LQ2][lane] * a.in[I_LK2][lane];
      lam = __expf(wave_sum(p1)) - __expf(wave_sum(p2)) + LAM_INIT; }
    const bf16_t* Q = (const bf16_t*)(ws + WS_Q); const bf16_t* KA = (const bf16_t*)(ws + WS_K); const bf16_t* VA = (const bf16_t*)(ws + WS_V);
    __syncthreads();
    for (int u = vcu * 8; u < 2048; u += G * 8) {
        const int x = (u >> 3) / 32, jj = (u >> 3) % 32;
        for (int i = 0; i < 8; ++i) {
            const int bh = 16 * x + 2 * i + (jj >> 4), qb = jj & 15;
            att::unit(lds, bh >> 2, bh & 3, qb, Q, KA, VA, MIXIN, a.in[I_SUBLN], lam, (const unsigned*)(ws + WS_CTL) + CW_KMAX);
        }
    }
}

struct P5In { f32x4 x[4]; u32x2 m[4]; };
__device__ __forceinline__ void p5_load(P5In& r, int row, int lane, const float* X, const bf16_t* MIX) {
    const f32x4* xr = (const f32x4*)(X + (size_t)row * D) + lane; const u32x2* mr = (const u32x2*)(MIX + (size_t)row * D) + lane;
#pragma unroll
    for (int j = 0; j < 4; ++j) { r.x[j] = __builtin_nontemporal_load(xr + 64 * j); r.m[j] = __builtin_nontemporal_load(mr + 64 * j); }
}
__device__ __forceinline__ float p5_resid(const P5In& r, f32x4 (&h)[4], int row, int lane, const LAS float* mv, const f32x4* npm, bf16_t* H1) {
    f32x4 mx[4]; float s = 0.f;
#pragma unroll
    for (int j = 0; j < 4; ++j) { const u32x2 wv = r.m[j]; mx[j] = (f32x4){bflo(wv.x), bfhi(wv.x), bflo(wv.y), bfhi(wv.y)};
        s += (mx[j].x * mx[j].x + mx[j].y * mx[j].y) + (mx[j].z * mx[j].z + mx[j].w * mx[j].w); }
    const float rstd1 = 1.0f / sqrtf(wave_sum(s) * (1.f / D) + EPS);
    u32x2* hr = (u32x2*)(H1 + (size_t)row * D) + lane; float s2 = 0.f;
#pragma unroll
    for (int j = 0; j < 4; ++j) { const f32x4 g1 = *(const LAS f32x4*)(mv + 4 * lane + 256 * j);
        h[j] = r.x[j] + g1 * ((mx[j] * rstd1) * npm[64 * j]);
        u32x2 wv; wv.x = pk2(h[j].x, h[j].y); wv.y = pk2(h[j].z, h[j].w); __builtin_nontemporal_store(wv, hr + 64 * j);
        s2 += (h[j].x * h[j].x + h[j].y * h[j].y) + (h[j].z * h[j].z + h[j].w * h[j].w); }
    return 1.0f / sqrtf(wave_sum(s2) * (1.f / D) + EPS);
}
__device__ __forceinline__ void p5_rows(const Args& a, LAS unsigned char* lds, int p  ) {
    const int tid = opaque_tid(), lane = tid & 63, wave = __builtin_amdgcn_readfirstlane(tid >> 6);
    unsigned char* ws = a.ws;
    const int b = p >> 3;
    LAS float* wrt = (LAS float*)lds;
    LAS float* mv = (LAS float*)(lds + 65536);
    const float* wr = a.in[I_WROUTER];
    const bf16_t* MIX = (const bf16_t*)(ws + WS_MIX); unsigned char* XN2 = ws + WS_XN; float* AFFT = (float*)(ws + WS_AFFT); bf16_t* H1 = (bf16_t*)(ws + WS_H1);
    const float* X = a.in[I_X];
    const int rbase = p * 256 + wave * 32;
    P5In cA, cB;
    p5_load(cA, rbase, lane, X, MIX); p5_load(cB, rbase + 16, lane, X, MIX);
    for (int n = tid; n < D * NE; n += NTHREADS) { const int k = n >> 4, e = n & 15; wrt[e * D + k] = wr[n]; }
    const float* MOD = (const float*)(ws + WS_MOD) + (size_t)b * NMOD;
    for (int n = tid; n < 3 * D; n += NTHREADS) mv[n] = MOD[2 * D + n];
    __syncthreads();
    const f32x4* npm = (const f32x4*)a.in[I_NPOST_MIX] + lane; const f32x4* npf = (const f32x4*)a.in[I_NPRE_FFN] + lane;
    for (int i = 0; i < 16; ++i) {
        const int rowA = rbase + i, rowB = rbase + 16 + i;
        P5In nA, nB;
        if (i + 1 < 16) { p5_load(nA, rowA + 1, lane, X, MIX); p5_load(nB, rowB + 1, lane, X, MIX); }
        f32x4 hA[4], hB[4];
        const float rsA = p5_resid(cA, hA, rowA, lane, mv, npm, H1);
        const float rsB = p5_resid(cB, hB, rowB, lane, mv, npm, H1);
        unsigned* oA = (unsigned*)(XN2 + (size_t)rowA * D) + lane; unsigned* oB = (unsigned*)(XN2 + (size_t)rowB * D) + lane;
        typedef float f32x2v __attribute__((ext_vector_type(2)));
        f32x2v lg2[16];
#pragma unroll
        for (int e = 0; e < 16; ++e) lg2[e] = (f32x2v){0.f, 0.f};
#pragma unroll
        for (int j = 0; j < 4; ++j) { const f32x4 sh2 = *(const LAS f32x4*)(mv + 1024 + 4 * lane + 256 * j), sc2 = *(const LAS f32x4*)(mv + 2048 + 4 * lane + 256 * j);
            const f32x4 gn = npf[64 * j];
            const f32x4 zA = ((hA[j] * rsA) * gn) * (sc2 + 1.0f) + sh2, zB = ((hB[j] * rsB) * gn) * (sc2 + 1.0f) + sh2;
            { const f32x4 qa = zA * pg8::F8_ACT, qb = zB * pg8::F8_ACT; oA[64 * j] = pg8::pk4_fp8(qa.x, qa.y, qa.z, qa.w); oB[64 * j] = pg8::pk4_fp8(qb.x, qb.y, qb.z, qb.w); }
            const f32x2v zx = {zA.x, zB.x}, zy = {zA.y, zB.y}, zz = {zA.z, zB.z}, zw = {zA.w, zB.w};
#pragma unroll
            for (int e = 0; e < 16; ++e) { const f32x4 wq = *(const LAS f32x4*)(wrt + e * D + 4 * lane + 256 * j);
                lg2[e] = __builtin_elementwise_fma(zx, (f32x2v){wq.x, wq.x}, lg2[e]); lg2[e] = __builtin_elementwise_fma(zy, (f32x2v){wq.y, wq.y}, lg2[e]);
                lg2[e] = __builtin_elementwise_fma(zz, (f32x2v){wq.z, wq.z}, lg2[e]); lg2[e] = __builtin_elementwise_fma(zw, (f32x2v){wq.w, wq.w}, lg2[e]);
                if ((e & 3) == 3) __builtin_amdgcn_sched_barrier(0); } }
        float lg[32];
#pragma unroll
        for (int e = 0; e < 16; ++e) { lg[e] = lg2[e].x; lg[16 + e] = lg2[e].y; }
#pragma unroll
        for (int st = 0; st < 5; ++st) { const int d = 1 << st, cntv = 16 >> st; const bool up = (lane & d) != 0;
#pragma unroll
            for (int q = 0; q < 16; ++q) if (q < cntv) { const float send = up ? lg[2 * q] : lg[2 * q + 1], keep = up ? lg[2 * q + 1] : lg[2 * q]; lg[q] = keep + __shfl_xor(send, d); } }
        float lv = lg[0] + __shfl_xor(lg[0], 32);
        float mxl = lv;
#pragma unroll
        for (int d = 1; d < 16; d <<= 1) mxl = fmaxf(mxl, __shfl_xor(mxl, d));
        const float ev = __expf(lv - mxl); float se = ev;
#pragma unroll
        for (int d = 1; d < 16; d <<= 1) se += __shfl_xor(se, d);
        if (lane < 32) { const int row = (lane < 16) ? rowA : rowB; AFFT[((size_t)b * NE + (lane & 15)) * T + (row & (T - 1))] = ev / se; }
        cA = nA; cB = nB;
    }
}

__device__ __forceinline__ void p6_topk(const Args& a, LAS unsigned char* lds, int c, int G) {
    const int tid = opaque_tid(), lane = tid & 63, wave = __builtin_amdgcn_readfirstlane(tid >> 6);
    unsigned char* ws = a.ws;
    const float* AFFT = (const float*)(ws + WS_AFFT); short* SLOT = (short*)(ws + WS_SLOT); int* IDX = (int*)(ws + WS_IDX); float* GATE = (float*)(ws + WS_GATE);
    LAS unsigned* sv = (LAS unsigned*)(lds + wave * 16384);
    for (int item = c + wave * G; item < NITEM; item += G * NWAVES) {
        const int b = item >> 4, e = item & 15;
        const float* src = AFFT + (size_t)item * T;
#pragma unroll 8
        for (int j = 0; j < 32; ++j) sv[j * 64 + lane] = __float_as_uint(src[j * 64 + lane]);
        LDS_WAIT(); asm volatile("" ::: "memory");
        unsigned pre = 0u;
        for (int bit = 30; bit >= 0; --bit) {
            const unsigned cand = pre | (1u << bit);
            int cnt = 0;
#pragma unroll 4
            for (int j = 0; j < 32; ++j) cnt += (int)__popcll(__ballot(sv[j * 64 + lane] >= cand));
            if (cnt >= CAP) pre = cand;
        }
        int ngt = 0;
#pragma unroll 4
        for (int j = 0; j < 32; ++j) ngt += (int)__popcll(__ballot(sv[j * 64 + lane] > pre));
        const int need_eq = CAP - ngt;
        const unsigned long long ltmask = (1ull << lane) - 1ull;
        int base_gt = 0, base_eq = 0;
#pragma unroll 2
        for (int j = 0; j < 32; ++j) {
            const unsigned vj = sv[j * 64 + lane];
            const bool gt = vj > pre, eq = vj == pre;
            const unsigned long long mg = __ballot(gt), me = __ballot(eq);
            const int pg = base_gt + (int)__popcll(mg & ltmask), pe = base_eq + (int)__popcll(me & ltmask);
            int sl = -1; if (gt) sl = pg; else if (eq && pe < need_eq) sl = ngt + pe;
            const int t = j * 64 + lane;
            SLOT[((size_t)b * T + t) * NE + e] = (short)sl;
            if (sl >= 0) { IDX[item * CAP + sl] = t; GATE[item * CAP + sl] = __uint_as_float(vj); }
            base_gt += (int)__popcll(mg); base_eq += (int)__popcll(me);
        }
        LDS_WAIT(); asm volatile("" ::: "memory");
    }
}

struct P8Row { u32x2 h[4]; unsigned y[4][4]; float wt[4]; unsigned long long rest; int sl; };
__device__ __forceinline__ f32x4 fp8x4_to_f32(unsigned w) { typedef float f2 __attribute__((ext_vector_type(2))); const f2 lo = __builtin_amdgcn_cvt_pk_f32_fp8((int)w, false), hi = __builtin_amdgcn_cvt_pk_f32_fp8((int)w, true); return (f32x4){lo.x, lo.y, hi.x, hi.y}; }
__device__ __forceinline__ void p8_issue(P8Row& r, int row, int lane, const short* SLOT, const unsigned char* Y, const bf16_t* H1) {
    const int b = row >> 11;
    const int s_e = (lane < NE) ? (int)SLOT[(size_t)row * NE + lane] : -1;
    unsigned long long mask = __ballot(s_e >= 0);
    const u32x2* hr = (const u32x2*)(H1 + (size_t)row * D) + lane;
#pragma unroll
    for (int j = 0; j < 4; ++j) r.h[j] = __builtin_nontemporal_load(hr + 64 * j);
#pragma unroll
    for (int q = 0; q < 4; ++q) {
        int e = 0, s = 0; r.wt[q] = 0.f;
        if (mask) { e = (int)__builtin_ctzll(mask); mask &= mask - 1ull; s = __builtin_amdgcn_readlane(s_e, e); r.wt[q] = 1.f; }
        const unsigned* yr = (const unsigned*)(Y + ((size_t)(b * NE + e) * CAP + s) * D) + lane;
#pragma unroll
        for (int j = 0; j < 4; ++j) r.y[q][j] = __builtin_nontemporal_load(yr + 64 * j);
    }
    r.rest = mask; r.sl = s_e;
}
__device__ __forceinline__ void p8_finish(P8Row& r, int row, int lane, const unsigned char* Y, const float* MOD, const f32x4* npo, float* out) {
    const int b = row >> 11;
    f32x4 ff[4];
#pragma unroll
    for (int j = 0; j < 4; ++j) ff[j] = (f32x4){0.f, 0.f, 0.f, 0.f};
#pragma unroll
    for (int q = 0; q < 4; ++q)
#pragma unroll
        for (int j = 0; j < 4; ++j) ff[j] += fp8x4_to_f32(r.y[q][j]) * r.wt[q];
    unsigned long long mask = r.rest;
    while (mask) {
        const int e = (int)__builtin_ctzll(mask); mask &= mask - 1ull; const int s = __builtin_amdgcn_readlane(r.sl, e);
        const unsigned* yr = (const unsigned*)(Y + ((size_t)(b * NE + e) * CAP + s) * D) + lane;
#pragma unroll
        for (int j = 0; j < 4; ++j) ff[j] += fp8x4_to_f32(yr[64 * j]);
    }
#pragma unroll
    for (int j = 0; j < 4; ++j) ff[j] = ff[j] * (1.0f / pg8::F8_Y);
    float s2 = 0.f;
#pragma unroll
    for (int j = 0; j < 4; ++j) s2 += (ff[j].x * ff[j].x + ff[j].y * ff[j].y) + (ff[j].z * ff[j].z + ff[j].w * ff[j].w);
    const float rstd = 1.0f / sqrtf(wave_sum(s2) * (1.f / D) + EPS);
    f32x4* orow = (f32x4*)(out + (size_t)row * D) + lane; const f32x4* g2 = (const f32x4*)(MOD + (size_t)b * NMOD + 5 * D) + lane;
#pragma unroll
    for (int j = 0; j < 4; ++j) { const u32x2 hv = r.h[j]; const f32x4 h = (f32x4){bflo(hv.x), bfhi(hv.x), bflo(hv.y), bfhi(hv.y)};
        __builtin_nontemporal_store(h + g2[64 * j] * ((ff[j] * rstd) * npo[64 * j]), orow + 64 * j); }
}
__device__ __forceinline__ void p8_final(const Args& a, int vcu, int G) {
    const int tid = opaque_tid(), lane = tid & 63, wave = __builtin_amdgcn_readfirstlane(tid >> 6);
    unsigned char* ws = a.ws;
    const short* SLOT = (const short*)(ws + WS_SLOT); const unsigned char* Y = ws + WS_Y; const float* MOD = (const float*)(ws + WS_MOD); const bf16_t* H1 = (const bf16_t*)(ws + WS_H1);
    const f32x4* npo = (const f32x4*)a.in[I_NPOST_FFN] + lane;
    const int gw = vcu * NWAVES + wave, NGW = G * NWAVES;
    for (int row = gw; row < M; row += 4 * NGW) {
        P8Row r0, r1, r2, r3;
        p8_issue(r0, row, lane, SLOT, Y, H1);
        p8_issue(r1, row + NGW, lane, SLOT, Y, H1);
        p8_issue(r2, row + 2 * NGW, lane, SLOT, Y, H1);
        p8_issue(r3, row + 3 * NGW, lane, SLOT, Y, H1);
        p8_finish(r0, row, lane, Y, MOD, npo, a.out);
        p8_finish(r1, row + NGW, lane, Y, MOD, npo, a.out);
        p8_finish(r2, row + 2 * NGW, lane, Y, MOD, npo, a.out);
        p8_finish(r3, row + 3 * NGW, lane, Y, MOD, npo, a.out);
    }
}

__global__ void __launch_bounds__(NTHREADS, 2) fwd_kernel(Args args) {
    extern __shared__ __attribute__((aligned(16))) unsigned char lds_raw[];
    LAS unsigned char* lds = (LAS unsigned char*)lds_raw;
    volatile LAS unsigned* MISC = (volatile LAS unsigned*)(lds + MISC_OFF);
    const int tid = threadIdx.x;
    const int G = gridDim.x, c = blockIdx.x;
    const int vcu = (G % 8 == 0) ? (c % 8) * (G / 8) + c / 8 : c;
    unsigned char* ws = args.ws;
    gu32* ctl = (gu32*)(ws + WS_CTL);
    for (int u = tid; u < (LDS_BYTES - LDSCTL_OFF) / 4; u += NTHREADS) ((LAS unsigned*)(lds + LDSCTL_OFF))[u] = 0u;
    __syncthreads();
    XcdBarrier bar; bar.bar = (unsigned*)(ctl + CW_BAR); bar.x = 0; bar.st = nullptr;
    const int lo = args.ph_lo, hi = args.ph_hi;
    if (hi - lo > 1) bar = xcd_barrier_post((unsigned*)(ctl + CW_BAR), MISC + 8);
#ifndef PHMASK
#define PHMASK 0xff
#endif
#define IN(k) (((PHMASK >> (k)) & 1) && lo <= (k) && (k) < hi)
#define SEAM(k) do { if (IN(k) && IN((k) + 1)) xcd_barrier(bar); } while (0)
#ifndef PROBE_PHASE
#define PROBE_PHASE -1
#endif
#define PB(k) do { if (PROBE_PHASE == (k)) { if (tid == 0) { const unsigned long long t0_ = __builtin_amdgcn_s_memrealtime(); MISC[16] = (unsigned)t0_; MISC[17] = (unsigned)(t0_ >> 32); } } } while (0)
#define PE(k) do { if (PROBE_PHASE == (k)) { if (tid == 0) { const unsigned long long t0_ = ((unsigned long long)MISC[17] << 32) | MISC[16]; const unsigned long long t1_ = __builtin_amdgcn_s_memrealtime(); \
      while (__builtin_amdgcn_s_memrealtime() - t1_ < t1_ - t0_) __builtin_amdgcn_s_sleep(8); } __syncthreads(); } } while (0)

    PB(0); if (IN(0)) { p0_prologue(args, lds, vcu, G); } SEAM(0); PE(0);
    PB(1); if (IN(1)) { p1_xn(args, lds, c, G); inout_weight_copies(args, lds, vcu, G); } SEAM(1); PE(1);
    PB(2); if (IN(2)) {
        pg8::Gemm g{(const bf16_t*)(ws + WS_XN), (const bf16_t*)(ws + WS_WIN), D, nullptr};
        pg8::SchedProj S{G, c};
        pg8::EpiProj E{(bf16_t*)(ws + WS_Q), (bf16_t*)(ws + WS_K), (bf16_t*)(ws + WS_V), (bf16_t*)(ws + WS_GB), (bf16_t*)(ws + WS_U), (const float*)(ws + WS_TAB), (unsigned*)(ws + WS_CTL) + CW_KMAX};
        pg8::gemm_phase<pg8::EpiProj, pg8::SchedProj, true, true>(lds, g, S, E);
        if (c >= 128) expert_weight_copies(args, lds, c - 128, G - 128, 0, 9216);
    } SEAM(2); PE(2);
    PB(3); if (IN(3)) { if (c & 1) expert_weight_copies(args, lds, vcu, G, 9216, 24576); p3_conv_attn(args, lds, c, vcu, G); if (!(c & 1)) expert_weight_copies(args, lds, vcu, G, 9216, 24576); } SEAM(3); PE(3);
    PB(4); if (IN(4)) {
        {
            const int p = c;
#ifndef NO_P4
            pg8::Gemm g{(const bf16_t*)(ws + WS_MIXIN), (const bf16_t*)(ws + WS_WOUT), D, nullptr};
            pg8::SchedPanel S{p, 4};
            pg8::EpiBf16 E{(bf16_t*)(ws + WS_MIX), D};
            pg8::gemm_phase<pg8::EpiBf16, pg8::SchedPanel, true, true>(lds, g, S, E);
#endif
            VM_WAIT(); __syncthreads();
#ifndef NO_P5
            p5_rows(args, lds, p);
#endif
            __syncthreads();
        }
    } SEAM(4); PE(4);
    PB(5); if (IN(5)) { p6_topk(args, lds, c, G); } SEAM(5); PE(5);
    PB(6); if (IN(6)) {
#pragma unroll 1
        for (int it = 0; it < 2; ++it) {
            {
                const int item = 2 * c + it;
                const int b = item >> 4, e = item & 15;
#ifndef NO_G1
                if (it == 0) PB(8);
                {
                    pg8::Gemm g{(const bf16_t*)(ws + WS_XN + (size_t)b * T * D), (const bf16_t*)(ws + WS_WGU + (size_t)e * 2048 * D), D, (const int*)(ws + WS_IDX) + item * CAP};
                    pg8::SchedPanel S{0, 8};
                    pg8::EpiGU8 E{ws + WS_HMID + (size_t)item * CAP * D};
                    pg8::gemm_phase<pg8::EpiGU8, pg8::SchedPanel, true, true, true, true>(lds, g, S, E);
                }
#endif
                VM_WAIT(); __syncthreads();
                if (it == 0) { PE(8); PB(9); }
#ifndef NO_G2
                {
                    pg8::Gemm g{(const bf16_t*)(ws + WS_HMID + (size_t)item * CAP * D), (const bf16_t*)(ws + WS_WDN + (size_t)e * D * D), D, nullptr};
                    pg8::SchedPanel S{0, 4};
                    pg8::EpiDown8 E{ws + WS_Y + (size_t)item * CAP * D, (const float*)(ws + WS_GATE) + item * CAP, pg8::F8_INV * pg8::F8_Y};
                    pg8::gemm_phase<pg8::EpiDown8, pg8::SchedPanel, true, true, false, true>(lds, g, S, E);
                }
#endif
                VM_WAIT(); __syncthreads();
                if (it == 0) PE(9);
            }
        }
    } SEAM(6); PE(6);
    PB(7); if (IN(7)) { p8_final(args, vcu, G); } PE(7);
#undef IN
#undef SEAM
}

extern "C" void kernel_launch(void* const* d_in, const int* in_sizes, int n_in, void* d_out, int out_size, void* d_ws, size_t ws_size, hipStream_t stream) {
    static int grid = 0;
    if (grid == 0) {
        if (n_in != 22 || in_sizes[0] != M * D || out_size != M * D || ws_size < WS_END) { fprintf(stderr, "kernel_launch: unexpected shapes (n_in %d, in0 %d, out %d, ws %zu)\n", n_in, n_in > 0 ? in_sizes[0] : -1, out_size, ws_size); grid = -1; return; }
        int dev = 0, cus = 0;
        if (hipGetDevice(&dev) != hipSuccess || hipDeviceGetAttribute(&cus, hipDeviceAttributeMultiprocessorCount, dev) != hipSuccess) { grid = -1; return; }
        if (hipFuncSetAttribute((const void*)fwd_kernel, hipFuncAttributeMaxDynamicSharedMemorySize, LDS_BYTES) != hipSuccess) { fprintf(stderr, "kernel_launch: hipFuncSetAttribute failed\n"); grid = -1; return; }
        (void)hipGetLastError();
        grid = cus;
        if (grid != 256) { fprintf(stderr, "kernel_launch: this kernel needs a 256-CU device (got %d)\n", cus); grid = -1; return; }
    }
    if (grid < 0) return;
    (void)hipMemsetAsync((char*)d_ws + WS_CTL, 0, CTL_ZERO_BYTES, stream);
    Args a{};
    for (int i = 0; i < 22; ++i) a.in[i] = (const float*)d_in[i];
    a.out = (float*)d_out; a.ws = (unsigned char*)d_ws;
    constexpr int NPH = 8;
    if (MK_N_LAUNCHES == 1) { a.ph_lo = 0; a.ph_hi = NPH; hipLaunchKernelGGL(fwd_kernel, dim3(grid), dim3(NTHREADS), LDS_BYTES, stream, a); }
    else { for (int k = 0; k < NPH; ++k) { a.ph_lo = k; a.ph_hi = k + 1; hipLaunchKernelGGL(fwd_kernel, dim3(grid), dim3(NTHREADS), LDS_BYTES, stream, a); } }
}
```

```cpp
#include <hip/hip_runtime.h>
#include <cstdio>
#include <cstdint>

#ifndef MK_N_LAUNCHES
#define MK_N_LAUNCHES 1
#endif

#define LAS __attribute__((address_space(3)))
#define GAS __attribute__((address_space(1)))
typedef unsigned short bf16_t;
typedef short bf16x8 __attribute__((ext_vector_type(8)));
typedef short s16x4 __attribute__((ext_vector_type(4)));
typedef float f32x4 __attribute__((ext_vector_type(4)));
typedef float f32x16 __attribute__((ext_vector_type(16)));
typedef unsigned u32x4 __attribute__((ext_vector_type(4)));
typedef unsigned u32x2 __attribute__((ext_vector_type(2)));

constexpr int NB = 32, T = 2048, D = 1024, TC = 256, M = NB * T, MC = NB * TC, MA = M + MC, TK = TC + T;
constexpr int NE = 16, CAP = 256, NITEM = NB * NE, NPROJ = 3072, NMOD = 6 * D;
constexpr float EPS = 1e-6f;
constexpr float C2 = 0.125f * 1.4426950408889634f;
constexpr float LAM_INIT = 0.2f;
constexpr int NWAVES = 8, NTHREADS = 512;

constexpr size_t MiB = 1u << 20;
constexpr size_t WS_CTL = 0, CTL_ZERO_BYTES = 1 * MiB;
constexpr size_t WS_MODP = 2 * MiB;
constexpr size_t WS_MOD = 16 * MiB;
constexpr size_t WS_TAB = 17 * MiB;
constexpr size_t WS_WIN = 18 * MiB;
constexpr size_t WS_WOUT = 24 * MiB;
constexpr size_t WS_WGU = 26 * MiB;
constexpr size_t WS_WDN = 90 * MiB;
constexpr size_t WS_AFFT = 122 * MiB;
constexpr size_t WS_SLOT = 126 * MiB;
constexpr size_t WS_IDX = 128 * MiB;
constexpr size_t WS_GATE = 129 * MiB;
constexpr size_t WS_XN = 130 * MiB;
constexpr size_t WS_Q = 274 * MiB;
constexpr size_t WS_K = 338 * MiB;
constexpr size_t WS_V = 410 * MiB;
constexpr size_t WS_GB = 482 * MiB;
constexpr size_t WS_U = 546 * MiB;
constexpr size_t WS_MIXIN = 610 * MiB;
constexpr size_t WS_MIX = 738 * MiB;
constexpr size_t WS_HMID = 274 * MiB;
constexpr size_t WS_Y = 610 * MiB;
constexpr size_t WS_H1 = 866 * MiB;
constexpr size_t WS_END = 994 * MiB;

__device__ __forceinline__ int opaque_tid() { int t = threadIdx.x; asm volatile("" : "+v"(t)); return t; }

namespace pg8 {
constexpr int BM = 256, BK = 64, HALF = 128, HTB = HALF * BK * 2, STAGE_BYTES = 8 * HTB;
__host__ __device__ __forceinline__ int lds_byte(int r, int c) { const int st = (r >> 4) * 2 + (c >> 5), rr = r & 15, cc = c & 31, ob = rr * 64 + cc * 2; return st * 1024 + (ob ^ (((ob >> 9) & 1) << 5)); }
__host__ __device__ __forceinline__ void stage_rc(int b, int& R, int& C) { const int st = b / 1024, sb = b % 1024, swz = sb ^ (((sb >> 9) & 1) << 5); R = (st >> 1) * 16 + swz / 64; C = (st & 1) * 32 + (swz % 64) / 2; }
__host__ __device__ __forceinline__ int perm32(int rho) { const int n = rho >> 4, i = rho & 15; return 8 * (i >> 2) + 4 * n + (i & 3); }

struct Unit { int pm, pn; };
struct Gemm { const bf16_t* A; const bf16_t* Bt; int K; const int* gidx; };

typedef float f32x2_t __attribute__((ext_vector_type(2))); typedef __bf16 bf16x2_t __attribute__((ext_vector_type(2)));
__device__ __forceinline__ unsigned cvt_pk_bf16(float lo, float hi) { const f32x2_t v = {lo, hi}; const bf16x2_t b = __builtin_convertvector(v, bf16x2_t); return __builtin_bit_cast(unsigned, b); }

struct EpiBf16 {
    static constexpr bool PERM = true, AFTER_DRAIN = false;
    bf16_t* O; int ldc;
    __device__ __forceinline__ void operator()(const f32x4 (&acc)[2][2][4][2], const Unit& u, int wr, int wc, int fr, int fq) const {
        const int row0 = u.pm * BM + wr * 64 + fr; const int col0 = u.pn * BM + wc * 32 + 8 * fq;
#pragma unroll
        for (int ai = 0; ai < 2; ++ai)
#pragma unroll
            for (int m = 0; m < 4; ++m) { bf16_t* rowp = O + (size_t)(row0 + ai * HALF + m * 16) * ldc + col0;
#pragma unroll
                for (int bj = 0; bj < 2; ++bj) { const f32x4 v0 = acc[ai][bj][m][0], v1 = acc[ai][bj][m][1];
                    u32x4 w; w.x = cvt_pk_bf16(v0[0], v0[1]); w.y = cvt_pk_bf16(v0[2], v0[3]); w.z = cvt_pk_bf16(v1[0], v1[1]); w.w = cvt_pk_bf16(v1[2], v1[3]);
                    *(u32x4*)(rowp + bj * HALF) = w; } }
    }
};

struct EpiProj {
    static constexpr bool PERM = true, AFTER_DRAIN = false;
    bf16_t *Q, *KA, *VA, *GB, *U; const float* tab;
    unsigned* kmaxh;
    __device__ __forceinline__ void operator()(const f32x4 (&acc)[2][2][4][2], const Unit& u, int wr, int wc, int fr, int fq) const {
        const int pn = u.pn; const bool ctx = u.pm >= 256;
        float km[2] = {0.f, 0.f};
#pragma unroll
        for (int ai = 0; ai < 2; ++ai)
#pragma unroll
            for (int m = 0; m < 4; ++m) {
                const int row = u.pm * BM + ai * HALF + wr * 64 + m * 16 + fr;
                int t, kvrow;
                if (!ctx) { const int b = row >> 11; t = row & 2047; kvrow = b * TK + TC + t; }
                else { const int rc = row - M; const int b = rc >> 8; t = 0; kvrow = b * TK + (rc & 255); }
                if (pn < 4) {
                    f32x4 cs0 = {1.f, 0.f, 1.f, 0.f}, cs1 = cs0, cs2 = cs0, cs3 = cs0;
                    if (!ctx) { const float* tp = tab + ((size_t)t * 32 + 16 * (wc & 1) + 4 * fq) * 2;
                        cs0 = *(const f32x4*)(tp); cs1 = *(const f32x4*)(tp + 4); }
                    (void)cs2; (void)cs3;
#pragma unroll
                    for (int bj = 0; bj < 2; ++bj) {
                        const f32x4 v0 = acc[ai][bj][m][0], v1 = acc[ai][bj][m][1];
                        float e0 = v0[0], o0 = v0[1], e1 = v0[2], o1 = v0[3], e2 = v1[0], o2 = v1[1], e3 = v1[2], o3 = v1[3];
                        if (pn >= 2) {
                            float ss = ((e0 * e0 + o0 * o0) + (e1 * e1 + o1 * o1)) + ((e2 * e2 + o2 * o2) + (e3 * e3 + o3 * o3));
                            ss += __shfl_xor(ss, 16); ss += __shfl_xor(ss, 32); km[bj] = fmaxf(km[bj], ss); }
                        float r0 = e0 * cs0[0] - o0 * cs0[1], s0 = o0 * cs0[0] + e0 * cs0[1];
                        float r1 = e1 * cs0[2] - o1 * cs0[3], s1 = o1 * cs0[2] + e1 * cs0[3];
                        float r2 = e2 * cs1[0] - o2 * cs1[1], s2 = o2 * cs1[0] + e2 * cs1[1];
                        float r3 = e3 * cs1[2] - o3 * cs1[3], s3 = o3 * cs1[2] + e3 * cs1[3];
                        const float sc = (pn < 2) ? C2 : 1.f;
                        u32x4 w; w.x = cvt_pk_bf16(r0 * sc, s0 * sc); w.y = cvt_pk_bf16(r1 * sc, s1 * sc); w.z = cvt_pk_bf16(r2 * sc, s2 * sc); w.w = cvt_pk_bf16(r3 * sc, s3 * sc);
                        const int col = (pn & 1) * 256 + bj * HALF + wc * 32 + 8 * fq;
                        bf16_t* dst = (pn < 2) ? (Q + (size_t)row * 512 + col) : (KA + (size_t)kvrow * 512 + col);
                        *(u32x4*)dst = w;
                    }
                } else if (pn < 8) {
#pragma unroll
                    for (int bj = 0; bj < 2; ++bj) {
                        const f32x4 v0 = acc[ai][bj][m][0], v1 = acc[ai][bj][m][1];
                        u32x4 w; w.x = cvt_pk_bf16(v0[0], v0[1]); w.y = cvt_pk_bf16(v0[2], v0[3]); w.z = cvt_pk_bf16(v1[0], v1[1]); w.w = cvt_pk_bf16(v1[2], v1[3]);
                        const int col = (pn & 1) * 256 + bj * HALF + wc * 32 + 8 * fq;
                        bf16_t* dst = (pn < 6) ? (VA + (size_t)kvrow * 512 + col) : (GB + (size_t)row * 512 + col);
                        *(u32x4*)dst = w;
                    }
                } else {
                    const f32x4 a0 = acc[ai][0][m][0], a1 = acc[ai][0][m][1], b0 = acc[ai][1][m][0], b1 = acc[ai][1][m][1];
                    u32x4 w; w.x = cvt_pk_bf16(a0[0] * b0[0], a0[1] * b0[1]); w.y = cvt_pk_bf16(a0[2] * b0[2], a0[3] * b0[3]);
                    w.z = cvt_pk_bf16(a1[0] * b1[0], a1[1] * b1[1]); w.w = cvt_pk_bf16(a1[2] * b1[2], a1[3] * b1[3]);
                    const int col = (pn - 8) * 128 + wc * 32 + 8 * fq;
                    *(u32x4*)(U + (size_t)row * 512 + col) = w;
                }
            }
        if (pn == 2 || pn == 3) {
            const int b = ctx ? (u.pm - 256) : (u.pm >> 3);
#pragma unroll
            for (int bj = 0; bj < 2; ++bj) { float v = km[bj];
#pragma unroll
                for (int d = 1; d < 16; d <<= 1) v = fmaxf(v, __shfl_xor(v, d));
                if (fr == 0 && fq == 0) atomicMax(kmaxh + ((b * 8 + (pn & 1) * 4 + bj * 2 + (wc >> 1)) * 2 + (wc & 1)), __float_as_uint(v)); }
        }
    }
};

struct EpiGU {
    static constexpr bool PERM = true, AFTER_DRAIN = false;
    bf16_t* H;
    __device__ __forceinline__ float silu(float x) const { return x * __builtin_amdgcn_rcpf(1.f + __expf(-x)); }
    __device__ __forceinline__ void operator()(const f32x4 (&acc)[2][2][4][2], const Unit& u, int wr, int wc, int fr, int fq) const {
#pragma unroll
        for (int ai = 0; ai < 2; ++ai)
#pragma unroll
            for (int m = 0; m < 4; ++m) {
                const int row = ai * HALF + wr * 64 + m * 16 + fr;
                const f32x4 a0 = acc[ai][0][m][0], a1 = acc[ai][0][m][1], b0 = acc[ai][1][m][0], b1 = acc[ai][1][m][1];
                u32x4 w; w.x = cvt_pk_bf16(silu(a0[0]) * b0[0], silu(a0[1]) * b0[1]); w.y = cvt_pk_bf16(silu(a0[2]) * b0[2], silu(a0[3]) * b0[3]);
                w.z = cvt_pk_bf16(silu(a1[0]) * b1[0], silu(a1[1]) * b1[1]); w.w = cvt_pk_bf16(silu(a1[2]) * b1[2], silu(a1[3]) * b1[3]);
                *(u32x4*)(H + (size_t)row * 1024 + u.pn * 128 + wc * 32 + 8 * fq) = w;
            }
    }
};
__device__ __forceinline__ unsigned pk4_fp8(float a, float b, float c, float d) { int w = 0; w = __builtin_amdgcn_cvt_pk_fp8_f32(a, b, w, false); w = __builtin_amdgcn_cvt_pk_fp8_f32(c, d, w, true); return (unsigned)w; }
constexpr float F8_ACT = 4.0f, F8_WGT = 64.0f, F8_INV = 1.0f / (4.0f * 64.0f);
struct EpiGU8 {
    static constexpr bool PERM = true, AFTER_DRAIN = false;
    unsigned char* H;
    __device__ __forceinline__ float hval(float g, float u) const {
        const float e = __builtin_amdgcn_exp2f(g * (-F8_INV * 1.4426950408889634f));
        const float r = __builtin_amdgcn_rcpf(1.f + e);
        return __builtin_amdgcn_fmed3f((g * u) * (r * (F8_INV * F8_INV * F8_ACT)), -448.f, 448.f); }
    __device__ __forceinline__ void operator()(const f32x4 (&acc)[2][2][4][2], const Unit& u, int wr, int wc, int fr, int fq) const {
        asm volatile("" : "+v"(fr));
#pragma unroll
        for (int ai = 0; ai < 2; ++ai)
#pragma unroll
            for (int m = 0; m < 4; ++m) {
                const int row = ai * HALF + wr * 64 + m * 16 + fr;
                const f32x4 a0 = acc[ai][0][m][0], a1 = acc[ai][0][m][1], b0 = acc[ai][1][m][0], b1 = acc[ai][1][m][1];
                u32x2 w; w.x = pk4_fp8(hval(a0[0], b0[0]), hval(a0[1], b0[1]), hval(a0[2], b0[2]), hval(a0[3], b0[3]));
                w.y = pk4_fp8(hval(a1[0], b1[0]), hval(a1[1], b1[1]), hval(a1[2], b1[2]), hval(a1[3], b1[3]));
                *(u32x2*)(H + (size_t)row * 1024 + u.pn * 128 + wc * 32 + 8 * fq) = w;
            }
    }
};
struct EpiDown {
    static constexpr bool PERM = true, AFTER_DRAIN = false;
    bf16_t* Y; const float* gate; float scale;
    __device__ __forceinline__ void operator()(const f32x4 (&acc)[2][2][4][2], const Unit& u, int wr, int wc, int fr, int fq) const {
        asm volatile("" : "+v"(fr));
#pragma unroll
        for (int ai = 0; ai < 2; ++ai)
#pragma unroll
            for (int m = 0; m < 4; ++m) {
                const int row = ai * HALF + wr * 64 + m * 16 + fr; const float g = gate[row] * scale;
#pragma unroll
                for (int bj = 0; bj < 2; ++bj) { const f32x4 v0 = acc[ai][bj][m][0] * g, v1 = acc[ai][bj][m][1] * g;
                    u32x4 w; w.x = cvt_pk_bf16(v0[0], v0[1]); w.y = cvt_pk_bf16(v0[2], v0[3]); w.z = cvt_pk_bf16(v1[0], v1[1]); w.w = cvt_pk_bf16(v1[2], v1[3]);
                    *(u32x4*)(Y + (size_t)row * 1024 + u.pn * BM + bj * HALF + wc * 32 + 8 * fq) = w; }
            }
    }
};

constexpr float F8_Y = 64.0f;
struct EpiDown8 {
    static constexpr bool PERM = true, AFTER_DRAIN = false;
    unsigned char* Y; const float* gate; float scale;
    __device__ __forceinline__ void operator()(const f32x4 (&acc)[2][2][4][2], const Unit& u, int wr, int wc, int fr, int fq) const {
        asm volatile("" : "+v"(fr));
#pragma unroll
        for (int ai = 0; ai < 2; ++ai)
#pragma unroll
            for (int m = 0; m < 4; ++m) {
                const int row = ai * HALF + wr * 64 + m * 16 + fr; const float g = gate[row] * scale;
#pragma unroll
                for (int bj = 0; bj < 2; ++bj) { f32x4 v0 = acc[ai][bj][m][0] * g, v1 = acc[ai][bj][m][1] * g;
#pragma unroll
                    for (int i = 0; i < 4; ++i) { v0[i] = __builtin_amdgcn_fmed3f(v0[i], -448.f, 448.f); v1[i] = __builtin_amdgcn_fmed3f(v1[i], -448.f, 448.f); }
                    u32x2 w; w.x = pk4_fp8(v0[0], v0[1], v0[2], v0[3]); w.y = pk4_fp8(v1[0], v1[1], v1[2], v1[3]);
                    *(u32x2*)(Y + (size_t)row * 1024 + u.pn * BM + bj * HALF + wc * 32 + 8 * fq) = w; }
            }
    }
};

struct SchedProj {
    int G, c;
    __device__ __forceinline__ bool next(int i, Unit& u) const {
        if (i < 12) { const int x = c & 7, j = c >> 3, ja = j & 7, jb = j >> 3, r = i / 3, q = i - 3 * r;
            u.pm = x + 8 * (8 * r + ja); u.pn = 4 * q + jb; return true; }
        if (i == 12 && c < 128) { u.pm = 256 + (c >> 2); u.pn = 2 + (c & 3); return true; }
        return false;
    }
    __device__ __forceinline__ void a_ready(const Unit&) const {}
    __device__ __forceinline__ void done(const Unit&) const {}
};
struct SchedPanel {
    int pm, ntn;
    __device__ __forceinline__ bool next(int i, Unit& u) const { if (i >= ntn) return false; u.pm = pm; u.pn = i; return true; }
    __device__ __forceinline__ void a_ready(const Unit&) const {}
    __device__ __forceinline__ void done(const Unit&) const {}
};

typedef int i32x4v __attribute__((ext_vector_type(4)));
typedef int i32x8v __attribute__((ext_vector_type(8)));
__device__ __forceinline__ i32x8v cat8(bf16x8 a, bf16x8 b) { const i32x4v x = __builtin_bit_cast(i32x4v, a), y = __builtin_bit_cast(i32x4v, b); return __builtin_shufflevector(x, y, 0, 1, 2, 3, 4, 5, 6, 7); }
template <bool F8> struct Frag;
template <> struct Frag<false> { bf16x8 v[2]; __device__ __forceinline__ void set(bf16x8 a, bf16x8 b) { v[0] = a; v[1] = b; } };
template <> struct Frag<true> { i32x8v v; __device__ __forceinline__ void set(bf16x8 a, bf16x8 b) { v = cat8(a, b); } };
__device__ __forceinline__ f32x4 frag_mma(const Frag<false>& b, const Frag<false>& a, f32x4 c) { c = __builtin_amdgcn_mfma_f32_16x16x32_bf16(b.v[0], a.v[0], c, 0, 0, 0); return __builtin_amdgcn_mfma_f32_16x16x32_bf16(b.v[1], a.v[1], c, 0, 0, 0); }
__device__ __forceinline__ f32x4 frag_mma(const Frag<true>& b, const Frag<true>& a, f32x4 c) {
    const int sc1 = 0x7f7f7f7f;
    asm volatile("v_mfma_scale_f32_16x16x128_f8f6f4 %0, %1, %2, %0, %3, %3 op_sel_hi:[0,0,0]" : "+v"(c) : "v"(b.v), "v"(a.v), "v"(sc1));
    return c; }
template <class Epi, class Sched, bool ALIGN_EPI, bool SP2, bool GATHER = false, bool F8 = false>
__device__ __forceinline__ void gemm_phase(LAS unsigned char* lds, const Gemm g, const Sched& S, const Epi& E) {
    const int tid = opaque_tid(), wid = __builtin_amdgcn_readfirstlane(tid >> 6), lane = tid & 63, wr = wid >> 2, wc = wid & 3, fr = lane & 15, fq = lane >> 4;
    const int K = g.K * (F8 ? 1 : 2), nt = K / 128;
    unsigned voffA[2][2], voffB[2];
#pragma unroll
    for (int i = 0; i < 2; ++i) { int R, C; stage_rc(tid * 16 + i * 8192, R, C); const int Rb = Epi::PERM ? ((R & ~31) + perm32(R & 31)) : R;
        if constexpr (GATHER) { voffA[0][i] = (unsigned)(g.gidx[R] * K + C * 2); voffA[1][i] = (unsigned)(g.gidx[HALF + R] * K + C * 2); }
        else { voffA[0][i] = (unsigned)(R * K + C * 2); voffA[1][i] = voffA[0][i]; }
        voffB[i] = (unsigned)(Rb * K + C * 2); }
    const size_t kstep = (size_t)(BK * 2);
    const size_t hstep = (size_t)HALF * K;
    const size_t hstepA = GATHER ? (size_t)0 : hstep;
    const size_t tstep = 2 * hstep;
    const unsigned ldsw = (unsigned)wid * 1024u;
    const int aoff = F8 ? lds_byte(wr * 64 + fr, (fq >> 1) * 32 + (fq & 1) * 16) : lds_byte(wr * 64 + fr, fq * 8), boff = F8 ? lds_byte(wc * 32 + fr, (fq >> 1) * 32 + (fq & 1) * 16) : lds_byte(wc * 32 + fr, fq * 8);
    const int aoff1 = F8 ? aoff + 16 : aoff + 1024, boff1 = F8 ? boff + 16 : boff + 1024;
#define PG8_SA(b, h) (((b) * 2 + (h)) * HTB)
#define PG8_SB(b, h) ((4 + (b) * 2 + (h)) * HTB)
#define PG8_STAGE(bufoff, gbase, voff) do { _Pragma("unroll") for (int _i = 0; _i < 2; ++_i) \
        __builtin_amdgcn_global_load_lds((const unsigned*)((const char*)(gbase) + (voff)[_i]), (LAS unsigned*)(lds + (bufoff) + ldsw + _i * 8192), 16, 0, 0); } while (0)
#define PG8_LDA(dst, b, h) do { _Pragma("unroll") for (int m = 0; m < 4; ++m) dst[m].set(*(const LAS bf16x8*)(lds + PG8_SA(b, h) + aoff + m * 2048), *(const LAS bf16x8*)(lds + PG8_SA(b, h) + aoff1 + m * 2048)); } while (0)
#define PG8_LDB(dst, b, h) do { _Pragma("unroll") for (int n = 0; n < 2; ++n) dst[n].set(*(const LAS bf16x8*)(lds + PG8_SB(b, h) + boff + n * 2048), *(const LAS bf16x8*)(lds + PG8_SB(b, h) + boff1 + n * 2048)); } while (0)
#define PG8_MMA(ai, bj, At, Bt) do { __builtin_amdgcn_s_setprio(1); _Pragma("unroll") for (int m = 0; m < 4; ++m) _Pragma("unroll") for (int n = 0; n < 2; ++n) \
        acc[ai][bj][m][n] = frag_mma(Bt[n], At[m], acc[ai][bj][m][n]); __builtin_amdgcn_s_setprio(0); } while (0)
#define PG8_WAIT_V(n) asm volatile("s_waitcnt vmcnt(" #n ")" ::: "memory")
#define PG8_WAIT_L(n) asm volatile("s_waitcnt lgkmcnt(" #n ")" ::: "memory")
#define PG8_BAR __builtin_amdgcn_s_barrier()
#define PG8_SCHED __builtin_amdgcn_sched_barrier(0)
    Unit cur, nxt; int ui = 0;
    if (!S.next(0, cur)) return;
    f32x4 acc[2][2][4][2];
#pragma unroll
    for (int a = 0; a < 2; ++a)
#pragma unroll
        for (int b = 0; b < 2; ++b)
#pragma unroll
            for (int m = 0; m < 4; ++m)
#pragma unroll
                for (int n = 0; n < 2; ++n) acc[a][b][m][n] = (f32x4){0.f, 0.f, 0.f, 0.f};
    Frag<F8> At[4], B0[2], B1[2];
    const char* cA = (const char*)g.A + (size_t)cur.pm * tstep; const char* cB = (const char*)g.Bt + (size_t)cur.pn * tstep;
    S.a_ready(cur);
    if constexpr (SP2) {
        PG8_STAGE(PG8_SB(0, 0), cB, voffB); PG8_STAGE(PG8_SB(0, 1), cB + hstep, voffB); PG8_STAGE(PG8_SA(0, 0), cA, voffA[0]); PG8_STAGE(PG8_SA(0, 1), cA + hstepA, voffA[GATHER ? 1 : 0]);
        if (wr == 1) PG8_BAR;
        PG8_WAIT_V(2); PG8_BAR;
        PG8_STAGE(PG8_SB(1, 0), cB + kstep, voffB); PG8_STAGE(PG8_SA(1, 0), cA + kstep, voffA[0]); PG8_STAGE(PG8_SB(1, 1), cB + hstep + kstep, voffB);
        PG8_WAIT_V(6); PG8_BAR;
    } else {
        PG8_STAGE(PG8_SB(0, 0), cB, voffB); PG8_STAGE(PG8_SA(0, 0), cA, voffA[0]); PG8_STAGE(PG8_SB(0, 1), cB + hstep, voffB); PG8_STAGE(PG8_SA(0, 1), cA + hstepA, voffA[GATHER ? 1 : 0]);
        if (wr == 1) PG8_BAR;
        PG8_WAIT_V(4); PG8_BAR;
        PG8_STAGE(PG8_SB(1, 0), cB + kstep, voffB); PG8_STAGE(PG8_SA(1, 0), cA + kstep, voffA[0]); PG8_STAGE(PG8_SB(1, 1), cB + hstep + kstep, voffB);
        PG8_WAIT_V(6); PG8_BAR;
    }
    for (;;) {
        const bool has_next = S.next(ui + 1, nxt);
        const char* nA = has_next ? (const char*)g.A + (size_t)nxt.pm * tstep : cA; const char* nB = has_next ? (const char*)g.Bt + (size_t)nxt.pn * tstep : cB;
#pragma unroll 1
        for (int t = 0; t < nt; t += 2) {
            const bool last = (t == nt - 2);
            if constexpr (F8) { asm volatile("" : "+v"(voffA[0][0]), "+v"(voffA[0][1]), "+v"(voffB[0]), "+v"(voffB[1])); if constexpr (GATHER) asm volatile("" : "+v"(voffA[1][0]), "+v"(voffA[1][1])); }
            const char* a1 = cA + (size_t)(t + 1) * kstep;
            const char* a2 = last ? nA : cA + (size_t)(t + 2) * kstep; const char* b2 = last ? nB : cB + (size_t)(t + 2) * kstep;
            const char* a3 = a2 + kstep; const char* b3 = b2 + kstep;
            if (last && has_next) S.a_ready(nxt);
            if constexpr (SP2) {
            PG8_LDB(B0, 0, 0); PG8_LDB(B1, 0, 1); PG8_SCHED; PG8_LDA(At, 0, 0); PG8_STAGE(PG8_SA(1, 1), a1 + hstepA, voffA[GATHER ? 1 : 0]);
            PG8_WAIT_V(8); PG8_WAIT_L(0); PG8_BAR; PG8_MMA(0, 0, At, B0); PG8_MMA(0, 1, At, B1); PG8_BAR; PG8_SCHED;
            PG8_LDA(At, 0, 1); PG8_STAGE(PG8_SB(0, 0), b2, voffB); PG8_STAGE(PG8_SB(0, 1), b2 + hstep, voffB); PG8_STAGE(PG8_SA(0, 0), a2, voffA[0]);
            PG8_WAIT_V(8); PG8_WAIT_L(0); PG8_BAR; PG8_MMA(1, 0, At, B0); PG8_MMA(1, 1, At, B1); PG8_BAR; PG8_SCHED;
            PG8_LDB(B0, 1, 0); PG8_LDB(B1, 1, 1); PG8_SCHED; PG8_LDA(At, 1, 0); PG8_STAGE(PG8_SA(0, 1), a2 + hstepA, voffA[GATHER ? 1 : 0]);
            PG8_WAIT_V(8); PG8_WAIT_L(0); PG8_BAR; PG8_MMA(0, 0, At, B0); PG8_MMA(0, 1, At, B1); PG8_BAR; PG8_SCHED;
            PG8_LDA(At, 1, 1); PG8_STAGE(PG8_SB(1, 0), b3, voffB); PG8_STAGE(PG8_SB(1, 1), b3 + hstep, voffB); PG8_STAGE(PG8_SA(1, 0), a3, voffA[0]);
            PG8_WAIT_V(8); PG8_WAIT_L(0); PG8_BAR; PG8_MMA(1, 0, At, B0); PG8_MMA(1, 1, At, B1); PG8_BAR; PG8_SCHED;
            } else {
            PG8_LDB(B0, 0, 0); PG8_SCHED; PG8_LDA(At, 0, 0); PG8_STAGE(PG8_SA(1, 1), a1 + hstepA, voffA[GATHER ? 1 : 0]);
            PG8_WAIT_L(8); PG8_BAR; PG8_WAIT_L(0); PG8_MMA(0, 0, At, B0); PG8_BAR; PG8_SCHED;
            PG8_LDB(B1, 0, 1); PG8_STAGE(PG8_SB(0, 0), b2, voffB);
            PG8_BAR; PG8_WAIT_L(0); PG8_MMA(0, 1, At, B1); PG8_BAR;
            PG8_LDA(At, 0, 1); PG8_STAGE(PG8_SA(0, 0), a2, voffA[0]);
            PG8_BAR; PG8_WAIT_L(0); PG8_MMA(1, 0, At, B0); PG8_BAR; PG8_SCHED;
            PG8_STAGE(PG8_SB(0, 1), b2 + hstep, voffB);
            PG8_WAIT_V(6); PG8_BAR; PG8_MMA(1, 1, At, B1); PG8_BAR;
            PG8_LDB(B0, 1, 0); PG8_SCHED; PG8_LDA(At, 1, 0); PG8_STAGE(PG8_SA(0, 1), a2 + hstepA, voffA[GATHER ? 1 : 0]);
            PG8_WAIT_L(8); PG8_BAR; PG8_WAIT_L(0); PG8_MMA(0, 0, At, B0); PG8_BAR; PG8_SCHED;
            PG8_LDB(B1, 1, 1); PG8_STAGE(PG8_SB(1, 0), b3, voffB);
            PG8_BAR; PG8_WAIT_L(0); PG8_MMA(0, 1, At, B1); PG8_BAR;
            PG8_LDA(At, 1, 1); PG8_STAGE(PG8_SA(1, 0), a3, voffA[0]);
            PG8_BAR; PG8_WAIT_L(0); PG8_MMA(1, 0, At, B0); PG8_BAR; PG8_SCHED;
            PG8_STAGE(PG8_SB(1, 1), b3 + hstep, voffB);
            PG8_WAIT_V(6); PG8_BAR; PG8_MMA(1, 1, At, B1); PG8_BAR;
            }
        }
        if constexpr (ALIGN_EPI) { if (wr == 0) PG8_BAR; }
        if constexpr (F8) asm volatile("s_nop 15\n\ts_nop 7" ::: "memory");
        E(acc, cur, wr, wc, fr, fq); S.done(cur);
        if (!has_next) break;
#pragma unroll
        for (int a = 0; a < 2; ++a)
#pragma unroll
            for (int b = 0; b < 2; ++b)
#pragma unroll
                for (int m = 0; m < 4; ++m)
#pragma unroll
                    for (int n = 0; n < 2; ++n) acc[a][b][m][n] = (f32x4){0.f, 0.f, 0.f, 0.f};
        cur = nxt; cA = nA; cB = nB; ++ui;
        if constexpr (ALIGN_EPI) { if (wr == 1) PG8_BAR; }
    }
    PG8_WAIT_V(0);
    if constexpr (!ALIGN_EPI) { if (wr == 0) PG8_BAR; }
    PG8_BAR;
#undef PG8_SA
#undef PG8_SB
#undef PG8_STAGE
#undef PG8_LDA
#undef PG8_LDB
#undef PG8_MMA
#undef PG8_WAIT_V
#undef PG8_WAIT_L
#undef PG8_BAR
#undef PG8_SCHED
}
}

typedef GAS unsigned gu32;
#define RLX_AGENT __ATOMIC_RELAXED, __HIP_MEMORY_SCOPE_AGENT
#define LDS_WAIT() asm volatile("s_waitcnt lgkmcnt(0)" ::: "memory")
#define VM_WAIT() asm volatile("s_waitcnt vmcnt(0)" ::: "memory")
__device__ __forceinline__ unsigned pk2(float lo, float hi) { return pg8::cvt_pk_bf16(lo, hi); }
__device__ __forceinline__ float bf2f(unsigned short h) { return __uint_as_float((unsigned)h << 16); }
__device__ __forceinline__ float bflo(unsigned w) { return __uint_as_float(w << 16); }
__device__ __forceinline__ float bfhi(unsigned w) { return __uint_as_float(w & 0xffff0000u); }
__device__ __forceinline__ float wave_sum(float v) {
    v += __builtin_bit_cast(float, __builtin_amdgcn_update_dpp(0, __builtin_bit_cast(int, v), 0xB1, 0xf, 0xf, true));
    v += __builtin_bit_cast(float, __builtin_amdgcn_update_dpp(0, __builtin_bit_cast(int, v), 0x4E, 0xf, 0xf, true));
    v += __builtin_bit_cast(float, __builtin_amdgcn_update_dpp(0, __builtin_bit_cast(int, v), 0x141, 0xf, 0xf, true));
    v += __builtin_bit_cast(float, __builtin_amdgcn_update_dpp(0, __builtin_bit_cast(int, v), 0x140, 0xf, 0xf, true));
    v += __builtin_bit_cast(float, __builtin_amdgcn_update_dpp(0, __builtin_bit_cast(int, v), 0x142, 0xa, 0xf, false));
    v += __builtin_bit_cast(float, __builtin_amdgcn_update_dpp(0, __builtin_bit_cast(int, v), 0x143, 0xc, 0xf, false));
    return __builtin_bit_cast(float, __builtin_amdgcn_readlane(__builtin_bit_cast(int, v), 63));
}

#define XB_TMO      128
#define XB_XCNT(j)  (256  + 64 * (j))
#define XB_XSUB(j)  (1280 + 64 * (j))
#define XB_XGEN(j)  (2304 + 64 * (j))
#define XB_TOP      3328
#define XB_TOPGEN   3392
#define XCD_BAR_WORDS 3456
#define XB_SPIN_CAP (1u << 18)
__device__ __forceinline__ unsigned xb_ld(unsigned* p)              { return __hip_atomic_load(p, __ATOMIC_RELAXED, __HIP_MEMORY_SCOPE_AGENT); }
__device__ __forceinline__ unsigned xb_add(unsigned* p, unsigned v) { return __hip_atomic_fetch_add(p, v, __ATOMIC_RELAXED, __HIP_MEMORY_SCOPE_AGENT); }
__device__ __forceinline__ unsigned xb_xcc_id() { return (unsigned)__builtin_amdgcn_s_getreg((3 << 11) | 20) & 0xFu; }
#define XB_SPIN(cond, bar) do { unsigned _sp = 0; while (cond) { __builtin_amdgcn_s_sleep(1); \
    if ((++_sp & 255u) == 0u) { if (xb_ld(&(bar)[XB_TMO])) break; if (_sp > XB_SPIN_CAP) { atomicAdd(&(bar)[XB_TMO], 1u); break; } } } } while (0)
struct XcdBarrier { unsigned* bar; unsigned x; volatile LAS unsigned* st; };
__device__ __forceinline__ XcdBarrier xcd_barrier_post(unsigned* bar, volatile LAS unsigned* st) {
    XcdBarrier b; b.bar = bar; b.x = xb_xcc_id(); b.st = st;
    if (threadIdx.x == 0) (void)xb_add(&bar[XB_XCNT(b.x)], 1u);
    return b;
}
__device__ __forceinline__ void xcd_barrier_complete(unsigned* bar, unsigned x, unsigned& nloc, unsigned& nx) {
    const unsigned G = gridDim.x * gridDim.y * gridDim.z;
    unsigned sum, cnt, mine, sp = 0u;
    for (;;) {
        sum = 0u; cnt = 0u; mine = 0u;
#pragma unroll
        for (unsigned j = 0; j < 16; ++j) { const unsigned c = xb_ld(&bar[XB_XCNT(j)]); sum += c; cnt += (c > 0u) ? 1u : 0u; mine = (j == x) ? c : mine; }
        if (sum == G) break;
        __builtin_amdgcn_s_sleep(1);
        if ((++sp & 255u) == 0u) { if (xb_ld(&bar[XB_TMO])) break; if (sp > XB_SPIN_CAP) { atomicAdd(&bar[XB_TMO], 1u); break; } }
    }
    nloc = mine > 0u ? mine : 1u; nx = cnt > 0u ? cnt : 1u;
}
__device__ __forceinline__ void xcd_barrier(const XcdBarrier& b) {
    asm volatile("s_waitcnt vmcnt(0)" ::: "memory");
    __syncthreads();
    if (threadIdx.x == 0) {
        unsigned* bar = b.bar;
        __builtin_amdgcn_s_waitcnt(0);
        unsigned nloc = b.st[0], nx = b.st[1];
        if (nloc == 0u) { xcd_barrier_complete(bar, b.x, nloc, nx); b.st[0] = nloc; b.st[1] = nx; }
        const unsigned old = xb_add(&bar[XB_XSUB(b.x)], 1u);
        const unsigned gen = old / nloc;
        if (old + 1u == (gen + 1u) * nloc) {
            __builtin_amdgcn_fence(__ATOMIC_RELEASE, "agent");
            asm volatile("s_waitcnt vmcnt(0)" ::: "memory");
            const unsigned og = xb_add(&bar[XB_TOP], 1u);
            const unsigned tg = og / nx;
            if (og + 1u == (tg + 1u) * nx) xb_add(&bar[XB_TOPGEN], 1u);
            else XB_SPIN(xb_ld(&bar[XB_TOPGEN]) == tg, bar);
            __builtin_amdgcn_fence(__ATOMIC_ACQUIRE, "agent");
            xb_add(&bar[XB_XGEN(b.x)], 1u);
            asm volatile("s_waitcnt vmcnt(0)" ::: "memory");
        } else {
            XB_SPIN(xb_ld(&bar[XB_XGEN(b.x)]) == gen, bar);
            __builtin_amdgcn_fence(__ATOMIC_ACQUIRE, "agent");
            asm volatile("s_waitcnt vmcnt(0)" ::: "memory");
        }
    }
    __syncthreads();
}

constexpr int RING_BYTES = 131072;
constexpr int LDSCTL_OFF = RING_BYTES, MISC_OFF = LDSCTL_OFF + 320;
constexpr int LDS_BYTES = 147456;
constexpr int CW_BAR = 4096;
constexpr int CW_KMAX = 65536;

struct Args { const float* in[22]; float* out; unsigned char* ws; int ph_lo, ph_hi; };
enum { I_X = 0, I_C, I_CTX, I_CCTX, I_WADA, I_BADA, I_NPRE_MIX, I_NPOST_MIX, I_NPRE_FFN, I_NPOST_FFN, I_WIN, I_CONVW, I_LQ1, I_LK1, I_LQ2, I_LK2, I_SUBLN, I_WOUT, I_WROUTER, I_WGATE, I_WUP, I_WDOWN };

__device__ __forceinline__ int win_dest(int n) {
    if (n < 1024) { const int j = n & 63; const int p = ((j >> 5) << 5) + ((j & 15) << 1) + ((j >> 4) & 1); return (n & ~63) + p; }
    if (n < 2048) return n;
    int c = n - 2048; const int isx = c >= 512; c &= 511; return 2048 + ((c >> 7) << 8) + (isx << 7) + (c & 127);
}
template <int MODE>
__device__ __forceinline__ int tr_dest(int n) {
    if (MODE == 0) return n;
    if (MODE == 1) return win_dest(n);
    if (MODE == 2) return ((n >> 7) << 8) + (n & 127);
    return ((n >> 7) << 8) + 128 + (n & 127);
}
template <int MODE>
__device__ __forceinline__ void p0_transpose_item_f8(const float* W, int K, int N, unsigned char* WT, LAS float* scr, int item, int lane) {
    const int nblk = N / 32, kb = item / nblk, nb = item % nblk, k0 = 64 * kb, n0 = 32 * nb;
#pragma unroll 8
    for (int i = 0; i < 32; ++i) { const int kk = 2 * i + (lane >> 5); scr[kk * 33 + (lane & 31)] = __builtin_nontemporal_load(W + (size_t)(k0 + kk) * N + n0 + (lane & 31)) * pg8::F8_WGT; }
    LDS_WAIT(); asm volatile("" ::: "memory");
    const int c = lane & 7;
#pragma unroll
    for (int j = 0; j < 4; ++j) { const int n = (lane >> 3) + 8 * j; const LAS float* s = scr + (8 * c) * 33 + n;
        u32x2 o; o.x = pg8::pk4_fp8(s[0 * 33], s[1 * 33], s[2 * 33], s[3 * 33]); o.y = pg8::pk4_fp8(s[4 * 33], s[5 * 33], s[6 * 33], s[7 * 33]);
        *(GAS u32x2*)(WT + (size_t)tr_dest<MODE>(n0 + n) * K + k0 + 8 * c) = o; }
    LDS_WAIT(); asm volatile("" ::: "memory");
}
template <int MODE>
__device__ __forceinline__ void p0_transpose_item(const float* W, int K, int N, bf16_t* WT, LAS float* scr, int item, int lane) {
    const int nblk = N / 32, kb = item / nblk, nb = item % nblk, k0 = 64 * kb, n0 = 32 * nb;
#pragma unroll 8
    for (int i = 0; i < 32; ++i) { const int kk = 2 * i + (lane >> 5); scr[kk * 33 + (lane & 31)] = W[(size_t)(k0 + kk) * N + n0 + (lane & 31)]; }
    LDS_WAIT(); asm volatile("" ::: "memory");
    const int c = lane & 7;
#pragma unroll
    for (int j = 0; j < 4; ++j) { const int n = (lane >> 3) + 8 * j; const LAS float* s = scr + (8 * c) * 33 + n;
        u32x4 o; o.x = pk2(s[0 * 33], s[1 * 33]); o.y = pk2(s[2 * 33], s[3 * 33]); o.z = pk2(s[4 * 33], s[5 * 33]); o.w = pk2(s[6 * 33], s[7 * 33]);
        *(GAS u32x4*)(WT + (size_t)tr_dest<MODE>(n0 + n) * K + k0 + 8 * c) = o; }
    LDS_WAIT(); asm volatile("" ::: "memory");
}

__device__ __forceinline__ void p0_prologue(const Args& a, LAS unsigned char* lds, int vcu, int G) {
    const int tid = opaque_tid(), lane = tid & 63, wave = __builtin_amdgcn_readfirstlane(tid >> 6);
    LAS float* scr = (LAS float*)(lds + wave * 16384);
    const int gw = vcu * NWAVES + wave, NGW = G * NWAVES;
    unsigned char* ws = a.ws;
    if (gw < 96 * 16) {
        float* MODP = (float*)(ws + WS_MODP);
        const float* wada = a.in[I_WADA];
        for (int it = gw; it < 96 * 16; it += NGW) {
            const int cg = it % 96, kc = it / 96;
            for (int b = 0; b < 33; ++b) { const float v = (b < 32) ? a.in[I_C][b * D + kc * 64 + lane] : a.in[I_CCTX][kc * 64 + lane]; scr[b * 64 + lane] = v / (1.f + __expf(-v)); }
            LDS_WAIT(); asm volatile("" ::: "memory");
            float acc[33];
#pragma unroll
            for (int b = 0; b < 33; ++b) acc[b] = 0.f;
            const float* wp = wada + (size_t)(kc * 64) * NMOD + cg * 64 + lane;
#pragma unroll 2
            for (int k = 0; k < 64; k += 4) {
                const float w0 = __builtin_nontemporal_load(wp + (size_t)(k + 0) * NMOD), w1 = __builtin_nontemporal_load(wp + (size_t)(k + 1) * NMOD),
                            w2 = __builtin_nontemporal_load(wp + (size_t)(k + 2) * NMOD), w3 = __builtin_nontemporal_load(wp + (size_t)(k + 3) * NMOD);
#pragma unroll
                for (int b = 0; b < 33; ++b) { const f32x4 sv4 = *(const LAS f32x4*)(scr + b * 64 + k); acc[b] += (sv4.x * w0 + sv4.y * w1) + (sv4.z * w2 + sv4.w * w3); }
            }
#pragma unroll
            for (int b = 0; b < 33; ++b) MODP[((size_t)kc * 33 + b) * NMOD + cg * 64 + lane] = acc[b];
            LDS_WAIT(); asm volatile("" ::: "memory");
        }
    } else {
        float* tab = (float*)(ws + WS_TAB);
        const int nw = NGW - 96 * 16;
        for (int e = (gw - 96 * 16) * 64 + lane; e < T * 32; e += nw * 64) {
            const int t = e >> 5, i = e & 31;
            const float inv = powf(10000.0f, -(float)(2 * (i & 15)) / 32.0f);
            const float pos = (i < 16) ? (float)(t >> 6) : (float)(t & 63);
            const float ang = pos * inv;
            tab[2 * e] = cosf(ang); tab[2 * e + 1] = sinf(ang);
        }
    }
}
__device__ __forceinline__ void inout_weight_copies(const Args& a, LAS unsigned char* lds, int vcu, int G) {
    const int tid = opaque_tid(), lane = tid & 63, wave = __builtin_amdgcn_readfirstlane(tid >> 6);
    LAS float* scr = (LAS float*)(lds + 16384 + wave * 12288);
    const int gw = vcu * NWAVES + wave, NGW = G * NWAVES;
    unsigned char* ws = a.ws;
    constexpr int I_IN = (D / 64) * (NPROJ / 32), I_OUT = (D / 64) * (D / 32);
    constexpr int NITEMS = I_IN + I_OUT;
    bf16_t* Win_t = (bf16_t*)(ws + WS_WIN); bf16_t* Wout_t = (bf16_t*)(ws + WS_WOUT);
    for (int it = gw; it < NITEMS; it += NGW) {
        int r = it;
        if (r < I_IN) { p0_transpose_item<1>(a.in[I_WIN], D, NPROJ, Win_t, scr, r, lane); continue; } r -= I_IN;
        p0_transpose_item<0>(a.in[I_WOUT], D, D, Wout_t, scr, r, lane);
    }
}
__device__ __forceinline__ void expert_weight_copies(const Args& a, LAS unsigned char* lds, int gw0  , int ngroups, int r_lo, int r_hi) {
    const int tid = opaque_tid(), lane = tid & 63, wave = __builtin_amdgcn_readfirstlane(tid >> 6);
    LAS float* scr = (LAS float*)(lds + wave * 16384);
    const int gw = gw0 * NWAVES + wave, NGW = ngroups * NWAVES;
    unsigned char* ws = a.ws;
    constexpr int I_EXP = (D / 64) * (D / 32);
    unsigned char* Wgu_t = ws + WS_WGU; unsigned char* Wdn_t = ws + WS_WDN;
    for (int r = r_lo + gw; r < r_hi; r += NGW) {
        const int e = r / (3 * I_EXP), q = (r % (3 * I_EXP)) / I_EXP, rr = r % I_EXP;
        if (q == 0) p0_transpose_item_f8<2>(a.in[I_WGATE] + (size_t)e * D * D, D, D, Wgu_t + (size_t)e * 2048 * D, scr, rr, lane);
        else if (q == 1) p0_transpose_item_f8<3>(a.in[I_WUP] + (size_t)e * D * D, D, D, Wgu_t + (size_t)e * 2048 * D, scr, rr, lane);
        else p0_transpose_item_f8<0>(a.in[I_WDOWN] + (size_t)e * D * D, D, D, Wdn_t + (size_t)e * D * D, scr, rr, lane);
    }
    __syncthreads();
}

struct RowF { f32x4 v[4]; };
__device__ __forceinline__ void row_load(RowF& r, const float* xrow, int lane) {
    const f32x4* xr = (const f32x4*)xrow + lane;
#pragma unroll
    for (int j = 0; j < 4; ++j) r.v[j] = __builtin_nontemporal_load(xr + 64 * j);
}
__device__ __forceinline__ void norm_mod_row(const RowF& r, bf16_t* orow, const float* gain, const LAS float* sc, const LAS float* sh, int lane) {
    const f32x4* gr = (const f32x4*)gain + lane;
    float s = 0.f;
#pragma unroll
    for (int j = 0; j < 4; ++j) s += (r.v[j].x * r.v[j].x + r.v[j].y * r.v[j].y) + (r.v[j].z * r.v[j].z + r.v[j].w * r.v[j].w);
    const float rstd = 1.0f / sqrtf(wave_sum(s) * (1.f / D) + EPS);
    u32x2* o8 = (u32x2*)orow + lane;
#pragma unroll
    for (int j = 0; j < 4; ++j) { const f32x4 g = gr[64 * j]; const f32x4 c1 = *(const LAS f32x4*)(sc + 4 * lane + 256 * j), h1 = *(const LAS f32x4*)(sh + 4 * lane + 256 * j);
        const f32x4 y = (r.v[j] * rstd) * g; const f32x4 z = y * (c1 + 1.0f) + h1;
        u32x2 w; w.x = pk2(z.x, z.y); w.y = pk2(z.z, z.w); o8[64 * j] = w; }
}
__device__ __forceinline__ void p1_xn(const Args& a, LAS unsigned char* lds, int c, int G) {
    const int tid = opaque_tid(), lane = tid & 63, wave = __builtin_amdgcn_readfirstlane(tid >> 6);
    unsigned char* ws = a.ws;
    const float* MODP = (const float*)(ws + WS_MODP); float* MOD = (float*)(ws + WS_MOD); const float* bada = a.in[I_BADA];
    { const int per = (33 * NMOD + G - 1) / G;
      for (int i = c * per + tid; i < (c + 1) * per && i < 33 * NMOD; i += NTHREADS) { const int r = i / NMOD, n = i - r * NMOD; float s = bada[n];
#pragma unroll
            for (int kc = 0; kc < 16; ++kc) s += MODP[((size_t)kc * 33 + r) * NMOD + n];
            MOD[i] = s; } }
    LAS float* sv = (LAS float*)lds;
    bf16_t* XN = (bf16_t*)(ws + WS_XN);
    const float* X = a.in[I_X]; const float* CTX = a.in[I_CTX]; const float* gain = a.in[I_NPRE_MIX];
    for (int p = c; p < 256; p += G) {
        const int b = p >> 3;
        const int rbase = p * 256 + wave * 32;
        RowF a0, a1, a2, a3;
        row_load(a0, X + (size_t)rbase * D, lane); row_load(a1, X + (size_t)(rbase + 1) * D, lane); row_load(a2, X + (size_t)(rbase + 2) * D, lane); row_load(a3, X + (size_t)(rbase + 3) * D, lane);
        __syncthreads();
        for (int n = tid; n < 4096; n += NTHREADS) { const int r = (n < 2048) ? b : 32; const int col = n & 2047; float s = bada[col];
#pragma unroll
            for (int kc = 0; kc < 16; ++kc) s += MODP[((size_t)kc * 33 + r) * NMOD + col];
            sv[n] = s; }
        __syncthreads();
        const int crow = p * 32 + wave * 4;
        for (int i = 0; i < 8; ++i) {
            RowF n0, n1, n2, n3;
            const float* nx = (i + 1 < 8) ? X + (size_t)(rbase + 4 * (i + 1)) * D : CTX + (size_t)crow * D;
            row_load(n0, nx, lane); row_load(n1, nx + D, lane); row_load(n2, nx + 2 * D, lane); row_load(n3, nx + 3 * D, lane);
            bf16_t* orow = XN + (size_t)(rbase + 4 * i) * D;
            norm_mod_row(a0, orow, gain, sv + 1024, sv, lane);
            norm_mod_row(a1, orow + D, gain, sv + 1024, sv, lane);
            norm_mod_row(a2, orow + 2 * D, gain, sv + 1024, sv, lane);
            norm_mod_row(a3, orow + 3 * D, gain, sv + 1024, sv, lane);
            a0 = n0; a1 = n1; a2 = n2; a3 = n3;
        }
        { bf16_t* orow = XN + (size_t)(M + crow) * D;
          norm_mod_row(a0, orow, gain, sv + 3072, sv + 2048, lane);
          norm_mod_row(a1, orow + D, gain, sv + 3072, sv + 2048, lane);
          norm_mod_row(a2, orow + 2 * D, gain, sv + 3072, sv + 2048, lane);
          norm_mod_row(a3, orow + 3 * D, gain, sv + 3072, sv + 2048, lane); }
    }
}

namespace att {
constexpr int KP = 272, KBUF = 64 * KP, VBUF = 16384;
constexpr int OFF_K = 0, OFF_V = 2 * KBUF, OFF_WSF = OFF_V + 2 * VBUF, OFF_END = OFF_WSF + NWAVES * 256;
static_assert(OFF_WSF >= 65536 && OFF_END <= RING_BYTES, "attention LDS map");
constexpr int NT = TK / 64;
constexpr float THR = 8.0f;
__device__ __forceinline__ int crow(int r, int hi) { return (r & 3) + 8 * (r >> 2) + 4 * hi; }
__device__ __forceinline__ float max3f(float a, float b, float c) { float r; asm("v_max3_f32 %0, %1, %2, %3" : "=v"(r) : "v"(a), "v"(b), "v"(c)); return r; }
__device__ __forceinline__ float max2f(float a, float b) { float r; asm("v_max_f32_e32 %0, %1, %2" : "=v"(r) : "v"(a), "v"(b)); return r; }
__device__ __forceinline__ s16x4 vtr(const LAS unsigned char* p) { return __builtin_bit_cast(s16x4, __builtin_amdgcn_ds_read_tr16_b64_v4i16((LAS s16x4*)p)); }

#define ATT_BAR() asm volatile("s_waitcnt lgkmcnt(0)\n\ts_barrier" ::: "memory")
#define ATT_SB() __builtin_amdgcn_sched_barrier(0)
#define ATT_KLD(i, KF) KF = *(const LAS bf16x8*)(kb_ + ((i) & 1) * (32 * KP) + ((i) >> 1) * 32)
#define ATT_XSTEP(i, KC, KN) do { if ((i) + 2 < 8) { ATT_KLD((i) + 2, KN); } \
    if ((i) == 0) p0 = __builtin_amdgcn_mfma_f32_32x32x16_bf16(KC, qr[0], negref, 0, 0, 0); \
    else if ((i) == 1) p1 = __builtin_amdgcn_mfma_f32_32x32x16_bf16(KC, qr[0], negref, 0, 0, 0); \
    else if (((i) & 1) == 0) p0 = __builtin_amdgcn_mfma_f32_32x32x16_bf16(KC, qr[(i) >> 1], p0, 0, 0, 0); else p1 = __builtin_amdgcn_mfma_f32_32x32x16_bf16(KC, qr[(i) >> 1], p1, 0, 0, 0); ATT_SB(); } while (0)
#define ATT_X(kcur) do { \
    const LAS unsigned char* kb_ = lds + OFF_K + (kcur) * KBUF + koff; \
    bf16x8 ka_, kb2_, kc_; \
    ATT_KLD(0, ka_); ATT_KLD(1, kb2_); \
    ATT_SB(); \
    ATT_XSTEP(0, ka_, kc_); ATT_XSTEP(1, kb2_, ka_); ATT_XSTEP(2, kc_, kb2_); ATT_XSTEP(3, ka_, kc_); \
    ATT_XSTEP(4, kb2_, ka_); ATT_XSTEP(5, kc_, kb2_); ATT_XSTEP(6, ka_, kc_); ATT_XSTEP(7, kb2_, ka_); \
} while (0)
#define ATT_EXP2(i, PWN) do { \
    const float e0_ = __builtin_amdgcn_exp2f((i) < 8 ? p0[2 * ((i) & 7)] : p1[2 * ((i) & 7)]), e1_ = __builtin_amdgcn_exp2f((i) < 8 ? p0[2 * ((i) & 7) + 1] : p1[2 * ((i) & 7) + 1]); \
    sacc_ += e0_ + e1_; PWN[(i) >> 2][(i) & 3] = pk2(e0_, e1_); asm volatile("" : "+v"(PWN[(i) >> 2]), "+v"(sacc_)); } while (0)
#define ATT_VLD(i, LO, HI) do { LO = vtr(vb_ + ((i) & 3) * 4096 + ((i) >> 2) * 1024); HI = vtr(vb_ + ((i) & 3) * 4096 + ((i) >> 2) * 1024 + 512); } while (0)
#define ATT_VF(LO, HI) ((bf16x8){LO[0], LO[1], LO[2], LO[3], HI[0], HI[1], HI[2], HI[3]})
#define ATT_YSTEP(i, PWC, PWN, LC, HC, LN, HN) do { if ((i) + 2 < 16) { ATT_VLD((i) + 2, LN, HN); } \
    o[(i) & 3] = __builtin_amdgcn_mfma_f32_32x32x16_bf16(__builtin_bit_cast(bf16x8, PWC[(i) >> 2]), ATT_VF(LC, HC), o[(i) & 3], 0, 0, 0); \
    ATT_EXP2(i, PWN); ATT_SB(); } while (0)
#define ATT_Y(vcur, PWC, PWN) do { \
    const LAS unsigned char* vb_ = lds + OFF_V + (vcur) * VBUF + voff; \
    float sacc_ = 0.f; s16x4 la_, ha_, lb_, hb_, lc_, hc_; \
    ATT_VLD(0, la_, ha_); ATT_VLD(1, lb_, hb_); ATT_SB(); \
    ATT_YSTEP(0, PWC, PWN, la_, ha_, lc_, hc_); ATT_YSTEP(1, PWC, PWN, lb_, hb_, la_, ha_); ATT_YSTEP(2, PWC, PWN, lc_, hc_, lb_, hb_); \
    ATT_YSTEP(3, PWC, PWN, la_, ha_, lc_, hc_); ATT_YSTEP(4, PWC, PWN, lb_, hb_, la_, ha_); ATT_YSTEP(5, PWC, PWN, lc_, hc_, lb_, hb_); \
    ATT_YSTEP(6, PWC, PWN, la_, ha_, lc_, hc_); ATT_YSTEP(7, PWC, PWN, lb_, hb_, la_, ha_); ATT_YSTEP(8, PWC, PWN, lc_, hc_, lb_, hb_); \
    ATT_YSTEP(9, PWC, PWN, la_, ha_, lc_, hc_); ATT_YSTEP(10, PWC, PWN, lb_, hb_, la_, ha_); ATT_YSTEP(11, PWC, PWN, lc_, hc_, lb_, hb_); \
    ATT_YSTEP(12, PWC, PWN, la_, ha_, lc_, hc_); ATT_YSTEP(13, PWC, PWN, lb_, hb_, la_, ha_); ATT_YSTEP(14, PWC, PWN, lc_, hc_, lb_, hb_); \
    ATT_YSTEP(15, PWC, PWN, la_, ha_, lc_, hc_); \
    l_reg += sacc_; \
} while (0)
#define ATT_Y0(PWN) do { float sacc_ = 0.f; _Pragma("unroll") for (int i = 0; i < 16; ++i) ATT_EXP2(i, PWN); l_reg += sacc_; } while (0)
#define ATT_ZSTEP(i, PWC, LC, HC, LN, HN) do { if ((i) + 2 < 16) { ATT_VLD((i) + 2, LN, HN); } \
    o[(i) & 3] = __builtin_amdgcn_mfma_f32_32x32x16_bf16(__builtin_bit_cast(bf16x8, PWC[(i) >> 2]), ATT_VF(LC, HC), o[(i) & 3], 0, 0, 0); ATT_SB(); } while (0)
#define ATT_Z(vcur, PWC) do { \
    const LAS unsigned char* vb_ = lds + OFF_V + (vcur) * VBUF + voff; \
    s16x4 la_, ha_, lb_, hb_, lc_, hc_; \
    ATT_VLD(0, la_, ha_); ATT_VLD(1, lb_, hb_); ATT_SB(); \
    ATT_ZSTEP(0, PWC, la_, ha_, lc_, hc_); ATT_ZSTEP(1, PWC, lb_, hb_, la_, ha_); ATT_ZSTEP(2, PWC, lc_, hc_, lb_, hb_); \
    ATT_ZSTEP(3, PWC, la_, ha_, lc_, hc_); ATT_ZSTEP(4, PWC, lb_, hb_, la_, ha_); ATT_ZSTEP(5, PWC, lc_, hc_, lb_, hb_); \
    ATT_ZSTEP(6, PWC, la_, ha_, lc_, hc_); ATT_ZSTEP(7, PWC, lb_, hb_, la_, ha_); ATT_ZSTEP(8, PWC, lc_, hc_, lb_, hb_); \
    ATT_ZSTEP(9, PWC, la_, ha_, lc_, hc_); ATT_ZSTEP(10, PWC, lb_, hb_, la_, ha_); ATT_ZSTEP(11, PWC, lc_, hc_, lb_, hb_); \
    ATT_ZSTEP(12, PWC, la_, ha_, lc_, hc_); ATT_ZSTEP(13, PWC, lb_, hb_, la_, ha_); ATT_ZSTEP(14, PWC, lc_, hc_, lb_, hb_); \
    ATT_ZSTEP(15, PWC, la_, ha_, lc_, hc_); \
} while (0)
#define ATT_STAGE(j) do { \
    if ((j) + 1 < NT) { _Pragma("unroll") for (int i = 0; i < 2; ++i) *(LAS u32x4*)(lds + OFF_K + (((j) + 1) & 1) * KBUF + kdst[i]) = kr[i]; } \
    _Pragma("unroll") for (int i = 0; i < 2; ++i) *(LAS u32x4*)(lds + OFF_V + ((j) & 1) * VBUF + vdst[i]) = vr[i]; \
    if ((j) + 2 < NT) { _Pragma("unroll") for (int i = 0; i < 2; ++i) kr[i] = *(const u32x4*)(Kb + (size_t)((j) + 2) * 64 * 512 + gsrc[i]); } \
    if ((j) + 1 < NT) { _Pragma("unroll") for (int i = 0; i < 2; ++i) vr[i] = *(const u32x4*)(Vb + (size_t)((j) + 1) * 64 * 512 + gsrc[i]); } } while (0)

__device__ __forceinline__ void unit(LAS unsigned char* lds, int b, int h, int qb, const bf16_t* Q, const bf16_t* KA, const bf16_t* VA, bf16_t* MIXIN, const float* subg, float lam, const unsigned* KM) {
    const int tid = opaque_tid(), lane = tid & 63, r32 = lane & 31, hi = lane >> 5;
    const int wid = __builtin_amdgcn_readfirstlane(tid >> 6), w = wid & 3, m = wid >> 2;
    LAS float* wsf = (LAS float*)(lds + OFF_WSF) + wid * 64;
    const int rowQ = b * T + qb * 128 + w * 32;
    bf16x8 qr[4];
#pragma unroll
    for (int d0 = 0; d0 < 4; ++d0) qr[d0] = *(const bf16x8*)(Q + (size_t)(rowQ + r32) * 512 + h * 128 + m * 64 + d0 * 16 + hi * 8);
    const bf16_t* Kb = KA + (size_t)b * TK * 512 + h * 128; const bf16_t* Vb = VA + (size_t)b * TK * 512 + h * 128;
    int gsrc[2], kdst[2], vdst[2];
#pragma unroll
    for (int i = 0; i < 2; ++i) { const int cid = tid + 512 * i, kv = cid >> 4, c16 = cid & 15;
        gsrc[i] = kv * 512 + c16 * 8; kdst[i] = kv * KP + c16 * 16; vdst[i] = (c16 >> 2) * 4096 + (kv >> 4) * 1024 + (kv & 15) * 64 + (c16 & 3) * 16; }
    u32x4 kr[2], vr[2];
#pragma unroll
    for (int i = 0; i < 2; ++i) { kr[i] = *(const u32x4*)(Kb + gsrc[i]); vr[i] = *(const u32x4*)(Vb + gsrc[i]); }
#pragma unroll
    for (int i = 0; i < 2; ++i) *(LAS u32x4*)(lds + OFF_K + kdst[i]) = kr[i];
#pragma unroll
    for (int i = 0; i < 2; ++i) kr[i] = *(const u32x4*)(Kb + (size_t)64 * 512 + gsrc[i]);
    ATT_BAR();
    f32x16 o[4];
#pragma unroll
    for (int d0 = 0; d0 < 4; ++d0) o[d0] = (f32x16){};
    float l_reg = 0.f;
    f32x16 p0, p1, negref;
    {
        const unsigned* km = KM + (b * 8 + h * 2 + m) * 2;
        const float kmax2 = __uint_as_float(km[0]) + __uint_as_float(km[1]);
        float ss = 0.f;
#pragma unroll
        for (int d0 = 0; d0 < 4; ++d0)
#pragma unroll
            for (int i = 0; i < 8; ++i) { const float v = bf2f((unsigned short)qr[d0][i]); ss += v * v; }
        ss += __shfl_xor(ss, 32);
        const float ref = sqrtf(ss * kmax2) * 1.02f;
#pragma unroll
        for (int r = 0; r < 16; ++r) negref[r] = -ref;
    }
    u32x4 pwA[4], pwB[4];
    const int koff = r32 * KP + m * 128 + hi * 16;
    const int voff = ((lane >> 4) & 1) * 32 + (lane & 3) * 8 + (4 * hi + ((lane & 15) >> 2)) * 64;
    ATT_X(0); ATT_STAGE(0); ATT_Y0(pwA); ATT_BAR();
    ATT_X(1); ATT_STAGE(1); ATT_Y(0, pwA, pwB); ATT_BAR();
    for (int j = 2; j < NT; j += 2) {
        ATT_X(0); ATT_STAGE(j); ATT_Y(1, pwB, pwA); ATT_BAR();
        ATT_X(1); ATT_STAGE(j + 1); ATT_Y(0, pwA, pwB); ATT_BAR();
    }
    ATT_Z(1, pwB); ATT_BAR();
    l_reg += __shfl_xor(l_reg, 32);
    if (hi == 0) wsf[32 + r32] = l_reg;
    LDS_WAIT();
    float rli[16];
#pragma unroll
    for (int r = 0; r < 16; ++r) rli[r] = 1.0f / wsf[32 + crow(r, hi)];
    LDS_WAIT();
    LAS float* ex = (LAS float*)lds + w * 4096;
    if (m == 1) {
#pragma unroll
        for (int r = 0; r < 16; ++r)
#pragma unroll
            for (int d0 = 0; d0 < 4; ++d0) ex[crow(r, hi) * 128 + d0 * 32 + r32] = o[d0][r] * rli[r];
    }
    ATT_BAR();
    if (m == 0) {
        float g4[4];
#pragma unroll
        for (int d0 = 0; d0 < 4; ++d0) g4[d0] = subg[d0 * 32 + r32] * (1.0f - LAM_INIT);
#pragma unroll
        for (int r = 0; r < 16; ++r) {
            const int q = crow(r, hi); float x[4]; float ss = 0.f;
#pragma unroll
            for (int d0 = 0; d0 < 4; ++d0) { x[d0] = o[d0][r] * rli[r] - lam * ex[q * 128 + d0 * 32 + r32]; ss += x[d0] * x[d0]; }
#pragma unroll
            for (int off = 1; off < 32; off <<= 1) ss += __shfl_xor(ss, off);
            const float rstd = 1.0f / sqrtf(ss * (1.f / 128.f) + EPS);
            bf16_t* dst = MIXIN + (size_t)(rowQ + q) * 1024 + h * 128 + r32;
#pragma unroll
            for (int d0 = 0; d0 < 4; ++d0) dst[d0 * 32] = (bf16_t)(pk2(x[d0] * rstd * g4[d0], 0.f) & 0xffffu);
        }
    }
    ATT_BAR();
}
#undef ATT_BAR
#undef ATT_X
#undef ATT_EXP2
#undef ATT_Y
#undef ATT_Y0
#undef ATT_Z
#undef ATT_STAGE
#undef ATT_SB
#undef ATT_KLD
#undef ATT_XSTEP
#undef ATT_VLD
#undef ATT_VF
#undef ATT_YSTEP
#undef ATT_ZSTEP
}

__device__ __forceinline__ void p3_conv_attn(const Args& a, LAS unsigned char* lds, int c, int vcu, int G) {
    const int tid = opaque_tid(), lane = tid & 63, wave = __builtin_amdgcn_readfirstlane(tid >> 6);
    unsigned char* ws = a.ws;
    const bf16_t* GB = (const bf16_t*)(ws + WS_GB); const bf16_t* U = (const bf16_t*)(ws + WS_U); bf16_t* MIXIN = (bf16_t*)(ws + WS_MIXIN);
    {
        const float* cw = a.in[I_CONVW]; float w0[8], w1[8], w2[8];
#pragma unroll
        for (int i = 0; i < 8; ++i) { w0[i] = cw[lane * 8 + i]; w1[i] = cw[512 + lane * 8 + i]; w2[i] = cw[1024 + lane * 8 + i]; }
        const int gw = vcu * NWAVES + wave, NGW = G * NWAVES;
        for (int row = gw * (M / NGW); row < (gw + 1) * (M / NGW); ++row) {
            const int t = row & (T - 1);
            const u32x4 z = {0u, 0u, 0u, 0u};
            const u32x4 uc = *(const u32x4*)(U + (size_t)row * 512 + lane * 8);
            const u32x4 up = (t > 0) ? *(const u32x4*)(U + (size_t)(row - 1) * 512 + lane * 8) : z;
            const u32x4 un = (t < T - 1) ? *(const u32x4*)(U + (size_t)(row + 1) * 512 + lane * 8) : z;
            const u32x4 gb = *(const u32x4*)(GB + (size_t)row * 512 + lane * 8);
            u32x4 o;
#pragma unroll
            for (int q = 0; q < 4; ++q) {
                const float y0 = w0[2 * q] * bflo(up[q]) + w1[2 * q] * bflo(uc[q]) + w2[2 * q] * bflo(un[q]);
                const float y1 = w0[2 * q + 1] * bfhi(up[q]) + w1[2 * q + 1] * bfhi(uc[q]) + w2[2 * q + 1] * bfhi(un[q]);
                o[q] = pk2(bflo(gb[q]) * y0, bfhi(gb[q]) * y1);
            }
            *(u32x4*)(MIXIN + (size_t)row * 1024 + 512 + lane * 8) = o;
        }
    }
    float lam;
    { const float p1 = a.in[I_LQ1][lane] * a.in[I_LK1][lane], p2 = a.in[I_LQ2][lane] * a.in[I_LK2][lane];
      lam = __expf(wave_sum(p1)) - __expf(wave_sum(p2)) + LAM_INIT; }
    const bf16_t* Q = (const bf16_t*)(ws + WS_Q); const bf16_t* KA = (const bf16_t*)(ws + WS_K); const bf16_t* VA = (const bf16_t*)(ws + WS_V);
    __syncthreads();
    for (int u = vcu * 8; u < 2048; u += G * 8) {
        const int x = (u >> 3) / 32, jj = (u >> 3) % 32;
        for (int i = 0; i < 8; ++i) {
            const int bh = 16 * x + 2 * i + (jj >> 4), qb = jj & 15;
            att::unit(lds, bh >> 2, bh & 3, qb, Q, KA, VA, MIXIN, a.in[I_SUBLN], lam, (const unsigned*)(ws + WS_CTL) + CW_KMAX);
        }
    }
}

struct P5In { f32x4 x[4]; u32x2 m[4]; };
__device__ __forceinline__ void p5_load(P5In& r, int row, int lane, const float* X, const bf16_t* MIX) {
    const f32x4* xr = (const f32x4*)(X + (size_t)row * D) + lane; const u32x2* mr = (const u32x2*)(MIX + (size_t)row * D) + lane;
#pragma unroll
    for (int j = 0; j < 4; ++j) { r.x[j] = __builtin_nontemporal_load(xr + 64 * j); r.m[j] = __builtin_nontemporal_load(mr + 64 * j); }
}
__device__ __forceinline__ float p5_resid(const P5In& r, f32x4 (&h)[4], int row, int lane, const LAS float* mv, const f32x4* npm, bf16_t* H1) {
    f32x4 mx[4]; float s = 0.f;
#pragma unroll
    for (int j = 0; j < 4; ++j) { const u32x2 wv = r.m[j]; mx[j] = (f32x4){bflo(wv.x), bfhi(wv.x), bflo(wv.y), bfhi(wv.y)};
        s += (mx[j].x * mx[j].x + mx[j].y * mx[j].y) + (mx[j].z * mx[j].z + mx[j].w * mx[j].w); }
    const float rstd1 = 1.0f / sqrtf(wave_sum(s) * (1.f / D) + EPS);
    u32x2* hr = (u32x2*)(H1 + (size_t)row * D) + lane; float s2 = 0.f;
#pragma unroll
    for (int j = 0; j < 4; ++j) { const f32x4 g1 = *(const LAS f32x4*)(mv + 4 * lane + 256 * j);
        h[j] = r.x[j] + g1 * ((mx[j] * rstd1) * npm[64 * j]);
        u32x2 wv; wv.x = pk2(h[j].x, h[j].y); wv.y = pk2(h[j].z, h[j].w); __builtin_nontemporal_store(wv, hr + 64 * j);
        s2 += (h[j].x * h[j].x + h[j].y * h[j].y) + (h[j].z * h[j].z + h[j].w * h[j].w); }
    return 1.0f / sqrtf(wave_sum(s2) * (1.f / D) + EPS);
}
__device__ __forceinline__ void p5_rows(const Args& a, LAS unsigned char* lds, int p  ) {
    const int tid = opaque_tid(), lane = tid & 63, wave = __builtin_amdgcn_readfirstlane(tid >> 6);
    unsigned char* ws = a.ws;
    const int b = p >> 3;
    LAS float* wrt = (LAS float*)lds;
    LAS float* mv = (LAS float*)(lds + 65536);
    const float* wr = a.in[I_WROUTER];
    const bf16_t* MIX = (const bf16_t*)(ws + WS_MIX); unsigned char* XN2 = ws + WS_XN; float* AFFT = (float*)(ws + WS_AFFT); bf16_t* H1 = (bf16_t*)(ws + WS_H1);
    const float* X = a.in[I_X];
    const int rbase = p * 256 + wave * 32;
    P5In cA, cB;
    p5_load(cA, rbase, lane, X, MIX); p5_load(cB, rbase + 1, lane, X, MIX);
    for (int n = tid; n < D * NE; n += NTHREADS) { const int k = n >> 4, e = n & 15; wrt[e * D + k] = wr[n]; }
    const float* MOD = (const float*)(ws + WS_MOD) + (size_t)b * NMOD;
    for (int n = tid; n < 3 * D; n += NTHREADS) mv[n] = MOD[2 * D + n];
    __syncthreads();
    const f32x4* npm = (const f32x4*)a.in[I_NPOST_MIX] + lane; const f32x4* npf = (const f32x4*)a.in[I_NPRE_FFN] + lane;
    for (int i = 0; i < 16; ++i) {
        const int rowA = rbase + 2 * i, rowB = rowA + 1;
        P5In nA, nB;
        if (i + 1 < 16) { p5_load(nA, rowA + 2, lane, X, MIX); p5_load(nB, rowB + 2, lane, X, MIX); }
        f32x4 hA[4], hB[4];
        const float rsA = p5_resid(cA, hA, rowA, lane, mv, npm, H1);
        const float rsB = p5_resid(cB, hB, rowB, lane, mv, npm, H1);
        unsigned* oA = (unsigned*)(XN2 + (size_t)rowA * D) + lane; unsigned* oB = (unsigned*)(XN2 + (size_t)rowB * D) + lane;
        typedef float f32x2v __attribute__((ext_vector_type(2)));
        f32x2v lg2[16];
#pragma unroll
        for (int e = 0; e < 16; ++e) lg2[e] = (f32x2v){0.f, 0.f};
#pragma unroll
        for (int j = 0; j < 4; ++j) { const f32x4 sh2 = *(const LAS f32x4*)(mv + 1024 + 4 * lane + 256 * j), sc2 = *(const LAS f32x4*)(mv + 2048 + 4 * lane + 256 * j);
            const f32x4 gn = npf[64 * j];
            const f32x4 zA = ((hA[j] * rsA) * gn) * (sc2 + 1.0f) + sh2, zB = ((hB[j] * rsB) * gn) * (sc2 + 1.0f) + sh2;
            { const f32x4 qa = zA * pg8::F8_ACT, qb = zB * pg8::F8_ACT; oA[64 * j] = pg8::pk4_fp8(qa.x, qa.y, qa.z, qa.w); oB[64 * j] = pg8::pk4_fp8(qb.x, qb.y, qb.z, qb.w); }
            const f32x2v zx = {zA.x, zB.x}, zy = {zA.y, zB.y}, zz = {zA.z, zB.z}, zw = {zA.w, zB.w};
#pragma unroll
            for (int e = 0; e < 16; ++e) { const f32x4 wq = *(const LAS f32x4*)(wrt + e * D + 4 * lane + 256 * j);
                lg2[e] = __builtin_elementwise_fma(zx, (f32x2v){wq.x, wq.x}, lg2[e]); lg2[e] = __builtin_elementwise_fma(zy, (f32x2v){wq.y, wq.y}, lg2[e]);
                lg2[e] = __builtin_elementwise_fma(zz, (f32x2v){wq.z, wq.z}, lg2[e]); lg2[e] = __builtin_elementwise_fma(zw, (f32x2v){wq.w, wq.w}, lg2[e]);
                if ((e & 3) == 3) __builtin_amdgcn_sched_barrier(0); } }
        float lg[32];
#pragma unroll
        for (int e = 0; e < 16; ++e) { lg[e] = lg2[e].x; lg[16 + e] = lg2[e].y; }
#pragma unroll
        for (int st = 0; st < 5; ++st) { const int d = 1 << st, cntv = 16 >> st; const bool up = (lane & d) != 0;
#pragma unroll
            for (int q = 0; q < 16; ++q) if (q < cntv) { const float send = up ? lg[2 * q] : lg[2 * q + 1], keep = up ? lg[2 * q + 1] : lg[2 * q]; lg[q] = keep + __shfl_xor(send, d); } }
        float lv = lg[0] + __shfl_xor(lg[0], 32);
        float mxl = lv;
#pragma unroll
        for (int d = 1; d < 16; d <<= 1) mxl = fmaxf(mxl, __shfl_xor(mxl, d));
        const float ev = __expf(lv - mxl); float se = ev;
#pragma unroll
        for (int d = 1; d < 16; d <<= 1) se += __shfl_xor(se, d);
        if (lane < 32) { const int row = (lane < 16) ? rowA : rowB; AFFT[((size_t)b * NE + (lane & 15)) * T + (row & (T - 1))] = ev / se; }
        cA = nA; cB = nB;
    }
}

__device__ __forceinline__ void p6_topk(const Args& a, LAS unsigned char* lds, int c, int G) {
    const int tid = opaque_tid(), lane = tid & 63, wave = __builtin_amdgcn_readfirstlane(tid >> 6);
    unsigned char* ws = a.ws;
    const float* AFFT = (const float*)(ws + WS_AFFT); short* SLOT = (short*)(ws + WS_SLOT); int* IDX = (int*)(ws + WS_IDX); float* GATE = (float*)(ws + WS_GATE);
    LAS unsigned* sv = (LAS unsigned*)(lds + wave * 16384);
    for (int item = c + wave * G; item < NITEM; item += G * NWAVES) {
        const int b = item >> 4, e = item & 15;
        const float* src = AFFT + (size_t)item * T;
#pragma unroll 8
        for (int j = 0; j < 32; ++j) sv[j * 64 + lane] = __float_as_uint(src[j * 64 + lane]);
        LDS_WAIT(); asm volatile("" ::: "memory");
        unsigned pre = 0u;
        for (int bit = 30; bit >= 0; --bit) {
            const unsigned cand = pre | (1u << bit);
            int cnt = 0;
#pragma unroll 4
            for (int j = 0; j < 32; ++j) cnt += (int)__popcll(__ballot(sv[j * 64 + lane] >= cand));
            if (cnt >= CAP) pre = cand;
        }
        int ngt = 0;
#pragma unroll 4
        for (int j = 0; j < 32; ++j) ngt += (int)__popcll(__ballot(sv[j * 64 + lane] > pre));
        const int need_eq = CAP - ngt;
        const unsigned long long ltmask = (1ull << lane) - 1ull;
        int base_gt = 0, base_eq = 0;
#pragma unroll 2
        for (int j = 0; j < 32; ++j) {
            const unsigned vj = sv[j * 64 + lane];
            const bool gt = vj > pre, eq = vj == pre;
            const unsigned long long mg = __ballot(gt), me = __ballot(eq);
            const int pg = base_gt + (int)__popcll(mg & ltmask), pe = base_eq + (int)__popcll(me & ltmask);
            int sl = -1; if (gt) sl = pg; else if (eq && pe < need_eq) sl = ngt + pe;
            const int t = j * 64 + lane;
            SLOT[((size_t)b * T + t) * NE + e] = (short)sl;
            if (sl >= 0) { IDX[item * CAP + sl] = t; GATE[item * CAP + sl] = __uint_as_float(vj); }
            base_gt += (int)__popcll(mg); base_eq += (int)__popcll(me);
        }
        LDS_WAIT(); asm volatile("" ::: "memory");
    }
}

struct P8Row { u32x2 h[4]; unsigned y[4][4]; float wt[4]; unsigned long long rest; int sl; };
__device__ __forceinline__ f32x4 fp8x4_to_f32(unsigned w) { typedef float f2 __attribute__((ext_vector_type(2))); const f2 lo = __builtin_amdgcn_cvt_pk_f32_fp8((int)w, false), hi = __builtin_amdgcn_cvt_pk_f32_fp8((int)w, true); return (f32x4){lo.x, lo.y, hi.x, hi.y}; }
__device__ __forceinline__ void p8_issue(P8Row& r, int row, int lane, const short* SLOT, const unsigned char* Y, const bf16_t* H1) {
    const int b = row >> 11;
    const int s_e = (lane < NE) ? (int)SLOT[(size_t)row * NE + lane] : -1;
    unsigned long long mask = __ballot(s_e >= 0);
    const u32x2* hr = (const u32x2*)(H1 + (size_t)row * D) + lane;
#pragma unroll
    for (int j = 0; j < 4; ++j) r.h[j] = __builtin_nontemporal_load(hr + 64 * j);
#pragma unroll
    for (int q = 0; q < 4; ++q) {
        int e = 0, s = 0; r.wt[q] = 0.f;
        if (mask) { e = (int)__builtin_ctzll(mask); mask &= mask - 1ull; s = __builtin_amdgcn_readlane(s_e, e); r.wt[q] = 1.f; }
        const unsigned* yr = (const unsigned*)(Y + ((size_t)(b * NE + e) * CAP + s) * D) + lane;
#pragma unroll
        for (int j = 0; j < 4; ++j) r.y[q][j] = __builtin_nontemporal_load(yr + 64 * j);
    }
    r.rest = mask; r.sl = s_e;
}
__device__ __forceinline__ void p8_finish(P8Row& r, int row, int lane, const unsigned char* Y, const float* MOD, const f32x4* npo, float* out) {
    const int b = row >> 11;
    f32x4 ff[4];
#pragma unroll
    for (int j = 0; j < 4; ++j) ff[j] = (f32x4){0.f, 0.f, 0.f, 0.f};
#pragma unroll
    for (int q = 0; q < 4; ++q)
#pragma unroll
        for (int j = 0; j < 4; ++j) ff[j] += fp8x4_to_f32(r.y[q][j]) * r.wt[q];
    unsigned long long mask = r.rest;
    while (mask) {
        const int e = (int)__builtin_ctzll(mask); mask &= mask - 1ull; const int s = __builtin_amdgcn_readlane(r.sl, e);
        const unsigned* yr = (const unsigned*)(Y + ((size_t)(b * NE + e) * CAP + s) * D) + lane;
#pragma unroll
        for (int j = 0; j < 4; ++j) ff[j] += fp8x4_to_f32(yr[64 * j]);
    }
#pragma unroll
    for (int j = 0; j < 4; ++j) ff[j] = ff[j] * (1.0f / pg8::F8_Y);
    float s2 = 0.f;
#pragma unroll
    for (int j = 0; j < 4; ++j) s2 += (ff[j].x * ff[j].x + ff[j].y * ff[j].y) + (ff[j].z * ff[j].z + ff[j].w * ff[j].w);
    const float rstd = 1.0f / sqrtf(wave_sum(s2) * (1.f / D) + EPS);
    f32x4* orow = (f32x4*)(out + (size_t)row * D) + lane; const f32x4* g2 = (const f32x4*)(MOD + (size_t)b * NMOD + 5 * D) + lane;
#pragma unroll
    for (int j = 0; j < 4; ++j) { const u32x2 hv = r.h[j]; const f32x4 h = (f32x4){bflo(hv.x), bfhi(hv.x), bflo(hv.y), bfhi(hv.y)};
        __builtin_nontemporal_store(h + g2[64 * j] * ((ff[j] * rstd) * npo[64 * j]), orow + 64 * j); }
}
__device__ __forceinline__ void p8_final(const Args& a, int vcu, int G) {
    const int tid = opaque_tid(), lane = tid & 63, wave = __builtin_amdgcn_readfirstlane(tid >> 6);
    unsigned char* ws = a.ws;
    const short* SLOT = (const short*)(ws + WS_SLOT); const unsigned char* Y = ws + WS_Y; const float* MOD = (const float*)(ws + WS_MOD); const bf16_t* H1 = (const bf16_t*)(ws + WS_H1);
    const f32x4* npo = (const f32x4*)a.in[I_NPOST_FFN] + lane;
    const int gw = vcu * NWAVES + wave, NGW = G * NWAVES;
    const int per = M / NGW;
    for (int row = gw * per; row < (gw + 1) * per; row += 4) {
        P8Row r0, r1, r2, r3;
        p8_issue(r0, row, lane, SLOT, Y, H1);
        p8_issue(r1, row + 1, lane, SLOT, Y, H1);
        p8_issue(r2, row + 2, lane, SLOT, Y, H1);
        p8_issue(r3, row + 3, lane, SLOT, Y, H1);
        p8_finish(r0, row, lane, Y, MOD, npo, a.out);
        p8_finish(r1, row + 1, lane, Y, MOD, npo, a.out);
        p8_finish(r2, row + 2, lane, Y, MOD, npo, a.out);
        p8_finish(r3, row + 3, lane, Y, MOD, npo, a.out);
    }
}

__global__ void __launch_bounds__(NTHREADS, 2) fwd_kernel(Args args) {
    extern __shared__ __attribute__((aligned(16))) unsigned char lds_raw[];
    LAS unsigned char* lds = (LAS unsigned char*)lds_raw;
    volatile LAS unsigned* MISC = (volatile LAS unsigned*)(lds + MISC_OFF);
    const int tid = threadIdx.x;
    const int G = gridDim.x, c = blockIdx.x;
    const int vcu = (G % 8 == 0) ? (c % 8) * (G / 8) + c / 8 : c;
    unsigned char* ws = args.ws;
    gu32* ctl = (gu32*)(ws + WS_CTL);
    for (int u = tid; u < (LDS_BYTES - LDSCTL_OFF) / 4; u += NTHREADS) ((LAS unsigned*)(lds + LDSCTL_OFF))[u] = 0u;
    __syncthreads();
    XcdBarrier bar; bar.bar = (unsigned*)(ctl + CW_BAR); bar.x = 0; bar.st = nullptr;
    const int lo = args.ph_lo, hi = args.ph_hi;
    if (hi - lo > 1) bar = xcd_barrier_post((unsigned*)(ctl + CW_BAR), MISC + 8);
#ifndef PHMASK
#define PHMASK 0xff
#endif
#define IN(k) (((PHMASK >> (k)) & 1) && lo <= (k) && (k) < hi)
#define SEAM(k) do { if (IN(k) && IN((k) + 1)) xcd_barrier(bar); } while (0)
#ifndef PROBE_PHASE
#define PROBE_PHASE -1
#endif
#define PB(k) do { if (PROBE_PHASE == (k)) { if (tid == 0) { const unsigned long long t0_ = __builtin_amdgcn_s_memrealtime(); MISC[16] = (unsigned)t0_; MISC[17] = (unsigned)(t0_ >> 32); } } } while (0)
#define PE(k) do { if (PROBE_PHASE == (k)) { if (tid == 0) { const unsigned long long t0_ = ((unsigned long long)MISC[17] << 32) | MISC[16]; const unsigned long long t1_ = __builtin_amdgcn_s_memrealtime(); \
      while (__builtin_amdgcn_s_memrealtime() - t1_ < t1_ - t0_) __builtin_amdgcn_s_sleep(8); } __syncthreads(); } } while (0)

    PB(0); if (IN(0)) { p0_prologue(args, lds, vcu, G); } SEAM(0); PE(0);
    PB(1); if (IN(1)) { p1_xn(args, lds, c, G); inout_weight_copies(args, lds, vcu, G); } SEAM(1); PE(1);
    PB(2); if (IN(2)) {
        pg8::Gemm g{(const bf16_t*)(ws + WS_XN), (const bf16_t*)(ws + WS_WIN), D, nullptr};
        pg8::SchedProj S{G, c};
        pg8::EpiProj E{(bf16_t*)(ws + WS_Q), (bf16_t*)(ws + WS_K), (bf16_t*)(ws + WS_V), (bf16_t*)(ws + WS_GB), (bf16_t*)(ws + WS_U), (const float*)(ws + WS_TAB), (unsigned*)(ws + WS_CTL) + CW_KMAX};
        pg8::gemm_phase<pg8::EpiProj, pg8::SchedProj, true, true>(lds, g, S, E);
        if (c >= 128) expert_weight_copies(args, lds, c - 128, G - 128, 0, 9216);
    } SEAM(2); PE(2);
    PB(3); if (IN(3)) { if (c & 1) expert_weight_copies(args, lds, vcu, G, 9216, 24576); p3_conv_attn(args, lds, c, vcu, G); if (!(c & 1)) expert_weight_copies(args, lds, vcu, G, 9216, 24576); } SEAM(3); PE(3);
    PB(4); if (IN(4)) {
        {
            const int p = c;
#ifndef NO_P4
            pg8::Gemm g{(const bf16_t*)(ws + WS_MIXIN), (const bf16_t*)(ws + WS_WOUT), D, nullptr};
            pg8::SchedPanel S{p, 4};
            pg8::EpiBf16 E{(bf16_t*)(ws + WS_MIX), D};
            pg8::gemm_phase<pg8::EpiBf16, pg8::SchedPanel, true, true>(lds, g, S, E);
#endif
            VM_WAIT(); __syncthreads();
#ifndef NO_P5
            p5_rows(args, lds, p);
#endif
            __syncthreads();
        }
    } SEAM(4); PE(4);
    PB(5); if (IN(5)) { p6_topk(args, lds, c, G); } SEAM(5); PE(5);
    PB(6); if (IN(6)) {
#pragma unroll 1
        for (int it = 0; it < 2; ++it) {
            {
                const int item = 2 * c + it;
                const int b = item >> 4, e = item & 15;
#ifndef NO_G1
                if (it == 0) PB(8);
                {
                    pg8::Gemm g{(const bf16_t*)(ws + WS_XN + (size_t)b * T * D), (const bf16_t*)(ws + WS_WGU + (size_t)e * 2048 * D), D, (const int*)(ws + WS_IDX) + item * CAP};
                    pg8::SchedPanel S{0, 8};
                    pg8::EpiGU8 E{ws + WS_HMID + (size_t)item * CAP * D};
                    pg8::gemm_phase<pg8::EpiGU8, pg8::SchedPanel, true, true, true, true>(lds, g, S, E);
                }
#endif
                VM_WAIT(); __syncthreads();
                if (it == 0) { PE(8); PB(9); }
#ifndef NO_G2
                {
                    pg8::Gemm g{(const bf16_t*)(ws + WS_HMID + (size_t)item * CAP * D), (const bf16_t*)(ws + WS_WDN + (size_t)e * D * D), D, nullptr};
                    pg8::SchedPanel S{0, 4};
                    pg8::EpiDown8 E{ws + WS_Y + (size_t)item * CAP * D, (const float*)(ws + WS_GATE) + item * CAP, pg8::F8_INV * pg8::F8_Y};
                    pg8::gemm_phase<pg8::EpiDown8, pg8::SchedPanel, true, true, false, true>(lds, g, S, E);
                }
#endif
                VM_WAIT(); __syncthreads();
                if (it == 0) PE(9);
            }
        }
    } SEAM(6); PE(6);
    PB(7); if (IN(7)) { p8_final(args, vcu, G); } PE(7);
#undef IN
#undef SEAM
}

extern "C" void kernel_launch(void* const* d_in, const int* in_sizes, int n_in, void* d_out, int out_size, void* d_ws, size_t ws_size, hipStream_t stream) {
    static int grid = 0;
    if (grid == 0) {
        if (n_in != 22 || in_sizes[0] != M * D || out_size != M * D || ws_size < WS_END) { fprintf(stderr, "kernel_launch: unexpected shapes (n_in %d, in0 %d, out %d, ws %zu)\n", n_in, n_in > 0 ? in_sizes[0] : -1, out_size, ws_size); grid = -1; return; }
        int dev = 0, cus = 0;
        if (hipGetDevice(&dev) != hipSuccess || hipDeviceGetAttribute(&cus, hipDeviceAttributeMultiprocessorCount, dev) != hipSuccess) { grid = -1; return; }
        if (hipFuncSetAttribute((const void*)fwd_kernel, hipFuncAttributeMaxDynamicSharedMemorySize, LDS_BYTES) != hipSuccess) { fprintf(stderr, "kernel_launch: hipFuncSetAttribute failed\n"); grid = -1; return; }
        (void)hipGetLastError();
        grid = cus;
        if (grid != 256) { fprintf(stderr, "kernel_launch: this kernel needs a 256-CU device (got %d)\n", cus); grid = -1; return; }
    }
    if (grid < 0) return;
    (void)hipMemsetAsync((char*)d_ws + WS_CTL, 0, CTL_ZERO_BYTES, stream);
    Args a{};
    for (int i = 0; i < 22; ++i) a.in[i] = (const float*)d_in[i];
    a.out = (float*)d_out; a.ws = (unsigned char*)d_ws;
    constexpr int NPH = 8;
    if (MK_N_LAUNCHES == 1) { a.ph_lo = 0; a.ph_hi = NPH; hipLaunchKernelGGL(fwd_kernel, dim3(grid), dim3(NTHREADS), LDS_BYTES, stream, a); }
    else { for (int k = 0; k < NPH; ++k) { a.ph_lo = k; a.ph_hi = k + 1; hipLaunchKernelGGL(fwd_kernel, dim3(grid), dim3(NTHREADS), LDS_BYTES, stream, a); } }
}
```

```cpp
#include <hip/hip_runtime.h>
#include <cstdio>
#include <cstdint>

#ifndef MK_N_LAUNCHES
#define MK_N_LAUNCHES 1
#endif

#define LAS __attribute__((address_space(3)))
#define GAS __attribute__((address_space(1)))
typedef unsigned short bf16_t;
typedef short bf16x8 __attribute__((ext_vector_type(8)));
typedef short s16x4 __attribute__((ext_vector_type(4)));
typedef float f32x4 __attribute__((ext_vector_type(4)));
typedef float f32x16 __attribute__((ext_vector_type(16)));
typedef unsigned u32x4 __attribute__((ext_vector_type(4)));
typedef unsigned u32x2 __attribute__((ext_vector_type(2)));

constexpr int NB = 32, T = 2048, D = 1024, TC = 256, M = NB * T, MC = NB * TC, MA = M + MC, TK = TC + T;
constexpr int NE = 16, CAP = 256, NITEM = NB * NE, NPROJ = 3072, NMOD = 6 * D;
constexpr float EPS = 1e-6f;
constexpr float C2 = 0.125f * 1.4426950408889634f;
constexpr float LAM_INIT = 0.2f;
constexpr int NWAVES = 8, NTHREADS = 512;

constexpr size_t MiB = 1u << 20;
constexpr size_t WS_CTL = 0, CTL_ZERO_BYTES = 1 * MiB;
constexpr size_t WS_MODP = 2 * MiB;
constexpr size_t WS_MOD = 16 * MiB;
constexpr size_t WS_TAB = 17 * MiB;
constexpr size_t WS_WIN = 18 * MiB;
constexpr size_t WS_WOUT = 24 * MiB;
constexpr size_t WS_WGU = 26 * MiB;
constexpr size_t WS_WDN = 90 * MiB;
constexpr size_t WS_AFFT = 122 * MiB;
constexpr size_t WS_SLOT = 126 * MiB;
constexpr size_t WS_IDX = 128 * MiB;
constexpr size_t WS_GATE = 129 * MiB;
constexpr size_t WS_XN = 130 * MiB;
constexpr size_t WS_Q = 274 * MiB;
constexpr size_t WS_K = 338 * MiB;
constexpr size_t WS_V = 410 * MiB;
constexpr size_t WS_GB = 482 * MiB;
constexpr size_t WS_U = 546 * MiB;
constexpr size_t WS_MIXIN = 610 * MiB;
constexpr size_t WS_MIX = 738 * MiB;
constexpr size_t WS_HMID = 274 * MiB;
constexpr size_t WS_Y = 610 * MiB;
constexpr size_t WS_H1 = 866 * MiB;
constexpr size_t WS_END = 994 * MiB;

__device__ __forceinline__ int opaque_tid() { int t = threadIdx.x; asm volatile("" : "+v"(t)); return t; }

namespace pg8 {
constexpr int BM = 256, BK = 64, HALF = 128, HTB = HALF * BK * 2, STAGE_BYTES = 8 * HTB;
__host__ __device__ __forceinline__ int lds_byte(int r, int c) { const int st = (r >> 4) * 2 + (c >> 5), rr = r & 15, cc = c & 31, ob = rr * 64 + cc * 2; return st * 1024 + (ob ^ (((ob >> 9) & 1) << 5)); }
__host__ __device__ __forceinline__ void stage_rc(int b, int& R, int& C) { const int st = b / 1024, sb = b % 1024, swz = sb ^ (((sb >> 9) & 1) << 5); R = (st >> 1) * 16 + swz / 64; C = (st & 1) * 32 + (swz % 64) / 2; }
__host__ __device__ __forceinline__ int perm32(int rho) { const int n = rho >> 4, i = rho & 15; return 8 * (i >> 2) + 4 * n + (i & 3); }

struct Unit { int pm, pn; };
struct Gemm { const bf16_t* A; const bf16_t* Bt; int K; const int* gidx; };

typedef float f32x2_t __attribute__((ext_vector_type(2))); typedef __bf16 bf16x2_t __attribute__((ext_vector_type(2)));
__device__ __forceinline__ unsigned cvt_pk_bf16(float lo, float hi) { const f32x2_t v = {lo, hi}; const bf16x2_t b = __builtin_convertvector(v, bf16x2_t); return __builtin_bit_cast(unsigned, b); }

struct EpiBf16 {
    static constexpr bool PERM = true, AFTER_DRAIN = false;
    bf16_t* O; int ldc;
    __device__ __forceinline__ void operator()(const f32x4 (&acc)[2][2][4][2], const Unit& u, int wr, int wc, int fr, int fq) const {
        const int row0 = u.pm * BM + wr * 64 + fr; const int col0 = u.pn * BM + wc * 32 + 8 * fq;
#pragma unroll
        for (int ai = 0; ai < 2; ++ai)
#pragma unroll
            for (int m = 0; m < 4; ++m) { bf16_t* rowp = O + (size_t)(row0 + ai * HALF + m * 16) * ldc + col0;
#pragma unroll
                for (int bj = 0; bj < 2; ++bj) { const f32x4 v0 = acc[ai][bj][m][0], v1 = acc[ai][bj][m][1];
                    u32x4 w; w.x = cvt_pk_bf16(v0[0], v0[1]); w.y = cvt_pk_bf16(v0[2], v0[3]); w.z = cvt_pk_bf16(v1[0], v1[1]); w.w = cvt_pk_bf16(v1[2], v1[3]);
                    *(u32x4*)(rowp + bj * HALF) = w; } }
    }
};

struct EpiProj {
    static constexpr bool PERM = true, AFTER_DRAIN = false;
    bf16_t *Q, *KA, *VA, *GB, *U; const float* tab;
    unsigned* kmaxh;
    __device__ __forceinline__ void operator()(const f32x4 (&acc)[2][2][4][2], const Unit& u, int wr, int wc, int fr, int fq) const {
        const int pn = u.pn; const bool ctx = u.pm >= 256;
        float km[2] = {0.f, 0.f};
#pragma unroll
        for (int ai = 0; ai < 2; ++ai)
#pragma unroll
            for (int m = 0; m < 4; ++m) {
                const int row = u.pm * BM + ai * HALF + wr * 64 + m * 16 + fr;
                int t, kvrow;
                if (!ctx) { const int b = row >> 11; t = row & 2047; kvrow = b * TK + TC + t; }
                else { const int rc = row - M; const int b = rc >> 8; t = 0; kvrow = b * TK + (rc & 255); }
                if (pn < 4) {
                    f32x4 cs0 = {1.f, 0.f, 1.f, 0.f}, cs1 = cs0, cs2 = cs0, cs3 = cs0;
                    if (!ctx) { const float* tp = tab + ((size_t)t * 32 + 16 * (wc & 1) + 4 * fq) * 2;
                        cs0 = *(const f32x4*)(tp); cs1 = *(const f32x4*)(tp + 4); }
                    (void)cs2; (void)cs3;
#pragma unroll
                    for (int bj = 0; bj < 2; ++bj) {
                        const f32x4 v0 = acc[ai][bj][m][0], v1 = acc[ai][bj][m][1];
                        float e0 = v0[0], o0 = v0[1], e1 = v0[2], o1 = v0[3], e2 = v1[0], o2 = v1[1], e3 = v1[2], o3 = v1[3];
                        if (pn >= 2) {
                            float ss = ((e0 * e0 + o0 * o0) + (e1 * e1 + o1 * o1)) + ((e2 * e2 + o2 * o2) + (e3 * e3 + o3 * o3));
                            ss += __shfl_xor(ss, 16); ss += __shfl_xor(ss, 32); km[bj] = fmaxf(km[bj], ss); }
                        float r0 = e0 * cs0[0] - o0 * cs0[1], s0 = o0 * cs0[0] + e0 * cs0[1];
                        float r1 = e1 * cs0[2] - o1 * cs0[3], s1 = o1 * cs0[2] + e1 * cs0[3];
                        float r2 = e2 * cs1[0] - o2 * cs1[1], s2 = o2 * cs1[0] + e2 * cs1[1];
                        float r3 = e3 * cs1[2] - o3 * cs1[3], s3 = o3 * cs1[2] + e3 * cs1[3];
                        const float sc = (pn < 2) ? C2 : 1.f;
                        u32x4 w; w.x = cvt_pk_bf16(r0 * sc, s0 * sc); w.y = cvt_pk_bf16(r1 * sc, s1 * sc); w.z = cvt_pk_bf16(r2 * sc, s2 * sc); w.w = cvt_pk_bf16(r3 * sc, s3 * sc);
                        const int col = (pn & 1) * 256 + bj * HALF + wc * 32 + 8 * fq;
                        bf16_t* dst = (pn < 2) ? (Q + (size_t)row * 512 + col) : (KA + (size_t)kvrow * 512 + col);
                        *(u32x4*)dst = w;
                    }
                } else if (pn < 8) {
#pragma unroll
                    for (int bj = 0; bj < 2; ++bj) {
                        const f32x4 v0 = acc[ai][bj][m][0], v1 = acc[ai][bj][m][1];
                        u32x4 w; w.x = cvt_pk_bf16(v0[0], v0[1]); w.y = cvt_pk_bf16(v0[2], v0[3]); w.z = cvt_pk_bf16(v1[0], v1[1]); w.w = cvt_pk_bf16(v1[2], v1[3]);
                        const int col = (pn & 1) * 256 + bj * HALF + wc * 32 + 8 * fq;
                        bf16_t* dst = (pn < 6) ? (VA + (size_t)kvrow * 512 + col) : (GB + (size_t)row * 512 + col);
                        *(u32x4*)dst = w;
                    }
                } else {
                    const f32x4 a0 = acc[ai][0][m][0], a1 = acc[ai][0][m][1], b0 = acc[ai][1][m][0], b1 = acc[ai][1][m][1];
                    u32x4 w; w.x = cvt_pk_bf16(a0[0] * b0[0], a0[1] * b0[1]); w.y = cvt_pk_bf16(a0[2] * b0[2], a0[3] * b0[3]);
                    w.z = cvt_pk_bf16(a1[0] * b1[0], a1[1] * b1[1]); w.w = cvt_pk_bf16(a1[2] * b1[2], a1[3] * b1[3]);
                    const int col = (pn - 8) * 128 + wc * 32 + 8 * fq;
                    *(u32x4*)(U + (size_t)row * 512 + col) = w;
                }
            }
        if (pn == 2 || pn == 3) {
            const int b = ctx ? (u.pm - 256) : (u.pm >> 3);
#pragma unroll
            for (int bj = 0; bj < 2; ++bj) { float v = km[bj];
#pragma unroll
                for (int d = 1; d < 16; d <<= 1) v = fmaxf(v, __shfl_xor(v, d));
                if (fr == 0 && fq == 0) atomicMax(kmaxh + ((b * 8 + (pn & 1) * 4 + bj * 2 + (wc >> 1)) * 2 + (wc & 1)), __float_as_uint(v)); }
        }
    }
};

struct EpiGU {
    static constexpr bool PERM = true, AFTER_DRAIN = false;
    bf16_t* H;
    __device__ __forceinline__ float silu(float x) const { return x * __builtin_amdgcn_rcpf(1.f + __expf(-x)); }
    __device__ __forceinline__ void operator()(const f32x4 (&acc)[2][2][4][2], const Unit& u, int wr, int wc, int fr, int fq) const {
#pragma unroll
        for (int ai = 0; ai < 2; ++ai)
#pragma unroll
            for (int m = 0; m < 4; ++m) {
                const int row = ai * HALF + wr * 64 + m * 16 + fr;
                const f32x4 a0 = acc[ai][0][m][0], a1 = acc[ai][0][m][1], b0 = acc[ai][1][m][0], b1 = acc[ai][1][m][1];
                u32x4 w; w.x = cvt_pk_bf16(silu(a0[0]) * b0[0], silu(a0[1]) * b0[1]); w.y = cvt_pk_bf16(silu(a0[2]) * b0[2], silu(a0[3]) * b0[3]);
                w.z = cvt_pk_bf16(silu(a1[0]) * b1[0], silu(a1[1]) * b1[1]); w.w = cvt_pk_bf16(silu(a1[2]) * b1[2], silu(a1[3]) * b1[3]);
                *(u32x4*)(H + (size_t)row * 1024 + u.pn * 128 + wc * 32 + 8 * fq) = w;
            }
    }
};
__device__ __forceinline__ unsigned pk4_fp8(float a, float b, float c, float d) { int w = 0; w = __builtin_amdgcn_cvt_pk_fp8_f32(a, b, w, false); w = __builtin_amdgcn_cvt_pk_fp8_f32(c, d, w, true); return (unsigned)w; }
constexpr float F8_ACT = 4.0f, F8_WGT = 64.0f, F8_INV = 1.0f / (4.0f * 64.0f);
struct EpiGU8 {
    static constexpr bool PERM = true, AFTER_DRAIN = false;
    unsigned char* H;
    __device__ __forceinline__ float hval(float g, float u) const {
        const float e = __builtin_amdgcn_exp2f(g * (-F8_INV * 1.4426950408889634f));
        const float r = __builtin_amdgcn_rcpf(1.f + e);
        return __builtin_amdgcn_fmed3f((g * u) * (r * (F8_INV * F8_INV * F8_ACT)), -448.f, 448.f); }
    __device__ __forceinline__ void row(const f32x4 (&acc)[2][2][4][2], const Unit& u, int ai, int m, int wr, int wc, int fr, int fq) const {
        unsigned off = (unsigned)((ai * HALF + wr * 64 + m * 16 + fr) * 1024 + u.pn * 128 + wc * 32 + 8 * fq);
        asm volatile("" : "+v"(off));
        const f32x4 a0 = acc[ai][0][m][0], a1 = acc[ai][0][m][1], b0 = acc[ai][1][m][0], b1 = acc[ai][1][m][1];
        u32x2 w; w.x = pk4_fp8(hval(a0[0], b0[0]), hval(a0[1], b0[1]), hval(a0[2], b0[2]), hval(a0[3], b0[3]));
        w.y = pk4_fp8(hval(a1[0], b1[0]), hval(a1[1], b1[1]), hval(a1[2], b1[2]), hval(a1[3], b1[3]));
        *(u32x2*)(H + off) = w;
    }
    __device__ __forceinline__ void operator()(const f32x4 (&acc)[2][2][4][2], const Unit& u, int wr, int wc, int fr, int fq) const {
#pragma unroll
        for (int ai = 0; ai < 2; ++ai)
#pragma unroll
            for (int m = 0; m < 4; ++m) row(acc, u, ai, m, wr, wc, fr, fq);
    }
};
struct EpiDown {
    static constexpr bool PERM = true, AFTER_DRAIN = false;
    bf16_t* Y; const float* gate; float scale;
    __device__ __forceinline__ void operator()(const f32x4 (&acc)[2][2][4][2], const Unit& u, int wr, int wc, int fr, int fq) const {
        asm volatile("" : "+v"(fr));
#pragma unroll
        for (int ai = 0; ai < 2; ++ai)
#pragma unroll
            for (int m = 0; m < 4; ++m) {
                const int row = ai * HALF + wr * 64 + m * 16 + fr; const float g = gate[row] * scale;
#pragma unroll
                for (int bj = 0; bj < 2; ++bj) { const f32x4 v0 = acc[ai][bj][m][0] * g, v1 = acc[ai][bj][m][1] * g;
                    u32x4 w; w.x = cvt_pk_bf16(v0[0], v0[1]); w.y = cvt_pk_bf16(v0[2], v0[3]); w.z = cvt_pk_bf16(v1[0], v1[1]); w.w = cvt_pk_bf16(v1[2], v1[3]);
                    *(u32x4*)(Y + (size_t)row * 1024 + u.pn * BM + bj * HALF + wc * 32 + 8 * fq) = w; }
            }
    }
};

constexpr float F8_Y = 64.0f;
struct EpiDown8 {
    static constexpr bool PERM = true, AFTER_DRAIN = false;
    unsigned char* Y; const LAS float* gl;
    __device__ __forceinline__ void row(const f32x4 (&acc)[2][2][4][2], const Unit& u, int ai, int m, int wr, int wc, int fr, int fq) const {
        unsigned off = (unsigned)((ai * HALF + wr * 64 + m * 16 + fr) * 1024 + u.pn * BM + wc * 32 + 8 * fq);
        asm volatile("" : "+v"(off));
        const float g = gl[ai * HALF + wr * 64 + m * 16 + fr];
#pragma unroll
        for (int bj = 0; bj < 2; ++bj) { f32x4 v0 = acc[ai][bj][m][0] * g, v1 = acc[ai][bj][m][1] * g;
#pragma unroll
            for (int i = 0; i < 4; ++i) { v0[i] = __builtin_amdgcn_fmed3f(v0[i], -448.f, 448.f); v1[i] = __builtin_amdgcn_fmed3f(v1[i], -448.f, 448.f); }
            u32x2 w; w.x = pk4_fp8(v0[0], v0[1], v0[2], v0[3]); w.y = pk4_fp8(v1[0], v1[1], v1[2], v1[3]);
            *(u32x2*)(Y + off + bj * HALF) = w; }
    }
    __device__ __forceinline__ void operator()(const f32x4 (&acc)[2][2][4][2], const Unit& u, int wr, int wc, int fr, int fq) const {
#pragma unroll
        for (int ai = 0; ai < 2; ++ai)
#pragma unroll
            for (int m = 0; m < 4; ++m) row(acc, u, ai, m, wr, wc, fr, fq);
    }
};

struct SchedProj {
    int G, c;
    __device__ __forceinline__ bool next(int i, Unit& u) const {
        if (i < 12) { const int x = c & 7, j = c >> 3, ja = j & 7, jb = j >> 3, r = i / 3, q = i - 3 * r;
            u.pm = x + 8 * (8 * r + ja); u.pn = 4 * q + jb; return true; }
        if (i == 12 && c < 128) { u.pm = 256 + (c >> 2); u.pn = 2 + (c & 3); return true; }
        return false;
    }
    __device__ __forceinline__ void a_ready(const Unit&) const {}
    __device__ __forceinline__ void done(const Unit&) const {}
};
struct SchedPanel {
    int pm, ntn;
    __device__ __forceinline__ bool next(int i, Unit& u) const { if (i >= ntn) return false; u.pm = pm; u.pn = i; return true; }
    __device__ __forceinline__ void a_ready(const Unit&) const {}
    __device__ __forceinline__ void done(const Unit&) const {}
};

typedef int i32x4v __attribute__((ext_vector_type(4)));
typedef int i32x8v __attribute__((ext_vector_type(8)));
__device__ __forceinline__ i32x8v cat8(bf16x8 a, bf16x8 b) { const i32x4v x = __builtin_bit_cast(i32x4v, a), y = __builtin_bit_cast(i32x4v, b); return __builtin_shufflevector(x, y, 0, 1, 2, 3, 4, 5, 6, 7); }
template <bool F8> struct Frag;
template <> struct Frag<false> { bf16x8 v[2]; __device__ __forceinline__ void set(bf16x8 a, bf16x8 b) { v[0] = a; v[1] = b; } };
template <> struct Frag<true> { i32x8v v; __device__ __forceinline__ void set(bf16x8 a, bf16x8 b) { v = cat8(a, b); } };
__device__ __forceinline__ f32x4 frag_mma(const Frag<false>& b, const Frag<false>& a, f32x4 c) { c = __builtin_amdgcn_mfma_f32_16x16x32_bf16(b.v[0], a.v[0], c, 0, 0, 0); return __builtin_amdgcn_mfma_f32_16x16x32_bf16(b.v[1], a.v[1], c, 0, 0, 0); }
__device__ __forceinline__ f32x4 frag_mma(const Frag<true>& b, const Frag<true>& a, f32x4 c) {
    const int sc1 = 0x7f7f7f7f;
    asm volatile("s_nop 1\n\tv_mfma_scale_f32_16x16x128_f8f6f4 %0, %1, %2, %0, %3, %3 op_sel_hi:[0,0,0]" : "+v"(c) : "v"(b.v), "v"(a.v), "v"(sc1));
    return c; }
template <class Epi, class Sched, bool ALIGN_EPI, bool SP2, bool GATHER = false, bool F8 = false, bool DEFER = false>
__device__ __forceinline__ void gemm_phase(LAS unsigned char* lds, const Gemm g, const Sched& S, const Epi& E) {
    const int tid = opaque_tid(), wid = __builtin_amdgcn_readfirstlane(tid >> 6), lane = tid & 63, wr = wid >> 2, wc = wid & 3, fr = lane & 15, fq = lane >> 4;
    const int K = g.K * (F8 ? 1 : 2), nt = K / 128;
    unsigned voffA[2][2], voffB[2];
#pragma unroll
    for (int i = 0; i < 2; ++i) { int R, C; stage_rc(tid * 16 + i * 8192, R, C); const int Rb = Epi::PERM ? ((R & ~31) + perm32(R & 31)) : R;
        if constexpr (GATHER) { voffA[0][i] = (unsigned)(g.gidx[R] * K + C * 2); voffA[1][i] = (unsigned)(g.gidx[HALF + R] * K + C * 2); }
        else { voffA[0][i] = (unsigned)(R * K + C * 2); voffA[1][i] = voffA[0][i]; }
        voffB[i] = (unsigned)(Rb * K + C * 2); }
    const size_t kstep = (size_t)(BK * 2);
    const size_t hstep = (size_t)HALF * K;
    const size_t hstepA = GATHER ? (size_t)0 : hstep;
    const size_t tstep = 2 * hstep;
    const unsigned ldsw = (unsigned)wid * 1024u;
    const int aoff = F8 ? lds_byte(wr * 64 + fr, (fq >> 1) * 32 + (fq & 1) * 16) : lds_byte(wr * 64 + fr, fq * 8), boff = F8 ? lds_byte(wc * 32 + fr, (fq >> 1) * 32 + (fq & 1) * 16) : lds_byte(wc * 32 + fr, fq * 8);
    const int aoff1 = F8 ? aoff + 16 : aoff + 1024, boff1 = F8 ? boff + 16 : boff + 1024;
#define PG8_SA(b, h) (((b) * 2 + (h)) * HTB)
#define PG8_SB(b, h) ((4 + (b) * 2 + (h)) * HTB)
#define PG8_STAGE(bufoff, gbase, voff) do { _Pragma("unroll") for (int _i = 0; _i < 2; ++_i) \
        __builtin_amdgcn_global_load_lds((const unsigned*)((const char*)(gbase) + (voff)[_i]), (LAS unsigned*)(lds + (bufoff) + ldsw + _i * 8192), 16, 0, 0); } while (0)
#define PG8_LDA(dst, b, h) do { _Pragma("unroll") for (int m = 0; m < 4; ++m) dst[m].set(*(const LAS bf16x8*)(lds + PG8_SA(b, h) + aoff + m * 2048), *(const LAS bf16x8*)(lds + PG8_SA(b, h) + aoff1 + m * 2048)); } while (0)
#define PG8_LDB(dst, b, h) do { _Pragma("unroll") for (int n = 0; n < 2; ++n) dst[n].set(*(const LAS bf16x8*)(lds + PG8_SB(b, h) + boff + n * 2048), *(const LAS bf16x8*)(lds + PG8_SB(b, h) + boff1 + n * 2048)); } while (0)
#define PG8_MMA(ai, bj, At, Bt) do { __builtin_amdgcn_s_setprio(1); _Pragma("unroll") for (int m = 0; m < 4; ++m) _Pragma("unroll") for (int n = 0; n < 2; ++n) \
        acc[ai][bj][m][n] = frag_mma(Bt[n], At[m], acc[ai][bj][m][n]); __builtin_amdgcn_s_setprio(0); } while (0)
#define PG8_MMA_E(ai, At, Bt) do { __builtin_amdgcn_s_setprio(1); _Pragma("unroll") for (int m = 0; m < 4; ++m) { \
        if constexpr (DEFER) { if (defer_now) { E.row(acc, pu, ai, m, wr, wc, fr, fq); \
            _Pragma("unroll") for (int n = 0; n < 2; ++n) { acc[ai][0][m][n] = (f32x4){0.f, 0.f, 0.f, 0.f}; acc[ai][1][m][n] = (f32x4){0.f, 0.f, 0.f, 0.f}; } } PG8_SCHED; } \
        _Pragma("unroll") for (int n = 0; n < 2; ++n) acc[ai][0][m][n] = frag_mma(Bt[n], At[m], acc[ai][0][m][n]); } __builtin_amdgcn_s_setprio(0); } while (0)
#define PG8_WAIT_V(n) asm volatile("s_waitcnt vmcnt(" #n ")" ::: "memory")
#define PG8_WAIT_L(n) asm volatile("s_waitcnt lgkmcnt(" #n ")" ::: "memory")
#define PG8_BAR __builtin_amdgcn_s_barrier()
#define PG8_SCHED __builtin_amdgcn_sched_barrier(0)
    Unit cur, nxt; int ui = 0;
    if (!S.next(0, cur)) return;
    f32x4 acc[2][2][4][2];
#pragma unroll
    for (int a = 0; a < 2; ++a)
#pragma unroll
        for (int b = 0; b < 2; ++b)
#pragma unroll
            for (int m = 0; m < 4; ++m)
#pragma unroll
                for (int n = 0; n < 2; ++n) acc[a][b][m][n] = (f32x4){0.f, 0.f, 0.f, 0.f};
    Frag<F8> At[4], B0[2], B1[2];
    bool pend = false; Unit pu = cur;
    const char* cA = (const char*)g.A + (size_t)cur.pm * tstep; const char* cB = (const char*)g.Bt + (size_t)cur.pn * tstep;
    S.a_ready(cur);
    if constexpr (SP2) {
        PG8_STAGE(PG8_SB(0, 0), cB, voffB); PG8_STAGE(PG8_SB(0, 1), cB + hstep, voffB); PG8_STAGE(PG8_SA(0, 0), cA, voffA[0]); PG8_STAGE(PG8_SA(0, 1), cA + hstepA, voffA[GATHER ? 1 : 0]);
        if (wr == 1) PG8_BAR;
        PG8_WAIT_V(2); PG8_BAR;
        PG8_STAGE(PG8_SB(1, 0), cB + kstep, voffB); PG8_STAGE(PG8_SA(1, 0), cA + kstep, voffA[0]); PG8_STAGE(PG8_SB(1, 1), cB + hstep + kstep, voffB);
        PG8_WAIT_V(6); PG8_BAR;
    } else {
        PG8_STAGE(PG8_SB(0, 0), cB, voffB); PG8_STAGE(PG8_SA(0, 0), cA, voffA[0]); PG8_STAGE(PG8_SB(0, 1), cB + hstep, voffB); PG8_STAGE(PG8_SA(0, 1), cA + hstepA, voffA[GATHER ? 1 : 0]);
        if (wr == 1) PG8_BAR;
        PG8_WAIT_V(4); PG8_BAR;
        PG8_STAGE(PG8_SB(1, 0), cB + kstep, voffB); PG8_STAGE(PG8_SA(1, 0), cA + kstep, voffA[0]); PG8_STAGE(PG8_SB(1, 1), cB + hstep + kstep, voffB);
        PG8_WAIT_V(6); PG8_BAR;
    }
    for (;;) {
        const bool has_next = S.next(ui + 1, nxt);
        const char* nA = has_next ? (const char*)g.A + (size_t)nxt.pm * tstep : cA; const char* nB = has_next ? (const char*)g.Bt + (size_t)nxt.pn * tstep : cB;
#pragma unroll 1
        for (int t = 0; t < nt; t += 2) {
            const bool last = (t == nt - 2);
            if constexpr (F8) { asm volatile("" : "+v"(voffA[0][0]), "+v"(voffA[0][1]), "+v"(voffB[0]), "+v"(voffB[1])); if constexpr (GATHER) asm volatile("" : "+v"(voffA[1][0]), "+v"(voffA[1][1])); }
            const char* a1 = cA + (size_t)(t + 1) * kstep;
            const char* a2 = last ? nA : cA + (size_t)(t + 2) * kstep; const char* b2 = last ? nB : cB + (size_t)(t + 2) * kstep;
            const char* a3 = a2 + kstep; const char* b3 = b2 + kstep;
            if (last && has_next) S.a_ready(nxt);
            if constexpr (SP2) {
            PG8_LDB(B0, 0, 0); PG8_LDB(B1, 0, 1); PG8_SCHED; PG8_LDA(At, 0, 0); PG8_STAGE(PG8_SA(1, 1), a1 + hstepA, voffA[GATHER ? 1 : 0]);
            bool defer_now = false; if constexpr (DEFER) defer_now = pend && t == 0;
            PG8_WAIT_V(8); PG8_WAIT_L(0); PG8_BAR; PG8_MMA_E(0, At, B0); PG8_MMA(0, 1, At, B1); PG8_BAR; PG8_SCHED;
            PG8_LDA(At, 0, 1); PG8_STAGE(PG8_SB(0, 0), b2, voffB); PG8_STAGE(PG8_SB(0, 1), b2 + hstep, voffB); PG8_STAGE(PG8_SA(0, 0), a2, voffA[0]);
            PG8_WAIT_V(8); PG8_WAIT_L(0); PG8_BAR; PG8_MMA_E(1, At, B0); PG8_MMA(1, 1, At, B1); PG8_BAR; PG8_SCHED;
            PG8_LDB(B0, 1, 0); PG8_LDB(B1, 1, 1); PG8_SCHED; PG8_LDA(At, 1, 0); PG8_STAGE(PG8_SA(0, 1), a2 + hstepA, voffA[GATHER ? 1 : 0]);
            PG8_WAIT_V(8); PG8_WAIT_L(0); PG8_BAR; PG8_MMA(0, 0, At, B0); PG8_MMA(0, 1, At, B1); PG8_BAR; PG8_SCHED;
            PG8_LDA(At, 1, 1); PG8_STAGE(PG8_SB(1, 0), b3, voffB); PG8_STAGE(PG8_SB(1, 1), b3 + hstep, voffB); PG8_STAGE(PG8_SA(1, 0), a3, voffA[0]);
            PG8_WAIT_V(8); PG8_WAIT_L(0); PG8_BAR; PG8_MMA(1, 0, At, B0); PG8_MMA(1, 1, At, B1); PG8_BAR; PG8_SCHED;
            } else {
            PG8_LDB(B0, 0, 0); PG8_SCHED; PG8_LDA(At, 0, 0); PG8_STAGE(PG8_SA(1, 1), a1 + hstepA, voffA[GATHER ? 1 : 0]);
            PG8_WAIT_L(8); PG8_BAR; PG8_WAIT_L(0); PG8_MMA(0, 0, At, B0); PG8_BAR; PG8_SCHED;
            PG8_LDB(B1, 0, 1); PG8_STAGE(PG8_SB(0, 0), b2, voffB);
            PG8_BAR; PG8_WAIT_L(0); PG8_MMA(0, 1, At, B1); PG8_BAR;
            PG8_LDA(At, 0, 1); PG8_STAGE(PG8_SA(0, 0), a2, voffA[0]);
            PG8_BAR; PG8_WAIT_L(0); PG8_MMA(1, 0, At, B0); PG8_BAR; PG8_SCHED;
            PG8_STAGE(PG8_SB(0, 1), b2 + hstep, voffB);
            PG8_WAIT_V(6); PG8_BAR; PG8_MMA(1, 1, At, B1); PG8_BAR;
            PG8_LDB(B0, 1, 0); PG8_SCHED; PG8_LDA(At, 1, 0); PG8_STAGE(PG8_SA(0, 1), a2 + hstepA, voffA[GATHER ? 1 : 0]);
            PG8_WAIT_L(8); PG8_BAR; PG8_WAIT_L(0); PG8_MMA(0, 0, At, B0); PG8_BAR; PG8_SCHED;
            PG8_LDB(B1, 1, 1); PG8_STAGE(PG8_SB(1, 0), b3, voffB);
            PG8_BAR; PG8_WAIT_L(0); PG8_MMA(0, 1, At, B1); PG8_BAR;
            PG8_LDA(At, 1, 1); PG8_STAGE(PG8_SA(1, 0), a3, voffA[0]);
            PG8_BAR; PG8_WAIT_L(0); PG8_MMA(1, 0, At, B0); PG8_BAR; PG8_SCHED;
            PG8_STAGE(PG8_SB(1, 1), b3 + hstep, voffB);
            PG8_WAIT_V(6); PG8_BAR; PG8_MMA(1, 1, At, B1); PG8_BAR;
            }
        }
        if (DEFER && has_next) { pend = true; pu = cur; cur = nxt; cA = nA; cB = nB; ++ui; continue; }
        if constexpr (ALIGN_EPI) { if (wr == 0) PG8_BAR; }
        if constexpr (F8) asm volatile("s_nop 15\n\ts_nop 7" ::: "memory");
        E(acc, cur, wr, wc, fr, fq); S.done(cur);
        if (!has_next) break;
#pragma unroll
        for (int a = 0; a < 2; ++a)
#pragma unroll
            for (int b = 0; b < 2; ++b)
#pragma unroll
                for (int m = 0; m < 4; ++m)
#pragma unroll
                    for (int n = 0; n < 2; ++n) acc[a][b][m][n] = (f32x4){0.f, 0.f, 0.f, 0.f};
        cur = nxt; cA = nA; cB = nB; ++ui;
        if constexpr (ALIGN_EPI) { if (wr == 1) PG8_BAR; }
    }
    PG8_WAIT_V(0);
    if constexpr (!ALIGN_EPI) { if (wr == 0) PG8_BAR; }
    PG8_BAR;
#undef PG8_SA
#undef PG8_SB
#undef PG8_STAGE
#undef PG8_LDA
#undef PG8_LDB
#undef PG8_MMA
#undef PG8_WAIT_V
#undef PG8_WAIT_L
#undef PG8_BAR
#undef PG8_SCHED
}
}

typedef GAS unsigned gu32;
#define RLX_AGENT __ATOMIC_RELAXED, __HIP_MEMORY_SCOPE_AGENT
#define LDS_WAIT() asm volatile("s_waitcnt lgkmcnt(0)" ::: "memory")
#define VM_WAIT() asm volatile("s_waitcnt vmcnt(0)" ::: "memory")
__device__ __forceinline__ unsigned pk2(float lo, float hi) { return pg8::cvt_pk_bf16(lo, hi); }
__device__ __forceinline__ float bf2f(unsigned short h) { return __uint_as_float((unsigned)h << 16); }
__device__ __forceinline__ float bflo(unsigned w) { return __uint_as_float(w << 16); }
__device__ __forceinline__ float bfhi(unsigned w) { return __uint_as_float(w & 0xffff0000u); }
__device__ __forceinline__ float wave_sum(float v) {
    v += __builtin_bit_cast(float, __builtin_amdgcn_update_dpp(0, __builtin_bit_cast(int, v), 0xB1, 0xf, 0xf, true));
    v += __builtin_bit_cast(float, __builtin_amdgcn_update_dpp(0, __builtin_bit_cast(int, v), 0x4E, 0xf, 0xf, true));
    v += __builtin_bit_cast(float, __builtin_amdgcn_update_dpp(0, __builtin_bit_cast(int, v), 0x141, 0xf, 0xf, true));
    v += __builtin_bit_cast(float, __builtin_amdgcn_update_dpp(0, __builtin_bit_cast(int, v), 0x140, 0xf, 0xf, true));
    v += __builtin_bit_cast(float, __builtin_amdgcn_update_dpp(0, __builtin_bit_cast(int, v), 0x142, 0xa, 0xf, false));
    v += __builtin_bit_cast(float, __builtin_amdgcn_update_dpp(0, __builtin_bit_cast(int, v), 0x143, 0xc, 0xf, false));
    return __builtin_bit_cast(float, __builtin_amdgcn_readlane(__builtin_bit_cast(int, v), 63));
}

#define XB_TMO      128
#define XB_XCNT(j)  (256  + 64 * (j))
#define XB_XSUB(j)  (1280 + 64 * (j))
#define XB_XGEN(j)  (2304 + 64 * (j))
#define XB_TOP      3328
#define XB_TOPGEN   3392
#define XCD_BAR_WORDS 3456
#define XB_SPIN_CAP (1u << 18)
__device__ __forceinline__ unsigned xb_ld(unsigned* p)              { return __hip_atomic_load(p, __ATOMIC_RELAXED, __HIP_MEMORY_SCOPE_AGENT); }
__device__ __forceinline__ unsigned xb_add(unsigned* p, unsigned v) { return __hip_atomic_fetch_add(p, v, __ATOMIC_RELAXED, __HIP_MEMORY_SCOPE_AGENT); }
__device__ __forceinline__ unsigned xb_xcc_id() { return (unsigned)__builtin_amdgcn_s_getreg((3 << 11) | 20) & 0xFu; }
#define XB_SPIN(cond, bar) do { unsigned _sp = 0; while (cond) { __builtin_amdgcn_s_sleep(1); \
    if ((++_sp & 255u) == 0u) { if (xb_ld(&(bar)[XB_TMO])) break; if (_sp > XB_SPIN_CAP) { atomicAdd(&(bar)[XB_TMO], 1u); break; } } } } while (0)
struct XcdBarrier { unsigned* bar; unsigned x; volatile LAS unsigned* st; };
__device__ __forceinline__ XcdBarrier xcd_barrier_post(unsigned* bar, volatile LAS unsigned* st) {
    XcdBarrier b; b.bar = bar; b.x = xb_xcc_id(); b.st = st;
    if (threadIdx.x == 0) (void)xb_add(&bar[XB_XCNT(b.x)], 1u);
    return b;
}
__device__ __forceinline__ void xcd_barrier_complete(unsigned* bar, unsigned x, unsigned& nloc, unsigned& nx) {
    const unsigned G = gridDim.x * gridDim.y * gridDim.z;
    unsigned sum, cnt, mine, sp = 0u;
    for (;;) {
        sum = 0u; cnt = 0u; mine = 0u;
#pragma unroll
        for (unsigned j = 0; j < 16; ++j) { const unsigned c = xb_ld(&bar[XB_XCNT(j)]); sum += c; cnt += (c > 0u) ? 1u : 0u; mine = (j == x) ? c : mine; }
        if (sum == G) break;
        __builtin_amdgcn_s_sleep(1);
        if ((++sp & 255u) == 0u) { if (xb_ld(&bar[XB_TMO])) break; if (sp > XB_SPIN_CAP) { atomicAdd(&bar[XB_TMO], 1u); break; } }
    }
    nloc = mine > 0u ? mine : 1u; nx = cnt > 0u ? cnt : 1u;
}
__device__ __forceinline__ void xcd_barrier(const XcdBarrier& b) {
    asm volatile("s_waitcnt vmcnt(0)" ::: "memory");
    __syncthreads();
    if (threadIdx.x == 0) {
        unsigned* bar = b.bar;
        __builtin_amdgcn_s_waitcnt(0);
        unsigned nloc = b.st[0], nx = b.st[1];
        if (nloc == 0u) { xcd_barrier_complete(bar, b.x, nloc, nx); b.st[0] = nloc; b.st[1] = nx; }
        const unsigned old = xb_add(&bar[XB_XSUB(b.x)], 1u);
        const unsigned gen = old / nloc;
        if (old + 1u == (gen + 1u) * nloc) {
            __builtin_amdgcn_fence(__ATOMIC_RELEASE, "agent");
            asm volatile("s_waitcnt vmcnt(0)" ::: "memory");
            const unsigned og = xb_add(&bar[XB_TOP], 1u);
            const unsigned tg = og / nx;
            if (og + 1u == (tg + 1u) * nx) xb_add(&bar[XB_TOPGEN], 1u);
            else XB_SPIN(xb_ld(&bar[XB_TOPGEN]) == tg, bar);
            __builtin_amdgcn_fence(__ATOMIC_ACQUIRE, "agent");
            xb_add(&bar[XB_XGEN(b.x)], 1u);
            asm volatile("s_waitcnt vmcnt(0)" ::: "memory");
        } else {
            XB_SPIN(xb_ld(&bar[XB_XGEN(b.x)]) == gen, bar);
            __builtin_amdgcn_fence(__ATOMIC_ACQUIRE, "agent");
            asm volatile("s_waitcnt vmcnt(0)" ::: "memory");
        }
    }
    __syncthreads();
}

constexpr int RING_BYTES = 131072;
constexpr int LDSCTL_OFF = RING_BYTES, MISC_OFF = LDSCTL_OFF + 320;
constexpr int LDS_BYTES = 147456;
constexpr int CW_BAR = 4096;
constexpr int CW_KMAX = 65536;

struct Args { const float* in[22]; float* out; unsigned char* ws; int ph_lo, ph_hi; };
enum { I_X = 0, I_C, I_CTX, I_CCTX, I_WADA, I_BADA, I_NPRE_MIX, I_NPOST_MIX, I_NPRE_FFN, I_NPOST_FFN, I_WIN, I_CONVW, I_LQ1, I_LK1, I_LQ2, I_LK2, I_SUBLN, I_WOUT, I_WROUTER, I_WGATE, I_WUP, I_WDOWN };

__device__ __forceinline__ int win_dest(int n) {
    if (n < 1024) { const int j = n & 63; const int p = ((j >> 5) << 5) + ((j & 15) << 1) + ((j >> 4) & 1); return (n & ~63) + p; }
    if (n < 2048) return n;
    int c = n - 2048; const int isx = c >= 512; c &= 511; return 2048 + ((c >> 7) << 8) + (isx << 7) + (c & 127);
}
template <int MODE>
__device__ __forceinline__ int tr_dest(int n) {
    if (MODE == 0) return n;
    if (MODE == 1) return win_dest(n);
    if (MODE == 2) return ((n >> 7) << 8) + (n & 127);
    return ((n >> 7) << 8) + 128 + (n & 127);
}
template <int MODE>
__device__ __forceinline__ void p0_transpose_item_f8(const float* W, int K, int N, unsigned char* WT, LAS float* scr, int item, int lane) {
    const int nblk = N / 32, kb = item / nblk, nb = item % nblk, k0 = 64 * kb, n0 = 32 * nb;
#pragma unroll 8
    for (int i = 0; i < 32; ++i) { const int kk = 2 * i + (lane >> 5); scr[kk * 33 + (lane & 31)] = __builtin_nontemporal_load(W + (size_t)(k0 + kk) * N + n0 + (lane & 31)) * pg8::F8_WGT; }
    LDS_WAIT(); asm volatile("" ::: "memory");
    const int c = lane & 7;
#pragma unroll
    for (int j = 0; j < 4; ++j) { const int n = (lane >> 3) + 8 * j; const LAS float* s = scr + (8 * c) * 33 + n;
        u32x2 o; o.x = pg8::pk4_fp8(s[0 * 33], s[1 * 33], s[2 * 33], s[3 * 33]); o.y = pg8::pk4_fp8(s[4 * 33], s[5 * 33], s[6 * 33], s[7 * 33]);
        *(GAS u32x2*)(WT + (size_t)tr_dest<MODE>(n0 + n) * K + k0 + 8 * c) = o; }
    LDS_WAIT(); asm volatile("" ::: "memory");
}
template <int MODE>
__device__ __forceinline__ void p0_transpose_item(const float* W, int K, int N, bf16_t* WT, LAS float* scr, int item, int lane) {
    const int nblk = N / 32, kb = item / nblk, nb = item % nblk, k0 = 64 * kb, n0 = 32 * nb;
#pragma unroll 8
    for (int i = 0; i < 32; ++i) { const int kk = 2 * i + (lane >> 5); scr[kk * 33 + (lane & 31)] = W[(size_t)(k0 + kk) * N + n0 + (lane & 31)]; }
    LDS_WAIT(); asm volatile("" ::: "memory");
    const int c = lane & 7;
#pragma unroll
    for (int j = 0; j < 4; ++j) { const int n = (lane >> 3) + 8 * j; const LAS float* s = scr + (8 * c) * 33 + n;
        u32x4 o; o.x = pk2(s[0 * 33], s[1 * 33]); o.y = pk2(s[2 * 33], s[3 * 33]); o.z = pk2(s[4 * 33], s[5 * 33]); o.w = pk2(s[6 * 33], s[7 * 33]);
        *(GAS u32x4*)(WT + (size_t)tr_dest<MODE>(n0 + n) * K + k0 + 8 * c) = o; }
    LDS_WAIT(); asm volatile("" ::: "memory");
}

__device__ __forceinline__ void p0_prologue(const Args& a, LAS unsigned char* lds, int vcu, int G) {
    const int tid = opaque_tid(), lane = tid & 63, wave = __builtin_amdgcn_readfirstlane(tid >> 6);
    LAS float* scr = (LAS float*)(lds + wave * 16384);
    const int gw = vcu * NWAVES + wave, NGW = G * NWAVES;
    unsigned char* ws = a.ws;
    if (gw < 96 * 16) {
        float* MODP = (float*)(ws + WS_MODP);
        const float* wada = a.in[I_WADA];
        for (int it = gw; it < 96 * 16; it += NGW) {
            const int cg = it % 96, kc = it / 96;
            for (int b = 0; b < 33; ++b) { const float v = (b < 32) ? a.in[I_C][b * D + kc * 64 + lane] : a.in[I_CCTX][kc * 64 + lane]; scr[b * 64 + lane] = v / (1.f + __expf(-v)); }
            LDS_WAIT(); asm volatile("" ::: "memory");
            float acc[33];
#pragma unroll
            for (int b = 0; b < 33; ++b) acc[b] = 0.f;
            const float* wp = wada + (size_t)(kc * 64) * NMOD + cg * 64 + lane;
#pragma unroll 2
            for (int k = 0; k < 64; k += 4) {
                const float w0 = __builtin_nontemporal_load(wp + (size_t)(k + 0) * NMOD), w1 = __builtin_nontemporal_load(wp + (size_t)(k + 1) * NMOD),
                            w2 = __builtin_nontemporal_load(wp + (size_t)(k + 2) * NMOD), w3 = __builtin_nontemporal_load(wp + (size_t)(k + 3) * NMOD);
#pragma unroll
                for (int b = 0; b < 33; ++b) { const f32x4 sv4 = *(const LAS f32x4*)(scr + b * 64 + k); acc[b] += (sv4.x * w0 + sv4.y * w1) + (sv4.z * w2 + sv4.w * w3); }
            }
#pragma unroll
            for (int b = 0; b < 33; ++b) MODP[((size_t)kc * 33 + b) * NMOD + cg * 64 + lane] = acc[b];
            LDS_WAIT(); asm volatile("" ::: "memory");
        }
    } else {
        float* tab = (float*)(ws + WS_TAB);
        const int nw = NGW - 96 * 16;
        for (int e = (gw - 96 * 16) * 64 + lane; e < T * 32; e += nw * 64) {
            const int t = e >> 5, i = e & 31;
            const float inv = powf(10000.0f, -(float)(2 * (i & 15)) / 32.0f);
            const float pos = (i < 16) ? (float)(t >> 6) : (float)(t & 63);
            const float ang = pos * inv;
            tab[2 * e] = cosf(ang); tab[2 * e + 1] = sinf(ang);
        }
    }
}
__device__ __forceinline__ void inout_weight_copies(const Args& a, LAS unsigned char* lds, int vcu, int G) {
    const int tid = opaque_tid(), lane = tid & 63, wave = __builtin_amdgcn_readfirstlane(tid >> 6);
    LAS float* scr = (LAS float*)(lds + 16384 + wave * 12288);
    const int gw = vcu * NWAVES + wave, NGW = G * NWAVES;
    unsigned char* ws = a.ws;
    constexpr int I_IN = (D / 64) * (NPROJ / 32), I_OUT = (D / 64) * (D / 32);
    constexpr int NITEMS = I_IN + I_OUT;
    bf16_t* Win_t = (bf16_t*)(ws + WS_WIN); bf16_t* Wout_t = (bf16_t*)(ws + WS_WOUT);
    for (int it = gw; it < NITEMS; it += NGW) {
        int r = it;
        if (r < I_IN) { p0_transpose_item<1>(a.in[I_WIN], D, NPROJ, Win_t, scr, r, lane); continue; } r -= I_IN;
        p0_transpose_item<0>(a.in[I_WOUT], D, D, Wout_t, scr, r, lane);
    }
}
__device__ __forceinline__ void expert_weight_copies(const Args& a, LAS unsigned char* lds, int gw0  , int ngroups, int r_lo, int r_hi) {
    const int tid = opaque_tid(), lane = tid & 63, wave = __builtin_amdgcn_readfirstlane(tid >> 6);
    LAS float* scr = (LAS float*)(lds + wave * 16384);
    const int gw = gw0 * NWAVES + wave, NGW = ngroups * NWAVES;
    unsigned char* ws = a.ws;
    constexpr int I_EXP = (D / 64) * (D / 32);
    unsigned char* Wgu_t = ws + WS_WGU; unsigned char* Wdn_t = ws + WS_WDN;
    for (int r = r_lo + gw; r < r_hi; r += NGW) {
        const int e = r / (3 * I_EXP), q = (r % (3 * I_EXP)) / I_EXP, rr = r % I_EXP;
        if (q == 0) p0_transpose_item_f8<2>(a.in[I_WGATE] + (size_t)e * D * D, D, D, Wgu_t + (size_t)e * 2048 * D, scr, rr, lane);
        else if (q == 1) p0_transpose_item_f8<3>(a.in[I_WUP] + (size_t)e * D * D, D, D, Wgu_t + (size_t)e * 2048 * D, scr, rr, lane);
        else p0_transpose_item_f8<0>(a.in[I_WDOWN] + (size_t)e * D * D, D, D, Wdn_t + (size_t)e * D * D, scr, rr, lane);
    }
    __syncthreads();
}

struct RowF { f32x4 v[4]; };
__device__ __forceinline__ void row_load(RowF& r, const float* xrow, int lane) {
    const f32x4* xr = (const f32x4*)xrow + lane;
#pragma unroll
    for (int j = 0; j < 4; ++j) r.v[j] = __builtin_nontemporal_load(xr + 64 * j);
}
__device__ __forceinline__ void norm_mod_row(const RowF& r, bf16_t* orow, const float* gain, const LAS float* sc, const LAS float* sh, int lane) {
    const f32x4* gr = (const f32x4*)gain + lane;
    float s = 0.f;
#pragma unroll
    for (int j = 0; j < 4; ++j) s += (r.v[j].x * r.v[j].x + r.v[j].y * r.v[j].y) + (r.v[j].z * r.v[j].z + r.v[j].w * r.v[j].w);
    const float rstd = 1.0f / sqrtf(wave_sum(s) * (1.f / D) + EPS);
    u32x2* o8 = (u32x2*)orow + lane;
#pragma unroll
    for (int j = 0; j < 4; ++j) { const f32x4 g = gr[64 * j]; const f32x4 c1 = *(const LAS f32x4*)(sc + 4 * lane + 256 * j), h1 = *(const LAS f32x4*)(sh + 4 * lane + 256 * j);
        const f32x4 y = (r.v[j] * rstd) * g; const f32x4 z = y * (c1 + 1.0f) + h1;
        u32x2 w; w.x = pk2(z.x, z.y); w.y = pk2(z.z, z.w); o8[64 * j] = w; }
}
__device__ __forceinline__ void p1_xn(const Args& a, LAS unsigned char* lds, int c, int G) {
    const int tid = opaque_tid(), lane = tid & 63, wave = __builtin_amdgcn_readfirstlane(tid >> 6);
    unsigned char* ws = a.ws;
    const float* MODP = (const float*)(ws + WS_MODP); float* MOD = (float*)(ws + WS_MOD); const float* bada = a.in[I_BADA];
    { const int per = (33 * NMOD + G - 1) / G;
      for (int i = c * per + tid; i < (c + 1) * per && i < 33 * NMOD; i += NTHREADS) { const int r = i / NMOD, n = i - r * NMOD; float s = bada[n];
#pragma unroll
            for (int kc = 0; kc < 16; ++kc) s += MODP[((size_t)kc * 33 + r) * NMOD + n];
            MOD[i] = s; } }
    LAS float* sv = (LAS float*)lds;
    bf16_t* XN = (bf16_t*)(ws + WS_XN);
    const float* X = a.in[I_X]; const float* CTX = a.in[I_CTX]; const float* gain = a.in[I_NPRE_MIX];
    for (int p = c; p < 256; p += G) {
        const int b = p >> 3;
        const int rbase = p * 256 + wave * 32;
        RowF a0, a1, a2, a3;
        row_load(a0, X + (size_t)rbase * D, lane); row_load(a1, X + (size_t)(rbase + 1) * D, lane); row_load(a2, X + (size_t)(rbase + 2) * D, lane); row_load(a3, X + (size_t)(rbase + 3) * D, lane);
        __syncthreads();
        for (int n = tid; n < 4096; n += NTHREADS) { const int r = (n < 2048) ? b : 32; const int col = n & 2047; float s = bada[col];
#pragma unroll
            for (int kc = 0; kc < 16; ++kc) s += MODP[((size_t)kc * 33 + r) * NMOD + col];
            sv[n] = s; }
        __syncthreads();
        const int crow = p * 32 + wave * 4;
        for (int i = 0; i < 8; ++i) {
            RowF n0, n1, n2, n3;
            const float* nx = (i + 1 < 8) ? X + (size_t)(rbase + 4 * (i + 1)) * D : CTX + (size_t)crow * D;
            row_load(n0, nx, lane); row_load(n1, nx + D, lane); row_load(n2, nx + 2 * D, lane); row_load(n3, nx + 3 * D, lane);
            bf16_t* orow = XN + (size_t)(rbase + 4 * i) * D;
            norm_mod_row(a0, orow, gain, sv + 1024, sv, lane);
            norm_mod_row(a1, orow + D, gain, sv + 1024, sv, lane);
            norm_mod_row(a2, orow + 2 * D, gain, sv + 1024, sv, lane);
            norm_mod_row(a3, orow + 3 * D, gain, sv + 1024, sv, lane);
            a0 = n0; a1 = n1; a2 = n2; a3 = n3;
        }
        { bf16_t* orow = XN + (size_t)(M + crow) * D;
          norm_mod_row(a0, orow, gain, sv + 3072, sv + 2048, lane);
          norm_mod_row(a1, orow + D, gain, sv + 3072, sv + 2048, lane);
          norm_mod_row(a2, orow + 2 * D, gain, sv + 3072, sv + 2048, lane);
          norm_mod_row(a3, orow + 3 * D, gain, sv + 3072, sv + 2048, lane); }
    }
}

namespace att {
constexpr int KP = 272, KBUF = 64 * KP, VBUF = 16384;
constexpr int OFF_K = 0, OFF_V = 2 * KBUF, OFF_WSF = OFF_V + 2 * VBUF, OFF_END = OFF_WSF + NWAVES * 256;
static_assert(OFF_WSF >= 65536 && OFF_END <= RING_BYTES, "attention LDS map");
constexpr int NT = TK / 64;
constexpr float THR = 8.0f;
__device__ __forceinline__ int crow(int r, int hi) { return (r & 3) + 8 * (r >> 2) + 4 * hi; }
__device__ __forceinline__ float max3f(float a, float b, float c) { float r; asm("v_max3_f32 %0, %1, %2, %3" : "=v"(r) : "v"(a), "v"(b), "v"(c)); return r; }
__device__ __forceinline__ float max2f(float a, float b) { float r; asm("v_max_f32_e32 %0, %1, %2" : "=v"(r) : "v"(a), "v"(b)); return r; }
__device__ __forceinline__ s16x4 vtr(const LAS unsigned char* p) { return __builtin_bit_cast(s16x4, __builtin_amdgcn_ds_read_tr16_b64_v4i16((LAS s16x4*)p)); }

#define ATT_BAR() asm volatile("s_waitcnt lgkmcnt(0)\n\ts_barrier" ::: "memory")
#define ATT_SB() __builtin_amdgcn_sched_barrier(0)
#define ATT_KLD(i, KF) KF = *(const LAS bf16x8*)(kb_ + ((i) & 1) * (32 * KP) + ((i) >> 1) * 32)
#define ATT_XSTEP(i, KC, KN) do { if ((i) + 2 < 8) { ATT_KLD((i) + 2, KN); } \
    if ((i) == 0) p0 = __builtin_amdgcn_mfma_f32_32x32x16_bf16(KC, qr[0], negref, 0, 0, 0); \
    else if ((i) == 1) p1 = __builtin_amdgcn_mfma_f32_32x32x16_bf16(KC, qr[0], negref, 0, 0, 0); \
    else if (((i) & 1) == 0) p0 = __builtin_amdgcn_mfma_f32_32x32x16_bf16(KC, qr[(i) >> 1], p0, 0, 0, 0); else p1 = __builtin_amdgcn_mfma_f32_32x32x16_bf16(KC, qr[(i) >> 1], p1, 0, 0, 0); ATT_SB(); } while (0)
#define ATT_X(kcur) do { \
    const LAS unsigned char* kb_ = lds + OFF_K + (kcur) * KBUF + koff; \
    bf16x8 ka_, kb2_, kc_; \
    ATT_KLD(0, ka_); ATT_KLD(1, kb2_); \
    ATT_SB(); \
    ATT_XSTEP(0, ka_, kc_); ATT_XSTEP(1, kb2_, ka_); ATT_XSTEP(2, kc_, kb2_); ATT_XSTEP(3, ka_, kc_); \
    ATT_XSTEP(4, kb2_, ka_); ATT_XSTEP(5, kc_, kb2_); ATT_XSTEP(6, ka_, kc_); ATT_XSTEP(7, kb2_, ka_); \
} while (0)
#define ATT_EXP2(i, PWN) do { \
    const float e0_ = __builtin_amdgcn_exp2f((i) < 8 ? p0[2 * ((i) & 7)] : p1[2 * ((i) & 7)]), e1_ = __builtin_amdgcn_exp2f((i) < 8 ? p0[2 * ((i) & 7) + 1] : p1[2 * ((i) & 7) + 1]); \
    sacc_ += e0_ + e1_; PWN[(i) >> 2][(i) & 3] = pk2(e0_, e1_); asm volatile("" : "+v"(PWN[(i) >> 2]), "+v"(sacc_)); } while (0)
#define ATT_VLD(i, LO, HI) do { LO = vtr(vb_ + ((i) & 3) * 4096 + ((i) >> 2) * 1024); HI = vtr(vb_ + ((i) & 3) * 4096 + ((i) >> 2) * 1024 + 512); } while (0)
#define ATT_VF(LO, HI) ((bf16x8){LO[0], LO[1], LO[2], LO[3], HI[0], HI[1], HI[2], HI[3]})
#define ATT_YSTEP(i, PWC, PWN, LC, HC, LN, HN) do { if ((i) + 2 < 16) { ATT_VLD((i) + 2, LN, HN); } \
    o[(i) & 3] = __builtin_amdgcn_mfma_f32_32x32x16_bf16(__builtin_bit_cast(bf16x8, PWC[(i) >> 2]), ATT_VF(LC, HC), o[(i) & 3], 0, 0, 0); \
    ATT_EXP2(i, PWN); ATT_SB(); } while (0)
#define ATT_Y(vcur, PWC, PWN) do { \
    const LAS unsigned char* vb_ = lds + OFF_V + (vcur) * VBUF + voff; \
    float sacc_ = 0.f; s16x4 la_, ha_, lb_, hb_, lc_, hc_; \
    ATT_VLD(0, la_, ha_); ATT_VLD(1, lb_, hb_); ATT_SB(); \
    ATT_YSTEP(0, PWC, PWN, la_, ha_, lc_, hc_); ATT_YSTEP(1, PWC, PWN, lb_, hb_, la_, ha_); ATT_YSTEP(2, PWC, PWN, lc_, hc_, lb_, hb_); \
    ATT_YSTEP(3, PWC, PWN, la_, ha_, lc_, hc_); ATT_YSTEP(4, PWC, PWN, lb_, hb_, la_, ha_); ATT_YSTEP(5, PWC, PWN, lc_, hc_, lb_, hb_); \
    ATT_YSTEP(6, PWC, PWN, la_, ha_, lc_, hc_); ATT_YSTEP(7, PWC, PWN, lb_, hb_, la_, ha_); ATT_YSTEP(8, PWC, PWN, lc_, hc_, lb_, hb_); \
    ATT_YSTEP(9, PWC, PWN, la_, ha_, lc_, hc_); ATT_YSTEP(10, PWC, PWN, lb_, hb_, la_, ha_); ATT_YSTEP(11, PWC, PWN, lc_, hc_, lb_, hb_); \
    ATT_YSTEP(12, PWC, PWN, la_, ha_, lc_, hc_); ATT_YSTEP(13, PWC, PWN, lb_, hb_, la_, ha_); ATT_YSTEP(14, PWC, PWN, lc_, hc_, lb_, hb_); \
    ATT_YSTEP(15, PWC, PWN, la_, ha_, lc_, hc_); \
    l_reg += sacc_; \
} while (0)
#define ATT_Y0(PWN) do { float sacc_ = 0.f; _Pragma("unroll") for (int i = 0; i < 16; ++i) ATT_EXP2(i, PWN); l_reg += sacc_; } while (0)
#define ATT_ZSTEP(i, PWC, LC, HC, LN, HN) do { if ((i) + 2 < 16) { ATT_VLD((i) + 2, LN, HN); } \
    o[(i) & 3] = __builtin_amdgcn_mfma_f32_32x32x16_bf16(__builtin_bit_cast(bf16x8, PWC[(i) >> 2]), ATT_VF(LC, HC), o[(i) & 3], 0, 0, 0); ATT_SB(); } while (0)
#define ATT_Z(vcur, PWC) do { \
    const LAS unsigned char* vb_ = lds + OFF_V + (vcur) * VBUF + voff; \
    s16x4 la_, ha_, lb_, hb_, lc_, hc_; \
    ATT_VLD(0, la_, ha_); ATT_VLD(1, lb_, hb_); ATT_SB(); \
    ATT_ZSTEP(0, PWC, la_, ha_, lc_, hc_); ATT_ZSTEP(1, PWC, lb_, hb_, la_, ha_); ATT_ZSTEP(2, PWC, lc_, hc_, lb_, hb_); \
    ATT_ZSTEP(3, PWC, la_, ha_, lc_, hc_); ATT_ZSTEP(4, PWC, lb_, hb_, la_, ha_); ATT_ZSTEP(5, PWC, lc_, hc_, lb_, hb_); \
    ATT_ZSTEP(6, PWC, la_, ha_, lc_, hc_); ATT_ZSTEP(7, PWC, lb_, hb_, la_, ha_); ATT_ZSTEP(8, PWC, lc_, hc_, lb_, hb_); \
    ATT_ZSTEP(9, PWC, la_, ha_, lc_, hc_); ATT_ZSTEP(10, PWC, lb_, hb_, la_, ha_); ATT_ZSTEP(11, PWC, lc_, hc_, lb_, hb_); \
    ATT_ZSTEP(12, PWC, la_, ha_, lc_, hc_); ATT_ZSTEP(13, PWC, lb_, hb_, la_, ha_); ATT_ZSTEP(14, PWC, lc_, hc_, lb_, hb_); \
    ATT_ZSTEP(15, PWC, la_, ha_, lc_, hc_); \
} while (0)
#define ATT_STAGE(j) do { \
    if ((j) + 1 < NT) { _Pragma("unroll") for (int i = 0; i < 2; ++i) *(LAS u32x4*)(lds + OFF_K + (((j) + 1) & 1) * KBUF + kdst[i]) = kr[i]; } \
    _Pragma("unroll") for (int i = 0; i < 2; ++i) *(LAS u32x4*)(lds + OFF_V + ((j) & 1) * VBUF + vdst[i]) = vr[i]; \
    if ((j) + 2 < NT) { _Pragma("unroll") for (int i = 0; i < 2; ++i) kr[i] = *(const u32x4*)(Kb + (size_t)((j) + 2) * 64 * 512 + gsrc[i]); } \
    if ((j) + 1 < NT) { _Pragma("unroll") for (int i = 0; i < 2; ++i) vr[i] = *(const u32x4*)(Vb + (size_t)((j) + 1) * 64 * 512 + gsrc[i]); } } while (0)

__device__ __forceinline__ void unit(LAS unsigned char* lds, int b, int h, int qb, const bf16_t* Q, const bf16_t* KA, const bf16_t* VA, bf16_t* MIXIN, const float* subg, float lam, const unsigned* KM) {
    const int tid = opaque_tid(), lane = tid & 63, r32 = lane & 31, hi = lane >> 5;
    const int wid = __builtin_amdgcn_readfirstlane(tid >> 6), w = wid & 3, m = wid >> 2;
    LAS float* wsf = (LAS float*)(lds + OFF_WSF) + wid * 64;
    const int rowQ = b * T + qb * 128 + w * 32;
    bf16x8 qr[4];
#pragma unroll
    for (int d0 = 0; d0 < 4; ++d0) qr[d0] = *(const bf16x8*)(Q + (size_t)(rowQ + r32) * 512 + h * 128 + m * 64 + d0 * 16 + hi * 8);
    const bf16_t* Kb = KA + (size_t)b * TK * 512 + h * 128; const bf16_t* Vb = VA + (size_t)b * TK * 512 + h * 128;
    int gsrc[2], kdst[2], vdst[2];
#pragma unroll
    for (int i = 0; i < 2; ++i) { const int cid = tid + 512 * i, kv = cid >> 4, c16 = cid & 15;
        gsrc[i] = kv * 512 + c16 * 8; kdst[i] = kv * KP + c16 * 16; vdst[i] = (c16 >> 2) * 4096 + (kv >> 4) * 1024 + (kv & 15) * 64 + (c16 & 3) * 16; }
    u32x4 kr[2], vr[2];
#pragma unroll
    for (int i = 0; i < 2; ++i) { kr[i] = *(const u32x4*)(Kb + gsrc[i]); vr[i] = *(const u32x4*)(Vb + gsrc[i]); }
#pragma unroll
    for (int i = 0; i < 2; ++i) *(LAS u32x4*)(lds + OFF_K + kdst[i]) = kr[i];
#pragma unroll
    for (int i = 0; i < 2; ++i) kr[i] = *(const u32x4*)(Kb + (size_t)64 * 512 + gsrc[i]);
    ATT_BAR();
    f32x16 o[4];
#pragma unroll
    for (int d0 = 0; d0 < 4; ++d0) o[d0] = (f32x16){};
    float l_reg = 0.f;
    f32x16 p0, p1, negref;
    {
        const unsigned* km = KM + (b * 8 + h * 2 + m) * 2;
        const float kmax2 = __uint_as_float(km[0]) + __uint_as_float(km[1]);
        float ss = 0.f;
#pragma unroll
        for (int d0 = 0; d0 < 4; ++d0)
#pragma unroll
            for (int i = 0; i < 8; ++i) { const float v = bf2f((unsigned short)qr[d0][i]); ss += v * v; }
        ss += __shfl_xor(ss, 32);
        const float ref = sqrtf(ss * kmax2) * 1.02f;
#pragma unroll
        for (int r = 0; r < 16; ++r) negref[r] = -ref;
    }
    u32x4 pwA[4], pwB[4];
    const int koff = r32 * KP + m * 128 + hi * 16;
    const int voff = ((lane >> 4) & 1) * 32 + (lane & 3) * 8 + (4 * hi + ((lane & 15) >> 2)) * 64;
    ATT_X(0); ATT_STAGE(0); ATT_Y0(pwA); ATT_BAR();
    ATT_X(1); ATT_STAGE(1); ATT_Y(0, pwA, pwB); ATT_BAR();
    for (int j = 2; j < NT; j += 2) {
        ATT_X(0); ATT_STAGE(j); ATT_Y(1, pwB, pwA); ATT_BAR();
        ATT_X(1); ATT_STAGE(j + 1); ATT_Y(0, pwA, pwB); ATT_BAR();
    }
    ATT_Z(1, pwB); ATT_BAR();
    l_reg += __shfl_xor(l_reg, 32);
    if (hi == 0) wsf[32 + r32] = l_reg;
    LDS_WAIT();
    float rli[16];
#pragma unroll
    for (int r = 0; r < 16; ++r) rli[r] = 1.0f / wsf[32 + crow(r, hi)];
    LDS_WAIT();
    LAS float* ex = (LAS float*)lds + w * 4096;
    if (m == 1) {
#pragma unroll
        for (int r = 0; r < 16; ++r)
#pragma unroll
            for (int d0 = 0; d0 < 4; ++d0) ex[crow(r, hi) * 128 + d0 * 32 + r32] = o[d0][r] * rli[r];
    }
    ATT_BAR();
    if (m == 0) {
        float g4[4];
#pragma unroll
        for (int d0 = 0; d0 < 4; ++d0) g4[d0] = subg[d0 * 32 + r32] * (1.0f - LAM_INIT);
#pragma unroll
        for (int r = 0; r < 16; ++r) {
            const int q = crow(r, hi); float x[4]; float ss = 0.f;
#pragma unroll
            for (int d0 = 0; d0 < 4; ++d0) { x[d0] = o[d0][r] * rli[r] - lam * ex[q * 128 + d0 * 32 + r32]; ss += x[d0] * x[d0]; }
#pragma unroll
            for (int off = 1; off < 32; off <<= 1) ss += __shfl_xor(ss, off);
            const float rstd = 1.0f / sqrtf(ss * (1.f / 128.f) + EPS);
            bf16_t* dst = MIXIN + (size_t)(rowQ + q) * 1024 + h * 128 + r32;
#pragma unroll
            for (int d0 = 0; d0 < 4; ++d0) dst[d0 * 32] = (bf16_t)(pk2(x[d0] * rstd * g4[d0], 0.f) & 0xffffu);
        }
    }
    ATT_BAR();
}
#undef ATT_BAR
#undef ATT_X
#undef ATT_EXP2
#undef ATT_Y
#undef ATT_Y0
#undef ATT_Z
#undef ATT_STAGE
#undef ATT_SB
#undef ATT_KLD
#undef ATT_XSTEP
#undef ATT_VLD
#undef ATT_VF
#undef ATT_YSTEP
#undef ATT_ZSTEP
}

__device__ __forceinline__ void p3_conv_attn(const Args& a, LAS unsigned char* lds, int c, int vcu, int G) {
    const int tid = opaque_tid(), lane = tid & 63, wave = __builtin_amdgcn_readfirstlane(tid >> 6);
    unsigned char* ws = a.ws;
    const bf16_t* GB = (const bf16_t*)(ws + WS_GB); const bf16_t* U = (const bf16_t*)(ws + WS_U); bf16_t* MIXIN = (bf16_t*)(ws + WS_MIXIN);
    {
        const float* cw = a.in[I_CONVW]; float w0[8], w1[8], w2[8];
#pragma unroll
        for (int i = 0; i < 8; ++i) { w0[i] = cw[lane * 8 + i]; w1[i] = cw[512 + lane * 8 + i]; w2[i] = cw[1024 + lane * 8 + i]; }
        const int gw = vcu * NWAVES + wave, NGW = G * NWAVES;
        for (int row = gw * (M / NGW); row < (gw + 1) * (M / NGW); ++row) {
            const int t = row & (T - 1);
            const u32x4 z = {0u, 0u, 0u, 0u};
            const u32x4 uc = *(const u32x4*)(U + (size_t)row * 512 + lane * 8);
            const u32x4 up = (t > 0) ? *(const u32x4*)(U + (size_t)(row - 1) * 512 + lane * 8) : z;
            const u32x4 un = (t < T - 1) ? *(const u32x4*)(U + (size_t)(row + 1) * 512 + lane * 8) : z;
            const u32x4 gb = *(const u32x4*)(GB + (size_t)row * 512 + lane * 8);
            u32x4 o;
#pragma unroll
            for (int q = 0; q < 4; ++q) {
                const float y0 = w0[2 * q] * bflo(up[q]) + w1[2 * q] * bflo(uc[q]) + w2[2 * q] * bflo(un[q]);
                const float y1 = w0[2 * q + 1] * bfhi(up[q]) + w1[2 * q + 1] * bfhi(uc[q]) + w2[2 * q + 1] * bfhi(un[q]);
                o[q] = pk2(bflo(gb[q]) * y0, bfhi(gb[q]) * y1);
            }
            *(u32x4*)(MIXIN + (size_t)row * 1024 + 512 + lane * 8) = o;
        }
    }
    float lam;
    { const float p1 = a.in[I_LQ1][lane] * a.in[I_LK1][lane], p2 = a.in[I_LQ2][lane] * a.in[I_LK2][lane];
      lam = __expf(wave_sum(p1)) - __expf(wave_sum(p2)) + LAM_INIT; }
    const bf16_t* Q = (const bf16_t*)(ws + WS_Q); const bf16_t* KA = (const bf16_t*)(ws + WS_K); const bf16_t* VA = (const bf16_t*)(ws + WS_V);
    __syncthreads();
    for (int u = vcu * 8; u < 2048; u += G * 8) {
        const int x = (u >> 3) / 32, jj = (u >> 3) % 32;
        for (int i = 0; i < 8; ++i) {
            const int bh = 16 * x + 2 * i + (jj >> 4), qb = jj & 15;
            att::unit(lds, bh >> 2, bh & 3, qb, Q, KA, VA, MIXIN, a.in[I_SUBLN], lam, (const unsigned*)(ws + WS_CTL) + CW_KMAX);
        }
    }
}

struct P5In { f32x4 x[4]; u32x2 m[4]; };
__device__ __forceinline__ void p5_load(P5In& r, int row, int lane, const float* X, const bf16_t* MIX) {
    const f32x4* xr = (const f32x4*)(X + (size_t)row * D) + lane; const u32x2* mr = (const u32x2*)(MIX + (size_t)row * D) + lane;
#pragma unroll
    for (int j = 0; j < 4; ++j) { r.x[j] = __builtin_nontemporal_load(xr + 64 * j); r.m[j] = __builtin_nontemporal_load(mr + 64 * j); }
}
__device__ __forceinline__ float p5_resid(const P5In& r, f32x4 (&h)[4], int row, int lane, const LAS float* mv, const f32x4* npm, bf16_t* H1) {
    f32x4 mx[4]; float s = 0.f;
#pragma unroll
    for (int j = 0; j < 4; ++j) { const u32x2 wv = r.m[j]; mx[j] = (f32x4){bflo(wv.x), bfhi(wv.x), bflo(wv.y), bfhi(wv.y)};
        s += (mx[j].x * mx[j].x + mx[j].y * mx[j].y) + (mx[j].z * mx[j].z + mx[j].w * mx[j].w); }
    const float rstd1 = 1.0f / sqrtf(wave_sum(s) * (1.f / D) + EPS);
    u32x2* hr = (u32x2*)(H1 + (size_t)row * D) + lane; float s2 = 0.f;
#pragma unroll
    for (int j = 0; j < 4; ++j) { const f32x4 g1 = *(const LAS f32x4*)(mv + 4 * lane + 256 * j);
        h[j] = r.x[j] + g1 * ((mx[j] * rstd1) * npm[64 * j]);
        u32x2 wv; wv.x = pk2(h[j].x, h[j].y); wv.y = pk2(h[j].z, h[j].w); __builtin_nontemporal_store(wv, hr + 64 * j);
        s2 += (h[j].x * h[j].x + h[j].y * h[j].y) + (h[j].z * h[j].z + h[j].w * h[j].w); }
    return 1.0f / sqrtf(wave_sum(s2) * (1.f / D) + EPS);
}
__device__ __forceinline__ void p5_rows(const Args& a, LAS unsigned char* lds, int p  ) {
    const int tid = opaque_tid(), lane = tid & 63, wave = __builtin_amdgcn_readfirstlane(tid >> 6);
    unsigned char* ws = a.ws;
    const int b = p >> 3;
    LAS float* wrt = (LAS float*)lds;
    LAS float* mv = (LAS float*)(lds + 65536);
    const float* wr = a.in[I_WROUTER];
    const bf16_t* MIX = (const bf16_t*)(ws + WS_MIX); unsigned char* XN2 = ws + WS_XN; float* AFFT = (float*)(ws + WS_AFFT); bf16_t* H1 = (bf16_t*)(ws + WS_H1);
    const float* X = a.in[I_X];
    const int rbase = p * 256 + wave * 32;
    P5In cA, cB;
    p5_load(cA, rbase, lane, X, MIX); p5_load(cB, rbase + 1, lane, X, MIX);
    for (int n = tid; n < D * NE; n += NTHREADS) { const int k = n >> 4, e = n & 15; wrt[e * D + k] = wr[n]; }
    const float* MOD = (const float*)(ws + WS_MOD) + (size_t)b * NMOD;
    for (int n = tid; n < 3 * D; n += NTHREADS) mv[n] = MOD[2 * D + n];
    __syncthreads();
    const f32x4* npm = (const f32x4*)a.in[I_NPOST_MIX] + lane; const f32x4* npf = (const f32x4*)a.in[I_NPRE_FFN] + lane;
    for (int i = 0; i < 16; ++i) {
        const int rowA = rbase + 2 * i, rowB = rowA + 1;
        P5In nA, nB;
        if (i + 1 < 16) { p5_load(nA, rowA + 2, lane, X, MIX); p5_load(nB, rowB + 2, lane, X, MIX); }
        f32x4 hA[4], hB[4];
        const float rsA = p5_resid(cA, hA, rowA, lane, mv, npm, H1);
        const float rsB = p5_resid(cB, hB, rowB, lane, mv, npm, H1);
        unsigned* oA = (unsigned*)(XN2 + (size_t)rowA * D) + lane; unsigned* oB = (unsigned*)(XN2 + (size_t)rowB * D) + lane;
        typedef float f32x2v __attribute__((ext_vector_type(2)));
        f32x2v lg2[16];
#pragma unroll
        for (int e = 0; e < 16; ++e) lg2[e] = (f32x2v){0.f, 0.f};
#pragma unroll
        for (int j = 0; j < 4; ++j) { const f32x4 sh2 = *(const LAS f32x4*)(mv + 1024 + 4 * lane + 256 * j), sc2 = *(const LAS f32x4*)(mv + 2048 + 4 * lane + 256 * j);
            const f32x4 gn = npf[64 * j];
            const f32x4 zA = ((hA[j] * rsA) * gn) * (sc2 + 1.0f) + sh2, zB = ((hB[j] * rsB) * gn) * (sc2 + 1.0f) + sh2;
            { const f32x4 qa = zA * pg8::F8_ACT, qb = zB * pg8::F8_ACT; oA[64 * j] = pg8::pk4_fp8(qa.x, qa.y, qa.z, qa.w); oB[64 * j] = pg8::pk4_fp8(qb.x, qb.y, qb.z, qb.w); }
            const f32x2v zx = {zA.x, zB.x}, zy = {zA.y, zB.y}, zz = {zA.z, zB.z}, zw = {zA.w, zB.w};
#pragma unroll
            for (int e = 0; e < 16; ++e) { const f32x4 wq = *(const LAS f32x4*)(wrt + e * D + 4 * lane + 256 * j);
                lg2[e] = __builtin_elementwise_fma(zx, (f32x2v){wq.x, wq.x}, lg2[e]); lg2[e] = __builtin_elementwise_fma(zy, (f32x2v){wq.y, wq.y}, lg2[e]);
                lg2[e] = __builtin_elementwise_fma(zz, (f32x2v){wq.z, wq.z}, lg2[e]); lg2[e] = __builtin_elementwise_fma(zw, (f32x2v){wq.w, wq.w}, lg2[e]);
                if ((e & 3) == 3) __builtin_amdgcn_sched_barrier(0); } }
        float lg[32];
#pragma unroll
        for (int e = 0; e < 16; ++e) { lg[e] = lg2[e].x; lg[16 + e] = lg2[e].y; }
#pragma unroll
        for (int st = 0; st < 5; ++st) { const int d = 1 << st, cntv = 16 >> st; const bool up = (lane & d) != 0;
#pragma unroll
            for (int q = 0; q < 16; ++q) if (q < cntv) { const float send = up ? lg[2 * q] : lg[2 * q + 1], keep = up ? lg[2 * q + 1] : lg[2 * q]; lg[q] = keep + __shfl_xor(send, d); } }
        float lv = lg[0] + __shfl_xor(lg[0], 32);
        float mxl = lv;
#pragma unroll
        for (int d = 1; d < 16; d <<= 1) mxl = fmaxf(mxl, __shfl_xor(mxl, d));
        const float ev = __expf(lv - mxl); float se = ev;
#pragma unroll
        for (int d = 1; d < 16; d <<= 1) se += __shfl_xor(se, d);
        if (lane < 32) { const int row = (lane < 16) ? rowA : rowB; AFFT[((size_t)b * NE + (lane & 15)) * T + (row & (T - 1))] = ev / se; }
        cA = nA; cB = nB;
    }
}

__device__ __forceinline__ void p6_topk(const Args& a, LAS unsigned char* lds, int c, int G) {
    const int tid = opaque_tid(), lane = tid & 63, wave = __builtin_amdgcn_readfirstlane(tid >> 6);
    unsigned char* ws = a.ws;
    const float* AFFT = (const float*)(ws + WS_AFFT); short* SLOT = (short*)(ws + WS_SLOT); int* IDX = (int*)(ws + WS_IDX); float* GATE = (float*)(ws + WS_GATE);
    LAS unsigned* sv = (LAS unsigned*)(lds + wave * 16384);
    for (int item = c + wave * G; item < NITEM; item += G * NWAVES) {
        const int b = item >> 4, e = item & 15;
        const float* src = AFFT + (size_t)item * T;
#pragma unroll 8
        for (int j = 0; j < 32; ++j) sv[j * 64 + lane] = __float_as_uint(src[j * 64 + lane]);
        LDS_WAIT(); asm volatile("" ::: "memory");
        unsigned pre = 0u;
        for (int bit = 30; bit >= 0; --bit) {
            const unsigned cand = pre | (1u << bit);
            int cnt = 0;
#pragma unroll 4
            for (int j = 0; j < 32; ++j) cnt += (int)__popcll(__ballot(sv[j * 64 + lane] >= cand));
            if (cnt >= CAP) pre = cand;
        }
        int ngt = 0;
#pragma unroll 4
        for (int j = 0; j < 32; ++j) ngt += (int)__popcll(__ballot(sv[j * 64 + lane] > pre));
        const int need_eq = CAP - ngt;
        const unsigned long long ltmask = (1ull << lane) - 1ull;
        int base_gt = 0, base_eq = 0;
#pragma unroll 2
        for (int j = 0; j < 32; ++j) {
            const unsigned vj = sv[j * 64 + lane];
            const bool gt = vj > pre, eq = vj == pre;
            const unsigned long long mg = __ballot(gt), me = __ballot(eq);
            const int pg = base_gt + (int)__popcll(mg & ltmask), pe = base_eq + (int)__popcll(me & ltmask);
            int sl = -1; if (gt) sl = pg; else if (eq && pe < need_eq) sl = ngt + pe;
            const int t = j * 64 + lane;
            SLOT[((size_t)b * T + t) * NE + e] = (short)sl;
            if (sl >= 0) { IDX[item * CAP + sl] = t; GATE[item * CAP + sl] = __uint_as_float(vj); }
            base_gt += (int)__popcll(mg); base_eq += (int)__popcll(me);
        }
        LDS_WAIT(); asm volatile("" ::: "memory");
    }
}

struct P8Row { u32x2 h[4]; unsigned y[4][4]; float wt[4]; unsigned long long rest; int sl; };
__device__ __forceinline__ f32x4 fp8x4_to_f32(unsigned w) { typedef float f2 __attribute__((ext_vector_type(2))); const f2 lo = __builtin_amdgcn_cvt_pk_f32_fp8((int)w, false), hi = __builtin_amdgcn_cvt_pk_f32_fp8((int)w, true); return (f32x4){lo.x, lo.y, hi.x, hi.y}; }
__device__ __forceinline__ void p8_issue(P8Row& r, int row, int lane, const short* SLOT, const unsigned char* Y, const bf16_t* H1) {
    const int b = row >> 11;
    const int s_e = (lane < NE) ? (int)SLOT[(size_t)row * NE + lane] : -1;
    unsigned long long mask = __ballot(s_e >= 0);
    const u32x2* hr = (const u32x2*)(H1 + (size_t)row * D) + lane;
#pragma unroll
    for (int j = 0; j < 4; ++j) r.h[j] = __builtin_nontemporal_load(hr + 64 * j);
#pragma unroll
    for (int q = 0; q < 4; ++q) {
        int e = 0, s = 0; r.wt[q] = 0.f;
        if (mask) { e = (int)__builtin_ctzll(mask); mask &= mask - 1ull; s = __builtin_amdgcn_readlane(s_e, e); r.wt[q] = 1.f; }
        const unsigned* yr = (const unsigned*)(Y + ((size_t)(b * NE + e) * CAP + s) * D) + lane;
#pragma unroll
        for (int j = 0; j < 4; ++j) r.y[q][j] = __builtin_nontemporal_load(yr + 64 * j);
    }
    r.rest = mask; r.sl = s_e;
}
__device__ __forceinline__ void p8_finish(P8Row& r, int row, int lane, const unsigned char* Y, const float* MOD, const f32x4* npo, float* out) {
    const int b = row >> 11;
    f32x4 ff[4];
#pragma unroll
    for (int j = 0; j < 4; ++j) ff[j] = (f32x4){0.f, 0.f, 0.f, 0.f};
#pragma unroll
    for (int q = 0; q < 4; ++q)
#pragma unroll
        for (int j = 0; j < 4; ++j) ff[j] += fp8x4_to_f32(r.y[q][j]) * r.wt[q];
    unsigned long long mask = r.rest;
    while (mask) {
        const int e = (int)__builtin_ctzll(mask); mask &= mask - 1ull; const int s = __builtin_amdgcn_readlane(r.sl, e);
        const unsigned* yr = (const unsigned*)(Y + ((size_t)(b * NE + e) * CAP + s) * D) + lane;
#pragma unroll
        for (int j = 0; j < 4; ++j) ff[j] += fp8x4_to_f32(yr[64 * j]);
    }
#pragma unroll
    for (int j = 0; j < 4; ++j) ff[j] = ff[j] * (1.0f / pg8::F8_Y);
    float s2 = 0.f;
#pragma unroll
    for (int j = 0; j < 4; ++j) s2 += (ff[j].x * ff[j].x + ff[j].y * ff[j].y) + (ff[j].z * ff[j].z + ff[j].w * ff[j].w);
    const float rstd = 1.0f / sqrtf(wave_sum(s2) * (1.f / D) + EPS);
    f32x4* orow = (f32x4*)(out + (size_t)row * D) + lane; const f32x4* g2 = (const f32x4*)(MOD + (size_t)b * NMOD + 5 * D) + lane;
#pragma unroll
    for (int j = 0; j < 4; ++j) { const u32x2 hv = r.h[j]; const f32x4 h = (f32x4){bflo(hv.x), bfhi(hv.x), bflo(hv.y), bfhi(hv.y)};
        __builtin_nontemporal_store(h + g2[64 * j] * ((ff[j] * rstd) * npo[64 * j]), orow + 64 * j); }
}
__device__ __forceinline__ void p8_final(const Args& a, int vcu, int G) {
    const int tid = opaque_tid(), lane = tid & 63, wave = __builtin_amdgcn_readfirstlane(tid >> 6);
    unsigned char* ws = a.ws;
    const short* SLOT = (const short*)(ws + WS_SLOT); const unsigned char* Y = ws + WS_Y; const float* MOD = (const float*)(ws + WS_MOD); const bf16_t* H1 = (const bf16_t*)(ws + WS_H1);
    const f32x4* npo = (const f32x4*)a.in[I_NPOST_FFN] + lane;
    const int gw = vcu * NWAVES + wave, NGW = G * NWAVES;
    const int per = M / NGW;
    for (int row = gw * per; row < (gw + 1) * per; row += 4) {
        P8Row r0, r1, r2, r3;
        p8_issue(r0, row, lane, SLOT, Y, H1);
        p8_issue(r1, row + 1, lane, SLOT, Y, H1);
        p8_issue(r2, row + 2, lane, SLOT, Y, H1);
        p8_issue(r3, row + 3, lane, SLOT, Y, H1);
        p8_finish(r0, row, lane, Y, MOD, npo, a.out);
        p8_finish(r1, row + 1, lane, Y, MOD, npo, a.out);
        p8_finish(r2, row + 2, lane, Y, MOD, npo, a.out);
        p8_finish(r3, row + 3, lane, Y, MOD, npo, a.out);
    }
}

__global__ void __launch_bounds__(NTHREADS, 2) fwd_kernel(Args args) {
    extern __shared__ __attribute__((aligned(16))) unsigned char lds_raw[];
    LAS unsigned char* lds = (LAS unsigned char*)lds_raw;
    volatile LAS unsigned* MISC = (volatile LAS unsigned*)(lds + MISC_OFF);
    const int tid = threadIdx.x;
    const int G = gridDim.x, c = blockIdx.x;
    const int vcu = (G % 8 == 0) ? (c % 8) * (G / 8) + c / 8 : c;
    unsigned char* ws = args.ws;
    gu32* ctl = (gu32*)(ws + WS_CTL);
    for (int u = tid; u < (LDS_BYTES - LDSCTL_OFF) / 4; u += NTHREADS) ((LAS unsigned*)(lds + LDSCTL_OFF))[u] = 0u;
    __syncthreads();
    XcdBarrier bar; bar.bar = (unsigned*)(ctl + CW_BAR); bar.x = 0; bar.st = nullptr;
    const int lo = args.ph_lo, hi = args.ph_hi;
    if (hi - lo > 1) bar = xcd_barrier_post((unsigned*)(ctl + CW_BAR), MISC + 8);
#ifndef PHMASK
#define PHMASK 0xff
#endif
#define IN(k) (((PHMASK >> (k)) & 1) && lo <= (k) && (k) < hi)
#define SEAM(k) do { if (IN(k) && IN((k) + 1)) xcd_barrier(bar); } while (0)
#ifndef PROBE_PHASE
#define PROBE_PHASE -1
#endif
#define PB(k) do { if (PROBE_PHASE == (k)) { if (tid == 0) { const unsigned long long t0_ = __builtin_amdgcn_s_memrealtime(); MISC[16] = (unsigned)t0_; MISC[17] = (unsigned)(t0_ >> 32); } } } while (0)
#define PE(k) do { if (PROBE_PHASE == (k)) { if (tid == 0) { const unsigned long long t0_ = ((unsigned long long)MISC[17] << 32) | MISC[16]; const unsigned long long t1_ = __builtin_amdgcn_s_memrealtime(); \
      while (__builtin_amdgcn_s_memrealtime() - t1_ < t1_ - t0_) __builtin_amdgcn_s_sleep(8); } __syncthreads(); } } while (0)

    PB(0); if (IN(0)) { p0_prologue(args, lds, vcu, G); } SEAM(0); PE(0);
    PB(1); if (IN(1)) { p1_xn(args, lds, c, G); inout_weight_copies(args, lds, vcu, G); } SEAM(1); PE(1);
    PB(2); if (IN(2)) {
        pg8::Gemm g{(const bf16_t*)(ws + WS_XN), (const bf16_t*)(ws + WS_WIN), D, nullptr};
        pg8::SchedProj S{G, c};
        pg8::EpiProj E{(bf16_t*)(ws + WS_Q), (bf16_t*)(ws + WS_K), (bf16_t*)(ws + WS_V), (bf16_t*)(ws + WS_GB), (bf16_t*)(ws + WS_U), (const float*)(ws + WS_TAB), (unsigned*)(ws + WS_CTL) + CW_KMAX};
        pg8::gemm_phase<pg8::EpiProj, pg8::SchedProj, true, true>(lds, g, S, E);
        if (c >= 128) expert_weight_copies(args, lds, c - 128, G - 128, 0, 9216);
    } SEAM(2); PE(2);
    PB(3); if (IN(3)) { if (c & 1) expert_weight_copies(args, lds, vcu, G, 9216, 24576); p3_conv_attn(args, lds, c, vcu, G); if (!(c & 1)) expert_weight_copies(args, lds, vcu, G, 9216, 24576); } SEAM(3); PE(3);
    PB(4); if (IN(4)) {
        {
            const int p = c;
#ifndef NO_P4
            pg8::Gemm g{(const bf16_t*)(ws + WS_MIXIN), (const bf16_t*)(ws + WS_WOUT), D, nullptr};
            pg8::SchedPanel S{p, 4};
            pg8::EpiBf16 E{(bf16_t*)(ws + WS_MIX), D};
            pg8::gemm_phase<pg8::EpiBf16, pg8::SchedPanel, true, true>(lds, g, S, E);
#endif
            VM_WAIT(); __syncthreads();
#ifndef NO_P5
            p5_rows(args, lds, p);
#endif
            __syncthreads();
        }
    } SEAM(4); PE(4);
    PB(5); if (IN(5)) { p6_topk(args, lds, c, G); } SEAM(5); PE(5);
    PB(6); if (IN(6)) {
#pragma unroll 1
        for (int it = 0; it < 2; ++it) {
            {
                const int item = 2 * c + it;
                const int b = item >> 4, e = item & 15;
#ifndef NO_G1
                if (it == 0) PB(8);
                {
                    pg8::Gemm g{(const bf16_t*)(ws + WS_XN + (size_t)b * T * D), (const bf16_t*)(ws + WS_WGU + (size_t)e * 2048 * D), D, (const int*)(ws + WS_IDX) + item * CAP};
                    pg8::SchedPanel S{0, 8};
                    pg8::EpiGU8 E{ws + WS_HMID + (size_t)item * CAP * D};
                    pg8::gemm_phase<pg8::EpiGU8, pg8::SchedPanel, false, true, true, true, true>(lds, g, S, E);
                }
#endif
                VM_WAIT(); __syncthreads();
                if (it == 0) { PE(8); PB(9); }
#ifndef NO_G2
                {
                    pg8::Gemm g{(const bf16_t*)(ws + WS_HMID + (size_t)item * CAP * D), (const bf16_t*)(ws + WS_WDN + (size_t)e * D * D), D, nullptr};
                    pg8::SchedPanel S{0, 4};
                    LAS float* gl = (LAS float*)(lds + LDSCTL_OFF + 4096);
                    { const int t_ = opaque_tid(); if (t_ < CAP) gl[t_] = ((const float*)(ws + WS_GATE))[item * CAP + t_] * (pg8::F8_INV * pg8::F8_Y); }
                    __syncthreads();
                    pg8::EpiDown8 E{ws + WS_Y + (size_t)item * CAP * D, gl};
                    pg8::gemm_phase<pg8::EpiDown8, pg8::SchedPanel, false, true, false, true, true>(lds, g, S, E);
                }
#endif
                VM_WAIT(); __syncthreads();
                if (it == 0) PE(9);
            }
        }
    } SEAM(6); PE(6);
    PB(7); if (IN(7)) { p8_final(args, vcu, G); } PE(7);
#undef IN
#undef SEAM
}

extern "C" void kernel_launch(void* const* d_in, const int* in_sizes, int n_in, void* d_out, int out_size, void* d_ws, size_t ws_size, hipStream_t stream) {
    static int grid = 0;
    if (grid == 0) {
        if (n_in != 22 || in_sizes[0] != M * D || out_size != M * D || ws_size < WS_END) { fprintf(stderr, "kernel_launch: unexpected shapes (n_in %d, in0 %d, out %d, ws %zu)\n", n_in, n_in > 0 ? in_sizes[0] : -1, out_size, ws_size); grid = -1; return; }
        int dev = 0, cus = 0;
        if (hipGetDevice(&dev) != hipSuccess || hipDeviceGetAttribute(&cus, hipDeviceAttributeMultiprocessorCount, dev) != hipSuccess) { grid = -1; return; }
        if (hipFuncSetAttribute((const void*)fwd_kernel, hipFuncAttributeMaxDynamicSharedMemorySize, LDS_BYTES) != hipSuccess) { fprintf(stderr, "kernel_launch: hipFuncSetAttribute failed\n"); grid = -1; return; }
        (void)hipGetLastError();
        grid = cus;
        if (grid != 256) { fprintf(stderr, "kernel_launch: this kernel needs a 256-CU device (got %d)\n", cus); grid = -1; return; }
    }
    if (grid < 0) return;
    (void)hipMemsetAsync((char*)d_ws + WS_CTL, 0, CTL_ZERO_BYTES, stream);
    Args a{};
    for (int i = 0; i < 22; ++i) a.in[i] = (const float*)d_in[i];
    a.out = (float*)d_out; a.ws = (unsigned char*)d_ws;
    constexpr int NPH = 8;
    if (MK_N_LAUNCHES == 1) { a.ph_lo = 0; a.ph_hi = NPH; hipLaunchKernelGGL(fwd_kernel, dim3(grid), dim3(NTHREADS), LDS_BYTES, stream, a); }
    else { for (int k = 0; k < NPH; ++k) { a.ph_lo = k; a.ph_hi = k + 1; hipLaunchKernelGGL(fwd_kernel, dim3(grid), dim3(NTHREADS), LDS_BYTES, stream, a); } }
}
```

```cpp
#include <hip/hip_runtime.h>
#include <cstdio>
#include <cstdint>

#ifndef MK_N_LAUNCHES
#define MK_N_LAUNCHES 1
#endif

#define LAS __attribute__((address_space(3)))
#define GAS __attribute__((address_space(1)))
typedef unsigned short bf16_t;
typedef short bf16x8 __attribute__((ext_vector_type(8)));
typedef short s16x4 __attribute__((ext_vector_type(4)));
typedef float f32x4 __attribute__((ext_vector_type(4)));
typedef float f32x16 __attribute__((ext_vector_type(16)));
typedef unsigned u32x4 __attribute__((ext_vector_type(4)));
typedef unsigned u32x2 __attribute__((ext_vector_type(2)));

constexpr int NB = 32, T = 2048, D = 1024, TC = 256, M = NB * T, MC = NB * TC, MA = M + MC, TK = TC + T;
constexpr int NE = 16, CAP = 256, NITEM = NB * NE, NPROJ = 3072, NMOD = 6 * D;
constexpr float EPS = 1e-6f;
constexpr float C2 = 0.125f * 1.4426950408889634f;
constexpr float LAM_INIT = 0.2f;
constexpr int NWAVES = 8, NTHREADS = 512;

constexpr size_t MiB = 1u << 20;
constexpr size_t WS_CTL = 0, CTL_ZERO_BYTES = 1 * MiB;
constexpr size_t WS_MODP = 2 * MiB;
constexpr size_t WS_MOD = 16 * MiB;
constexpr size_t WS_TAB = 17 * MiB;
constexpr size_t WS_WIN = 18 * MiB;
constexpr size_t WS_WOUT = 24 * MiB;
constexpr size_t WS_WGU = 26 * MiB;
constexpr size_t WS_WDN = 90 * MiB;
constexpr size_t WS_AFFT = 122 * MiB;
constexpr size_t WS_SLOT = 126 * MiB;
constexpr size_t WS_IDX = 128 * MiB;
constexpr size_t WS_GATE = 129 * MiB;
constexpr size_t WS_XN = 130 * MiB;
constexpr size_t WS_Q = 274 * MiB;
constexpr size_t WS_K = 338 * MiB;
constexpr size_t WS_V = 410 * MiB;
constexpr size_t WS_GB = 482 * MiB;
constexpr size_t WS_U = 546 * MiB;
constexpr size_t WS_MIXIN = 610 * MiB;
constexpr size_t WS_MIX = 738 * MiB;
constexpr size_t WS_HMID = 274 * MiB;
constexpr size_t WS_Y = 610 * MiB;
constexpr size_t WS_H1 = 866 * MiB;
constexpr size_t WS_END = 994 * MiB;

__device__ __forceinline__ int opaque_tid() { int t = threadIdx.x; asm volatile("" : "+v"(t)); return t; }

namespace pg8 {
constexpr int BM = 256, BK = 64, HALF = 128, HTB = HALF * BK * 2, STAGE_BYTES = 8 * HTB;
__host__ __device__ __forceinline__ int lds_byte(int r, int c) { const int st = (r >> 4) * 2 + (c >> 5), rr = r & 15, cc = c & 31, ob = rr * 64 + cc * 2; return st * 1024 + (ob ^ (((ob >> 9) & 1) << 5)); }
__host__ __device__ __forceinline__ void stage_rc(int b, int& R, int& C) { const int st = b / 1024, sb = b % 1024, swz = sb ^ (((sb >> 9) & 1) << 5); R = (st >> 1) * 16 + swz / 64; C = (st & 1) * 32 + (swz % 64) / 2; }
__host__ __device__ __forceinline__ int perm32(int rho) { const int n = rho >> 4, i = rho & 15; return 8 * (i >> 2) + 4 * n + (i & 3); }

struct Unit { int pm, pn; };
struct Gemm { const bf16_t* A; const bf16_t* Bt; int K; const int* gidx; };

typedef float f32x2_t __attribute__((ext_vector_type(2))); typedef __bf16 bf16x2_t __attribute__((ext_vector_type(2)));
__device__ __forceinline__ unsigned cvt_pk_bf16(float lo, float hi) { const f32x2_t v = {lo, hi}; const bf16x2_t b = __builtin_convertvector(v, bf16x2_t); return __builtin_bit_cast(unsigned, b); }

struct EpiBf16 {
    static constexpr bool PERM = true, AFTER_DRAIN = false;
    bf16_t* O; int ldc;
    __device__ __forceinline__ void operator()(const f32x4 (&acc)[2][2][4][2], const Unit& u, int wr, int wc, int fr, int fq) const {
        const int row0 = u.pm * BM + wr * 64 + fr; const int col0 = u.pn * BM + wc * 32 + 8 * fq;
#pragma unroll
        for (int ai = 0; ai < 2; ++ai)
#pragma unroll
            for (int m = 0; m < 4; ++m) { bf16_t* rowp = O + (size_t)(row0 + ai * HALF + m * 16) * ldc + col0;
#pragma unroll
                for (int bj = 0; bj < 2; ++bj) { const f32x4 v0 = acc[ai][bj][m][0], v1 = acc[ai][bj][m][1];
                    u32x4 w; w.x = cvt_pk_bf16(v0[0], v0[1]); w.y = cvt_pk_bf16(v0[2], v0[3]); w.z = cvt_pk_bf16(v1[0], v1[1]); w.w = cvt_pk_bf16(v1[2], v1[3]);
                    *(u32x4*)(rowp + bj * HALF) = w; } }
    }
};

struct EpiProj {
    static constexpr bool PERM = true, AFTER_DRAIN = false;
    bf16_t *Q, *KA, *VA, *GB, *U; const float* tab;
    unsigned* kmaxh;
    __device__ __forceinline__ void operator()(const f32x4 (&acc)[2][2][4][2], const Unit& u, int wr, int wc, int fr, int fq) const {
        const int pn = u.pn; const bool ctx = u.pm >= 256;
        float km[2] = {0.f, 0.f};
#pragma unroll
        for (int ai = 0; ai < 2; ++ai)
#pragma unroll
            for (int m = 0; m < 4; ++m) {
                const int row = u.pm * BM + ai * HALF + wr * 64 + m * 16 + fr;
                int t, kvrow;
                if (!ctx) { const int b = row >> 11; t = row & 2047; kvrow = b * TK + TC + t; }
                else { const int rc = row - M; const int b = rc >> 8; t = 0; kvrow = b * TK + (rc & 255); }
                if (pn < 4) {
                    f32x4 cs0 = {1.f, 0.f, 1.f, 0.f}, cs1 = cs0, cs2 = cs0, cs3 = cs0;
                    if (!ctx) { const float* tp = tab + ((size_t)t * 32 + 16 * (wc & 1) + 4 * fq) * 2;
                        cs0 = *(const f32x4*)(tp); cs1 = *(const f32x4*)(tp + 4); }
                    (void)cs2; (void)cs3;
#pragma unroll
                    for (int bj = 0; bj < 2; ++bj) {
                        const f32x4 v0 = acc[ai][bj][m][0], v1 = acc[ai][bj][m][1];
                        float e0 = v0[0], o0 = v0[1], e1 = v0[2], o1 = v0[3], e2 = v1[0], o2 = v1[1], e3 = v1[2], o3 = v1[3];
                        if (pn >= 2) {
                            float ss = ((e0 * e0 + o0 * o0) + (e1 * e1 + o1 * o1)) + ((e2 * e2 + o2 * o2) + (e3 * e3 + o3 * o3));
                            ss += __shfl_xor(ss, 16); ss += __shfl_xor(ss, 32); km[bj] = fmaxf(km[bj], ss); }
                        float r0 = e0 * cs0[0] - o0 * cs0[1], s0 = o0 * cs0[0] + e0 * cs0[1];
                        float r1 = e1 * cs0[2] - o1 * cs0[3], s1 = o1 * cs0[2] + e1 * cs0[3];
                        float r2 = e2 * cs1[0] - o2 * cs1[1], s2 = o2 * cs1[0] + e2 * cs1[1];
                        float r3 = e3 * cs1[2] - o3 * cs1[3], s3 = o3 * cs1[2] + e3 * cs1[3];
                        const float sc = (pn < 2) ? C2 : 1.f;
                        u32x4 w; w.x = cvt_pk_bf16(r0 * sc, s0 * sc); w.y = cvt_pk_bf16(r1 * sc, s1 * sc); w.z = cvt_pk_bf16(r2 * sc, s2 * sc); w.w = cvt_pk_bf16(r3 * sc, s3 * sc);
                        const int col = (pn & 1) * 256 + bj * HALF + wc * 32 + 8 * fq;
                        bf16_t* dst = (pn < 2) ? (Q + (size_t)row * 512 + col) : (KA + (size_t)kvrow * 512 + col);
                        *(u32x4*)dst = w;
                    }
                } else if (pn < 8) {
#pragma unroll
                    for (int bj = 0; bj < 2; ++bj) {
                        const f32x4 v0 = acc[ai][bj][m][0], v1 = acc[ai][bj][m][1];
                        u32x4 w; w.x = cvt_pk_bf16(v0[0], v0[1]); w.y = cvt_pk_bf16(v0[2], v0[3]); w.z = cvt_pk_bf16(v1[0], v1[1]); w.w = cvt_pk_bf16(v1[2], v1[3]);
                        const int col = (pn & 1) * 256 + bj * HALF + wc * 32 + 8 * fq;
                        bf16_t* dst = (pn < 6) ? (VA + (size_t)kvrow * 512 + col) : (GB + (size_t)row * 512 + col);
                        *(u32x4*)dst = w;
                    }
                } else {
                    const f32x4 a0 = acc[ai][0][m][0], a1 = acc[ai][0][m][1], b0 = acc[ai][1][m][0], b1 = acc[ai][1][m][1];
                    u32x4 w; w.x = cvt_pk_bf16(a0[0] * b0[0], a0[1] * b0[1]); w.y = cvt_pk_bf16(a0[2] * b0[2], a0[3] * b0[3]);
                    w.z = cvt_pk_bf16(a1[0] * b1[0], a1[1] * b1[1]); w.w = cvt_pk_bf16(a1[2] * b1[2], a1[3] * b1[3]);
                    const int col = (pn - 8) * 128 + wc * 32 + 8 * fq;
                    *(u32x4*)(U + (size_t)row * 512 + col) = w;
                }
            }
        if (pn == 2 || pn == 3) {
            const int b = ctx ? (u.pm - 256) : (u.pm >> 3);
#pragma unroll
            for (int bj = 0; bj < 2; ++bj) { float v = km[bj];
#pragma unroll
                for (int d = 1; d < 16; d <<= 1) v = fmaxf(v, __shfl_xor(v, d));
                if (fr == 0 && fq == 0) atomicMax(kmaxh + ((b * 8 + (pn & 1) * 4 + bj * 2 + (wc >> 1)) * 2 + (wc & 1)), __float_as_uint(v)); }
        }
    }
};

struct EpiGU {
    static constexpr bool PERM = true, AFTER_DRAIN = false;
    bf16_t* H;
    __device__ __forceinline__ float silu(float x) const { return x * __builtin_amdgcn_rcpf(1.f + __expf(-x)); }
    __device__ __forceinline__ void operator()(const f32x4 (&acc)[2][2][4][2], const Unit& u, int wr, int wc, int fr, int fq) const {
#pragma unroll
        for (int ai = 0; ai < 2; ++ai)
#pragma unroll
            for (int m = 0; m < 4; ++m) {
                const int row = ai * HALF + wr * 64 + m * 16 + fr;
                const f32x4 a0 = acc[ai][0][m][0], a1 = acc[ai][0][m][1], b0 = acc[ai][1][m][0], b1 = acc[ai][1][m][1];
                u32x4 w; w.x = cvt_pk_bf16(silu(a0[0]) * b0[0], silu(a0[1]) * b0[1]); w.y = cvt_pk_bf16(silu(a0[2]) * b0[2], silu(a0[3]) * b0[3]);
                w.z = cvt_pk_bf16(silu(a1[0]) * b1[0], silu(a1[1]) * b1[1]); w.w = cvt_pk_bf16(silu(a1[2]) * b1[2], silu(a1[3]) * b1[3]);
                *(u32x4*)(H + (size_t)row * 1024 + u.pn * 128 + wc * 32 + 8 * fq) = w;
            }
    }
};
__device__ __forceinline__ unsigned pk4_fp8(float a, float b, float c, float d) { int w = 0; w = __builtin_amdgcn_cvt_pk_fp8_f32(a, b, w, false); w = __builtin_amdgcn_cvt_pk_fp8_f32(c, d, w, true); return (unsigned)w; }
constexpr float F8_ACT = 4.0f, F8_WGT = 64.0f, F8_INV = 1.0f / (4.0f * 64.0f);
struct EpiGU8 {
    static constexpr bool PERM = true, AFTER_DRAIN = false;
    unsigned char* H;
    __device__ __forceinline__ float hval(float g, float u) const {
        const float e = __builtin_amdgcn_exp2f(g * (-F8_INV * 1.4426950408889634f));
        const float r = __builtin_amdgcn_rcpf(1.f + e);
        return __builtin_amdgcn_fmed3f((g * u) * (r * (F8_INV * F8_INV * F8_ACT)), -448.f, 448.f); }
    __device__ __forceinline__ void row(const f32x4 (&acc)[2][2][4][2], const Unit& u, int ai, int m, int wr, int wc, int fr, int fq) const {
        unsigned off = (unsigned)((ai * HALF + wr * 64 + m * 16 + fr) * 1024 + u.pn * 128 + wc * 32 + 8 * fq);
        asm volatile("" : "+v"(off));
        const f32x4 a0 = acc[ai][0][m][0], a1 = acc[ai][0][m][1], b0 = acc[ai][1][m][0], b1 = acc[ai][1][m][1];
        u32x2 w; w.x = pk4_fp8(hval(a0[0], b0[0]), hval(a0[1], b0[1]), hval(a0[2], b0[2]), hval(a0[3], b0[3]));
        w.y = pk4_fp8(hval(a1[0], b1[0]), hval(a1[1], b1[1]), hval(a1[2], b1[2]), hval(a1[3], b1[3]));
        *(u32x2*)(H + off) = w;
    }
    __device__ __forceinline__ void operator()(const f32x4 (&acc)[2][2][4][2], const Unit& u, int wr, int wc, int fr, int fq) const {
#pragma unroll
        for (int ai = 0; ai < 2; ++ai)
#pragma unroll
            for (int m = 0; m < 4; ++m) row(acc, u, ai, m, wr, wc, fr, fq);
    }
};
struct EpiDown {
    static constexpr bool PERM = true, AFTER_DRAIN = false;
    bf16_t* Y; const float* gate; float scale;
    __device__ __forceinline__ void operator()(const f32x4 (&acc)[2][2][4][2], const Unit& u, int wr, int wc, int fr, int fq) const {
        asm volatile("" : "+v"(fr));
#pragma unroll
        for (int ai = 0; ai < 2; ++ai)
#pragma unroll
            for (int m = 0; m < 4; ++m) {
                const int row = ai * HALF + wr * 64 + m * 16 + fr; const float g = gate[row] * scale;
#pragma unroll
                for (int bj = 0; bj < 2; ++bj) { const f32x4 v0 = acc[ai][bj][m][0] * g, v1 = acc[ai][bj][m][1] * g;
                    u32x4 w; w.x = cvt_pk_bf16(v0[0], v0[1]); w.y = cvt_pk_bf16(v0[2], v0[3]); w.z = cvt_pk_bf16(v1[0], v1[1]); w.w = cvt_pk_bf16(v1[2], v1[3]);
                    *(u32x4*)(Y + (size_t)row * 1024 + u.pn * BM + bj * HALF + wc * 32 + 8 * fq) = w; }
            }
    }
};

constexpr float F8_Y = 64.0f;
struct EpiDown8 {
    static constexpr bool PERM = true, AFTER_DRAIN = false;
    unsigned char* Y; const LAS float* gl;
    __device__ __forceinline__ void row(const f32x4 (&acc)[2][2][4][2], const Unit& u, int ai, int m, int wr, int wc, int fr, int fq) const {
        unsigned off = (unsigned)((ai * HALF + wr * 64 + m * 16 + fr) * 1024 + u.pn * BM + wc * 32 + 8 * fq);
        asm volatile("" : "+v"(off));
        const float g = gl[ai * HALF + wr * 64 + m * 16 + fr];
#pragma unroll
        for (int bj = 0; bj < 2; ++bj) { f32x4 v0 = acc[ai][bj][m][0] * g, v1 = acc[ai][bj][m][1] * g;
#pragma unroll
            for (int i = 0; i < 4; ++i) { v0[i] = __builtin_amdgcn_fmed3f(v0[i], -448.f, 448.f); v1[i] = __builtin_amdgcn_fmed3f(v1[i], -448.f, 448.f); }
            u32x2 w; w.x = pk4_fp8(v0[0], v0[1], v0[2], v0[3]); w.y = pk4_fp8(v1[0], v1[1], v1[2], v1[3]);
            *(u32x2*)(Y + off + bj * HALF) = w; }
    }
    __device__ __forceinline__ void operator()(const f32x4 (&acc)[2][2][4][2], const Unit& u, int wr, int wc, int fr, int fq) const {
#pragma unroll
        for (int ai = 0; ai < 2; ++ai)
#pragma unroll
            for (int m = 0; m < 4; ++m) row(acc, u, ai, m, wr, wc, fr, fq);
    }
};

struct SchedProj {
    int G, c;
    __device__ __forceinline__ bool next(int i, Unit& u) const {
        if (i < 12) { const int x = c & 7, j = c >> 3, ja = j & 7, jb = j >> 3, r = i / 3, q = i - 3 * r;
            u.pm = x + 8 * (8 * r + ja); u.pn = 4 * q + jb; return true; }
        if (i == 12 && c < 128) { u.pm = 256 + (c >> 2); u.pn = 2 + (c & 3); return true; }
        return false;
    }
    __device__ __forceinline__ void a_ready(const Unit&) const {}
    __device__ __forceinline__ void done(const Unit&) const {}
};
struct SchedPanel {
    int pm, ntn;
    __device__ __forceinline__ bool next(int i, Unit& u) const { if (i >= ntn) return false; u.pm = pm; u.pn = i; return true; }
    __device__ __forceinline__ void a_ready(const Unit&) const {}
    __device__ __forceinline__ void done(const Unit&) const {}
};

typedef int i32x4v __attribute__((ext_vector_type(4)));
typedef int i32x8v __attribute__((ext_vector_type(8)));
__device__ __forceinline__ i32x8v cat8(bf16x8 a, bf16x8 b) { const i32x4v x = __builtin_bit_cast(i32x4v, a), y = __builtin_bit_cast(i32x4v, b); return __builtin_shufflevector(x, y, 0, 1, 2, 3, 4, 5, 6, 7); }
template <bool F8> struct Frag;
template <> struct Frag<false> { bf16x8 v[2]; __device__ __forceinline__ void set(bf16x8 a, bf16x8 b) { v[0] = a; v[1] = b; } };
template <> struct Frag<true> { i32x8v v; __device__ __forceinline__ void set(bf16x8 a, bf16x8 b) { v = cat8(a, b); } };
__device__ __forceinline__ f32x4 frag_mma(const Frag<false>& b, const Frag<false>& a, f32x4 c) { c = __builtin_amdgcn_mfma_f32_16x16x32_bf16(b.v[0], a.v[0], c, 0, 0, 0); return __builtin_amdgcn_mfma_f32_16x16x32_bf16(b.v[1], a.v[1], c, 0, 0, 0); }
__device__ __forceinline__ f32x4 frag_mma(const Frag<true>& b, const Frag<true>& a, f32x4 c) {
    const int sc1 = 0x7f7f7f7f;
    asm volatile("s_nop 1\n\tv_mfma_scale_f32_16x16x128_f8f6f4 %0, %1, %2, %0, %3, %3 op_sel_hi:[0,0,0]" : "+v"(c) : "v"(b.v), "v"(a.v), "v"(sc1));
    return c; }
template <class Epi, class Sched, bool ALIGN_EPI, bool SP2, bool GATHER = false, bool F8 = false, bool DEFER = false>
__device__ __forceinline__ void gemm_phase(LAS unsigned char* lds, const Gemm g, const Sched& S, const Epi& E) {
    const int tid = opaque_tid(), wid = __builtin_amdgcn_readfirstlane(tid >> 6), lane = tid & 63, wr = wid >> 2, wc = wid & 3, fr = lane & 15, fq = lane >> 4;
    const int K = g.K * (F8 ? 1 : 2), nt = K / 128;
    unsigned voffA[2][2], voffB[2];
#pragma unroll
    for (int i = 0; i < 2; ++i) { int R, C; stage_rc(tid * 16 + i * 8192, R, C); const int Rb = Epi::PERM ? ((R & ~31) + perm32(R & 31)) : R;
        if constexpr (GATHER) { voffA[0][i] = (unsigned)(g.gidx[R] * K + C * 2); voffA[1][i] = (unsigned)(g.gidx[HALF + R] * K + C * 2); }
        else { voffA[0][i] = (unsigned)(R * K + C * 2); voffA[1][i] = voffA[0][i]; }
        voffB[i] = (unsigned)(Rb * K + C * 2); }
    const size_t kstep = (size_t)(BK * 2);
    const size_t hstep = (size_t)HALF * K;
    const size_t hstepA = GATHER ? (size_t)0 : hstep;
    const size_t tstep = 2 * hstep;
    const unsigned ldsw = (unsigned)wid * 1024u;
    const int aoff = F8 ? lds_byte(wr * 64 + fr, (fq >> 1) * 32 + (fq & 1) * 16) : lds_byte(wr * 64 + fr, fq * 8), boff = F8 ? lds_byte(wc * 32 + fr, (fq >> 1) * 32 + (fq & 1) * 16) : lds_byte(wc * 32 + fr, fq * 8);
    const int aoff1 = F8 ? aoff + 16 : aoff + 1024, boff1 = F8 ? boff + 16 : boff + 1024;
#define PG8_SA(b, h) (((b) * 2 + (h)) * HTB)
#define PG8_SB(b, h) ((4 + (b) * 2 + (h)) * HTB)
#define PG8_STAGE(bufoff, gbase, voff) do { _Pragma("unroll") for (int _i = 0; _i < 2; ++_i) \
        __builtin_amdgcn_global_load_lds((const unsigned*)((const char*)(gbase) + (voff)[_i]), (LAS unsigned*)(lds + (bufoff) + ldsw + _i * 8192), 16, 0, 0); } while (0)
#define PG8_LDA(dst, b, h) do { _Pragma("unroll") for (int m = 0; m < 4; ++m) dst[m].set(*(const LAS bf16x8*)(lds + PG8_SA(b, h) + aoff + m * 2048), *(const LAS bf16x8*)(lds + PG8_SA(b, h) + aoff1 + m * 2048)); } while (0)
#define PG8_LDB(dst, b, h) do { _Pragma("unroll") for (int n = 0; n < 2; ++n) dst[n].set(*(const LAS bf16x8*)(lds + PG8_SB(b, h) + boff + n * 2048), *(const LAS bf16x8*)(lds + PG8_SB(b, h) + boff1 + n * 2048)); } while (0)
#define PG8_MMA(ai, bj, At, Bt) do { __builtin_amdgcn_s_setprio(1); _Pragma("unroll") for (int m = 0; m < 4; ++m) _Pragma("unroll") for (int n = 0; n < 2; ++n) \
        acc[ai][bj][m][n] = frag_mma(Bt[n], At[m], acc[ai][bj][m][n]); __builtin_amdgcn_s_setprio(0); } while (0)
#define PG8_MMA_E(ai, At, Bt) do { __builtin_amdgcn_s_setprio(1); _Pragma("unroll") for (int m = 0; m < 4; ++m) { \
        if constexpr (DEFER) { if (defer_now) { E.row(acc, pu, ai, m, wr, wc, fr, fq); \
            _Pragma("unroll") for (int n = 0; n < 2; ++n) { acc[ai][0][m][n] = (f32x4){0.f, 0.f, 0.f, 0.f}; acc[ai][1][m][n] = (f32x4){0.f, 0.f, 0.f, 0.f}; } } PG8_SCHED; } \
        _Pragma("unroll") for (int n = 0; n < 2; ++n) acc[ai][0][m][n] = frag_mma(Bt[n], At[m], acc[ai][0][m][n]); } __builtin_amdgcn_s_setprio(0); } while (0)
#define PG8_WAIT_V(n) asm volatile("s_waitcnt vmcnt(" #n ")" ::: "memory")
#define PG8_WAIT_L(n) asm volatile("s_waitcnt lgkmcnt(" #n ")" ::: "memory")
#define PG8_BAR __builtin_amdgcn_s_barrier()
#define PG8_SCHED __builtin_amdgcn_sched_barrier(0)
    Unit cur, nxt; int ui = 0;
    if (!S.next(0, cur)) return;
    f32x4 acc[2][2][4][2];
#pragma unroll
    for (int a = 0; a < 2; ++a)
#pragma unroll
        for (int b = 0; b < 2; ++b)
#pragma unroll
            for (int m = 0; m < 4; ++m)
#pragma unroll
                for (int n = 0; n < 2; ++n) acc[a][b][m][n] = (f32x4){0.f, 0.f, 0.f, 0.f};
    Frag<F8> At[4], B0[2], B1[2];
    bool pend = false; Unit pu = cur;
    const char* cA = (const char*)g.A + (size_t)cur.pm * tstep; const char* cB = (const char*)g.Bt + (size_t)cur.pn * tstep;
    S.a_ready(cur);
    if constexpr (SP2) {
        PG8_STAGE(PG8_SB(0, 0), cB, voffB); PG8_STAGE(PG8_SB(0, 1), cB + hstep, voffB); PG8_STAGE(PG8_SA(0, 0), cA, voffA[0]); PG8_STAGE(PG8_SA(0, 1), cA + hstepA, voffA[GATHER ? 1 : 0]);
        if (wr == 1) PG8_BAR;
        PG8_WAIT_V(2); PG8_BAR;
        PG8_STAGE(PG8_SB(1, 0), cB + kstep, voffB); PG8_STAGE(PG8_SA(1, 0), cA + kstep, voffA[0]); PG8_STAGE(PG8_SB(1, 1), cB + hstep + kstep, voffB);
        PG8_WAIT_V(6); PG8_BAR;
    } else {
        PG8_STAGE(PG8_SB(0, 0), cB, voffB); PG8_STAGE(PG8_SA(0, 0), cA, voffA[0]); PG8_STAGE(PG8_SB(0, 1), cB + hstep, voffB); PG8_STAGE(PG8_SA(0, 1), cA + hstepA, voffA[GATHER ? 1 : 0]);
        if (wr == 1) PG8_BAR;
        PG8_WAIT_V(4); PG8_BAR;
        PG8_STAGE(PG8_SB(1, 0), cB + kstep, voffB); PG8_STAGE(PG8_SA(1, 0), cA + kstep, voffA[0]); PG8_STAGE(PG8_SB(1, 1), cB + hstep + kstep, voffB);
        PG8_WAIT_V(6); PG8_BAR;
    }
    for (;;) {
        const bool has_next = S.next(ui + 1, nxt);
        const char* nA = has_next ? (const char*)g.A + (size_t)nxt.pm * tstep : cA; const char* nB = has_next ? (const char*)g.Bt + (size_t)nxt.pn * tstep : cB;
#pragma unroll 1
        for (int t = 0; t < nt; t += 2) {
            const bool last = (t == nt - 2);
            if constexpr (F8) { asm volatile("" : "+v"(voffA[0][0]), "+v"(voffA[0][1]), "+v"(voffB[0]), "+v"(voffB[1])); if constexpr (GATHER) asm volatile("" : "+v"(voffA[1][0]), "+v"(voffA[1][1])); }
            const char* a1 = cA + (size_t)(t + 1) * kstep;
            const char* a2 = last ? nA : cA + (size_t)(t + 2) * kstep; const char* b2 = last ? nB : cB + (size_t)(t + 2) * kstep;
            const char* a3 = a2 + kstep; const char* b3 = b2 + kstep;
            if (last && has_next) S.a_ready(nxt);
            if constexpr (SP2) {
            PG8_LDB(B0, 0, 0); PG8_LDB(B1, 0, 1); PG8_SCHED; PG8_LDA(At, 0, 0); PG8_STAGE(PG8_SA(1, 1), a1 + hstepA, voffA[GATHER ? 1 : 0]);
            bool defer_now = false; if constexpr (DEFER) defer_now = pend && t == 0;
            PG8_WAIT_V(8); PG8_WAIT_L(0); PG8_BAR; PG8_MMA_E(0, At, B0); PG8_MMA(0, 1, At, B1); PG8_BAR; PG8_SCHED;
            PG8_LDA(At, 0, 1); PG8_STAGE(PG8_SB(0, 0), b2, voffB); PG8_STAGE(PG8_SB(0, 1), b2 + hstep, voffB); PG8_STAGE(PG8_SA(0, 0), a2, voffA[0]);
            PG8_WAIT_V(8); PG8_WAIT_L(0); PG8_BAR; PG8_MMA_E(1, At, B0); PG8_MMA(1, 1, At, B1); PG8_BAR; PG8_SCHED;
            PG8_LDB(B0, 1, 0); PG8_LDB(B1, 1, 1); PG8_SCHED; PG8_LDA(At, 1, 0); PG8_STAGE(PG8_SA(0, 1), a2 + hstepA, voffA[GATHER ? 1 : 0]);
            PG8_WAIT_V(8); PG8_WAIT_L(0); PG8_BAR; PG8_MMA(0, 0, At, B0); PG8_MMA(0, 1, At, B1); PG8_BAR; PG8_SCHED;
            PG8_LDA(At, 1, 1); PG8_STAGE(PG8_SB(1, 0), b3, voffB); PG8_STAGE(PG8_SB(1, 1), b3 + hstep, voffB); PG8_STAGE(PG8_SA(1, 0), a3, voffA[0]);
            PG8_WAIT_V(8); PG8_WAIT_L(0); PG8_BAR; PG8_MMA(1, 0, At, B0); PG8_MMA(1, 1, At, B1); PG8_BAR; PG8_SCHED;
            } else {
            PG8_LDB(B0, 0, 0); PG8_SCHED; PG8_LDA(At, 0, 0); PG8_STAGE(PG8_SA(1, 1), a1 + hstepA, voffA[GATHER ? 1 : 0]);
            PG8_WAIT_L(8); PG8_BAR; PG8_WAIT_L(0); PG8_MMA(0, 0, At, B0); PG8_BAR; PG8_SCHED;
            PG8_LDB(B1, 0, 1); PG8_STAGE(PG8_SB(0, 0), b2, voffB);
            PG8_BAR; PG8_WAIT_L(0); PG8_MMA(0, 1, At, B1); PG8_BAR;
            PG8_LDA(At, 0, 1); PG8_STAGE(PG8_SA(0, 0), a2, voffA[0]);
            PG8_BAR; PG8_WAIT_L(0); PG8_MMA(1, 0, At, B0); PG8_BAR; PG8_SCHED;
            PG8_STAGE(PG8_SB(0, 1), b2 + hstep, voffB);
            PG8_WAIT_V(6); PG8_BAR; PG8_MMA(1, 1, At, B1); PG8_BAR;
            PG8_LDB(B0, 1, 0); PG8_SCHED; PG8_LDA(At, 1, 0); PG8_STAGE(PG8_SA(0, 1), a2 + hstepA, voffA[GATHER ? 1 : 0]);
            PG8_WAIT_L(8); PG8_BAR; PG8_WAIT_L(0); PG8_MMA(0, 0, At, B0); PG8_BAR; PG8_SCHED;
            PG8_LDB(B1, 1, 1); PG8_STAGE(PG8_SB(1, 0), b3, voffB);
            PG8_BAR; PG8_WAIT_L(0); PG8_MMA(0, 1, At, B1); PG8_BAR;
            PG8_LDA(At, 1, 1); PG8_STAGE(PG8_SA(1, 0), a3, voffA[0]);
            PG8_BAR; PG8_WAIT_L(0); PG8_MMA(1, 0, At, B0); PG8_BAR; PG8_SCHED;
            PG8_STAGE(PG8_SB(1, 1), b3 + hstep, voffB);
            PG8_WAIT_V(6); PG8_BAR; PG8_MMA(1, 1, At, B1); PG8_BAR;
            }
        }
        if (DEFER && has_next) { pend = true; pu = cur; cur = nxt; cA = nA; cB = nB; ++ui; continue; }
        if constexpr (ALIGN_EPI) { if (wr == 0) PG8_BAR; }
        if constexpr (F8) asm volatile("s_nop 15\n\ts_nop 7" ::: "memory");
        E(acc, cur, wr, wc, fr, fq); S.done(cur);
        if (!has_next) break;
#pragma unroll
        for (int a = 0; a < 2; ++a)
#pragma unroll
            for (int b = 0; b < 2; ++b)
#pragma unroll
                for (int m = 0; m < 4; ++m)
#pragma unroll
                    for (int n = 0; n < 2; ++n) acc[a][b][m][n] = (f32x4){0.f, 0.f, 0.f, 0.f};
        cur = nxt; cA = nA; cB = nB; ++ui;
        if constexpr (ALIGN_EPI) { if (wr == 1) PG8_BAR; }
    }
    PG8_WAIT_V(0);
    if constexpr (!ALIGN_EPI) { if (wr == 0) PG8_BAR; }
    PG8_BAR;
#undef PG8_SA
#undef PG8_SB
#undef PG8_STAGE
#undef PG8_LDA
#undef PG8_LDB
#undef PG8_MMA
#undef PG8_WAIT_V
#undef PG8_WAIT_L
#undef PG8_BAR
#undef PG8_SCHED
}
}

typedef GAS unsigned gu32;
#define RLX_AGENT __ATOMIC_RELAXED, __HIP_MEMORY_SCOPE_AGENT
#define LDS_WAIT() asm volatile("s_waitcnt lgkmcnt(0)" ::: "memory")
#define VM_WAIT() asm volatile("s_waitcnt vmcnt(0)" ::: "memory")
__device__ __forceinline__ unsigned pk2(float lo, float hi) { return pg8::cvt_pk_bf16(lo, hi); }
__device__ __forceinline__ float bf2f(unsigned short h) { return __uint_as_float((unsigned)h << 16); }
__device__ __forceinline__ float bflo(unsigned w) { return __uint_as_float(w << 16); }
__device__ __forceinline__ float bfhi(unsigned w) { return __uint_as_float(w & 0xffff0000u); }
__device__ __forceinline__ float wave_sum(float v) {
    v += __builtin_bit_cast(float, __builtin_amdgcn_update_dpp(0, __builtin_bit_cast(int, v), 0xB1, 0xf, 0xf, true));
    v += __builtin_bit_cast(float, __builtin_amdgcn_update_dpp(0, __builtin_bit_cast(int, v), 0x4E, 0xf, 0xf, true));
    v += __builtin_bit_cast(float, __builtin_amdgcn_update_dpp(0, __builtin_bit_cast(int, v), 0x141, 0xf, 0xf, true));
    v += __builtin_bit_cast(float, __builtin_amdgcn_update_dpp(0, __builtin_bit_cast(int, v), 0x140, 0xf, 0xf, true));
    v += __builtin_bit_cast(float, __builtin_amdgcn_update_dpp(0, __builtin_bit_cast(int, v), 0x142, 0xa, 0xf, false));
    v += __builtin_bit_cast(float, __builtin_amdgcn_update_dpp(0, __builtin_bit_cast(int, v), 0x143, 0xc, 0xf, false));
    return __builtin_bit_cast(float, __builtin_amdgcn_readlane(__builtin_bit_cast(int, v), 63));
}

#define XB_TMO      128
#define XB_XCNT(j)  (256  + 64 * (j))
#define XB_XSUB(j)  (1280 + 64 * (j))
#define XB_XGEN(j)  (2304 + 64 * (j))
#define XB_TOP      3328
#define XB_TOPGEN   3392
#define XCD_BAR_WORDS 3456
#define XB_SPIN_CAP (1u << 18)
__device__ __forceinline__ unsigned xb_ld(unsigned* p)              { return __hip_atomic_load(p, __ATOMIC_RELAXED, __HIP_MEMORY_SCOPE_AGENT); }
__device__ __forceinline__ unsigned xb_add(unsigned* p, unsigned v) { return __hip_atomic_fetch_add(p, v, __ATOMIC_RELAXED, __HIP_MEMORY_SCOPE_AGENT); }
__device__ __forceinline__ unsigned xb_xcc_id() { return (unsigned)__builtin_amdgcn_s_getreg((3 << 11) | 20) & 0xFu; }
#define XB_SPIN(cond, bar) do { unsigned _sp = 0; while (cond) { __builtin_amdgcn_s_sleep(1); \
    if ((++_sp & 255u) == 0u) { if (xb_ld(&(bar)[XB_TMO])) break; if (_sp > XB_SPIN_CAP) { atomicAdd(&(bar)[XB_TMO], 1u); break; } } } } while (0)
struct XcdBarrier { unsigned* bar; unsigned x; volatile LAS unsigned* st; };
__device__ __forceinline__ XcdBarrier xcd_barrier_post(unsigned* bar, volatile LAS unsigned* st) {
    XcdBarrier b; b.bar = bar; b.x = xb_xcc_id(); b.st = st;
    if (threadIdx.x == 0) (void)xb_add(&bar[XB_XCNT(b.x)], 1u);
    return b;
}
__device__ __forceinline__ void xcd_barrier_complete(unsigned* bar, unsigned x, unsigned& nloc, unsigned& nx) {
    const unsigned G = gridDim.x * gridDim.y * gridDim.z;
    unsigned sum, cnt, mine, sp = 0u;
    for (;;) {
        sum = 0u; cnt = 0u; mine = 0u;
#pragma unroll
        for (unsigned j = 0; j < 16; ++j) { const unsigned c = xb_ld(&bar[XB_XCNT(j)]); sum += c; cnt += (c > 0u) ? 1u : 0u; mine = (j == x) ? c : mine; }
        if (sum == G) break;
        __builtin_amdgcn_s_sleep(1);
        if ((++sp & 255u) == 0u) { if (xb_ld(&bar[XB_TMO])) break; if (sp > XB_SPIN_CAP) { atomicAdd(&bar[XB_TMO], 1u); break; } }
    }
    nloc = mine > 0u ? mine : 1u; nx = cnt > 0u ? cnt : 1u;
}
__device__ __forceinline__ void xcd_barrier(const XcdBarrier& b) {
    asm volatile("s_waitcnt vmcnt(0)" ::: "memory");
    __syncthreads();
    if (threadIdx.x == 0) {
        unsigned* bar = b.bar;
        __builtin_amdgcn_s_waitcnt(0);
        unsigned nloc = b.st[0], nx = b.st[1];
        if (nloc == 0u) { xcd_barrier_complete(bar, b.x, nloc, nx); b.st[0] = nloc; b.st[1] = nx; }
        const unsigned old = xb_add(&bar[XB_XSUB(b.x)], 1u);
        const unsigned gen = old / nloc;
        if (old + 1u == (gen + 1u) * nloc) {
            __builtin_amdgcn_fence(__ATOMIC_RELEASE, "agent");
            asm volatile("s_waitcnt vmcnt(0)" ::: "memory");
            const unsigned og = xb_add(&bar[XB_TOP], 1u);
            const unsigned tg = og / nx;
            if (og + 1u == (tg + 1u) * nx) xb_add(&bar[XB_TOPGEN], 1u);
            else XB_SPIN(xb_ld(&bar[XB_TOPGEN]) == tg, bar);
            __builtin_amdgcn_fence(__ATOMIC_ACQUIRE, "agent");
            xb_add(&bar[XB_XGEN(b.x)], 1u);
            asm volatile("s_waitcnt vmcnt(0)" ::: "memory");
        } else {
            XB_SPIN(xb_ld(&bar[XB_XGEN(b.x)]) == gen, bar);
            __builtin_amdgcn_fence(__ATOMIC_ACQUIRE, "agent");
            asm volatile("s_waitcnt vmcnt(0)" ::: "memory");
        }
    }
    __syncthreads();
}

constexpr int RING_BYTES = 131072;
constexpr int LDSCTL_OFF = RING_BYTES, MISC_OFF = LDSCTL_OFF + 320;
constexpr int LDS_BYTES = 147456;
constexpr int CW_BAR = 4096;
constexpr int CW_KMAX = 65536;

struct Args { const float* in[22]; float* out; unsigned char* ws; int ph_lo, ph_hi; };
enum { I_X = 0, I_C, I_CTX, I_CCTX, I_WADA, I_BADA, I_NPRE_MIX, I_NPOST_MIX, I_NPRE_FFN, I_NPOST_FFN, I_WIN, I_CONVW, I_LQ1, I_LK1, I_LQ2, I_LK2, I_SUBLN, I_WOUT, I_WROUTER, I_WGATE, I_WUP, I_WDOWN };

__device__ __forceinline__ int win_dest(int n) {
    if (n < 1024) { const int j = n & 63; const int p = ((j >> 5) << 5) + ((j & 15) << 1) + ((j >> 4) & 1); return (n & ~63) + p; }
    if (n < 1536) { const int dv = n & 127; return (n & ~127) + ((dv & 3) << 5) + (dv >> 2); }
    if (n < 2048) return n;
    int c = n - 2048; const int isx = c >= 512; c &= 511; return 2048 + ((c >> 7) << 8) + (isx << 7) + (c & 127);
}
template <int MODE>
__device__ __forceinline__ int tr_dest(int n) {
    if (MODE == 0) return n;
    if (MODE == 1) return win_dest(n);
    if (MODE == 2) return ((n >> 7) << 8) + (n & 127);
    return ((n >> 7) << 8) + 128 + (n & 127);
}
template <int MODE>
__device__ __forceinline__ void p0_transpose_item_f8(const float* W, int K, int N, unsigned char* WT, LAS float* scr, int item, int lane) {
    const int nblk = N / 32, kb = item / nblk, nb = item % nblk, k0 = 64 * kb, n0 = 32 * nb;
#pragma unroll 8
    for (int i = 0; i < 32; ++i) { const int kk = 2 * i + (lane >> 5); scr[kk * 33 + (lane & 31)] = __builtin_nontemporal_load(W + (size_t)(k0 + kk) * N + n0 + (lane & 31)) * pg8::F8_WGT; }
    LDS_WAIT(); asm volatile("" ::: "memory");
    const int c = lane & 7;
#pragma unroll
    for (int j = 0; j < 4; ++j) { const int n = (lane >> 3) + 8 * j; const LAS float* s = scr + (8 * c) * 33 + n;
        u32x2 o; o.x = pg8::pk4_fp8(s[0 * 33], s[1 * 33], s[2 * 33], s[3 * 33]); o.y = pg8::pk4_fp8(s[4 * 33], s[5 * 33], s[6 * 33], s[7 * 33]);
        *(GAS u32x2*)(WT + (size_t)tr_dest<MODE>(n0 + n) * K + k0 + 8 * c) = o; }
    LDS_WAIT(); asm volatile("" ::: "memory");
}
template <int MODE>
__device__ __forceinline__ void p0_transpose_item(const float* W, int K, int N, bf16_t* WT, LAS float* scr, int item, int lane) {
    const int nblk = N / 32, kb = item / nblk, nb = item % nblk, k0 = 64 * kb, n0 = 32 * nb;
#pragma unroll 8
    for (int i = 0; i < 32; ++i) { const int kk = 2 * i + (lane >> 5); scr[kk * 33 + (lane & 31)] = W[(size_t)(k0 + kk) * N + n0 + (lane & 31)]; }
    LDS_WAIT(); asm volatile("" ::: "memory");
    const int c = lane & 7;
#pragma unroll
    for (int j = 0; j < 4; ++j) { const int n = (lane >> 3) + 8 * j; const LAS float* s = scr + (8 * c) * 33 + n;
        u32x4 o; o.x = pk2(s[0 * 33], s[1 * 33]); o.y = pk2(s[2 * 33], s[3 * 33]); o.z = pk2(s[4 * 33], s[5 * 33]); o.w = pk2(s[6 * 33], s[7 * 33]);
        *(GAS u32x4*)(WT + (size_t)tr_dest<MODE>(n0 + n) * K + k0 + 8 * c) = o; }
    LDS_WAIT(); asm volatile("" ::: "memory");
}

__device__ __forceinline__ void p0_prologue(const Args& a, LAS unsigned char* lds, int vcu, int G) {
    const int tid = opaque_tid(), lane = tid & 63, wave = __builtin_amdgcn_readfirstlane(tid >> 6);
    LAS float* scr = (LAS float*)(lds + wave * 16384);
    const int gw = vcu * NWAVES + wave, NGW = G * NWAVES;
    unsigned char* ws = a.ws;
    if (gw < 96 * 16) {
        float* MODP = (float*)(ws + WS_MODP);
        const float* wada = a.in[I_WADA];
        for (int it = gw; it < 96 * 16; it += NGW) {
            const int cg = it % 96, kc = it / 96;
            for (int b = 0; b < 33; ++b) { const float v = (b < 32) ? a.in[I_C][b * D + kc * 64 + lane] : a.in[I_CCTX][kc * 64 + lane]; scr[b * 64 + lane] = v / (1.f + __expf(-v)); }
            LDS_WAIT(); asm volatile("" ::: "memory");
            float acc[33];
#pragma unroll
            for (int b = 0; b < 33; ++b) acc[b] = 0.f;
            const float* wp = wada + (size_t)(kc * 64) * NMOD + cg * 64 + lane;
#pragma unroll 2
            for (int k = 0; k < 64; k += 4) {
                const float w0 = __builtin_nontemporal_load(wp + (size_t)(k + 0) * NMOD), w1 = __builtin_nontemporal_load(wp + (size_t)(k + 1) * NMOD),
                            w2 = __builtin_nontemporal_load(wp + (size_t)(k + 2) * NMOD), w3 = __builtin_nontemporal_load(wp + (size_t)(k + 3) * NMOD);
#pragma unroll
                for (int b = 0; b < 33; ++b) { const f32x4 sv4 = *(const LAS f32x4*)(scr + b * 64 + k); acc[b] += (sv4.x * w0 + sv4.y * w1) + (sv4.z * w2 + sv4.w * w3); }
            }
#pragma unroll
            for (int b = 0; b < 33; ++b) MODP[((size_t)kc * 33 + b) * NMOD + cg * 64 + lane] = acc[b];
            LDS_WAIT(); asm volatile("" ::: "memory");
        }
    } else {
        float* tab = (float*)(ws + WS_TAB);
        const int nw = NGW - 96 * 16;
        for (int e = (gw - 96 * 16) * 64 + lane; e < T * 32; e += nw * 64) {
            const int t = e >> 5, i = e & 31;
            const float inv = powf(10000.0f, -(float)(2 * (i & 15)) / 32.0f);
            const float pos = (i < 16) ? (float)(t >> 6) : (float)(t & 63);
            const float ang = pos * inv;
            tab[2 * e] = cosf(ang); tab[2 * e + 1] = sinf(ang);
        }
    }
}
__device__ __forceinline__ void inout_weight_copies(const Args& a, LAS unsigned char* lds, int vcu, int G) {
    const int tid = opaque_tid(), lane = tid & 63, wave = __builtin_amdgcn_readfirstlane(tid >> 6);
    LAS float* scr = (LAS float*)(lds + 16384 + wave * 12288);
    const int gw = vcu * NWAVES + wave, NGW = G * NWAVES;
    unsigned char* ws = a.ws;
    constexpr int I_IN = (D / 64) * (NPROJ / 32), I_OUT = (D / 64) * (D / 32);
    constexpr int NITEMS = I_IN + I_OUT;
    bf16_t* Win_t = (bf16_t*)(ws + WS_WIN); bf16_t* Wout_t = (bf16_t*)(ws + WS_WOUT);
    for (int it = gw; it < NITEMS; it += NGW) {
        int r = it;
        if (r < I_IN) { p0_transpose_item<1>(a.in[I_WIN], D, NPROJ, Win_t, scr, r, lane); continue; } r -= I_IN;
        p0_transpose_item<0>(a.in[I_WOUT], D, D, Wout_t, scr, r, lane);
    }
}
__device__ __forceinline__ void expert_weight_copies(const Args& a, LAS unsigned char* lds, int gw0  , int ngroups, int r_lo, int r_hi) {
    const int tid = opaque_tid(), lane = tid & 63, wave = __builtin_amdgcn_readfirstlane(tid >> 6);
    LAS float* scr = (LAS float*)(lds + wave * 16384);
    const int gw = gw0 * NWAVES + wave, NGW = ngroups * NWAVES;
    unsigned char* ws = a.ws;
    constexpr int I_EXP = (D / 64) * (D / 32);
    unsigned char* Wgu_t = ws + WS_WGU; unsigned char* Wdn_t = ws + WS_WDN;
    for (int r = r_lo + gw; r < r_hi; r += NGW) {
        const int e = r / (3 * I_EXP), q = (r % (3 * I_EXP)) / I_EXP, rr = r % I_EXP;
        if (q == 0) p0_transpose_item_f8<2>(a.in[I_WGATE] + (size_t)e * D * D, D, D, Wgu_t + (size_t)e * 2048 * D, scr, rr, lane);
        else if (q == 1) p0_transpose_item_f8<3>(a.in[I_WUP] + (size_t)e * D * D, D, D, Wgu_t + (size_t)e * 2048 * D, scr, rr, lane);
        else p0_transpose_item_f8<0>(a.in[I_WDOWN] + (size_t)e * D * D, D, D, Wdn_t + (size_t)e * D * D, scr, rr, lane);
    }
    __syncthreads();
}

struct RowF { f32x4 v[4]; };
__device__ __forceinline__ void row_load(RowF& r, const float* xrow, int lane) {
    const f32x4* xr = (const f32x4*)xrow + lane;
#pragma unroll
    for (int j = 0; j < 4; ++j) r.v[j] = __builtin_nontemporal_load(xr + 64 * j);
}
__device__ __forceinline__ void norm_mod_row(const RowF& r, bf16_t* orow, const float* gain, const LAS float* sc, const LAS float* sh, int lane) {
    const f32x4* gr = (const f32x4*)gain + lane;
    float s = 0.f;
#pragma unroll
    for (int j = 0; j < 4; ++j) s += (r.v[j].x * r.v[j].x + r.v[j].y * r.v[j].y) + (r.v[j].z * r.v[j].z + r.v[j].w * r.v[j].w);
    const float rstd = 1.0f / sqrtf(wave_sum(s) * (1.f / D) + EPS);
    u32x2* o8 = (u32x2*)orow + lane;
#pragma unroll
    for (int j = 0; j < 4; ++j) { const f32x4 g = gr[64 * j]; const f32x4 c1 = *(const LAS f32x4*)(sc + 4 * lane + 256 * j), h1 = *(const LAS f32x4*)(sh + 4 * lane + 256 * j);
        const f32x4 y = (r.v[j] * rstd) * g; const f32x4 z = y * (c1 + 1.0f) + h1;
        u32x2 w; w.x = pk2(z.x, z.y); w.y = pk2(z.z, z.w); o8[64 * j] = w; }
}
__device__ __forceinline__ void p1_xn(const Args& a, LAS unsigned char* lds, int c, int G) {
    const int tid = opaque_tid(), lane = tid & 63, wave = __builtin_amdgcn_readfirstlane(tid >> 6);
    unsigned char* ws = a.ws;
    const float* MODP = (const float*)(ws + WS_MODP); float* MOD = (float*)(ws + WS_MOD); const float* bada = a.in[I_BADA];
    { const int per = (33 * NMOD + G - 1) / G;
      for (int i = c * per + tid; i < (c + 1) * per && i < 33 * NMOD; i += NTHREADS) { const int r = i / NMOD, n = i - r * NMOD; float s = bada[n];
#pragma unroll
            for (int kc = 0; kc < 16; ++kc) s += MODP[((size_t)kc * 33 + r) * NMOD + n];
            MOD[i] = s; } }
    LAS float* sv = (LAS float*)lds;
    bf16_t* XN = (bf16_t*)(ws + WS_XN);
    const float* X = a.in[I_X]; const float* CTX = a.in[I_CTX]; const float* gain = a.in[I_NPRE_MIX];
    for (int p = c; p < 256; p += G) {
        const int b = p >> 3;
        const int rbase = p * 256 + wave * 32;
        RowF a0, a1, a2, a3;
        row_load(a0, X + (size_t)rbase * D, lane); row_load(a1, X + (size_t)(rbase + 1) * D, lane); row_load(a2, X + (size_t)(rbase + 2) * D, lane); row_load(a3, X + (size_t)(rbase + 3) * D, lane);
        __syncthreads();
        for (int n = tid; n < 4096; n += NTHREADS) { const int r = (n < 2048) ? b : 32; const int col = n & 2047; float s = bada[col];
#pragma unroll
            for (int kc = 0; kc < 16; ++kc) s += MODP[((size_t)kc * 33 + r) * NMOD + col];
            sv[n] = s; }
        __syncthreads();
        const int crow = p * 32 + wave * 4;
        for (int i = 0; i < 8; ++i) {
            RowF n0, n1, n2, n3;
            const float* nx = (i + 1 < 8) ? X + (size_t)(rbase + 4 * (i + 1)) * D : CTX + (size_t)crow * D;
            row_load(n0, nx, lane); row_load(n1, nx + D, lane); row_load(n2, nx + 2 * D, lane); row_load(n3, nx + 3 * D, lane);
            bf16_t* orow = XN + (size_t)(rbase + 4 * i) * D;
            norm_mod_row(a0, orow, gain, sv + 1024, sv, lane);
            norm_mod_row(a1, orow + D, gain, sv + 1024, sv, lane);
            norm_mod_row(a2, orow + 2 * D, gain, sv + 1024, sv, lane);
            norm_mod_row(a3, orow + 3 * D, gain, sv + 1024, sv, lane);
            a0 = n0; a1 = n1; a2 = n2; a3 = n3;
        }
        { bf16_t* orow = XN + (size_t)(M + crow) * D;
          norm_mod_row(a0, orow, gain, sv + 3072, sv + 2048, lane);
          norm_mod_row(a1, orow + D, gain, sv + 3072, sv + 2048, lane);
          norm_mod_row(a2, orow + 2 * D, gain, sv + 3072, sv + 2048, lane);
          norm_mod_row(a3, orow + 3 * D, gain, sv + 3072, sv + 2048, lane); }
    }
}

__device__ __forceinline__ float half_sum32(float v, int hi) {
    v += __builtin_bit_cast(float, __builtin_amdgcn_update_dpp(0, __builtin_bit_cast(int, v), 0xB1, 0xf, 0xf, true));
    v += __builtin_bit_cast(float, __builtin_amdgcn_update_dpp(0, __builtin_bit_cast(int, v), 0x4E, 0xf, 0xf, true));
    v += __builtin_bit_cast(float, __builtin_amdgcn_update_dpp(0, __builtin_bit_cast(int, v), 0x141, 0xf, 0xf, true));
    v += __builtin_bit_cast(float, __builtin_amdgcn_update_dpp(0, __builtin_bit_cast(int, v), 0x140, 0xf, 0xf, true));
    v += __builtin_bit_cast(float, __builtin_amdgcn_update_dpp(0, __builtin_bit_cast(int, v), 0x142, 0xa, 0xf, false));
    const float s0 = __builtin_bit_cast(float, __builtin_amdgcn_readlane(__builtin_bit_cast(int, v), 31)), s1 = __builtin_bit_cast(float, __builtin_amdgcn_readlane(__builtin_bit_cast(int, v), 63));
    return hi ? s1 : s0;
}
namespace att {
constexpr int KP = 272, KBUF = 64 * KP, VBUF = 16384;
constexpr int OFF_K = 0, OFF_V = 2 * KBUF, OFF_WSF = OFF_V + 2 * VBUF, OFF_END = OFF_WSF + NWAVES * 256;
static_assert(OFF_WSF >= 65536 && OFF_END <= RING_BYTES, "attention LDS map");
constexpr int NT = TK / 64;
constexpr float THR = 8.0f;
__device__ __forceinline__ int crow(int r, int hi) { return (r & 3) + 8 * (r >> 2) + 4 * hi; }
__device__ __forceinline__ float max3f(float a, float b, float c) { float r; asm("v_max3_f32 %0, %1, %2, %3" : "=v"(r) : "v"(a), "v"(b), "v"(c)); return r; }
__device__ __forceinline__ float max2f(float a, float b) { float r; asm("v_max_f32_e32 %0, %1, %2" : "=v"(r) : "v"(a), "v"(b)); return r; }
__device__ __forceinline__ s16x4 vtr(const LAS unsigned char* p) { return __builtin_bit_cast(s16x4, __builtin_amdgcn_ds_read_tr16_b64_v4i16((LAS s16x4*)p)); }

#define ATT_BAR() asm volatile("s_waitcnt lgkmcnt(0)\n\ts_barrier" ::: "memory")
#define ATT_SB() __builtin_amdgcn_sched_barrier(0)
#define ATT_KLD(i, KF) KF = *(const LAS bf16x8*)(kb_ + ((i) & 1) * (32 * KP) + ((i) >> 1) * 32)
#define ATT_XSTEP(i, KC, KN) do { if ((i) + 2 < 8) { ATT_KLD((i) + 2, KN); } \
    if ((i) == 0) p0 = __builtin_amdgcn_mfma_f32_32x32x16_bf16(KC, qr[0], negref, 0, 0, 0); \
    else if ((i) == 1) p1 = __builtin_amdgcn_mfma_f32_32x32x16_bf16(KC, qr[0], negref, 0, 0, 0); \
    else if (((i) & 1) == 0) p0 = __builtin_amdgcn_mfma_f32_32x32x16_bf16(KC, qr[(i) >> 1], p0, 0, 0, 0); else p1 = __builtin_amdgcn_mfma_f32_32x32x16_bf16(KC, qr[(i) >> 1], p1, 0, 0, 0); ATT_SB(); } while (0)
#define ATT_X(kcur) do { \
    const LAS unsigned char* kb_ = lds + OFF_K + (kcur) * KBUF + koff; \
    bf16x8 ka_, kb2_, kc_; \
    ATT_KLD(0, ka_); ATT_KLD(1, kb2_); \
    ATT_SB(); \
    ATT_XSTEP(0, ka_, kc_); ATT_XSTEP(1, kb2_, ka_); ATT_XSTEP(2, kc_, kb2_); ATT_XSTEP(3, ka_, kc_); \
    ATT_XSTEP(4, kb2_, ka_); ATT_XSTEP(5, kc_, kb2_); ATT_XSTEP(6, ka_, kc_); ATT_XSTEP(7, kb2_, ka_); \
} while (0)
#define ATT_EXP2(i, PWN) do { \
    const float e0_ = __builtin_amdgcn_exp2f((i) < 8 ? p0[2 * ((i) & 7)] : p1[2 * ((i) & 7)]), e1_ = __builtin_amdgcn_exp2f((i) < 8 ? p0[2 * ((i) & 7) + 1] : p1[2 * ((i) & 7) + 1]); \
    sacc_ += e0_ + e1_; PWN[(i) >> 2][(i) & 3] = pk2(e0_, e1_); asm volatile("" : "+v"(PWN[(i) >> 2]), "+v"(sacc_)); } while (0)
#define ATT_VLD(i, LO, HI) do { LO = vtr(vb_ + ((i) & 3) * 4096 + ((i) >> 2) * 1024); HI = vtr(vb_ + ((i) & 3) * 4096 + ((i) >> 2) * 1024 + 512); } while (0)
#define ATT_VF(LO, HI) ((bf16x8){LO[0], LO[1], LO[2], LO[3], HI[0], HI[1], HI[2], HI[3]})
#define ATT_YSTEP(i, PWC, PWN, LC, HC, LN, HN) do { if ((i) + 2 < 16) { ATT_VLD((i) + 2, LN, HN); } \
    o[(i) & 3] = __builtin_amdgcn_mfma_f32_32x32x16_bf16(__builtin_bit_cast(bf16x8, PWC[(i) >> 2]), ATT_VF(LC, HC), o[(i) & 3], 0, 0, 0); \
    ATT_EXP2(i, PWN); ATT_SB(); } while (0)
#define ATT_Y(vcur, PWC, PWN) do { \
    const LAS unsigned char* vb_ = lds + OFF_V + (vcur) * VBUF + voff; \
    float sacc_ = 0.f; s16x4 la_, ha_, lb_, hb_, lc_, hc_; \
    ATT_VLD(0, la_, ha_); ATT_VLD(1, lb_, hb_); ATT_SB(); \
    ATT_YSTEP(0, PWC, PWN, la_, ha_, lc_, hc_); ATT_YSTEP(1, PWC, PWN, lb_, hb_, la_, ha_); ATT_YSTEP(2, PWC, PWN, lc_, hc_, lb_, hb_); \
    ATT_YSTEP(3, PWC, PWN, la_, ha_, lc_, hc_); ATT_YSTEP(4, PWC, PWN, lb_, hb_, la_, ha_); ATT_YSTEP(5, PWC, PWN, lc_, hc_, lb_, hb_); \
    ATT_YSTEP(6, PWC, PWN, la_, ha_, lc_, hc_); ATT_YSTEP(7, PWC, PWN, lb_, hb_, la_, ha_); ATT_YSTEP(8, PWC, PWN, lc_, hc_, lb_, hb_); \
    ATT_YSTEP(9, PWC, PWN, la_, ha_, lc_, hc_); ATT_YSTEP(10, PWC, PWN, lb_, hb_, la_, ha_); ATT_YSTEP(11, PWC, PWN, lc_, hc_, lb_, hb_); \
    ATT_YSTEP(12, PWC, PWN, la_, ha_, lc_, hc_); ATT_YSTEP(13, PWC, PWN, lb_, hb_, la_, ha_); ATT_YSTEP(14, PWC, PWN, lc_, hc_, lb_, hb_); \
    ATT_YSTEP(15, PWC, PWN, la_, ha_, lc_, hc_); \
    l_reg += sacc_; \
} while (0)
#define ATT_Y0(PWN) do { float sacc_ = 0.f; _Pragma("unroll") for (int i = 0; i < 16; ++i) ATT_EXP2(i, PWN); l_reg += sacc_; } while (0)
#define ATT_ZSTEP(i, PWC, LC, HC, LN, HN) do { if ((i) + 2 < 16) { ATT_VLD((i) + 2, LN, HN); } \
    o[(i) & 3] = __builtin_amdgcn_mfma_f32_32x32x16_bf16(__builtin_bit_cast(bf16x8, PWC[(i) >> 2]), ATT_VF(LC, HC), o[(i) & 3], 0, 0, 0); ATT_SB(); } while (0)
#define ATT_Z(vcur, PWC) do { \
    const LAS unsigned char* vb_ = lds + OFF_V + (vcur) * VBUF + voff; \
    s16x4 la_, ha_, lb_, hb_, lc_, hc_; \
    ATT_VLD(0, la_, ha_); ATT_VLD(1, lb_, hb_); ATT_SB(); \
    ATT_ZSTEP(0, PWC, la_, ha_, lc_, hc_); ATT_ZSTEP(1, PWC, lb_, hb_, la_, ha_); ATT_ZSTEP(2, PWC, lc_, hc_, lb_, hb_); \
    ATT_ZSTEP(3, PWC, la_, ha_, lc_, hc_); ATT_ZSTEP(4, PWC, lb_, hb_, la_, ha_); ATT_ZSTEP(5, PWC, lc_, hc_, lb_, hb_); \
    ATT_ZSTEP(6, PWC, la_, ha_, lc_, hc_); ATT_ZSTEP(7, PWC, lb_, hb_, la_, ha_); ATT_ZSTEP(8, PWC, lc_, hc_, lb_, hb_); \
    ATT_ZSTEP(9, PWC, la_, ha_, lc_, hc_); ATT_ZSTEP(10, PWC, lb_, hb_, la_, ha_); ATT_ZSTEP(11, PWC, lc_, hc_, lb_, hb_); \
    ATT_ZSTEP(12, PWC, la_, ha_, lc_, hc_); ATT_ZSTEP(13, PWC, lb_, hb_, la_, ha_); ATT_ZSTEP(14, PWC, lc_, hc_, lb_, hb_); \
    ATT_ZSTEP(15, PWC, la_, ha_, lc_, hc_); \
} while (0)
#define ATT_STAGE(j) do { \
    if ((j) + 1 < NT) { _Pragma("unroll") for (int i = 0; i < 2; ++i) *(LAS u32x4*)(lds + OFF_K + (((j) + 1) & 1) * KBUF + kdst[i]) = kr[i]; } \
    _Pragma("unroll") for (int i = 0; i < 2; ++i) *(LAS u32x4*)(lds + OFF_V + ((j) & 1) * VBUF + vdst[i]) = vr[i]; \
    if ((j) + 2 < NT) { _Pragma("unroll") for (int i = 0; i < 2; ++i) kr[i] = *(const u32x4*)(Kb + (size_t)((j) + 2) * 64 * 512 + gsrc[i]); } \
    if ((j) + 1 < NT) { _Pragma("unroll") for (int i = 0; i < 2; ++i) vr[i] = *(const u32x4*)(Vb + (size_t)((j) + 1) * 64 * 512 + gsrc[i]); } } while (0)

__device__ __forceinline__ void unit(LAS unsigned char* lds, int b, int h, int qb, const bf16_t* Q, const bf16_t* KA, const bf16_t* VA, bf16_t* MIXIN, const float* subg, float lam, const unsigned* KM) {
    const int tid = opaque_tid(), lane = tid & 63, r32 = lane & 31, hi = lane >> 5;
    const int wid = __builtin_amdgcn_readfirstlane(tid >> 6), w = wid & 3, m = wid >> 2;
    LAS float* wsf = (LAS float*)(lds + OFF_WSF) + wid * 64;
    const int rowQ = b * T + qb * 128 + w * 32;
    bf16x8 qr[4];
#pragma unroll
    for (int d0 = 0; d0 < 4; ++d0) qr[d0] = *(const bf16x8*)(Q + (size_t)(rowQ + r32) * 512 + h * 128 + m * 64 + d0 * 16 + hi * 8);
    const bf16_t* Kb = KA + (size_t)b * TK * 512 + h * 128; const bf16_t* Vb = VA + (size_t)b * TK * 512 + h * 128;
    int gsrc[2], kdst[2], vdst[2];
#pragma unroll
    for (int i = 0; i < 2; ++i) { const int cid = tid + 512 * i, kv = cid >> 4, c16 = cid & 15;
        gsrc[i] = kv * 512 + c16 * 8; kdst[i] = kv * KP + c16 * 16; vdst[i] = (c16 >> 2) * 4096 + (kv >> 4) * 1024 + (kv & 15) * 64 + (c16 & 3) * 16; }
    u32x4 kr[2], vr[2];
#pragma unroll
    for (int i = 0; i < 2; ++i) { kr[i] = *(const u32x4*)(Kb + gsrc[i]); vr[i] = *(const u32x4*)(Vb + gsrc[i]); }
#pragma unroll
    for (int i = 0; i < 2; ++i) *(LAS u32x4*)(lds + OFF_K + kdst[i]) = kr[i];
#pragma unroll
    for (int i = 0; i < 2; ++i) kr[i] = *(const u32x4*)(Kb + (size_t)64 * 512 + gsrc[i]);
    ATT_BAR();
    f32x16 o[4];
#pragma unroll
    for (int d0 = 0; d0 < 4; ++d0) o[d0] = (f32x16){};
    float l_reg = 0.f;
    f32x16 p0, p1, negref;
    {
        const unsigned* km = KM + (b * 8 + h * 2 + m) * 2;
        const float kmax2 = __uint_as_float(km[0]) + __uint_as_float(km[1]);
        float ss = 0.f;
#pragma unroll
        for (int d0 = 0; d0 < 4; ++d0)
#pragma unroll
            for (int i = 0; i < 8; ++i) { const float v = bf2f((unsigned short)qr[d0][i]); ss += v * v; }
        ss += __shfl_xor(ss, 32);
        const float ref = sqrtf(ss * kmax2) * 1.02f;
#pragma unroll
        for (int r = 0; r < 16; ++r) negref[r] = -ref;
    }
    u32x4 pwA[4], pwB[4];
    const int koff = r32 * KP + m * 128 + hi * 16;
    const int voff = ((lane >> 4) & 1) * 32 + (lane & 3) * 8 + (4 * hi + ((lane & 15) >> 2)) * 64;
    ATT_X(0); ATT_STAGE(0); ATT_Y0(pwA); ATT_BAR();
    ATT_X(1); ATT_STAGE(1); ATT_Y(0, pwA, pwB); ATT_BAR();
    for (int j = 2; j < NT; j += 2) {
        ATT_X(0); ATT_STAGE(j); ATT_Y(1, pwB, pwA); ATT_BAR();
        ATT_X(1); ATT_STAGE(j + 1); ATT_Y(0, pwA, pwB); ATT_BAR();
    }
    ATT_Z(1, pwB); ATT_BAR();
    const float lsum_ = l_reg + __shfl_xor(l_reg, 32);
    if (hi == 0) wsf[32 + r32] = lsum_;
    LDS_WAIT();
    LAS float* ex = (LAS float*)lds + w * 4096 + 4 * r32;
    const f32x4 g4 = *(const f32x4*)(subg + 4 * r32) * (1.0f - LAM_INIT);
    bf16_t* dstb = MIXIN + (size_t)rowQ * 1024 + h * 128 + 4 * r32;
#define ATT_EPI(KEEP) do { \
    _Pragma("unroll") for (int rr = 0; rr < 8; ++rr) { const int r = 8 - (KEEP) + rr; const int q = crow(r, hi); const float rl = __builtin_amdgcn_rcpf(wsf[32 + q]); \
        *(LAS f32x4*)(ex + q * 128) = (f32x4){o[0][r] * rl, o[1][r] * rl, o[2][r] * rl, o[3][r] * rl}; } \
    ATT_BAR(); \
    _Pragma("unroll") for (int rr = 0; rr < 8; ++rr) { const int r = (KEEP) + rr; const int q = crow(r, hi); const float rl = __builtin_amdgcn_rcpf(wsf[32 + q]); \
        const f32x4 own = (f32x4){o[0][r] * rl, o[1][r] * rl, o[2][r] * rl, o[3][r] * rl}; const f32x4 oth = *(const LAS f32x4*)(ex + q * 128); \
        const f32x4 x = ((KEEP) == 0) ? (own - lam * oth) : (oth - lam * own); \
        const float ss = half_sum32((x[0] * x[0] + x[1] * x[1]) + (x[2] * x[2] + x[3] * x[3]), hi); \
        const float rstd = __builtin_amdgcn_rsqf(ss * (1.f / 128.f) + EPS); \
        u32x2 wv; wv.x = pk2(x[0] * rstd * g4[0], x[1] * rstd * g4[1]); wv.y = pk2(x[2] * rstd * g4[2], x[3] * rstd * g4[3]); \
        *(u32x2*)(dstb + (size_t)q * 1024) = wv; } } while (0)
    if (m == 0) ATT_EPI(0); else ATT_EPI(8);
#undef ATT_EPI
    ATT_BAR();
}
#undef ATT_BAR
#undef ATT_X
#undef ATT_EXP2
#undef ATT_Y
#undef ATT_Y0
#undef ATT_Z
#undef ATT_STAGE
#undef ATT_SB
#undef ATT_KLD
#undef ATT_XSTEP
#undef ATT_VLD
#undef ATT_VF
#undef ATT_YSTEP
#undef ATT_ZSTEP
}

__device__ __forceinline__ void p3_conv_attn(const Args& a, LAS unsigned char* lds, int c, int vcu, int G) {
    const int tid = opaque_tid(), lane = tid & 63, wave = __builtin_amdgcn_readfirstlane(tid >> 6);
    unsigned char* ws = a.ws;
    const bf16_t* GB = (const bf16_t*)(ws + WS_GB); const bf16_t* U = (const bf16_t*)(ws + WS_U); bf16_t* MIXIN = (bf16_t*)(ws + WS_MIXIN);
    {
        const float* cw = a.in[I_CONVW]; float w0[8], w1[8], w2[8];
#pragma unroll
        for (int i = 0; i < 8; ++i) { w0[i] = cw[lane * 8 + i]; w1[i] = cw[512 + lane * 8 + i]; w2[i] = cw[1024 + lane * 8 + i]; }
        const int gw = vcu * NWAVES + wave, NGW = G * NWAVES;
        for (int row = gw * (M / NGW); row < (gw + 1) * (M / NGW); ++row) {
            const int t = row & (T - 1);
            const u32x4 z = {0u, 0u, 0u, 0u};
            const u32x4 uc = *(const u32x4*)(U + (size_t)row * 512 + lane * 8);
            const u32x4 up = (t > 0) ? *(const u32x4*)(U + (size_t)(row - 1) * 512 + lane * 8) : z;
            const u32x4 un = (t < T - 1) ? *(const u32x4*)(U + (size_t)(row + 1) * 512 + lane * 8) : z;
            const u32x4 gb = *(const u32x4*)(GB + (size_t)row * 512 + lane * 8);
            u32x4 o;
#pragma unroll
            for (int q = 0; q < 4; ++q) {
                const float y0 = w0[2 * q] * bflo(up[q]) + w1[2 * q] * bflo(uc[q]) + w2[2 * q] * bflo(un[q]);
                const float y1 = w0[2 * q + 1] * bfhi(up[q]) + w1[2 * q + 1] * bfhi(uc[q]) + w2[2 * q + 1] * bfhi(un[q]);
                o[q] = pk2(bflo(gb[q]) * y0, bfhi(gb[q]) * y1);
            }
            *(u32x4*)(MIXIN + (size_t)row * 1024 + 512 + lane * 8) = o;
        }
    }
    float lam;
    { const float p1 = a.in[I_LQ1][lane] * a.in[I_LK1][lane], p2 = a.in[I_LQ2][lane] * a.in[I_LK2][lane];
      lam = __expf(wave_sum(p1)) - __expf(wave_sum(p2)) + LAM_INIT; }
    const bf16_t* Q = (const bf16_t*)(ws + WS_Q); const bf16_t* KA = (const bf16_t*)(ws + WS_K); const bf16_t* VA = (const bf16_t*)(ws + WS_V);
    __syncthreads();
    for (int u = vcu * 8; u < 2048; u += G * 8) {
        const int x = (u >> 3) / 32, jj = (u >> 3) % 32;
        for (int i = 0; i < 8; ++i) {
            const int bh = 16 * x + 2 * i + (jj >> 4), qb = jj & 15;
            att::unit(lds, bh >> 2, bh & 3, qb, Q, KA, VA, MIXIN, a.in[I_SUBLN], lam, (const unsigned*)(ws + WS_CTL) + CW_KMAX);
        }
    }
}

struct P5In { f32x4 x[4]; u32x2 m[4]; };
__device__ __forceinline__ void p5_load(P5In& r, int row, int lane, const float* X, const bf16_t* MIX) {
    const f32x4* xr = (const f32x4*)(X + (size_t)row * D) + lane; const u32x2* mr = (const u32x2*)(MIX + (size_t)row * D) + lane;
#pragma unroll
    for (int j = 0; j < 4; ++j) { r.x[j] = __builtin_nontemporal_load(xr + 64 * j); r.m[j] = __builtin_nontemporal_load(mr + 64 * j); }
}
__device__ __forceinline__ float p5_resid(const P5In& r, f32x4 (&h)[4], int row, int lane, const LAS float* mv, const f32x4* npm, bf16_t* H1) {
    f32x4 mx[4]; float s = 0.f;
#pragma unroll
    for (int j = 0; j < 4; ++j) { const u32x2 wv = r.m[j]; mx[j] = (f32x4){bflo(wv.x), bfhi(wv.x), bflo(wv.y), bfhi(wv.y)};
        s += (mx[j].x * mx[j].x + mx[j].y * mx[j].y) + (mx[j].z * mx[j].z + mx[j].w * mx[j].w); }
    const float rstd1 = 1.0f / sqrtf(wave_sum(s) * (1.f / D) + EPS);
    u32x2* hr = (u32x2*)(H1 + (size_t)row * D) + lane; float s2 = 0.f;
#pragma unroll
    for (int j = 0; j < 4; ++j) { const f32x4 g1 = *(const LAS f32x4*)(mv + 4 * lane + 256 * j);
        h[j] = r.x[j] + g1 * ((mx[j] * rstd1) * npm[64 * j]);
        u32x2 wv; wv.x = pk2(h[j].x, h[j].y); wv.y = pk2(h[j].z, h[j].w); __builtin_nontemporal_store(wv, hr + 64 * j);
        s2 += (h[j].x * h[j].x + h[j].y * h[j].y) + (h[j].z * h[j].z + h[j].w * h[j].w); }
    return 1.0f / sqrtf(wave_sum(s2) * (1.f / D) + EPS);
}
__device__ __forceinline__ void p5_rows(const Args& a, LAS unsigned char* lds, int p  ) {
    const int tid = opaque_tid(), lane = tid & 63, wave = __builtin_amdgcn_readfirstlane(tid >> 6);
    unsigned char* ws = a.ws;
    const int b = p >> 3;
    LAS float* wrt = (LAS float*)lds;
    LAS float* mv = (LAS float*)(lds + 65536);
    const float* wr = a.in[I_WROUTER];
    const bf16_t* MIX = (const bf16_t*)(ws + WS_MIX); unsigned char* XN2 = ws + WS_XN; float* AFFT = (float*)(ws + WS_AFFT); bf16_t* H1 = (bf16_t*)(ws + WS_H1);
    const float* X = a.in[I_X];
    const int rbase = p * 256 + wave * 32;
    P5In cA, cB;
    p5_load(cA, rbase, lane, X, MIX); p5_load(cB, rbase + 1, lane, X, MIX);
    for (int n = tid; n < D * NE; n += NTHREADS) { const int k = n >> 4, e = n & 15; wrt[e * D + k] = wr[n]; }
    const float* MOD = (const float*)(ws + WS_MOD) + (size_t)b * NMOD;
    for (int n = tid; n < 3 * D; n += NTHREADS) mv[n] = MOD[2 * D + n];
    __syncthreads();
    const f32x4* npm = (const f32x4*)a.in[I_NPOST_MIX] + lane; const f32x4* npf = (const f32x4*)a.in[I_NPRE_FFN] + lane;
    for (int i = 0; i < 16; ++i) {
        const int rowA = rbase + 2 * i, rowB = rowA + 1;
        P5In nA, nB;
        if (i + 1 < 16) { p5_load(nA, rowA + 2, lane, X, MIX); p5_load(nB, rowB + 2, lane, X, MIX); }
        f32x4 hA[4], hB[4];
        const float rsA = p5_resid(cA, hA, rowA, lane, mv, npm, H1);
        const float rsB = p5_resid(cB, hB, rowB, lane, mv, npm, H1);
        unsigned* oA = (unsigned*)(XN2 + (size_t)rowA * D) + lane; unsigned* oB = (unsigned*)(XN2 + (size_t)rowB * D) + lane;
        typedef float f32x2v __attribute__((ext_vector_type(2)));
        f32x2v lg2[16];
#pragma unroll
        for (int e = 0; e < 16; ++e) lg2[e] = (f32x2v){0.f, 0.f};
#pragma unroll
        for (int j = 0; j < 4; ++j) { const f32x4 sh2 = *(const LAS f32x4*)(mv + 1024 + 4 * lane + 256 * j), sc2 = *(const LAS f32x4*)(mv + 2048 + 4 * lane + 256 * j);
            const f32x4 gn = npf[64 * j];
            const f32x4 zA = ((hA[j] * rsA) * gn) * (sc2 + 1.0f) + sh2, zB = ((hB[j] * rsB) * gn) * (sc2 + 1.0f) + sh2;
            { const f32x4 qa = zA * pg8::F8_ACT, qb = zB * pg8::F8_ACT; oA[64 * j] = pg8::pk4_fp8(qa.x, qa.y, qa.z, qa.w); oB[64 * j] = pg8::pk4_fp8(qb.x, qb.y, qb.z, qb.w); }
            const f32x2v zx = {zA.x, zB.x}, zy = {zA.y, zB.y}, zz = {zA.z, zB.z}, zw = {zA.w, zB.w};
#pragma unroll
            for (int e = 0; e < 16; ++e) { const f32x4 wq = *(const LAS f32x4*)(wrt + e * D + 4 * lane + 256 * j);
                lg2[e] = __builtin_elementwise_fma(zx, (f32x2v){wq.x, wq.x}, lg2[e]); lg2[e] = __builtin_elementwise_fma(zy, (f32x2v){wq.y, wq.y}, lg2[e]);
                lg2[e] = __builtin_elementwise_fma(zz, (f32x2v){wq.z, wq.z}, lg2[e]); lg2[e] = __builtin_elementwise_fma(zw, (f32x2v){wq.w, wq.w}, lg2[e]);
                if ((e & 3) == 3) __builtin_amdgcn_sched_barrier(0); } }
        float lg[32];
#pragma unroll
        for (int e = 0; e < 16; ++e) { lg[e] = lg2[e].x; lg[16 + e] = lg2[e].y; }
#pragma unroll
        for (int st = 0; st < 5; ++st) { const int d = 1 << st, cntv = 16 >> st; const bool up = (lane & d) != 0;
#pragma unroll
            for (int q = 0; q < 16; ++q) if (q < cntv) { const float send = up ? lg[2 * q] : lg[2 * q + 1], keep = up ? lg[2 * q + 1] : lg[2 * q]; lg[q] = keep + __shfl_xor(send, d); } }
        float lv = lg[0] + __shfl_xor(lg[0], 32);
        float mxl = lv;
#pragma unroll
        for (int d = 1; d < 16; d <<= 1) mxl = fmaxf(mxl, __shfl_xor(mxl, d));
        const float ev = __expf(lv - mxl); float se = ev;
#pragma unroll
        for (int d = 1; d < 16; d <<= 1) se += __shfl_xor(se, d);
        if (lane < 32) { const int row = (lane < 16) ? rowA : rowB; AFFT[((size_t)b * NE + (lane & 15)) * T + (row & (T - 1))] = ev / se; }
        cA = nA; cB = nB;
    }
}

__device__ __forceinline__ void p6_topk(const Args& a, LAS unsigned char* lds, int c, int G) {
    const int tid = opaque_tid(), lane = tid & 63, wave = __builtin_amdgcn_readfirstlane(tid >> 6);
    unsigned char* ws = a.ws;
    const float* AFFT = (const float*)(ws + WS_AFFT); short* SLOT = (short*)(ws + WS_SLOT); int* IDX = (int*)(ws + WS_IDX); float* GATE = (float*)(ws + WS_GATE);
    LAS unsigned* sv = (LAS unsigned*)(lds + wave * 16384);
    for (int item = c + wave * G; item < NITEM; item += G * NWAVES) {
        const int b = item >> 4, e = item & 15;
        const float* src = AFFT + (size_t)item * T;
#pragma unroll 8
        for (int j = 0; j < 32; ++j) sv[j * 64 + lane] = __float_as_uint(src[j * 64 + lane]);
        LDS_WAIT(); asm volatile("" ::: "memory");
        unsigned pre = 0u;
        for (int bit = 30; bit >= 0; --bit) {
            const unsigned cand = pre | (1u << bit);
            int cnt = 0;
#pragma unroll 4
            for (int j = 0; j < 32; ++j) cnt += (int)__popcll(__ballot(sv[j * 64 + lane] >= cand));
            if (cnt >= CAP) pre = cand;
        }
        int ngt = 0;
#pragma unroll 4
        for (int j = 0; j < 32; ++j) ngt += (int)__popcll(__ballot(sv[j * 64 + lane] > pre));
        const int need_eq = CAP - ngt;
        const unsigned long long ltmask = (1ull << lane) - 1ull;
        int base_gt = 0, base_eq = 0;
#pragma unroll 2
        for (int j = 0; j < 32; ++j) {
            const unsigned vj = sv[j * 64 + lane];
            const bool gt = vj > pre, eq = vj == pre;
            const unsigned long long mg = __ballot(gt), me = __ballot(eq);
            const int pg = base_gt + (int)__popcll(mg & ltmask), pe = base_eq + (int)__popcll(me & ltmask);
            int sl = -1; if (gt) sl = pg; else if (eq && pe < need_eq) sl = ngt + pe;
            const int t = j * 64 + lane;
            SLOT[((size_t)b * T + t) * NE + e] = (short)sl;
            if (sl >= 0) { IDX[item * CAP + sl] = t; GATE[item * CAP + sl] = __uint_as_float(vj); }
            base_gt += (int)__popcll(mg); base_eq += (int)__popcll(me);
        }
        LDS_WAIT(); asm volatile("" ::: "memory");
    }
}

struct P8Row { u32x2 h[4]; unsigned y[4][4]; float wt[4]; unsigned long long rest; int sl; };
__device__ __forceinline__ f32x4 fp8x4_to_f32(unsigned w) { typedef float f2 __attribute__((ext_vector_type(2))); const f2 lo = __builtin_amdgcn_cvt_pk_f32_fp8((int)w, false), hi = __builtin_amdgcn_cvt_pk_f32_fp8((int)w, true); return (f32x4){lo.x, lo.y, hi.x, hi.y}; }
__device__ __forceinline__ void p8_issue(P8Row& r, int row, int lane, const short* SLOT, const unsigned char* Y, const bf16_t* H1) {
    const int b = row >> 11;
    const int s_e = (lane < NE) ? (int)SLOT[(size_t)row * NE + lane] : -1;
    unsigned long long mask = __ballot(s_e >= 0);
    const u32x2* hr = (const u32x2*)(H1 + (size_t)row * D) + lane;
#pragma unroll
    for (int j = 0; j < 4; ++j) r.h[j] = __builtin_nontemporal_load(hr + 64 * j);
#pragma unroll
    for (int q = 0; q < 4; ++q) {
        int e = 0, s = 0; r.wt[q] = 0.f;
        if (mask) { e = (int)__builtin_ctzll(mask); mask &= mask - 1ull; s = __builtin_amdgcn_readlane(s_e, e); r.wt[q] = 1.f; }
        const unsigned* yr = (const unsigned*)(Y + ((size_t)(b * NE + e) * CAP + s) * D) + lane;
#pragma unroll
        for (int j = 0; j < 4; ++j) r.y[q][j] = __builtin_nontemporal_load(yr + 64 * j);
    }
    r.rest = mask; r.sl = s_e;
}
__device__ __forceinline__ void p8_finish(P8Row& r, int row, int lane, const unsigned char* Y, const float* MOD, const f32x4* npo, float* out) {
    const int b = row >> 11;
    f32x4 ff[4];
#pragma unroll
    for (int j = 0; j < 4; ++j) ff[j] = (f32x4){0.f, 0.f, 0.f, 0.f};
#pragma unroll
    for (int q = 0; q < 4; ++q)
#pragma unroll
        for (int j = 0; j < 4; ++j) ff[j] += fp8x4_to_f32(r.y[q][j]) * r.wt[q];
    unsigned long long mask = r.rest;
    while (mask) {
        const int e = (int)__builtin_ctzll(mask); mask &= mask - 1ull; const int s = __builtin_amdgcn_readlane(r.sl, e);
        const unsigned* yr = (const unsigned*)(Y + ((size_t)(b * NE + e) * CAP + s) * D) + lane;
#pragma unroll
        for (int j = 0; j < 4; ++j) ff[j] += fp8x4_to_f32(yr[64 * j]);
    }
#pragma unroll
    for (int j = 0; j < 4; ++j) ff[j] = ff[j] * (1.0f / pg8::F8_Y);
    float s2 = 0.f;
#pragma unroll
    for (int j = 0; j < 4; ++j) s2 += (ff[j].x * ff[j].x + ff[j].y * ff[j].y) + (ff[j].z * ff[j].z + ff[j].w * ff[j].w);
    const float rstd = 1.0f / sqrtf(wave_sum(s2) * (1.f / D) + EPS);
    f32x4* orow = (f32x4*)(out + (size_t)row * D) + lane; const f32x4* g2 = (const f32x4*)(MOD + (size_t)b * NMOD + 5 * D) + lane;
#pragma unroll
    for (int j = 0; j < 4; ++j) { const u32x2 hv = r.h[j]; const f32x4 h = (f32x4){bflo(hv.x), bfhi(hv.x), bflo(hv.y), bfhi(hv.y)};
        __builtin_nontemporal_store(h + g2[64 * j] * ((ff[j] * rstd) * npo[64 * j]), orow + 64 * j); }
}
__device__ __forceinline__ void p8_final(const Args& a, int vcu, int G) {
    const int tid = opaque_tid(), lane = tid & 63, wave = __builtin_amdgcn_readfirstlane(tid >> 6);
    unsigned char* ws = a.ws;
    const short* SLOT = (const short*)(ws + WS_SLOT); const unsigned char* Y = ws + WS_Y; const float* MOD = (const float*)(ws + WS_MOD); const bf16_t* H1 = (const bf16_t*)(ws + WS_H1);
    const f32x4* npo = (const f32x4*)a.in[I_NPOST_FFN] + lane;
    const int gw = vcu * NWAVES + wave, NGW = G * NWAVES;
    const int per = M / NGW;
    for (int row = gw * per; row < (gw + 1) * per; row += 4) {
        P8Row r0, r1, r2, r3;
        p8_issue(r0, row, lane, SLOT, Y, H1);
        p8_issue(r1, row + 1, lane, SLOT, Y, H1);
        p8_issue(r2, row + 2, lane, SLOT, Y, H1);
        p8_issue(r3, row + 3, lane, SLOT, Y, H1);
        p8_finish(r0, row, lane, Y, MOD, npo, a.out);
        p8_finish(r1, row + 1, lane, Y, MOD, npo, a.out);
        p8_finish(r2, row + 2, lane, Y, MOD, npo, a.out);
        p8_finish(r3, row + 3, lane, Y, MOD, npo, a.out);
    }
}

__global__ void __launch_bounds__(NTHREADS, 2) fwd_kernel(Args args) {
    extern __shared__ __attribute__((aligned(16))) unsigned char lds_raw[];
    LAS unsigned char* lds = (LAS unsigned char*)lds_raw;
    volatile LAS unsigned* MISC = (volatile LAS unsigned*)(lds + MISC_OFF);
    const int tid = threadIdx.x;
    const int G = gridDim.x, c = blockIdx.x;
    const int vcu = (G % 8 == 0) ? (c % 8) * (G / 8) + c / 8 : c;
    unsigned char* ws = args.ws;
    gu32* ctl = (gu32*)(ws + WS_CTL);
    for (int u = tid; u < (LDS_BYTES - LDSCTL_OFF) / 4; u += NTHREADS) ((LAS unsigned*)(lds + LDSCTL_OFF))[u] = 0u;
    __syncthreads();
    XcdBarrier bar; bar.bar = (unsigned*)(ctl + CW_BAR); bar.x = 0; bar.st = nullptr;
    const int lo = args.ph_lo, hi = args.ph_hi;
    if (hi - lo > 1) bar = xcd_barrier_post((unsigned*)(ctl + CW_BAR), MISC + 8);
#ifndef PHMASK
#define PHMASK 0xff
#endif
#define IN(k) (((PHMASK >> (k)) & 1) && lo <= (k) && (k) < hi)
#define SEAM(k) do { if (IN(k) && IN((k) + 1)) xcd_barrier(bar); } while (0)
#ifndef PROBE_PHASE
#define PROBE_PHASE -1
#endif
#define PB(k) do { if (PROBE_PHASE == (k)) { if (tid == 0) { const unsigned long long t0_ = __builtin_amdgcn_s_memrealtime(); MISC[16] = (unsigned)t0_; MISC[17] = (unsigned)(t0_ >> 32); } } } while (0)
#define PE(k) do { if (PROBE_PHASE == (k)) { if (tid == 0) { const unsigned long long t0_ = ((unsigned long long)MISC[17] << 32) | MISC[16]; const unsigned long long t1_ = __builtin_amdgcn_s_memrealtime(); \
      while (__builtin_amdgcn_s_memrealtime() - t1_ < t1_ - t0_) __builtin_amdgcn_s_sleep(8); } __syncthreads(); } } while (0)

    PB(0); if (IN(0)) { p0_prologue(args, lds, vcu, G); } SEAM(0); PE(0);
    PB(1); if (IN(1)) { p1_xn(args, lds, c, G); inout_weight_copies(args, lds, vcu, G); } SEAM(1); PE(1);
    PB(2); if (IN(2)) {
        pg8::Gemm g{(const bf16_t*)(ws + WS_XN), (const bf16_t*)(ws + WS_WIN), D, nullptr};
        pg8::SchedProj S{G, c};
        pg8::EpiProj E{(bf16_t*)(ws + WS_Q), (bf16_t*)(ws + WS_K), (bf16_t*)(ws + WS_V), (bf16_t*)(ws + WS_GB), (bf16_t*)(ws + WS_U), (const float*)(ws + WS_TAB), (unsigned*)(ws + WS_CTL) + CW_KMAX};
        pg8::gemm_phase<pg8::EpiProj, pg8::SchedProj, true, true>(lds, g, S, E);
        if (c >= 128) expert_weight_copies(args, lds, c - 128, G - 128, 0, 9216);
    } SEAM(2); PE(2);
    PB(3); if (IN(3)) { if (c & 1) expert_weight_copies(args, lds, vcu, G, 9216, 24576); p3_conv_attn(args, lds, c, vcu, G); if (!(c & 1)) expert_weight_copies(args, lds, vcu, G, 9216, 24576); } SEAM(3); PE(3);
    PB(4); if (IN(4)) {
        {
            const int p = c;
#ifndef NO_P4
            pg8::Gemm g{(const bf16_t*)(ws + WS_MIXIN), (const bf16_t*)(ws + WS_WOUT), D, nullptr};
            pg8::SchedPanel S{p, 4};
            pg8::EpiBf16 E{(bf16_t*)(ws + WS_MIX), D};
            pg8::gemm_phase<pg8::EpiBf16, pg8::SchedPanel, true, true>(lds, g, S, E);
#endif
            VM_WAIT(); __syncthreads();
#ifndef NO_P5
            p5_rows(args, lds, p);
#endif
            __syncthreads();
        }
    } SEAM(4); PE(4);
    PB(5); if (IN(5)) { p6_topk(args, lds, c, G); } SEAM(5); PE(5);
    PB(6); if (IN(6)) {
#pragma unroll 1
        for (int it = 0; it < 2; ++it) {
            {
                const int item = 2 * c + it;
                const int b = item >> 4, e = item & 15;
#ifndef NO_G1
                if (it == 0) PB(8);
                {
                    pg8::Gemm g{(const bf16_t*)(ws + WS_XN + (size_t)b * T * D), (const bf16_t*)(ws + WS_WGU + (size_t)e * 2048 * D), D, (const int*)(ws + WS_IDX) + item * CAP};
                    pg8::SchedPanel S{0, 8};
                    pg8::EpiGU8 E{ws + WS_HMID + (size_t)item * CAP * D};
                    pg8::gemm_phase<pg8::EpiGU8, pg8::SchedPanel, false, true, true, true, true>(lds, g, S, E);
                }
#endif
                VM_WAIT(); __syncthreads();
                if (it == 0) { PE(8); PB(9); }
#ifndef NO_G2
                {
                    pg8::Gemm g{(const bf16_t*)(ws + WS_HMID + (size_t)item * CAP * D), (const bf16_t*)(ws + WS_WDN + (size_t)e * D * D), D, nullptr};
                    pg8::SchedPanel S{0, 4};
                    LAS float* gl = (LAS float*)(lds + LDSCTL_OFF + 4096);
                    { const int t_ = opaque_tid(); if (t_ < CAP) gl[t_] = ((const float*)(ws + WS_GATE))[item * CAP + t_] * (pg8::F8_INV * pg8::F8_Y); }
                    __syncthreads();
                    pg8::EpiDown8 E{ws + WS_Y + (size_t)item * CAP * D, gl};
                    pg8::gemm_phase<pg8::EpiDown8, pg8::SchedPanel, false, true, false, true, true>(lds, g, S, E);
                }
#endif
                VM_WAIT(); __syncthreads();
                if (it == 0) PE(9);
            }
        }
    } SEAM(6); PE(6);
    PB(7); if (IN(7)) { p8_final(args, vcu, G); } PE(7);
#undef IN
#undef SEAM
}

extern "C" void kernel_launch(void* const* d_in, const int* in_sizes, int n_in, void* d_out, int out_size, void* d_ws, size_t ws_size, hipStream_t stream) {
    static int grid = 0;
    if (grid == 0) {
        if (n_in != 22 || in_sizes[0] != M * D || out_size != M * D || ws_size < WS_END) { fprintf(stderr, "kernel_launch: unexpected shapes (n_in %d, in0 %d, out %d, ws %zu)\n", n_in, n_in > 0 ? in_sizes[0] : -1, out_size, ws_size); grid = -1; return; }
        int dev = 0, cus = 0;
        if (hipGetDevice(&dev) != hipSuccess || hipDeviceGetAttribute(&cus, hipDeviceAttributeMultiprocessorCount, dev) != hipSuccess) { grid = -1; return; }
        if (hipFuncSetAttribute((const void*)fwd_kernel, hipFuncAttributeMaxDynamicSharedMemorySize, LDS_BYTES) != hipSuccess) { fprintf(stderr, "kernel_launch: hipFuncSetAttribute failed\n"); grid = -1; return; }
        (void)hipGetLastError();
        grid = cus;
        if (grid != 256) { fprintf(stderr, "kernel_launch: this kernel needs a 256-CU device (got %d)\n", cus); grid = -1; return; }
    }
    if (grid < 0) return;
    (void)hipMemsetAsync((char*)d_ws + WS_CTL, 0, CTL_ZERO_BYTES, stream);
    Args a{};
    for (int i = 0; i < 22; ++i) a.in[i] = (const float*)d_in[i];
    a.out = (float*)d_out; a.ws = (unsigned char*)d_ws;
    constexpr int NPH = 8;
    if (MK_N_LAUNCHES == 1) { a.ph_lo = 0; a.ph_hi = NPH; hipLaunchKernelGGL(fwd_kernel, dim3(grid), dim3(NTHREADS), LDS_BYTES, stream, a); }
    else { for (int k = 0; k < NPH; ++k) { a.ph_lo = k; a.ph_hi = k + 1; hipLaunchKernelGGL(fwd_kernel, dim3(grid), dim3(NTHREADS), LDS_BYTES, stream, a); } }
}
```

```cpp
#include <hip/hip_runtime.h>
#include <cstdio>
#include <cstdint>

#ifndef MK_N_LAUNCHES
#define MK_N_LAUNCHES 1
#endif

#define LAS __attribute__((address_space(3)))
#define GAS __attribute__((address_space(1)))
typedef unsigned short bf16_t;
typedef short bf16x8 __attribute__((ext_vector_type(8)));
typedef short s16x4 __attribute__((ext_vector_type(4)));
typedef float f32x4 __attribute__((ext_vector_type(4)));
typedef float f32x16 __attribute__((ext_vector_type(16)));
typedef unsigned u32x4 __attribute__((ext_vector_type(4)));
typedef unsigned u32x2 __attribute__((ext_vector_type(2)));

constexpr int NB = 32, T = 2048, D = 1024, TC = 256, M = NB * T, MC = NB * TC, MA = M + MC, TK = TC + T;
constexpr int NE = 16, CAP = 256, NITEM = NB * NE, NPROJ = 3072, NMOD = 6 * D;
constexpr float EPS = 1e-6f;
constexpr float C2 = 0.125f * 1.4426950408889634f;
constexpr float LAM_INIT = 0.2f;
constexpr int NWAVES = 8, NTHREADS = 512;

constexpr size_t MiB = 1u << 20;
constexpr size_t WS_CTL = 0, CTL_ZERO_BYTES = 1 * MiB;
constexpr size_t WS_MODP = 2 * MiB;
constexpr size_t WS_MOD = 16 * MiB;
constexpr size_t WS_TAB = 17 * MiB;
constexpr size_t WS_WIN = 18 * MiB;
constexpr size_t WS_WOUT = 24 * MiB;
constexpr size_t WS_WGU = 26 * MiB;
constexpr size_t WS_WDN = 90 * MiB;
constexpr size_t WS_AFFT = 122 * MiB;
constexpr size_t WS_SLOT = 126 * MiB;
constexpr size_t WS_IDX = 128 * MiB;
constexpr size_t WS_GATE = 129 * MiB;
constexpr size_t WS_XN = 130 * MiB;
constexpr size_t WS_Q = 274 * MiB;
constexpr size_t WS_K = 338 * MiB;
constexpr size_t WS_V = 410 * MiB;
constexpr size_t WS_GB = 482 * MiB;
constexpr size_t WS_U = 546 * MiB;
constexpr size_t WS_MIXIN = 610 * MiB;
constexpr size_t WS_MIX = 738 * MiB;
constexpr size_t WS_HMID = 274 * MiB;
constexpr size_t WS_Y = 610 * MiB;
constexpr size_t WS_H1 = 866 * MiB;
constexpr size_t WS_END = 994 * MiB;

__device__ __forceinline__ int opaque_tid() { int t = threadIdx.x; asm volatile("" : "+v"(t)); return t; }

namespace pg8 {
constexpr int BM = 256, BK = 64, HALF = 128, HTB = HALF * BK * 2, STAGE_BYTES = 8 * HTB;
__host__ __device__ __forceinline__ int lds_byte(int r, int c) { const int st = (r >> 4) * 2 + (c >> 5), rr = r & 15, cc = c & 31, ob = rr * 64 + cc * 2; return st * 1024 + (ob ^ (((ob >> 9) & 1) << 5)); }
__host__ __device__ __forceinline__ void stage_rc(int b, int& R, int& C) { const int st = b / 1024, sb = b % 1024, swz = sb ^ (((sb >> 9) & 1) << 5); R = (st >> 1) * 16 + swz / 64; C = (st & 1) * 32 + (swz % 64) / 2; }
__host__ __device__ __forceinline__ int perm32(int rho) { const int n = rho >> 4, i = rho & 15; return 8 * (i >> 2) + 4 * n + (i & 3); }

struct Unit { int pm, pn; };
struct Gemm { const bf16_t* A; const bf16_t* Bt; int K; const int* gidx; };

typedef float f32x2_t __attribute__((ext_vector_type(2))); typedef __bf16 bf16x2_t __attribute__((ext_vector_type(2)));
__device__ __forceinline__ unsigned cvt_pk_bf16(float lo, float hi) { const f32x2_t v = {lo, hi}; const bf16x2_t b = __builtin_convertvector(v, bf16x2_t); return __builtin_bit_cast(unsigned, b); }

struct EpiBf16 {
    static constexpr bool PERM = true, AFTER_DRAIN = false;
    bf16_t* O; int ldc;
    __device__ __forceinline__ void operator()(const f32x4 (&acc)[2][2][4][2], const Unit& u, int wr, int wc, int fr, int fq) const {
        const int row0 = u.pm * BM + wr * 64 + fr; const int col0 = u.pn * BM + wc * 32 + 8 * fq;
#pragma unroll
        for (int ai = 0; ai < 2; ++ai)
#pragma unroll
            for (int m = 0; m < 4; ++m) { bf16_t* rowp = O + (size_t)(row0 + ai * HALF + m * 16) * ldc + col0;
#pragma unroll
                for (int bj = 0; bj < 2; ++bj) { const f32x4 v0 = acc[ai][bj][m][0], v1 = acc[ai][bj][m][1];
                    u32x4 w; w.x = cvt_pk_bf16(v0[0], v0[1]); w.y = cvt_pk_bf16(v0[2], v0[3]); w.z = cvt_pk_bf16(v1[0], v1[1]); w.w = cvt_pk_bf16(v1[2], v1[3]);
                    *(u32x4*)(rowp + bj * HALF) = w; } }
    }
};

struct EpiProj {
    static constexpr bool PERM = true, AFTER_DRAIN = false;
    bf16_t *Q, *KA, *VA, *GB, *U; const float* tab;
    unsigned* kmaxh;
    __device__ __forceinline__ void operator()(const f32x4 (&acc)[2][2][4][2], const Unit& u, int wr, int wc, int fr, int fq) const {
        const int pn = u.pn; const bool ctx = u.pm >= 256;
        float km[2] = {0.f, 0.f};
#pragma unroll
        for (int ai = 0; ai < 2; ++ai)
#pragma unroll
            for (int m = 0; m < 4; ++m) {
                const int row = u.pm * BM + ai * HALF + wr * 64 + m * 16 + fr;
                int t, kvrow;
                if (!ctx) { const int b = row >> 11; t = row & 2047; kvrow = b * TK + TC + t; }
                else { const int rc = row - M; const int b = rc >> 8; t = 0; kvrow = b * TK + (rc & 255); }
                if (pn < 4) {
                    f32x4 cs0 = {1.f, 0.f, 1.f, 0.f}, cs1 = cs0, cs2 = cs0, cs3 = cs0;
                    if (!ctx) { const float* tp = tab + ((size_t)t * 32 + 16 * (wc & 1) + 4 * fq) * 2;
                        cs0 = *(const f32x4*)(tp); cs1 = *(const f32x4*)(tp + 4); }
                    (void)cs2; (void)cs3;
#pragma unroll
                    for (int bj = 0; bj < 2; ++bj) {
                        const f32x4 v0 = acc[ai][bj][m][0], v1 = acc[ai][bj][m][1];
                        float e0 = v0[0], o0 = v0[1], e1 = v0[2], o1 = v0[3], e2 = v1[0], o2 = v1[1], e3 = v1[2], o3 = v1[3];
                        if (pn >= 2) {
                            float ss = ((e0 * e0 + o0 * o0) + (e1 * e1 + o1 * o1)) + ((e2 * e2 + o2 * o2) + (e3 * e3 + o3 * o3));
                            ss += __shfl_xor(ss, 16); ss += __shfl_xor(ss, 32); km[bj] = fmaxf(km[bj], ss); }
                        float r0 = e0 * cs0[0] - o0 * cs0[1], s0 = o0 * cs0[0] + e0 * cs0[1];
                        float r1 = e1 * cs0[2] - o1 * cs0[3], s1 = o1 * cs0[2] + e1 * cs0[3];
                        float r2 = e2 * cs1[0] - o2 * cs1[1], s2 = o2 * cs1[0] + e2 * cs1[1];
                        float r3 = e3 * cs1[2] - o3 * cs1[3], s3 = o3 * cs1[2] + e3 * cs1[3];
                        const float sc = (pn < 2) ? C2 : 1.f;
                        u32x4 w; w.x = cvt_pk_bf16(r0 * sc, s0 * sc); w.y = cvt_pk_bf16(r1 * sc, s1 * sc); w.z = cvt_pk_bf16(r2 * sc, s2 * sc); w.w = cvt_pk_bf16(r3 * sc, s3 * sc);
                        const int col = (pn & 1) * 256 + bj * HALF + wc * 32 + 8 * fq;
                        bf16_t* dst = (pn < 2) ? (Q + (size_t)row * 512 + col) : (KA + (size_t)kvrow * 512 + col);
                        *(u32x4*)dst = w;
                    }
                } else if (pn < 8) {
#pragma unroll
                    for (int bj = 0; bj < 2; ++bj) {
                        const f32x4 v0 = acc[ai][bj][m][0], v1 = acc[ai][bj][m][1];
                        u32x4 w; w.x = cvt_pk_bf16(v0[0], v0[1]); w.y = cvt_pk_bf16(v0[2], v0[3]); w.z = cvt_pk_bf16(v1[0], v1[1]); w.w = cvt_pk_bf16(v1[2], v1[3]);
                        const int col = (pn & 1) * 256 + bj * HALF + wc * 32 + 8 * fq;
                        bf16_t* dst = (pn < 6) ? (VA + (size_t)kvrow * 512 + col) : (GB + (size_t)row * 512 + col);
                        *(u32x4*)dst = w;
                    }
                } else {
                    const f32x4 a0 = acc[ai][0][m][0], a1 = acc[ai][0][m][1], b0 = acc[ai][1][m][0], b1 = acc[ai][1][m][1];
                    u32x4 w; w.x = cvt_pk_bf16(a0[0] * b0[0], a0[1] * b0[1]); w.y = cvt_pk_bf16(a0[2] * b0[2], a0[3] * b0[3]);
                    w.z = cvt_pk_bf16(a1[0] * b1[0], a1[1] * b1[1]); w.w = cvt_pk_bf16(a1[2] * b1[2], a1[3] * b1[3]);
                    const int col = (pn - 8) * 128 + wc * 32 + 8 * fq;
                    *(u32x4*)(U + (size_t)row * 512 + col) = w;
                }
            }
        if (pn == 2 || pn == 3) {
            const int b = ctx ? (u.pm - 256) : (u.pm >> 3);
#pragma unroll
            for (int bj = 0; bj < 2; ++bj) { float v = km[bj];
#pragma unroll
                for (int d = 1; d < 16; d <<= 1) v = fmaxf(v, __shfl_xor(v, d));
                if (fr == 0 && fq == 0) atomicMax(kmaxh + ((b * 8 + (pn & 1) * 4 + bj * 2 + (wc >> 1)) * 2 + (wc & 1)), __float_as_uint(v)); }
        }
    }
};

struct EpiGU {
    static constexpr bool PERM = true, AFTER_DRAIN = false;
    bf16_t* H;
    __device__ __forceinline__ float silu(float x) const { return x * __builtin_amdgcn_rcpf(1.f + __expf(-x)); }
    __device__ __forceinline__ void operator()(const f32x4 (&acc)[2][2][4][2], const Unit& u, int wr, int wc, int fr, int fq) const {
#pragma unroll
        for (int ai = 0; ai < 2; ++ai)
#pragma unroll
            for (int m = 0; m < 4; ++m) {
                const int row = ai * HALF + wr * 64 + m * 16 + fr;
                const f32x4 a0 = acc[ai][0][m][0], a1 = acc[ai][0][m][1], b0 = acc[ai][1][m][0], b1 = acc[ai][1][m][1];
                u32x4 w; w.x = cvt_pk_bf16(silu(a0[0]) * b0[0], silu(a0[1]) * b0[1]); w.y = cvt_pk_bf16(silu(a0[2]) * b0[2], silu(a0[3]) * b0[3]);
                w.z = cvt_pk_bf16(silu(a1[0]) * b1[0], silu(a1[1]) * b1[1]); w.w = cvt_pk_bf16(silu(a1[2]) * b1[2], silu(a1[3]) * b1[3]);
                *(u32x4*)(H + (size_t)row * 1024 + u.pn * 128 + wc * 32 + 8 * fq) = w;
            }
    }
};
__device__ __forceinline__ unsigned pk4_fp8(float a, float b, float c, float d) { int w = 0; w = __builtin_amdgcn_cvt_pk_fp8_f32(a, b, w, false); w = __builtin_amdgcn_cvt_pk_fp8_f32(c, d, w, true); return (unsigned)w; }
constexpr float F8_ACT = 4.0f, F8_WGT = 64.0f, F8_INV = 1.0f / (4.0f * 64.0f);
struct EpiGU8 {
    static constexpr bool PERM = true, AFTER_DRAIN = false;
    unsigned char* H;
    __device__ __forceinline__ float hval(float g, float u) const {
        const float e = __builtin_amdgcn_exp2f(g * (-F8_INV * 1.4426950408889634f));
        const float r = __builtin_amdgcn_rcpf(1.f + e);
        return __builtin_amdgcn_fmed3f((g * u) * (r * (F8_INV * F8_INV * F8_ACT)), -448.f, 448.f); }
    __device__ __forceinline__ void row(const f32x4 (&acc)[2][2][4][2], const Unit& u, int ai, int m, int wr, int wc, int fr, int fq) const {
        unsigned off = (unsigned)((ai * HALF + wr * 64 + m * 16 + fr) * 1024 + u.pn * 128 + wc * 32 + 8 * fq);
        asm volatile("" : "+v"(off));
        const f32x4 a0 = acc[ai][0][m][0], a1 = acc[ai][0][m][1], b0 = acc[ai][1][m][0], b1 = acc[ai][1][m][1];
        u32x2 w; w.x = pk4_fp8(hval(a0[0], b0[0]), hval(a0[1], b0[1]), hval(a0[2], b0[2]), hval(a0[3], b0[3]));
        w.y = pk4_fp8(hval(a1[0], b1[0]), hval(a1[1], b1[1]), hval(a1[2], b1[2]), hval(a1[3], b1[3]));
        *(u32x2*)(H + off) = w;
    }
    __device__ __forceinline__ void operator()(const f32x4 (&acc)[2][2][4][2], const Unit& u, int wr, int wc, int fr, int fq) const {
#pragma unroll
        for (int ai = 0; ai < 2; ++ai)
#pragma unroll
            for (int m = 0; m < 4; ++m) row(acc, u, ai, m, wr, wc, fr, fq);
    }
};
struct EpiDown {
    static constexpr bool PERM = true, AFTER_DRAIN = false;
    bf16_t* Y; const float* gate; float scale;
    __device__ __forceinline__ void operator()(const f32x4 (&acc)[2][2][4][2], const Unit& u, int wr, int wc, int fr, int fq) const {
        asm volatile("" : "+v"(fr));
#pragma unroll
        for (int ai = 0; ai < 2; ++ai)
#pragma unroll
            for (int m = 0; m < 4; ++m) {
                const int row = ai * HALF + wr * 64 + m * 16 + fr; const float g = gate[row] * scale;
#pragma unroll
                for (int bj = 0; bj < 2; ++bj) { const f32x4 v0 = acc[ai][bj][m][0] * g, v1 = acc[ai][bj][m][1] * g;
                    u32x4 w; w.x = cvt_pk_bf16(v0[0], v0[1]); w.y = cvt_pk_bf16(v0[2], v0[3]); w.z = cvt_pk_bf16(v1[0], v1[1]); w.w = cvt_pk_bf16(v1[2], v1[3]);
                    *(u32x4*)(Y + (size_t)row * 1024 + u.pn * BM + bj * HALF + wc * 32 + 8 * fq) = w; }
            }
    }
};

constexpr float F8_Y = 64.0f;
struct EpiDown8 {
    static constexpr bool PERM = true, AFTER_DRAIN = false;
    unsigned char* Y; const LAS float* gl;
    __device__ __forceinline__ void row(const f32x4 (&acc)[2][2][4][2], const Unit& u, int ai, int m, int wr, int wc, int fr, int fq) const {
        unsigned off = (unsigned)((ai * HALF + wr * 64 + m * 16 + fr) * 1024 + u.pn * BM + wc * 32 + 8 * fq);
        asm volatile("" : "+v"(off));
        const float g = gl[ai * HALF + wr * 64 + m * 16 + fr];
#pragma unroll
        for (int bj = 0; bj < 2; ++bj) { f32x4 v0 = acc[ai][bj][m][0] * g, v1 = acc[ai][bj][m][1] * g;
#pragma unroll
            for (int i = 0; i < 4; ++i) { v0[i] = __builtin_amdgcn_fmed3f(v0[i], -448.f, 448.f); v1[i] = __builtin_amdgcn_fmed3f(v1[i], -448.f, 448.f); }
            u32x2 w; w.x = pk4_fp8(v0[0], v0[1], v0[2], v0[3]); w.y = pk4_fp8(v1[0], v1[1], v1[2], v1[3]);
            *(u32x2*)(Y + off + bj * HALF) = w; }
    }
    __device__ __forceinline__ void operator()(const f32x4 (&acc)[2][2][4][2], const Unit& u, int wr, int wc, int fr, int fq) const {
#pragma unroll
        for (int ai = 0; ai < 2; ++ai)
#pragma unroll
            for (int m = 0; m < 4; ++m) row(acc, u, ai, m, wr, wc, fr, fq);
    }
};

struct SchedProj {
    int G, c;
    __device__ __forceinline__ bool next(int i, Unit& u) const {
        if (i < 12) { const int x = c & 7, j = c >> 3, ja = j & 7, jb = j >> 3, r = i / 3, q = i - 3 * r;
            u.pm = x + 8 * (8 * r + ja); u.pn = 4 * q + jb; return true; }
        if (i == 12 && c < 128) { u.pm = 256 + (c >> 2); u.pn = 2 + (c & 3); return true; }
        return false;
    }
    __device__ __forceinline__ void a_ready(const Unit&) const {}
    __device__ __forceinline__ void done(const Unit&) const {}
};
struct SchedPanel {
    int pm, ntn;
    __device__ __forceinline__ bool next(int i, Unit& u) const { if (i >= ntn) return false; u.pm = pm; u.pn = i; return true; }
    __device__ __forceinline__ void a_ready(const Unit&) const {}
    __device__ __forceinline__ void done(const Unit&) const {}
};

typedef int i32x4v __attribute__((ext_vector_type(4)));
typedef int i32x8v __attribute__((ext_vector_type(8)));
__device__ __forceinline__ i32x8v cat8(bf16x8 a, bf16x8 b) { const i32x4v x = __builtin_bit_cast(i32x4v, a), y = __builtin_bit_cast(i32x4v, b); return __builtin_shufflevector(x, y, 0, 1, 2, 3, 4, 5, 6, 7); }
template <bool F8> struct Frag;
template <> struct Frag<false> { bf16x8 v[2]; __device__ __forceinline__ void set(bf16x8 a, bf16x8 b) { v[0] = a; v[1] = b; } };
template <> struct Frag<true> { i32x8v v; __device__ __forceinline__ void set(bf16x8 a, bf16x8 b) { v = cat8(a, b); } };
__device__ __forceinline__ f32x4 frag_mma(const Frag<false>& b, const Frag<false>& a, f32x4 c) { c = __builtin_amdgcn_mfma_f32_16x16x32_bf16(b.v[0], a.v[0], c, 0, 0, 0); return __builtin_amdgcn_mfma_f32_16x16x32_bf16(b.v[1], a.v[1], c, 0, 0, 0); }
__device__ __forceinline__ f32x4 frag_mma(const Frag<true>& b, const Frag<true>& a, f32x4 c) {
    const int sc1 = 0x7f7f7f7f;
    asm volatile("s_nop 1\n\tv_mfma_scale_f32_16x16x128_f8f6f4 %0, %1, %2, %0, %3, %3 op_sel_hi:[0,0,0]" : "+v"(c) : "v"(b.v), "v"(a.v), "v"(sc1));
    return c; }
template <class Epi, class Sched, bool ALIGN_EPI, bool SP2, bool GATHER = false, bool F8 = false, bool DEFER = false>
__device__ __forceinline__ void gemm_phase(LAS unsigned char* lds, const Gemm g, const Sched& S, const Epi& E) {
    const int tid = opaque_tid(), wid = __builtin_amdgcn_readfirstlane(tid >> 6), lane = tid & 63, wr = wid >> 2, wc = wid & 3, fr = lane & 15, fq = lane >> 4;
    const int K = g.K * (F8 ? 1 : 2), nt = K / 128;
    unsigned voffA[2][2], voffB[2];
#pragma unroll
    for (int i = 0; i < 2; ++i) { int R, C; stage_rc(tid * 16 + i * 8192, R, C); const int Rb = Epi::PERM ? ((R & ~31) + perm32(R & 31)) : R;
        if constexpr (GATHER) { voffA[0][i] = (unsigned)(g.gidx[R] * K + C * 2); voffA[1][i] = (unsigned)(g.gidx[HALF + R] * K + C * 2); }
        else { voffA[0][i] = (unsigned)(R * K + C * 2); voffA[1][i] = voffA[0][i]; }
        voffB[i] = (unsigned)(Rb * K + C * 2); }
    const size_t kstep = (size_t)(BK * 2);
    const size_t hstep = (size_t)HALF * K;
    const size_t hstepA = GATHER ? (size_t)0 : hstep;
    const size_t tstep = 2 * hstep;
    const unsigned ldsw = (unsigned)wid * 1024u;
    const int aoff = F8 ? lds_byte(wr * 64 + fr, (fq >> 1) * 32 + (fq & 1) * 16) : lds_byte(wr * 64 + fr, fq * 8), boff = F8 ? lds_byte(wc * 32 + fr, (fq >> 1) * 32 + (fq & 1) * 16) : lds_byte(wc * 32 + fr, fq * 8);
    const int aoff1 = F8 ? aoff + 16 : aoff + 1024, boff1 = F8 ? boff + 16 : boff + 1024;
#define PG8_SA(b, h) (((b) * 2 + (h)) * HTB)
#define PG8_SB(b, h) ((4 + (b) * 2 + (h)) * HTB)
#define PG8_STAGE(bufoff, gbase, voff) do { _Pragma("unroll") for (int _i = 0; _i < 2; ++_i) \
        __builtin_amdgcn_global_load_lds((const unsigned*)((const char*)(gbase) + (voff)[_i]), (LAS unsigned*)(lds + (bufoff) + ldsw + _i * 8192), 16, 0, 0); } while (0)
#define PG8_LDA(dst, b, h) do { _Pragma("unroll") for (int m = 0; m < 4; ++m) dst[m].set(*(const LAS bf16x8*)(lds + PG8_SA(b, h) + aoff + m * 2048), *(const LAS bf16x8*)(lds + PG8_SA(b, h) + aoff1 + m * 2048)); } while (0)
#define PG8_LDB(dst, b, h) do { _Pragma("unroll") for (int n = 0; n < 2; ++n) dst[n].set(*(const LAS bf16x8*)(lds + PG8_SB(b, h) + boff + n * 2048), *(const LAS bf16x8*)(lds + PG8_SB(b, h) + boff1 + n * 2048)); } while (0)
#define PG8_MMA(ai, bj, At, Bt) do { __builtin_amdgcn_s_setprio(1); _Pragma("unroll") for (int m = 0; m < 4; ++m) _Pragma("unroll") for (int n = 0; n < 2; ++n) \
        acc[ai][bj][m][n] = frag_mma(Bt[n], At[m], acc[ai][bj][m][n]); __builtin_amdgcn_s_setprio(0); } while (0)
#define PG8_MMA_E(ai, At, Bt) do { __builtin_amdgcn_s_setprio(1); _Pragma("unroll") for (int m = 0; m < 4; ++m) { \
        if constexpr (DEFER) { if (defer_now) { E.row(acc, pu, ai, m, wr, wc, fr, fq); \
            _Pragma("unroll") for (int n = 0; n < 2; ++n) { acc[ai][0][m][n] = (f32x4){0.f, 0.f, 0.f, 0.f}; acc[ai][1][m][n] = (f32x4){0.f, 0.f, 0.f, 0.f}; } } PG8_SCHED; } \
        _Pragma("unroll") for (int n = 0; n < 2; ++n) acc[ai][0][m][n] = frag_mma(Bt[n], At[m], acc[ai][0][m][n]); } __builtin_amdgcn_s_setprio(0); } while (0)
#define PG8_WAIT_V(n) asm volatile("s_waitcnt vmcnt(" #n ")" ::: "memory")
#define PG8_WAIT_L(n) asm volatile("s_waitcnt lgkmcnt(" #n ")" ::: "memory")
#define PG8_BAR __builtin_amdgcn_s_barrier()
#define PG8_SCHED __builtin_amdgcn_sched_barrier(0)
    Unit cur, nxt; int ui = 0;
    if (!S.next(0, cur)) return;
    f32x4 acc[2][2][4][2];
#pragma unroll
    for (int a = 0; a < 2; ++a)
#pragma unroll
        for (int b = 0; b < 2; ++b)
#pragma unroll
            for (int m = 0; m < 4; ++m)
#pragma unroll
                for (int n = 0; n < 2; ++n) acc[a][b][m][n] = (f32x4){0.f, 0.f, 0.f, 0.f};
    Frag<F8> At[4], B0[2], B1[2];
    bool pend = false; Unit pu = cur;
    const char* cA = (const char*)g.A + (size_t)cur.pm * tstep; const char* cB = (const char*)g.Bt + (size_t)cur.pn * tstep;
    S.a_ready(cur);
    if constexpr (SP2) {
        PG8_STAGE(PG8_SB(0, 0), cB, voffB); PG8_STAGE(PG8_SB(0, 1), cB + hstep, voffB); PG8_STAGE(PG8_SA(0, 0), cA, voffA[0]); PG8_STAGE(PG8_SA(0, 1), cA + hstepA, voffA[GATHER ? 1 : 0]);
        if (wr == 1) PG8_BAR;
        PG8_WAIT_V(2); PG8_BAR;
        PG8_STAGE(PG8_SB(1, 0), cB + kstep, voffB); PG8_STAGE(PG8_SA(1, 0), cA + kstep, voffA[0]); PG8_STAGE(PG8_SB(1, 1), cB + hstep + kstep, voffB);
        PG8_WAIT_V(6); PG8_BAR;
    } else {
        PG8_STAGE(PG8_SB(0, 0), cB, voffB); PG8_STAGE(PG8_SA(0, 0), cA, voffA[0]); PG8_STAGE(PG8_SB(0, 1), cB + hstep, voffB); PG8_STAGE(PG8_SA(0, 1), cA + hstepA, voffA[GATHER ? 1 : 0]);
        if (wr == 1) PG8_BAR;
        PG8_WAIT_V(4); PG8_BAR;
        PG8_STAGE(PG8_SB(1, 0), cB + kstep, voffB); PG8_STAGE(PG8_SA(1, 0), cA + kstep, voffA[0]); PG8_STAGE(PG8_SB(1, 1), cB + hstep + kstep, voffB);
        PG8_WAIT_V(6); PG8_BAR;
    }
    for (;;) {
        const bool has_next = S.next(ui + 1, nxt);
        const char* nA = has_next ? (const char*)g.A + (size_t)nxt.pm * tstep : cA; const char* nB = has_next ? (const char*)g.Bt + (size_t)nxt.pn * tstep : cB;
#pragma unroll 1
        for (int t = 0; t < nt; t += 2) {
            const bool last = (t == nt - 2);
            if constexpr (F8) { asm volatile("" : "+v"(voffA[0][0]), "+v"(voffA[0][1]), "+v"(voffB[0]), "+v"(voffB[1])); if constexpr (GATHER) asm volatile("" : "+v"(voffA[1][0]), "+v"(voffA[1][1])); }
            const char* a1 = cA + (size_t)(t + 1) * kstep;
            const char* a2 = last ? nA : cA + (size_t)(t + 2) * kstep; const char* b2 = last ? nB : cB + (size_t)(t + 2) * kstep;
            const char* a3 = a2 + kstep; const char* b3 = b2 + kstep;
            if (last && has_next) S.a_ready(nxt);
            if constexpr (SP2) {
            PG8_LDB(B0, 0, 0); PG8_LDB(B1, 0, 1); PG8_SCHED; PG8_LDA(At, 0, 0); PG8_STAGE(PG8_SA(1, 1), a1 + hstepA, voffA[GATHER ? 1 : 0]);
            bool defer_now = false; if constexpr (DEFER) defer_now = pend && t == 0;
            PG8_WAIT_V(8); PG8_WAIT_L(0); PG8_BAR; PG8_MMA_E(0, At, B0); PG8_MMA(0, 1, At, B1); PG8_BAR; PG8_SCHED;
            PG8_LDA(At, 0, 1); PG8_STAGE(PG8_SB(0, 0), b2, voffB); PG8_STAGE(PG8_SB(0, 1), b2 + hstep, voffB); PG8_STAGE(PG8_SA(0, 0), a2, voffA[0]);
            PG8_WAIT_V(8); PG8_WAIT_L(0); PG8_BAR; PG8_MMA_E(1, At, B0); PG8_MMA(1, 1, At, B1); PG8_BAR; PG8_SCHED;
            PG8_LDB(B0, 1, 0); PG8_LDB(B1, 1, 1); PG8_SCHED; PG8_LDA(At, 1, 0); PG8_STAGE(PG8_SA(0, 1), a2 + hstepA, voffA[GATHER ? 1 : 0]);
            PG8_WAIT_V(8); PG8_WAIT_L(0); PG8_BAR; PG8_MMA(0, 0, At, B0); PG8_MMA(0, 1, At, B1); PG8_BAR; PG8_SCHED;
            PG8_LDA(At, 1, 1); PG8_STAGE(PG8_SB(1, 0), b3, voffB); PG8_STAGE(PG8_SB(1, 1), b3 + hstep, voffB); PG8_STAGE(PG8_SA(1, 0), a3, voffA[0]);
            PG8_WAIT_V(8); PG8_WAIT_L(0); PG8_BAR; PG8_MMA(1, 0, At, B0); PG8_MMA(1, 1, At, B1); PG8_BAR; PG8_SCHED;
            } else {
            PG8_LDB(B0, 0, 0); PG8_SCHED; PG8_LDA(At, 0, 0); PG8_STAGE(PG8_SA(1, 1), a1 + hstepA, voffA[GATHER ? 1 : 0]);
            PG8_WAIT_L(8); PG8_BAR; PG8_WAIT_L(0); PG8_MMA(0, 0, At, B0); PG8_BAR; PG8_SCHED;
            PG8_LDB(B1, 0, 1); PG8_STAGE(PG8_SB(0, 0), b2, voffB);
            PG8_BAR; PG8_WAIT_L(0); PG8_MMA(0, 1, At, B1); PG8_BAR;
            PG8_LDA(At, 0, 1); PG8_STAGE(PG8_SA(0, 0), a2, voffA[0]);
            PG8_BAR; PG8_WAIT_L(0); PG8_MMA(1, 0, At, B0); PG8_BAR; PG8_SCHED;
            PG8_STAGE(PG8_SB(0, 1), b2 + hstep, voffB);
            PG8_WAIT_V(6); PG8_BAR; PG8_MMA(1, 1, At, B1); PG8_BAR;
            PG8_LDB(B0, 1, 0); PG8_SCHED; PG8_LDA(At, 1, 0); PG8_STAGE(PG8_SA(0, 1), a2 + hstepA, voffA[GATHER ? 1 : 0]);
            PG8_WAIT_L(8); PG8_BAR; PG8_WAIT_L(0); PG8_MMA(0, 0, At, B0); PG8_BAR; PG8_SCHED;
            PG8_LDB(B1, 1, 1); PG8_STAGE(PG8_SB(1, 0), b3, voffB);
            PG8_BAR; PG8_WAIT_L(0); PG8_MMA(0, 1, At, B1); PG8_BAR;
            PG8_LDA(At, 1, 1); PG8_STAGE(PG8_SA(1, 0), a3, voffA[0]);
            PG8_BAR; PG8_WAIT_L(0); PG8_MMA(1, 0, At, B0); PG8_BAR; PG8_SCHED;
            PG8_STAGE(PG8_SB(1, 1), b3 + hstep, voffB);
            PG8_WAIT_V(6); PG8_BAR; PG8_MMA(1, 1, At, B1); PG8_BAR;
            }
        }
        if (DEFER && has_next) { pend = true; pu = cur; cur = nxt; cA = nA; cB = nB; ++ui; continue; }
        if constexpr (ALIGN_EPI) { if (wr == 0) PG8_BAR; }
        if constexpr (F8) asm volatile("s_nop 15\n\ts_nop 7" ::: "memory");
        E(acc, cur, wr, wc, fr, fq); S.done(cur);
        if (!has_next) break;
#pragma unroll
        for (int a = 0; a < 2; ++a)
#pragma unroll
            for (int b = 0; b < 2; ++b)
#pragma unroll
                for (int m = 0; m < 4; ++m)
#pragma unroll
                    for (int n = 0; n < 2; ++n) acc[a][b][m][n] = (f32x4){0.f, 0.f, 0.f, 0.f};
        cur = nxt; cA = nA; cB = nB; ++ui;
        if constexpr (ALIGN_EPI) { if (wr == 1) PG8_BAR; }
    }
    PG8_WAIT_V(0);
    if constexpr (!ALIGN_EPI) { if (wr == 0) PG8_BAR; }
    PG8_BAR;
#undef PG8_SA
#undef PG8_SB
#undef PG8_STAGE
#undef PG8_LDA
#undef PG8_LDB
#undef PG8_MMA
#undef PG8_WAIT_V
#undef PG8_WAIT_L
#undef PG8_BAR
#undef PG8_SCHED
}
}

typedef GAS unsigned gu32;
#define RLX_AGENT __ATOMIC_RELAXED, __HIP_MEMORY_SCOPE_AGENT
#define LDS_WAIT() asm volatile("s_waitcnt lgkmcnt(0)" ::: "memory")
#define VM_WAIT() asm volatile("s_waitcnt vmcnt(0)" ::: "memory")
__device__ __forceinline__ unsigned pk2(float lo, float hi) { return pg8::cvt_pk_bf16(lo, hi); }
__device__ __forceinline__ float bf2f(unsigned short h) { return __uint_as_float((unsigned)h << 16); }
__device__ __forceinline__ float bflo(unsigned w) { return __uint_as_float(w << 16); }
__device__ __forceinline__ float bfhi(unsigned w) { return __uint_as_float(w & 0xffff0000u); }
__device__ __forceinline__ float wave_sum(float v) {
    v += __builtin_bit_cast(float, __builtin_amdgcn_update_dpp(0, __builtin_bit_cast(int, v), 0xB1, 0xf, 0xf, true));
    v += __builtin_bit_cast(float, __builtin_amdgcn_update_dpp(0, __builtin_bit_cast(int, v), 0x4E, 0xf, 0xf, true));
    v += __builtin_bit_cast(float, __builtin_amdgcn_update_dpp(0, __builtin_bit_cast(int, v), 0x141, 0xf, 0xf, true));
    v += __builtin_bit_cast(float, __builtin_amdgcn_update_dpp(0, __builtin_bit_cast(int, v), 0x140, 0xf, 0xf, true));
    v += __builtin_bit_cast(float, __builtin_amdgcn_update_dpp(0, __builtin_bit_cast(int, v), 0x142, 0xa, 0xf, false));
    v += __builtin_bit_cast(float, __builtin_amdgcn_update_dpp(0, __builtin_bit_cast(int, v), 0x143, 0xc, 0xf, false));
    return __builtin_bit_cast(float, __builtin_amdgcn_readlane(__builtin_bit_cast(int, v), 63));
}

#define XB_TMO      128
#define XB_XCNT(j)  (256  + 64 * (j))
#define XB_XSUB(j)  (1280 + 64 * (j))
#define XB_XGEN(j)  (2304 + 64 * (j))
#define XB_TOP      3328
#define XB_TOPGEN   3392
#define XCD_BAR_WORDS 3456
#define XB_SPIN_CAP (1u << 18)
__device__ __forceinline__ unsigned xb_ld(unsigned* p)              { return __hip_atomic_load(p, __ATOMIC_RELAXED, __HIP_MEMORY_SCOPE_AGENT); }
__device__ __forceinline__ unsigned xb_add(unsigned* p, unsigned v) { return __hip_atomic_fetch_add(p, v, __ATOMIC_RELAXED, __HIP_MEMORY_SCOPE_AGENT); }
__device__ __forceinline__ unsigned xb_xcc_id() { return (unsigned)__builtin_amdgcn_s_getreg((3 << 11) | 20) & 0xFu; }
#define XB_SPIN(cond, bar) do { unsigned _sp = 0; while (cond) { __builtin_amdgcn_s_sleep(1); \
    if ((++_sp & 255u) == 0u) { if (xb_ld(&(bar)[XB_TMO])) break; if (_sp > XB_SPIN_CAP) { atomicAdd(&(bar)[XB_TMO], 1u); break; } } } } while (0)
struct XcdBarrier { unsigned* bar; unsigned x; volatile LAS unsigned* st; };
__device__ __forceinline__ XcdBarrier xcd_barrier_post(unsigned* bar, volatile LAS unsigned* st) {
    XcdBarrier b; b.bar = bar; b.x = xb_xcc_id(); b.st = st;
    if (threadIdx.x == 0) (void)xb_add(&bar[XB_XCNT(b.x)], 1u);
    return b;
}
__device__ __forceinline__ void xcd_barrier_complete(unsigned* bar, unsigned x, unsigned& nloc, unsigned& nx) {
    const unsigned G = gridDim.x * gridDim.y * gridDim.z;
    unsigned sum, cnt, mine, sp = 0u;
    for (;;) {
        sum = 0u; cnt = 0u; mine = 0u;
#pragma unroll
        for (unsigned j = 0; j < 16; ++j) { const unsigned c = xb_ld(&bar[XB_XCNT(j)]); sum += c; cnt += (c > 0u) ? 1u : 0u; mine = (j == x) ? c : mine; }
        if (sum == G) break;
        __builtin_amdgcn_s_sleep(1);
        if ((++sp & 255u) == 0u) { if (xb_ld(&bar[XB_TMO])) break; if (sp > XB_SPIN_CAP) { atomicAdd(&bar[XB_TMO], 1u); break; } }
    }
    nloc = mine > 0u ? mine : 1u; nx = cnt > 0u ? cnt : 1u;
}
__device__ __forceinline__ void xcd_barrier(const XcdBarrier& b) {
    asm volatile("s_waitcnt vmcnt(0)" ::: "memory");
    __syncthreads();
    if (threadIdx.x == 0) {
        unsigned* bar = b.bar;
        __builtin_amdgcn_s_waitcnt(0);
        unsigned nloc = b.st[0], nx = b.st[1];
        if (nloc == 0u) { xcd_barrier_complete(bar, b.x, nloc, nx); b.st[0] = nloc; b.st[1] = nx; }
        const unsigned old = xb_add(&bar[XB_XSUB(b.x)], 1u);
        const unsigned gen = old / nloc;
        if (old + 1u == (gen + 1u) * nloc) {
            __builtin_amdgcn_fence(__ATOMIC_RELEASE, "agent");
            asm volatile("s_waitcnt vmcnt(0)" ::: "memory");
            const unsigned og = xb_add(&bar[XB_TOP], 1u);
            const unsigned tg = og / nx;
            if (og + 1u == (tg + 1u) * nx) xb_add(&bar[XB_TOPGEN], 1u);
            else XB_SPIN(xb_ld(&bar[XB_TOPGEN]) == tg, bar);
            __builtin_amdgcn_fence(__ATOMIC_ACQUIRE, "agent");
            xb_add(&bar[XB_XGEN(b.x)], 1u);
            asm volatile("s_waitcnt vmcnt(0)" ::: "memory");
        } else {
            XB_SPIN(xb_ld(&bar[XB_XGEN(b.x)]) == gen, bar);
            __builtin_amdgcn_fence(__ATOMIC_ACQUIRE, "agent");
            asm volatile("s_waitcnt vmcnt(0)" ::: "memory");
        }
    }
    __syncthreads();
}

constexpr int RING_BYTES = 131072;
constexpr int LDSCTL_OFF = RING_BYTES, MISC_OFF = LDSCTL_OFF + 320;
constexpr int LDS_BYTES = 147456;
constexpr int CW_BAR = 4096;
constexpr int CW_KMAX = 65536;

struct Args { const float* in[22]; float* out; unsigned char* ws; int ph_lo, ph_hi; };
enum { I_X = 0, I_C, I_CTX, I_CCTX, I_WADA, I_BADA, I_NPRE_MIX, I_NPOST_MIX, I_NPRE_FFN, I_NPOST_FFN, I_WIN, I_CONVW, I_LQ1, I_LK1, I_LQ2, I_LK2, I_SUBLN, I_WOUT, I_WROUTER, I_WGATE, I_WUP, I_WDOWN };

__device__ __forceinline__ int win_dest(int n) {
    if (n < 1024) { const int j = n & 63; const int p = ((j >> 5) << 5) + ((j & 15) << 1) + ((j >> 4) & 1); return (n & ~63) + p; }
    if (n < 1536) { const int dv = n & 127; return (n & ~127) + ((dv & 3) << 5) + (dv >> 2); }
    if (n < 2048) return n;
    int c = n - 2048; const int isx = c >= 512; c &= 511; return 2048 + ((c >> 7) << 8) + (isx << 7) + (c & 127);
}
template <int MODE>
__device__ __forceinline__ int tr_dest(int n) {
    if (MODE == 0) return n;
    if (MODE == 1) return win_dest(n);
    if (MODE == 2) return ((n >> 7) << 8) + (n & 127);
    return ((n >> 7) << 8) + 128 + (n & 127);
}
template <int MODE>
__device__ __forceinline__ void p0_transpose_item_f8(const float* W, int K, int N, unsigned char* WT, LAS float* scr, int item, int lane) {
    const int nblk = N / 32, kb = item / nblk, nb = item % nblk, k0 = 64 * kb, n0 = 32 * nb;
#pragma unroll 8
    for (int i = 0; i < 32; ++i) { const int kk = 2 * i + (lane >> 5); scr[kk * 33 + (lane & 31)] = __builtin_nontemporal_load(W + (size_t)(k0 + kk) * N + n0 + (lane & 31)) * pg8::F8_WGT; }
    LDS_WAIT(); asm volatile("" ::: "memory");
    const int c = lane & 7;
#pragma unroll
    for (int j = 0; j < 4; ++j) { const int n = (lane >> 3) + 8 * j; const LAS float* s = scr + (8 * c) * 33 + n;
        u32x2 o; o.x = pg8::pk4_fp8(s[0 * 33], s[1 * 33], s[2 * 33], s[3 * 33]); o.y = pg8::pk4_fp8(s[4 * 33], s[5 * 33], s[6 * 33], s[7 * 33]);
        *(GAS u32x2*)(WT + (size_t)tr_dest<MODE>(n0 + n) * K + k0 + 8 * c) = o; }
    LDS_WAIT(); asm volatile("" ::: "memory");
}
template <int MODE>
__device__ __forceinline__ void p0_transpose_item(const float* W, int K, int N, bf16_t* WT, LAS float* scr, int item, int lane) {
    const int nblk = N / 32, kb = item / nblk, nb = item % nblk, k0 = 64 * kb, n0 = 32 * nb;
#pragma unroll 8
    for (int i = 0; i < 32; ++i) { const int kk = 2 * i + (lane >> 5); scr[kk * 33 + (lane & 31)] = W[(size_t)(k0 + kk) * N + n0 + (lane & 31)]; }
    LDS_WAIT(); asm volatile("" ::: "memory");
    const int c = lane & 7;
#pragma unroll
    for (int j = 0; j < 4; ++j) { const int n = (lane >> 3) + 8 * j; const LAS float* s = scr + (8 * c) * 33 + n;
        u32x4 o; o.x = pk2(s[0 * 33], s[1 * 33]); o.y = pk2(s[2 * 33], s[3 * 33]); o.z = pk2(s[4 * 33], s[5 * 33]); o.w = pk2(s[6 * 33], s[7 * 33]);
        *(GAS u32x4*)(WT + (size_t)tr_dest<MODE>(n0 + n) * K + k0 + 8 * c) = o; }
    LDS_WAIT(); asm volatile("" ::: "memory");
}

__device__ __forceinline__ void p0_prologue(const Args& a, LAS unsigned char* lds, int vcu, int G) {
    const int tid = opaque_tid(), lane = tid & 63, wave = __builtin_amdgcn_readfirstlane(tid >> 6);
    LAS float* scr = (LAS float*)(lds + wave * 16384);
    const int gw = vcu * NWAVES + wave, NGW = G * NWAVES;
    unsigned char* ws = a.ws;
    if (gw < 96 * 16) {
        float* MODP = (float*)(ws + WS_MODP);
        const float* wada = a.in[I_WADA];
        for (int it = gw; it < 96 * 16; it += NGW) {
            const int cg = it % 96, kc = it / 96;
            for (int b = 0; b < 33; ++b) { const float v = (b < 32) ? a.in[I_C][b * D + kc * 64 + lane] : a.in[I_CCTX][kc * 64 + lane]; scr[b * 64 + lane] = v / (1.f + __expf(-v)); }
            LDS_WAIT(); asm volatile("" ::: "memory");
            float acc[33];
#pragma unroll
            for (int b = 0; b < 33; ++b) acc[b] = 0.f;
            const float* wp = wada + (size_t)(kc * 64) * NMOD + cg * 64 + lane;
#pragma unroll 2
            for (int k = 0; k < 64; k += 4) {
                const float w0 = __builtin_nontemporal_load(wp + (size_t)(k + 0) * NMOD), w1 = __builtin_nontemporal_load(wp + (size_t)(k + 1) * NMOD),
                            w2 = __builtin_nontemporal_load(wp + (size_t)(k + 2) * NMOD), w3 = __builtin_nontemporal_load(wp + (size_t)(k + 3) * NMOD);
#pragma unroll
                for (int b = 0; b < 33; ++b) { const f32x4 sv4 = *(const LAS f32x4*)(scr + b * 64 + k); acc[b] += (sv4.x * w0 + sv4.y * w1) + (sv4.z * w2 + sv4.w * w3); }
            }
#pragma unroll
            for (int b = 0; b < 33; ++b) MODP[((size_t)kc * 33 + b) * NMOD + cg * 64 + lane] = acc[b];
            LDS_WAIT(); asm volatile("" ::: "memory");
        }
    } else {
        float* tab = (float*)(ws + WS_TAB);
        const int nw = NGW - 96 * 16;
        for (int e = (gw - 96 * 16) * 64 + lane; e < T * 32; e += nw * 64) {
            const int t = e >> 5, i = e & 31;
            const float inv = powf(10000.0f, -(float)(2 * (i & 15)) / 32.0f);
            const float pos = (i < 16) ? (float)(t >> 6) : (float)(t & 63);
            const float ang = pos * inv;
            tab[2 * e] = cosf(ang); tab[2 * e + 1] = sinf(ang);
        }
    }
}
__device__ __forceinline__ void inout_weight_copies(const Args& a, LAS unsigned char* lds, int vcu, int G) {
    const int tid = opaque_tid(), lane = tid & 63, wave = __builtin_amdgcn_readfirstlane(tid >> 6);
    LAS float* scr = (LAS float*)(lds + 16384 + wave * 12288);
    const int gw = vcu * NWAVES + wave, NGW = G * NWAVES;
    unsigned char* ws = a.ws;
    constexpr int I_IN = (D / 64) * (NPROJ / 32), I_OUT = (D / 64) * (D / 32);
    constexpr int NITEMS = I_IN + I_OUT;
    bf16_t* Win_t = (bf16_t*)(ws + WS_WIN); bf16_t* Wout_t = (bf16_t*)(ws + WS_WOUT);
    for (int it = gw; it < NITEMS; it += NGW) {
        int r = it;
        if (r < I_IN) { p0_transpose_item<1>(a.in[I_WIN], D, NPROJ, Win_t, scr, r, lane); continue; } r -= I_IN;
        p0_transpose_item<0>(a.in[I_WOUT], D, D, Wout_t, scr, r, lane);
    }
}
__device__ __forceinline__ void expert_weight_copies(const Args& a, LAS unsigned char* lds, int gw0  , int ngroups, int r_lo, int r_hi) {
    const int tid = opaque_tid(), lane = tid & 63, wave = __builtin_amdgcn_readfirstlane(tid >> 6);
    LAS float* scr = (LAS float*)(lds + wave * 16384);
    const int gw = gw0 * NWAVES + wave, NGW = ngroups * NWAVES;
    unsigned char* ws = a.ws;
    constexpr int I_EXP = (D / 64) * (D / 32);
    unsigned char* Wgu_t = ws + WS_WGU; unsigned char* Wdn_t = ws + WS_WDN;
    for (int r = r_lo + gw; r < r_hi; r += NGW) {
        const int e = r / (3 * I_EXP), q = (r % (3 * I_EXP)) / I_EXP, rr = r % I_EXP;
        if (q == 0) p0_transpose_item_f8<2>(a.in[I_WGATE] + (size_t)e * D * D, D, D, Wgu_t + (size_t)e * 2048 * D, scr, rr, lane);
        else if (q == 1) p0_transpose_item_f8<3>(a.in[I_WUP] + (size_t)e * D * D, D, D, Wgu_t + (size_t)e * 2048 * D, scr, rr, lane);
        else p0_transpose_item_f8<0>(a.in[I_WDOWN] + (size_t)e * D * D, D, D, Wdn_t + (size_t)e * D * D, scr, rr, lane);
    }
    __syncthreads();
}

struct RowF { f32x4 v[4]; };
__device__ __forceinline__ void row_load(RowF& r, const float* xrow, int lane) {
    const f32x4* xr = (const f32x4*)xrow + lane;
#pragma unroll
    for (int j = 0; j < 4; ++j) r.v[j] = __builtin_nontemporal_load(xr + 64 * j);
}
__device__ __forceinline__ void norm_mod_row(const RowF& r, bf16_t* orow, const float* gain, const LAS float* sc, const LAS float* sh, int lane) {
    const f32x4* gr = (const f32x4*)gain + lane;
    float s = 0.f;
#pragma unroll
    for (int j = 0; j < 4; ++j) s += (r.v[j].x * r.v[j].x + r.v[j].y * r.v[j].y) + (r.v[j].z * r.v[j].z + r.v[j].w * r.v[j].w);
    const float rstd = 1.0f / sqrtf(wave_sum(s) * (1.f / D) + EPS);
    u32x2* o8 = (u32x2*)orow + lane;
#pragma unroll
    for (int j = 0; j < 4; ++j) { const f32x4 g = gr[64 * j]; const f32x4 c1 = *(const LAS f32x4*)(sc + 4 * lane + 256 * j), h1 = *(const LAS f32x4*)(sh + 4 * lane + 256 * j);
        const f32x4 y = (r.v[j] * rstd) * g; const f32x4 z = y * (c1 + 1.0f) + h1;
        u32x2 w; w.x = pk2(z.x, z.y); w.y = pk2(z.z, z.w); o8[64 * j] = w; }
}
__device__ __forceinline__ void p1_xn(const Args& a, LAS unsigned char* lds, int c, int G) {
    const int tid = opaque_tid(), lane = tid & 63, wave = __builtin_amdgcn_readfirstlane(tid >> 6);
    unsigned char* ws = a.ws;
    const float* MODP = (const float*)(ws + WS_MODP); float* MOD = (float*)(ws + WS_MOD); const float* bada = a.in[I_BADA];
    { const int per = (33 * NMOD + G - 1) / G;
      for (int i = c * per + tid; i < (c + 1) * per && i < 33 * NMOD; i += NTHREADS) { const int r = i / NMOD, n = i - r * NMOD; float s = bada[n];
#pragma unroll
            for (int kc = 0; kc < 16; ++kc) s += MODP[((size_t)kc * 33 + r) * NMOD + n];
            MOD[i] = s; } }
    LAS float* sv = (LAS float*)lds;
    bf16_t* XN = (bf16_t*)(ws + WS_XN);
    const float* X = a.in[I_X]; const float* CTX = a.in[I_CTX]; const float* gain = a.in[I_NPRE_MIX];
    for (int p = c; p < 256; p += G) {
        const int b = p >> 3;
        const int rbase = p * 256 + wave * 32;
        RowF a0, a1, a2, a3;
        row_load(a0, X + (size_t)rbase * D, lane); row_load(a1, X + (size_t)(rbase + 1) * D, lane); row_load(a2, X + (size_t)(rbase + 2) * D, lane); row_load(a3, X + (size_t)(rbase + 3) * D, lane);
        __syncthreads();
        for (int n = tid; n < 4096; n += NTHREADS) { const int r = (n < 2048) ? b : 32; const int col = n & 2047; float s = bada[col];
#pragma unroll
            for (int kc = 0; kc < 16; ++kc) s += MODP[((size_t)kc * 33 + r) * NMOD + col];
            sv[n] = s; }
        __syncthreads();
        const int crow = p * 32 + wave * 4;
        for (int i = 0; i < 8; ++i) {
            RowF n0, n1, n2, n3;
            const float* nx = (i + 1 < 8) ? X + (size_t)(rbase + 4 * (i + 1)) * D : CTX + (size_t)crow * D;
            row_load(n0, nx, lane); row_load(n1, nx + D, lane); row_load(n2, nx + 2 * D, lane); row_load(n3, nx + 3 * D, lane);
            bf16_t* orow = XN + (size_t)(rbase + 4 * i) * D;
            norm_mod_row(a0, orow, gain, sv + 1024, sv, lane);
            norm_mod_row(a1, orow + D, gain, sv + 1024, sv, lane);
            norm_mod_row(a2, orow + 2 * D, gain, sv + 1024, sv, lane);
            norm_mod_row(a3, orow + 3 * D, gain, sv + 1024, sv, lane);
            a0 = n0; a1 = n1; a2 = n2; a3 = n3;
        }
        { bf16_t* orow = XN + (size_t)(M + crow) * D;
          norm_mod_row(a0, orow, gain, sv + 3072, sv + 2048, lane);
          norm_mod_row(a1, orow + D, gain, sv + 3072, sv + 2048, lane);
          norm_mod_row(a2, orow + 2 * D, gain, sv + 3072, sv + 2048, lane);
          norm_mod_row(a3, orow + 3 * D, gain, sv + 3072, sv + 2048, lane); }
    }
}

__device__ __forceinline__ float half_sum32(float v, int hi) {
    v += __builtin_bit_cast(float, __builtin_amdgcn_update_dpp(0, __builtin_bit_cast(int, v), 0xB1, 0xf, 0xf, true));
    v += __builtin_bit_cast(float, __builtin_amdgcn_update_dpp(0, __builtin_bit_cast(int, v), 0x4E, 0xf, 0xf, true));
    v += __builtin_bit_cast(float, __builtin_amdgcn_update_dpp(0, __builtin_bit_cast(int, v), 0x141, 0xf, 0xf, true));
    v += __builtin_bit_cast(float, __builtin_amdgcn_update_dpp(0, __builtin_bit_cast(int, v), 0x140, 0xf, 0xf, true));
    v += __builtin_bit_cast(float, __builtin_amdgcn_update_dpp(0, __builtin_bit_cast(int, v), 0x142, 0xa, 0xf, false));
    const float s0 = __builtin_bit_cast(float, __builtin_amdgcn_readlane(__builtin_bit_cast(int, v), 31)), s1 = __builtin_bit_cast(float, __builtin_amdgcn_readlane(__builtin_bit_cast(int, v), 63));
    return hi ? s1 : s0;
}
namespace att {
constexpr int KP = 272, KBUF = 64 * KP, VBUF = 16384;
constexpr int OFF_K = 0, OFF_V = 2 * KBUF, OFF_WSF = OFF_V + 2 * VBUF, OFF_END = OFF_WSF + NWAVES * 256;
static_assert(OFF_WSF >= 65536 && OFF_END <= RING_BYTES, "attention LDS map");
constexpr int NT = TK / 64;
constexpr float THR = 8.0f;
__device__ __forceinline__ int crow(int r, int hi) { return (r & 3) + 8 * (r >> 2) + 4 * hi; }
__device__ __forceinline__ float max3f(float a, float b, float c) { float r; asm("v_max3_f32 %0, %1, %2, %3" : "=v"(r) : "v"(a), "v"(b), "v"(c)); return r; }
__device__ __forceinline__ float max2f(float a, float b) { float r; asm("v_max_f32_e32 %0, %1, %2" : "=v"(r) : "v"(a), "v"(b)); return r; }
__device__ __forceinline__ s16x4 vtr(const LAS unsigned char* p) { return __builtin_bit_cast(s16x4, __builtin_amdgcn_ds_read_tr16_b64_v4i16((LAS s16x4*)p)); }

#define ATT_BAR() asm volatile("s_waitcnt lgkmcnt(0)\n\ts_barrier" ::: "memory")
#define ATT_SB() __builtin_amdgcn_sched_barrier(0)
#define ATT_KLD(i, KF) KF = *(const LAS bf16x8*)(kb_ + ((i) & 1) * (32 * KP) + ((i) >> 1) * 32)
#define ATT_XSTEP(i, KC, KN) do { if ((i) + 2 < 8) { ATT_KLD((i) + 2, KN); } \
    if ((i) == 0) p0 = __builtin_amdgcn_mfma_f32_32x32x16_bf16(KC, qr[0], negref, 0, 0, 0); \
    else if ((i) == 1) p1 = __builtin_amdgcn_mfma_f32_32x32x16_bf16(KC, qr[0], negref, 0, 0, 0); \
    else if (((i) & 1) == 0) p0 = __builtin_amdgcn_mfma_f32_32x32x16_bf16(KC, qr[(i) >> 1], p0, 0, 0, 0); else p1 = __builtin_amdgcn_mfma_f32_32x32x16_bf16(KC, qr[(i) >> 1], p1, 0, 0, 0); ATT_SB(); } while (0)
#define ATT_X(kcur) do { \
    const LAS unsigned char* kb_ = lds + OFF_K + (kcur) * KBUF + koff; \
    bf16x8 ka_, kb2_, kc_; \
    ATT_KLD(0, ka_); ATT_KLD(1, kb2_); \
    ATT_SB(); \
    ATT_XSTEP(0, ka_, kc_); ATT_XSTEP(1, kb2_, ka_); ATT_XSTEP(2, kc_, kb2_); ATT_XSTEP(3, ka_, kc_); \
    ATT_XSTEP(4, kb2_, ka_); ATT_XSTEP(5, kc_, kb2_); ATT_XSTEP(6, ka_, kc_); ATT_XSTEP(7, kb2_, ka_); \
} while (0)
#define ATT_EXP2(i, PWN) do { \
    const float e0_ = __builtin_amdgcn_exp2f((i) < 8 ? p0[2 * ((i) & 7)] : p1[2 * ((i) & 7)]), e1_ = __builtin_amdgcn_exp2f((i) < 8 ? p0[2 * ((i) & 7) + 1] : p1[2 * ((i) & 7) + 1]); \
    sacc_ += e0_ + e1_; PWN[(i) >> 2][(i) & 3] = pk2(e0_, e1_); asm volatile("" : "+v"(PWN[(i) >> 2]), "+v"(sacc_)); } while (0)
#define ATT_VLD(i, LO, HI) do { LO = vtr(vb_ + ((i) & 3) * 4096 + ((i) >> 2) * 1024); HI = vtr(vb_ + ((i) & 3) * 4096 + ((i) >> 2) * 1024 + 512); } while (0)
#define ATT_VF(LO, HI) ((bf16x8){LO[0], LO[1], LO[2], LO[3], HI[0], HI[1], HI[2], HI[3]})
#define ATT_YSTEP(i, PWC, PWN, LC, HC, LN, HN) do { if ((i) + 2 < 16) { ATT_VLD((i) + 2, LN, HN); } \
    o[(i) & 3] = __builtin_amdgcn_mfma_f32_32x32x16_bf16(__builtin_bit_cast(bf16x8, PWC[(i) >> 2]), ATT_VF(LC, HC), o[(i) & 3], 0, 0, 0); \
    ATT_EXP2(i, PWN); ATT_SB(); } while (0)
#define ATT_Y(vcur, PWC, PWN) do { \
    const LAS unsigned char* vb_ = lds + OFF_V + (vcur) * VBUF + voff; \
    float sacc_ = 0.f; s16x4 la_, ha_, lb_, hb_, lc_, hc_; \
    ATT_VLD(0, la_, ha_); ATT_VLD(1, lb_, hb_); ATT_SB(); \
    ATT_YSTEP(0, PWC, PWN, la_, ha_, lc_, hc_); ATT_YSTEP(1, PWC, PWN, lb_, hb_, la_, ha_); ATT_YSTEP(2, PWC, PWN, lc_, hc_, lb_, hb_); \
    ATT_YSTEP(3, PWC, PWN, la_, ha_, lc_, hc_); ATT_YSTEP(4, PWC, PWN, lb_, hb_, la_, ha_); ATT_YSTEP(5, PWC, PWN, lc_, hc_, lb_, hb_); \
    ATT_YSTEP(6, PWC, PWN, la_, ha_, lc_, hc_); ATT_YSTEP(7, PWC, PWN, lb_, hb_, la_, ha_); ATT_YSTEP(8, PWC, PWN, lc_, hc_, lb_, hb_); \
    ATT_YSTEP(9, PWC, PWN, la_, ha_, lc_, hc_); ATT_YSTEP(10, PWC, PWN, lb_, hb_, la_, ha_); ATT_YSTEP(11, PWC, PWN, lc_, hc_, lb_, hb_); \
    ATT_YSTEP(12, PWC, PWN, la_, ha_, lc_, hc_); ATT_YSTEP(13, PWC, PWN, lb_, hb_, la_, ha_); ATT_YSTEP(14, PWC, PWN, lc_, hc_, lb_, hb_); \
    ATT_YSTEP(15, PWC, PWN, la_, ha_, lc_, hc_); \
    l_reg += sacc_; \
} while (0)
#define ATT_Y0(PWN) do { float sacc_ = 0.f; _Pragma("unroll") for (int i = 0; i < 16; ++i) ATT_EXP2(i, PWN); l_reg += sacc_; } while (0)
#define ATT_ZSTEP(i, PWC, LC, HC, LN, HN) do { if ((i) + 2 < 16) { ATT_VLD((i) + 2, LN, HN); } \
    o[(i) & 3] = __builtin_amdgcn_mfma_f32_32x32x16_bf16(__builtin_bit_cast(bf16x8, PWC[(i) >> 2]), ATT_VF(LC, HC), o[(i) & 3], 0, 0, 0); ATT_SB(); } while (0)
#define ATT_Z(vcur, PWC) do { \
    const LAS unsigned char* vb_ = lds + OFF_V + (vcur) * VBUF + voff; \
    s16x4 la_, ha_, lb_, hb_, lc_, hc_; \
    ATT_VLD(0, la_, ha_); ATT_VLD(1, lb_, hb_); ATT_SB(); \
    ATT_ZSTEP(0, PWC, la_, ha_, lc_, hc_); ATT_ZSTEP(1, PWC, lb_, hb_, la_, ha_); ATT_ZSTEP(2, PWC, lc_, hc_, lb_, hb_); \
    ATT_ZSTEP(3, PWC, la_, ha_, lc_, hc_); ATT_ZSTEP(4, PWC, lb_, hb_, la_, ha_); ATT_ZSTEP(5, PWC, lc_, hc_, lb_, hb_); \
    ATT_ZSTEP(6, PWC, la_, ha_, lc_, hc_); ATT_ZSTEP(7, PWC, lb_, hb_, la_, ha_); ATT_ZSTEP(8, PWC, lc_, hc_, lb_, hb_); \
    ATT_ZSTEP(9, PWC, la_, ha_, lc_, hc_); ATT_ZSTEP(10, PWC, lb_, hb_, la_, ha_); ATT_ZSTEP(11, PWC, lc_, hc_, lb_, hb_); \
    ATT_ZSTEP(12, PWC, la_, ha_, lc_, hc_); ATT_ZSTEP(13, PWC, lb_, hb_, la_, ha_); ATT_ZSTEP(14, PWC, lc_, hc_, lb_, hb_); \
    ATT_ZSTEP(15, PWC, la_, ha_, lc_, hc_); \
} while (0)
#define ATT_STAGE(j) do { \
    if ((j) + 1 < NT) { _Pragma("unroll") for (int i = 0; i < 2; ++i) *(LAS u32x4*)(lds + OFF_K + (((j) + 1) & 1) * KBUF + kdst[i]) = kr[i]; } \
    _Pragma("unroll") for (int i = 0; i < 2; ++i) *(LAS u32x4*)(lds + OFF_V + ((j) & 1) * VBUF + vdst[i]) = vr[i]; \
    if ((j) + 2 < NT) { _Pragma("unroll") for (int i = 0; i < 2; ++i) kr[i] = ATT_BLD(krs, gsrc[i], ((j) + 2) * (64 * 1024)); } \
    if ((j) + 1 < NT) { _Pragma("unroll") for (int i = 0; i < 2; ++i) vr[i] = ATT_BLD(vrs, gsrc[i], ((j) + 1) * (64 * 1024)); } } while (0)
#define ATT_BLD(rs, voff_, soff_) __builtin_bit_cast(u32x4, __builtin_amdgcn_raw_buffer_load_b128(rs, (int)(voff_), (int)(soff_), 0))

__device__ __forceinline__ void unit(LAS unsigned char* lds, int b, int h, int qb, const bf16_t* Q, const bf16_t* KA, const bf16_t* VA, bf16_t* MIXIN, const float* subg, float lam, const unsigned* KM) {
    const int tid = opaque_tid(), lane = tid & 63, r32 = lane & 31, hi = lane >> 5;
    const int wid = __builtin_amdgcn_readfirstlane(tid >> 6), w = wid & 3, m = wid >> 2;
    LAS float* wsf = (LAS float*)(lds + OFF_WSF) + wid * 64;
    const int rowQ = b * T + qb * 128 + w * 32;
    bf16x8 qr[4];
#pragma unroll
    for (int d0 = 0; d0 < 4; ++d0) qr[d0] = *(const bf16x8*)(Q + (size_t)(rowQ + r32) * 512 + h * 128 + m * 64 + d0 * 16 + hi * 8);
    const bf16_t* Kb = KA + (size_t)b * TK * 512 + h * 128; const bf16_t* Vb = VA + (size_t)b * TK * 512 + h * 128;
    const __amdgpu_buffer_rsrc_t krs = __builtin_amdgcn_make_buffer_rsrc((void*)Kb, 0, 0x7fffffff, 0x00020000), vrs = __builtin_amdgcn_make_buffer_rsrc((void*)Vb, 0, 0x7fffffff, 0x00020000);
    unsigned gsrc[2]; int kdst[2], vdst[2];
#pragma unroll
    for (int i = 0; i < 2; ++i) { const int cid = tid + 512 * i, kv = cid >> 4, c16 = cid & 15;
        gsrc[i] = (unsigned)(kv * 1024 + c16 * 16); kdst[i] = kv * KP + c16 * 16; vdst[i] = (c16 >> 2) * 4096 + (kv >> 4) * 1024 + (kv & 15) * 64 + (c16 & 3) * 16; }
    u32x4 kr[2], vr[2];
#pragma unroll
    for (int i = 0; i < 2; ++i) { kr[i] = ATT_BLD(krs, gsrc[i], 0); vr[i] = ATT_BLD(vrs, gsrc[i], 0); }
#pragma unroll
    for (int i = 0; i < 2; ++i) *(LAS u32x4*)(lds + OFF_K + kdst[i]) = kr[i];
#pragma unroll
    for (int i = 0; i < 2; ++i) kr[i] = ATT_BLD(krs, gsrc[i], 64 * 1024);
    ATT_BAR();
    f32x16 o[4];
#pragma unroll
    for (int d0 = 0; d0 < 4; ++d0) o[d0] = (f32x16){};
    float l_reg = 0.f;
    f32x16 p0, p1, negref;
    {
        const unsigned* km = KM + (b * 8 + h * 2 + m) * 2;
        const float kmax2 = __uint_as_float(km[0]) + __uint_as_float(km[1]);
        float ss = 0.f;
#pragma unroll
        for (int d0 = 0; d0 < 4; ++d0)
#pragma unroll
            for (int i = 0; i < 8; ++i) { const float v = bf2f((unsigned short)qr[d0][i]); ss += v * v; }
        ss += __shfl_xor(ss, 32);
        const float ref = sqrtf(ss * kmax2) * 1.02f;
#pragma unroll
        for (int r = 0; r < 16; ++r) negref[r] = -ref;
    }
    u32x4 pwA[4], pwB[4];
    const int koff = r32 * KP + m * 128 + hi * 16;
    const int voff = ((lane >> 4) & 1) * 32 + (lane & 3) * 8 + (4 * hi + ((lane & 15) >> 2)) * 64;
    ATT_X(0); ATT_STAGE(0); ATT_Y0(pwA); ATT_BAR();
    ATT_X(1); ATT_STAGE(1); ATT_Y(0, pwA, pwB); ATT_BAR();
    for (int j = 2; j < NT; j += 2) {
        ATT_X(0); ATT_STAGE(j); ATT_Y(1, pwB, pwA); ATT_BAR();
        ATT_X(1); ATT_STAGE(j + 1); ATT_Y(0, pwA, pwB); ATT_BAR();
    }
    ATT_Z(1, pwB); ATT_BAR();
    const float lsum_ = l_reg + __shfl_xor(l_reg, 32);
    if (hi == 0) wsf[32 + r32] = lsum_;
    LDS_WAIT();
    LAS float* ex = (LAS float*)lds + w * 4096 + 4 * r32;
    const f32x4 g4 = *(const f32x4*)(subg + 4 * r32) * (1.0f - LAM_INIT);
    bf16_t* dstb = MIXIN + (size_t)rowQ * 1024 + h * 128 + 4 * r32;
#define ATT_EPI(KEEP) do { \
    _Pragma("unroll") for (int rr = 0; rr < 8; ++rr) { const int r = 8 - (KEEP) + rr; const int q = crow(r, hi); const float rl = __builtin_amdgcn_rcpf(wsf[32 + q]); \
        *(LAS f32x4*)(ex + q * 128) = (f32x4){o[0][r] * rl, o[1][r] * rl, o[2][r] * rl, o[3][r] * rl}; } \
    ATT_BAR(); \
    _Pragma("unroll") for (int rr = 0; rr < 8; ++rr) { const int r = (KEEP) + rr; const int q = crow(r, hi); const float rl = __builtin_amdgcn_rcpf(wsf[32 + q]); \
        const f32x4 own = (f32x4){o[0][r] * rl, o[1][r] * rl, o[2][r] * rl, o[3][r] * rl}; const f32x4 oth = *(const LAS f32x4*)(ex + q * 128); \
        const f32x4 x = ((KEEP) == 0) ? (own - lam * oth) : (oth - lam * own); \
        const float ss = half_sum32((x[0] * x[0] + x[1] * x[1]) + (x[2] * x[2] + x[3] * x[3]), hi); \
        const float rstd = __builtin_amdgcn_rsqf(ss * (1.f / 128.f) + EPS); \
        u32x2 wv; wv.x = pk2(x[0] * rstd * g4[0], x[1] * rstd * g4[1]); wv.y = pk2(x[2] * rstd * g4[2], x[3] * rstd * g4[3]); \
        *(u32x2*)(dstb + (size_t)q * 1024) = wv; } } while (0)
    if (m == 0) ATT_EPI(0); else ATT_EPI(8);
#undef ATT_EPI
    ATT_BAR();
}
#undef ATT_BAR
#undef ATT_X
#undef ATT_EXP2
#undef ATT_Y
#undef ATT_Y0
#undef ATT_Z
#undef ATT_STAGE
#undef ATT_BLD
#undef ATT_SB
#undef ATT_KLD
#undef ATT_XSTEP
#undef ATT_VLD
#undef ATT_VF
#undef ATT_YSTEP
#undef ATT_ZSTEP
}

__device__ __forceinline__ void p3_conv_attn(const Args& a, LAS unsigned char* lds, int c, int vcu, int G) {
    const int tid = opaque_tid(), lane = tid & 63, wave = __builtin_amdgcn_readfirstlane(tid >> 6);
    unsigned char* ws = a.ws;
    const bf16_t* GB = (const bf16_t*)(ws + WS_GB); const bf16_t* U = (const bf16_t*)(ws + WS_U); bf16_t* MIXIN = (bf16_t*)(ws + WS_MIXIN);
    {
        const float* cw = a.in[I_CONVW]; float w0[8], w1[8], w2[8];
#pragma unroll
        for (int i = 0; i < 8; ++i) { w0[i] = cw[lane * 8 + i]; w1[i] = cw[512 + lane * 8 + i]; w2[i] = cw[1024 + lane * 8 + i]; }
        const int gw = vcu * NWAVES + wave, NGW = G * NWAVES;
        for (int row = gw * (M / NGW); row < (gw + 1) * (M / NGW); ++row) {
            const int t = row & (T - 1);
            const u32x4 z = {0u, 0u, 0u, 0u};
            const u32x4 uc = *(const u32x4*)(U + (size_t)row * 512 + lane * 8);
            const u32x4 up = (t > 0) ? *(const u32x4*)(U + (size_t)(row - 1) * 512 + lane * 8) : z;
            const u32x4 un = (t < T - 1) ? *(const u32x4*)(U + (size_t)(row + 1) * 512 + lane * 8) : z;
            const u32x4 gb = *(const u32x4*)(GB + (size_t)row * 512 + lane * 8);
            u32x4 o;
#pragma unroll
            for (int q = 0; q < 4; ++q) {
                const float y0 = w0[2 * q] * bflo(up[q]) + w1[2 * q] * bflo(uc[q]) + w2[2 * q] * bflo(un[q]);
                const float y1 = w0[2 * q + 1] * bfhi(up[q]) + w1[2 * q + 1] * bfhi(uc[q]) + w2[2 * q + 1] * bfhi(un[q]);
                o[q] = pk2(bflo(gb[q]) * y0, bfhi(gb[q]) * y1);
            }
            *(u32x4*)(MIXIN + (size_t)row * 1024 + 512 + lane * 8) = o;
        }
    }
    float lam;
    { const float p1 = a.in[I_LQ1][lane] * a.in[I_LK1][lane], p2 = a.in[I_LQ2][lane] * a.in[I_LK2][lane];
      lam = __expf(wave_sum(p1)) - __expf(wave_sum(p2)) + LAM_INIT; }
    const bf16_t* Q = (const bf16_t*)(ws + WS_Q); const bf16_t* KA = (const bf16_t*)(ws + WS_K); const bf16_t* VA = (const bf16_t*)(ws + WS_V);
    __syncthreads();
    for (int u = vcu * 8; u < 2048; u += G * 8) {
        const int x = (u >> 3) / 32, jj = (u >> 3) % 32;
        for (int i = 0; i < 8; ++i) {
            const int bh = 16 * x + 2 * i + (jj >> 4), qb = jj & 15;
            att::unit(lds, bh >> 2, bh & 3, qb, Q, KA, VA, MIXIN, a.in[I_SUBLN], lam, (const unsigned*)(ws + WS_CTL) + CW_KMAX);
        }
    }
}

struct P5In { f32x4 x[4]; u32x2 m[4]; };
__device__ __forceinline__ void p5_load(P5In& r, int row, int lane, const float* X, const bf16_t* MIX) {
    const f32x4* xr = (const f32x4*)(X + (size_t)row * D) + lane; const u32x2* mr = (const u32x2*)(MIX + (size_t)row * D) + lane;
#pragma unroll
    for (int j = 0; j < 4; ++j) { r.x[j] = __builtin_nontemporal_load(xr + 64 * j); r.m[j] = __builtin_nontemporal_load(mr + 64 * j); }
}
__device__ __forceinline__ float p5_resid(const P5In& r, f32x4 (&h)[4], int row, int lane, const LAS float* mv, const f32x4* npm, bf16_t* H1) {
    f32x4 mx[4]; float s = 0.f;
#pragma unroll
    for (int j = 0; j < 4; ++j) { const u32x2 wv = r.m[j]; mx[j] = (f32x4){bflo(wv.x), bfhi(wv.x), bflo(wv.y), bfhi(wv.y)};
        s += (mx[j].x * mx[j].x + mx[j].y * mx[j].y) + (mx[j].z * mx[j].z + mx[j].w * mx[j].w); }
    const float rstd1 = 1.0f / sqrtf(wave_sum(s) * (1.f / D) + EPS);
    u32x2* hr = (u32x2*)(H1 + (size_t)row * D) + lane; float s2 = 0.f;
#pragma unroll
    for (int j = 0; j < 4; ++j) { const f32x4 g1 = *(const LAS f32x4*)(mv + 4 * lane + 256 * j);
        h[j] = r.x[j] + g1 * ((mx[j] * rstd1) * npm[64 * j]);
        u32x2 wv; wv.x = pk2(h[j].x, h[j].y); wv.y = pk2(h[j].z, h[j].w); __builtin_nontemporal_store(wv, hr + 64 * j);
        s2 += (h[j].x * h[j].x + h[j].y * h[j].y) + (h[j].z * h[j].z + h[j].w * h[j].w); }
    return 1.0f / sqrtf(wave_sum(s2) * (1.f / D) + EPS);
}
__device__ __forceinline__ void p5_rows(const Args& a, LAS unsigned char* lds, int p  ) {
    const int tid = opaque_tid(), lane = tid & 63, wave = __builtin_amdgcn_readfirstlane(tid >> 6);
    unsigned char* ws = a.ws;
    const int b = p >> 3;
    LAS float* wrt = (LAS float*)lds;
    LAS float* mv = (LAS float*)(lds + 65536);
    const float* wr = a.in[I_WROUTER];
    const bf16_t* MIX = (const bf16_t*)(ws + WS_MIX); unsigned char* XN2 = ws + WS_XN; float* AFFT = (float*)(ws + WS_AFFT); bf16_t* H1 = (bf16_t*)(ws + WS_H1);
    const float* X = a.in[I_X];
    const int rbase = p * 256 + wave * 32;
    P5In cA, cB;
    p5_load(cA, rbase, lane, X, MIX); p5_load(cB, rbase + 1, lane, X, MIX);
    for (int n = tid; n < D * NE; n += NTHREADS) { const int k = n >> 4, e = n & 15; wrt[e * D + k] = wr[n]; }
    const float* MOD = (const float*)(ws + WS_MOD) + (size_t)b * NMOD;
    for (int n = tid; n < 3 * D; n += NTHREADS) mv[n] = MOD[2 * D + n];
    __syncthreads();
    const f32x4* npm = (const f32x4*)a.in[I_NPOST_MIX] + lane; const f32x4* npf = (const f32x4*)a.in[I_NPRE_FFN] + lane;
    for (int i = 0; i < 16; ++i) {
        const int rowA = rbase + 2 * i, rowB = rowA + 1;
        P5In nA, nB;
        if (i + 1 < 16) { p5_load(nA, rowA + 2, lane, X, MIX); p5_load(nB, rowB + 2, lane, X, MIX); }
        f32x4 hA[4], hB[4];
        const float rsA = p5_resid(cA, hA, rowA, lane, mv, npm, H1);
        const float rsB = p5_resid(cB, hB, rowB, lane, mv, npm, H1);
        unsigned* oA = (unsigned*)(XN2 + (size_t)rowA * D) + lane; unsigned* oB = (unsigned*)(XN2 + (size_t)rowB * D) + lane;
        typedef float f32x2v __attribute__((ext_vector_type(2)));
        f32x2v lg2[16];
#pragma unroll
        for (int e = 0; e < 16; ++e) lg2[e] = (f32x2v){0.f, 0.f};
#pragma unroll
        for (int j = 0; j < 4; ++j) { const f32x4 sh2 = *(const LAS f32x4*)(mv + 1024 + 4 * lane + 256 * j), sc2 = *(const LAS f32x4*)(mv + 2048 + 4 * lane + 256 * j);
            const f32x4 gn = npf[64 * j];
            const f32x4 zA = ((hA[j] * rsA) * gn) * (sc2 + 1.0f) + sh2, zB = ((hB[j] * rsB) * gn) * (sc2 + 1.0f) + sh2;
            { const f32x4 qa = zA * pg8::F8_ACT, qb = zB * pg8::F8_ACT; oA[64 * j] = pg8::pk4_fp8(qa.x, qa.y, qa.z, qa.w); oB[64 * j] = pg8::pk4_fp8(qb.x, qb.y, qb.z, qb.w); }
            const f32x2v zx = {zA.x, zB.x}, zy = {zA.y, zB.y}, zz = {zA.z, zB.z}, zw = {zA.w, zB.w};
#pragma unroll
            for (int e = 0; e < 16; ++e) { const f32x4 wq = *(const LAS f32x4*)(wrt + e * D + 4 * lane + 256 * j);
                lg2[e] = __builtin_elementwise_fma(zx, (f32x2v){wq.x, wq.x}, lg2[e]); lg2[e] = __builtin_elementwise_fma(zy, (f32x2v){wq.y, wq.y}, lg2[e]);
                lg2[e] = __builtin_elementwise_fma(zz, (f32x2v){wq.z, wq.z}, lg2[e]); lg2[e] = __builtin_elementwise_fma(zw, (f32x2v){wq.w, wq.w}, lg2[e]);
                if ((e & 3) == 3) __builtin_amdgcn_sched_barrier(0); } }
        float lg[32];
#pragma unroll
        for (int e = 0; e < 16; ++e) { lg[e] = lg2[e].x; lg[16 + e] = lg2[e].y; }
#pragma unroll
        for (int st = 0; st < 5; ++st) { const int d = 1 << st, cntv = 16 >> st; const bool up = (lane & d) != 0;
#pragma unroll
            for (int q = 0; q < 16; ++q) if (q < cntv) { const float send = up ? lg[2 * q] : lg[2 * q + 1], keep = up ? lg[2 * q + 1] : lg[2 * q]; lg[q] = keep + __shfl_xor(send, d); } }
        float lv = lg[0] + __shfl_xor(lg[0], 32);
        float mxl = lv;
#pragma unroll
        for (int d = 1; d < 16; d <<= 1) mxl = fmaxf(mxl, __shfl_xor(mxl, d));
        const float ev = __expf(lv - mxl); float se = ev;
#pragma unroll
        for (int d = 1; d < 16; d <<= 1) se += __shfl_xor(se, d);
        if (lane < 32) { const int row = (lane < 16) ? rowA : rowB; AFFT[((size_t)b * NE + (lane & 15)) * T + (row & (T - 1))] = ev / se; }
        cA = nA; cB = nB;
    }
}

__device__ __forceinline__ void p6_topk(const Args& a, LAS unsigned char* lds, int c, int G) {
    const int tid = opaque_tid(), lane = tid & 63, wave = __builtin_amdgcn_readfirstlane(tid >> 6);
    unsigned char* ws = a.ws;
    const float* AFFT = (const float*)(ws + WS_AFFT); short* SLOT = (short*)(ws + WS_SLOT); int* IDX = (int*)(ws + WS_IDX); float* GATE = (float*)(ws + WS_GATE);
    LAS unsigned* sv = (LAS unsigned*)(lds + wave * 16384);
    for (int item = c + wave * G; item < NITEM; item += G * NWAVES) {
        const int b = item >> 4, e = item & 15;
        const float* src = AFFT + (size_t)item * T;
#pragma unroll 8
        for (int j = 0; j < 32; ++j) sv[j * 64 + lane] = __float_as_uint(src[j * 64 + lane]);
        LDS_WAIT(); asm volatile("" ::: "memory");
        unsigned pre = 0u;
        for (int bit = 30; bit >= 0; --bit) {
            const unsigned cand = pre | (1u << bit);
            int cnt = 0;
#pragma unroll 4
            for (int j = 0; j < 32; ++j) cnt += (int)__popcll(__ballot(sv[j * 64 + lane] >= cand));
            if (cnt >= CAP) pre = cand;
        }
        int ngt = 0;
#pragma unroll 4
        for (int j = 0; j < 32; ++j) ngt += (int)__popcll(__ballot(sv[j * 64 + lane] > pre));
        const int need_eq = CAP - ngt;
        const unsigned long long ltmask = (1ull << lane) - 1ull;
        int base_gt = 0, base_eq = 0;
#pragma unroll 2
        for (int j = 0; j < 32; ++j) {
            const unsigned vj = sv[j * 64 + lane];
            const bool gt = vj > pre, eq = vj == pre;
            const unsigned long long mg = __ballot(gt), me = __ballot(eq);
            const int pg = base_gt + (int)__popcll(mg & ltmask), pe = base_eq + (int)__popcll(me & ltmask);
            int sl = -1; if (gt) sl = pg; else if (eq && pe < need_eq) sl = ngt + pe;
            const int t = j * 64 + lane;
            SLOT[((size_t)b * T + t) * NE + e] = (short)sl;
            if (sl >= 0) { IDX[item * CAP + sl] = t; GATE[item * CAP + sl] = __uint_as_float(vj); }
            base_gt += (int)__popcll(mg); base_eq += (int)__popcll(me);
        }
        LDS_WAIT(); asm volatile("" ::: "memory");
    }
}

struct P8Row { u32x2 h[4]; unsigned y[4][4]; float wt[4]; unsigned long long rest; int sl; };
__device__ __forceinline__ f32x4 fp8x4_to_f32(unsigned w) { typedef float f2 __attribute__((ext_vector_type(2))); const f2 lo = __builtin_amdgcn_cvt_pk_f32_fp8((int)w, false), hi = __builtin_amdgcn_cvt_pk_f32_fp8((int)w, true); return (f32x4){lo.x, lo.y, hi.x, hi.y}; }
__device__ __forceinline__ void p8_issue(P8Row& r, int row, int lane, const short* SLOT, const unsigned char* Y, const bf16_t* H1) {
    const int b = row >> 11;
    const int s_e = (lane < NE) ? (int)SLOT[(size_t)row * NE + lane] : -1;
    unsigned long long mask = __ballot(s_e >= 0);
    const u32x2* hr = (const u32x2*)(H1 + (size_t)row * D) + lane;
#pragma unroll
    for (int j = 0; j < 4; ++j) r.h[j] = __builtin_nontemporal_load(hr + 64 * j);
#pragma unroll
    for (int q = 0; q < 4; ++q) {
        int e = 0, s = 0; r.wt[q] = 0.f;
        if (mask) { e = (int)__builtin_ctzll(mask); mask &= mask - 1ull; s = __builtin_amdgcn_readlane(s_e, e); r.wt[q] = 1.f; }
        const unsigned* yr = (const unsigned*)(Y + ((size_t)(b * NE + e) * CAP + s) * D) + lane;
#pragma unroll
        for (int j = 0; j < 4; ++j) r.y[q][j] = __builtin_nontemporal_load(yr + 64 * j);
    }
    r.rest = mask; r.sl = s_e;
}
__device__ __forceinline__ void p8_finish(P8Row& r, int row, int lane, const unsigned char* Y, const float* MOD, const f32x4* npo, float* out) {
    const int b = row >> 11;
    f32x4 ff[4];
#pragma unroll
    for (int j = 0; j < 4; ++j) ff[j] = (f32x4){0.f, 0.f, 0.f, 0.f};
#pragma unroll
    for (int q = 0; q < 4; ++q)
#pragma unroll
        for (int j = 0; j < 4; ++j) ff[j] += fp8x4_to_f32(r.y[q][j]) * r.wt[q];
    unsigned long long mask = r.rest;
    while (mask) {
        const int e = (int)__builtin_ctzll(mask); mask &= mask - 1ull; const int s = __builtin_amdgcn_readlane(r.sl, e);
        const unsigned* yr = (const unsigned*)(Y + ((size_t)(b * NE + e) * CAP + s) * D) + lane;
#pragma unroll
        for (int j = 0; j < 4; ++j) ff[j] += fp8x4_to_f32(yr[64 * j]);
    }
#pragma unroll
    for (int j = 0; j < 4; ++j) ff[j] = ff[j] * (1.0f / pg8::F8_Y);
    float s2 = 0.f;
#pragma unroll
    for (int j = 0; j < 4; ++j) s2 += (ff[j].x * ff[j].x + ff[j].y * ff[j].y) + (ff[j].z * ff[j].z + ff[j].w * ff[j].w);
    const float rstd = 1.0f / sqrtf(wave_sum(s2) * (1.f / D) + EPS);
    f32x4* orow = (f32x4*)(out + (size_t)row * D) + lane; const f32x4* g2 = (const f32x4*)(MOD + (size_t)b * NMOD + 5 * D) + lane;
#pragma unroll
    for (int j = 0; j < 4; ++j) { const u32x2 hv = r.h[j]; const f32x4 h = (f32x4){bflo(hv.x), bfhi(hv.x), bflo(hv.y), bfhi(hv.y)};
        __builtin_nontemporal_store(h + g2[64 * j] * ((ff[j] * rstd) * npo[64 * j]), orow + 64 * j); }
}
__device__ __forceinline__ void p8_final(const Args& a, int vcu, int G) {
    const int tid = opaque_tid(), lane = tid & 63, wave = __builtin_amdgcn_readfirstlane(tid >> 6);
    unsigned char* ws = a.ws;
    const short* SLOT = (const short*)(ws + WS_SLOT); const unsigned char* Y = ws + WS_Y; const float* MOD = (const float*)(ws + WS_MOD); const bf16_t* H1 = (const bf16_t*)(ws + WS_H1);
    const f32x4* npo = (const f32x4*)a.in[I_NPOST_FFN] + lane;
    const int gw = vcu * NWAVES + wave, NGW = G * NWAVES;
    const int per = M / NGW;
    for (int row = gw * per; row < (gw + 1) * per; row += 4) {
        P8Row r0, r1, r2, r3;
        p8_issue(r0, row, lane, SLOT, Y, H1);
        p8_issue(r1, row + 1, lane, SLOT, Y, H1);
        p8_issue(r2, row + 2, lane, SLOT, Y, H1);
        p8_issue(r3, row + 3, lane, SLOT, Y, H1);
        p8_finish(r0, row, lane, Y, MOD, npo, a.out);
        p8_finish(r1, row + 1, lane, Y, MOD, npo, a.out);
        p8_finish(r2, row + 2, lane, Y, MOD, npo, a.out);
        p8_finish(r3, row + 3, lane, Y, MOD, npo, a.out);
    }
}

__global__ void __launch_bounds__(NTHREADS, 2) fwd_kernel(Args args) {
    extern __shared__ __attribute__((aligned(16))) unsigned char lds_raw[];
    LAS unsigned char* lds = (LAS unsigned char*)lds_raw;
    volatile LAS unsigned* MISC = (volatile LAS unsigned*)(lds + MISC_OFF);
    const int tid = threadIdx.x;
    const int G = gridDim.x, c = blockIdx.x;
    const int vcu = (G % 8 == 0) ? (c % 8) * (G / 8) + c / 8 : c;
    unsigned char* ws = args.ws;
    gu32* ctl = (gu32*)(ws + WS_CTL);
    for (int u = tid; u < (LDS_BYTES - LDSCTL_OFF) / 4; u += NTHREADS) ((LAS unsigned*)(lds + LDSCTL_OFF))[u] = 0u;
    __syncthreads();
    XcdBarrier bar; bar.bar = (unsigned*)(ctl + CW_BAR); bar.x = 0; bar.st = nullptr;
    const int lo = args.ph_lo, hi = args.ph_hi;
    if (hi - lo > 1) bar = xcd_barrier_post((unsigned*)(ctl + CW_BAR), MISC + 8);
#ifndef PHMASK
#define PHMASK 0xff
#endif
#define IN(k) (((PHMASK >> (k)) & 1) && lo <= (k) && (k) < hi)
#define SEAM(k) do { if (IN(k) && IN((k) + 1)) xcd_barrier(bar); } while (0)
#ifndef PROBE_PHASE
#define PROBE_PHASE -1
#endif
#define PB(k) do { if (PROBE_PHASE == (k)) { if (tid == 0) { const unsigned long long t0_ = __builtin_amdgcn_s_memrealtime(); MISC[16] = (unsigned)t0_; MISC[17] = (unsigned)(t0_ >> 32); } } } while (0)
#define PE(k) do { if (PROBE_PHASE == (k)) { if (tid == 0) { const unsigned long long t0_ = ((unsigned long long)MISC[17] << 32) | MISC[16]; const unsigned long long t1_ = __builtin_amdgcn_s_memrealtime(); \
      while (__builtin_amdgcn_s_memrealtime() - t1_ < t1_ - t0_) __builtin_amdgcn_s_sleep(8); } __syncthreads(); } } while (0)

    PB(0); if (IN(0)) { p0_prologue(args, lds, vcu, G); } SEAM(0); PE(0);
    PB(1); if (IN(1)) { p1_xn(args, lds, c, G); inout_weight_copies(args, lds, vcu, G); } SEAM(1); PE(1);
    PB(2); if (IN(2)) {
        pg8::Gemm g{(const bf16_t*)(ws + WS_XN), (const bf16_t*)(ws + WS_WIN), D, nullptr};
        pg8::SchedProj S{G, c};
        pg8::EpiProj E{(bf16_t*)(ws + WS_Q), (bf16_t*)(ws + WS_K), (bf16_t*)(ws + WS_V), (bf16_t*)(ws + WS_GB), (bf16_t*)(ws + WS_U), (const float*)(ws + WS_TAB), (unsigned*)(ws + WS_CTL) + CW_KMAX};
        pg8::gemm_phase<pg8::EpiProj, pg8::SchedProj, true, true>(lds, g, S, E);
        if (c >= 128) expert_weight_copies(args, lds, c - 128, G - 128, 0, 9216);
    } SEAM(2); PE(2);
    PB(3); if (IN(3)) { if (c & 1) expert_weight_copies(args, lds, vcu, G, 9216, 24576); p3_conv_attn(args, lds, c, vcu, G); if (!(c & 1)) expert_weight_copies(args, lds, vcu, G, 9216, 24576); } SEAM(3); PE(3);
    PB(4); if (IN(4)) {
        {
            const int p = c;
#ifndef NO_P4
            pg8::Gemm g{(const bf16_t*)(ws + WS_MIXIN), (const bf16_t*)(ws + WS_WOUT), D, nullptr};
            pg8::SchedPanel S{p, 4};
            pg8::EpiBf16 E{(bf16_t*)(ws + WS_MIX), D};
            pg8::gemm_phase<pg8::EpiBf16, pg8::SchedPanel, true, true>(lds, g, S, E);
#endif
            VM_WAIT(); __syncthreads();
#ifndef NO_P5
            p5_rows(args, lds, p);
#endif
            __syncthreads();
        }
    } SEAM(4); PE(4);
    PB(5); if (IN(5)) { p6_topk(args, lds, c, G); } SEAM(5); PE(5);
    PB(6); if (IN(6)) {
#pragma unroll 1
        for (int it = 0; it < 2; ++it) {
            {
                const int item = 2 * c + it;
                const int b = item >> 4, e = item & 15;
#ifndef NO_G1
                if (it == 0) PB(8);
                {
                    pg8::Gemm g{(const bf16_t*)(ws + WS_XN + (size_t)b * T * D), (const bf16_t*)(ws + WS_WGU + (size_t)e * 2048 * D), D, (const int*)(ws + WS_IDX) + item * CAP};
                    pg8::SchedPanel S{0, 8};
                    pg8::EpiGU8 E{ws + WS_HMID + (size_t)item * CAP * D};
                    pg8::gemm_phase<pg8::EpiGU8, pg8::SchedPanel, false, true, true, true, true>(lds, g, S, E);
                }
#endif
                VM_WAIT(); __syncthreads();
                if (it == 0) { PE(8); PB(9); }
#ifndef NO_G2
                {
                    pg8::Gemm g{(const bf16_t*)(ws + WS_HMID + (size_t)item * CAP * D), (const bf16_t*)(ws + WS_WDN + (size_t)e * D * D), D, nullptr};
                    pg8::SchedPanel S{0, 4};
                    LAS float* gl = (LAS float*)(lds + LDSCTL_OFF + 4096);
                    { const int t_ = opaque_tid(); if (t_ < CAP) gl[t_] = ((const float*)(ws + WS_GATE))[item * CAP + t_] * (pg8::F8_INV * pg8::F8_Y); }
                    __syncthreads();
                    pg8::EpiDown8 E{ws + WS_Y + (size_t)item * CAP * D, gl};
                    pg8::gemm_phase<pg8::EpiDown8, pg8::SchedPanel, false, true, false, true, true>(lds, g, S, E);
                }
#endif
                VM_WAIT(); __syncthreads();
                if (it == 0) PE(9);
            }
        }
    } SEAM(6); PE(6);
    PB(7); if (IN(7)) { p8_final(args, vcu, G); } PE(7);
#undef IN
#undef SEAM
}

extern "C" void kernel_launch(void* const* d_in, const int* in_sizes, int n_in, void* d_out, int out_size, void* d_ws, size_t ws_size, hipStream_t stream) {
    static int grid = 0;
    if (grid == 0) {
        if (n_in != 22 || in_sizes[0] != M * D || out_size != M * D || ws_size < WS_END) { fprintf(stderr, "kernel_launch: unexpected shapes (n_in %d, in0 %d, out %d, ws %zu)\n", n_in, n_in > 0 ? in_sizes[0] : -1, out_size, ws_size); grid = -1; return; }
        int dev = 0, cus = 0;
        if (hipGetDevice(&dev) != hipSuccess || hipDeviceGetAttribute(&cus, hipDeviceAttributeMultiprocessorCount, dev) != hipSuccess) { grid = -1; return; }
        if (hipFuncSetAttribute((const void*)fwd_kernel, hipFuncAttributeMaxDynamicSharedMemorySize, LDS_BYTES) != hipSuccess) { fprintf(stderr, "kernel_launch: hipFuncSetAttribute failed\n"); grid = -1; return; }
        (void)hipGetLastError();
        grid = cus;
        if (grid != 256) { fprintf(stderr, "kernel_launch: this kernel needs a 256-CU device (got %d)\n", cus); grid = -1; return; }
    }
    if (grid < 0) return;
    (void)hipMemsetAsync((char*)d_ws + WS_CTL, 0, CTL_ZERO_BYTES, stream);
    Args a{};
    for (int i = 0; i < 22; ++i) a.in[i] = (const float*)d_in[i];
    a.out = (float*)d_out; a.ws = (unsigned char*)d_ws;
    constexpr int NPH = 8;
    if (MK_N_LAUNCHES == 1) { a.ph_lo = 0; a.ph_hi = NPH; hipLaunchKernelGGL(fwd_kernel, dim3(grid), dim3(NTHREADS), LDS_BYTES, stream, a); }
    else { for (int k = 0; k < NPH; ++k) { a.ph_lo = k; a.ph_hi = k + 1; hipLaunchKernelGGL(fwd_kernel, dim3(grid), dim3(NTHREADS), LDS_BYTES, stream, a); } }
}
```

```cpp
#include <hip/hip_runtime.h>
#include <cstdio>
#include <cstdint>

#ifndef MK_N_LAUNCHES
#define MK_N_LAUNCHES 1
#endif

#define LAS __attribute__((address_space(3)))
#define GAS __attribute__((address_space(1)))
typedef unsigned short bf16_t;
typedef short bf16x8 __attribute__((ext_vector_type(8)));
typedef short s16x4 __attribute__((ext_vector_type(4)));
typedef float f32x4 __attribute__((ext_vector_type(4)));
typedef float f32x16 __attribute__((ext_vector_type(16)));
typedef unsigned u32x4 __attribute__((ext_vector_type(4)));
typedef unsigned u32x2 __attribute__((ext_vector_type(2)));

constexpr int NB = 32, T = 2048, D = 1024, TC = 256, M = NB * T, MC = NB * TC, MA = M + MC, TK = TC + T;
constexpr int NE = 16, CAP = 256, NITEM = NB * NE, NPROJ = 3072, NMOD = 6 * D;
constexpr float EPS = 1e-6f;
constexpr float C2 = 0.125f * 1.4426950408889634f;
constexpr float LAM_INIT = 0.2f;
constexpr int NWAVES = 8, NTHREADS = 512;

constexpr size_t MiB = 1u << 20;
constexpr size_t WS_CTL = 0, CTL_ZERO_BYTES = 1 * MiB;
constexpr size_t WS_MODP = 2 * MiB;
constexpr size_t WS_MOD = 16 * MiB;
constexpr size_t WS_TAB = 17 * MiB;
constexpr size_t WS_WIN = 18 * MiB;
constexpr size_t WS_WOUT = 24 * MiB;
constexpr size_t WS_WGU = 26 * MiB;
constexpr size_t WS_WDN = 90 * MiB;
constexpr size_t WS_AFFT = 122 * MiB;
constexpr size_t WS_SLOT = 126 * MiB;
constexpr size_t WS_IDX = 128 * MiB;
constexpr size_t WS_GATE = 129 * MiB;
constexpr size_t WS_XN = 130 * MiB;
constexpr size_t WS_Q = 274 * MiB;
constexpr size_t WS_K = 338 * MiB;
constexpr size_t WS_V = 410 * MiB;
constexpr size_t WS_GB = 482 * MiB;
constexpr size_t WS_U = 546 * MiB;
constexpr size_t WS_MIXIN = 610 * MiB;
constexpr size_t WS_MIX = 738 * MiB;
constexpr size_t WS_HMID = 274 * MiB;
constexpr size_t WS_Y = 610 * MiB;
constexpr size_t WS_H1 = 866 * MiB;
constexpr size_t WS_END = 994 * MiB;

__device__ __forceinline__ int opaque_tid() { int t = threadIdx.x; asm volatile("" : "+v"(t)); return t; }

namespace pg8 {
constexpr int BM = 256, BK = 64, HALF = 128, HTB = HALF * BK * 2, STAGE_BYTES = 8 * HTB;
__host__ __device__ __forceinline__ int lds_byte(int r, int c) { const int st = (r >> 4) * 2 + (c >> 5), rr = r & 15, cc = c & 31, ob = rr * 64 + cc * 2; return st * 1024 + (ob ^ (((ob >> 9) & 1) << 5)); }
__host__ __device__ __forceinline__ void stage_rc(int b, int& R, int& C) { const int st = b / 1024, sb = b % 1024, swz = sb ^ (((sb >> 9) & 1) << 5); R = (st >> 1) * 16 + swz / 64; C = (st & 1) * 32 + (swz % 64) / 2; }
__host__ __device__ __forceinline__ int perm32(int rho) { const int n = rho >> 4, i = rho & 15; return 8 * (i >> 2) + 4 * n + (i & 3); }

struct Unit { int pm, pn; };
struct Gemm { const bf16_t* A; const bf16_t* Bt; int K; const int* gidx; };

typedef float f32x2_t __attribute__((ext_vector_type(2))); typedef __bf16 bf16x2_t __attribute__((ext_vector_type(2)));
__device__ __forceinline__ unsigned cvt_pk_bf16(float lo, float hi) { const f32x2_t v = {lo, hi}; const bf16x2_t b = __builtin_convertvector(v, bf16x2_t); return __builtin_bit_cast(unsigned, b); }

struct EpiBf16 {
    static constexpr bool PERM = true, AFTER_DRAIN = false;
    bf16_t* O; int ldc;
    __device__ __forceinline__ void operator()(const f32x4 (&acc)[2][2][4][2], const Unit& u, int wr, int wc, int fr, int fq) const {
        const int row0 = u.pm * BM + wr * 64 + fr; const int col0 = u.pn * BM + wc * 32 + 8 * fq;
#pragma unroll
        for (int ai = 0; ai < 2; ++ai)
#pragma unroll
            for (int m = 0; m < 4; ++m) { bf16_t* rowp = O + (size_t)(row0 + ai * HALF + m * 16) * ldc + col0;
#pragma unroll
                for (int bj = 0; bj < 2; ++bj) { const f32x4 v0 = acc[ai][bj][m][0], v1 = acc[ai][bj][m][1];
                    u32x4 w; w.x = cvt_pk_bf16(v0[0], v0[1]); w.y = cvt_pk_bf16(v0[2], v0[3]); w.z = cvt_pk_bf16(v1[0], v1[1]); w.w = cvt_pk_bf16(v1[2], v1[3]);
                    *(u32x4*)(rowp + bj * HALF) = w; } }
    }
};

struct EpiProj {
    static constexpr bool PERM = true, AFTER_DRAIN = false;
    bf16_t *Q, *KA, *VA, *GB, *U; const float* tab;
    unsigned* kmaxh;
    __device__ __forceinline__ void operator()(const f32x4 (&acc)[2][2][4][2], const Unit& u, int wr, int wc, int fr, int fq) const {
        const int pn = u.pn; const bool ctx = u.pm >= 256;
        float km[2] = {0.f, 0.f};
#pragma unroll
        for (int ai = 0; ai < 2; ++ai)
#pragma unroll
            for (int m = 0; m < 4; ++m) {
                const int row = u.pm * BM + ai * HALF + wr * 64 + m * 16 + fr;
                int t, kvrow;
                if (!ctx) { const int b = row >> 11; t = row & 2047; kvrow = b * TK + TC + t; }
                else { const int rc = row - M; const int b = rc >> 8; t = 0; kvrow = b * TK + (rc & 255); }
                if (pn < 4) {
                    f32x4 cs0 = {1.f, 0.f, 1.f, 0.f}, cs1 = cs0, cs2 = cs0, cs3 = cs0;
                    if (!ctx) { const float* tp = tab + ((size_t)t * 32 + 16 * (wc & 1) + 4 * fq) * 2;
                        cs0 = *(const f32x4*)(tp); cs1 = *(const f32x4*)(tp + 4); }
                    (void)cs2; (void)cs3;
#pragma unroll
                    for (int bj = 0; bj < 2; ++bj) {
                        const f32x4 v0 = acc[ai][bj][m][0], v1 = acc[ai][bj][m][1];
                        float e0 = v0[0], o0 = v0[1], e1 = v0[2], o1 = v0[3], e2 = v1[0], o2 = v1[1], e3 = v1[2], o3 = v1[3];
                        if (pn >= 2) {
                            float ss = ((e0 * e0 + o0 * o0) + (e1 * e1 + o1 * o1)) + ((e2 * e2 + o2 * o2) + (e3 * e3 + o3 * o3));
                            ss += __shfl_xor(ss, 16); ss += __shfl_xor(ss, 32); km[bj] = fmaxf(km[bj], ss); }
                        float r0 = e0 * cs0[0] - o0 * cs0[1], s0 = o0 * cs0[0] + e0 * cs0[1];
                        float r1 = e1 * cs0[2] - o1 * cs0[3], s1 = o1 * cs0[2] + e1 * cs0[3];
                        float r2 = e2 * cs1[0] - o2 * cs1[1], s2 = o2 * cs1[0] + e2 * cs1[1];
                        float r3 = e3 * cs1[2] - o3 * cs1[3], s3 = o3 * cs1[2] + e3 * cs1[3];
                        const float sc = (pn < 2) ? C2 : 1.f;
                        u32x4 w; w.x = cvt_pk_bf16(r0 * sc, s0 * sc); w.y = cvt_pk_bf16(r1 * sc, s1 * sc); w.z = cvt_pk_bf16(r2 * sc, s2 * sc); w.w = cvt_pk_bf16(r3 * sc, s3 * sc);
                        const int col = (pn & 1) * 256 + bj * HALF + wc * 32 + 8 * fq;
                        bf16_t* dst = (pn < 2) ? (Q + (size_t)row * 512 + col) : (KA + (size_t)kvrow * 512 + col);
                        *(u32x4*)dst = w;
                    }
                } else if (pn < 8) {
#pragma unroll
                    for (int bj = 0; bj < 2; ++bj) {
                        const f32x4 v0 = acc[ai][bj][m][0], v1 = acc[ai][bj][m][1];
                        u32x4 w; w.x = cvt_pk_bf16(v0[0], v0[1]); w.y = cvt_pk_bf16(v0[2], v0[3]); w.z = cvt_pk_bf16(v1[0], v1[1]); w.w = cvt_pk_bf16(v1[2], v1[3]);
                        const int col = (pn & 1) * 256 + bj * HALF + wc * 32 + 8 * fq;
                        bf16_t* dst = (pn < 6) ? (VA + (size_t)kvrow * 512 + col) : (GB + (size_t)row * 512 + col);
                        *(u32x4*)dst = w;
                    }
                } else {
                    const f32x4 a0 = acc[ai][0][m][0], a1 = acc[ai][0][m][1], b0 = acc[ai][1][m][0], b1 = acc[ai][1][m][1];
                    u32x4 w; w.x = cvt_pk_bf16(a0[0] * b0[0], a0[1] * b0[1]); w.y = cvt_pk_bf16(a0[2] * b0[2], a0[3] * b0[3]);
                    w.z = cvt_pk_bf16(a1[0] * b1[0], a1[1] * b1[1]); w.w = cvt_pk_bf16(a1[2] * b1[2], a1[3] * b1[3]);
                    const int col = (pn - 8) * 128 + wc * 32 + 8 * fq;
                    *(u32x4*)(U + (size_t)row * 512 + col) = w;
                }
            }
        if (pn == 2 || pn == 3) {
            const int b = ctx ? (u.pm - 256) : (u.pm >> 3);
#pragma unroll
            for (int bj = 0; bj < 2; ++bj) { float v = km[bj];
#pragma unroll
                for (int d = 1; d < 16; d <<= 1) v = fmaxf(v, __shfl_xor(v, d));
                if (fr == 0 && fq == 0) atomicMax(kmaxh + ((b * 8 + (pn & 1) * 4 + bj * 2 + (wc >> 1)) * 2 + (wc & 1)), __float_as_uint(v)); }
        }
    }
};

struct EpiGU {
    static constexpr bool PERM = true, AFTER_DRAIN = false;
    bf16_t* H;
    __device__ __forceinline__ float silu(float x) const { return x * __builtin_amdgcn_rcpf(1.f + __expf(-x)); }
    __device__ __forceinline__ void operator()(const f32x4 (&acc)[2][2][4][2], const Unit& u, int wr, int wc, int fr, int fq) const {
#pragma unroll
        for (int ai = 0; ai < 2; ++ai)
#pragma unroll
            for (int m = 0; m < 4; ++m) {
                const int row = ai * HALF + wr * 64 + m * 16 + fr;
                const f32x4 a0 = acc[ai][0][m][0], a1 = acc[ai][0][m][1], b0 = acc[ai][1][m][0], b1 = acc[ai][1][m][1];
                u32x4 w; w.x = cvt_pk_bf16(silu(a0[0]) * b0[0], silu(a0[1]) * b0[1]); w.y = cvt_pk_bf16(silu(a0[2]) * b0[2], silu(a0[3]) * b0[3]);
                w.z = cvt_pk_bf16(silu(a1[0]) * b1[0], silu(a1[1]) * b1[1]); w.w = cvt_pk_bf16(silu(a1[2]) * b1[2], silu(a1[3]) * b1[3]);
                *(u32x4*)(H + (size_t)row * 1024 + u.pn * 128 + wc * 32 + 8 * fq) = w;
            }
    }
};
__device__ __forceinline__ unsigned pk4_fp8(float a, float b, float c, float d) { int w = 0; w = __builtin_amdgcn_cvt_pk_fp8_f32(a, b, w, false); w = __builtin_amdgcn_cvt_pk_fp8_f32(c, d, w, true); return (unsigned)w; }
constexpr float F8_ACT = 4.0f, F8_WGT = 64.0f, F8_INV = 1.0f / (4.0f * 64.0f);
struct EpiGU8 {
    static constexpr bool PERM = true, AFTER_DRAIN = false;
    unsigned char* H;
    __device__ __forceinline__ float hval(float g, float u) const {
        const float e = __builtin_amdgcn_exp2f(g * (-F8_INV * 1.4426950408889634f));
        const float r = __builtin_amdgcn_rcpf(1.f + e);
        return __builtin_amdgcn_fmed3f((g * u) * (r * (F8_INV * F8_INV * F8_ACT)), -448.f, 448.f); }
    __device__ __forceinline__ void row(const f32x4 (&acc)[2][2][4][2], const Unit& u, int ai, int m, int wr, int wc, int fr, int fq) const {
        unsigned off = (unsigned)((ai * HALF + wr * 64 + m * 16 + fr) * 1024 + u.pn * 128 + wc * 32 + 8 * fq);
        asm volatile("" : "+v"(off));
        const f32x4 a0 = acc[ai][0][m][0], a1 = acc[ai][0][m][1], b0 = acc[ai][1][m][0], b1 = acc[ai][1][m][1];
        u32x2 w; w.x = pk4_fp8(hval(a0[0], b0[0]), hval(a0[1], b0[1]), hval(a0[2], b0[2]), hval(a0[3], b0[3]));
        w.y = pk4_fp8(hval(a1[0], b1[0]), hval(a1[1], b1[1]), hval(a1[2], b1[2]), hval(a1[3], b1[3]));
        *(u32x2*)(H + off) = w;
    }
    __device__ __forceinline__ void operator()(const f32x4 (&acc)[2][2][4][2], const Unit& u, int wr, int wc, int fr, int fq) const {
#pragma unroll
        for (int ai = 0; ai < 2; ++ai)
#pragma unroll
            for (int m = 0; m < 4; ++m) row(acc, u, ai, m, wr, wc, fr, fq);
    }
};
struct EpiDown {
    static constexpr bool PERM = true, AFTER_DRAIN = false;
    bf16_t* Y; const float* gate; float scale;
    __device__ __forceinline__ void operator()(const f32x4 (&acc)[2][2][4][2], const Unit& u, int wr, int wc, int fr, int fq) const {
        asm volatile("" : "+v"(fr));
#pragma unroll
        for (int ai = 0; ai < 2; ++ai)
#pragma unroll
            for (int m = 0; m < 4; ++m) {
                const int row = ai * HALF + wr * 64 + m * 16 + fr; const float g = gate[row] * scale;
#pragma unroll
                for (int bj = 0; bj < 2; ++bj) { const f32x4 v0 = acc[ai][bj][m][0] * g, v1 = acc[ai][bj][m][1] * g;
                    u32x4 w; w.x = cvt_pk_bf16(v0[0], v0[1]); w.y = cvt_pk_bf16(v0[2], v0[3]); w.z = cvt_pk_bf16(v1[0], v1[1]); w.w = cvt_pk_bf16(v1[2], v1[3]);
                    *(u32x4*)(Y + (size_t)row * 1024 + u.pn * BM + bj * HALF + wc * 32 + 8 * fq) = w; }
            }
    }
};

constexpr float F8_Y = 64.0f;
struct EpiDown8 {
    static constexpr bool PERM = true, AFTER_DRAIN = false;
    unsigned char* Y; const LAS float* gl;
    __device__ __forceinline__ void row(const f32x4 (&acc)[2][2][4][2], const Unit& u, int ai, int m, int wr, int wc, int fr, int fq) const {
        unsigned off = (unsigned)((ai * HALF + wr * 64 + m * 16 + fr) * 1024 + u.pn * BM + wc * 32 + 8 * fq);
        asm volatile("" : "+v"(off));
        const float g = gl[ai * HALF + wr * 64 + m * 16 + fr];
#pragma unroll
        for (int bj = 0; bj < 2; ++bj) { f32x4 v0 = acc[ai][bj][m][0] * g, v1 = acc[ai][bj][m][1] * g;
#pragma unroll
            for (int i = 0; i < 4; ++i) { v0[i] = __builtin_amdgcn_fmed3f(v0[i], -448.f, 448.f); v1[i] = __builtin_amdgcn_fmed3f(v1[i], -448.f, 448.f); }
            u32x2 w; w.x = pk4_fp8(v0[0], v0[1], v0[2], v0[3]); w.y = pk4_fp8(v1[0], v1[1], v1[2], v1[3]);
            *(u32x2*)(Y + off + bj * HALF) = w; }
    }
    __device__ __forceinline__ void operator()(const f32x4 (&acc)[2][2][4][2], const Unit& u, int wr, int wc, int fr, int fq) const {
#pragma unroll
        for (int ai = 0; ai < 2; ++ai)
#pragma unroll
            for (int m = 0; m < 4; ++m) row(acc, u, ai, m, wr, wc, fr, fq);
    }
};

struct SchedProj {
    int G, c;
    __device__ __forceinline__ bool next(int i, Unit& u) const {
        if (i < 12) { const int x = c & 7, j = c >> 3, ja = j & 7, jb = j >> 3, r = i / 3, q = i - 3 * r;
            u.pm = x + 8 * (8 * r + ja); u.pn = 4 * q + jb; return true; }
        if (i == 12 && c < 128) { u.pm = 256 + (c >> 2); u.pn = 2 + (c & 3); return true; }
        return false;
    }
    __device__ __forceinline__ void a_ready(const Unit&) const {}
    __device__ __forceinline__ void done(const Unit&) const {}
};
struct SchedPanel {
    int pm, ntn;
    __device__ __forceinline__ bool next(int i, Unit& u) const { if (i >= ntn) return false; u.pm = pm; u.pn = i; return true; }
    __device__ __forceinline__ void a_ready(const Unit&) const {}
    __device__ __forceinline__ void done(const Unit&) const {}
};

typedef int i32x4v __attribute__((ext_vector_type(4)));
typedef int i32x8v __attribute__((ext_vector_type(8)));
__device__ __forceinline__ i32x8v cat8(bf16x8 a, bf16x8 b) { const i32x4v x = __builtin_bit_cast(i32x4v, a), y = __builtin_bit_cast(i32x4v, b); return __builtin_shufflevector(x, y, 0, 1, 2, 3, 4, 5, 6, 7); }
template <bool F8> struct Frag;
template <> struct Frag<false> { bf16x8 v[2]; __device__ __forceinline__ void set(bf16x8 a, bf16x8 b) { v[0] = a; v[1] = b; } };
template <> struct Frag<true> { i32x8v v; __device__ __forceinline__ void set(bf16x8 a, bf16x8 b) { v = cat8(a, b); } };
__device__ __forceinline__ f32x4 frag_mma(const Frag<false>& b, const Frag<false>& a, f32x4 c) { c = __builtin_amdgcn_mfma_f32_16x16x32_bf16(b.v[0], a.v[0], c, 0, 0, 0); return __builtin_amdgcn_mfma_f32_16x16x32_bf16(b.v[1], a.v[1], c, 0, 0, 0); }
__device__ __forceinline__ f32x4 frag_mma(const Frag<true>& b, const Frag<true>& a, f32x4 c) {
    const int sc1 = 0x7f7f7f7f;
    asm volatile("s_nop 1\n\tv_mfma_scale_f32_16x16x128_f8f6f4 %0, %1, %2, %0, %3, %3 op_sel_hi:[0,0,0]" : "+v"(c) : "v"(b.v), "v"(a.v), "v"(sc1));
    return c; }
template <class Epi, class Sched, bool ALIGN_EPI, bool SP2, bool GATHER = false, bool F8 = false, bool DEFER = false>
__device__ __forceinline__ void gemm_phase(LAS unsigned char* lds, const Gemm g, const Sched& S, const Epi& E) {
    const int tid = opaque_tid(), wid = __builtin_amdgcn_readfirstlane(tid >> 6), lane = tid & 63, wr = wid >> 2, wc = wid & 3, fr = lane & 15, fq = lane >> 4;
    const int K = g.K * (F8 ? 1 : 2), nt = K / 128;
    unsigned voffA[2][2], voffB[2];
#pragma unroll
    for (int i = 0; i < 2; ++i) { int R, C; stage_rc(tid * 16 + i * 8192, R, C); const int Rb = Epi::PERM ? ((R & ~31) + perm32(R & 31)) : R;
        if constexpr (GATHER) { voffA[0][i] = (unsigned)(g.gidx[R] * K + C * 2); voffA[1][i] = (unsigned)(g.gidx[HALF + R] * K + C * 2); }
        else { voffA[0][i] = (unsigned)(R * K + C * 2); voffA[1][i] = voffA[0][i]; }
        voffB[i] = (unsigned)(Rb * K + C * 2); }
    const size_t kstep = (size_t)(BK * 2);
    const size_t hstep = (size_t)HALF * K;
    const size_t hstepA = GATHER ? (size_t)0 : hstep;
    const size_t tstep = 2 * hstep;
    const unsigned ldsw = (unsigned)wid * 1024u;
    const int aoff = F8 ? lds_byte(wr * 64 + fr, (fq >> 1) * 32 + (fq & 1) * 16) : lds_byte(wr * 64 + fr, fq * 8), boff = F8 ? lds_byte(wc * 32 + fr, (fq >> 1) * 32 + (fq & 1) * 16) : lds_byte(wc * 32 + fr, fq * 8);
    const int aoff1 = F8 ? aoff + 16 : aoff + 1024, boff1 = F8 ? boff + 16 : boff + 1024;
#define PG8_SA(b, h) (((b) * 2 + (h)) * HTB)
#define PG8_SB(b, h) ((4 + (b) * 2 + (h)) * HTB)
#define PG8_STAGE(bufoff, gbase, voff) do { _Pragma("unroll") for (int _i = 0; _i < 2; ++_i) \
        __builtin_amdgcn_global_load_lds((const unsigned*)((const char*)(gbase) + (voff)[_i]), (LAS unsigned*)(lds + (bufoff) + ldsw + _i * 8192), 16, 0, 0); } while (0)
#define PG8_LDA(dst, b, h) do { _Pragma("unroll") for (int m = 0; m < 4; ++m) dst[m].set(*(const LAS bf16x8*)(lds + PG8_SA(b, h) + aoff + m * 2048), *(const LAS bf16x8*)(lds + PG8_SA(b, h) + aoff1 + m * 2048)); } while (0)
#define PG8_LDB(dst, b, h) do { _Pragma("unroll") for (int n = 0; n < 2; ++n) dst[n].set(*(const LAS bf16x8*)(lds + PG8_SB(b, h) + boff + n * 2048), *(const LAS bf16x8*)(lds + PG8_SB(b, h) + boff1 + n * 2048)); } while (0)
#define PG8_MMA(ai, bj, At, Bt) do { __builtin_amdgcn_s_setprio(1); _Pragma("unroll") for (int m = 0; m < 4; ++m) _Pragma("unroll") for (int n = 0; n < 2; ++n) \
        acc[ai][bj][m][n] = frag_mma(Bt[n], At[m], acc[ai][bj][m][n]); __builtin_amdgcn_s_setprio(0); } while (0)
#define PG8_MMA_E(ai, At, Bt) do { __builtin_amdgcn_s_setprio(1); _Pragma("unroll") for (int m = 0; m < 4; ++m) { \
        if constexpr (DEFER) { if (defer_now) { E.row(acc, pu, ai, m, wr, wc, fr, fq); \
            _Pragma("unroll") for (int n = 0; n < 2; ++n) { acc[ai][0][m][n] = (f32x4){0.f, 0.f, 0.f, 0.f}; acc[ai][1][m][n] = (f32x4){0.f, 0.f, 0.f, 0.f}; } } PG8_SCHED; } \
        _Pragma("unroll") for (int n = 0; n < 2; ++n) acc[ai][0][m][n] = frag_mma(Bt[n], At[m], acc[ai][0][m][n]); } __builtin_amdgcn_s_setprio(0); } while (0)
#define PG8_WAIT_V(n) asm volatile("s_waitcnt vmcnt(" #n ")" ::: "memory")
#define PG8_WAIT_L(n) asm volatile("s_waitcnt lgkmcnt(" #n ")" ::: "memory")
#define PG8_BAR __builtin_amdgcn_s_barrier()
#define PG8_SCHED __builtin_amdgcn_sched_barrier(0)
    Unit cur, nxt; int ui = 0;
    if (!S.next(0, cur)) return;
    f32x4 acc[2][2][4][2];
#pragma unroll
    for (int a = 0; a < 2; ++a)
#pragma unroll
        for (int b = 0; b < 2; ++b)
#pragma unroll
            for (int m = 0; m < 4; ++m)
#pragma unroll
                for (int n = 0; n < 2; ++n) acc[a][b][m][n] = (f32x4){0.f, 0.f, 0.f, 0.f};
    Frag<F8> At[4], B0[2], B1[2];
    bool pend = false; Unit pu = cur;
    const char* cA = (const char*)g.A + (size_t)cur.pm * tstep; const char* cB = (const char*)g.Bt + (size_t)cur.pn * tstep;
    S.a_ready(cur);
    if constexpr (SP2) {
        PG8_STAGE(PG8_SB(0, 0), cB, voffB); PG8_STAGE(PG8_SB(0, 1), cB + hstep, voffB); PG8_STAGE(PG8_SA(0, 0), cA, voffA[0]); PG8_STAGE(PG8_SA(0, 1), cA + hstepA, voffA[GATHER ? 1 : 0]);
        if (wr == 1) PG8_BAR;
        PG8_WAIT_V(2); PG8_BAR;
        PG8_STAGE(PG8_SB(1, 0), cB + kstep, voffB); PG8_STAGE(PG8_SA(1, 0), cA + kstep, voffA[0]); PG8_STAGE(PG8_SB(1, 1), cB + hstep + kstep, voffB);
        PG8_WAIT_V(6); PG8_BAR;
    } else {
        PG8_STAGE(PG8_SB(0, 0), cB, voffB); PG8_STAGE(PG8_SA(0, 0), cA, voffA[0]); PG8_STAGE(PG8_SB(0, 1), cB + hstep, voffB); PG8_STAGE(PG8_SA(0, 1), cA + hstepA, voffA[GATHER ? 1 : 0]);
        if (wr == 1) PG8_BAR;
        PG8_WAIT_V(4); PG8_BAR;
        PG8_STAGE(PG8_SB(1, 0), cB + kstep, voffB); PG8_STAGE(PG8_SA(1, 0), cA + kstep, voffA[0]); PG8_STAGE(PG8_SB(1, 1), cB + hstep + kstep, voffB);
        PG8_WAIT_V(6); PG8_BAR;
    }
    for (;;) {
        const bool has_next = S.next(ui + 1, nxt);
        const char* nA = has_next ? (const char*)g.A + (size_t)nxt.pm * tstep : cA; const char* nB = has_next ? (const char*)g.Bt + (size_t)nxt.pn * tstep : cB;
#pragma unroll 1
        for (int t = 0; t < nt; t += 2) {
            const bool last = (t == nt - 2);
            if constexpr (F8) { asm volatile("" : "+v"(voffA[0][0]), "+v"(voffA[0][1]), "+v"(voffB[0]), "+v"(voffB[1])); if constexpr (GATHER) asm volatile("" : "+v"(voffA[1][0]), "+v"(voffA[1][1])); }
            const char* a1 = cA + (size_t)(t + 1) * kstep;
            const char* a2 = last ? nA : cA + (size_t)(t + 2) * kstep; const char* b2 = last ? nB : cB + (size_t)(t + 2) * kstep;
            const char* a3 = a2 + kstep; const char* b3 = b2 + kstep;
            if (last && has_next) S.a_ready(nxt);
            if constexpr (SP2) {
            PG8_LDB(B0, 0, 0); PG8_LDB(B1, 0, 1); PG8_SCHED; PG8_LDA(At, 0, 0); PG8_STAGE(PG8_SA(1, 1), a1 + hstepA, voffA[GATHER ? 1 : 0]);
            bool defer_now = false; if constexpr (DEFER) defer_now = pend && t == 0;
            PG8_WAIT_V(8); PG8_WAIT_L(0); PG8_BAR; PG8_MMA_E(0, At, B0); PG8_MMA(0, 1, At, B1); PG8_BAR; PG8_SCHED;
            PG8_LDA(At, 0, 1); PG8_STAGE(PG8_SB(0, 0), b2, voffB); PG8_STAGE(PG8_SB(0, 1), b2 + hstep, voffB); PG8_STAGE(PG8_SA(0, 0), a2, voffA[0]);
            PG8_WAIT_V(8); PG8_WAIT_L(0); PG8_BAR; PG8_MMA_E(1, At, B0); PG8_MMA(1, 1, At, B1); PG8_BAR; PG8_SCHED;
            PG8_LDB(B0, 1, 0); PG8_LDB(B1, 1, 1); PG8_SCHED; PG8_LDA(At, 1, 0); PG8_STAGE(PG8_SA(0, 1), a2 + hstepA, voffA[GATHER ? 1 : 0]);
            PG8_WAIT_V(8); PG8_WAIT_L(0); PG8_BAR; PG8_MMA(0, 0, At, B0); PG8_MMA(0, 1, At, B1); PG8_BAR; PG8_SCHED;
            PG8_LDA(At, 1, 1); PG8_STAGE(PG8_SB(1, 0), b3, voffB); PG8_STAGE(PG8_SB(1, 1), b3 + hstep, voffB); PG8_STAGE(PG8_SA(1, 0), a3, voffA[0]);
            PG8_WAIT_V(8); PG8_WAIT_L(0); PG8_BAR; PG8_MMA(1, 0, At, B0); PG8_MMA(1, 1, At, B1); PG8_BAR; PG8_SCHED;
            } else {
            PG8_LDB(B0, 0, 0); PG8_SCHED; PG8_LDA(At, 0, 0); PG8_STAGE(PG8_SA(1, 1), a1 + hstepA, voffA[GATHER ? 1 : 0]);
            PG8_WAIT_L(8); PG8_BAR; PG8_WAIT_L(0); PG8_MMA(0, 0, At, B0); PG8_BAR; PG8_SCHED;
            PG8_LDB(B1, 0, 1); PG8_STAGE(PG8_SB(0, 0), b2, voffB);
            PG8_BAR; PG8_WAIT_L(0); PG8_MMA(0, 1, At, B1); PG8_BAR;
            PG8_LDA(At, 0, 1); PG8_STAGE(PG8_SA(0, 0), a2, voffA[0]);
            PG8_BAR; PG8_WAIT_L(0); PG8_MMA(1, 0, At, B0); PG8_BAR; PG8_SCHED;
            PG8_STAGE(PG8_SB(0, 1), b2 + hstep, voffB);
            PG8_WAIT_V(6); PG8_BAR; PG8_MMA(1, 1, At, B1); PG8_BAR;
            PG8_LDB(B0, 1, 0); PG8_SCHED; PG8_LDA(At, 1, 0); PG8_STAGE(PG8_SA(0, 1), a2 + hstepA, voffA[GATHER ? 1 : 0]);
            PG8_WAIT_L(8); PG8_BAR; PG8_WAIT_L(0); PG8_MMA(0, 0, At, B0); PG8_BAR; PG8_SCHED;
            PG8_LDB(B1, 1, 1); PG8_STAGE(PG8_SB(1, 0), b3, voffB);
            PG8_BAR; PG8_WAIT_L(0); PG8_MMA(0, 1, At, B1); PG8_BAR;
            PG8_LDA(At, 1, 1); PG8_STAGE(PG8_SA(1, 0), a3, voffA[0]);
            PG8_BAR; PG8_WAIT_L(0); PG8_MMA(1, 0, At, B0); PG8_BAR; PG8_SCHED;
            PG8_STAGE(PG8_SB(1, 1), b3 + hstep, voffB);
            PG8_WAIT_V(6); PG8_BAR; PG8_MMA(1, 1, At, B1); PG8_BAR;
            }
        }
        if (DEFER && has_next) { pend = true; pu = cur; cur = nxt; cA = nA; cB = nB; ++ui; continue; }
        if constexpr (ALIGN_EPI) { if (wr == 0) PG8_BAR; }
        if constexpr (F8) asm volatile("s_nop 15\n\ts_nop 7" ::: "memory");
        E(acc, cur, wr, wc, fr, fq); S.done(cur);
        if (!has_next) break;
#pragma unroll
        for (int a = 0; a < 2; ++a)
#pragma unroll
            for (int b = 0; b < 2; ++b)
#pragma unroll
                for (int m = 0; m < 4; ++m)
#pragma unroll
                    for (int n = 0; n < 2; ++n) acc[a][b][m][n] = (f32x4){0.f, 0.f, 0.f, 0.f};
        cur = nxt; cA = nA; cB = nB; ++ui;
        if constexpr (ALIGN_EPI) { if (wr == 1) PG8_BAR; }
    }
    PG8_WAIT_V(0);
    if constexpr (!ALIGN_EPI) { if (wr == 0) PG8_BAR; }
    PG8_BAR;
#undef PG8_SA
#undef PG8_SB
#undef PG8_STAGE
#undef PG8_LDA
#undef PG8_LDB
#undef PG8_MMA
#undef PG8_WAIT_V
#undef PG8_WAIT_L
#undef PG8_BAR
#undef PG8_SCHED
}
}

typedef GAS unsigned gu32;
#define RLX_AGENT __ATOMIC_RELAXED, __HIP_MEMORY_SCOPE_AGENT
#define LDS_WAIT() asm volatile("s_waitcnt lgkmcnt(0)" ::: "memory")
#define VM_WAIT() asm volatile("s_waitcnt vmcnt(0)" ::: "memory")
__device__ __forceinline__ unsigned pk2(float lo, float hi) { return pg8::cvt_pk_bf16(lo, hi); }
__device__ __forceinline__ float bf2f(unsigned short h) { return __uint_as_float((unsigned)h << 16); }
__device__ __forceinline__ float bflo(unsigned w) { return __uint_as_float(w << 16); }
__device__ __forceinline__ float bfhi(unsigned w) { return __uint_as_float(w & 0xffff0000u); }
__device__ __forceinline__ float wave_sum(float v) {
    v += __builtin_bit_cast(float, __builtin_amdgcn_update_dpp(0, __builtin_bit_cast(int, v), 0xB1, 0xf, 0xf, true));
    v += __builtin_bit_cast(float, __builtin_amdgcn_update_dpp(0, __builtin_bit_cast(int, v), 0x4E, 0xf, 0xf, true));
    v += __builtin_bit_cast(float, __builtin_amdgcn_update_dpp(0, __builtin_bit_cast(int, v), 0x141, 0xf, 0xf, true));
    v += __builtin_bit_cast(float, __builtin_amdgcn_update_dpp(0, __builtin_bit_cast(int, v), 0x140, 0xf, 0xf, true));
    v += __builtin_bit_cast(float, __builtin_amdgcn_update_dpp(0, __builtin_bit_cast(int, v), 0x142, 0xa, 0xf, false));
    v += __builtin_bit_cast(float, __builtin_amdgcn_update_dpp(0, __builtin_bit_cast(int, v), 0x143, 0xc, 0xf, false));
    return __builtin_bit_cast(float, __builtin_amdgcn_readlane(__builtin_bit_cast(int, v), 63));
}

#define XB_TMO      128
#define XB_XCNT(j)  (256  + 64 * (j))
#define XB_XSUB(j)  (1280 + 64 * (j))
#define XB_XGEN(j)  (2304 + 64 * (j))
#define XB_TOP      3328
#define XB_TOPGEN   3392
#define XCD_BAR_WORDS 3456
#define XB_SPIN_CAP (1u << 18)
__device__ __forceinline__ unsigned xb_ld(unsigned* p)              { return __hip_atomic_load(p, __ATOMIC_RELAXED, __HIP_MEMORY_SCOPE_AGENT); }
__device__ __forceinline__ unsigned xb_add(unsigned* p, unsigned v) { return __hip_atomic_fetch_add(p, v, __ATOMIC_RELAXED, __HIP_MEMORY_SCOPE_AGENT); }
__device__ __forceinline__ unsigned xb_xcc_id() { return (unsigned)__builtin_amdgcn_s_getreg((3 << 11) | 20) & 0xFu; }
#define XB_SPIN(cond, bar) do { unsigned _sp = 0; while (cond) { __builtin_amdgcn_s_sleep(1); \
    if ((++_sp & 255u) == 0u) { if (xb_ld(&(bar)[XB_TMO])) break; if (_sp > XB_SPIN_CAP) { atomicAdd(&(bar)[XB_TMO], 1u); break; } } } } while (0)
struct XcdBarrier { unsigned* bar; unsigned x; volatile LAS unsigned* st; };
__device__ __forceinline__ XcdBarrier xcd_barrier_post(unsigned* bar, volatile LAS unsigned* st) {
    XcdBarrier b; b.bar = bar; b.x = xb_xcc_id(); b.st = st;
    if (threadIdx.x == 0) (void)xb_add(&bar[XB_XCNT(b.x)], 1u);
    return b;
}
__device__ __forceinline__ void xcd_barrier_complete(unsigned* bar, unsigned x, unsigned& nloc, unsigned& nx) {
    const unsigned G = gridDim.x * gridDim.y * gridDim.z;
    unsigned sum, cnt, mine, sp = 0u;
    for (;;) {
        sum = 0u; cnt = 0u; mine = 0u;
#pragma unroll
        for (unsigned j = 0; j < 16; ++j) { const unsigned c = xb_ld(&bar[XB_XCNT(j)]); sum += c; cnt += (c > 0u) ? 1u : 0u; mine = (j == x) ? c : mine; }
        if (sum == G) break;
        __builtin_amdgcn_s_sleep(1);
        if ((++sp & 255u) == 0u) { if (xb_ld(&bar[XB_TMO])) break; if (sp > XB_SPIN_CAP) { atomicAdd(&bar[XB_TMO], 1u); break; } }
    }
    nloc = mine > 0u ? mine : 1u; nx = cnt > 0u ? cnt : 1u;
}
__device__ __forceinline__ void xcd_barrier(const XcdBarrier& b) {
    asm volatile("s_waitcnt vmcnt(0)" ::: "memory");
    __syncthreads();
    if (threadIdx.x == 0) {
        unsigned* bar = b.bar;
        __builtin_amdgcn_s_waitcnt(0);
        unsigned nloc = b.st[0], nx = b.st[1];
        if (nloc == 0u) { xcd_barrier_complete(bar, b.x, nloc, nx); b.st[0] = nloc; b.st[1] = nx; }
        const unsigned old = xb_add(&bar[XB_XSUB(b.x)], 1u);
        const unsigned gen = old / nloc;
        if (old + 1u == (gen + 1u) * nloc) {
            __builtin_amdgcn_fence(__ATOMIC_RELEASE, "agent");
            asm volatile("s_waitcnt vmcnt(0)" ::: "memory");
            const unsigned og = xb_add(&bar[XB_TOP], 1u);
            const unsigned tg = og / nx;
            if (og + 1u == (tg + 1u) * nx) xb_add(&bar[XB_TOPGEN], 1u);
            else XB_SPIN(xb_ld(&bar[XB_TOPGEN]) == tg, bar);
            __builtin_amdgcn_fence(__ATOMIC_ACQUIRE, "agent");
            xb_add(&bar[XB_XGEN(b.x)], 1u);
            asm volatile("s_waitcnt vmcnt(0)" ::: "memory");
        } else {
            XB_SPIN(xb_ld(&bar[XB_XGEN(b.x)]) == gen, bar);
            __builtin_amdgcn_fence(__ATOMIC_ACQUIRE, "agent");
            asm volatile("s_waitcnt vmcnt(0)" ::: "memory");
        }
    }
    __syncthreads();
}

constexpr int RING_BYTES = 131072;
constexpr int LDSCTL_OFF = RING_BYTES, MISC_OFF = LDSCTL_OFF + 320;
constexpr int LDS_BYTES = 147456;
constexpr int CW_BAR = 4096;
constexpr int CW_KMAX = 65536;

struct Args { const float* in[22]; float* out; unsigned char* ws; int ph_lo, ph_hi; };
enum { I_X = 0, I_C, I_CTX, I_CCTX, I_WADA, I_BADA, I_NPRE_MIX, I_NPOST_MIX, I_NPRE_FFN, I_NPOST_FFN, I_WIN, I_CONVW, I_LQ1, I_LK1, I_LQ2, I_LK2, I_SUBLN, I_WOUT, I_WROUTER, I_WGATE, I_WUP, I_WDOWN };

__device__ __forceinline__ int win_dest(int n) {
    if (n < 1024) { const int j = n & 63; const int p = ((j >> 5) << 5) + ((j & 15) << 1) + ((j >> 4) & 1); return (n & ~63) + p; }
    if (n < 1536) { const int dv = n & 127; return (n & ~127) + ((dv & 3) << 5) + (dv >> 2); }
    if (n < 2048) return n;
    int c = n - 2048; const int isx = c >= 512; c &= 511; return 2048 + ((c >> 7) << 8) + (isx << 7) + (c & 127);
}
template <int MODE>
__device__ __forceinline__ int tr_dest(int n) {
    if (MODE == 0) return n;
    if (MODE == 1) return win_dest(n);
    if (MODE == 2) return ((n >> 7) << 8) + (n & 127);
    return ((n >> 7) << 8) + 128 + (n & 127);
}
template <int MODE>
__device__ __forceinline__ void p0_transpose_item_f8(const float* W, int K, int N, unsigned char* WT, LAS float* scr, int item, int lane) {
    const int nblk = N / 32, kb = item / nblk, nb = item % nblk, k0 = 64 * kb, n0 = 32 * nb;
#pragma unroll 8
    for (int i = 0; i < 32; ++i) { const int kk = 2 * i + (lane >> 5); scr[kk * 33 + (lane & 31)] = __builtin_nontemporal_load(W + (size_t)(k0 + kk) * N + n0 + (lane & 31)) * pg8::F8_WGT; }
    LDS_WAIT(); asm volatile("" ::: "memory");
    const int c = lane & 7;
#pragma unroll
    for (int j = 0; j < 4; ++j) { const int n = (lane >> 3) + 8 * j; const LAS float* s = scr + (8 * c) * 33 + n;
        u32x2 o; o.x = pg8::pk4_fp8(s[0 * 33], s[1 * 33], s[2 * 33], s[3 * 33]); o.y = pg8::pk4_fp8(s[4 * 33], s[5 * 33], s[6 * 33], s[7 * 33]);
        *(GAS u32x2*)(WT + (size_t)tr_dest<MODE>(n0 + n) * K + k0 + 8 * c) = o; }
    LDS_WAIT(); asm volatile("" ::: "memory");
}
template <int MODE>
__device__ __forceinline__ void p0_transpose_item(const float* W, int K, int N, bf16_t* WT, LAS float* scr, int item, int lane) {
    const int nblk = N / 32, kb = item / nblk, nb = item % nblk, k0 = 64 * kb, n0 = 32 * nb;
#pragma unroll 8
    for (int i = 0; i < 32; ++i) { const int kk = 2 * i + (lane >> 5); scr[kk * 33 + (lane & 31)] = W[(size_t)(k0 + kk) * N + n0 + (lane & 31)]; }
    LDS_WAIT(); asm volatile("" ::: "memory");
    const int c = lane & 7;
#pragma unroll
    for (int j = 0; j < 4; ++j) { const int n = (lane >> 3) + 8 * j; const LAS float* s = scr + (8 * c) * 33 + n;
        u32x4 o; o.x = pk2(s[0 * 33], s[1 * 33]); o.y = pk2(s[2 * 33], s[3 * 33]); o.z = pk2(s[4 * 33], s[5 * 33]); o.w = pk2(s[6 * 33], s[7 * 33]);
        *(GAS u32x4*)(WT + (size_t)tr_dest<MODE>(n0 + n) * K + k0 + 8 * c) = o; }
    LDS_WAIT(); asm volatile("" ::: "memory");
}

__device__ __forceinline__ void p0_prologue(const Args& a, LAS unsigned char* lds, int vcu, int G) {
    const int tid = opaque_tid(), lane = tid & 63, wave = __builtin_amdgcn_readfirstlane(tid >> 6);
    LAS float* scr = (LAS float*)(lds + wave * 16384);
    const int gw = vcu * NWAVES + wave, NGW = G * NWAVES;
    unsigned char* ws = a.ws;
    if (gw < 96 * 16) {
        float* MODP = (float*)(ws + WS_MODP);
        const float* wada = a.in[I_WADA];
        for (int it = gw; it < 96 * 16; it += NGW) {
            const int cg = it % 96, kc = it / 96;
            for (int b = 0; b < 33; ++b) { const float v = (b < 32) ? a.in[I_C][b * D + kc * 64 + lane] : a.in[I_CCTX][kc * 64 + lane]; scr[b * 64 + lane] = v / (1.f + __expf(-v)); }
            LDS_WAIT(); asm volatile("" ::: "memory");
            float acc[33];
#pragma unroll
            for (int b = 0; b < 33; ++b) acc[b] = 0.f;
            const float* wp = wada + (size_t)(kc * 64) * NMOD + cg * 64 + lane;
#pragma unroll 2
            for (int k = 0; k < 64; k += 4) {
                const float w0 = __builtin_nontemporal_load(wp + (size_t)(k + 0) * NMOD), w1 = __builtin_nontemporal_load(wp + (size_t)(k + 1) * NMOD),
                            w2 = __builtin_nontemporal_load(wp + (size_t)(k + 2) * NMOD), w3 = __builtin_nontemporal_load(wp + (size_t)(k + 3) * NMOD);
#pragma unroll
                for (int b = 0; b < 33; ++b) { const f32x4 sv4 = *(const LAS f32x4*)(scr + b * 64 + k); acc[b] += (sv4.x * w0 + sv4.y * w1) + (sv4.z * w2 + sv4.w * w3); }
            }
#pragma unroll
            for (int b = 0; b < 33; ++b) MODP[((size_t)kc * 33 + b) * NMOD + cg * 64 + lane] = acc[b];
            LDS_WAIT(); asm volatile("" ::: "memory");
        }
    } else {
        float* tab = (float*)(ws + WS_TAB);
        const int nw = NGW - 96 * 16;
        for (int e = (gw - 96 * 16) * 64 + lane; e < T * 32; e += nw * 64) {
            const int t = e >> 5, i = e & 31;
            const float inv = powf(10000.0f, -(float)(2 * (i & 15)) / 32.0f);
            const float pos = (i < 16) ? (float)(t >> 6) : (float)(t & 63);
            const float ang = pos * inv;
            tab[2 * e] = cosf(ang); tab[2 * e + 1] = sinf(ang);
        }
    }
}
__device__ __forceinline__ void inout_weight_copies(const Args& a, LAS unsigned char* lds, int vcu, int G) {
    const int tid = opaque_tid(), lane = tid & 63, wave = __builtin_amdgcn_readfirstlane(tid >> 6);
    LAS float* scr = (LAS float*)(lds + 16384 + wave * 12288);
    const int gw = vcu * NWAVES + wave, NGW = G * NWAVES;
    unsigned char* ws = a.ws;
    constexpr int I_IN = (D / 64) * (NPROJ / 32), I_OUT = (D / 64) * (D / 32);
    constexpr int NITEMS = I_IN + I_OUT;
    bf16_t* Win_t = (bf16_t*)(ws + WS_WIN); bf16_t* Wout_t = (bf16_t*)(ws + WS_WOUT);
    for (int it = gw; it < NITEMS; it += NGW) {
        int r = it;
        if (r < I_IN) { p0_transpose_item<1>(a.in[I_WIN], D, NPROJ, Win_t, scr, r, lane); continue; } r -= I_IN;
        p0_transpose_item<0>(a.in[I_WOUT], D, D, Wout_t, scr, r, lane);
    }
}
__device__ __forceinline__ void expert_weight_copies(const Args& a, LAS unsigned char* lds, int gw0  , int ngroups, int r_lo, int r_hi) {
    const int tid = opaque_tid(), lane = tid & 63, wave = __builtin_amdgcn_readfirstlane(tid >> 6);
    LAS float* scr = (LAS float*)(lds + wave * 16384);
    const int gw = gw0 * NWAVES + wave, NGW = ngroups * NWAVES;
    unsigned char* ws = a.ws;
    constexpr int I_EXP = (D / 64) * (D / 32);
    unsigned char* Wgu_t = ws + WS_WGU; unsigned char* Wdn_t = ws + WS_WDN;
    for (int r = r_lo + gw; r < r_hi; r += NGW) {
        const int e = r / (3 * I_EXP), q = (r % (3 * I_EXP)) / I_EXP, rr = r % I_EXP;
        if (q == 0) p0_transpose_item_f8<2>(a.in[I_WGATE] + (size_t)e * D * D, D, D, Wgu_t + (size_t)e * 2048 * D, scr, rr, lane);
        else if (q == 1) p0_transpose_item_f8<3>(a.in[I_WUP] + (size_t)e * D * D, D, D, Wgu_t + (size_t)e * 2048 * D, scr, rr, lane);
        else p0_transpose_item_f8<0>(a.in[I_WDOWN] + (size_t)e * D * D, D, D, Wdn_t + (size_t)e * D * D, scr, rr, lane);
    }
    __syncthreads();
}

struct RowF { f32x4 v[4]; };
__device__ __forceinline__ void row_load(RowF& r, const float* xrow, int lane) {
    const f32x4* xr = (const f32x4*)xrow + lane;
#pragma unroll
    for (int j = 0; j < 4; ++j) r.v[j] = __builtin_nontemporal_load(xr + 64 * j);
}
__device__ __forceinline__ void norm_mod_row(const RowF& r, bf16_t* orow, const float* gain, const LAS float* sc, const LAS float* sh, int lane) {
    const f32x4* gr = (const f32x4*)gain + lane;
    float s = 0.f;
#pragma unroll
    for (int j = 0; j < 4; ++j) s += (r.v[j].x * r.v[j].x + r.v[j].y * r.v[j].y) + (r.v[j].z * r.v[j].z + r.v[j].w * r.v[j].w);
    const float rstd = 1.0f / sqrtf(wave_sum(s) * (1.f / D) + EPS);
    u32x2* o8 = (u32x2*)orow + lane;
#pragma unroll
    for (int j = 0; j < 4; ++j) { const f32x4 g = gr[64 * j]; const f32x4 c1 = *(const LAS f32x4*)(sc + 4 * lane + 256 * j), h1 = *(const LAS f32x4*)(sh + 4 * lane + 256 * j);
        const f32x4 y = (r.v[j] * rstd) * g; const f32x4 z = y * (c1 + 1.0f) + h1;
        u32x2 w; w.x = pk2(z.x, z.y); w.y = pk2(z.z, z.w); o8[64 * j] = w; }
}
__device__ __forceinline__ void p1_xn(const Args& a, LAS unsigned char* lds, int c, int G) {
    const int tid = opaque_tid(), lane = tid & 63, wave = __builtin_amdgcn_readfirstlane(tid >> 6);
    unsigned char* ws = a.ws;
    const float* MODP = (const float*)(ws + WS_MODP); float* MOD = (float*)(ws + WS_MOD); const float* bada = a.in[I_BADA];
    { const int per = (33 * NMOD + G - 1) / G;
      for (int i = c * per + tid; i < (c + 1) * per && i < 33 * NMOD; i += NTHREADS) { const int r = i / NMOD, n = i - r * NMOD; float s = bada[n];
#pragma unroll
            for (int kc = 0; kc < 16; ++kc) s += MODP[((size_t)kc * 33 + r) * NMOD + n];
            MOD[i] = s; } }
    LAS float* sv = (LAS float*)lds;
    bf16_t* XN = (bf16_t*)(ws + WS_XN);
    const float* X = a.in[I_X]; const float* CTX = a.in[I_CTX]; const float* gain = a.in[I_NPRE_MIX];
    for (int p = c; p < 256; p += G) {
        const int b = p >> 3;
        const int rbase = p * 256 + wave * 32;
        RowF a0, a1, a2, a3;
        row_load(a0, X + (size_t)rbase * D, lane); row_load(a1, X + (size_t)(rbase + 1) * D, lane); row_load(a2, X + (size_t)(rbase + 2) * D, lane); row_load(a3, X + (size_t)(rbase + 3) * D, lane);
        __syncthreads();
        for (int n = tid; n < 4096; n += NTHREADS) { const int r = (n < 2048) ? b : 32; const int col = n & 2047; float s = bada[col];
#pragma unroll
            for (int kc = 0; kc < 16; ++kc) s += MODP[((size_t)kc * 33 + r) * NMOD + col];
            sv[n] = s; }
        __syncthreads();
        const int crow = p * 32 + wave * 4;
        for (int i = 0; i < 8; ++i) {
            RowF n0, n1, n2, n3;
            const float* nx = (i + 1 < 8) ? X + (size_t)(rbase + 4 * (i + 1)) * D : CTX + (size_t)crow * D;
            row_load(n0, nx, lane); row_load(n1, nx + D, lane); row_load(n2, nx + 2 * D, lane); row_load(n3, nx + 3 * D, lane);
            bf16_t* orow = XN + (size_t)(rbase + 4 * i) * D;
            norm_mod_row(a0, orow, gain, sv + 1024, sv, lane);
            norm_mod_row(a1, orow + D, gain, sv + 1024, sv, lane);
            norm_mod_row(a2, orow + 2 * D, gain, sv + 1024, sv, lane);
            norm_mod_row(a3, orow + 3 * D, gain, sv + 1024, sv, lane);
            a0 = n0; a1 = n1; a2 = n2; a3 = n3;
        }
        { bf16_t* orow = XN + (size_t)(M + crow) * D;
          norm_mod_row(a0, orow, gain, sv + 3072, sv + 2048, lane);
          norm_mod_row(a1, orow + D, gain, sv + 3072, sv + 2048, lane);
          norm_mod_row(a2, orow + 2 * D, gain, sv + 3072, sv + 2048, lane);
          norm_mod_row(a3, orow + 3 * D, gain, sv + 3072, sv + 2048, lane); }
    }
}

__device__ __forceinline__ float half_sum32(float v, int hi) {
    v += __builtin_bit_cast(float, __builtin_amdgcn_update_dpp(0, __builtin_bit_cast(int, v), 0xB1, 0xf, 0xf, true));
    v += __builtin_bit_cast(float, __builtin_amdgcn_update_dpp(0, __builtin_bit_cast(int, v), 0x4E, 0xf, 0xf, true));
    v += __builtin_bit_cast(float, __builtin_amdgcn_update_dpp(0, __builtin_bit_cast(int, v), 0x141, 0xf, 0xf, true));
    v += __builtin_bit_cast(float, __builtin_amdgcn_update_dpp(0, __builtin_bit_cast(int, v), 0x140, 0xf, 0xf, true));
    v += __builtin_bit_cast(float, __builtin_amdgcn_update_dpp(0, __builtin_bit_cast(int, v), 0x142, 0xa, 0xf, false));
    const float s0 = __builtin_bit_cast(float, __builtin_amdgcn_readlane(__builtin_bit_cast(int, v), 31)), s1 = __builtin_bit_cast(float, __builtin_amdgcn_readlane(__builtin_bit_cast(int, v), 63));
    return hi ? s1 : s0;
}
namespace att {
constexpr int KP = 272, KBUF = 64 * KP, VBUF = 16384;
constexpr int OFF_K = 0, OFF_V = 2 * KBUF, OFF_WSF = OFF_V + 2 * VBUF, OFF_END = OFF_WSF + NWAVES * 256;
static_assert(OFF_WSF >= 65536 && OFF_END <= RING_BYTES, "attention LDS map");
constexpr int NT = TK / 64;
constexpr float THR = 8.0f;
__device__ __forceinline__ int crow(int r, int hi) { return (r & 3) + 8 * (r >> 2) + 4 * hi; }
__device__ __forceinline__ float max3f(float a, float b, float c) { float r; asm("v_max3_f32 %0, %1, %2, %3" : "=v"(r) : "v"(a), "v"(b), "v"(c)); return r; }
__device__ __forceinline__ float max2f(float a, float b) { float r; asm("v_max_f32_e32 %0, %1, %2" : "=v"(r) : "v"(a), "v"(b)); return r; }
__device__ __forceinline__ s16x4 vtr(const LAS unsigned char* p) { return __builtin_bit_cast(s16x4, __builtin_amdgcn_ds_read_tr16_b64_v4i16((LAS s16x4*)p)); }

#define ATT_BAR() asm volatile("s_waitcnt lgkmcnt(0)\n\ts_barrier" ::: "memory")
#define ATT_SB() __builtin_amdgcn_sched_barrier(0)
#define ATT_KLD(i, KF) KF = *(const LAS bf16x8*)(kb_ + ((i) & 1) * (32 * KP) + ((i) >> 1) * 32)
#define ATT_XSTEP(i, KC, KN) do { if ((i) + 2 < 8) { ATT_KLD((i) + 2, KN); } \
    if ((i) == 0) p0 = __builtin_amdgcn_mfma_f32_32x32x16_bf16(KC, qr[0], negref, 0, 0, 0); \
    else if ((i) == 1) p1 = __builtin_amdgcn_mfma_f32_32x32x16_bf16(KC, qr[0], negref, 0, 0, 0); \
    else if (((i) & 1) == 0) p0 = __builtin_amdgcn_mfma_f32_32x32x16_bf16(KC, qr[(i) >> 1], p0, 0, 0, 0); else p1 = __builtin_amdgcn_mfma_f32_32x32x16_bf16(KC, qr[(i) >> 1], p1, 0, 0, 0); ATT_SB(); } while (0)
#define ATT_X(kcur) do { \
    const LAS unsigned char* kb_ = lds + OFF_K + (kcur) * KBUF + koff; \
    bf16x8 ka_, kb2_, kc_; \
    ATT_KLD(0, ka_); ATT_KLD(1, kb2_); \
    ATT_SB(); \
    ATT_XSTEP(0, ka_, kc_); ATT_XSTEP(1, kb2_, ka_); ATT_XSTEP(2, kc_, kb2_); ATT_XSTEP(3, ka_, kc_); \
    ATT_XSTEP(4, kb2_, ka_); ATT_XSTEP(5, kc_, kb2_); ATT_XSTEP(6, ka_, kc_); ATT_XSTEP(7, kb2_, ka_); \
} while (0)
#define ATT_EXP2(i, PWN) do { \
    const float e0_ = __builtin_amdgcn_exp2f((i) < 8 ? p0[2 * ((i) & 7)] : p1[2 * ((i) & 7)]), e1_ = __builtin_amdgcn_exp2f((i) < 8 ? p0[2 * ((i) & 7) + 1] : p1[2 * ((i) & 7) + 1]); \
    sacc_ += e0_ + e1_; PWN[(i) >> 2][(i) & 3] = pk2(e0_, e1_); asm volatile("" : "+v"(PWN[(i) >> 2]), "+v"(sacc_)); } while (0)
#define ATT_VLD(i, LO, HI) do { LO = vtr(vb_ + ((i) & 3) * 4096 + ((i) >> 2) * 1024); HI = vtr(vb_ + ((i) & 3) * 4096 + ((i) >> 2) * 1024 + 512); } while (0)
#define ATT_VF(LO, HI) ((bf16x8){LO[0], LO[1], LO[2], LO[3], HI[0], HI[1], HI[2], HI[3]})
#define ATT_YSTEP(i, PWC, PWN, LC, HC, LN, HN) do { if ((i) + 2 < 16) { ATT_VLD((i) + 2, LN, HN); } \
    o[(i) & 3] = __builtin_amdgcn_mfma_f32_32x32x16_bf16(__builtin_bit_cast(bf16x8, PWC[(i) >> 2]), ATT_VF(LC, HC), o[(i) & 3], 0, 0, 0); \
    ATT_EXP2(i, PWN); ATT_SB(); } while (0)
#define ATT_Y(vcur, PWC, PWN) do { \
    const LAS unsigned char* vb_ = lds + OFF_V + (vcur) * VBUF + voff; \
    float sacc_ = 0.f; s16x4 la_, ha_, lb_, hb_, lc_, hc_; \
    ATT_VLD(0, la_, ha_); ATT_VLD(1, lb_, hb_); ATT_SB(); \
    ATT_YSTEP(0, PWC, PWN, la_, ha_, lc_, hc_); ATT_YSTEP(1, PWC, PWN, lb_, hb_, la_, ha_); ATT_YSTEP(2, PWC, PWN, lc_, hc_, lb_, hb_); \
    ATT_YSTEP(3, PWC, PWN, la_, ha_, lc_, hc_); ATT_YSTEP(4, PWC, PWN, lb_, hb_, la_, ha_); ATT_YSTEP(5, PWC, PWN, lc_, hc_, lb_, hb_); \
    ATT_YSTEP(6, PWC, PWN, la_, ha_, lc_, hc_); ATT_YSTEP(7, PWC, PWN, lb_, hb_, la_, ha_); ATT_YSTEP(8, PWC, PWN, lc_, hc_, lb_, hb_); \
    ATT_YSTEP(9, PWC, PWN, la_, ha_, lc_, hc_); ATT_YSTEP(10, PWC, PWN, lb_, hb_, la_, ha_); ATT_YSTEP(11, PWC, PWN, lc_, hc_, lb_, hb_); \
    ATT_YSTEP(12, PWC, PWN, la_, ha_, lc_, hc_); ATT_YSTEP(13, PWC, PWN, lb_, hb_, la_, ha_); ATT_YSTEP(14, PWC, PWN, lc_, hc_, lb_, hb_); \
    ATT_YSTEP(15, PWC, PWN, la_, ha_, lc_, hc_); \
    l_reg += sacc_; \
} while (0)
#define ATT_Y0(PWN) do { float sacc_ = 0.f; _Pragma("unroll") for (int i = 0; i < 16; ++i) ATT_EXP2(i, PWN); l_reg += sacc_; } while (0)
#define ATT_ZSTEP(i, PWC, LC, HC, LN, HN) do { if ((i) + 2 < 16) { ATT_VLD((i) + 2, LN, HN); } \
    o[(i) & 3] = __builtin_amdgcn_mfma_f32_32x32x16_bf16(__builtin_bit_cast(bf16x8, PWC[(i) >> 2]), ATT_VF(LC, HC), o[(i) & 3], 0, 0, 0); ATT_SB(); } while (0)
#define ATT_Z(vcur, PWC) do { \
    const LAS unsigned char* vb_ = lds + OFF_V + (vcur) * VBUF + voff; \
    s16x4 la_, ha_, lb_, hb_, lc_, hc_; \
    ATT_VLD(0, la_, ha_); ATT_VLD(1, lb_, hb_); ATT_SB(); \
    ATT_ZSTEP(0, PWC, la_, ha_, lc_, hc_); ATT_ZSTEP(1, PWC, lb_, hb_, la_, ha_); ATT_ZSTEP(2, PWC, lc_, hc_, lb_, hb_); \
    ATT_ZSTEP(3, PWC, la_, ha_, lc_, hc_); ATT_ZSTEP(4, PWC, lb_, hb_, la_, ha_); ATT_ZSTEP(5, PWC, lc_, hc_, lb_, hb_); \
    ATT_ZSTEP(6, PWC, la_, ha_, lc_, hc_); ATT_ZSTEP(7, PWC, lb_, hb_, la_, ha_); ATT_ZSTEP(8, PWC, lc_, hc_, lb_, hb_); \
    ATT_ZSTEP(9, PWC, la_, ha_, lc_, hc_); ATT_ZSTEP(10, PWC, lb_, hb_, la_, ha_); ATT_ZSTEP(11, PWC, lc_, hc_, lb_, hb_); \
    ATT_ZSTEP(12, PWC, la_, ha_, lc_, hc_); ATT_ZSTEP(13, PWC, lb_, hb_, la_, ha_); ATT_ZSTEP(14, PWC, lc_, hc_, lb_, hb_); \
    ATT_ZSTEP(15, PWC, la_, ha_, lc_, hc_); \
} while (0)
#define ATT_STAGE(j) do { \
    if ((j) + 1 < NT) { _Pragma("unroll") for (int i = 0; i < 2; ++i) *(LAS u32x4*)(lds + OFF_K + (((j) + 1) & 1) * KBUF + kdst[i]) = kr[i]; } \
    _Pragma("unroll") for (int i = 0; i < 2; ++i) *(LAS u32x4*)(lds + OFF_V + ((j) & 1) * VBUF + vdst[i]) = vr[i]; \
    if ((j) + 2 < NT) { _Pragma("unroll") for (int i = 0; i < 2; ++i) kr[i] = ATT_BLD(krs, gsrc[i], ((j) + 2) * (64 * 1024)); } \
    if ((j) + 1 < NT) { _Pragma("unroll") for (int i = 0; i < 2; ++i) vr[i] = ATT_BLD(vrs, gsrc[i], ((j) + 1) * (64 * 1024)); } } while (0)
#define ATT_BLD(rs, voff_, soff_) __builtin_bit_cast(u32x4, __builtin_amdgcn_raw_buffer_load_b128(rs, (int)(voff_), (int)(soff_), 0))

__device__ __forceinline__ void unit(LAS unsigned char* lds, int b, int h, int qb, const bf16_t* Q, const bf16_t* KA, const bf16_t* VA, bf16_t* MIXIN, const float* subg, float lam, const unsigned* KM) {
    const int tid = opaque_tid(), lane = tid & 63, r32 = lane & 31, hi = lane >> 5;
    const int wid = __builtin_amdgcn_readfirstlane(tid >> 6), w = wid & 3, m = wid >> 2;
    LAS float* wsf = (LAS float*)(lds + OFF_WSF) + wid * 64;
    const int rowQ = b * T + qb * 128 + w * 32;
    bf16x8 qr[4];
#pragma unroll
    for (int d0 = 0; d0 < 4; ++d0) qr[d0] = *(const bf16x8*)(Q + (size_t)(rowQ + r32) * 512 + h * 128 + m * 64 + d0 * 16 + hi * 8);
    const bf16_t* Kb = KA + (size_t)b * TK * 512 + h * 128; const bf16_t* Vb = VA + (size_t)b * TK * 512 + h * 128;
    const __amdgpu_buffer_rsrc_t krs = __builtin_amdgcn_make_buffer_rsrc((void*)Kb, 0, 0x7fffffff, 0x00020000), vrs = __builtin_amdgcn_make_buffer_rsrc((void*)Vb, 0, 0x7fffffff, 0x00020000);
    unsigned gsrc[2]; int kdst[2], vdst[2];
#pragma unroll
    for (int i = 0; i < 2; ++i) { const int cid = tid + 512 * i, kv = cid >> 4, c16 = cid & 15;
        gsrc[i] = (unsigned)(kv * 1024 + c16 * 16); kdst[i] = kv * KP + c16 * 16; vdst[i] = (c16 >> 2) * 4096 + (kv >> 4) * 1024 + (kv & 15) * 64 + (c16 & 3) * 16; }
    u32x4 kr[2], vr[2];
#pragma unroll
    for (int i = 0; i < 2; ++i) { kr[i] = ATT_BLD(krs, gsrc[i], 0); vr[i] = ATT_BLD(vrs, gsrc[i], 0); }
#pragma unroll
    for (int i = 0; i < 2; ++i) *(LAS u32x4*)(lds + OFF_K + kdst[i]) = kr[i];
#pragma unroll
    for (int i = 0; i < 2; ++i) kr[i] = ATT_BLD(krs, gsrc[i], 64 * 1024);
    ATT_BAR();
    f32x16 o[4];
#pragma unroll
    for (int d0 = 0; d0 < 4; ++d0) o[d0] = (f32x16){};
    float l_reg = 0.f;
    f32x16 p0, p1, negref;
    {
        const unsigned* km = KM + (b * 8 + h * 2 + m) * 2;
        const float kmax2 = __uint_as_float(km[0]) + __uint_as_float(km[1]);
        float ss = 0.f;
#pragma unroll
        for (int d0 = 0; d0 < 4; ++d0)
#pragma unroll
            for (int i = 0; i < 8; ++i) { const float v = bf2f((unsigned short)qr[d0][i]); ss += v * v; }
        ss += __shfl_xor(ss, 32);
        const float ref = sqrtf(ss * kmax2) * 1.02f;
#pragma unroll
        for (int r = 0; r < 16; ++r) negref[r] = -ref;
    }
    u32x4 pwA[4], pwB[4];
    const int koff = r32 * KP + m * 128 + hi * 16;
    const int voff = ((lane >> 4) & 1) * 32 + (lane & 3) * 8 + (4 * hi + ((lane & 15) >> 2)) * 64;
    ATT_X(0); ATT_STAGE(0); ATT_Y0(pwA); ATT_BAR();
    ATT_X(1); ATT_STAGE(1); ATT_Y(0, pwA, pwB); ATT_BAR();
    for (int j = 2; j < NT; j += 2) {
        ATT_X(0); ATT_STAGE(j); ATT_Y(1, pwB, pwA); ATT_BAR();
        ATT_X(1); ATT_STAGE(j + 1); ATT_Y(0, pwA, pwB); ATT_BAR();
    }
    ATT_Z(1, pwB); ATT_BAR();
    const float lsum_ = l_reg + __shfl_xor(l_reg, 32);
    if (hi == 0) wsf[32 + r32] = lsum_;
    LDS_WAIT();
    LAS float* ex = (LAS float*)lds + w * 4096 + 4 * r32;
    const f32x4 g4 = *(const f32x4*)(subg + 4 * r32) * (1.0f - LAM_INIT);
    bf16_t* dstb = MIXIN + (size_t)rowQ * 1024 + h * 128 + 4 * r32;
#define ATT_EPI(KEEP) do { \
    _Pragma("unroll") for (int rr = 0; rr < 8; ++rr) { const int r = 8 - (KEEP) + rr; const int q = crow(r, hi); const float rl = __builtin_amdgcn_rcpf(wsf[32 + q]); \
        *(LAS f32x4*)(ex + q * 128) = (f32x4){o[0][r] * rl, o[1][r] * rl, o[2][r] * rl, o[3][r] * rl}; } \
    ATT_BAR(); \
    _Pragma("unroll") for (int rr = 0; rr < 8; ++rr) { const int r = (KEEP) + rr; const int q = crow(r, hi); const float rl = __builtin_amdgcn_rcpf(wsf[32 + q]); \
        const f32x4 own = (f32x4){o[0][r] * rl, o[1][r] * rl, o[2][r] * rl, o[3][r] * rl}; const f32x4 oth = *(const LAS f32x4*)(ex + q * 128); \
        const f32x4 x = ((KEEP) == 0) ? (own - lam * oth) : (oth - lam * own); \
        const float ss = half_sum32((x[0] * x[0] + x[1] * x[1]) + (x[2] * x[2] + x[3] * x[3]), hi); \
        const float rstd = __builtin_amdgcn_rsqf(ss * (1.f / 128.f) + EPS); \
        u32x2 wv; wv.x = pk2(x[0] * rstd * g4[0], x[1] * rstd * g4[1]); wv.y = pk2(x[2] * rstd * g4[2], x[3] * rstd * g4[3]); \
        *(u32x2*)(dstb + (size_t)q * 1024) = wv; } } while (0)
    if (m == 0) ATT_EPI(0); else ATT_EPI(8);
#undef ATT_EPI
    ATT_BAR();
}
#undef ATT_BAR
#undef ATT_X
#undef ATT_EXP2
#undef ATT_Y
#undef ATT_Y0
#undef ATT_Z
#undef ATT_STAGE
#undef ATT_BLD
#undef ATT_SB
#undef ATT_KLD
#undef ATT_XSTEP
#undef ATT_VLD
#undef ATT_VF
#undef ATT_YSTEP
#undef ATT_ZSTEP
}

__device__ __forceinline__ void p3_conv_attn(const Args& a, LAS unsigned char* lds, int c, int vcu, int G) {
    const int tid = opaque_tid(), lane = tid & 63, wave = __builtin_amdgcn_readfirstlane(tid >> 6);
    unsigned char* ws = a.ws;
    const bf16_t* GB = (const bf16_t*)(ws + WS_GB); const bf16_t* U = (const bf16_t*)(ws + WS_U); bf16_t* MIXIN = (bf16_t*)(ws + WS_MIXIN);
    {
        const float* cw = a.in[I_CONVW]; float w0[8], w1[8], w2[8];
#pragma unroll
        for (int i = 0; i < 8; ++i) { w0[i] = cw[lane * 8 + i]; w1[i] = cw[512 + lane * 8 + i]; w2[i] = cw[1024 + lane * 8 + i]; }
        const int gw = vcu * NWAVES + wave, NGW = G * NWAVES;
        for (int row = gw * (M / NGW); row < (gw + 1) * (M / NGW); ++row) {
            const int t = row & (T - 1);
            const u32x4 z = {0u, 0u, 0u, 0u};
            const u32x4 uc = *(const u32x4*)(U + (size_t)row * 512 + lane * 8);
            const u32x4 up = (t > 0) ? *(const u32x4*)(U + (size_t)(row - 1) * 512 + lane * 8) : z;
            const u32x4 un = (t < T - 1) ? *(const u32x4*)(U + (size_t)(row + 1) * 512 + lane * 8) : z;
            const u32x4 gb = *(const u32x4*)(GB + (size_t)row * 512 + lane * 8);
            u32x4 o;
#pragma unroll
            for (int q = 0; q < 4; ++q) {
                const float y0 = w0[2 * q] * bflo(up[q]) + w1[2 * q] * bflo(uc[q]) + w2[2 * q] * bflo(un[q]);
                const float y1 = w0[2 * q + 1] * bfhi(up[q]) + w1[2 * q + 1] * bfhi(uc[q]) + w2[2 * q + 1] * bfhi(un[q]);
                o[q] = pk2(bflo(gb[q]) * y0, bfhi(gb[q]) * y1);
            }
            *(u32x4*)(MIXIN + (size_t)row * 1024 + 512 + lane * 8) = o;
        }
    }
    float lam;
    { const float p1 = a.in[I_LQ1][lane] * a.in[I_LK1][lane], p2 = a.in[I_LQ2][lane] * a.in[I_LK2][lane];
      lam = __expf(wave_sum(p1)) - __expf(wave_sum(p2)) + LAM_INIT; }
    const bf16_t* Q = (const bf16_t*)(ws + WS_Q); const bf16_t* KA = (const bf16_t*)(ws + WS_K); const bf16_t* VA = (const bf16_t*)(ws + WS_V);
    __syncthreads();
    for (int u = vcu * 8; u < 2048; u += G * 8) {
        const int x = (u >> 3) / 32, jj = (u >> 3) % 32;
        for (int i = 0; i < 8; ++i) {
            const int bh = 16 * x + 2 * i + (jj >> 4), qb = jj & 15;
            att::unit(lds, bh >> 2, bh & 3, qb, Q, KA, VA, MIXIN, a.in[I_SUBLN], lam, (const unsigned*)(ws + WS_CTL) + CW_KMAX);
        }
    }
}

struct P5In { f32x4 x[4]; u32x2 m[4]; };
__device__ __forceinline__ void p5_load(P5In& r, int row, int lane, const float* X, const bf16_t* MIX) {
    const f32x4* xr = (const f32x4*)(X + (size_t)row * D) + lane; const u32x2* mr = (const u32x2*)(MIX + (size_t)row * D) + lane;
#pragma unroll
    for (int j = 0; j < 4; ++j) { r.x[j] = __builtin_nontemporal_load(xr + 64 * j); r.m[j] = __builtin_nontemporal_load(mr + 64 * j); }
}
__device__ __forceinline__ float p5_resid(const P5In& r, f32x4 (&h)[4], int row, int lane, const LAS float* mv, const LAS f32x4* npm, bf16_t* H1) {
    f32x4 mx[4]; float s = 0.f;
#pragma unroll
    for (int j = 0; j < 4; ++j) { const u32x2 wv = r.m[j]; mx[j] = (f32x4){bflo(wv.x), bfhi(wv.x), bflo(wv.y), bfhi(wv.y)};
        s += (mx[j].x * mx[j].x + mx[j].y * mx[j].y) + (mx[j].z * mx[j].z + mx[j].w * mx[j].w); }
    const float rstd1 = 1.0f / sqrtf(wave_sum(s) * (1.f / D) + EPS);
    u32x2* hr = (u32x2*)(H1 + (size_t)row * D) + lane; float s2 = 0.f;
#pragma unroll
    for (int j = 0; j < 4; ++j) { const f32x4 g1 = *(const LAS f32x4*)(mv + 4 * lane + 256 * j);
        h[j] = r.x[j] + g1 * ((mx[j] * rstd1) * npm[64 * j]);
        u32x2 wv; wv.x = pk2(h[j].x, h[j].y); wv.y = pk2(h[j].z, h[j].w); __builtin_nontemporal_store(wv, hr + 64 * j);
        s2 += (h[j].x * h[j].x + h[j].y * h[j].y) + (h[j].z * h[j].z + h[j].w * h[j].w); }
    return 1.0f / sqrtf(wave_sum(s2) * (1.f / D) + EPS);
}
__device__ __forceinline__ void p5_rows(const Args& a, LAS unsigned char* lds, int p  ) {
    const int tid = opaque_tid(), lane = tid & 63, wave = __builtin_amdgcn_readfirstlane(tid >> 6);
    unsigned char* ws = a.ws;
    const int b = p >> 3;
    LAS float* wrt = (LAS float*)lds;
    LAS float* mv = (LAS float*)(lds + 65536);
    const float* wr = a.in[I_WROUTER];
    const bf16_t* MIX = (const bf16_t*)(ws + WS_MIX); unsigned char* XN2 = ws + WS_XN; float* AFFT = (float*)(ws + WS_AFFT); bf16_t* H1 = (bf16_t*)(ws + WS_H1);
    const float* X = a.in[I_X];
    const int rbase = p * 256 + wave * 32;
    P5In cA, cB;
    p5_load(cA, rbase, lane, X, MIX); p5_load(cB, rbase + 1, lane, X, MIX);
    for (int n = tid; n < D * NE; n += NTHREADS) { const int k = n >> 4, e = n & 15; wrt[e * D + k] = wr[n]; }
    const float* MOD = (const float*)(ws + WS_MOD) + (size_t)b * NMOD;
    for (int n = tid; n < 3 * D; n += NTHREADS) mv[n] = MOD[2 * D + n];
    for (int n = tid; n < D; n += NTHREADS) { mv[3 * D + n] = a.in[I_NPOST_MIX][n]; mv[4 * D + n] = a.in[I_NPRE_FFN][n]; }
    __syncthreads();
    const LAS f32x4* npm = (const LAS f32x4*)(mv + 3 * D) + lane; const LAS f32x4* npf = (const LAS f32x4*)(mv + 4 * D) + lane;
    for (int i = 0; i < 16; ++i) {
        const int rowA = rbase + 2 * i, rowB = rowA + 1;
        P5In nA, nB;
        if (i + 1 < 16) { p5_load(nA, rowA + 2, lane, X, MIX); p5_load(nB, rowB + 2, lane, X, MIX); }
        f32x4 hA[4], hB[4];
        const float rsA = p5_resid(cA, hA, rowA, lane, mv, npm, H1);
        const float rsB = p5_resid(cB, hB, rowB, lane, mv, npm, H1);
        unsigned* oA = (unsigned*)(XN2 + (size_t)rowA * D) + lane; unsigned* oB = (unsigned*)(XN2 + (size_t)rowB * D) + lane;
        typedef float f32x2v __attribute__((ext_vector_type(2)));
        f32x2v lg2[16];
#pragma unroll
        for (int e = 0; e < 16; ++e) lg2[e] = (f32x2v){0.f, 0.f};
#pragma unroll
        for (int j = 0; j < 4; ++j) { const f32x4 sh2 = *(const LAS f32x4*)(mv + 1024 + 4 * lane + 256 * j), sc2 = *(const LAS f32x4*)(mv + 2048 + 4 * lane + 256 * j);
            const f32x4 gn = npf[64 * j];
            const f32x4 zA = ((hA[j] * rsA) * gn) * (sc2 + 1.0f) + sh2, zB = ((hB[j] * rsB) * gn) * (sc2 + 1.0f) + sh2;
            { const f32x4 qa = zA * pg8::F8_ACT, qb = zB * pg8::F8_ACT; oA[64 * j] = pg8::pk4_fp8(qa.x, qa.y, qa.z, qa.w); oB[64 * j] = pg8::pk4_fp8(qb.x, qb.y, qb.z, qb.w); }
            const f32x2v zx = {zA.x, zB.x}, zy = {zA.y, zB.y}, zz = {zA.z, zB.z}, zw = {zA.w, zB.w};
#pragma unroll
            for (int e = 0; e < 16; ++e) { const f32x4 wq = *(const LAS f32x4*)(wrt + e * D + 4 * lane + 256 * j);
                lg2[e] = __builtin_elementwise_fma(zx, (f32x2v){wq.x, wq.x}, lg2[e]); lg2[e] = __builtin_elementwise_fma(zy, (f32x2v){wq.y, wq.y}, lg2[e]);
                lg2[e] = __builtin_elementwise_fma(zz, (f32x2v){wq.z, wq.z}, lg2[e]); lg2[e] = __builtin_elementwise_fma(zw, (f32x2v){wq.w, wq.w}, lg2[e]);
                if ((e & 3) == 3) __builtin_amdgcn_sched_barrier(0); } }
        float lg[32];
#pragma unroll
        for (int e = 0; e < 16; ++e) { lg[e] = lg2[e].x; lg[16 + e] = lg2[e].y; }
#pragma unroll
        for (int st = 0; st < 5; ++st) { const int d = 1 << st, cntv = 16 >> st; const bool up = (lane & d) != 0;
#pragma unroll
            for (int q = 0; q < 16; ++q) if (q < cntv) { const float send = up ? lg[2 * q] : lg[2 * q + 1], keep = up ? lg[2 * q + 1] : lg[2 * q]; lg[q] = keep + __shfl_xor(send, d); } }
        float lv = lg[0] + __shfl_xor(lg[0], 32);
        float mxl = lv;
#pragma unroll
        for (int d = 1; d < 16; d <<= 1) mxl = fmaxf(mxl, __shfl_xor(mxl, d));
        const float ev = __expf(lv - mxl); float se = ev;
#pragma unroll
        for (int d = 1; d < 16; d <<= 1) se += __shfl_xor(se, d);
        if (lane < 32) { const int row = (lane < 16) ? rowA : rowB; AFFT[((size_t)b * NE + (lane & 15)) * T + (row & (T - 1))] = ev / se; }
        cA = nA; cB = nB;
    }
}

__device__ __forceinline__ void p6_topk(const Args& a, LAS unsigned char* lds, int c, int G) {
    const int tid = opaque_tid(), lane = tid & 63, wave = __builtin_amdgcn_readfirstlane(tid >> 6);
    unsigned char* ws = a.ws;
    const float* AFFT = (const float*)(ws + WS_AFFT); short* SLOT = (short*)(ws + WS_SLOT); int* IDX = (int*)(ws + WS_IDX); float* GATE = (float*)(ws + WS_GATE);
    LAS unsigned* sv = (LAS unsigned*)(lds + wave * 16384);
    for (int item = c + wave * G; item < NITEM; item += G * NWAVES) {
        const int b = item >> 4, e = item & 15;
        const float* src = AFFT + (size_t)item * T;
#pragma unroll 8
        for (int j = 0; j < 32; ++j) sv[j * 64 + lane] = __float_as_uint(src[j * 64 + lane]);
        LDS_WAIT(); asm volatile("" ::: "memory");
        unsigned pre = 0u;
        for (int bit = 30; bit >= 0; --bit) {
            const unsigned cand = pre | (1u << bit);
            int cnt = 0;
#pragma unroll 4
            for (int j = 0; j < 32; ++j) cnt += (int)__popcll(__ballot(sv[j * 64 + lane] >= cand));
            if (cnt >= CAP) pre = cand;
        }
        int ngt = 0;
#pragma unroll 4
        for (int j = 0; j < 32; ++j) ngt += (int)__popcll(__ballot(sv[j * 64 + lane] > pre));
        const int need_eq = CAP - ngt;
        const unsigned long long ltmask = (1ull << lane) - 1ull;
        int base_gt = 0, base_eq = 0;
#pragma unroll 2
        for (int j = 0; j < 32; ++j) {
            const unsigned vj = sv[j * 64 + lane];
            const bool gt = vj > pre, eq = vj == pre;
            const unsigned long long mg = __ballot(gt), me = __ballot(eq);
            const int pg = base_gt + (int)__popcll(mg & ltmask), pe = base_eq + (int)__popcll(me & ltmask);
            int sl = -1; if (gt) sl = pg; else if (eq && pe < need_eq) sl = ngt + pe;
            const int t = j * 64 + lane;
            SLOT[((size_t)b * T + t) * NE + e] = (short)sl;
            if (sl >= 0) { IDX[item * CAP + sl] = t; GATE[item * CAP + sl] = __uint_as_float(vj); }
            base_gt += (int)__popcll(mg); base_eq += (int)__popcll(me);
        }
        LDS_WAIT(); asm volatile("" ::: "memory");
    }
}

struct P8Row { u32x2 h[4]; unsigned y[4][4]; float wt[4]; unsigned long long rest; int sl; };
__device__ __forceinline__ f32x4 fp8x4_to_f32(unsigned w) { typedef float f2 __attribute__((ext_vector_type(2))); const f2 lo = __builtin_amdgcn_cvt_pk_f32_fp8((int)w, false), hi = __builtin_amdgcn_cvt_pk_f32_fp8((int)w, true); return (f32x4){lo.x, lo.y, hi.x, hi.y}; }
__device__ __forceinline__ void p8_issue(P8Row& r, int row, int lane, const short* SLOT, const unsigned char* Y, const bf16_t* H1) {
    const int b = row >> 11;
    const int s_e = (lane < NE) ? (int)SLOT[(size_t)row * NE + lane] : -1;
    unsigned long long mask = __ballot(s_e >= 0);
    const u32x2* hr = (const u32x2*)(H1 + (size_t)row * D) + lane;
#pragma unroll
    for (int j = 0; j < 4; ++j) r.h[j] = __builtin_nontemporal_load(hr + 64 * j);
#pragma unroll
    for (int q = 0; q < 4; ++q) {
        int e = 0, s = 0; r.wt[q] = 0.f;
        if (mask) { e = (int)__builtin_ctzll(mask); mask &= mask - 1ull; s = __builtin_amdgcn_readlane(s_e, e); r.wt[q] = 1.f; }
        const unsigned* yr = (const unsigned*)(Y + ((size_t)(b * NE + e) * CAP + s) * D) + lane;
#pragma unroll
        for (int j = 0; j < 4; ++j) r.y[q][j] = __builtin_nontemporal_load(yr + 64 * j);
    }
    r.rest = mask; r.sl = s_e;
}
__device__ __forceinline__ void p8_finish(P8Row& r, int row, int lane, const unsigned char* Y, const float* MOD, const f32x4* npo, float* out) {
    const int b = row >> 11;
    f32x4 ff[4];
#pragma unroll
    for (int j = 0; j < 4; ++j) ff[j] = (f32x4){0.f, 0.f, 0.f, 0.f};
#pragma unroll
    for (int q = 0; q < 4; ++q)
#pragma unroll
        for (int j = 0; j < 4; ++j) ff[j] += fp8x4_to_f32(r.y[q][j]) * r.wt[q];
    unsigned long long mask = r.rest;
    while (mask) {
        const int e = (int)__builtin_ctzll(mask); mask &= mask - 1ull; const int s = __builtin_amdgcn_readlane(r.sl, e);
        const unsigned* yr = (const unsigned*)(Y + ((size_t)(b * NE + e) * CAP + s) * D) + lane;
#pragma unroll
        for (int j = 0; j < 4; ++j) ff[j] += fp8x4_to_f32(yr[64 * j]);
    }
#pragma unroll
    for (int j = 0; j < 4; ++j) ff[j] = ff[j] * (1.0f / pg8::F8_Y);
    float s2 = 0.f;
#pragma unroll
    for (int j = 0; j < 4; ++j) s2 += (ff[j].x * ff[j].x + ff[j].y * ff[j].y) + (ff[j].z * ff[j].z + ff[j].w * ff[j].w);
    const float rstd = 1.0f / sqrtf(wave_sum(s2) * (1.f / D) + EPS);
    f32x4* orow = (f32x4*)(out + (size_t)row * D) + lane; const f32x4* g2 = (const f32x4*)(MOD + (size_t)b * NMOD + 5 * D) + lane;
#pragma unroll
    for (int j = 0; j < 4; ++j) { const u32x2 hv = r.h[j]; const f32x4 h = (f32x4){bflo(hv.x), bfhi(hv.x), bflo(hv.y), bfhi(hv.y)};
        __builtin_nontemporal_store(h + g2[64 * j] * ((ff[j] * rstd) * npo[64 * j]), orow + 64 * j); }
}
__device__ __forceinline__ void p8_final(const Args& a, int vcu, int G) {
    const int tid = opaque_tid(), lane = tid & 63, wave = __builtin_amdgcn_readfirstlane(tid >> 6);
    unsigned char* ws = a.ws;
    const short* SLOT = (const short*)(ws + WS_SLOT); const unsigned char* Y = ws + WS_Y; const float* MOD = (const float*)(ws + WS_MOD); const bf16_t* H1 = (const bf16_t*)(ws + WS_H1);
    const f32x4* npo = (const f32x4*)a.in[I_NPOST_FFN] + lane;
    const int gw = vcu * NWAVES + wave, NGW = G * NWAVES;
    const int per = M / NGW;
    for (int row = gw * per; row < (gw + 1) * per; row += 4) {
        P8Row r0, r1, r2, r3;
        p8_issue(r0, row, lane, SLOT, Y, H1);
        p8_issue(r1, row + 1, lane, SLOT, Y, H1);
        p8_issue(r2, row + 2, lane, SLOT, Y, H1);
        p8_issue(r3, row + 3, lane, SLOT, Y, H1);
        p8_finish(r0, row, lane, Y, MOD, npo, a.out);
        p8_finish(r1, row + 1, lane, Y, MOD, npo, a.out);
        p8_finish(r2, row + 2, lane, Y, MOD, npo, a.out);
        p8_finish(r3, row + 3, lane, Y, MOD, npo, a.out);
    }
}

__global__ void __launch_bounds__(NTHREADS, 2) fwd_kernel(Args args) {
    extern __shared__ __attribute__((aligned(16))) unsigned char lds_raw[];
    LAS unsigned char* lds = (LAS unsigned char*)lds_raw;
    volatile LAS unsigned* MISC = (volatile LAS unsigned*)(lds + MISC_OFF);
    const int tid = threadIdx.x;
    const int G = gridDim.x, c = blockIdx.x;
    const int vcu = (G % 8 == 0) ? (c % 8) * (G / 8) + c / 8 : c;
    unsigned char* ws = args.ws;
    gu32* ctl = (gu32*)(ws + WS_CTL);
    for (int u = tid; u < (LDS_BYTES - LDSCTL_OFF) / 4; u += NTHREADS) ((LAS unsigned*)(lds + LDSCTL_OFF))[u] = 0u;
    __syncthreads();
    XcdBarrier bar; bar.bar = (unsigned*)(ctl + CW_BAR); bar.x = 0; bar.st = nullptr;
    const int lo = args.ph_lo, hi = args.ph_hi;
    if (hi - lo > 1) bar = xcd_barrier_post((unsigned*)(ctl + CW_BAR), MISC + 8);
#ifndef PHMASK
#define PHMASK 0xff
#endif
#define IN(k) (((PHMASK >> (k)) & 1) && lo <= (k) && (k) < hi)
#define SEAM(k) do { if (IN(k) && IN((k) + 1)) xcd_barrier(bar); } while (0)
#ifndef PROBE_PHASE
#define PROBE_PHASE -1
#endif
#define PB(k) do { if (PROBE_PHASE == (k)) { if (tid == 0) { const unsigned long long t0_ = __builtin_amdgcn_s_memrealtime(); MISC[16] = (unsigned)t0_; MISC[17] = (unsigned)(t0_ >> 32); } } } while (0)
#define PE(k) do { if (PROBE_PHASE == (k)) { if (tid == 0) { const unsigned long long t0_ = ((unsigned long long)MISC[17] << 32) | MISC[16]; const unsigned long long t1_ = __builtin_amdgcn_s_memrealtime(); \
      while (__builtin_amdgcn_s_memrealtime() - t1_ < t1_ - t0_) __builtin_amdgcn_s_sleep(8); } __syncthreads(); } } while (0)

    PB(0); if (IN(0)) { p0_prologue(args, lds, vcu, G); } SEAM(0); PE(0);
    PB(1); if (IN(1)) { p1_xn(args, lds, c, G); inout_weight_copies(args, lds, vcu, G); } SEAM(1); PE(1);
    PB(2); if (IN(2)) {
        pg8::Gemm g{(const bf16_t*)(ws + WS_XN), (const bf16_t*)(ws + WS_WIN), D, nullptr};
        pg8::SchedProj S{G, c};
        pg8::EpiProj E{(bf16_t*)(ws + WS_Q), (bf16_t*)(ws + WS_K), (bf16_t*)(ws + WS_V), (bf16_t*)(ws + WS_GB), (bf16_t*)(ws + WS_U), (const float*)(ws + WS_TAB), (unsigned*)(ws + WS_CTL) + CW_KMAX};
        pg8::gemm_phase<pg8::EpiProj, pg8::SchedProj, true, true>(lds, g, S, E);
        if (c >= 128) expert_weight_copies(args, lds, c - 128, G - 128, 0, 9216);
    } SEAM(2); PE(2);
    PB(3); if (IN(3)) { if (c & 1) expert_weight_copies(args, lds, vcu, G, 9216, 24576); p3_conv_attn(args, lds, c, vcu, G); if (!(c & 1)) expert_weight_copies(args, lds, vcu, G, 9216, 24576); } SEAM(3); PE(3);
    PB(4); if (IN(4)) {
        {
            const int p = c;
#ifndef NO_P4
            pg8::Gemm g{(const bf16_t*)(ws + WS_MIXIN), (const bf16_t*)(ws + WS_WOUT), D, nullptr};
            pg8::SchedPanel S{p, 4};
            pg8::EpiBf16 E{(bf16_t*)(ws + WS_MIX), D};
            pg8::gemm_phase<pg8::EpiBf16, pg8::SchedPanel, true, true>(lds, g, S, E);
#endif
            VM_WAIT(); __syncthreads();
#ifndef NO_P5
            p5_rows(args, lds, p);
#endif
            __syncthreads();
        }
    } SEAM(4); PE(4);
    PB(5); if (IN(5)) { p6_topk(args, lds, c, G); } SEAM(5); PE(5);
    PB(6); if (IN(6)) {
#pragma unroll 1
        for (int it = 0; it < 2; ++it) {
            {
                const int item = 2 * c + it;
                const int b = item >> 4, e = item & 15;
#ifndef NO_G1
                if (it == 0) PB(8);
                {
                    pg8::Gemm g{(const bf16_t*)(ws + WS_XN + (size_t)b * T * D), (const bf16_t*)(ws + WS_WGU + (size_t)e * 2048 * D), D, (const int*)(ws + WS_IDX) + item * CAP};
                    pg8::SchedPanel S{0, 8};
                    pg8::EpiGU8 E{ws + WS_HMID + (size_t)item * CAP * D};
                    pg8::gemm_phase<pg8::EpiGU8, pg8::SchedPanel, false, true, true, true, true>(lds, g, S, E);
                }
#endif
                VM_WAIT(); __syncthreads();
                if (it == 0) { PE(8); PB(9); }
#ifndef NO_G2
                {
                    pg8::Gemm g{(const bf16_t*)(ws + WS_HMID + (size_t)item * CAP * D), (const bf16_t*)(ws + WS_WDN + (size_t)e * D * D), D, nullptr};
                    pg8::SchedPanel S{0, 4};
                    LAS float* gl = (LAS float*)(lds + LDSCTL_OFF + 4096);
                    { const int t_ = opaque_tid(); if (t_ < CAP) gl[t_] = ((const float*)(ws + WS_GATE))[item * CAP + t_] * (pg8::F8_INV * pg8::F8_Y); }
                    __syncthreads();
                    pg8::EpiDown8 E{ws + WS_Y + (size_t)item * CAP * D, gl};
                    pg8::gemm_phase<pg8::EpiDown8, pg8::SchedPanel, false, true, false, true, true>(lds, g, S, E);
                }
#endif
                VM_WAIT(); __syncthreads();
                if (it == 0) PE(9);
            }
        }
    } SEAM(6); PE(6);
    PB(7); if (IN(7)) { p8_final(args, vcu, G); } PE(7);
#undef IN
#undef SEAM
}

extern "C" void kernel_launch(void* const* d_in, const int* in_sizes, int n_in, void* d_out, int out_size, void* d_ws, size_t ws_size, hipStream_t stream) {
    static int grid = 0;
    if (grid == 0) {
        if (n_in != 22 || in_sizes[0] != M * D || out_size != M * D || ws_size < WS_END) { fprintf(stderr, "kernel_launch: unexpected shapes (n_in %d, in0 %d, out %d, ws %zu)\n", n_in, n_in > 0 ? in_sizes[0] : -1, out_size, ws_size); grid = -1; return; }
        int dev = 0, cus = 0;
        if (hipGetDevice(&dev) != hipSuccess || hipDeviceGetAttribute(&cus, hipDeviceAttributeMultiprocessorCount, dev) != hipSuccess) { grid = -1; return; }
        if (hipFuncSetAttribute((const void*)fwd_kernel, hipFuncAttributeMaxDynamicSharedMemorySize, LDS_BYTES) != hipSuccess) { fprintf(stderr, "kernel_launch: hipFuncSetAttribute failed\n"); grid = -1; return; }
        (void)hipGetLastError();
        grid = cus;
        if (grid != 256) { fprintf(stderr, "kernel_launch: this kernel needs a 256-CU device (got %d)\n", cus); grid = -1; return; }
    }
    if (grid < 0) return;
    (void)hipMemsetAsync((char*)d_ws + WS_CTL, 0, CTL_ZERO_BYTES, stream);
    Args a{};
    for (int i = 0; i < 22; ++i) a.in[i] = (const float*)d_in[i];
    a.out = (float*)d_out; a.ws = (unsigned char*)d_ws;
    constexpr int NPH = 8;
    if (MK_N_LAUNCHES == 1) { a.ph_lo = 0; a.ph_hi = NPH; hipLaunchKernelGGL(fwd_kernel, dim3(grid), dim3(NTHREADS), LDS_BYTES, stream, a); }
    else { for (int k = 0; k < NPH; ++k) { a.ph_lo = k; a.ph_hi = k + 1; hipLaunchKernelGGL(fwd_kernel, dim3(grid), dim3(NTHREADS), LDS_BYTES, stream, a); } }
}
```

```cpp
#include <hip/hip_runtime.h>
#include <cstdio>
#include <cstdint>

#ifndef MK_N_LAUNCHES
#define MK_N_LAUNCHES 1
#endif

#define LAS __attribute__((address_space(3)))
#define GAS __attribute__((address_space(1)))
typedef unsigned short bf16_t;
typedef short bf16x8 __attribute__((ext_vector_type(8)));
typedef short s16x4 __attribute__((ext_vector_type(4)));
typedef float f32x4 __attribute__((ext_vector_type(4)));
typedef float f32x16 __attribute__((ext_vector_type(16)));
typedef unsigned u32x4 __attribute__((ext_vector_type(4)));
typedef unsigned u32x2 __attribute__((ext_vector_type(2)));

constexpr int NB = 32, T = 2048, D = 1024, TC = 256, M = NB * T, MC = NB * TC, MA = M + MC, TK = TC + T;
constexpr int NE = 16, CAP = 256, NITEM = NB * NE, NPROJ = 3072, NMOD = 6 * D;
constexpr float EPS = 1e-6f;
constexpr float C2 = 0.125f * 1.4426950408889634f;
constexpr float LAM_INIT = 0.2f;
constexpr int NWAVES = 8, NTHREADS = 512;

constexpr size_t MiB = 1u << 20;
constexpr size_t WS_CTL = 0, CTL_ZERO_BYTES = 1 * MiB;
constexpr size_t WS_MODP = 2 * MiB;
constexpr size_t WS_MOD = 16 * MiB;
constexpr size_t WS_TAB = 17 * MiB;
constexpr size_t WS_WIN = 18 * MiB;
constexpr size_t WS_WOUT = 24 * MiB;
constexpr size_t WS_WGU = 26 * MiB;
constexpr size_t WS_WDN = 90 * MiB;
constexpr size_t WS_AFFT = 122 * MiB;
constexpr size_t WS_SLOT = 126 * MiB;
constexpr size_t WS_IDX = 128 * MiB;
constexpr size_t WS_GATE = 129 * MiB;
constexpr size_t WS_XN = 130 * MiB;
constexpr size_t WS_Q = 274 * MiB;
constexpr size_t WS_K = 338 * MiB;
constexpr size_t WS_V = 410 * MiB;
constexpr size_t WS_GB = 482 * MiB;
constexpr size_t WS_U = 546 * MiB;
constexpr size_t WS_MIXIN = 610 * MiB;
constexpr size_t WS_MIX = 738 * MiB;
constexpr size_t WS_HMID = 274 * MiB;
constexpr size_t WS_Y = 610 * MiB;
constexpr size_t WS_H1 = 866 * MiB;
constexpr size_t WS_END = 994 * MiB;

__device__ __forceinline__ int opaque_tid() { int t = threadIdx.x; asm volatile("" : "+v"(t)); return t; }

namespace pg8 {
constexpr int BM = 256, BK = 64, HALF = 128, HTB = HALF * BK * 2, STAGE_BYTES = 8 * HTB;
__host__ __device__ __forceinline__ int lds_byte(int r, int c) { const int st = (r >> 4) * 2 + (c >> 5), rr = r & 15, cc = c & 31, ob = rr * 64 + cc * 2; return st * 1024 + (ob ^ (((ob >> 9) & 1) << 5)); }
__host__ __device__ __forceinline__ void stage_rc(int b, int& R, int& C) { const int st = b / 1024, sb = b % 1024, swz = sb ^ (((sb >> 9) & 1) << 5); R = (st >> 1) * 16 + swz / 64; C = (st & 1) * 32 + (swz % 64) / 2; }
__host__ __device__ __forceinline__ int perm32(int rho) { const int n = rho >> 4, i = rho & 15; return 8 * (i >> 2) + 4 * n + (i & 3); }

struct Unit { int pm, pn; };
struct Gemm { const bf16_t* A; const bf16_t* Bt; int K; const int* gidx; };

typedef float f32x2_t __attribute__((ext_vector_type(2))); typedef __bf16 bf16x2_t __attribute__((ext_vector_type(2)));
__device__ __forceinline__ unsigned cvt_pk_bf16(float lo, float hi) { const f32x2_t v = {lo, hi}; const bf16x2_t b = __builtin_convertvector(v, bf16x2_t); return __builtin_bit_cast(unsigned, b); }

struct EpiBf16 {
    static constexpr bool PERM = true, AFTER_DRAIN = false;
    bf16_t* O; int ldc;
    __device__ __forceinline__ void operator()(const f32x4 (&acc)[2][2][4][2], const Unit& u, int wr, int wc, int fr, int fq) const {
        const int row0 = u.pm * BM + wr * 64 + fr; const int col0 = u.pn * BM + wc * 32 + 8 * fq;
#pragma unroll
        for (int ai = 0; ai < 2; ++ai)
#pragma unroll
            for (int m = 0; m < 4; ++m) { bf16_t* rowp = O + (size_t)(row0 + ai * HALF + m * 16) * ldc + col0;
#pragma unroll
                for (int bj = 0; bj < 2; ++bj) { const f32x4 v0 = acc[ai][bj][m][0], v1 = acc[ai][bj][m][1];
                    u32x4 w; w.x = cvt_pk_bf16(v0[0], v0[1]); w.y = cvt_pk_bf16(v0[2], v0[3]); w.z = cvt_pk_bf16(v1[0], v1[1]); w.w = cvt_pk_bf16(v1[2], v1[3]);
                    *(u32x4*)(rowp + bj * HALF) = w; } }
    }
};

struct EpiProj {
    static constexpr bool PERM = true, AFTER_DRAIN = false;
    bf16_t *Q, *KA, *VA, *GB, *U; const float* tab;
    unsigned* kmaxh;
    __device__ __forceinline__ void operator()(const f32x4 (&acc)[2][2][4][2], const Unit& u, int wr, int wc, int fr, int fq) const {
        const int pn = u.pn; const bool ctx = u.pm >= 256;
        float km[2] = {0.f, 0.f};
#pragma unroll
        for (int ai = 0; ai < 2; ++ai)
#pragma unroll
            for (int m = 0; m < 4; ++m) {
                const int row = u.pm * BM + ai * HALF + wr * 64 + m * 16 + fr;
                int t, kvrow;
                if (!ctx) { const int b = row >> 11; t = row & 2047; kvrow = b * TK + TC + t; }
                else { const int rc = row - M; const int b = rc >> 8; t = 0; kvrow = b * TK + (rc & 255); }
                if (pn < 4) {
                    f32x4 cs0 = {1.f, 0.f, 1.f, 0.f}, cs1 = cs0, cs2 = cs0, cs3 = cs0;
                    if (!ctx) { const float* tp = tab + ((size_t)t * 32 + 16 * (wc & 1) + 4 * fq) * 2;
                        cs0 = *(const f32x4*)(tp); cs1 = *(const f32x4*)(tp + 4); }
                    (void)cs2; (void)cs3;
#pragma unroll
                    for (int bj = 0; bj < 2; ++bj) {
                        const f32x4 v0 = acc[ai][bj][m][0], v1 = acc[ai][bj][m][1];
                        float e0 = v0[0], o0 = v0[1], e1 = v0[2], o1 = v0[3], e2 = v1[0], o2 = v1[1], e3 = v1[2], o3 = v1[3];
                        if (pn >= 2) {
                            float ss = ((e0 * e0 + o0 * o0) + (e1 * e1 + o1 * o1)) + ((e2 * e2 + o2 * o2) + (e3 * e3 + o3 * o3));
                            ss += __shfl_xor(ss, 16); ss += __shfl_xor(ss, 32); km[bj] = fmaxf(km[bj], ss); }
                        float r0 = e0 * cs0[0] - o0 * cs0[1], s0 = o0 * cs0[0] + e0 * cs0[1];
                        float r1 = e1 * cs0[2] - o1 * cs0[3], s1 = o1 * cs0[2] + e1 * cs0[3];
                        float r2 = e2 * cs1[0] - o2 * cs1[1], s2 = o2 * cs1[0] + e2 * cs1[1];
                        float r3 = e3 * cs1[2] - o3 * cs1[3], s3 = o3 * cs1[2] + e3 * cs1[3];
                        const float sc = (pn < 2) ? C2 : 1.f;
                        u32x4 w; w.x = cvt_pk_bf16(r0 * sc, s0 * sc); w.y = cvt_pk_bf16(r1 * sc, s1 * sc); w.z = cvt_pk_bf16(r2 * sc, s2 * sc); w.w = cvt_pk_bf16(r3 * sc, s3 * sc);
                        const int col = (pn & 1) * 256 + bj * HALF + wc * 32 + 8 * fq;
                        bf16_t* dst = (pn < 2) ? (Q + (size_t)row * 512 + col) : (KA + (size_t)kvrow * 512 + col);
                        *(u32x4*)dst = w;
                    }
                } else if (pn < 8) {
#pragma unroll
                    for (int bj = 0; bj < 2; ++bj) {
                        const f32x4 v0 = acc[ai][bj][m][0], v1 = acc[ai][bj][m][1];
                        u32x4 w; w.x = cvt_pk_bf16(v0[0], v0[1]); w.y = cvt_pk_bf16(v0[2], v0[3]); w.z = cvt_pk_bf16(v1[0], v1[1]); w.w = cvt_pk_bf16(v1[2], v1[3]);
                        const int col = (pn & 1) * 256 + bj * HALF + wc * 32 + 8 * fq;
                        bf16_t* dst = (pn < 6) ? (VA + (size_t)kvrow * 512 + col) : (GB + (size_t)row * 512 + col);
                        *(u32x4*)dst = w;
                    }
                } else {
                    const f32x4 a0 = acc[ai][0][m][0], a1 = acc[ai][0][m][1], b0 = acc[ai][1][m][0], b1 = acc[ai][1][m][1];
                    u32x4 w; w.x = cvt_pk_bf16(a0[0] * b0[0], a0[1] * b0[1]); w.y = cvt_pk_bf16(a0[2] * b0[2], a0[3] * b0[3]);
                    w.z = cvt_pk_bf16(a1[0] * b1[0], a1[1] * b1[1]); w.w = cvt_pk_bf16(a1[2] * b1[2], a1[3] * b1[3]);
                    const int col = (pn - 8) * 128 + wc * 32 + 8 * fq;
                    *(u32x4*)(U + (size_t)row * 512 + col) = w;
                }
            }
        if (pn == 2 || pn == 3) {
            const int b = ctx ? (u.pm - 256) : (u.pm >> 3);
#pragma unroll
            for (int bj = 0; bj < 2; ++bj) { float v = km[bj];
#pragma unroll
                for (int d = 1; d < 16; d <<= 1) v = fmaxf(v, __shfl_xor(v, d));
                if (fr == 0 && fq == 0) atomicMax(kmaxh + ((b * 8 + (pn & 1) * 4 + bj * 2 + (wc >> 1)) * 2 + (wc & 1)), __float_as_uint(v)); }
        }
    }
};

struct EpiGU {
    static constexpr bool PERM = true, AFTER_DRAIN = false;
    bf16_t* H;
    __device__ __forceinline__ float silu(float x) const { return x * __builtin_amdgcn_rcpf(1.f + __expf(-x)); }
    __device__ __forceinline__ void operator()(const f32x4 (&acc)[2][2][4][2], const Unit& u, int wr, int wc, int fr, int fq) const {
#pragma unroll
        for (int ai = 0; ai < 2; ++ai)
#pragma unroll
            for (int m = 0; m < 4; ++m) {
                const int row = ai * HALF + wr * 64 + m * 16 + fr;
                const f32x4 a0 = acc[ai][0][m][0], a1 = acc[ai][0][m][1], b0 = acc[ai][1][m][0], b1 = acc[ai][1][m][1];
                u32x4 w; w.x = cvt_pk_bf16(silu(a0[0]) * b0[0], silu(a0[1]) * b0[1]); w.y = cvt_pk_bf16(silu(a0[2]) * b0[2], silu(a0[3]) * b0[3]);
                w.z = cvt_pk_bf16(silu(a1[0]) * b1[0], silu(a1[1]) * b1[1]); w.w = cvt_pk_bf16(silu(a1[2]) * b1[2], silu(a1[3]) * b1[3]);
                *(u32x4*)(H + (size_t)row * 1024 + u.pn * 128 + wc * 32 + 8 * fq) = w;
            }
    }
};
__device__ __forceinline__ unsigned pk4_fp8(float a, float b, float c, float d) { int w = 0; w = __builtin_amdgcn_cvt_pk_fp8_f32(a, b, w, false); w = __builtin_amdgcn_cvt_pk_fp8_f32(c, d, w, true); return (unsigned)w; }
constexpr float F8_ACT = 4.0f, F8_WGT = 64.0f, F8_INV = 1.0f / (4.0f * 64.0f);
struct EpiGU8 {
    static constexpr bool PERM = true, AFTER_DRAIN = false;
    unsigned char* H;
    __device__ __forceinline__ float hval(float g, float u) const {
        const float e = __builtin_amdgcn_exp2f(g * (-F8_INV * 1.4426950408889634f));
        const float r = __builtin_amdgcn_rcpf(1.f + e);
        return __builtin_amdgcn_fmed3f((g * u) * (r * (F8_INV * F8_INV * F8_ACT)), -448.f, 448.f); }
    __device__ __forceinline__ void row(const f32x4 (&acc)[2][2][4][2], const Unit& u, int ai, int m, int wr, int wc, int fr, int fq) const {
        unsigned off = (unsigned)((ai * HALF + wr * 64 + m * 16 + fr) * 1024 + u.pn * 128 + wc * 32 + 8 * fq);
        asm volatile("" : "+v"(off));
        const f32x4 a0 = acc[ai][0][m][0], a1 = acc[ai][0][m][1], b0 = acc[ai][1][m][0], b1 = acc[ai][1][m][1];
        u32x2 w; w.x = pk4_fp8(hval(a0[0], b0[0]), hval(a0[1], b0[1]), hval(a0[2], b0[2]), hval(a0[3], b0[3]));
        w.y = pk4_fp8(hval(a1[0], b1[0]), hval(a1[1], b1[1]), hval(a1[2], b1[2]), hval(a1[3], b1[3]));
        *(u32x2*)(H + off) = w;
    }
    __device__ __forceinline__ void operator()(const f32x4 (&acc)[2][2][4][2], const Unit& u, int wr, int wc, int fr, int fq) const {
#pragma unroll
        for (int ai = 0; ai < 2; ++ai)
#pragma unroll
            for (int m = 0; m < 4; ++m) row(acc, u, ai, m, wr, wc, fr, fq);
    }
};
struct EpiDown {
    static constexpr bool PERM = true, AFTER_DRAIN = false;
    bf16_t* Y; const float* gate; float scale;
    __device__ __forceinline__ void operator()(const f32x4 (&acc)[2][2][4][2], const Unit& u, int wr, int wc, int fr, int fq) const {
        asm volatile("" : "+v"(fr));
#pragma unroll
        for (int ai = 0; ai < 2; ++ai)
#pragma unroll
            for (int m = 0; m < 4; ++m) {
                const int row = ai * HALF + wr * 64 + m * 16 + fr; const float g = gate[row] * scale;
#pragma unroll
                for (int bj = 0; bj < 2; ++bj) { const f32x4 v0 = acc[ai][bj][m][0] * g, v1 = acc[ai][bj][m][1] * g;
                    u32x4 w; w.x = cvt_pk_bf16(v0[0], v0[1]); w.y = cvt_pk_bf16(v0[2], v0[3]); w.z = cvt_pk_bf16(v1[0], v1[1]); w.w = cvt_pk_bf16(v1[2], v1[3]);
                    *(u32x4*)(Y + (size_t)row * 1024 + u.pn * BM + bj * HALF + wc * 32 + 8 * fq) = w; }
            }
    }
};

constexpr float F8_Y = 64.0f;
struct EpiDown8 {
    static constexpr bool PERM = true, AFTER_DRAIN = false;
    unsigned char* Y; const LAS float* gl;
    __device__ __forceinline__ void row(const f32x4 (&acc)[2][2][4][2], const Unit& u, int ai, int m, int wr, int wc, int fr, int fq) const {
        unsigned off = (unsigned)((ai * HALF + wr * 64 + m * 16 + fr) * 1024 + u.pn * BM + wc * 32 + 8 * fq);
        asm volatile("" : "+v"(off));
        const float g = gl[ai * HALF + wr * 64 + m * 16 + fr];
#pragma unroll
        for (int bj = 0; bj < 2; ++bj) { f32x4 v0 = acc[ai][bj][m][0] * g, v1 = acc[ai][bj][m][1] * g;
#pragma unroll
            for (int i = 0; i < 4; ++i) { v0[i] = __builtin_amdgcn_fmed3f(v0[i], -448.f, 448.f); v1[i] = __builtin_amdgcn_fmed3f(v1[i], -448.f, 448.f); }
            u32x2 w; w.x = pk4_fp8(v0[0], v0[1], v0[2], v0[3]); w.y = pk4_fp8(v1[0], v1[1], v1[2], v1[3]);
            *(u32x2*)(Y + off + bj * HALF) = w; }
    }
    __device__ __forceinline__ void operator()(const f32x4 (&acc)[2][2][4][2], const Unit& u, int wr, int wc, int fr, int fq) const {
#pragma unroll
        for (int ai = 0; ai < 2; ++ai)
#pragma unroll
            for (int m = 0; m < 4; ++m) row(acc, u, ai, m, wr, wc, fr, fq);
    }
};

struct SchedProj {
    int G, c;
    __device__ __forceinline__ bool next(int i, Unit& u) const {
        if (i < 12) { const int x = c & 7, j = c >> 3, ja = j & 7, jb = j >> 3, r = i / 3, q = i - 3 * r;
            u.pm = x + 8 * (8 * r + ja); u.pn = 4 * q + jb; return true; }
        if (i == 12 && c < 128) { u.pm = 256 + (c >> 2); u.pn = 2 + (c & 3); return true; }
        return false;
    }
    __device__ __forceinline__ void a_ready(const Unit&) const {}
    __device__ __forceinline__ void done(const Unit&) const {}
};
struct SchedPanel {
    int pm, ntn;
    __device__ __forceinline__ bool next(int i, Unit& u) const { if (i >= ntn) return false; u.pm = pm; u.pn = i; return true; }
    __device__ __forceinline__ void a_ready(const Unit&) const {}
    __device__ __forceinline__ void done(const Unit&) const {}
};

typedef int i32x4v __attribute__((ext_vector_type(4)));
typedef int i32x8v __attribute__((ext_vector_type(8)));
__device__ __forceinline__ i32x8v cat8(bf16x8 a, bf16x8 b) { const i32x4v x = __builtin_bit_cast(i32x4v, a), y = __builtin_bit_cast(i32x4v, b); return __builtin_shufflevector(x, y, 0, 1, 2, 3, 4, 5, 6, 7); }
template <bool F8> struct Frag;
template <> struct Frag<false> { bf16x8 v[2]; __device__ __forceinline__ void set(bf16x8 a, bf16x8 b) { v[0] = a; v[1] = b; } };
template <> struct Frag<true> { i32x8v v; __device__ __forceinline__ void set(bf16x8 a, bf16x8 b) { v = cat8(a, b); } };
__device__ __forceinline__ f32x4 frag_mma(const Frag<false>& b, const Frag<false>& a, f32x4 c) { c = __builtin_amdgcn_mfma_f32_16x16x32_bf16(b.v[0], a.v[0], c, 0, 0, 0); return __builtin_amdgcn_mfma_f32_16x16x32_bf16(b.v[1], a.v[1], c, 0, 0, 0); }
__device__ __forceinline__ f32x4 frag_mma(const Frag<true>& b, const Frag<true>& a, f32x4 c) {
    const int sc1 = 0x7f7f7f7f;
    asm volatile("s_nop 1\n\tv_mfma_scale_f32_16x16x128_f8f6f4 %0, %1, %2, %0, %3, %3 op_sel_hi:[0,0,0]" : "+v"(c) : "v"(b.v), "v"(a.v), "v"(sc1));
    return c; }
template <class Epi, class Sched, bool ALIGN_EPI, bool SP2, bool GATHER = false, bool F8 = false, bool DEFER = false>
__device__ __forceinline__ void gemm_phase(LAS unsigned char* lds, const Gemm g, const Sched& S, const Epi& E) {
    const int tid = opaque_tid(), wid = __builtin_amdgcn_readfirstlane(tid >> 6), lane = tid & 63, wr = wid >> 2, wc = wid & 3, fr = lane & 15, fq = lane >> 4;
    const int K = g.K * (F8 ? 1 : 2), nt = K / 128;
    unsigned voffA[2][2], voffB[2];
#pragma unroll
    for (int i = 0; i < 2; ++i) { int R, C; stage_rc(tid * 16 + i * 8192, R, C); const int Rb = Epi::PERM ? ((R & ~31) + perm32(R & 31)) : R;
        if constexpr (GATHER) { voffA[0][i] = (unsigned)(g.gidx[R] * K + C * 2); voffA[1][i] = (unsigned)(g.gidx[HALF + R] * K + C * 2); }
        else { voffA[0][i] = (unsigned)(R * K + C * 2); voffA[1][i] = voffA[0][i]; }
        voffB[i] = (unsigned)(Rb * K + C * 2); }
    const size_t kstep = (size_t)(BK * 2);
    const size_t hstep = (size_t)HALF * K;
    const size_t hstepA = GATHER ? (size_t)0 : hstep;
    const size_t tstep = 2 * hstep;
    const unsigned ldsw = (unsigned)wid * 1024u;
    const int aoff = F8 ? lds_byte(wr * 64 + fr, (fq >> 1) * 32 + (fq & 1) * 16) : lds_byte(wr * 64 + fr, fq * 8), boff = F8 ? lds_byte(wc * 32 + fr, (fq >> 1) * 32 + (fq & 1) * 16) : lds_byte(wc * 32 + fr, fq * 8);
    const int aoff1 = F8 ? aoff + 16 : aoff + 1024, boff1 = F8 ? boff + 16 : boff + 1024;
#define PG8_SA(b, h) (((b) * 2 + (h)) * HTB)
#define PG8_SB(b, h) ((4 + (b) * 2 + (h)) * HTB)
#define PG8_STAGE(bufoff, gbase, voff) do { _Pragma("unroll") for (int _i = 0; _i < 2; ++_i) \
        __builtin_amdgcn_global_load_lds((const unsigned*)((const char*)(gbase) + (voff)[_i]), (LAS unsigned*)(lds + (bufoff) + ldsw + _i * 8192), 16, 0, 0); } while (0)
#define PG8_LDA(dst, b, h) do { _Pragma("unroll") for (int m = 0; m < 4; ++m) dst[m].set(*(const LAS bf16x8*)(lds + PG8_SA(b, h) + aoff + m * 2048), *(const LAS bf16x8*)(lds + PG8_SA(b, h) + aoff1 + m * 2048)); } while (0)
#define PG8_LDB(dst, b, h) do { _Pragma("unroll") for (int n = 0; n < 2; ++n) dst[n].set(*(const LAS bf16x8*)(lds + PG8_SB(b, h) + boff + n * 2048), *(const LAS bf16x8*)(lds + PG8_SB(b, h) + boff1 + n * 2048)); } while (0)
#define PG8_MMA(ai, bj, At, Bt) do { __builtin_amdgcn_s_setprio(1); _Pragma("unroll") for (int m = 0; m < 4; ++m) _Pragma("unroll") for (int n = 0; n < 2; ++n) \
        acc[ai][bj][m][n] = frag_mma(Bt[n], At[m], acc[ai][bj][m][n]); __builtin_amdgcn_s_setprio(0); } while (0)
#define PG8_MMA_E(ai, At, Bt) do { __builtin_amdgcn_s_setprio(1); _Pragma("unroll") for (int m = 0; m < 4; ++m) { \
        if constexpr (DEFER) { if (defer_now) { E.row(acc, pu, ai, m, wr, wc, fr, fq); \
            _Pragma("unroll") for (int n = 0; n < 2; ++n) { acc[ai][0][m][n] = (f32x4){0.f, 0.f, 0.f, 0.f}; acc[ai][1][m][n] = (f32x4){0.f, 0.f, 0.f, 0.f}; } } PG8_SCHED; } \
        _Pragma("unroll") for (int n = 0; n < 2; ++n) acc[ai][0][m][n] = frag_mma(Bt[n], At[m], acc[ai][0][m][n]); } __builtin_amdgcn_s_setprio(0); } while (0)
#define PG8_WAIT_V(n) asm volatile("s_waitcnt vmcnt(" #n ")" ::: "memory")
#define PG8_WAIT_L(n) asm volatile("s_waitcnt lgkmcnt(" #n ")" ::: "memory")
#define PG8_BAR __builtin_amdgcn_s_barrier()
#define PG8_SCHED __builtin_amdgcn_sched_barrier(0)
    Unit cur, nxt; int ui = 0;
    if (!S.next(0, cur)) return;
    f32x4 acc[2][2][4][2];
#pragma unroll
    for (int a = 0; a < 2; ++a)
#pragma unroll
        for (int b = 0; b < 2; ++b)
#pragma unroll
            for (int m = 0; m < 4; ++m)
#pragma unroll
                for (int n = 0; n < 2; ++n) acc[a][b][m][n] = (f32x4){0.f, 0.f, 0.f, 0.f};
    Frag<F8> At[4], B0[2], B1[2];
    bool pend = false; Unit pu = cur;
    const char* cA = (const char*)g.A + (size_t)cur.pm * tstep; const char* cB = (const char*)g.Bt + (size_t)cur.pn * tstep;
    S.a_ready(cur);
    if constexpr (SP2) {
        PG8_STAGE(PG8_SB(0, 0), cB, voffB); PG8_STAGE(PG8_SB(0, 1), cB + hstep, voffB); PG8_STAGE(PG8_SA(0, 0), cA, voffA[0]); PG8_STAGE(PG8_SA(0, 1), cA + hstepA, voffA[GATHER ? 1 : 0]);
        if (wr == 1) PG8_BAR;
        PG8_WAIT_V(2); PG8_BAR;
        PG8_STAGE(PG8_SB(1, 0), cB + kstep, voffB); PG8_STAGE(PG8_SA(1, 0), cA + kstep, voffA[0]); PG8_STAGE(PG8_SB(1, 1), cB + hstep + kstep, voffB);
        PG8_WAIT_V(6); PG8_BAR;
    } else {
        PG8_STAGE(PG8_SB(0, 0), cB, voffB); PG8_STAGE(PG8_SA(0, 0), cA, voffA[0]); PG8_STAGE(PG8_SB(0, 1), cB + hstep, voffB); PG8_STAGE(PG8_SA(0, 1), cA + hstepA, voffA[GATHER ? 1 : 0]);
        if (wr == 1) PG8_BAR;
        PG8_WAIT_V(4); PG8_BAR;
        PG8_STAGE(PG8_SB(1, 0), cB + kstep, voffB); PG8_STAGE(PG8_SA(1, 0), cA + kstep, voffA[0]); PG8_STAGE(PG8_SB(1, 1), cB + hstep + kstep, voffB);
        PG8_WAIT_V(6); PG8_BAR;
    }
    for (;;) {
        const bool has_next = S.next(ui + 1, nxt);
        const char* nA = has_next ? (const char*)g.A + (size_t)nxt.pm * tstep : cA; const char* nB = has_next ? (const char*)g.Bt + (size_t)nxt.pn * tstep : cB;
#pragma unroll 1
        for (int t = 0; t < nt; t += 2) {
            const bool last = (t == nt - 2);
            if constexpr (F8) { asm volatile("" : "+v"(voffA[0][0]), "+v"(voffA[0][1]), "+v"(voffB[0]), "+v"(voffB[1])); if constexpr (GATHER) asm volatile("" : "+v"(voffA[1][0]), "+v"(voffA[1][1])); }
            const char* a1 = cA + (size_t)(t + 1) * kstep;
            const char* a2 = last ? nA : cA + (size_t)(t + 2) * kstep; const char* b2 = last ? nB : cB + (size_t)(t + 2) * kstep;
            const char* a3 = a2 + kstep; const char* b3 = b2 + kstep;
            if (last && has_next) S.a_ready(nxt);
            if constexpr (SP2) {
            PG8_LDB(B0, 0, 0); PG8_LDB(B1, 0, 1); PG8_SCHED; PG8_LDA(At, 0, 0); PG8_STAGE(PG8_SA(1, 1), a1 + hstepA, voffA[GATHER ? 1 : 0]);
            bool defer_now = false; if constexpr (DEFER) defer_now = pend && t == 0;
            PG8_WAIT_V(8); PG8_WAIT_L(0); PG8_BAR; PG8_MMA_E(0, At, B0); PG8_MMA(0, 1, At, B1); PG8_BAR; PG8_SCHED;
            PG8_LDA(At, 0, 1); PG8_STAGE(PG8_SB(0, 0), b2, voffB); PG8_STAGE(PG8_SB(0, 1), b2 + hstep, voffB); PG8_STAGE(PG8_SA(0, 0), a2, voffA[0]);
            PG8_WAIT_V(8); PG8_WAIT_L(0); PG8_BAR; PG8_MMA_E(1, At, B0); PG8_MMA(1, 1, At, B1); PG8_BAR; PG8_SCHED;
            PG8_LDB(B0, 1, 0); PG8_LDB(B1, 1, 1); PG8_SCHED; PG8_LDA(At, 1, 0); PG8_STAGE(PG8_SA(0, 1), a2 + hstepA, voffA[GATHER ? 1 : 0]);
            PG8_WAIT_V(8); PG8_WAIT_L(0); PG8_BAR; PG8_MMA(0, 0, At, B0); PG8_MMA(0, 1, At, B1); PG8_BAR; PG8_SCHED;
            PG8_LDA(At, 1, 1); PG8_STAGE(PG8_SB(1, 0), b3, voffB); PG8_STAGE(PG8_SB(1, 1), b3 + hstep, voffB); PG8_STAGE(PG8_SA(1, 0), a3, voffA[0]);
            PG8_WAIT_V(8); PG8_WAIT_L(0); PG8_BAR; PG8_MMA(1, 0, At, B0); PG8_MMA(1, 1, At, B1); PG8_BAR; PG8_SCHED;
            } else {
            PG8_LDB(B0, 0, 0); PG8_SCHED; PG8_LDA(At, 0, 0); PG8_STAGE(PG8_SA(1, 1), a1 + hstepA, voffA[GATHER ? 1 : 0]);
            PG8_WAIT_L(8); PG8_BAR; PG8_WAIT_L(0); PG8_MMA(0, 0, At, B0); PG8_BAR; PG8_SCHED;
            PG8_LDB(B1, 0, 1); PG8_STAGE(PG8_SB(0, 0), b2, voffB);
            PG8_BAR; PG8_WAIT_L(0); PG8_MMA(0, 1, At, B1); PG8_BAR;
            PG8_LDA(At, 0, 1); PG8_STAGE(PG8_SA(0, 0), a2, voffA[0]);
            PG8_BAR; PG8_WAIT_L(0); PG8_MMA(1, 0, At, B0); PG8_BAR; PG8_SCHED;
            PG8_STAGE(PG8_SB(0, 1), b2 + hstep, voffB);
            PG8_WAIT_V(6); PG8_BAR; PG8_MMA(1, 1, At, B1); PG8_BAR;
            PG8_LDB(B0, 1, 0); PG8_SCHED; PG8_LDA(At, 1, 0); PG8_STAGE(PG8_SA(0, 1), a2 + hstepA, voffA[GATHER ? 1 : 0]);
            PG8_WAIT_L(8); PG8_BAR; PG8_WAIT_L(0); PG8_MMA(0, 0, At, B0); PG8_BAR; PG8_SCHED;
            PG8_LDB(B1, 1, 1); PG8_STAGE(PG8_SB(1, 0), b3, voffB);
            PG8_BAR; PG8_WAIT_L(0); PG8_MMA(0, 1, At, B1); PG8_BAR;
            PG8_LDA(At, 1, 1); PG8_STAGE(PG8_SA(1, 0), a3, voffA[0]);
            PG8_BAR; PG8_WAIT_L(0); PG8_MMA(1, 0, At, B0); PG8_BAR; PG8_SCHED;
            PG8_STAGE(PG8_SB(1, 1), b3 + hstep, voffB);
            PG8_WAIT_V(6); PG8_BAR; PG8_MMA(1, 1, At, B1); PG8_BAR;
            }
        }
        if (DEFER && has_next) { pend = true; pu = cur; cur = nxt; cA = nA; cB = nB; ++ui; continue; }
        if constexpr (ALIGN_EPI) { if (wr == 0) PG8_BAR; }
        if constexpr (F8) asm volatile("s_nop 15\n\ts_nop 7" ::: "memory");
        E(acc, cur, wr, wc, fr, fq); S.done(cur);
        if (!has_next) break;
#pragma unroll
        for (int a = 0; a < 2; ++a)
#pragma unroll
            for (int b = 0; b < 2; ++b)
#pragma unroll
                for (int m = 0; m < 4; ++m)
#pragma unroll
                    for (int n = 0; n < 2; ++n) acc[a][b][m][n] = (f32x4){0.f, 0.f, 0.f, 0.f};
        cur = nxt; cA = nA; cB = nB; ++ui;
        if constexpr (ALIGN_EPI) { if (wr == 1) PG8_BAR; }
    }
    PG8_WAIT_V(0);
    if constexpr (!ALIGN_EPI) { if (wr == 0) PG8_BAR; }
    PG8_BAR;
#undef PG8_SA
#undef PG8_SB
#undef PG8_STAGE
#undef PG8_LDA
#undef PG8_LDB
#undef PG8_MMA
#undef PG8_WAIT_V
#undef PG8_WAIT_L
#undef PG8_BAR
#undef PG8_SCHED
}
}

typedef GAS unsigned gu32;
#define RLX_AGENT __ATOMIC_RELAXED, __HIP_MEMORY_SCOPE_AGENT
#define LDS_WAIT() asm volatile("s_waitcnt lgkmcnt(0)" ::: "memory")
#define VM_WAIT() asm volatile("s_waitcnt vmcnt(0)" ::: "memory")
__device__ __forceinline__ unsigned pk2(float lo, float hi) { return pg8::cvt_pk_bf16(lo, hi); }
__device__ __forceinline__ float bf2f(unsigned short h) { return __uint_as_float((unsigned)h << 16); }
__device__ __forceinline__ float bflo(unsigned w) { return __uint_as_float(w << 16); }
__device__ __forceinline__ float bfhi(unsigned w) { return __uint_as_float(w & 0xffff0000u); }
__device__ __forceinline__ float wave_sum(float v) {
    v += __builtin_bit_cast(float, __builtin_amdgcn_update_dpp(0, __builtin_bit_cast(int, v), 0xB1, 0xf, 0xf, true));
    v += __builtin_bit_cast(float, __builtin_amdgcn_update_dpp(0, __builtin_bit_cast(int, v), 0x4E, 0xf, 0xf, true));
    v += __builtin_bit_cast(float, __builtin_amdgcn_update_dpp(0, __builtin_bit_cast(int, v), 0x141, 0xf, 0xf, true));
    v += __builtin_bit_cast(float, __builtin_amdgcn_update_dpp(0, __builtin_bit_cast(int, v), 0x140, 0xf, 0xf, true));
    v += __builtin_bit_cast(float, __builtin_amdgcn_update_dpp(0, __builtin_bit_cast(int, v), 0x142, 0xa, 0xf, false));
    v += __builtin_bit_cast(float, __builtin_amdgcn_update_dpp(0, __builtin_bit_cast(int, v), 0x143, 0xc, 0xf, false));
    return __builtin_bit_cast(float, __builtin_amdgcn_readlane(__builtin_bit_cast(int, v), 63));
}

#define XB_TMO      128
#define XB_XCNT(j)  (256  + 64 * (j))
#define XB_XSUB(j)  (1280 + 64 * (j))
#define XB_XGEN(j)  (2304 + 64 * (j))
#define XB_TOP      3328
#define XB_TOPGEN   3392
#define XCD_BAR_WORDS 3456
#define XB_SPIN_CAP (1u << 18)
__device__ __forceinline__ unsigned xb_ld(unsigned* p)              { return __hip_atomic_load(p, __ATOMIC_RELAXED, __HIP_MEMORY_SCOPE_AGENT); }
__device__ __forceinline__ unsigned xb_add(unsigned* p, unsigned v) { return __hip_atomic_fetch_add(p, v, __ATOMIC_RELAXED, __HIP_MEMORY_SCOPE_AGENT); }
__device__ __forceinline__ unsigned xb_xcc_id() { return (unsigned)__builtin_amdgcn_s_getreg((3 << 11) | 20) & 0xFu; }
#define XB_SPIN(cond, bar) do { unsigned _sp = 0; while (cond) { __builtin_amdgcn_s_sleep(1); \
    if ((++_sp & 255u) == 0u) { if (xb_ld(&(bar)[XB_TMO])) break; if (_sp > XB_SPIN_CAP) { atomicAdd(&(bar)[XB_TMO], 1u); break; } } } } while (0)
struct XcdBarrier { unsigned* bar; unsigned x; volatile LAS unsigned* st; };
__device__ __forceinline__ XcdBarrier xcd_barrier_post(unsigned* bar, volatile LAS unsigned* st) {
    XcdBarrier b; b.bar = bar; b.x = xb_xcc_id(); b.st = st;
    if (threadIdx.x == 0) (void)xb_add(&bar[XB_XCNT(b.x)], 1u);
    return b;
}
__device__ __forceinline__ void xcd_barrier_complete(unsigned* bar, unsigned x, unsigned& nloc, unsigned& nx) {
    const unsigned G = gridDim.x * gridDim.y * gridDim.z;
    unsigned sum, cnt, mine, sp = 0u;
    for (;;) {
        sum = 0u; cnt = 0u; mine = 0u;
#pragma unroll
        for (unsigned j = 0; j < 16; ++j) { const unsigned c = xb_ld(&bar[XB_XCNT(j)]); sum += c; cnt += (c > 0u) ? 1u : 0u; mine = (j == x) ? c : mine; }
        if (sum == G) break;
        __builtin_amdgcn_s_sleep(1);
        if ((++sp & 255u) == 0u) { if (xb_ld(&bar[XB_TMO])) break; if (sp > XB_SPIN_CAP) { atomicAdd(&bar[XB_TMO], 1u); break; } }
    }
    nloc = mine > 0u ? mine : 1u; nx = cnt > 0u ? cnt : 1u;
}
__device__ __forceinline__ void xcd_barrier(const XcdBarrier& b) {
    asm volatile("s_waitcnt vmcnt(0)" ::: "memory");
    __syncthreads();
    if (threadIdx.x == 0) {
        unsigned* bar = b.bar;
        __builtin_amdgcn_s_waitcnt(0);
        unsigned nloc = b.st[0], nx = b.st[1];
        if (nloc == 0u) { xcd_barrier_complete(bar, b.x, nloc, nx); b.st[0] = nloc; b.st[1] = nx; }
        const unsigned old = xb_add(&bar[XB_XSUB(b.x)], 1u);
        const unsigned gen = old / nloc;
        if (old + 1u == (gen + 1u) * nloc) {
            __builtin_amdgcn_fence(__ATOMIC_RELEASE, "agent");
            asm volatile("s_waitcnt vmcnt(0)" ::: "memory");
            const unsigned og = xb_add(&bar[XB_TOP], 1u);
            const unsigned tg = og / nx;
            if (og + 1u == (tg + 1u) * nx) xb_add(&bar[XB_TOPGEN], 1u);
            else XB_SPIN(xb_ld(&bar[XB_TOPGEN]) == tg, bar);
            __builtin_amdgcn_fence(__ATOMIC_ACQUIRE, "agent");
            xb_add(&bar[XB_XGEN(b.x)], 1u);
            asm volatile("s_waitcnt vmcnt(0)" ::: "memory");
        } else {
            XB_SPIN(xb_ld(&bar[XB_XGEN(b.x)]) == gen, bar);
            __builtin_amdgcn_fence(__ATOMIC_ACQUIRE, "agent");
            asm volatile("s_waitcnt vmcnt(0)" ::: "memory");
        }
    }
    __syncthreads();
}

constexpr int RING_BYTES = 131072;
constexpr int LDSCTL_OFF = RING_BYTES, MISC_OFF = LDSCTL_OFF + 320;
constexpr int LDS_BYTES = 147456;
constexpr int CW_BAR = 4096;
constexpr int CW_KMAX = 65536;

struct Args { const float* in[22]; float* out; unsigned char* ws; int ph_lo, ph_hi; };
enum { I_X = 0, I_C, I_CTX, I_CCTX, I_WADA, I_BADA, I_NPRE_MIX, I_NPOST_MIX, I_NPRE_FFN, I_NPOST_FFN, I_WIN, I_CONVW, I_LQ1, I_LK1, I_LQ2, I_LK2, I_SUBLN, I_WOUT, I_WROUTER, I_WGATE, I_WUP, I_WDOWN };

__device__ __forceinline__ int win_dest(int n) {
    if (n < 1024) { const int j = n & 63; const int p = ((j >> 5) << 5) + ((j & 15) << 1) + ((j >> 4) & 1); return (n & ~63) + p; }
    if (n < 1536) { const int dv = n & 127; return (n & ~127) + ((dv & 3) << 5) + (dv >> 2); }
    if (n < 2048) return n;
    int c = n - 2048; const int isx = c >= 512; c &= 511; return 2048 + ((c >> 7) << 8) + (isx << 7) + (c & 127);
}
template <int MODE>
__device__ __forceinline__ int tr_dest(int n) {
    if (MODE == 0) return n;
    if (MODE == 1) return win_dest(n);
    if (MODE == 2) return ((n >> 7) << 8) + (n & 127);
    return ((n >> 7) << 8) + 128 + (n & 127);
}
template <int MODE>
__device__ __forceinline__ void p0_transpose_item_f8(const float* W, int K, int N, unsigned char* WT, LAS float* scr, int item, int lane) {
    const int nblk = N / 32, kb = item / nblk, nb = item % nblk, k0 = 64 * kb, n0 = 32 * nb;
#pragma unroll 8
    for (int i = 0; i < 32; ++i) { const int kk = 2 * i + (lane >> 5); scr[kk * 33 + (lane & 31)] = __builtin_nontemporal_load(W + (size_t)(k0 + kk) * N + n0 + (lane & 31)) * pg8::F8_WGT; }
    LDS_WAIT(); asm volatile("" ::: "memory");
    const int c = lane & 7;
#pragma unroll
    for (int j = 0; j < 4; ++j) { const int n = (lane >> 3) + 8 * j; const LAS float* s = scr + (8 * c) * 33 + n;
        u32x2 o; o.x = pg8::pk4_fp8(s[0 * 33], s[1 * 33], s[2 * 33], s[3 * 33]); o.y = pg8::pk4_fp8(s[4 * 33], s[5 * 33], s[6 * 33], s[7 * 33]);
        *(GAS u32x2*)(WT + (size_t)tr_dest<MODE>(n0 + n) * K + k0 + 8 * c) = o; }
    LDS_WAIT(); asm volatile("" ::: "memory");
}
template <int MODE>
__device__ __forceinline__ void p0_transpose_item(const float* W, int K, int N, bf16_t* WT, LAS float* scr, int item, int lane) {
    const int nblk = N / 32, kb = item / nblk, nb = item % nblk, k0 = 64 * kb, n0 = 32 * nb;
#pragma unroll 8
    for (int i = 0; i < 32; ++i) { const int kk = 2 * i + (lane >> 5); scr[kk * 33 + (lane & 31)] = W[(size_t)(k0 + kk) * N + n0 + (lane & 31)]; }
    LDS_WAIT(); asm volatile("" ::: "memory");
    const int c = lane & 7;
#pragma unroll
    for (int j = 0; j < 4; ++j) { const int n = (lane >> 3) + 8 * j; const LAS float* s = scr + (8 * c) * 33 + n;
        u32x4 o; o.x = pk2(s[0 * 33], s[1 * 33]); o.y = pk2(s[2 * 33], s[3 * 33]); o.z = pk2(s[4 * 33], s[5 * 33]); o.w = pk2(s[6 * 33], s[7 * 33]);
        *(GAS u32x4*)(WT + (size_t)tr_dest<MODE>(n0 + n) * K + k0 + 8 * c) = o; }
    LDS_WAIT(); asm volatile("" ::: "memory");
}

__device__ __forceinline__ void p0_prologue(const Args& a, LAS unsigned char* lds, int vcu, int G) {
    const int tid = opaque_tid(), lane = tid & 63, wave = __builtin_amdgcn_readfirstlane(tid >> 6);
    LAS float* scr = (LAS float*)(lds + wave * 16384);
    const int gw = vcu * NWAVES + wave, NGW = G * NWAVES;
    unsigned char* ws = a.ws;
    if (gw < 96 * 16) {
        float* MODP = (float*)(ws + WS_MODP);
        const float* wada = a.in[I_WADA];
        for (int it = gw; it < 96 * 16; it += NGW) {
            const int cg = it % 96, kc = it / 96;
            for (int b = 0; b < 33; ++b) { const float v = (b < 32) ? a.in[I_C][b * D + kc * 64 + lane] : a.in[I_CCTX][kc * 64 + lane]; scr[b * 64 + lane] = v / (1.f + __expf(-v)); }
            LDS_WAIT(); asm volatile("" ::: "memory");
            float acc[33];
#pragma unroll
            for (int b = 0; b < 33; ++b) acc[b] = 0.f;
            const float* wp = wada + (size_t)(kc * 64) * NMOD + cg * 64 + lane;
#pragma unroll 2
            for (int k = 0; k < 64; k += 4) {
                const float w0 = __builtin_nontemporal_load(wp + (size_t)(k + 0) * NMOD), w1 = __builtin_nontemporal_load(wp + (size_t)(k + 1) * NMOD),
                            w2 = __builtin_nontemporal_load(wp + (size_t)(k + 2) * NMOD), w3 = __builtin_nontemporal_load(wp + (size_t)(k + 3) * NMOD);
#pragma unroll
                for (int b = 0; b < 33; ++b) { const f32x4 sv4 = *(const LAS f32x4*)(scr + b * 64 + k); acc[b] += (sv4.x * w0 + sv4.y * w1) + (sv4.z * w2 + sv4.w * w3); }
            }
#pragma unroll
            for (int b = 0; b < 33; ++b) MODP[((size_t)kc * 33 + b) * NMOD + cg * 64 + lane] = acc[b];
            LDS_WAIT(); asm volatile("" ::: "memory");
        }
    } else {
        float* tab = (float*)(ws + WS_TAB);
        const int nw = NGW - 96 * 16;
        for (int e = (gw - 96 * 16) * 64 + lane; e < T * 32; e += nw * 64) {
            const int t = e >> 5, i = e & 31;
            const float inv = powf(10000.0f, -(float)(2 * (i & 15)) / 32.0f);
            const float pos = (i < 16) ? (float)(t >> 6) : (float)(t & 63);
            const float ang = pos * inv;
            tab[2 * e] = cosf(ang); tab[2 * e + 1] = sinf(ang);
        }
    }
}
__device__ __forceinline__ void inout_weight_copies(const Args& a, LAS unsigned char* lds, int vcu, int G) {
    const int tid = opaque_tid(), lane = tid & 63, wave = __builtin_amdgcn_readfirstlane(tid >> 6);
    LAS float* scr = (LAS float*)(lds + 16384 + wave * 12288);
    const int gw = vcu * NWAVES + wave, NGW = G * NWAVES;
    unsigned char* ws = a.ws;
    constexpr int I_IN = (D / 64) * (NPROJ / 32), I_OUT = (D / 64) * (D / 32);
    constexpr int NITEMS = I_IN + I_OUT;
    bf16_t* Win_t = (bf16_t*)(ws + WS_WIN); bf16_t* Wout_t = (bf16_t*)(ws + WS_WOUT);
    for (int it = gw; it < NITEMS; it += NGW) {
        int r = it;
        if (r < I_IN) { p0_transpose_item<1>(a.in[I_WIN], D, NPROJ, Win_t, scr, r, lane); continue; } r -= I_IN;
        p0_transpose_item<0>(a.in[I_WOUT], D, D, Wout_t, scr, r, lane);
    }
}
__device__ __forceinline__ void expert_weight_copies(const Args& a, LAS unsigned char* lds, int gw0  , int ngroups, int r_lo, int r_hi) {
    const int tid = opaque_tid(), lane = tid & 63, wave = __builtin_amdgcn_readfirstlane(tid >> 6);
    LAS float* scr = (LAS float*)(lds + wave * 16384);
    const int gw = gw0 * NWAVES + wave, NGW = ngroups * NWAVES;
    unsigned char* ws = a.ws;
    constexpr int I_EXP = (D / 64) * (D / 32);
    unsigned char* Wgu_t = ws + WS_WGU; unsigned char* Wdn_t = ws + WS_WDN;
    for (int r = r_lo + gw; r < r_hi; r += NGW) {
        const int e = r / (3 * I_EXP), q = (r % (3 * I_EXP)) / I_EXP, rr = r % I_EXP;
        if (q == 0) p0_transpose_item_f8<2>(a.in[I_WGATE] + (size_t)e * D * D, D, D, Wgu_t + (size_t)e * 2048 * D, scr, rr, lane);
        else if (q == 1) p0_transpose_item_f8<3>(a.in[I_WUP] + (size_t)e * D * D, D, D, Wgu_t + (size_t)e * 2048 * D, scr, rr, lane);
        else p0_transpose_item_f8<0>(a.in[I_WDOWN] + (size_t)e * D * D, D, D, Wdn_t + (size_t)e * D * D, scr, rr, lane);
    }
    __syncthreads();
}

struct RowF { f32x4 v[4]; };
__device__ __forceinline__ void row_load(RowF& r, const float* xrow, int lane) {
    const f32x4* xr = (const f32x4*)xrow + lane;
#pragma unroll
    for (int j = 0; j < 4; ++j) r.v[j] = __builtin_nontemporal_load(xr + 64 * j);
}
__device__ __forceinline__ void norm_mod_row(const RowF& r, bf16_t* orow, const float* gain, const LAS float* sc, const LAS float* sh, int lane) {
    const f32x4* gr = (const f32x4*)gain + lane;
    float s = 0.f;
#pragma unroll
    for (int j = 0; j < 4; ++j) s += (r.v[j].x * r.v[j].x + r.v[j].y * r.v[j].y) + (r.v[j].z * r.v[j].z + r.v[j].w * r.v[j].w);
    const float rstd = 1.0f / sqrtf(wave_sum(s) * (1.f / D) + EPS);
    u32x2* o8 = (u32x2*)orow + lane;
#pragma unroll
    for (int j = 0; j < 4; ++j) { const f32x4 g = gr[64 * j]; const f32x4 c1 = *(const LAS f32x4*)(sc + 4 * lane + 256 * j), h1 = *(const LAS f32x4*)(sh + 4 * lane + 256 * j);
        const f32x4 y = (r.v[j] * rstd) * g; const f32x4 z = y * (c1 + 1.0f) + h1;
        u32x2 w; w.x = pk2(z.x, z.y); w.y = pk2(z.z, z.w); o8[64 * j] = w; }
}
__device__ __forceinline__ void p1_xn(const Args& a, LAS unsigned char* lds, int c, int G) {
    const int tid = opaque_tid(), lane = tid & 63, wave = __builtin_amdgcn_readfirstlane(tid >> 6);
    unsigned char* ws = a.ws;
    const float* MODP = (const float*)(ws + WS_MODP); float* MOD = (float*)(ws + WS_MOD); const float* bada = a.in[I_BADA];
    { const int per = (33 * NMOD + G - 1) / G;
      for (int i = c * per + tid; i < (c + 1) * per && i < 33 * NMOD; i += NTHREADS) { const int r = i / NMOD, n = i - r * NMOD; float s = bada[n];
#pragma unroll
            for (int kc = 0; kc < 16; ++kc) s += MODP[((size_t)kc * 33 + r) * NMOD + n];
            MOD[i] = s; } }
    LAS float* sv = (LAS float*)lds;
    bf16_t* XN = (bf16_t*)(ws + WS_XN);
    const float* X = a.in[I_X]; const float* CTX = a.in[I_CTX]; const float* gain = a.in[I_NPRE_MIX];
    for (int p = c; p < 256; p += G) {
        const int b = p >> 3;
        const int rbase = p * 256 + wave * 32;
        RowF a0, a1, a2, a3;
        row_load(a0, X + (size_t)rbase * D, lane); row_load(a1, X + (size_t)(rbase + 1) * D, lane); row_load(a2, X + (size_t)(rbase + 2) * D, lane); row_load(a3, X + (size_t)(rbase + 3) * D, lane);
        __syncthreads();
        for (int n = tid; n < 4096; n += NTHREADS) { const int r = (n < 2048) ? b : 32; const int col = n & 2047; float s = bada[col];
#pragma unroll
            for (int kc = 0; kc < 16; ++kc) s += MODP[((size_t)kc * 33 + r) * NMOD + col];
            sv[n] = s; }
        __syncthreads();
        const int crow = p * 32 + wave * 4;
        for (int i = 0; i < 8; ++i) {
            RowF n0, n1, n2, n3;
            const float* nx = (i + 1 < 8) ? X + (size_t)(rbase + 4 * (i + 1)) * D : CTX + (size_t)crow * D;
            row_load(n0, nx, lane); row_load(n1, nx + D, lane); row_load(n2, nx + 2 * D, lane); row_load(n3, nx + 3 * D, lane);
            bf16_t* orow = XN + (size_t)(rbase + 4 * i) * D;
            norm_mod_row(a0, orow, gain, sv + 1024, sv, lane);
            norm_mod_row(a1, orow + D, gain, sv + 1024, sv, lane);
            norm_mod_row(a2, orow + 2 * D, gain, sv + 1024, sv, lane);
            norm_mod_row(a3, orow + 3 * D, gain, sv + 1024, sv, lane);
            a0 = n0; a1 = n1; a2 = n2; a3 = n3;
        }
        { bf16_t* orow = XN + (size_t)(M + crow) * D;
          norm_mod_row(a0, orow, gain, sv + 3072, sv + 2048, lane);
          norm_mod_row(a1, orow + D, gain, sv + 3072, sv + 2048, lane);
          norm_mod_row(a2, orow + 2 * D, gain, sv + 3072, sv + 2048, lane);
          norm_mod_row(a3, orow + 3 * D, gain, sv + 3072, sv + 2048, lane); }
    }
}

__device__ __forceinline__ float half_sum32(float v, int hi) {
    v += __builtin_bit_cast(float, __builtin_amdgcn_update_dpp(0, __builtin_bit_cast(int, v), 0xB1, 0xf, 0xf, true));
    v += __builtin_bit_cast(float, __builtin_amdgcn_update_dpp(0, __builtin_bit_cast(int, v), 0x4E, 0xf, 0xf, true));
    v += __builtin_bit_cast(float, __builtin_amdgcn_update_dpp(0, __builtin_bit_cast(int, v), 0x141, 0xf, 0xf, true));
    v += __builtin_bit_cast(float, __builtin_amdgcn_update_dpp(0, __builtin_bit_cast(int, v), 0x140, 0xf, 0xf, true));
    v += __builtin_bit_cast(float, __builtin_amdgcn_update_dpp(0, __builtin_bit_cast(int, v), 0x142, 0xa, 0xf, false));
    const float s0 = __builtin_bit_cast(float, __builtin_amdgcn_readlane(__builtin_bit_cast(int, v), 31)), s1 = __builtin_bit_cast(float, __builtin_amdgcn_readlane(__builtin_bit_cast(int, v), 63));
    return hi ? s1 : s0;
}
namespace att {
constexpr int KP = 272, KBUF = 64 * KP, VBUF = 16384;
constexpr int OFF_K = 0, OFF_V = 2 * KBUF, OFF_WSF = OFF_V + 2 * VBUF, OFF_END = OFF_WSF + NWAVES * 256;
static_assert(OFF_WSF >= 65536 && OFF_END <= RING_BYTES, "attention LDS map");
constexpr int NT = TK / 64;
constexpr float THR = 8.0f;
__device__ __forceinline__ int crow(int r, int hi) { return (r & 3) + 8 * (r >> 2) + 4 * hi; }
__device__ __forceinline__ float max3f(float a, float b, float c) { float r; asm("v_max3_f32 %0, %1, %2, %3" : "=v"(r) : "v"(a), "v"(b), "v"(c)); return r; }
__device__ __forceinline__ float max2f(float a, float b) { float r; asm("v_max_f32_e32 %0, %1, %2" : "=v"(r) : "v"(a), "v"(b)); return r; }
__device__ __forceinline__ s16x4 vtr(const LAS unsigned char* p) { return __builtin_bit_cast(s16x4, __builtin_amdgcn_ds_read_tr16_b64_v4i16((LAS s16x4*)p)); }

#define ATT_BAR() asm volatile("s_waitcnt lgkmcnt(0)\n\ts_barrier" ::: "memory")
#define ATT_SB() __builtin_amdgcn_sched_barrier(0)
#define ATT_KLD(i, KF) KF = *(const LAS bf16x8*)(kb_ + ((i) & 1) * (32 * KP) + ((i) >> 1) * 32)
#define ATT_XSTEP(i, KC, KN) do { if ((i) + 2 < 8) { ATT_KLD((i) + 2, KN); } \
    if ((i) == 0) p0 = __builtin_amdgcn_mfma_f32_32x32x16_bf16(KC, qr[0], negref, 0, 0, 0); \
    else if ((i) == 1) p1 = __builtin_amdgcn_mfma_f32_32x32x16_bf16(KC, qr[0], negref, 0, 0, 0); \
    else if (((i) & 1) == 0) p0 = __builtin_amdgcn_mfma_f32_32x32x16_bf16(KC, qr[(i) >> 1], p0, 0, 0, 0); else p1 = __builtin_amdgcn_mfma_f32_32x32x16_bf16(KC, qr[(i) >> 1], p1, 0, 0, 0); ATT_SB(); } while (0)
#define ATT_X(kcur) do { \
    const LAS unsigned char* kb_ = lds + OFF_K + (kcur) * KBUF + koff; \
    bf16x8 ka_, kb2_, kc_; \
    ATT_KLD(0, ka_); ATT_KLD(1, kb2_); \
    ATT_SB(); \
    ATT_XSTEP(0, ka_, kc_); ATT_XSTEP(1, kb2_, ka_); ATT_XSTEP(2, kc_, kb2_); ATT_XSTEP(3, ka_, kc_); \
    ATT_XSTEP(4, kb2_, ka_); ATT_XSTEP(5, kc_, kb2_); ATT_XSTEP(6, ka_, kc_); ATT_XSTEP(7, kb2_, ka_); \
} while (0)
#define ATT_EXP2(i, PWN) do { \
    const float e0_ = __builtin_amdgcn_exp2f((i) < 8 ? p0[2 * ((i) & 7)] : p1[2 * ((i) & 7)]), e1_ = __builtin_amdgcn_exp2f((i) < 8 ? p0[2 * ((i) & 7) + 1] : p1[2 * ((i) & 7) + 1]); \
    sacc_ += e0_ + e1_; PWN[(i) >> 2][(i) & 3] = pk2(e0_, e1_); asm volatile("" : "+v"(PWN[(i) >> 2]), "+v"(sacc_)); } while (0)
#define ATT_VLD(i, LO, HI) do { LO = vtr(vb_ + ((i) & 3) * 4096 + ((i) >> 2) * 1024); HI = vtr(vb_ + ((i) & 3) * 4096 + ((i) >> 2) * 1024 + 512); } while (0)
#define ATT_VF(LO, HI) ((bf16x8){LO[0], LO[1], LO[2], LO[3], HI[0], HI[1], HI[2], HI[3]})
#define ATT_YSTEP(i, PWC, PWN, LC, HC, LN, HN) do { if ((i) + 2 < 16) { ATT_VLD((i) + 2, LN, HN); } \
    o[(i) & 3] = __builtin_amdgcn_mfma_f32_32x32x16_bf16(__builtin_bit_cast(bf16x8, PWC[(i) >> 2]), ATT_VF(LC, HC), o[(i) & 3], 0, 0, 0); \
    ATT_EXP2(i, PWN); ATT_SB(); } while (0)
#define ATT_Y(vcur, PWC, PWN) do { \
    const LAS unsigned char* vb_ = lds + OFF_V + (vcur) * VBUF + voff; \
    float sacc_ = 0.f; s16x4 la_, ha_, lb_, hb_, lc_, hc_; \
    ATT_VLD(0, la_, ha_); ATT_VLD(1, lb_, hb_); ATT_SB(); \
    ATT_YSTEP(0, PWC, PWN, la_, ha_, lc_, hc_); ATT_YSTEP(1, PWC, PWN, lb_, hb_, la_, ha_); ATT_YSTEP(2, PWC, PWN, lc_, hc_, lb_, hb_); \
    ATT_YSTEP(3, PWC, PWN, la_, ha_, lc_, hc_); ATT_YSTEP(4, PWC, PWN, lb_, hb_, la_, ha_); ATT_YSTEP(5, PWC, PWN, lc_, hc_, lb_, hb_); \
    ATT_YSTEP(6, PWC, PWN, la_, ha_, lc_, hc_); ATT_YSTEP(7, PWC, PWN, lb_, hb_, la_, ha_); ATT_YSTEP(8, PWC, PWN, lc_, hc_, lb_, hb_); \
    ATT_YSTEP(9, PWC, PWN, la_, ha_, lc_, hc_); ATT_YSTEP(10, PWC, PWN, lb_, hb_, la_, ha_); ATT_YSTEP(11, PWC, PWN, lc_, hc_, lb_, hb_); \
    ATT_YSTEP(12, PWC, PWN, la_, ha_, lc_, hc_); ATT_YSTEP(13, PWC, PWN, lb_, hb_, la_, ha_); ATT_YSTEP(14, PWC, PWN, lc_, hc_, lb_, hb_); \
    ATT_YSTEP(15, PWC, PWN, la_, ha_, lc_, hc_); \
    l_reg += sacc_; \
} while (0)
#define ATT_Y0(PWN) do { float sacc_ = 0.f; _Pragma("unroll") for (int i = 0; i < 16; ++i) ATT_EXP2(i, PWN); l_reg += sacc_; } while (0)
#define ATT_ZSTEP(i, PWC, LC, HC, LN, HN) do { if ((i) + 2 < 16) { ATT_VLD((i) + 2, LN, HN); } \
    o[(i) & 3] = __builtin_amdgcn_mfma_f32_32x32x16_bf16(__builtin_bit_cast(bf16x8, PWC[(i) >> 2]), ATT_VF(LC, HC), o[(i) & 3], 0, 0, 0); ATT_SB(); } while (0)
#define ATT_Z(vcur, PWC) do { \
    const LAS unsigned char* vb_ = lds + OFF_V + (vcur) * VBUF + voff; \
    s16x4 la_, ha_, lb_, hb_, lc_, hc_; \
    ATT_VLD(0, la_, ha_); ATT_VLD(1, lb_, hb_); ATT_SB(); \
    ATT_ZSTEP(0, PWC, la_, ha_, lc_, hc_); ATT_ZSTEP(1, PWC, lb_, hb_, la_, ha_); ATT_ZSTEP(2, PWC, lc_, hc_, lb_, hb_); \
    ATT_ZSTEP(3, PWC, la_, ha_, lc_, hc_); ATT_ZSTEP(4, PWC, lb_, hb_, la_, ha_); ATT_ZSTEP(5, PWC, lc_, hc_, lb_, hb_); \
    ATT_ZSTEP(6, PWC, la_, ha_, lc_, hc_); ATT_ZSTEP(7, PWC, lb_, hb_, la_, ha_); ATT_ZSTEP(8, PWC, lc_, hc_, lb_, hb_); \
    ATT_ZSTEP(9, PWC, la_, ha_, lc_, hc_); ATT_ZSTEP(10, PWC, lb_, hb_, la_, ha_); ATT_ZSTEP(11, PWC, lc_, hc_, lb_, hb_); \
    ATT_ZSTEP(12, PWC, la_, ha_, lc_, hc_); ATT_ZSTEP(13, PWC, lb_, hb_, la_, ha_); ATT_ZSTEP(14, PWC, lc_, hc_, lb_, hb_); \
    ATT_ZSTEP(15, PWC, la_, ha_, lc_, hc_); \
} while (0)
#define ATT_STAGE(j) do { \
    if ((j) + 1 < NT) { _Pragma("unroll") for (int i = 0; i < 2; ++i) *(LAS u32x4*)(lds + OFF_K + (((j) + 1) & 1) * KBUF + kdst[i]) = kr[i]; } \
    _Pragma("unroll") for (int i = 0; i < 2; ++i) *(LAS u32x4*)(lds + OFF_V + ((j) & 1) * VBUF + vdst[i]) = vr[i]; \
    if ((j) + 2 < NT) { _Pragma("unroll") for (int i = 0; i < 2; ++i) kr[i] = ATT_BLD(krs, gsrc[i], ((j) + 2) * (64 * 1024)); } \
    if ((j) + 1 < NT) { _Pragma("unroll") for (int i = 0; i < 2; ++i) vr[i] = ATT_BLD(vrs, gsrc[i], ((j) + 1) * (64 * 1024)); } } while (0)
#define ATT_BLD(rs, voff_, soff_) __builtin_bit_cast(u32x4, __builtin_amdgcn_raw_buffer_load_b128(rs, (int)(voff_), (int)(soff_), 0))

__device__ __forceinline__ void unit(LAS unsigned char* lds, int b, int h, int qb, const bf16_t* Q, const bf16_t* KA, const bf16_t* VA, bf16_t* MIXIN, const float* subg, float lam, const unsigned* KM) {
    const int tid = opaque_tid(), lane = tid & 63, r32 = lane & 31, hi = lane >> 5;
    const int wid = __builtin_amdgcn_readfirstlane(tid >> 6), w = wid & 3, m = wid >> 2;
    LAS float* wsf = (LAS float*)(lds + OFF_WSF) + wid * 64;
    const int rowQ = b * T + qb * 128 + w * 32;
    bf16x8 qr[4];
#pragma unroll
    for (int d0 = 0; d0 < 4; ++d0) qr[d0] = *(const bf16x8*)(Q + (size_t)(rowQ + r32) * 512 + h * 128 + m * 64 + d0 * 16 + hi * 8);
    const bf16_t* Kb = KA + (size_t)b * TK * 512 + h * 128; const bf16_t* Vb = VA + (size_t)b * TK * 512 + h * 128;
    const __amdgpu_buffer_rsrc_t krs = __builtin_amdgcn_make_buffer_rsrc((void*)Kb, 0, 0x7fffffff, 0x00020000), vrs = __builtin_amdgcn_make_buffer_rsrc((void*)Vb, 0, 0x7fffffff, 0x00020000);
    unsigned gsrc[2]; int kdst[2], vdst[2];
#pragma unroll
    for (int i = 0; i < 2; ++i) { const int cid = tid + 512 * i, kv = cid >> 4, c16 = cid & 15;
        gsrc[i] = (unsigned)(kv * 1024 + c16 * 16); kdst[i] = kv * KP + c16 * 16; vdst[i] = (c16 >> 2) * 4096 + (kv >> 4) * 1024 + (kv & 15) * 64 + (c16 & 3) * 16; }
    u32x4 kr[2], vr[2];
#pragma unroll
    for (int i = 0; i < 2; ++i) { kr[i] = ATT_BLD(krs, gsrc[i], 0); vr[i] = ATT_BLD(vrs, gsrc[i], 0); }
#pragma unroll
    for (int i = 0; i < 2; ++i) *(LAS u32x4*)(lds + OFF_K + kdst[i]) = kr[i];
#pragma unroll
    for (int i = 0; i < 2; ++i) kr[i] = ATT_BLD(krs, gsrc[i], 64 * 1024);
    ATT_BAR();
    f32x16 o[4];
#pragma unroll
    for (int d0 = 0; d0 < 4; ++d0) o[d0] = (f32x16){};
    float l_reg = 0.f;
    f32x16 p0, p1, negref;
    {
        const unsigned* km = KM + (b * 8 + h * 2 + m) * 2;
        const float kmax2 = __uint_as_float(km[0]) + __uint_as_float(km[1]);
        float ss = 0.f;
#pragma unroll
        for (int d0 = 0; d0 < 4; ++d0)
#pragma unroll
            for (int i = 0; i < 8; ++i) { const float v = bf2f((unsigned short)qr[d0][i]); ss += v * v; }
        ss += __shfl_xor(ss, 32);
        const float ref = sqrtf(ss * kmax2) * 1.02f;
#pragma unroll
        for (int r = 0; r < 16; ++r) negref[r] = -ref;
    }
    u32x4 pwA[4], pwB[4];
    const int koff = r32 * KP + m * 128 + hi * 16;
    const int voff = ((lane >> 4) & 1) * 32 + (lane & 3) * 8 + (4 * hi + ((lane & 15) >> 2)) * 64;
    ATT_X(0); ATT_STAGE(0); ATT_Y0(pwA); ATT_BAR();
    ATT_X(1); ATT_STAGE(1); ATT_Y(0, pwA, pwB); ATT_BAR();
    for (int j = 2; j < NT; j += 2) {
        ATT_X(0); ATT_STAGE(j); ATT_Y(1, pwB, pwA); ATT_BAR();
        ATT_X(1); ATT_STAGE(j + 1); ATT_Y(0, pwA, pwB); ATT_BAR();
    }
    ATT_Z(1, pwB); ATT_BAR();
    const float lsum_ = l_reg + __shfl_xor(l_reg, 32);
    if (hi == 0) wsf[32 + r32] = lsum_;
    LDS_WAIT();
    LAS float* ex = (LAS float*)lds + w * 4096 + 4 * r32;
    const f32x4 g4 = *(const f32x4*)(subg + 4 * r32) * (1.0f - LAM_INIT);
    bf16_t* dstb = MIXIN + (size_t)rowQ * 1024 + h * 128 + 4 * r32;
#define ATT_EPI(KEEP) do { \
    _Pragma("unroll") for (int rr = 0; rr < 8; ++rr) { const int r = 8 - (KEEP) + rr; const int q = crow(r, hi); const float rl = __builtin_amdgcn_rcpf(wsf[32 + q]); \
        *(LAS f32x4*)(ex + q * 128) = (f32x4){o[0][r] * rl, o[1][r] * rl, o[2][r] * rl, o[3][r] * rl}; } \
    ATT_BAR(); \
    _Pragma("unroll") for (int rr = 0; rr < 8; ++rr) { const int r = (KEEP) + rr; const int q = crow(r, hi); const float rl = __builtin_amdgcn_rcpf(wsf[32 + q]); \
        const f32x4 own = (f32x4){o[0][r] * rl, o[1][r] * rl, o[2][r] * rl, o[3][r] * rl}; const f32x4 oth = *(const LAS f32x4*)(ex + q * 128); \
        const f32x4 x = ((KEEP) == 0) ? (own - lam * oth) : (oth - lam * own); \
        const float ss = half_sum32((x[0] * x[0] + x[1] * x[1]) + (x[2] * x[2] + x[3] * x[3]), hi); \
        const float rstd = __builtin_amdgcn_rsqf(ss * (1.f / 128.f) + EPS); \
        u32x2 wv; wv.x = pk2(x[0] * rstd * g4[0], x[1] * rstd * g4[1]); wv.y = pk2(x[2] * rstd * g4[2], x[3] * rstd * g4[3]); \
        *(u32x2*)(dstb + (size_t)q * 1024) = wv; } } while (0)
    if (m == 0) ATT_EPI(0); else ATT_EPI(8);
#undef ATT_EPI
    ATT_BAR();
}
#undef ATT_BAR
#undef ATT_X
#undef ATT_EXP2
#undef ATT_Y
#undef ATT_Y0
#undef ATT_Z
#undef ATT_STAGE
#undef ATT_BLD
#undef ATT_SB
#undef ATT_KLD
#undef ATT_XSTEP
#undef ATT_VLD
#undef ATT_VF
#undef ATT_YSTEP
#undef ATT_ZSTEP
}

__device__ __forceinline__ void p3_conv_attn(const Args& a, LAS unsigned char* lds, int c, int vcu, int G) {
    const int tid = opaque_tid(), lane = tid & 63, wave = __builtin_amdgcn_readfirstlane(tid >> 6);
    unsigned char* ws = a.ws;
    const bf16_t* GB = (const bf16_t*)(ws + WS_GB); const bf16_t* U = (const bf16_t*)(ws + WS_U); bf16_t* MIXIN = (bf16_t*)(ws + WS_MIXIN);
    {
        const float* cw = a.in[I_CONVW]; float w0[8], w1[8], w2[8];
#pragma unroll
        for (int i = 0; i < 8; ++i) { w0[i] = cw[lane * 8 + i]; w1[i] = cw[512 + lane * 8 + i]; w2[i] = cw[1024 + lane * 8 + i]; }
        const int gw = vcu * NWAVES + wave, NGW = G * NWAVES;
        for (int row = gw * (M / NGW); row < (gw + 1) * (M / NGW); ++row) {
            const int t = row & (T - 1);
            const u32x4 z = {0u, 0u, 0u, 0u};
            const u32x4 uc = *(const u32x4*)(U + (size_t)row * 512 + lane * 8);
            const u32x4 up = (t > 0) ? *(const u32x4*)(U + (size_t)(row - 1) * 512 + lane * 8) : z;
            const u32x4 un = (t < T - 1) ? *(const u32x4*)(U + (size_t)(row + 1) * 512 + lane * 8) : z;
            const u32x4 gb = *(const u32x4*)(GB + (size_t)row * 512 + lane * 8);
            u32x4 o;
#pragma unroll
            for (int q = 0; q < 4; ++q) {
                const float y0 = w0[2 * q] * bflo(up[q]) + w1[2 * q] * bflo(uc[q]) + w2[2 * q] * bflo(un[q]);
                const float y1 = w0[2 * q + 1] * bfhi(up[q]) + w1[2 * q + 1] * bfhi(uc[q]) + w2[2 * q + 1] * bfhi(un[q]);
                o[q] = pk2(bflo(gb[q]) * y0, bfhi(gb[q]) * y1);
            }
            *(u32x4*)(MIXIN + (size_t)row * 1024 + 512 + lane * 8) = o;
        }
    }
    float lam;
    { const float p1 = a.in[I_LQ1][lane] * a.in[I_LK1][lane], p2 = a.in[I_LQ2][lane] * a.in[I_LK2][lane];
      lam = __expf(wave_sum(p1)) - __expf(wave_sum(p2)) + LAM_INIT; }
    const bf16_t* Q = (const bf16_t*)(ws + WS_Q); const bf16_t* KA = (const bf16_t*)(ws + WS_K); const bf16_t* VA = (const bf16_t*)(ws + WS_V);
    __syncthreads();
    for (int u = vcu * 8; u < 2048; u += G * 8) {
        const int x = (u >> 3) / 32, jj = (u >> 3) % 32;
        for (int i = 0; i < 8; ++i) {
            const int bh = 16 * x + 2 * i + (jj >> 4), qb = jj & 15;
            att::unit(lds, bh >> 2, bh & 3, qb, Q, KA, VA, MIXIN, a.in[I_SUBLN], lam, (const unsigned*)(ws + WS_CTL) + CW_KMAX);
        }
    }
}

struct P5In { f32x4 x[4]; u32x2 m[4]; };
__device__ __forceinline__ void p5_load(P5In& r, int row, int lane, const float* X, const bf16_t* MIX) {
    const f32x4* xr = (const f32x4*)(X + (size_t)row * D) + lane; const u32x2* mr = (const u32x2*)(MIX + (size_t)row * D) + lane;
#pragma unroll
    for (int j = 0; j < 4; ++j) { r.x[j] = __builtin_nontemporal_load(xr + 64 * j); r.m[j] = __builtin_nontemporal_load(mr + 64 * j); }
}
__device__ __forceinline__ float p5_resid(const P5In& r, f32x4 (&h)[4], int row, int lane, const LAS float* mv, const LAS f32x4* npm, bf16_t* H1) {
    f32x4 mx[4]; float s = 0.f;
#pragma unroll
    for (int j = 0; j < 4; ++j) { const u32x2 wv = r.m[j]; mx[j] = (f32x4){bflo(wv.x), bfhi(wv.x), bflo(wv.y), bfhi(wv.y)};
        s += (mx[j].x * mx[j].x + mx[j].y * mx[j].y) + (mx[j].z * mx[j].z + mx[j].w * mx[j].w); }
    const float rstd1 = 1.0f / sqrtf(wave_sum(s) * (1.f / D) + EPS);
    u32x2* hr = (u32x2*)(H1 + (size_t)row * D) + lane; float s2 = 0.f;
#pragma unroll
    for (int j = 0; j < 4; ++j) { const f32x4 g1 = *(const LAS f32x4*)(mv + 4 * lane + 256 * j);
        h[j] = r.x[j] + g1 * ((mx[j] * rstd1) * npm[64 * j]);
        u32x2 wv; wv.x = pk2(h[j].x, h[j].y); wv.y = pk2(h[j].z, h[j].w); __builtin_nontemporal_store(wv, hr + 64 * j);
        s2 += (h[j].x * h[j].x + h[j].y * h[j].y) + (h[j].z * h[j].z + h[j].w * h[j].w); }
    return 1.0f / sqrtf(wave_sum(s2) * (1.f / D) + EPS);
}
__device__ __forceinline__ void p5_rows(const Args& a, LAS unsigned char* lds, int p  ) {
    const int tid = opaque_tid(), lane = tid & 63, wave = __builtin_amdgcn_readfirstlane(tid >> 6);
    unsigned char* ws = a.ws;
    const int b = p >> 3;
    LAS float* wrt = (LAS float*)lds;
    LAS float* mv = (LAS float*)(lds + 65536);
    const float* wr = a.in[I_WROUTER];
    const bf16_t* MIX = (const bf16_t*)(ws + WS_MIX); unsigned char* XN2 = ws + WS_XN; float* AFFT = (float*)(ws + WS_AFFT); bf16_t* H1 = (bf16_t*)(ws + WS_H1);
    const float* X = a.in[I_X];
    const int rbase = p * 256 + wave * 32;
    P5In cA, cB;
    p5_load(cA, rbase, lane, X, MIX); p5_load(cB, rbase + 1, lane, X, MIX);
    for (int n = tid; n < D * NE; n += NTHREADS) { const int k = n >> 4, e = n & 15; wrt[e * D + k] = wr[n]; }
    const float* MOD = (const float*)(ws + WS_MOD) + (size_t)b * NMOD;
    for (int n = tid; n < 3 * D; n += NTHREADS) mv[n] = MOD[2 * D + n];
    for (int n = tid; n < D; n += NTHREADS) { mv[3 * D + n] = a.in[I_NPOST_MIX][n]; mv[4 * D + n] = a.in[I_NPRE_FFN][n]; }
    __syncthreads();
    const LAS f32x4* npm = (const LAS f32x4*)(mv + 3 * D) + lane; const LAS f32x4* npf = (const LAS f32x4*)(mv + 4 * D) + lane;
    for (int i = 0; i < 16; ++i) {
        const int rowA = rbase + 2 * i, rowB = rowA + 1;
        P5In nA, nB;
        if (i + 1 < 16) { p5_load(nA, rowA + 2, lane, X, MIX); p5_load(nB, rowB + 2, lane, X, MIX); }
        f32x4 hA[4], hB[4];
        const float rsA = p5_resid(cA, hA, rowA, lane, mv, npm, H1);
        const float rsB = p5_resid(cB, hB, rowB, lane, mv, npm, H1);
        unsigned* oA = (unsigned*)(XN2 + (size_t)rowA * D) + lane; unsigned* oB = (unsigned*)(XN2 + (size_t)rowB * D) + lane;
        typedef float f32x2v __attribute__((ext_vector_type(2)));
        f32x2v lg2[16];
#pragma unroll
        for (int e = 0; e < 16; ++e) lg2[e] = (f32x2v){0.f, 0.f};
#pragma unroll
        for (int j = 0; j < 4; ++j) { const f32x4 sh2 = *(const LAS f32x4*)(mv + 1024 + 4 * lane + 256 * j), sc2 = *(const LAS f32x4*)(mv + 2048 + 4 * lane + 256 * j);
            const f32x4 gn = npf[64 * j];
            const f32x4 zA = ((hA[j] * rsA) * gn) * (sc2 + 1.0f) + sh2, zB = ((hB[j] * rsB) * gn) * (sc2 + 1.0f) + sh2;
            { const f32x4 qa = zA * pg8::F8_ACT, qb = zB * pg8::F8_ACT; oA[64 * j] = pg8::pk4_fp8(qa.x, qa.y, qa.z, qa.w); oB[64 * j] = pg8::pk4_fp8(qb.x, qb.y, qb.z, qb.w); }
            const f32x2v zx = {zA.x, zB.x}, zy = {zA.y, zB.y}, zz = {zA.z, zB.z}, zw = {zA.w, zB.w};
#pragma unroll
            for (int e = 0; e < 16; ++e) { const f32x4 wq = *(const LAS f32x4*)(wrt + e * D + 4 * lane + 256 * j);
                lg2[e] = __builtin_elementwise_fma(zx, (f32x2v){wq.x, wq.x}, lg2[e]); lg2[e] = __builtin_elementwise_fma(zy, (f32x2v){wq.y, wq.y}, lg2[e]);
                lg2[e] = __builtin_elementwise_fma(zz, (f32x2v){wq.z, wq.z}, lg2[e]); lg2[e] = __builtin_elementwise_fma(zw, (f32x2v){wq.w, wq.w}, lg2[e]);
                if ((e & 3) == 3) __builtin_amdgcn_sched_barrier(0); } }
        float lg[32];
#pragma unroll
        for (int e = 0; e < 16; ++e) { lg[e] = lg2[e].x; lg[16 + e] = lg2[e].y; }
#pragma unroll
        for (int st = 0; st < 5; ++st) { const int d = 1 << st, cntv = 16 >> st; const bool up = (lane & d) != 0;
#pragma unroll
            for (int q = 0; q < 16; ++q) if (q < cntv) { const float send = up ? lg[2 * q] : lg[2 * q + 1], keep = up ? lg[2 * q + 1] : lg[2 * q]; lg[q] = keep + __shfl_xor(send, d); } }
        float lv = lg[0] + __shfl_xor(lg[0], 32);
        float mxl = lv;
#pragma unroll
        for (int d = 1; d < 16; d <<= 1) mxl = fmaxf(mxl, __shfl_xor(mxl, d));
        const float ev = __expf(lv - mxl); float se = ev;
#pragma unroll
        for (int d = 1; d < 16; d <<= 1) se += __shfl_xor(se, d);
        if (lane < 32) { const int row = (lane < 16) ? rowA : rowB; AFFT[((size_t)b * NE + (lane & 15)) * T + (row & (T - 1))] = ev / se; }
        cA = nA; cB = nB;
    }
}

__device__ __forceinline__ void p6_topk(const Args& a, LAS unsigned char* lds, int c, int G) {
    const int tid = opaque_tid(), lane = tid & 63, wave = __builtin_amdgcn_readfirstlane(tid >> 6);
    unsigned char* ws = a.ws;
    const float* AFFT = (const float*)(ws + WS_AFFT); short* SLOT = (short*)(ws + WS_SLOT); int* IDX = (int*)(ws + WS_IDX); float* GATE = (float*)(ws + WS_GATE);
    LAS unsigned* sv = (LAS unsigned*)(lds + wave * 16384);
    for (int item = c + wave * G; item < NITEM; item += G * NWAVES) {
        const int b = item >> 4, e = item & 15;
        const float* src = AFFT + (size_t)item * T;
#pragma unroll 8
        for (int j = 0; j < 32; ++j) sv[j * 64 + lane] = __float_as_uint(src[j * 64 + lane]);
        LDS_WAIT(); asm volatile("" ::: "memory");
        unsigned pre = 0u;
        for (int bit = 30; bit >= 0; --bit) {
            const unsigned cand = pre | (1u << bit);
            int cnt = 0;
#pragma unroll 4
            for (int j = 0; j < 32; ++j) cnt += (int)__popcll(__ballot(sv[j * 64 + lane] >= cand));
            if (cnt >= CAP) pre = cand;
        }
        int ngt = 0;
#pragma unroll 4
        for (int j = 0; j < 32; ++j) ngt += (int)__popcll(__ballot(sv[j * 64 + lane] > pre));
        const int need_eq = CAP - ngt;
        const unsigned long long ltmask = (1ull << lane) - 1ull;
        int base_gt = 0, base_eq = 0;
#pragma unroll 2
        for (int j = 0; j < 32; ++j) {
            const unsigned vj = sv[j * 64 + lane];
            const bool gt = vj > pre, eq = vj == pre;
            const unsigned long long mg = __ballot(gt), me = __ballot(eq);
            const int pg = base_gt + (int)__popcll(mg & ltmask), pe = base_eq + (int)__popcll(me & ltmask);
            int sl = -1; if (gt) sl = pg; else if (eq && pe < need_eq) sl = ngt + pe;
            const int t = j * 64 + lane;
            SLOT[((size_t)b * T + t) * NE + e] = (short)sl;
            if (sl >= 0) { IDX[item * CAP + sl] = t; GATE[item * CAP + sl] = __uint_as_float(vj); }
            base_gt += (int)__popcll(mg); base_eq += (int)__popcll(me);
        }
        LDS_WAIT(); asm volatile("" ::: "memory");
    }
}

struct P8Row { u32x2 h[4]; unsigned y[4][4]; float wt[4]; unsigned long long rest; int sl; };
__device__ __forceinline__ f32x4 fp8x4_to_f32(unsigned w) { typedef float f2 __attribute__((ext_vector_type(2))); const f2 lo = __builtin_amdgcn_cvt_pk_f32_fp8((int)w, false), hi = __builtin_amdgcn_cvt_pk_f32_fp8((int)w, true); return (f32x4){lo.x, lo.y, hi.x, hi.y}; }
__device__ __forceinline__ int p8_slot(int row, int lane, const short* SLOT) { return (lane < NE) ? (int)SLOT[(size_t)row * NE + lane] : -1; }
__device__ __forceinline__ void p8_issue(P8Row& r, int row, int lane, int s_e, const unsigned char* Y, const bf16_t* H1) {
    const int b = row >> 11;
    unsigned long long mask = __ballot(s_e >= 0);
    const u32x2* hr = (const u32x2*)(H1 + (size_t)row * D) + lane;
#pragma unroll
    for (int j = 0; j < 4; ++j) r.h[j] = __builtin_nontemporal_load(hr + 64 * j);
#pragma unroll
    for (int q = 0; q < 4; ++q) {
        int e = 0, s = 0; r.wt[q] = 0.f;
        if (mask) { e = (int)__builtin_ctzll(mask); mask &= mask - 1ull; s = __builtin_amdgcn_readlane(s_e, e); r.wt[q] = 1.f; }
        const unsigned* yr = (const unsigned*)(Y + ((size_t)(b * NE + e) * CAP + s) * D) + lane;
#pragma unroll
        for (int j = 0; j < 4; ++j) r.y[q][j] = __builtin_nontemporal_load(yr + 64 * j);
    }
    r.rest = mask; r.sl = s_e;
}
__device__ __forceinline__ void p8_finish(P8Row& r, int row, int lane, const unsigned char* Y, const f32x4 (&gg)[4], float* out) {
    const int b = row >> 11;
    f32x4 ff[4];
#pragma unroll
    for (int j = 0; j < 4; ++j) ff[j] = (f32x4){0.f, 0.f, 0.f, 0.f};
#pragma unroll
    for (int q = 0; q < 4; ++q)
#pragma unroll
        for (int j = 0; j < 4; ++j) ff[j] += fp8x4_to_f32(r.y[q][j]) * r.wt[q];
    unsigned long long mask = r.rest;
    while (mask) {
        const int e = (int)__builtin_ctzll(mask); mask &= mask - 1ull; const int s = __builtin_amdgcn_readlane(r.sl, e);
        const unsigned* yr = (const unsigned*)(Y + ((size_t)(b * NE + e) * CAP + s) * D) + lane;
#pragma unroll
        for (int j = 0; j < 4; ++j) ff[j] += fp8x4_to_f32(yr[64 * j]);
    }
#pragma unroll
    for (int j = 0; j < 4; ++j) ff[j] = ff[j] * (1.0f / pg8::F8_Y);
    float s2 = 0.f;
#pragma unroll
    for (int j = 0; j < 4; ++j) s2 += (ff[j].x * ff[j].x + ff[j].y * ff[j].y) + (ff[j].z * ff[j].z + ff[j].w * ff[j].w);
    const float rstd = 1.0f / sqrtf(wave_sum(s2) * (1.f / D) + EPS);
    f32x4* orow = (f32x4*)(out + (size_t)row * D) + lane;
#pragma unroll
    for (int j = 0; j < 4; ++j) { const u32x2 hv = r.h[j]; const f32x4 h = (f32x4){bflo(hv.x), bfhi(hv.x), bflo(hv.y), bfhi(hv.y)};
        __builtin_nontemporal_store(h + gg[j] * (ff[j] * rstd), orow + 64 * j); }
}
__device__ __forceinline__ void p8_final(const Args& a, int vcu, int G) {
    const int tid = opaque_tid(), lane = tid & 63, wave = __builtin_amdgcn_readfirstlane(tid >> 6);
    unsigned char* ws = a.ws;
    const short* SLOT = (const short*)(ws + WS_SLOT); const unsigned char* Y = ws + WS_Y; const float* MOD = (const float*)(ws + WS_MOD); const bf16_t* H1 = (const bf16_t*)(ws + WS_H1);
    const int gw = vcu * NWAVES + wave, NGW = G * NWAVES;
    const int per = M / NGW;
    const int row0 = gw * per, rend = row0 + per;
    f32x4 gg[4];
    { const f32x4* npo = (const f32x4*)a.in[I_NPOST_FFN] + lane; const f32x4* g2 = (const f32x4*)(MOD + (size_t)(row0 >> 11) * NMOD + 5 * D) + lane;
#pragma unroll
      for (int j = 0; j < 4; ++j) gg[j] = g2[64 * j] * npo[64 * j]; }
    P8Row r0, r1, r2, r3;
    { const int s0 = p8_slot(row0, lane, SLOT), s1 = p8_slot(row0 + 1, lane, SLOT), s2 = p8_slot(row0 + 2, lane, SLOT), s3 = p8_slot(row0 + 3, lane, SLOT);
      p8_issue(r0, row0, lane, s0, Y, H1); p8_issue(r1, row0 + 1, lane, s1, Y, H1); p8_issue(r2, row0 + 2, lane, s2, Y, H1); p8_issue(r3, row0 + 3, lane, s3, Y, H1); }
    for (int row = row0; row < rend; row += 4) {
        const bool more = row + 4 < rend;
        int n0 = -1, n1 = -1, n2 = -1, n3 = -1;
        if (more) { n0 = p8_slot(row + 4, lane, SLOT); n1 = p8_slot(row + 5, lane, SLOT); n2 = p8_slot(row + 6, lane, SLOT); n3 = p8_slot(row + 7, lane, SLOT); }
        p8_finish(r0, row, lane, Y, gg, a.out);
        p8_finish(r1, row + 1, lane, Y, gg, a.out);
        if (more) { p8_issue(r0, row + 4, lane, n0, Y, H1); p8_issue(r1, row + 5, lane, n1, Y, H1); }
        p8_finish(r2, row + 2, lane, Y, gg, a.out);
        p8_finish(r3, row + 3, lane, Y, gg, a.out);
        if (more) { p8_issue(r2, row + 6, lane, n2, Y, H1); p8_issue(r3, row + 7, lane, n3, Y, H1); }
    }
}

__global__ void __launch_bounds__(NTHREADS, 2) fwd_kernel(Args args) {
    extern __shared__ __attribute__((aligned(16))) unsigned char lds_raw[];
    LAS unsigned char* lds = (LAS unsigned char*)lds_raw;
    volatile LAS unsigned* MISC = (volatile LAS unsigned*)(lds + MISC_OFF);
    const int tid = threadIdx.x;
    const int G = gridDim.x, c = blockIdx.x;
    const int vcu = (G % 8 == 0) ? (c % 8) * (G / 8) + c / 8 : c;
    unsigned char* ws = args.ws;
    gu32* ctl = (gu32*)(ws + WS_CTL);
    for (int u = tid; u < (LDS_BYTES - LDSCTL_OFF) / 4; u += NTHREADS) ((LAS unsigned*)(lds + LDSCTL_OFF))[u] = 0u;
    __syncthreads();
    XcdBarrier bar; bar.bar = (unsigned*)(ctl + CW_BAR); bar.x = 0; bar.st = nullptr;
    const int lo = args.ph_lo, hi = args.ph_hi;
    if (hi - lo > 1) bar = xcd_barrier_post((unsigned*)(ctl + CW_BAR), MISC + 8);
#ifndef PHMASK
#define PHMASK 0xff
#endif
#define IN(k) (((PHMASK >> (k)) & 1) && lo <= (k) && (k) < hi)
#define SEAM(k) do { if (IN(k) && IN((k) + 1)) xcd_barrier(bar); } while (0)
#ifndef PROBE_PHASE
#define PROBE_PHASE -1
#endif
#define PB(k) do { if (PROBE_PHASE == (k)) { if (tid == 0) { const unsigned long long t0_ = __builtin_amdgcn_s_memrealtime(); MISC[16] = (unsigned)t0_; MISC[17] = (unsigned)(t0_ >> 32); } } } while (0)
#define PE(k) do { if (PROBE_PHASE == (k)) { if (tid == 0) { const unsigned long long t0_ = ((unsigned long long)MISC[17] << 32) | MISC[16]; const unsigned long long t1_ = __builtin_amdgcn_s_memrealtime(); \
      while (__builtin_amdgcn_s_memrealtime() - t1_ < t1_ - t0_) __builtin_amdgcn_s_sleep(8); } __syncthreads(); } } while (0)

    PB(0); if (IN(0)) { p0_prologue(args, lds, vcu, G); } SEAM(0); PE(0);
    PB(1); if (IN(1)) { p1_xn(args, lds, c, G); inout_weight_copies(args, lds, vcu, G); } SEAM(1); PE(1);
    PB(2); if (IN(2)) {
        pg8::Gemm g{(const bf16_t*)(ws + WS_XN), (const bf16_t*)(ws + WS_WIN), D, nullptr};
        pg8::SchedProj S{G, c};
        pg8::EpiProj E{(bf16_t*)(ws + WS_Q), (bf16_t*)(ws + WS_K), (bf16_t*)(ws + WS_V), (bf16_t*)(ws + WS_GB), (bf16_t*)(ws + WS_U), (const float*)(ws + WS_TAB), (unsigned*)(ws + WS_CTL) + CW_KMAX};
        pg8::gemm_phase<pg8::EpiProj, pg8::SchedProj, true, true>(lds, g, S, E);
        if (c >= 128) expert_weight_copies(args, lds, c - 128, G - 128, 0, 9216);
    } SEAM(2); PE(2);
    PB(3); if (IN(3)) { if (c & 1) expert_weight_copies(args, lds, vcu, G, 9216, 24576); p3_conv_attn(args, lds, c, vcu, G); if (!(c & 1)) expert_weight_copies(args, lds, vcu, G, 9216, 24576); } SEAM(3); PE(3);
    PB(4); if (IN(4)) {
        {
            const int p = c;
#ifndef NO_P4
            pg8::Gemm g{(const bf16_t*)(ws + WS_MIXIN), (const bf16_t*)(ws + WS_WOUT), D, nullptr};
            pg8::SchedPanel S{p, 4};
            pg8::EpiBf16 E{(bf16_t*)(ws + WS_MIX), D};
            pg8::gemm_phase<pg8::EpiBf16, pg8::SchedPanel, true, true>(lds, g, S, E);
#endif
            VM_WAIT(); __syncthreads();
#ifndef NO_P5
            p5_rows(args, lds, p);
#endif
            __syncthreads();
        }
    } SEAM(4); PE(4);
    PB(5); if (IN(5)) { p6_topk(args, lds, c, G); } SEAM(5); PE(5);
    PB(6); if (IN(6)) {
#pragma unroll 1
        for (int it = 0; it < 2; ++it) {
            {
                const int item = 2 * c + it;
                const int b = item >> 4, e = item & 15;
#ifndef NO_G1
                if (it == 0) PB(8);
                {
                    pg8::Gemm g{(const bf16_t*)(ws + WS_XN + (size_t)b * T * D), (const bf16_t*)(ws + WS_WGU + (size_t)e * 2048 * D), D, (const int*)(ws + WS_IDX) + item * CAP};
                    pg8::SchedPanel S{0, 8};
                    pg8::EpiGU8 E{ws + WS_HMID + (size_t)item * CAP * D};
                    pg8::gemm_phase<pg8::EpiGU8, pg8::SchedPanel, false, true, true, true, true>(lds, g, S, E);
                }
#endif
                VM_WAIT(); __syncthreads();
                if (it == 0) { PE(8); PB(9); }
#ifndef NO_G2
                {
                    pg8::Gemm g{(const bf16_t*)(ws + WS_HMID + (size_t)item * CAP * D), (const bf16_t*)(ws + WS_WDN + (size_t)e * D * D), D, nullptr};
                    pg8::SchedPanel S{0, 4};
                    LAS float* gl = (LAS float*)(lds + LDSCTL_OFF + 4096);
                    { const int t_ = opaque_tid(); if (t_ < CAP) gl[t_] = ((const float*)(ws + WS_GATE))[item * CAP + t_] * (pg8::F8_INV * pg8::F8_Y); }
                    __syncthreads();
                    pg8::EpiDown8 E{ws + WS_Y + (size_t)item * CAP * D, gl};
                    pg8::gemm_phase<pg8::EpiDown8, pg8::SchedPanel, false, true, false, true, true>(lds, g, S, E);
                }
#endif
                VM_WAIT(); __syncthreads();
                if (it == 0) PE(9);
            }
        }
    } SEAM(6); PE(6);
    PB(7); if (IN(7)) { p8_final(args, vcu, G); } PE(7);
#undef IN
#undef SEAM
}

extern "C" void kernel_launch(void* const* d_in, const int* in_sizes, int n_in, void* d_out, int out_size, void* d_ws, size_t ws_size, hipStream_t stream) {
    static int grid = 0;
    if (grid == 0) {
        if (n_in != 22 || in_sizes[0] != M * D || out_size != M * D || ws_size < WS_END) { fprintf(stderr, "kernel_launch: unexpected shapes (n_in %d, in0 %d, out %d, ws %zu)\n", n_in, n_in > 0 ? in_sizes[0] : -1, out_size, ws_size); grid = -1; return; }
        int dev = 0, cus = 0;
        if (hipGetDevice(&dev) != hipSuccess || hipDeviceGetAttribute(&cus, hipDeviceAttributeMultiprocessorCount, dev) != hipSuccess) { grid = -1; return; }
        if (hipFuncSetAttribute((const void*)fwd_kernel, hipFuncAttributeMaxDynamicSharedMemorySize, LDS_BYTES) != hipSuccess) { fprintf(stderr, "kernel_launch: hipFuncSetAttribute failed\n"); grid = -1; return; }
        (void)hipGetLastError();
        grid = cus;
        if (grid != 256) { fprintf(stderr, "kernel_launch: this kernel needs a 256-CU device (got %d)\n", cus); grid = -1; return; }
    }
    if (grid < 0) return;
    (void)hipMemsetAsync((char*)d_ws + WS_CTL, 0, CTL_ZERO_BYTES, stream);
    Args a{};
    for (int i = 0; i < 22; ++i) a.in[i] = (const float*)d_in[i];
    a.out = (float*)d_out; a.ws = (unsigned char*)d_ws;
    constexpr int NPH = 8;
    if (MK_N_LAUNCHES == 1) { a.ph_lo = 0; a.ph_hi = NPH; hipLaunchKernelGGL(fwd_kernel, dim3(grid), dim3(NTHREADS), LDS_BYTES, stream, a); }
    else { for (int k = 0; k < NPH; ++k) { a.ph_lo = k; a.ph_hi = k + 1; hipLaunchKernelGGL(fwd_kernel, dim3(grid), dim3(NTHREADS), LDS_BYTES, stream, a); } }
}
```

```cpp
#include <hip/hip_runtime.h>
#include <cstdio>
#include <cstdint>

#ifndef MK_N_LAUNCHES
#define MK_N_LAUNCHES 1
#endif

#define LAS __attribute__((address_space(3)))
#define GAS __attribute__((address_space(1)))
typedef unsigned short bf16_t;
typedef short bf16x8 __attribute__((ext_vector_type(8)));
typedef short s16x4 __attribute__((ext_vector_type(4)));
typedef float f32x4 __attribute__((ext_vector_type(4)));
typedef float f32x16 __attribute__((ext_vector_type(16)));
typedef unsigned u32x4 __attribute__((ext_vector_type(4)));
typedef unsigned u32x2 __attribute__((ext_vector_type(2)));

constexpr int NB = 32, T = 2048, D = 1024, TC = 256, M = NB * T, MC = NB * TC, MA = M + MC, TK = TC + T;
constexpr int NE = 16, CAP = 256, NITEM = NB * NE, NPROJ = 3072, NMOD = 6 * D;
constexpr float EPS = 1e-6f;
constexpr float C2 = 0.125f * 1.4426950408889634f;
constexpr float LAM_INIT = 0.2f;
constexpr int NWAVES = 8, NTHREADS = 512;

constexpr size_t MiB = 1u << 20;
constexpr size_t WS_CTL = 0, CTL_ZERO_BYTES = 1 * MiB;
constexpr size_t WS_MODP = 2 * MiB;
constexpr size_t WS_MOD = 16 * MiB;
constexpr size_t WS_TAB = 17 * MiB;
constexpr size_t WS_WIN = 18 * MiB;
constexpr size_t WS_WOUT = 24 * MiB;
constexpr size_t WS_WGU = 26 * MiB;
constexpr size_t WS_WDN = 90 * MiB;
constexpr size_t WS_AFFT = 122 * MiB;
constexpr size_t WS_SLOT = 126 * MiB;
constexpr size_t WS_IDX = 128 * MiB;
constexpr size_t WS_GATE = 129 * MiB;
constexpr size_t WS_XN = 130 * MiB;
constexpr size_t WS_Q = 274 * MiB;
constexpr size_t WS_K = 338 * MiB;
constexpr size_t WS_V = 410 * MiB;
constexpr size_t WS_GB = 482 * MiB;
constexpr size_t WS_U = 546 * MiB;
constexpr size_t WS_MIXIN = 610 * MiB;
constexpr size_t WS_MIX = 738 * MiB;
constexpr size_t WS_HMID = 274 * MiB;
constexpr size_t WS_Y = 610 * MiB;
constexpr size_t WS_H1 = 866 * MiB;
constexpr size_t WS_END = 994 * MiB;

__device__ __forceinline__ int opaque_tid() { int t = threadIdx.x; asm volatile("" : "+v"(t)); return t; }

namespace pg8 {
constexpr int BM = 256, BK = 64, HALF = 128, HTB = HALF * BK * 2, STAGE_BYTES = 8 * HTB;
__host__ __device__ __forceinline__ int lds_byte(int r, int c) { const int st = (r >> 4) * 2 + (c >> 5), rr = r & 15, cc = c & 31, ob = rr * 64 + cc * 2; return st * 1024 + (ob ^ (((ob >> 9) & 1) << 5)); }
__host__ __device__ __forceinline__ void stage_rc(int b, int& R, int& C) { const int st = b / 1024, sb = b % 1024, swz = sb ^ (((sb >> 9) & 1) << 5); R = (st >> 1) * 16 + swz / 64; C = (st & 1) * 32 + (swz % 64) / 2; }
__host__ __device__ __forceinline__ int perm32(int rho) { const int n = rho >> 4, i = rho & 15; return 8 * (i >> 2) + 4 * n + (i & 3); }

struct Unit { int pm, pn; };
struct Gemm { const bf16_t* A; const bf16_t* Bt; int K; const int* gidx; };

typedef float f32x2_t __attribute__((ext_vector_type(2))); typedef __bf16 bf16x2_t __attribute__((ext_vector_type(2)));
__device__ __forceinline__ unsigned cvt_pk_bf16(float lo, float hi) { const f32x2_t v = {lo, hi}; const bf16x2_t b = __builtin_convertvector(v, bf16x2_t); return __builtin_bit_cast(unsigned, b); }

struct EpiBf16 {
    static constexpr bool PERM = true, AFTER_DRAIN = false;
    bf16_t* O; int ldc;
    __device__ __forceinline__ void operator()(const f32x4 (&acc)[2][2][4][2], const Unit& u, int wr, int wc, int fr, int fq) const {
        const int row0 = u.pm * BM + wr * 64 + fr; const int col0 = u.pn * BM + wc * 32 + 8 * fq;
#pragma unroll
        for (int ai = 0; ai < 2; ++ai)
#pragma unroll
            for (int m = 0; m < 4; ++m) { bf16_t* rowp = O + (size_t)(row0 + ai * HALF + m * 16) * ldc + col0;
#pragma unroll
                for (int bj = 0; bj < 2; ++bj) { const f32x4 v0 = acc[ai][bj][m][0], v1 = acc[ai][bj][m][1];
                    u32x4 w; w.x = cvt_pk_bf16(v0[0], v0[1]); w.y = cvt_pk_bf16(v0[2], v0[3]); w.z = cvt_pk_bf16(v1[0], v1[1]); w.w = cvt_pk_bf16(v1[2], v1[3]);
                    *(u32x4*)(rowp + bj * HALF) = w; } }
    }
};

struct EpiProj {
    static constexpr bool PERM = true, AFTER_DRAIN = false;
    bf16_t *Q, *KA, *VA, *GB, *U; const float* tab;
    unsigned* kmaxh;
    __device__ __forceinline__ void operator()(const f32x4 (&acc)[2][2][4][2], const Unit& u, int wr, int wc, int fr, int fq) const {
        const int pn = u.pn; const bool ctx = u.pm >= 256;
        float km[2] = {0.f, 0.f};
#pragma unroll
        for (int ai = 0; ai < 2; ++ai)
#pragma unroll
            for (int m = 0; m < 4; ++m) {
                const int row = u.pm * BM + ai * HALF + wr * 64 + m * 16 + fr;
                int t, kvrow;
                if (!ctx) { const int b = row >> 11; t = row & 2047; kvrow = b * TK + TC + t; }
                else { const int rc = row - M; const int b = rc >> 8; t = 0; kvrow = b * TK + (rc & 255); }
                if (pn < 4) {
                    f32x4 cs0 = {1.f, 0.f, 1.f, 0.f}, cs1 = cs0, cs2 = cs0, cs3 = cs0;
                    if (!ctx) { const float* tp = tab + ((size_t)t * 32 + 16 * (wc & 1) + 4 * fq) * 2;
                        cs0 = *(const f32x4*)(tp); cs1 = *(const f32x4*)(tp + 4); }
                    (void)cs2; (void)cs3;
#pragma unroll
                    for (int bj = 0; bj < 2; ++bj) {
                        const f32x4 v0 = acc[ai][bj][m][0], v1 = acc[ai][bj][m][1];
                        float e0 = v0[0], o0 = v0[1], e1 = v0[2], o1 = v0[3], e2 = v1[0], o2 = v1[1], e3 = v1[2], o3 = v1[3];
                        if (pn >= 2) {
                            float ss = ((e0 * e0 + o0 * o0) + (e1 * e1 + o1 * o1)) + ((e2 * e2 + o2 * o2) + (e3 * e3 + o3 * o3));
                            ss += __shfl_xor(ss, 16); ss += __shfl_xor(ss, 32); km[bj] = fmaxf(km[bj], ss); }
                        float r0 = e0 * cs0[0] - o0 * cs0[1], s0 = o0 * cs0[0] + e0 * cs0[1];
                        float r1 = e1 * cs0[2] - o1 * cs0[3], s1 = o1 * cs0[2] + e1 * cs0[3];
                        float r2 = e2 * cs1[0] - o2 * cs1[1], s2 = o2 * cs1[0] + e2 * cs1[1];
                        float r3 = e3 * cs1[2] - o3 * cs1[3], s3 = o3 * cs1[2] + e3 * cs1[3];
                        const float sc = (pn < 2) ? C2 : 1.f;
                        u32x4 w; w.x = cvt_pk_bf16(r0 * sc, s0 * sc); w.y = cvt_pk_bf16(r1 * sc, s1 * sc); w.z = cvt_pk_bf16(r2 * sc, s2 * sc); w.w = cvt_pk_bf16(r3 * sc, s3 * sc);
                        const int col = (pn & 1) * 256 + bj * HALF + wc * 32 + 8 * fq;
                        bf16_t* dst = (pn < 2) ? (Q + (size_t)row * 512 + col) : (KA + (size_t)kvrow * 512 + col);
                        *(u32x4*)dst = w;
                    }
                } else if (pn < 8) {
#pragma unroll
                    for (int bj = 0; bj < 2; ++bj) {
                        const f32x4 v0 = acc[ai][bj][m][0], v1 = acc[ai][bj][m][1];
                        u32x4 w; w.x = cvt_pk_bf16(v0[0], v0[1]); w.y = cvt_pk_bf16(v0[2], v0[3]); w.z = cvt_pk_bf16(v1[0], v1[1]); w.w = cvt_pk_bf16(v1[2], v1[3]);
                        const int col = (pn & 1) * 256 + bj * HALF + wc * 32 + 8 * fq;
                        bf16_t* dst = (pn < 6) ? (VA + (size_t)kvrow * 512 + col) : (GB + (size_t)row * 512 + col);
                        *(u32x4*)dst = w;
                    }
                } else {
                    const f32x4 a0 = acc[ai][0][m][0], a1 = acc[ai][0][m][1], b0 = acc[ai][1][m][0], b1 = acc[ai][1][m][1];
                    u32x4 w; w.x = cvt_pk_bf16(a0[0] * b0[0], a0[1] * b0[1]); w.y = cvt_pk_bf16(a0[2] * b0[2], a0[3] * b0[3]);
                    w.z = cvt_pk_bf16(a1[0] * b1[0], a1[1] * b1[1]); w.w = cvt_pk_bf16(a1[2] * b1[2], a1[3] * b1[3]);
                    const int col = (pn - 8) * 128 + wc * 32 + 8 * fq;
                    *(u32x4*)(U + (size_t)row * 512 + col) = w;
                }
            }
        if (pn == 2 || pn == 3) {
            const int b = ctx ? (u.pm - 256) : (u.pm >> 3);
#pragma unroll
            for (int bj = 0; bj < 2; ++bj) { float v = km[bj];
#pragma unroll
                for (int d = 1; d < 16; d <<= 1) v = fmaxf(v, __shfl_xor(v, d));
                if (fr == 0 && fq == 0) atomicMax(kmaxh + ((b * 8 + (pn & 1) * 4 + bj * 2 + (wc >> 1)) * 2 + (wc & 1)), __float_as_uint(v)); }
        }
    }
};

struct EpiGU {
    static constexpr bool PERM = true, AFTER_DRAIN = false;
    bf16_t* H;
    __device__ __forceinline__ float silu(float x) const { return x * __builtin_amdgcn_rcpf(1.f + __expf(-x)); }
    __device__ __forceinline__ void operator()(const f32x4 (&acc)[2][2][4][2], const Unit& u, int wr, int wc, int fr, int fq) const {
#pragma unroll
        for (int ai = 0; ai < 2; ++ai)
#pragma unroll
            for (int m = 0; m < 4; ++m) {
                const int row = ai * HALF + wr * 64 + m * 16 + fr;
                const f32x4 a0 = acc[ai][0][m][0], a1 = acc[ai][0][m][1], b0 = acc[ai][1][m][0], b1 = acc[ai][1][m][1];
                u32x4 w; w.x = cvt_pk_bf16(silu(a0[0]) * b0[0], silu(a0[1]) * b0[1]); w.y = cvt_pk_bf16(silu(a0[2]) * b0[2], silu(a0[3]) * b0[3]);
                w.z = cvt_pk_bf16(silu(a1[0]) * b1[0], silu(a1[1]) * b1[1]); w.w = cvt_pk_bf16(silu(a1[2]) * b1[2], silu(a1[3]) * b1[3]);
                *(u32x4*)(H + (size_t)row * 1024 + u.pn * 128 + wc * 32 + 8 * fq) = w;
            }
    }
};
__device__ __forceinline__ unsigned pk4_fp8(float a, float b, float c, float d) { int w = 0; w = __builtin_amdgcn_cvt_pk_fp8_f32(a, b, w, false); w = __builtin_amdgcn_cvt_pk_fp8_f32(c, d, w, true); return (unsigned)w; }
constexpr float F8_ACT = 4.0f, F8_WGT = 64.0f, F8_INV = 1.0f / (4.0f * 64.0f);
struct EpiGU8 {
    static constexpr bool PERM = true, AFTER_DRAIN = false;
    unsigned char* H;
    __device__ __forceinline__ float hval(float g, float u) const {
        const float e = __builtin_amdgcn_exp2f(g * (-F8_INV * 1.4426950408889634f));
        const float r = __builtin_amdgcn_rcpf(1.f + e);
        return __builtin_amdgcn_fmed3f((g * u) * (r * (F8_INV * F8_INV * F8_ACT)), -448.f, 448.f); }
    __device__ __forceinline__ void row(const f32x4 (&acc)[2][2][4][2], const Unit& u, int ai, int m, int wr, int wc, int fr, int fq) const {
        unsigned off = (unsigned)((ai * HALF + wr * 64 + m * 16 + fr) * 1024 + u.pn * 128 + wc * 32 + 8 * fq);
        asm volatile("" : "+v"(off));
        const f32x4 a0 = acc[ai][0][m][0], a1 = acc[ai][0][m][1], b0 = acc[ai][1][m][0], b1 = acc[ai][1][m][1];
        u32x2 w; w.x = pk4_fp8(hval(a0[0], b0[0]), hval(a0[1], b0[1]), hval(a0[2], b0[2]), hval(a0[3], b0[3]));
        w.y = pk4_fp8(hval(a1[0], b1[0]), hval(a1[1], b1[1]), hval(a1[2], b1[2]), hval(a1[3], b1[3]));
        *(u32x2*)(H + off) = w;
    }
    __device__ __forceinline__ void operator()(const f32x4 (&acc)[2][2][4][2], const Unit& u, int wr, int wc, int fr, int fq) const {
#pragma unroll
        for (int ai = 0; ai < 2; ++ai)
#pragma unroll
            for (int m = 0; m < 4; ++m) row(acc, u, ai, m, wr, wc, fr, fq);
    }
};
struct EpiDown {
    static constexpr bool PERM = true, AFTER_DRAIN = false;
    bf16_t* Y; const float* gate; float scale;
    __device__ __forceinline__ void operator()(const f32x4 (&acc)[2][2][4][2], const Unit& u, int wr, int wc, int fr, int fq) const {
        asm volatile("" : "+v"(fr));
#pragma unroll
        for (int ai = 0; ai < 2; ++ai)
#pragma unroll
            for (int m = 0; m < 4; ++m) {
                const int row = ai * HALF + wr * 64 + m * 16 + fr; const float g = gate[row] * scale;
#pragma unroll
                for (int bj = 0; bj < 2; ++bj) { const f32x4 v0 = acc[ai][bj][m][0] * g, v1 = acc[ai][bj][m][1] * g;
                    u32x4 w; w.x = cvt_pk_bf16(v0[0], v0[1]); w.y = cvt_pk_bf16(v0[2], v0[3]); w.z = cvt_pk_bf16(v1[0], v1[1]); w.w = cvt_pk_bf16(v1[2], v1[3]);
                    *(u32x4*)(Y + (size_t)row * 1024 + u.pn * BM + bj * HALF + wc * 32 + 8 * fq) = w; }
            }
    }
};

constexpr float F8_Y = 64.0f;
struct EpiDown8 {
    static constexpr bool PERM = true, AFTER_DRAIN = false;
    unsigned char* Y; const LAS float* gl;
    __device__ __forceinline__ void row(const f32x4 (&acc)[2][2][4][2], const Unit& u, int ai, int m, int wr, int wc, int fr, int fq) const {
        unsigned off = (unsigned)((ai * HALF + wr * 64 + m * 16 + fr) * 1024 + u.pn * BM + wc * 32 + 8 * fq);
        asm volatile("" : "+v"(off));
        const float g = gl[ai * HALF + wr * 64 + m * 16 + fr];
#pragma unroll
        for (int bj = 0; bj < 2; ++bj) { f32x4 v0 = acc[ai][bj][m][0] * g, v1 = acc[ai][bj][m][1] * g;
#pragma unroll
            for (int i = 0; i < 4; ++i) { v0[i] = __builtin_amdgcn_fmed3f(v0[i], -448.f, 448.f); v1[i] = __builtin_amdgcn_fmed3f(v1[i], -448.f, 448.f); }
            u32x2 w; w.x = pk4_fp8(v0[0], v0[1], v0[2], v0[3]); w.y = pk4_fp8(v1[0], v1[1], v1[2], v1[3]);
            *(u32x2*)(Y + off + bj * HALF) = w; }
    }
    __device__ __forceinline__ void operator()(const f32x4 (&acc)[2][2][4][2], const Unit& u, int wr, int wc, int fr, int fq) const {
#pragma unroll
        for (int ai = 0; ai < 2; ++ai)
#pragma unroll
            for (int m = 0; m < 4; ++m) row(acc, u, ai, m, wr, wc, fr, fq);
    }
};

struct SchedProj {
    int G, c;
    __device__ __forceinline__ bool next(int i, Unit& u) const {
        if (i < 12) { const int x = c & 7, j = c >> 3, ja = j & 7, jb = j >> 3, r = i / 3, q = i - 3 * r;
            u.pm = x + 8 * (8 * r + ja); u.pn = 4 * q + jb; return true; }
        if (i == 12 && c < 128) { u.pm = 256 + (c >> 2); u.pn = 2 + (c & 3); return true; }
        return false;
    }
    __device__ __forceinline__ void a_ready(const Unit&) const {}
    __device__ __forceinline__ void done(const Unit&) const {}
};
struct SchedPanel {
    int pm, ntn;
    __device__ __forceinline__ bool next(int i, Unit& u) const { if (i >= ntn) return false; u.pm = pm; u.pn = i; return true; }
    __device__ __forceinline__ void a_ready(const Unit&) const {}
    __device__ __forceinline__ void done(const Unit&) const {}
};

typedef int i32x4v __attribute__((ext_vector_type(4)));
typedef int i32x8v __attribute__((ext_vector_type(8)));
__device__ __forceinline__ i32x8v cat8(bf16x8 a, bf16x8 b) { const i32x4v x = __builtin_bit_cast(i32x4v, a), y = __builtin_bit_cast(i32x4v, b); return __builtin_shufflevector(x, y, 0, 1, 2, 3, 4, 5, 6, 7); }
template <bool F8> struct Frag;
template <> struct Frag<false> { bf16x8 v[2]; __device__ __forceinline__ void set(bf16x8 a, bf16x8 b) { v[0] = a; v[1] = b; } };
template <> struct Frag<true> { i32x8v v; __device__ __forceinline__ void set(bf16x8 a, bf16x8 b) { v = cat8(a, b); } };
__device__ __forceinline__ f32x4 frag_mma(const Frag<false>& b, const Frag<false>& a, f32x4 c) { c = __builtin_amdgcn_mfma_f32_16x16x32_bf16(b.v[0], a.v[0], c, 0, 0, 0); return __builtin_amdgcn_mfma_f32_16x16x32_bf16(b.v[1], a.v[1], c, 0, 0, 0); }
__device__ __forceinline__ f32x4 frag_mma(const Frag<true>& b, const Frag<true>& a, f32x4 c) {
    const int sc1 = 0x7f7f7f7f;
    asm volatile("s_nop 1\n\tv_mfma_scale_f32_16x16x128_f8f6f4 %0, %1, %2, %0, %3, %3 op_sel_hi:[0,0,0]" : "+v"(c) : "v"(b.v), "v"(a.v), "v"(sc1));
    return c; }
template <class Epi, class Sched, bool ALIGN_EPI, bool SP2, bool GATHER = false, bool F8 = false, bool DEFER = false>
__device__ __forceinline__ void gemm_phase(LAS unsigned char* lds, const Gemm g, const Sched& S, const Epi& E) {
    const int tid = opaque_tid(), wid = __builtin_amdgcn_readfirstlane(tid >> 6), lane = tid & 63, wr = wid >> 2, wc = wid & 3, fr = lane & 15, fq = lane >> 4;
    const int K = g.K * (F8 ? 1 : 2), nt = K / 128;
    unsigned voffA[2][2], voffB[2];
#pragma unroll
    for (int i = 0; i < 2; ++i) { int R, C; stage_rc(tid * 16 + i * 8192, R, C); const int Rb = Epi::PERM ? ((R & ~31) + perm32(R & 31)) : R;
        if constexpr (GATHER) { voffA[0][i] = (unsigned)(g.gidx[R] * K + C * 2); voffA[1][i] = (unsigned)(g.gidx[HALF + R] * K + C * 2); }
        else { voffA[0][i] = (unsigned)(R * K + C * 2); voffA[1][i] = voffA[0][i]; }
        voffB[i] = (unsigned)(Rb * K + C * 2); }
    const size_t kstep = (size_t)(BK * 2);
    const size_t hstep = (size_t)HALF * K;
    const size_t hstepA = GATHER ? (size_t)0 : hstep;
    const size_t tstep = 2 * hstep;
    const unsigned ldsw = (unsigned)wid * 1024u;
    const int aoff = F8 ? lds_byte(wr * 64 + fr, (fq >> 1) * 32 + (fq & 1) * 16) : lds_byte(wr * 64 + fr, fq * 8), boff = F8 ? lds_byte(wc * 32 + fr, (fq >> 1) * 32 + (fq & 1) * 16) : lds_byte(wc * 32 + fr, fq * 8);
    const int aoff1 = F8 ? aoff + 16 : aoff + 1024, boff1 = F8 ? boff + 16 : boff + 1024;
#define PG8_SA(b, h) (((b) * 2 + (h)) * HTB)
#define PG8_SB(b, h) ((4 + (b) * 2 + (h)) * HTB)
#define PG8_STAGE(bufoff, gbase, voff) do { _Pragma("unroll") for (int _i = 0; _i < 2; ++_i) \
        __builtin_amdgcn_global_load_lds((const unsigned*)((const char*)(gbase) + (voff)[_i]), (LAS unsigned*)(lds + (bufoff) + ldsw + _i * 8192), 16, 0, 0); } while (0)
#define PG8_LDA(dst, b, h) do { _Pragma("unroll") for (int m = 0; m < 4; ++m) dst[m].set(*(const LAS bf16x8*)(lds + PG8_SA(b, h) + aoff + m * 2048), *(const LAS bf16x8*)(lds + PG8_SA(b, h) + aoff1 + m * 2048)); } while (0)
#define PG8_LDB(dst, b, h) do { _Pragma("unroll") for (int n = 0; n < 2; ++n) dst[n].set(*(const LAS bf16x8*)(lds + PG8_SB(b, h) + boff + n * 2048), *(const LAS bf16x8*)(lds + PG8_SB(b, h) + boff1 + n * 2048)); } while (0)
#define PG8_MMA(ai, bj, At, Bt) do { __builtin_amdgcn_s_setprio(1); _Pragma("unroll") for (int m = 0; m < 4; ++m) _Pragma("unroll") for (int n = 0; n < 2; ++n) \
        acc[ai][bj][m][n] = frag_mma(Bt[n], At[m], acc[ai][bj][m][n]); __builtin_amdgcn_s_setprio(0); } while (0)
#define PG8_MMA_E(ai, At, Bt) do { __builtin_amdgcn_s_setprio(1); _Pragma("unroll") for (int m = 0; m < 4; ++m) { \
        if constexpr (DEFER) { if (defer_now) { E.row(acc, pu, ai, m, wr, wc, fr, fq); \
            _Pragma("unroll") for (int n = 0; n < 2; ++n) { acc[ai][0][m][n] = (f32x4){0.f, 0.f, 0.f, 0.f}; acc[ai][1][m][n] = (f32x4){0.f, 0.f, 0.f, 0.f}; } } PG8_SCHED; } \
        _Pragma("unroll") for (int n = 0; n < 2; ++n) acc[ai][0][m][n] = frag_mma(Bt[n], At[m], acc[ai][0][m][n]); } __builtin_amdgcn_s_setprio(0); } while (0)
#define PG8_WAIT_V(n) asm volatile("s_waitcnt vmcnt(" #n ")" ::: "memory")
#define PG8_WAIT_L(n) asm volatile("s_waitcnt lgkmcnt(" #n ")" ::: "memory")
#define PG8_BAR __builtin_amdgcn_s_barrier()
#define PG8_SCHED __builtin_amdgcn_sched_barrier(0)
    Unit cur, nxt; int ui = 0;
    if (!S.next(0, cur)) return;
    f32x4 acc[2][2][4][2];
#pragma unroll
    for (int a = 0; a < 2; ++a)
#pragma unroll
        for (int b = 0; b < 2; ++b)
#pragma unroll
            for (int m = 0; m < 4; ++m)
#pragma unroll
                for (int n = 0; n < 2; ++n) acc[a][b][m][n] = (f32x4){0.f, 0.f, 0.f, 0.f};
    Frag<F8> At[4], B0[2], B1[2];
    bool pend = false; Unit pu = cur;
    const char* cA = (const char*)g.A + (size_t)cur.pm * tstep; const char* cB = (const char*)g.Bt + (size_t)cur.pn * tstep;
    S.a_ready(cur);
    if constexpr (SP2) {
        PG8_STAGE(PG8_SB(0, 0), cB, voffB); PG8_STAGE(PG8_SB(0, 1), cB + hstep, voffB); PG8_STAGE(PG8_SA(0, 0), cA, voffA[0]); PG8_STAGE(PG8_SA(0, 1), cA + hstepA, voffA[GATHER ? 1 : 0]);
        if (wr == 1) PG8_BAR;
        PG8_WAIT_V(2); PG8_BAR;
        PG8_STAGE(PG8_SB(1, 0), cB + kstep, voffB); PG8_STAGE(PG8_SA(1, 0), cA + kstep, voffA[0]); PG8_STAGE(PG8_SB(1, 1), cB + hstep + kstep, voffB);
        PG8_WAIT_V(6); PG8_BAR;
    } else {
        PG8_STAGE(PG8_SB(0, 0), cB, voffB); PG8_STAGE(PG8_SA(0, 0), cA, voffA[0]); PG8_STAGE(PG8_SB(0, 1), cB + hstep, voffB); PG8_STAGE(PG8_SA(0, 1), cA + hstepA, voffA[GATHER ? 1 : 0]);
        if (wr == 1) PG8_BAR;
        PG8_WAIT_V(4); PG8_BAR;
        PG8_STAGE(PG8_SB(1, 0), cB + kstep, voffB); PG8_STAGE(PG8_SA(1, 0), cA + kstep, voffA[0]); PG8_STAGE(PG8_SB(1, 1), cB + hstep + kstep, voffB);
        PG8_WAIT_V(6); PG8_BAR;
    }
    for (;;) {
        const bool has_next = S.next(ui + 1, nxt);
        const char* nA = has_next ? (const char*)g.A + (size_t)nxt.pm * tstep : cA; const char* nB = has_next ? (const char*)g.Bt + (size_t)nxt.pn * tstep : cB;
#pragma unroll 1
        for (int t = 0; t < nt; t += 2) {
            const bool last = (t == nt - 2);
            if constexpr (F8) { asm volatile("" : "+v"(voffA[0][0]), "+v"(voffA[0][1]), "+v"(voffB[0]), "+v"(voffB[1])); if constexpr (GATHER) asm volatile("" : "+v"(voffA[1][0]), "+v"(voffA[1][1])); }
            const char* a1 = cA + (size_t)(t + 1) * kstep;
            const char* a2 = last ? nA : cA + (size_t)(t + 2) * kstep; const char* b2 = last ? nB : cB + (size_t)(t + 2) * kstep;
            const char* a3 = a2 + kstep; const char* b3 = b2 + kstep;
            if (last && has_next) S.a_ready(nxt);
            if constexpr (SP2) {
            PG8_LDB(B0, 0, 0); PG8_LDB(B1, 0, 1); PG8_SCHED; PG8_LDA(At, 0, 0); PG8_STAGE(PG8_SA(1, 1), a1 + hstepA, voffA[GATHER ? 1 : 0]);
            bool defer_now = false; if constexpr (DEFER) defer_now = pend && t == 0;
            PG8_WAIT_V(8); PG8_WAIT_L(0); PG8_BAR; PG8_MMA_E(0, At, B0); PG8_MMA(0, 1, At, B1); PG8_BAR; PG8_SCHED;
            PG8_LDA(At, 0, 1); PG8_STAGE(PG8_SB(0, 0), b2, voffB); PG8_STAGE(PG8_SB(0, 1), b2 + hstep, voffB); PG8_STAGE(PG8_SA(0, 0), a2, voffA[0]);
            PG8_WAIT_V(8); PG8_WAIT_L(0); PG8_BAR; PG8_MMA_E(1, At, B0); PG8_MMA(1, 1, At, B1); PG8_BAR; PG8_SCHED;
            PG8_LDB(B0, 1, 0); PG8_LDB(B1, 1, 1); PG8_SCHED; PG8_LDA(At, 1, 0); PG8_STAGE(PG8_SA(0, 1), a2 + hstepA, voffA[GATHER ? 1 : 0]);
            PG8_WAIT_V(8); PG8_WAIT_L(0); PG8_BAR; PG8_MMA(0, 0, At, B0); PG8_MMA(0, 1, At, B1); PG8_BAR; PG8_SCHED;
            PG8_LDA(At, 1, 1); PG8_STAGE(PG8_SB(1, 0), b3, voffB); PG8_STAGE(PG8_SB(1, 1), b3 + hstep, voffB); PG8_STAGE(PG8_SA(1, 0), a3, voffA[0]);
            PG8_WAIT_V(8); PG8_WAIT_L(0); PG8_BAR; PG8_MMA(1, 0, At, B0); PG8_MMA(1, 1, At, B1); PG8_BAR; PG8_SCHED;
            } else {
            PG8_LDB(B0, 0, 0); PG8_SCHED; PG8_LDA(At, 0, 0); PG8_STAGE(PG8_SA(1, 1), a1 + hstepA, voffA[GATHER ? 1 : 0]);
            PG8_WAIT_L(8); PG8_BAR; PG8_WAIT_L(0); PG8_MMA(0, 0, At, B0); PG8_BAR; PG8_SCHED;
            PG8_LDB(B1, 0, 1); PG8_STAGE(PG8_SB(0, 0), b2, voffB);
            PG8_BAR; PG8_WAIT_L(0); PG8_MMA(0, 1, At, B1); PG8_BAR;
            PG8_LDA(At, 0, 1); PG8_STAGE(PG8_SA(0, 0), a2, voffA[0]);
            PG8_BAR; PG8_WAIT_L(0); PG8_MMA(1, 0, At, B0); PG8_BAR; PG8_SCHED;
            PG8_STAGE(PG8_SB(0, 1), b2 + hstep, voffB);
            PG8_WAIT_V(6); PG8_BAR; PG8_MMA(1, 1, At, B1); PG8_BAR;
            PG8_LDB(B0, 1, 0); PG8_SCHED; PG8_LDA(At, 1, 0); PG8_STAGE(PG8_SA(0, 1), a2 + hstepA, voffA[GATHER ? 1 : 0]);
            PG8_WAIT_L(8); PG8_BAR; PG8_WAIT_L(0); PG8_MMA(0, 0, At, B0); PG8_BAR; PG8_SCHED;
            PG8_LDB(B1, 1, 1); PG8_STAGE(PG8_SB(1, 0), b3, voffB);
            PG8_BAR; PG8_WAIT_L(0); PG8_MMA(0, 1, At, B1); PG8_BAR;
            PG8_LDA(At, 1, 1); PG8_STAGE(PG8_SA(1, 0), a3, voffA[0]);
            PG8_BAR; PG8_WAIT_L(0); PG8_MMA(1, 0, At, B0); PG8_BAR; PG8_SCHED;
            PG8_STAGE(PG8_SB(1, 1), b3 + hstep, voffB);
            PG8_WAIT_V(6); PG8_BAR; PG8_MMA(1, 1, At, B1); PG8_BAR;
            }
        }
        if (DEFER && has_next) { pend = true; pu = cur; cur = nxt; cA = nA; cB = nB; ++ui; continue; }
        if constexpr (ALIGN_EPI) { if (wr == 0) PG8_BAR; }
        if constexpr (F8) asm volatile("s_nop 15\n\ts_nop 7" ::: "memory");
        E(acc, cur, wr, wc, fr, fq); S.done(cur);
        if (!has_next) break;
#pragma unroll
        for (int a = 0; a < 2; ++a)
#pragma unroll
            for (int b = 0; b < 2; ++b)
#pragma unroll
                for (int m = 0; m < 4; ++m)
#pragma unroll
                    for (int n = 0; n < 2; ++n) acc[a][b][m][n] = (f32x4){0.f, 0.f, 0.f, 0.f};
        cur = nxt; cA = nA; cB = nB; ++ui;
        if constexpr (ALIGN_EPI) { if (wr == 1) PG8_BAR; }
    }
    PG8_WAIT_V(0);
    if constexpr (!ALIGN_EPI) { if (wr == 0) PG8_BAR; }
    PG8_BAR;
#undef PG8_SA
#undef PG8_SB
#undef PG8_STAGE
#undef PG8_LDA
#undef PG8_LDB
#undef PG8_MMA
#undef PG8_WAIT_V
#undef PG8_WAIT_L
#undef PG8_BAR
#undef PG8_SCHED
}
}

typedef GAS unsigned gu32;
#define RLX_AGENT __ATOMIC_RELAXED, __HIP_MEMORY_SCOPE_AGENT
#define LDS_WAIT() asm volatile("s_waitcnt lgkmcnt(0)" ::: "memory")
#define VM_WAIT() asm volatile("s_waitcnt vmcnt(0)" ::: "memory")
__device__ __forceinline__ unsigned pk2(float lo, float hi) { return pg8::cvt_pk_bf16(lo, hi); }
__device__ __forceinline__ float bf2f(unsigned short h) { return __uint_as_float((unsigned)h << 16); }
__device__ __forceinline__ float bflo(unsigned w) { return __uint_as_float(w << 16); }
__device__ __forceinline__ float bfhi(unsigned w) { return __uint_as_float(w & 0xffff0000u); }
__device__ __forceinline__ float wave_sum(float v) {
    v += __builtin_bit_cast(float, __builtin_amdgcn_update_dpp(0, __builtin_bit_cast(int, v), 0xB1, 0xf, 0xf, true));
    v += __builtin_bit_cast(float, __builtin_amdgcn_update_dpp(0, __builtin_bit_cast(int, v), 0x4E, 0xf, 0xf, true));
    v += __builtin_bit_cast(float, __builtin_amdgcn_update_dpp(0, __builtin_bit_cast(int, v), 0x141, 0xf, 0xf, true));
    v += __builtin_bit_cast(float, __builtin_amdgcn_update_dpp(0, __builtin_bit_cast(int, v), 0x140, 0xf, 0xf, true));
    v += __builtin_bit_cast(float, __builtin_amdgcn_update_dpp(0, __builtin_bit_cast(int, v), 0x142, 0xa, 0xf, false));
    v += __builtin_bit_cast(float, __builtin_amdgcn_update_dpp(0, __builtin_bit_cast(int, v), 0x143, 0xc, 0xf, false));
    return __builtin_bit_cast(float, __builtin_amdgcn_readlane(__builtin_bit_cast(int, v), 63));
}

#define XB_TMO      128
#define XB_XCNT(j)  (256  + 64 * (j))
#define XB_XSUB(j)  (1280 + 64 * (j))
#define XB_XGEN(j)  (2304 + 64 * (j))
#define XB_TOP      3328
#define XB_TOPGEN   3392
#define XCD_BAR_WORDS 3456
#define XB_SPIN_CAP (1u << 18)
__device__ __forceinline__ unsigned xb_ld(unsigned* p)              { return __hip_atomic_load(p, __ATOMIC_RELAXED, __HIP_MEMORY_SCOPE_AGENT); }
__device__ __forceinline__ unsigned xb_add(unsigned* p, unsigned v) { return __hip_atomic_fetch_add(p, v, __ATOMIC_RELAXED, __HIP_MEMORY_SCOPE_AGENT); }
__device__ __forceinline__ unsigned xb_xcc_id() { return (unsigned)__builtin_amdgcn_s_getreg((3 << 11) | 20) & 0xFu; }
#define XB_SPIN(cond, bar) do { unsigned _sp = 0; while (cond) { __builtin_amdgcn_s_sleep(1); \
    if ((++_sp & 255u) == 0u) { if (xb_ld(&(bar)[XB_TMO])) break; if (_sp > XB_SPIN_CAP) { atomicAdd(&(bar)[XB_TMO], 1u); break; } } } } while (0)
struct XcdBarrier { unsigned* bar; unsigned x; volatile LAS unsigned* st; };
__device__ __forceinline__ XcdBarrier xcd_barrier_post(unsigned* bar, volatile LAS unsigned* st) {
    XcdBarrier b; b.bar = bar; b.x = xb_xcc_id(); b.st = st;
    if (threadIdx.x == 0) (void)xb_add(&bar[XB_XCNT(b.x)], 1u);
    return b;
}
__device__ __forceinline__ void xcd_barrier_complete(unsigned* bar, unsigned x, unsigned& nloc, unsigned& nx) {
    const unsigned G = gridDim.x * gridDim.y * gridDim.z;
    unsigned sum, cnt, mine, sp = 0u;
    for (;;) {
        sum = 0u; cnt = 0u; mine = 0u;
#pragma unroll
        for (unsigned j = 0; j < 16; ++j) { const unsigned c = xb_ld(&bar[XB_XCNT(j)]); sum += c; cnt += (c > 0u) ? 1u : 0u; mine = (j == x) ? c : mine; }
        if (sum == G) break;
        __builtin_amdgcn_s_sleep(1);
        if ((++sp & 255u) == 0u) { if (xb_ld(&bar[XB_TMO])) break; if (sp > XB_SPIN_CAP) { atomicAdd(&bar[XB_TMO], 1u); break; } }
    }
    nloc = mine > 0u ? mine : 1u; nx = cnt > 0u ? cnt : 1u;
}
__device__ __forceinline__ void xcd_barrier(const XcdBarrier& b) {
    asm volatile("s_waitcnt vmcnt(0)" ::: "memory");
    __syncthreads();
    if (threadIdx.x == 0) {
        unsigned* bar = b.bar;
        __builtin_amdgcn_s_waitcnt(0);
        unsigned nloc = b.st[0], nx = b.st[1];
        if (nloc == 0u) { xcd_barrier_complete(bar, b.x, nloc, nx); b.st[0] = nloc; b.st[1] = nx; }
        const unsigned old = xb_add(&bar[XB_XSUB(b.x)], 1u);
        const unsigned gen = old / nloc;
        if (old + 1u == (gen + 1u) * nloc) {
            __builtin_amdgcn_fence(__ATOMIC_RELEASE, "agent");
            asm volatile("s_waitcnt vmcnt(0)" ::: "memory");
            const unsigned og = xb_add(&bar[XB_TOP], 1u);
            const unsigned tg = og / nx;
            if (og + 1u == (tg + 1u) * nx) xb_add(&bar[XB_TOPGEN], 1u);
            else XB_SPIN(xb_ld(&bar[XB_TOPGEN]) == tg, bar);
            __builtin_amdgcn_fence(__ATOMIC_ACQUIRE, "agent");
            xb_add(&bar[XB_XGEN(b.x)], 1u);
            asm volatile("s_waitcnt vmcnt(0)" ::: "memory");
        } else {
            XB_SPIN(xb_ld(&bar[XB_XGEN(b.x)]) == gen, bar);
            __builtin_amdgcn_fence(__ATOMIC_ACQUIRE, "agent");
            asm volatile("s_waitcnt vmcnt(0)" ::: "memory");
        }
    }
    __syncthreads();
}

constexpr int RING_BYTES = 131072;
constexpr int LDSCTL_OFF = RING_BYTES, MISC_OFF = LDSCTL_OFF + 320;
constexpr int LDS_BYTES = 147456;
constexpr int CW_BAR = 4096;
constexpr int CW_KMAX = 65536;

struct Args { const float* in[22]; float* out; unsigned char* ws; int ph_lo, ph_hi; };
enum { I_X = 0, I_C, I_CTX, I_CCTX, I_WADA, I_BADA, I_NPRE_MIX, I_NPOST_MIX, I_NPRE_FFN, I_NPOST_FFN, I_WIN, I_CONVW, I_LQ1, I_LK1, I_LQ2, I_LK2, I_SUBLN, I_WOUT, I_WROUTER, I_WGATE, I_WUP, I_WDOWN };

__device__ __forceinline__ int win_dest(int n) {
    if (n < 1024) { const int j = n & 63; const int p = ((j >> 5) << 5) + ((j & 15) << 1) + ((j >> 4) & 1); return (n & ~63) + p; }
    if (n < 1536) { const int dv = n & 127; return (n & ~127) + ((dv & 3) << 5) + (dv >> 2); }
    if (n < 2048) return n;
    int c = n - 2048; const int isx = c >= 512; c &= 511; return 2048 + ((c >> 7) << 8) + (isx << 7) + (c & 127);
}
template <int MODE>
__device__ __forceinline__ int tr_dest(int n) {
    if (MODE == 0) return n;
    if (MODE == 1) return win_dest(n);
    if (MODE == 2) return ((n >> 7) << 8) + (n & 127);
    return ((n >> 7) << 8) + 128 + (n & 127);
}
template <int MODE>
__device__ __forceinline__ void p0_transpose_item_f8(const float* W, int K, int N, unsigned char* WT, LAS float* scr, int item, int lane) {
    const int nblk = N / 32, kb = item / nblk, nb = item % nblk, k0 = 64 * kb, n0 = 32 * nb;
#pragma unroll 8
    for (int i = 0; i < 32; ++i) { const int kk = 2 * i + (lane >> 5); scr[kk * 33 + (lane & 31)] = __builtin_nontemporal_load(W + (size_t)(k0 + kk) * N + n0 + (lane & 31)) * pg8::F8_WGT; }
    LDS_WAIT(); asm volatile("" ::: "memory");
    const int c = lane & 7;
#pragma unroll
    for (int j = 0; j < 4; ++j) { const int n = (lane >> 3) + 8 * j; const LAS float* s = scr + (8 * c) * 33 + n;
        u32x2 o; o.x = pg8::pk4_fp8(s[0 * 33], s[1 * 33], s[2 * 33], s[3 * 33]); o.y = pg8::pk4_fp8(s[4 * 33], s[5 * 33], s[6 * 33], s[7 * 33]);
        *(GAS u32x2*)(WT + (size_t)tr_dest<MODE>(n0 + n) * K + k0 + 8 * c) = o; }
    LDS_WAIT(); asm volatile("" ::: "memory");
}
template <int MODE>
__device__ __forceinline__ void p0_transpose_item(const float* W, int K, int N, bf16_t* WT, LAS float* scr, int item, int lane) {
    const int nblk = N / 32, kb = item / nblk, nb = item % nblk, k0 = 64 * kb, n0 = 32 * nb;
#pragma unroll 8
    for (int i = 0; i < 32; ++i) { const int kk = 2 * i + (lane >> 5); scr[kk * 33 + (lane & 31)] = W[(size_t)(k0 + kk) * N + n0 + (lane & 31)]; }
    LDS_WAIT(); asm volatile("" ::: "memory");
    const int c = lane & 7;
#pragma unroll
    for (int j = 0; j < 4; ++j) { const int n = (lane >> 3) + 8 * j; const LAS float* s = scr + (8 * c) * 33 + n;
        u32x4 o; o.x = pk2(s[0 * 33], s[1 * 33]); o.y = pk2(s[2 * 33], s[3 * 33]); o.z = pk2(s[4 * 33], s[5 * 33]); o.w = pk2(s[6 * 33], s[7 * 33]);
        *(GAS u32x4*)(WT + (size_t)tr_dest<MODE>(n0 + n) * K + k0 + 8 * c) = o; }
    LDS_WAIT(); asm volatile("" ::: "memory");
}

__device__ __forceinline__ void p0_prologue(const Args& a, LAS unsigned char* lds, int vcu, int G) {
    const int tid = opaque_tid(), lane = tid & 63, wave = __builtin_amdgcn_readfirstlane(tid >> 6);
    LAS float* scr = (LAS float*)(lds + wave * 16384);
    const int gw = vcu * NWAVES + wave, NGW = G * NWAVES;
    unsigned char* ws = a.ws;
    if (gw < 96 * 16) {
        float* MODP = (float*)(ws + WS_MODP);
        const float* wada = a.in[I_WADA];
        for (int it = gw; it < 96 * 16; it += NGW) {
            const int cg = it % 96, kc = it / 96;
            for (int b = 0; b < 33; ++b) { const float v = (b < 32) ? a.in[I_C][b * D + kc * 64 + lane] : a.in[I_CCTX][kc * 64 + lane]; scr[b * 64 + lane] = v / (1.f + __expf(-v)); }
            LDS_WAIT(); asm volatile("" ::: "memory");
            float acc[33];
#pragma unroll
            for (int b = 0; b < 33; ++b) acc[b] = 0.f;
            const float* wp = wada + (size_t)(kc * 64) * NMOD + cg * 64 + lane;
#pragma unroll 2
            for (int k = 0; k < 64; k += 4) {
                const float w0 = __builtin_nontemporal_load(wp + (size_t)(k + 0) * NMOD), w1 = __builtin_nontemporal_load(wp + (size_t)(k + 1) * NMOD),
                            w2 = __builtin_nontemporal_load(wp + (size_t)(k + 2) * NMOD), w3 = __builtin_nontemporal_load(wp + (size_t)(k + 3) * NMOD);
#pragma unroll
                for (int b = 0; b < 33; ++b) { const f32x4 sv4 = *(const LAS f32x4*)(scr + b * 64 + k); acc[b] += (sv4.x * w0 + sv4.y * w1) + (sv4.z * w2 + sv4.w * w3); }
            }
#pragma unroll
            for (int b = 0; b < 33; ++b) MODP[((size_t)kc * 33 + b) * NMOD + cg * 64 + lane] = acc[b];
            LDS_WAIT(); asm volatile("" ::: "memory");
        }
    } else {
        float* tab = (float*)(ws + WS_TAB);
        const int nw = NGW - 96 * 16;
        for (int e = (gw - 96 * 16) * 64 + lane; e < T * 32; e += nw * 64) {
            const int t = e >> 5, i = e & 31;
            const float inv = powf(10000.0f, -(float)(2 * (i & 15)) / 32.0f);
            const float pos = (i < 16) ? (float)(t >> 6) : (float)(t & 63);
            const float ang = pos * inv;
            tab[2 * e] = cosf(ang); tab[2 * e + 1] = sinf(ang);
        }
    }
}
__device__ __forceinline__ void inout_weight_copies(const Args& a, LAS unsigned char* lds, int vcu, int G) {
    const int tid = opaque_tid(), lane = tid & 63, wave = __builtin_amdgcn_readfirstlane(tid >> 6);
    LAS float* scr = (LAS float*)(lds + 16384 + wave * 12288);
    const int gw = vcu * NWAVES + wave, NGW = G * NWAVES;
    unsigned char* ws = a.ws;
    constexpr int I_IN = (D / 64) * (NPROJ / 32), I_OUT = (D / 64) * (D / 32);
    constexpr int NITEMS = I_IN + I_OUT;
    bf16_t* Win_t = (bf16_t*)(ws + WS_WIN); bf16_t* Wout_t = (bf16_t*)(ws + WS_WOUT);
    for (int it = gw; it < NITEMS; it += NGW) {
        int r = it;
        if (r < I_IN) { p0_transpose_item<1>(a.in[I_WIN], D, NPROJ, Win_t, scr, r, lane); continue; } r -= I_IN;
        p0_transpose_item<0>(a.in[I_WOUT], D, D, Wout_t, scr, r, lane);
    }
}
__device__ __forceinline__ void expert_weight_copies(const Args& a, LAS unsigned char* lds, int gw0  , int ngroups, int r_lo, int r_hi) {
    const int tid = opaque_tid(), lane = tid & 63, wave = __builtin_amdgcn_readfirstlane(tid >> 6);
    LAS float* scr = (LAS float*)(lds + wave * 16384);
    const int gw = gw0 * NWAVES + wave, NGW = ngroups * NWAVES;
    unsigned char* ws = a.ws;
    constexpr int I_EXP = (D / 64) * (D / 32);
    unsigned char* Wgu_t = ws + WS_WGU; unsigned char* Wdn_t = ws + WS_WDN;
    for (int r = r_lo + gw; r < r_hi; r += NGW) {
        const int e = r / (3 * I_EXP), q = (r % (3 * I_EXP)) / I_EXP, rr = r % I_EXP;
        if (q == 0) p0_transpose_item_f8<2>(a.in[I_WGATE] + (size_t)e * D * D, D, D, Wgu_t + (size_t)e * 2048 * D, scr, rr, lane);
        else if (q == 1) p0_transpose_item_f8<3>(a.in[I_WUP] + (size_t)e * D * D, D, D, Wgu_t + (size_t)e * 2048 * D, scr, rr, lane);
        else p0_transpose_item_f8<0>(a.in[I_WDOWN] + (size_t)e * D * D, D, D, Wdn_t + (size_t)e * D * D, scr, rr, lane);
    }
    __syncthreads();
}

struct RowF { f32x4 v[4]; };
__device__ __forceinline__ void row_load(RowF& r, const float* xrow, int lane) {
    const f32x4* xr = (const f32x4*)xrow + lane;
#pragma unroll
    for (int j = 0; j < 4; ++j) r.v[j] = __builtin_nontemporal_load(xr + 64 * j);
}
__device__ __forceinline__ void norm_mod_row(const RowF& r, bf16_t* orow, const f32x4 (&gain)[4], const LAS float* sc, const LAS float* sh, int lane) {
    float s = 0.f;
#pragma unroll
    for (int j = 0; j < 4; ++j) s += (r.v[j].x * r.v[j].x + r.v[j].y * r.v[j].y) + (r.v[j].z * r.v[j].z + r.v[j].w * r.v[j].w);
    const float rstd = 1.0f / sqrtf(wave_sum(s) * (1.f / D) + EPS);
    u32x2* o8 = (u32x2*)orow + lane;
#pragma unroll
    for (int j = 0; j < 4; ++j) { const f32x4 g = gain[j]; const f32x4 c1 = *(const LAS f32x4*)(sc + 4 * lane + 256 * j), h1 = *(const LAS f32x4*)(sh + 4 * lane + 256 * j);
        const f32x4 y = (r.v[j] * rstd) * g; const f32x4 z = y * (c1 + 1.0f) + h1;
        u32x2 w; w.x = pk2(z.x, z.y); w.y = pk2(z.z, z.w); o8[64 * j] = w; }
}
__device__ __forceinline__ void p1_xn(const Args& a, LAS unsigned char* lds, int c, int G) {
    const int tid = opaque_tid(), lane = tid & 63, wave = __builtin_amdgcn_readfirstlane(tid >> 6);
    unsigned char* ws = a.ws;
    const float* MODP = (const float*)(ws + WS_MODP); float* MOD = (float*)(ws + WS_MOD); const float* bada = a.in[I_BADA];
    { const int per = (33 * NMOD + G - 1) / G;
      for (int i = c * per + tid; i < (c + 1) * per && i < 33 * NMOD; i += NTHREADS) { const int r = i / NMOD, n = i - r * NMOD; float s = bada[n];
#pragma unroll
            for (int kc = 0; kc < 16; ++kc) s += MODP[((size_t)kc * 33 + r) * NMOD + n];
            MOD[i] = s; } }
    LAS float* sv = (LAS float*)lds;
    bf16_t* XN = (bf16_t*)(ws + WS_XN);
    const float* X = a.in[I_X]; const float* CTX = a.in[I_CTX];
    f32x4 gain[4];
#pragma unroll
    for (int j = 0; j < 4; ++j) gain[j] = ((const f32x4*)a.in[I_NPRE_MIX])[lane + 64 * j];
    for (int p = c; p < 256; p += G) {
        const int b = p >> 3;
        const int rbase = p * 256 + wave * 32;
        RowF a0, a1, a2, a3;
        row_load(a0, X + (size_t)rbase * D, lane); row_load(a1, X + (size_t)(rbase + 1) * D, lane); row_load(a2, X + (size_t)(rbase + 2) * D, lane); row_load(a3, X + (size_t)(rbase + 3) * D, lane);
        __syncthreads();
        for (int n = tid; n < 4096; n += NTHREADS) { const int r = (n < 2048) ? b : 32; const int col = n & 2047; float s = bada[col];
#pragma unroll
            for (int kc = 0; kc < 16; ++kc) s += MODP[((size_t)kc * 33 + r) * NMOD + col];
            sv[n] = s; }
        __syncthreads();
        const int crow = p * 32 + wave * 4;
        for (int i = 0; i < 8; ++i) {
            RowF n0, n1, n2, n3;
            const float* nx = (i + 1 < 8) ? X + (size_t)(rbase + 4 * (i + 1)) * D : CTX + (size_t)crow * D;
            row_load(n0, nx, lane); row_load(n1, nx + D, lane); row_load(n2, nx + 2 * D, lane); row_load(n3, nx + 3 * D, lane);
            bf16_t* orow = XN + (size_t)(rbase + 4 * i) * D;
            norm_mod_row(a0, orow, gain, sv + 1024, sv, lane);
            norm_mod_row(a1, orow + D, gain, sv + 1024, sv, lane);
            norm_mod_row(a2, orow + 2 * D, gain, sv + 1024, sv, lane);
            norm_mod_row(a3, orow + 3 * D, gain, sv + 1024, sv, lane);
            a0 = n0; a1 = n1; a2 = n2; a3 = n3;
        }
        { bf16_t* orow = XN + (size_t)(M + crow) * D;
          norm_mod_row(a0, orow, gain, sv + 3072, sv + 2048, lane);
          norm_mod_row(a1, orow + D, gain, sv + 3072, sv + 2048, lane);
          norm_mod_row(a2, orow + 2 * D, gain, sv + 3072, sv + 2048, lane);
          norm_mod_row(a3, orow + 3 * D, gain, sv + 3072, sv + 2048, lane); }
    }
}

__device__ __forceinline__ float half_sum32(float v, int hi) {
    v += __builtin_bit_cast(float, __builtin_amdgcn_update_dpp(0, __builtin_bit_cast(int, v), 0xB1, 0xf, 0xf, true));
    v += __builtin_bit_cast(float, __builtin_amdgcn_update_dpp(0, __builtin_bit_cast(int, v), 0x4E, 0xf, 0xf, true));
    v += __builtin_bit_cast(float, __builtin_amdgcn_update_dpp(0, __builtin_bit_cast(int, v), 0x141, 0xf, 0xf, true));
    v += __builtin_bit_cast(float, __builtin_amdgcn_update_dpp(0, __builtin_bit_cast(int, v), 0x140, 0xf, 0xf, true));
    v += __builtin_bit_cast(float, __builtin_amdgcn_update_dpp(0, __builtin_bit_cast(int, v), 0x142, 0xa, 0xf, false));
    const float s0 = __builtin_bit_cast(float, __builtin_amdgcn_readlane(__builtin_bit_cast(int, v), 31)), s1 = __builtin_bit_cast(float, __builtin_amdgcn_readlane(__builtin_bit_cast(int, v), 63));
    return hi ? s1 : s0;
}
namespace att {
constexpr int KP = 272, KBUF = 64 * KP, VBUF = 16384;
constexpr int OFF_K = 0, OFF_V = 2 * KBUF, OFF_WSF = OFF_V + 2 * VBUF, OFF_END = OFF_WSF + NWAVES * 256;
static_assert(OFF_WSF >= 65536 && OFF_END <= RING_BYTES, "attention LDS map");
constexpr int NT = TK / 64;
constexpr float THR = 8.0f;
__device__ __forceinline__ int crow(int r, int hi) { return (r & 3) + 8 * (r >> 2) + 4 * hi; }
__device__ __forceinline__ float max3f(float a, float b, float c) { float r; asm("v_max3_f32 %0, %1, %2, %3" : "=v"(r) : "v"(a), "v"(b), "v"(c)); return r; }
__device__ __forceinline__ float max2f(float a, float b) { float r; asm("v_max_f32_e32 %0, %1, %2" : "=v"(r) : "v"(a), "v"(b)); return r; }
__device__ __forceinline__ s16x4 vtr(const LAS unsigned char* p) { return __builtin_bit_cast(s16x4, __builtin_amdgcn_ds_read_tr16_b64_v4i16((LAS s16x4*)p)); }

#define ATT_BAR() asm volatile("s_waitcnt lgkmcnt(0)\n\ts_barrier" ::: "memory")
#define ATT_SB() __builtin_amdgcn_sched_barrier(0)
#define ATT_KLD(i, KF) KF = *(const LAS bf16x8*)(kb_ + ((i) & 1) * (32 * KP) + ((i) >> 1) * 32)
#define ATT_XSTEP(i, KC, KN) do { if ((i) + 2 < 8) { ATT_KLD((i) + 2, KN); } \
    if ((i) == 0) p0 = __builtin_amdgcn_mfma_f32_32x32x16_bf16(KC, qr[0], negref, 0, 0, 0); \
    else if ((i) == 1) p1 = __builtin_amdgcn_mfma_f32_32x32x16_bf16(KC, qr[0], negref, 0, 0, 0); \
    else if (((i) & 1) == 0) p0 = __builtin_amdgcn_mfma_f32_32x32x16_bf16(KC, qr[(i) >> 1], p0, 0, 0, 0); else p1 = __builtin_amdgcn_mfma_f32_32x32x16_bf16(KC, qr[(i) >> 1], p1, 0, 0, 0); ATT_SB(); } while (0)
#define ATT_X(kcur) do { \
    const LAS unsigned char* kb_ = lds + OFF_K + (kcur) * KBUF + koff; \
    bf16x8 ka_, kb2_, kc_; \
    ATT_KLD(0, ka_); ATT_KLD(1, kb2_); \
    ATT_SB(); \
    ATT_XSTEP(0, ka_, kc_); ATT_XSTEP(1, kb2_, ka_); ATT_XSTEP(2, kc_, kb2_); ATT_XSTEP(3, ka_, kc_); \
    ATT_XSTEP(4, kb2_, ka_); ATT_XSTEP(5, kc_, kb2_); ATT_XSTEP(6, ka_, kc_); ATT_XSTEP(7, kb2_, ka_); \
} while (0)
#define ATT_EXP2(i, PWN) do { \
    const float e0_ = __builtin_amdgcn_exp2f((i) < 8 ? p0[2 * ((i) & 7)] : p1[2 * ((i) & 7)]), e1_ = __builtin_amdgcn_exp2f((i) < 8 ? p0[2 * ((i) & 7) + 1] : p1[2 * ((i) & 7) + 1]); \
    sacc_ += e0_ + e1_; PWN[(i) >> 2][(i) & 3] = pk2(e0_, e1_); asm volatile("" : "+v"(PWN[(i) >> 2]), "+v"(sacc_)); } while (0)
#define ATT_VLD(i, LO, HI) do { LO = vtr(vb_ + ((i) & 3) * 4096 + ((i) >> 2) * 1024); HI = vtr(vb_ + ((i) & 3) * 4096 + ((i) >> 2) * 1024 + 512); } while (0)
#define ATT_VF(LO, HI) ((bf16x8){LO[0], LO[1], LO[2], LO[3], HI[0], HI[1], HI[2], HI[3]})
#define ATT_YSTEP(i, PWC, PWN, LC, HC, LN, HN) do { if ((i) + 2 < 16) { ATT_VLD((i) + 2, LN, HN); } \
    o[(i) & 3] = __builtin_amdgcn_mfma_f32_32x32x16_bf16(__builtin_bit_cast(bf16x8, PWC[(i) >> 2]), ATT_VF(LC, HC), o[(i) & 3], 0, 0, 0); \
    ATT_EXP2(i, PWN); ATT_SB(); } while (0)
#define ATT_Y(vcur, PWC, PWN) do { \
    const LAS unsigned char* vb_ = lds + OFF_V + (vcur) * VBUF + voff; \
    float sacc_ = 0.f; s16x4 la_, ha_, lb_, hb_, lc_, hc_; \
    ATT_VLD(0, la_, ha_); ATT_VLD(1, lb_, hb_); ATT_SB(); \
    ATT_YSTEP(0, PWC, PWN, la_, ha_, lc_, hc_); ATT_YSTEP(1, PWC, PWN, lb_, hb_, la_, ha_); ATT_YSTEP(2, PWC, PWN, lc_, hc_, lb_, hb_); \
    ATT_YSTEP(3, PWC, PWN, la_, ha_, lc_, hc_); ATT_YSTEP(4, PWC, PWN, lb_, hb_, la_, ha_); ATT_YSTEP(5, PWC, PWN, lc_, hc_, lb_, hb_); \
    ATT_YSTEP(6, PWC, PWN, la_, ha_, lc_, hc_); ATT_YSTEP(7, PWC, PWN, lb_, hb_, la_, ha_); ATT_YSTEP(8, PWC, PWN, lc_, hc_, lb_, hb_); \
    ATT_YSTEP(9, PWC, PWN, la_, ha_, lc_, hc_); ATT_YSTEP(10, PWC, PWN, lb_, hb_, la_, ha_); ATT_YSTEP(11, PWC, PWN, lc_, hc_, lb_, hb_); \
    ATT_YSTEP(12, PWC, PWN, la_, ha_, lc_, hc_); ATT_YSTEP(13, PWC, PWN, lb_, hb_, la_, ha_); ATT_YSTEP(14, PWC, PWN, lc_, hc_, lb_, hb_); \
    ATT_YSTEP(15, PWC, PWN, la_, ha_, lc_, hc_); \
    l_reg += sacc_; \
} while (0)
#define ATT_Y0(PWN) do { float sacc_ = 0.f; _Pragma("unroll") for (int i = 0; i < 16; ++i) ATT_EXP2(i, PWN); l_reg += sacc_; } while (0)
#define ATT_ZSTEP(i, PWC, LC, HC, LN, HN) do { if ((i) + 2 < 16) { ATT_VLD((i) + 2, LN, HN); } \
    o[(i) & 3] = __builtin_amdgcn_mfma_f32_32x32x16_bf16(__builtin_bit_cast(bf16x8, PWC[(i) >> 2]), ATT_VF(LC, HC), o[(i) & 3], 0, 0, 0); ATT_SB(); } while (0)
#define ATT_Z(vcur, PWC) do { \
    const LAS unsigned char* vb_ = lds + OFF_V + (vcur) * VBUF + voff; \
    s16x4 la_, ha_, lb_, hb_, lc_, hc_; \
    ATT_VLD(0, la_, ha_); ATT_VLD(1, lb_, hb_); ATT_SB(); \
    ATT_ZSTEP(0, PWC, la_, ha_, lc_, hc_); ATT_ZSTEP(1, PWC, lb_, hb_, la_, ha_); ATT_ZSTEP(2, PWC, lc_, hc_, lb_, hb_); \
    ATT_ZSTEP(3, PWC, la_, ha_, lc_, hc_); ATT_ZSTEP(4, PWC, lb_, hb_, la_, ha_); ATT_ZSTEP(5, PWC, lc_, hc_, lb_, hb_); \
    ATT_ZSTEP(6, PWC, la_, ha_, lc_, hc_); ATT_ZSTEP(7, PWC, lb_, hb_, la_, ha_); ATT_ZSTEP(8, PWC, lc_, hc_, lb_, hb_); \
    ATT_ZSTEP(9, PWC, la_, ha_, lc_, hc_); ATT_ZSTEP(10, PWC, lb_, hb_, la_, ha_); ATT_ZSTEP(11, PWC, lc_, hc_, lb_, hb_); \
    ATT_ZSTEP(12, PWC, la_, ha_, lc_, hc_); ATT_ZSTEP(13, PWC, lb_, hb_, la_, ha_); ATT_ZSTEP(14, PWC, lc_, hc_, lb_, hb_); \
    ATT_ZSTEP(15, PWC, la_, ha_, lc_, hc_); \
} while (0)
#define ATT_STAGE(j) do { \
    if ((j) + 1 < NT) { _Pragma("unroll") for (int i = 0; i < 2; ++i) *(LAS u32x4*)(lds + OFF_K + (((j) + 1) & 1) * KBUF + kdst[i]) = kr[i]; } \
    _Pragma("unroll") for (int i = 0; i < 2; ++i) *(LAS u32x4*)(lds + OFF_V + ((j) & 1) * VBUF + vdst[i]) = vr[i]; \
    if ((j) + 2 < NT) { _Pragma("unroll") for (int i = 0; i < 2; ++i) kr[i] = ATT_BLD(krs, gsrc[i], ((j) + 2) * (64 * 1024)); } \
    if ((j) + 1 < NT) { _Pragma("unroll") for (int i = 0; i < 2; ++i) vr[i] = ATT_BLD(vrs, gsrc[i], ((j) + 1) * (64 * 1024)); } } while (0)
#define ATT_BLD(rs, voff_, soff_) __builtin_bit_cast(u32x4, __builtin_amdgcn_raw_buffer_load_b128(rs, (int)(voff_), (int)(soff_), 0))

__device__ __forceinline__ void unit(LAS unsigned char* lds, int b, int h, int qb, const bf16_t* Q, const bf16_t* KA, const bf16_t* VA, bf16_t* MIXIN, const float* subg, float lam, const unsigned* KM) {
    const int tid = opaque_tid(), lane = tid & 63, r32 = lane & 31, hi = lane >> 5;
    const int wid = __builtin_amdgcn_readfirstlane(tid >> 6), w = wid & 3, m = wid >> 2;
    LAS float* wsf = (LAS float*)(lds + OFF_WSF) + wid * 64;
    const int rowQ = b * T + qb * 128 + w * 32;
    bf16x8 qr[4];
#pragma unroll
    for (int d0 = 0; d0 < 4; ++d0) qr[d0] = *(const bf16x8*)(Q + (size_t)(rowQ + r32) * 512 + h * 128 + m * 64 + d0 * 16 + hi * 8);
    const bf16_t* Kb = KA + (size_t)b * TK * 512 + h * 128; const bf16_t* Vb = VA + (size_t)b * TK * 512 + h * 128;
    const __amdgpu_buffer_rsrc_t krs = __builtin_amdgcn_make_buffer_rsrc((void*)Kb, 0, 0x7fffffff, 0x00020000), vrs = __builtin_amdgcn_make_buffer_rsrc((void*)Vb, 0, 0x7fffffff, 0x00020000);
    unsigned gsrc[2]; int kdst[2], vdst[2];
#pragma unroll
    for (int i = 0; i < 2; ++i) { const int cid = tid + 512 * i, kv = cid >> 4, c16 = cid & 15;
        gsrc[i] = (unsigned)(kv * 1024 + c16 * 16); kdst[i] = kv * KP + c16 * 16; vdst[i] = (c16 >> 2) * 4096 + (kv >> 4) * 1024 + (kv & 15) * 64 + (c16 & 3) * 16; }
    u32x4 kr[2], vr[2];
#pragma unroll
    for (int i = 0; i < 2; ++i) { kr[i] = ATT_BLD(krs, gsrc[i], 0); vr[i] = ATT_BLD(vrs, gsrc[i], 0); }
#pragma unroll
    for (int i = 0; i < 2; ++i) *(LAS u32x4*)(lds + OFF_K + kdst[i]) = kr[i];
#pragma unroll
    for (int i = 0; i < 2; ++i) kr[i] = ATT_BLD(krs, gsrc[i], 64 * 1024);
    ATT_BAR();
    f32x16 o[4];
#pragma unroll
    for (int d0 = 0; d0 < 4; ++d0) o[d0] = (f32x16){};
    float l_reg = 0.f;
    f32x16 p0, p1, negref;
    {
        const unsigned* km = KM + (b * 8 + h * 2 + m) * 2;
        const float kmax2 = __uint_as_float(km[0]) + __uint_as_float(km[1]);
        float ss = 0.f;
#pragma unroll
        for (int d0 = 0; d0 < 4; ++d0)
#pragma unroll
            for (int i = 0; i < 8; ++i) { const float v = bf2f((unsigned short)qr[d0][i]); ss += v * v; }
        ss += __shfl_xor(ss, 32);
        const float ref = sqrtf(ss * kmax2) * 1.02f;
#pragma unroll
        for (int r = 0; r < 16; ++r) negref[r] = -ref;
    }
    u32x4 pwA[4], pwB[4];
    const int koff = r32 * KP + m * 128 + hi * 16;
    const int voff = ((lane >> 4) & 1) * 32 + (lane & 3) * 8 + (4 * hi + ((lane & 15) >> 2)) * 64;
    ATT_X(0); ATT_STAGE(0); ATT_Y0(pwA); ATT_BAR();
    ATT_X(1); ATT_STAGE(1); ATT_Y(0, pwA, pwB); ATT_BAR();
    for (int j = 2; j < NT; j += 2) {
        ATT_X(0); ATT_STAGE(j); ATT_Y(1, pwB, pwA); ATT_BAR();
        ATT_X(1); ATT_STAGE(j + 1); ATT_Y(0, pwA, pwB); ATT_BAR();
    }
    ATT_Z(1, pwB); ATT_BAR();
    const float lsum_ = l_reg + __shfl_xor(l_reg, 32);
    if (hi == 0) wsf[32 + r32] = lsum_;
    LDS_WAIT();
    LAS float* ex = (LAS float*)lds + w * 4096 + 4 * r32;
    const f32x4 g4 = *(const f32x4*)(subg + 4 * r32) * (1.0f - LAM_INIT);
    bf16_t* dstb = MIXIN + (size_t)rowQ * 1024 + h * 128 + 4 * r32;
#define ATT_EPI(KEEP) do { \
    _Pragma("unroll") for (int rr = 0; rr < 8; ++rr) { const int r = 8 - (KEEP) + rr; const int q = crow(r, hi); const float rl = __builtin_amdgcn_rcpf(wsf[32 + q]); \
        *(LAS f32x4*)(ex + q * 128) = (f32x4){o[0][r] * rl, o[1][r] * rl, o[2][r] * rl, o[3][r] * rl}; } \
    ATT_BAR(); \
    _Pragma("unroll") for (int rr = 0; rr < 8; ++rr) { const int r = (KEEP) + rr; const int q = crow(r, hi); const float rl = __builtin_amdgcn_rcpf(wsf[32 + q]); \
        const f32x4 own = (f32x4){o[0][r] * rl, o[1][r] * rl, o[2][r] * rl, o[3][r] * rl}; const f32x4 oth = *(const LAS f32x4*)(ex + q * 128); \
        const f32x4 x = ((KEEP) == 0) ? (own - lam * oth) : (oth - lam * own); \
        const float ss = half_sum32((x[0] * x[0] + x[1] * x[1]) + (x[2] * x[2] + x[3] * x[3]), hi); \
        const float rstd = __builtin_amdgcn_rsqf(ss * (1.f / 128.f) + EPS); \
        u32x2 wv; wv.x = pk2(x[0] * rstd * g4[0], x[1] * rstd * g4[1]); wv.y = pk2(x[2] * rstd * g4[2], x[3] * rstd * g4[3]); \
        *(u32x2*)(dstb + (size_t)q * 1024) = wv; } } while (0)
    if (m == 0) ATT_EPI(0); else ATT_EPI(8);
#undef ATT_EPI
    ATT_BAR();
}
#undef ATT_BAR
#undef ATT_X
#undef ATT_EXP2
#undef ATT_Y
#undef ATT_Y0
#undef ATT_Z
#undef ATT_STAGE
#undef ATT_BLD
#undef ATT_SB
#undef ATT_KLD
#undef ATT_XSTEP
#undef ATT_VLD
#undef ATT_VF
#undef ATT_YSTEP
#undef ATT_ZSTEP
}

__device__ __forceinline__ void p3_conv_attn(const Args& a, LAS unsigned char* lds, int c, int vcu, int G) {
    const int tid = opaque_tid(), lane = tid & 63, wave = __builtin_amdgcn_readfirstlane(tid >> 6);
    unsigned char* ws = a.ws;
    const bf16_t* GB = (const bf16_t*)(ws + WS_GB); const bf16_t* U = (const bf16_t*)(ws + WS_U); bf16_t* MIXIN = (bf16_t*)(ws + WS_MIXIN);
    {
        const float* cw = a.in[I_CONVW]; float w0[8], w1[8], w2[8];
#pragma unroll
        for (int i = 0; i < 8; ++i) { w0[i] = cw[lane * 8 + i]; w1[i] = cw[512 + lane * 8 + i]; w2[i] = cw[1024 + lane * 8 + i]; }
        const int gw = vcu * NWAVES + wave, NGW = G * NWAVES;
        const int rlo = gw * (M / NGW), rhi = rlo + M / NGW, slo = rlo & ~(T - 1), shi = slo + T;
        struct CIn { u32x4 u[6], g[4]; };
        auto cload = [&](CIn& c, int row) {
            const u32x4 z = {0u, 0u, 0u, 0u};
#pragma unroll
            for (int k = 0; k < 6; ++k) { const int rr = row - 1 + k; c.u[k] = (rr >= slo && rr < shi) ? *(const u32x4*)(U + (size_t)rr * 512 + lane * 8) : z; }
#pragma unroll
            for (int k = 0; k < 4; ++k) c.g[k] = *(const u32x4*)(GB + (size_t)(row + k) * 512 + lane * 8);
        };
        CIn ca; cload(ca, rlo);
        for (int row = rlo; row < rhi; row += 4) {
            CIn cn = ca;
            if (row + 4 < rhi) cload(cn, row + 4);
#pragma unroll
            for (int k = 0; k < 4; ++k) {
                const u32x4 up = ca.u[k], uc = ca.u[k + 1], un = ca.u[k + 2], gb = ca.g[k];
                u32x4 o;
#pragma unroll
                for (int q = 0; q < 4; ++q) {
                    const float y0 = w0[2 * q] * bflo(up[q]) + w1[2 * q] * bflo(uc[q]) + w2[2 * q] * bflo(un[q]);
                    const float y1 = w0[2 * q + 1] * bfhi(up[q]) + w1[2 * q + 1] * bfhi(uc[q]) + w2[2 * q + 1] * bfhi(un[q]);
                    o[q] = pk2(bflo(gb[q]) * y0, bfhi(gb[q]) * y1);
                }
                *(u32x4*)(MIXIN + (size_t)(row + k) * 1024 + 512 + lane * 8) = o;
            }
            ca = cn;
        }
    }
    float lam;
    { const float p1 = a.in[I_LQ1][lane] * a.in[I_LK1][lane], p2 = a.in[I_LQ2][lane] * a.in[I_LK2][lane];
      lam = __expf(wave_sum(p1)) - __expf(wave_sum(p2)) + LAM_INIT; }
    const bf16_t* Q = (const bf16_t*)(ws + WS_Q); const bf16_t* KA = (const bf16_t*)(ws + WS_K); const bf16_t* VA = (const bf16_t*)(ws + WS_V);
    __syncthreads();
    for (int u = vcu * 8; u < 2048; u += G * 8) {
        const int x = (u >> 3) / 32, jj = (u >> 3) % 32;
        for (int i = 0; i < 8; ++i) {
            const int bh = 16 * x + 2 * i + (jj >> 4), qb = jj & 15;
            att::unit(lds, bh >> 2, bh & 3, qb, Q, KA, VA, MIXIN, a.in[I_SUBLN], lam, (const unsigned*)(ws + WS_CTL) + CW_KMAX);
        }
    }
}

struct P5In { f32x4 x[4]; u32x2 m[4]; };
__device__ __forceinline__ void p5_load(P5In& r, int row, int lane, const float* X, const bf16_t* MIX) {
    const f32x4* xr = (const f32x4*)(X + (size_t)row * D) + lane; const u32x2* mr = (const u32x2*)(MIX + (size_t)row * D) + lane;
#pragma unroll
    for (int j = 0; j < 4; ++j) { r.x[j] = __builtin_nontemporal_load(xr + 64 * j); r.m[j] = __builtin_nontemporal_load(mr + 64 * j); }
}
__device__ __forceinline__ float p5_resid(const P5In& r, f32x4 (&h)[4], int row, int lane, const LAS float* mv, const LAS f32x4* npm, bf16_t* H1) {
    f32x4 mx[4]; float s = 0.f;
#pragma unroll
    for (int j = 0; j < 4; ++j) { const u32x2 wv = r.m[j]; mx[j] = (f32x4){bflo(wv.x), bfhi(wv.x), bflo(wv.y), bfhi(wv.y)};
        s += (mx[j].x * mx[j].x + mx[j].y * mx[j].y) + (mx[j].z * mx[j].z + mx[j].w * mx[j].w); }
    const float rstd1 = 1.0f / sqrtf(wave_sum(s) * (1.f / D) + EPS);
    u32x2* hr = (u32x2*)(H1 + (size_t)row * D) + lane; float s2 = 0.f;
#pragma unroll
    for (int j = 0; j < 4; ++j) { const f32x4 g1 = *(const LAS f32x4*)(mv + 4 * lane + 256 * j);
        h[j] = r.x[j] + g1 * ((mx[j] * rstd1) * npm[64 * j]);
        u32x2 wv; wv.x = pk2(h[j].x, h[j].y); wv.y = pk2(h[j].z, h[j].w); __builtin_nontemporal_store(wv, hr + 64 * j);
        s2 += (h[j].x * h[j].x + h[j].y * h[j].y) + (h[j].z * h[j].z + h[j].w * h[j].w); }
    return 1.0f / sqrtf(wave_sum(s2) * (1.f / D) + EPS);
}
__device__ __forceinline__ void p5_rows(const Args& a, LAS unsigned char* lds, int p  ) {
    const int tid = opaque_tid(), lane = tid & 63, wave = __builtin_amdgcn_readfirstlane(tid >> 6);
    unsigned char* ws = a.ws;
    const int b = p >> 3;
    LAS float* wrt = (LAS float*)lds;
    LAS float* mv = (LAS float*)(lds + 65536);
    const float* wr = a.in[I_WROUTER];
    const bf16_t* MIX = (const bf16_t*)(ws + WS_MIX); unsigned char* XN2 = ws + WS_XN; float* AFFT = (float*)(ws + WS_AFFT); bf16_t* H1 = (bf16_t*)(ws + WS_H1);
    const float* X = a.in[I_X];
    const int rbase = p * 256 + wave * 32;
    P5In cA, cB;
    p5_load(cA, rbase, lane, X, MIX); p5_load(cB, rbase + 1, lane, X, MIX);
    for (int n = tid; n < D * NE; n += NTHREADS) { const int k = n >> 4, e = n & 15; wrt[e * D + k] = wr[n]; }
    const float* MOD = (const float*)(ws + WS_MOD) + (size_t)b * NMOD;
    for (int n = tid; n < 3 * D; n += NTHREADS) mv[n] = MOD[2 * D + n];
    for (int n = tid; n < D; n += NTHREADS) { mv[3 * D + n] = a.in[I_NPOST_MIX][n]; mv[4 * D + n] = a.in[I_NPRE_FFN][n]; }
    __syncthreads();
    const LAS f32x4* npm = (const LAS f32x4*)(mv + 3 * D) + lane; const LAS f32x4* npf = (const LAS f32x4*)(mv + 4 * D) + lane;
    for (int i = 0; i < 16; ++i) {
        const int rowA = rbase + 2 * i, rowB = rowA + 1;
        P5In nA, nB;
        if (i + 1 < 16) { p5_load(nA, rowA + 2, lane, X, MIX); p5_load(nB, rowB + 2, lane, X, MIX); }
        f32x4 hA[4], hB[4];
        const float rsA = p5_resid(cA, hA, rowA, lane, mv, npm, H1);
        const float rsB = p5_resid(cB, hB, rowB, lane, mv, npm, H1);
        unsigned* oA = (unsigned*)(XN2 + (size_t)rowA * D) + lane; unsigned* oB = (unsigned*)(XN2 + (size_t)rowB * D) + lane;
        typedef float f32x2v __attribute__((ext_vector_type(2)));
        f32x2v lg2[16];
#pragma unroll
        for (int e = 0; e < 16; ++e) lg2[e] = (f32x2v){0.f, 0.f};
#pragma unroll
        for (int j = 0; j < 4; ++j) { const f32x4 sh2 = *(const LAS f32x4*)(mv + 1024 + 4 * lane + 256 * j), sc2 = *(const LAS f32x4*)(mv + 2048 + 4 * lane + 256 * j);
            const f32x4 gn = npf[64 * j];
            const f32x4 zA = ((hA[j] * rsA) * gn) * (sc2 + 1.0f) + sh2, zB = ((hB[j] * rsB) * gn) * (sc2 + 1.0f) + sh2;
            { const f32x4 qa = zA * pg8::F8_ACT, qb = zB * pg8::F8_ACT; oA[64 * j] = pg8::pk4_fp8(qa.x, qa.y, qa.z, qa.w); oB[64 * j] = pg8::pk4_fp8(qb.x, qb.y, qb.z, qb.w); }
            const f32x2v zx = {zA.x, zB.x}, zy = {zA.y, zB.y}, zz = {zA.z, zB.z}, zw = {zA.w, zB.w};
#pragma unroll
            for (int e = 0; e < 16; ++e) { const f32x4 wq = *(const LAS f32x4*)(wrt + e * D + 4 * lane + 256 * j);
                lg2[e] = __builtin_elementwise_fma(zx, (f32x2v){wq.x, wq.x}, lg2[e]); lg2[e] = __builtin_elementwise_fma(zy, (f32x2v){wq.y, wq.y}, lg2[e]);
                lg2[e] = __builtin_elementwise_fma(zz, (f32x2v){wq.z, wq.z}, lg2[e]); lg2[e] = __builtin_elementwise_fma(zw, (f32x2v){wq.w, wq.w}, lg2[e]);
                if ((e & 3) == 3) __builtin_amdgcn_sched_barrier(0); } }
        float lg[32];
#pragma unroll
        for (int e = 0; e < 16; ++e) { lg[e] = lg2[e].x; lg[16 + e] = lg2[e].y; }
#pragma unroll
        for (int st = 0; st < 5; ++st) { const int d = 1 << st, cntv = 16 >> st; const bool up = (lane & d) != 0;
#pragma unroll
            for (int q = 0; q < 16; ++q) if (q < cntv) { const float send = up ? lg[2 * q] : lg[2 * q + 1], keep = up ? lg[2 * q + 1] : lg[2 * q]; lg[q] = keep + __shfl_xor(send, d); } }
        float lv = lg[0] + __shfl_xor(lg[0], 32);
        float mxl = lv;
#pragma unroll
        for (int d = 1; d < 16; d <<= 1) mxl = fmaxf(mxl, __shfl_xor(mxl, d));
        const float ev = __expf(lv - mxl); float se = ev;
#pragma unroll
        for (int d = 1; d < 16; d <<= 1) se += __shfl_xor(se, d);
        if (lane < 32) { const int row = (lane < 16) ? rowA : rowB; AFFT[((size_t)b * NE + (lane & 15)) * T + (row & (T - 1))] = ev / se; }
        cA = nA; cB = nB;
    }
}

__device__ __forceinline__ void p6_topk(const Args& a, LAS unsigned char* lds, int c, int G) {
    const int tid = opaque_tid(), lane = tid & 63, wave = __builtin_amdgcn_readfirstlane(tid >> 6);
    unsigned char* ws = a.ws;
    const float* AFFT = (const float*)(ws + WS_AFFT); short* SLOT = (short*)(ws + WS_SLOT); int* IDX = (int*)(ws + WS_IDX); float* GATE = (float*)(ws + WS_GATE);
    LAS unsigned* sv = (LAS unsigned*)(lds + wave * 16384);
    for (int item = c + wave * G; item < NITEM; item += G * NWAVES) {
        const int b = item >> 4, e = item & 15;
        const float* src = AFFT + (size_t)item * T;
#pragma unroll 8
        for (int j = 0; j < 32; ++j) sv[j * 64 + lane] = __float_as_uint(src[j * 64 + lane]);
        LDS_WAIT(); asm volatile("" ::: "memory");
        unsigned pre = 0u;
        for (int bit = 30; bit >= 0; --bit) {
            const unsigned cand = pre | (1u << bit);
            int cnt = 0;
#pragma unroll 4
            for (int j = 0; j < 32; ++j) cnt += (int)__popcll(__ballot(sv[j * 64 + lane] >= cand));
            if (cnt >= CAP) pre = cand;
        }
        int ngt = 0;
#pragma unroll 4
        for (int j = 0; j < 32; ++j) ngt += (int)__popcll(__ballot(sv[j * 64 + lane] > pre));
        const int need_eq = CAP - ngt;
        const unsigned long long ltmask = (1ull << lane) - 1ull;
        int base_gt = 0, base_eq = 0;
#pragma unroll 2
        for (int j = 0; j < 32; ++j) {
            const unsigned vj = sv[j * 64 + lane];
            const bool gt = vj > pre, eq = vj == pre;
            const unsigned long long mg = __ballot(gt), me = __ballot(eq);
            const int pg = base_gt + (int)__popcll(mg & ltmask), pe = base_eq + (int)__popcll(me & ltmask);
            int sl = -1; if (gt) sl = pg; else if (eq && pe < need_eq) sl = ngt + pe;
            const int t = j * 64 + lane;
            SLOT[((size_t)b * T + t) * NE + e] = (short)sl;
            if (sl >= 0) { IDX[item * CAP + sl] = t; GATE[item * CAP + sl] = __uint_as_float(vj); }
            base_gt += (int)__popcll(mg); base_eq += (int)__popcll(me);
        }
        LDS_WAIT(); asm volatile("" ::: "memory");
    }
}

struct P8Row { u32x2 h[4]; unsigned y[4][4]; float wt[4]; unsigned long long rest; int sl; };
__device__ __forceinline__ f32x4 fp8x4_to_f32(unsigned w) { typedef float f2 __attribute__((ext_vector_type(2))); const f2 lo = __builtin_amdgcn_cvt_pk_f32_fp8((int)w, false), hi = __builtin_amdgcn_cvt_pk_f32_fp8((int)w, true); return (f32x4){lo.x, lo.y, hi.x, hi.y}; }
__device__ __forceinline__ int p8_slot(int row, int lane, const short* SLOT) { return (lane < NE) ? (int)SLOT[(size_t)row * NE + lane] : -1; }
__device__ __forceinline__ void p8_issue(P8Row& r, int row, int lane, int s_e, const unsigned char* Y, const bf16_t* H1) {
    const int b = row >> 11;
    unsigned long long mask = __ballot(s_e >= 0);
    const u32x2* hr = (const u32x2*)(H1 + (size_t)row * D) + lane;
#pragma unroll
    for (int j = 0; j < 4; ++j) r.h[j] = __builtin_nontemporal_load(hr + 64 * j);
#pragma unroll
    for (int q = 0; q < 4; ++q) {
        int e = 0, s = 0; r.wt[q] = 0.f;
        if (mask) { e = (int)__builtin_ctzll(mask); mask &= mask - 1ull; s = __builtin_amdgcn_readlane(s_e, e); r.wt[q] = 1.f; }
        const unsigned* yr = (const unsigned*)(Y + ((size_t)(b * NE + e) * CAP + s) * D) + lane;
#pragma unroll
        for (int j = 0; j < 4; ++j) r.y[q][j] = __builtin_nontemporal_load(yr + 64 * j);
    }
    r.rest = mask; r.sl = s_e;
}
__device__ __forceinline__ void p8_finish(P8Row& r, int row, int lane, const unsigned char* Y, const f32x4 (&gg)[4], float* out) {
    const int b = row >> 11;
    f32x4 ff[4];
#pragma unroll
    for (int j = 0; j < 4; ++j) ff[j] = (f32x4){0.f, 0.f, 0.f, 0.f};
#pragma unroll
    for (int q = 0; q < 4; ++q)
#pragma unroll
        for (int j = 0; j < 4; ++j) ff[j] += fp8x4_to_f32(r.y[q][j]) * r.wt[q];
    unsigned long long mask = r.rest;
    while (mask) {
        const int e = (int)__builtin_ctzll(mask); mask &= mask - 1ull; const int s = __builtin_amdgcn_readlane(r.sl, e);
        const unsigned* yr = (const unsigned*)(Y + ((size_t)(b * NE + e) * CAP + s) * D) + lane;
#pragma unroll
        for (int j = 0; j < 4; ++j) ff[j] += fp8x4_to_f32(yr[64 * j]);
    }
#pragma unroll
    for (int j = 0; j < 4; ++j) ff[j] = ff[j] * (1.0f / pg8::F8_Y);
    float s2 = 0.f;
#pragma unroll
    for (int j = 0; j < 4; ++j) s2 += (ff[j].x * ff[j].x + ff[j].y * ff[j].y) + (ff[j].z * ff[j].z + ff[j].w * ff[j].w);
    const float rstd = 1.0f / sqrtf(wave_sum(s2) * (1.f / D) + EPS);
    f32x4* orow = (f32x4*)(out + (size_t)row * D) + lane;
#pragma unroll
    for (int j = 0; j < 4; ++j) { const u32x2 hv = r.h[j]; const f32x4 h = (f32x4){bflo(hv.x), bfhi(hv.x), bflo(hv.y), bfhi(hv.y)};
        __builtin_nontemporal_store(h + gg[j] * (ff[j] * rstd), orow + 64 * j); }
}
__device__ __forceinline__ void p8_final(const Args& a, int vcu, int G) {
    const int tid = opaque_tid(), lane = tid & 63, wave = __builtin_amdgcn_readfirstlane(tid >> 6);
    unsigned char* ws = a.ws;
    const short* SLOT = (const short*)(ws + WS_SLOT); const unsigned char* Y = ws + WS_Y; const float* MOD = (const float*)(ws + WS_MOD); const bf16_t* H1 = (const bf16_t*)(ws + WS_H1);
    const int gw = vcu * NWAVES + wave, NGW = G * NWAVES;
    const int per = M / NGW;
    const int row0 = gw * per, rend = row0 + per;
    f32x4 gg[4];
    { const f32x4* npo = (const f32x4*)a.in[I_NPOST_FFN] + lane; const f32x4* g2 = (const f32x4*)(MOD + (size_t)(row0 >> 11) * NMOD + 5 * D) + lane;
#pragma unroll
      for (int j = 0; j < 4; ++j) gg[j] = g2[64 * j] * npo[64 * j]; }
    P8Row r0, r1, r2, r3;
    { const int s0 = p8_slot(row0, lane, SLOT), s1 = p8_slot(row0 + 1, lane, SLOT), s2 = p8_slot(row0 + 2, lane, SLOT), s3 = p8_slot(row0 + 3, lane, SLOT);
      p8_issue(r0, row0, lane, s0, Y, H1); p8_issue(r1, row0 + 1, lane, s1, Y, H1); p8_issue(r2, row0 + 2, lane, s2, Y, H1); p8_issue(r3, row0 + 3, lane, s3, Y, H1); }
    for (int row = row0; row < rend; row += 4) {
        const bool more = row + 4 < rend;
        int n0 = -1, n1 = -1, n2 = -1, n3 = -1;
        if (more) { n0 = p8_slot(row + 4, lane, SLOT); n1 = p8_slot(row + 5, lane, SLOT); n2 = p8_slot(row + 6, lane, SLOT); n3 = p8_slot(row + 7, lane, SLOT); }
        p8_finish(r0, row, lane, Y, gg, a.out);
        p8_finish(r1, row + 1, lane, Y, gg, a.out);
        if (more) { p8_issue(r0, row + 4, lane, n0, Y, H1); p8_issue(r1, row + 5, lane, n1, Y, H1); }
        p8_finish(r2, row + 2, lane, Y, gg, a.out);
        p8_finish(r3, row + 3, lane, Y, gg, a.out);
        if (more) { p8_issue(r2, row + 6, lane, n2, Y, H1); p8_issue(r3, row + 7, lane, n3, Y, H1); }
    }
}

__global__ void __launch_bounds__(NTHREADS, 2) fwd_kernel(Args args) {
    extern __shared__ __attribute__((aligned(16))) unsigned char lds_raw[];
    LAS unsigned char* lds = (LAS unsigned char*)lds_raw;
    volatile LAS unsigned* MISC = (volatile LAS unsigned*)(lds + MISC_OFF);
    const int tid = threadIdx.x;
    const int G = gridDim.x, c = blockIdx.x;
    const int vcu = (G % 8 == 0) ? (c % 8) * (G / 8) + c / 8 : c;
    unsigned char* ws = args.ws;
    gu32* ctl = (gu32*)(ws + WS_CTL);
    for (int u = tid; u < (LDS_BYTES - LDSCTL_OFF) / 4; u += NTHREADS) ((LAS unsigned*)(lds + LDSCTL_OFF))[u] = 0u;
    __syncthreads();
    XcdBarrier bar; bar.bar = (unsigned*)(ctl + CW_BAR); bar.x = 0; bar.st = nullptr;
    const int lo = args.ph_lo, hi = args.ph_hi;
    if (hi - lo > 1) bar = xcd_barrier_post((unsigned*)(ctl + CW_BAR), MISC + 8);
#ifndef PHMASK
#define PHMASK 0xff
#endif
#define IN(k) (((PHMASK >> (k)) & 1) && lo <= (k) && (k) < hi)
#define SEAM(k) do { if (IN(k) && IN((k) + 1)) xcd_barrier(bar); } while (0)
#ifndef PROBE_PHASE
#define PROBE_PHASE -1
#endif
#define PB(k) do { if (PROBE_PHASE == (k)) { if (tid == 0) { const unsigned long long t0_ = __builtin_amdgcn_s_memrealtime(); MISC[16] = (unsigned)t0_; MISC[17] = (unsigned)(t0_ >> 32); } } } while (0)
#define PE(k) do { if (PROBE_PHASE == (k)) { if (tid == 0) { const unsigned long long t0_ = ((unsigned long long)MISC[17] << 32) | MISC[16]; const unsigned long long t1_ = __builtin_amdgcn_s_memrealtime(); \
      while (__builtin_amdgcn_s_memrealtime() - t1_ < t1_ - t0_) __builtin_amdgcn_s_sleep(8); } __syncthreads(); } } while (0)

    PB(0); if (IN(0)) { p0_prologue(args, lds, vcu, G); } SEAM(0); PE(0);
    PB(1); if (IN(1)) { p1_xn(args, lds, c, G); inout_weight_copies(args, lds, vcu, G); } SEAM(1); PE(1);
    PB(2); if (IN(2)) {
        pg8::Gemm g{(const bf16_t*)(ws + WS_XN), (const bf16_t*)(ws + WS_WIN), D, nullptr};
        pg8::SchedProj S{G, c};
        pg8::EpiProj E{(bf16_t*)(ws + WS_Q), (bf16_t*)(ws + WS_K), (bf16_t*)(ws + WS_V), (bf16_t*)(ws + WS_GB), (bf16_t*)(ws + WS_U), (const float*)(ws + WS_TAB), (unsigned*)(ws + WS_CTL) + CW_KMAX};
        pg8::gemm_phase<pg8::EpiProj, pg8::SchedProj, true, true>(lds, g, S, E);
        if (c >= 128) expert_weight_copies(args, lds, c - 128, G - 128, 0, 9216);
    } SEAM(2); PE(2);
    PB(3); if (IN(3)) { if (c & 1) expert_weight_copies(args, lds, vcu, G, 9216, 24576); p3_conv_attn(args, lds, c, vcu, G); if (!(c & 1)) expert_weight_copies(args, lds, vcu, G, 9216, 24576); } SEAM(3); PE(3);
    PB(4); if (IN(4)) {
        {
            const int p = c;
#ifndef NO_P4
            pg8::Gemm g{(const bf16_t*)(ws + WS_MIXIN), (const bf16_t*)(ws + WS_WOUT), D, nullptr};
            pg8::SchedPanel S{p, 4};
            pg8::EpiBf16 E{(bf16_t*)(ws + WS_MIX), D};
            pg8::gemm_phase<pg8::EpiBf16, pg8::SchedPanel, true, true>(lds, g, S, E);
#endif
            VM_WAIT(); __syncthreads();
#ifndef NO_P5
            p5_rows(args, lds, p);
#endif
            __syncthreads();
        }
    } SEAM(4); PE(4);
    PB(5); if (IN(5)) { p6_topk(args, lds, c, G); } SEAM(5); PE(5);
    PB(6); if (IN(6)) {
#pragma unroll 1
        for (int it = 0; it < 2; ++it) {
            {
                const int item = 2 * c + it;
                const int b = item >> 4, e = item & 15;
#ifndef NO_G1
                if (it == 0) PB(8);
                {
                    pg8::Gemm g{(const bf16_t*)(ws + WS_XN + (size_t)b * T * D), (const bf16_t*)(ws + WS_WGU + (size_t)e * 2048 * D), D, (const int*)(ws + WS_IDX) + item * CAP};
                    pg8::SchedPanel S{0, 8};
                    pg8::EpiGU8 E{ws + WS_HMID + (size_t)item * CAP * D};
                    pg8::gemm_phase<pg8::EpiGU8, pg8::SchedPanel, false, true, true, true, true>(lds, g, S, E);
                }
#endif
                VM_WAIT(); __syncthreads();
                if (it == 0) { PE(8); PB(9); }
#ifndef NO_G2
                {
                    pg8::Gemm g{(const bf16_t*)(ws + WS_HMID + (size_t)item * CAP * D), (const bf16_t*)(ws + WS_WDN + (size_t)e * D * D), D, nullptr};
                    pg8::SchedPanel S{0, 4};
                    LAS float* gl = (LAS float*)(lds + LDSCTL_OFF + 4096);
                    { const int t_ = opaque_tid(); if (t_ < CAP) gl[t_] = ((const float*)(ws + WS_GATE))[item * CAP + t_] * (pg8::F8_INV * pg8::F8_Y); }
                    __syncthreads();
                    pg8::EpiDown8 E{ws + WS_Y + (size_t)item * CAP * D, gl};
                    pg8::gemm_phase<pg8::EpiDown8, pg8::SchedPanel, false, true, false, true, true>(lds, g, S, E);
                }
#endif
                VM_WAIT(); __syncthreads();
                if (it == 0) PE(9);
            }
        }
    } SEAM(6); PE(6);
    PB(7); if (IN(7)) { p8_final(args, vcu, G); } PE(7);
#undef IN
#undef SEAM
}

extern "C" void kernel_launch(void* const* d_in, const int* in_sizes, int n_in, void* d_out, int out_size, void* d_ws, size_t ws_size, hipStream_t stream) {
    static int grid = 0;
    if (grid == 0) {
        if (n_in != 22 || in_sizes[0] != M * D || out_size != M * D || ws_size < WS_END) { fprintf(stderr, "kernel_launch: unexpected shapes (n_in %d, in0 %d, out %d, ws %zu)\n", n_in, n_in > 0 ? in_sizes[0] : -1, out_size, ws_size); grid = -1; return; }
        int dev = 0, cus = 0;
        if (hipGetDevice(&dev) != hipSuccess || hipDeviceGetAttribute(&cus, hipDeviceAttributeMultiprocessorCount, dev) != hipSuccess) { grid = -1; return; }
        if (hipFuncSetAttribute((const void*)fwd_kernel, hipFuncAttributeMaxDynamicSharedMemorySize, LDS_BYTES) != hipSuccess) { fprintf(stderr, "kernel_launch: hipFuncSetAttribute failed\n"); grid = -1; return; }
        (void)hipGetLastError();
        grid = cus;
        if (grid != 256) { fprintf(stderr, "kernel_launch: this kernel needs a 256-CU device (got %d)\n", cus); grid = -1; return; }
    }
    if (grid < 0) return;
    (void)hipMemsetAsync((char*)d_ws + WS_CTL, 0, CTL_ZERO_BYTES, stream);
    Args a{};
    for (int i = 0; i < 22; ++i) a.in[i] = (const float*)d_in[i];
    a.out = (float*)d_out; a.ws = (unsigned char*)d_ws;
    constexpr int NPH = 8;
    if (MK_N_LAUNCHES == 1) { a.ph_lo = 0; a.ph_hi = NPH; hipLaunchKernelGGL(fwd_kernel, dim3(grid), dim3(NTHREADS), LDS_BYTES, stream, a); }
    else { for (int k = 0; k < NPH; ++k) { a.ph_lo = k; a.ph_hi = k + 1; hipLaunchKernelGGL(fwd_kernel, dim3(grid), dim3(NTHREADS), LDS_BYTES, stream, a); } }
}
```

```cpp
#include <hip/hip_runtime.h>
#include <cstdio>
#include <cstdint>

#ifndef MK_N_LAUNCHES
#define MK_N_LAUNCHES 1
#endif

#define LAS __attribute__((address_space(3)))
#define GAS __attribute__((address_space(1)))
typedef unsigned short bf16_t;
typedef short bf16x8 __attribute__((ext_vector_type(8)));
typedef short s16x4 __attribute__((ext_vector_type(4)));
typedef float f32x4 __attribute__((ext_vector_type(4)));
typedef float f32x16 __attribute__((ext_vector_type(16)));
typedef unsigned u32x4 __attribute__((ext_vector_type(4)));
typedef unsigned u32x2 __attribute__((ext_vector_type(2)));

constexpr int NB = 32, T = 2048, D = 1024, TC = 256, M = NB * T, MC = NB * TC, MA = M + MC, TK = TC + T;
constexpr int NE = 16, CAP = 256, NITEM = NB * NE, NPROJ = 3072, NMOD = 6 * D;
constexpr float EPS = 1e-6f;
constexpr float C2 = 0.125f * 1.4426950408889634f;
constexpr float LAM_INIT = 0.2f;
constexpr int NWAVES = 8, NTHREADS = 512;

constexpr size_t MiB = 1u << 20;
constexpr size_t WS_CTL = 0, CTL_ZERO_BYTES = 1 * MiB;
constexpr size_t WS_MODP = 2 * MiB;
constexpr size_t WS_MOD = 16 * MiB;
constexpr size_t WS_TAB = 17 * MiB;
constexpr size_t WS_WIN = 18 * MiB;
constexpr size_t WS_WOUT = 24 * MiB;
constexpr size_t WS_WGU = 26 * MiB;
constexpr size_t WS_WDN = 90 * MiB;
constexpr size_t WS_AFFT = 122 * MiB;
constexpr size_t WS_SLOT = 126 * MiB;
constexpr size_t WS_IDX = 128 * MiB;
constexpr size_t WS_GATE = 129 * MiB;
constexpr size_t WS_XN = 130 * MiB;
constexpr size_t WS_Q = 274 * MiB;
constexpr size_t WS_K = 338 * MiB;
constexpr size_t WS_V = 410 * MiB;
constexpr size_t WS_GB = 482 * MiB;
constexpr size_t WS_U = 546 * MiB;
constexpr size_t WS_MIXIN = 610 * MiB;
constexpr size_t WS_MIX = 738 * MiB;
constexpr size_t WS_HMID = 274 * MiB;
constexpr size_t WS_Y = 610 * MiB;
constexpr size_t WS_H1 = 866 * MiB;
constexpr size_t WS_END = 994 * MiB;

__device__ __forceinline__ int opaque_tid() { int t = threadIdx.x; asm volatile("" : "+v"(t)); return t; }

namespace pg8 {
constexpr int BM = 256, BK = 64, HALF = 128, HTB = HALF * BK * 2, STAGE_BYTES = 8 * HTB;
__host__ __device__ __forceinline__ int lds_byte(int r, int c) { const int st = (r >> 4) * 2 + (c >> 5), rr = r & 15, cc = c & 31, ob = rr * 64 + cc * 2; return st * 1024 + (ob ^ (((ob >> 9) & 1) << 5)); }
__host__ __device__ __forceinline__ void stage_rc(int b, int& R, int& C) { const int st = b / 1024, sb = b % 1024, swz = sb ^ (((sb >> 9) & 1) << 5); R = (st >> 1) * 16 + swz / 64; C = (st & 1) * 32 + (swz % 64) / 2; }
__host__ __device__ __forceinline__ int perm32(int rho) { const int n = rho >> 4, i = rho & 15; return 8 * (i >> 2) + 4 * n + (i & 3); }

struct Unit { int pm, pn; };
struct Gemm { const bf16_t* A; const bf16_t* Bt; int K; const int* gidx; };

typedef float f32x2_t __attribute__((ext_vector_type(2))); typedef __bf16 bf16x2_t __attribute__((ext_vector_type(2)));
__device__ __forceinline__ unsigned cvt_pk_bf16(float lo, float hi) { const f32x2_t v = {lo, hi}; const bf16x2_t b = __builtin_convertvector(v, bf16x2_t); return __builtin_bit_cast(unsigned, b); }

struct EpiBf16 {
    static constexpr bool PERM = true, AFTER_DRAIN = false;
    bf16_t* O; int ldc;
    __device__ __forceinline__ void operator()(const f32x4 (&acc)[2][2][4][2], const Unit& u, int wr, int wc, int fr, int fq) const {
        const int row0 = u.pm * BM + wr * 64 + fr; const int col0 = u.pn * BM + wc * 32 + 8 * fq;
#pragma unroll
        for (int ai = 0; ai < 2; ++ai)
#pragma unroll
            for (int m = 0; m < 4; ++m) { bf16_t* rowp = O + (size_t)(row0 + ai * HALF + m * 16) * ldc + col0;
#pragma unroll
                for (int bj = 0; bj < 2; ++bj) { const f32x4 v0 = acc[ai][bj][m][0], v1 = acc[ai][bj][m][1];
                    u32x4 w; w.x = cvt_pk_bf16(v0[0], v0[1]); w.y = cvt_pk_bf16(v0[2], v0[3]); w.z = cvt_pk_bf16(v1[0], v1[1]); w.w = cvt_pk_bf16(v1[2], v1[3]);
                    *(u32x4*)(rowp + bj * HALF) = w; } }
    }
};

struct EpiProj {
    static constexpr bool PERM = true, AFTER_DRAIN = false;
    bf16_t *Q, *KA, *VA, *GB, *U; const float* tab;
    unsigned* kmaxh;
    __device__ __forceinline__ void operator()(const f32x4 (&acc)[2][2][4][2], const Unit& u, int wr, int wc, int fr, int fq) const {
        const int pn = u.pn; const bool ctx = u.pm >= 256;
        float km[2] = {0.f, 0.f};
#pragma unroll
        for (int ai = 0; ai < 2; ++ai)
#pragma unroll
            for (int m = 0; m < 4; ++m) {
                const int row = u.pm * BM + ai * HALF + wr * 64 + m * 16 + fr;
                int t, kvrow;
                if (!ctx) { const int b = row >> 11; t = row & 2047; kvrow = b * TK + TC + t; }
                else { const int rc = row - M; const int b = rc >> 8; t = 0; kvrow = b * TK + (rc & 255); }
                if (pn < 4) {
                    f32x4 cs0 = {1.f, 0.f, 1.f, 0.f}, cs1 = cs0, cs2 = cs0, cs3 = cs0;
                    if (!ctx) { const float* tp = tab + ((size_t)t * 32 + 16 * (wc & 1) + 4 * fq) * 2;
                        cs0 = *(const f32x4*)(tp); cs1 = *(const f32x4*)(tp + 4); }
                    (void)cs2; (void)cs3;
#pragma unroll
                    for (int bj = 0; bj < 2; ++bj) {
                        const f32x4 v0 = acc[ai][bj][m][0], v1 = acc[ai][bj][m][1];
                        float e0 = v0[0], o0 = v0[1], e1 = v0[2], o1 = v0[3], e2 = v1[0], o2 = v1[1], e3 = v1[2], o3 = v1[3];
                        if (pn >= 2) {
                            float ss = ((e0 * e0 + o0 * o0) + (e1 * e1 + o1 * o1)) + ((e2 * e2 + o2 * o2) + (e3 * e3 + o3 * o3));
                            ss += __shfl_xor(ss, 16); ss += __shfl_xor(ss, 32); km[bj] = fmaxf(km[bj], ss); }
                        float r0 = e0 * cs0[0] - o0 * cs0[1], s0 = o0 * cs0[0] + e0 * cs0[1];
                        float r1 = e1 * cs0[2] - o1 * cs0[3], s1 = o1 * cs0[2] + e1 * cs0[3];
                        float r2 = e2 * cs1[0] - o2 * cs1[1], s2 = o2 * cs1[0] + e2 * cs1[1];
                        float r3 = e3 * cs1[2] - o3 * cs1[3], s3 = o3 * cs1[2] + e3 * cs1[3];
                        const float sc = (pn < 2) ? C2 : 1.f;
                        u32x4 w; w.x = cvt_pk_bf16(r0 * sc, s0 * sc); w.y = cvt_pk_bf16(r1 * sc, s1 * sc); w.z = cvt_pk_bf16(r2 * sc, s2 * sc); w.w = cvt_pk_bf16(r3 * sc, s3 * sc);
                        const int col = (pn & 1) * 256 + bj * HALF + wc * 32 + 8 * fq;
                        bf16_t* dst = (pn < 2) ? (Q + (size_t)row * 512 + col) : (KA + (size_t)kvrow * 512 + col);
                        *(u32x4*)dst = w;
                    }
                } else if (pn < 8) {
#pragma unroll
                    for (int bj = 0; bj < 2; ++bj) {
                        const f32x4 v0 = acc[ai][bj][m][0], v1 = acc[ai][bj][m][1];
                        u32x4 w; w.x = cvt_pk_bf16(v0[0], v0[1]); w.y = cvt_pk_bf16(v0[2], v0[3]); w.z = cvt_pk_bf16(v1[0], v1[1]); w.w = cvt_pk_bf16(v1[2], v1[3]);
                        const int col = (pn & 1) * 256 + bj * HALF + wc * 32 + 8 * fq;
                        bf16_t* dst = (pn < 6) ? (VA + (size_t)kvrow * 512 + col) : (GB + (size_t)row * 512 + col);
                        *(u32x4*)dst = w;
                    }
                } else {
                    const f32x4 a0 = acc[ai][0][m][0], a1 = acc[ai][0][m][1], b0 = acc[ai][1][m][0], b1 = acc[ai][1][m][1];
                    u32x4 w; w.x = cvt_pk_bf16(a0[0] * b0[0], a0[1] * b0[1]); w.y = cvt_pk_bf16(a0[2] * b0[2], a0[3] * b0[3]);
                    w.z = cvt_pk_bf16(a1[0] * b1[0], a1[1] * b1[1]); w.w = cvt_pk_bf16(a1[2] * b1[2], a1[3] * b1[3]);
                    const int col = (pn - 8) * 128 + wc * 32 + 8 * fq;
                    *(u32x4*)(U + (size_t)row * 512 + col) = w;
                }
            }
        if (pn == 2 || pn == 3) {
            const int b = ctx ? (u.pm - 256) : (u.pm >> 3);
#pragma unroll
            for (int bj = 0; bj < 2; ++bj) { float v = km[bj];
#pragma unroll
                for (int d = 1; d < 16; d <<= 1) v = fmaxf(v, __shfl_xor(v, d));
                if (fr == 0 && fq == 0) atomicMax(kmaxh + ((b * 8 + (pn & 1) * 4 + bj * 2 + (wc >> 1)) * 2 + (wc & 1)), __float_as_uint(v)); }
        }
    }
};

struct EpiGU {
    static constexpr bool PERM = true, AFTER_DRAIN = false;
    bf16_t* H;
    __device__ __forceinline__ float silu(float x) const { return x * __builtin_amdgcn_rcpf(1.f + __expf(-x)); }
    __device__ __forceinline__ void operator()(const f32x4 (&acc)[2][2][4][2], const Unit& u, int wr, int wc, int fr, int fq) const {
#pragma unroll
        for (int ai = 0; ai < 2; ++ai)
#pragma unroll
            for (int m = 0; m < 4; ++m) {
                const int row = ai * HALF + wr * 64 + m * 16 + fr;
                const f32x4 a0 = acc[ai][0][m][0], a1 = acc[ai][0][m][1], b0 = acc[ai][1][m][0], b1 = acc[ai][1][m][1];
                u32x4 w; w.x = cvt_pk_bf16(silu(a0[0]) * b0[0], silu(a0[1]) * b0[1]); w.y = cvt_pk_bf16(silu(a0[2]) * b0[2], silu(a0[3]) * b0[3]);
                w.z = cvt_pk_bf16(silu(a1[0]) * b1[0], silu(a1[1]) * b1[1]); w.w = cvt_pk_bf16(silu(a1[2]) * b1[2], silu(a1[3]) * b1[3]);
                *(u32x4*)(H + (size_t)row * 1024 + u.pn * 128 + wc * 32 + 8 * fq) = w;
            }
    }
};
__device__ __forceinline__ unsigned pk4_fp8(float a, float b, float c, float d) { int w = 0; w = __builtin_amdgcn_cvt_pk_fp8_f32(a, b, w, false); w = __builtin_amdgcn_cvt_pk_fp8_f32(c, d, w, true); return (unsigned)w; }
constexpr float F8_ACT = 4.0f, F8_WGT = 64.0f, F8_INV = 1.0f / (4.0f * 64.0f);
struct EpiGU8 {
    static constexpr bool PERM = true, AFTER_DRAIN = false;
    unsigned char* H;
    __device__ __forceinline__ float hval(float g, float u) const {
        const float e = __builtin_amdgcn_exp2f(g * (-F8_INV * 1.4426950408889634f));
        const float r = __builtin_amdgcn_rcpf(1.f + e);
        return __builtin_amdgcn_fmed3f((g * u) * (r * (F8_INV * F8_INV * F8_ACT)), -448.f, 448.f); }
    __device__ __forceinline__ void row(const f32x4 (&acc)[2][2][4][2], const Unit& u, int ai, int m, int wr, int wc, int fr, int fq) const {
        unsigned off = (unsigned)((ai * HALF + wr * 64 + m * 16 + fr) * 1024 + u.pn * 128 + wc * 32 + 8 * fq);
        asm volatile("" : "+v"(off));
        const f32x4 a0 = acc[ai][0][m][0], a1 = acc[ai][0][m][1], b0 = acc[ai][1][m][0], b1 = acc[ai][1][m][1];
        u32x2 w; w.x = pk4_fp8(hval(a0[0], b0[0]), hval(a0[1], b0[1]), hval(a0[2], b0[2]), hval(a0[3], b0[3]));
        w.y = pk4_fp8(hval(a1[0], b1[0]), hval(a1[1], b1[1]), hval(a1[2], b1[2]), hval(a1[3], b1[3]));
        *(u32x2*)(H + off) = w;
    }
    __device__ __forceinline__ void operator()(const f32x4 (&acc)[2][2][4][2], const Unit& u, int wr, int wc, int fr, int fq) const {
#pragma unroll
        for (int ai = 0; ai < 2; ++ai)
#pragma unroll
            for (int m = 0; m < 4; ++m) row(acc, u, ai, m, wr, wc, fr, fq);
    }
};
struct EpiDown {
    static constexpr bool PERM = true, AFTER_DRAIN = false;
    bf16_t* Y; const float* gate; float scale;
    __device__ __forceinline__ void operator()(const f32x4 (&acc)[2][2][4][2], const Unit& u, int wr, int wc, int fr, int fq) const {
        asm volatile("" : "+v"(fr));
#pragma unroll
        for (int ai = 0; ai < 2; ++ai)
#pragma unroll
            for (int m = 0; m < 4; ++m) {
                const int row = ai * HALF + wr * 64 + m * 16 + fr; const float g = gate[row] * scale;
#pragma unroll
                for (int bj = 0; bj < 2; ++bj) { const f32x4 v0 = acc[ai][bj][m][0] * g, v1 = acc[ai][bj][m][1] * g;
                    u32x4 w; w.x = cvt_pk_bf16(v0[0], v0[1]); w.y = cvt_pk_bf16(v0[2], v0[3]); w.z = cvt_pk_bf16(v1[0], v1[1]); w.w = cvt_pk_bf16(v1[2], v1[3]);
                    *(u32x4*)(Y + (size_t)row * 1024 + u.pn * BM + bj * HALF + wc * 32 + 8 * fq) = w; }
            }
    }
};

constexpr float F8_Y = 64.0f;
struct EpiDown8 {
    static constexpr bool PERM = true, AFTER_DRAIN = false;
    unsigned char* Y; const LAS float* gl;
    __device__ __forceinline__ void row(const f32x4 (&acc)[2][2][4][2], const Unit& u, int ai, int m, int wr, int wc, int fr, int fq) const {
        unsigned off = (unsigned)((ai * HALF + wr * 64 + m * 16 + fr) * 1024 + u.pn * BM + wc * 32 + 8 * fq);
        asm volatile("" : "+v"(off));
        const float g = gl[ai * HALF + wr * 64 + m * 16 + fr];
#pragma unroll
        for (int bj = 0; bj < 2; ++bj) { f32x4 v0 = acc[ai][bj][m][0] * g, v1 = acc[ai][bj][m][1] * g;
#pragma unroll
            for (int i = 0; i < 4; ++i) { v0[i] = __builtin_amdgcn_fmed3f(v0[i], -448.f, 448.f); v1[i] = __builtin_amdgcn_fmed3f(v1[i], -448.f, 448.f); }
            u32x2 w; w.x = pk4_fp8(v0[0], v0[1], v0[2], v0[3]); w.y = pk4_fp8(v1[0], v1[1], v1[2], v1[3]);
            *(u32x2*)(Y + off + bj * HALF) = w; }
    }
    __device__ __forceinline__ void operator()(const f32x4 (&acc)[2][2][4][2], const Unit& u, int wr, int wc, int fr, int fq) const {
#pragma unroll
        for (int ai = 0; ai < 2; ++ai)
#pragma unroll
            for (int m = 0; m < 4; ++m) row(acc, u, ai, m, wr, wc, fr, fq);
    }
};

struct SchedProj {
    int G, c;
    __device__ __forceinline__ bool next(int i, Unit& u) const {
        if (i < 12) { const int x = c & 7, j = c >> 3, ja = j & 7, jb = j >> 3, r = i / 3, q = i - 3 * r;
            u.pm = x + 8 * (8 * r + ja); u.pn = 4 * q + jb; return true; }
        if (i == 12 && c < 128) { u.pm = 256 + (c >> 2); u.pn = 2 + (c & 3); return true; }
        return false;
    }
    __device__ __forceinline__ void a_ready(const Unit&) const {}
    __device__ __forceinline__ void done(const Unit&) const {}
};
struct SchedPanel {
    int pm, ntn;
    __device__ __forceinline__ bool next(int i, Unit& u) const { if (i >= ntn) return false; u.pm = pm; u.pn = i; return true; }
    __device__ __forceinline__ void a_ready(const Unit&) const {}
    __device__ __forceinline__ void done(const Unit&) const {}
};

typedef int i32x4v __attribute__((ext_vector_type(4)));
typedef int i32x8v __attribute__((ext_vector_type(8)));
__device__ __forceinline__ i32x8v cat8(bf16x8 a, bf16x8 b) { const i32x4v x = __builtin_bit_cast(i32x4v, a), y = __builtin_bit_cast(i32x4v, b); return __builtin_shufflevector(x, y, 0, 1, 2, 3, 4, 5, 6, 7); }
template <bool F8> struct Frag;
template <> struct Frag<false> { bf16x8 v[2]; __device__ __forceinline__ void set(bf16x8 a, bf16x8 b) { v[0] = a; v[1] = b; } };
template <> struct Frag<true> { i32x8v v; __device__ __forceinline__ void set(bf16x8 a, bf16x8 b) { v = cat8(a, b); } };
__device__ __forceinline__ f32x4 frag_mma(const Frag<false>& b, const Frag<false>& a, f32x4 c) { c = __builtin_amdgcn_mfma_f32_16x16x32_bf16(b.v[0], a.v[0], c, 0, 0, 0); return __builtin_amdgcn_mfma_f32_16x16x32_bf16(b.v[1], a.v[1], c, 0, 0, 0); }
__device__ __forceinline__ f32x4 frag_mma(const Frag<true>& b, const Frag<true>& a, f32x4 c) {
    const int sc1 = 0x7f7f7f7f;
    asm volatile("s_nop 1\n\tv_mfma_scale_f32_16x16x128_f8f6f4 %0, %1, %2, %0, %3, %3 op_sel_hi:[0,0,0]" : "+v"(c) : "v"(b.v), "v"(a.v), "v"(sc1));
    return c; }
template <class Epi, class Sched, bool ALIGN_EPI, bool SP2, bool GATHER = false, bool F8 = false, bool DEFER = false>
__device__ __forceinline__ void gemm_phase(LAS unsigned char* lds, const Gemm g, const Sched& S, const Epi& E) {
    const int tid = opaque_tid(), wid = __builtin_amdgcn_readfirstlane(tid >> 6), lane = tid & 63, wr = wid >> 2, wc = wid & 3, fr = lane & 15, fq = lane >> 4;
    const int K = g.K * (F8 ? 1 : 2), nt = K / 128;
    unsigned voffA[2][2], voffB[2];
#pragma unroll
    for (int i = 0; i < 2; ++i) { int R, C; stage_rc(tid * 16 + i * 8192, R, C); const int Rb = Epi::PERM ? ((R & ~31) + perm32(R & 31)) : R;
        if constexpr (GATHER) { voffA[0][i] = (unsigned)(g.gidx[R] * K + C * 2); voffA[1][i] = (unsigned)(g.gidx[HALF + R] * K + C * 2); }
        else { voffA[0][i] = (unsigned)(R * K + C * 2); voffA[1][i] = voffA[0][i]; }
        voffB[i] = (unsigned)(Rb * K + C * 2); }
    const size_t kstep = (size_t)(BK * 2);
    const size_t hstep = (size_t)HALF * K;
    const size_t hstepA = GATHER ? (size_t)0 : hstep;
    const size_t tstep = 2 * hstep;
    const unsigned ldsw = (unsigned)wid * 1024u;
    const int aoff = F8 ? lds_byte(wr * 64 + fr, (fq >> 1) * 32 + (fq & 1) * 16) : lds_byte(wr * 64 + fr, fq * 8), boff = F8 ? lds_byte(wc * 32 + fr, (fq >> 1) * 32 + (fq & 1) * 16) : lds_byte(wc * 32 + fr, fq * 8);
    const int aoff1 = F8 ? aoff + 16 : aoff + 1024, boff1 = F8 ? boff + 16 : boff + 1024;
#define PG8_SA(b, h) (((b) * 2 + (h)) * HTB)
#define PG8_SB(b, h) ((4 + (b) * 2 + (h)) * HTB)
#define PG8_STAGE(bufoff, gbase, voff) do { _Pragma("unroll") for (int _i = 0; _i < 2; ++_i) \
        __builtin_amdgcn_global_load_lds((const unsigned*)((const char*)(gbase) + (voff)[_i]), (LAS unsigned*)(lds + (bufoff) + ldsw + _i * 8192), 16, 0, 0); } while (0)
#define PG8_LDA(dst, b, h) do { _Pragma("unroll") for (int m = 0; m < 4; ++m) dst[m].set(*(const LAS bf16x8*)(lds + PG8_SA(b, h) + aoff + m * 2048), *(const LAS bf16x8*)(lds + PG8_SA(b, h) + aoff1 + m * 2048)); } while (0)
#define PG8_LDB(dst, b, h) do { _Pragma("unroll") for (int n = 0; n < 2; ++n) dst[n].set(*(const LAS bf16x8*)(lds + PG8_SB(b, h) + boff + n * 2048), *(const LAS bf16x8*)(lds + PG8_SB(b, h) + boff1 + n * 2048)); } while (0)
#define PG8_MMA(ai, bj, At, Bt) do { __builtin_amdgcn_s_setprio(1); _Pragma("unroll") for (int m = 0; m < 4; ++m) _Pragma("unroll") for (int n = 0; n < 2; ++n) \
        acc[ai][bj][m][n] = frag_mma(Bt[n], At[m], acc[ai][bj][m][n]); __builtin_amdgcn_s_setprio(0); } while (0)
#define PG8_MMA_E(ai, At, Bt) do { __builtin_amdgcn_s_setprio(1); _Pragma("unroll") for (int m = 0; m < 4; ++m) { \
        if constexpr (DEFER) { if (defer_now) { E.row(acc, pu, ai, m, wr, wc, fr, fq); \
            _Pragma("unroll") for (int n = 0; n < 2; ++n) { acc[ai][0][m][n] = (f32x4){0.f, 0.f, 0.f, 0.f}; acc[ai][1][m][n] = (f32x4){0.f, 0.f, 0.f, 0.f}; } } PG8_SCHED; } \
        _Pragma("unroll") for (int n = 0; n < 2; ++n) acc[ai][0][m][n] = frag_mma(Bt[n], At[m], acc[ai][0][m][n]); } __builtin_amdgcn_s_setprio(0); } while (0)
#define PG8_WAIT_V(n) asm volatile("s_waitcnt vmcnt(" #n ")" ::: "memory")
#define PG8_WAIT_L(n) asm volatile("s_waitcnt lgkmcnt(" #n ")" ::: "memory")
#define PG8_BAR __builtin_amdgcn_s_barrier()
#define PG8_SCHED __builtin_amdgcn_sched_barrier(0)
    Unit cur, nxt; int ui = 0;
    if (!S.next(0, cur)) return;
    f32x4 acc[2][2][4][2];
#pragma unroll
    for (int a = 0; a < 2; ++a)
#pragma unroll
        for (int b = 0; b < 2; ++b)
#pragma unroll
            for (int m = 0; m < 4; ++m)
#pragma unroll
                for (int n = 0; n < 2; ++n) acc[a][b][m][n] = (f32x4){0.f, 0.f, 0.f, 0.f};
    Frag<F8> At[4], B0[2], B1[2];
    bool pend = false; Unit pu = cur;
    const char* cA = (const char*)g.A + (size_t)cur.pm * tstep; const char* cB = (const char*)g.Bt + (size_t)cur.pn * tstep;
    S.a_ready(cur);
    if constexpr (SP2) {
        PG8_STAGE(PG8_SB(0, 0), cB, voffB); PG8_STAGE(PG8_SB(0, 1), cB + hstep, voffB); PG8_STAGE(PG8_SA(0, 0), cA, voffA[0]); PG8_STAGE(PG8_SA(0, 1), cA + hstepA, voffA[GATHER ? 1 : 0]);
        if (wr == 1) PG8_BAR;
        PG8_WAIT_V(2); PG8_BAR;
        PG8_STAGE(PG8_SB(1, 0), cB + kstep, voffB); PG8_STAGE(PG8_SA(1, 0), cA + kstep, voffA[0]); PG8_STAGE(PG8_SB(1, 1), cB + hstep + kstep, voffB);
        PG8_WAIT_V(6); PG8_BAR;
    } else {
        PG8_STAGE(PG8_SB(0, 0), cB, voffB); PG8_STAGE(PG8_SA(0, 0), cA, voffA[0]); PG8_STAGE(PG8_SB(0, 1), cB + hstep, voffB); PG8_STAGE(PG8_SA(0, 1), cA + hstepA, voffA[GATHER ? 1 : 0]);
        if (wr == 1) PG8_BAR;
        PG8_WAIT_V(4); PG8_BAR;
        PG8_STAGE(PG8_SB(1, 0), cB + kstep, voffB); PG8_STAGE(PG8_SA(1, 0), cA + kstep, voffA[0]); PG8_STAGE(PG8_SB(1, 1), cB + hstep + kstep, voffB);
        PG8_WAIT_V(6); PG8_BAR;
    }
    for (;;) {
        const bool has_next = S.next(ui + 1, nxt);
        const char* nA = has_next ? (const char*)g.A + (size_t)nxt.pm * tstep : cA; const char* nB = has_next ? (const char*)g.Bt + (size_t)nxt.pn * tstep : cB;
#pragma unroll 1
        for (int t = 0; t < nt; t += 2) {
            const bool last = (t == nt - 2);
            if constexpr (F8) { asm volatile("" : "+v"(voffA[0][0]), "+v"(voffA[0][1]), "+v"(voffB[0]), "+v"(voffB[1])); if constexpr (GATHER) asm volatile("" : "+v"(voffA[1][0]), "+v"(voffA[1][1])); }
            const char* a1 = cA + (size_t)(t + 1) * kstep;
            const char* a2 = last ? nA : cA + (size_t)(t + 2) * kstep; const char* b2 = last ? nB : cB + (size_t)(t + 2) * kstep;
            const char* a3 = a2 + kstep; const char* b3 = b2 + kstep;
            if (last && has_next) S.a_ready(nxt);
            if constexpr (SP2) {
            PG8_LDB(B0, 0, 0); PG8_LDB(B1, 0, 1); PG8_SCHED; PG8_LDA(At, 0, 0); PG8_STAGE(PG8_SA(1, 1), a1 + hstepA, voffA[GATHER ? 1 : 0]);
            bool defer_now = false; if constexpr (DEFER) defer_now = pend && t == 0;
            PG8_WAIT_V(8); PG8_WAIT_L(0); PG8_BAR; PG8_MMA_E(0, At, B0); PG8_MMA(0, 1, At, B1); PG8_BAR; PG8_SCHED;
            PG8_LDA(At, 0, 1); PG8_STAGE(PG8_SB(0, 0), b2, voffB); PG8_STAGE(PG8_SB(0, 1), b2 + hstep, voffB); PG8_STAGE(PG8_SA(0, 0), a2, voffA[0]);
            PG8_WAIT_V(8); PG8_WAIT_L(0); PG8_BAR; PG8_MMA_E(1, At, B0); PG8_MMA(1, 1, At, B1); PG8_BAR; PG8_SCHED;
            PG8_LDB(B0, 1, 0); PG8_LDB(B1, 1, 1); PG8_SCHED; PG8_LDA(At, 1, 0); PG8_STAGE(PG8_SA(0, 1), a2 + hstepA, voffA[GATHER ? 1 : 0]);
            PG8_WAIT_V(8); PG8_WAIT_L(0); PG8_BAR; PG8_MMA(0, 0, At, B0); PG8_MMA(0, 1, At, B1); PG8_BAR; PG8_SCHED;
            PG8_LDA(At, 1, 1); PG8_STAGE(PG8_SB(1, 0), b3, voffB); PG8_STAGE(PG8_SB(1, 1), b3 + hstep, voffB); PG8_STAGE(PG8_SA(1, 0), a3, voffA[0]);
            PG8_WAIT_V(8); PG8_WAIT_L(0); PG8_BAR; PG8_MMA(1, 0, At, B0); PG8_MMA(1, 1, At, B1); PG8_BAR; PG8_SCHED;
            } else {
            PG8_LDB(B0, 0, 0); PG8_SCHED; PG8_LDA(At, 0, 0); PG8_STAGE(PG8_SA(1, 1), a1 + hstepA, voffA[GATHER ? 1 : 0]);
            PG8_WAIT_L(8); PG8_BAR; PG8_WAIT_L(0); PG8_MMA(0, 0, At, B0); PG8_BAR; PG8_SCHED;
            PG8_LDB(B1, 0, 1); PG8_STAGE(PG8_SB(0, 0), b2, voffB);
            PG8_BAR; PG8_WAIT_L(0); PG8_MMA(0, 1, At, B1); PG8_BAR;
            PG8_LDA(At, 0, 1); PG8_STAGE(PG8_SA(0, 0), a2, voffA[0]);
            PG8_BAR; PG8_WAIT_L(0); PG8_MMA(1, 0, At, B0); PG8_BAR; PG8_SCHED;
            PG8_STAGE(PG8_SB(0, 1), b2 + hstep, voffB);
            PG8_WAIT_V(6); PG8_BAR; PG8_MMA(1, 1, At, B1); PG8_BAR;
            PG8_LDB(B0, 1, 0); PG8_SCHED; PG8_LDA(At, 1, 0); PG8_STAGE(PG8_SA(0, 1), a2 + hstepA, voffA[GATHER ? 1 : 0]);
            PG8_WAIT_L(8); PG8_BAR; PG8_WAIT_L(0); PG8_MMA(0, 0, At, B0); PG8_BAR; PG8_SCHED;
            PG8_LDB(B1, 1, 1); PG8_STAGE(PG8_SB(1, 0), b3, voffB);
            PG8_BAR; PG8_WAIT_L(0); PG8_MMA(0, 1, At, B1); PG8_BAR;
            PG8_LDA(At, 1, 1); PG8_STAGE(PG8_SA(1, 0), a3, voffA[0]);
            PG8_BAR; PG8_WAIT_L(0); PG8_MMA(1, 0, At, B0); PG8_BAR; PG8_SCHED;
            PG8_STAGE(PG8_SB(1, 1), b3 + hstep, voffB);
            PG8_WAIT_V(6); PG8_BAR; PG8_MMA(1, 1, At, B1); PG8_BAR;
            }
        }
        if (DEFER && has_next) { pend = true; pu = cur; cur = nxt; cA = nA; cB = nB; ++ui; continue; }
        if constexpr (ALIGN_EPI) { if (wr == 0) PG8_BAR; }
        if constexpr (F8) asm volatile("s_nop 15\n\ts_nop 7" ::: "memory");
        E(acc, cur, wr, wc, fr, fq); S.done(cur);
        if (!has_next) break;
#pragma unroll
        for (int a = 0; a < 2; ++a)
#pragma unroll
            for (int b = 0; b < 2; ++b)
#pragma unroll
                for (int m = 0; m < 4; ++m)
#pragma unroll
                    for (int n = 0; n < 2; ++n) acc[a][b][m][n] = (f32x4){0.f, 0.f, 0.f, 0.f};
        cur = nxt; cA = nA; cB = nB; ++ui;
        if constexpr (ALIGN_EPI) { if (wr == 1) PG8_BAR; }
    }
    PG8_WAIT_V(0);
    if constexpr (!ALIGN_EPI) { if (wr == 0) PG8_BAR; }
    PG8_BAR;
#undef PG8_SA
#undef PG8_SB
#undef PG8_STAGE
#undef PG8_LDA
#undef PG8_LDB
#undef PG8_MMA
#undef PG8_WAIT_V
#undef PG8_WAIT_L
#undef PG8_BAR
#undef PG8_SCHED
}
}

typedef GAS unsigned gu32;
#define RLX_AGENT __ATOMIC_RELAXED, __HIP_MEMORY_SCOPE_AGENT
#define LDS_WAIT() asm volatile("s_waitcnt lgkmcnt(0)" ::: "memory")
#define VM_WAIT() asm volatile("s_waitcnt vmcnt(0)" ::: "memory")
__device__ __forceinline__ unsigned pk2(float lo, float hi) { return pg8::cvt_pk_bf16(lo, hi); }
__device__ __forceinline__ float bf2f(unsigned short h) { return __uint_as_float((unsigned)h << 16); }
__device__ __forceinline__ float bflo(unsigned w) { return __uint_as_float(w << 16); }
__device__ __forceinline__ float bfhi(unsigned w) { return __uint_as_float(w & 0xffff0000u); }
__device__ __forceinline__ float wave_sum(float v) {
    v += __builtin_bit_cast(float, __builtin_amdgcn_update_dpp(0, __builtin_bit_cast(int, v), 0xB1, 0xf, 0xf, true));
    v += __builtin_bit_cast(float, __builtin_amdgcn_update_dpp(0, __builtin_bit_cast(int, v), 0x4E, 0xf, 0xf, true));
    v += __builtin_bit_cast(float, __builtin_amdgcn_update_dpp(0, __builtin_bit_cast(int, v), 0x141, 0xf, 0xf, true));
    v += __builtin_bit_cast(float, __builtin_amdgcn_update_dpp(0, __builtin_bit_cast(int, v), 0x140, 0xf, 0xf, true));
    v += __builtin_bit_cast(float, __builtin_amdgcn_update_dpp(0, __builtin_bit_cast(int, v), 0x142, 0xa, 0xf, false));
    v += __builtin_bit_cast(float, __builtin_amdgcn_update_dpp(0, __builtin_bit_cast(int, v), 0x143, 0xc, 0xf, false));
    return __builtin_bit_cast(float, __builtin_amdgcn_readlane(__builtin_bit_cast(int, v), 63));
}

#define XB_TMO      128
#define XB_XCNT(j)  (256  + 64 * (j))
#define XB_XSUB(j)  (1280 + 64 * (j))
#define XB_XGEN(j)  (2304 + 64 * (j))
#define XB_TOP      3328
#define XB_TOPGEN   3392
#define XCD_BAR_WORDS 3456
#define XB_SPIN_CAP (1u << 18)
__device__ __forceinline__ unsigned xb_ld(unsigned* p)              { return __hip_atomic_load(p, __ATOMIC_RELAXED, __HIP_MEMORY_SCOPE_AGENT); }
__device__ __forceinline__ unsigned xb_add(unsigned* p, unsigned v) { return __hip_atomic_fetch_add(p, v, __ATOMIC_RELAXED, __HIP_MEMORY_SCOPE_AGENT); }
__device__ __forceinline__ unsigned xb_xcc_id() { return (unsigned)__builtin_amdgcn_s_getreg((3 << 11) | 20) & 0xFu; }
#define XB_SPIN(cond, bar) do { unsigned _sp = 0; while (cond) { __builtin_amdgcn_s_sleep(1); \
    if ((++_sp & 255u) == 0u) { if (xb_ld(&(bar)[XB_TMO])) break; if (_sp > XB_SPIN_CAP) { atomicAdd(&(bar)[XB_TMO], 1u); break; } } } } while (0)
struct XcdBarrier { unsigned* bar; unsigned x; volatile LAS unsigned* st; };
__device__ __forceinline__ XcdBarrier xcd_barrier_post(unsigned* bar, volatile LAS unsigned* st) {
    XcdBarrier b; b.bar = bar; b.x = xb_xcc_id(); b.st = st;
    if (threadIdx.x == 0) (void)xb_add(&bar[XB_XCNT(b.x)], 1u);
    return b;
}
__device__ __forceinline__ void xcd_barrier_complete(unsigned* bar, unsigned x, unsigned& nloc, unsigned& nx) {
    const unsigned G = gridDim.x * gridDim.y * gridDim.z;
    unsigned sum, cnt, mine, sp = 0u;
    for (;;) {
        sum = 0u; cnt = 0u; mine = 0u;
#pragma unroll
        for (unsigned j = 0; j < 16; ++j) { const unsigned c = xb_ld(&bar[XB_XCNT(j)]); sum += c; cnt += (c > 0u) ? 1u : 0u; mine = (j == x) ? c : mine; }
        if (sum == G) break;
        __builtin_amdgcn_s_sleep(1);
        if ((++sp & 255u) == 0u) { if (xb_ld(&bar[XB_TMO])) break; if (sp > XB_SPIN_CAP) { atomicAdd(&bar[XB_TMO], 1u); break; } }
    }
    nloc = mine > 0u ? mine : 1u; nx = cnt > 0u ? cnt : 1u;
}
__device__ __forceinline__ void xcd_barrier(const XcdBarrier& b) {
    asm volatile("s_waitcnt vmcnt(0)" ::: "memory");
    __syncthreads();
    if (threadIdx.x == 0) {
        unsigned* bar = b.bar;
        __builtin_amdgcn_s_waitcnt(0);
        unsigned nloc = b.st[0], nx = b.st[1];
        if (nloc == 0u) { xcd_barrier_complete(bar, b.x, nloc, nx); b.st[0] = nloc; b.st[1] = nx; }
        const unsigned old = xb_add(&bar[XB_XSUB(b.x)], 1u);
        const unsigned gen = old / nloc;
        if (old + 1u == (gen + 1u) * nloc) {
            __builtin_amdgcn_fence(__ATOMIC_RELEASE, "agent");
            asm volatile("s_waitcnt vmcnt(0)" ::: "memory");
            const unsigned og = xb_add(&bar[XB_TOP], 1u);
            const unsigned tg = og / nx;
            if (og + 1u == (tg + 1u) * nx) xb_add(&bar[XB_TOPGEN], 1u);
            else XB_SPIN(xb_ld(&bar[XB_TOPGEN]) == tg, bar);
            __builtin_amdgcn_fence(__ATOMIC_ACQUIRE, "agent");
            xb_add(&bar[XB_XGEN(b.x)], 1u);
            asm volatile("s_waitcnt vmcnt(0)" ::: "memory");
        } else {
            XB_SPIN(xb_ld(&bar[XB_XGEN(b.x)]) == gen, bar);
            __builtin_amdgcn_fence(__ATOMIC_ACQUIRE, "agent");
            asm volatile("s_waitcnt vmcnt(0)" ::: "memory");
        }
    }
    __syncthreads();
}

constexpr int RING_BYTES = 131072;
constexpr int LDSCTL_OFF = RING_BYTES, MISC_OFF = LDSCTL_OFF + 320;
constexpr int LDS_BYTES = 147456;
constexpr int CW_BAR = 4096;
constexpr int CW_KMAX = 65536;

struct Args { const float* in[22]; float* out; unsigned char* ws; int ph_lo, ph_hi; };
enum { I_X = 0, I_C, I_CTX, I_CCTX, I_WADA, I_BADA, I_NPRE_MIX, I_NPOST_MIX, I_NPRE_FFN, I_NPOST_FFN, I_WIN, I_CONVW, I_LQ1, I_LK1, I_LQ2, I_LK2, I_SUBLN, I_WOUT, I_WROUTER, I_WGATE, I_WUP, I_WDOWN };

__device__ __forceinline__ int win_dest(int n) {
    if (n < 1024) { const int j = n & 63; const int p = ((j >> 5) << 5) + ((j & 15) << 1) + ((j >> 4) & 1); return (n & ~63) + p; }
    if (n < 1536) { const int dv = n & 127; return (n & ~127) + ((dv & 3) << 5) + (dv >> 2); }
    if (n < 2048) return n;
    int c = n - 2048; const int isx = c >= 512; c &= 511; return 2048 + ((c >> 7) << 8) + (isx << 7) + (c & 127);
}
template <int MODE>
__device__ __forceinline__ int tr_dest(int n) {
    if (MODE == 0) return n;
    if (MODE == 1) return win_dest(n);
    if (MODE == 2) return ((n >> 7) << 8) + (n & 127);
    return ((n >> 7) << 8) + 128 + (n & 127);
}
template <int MODE>
__device__ __forceinline__ void p0_transpose_item_f8(const float* W, int K, int N, unsigned char* WT, LAS float* scr, int item, int lane) {
    const int nblk = N / 32, kb = item / nblk, nb = item % nblk, k0 = 64 * kb, n0 = 32 * nb;
#pragma unroll 8
    for (int i = 0; i < 32; ++i) { const int kk = 2 * i + (lane >> 5); scr[kk * 33 + (lane & 31)] = __builtin_nontemporal_load(W + (size_t)(k0 + kk) * N + n0 + (lane & 31)) * pg8::F8_WGT; }
    LDS_WAIT(); asm volatile("" ::: "memory");
    const int c = lane & 7;
#pragma unroll
    for (int j = 0; j < 4; ++j) { const int n = (lane >> 3) + 8 * j; const LAS float* s = scr + (8 * c) * 33 + n;
        u32x2 o; o.x = pg8::pk4_fp8(s[0 * 33], s[1 * 33], s[2 * 33], s[3 * 33]); o.y = pg8::pk4_fp8(s[4 * 33], s[5 * 33], s[6 * 33], s[7 * 33]);
        *(GAS u32x2*)(WT + (size_t)tr_dest<MODE>(n0 + n) * K + k0 + 8 * c) = o; }
    LDS_WAIT(); asm volatile("" ::: "memory");
}
template <int MODE>
__device__ __forceinline__ void p0_transpose_item(const float* W, int K, int N, bf16_t* WT, LAS float* scr, int item, int lane) {
    const int nblk = N / 32, kb = item / nblk, nb = item % nblk, k0 = 64 * kb, n0 = 32 * nb;
#pragma unroll 8
    for (int i = 0; i < 32; ++i) { const int kk = 2 * i + (lane >> 5); scr[kk * 33 + (lane & 31)] = W[(size_t)(k0 + kk) * N + n0 + (lane & 31)]; }
    LDS_WAIT(); asm volatile("" ::: "memory");
    const int c = lane & 7;
#pragma unroll
    for (int j = 0; j < 4; ++j) { const int n = (lane >> 3) + 8 * j; const LAS float* s = scr + (8 * c) * 33 + n;
        u32x4 o; o.x = pk2(s[0 * 33], s[1 * 33]); o.y = pk2(s[2 * 33], s[3 * 33]); o.z = pk2(s[4 * 33], s[5 * 33]); o.w = pk2(s[6 * 33], s[7 * 33]);
        *(GAS u32x4*)(WT + (size_t)tr_dest<MODE>(n0 + n) * K + k0 + 8 * c) = o; }
    LDS_WAIT(); asm volatile("" ::: "memory");
}

__device__ __forceinline__ void p0_prologue(const Args& a, LAS unsigned char* lds, int vcu, int G) {
    const int tid = opaque_tid(), lane = tid & 63, wave = __builtin_amdgcn_readfirstlane(tid >> 6);
    LAS float* scr = (LAS float*)(lds + wave * 16384);
    const int gw = vcu * NWAVES + wave, NGW = G * NWAVES;
    unsigned char* ws = a.ws;
    if (gw < 96 * 16) {
        float* MODP = (float*)(ws + WS_MODP);
        const float* wada = a.in[I_WADA];
        for (int it = gw; it < 96 * 16; it += NGW) {
            const int cg = it % 96, kc = it / 96;
            for (int b = 0; b < 33; ++b) { const float v = (b < 32) ? a.in[I_C][b * D + kc * 64 + lane] : a.in[I_CCTX][kc * 64 + lane]; scr[b * 64 + lane] = v / (1.f + __expf(-v)); }
            LDS_WAIT(); asm volatile("" ::: "memory");
            float acc[33];
#pragma unroll
            for (int b = 0; b < 33; ++b) acc[b] = 0.f;
            const float* wp = wada + (size_t)(kc * 64) * NMOD + cg * 64 + lane;
#pragma unroll 2
            for (int k = 0; k < 64; k += 4) {
                const float w0 = __builtin_nontemporal_load(wp + (size_t)(k + 0) * NMOD), w1 = __builtin_nontemporal_load(wp + (size_t)(k + 1) * NMOD),
                            w2 = __builtin_nontemporal_load(wp + (size_t)(k + 2) * NMOD), w3 = __builtin_nontemporal_load(wp + (size_t)(k + 3) * NMOD);
#pragma unroll
                for (int b = 0; b < 33; ++b) { const f32x4 sv4 = *(const LAS f32x4*)(scr + b * 64 + k); acc[b] += (sv4.x * w0 + sv4.y * w1) + (sv4.z * w2 + sv4.w * w3); }
            }
#pragma unroll
            for (int b = 0; b < 33; ++b) MODP[((size_t)kc * 33 + b) * NMOD + cg * 64 + lane] = acc[b];
            LDS_WAIT(); asm volatile("" ::: "memory");
        }
    } else {
        float* tab = (float*)(ws + WS_TAB);
        const int nw = NGW - 96 * 16;
        for (int e = (gw - 96 * 16) * 64 + lane; e < T * 32; e += nw * 64) {
            const int t = e >> 5, i = e & 31;
            const float inv = powf(10000.0f, -(float)(2 * (i & 15)) / 32.0f);
            const float pos = (i < 16) ? (float)(t >> 6) : (float)(t & 63);
            const float ang = pos * inv;
            tab[2 * e] = cosf(ang); tab[2 * e + 1] = sinf(ang);
        }
    }
}
__device__ __forceinline__ void inout_weight_copies(const Args& a, LAS unsigned char* lds, int vcu, int G) {
    const int tid = opaque_tid(), lane = tid & 63, wave = __builtin_amdgcn_readfirstlane(tid >> 6);
    LAS float* scr = (LAS float*)(lds + 16384 + wave * 12288);
    const int gw = vcu * NWAVES + wave, NGW = G * NWAVES;
    unsigned char* ws = a.ws;
    constexpr int I_IN = (D / 64) * (NPROJ / 32), I_OUT = (D / 64) * (D / 32);
    constexpr int NITEMS = I_IN + I_OUT;
    bf16_t* Win_t = (bf16_t*)(ws + WS_WIN); bf16_t* Wout_t = (bf16_t*)(ws + WS_WOUT);
    for (int it = gw; it < NITEMS; it += NGW) {
        int r = it;
        if (r < I_IN) { p0_transpose_item<1>(a.in[I_WIN], D, NPROJ, Win_t, scr, r, lane); continue; } r -= I_IN;
        p0_transpose_item<0>(a.in[I_WOUT], D, D, Wout_t, scr, r, lane);
    }
}
constexpr int EWC_END = 24576, EWC_P6 = 7680, EWC_P2 = 5120;
__device__ __forceinline__ void expert_weight_copies_w(const Args& a, LAS float* scr, int lane, int gw, int NGW, int r_lo, int r_hi) {
    unsigned char* ws = a.ws;
    constexpr int I_EXP = (D / 64) * (D / 32);
    unsigned char* Wgu_t = ws + WS_WGU; unsigned char* Wdn_t = ws + WS_WDN;
    for (int r = r_lo + gw; r < r_hi; r += NGW) {
        const int e = r / (3 * I_EXP), q = (r % (3 * I_EXP)) / I_EXP, rr = r % I_EXP;
        if (q == 0) p0_transpose_item_f8<2>(a.in[I_WGATE] + (size_t)e * D * D, D, D, Wgu_t + (size_t)e * 2048 * D, scr, rr, lane);
        else if (q == 1) p0_transpose_item_f8<3>(a.in[I_WUP] + (size_t)e * D * D, D, D, Wgu_t + (size_t)e * 2048 * D, scr, rr, lane);
        else p0_transpose_item_f8<0>(a.in[I_WDOWN] + (size_t)e * D * D, D, D, Wdn_t + (size_t)e * D * D, scr, rr, lane);
    }
}
__device__ __forceinline__ void expert_weight_copies(const Args& a, LAS unsigned char* lds, int gw0  , int ngroups, int r_lo, int r_hi) {
    const int tid = opaque_tid(), lane = tid & 63, wave = __builtin_amdgcn_readfirstlane(tid >> 6);
    expert_weight_copies_w(a, (LAS float*)(lds + wave * 16384), lane, gw0 * NWAVES + wave, ngroups * NWAVES, r_lo, r_hi);
    __syncthreads();
}

struct RowF { f32x4 v[4]; };
__device__ __forceinline__ void row_load(RowF& r, const float* xrow, int lane) {
    const f32x4* xr = (const f32x4*)xrow + lane;
#pragma unroll
    for (int j = 0; j < 4; ++j) r.v[j] = __builtin_nontemporal_load(xr + 64 * j);
}
__device__ __forceinline__ void norm_mod_row(const RowF& r, bf16_t* orow, const f32x4 (&gain)[4], const LAS float* sc, const LAS float* sh, int lane) {
    float s = 0.f;
#pragma unroll
    for (int j = 0; j < 4; ++j) s += (r.v[j].x * r.v[j].x + r.v[j].y * r.v[j].y) + (r.v[j].z * r.v[j].z + r.v[j].w * r.v[j].w);
    const float rstd = 1.0f / sqrtf(wave_sum(s) * (1.f / D) + EPS);
    u32x2* o8 = (u32x2*)orow + lane;
#pragma unroll
    for (int j = 0; j < 4; ++j) { const f32x4 g = gain[j]; const f32x4 c1 = *(const LAS f32x4*)(sc + 4 * lane + 256 * j), h1 = *(const LAS f32x4*)(sh + 4 * lane + 256 * j);
        const f32x4 y = (r.v[j] * rstd) * g; const f32x4 z = y * (c1 + 1.0f) + h1;
        u32x2 w; w.x = pk2(z.x, z.y); w.y = pk2(z.z, z.w); o8[64 * j] = w; }
}
__device__ __forceinline__ void p1_xn(const Args& a, LAS unsigned char* lds, int c, int G) {
    const int tid = opaque_tid(), lane = tid & 63, wave = __builtin_amdgcn_readfirstlane(tid >> 6);
    unsigned char* ws = a.ws;
    const float* MODP = (const float*)(ws + WS_MODP); float* MOD = (float*)(ws + WS_MOD); const float* bada = a.in[I_BADA];
    { const int per = (33 * NMOD + G - 1) / G;
      for (int i = c * per + tid; i < (c + 1) * per && i < 33 * NMOD; i += NTHREADS) { const int r = i / NMOD, n = i - r * NMOD; float s = bada[n];
#pragma unroll
            for (int kc = 0; kc < 16; ++kc) s += MODP[((size_t)kc * 33 + r) * NMOD + n];
            MOD[i] = s; } }
    LAS float* sv = (LAS float*)lds;
    bf16_t* XN = (bf16_t*)(ws + WS_XN);
    const float* X = a.in[I_X]; const float* CTX = a.in[I_CTX];
    f32x4 gain[4];
#pragma unroll
    for (int j = 0; j < 4; ++j) gain[j] = ((const f32x4*)a.in[I_NPRE_MIX])[lane + 64 * j];
    for (int p = c; p < 256; p += G) {
        const int b = p >> 3;
        const int rbase = p * 256 + wave * 32;
        RowF a0, a1, a2, a3;
        row_load(a0, X + (size_t)rbase * D, lane); row_load(a1, X + (size_t)(rbase + 1) * D, lane); row_load(a2, X + (size_t)(rbase + 2) * D, lane); row_load(a3, X + (size_t)(rbase + 3) * D, lane);
        __syncthreads();
        for (int n = tid; n < 4096; n += NTHREADS) { const int r = (n < 2048) ? b : 32; const int col = n & 2047; float s = bada[col];
#pragma unroll
            for (int kc = 0; kc < 16; ++kc) s += MODP[((size_t)kc * 33 + r) * NMOD + col];
            sv[n] = s; }
        __syncthreads();
        const int crow = p * 32 + wave * 4;
        for (int i = 0; i < 8; ++i) {
            RowF n0, n1, n2, n3;
            const float* nx = (i + 1 < 8) ? X + (size_t)(rbase + 4 * (i + 1)) * D : CTX + (size_t)crow * D;
            row_load(n0, nx, lane); row_load(n1, nx + D, lane); row_load(n2, nx + 2 * D, lane); row_load(n3, nx + 3 * D, lane);
            bf16_t* orow = XN + (size_t)(rbase + 4 * i) * D;
            norm_mod_row(a0, orow, gain, sv + 1024, sv, lane);
            norm_mod_row(a1, orow + D, gain, sv + 1024, sv, lane);
            norm_mod_row(a2, orow + 2 * D, gain, sv + 1024, sv, lane);
            norm_mod_row(a3, orow + 3 * D, gain, sv + 1024, sv, lane);
            a0 = n0; a1 = n1; a2 = n2; a3 = n3;
        }
        { bf16_t* orow = XN + (size_t)(M + crow) * D;
          norm_mod_row(a0, orow, gain, sv + 3072, sv + 2048, lane);
          norm_mod_row(a1, orow + D, gain, sv + 3072, sv + 2048, lane);
          norm_mod_row(a2, orow + 2 * D, gain, sv + 3072, sv + 2048, lane);
          norm_mod_row(a3, orow + 3 * D, gain, sv + 3072, sv + 2048, lane); }
    }
}

__device__ __forceinline__ float half_sum32(float v, int hi) {
    v += __builtin_bit_cast(float, __builtin_amdgcn_update_dpp(0, __builtin_bit_cast(int, v), 0xB1, 0xf, 0xf, true));
    v += __builtin_bit_cast(float, __builtin_amdgcn_update_dpp(0, __builtin_bit_cast(int, v), 0x4E, 0xf, 0xf, true));
    v += __builtin_bit_cast(float, __builtin_amdgcn_update_dpp(0, __builtin_bit_cast(int, v), 0x141, 0xf, 0xf, true));
    v += __builtin_bit_cast(float, __builtin_amdgcn_update_dpp(0, __builtin_bit_cast(int, v), 0x140, 0xf, 0xf, true));
    v += __builtin_bit_cast(float, __builtin_amdgcn_update_dpp(0, __builtin_bit_cast(int, v), 0x142, 0xa, 0xf, false));
    const float s0 = __builtin_bit_cast(float, __builtin_amdgcn_readlane(__builtin_bit_cast(int, v), 31)), s1 = __builtin_bit_cast(float, __builtin_amdgcn_readlane(__builtin_bit_cast(int, v), 63));
    return hi ? s1 : s0;
}
namespace att {
constexpr int KP = 272, KBUF = 64 * KP, VBUF = 16384;
constexpr int OFF_K = 0, OFF_V = 2 * KBUF, OFF_WSF = OFF_V + 2 * VBUF, OFF_END = OFF_WSF + NWAVES * 256;
static_assert(OFF_WSF >= 65536 && OFF_END <= RING_BYTES, "attention LDS map");
constexpr int NT = TK / 64;
constexpr float THR = 8.0f;
__device__ __forceinline__ int crow(int r, int hi) { return (r & 3) + 8 * (r >> 2) + 4 * hi; }
__device__ __forceinline__ float max3f(float a, float b, float c) { float r; asm("v_max3_f32 %0, %1, %2, %3" : "=v"(r) : "v"(a), "v"(b), "v"(c)); return r; }
__device__ __forceinline__ float max2f(float a, float b) { float r; asm("v_max_f32_e32 %0, %1, %2" : "=v"(r) : "v"(a), "v"(b)); return r; }
__device__ __forceinline__ s16x4 vtr(const LAS unsigned char* p) { return __builtin_bit_cast(s16x4, __builtin_amdgcn_ds_read_tr16_b64_v4i16((LAS s16x4*)p)); }

#define ATT_BAR() asm volatile("s_waitcnt lgkmcnt(0)\n\ts_barrier" ::: "memory")
#define ATT_SB() __builtin_amdgcn_sched_barrier(0)
#define ATT_KLD(i, KF) KF = *(const LAS bf16x8*)(kb_ + ((i) & 1) * (32 * KP) + ((i) >> 1) * 32)
#define ATT_XSTEP(i, KC, KN) do { if ((i) + 2 < 8) { ATT_KLD((i) + 2, KN); } \
    if ((i) == 0) p0 = __builtin_amdgcn_mfma_f32_32x32x16_bf16(KC, qr[0], negref, 0, 0, 0); \
    else if ((i) == 1) p1 = __builtin_amdgcn_mfma_f32_32x32x16_bf16(KC, qr[0], negref, 0, 0, 0); \
    else if (((i) & 1) == 0) p0 = __builtin_amdgcn_mfma_f32_32x32x16_bf16(KC, qr[(i) >> 1], p0, 0, 0, 0); else p1 = __builtin_amdgcn_mfma_f32_32x32x16_bf16(KC, qr[(i) >> 1], p1, 0, 0, 0); ATT_SB(); } while (0)
#define ATT_X(kcur) do { \
    const LAS unsigned char* kb_ = lds + OFF_K + (kcur) * KBUF + koff; \
    bf16x8 ka_, kb2_, kc_; \
    ATT_KLD(0, ka_); ATT_KLD(1, kb2_); \
    ATT_SB(); \
    ATT_XSTEP(0, ka_, kc_); ATT_XSTEP(1, kb2_, ka_); ATT_XSTEP(2, kc_, kb2_); ATT_XSTEP(3, ka_, kc_); \
    ATT_XSTEP(4, kb2_, ka_); ATT_XSTEP(5, kc_, kb2_); ATT_XSTEP(6, ka_, kc_); ATT_XSTEP(7, kb2_, ka_); \
} while (0)
#define ATT_EXP2(i, PWN) do { \
    const float e0_ = __builtin_amdgcn_exp2f((i) < 8 ? p0[2 * ((i) & 7)] : p1[2 * ((i) & 7)]), e1_ = __builtin_amdgcn_exp2f((i) < 8 ? p0[2 * ((i) & 7) + 1] : p1[2 * ((i) & 7) + 1]); \
    sacc_ += e0_ + e1_; PWN[(i) >> 2][(i) & 3] = pk2(e0_, e1_); asm volatile("" : "+v"(PWN[(i) >> 2]), "+v"(sacc_)); } while (0)
#define ATT_VLD(i, LO, HI) do { LO = vtr(vb_ + ((i) & 3) * 4096 + ((i) >> 2) * 1024); HI = vtr(vb_ + ((i) & 3) * 4096 + ((i) >> 2) * 1024 + 512); } while (0)
#define ATT_VF(LO, HI) ((bf16x8){LO[0], LO[1], LO[2], LO[3], HI[0], HI[1], HI[2], HI[3]})
#define ATT_YSTEP(i, PWC, PWN, LC, HC, LN, HN) do { if ((i) + 2 < 16) { ATT_VLD((i) + 2, LN, HN); } \
    o[(i) & 3] = __builtin_amdgcn_mfma_f32_32x32x16_bf16(__builtin_bit_cast(bf16x8, PWC[(i) >> 2]), ATT_VF(LC, HC), o[(i) & 3], 0, 0, 0); \
    ATT_EXP2(i, PWN); ATT_SB(); } while (0)
#define ATT_Y(vcur, PWC, PWN) do { \
    const LAS unsigned char* vb_ = lds + OFF_V + (vcur) * VBUF + voff; \
    float sacc_ = 0.f; s16x4 la_, ha_, lb_, hb_, lc_, hc_; \
    ATT_VLD(0, la_, ha_); ATT_VLD(1, lb_, hb_); ATT_SB(); \
    ATT_YSTEP(0, PWC, PWN, la_, ha_, lc_, hc_); ATT_YSTEP(1, PWC, PWN, lb_, hb_, la_, ha_); ATT_YSTEP(2, PWC, PWN, lc_, hc_, lb_, hb_); \
    ATT_YSTEP(3, PWC, PWN, la_, ha_, lc_, hc_); ATT_YSTEP(4, PWC, PWN, lb_, hb_, la_, ha_); ATT_YSTEP(5, PWC, PWN, lc_, hc_, lb_, hb_); \
    ATT_YSTEP(6, PWC, PWN, la_, ha_, lc_, hc_); ATT_YSTEP(7, PWC, PWN, lb_, hb_, la_, ha_); ATT_YSTEP(8, PWC, PWN, lc_, hc_, lb_, hb_); \
    ATT_YSTEP(9, PWC, PWN, la_, ha_, lc_, hc_); ATT_YSTEP(10, PWC, PWN, lb_, hb_, la_, ha_); ATT_YSTEP(11, PWC, PWN, lc_, hc_, lb_, hb_); \
    ATT_YSTEP(12, PWC, PWN, la_, ha_, lc_, hc_); ATT_YSTEP(13, PWC, PWN, lb_, hb_, la_, ha_); ATT_YSTEP(14, PWC, PWN, lc_, hc_, lb_, hb_); \
    ATT_YSTEP(15, PWC, PWN, la_, ha_, lc_, hc_); \
    l_reg += sacc_; \
} while (0)
#define ATT_Y0(PWN) do { float sacc_ = 0.f; _Pragma("unroll") for (int i = 0; i < 16; ++i) ATT_EXP2(i, PWN); l_reg += sacc_; } while (0)
#define ATT_ZSTEP(i, PWC, LC, HC, LN, HN) do { if ((i) + 2 < 16) { ATT_VLD((i) + 2, LN, HN); } \
    o[(i) & 3] = __builtin_amdgcn_mfma_f32_32x32x16_bf16(__builtin_bit_cast(bf16x8, PWC[(i) >> 2]), ATT_VF(LC, HC), o[(i) & 3], 0, 0, 0); ATT_SB(); } while (0)
#define ATT_Z(vcur, PWC) do { \
    const LAS unsigned char* vb_ = lds + OFF_V + (vcur) * VBUF + voff; \
    s16x4 la_, ha_, lb_, hb_, lc_, hc_; \
    ATT_VLD(0, la_, ha_); ATT_VLD(1, lb_, hb_); ATT_SB(); \
    ATT_ZSTEP(0, PWC, la_, ha_, lc_, hc_); ATT_ZSTEP(1, PWC, lb_, hb_, la_, ha_); ATT_ZSTEP(2, PWC, lc_, hc_, lb_, hb_); \
    ATT_ZSTEP(3, PWC, la_, ha_, lc_, hc_); ATT_ZSTEP(4, PWC, lb_, hb_, la_, ha_); ATT_ZSTEP(5, PWC, lc_, hc_, lb_, hb_); \
    ATT_ZSTEP(6, PWC, la_, ha_, lc_, hc_); ATT_ZSTEP(7, PWC, lb_, hb_, la_, ha_); ATT_ZSTEP(8, PWC, lc_, hc_, lb_, hb_); \
    ATT_ZSTEP(9, PWC, la_, ha_, lc_, hc_); ATT_ZSTEP(10, PWC, lb_, hb_, la_, ha_); ATT_ZSTEP(11, PWC, lc_, hc_, lb_, hb_); \
    ATT_ZSTEP(12, PWC, la_, ha_, lc_, hc_); ATT_ZSTEP(13, PWC, lb_, hb_, la_, ha_); ATT_ZSTEP(14, PWC, lc_, hc_, lb_, hb_); \
    ATT_ZSTEP(15, PWC, la_, ha_, lc_, hc_); \
} while (0)
#define ATT_STAGE(j) do { \
    if ((j) + 1 < NT) { _Pragma("unroll") for (int i = 0; i < 2; ++i) *(LAS u32x4*)(lds + OFF_K + (((j) + 1) & 1) * KBUF + kdst[i]) = kr[i]; } \
    _Pragma("unroll") for (int i = 0; i < 2; ++i) *(LAS u32x4*)(lds + OFF_V + ((j) & 1) * VBUF + vdst[i]) = vr[i]; \
    if ((j) + 2 < NT) { _Pragma("unroll") for (int i = 0; i < 2; ++i) kr[i] = ATT_BLD(krs, gsrc[i], ((j) + 2) * (64 * 1024)); } \
    if ((j) + 1 < NT) { _Pragma("unroll") for (int i = 0; i < 2; ++i) vr[i] = ATT_BLD(vrs, gsrc[i], ((j) + 1) * (64 * 1024)); } } while (0)
#define ATT_BLD(rs, voff_, soff_) __builtin_bit_cast(u32x4, __builtin_amdgcn_raw_buffer_load_b128(rs, (int)(voff_), (int)(soff_), 0))

__device__ __forceinline__ void unit(LAS unsigned char* lds, int b, int h, int qb, const bf16_t* Q, const bf16_t* KA, const bf16_t* VA, bf16_t* MIXIN, const float* subg, float lam, const unsigned* KM) {
    const int tid = opaque_tid(), lane = tid & 63, r32 = lane & 31, hi = lane >> 5;
    const int wid = __builtin_amdgcn_readfirstlane(tid >> 6), w = wid & 3, m = wid >> 2;
    LAS float* wsf = (LAS float*)(lds + OFF_WSF) + wid * 64;
    const int rowQ = b * T + qb * 128 + w * 32;
    bf16x8 qr[4];
#pragma unroll
    for (int d0 = 0; d0 < 4; ++d0) qr[d0] = *(const bf16x8*)(Q + (size_t)(rowQ + r32) * 512 + h * 128 + m * 64 + d0 * 16 + hi * 8);
    const bf16_t* Kb = KA + (size_t)b * TK * 512 + h * 128; const bf16_t* Vb = VA + (size_t)b * TK * 512 + h * 128;
    const __amdgpu_buffer_rsrc_t krs = __builtin_amdgcn_make_buffer_rsrc((void*)Kb, 0, 0x7fffffff, 0x00020000), vrs = __builtin_amdgcn_make_buffer_rsrc((void*)Vb, 0, 0x7fffffff, 0x00020000);
    unsigned gsrc[2]; int kdst[2], vdst[2];
#pragma unroll
    for (int i = 0; i < 2; ++i) { const int cid = tid + 512 * i, kv = cid >> 4, c16 = cid & 15;
        gsrc[i] = (unsigned)(kv * 1024 + c16 * 16); kdst[i] = kv * KP + c16 * 16; vdst[i] = (c16 >> 2) * 4096 + (kv >> 4) * 1024 + (kv & 15) * 64 + (c16 & 3) * 16; }
    u32x4 kr[2], vr[2];
#pragma unroll
    for (int i = 0; i < 2; ++i) { kr[i] = ATT_BLD(krs, gsrc[i], 0); vr[i] = ATT_BLD(vrs, gsrc[i], 0); }
#pragma unroll
    for (int i = 0; i < 2; ++i) *(LAS u32x4*)(lds + OFF_K + kdst[i]) = kr[i];
#pragma unroll
    for (int i = 0; i < 2; ++i) kr[i] = ATT_BLD(krs, gsrc[i], 64 * 1024);
    ATT_BAR();
    f32x16 o[4];
#pragma unroll
    for (int d0 = 0; d0 < 4; ++d0) o[d0] = (f32x16){};
    float l_reg = 0.f;
    f32x16 p0, p1, negref;
    {
        const unsigned* km = KM + (b * 8 + h * 2 + m) * 2;
        const float kmax2 = __uint_as_float(km[0]) + __uint_as_float(km[1]);
        float ss = 0.f;
#pragma unroll
        for (int d0 = 0; d0 < 4; ++d0)
#pragma unroll
            for (int i = 0; i < 8; ++i) { const float v = bf2f((unsigned short)qr[d0][i]); ss += v * v; }
        ss += __shfl_xor(ss, 32);
        const float ref = sqrtf(ss * kmax2) * 1.02f;
#pragma unroll
        for (int r = 0; r < 16; ++r) negref[r] = -ref;
    }
    u32x4 pwA[4], pwB[4];
    const int koff = r32 * KP + m * 128 + hi * 16;
    const int voff = ((lane >> 4) & 1) * 32 + (lane & 3) * 8 + (4 * hi + ((lane & 15) >> 2)) * 64;
    ATT_X(0); ATT_STAGE(0); ATT_Y0(pwA); ATT_BAR();
    ATT_X(1); ATT_STAGE(1); ATT_Y(0, pwA, pwB); ATT_BAR();
    for (int j = 2; j < NT; j += 2) {
        ATT_X(0); ATT_STAGE(j); ATT_Y(1, pwB, pwA); ATT_BAR();
        ATT_X(1); ATT_STAGE(j + 1); ATT_Y(0, pwA, pwB); ATT_BAR();
    }
    ATT_Z(1, pwB); ATT_BAR();
    const float lsum_ = l_reg + __shfl_xor(l_reg, 32);
    if (hi == 0) wsf[32 + r32] = lsum_;
    LDS_WAIT();
    LAS float* ex = (LAS float*)lds + w * 4096 + 4 * r32;
    const f32x4 g4 = *(const f32x4*)(subg + 4 * r32) * (1.0f - LAM_INIT);
    bf16_t* dstb = MIXIN + (size_t)rowQ * 1024 + h * 128 + 4 * r32;
#define ATT_EPI(KEEP) do { \
    _Pragma("unroll") for (int rr = 0; rr < 8; ++rr) { const int r = 8 - (KEEP) + rr; const int q = crow(r, hi); const float rl = __builtin_amdgcn_rcpf(wsf[32 + q]); \
        *(LAS f32x4*)(ex + q * 128) = (f32x4){o[0][r] * rl, o[1][r] * rl, o[2][r] * rl, o[3][r] * rl}; } \
    ATT_BAR(); \
    _Pragma("unroll") for (int rr = 0; rr < 8; ++rr) { const int r = (KEEP) + rr; const int q = crow(r, hi); const float rl = __builtin_amdgcn_rcpf(wsf[32 + q]); \
        const f32x4 own = (f32x4){o[0][r] * rl, o[1][r] * rl, o[2][r] * rl, o[3][r] * rl}; const f32x4 oth = *(const LAS f32x4*)(ex + q * 128); \
        const f32x4 x = ((KEEP) == 0) ? (own - lam * oth) : (oth - lam * own); \
        const float ss = half_sum32((x[0] * x[0] + x[1] * x[1]) + (x[2] * x[2] + x[3] * x[3]), hi); \
        const float rstd = __builtin_amdgcn_rsqf(ss * (1.f / 128.f) + EPS); \
        u32x2 wv; wv.x = pk2(x[0] * rstd * g4[0], x[1] * rstd * g4[1]); wv.y = pk2(x[2] * rstd * g4[2], x[3] * rstd * g4[3]); \
        *(u32x2*)(dstb + (size_t)q * 1024) = wv; } } while (0)
    if (m == 0) ATT_EPI(0); else ATT_EPI(8);
#undef ATT_EPI
    ATT_BAR();
}
#undef ATT_BAR
#undef ATT_X
#undef ATT_EXP2
#undef ATT_Y
#undef ATT_Y0
#undef ATT_Z
#undef ATT_STAGE
#undef ATT_BLD
#undef ATT_SB
#undef ATT_KLD
#undef ATT_XSTEP
#undef ATT_VLD
#undef ATT_VF
#undef ATT_YSTEP
#undef ATT_ZSTEP
}

__device__ __forceinline__ void p3_conv_attn(const Args& a, LAS unsigned char* lds, int c, int vcu, int G) {
    const int tid = opaque_tid(), lane = tid & 63, wave = __builtin_amdgcn_readfirstlane(tid >> 6);
    unsigned char* ws = a.ws;
    const bf16_t* GB = (const bf16_t*)(ws + WS_GB); const bf16_t* U = (const bf16_t*)(ws + WS_U); bf16_t* MIXIN = (bf16_t*)(ws + WS_MIXIN);
    {
        const float* cw = a.in[I_CONVW]; float w0[8], w1[8], w2[8];
#pragma unroll
        for (int i = 0; i < 8; ++i) { w0[i] = cw[lane * 8 + i]; w1[i] = cw[512 + lane * 8 + i]; w2[i] = cw[1024 + lane * 8 + i]; }
        const int gw = vcu * NWAVES + wave, NGW = G * NWAVES;
        const int rlo = gw * (M / NGW), rhi = rlo + M / NGW, slo = rlo & ~(T - 1), shi = slo + T;
        struct CIn { u32x4 u[6], g[4]; };
        auto cload = [&](CIn& c, int row) {
            const u32x4 z = {0u, 0u, 0u, 0u};
#pragma unroll
            for (int k = 0; k < 6; ++k) { const int rr = row - 1 + k; c.u[k] = (rr >= slo && rr < shi) ? *(const u32x4*)(U + (size_t)rr * 512 + lane * 8) : z; }
#pragma unroll
            for (int k = 0; k < 4; ++k) c.g[k] = *(const u32x4*)(GB + (size_t)(row + k) * 512 + lane * 8);
        };
        CIn ca; cload(ca, rlo);
        for (int row = rlo; row < rhi; row += 4) {
            CIn cn = ca;
            if (row + 4 < rhi) cload(cn, row + 4);
#pragma unroll
            for (int k = 0; k < 4; ++k) {
                const u32x4 up = ca.u[k], uc = ca.u[k + 1], un = ca.u[k + 2], gb = ca.g[k];
                u32x4 o;
#pragma unroll
                for (int q = 0; q < 4; ++q) {
                    const float y0 = w0[2 * q] * bflo(up[q]) + w1[2 * q] * bflo(uc[q]) + w2[2 * q] * bflo(un[q]);
                    const float y1 = w0[2 * q + 1] * bfhi(up[q]) + w1[2 * q + 1] * bfhi(uc[q]) + w2[2 * q + 1] * bfhi(un[q]);
                    o[q] = pk2(bflo(gb[q]) * y0, bfhi(gb[q]) * y1);
                }
                *(u32x4*)(MIXIN + (size_t)(row + k) * 1024 + 512 + lane * 8) = o;
            }
            ca = cn;
        }
    }
    float lam;
    { const float p1 = a.in[I_LQ1][lane] * a.in[I_LK1][lane], p2 = a.in[I_LQ2][lane] * a.in[I_LK2][lane];
      lam = __expf(wave_sum(p1)) - __expf(wave_sum(p2)) + LAM_INIT; }
    const bf16_t* Q = (const bf16_t*)(ws + WS_Q); const bf16_t* KA = (const bf16_t*)(ws + WS_K); const bf16_t* VA = (const bf16_t*)(ws + WS_V);
    __syncthreads();
    for (int u = vcu * 8; u < 2048; u += G * 8) {
        const int x = (u >> 3) / 32, jj = (u >> 3) % 32;
        for (int i = 0; i < 8; ++i) {
            const int bh = 16 * x + 2 * i + (jj >> 4), qb = jj & 15;
            att::unit(lds, bh >> 2, bh & 3, qb, Q, KA, VA, MIXIN, a.in[I_SUBLN], lam, (const unsigned*)(ws + WS_CTL) + CW_KMAX);
        }
    }
}

struct P5In { f32x4 x[4]; u32x2 m[4]; };
__device__ __forceinline__ void p5_load(P5In& r, int row, int lane, const float* X, const bf16_t* MIX) {
    const f32x4* xr = (const f32x4*)(X + (size_t)row * D) + lane; const u32x2* mr = (const u32x2*)(MIX + (size_t)row * D) + lane;
#pragma unroll
    for (int j = 0; j < 4; ++j) { r.x[j] = __builtin_nontemporal_load(xr + 64 * j); r.m[j] = __builtin_nontemporal_load(mr + 64 * j); }
}
__device__ __forceinline__ float p5_resid(const P5In& r, f32x4 (&h)[4], int row, int lane, const LAS float* mv, const LAS f32x4* npm, bf16_t* H1) {
    f32x4 mx[4]; float s = 0.f;
#pragma unroll
    for (int j = 0; j < 4; ++j) { const u32x2 wv = r.m[j]; mx[j] = (f32x4){bflo(wv.x), bfhi(wv.x), bflo(wv.y), bfhi(wv.y)};
        s += (mx[j].x * mx[j].x + mx[j].y * mx[j].y) + (mx[j].z * mx[j].z + mx[j].w * mx[j].w); }
    const float rstd1 = 1.0f / sqrtf(wave_sum(s) * (1.f / D) + EPS);
    u32x2* hr = (u32x2*)(H1 + (size_t)row * D) + lane; float s2 = 0.f;
#pragma unroll
    for (int j = 0; j < 4; ++j) { const f32x4 g1 = *(const LAS f32x4*)(mv + 4 * lane + 256 * j);
        h[j] = r.x[j] + g1 * ((mx[j] * rstd1) * npm[64 * j]);
        u32x2 wv; wv.x = pk2(h[j].x, h[j].y); wv.y = pk2(h[j].z, h[j].w); __builtin_nontemporal_store(wv, hr + 64 * j);
        s2 += (h[j].x * h[j].x + h[j].y * h[j].y) + (h[j].z * h[j].z + h[j].w * h[j].w); }
    return 1.0f / sqrtf(wave_sum(s2) * (1.f / D) + EPS);
}
__device__ __forceinline__ void p5_rows(const Args& a, LAS unsigned char* lds, int p  ) {
    const int tid = opaque_tid(), lane = tid & 63, wave = __builtin_amdgcn_readfirstlane(tid >> 6);
    unsigned char* ws = a.ws;
    const int b = p >> 3;
    LAS float* wrt = (LAS float*)lds;
    LAS float* mv = (LAS float*)(lds + 65536);
    const float* wr = a.in[I_WROUTER];
    const bf16_t* MIX = (const bf16_t*)(ws + WS_MIX); unsigned char* XN2 = ws + WS_XN; float* AFFT = (float*)(ws + WS_AFFT); bf16_t* H1 = (bf16_t*)(ws + WS_H1);
    const float* X = a.in[I_X];
    const int rbase = p * 256 + wave * 32;
    P5In cA, cB;
    p5_load(cA, rbase, lane, X, MIX); p5_load(cB, rbase + 1, lane, X, MIX);
    for (int n = tid; n < D * NE; n += NTHREADS) { const int k = n >> 4, e = n & 15; wrt[e * D + k] = wr[n]; }
    const float* MOD = (const float*)(ws + WS_MOD) + (size_t)b * NMOD;
    for (int n = tid; n < 3 * D; n += NTHREADS) mv[n] = MOD[2 * D + n];
    for (int n = tid; n < D; n += NTHREADS) { mv[3 * D + n] = a.in[I_NPOST_MIX][n]; mv[4 * D + n] = a.in[I_NPRE_FFN][n]; }
    __syncthreads();
    const LAS f32x4* npm = (const LAS f32x4*)(mv + 3 * D) + lane; const LAS f32x4* npf = (const LAS f32x4*)(mv + 4 * D) + lane;
    for (int i = 0; i < 16; ++i) {
        const int rowA = rbase + 2 * i, rowB = rowA + 1;
        P5In nA, nB;
        if (i + 1 < 16) { p5_load(nA, rowA + 2, lane, X, MIX); p5_load(nB, rowB + 2, lane, X, MIX); }
        f32x4 hA[4], hB[4];
        const float rsA = p5_resid(cA, hA, rowA, lane, mv, npm, H1);
        const float rsB = p5_resid(cB, hB, rowB, lane, mv, npm, H1);
        unsigned* oA = (unsigned*)(XN2 + (size_t)rowA * D) + lane; unsigned* oB = (unsigned*)(XN2 + (size_t)rowB * D) + lane;
        typedef float f32x2v __attribute__((ext_vector_type(2)));
        f32x2v lg2[16];
#pragma unroll
        for (int e = 0; e < 16; ++e) lg2[e] = (f32x2v){0.f, 0.f};
#pragma unroll
        for (int j = 0; j < 4; ++j) { const f32x4 sh2 = *(const LAS f32x4*)(mv + 1024 + 4 * lane + 256 * j), sc2 = *(const LAS f32x4*)(mv + 2048 + 4 * lane + 256 * j);
            const f32x4 gn = npf[64 * j];
            const f32x4 zA = ((hA[j] * rsA) * gn) * (sc2 + 1.0f) + sh2, zB = ((hB[j] * rsB) * gn) * (sc2 + 1.0f) + sh2;
            { const f32x4 qa = zA * pg8::F8_ACT, qb = zB * pg8::F8_ACT; oA[64 * j] = pg8::pk4_fp8(qa.x, qa.y, qa.z, qa.w); oB[64 * j] = pg8::pk4_fp8(qb.x, qb.y, qb.z, qb.w); }
            const f32x2v zx = {zA.x, zB.x}, zy = {zA.y, zB.y}, zz = {zA.z, zB.z}, zw = {zA.w, zB.w};
#pragma unroll
            for (int e = 0; e < 16; ++e) { const f32x4 wq = *(const LAS f32x4*)(wrt + e * D + 4 * lane + 256 * j);
                lg2[e] = __builtin_elementwise_fma(zx, (f32x2v){wq.x, wq.x}, lg2[e]); lg2[e] = __builtin_elementwise_fma(zy, (f32x2v){wq.y, wq.y}, lg2[e]);
                lg2[e] = __builtin_elementwise_fma(zz, (f32x2v){wq.z, wq.z}, lg2[e]); lg2[e] = __builtin_elementwise_fma(zw, (f32x2v){wq.w, wq.w}, lg2[e]);
                if ((e & 3) == 3) __builtin_amdgcn_sched_barrier(0); } }
        float lg[32];
#pragma unroll
        for (int e = 0; e < 16; ++e) { lg[e] = lg2[e].x; lg[16 + e] = lg2[e].y; }
#pragma unroll
        for (int st = 0; st < 5; ++st) { const int d = 1 << st, cntv = 16 >> st; const bool up = (lane & d) != 0;
#pragma unroll
            for (int q = 0; q < 16; ++q) if (q < cntv) { const float send = up ? lg[2 * q] : lg[2 * q + 1], keep = up ? lg[2 * q + 1] : lg[2 * q]; lg[q] = keep + __shfl_xor(send, d); } }
        float lv = lg[0] + __shfl_xor(lg[0], 32);
        float mxl = lv;
#pragma unroll
        for (int d = 1; d < 16; d <<= 1) mxl = fmaxf(mxl, __shfl_xor(mxl, d));
        const float ev = __expf(lv - mxl); float se = ev;
#pragma unroll
        for (int d = 1; d < 16; d <<= 1) se += __shfl_xor(se, d);
        if (lane < 32) { const int row = (lane < 16) ? rowA : rowB; AFFT[((size_t)b * NE + (lane & 15)) * T + (row & (T - 1))] = ev / se; }
        cA = nA; cB = nB;
    }
}

__device__ __forceinline__ void p6_topk(const Args& a, LAS unsigned char* lds, int c, int G) {
    const int tid = opaque_tid(), lane = tid & 63, wave = __builtin_amdgcn_readfirstlane(tid >> 6);
    unsigned char* ws = a.ws;
    const float* AFFT = (const float*)(ws + WS_AFFT); short* SLOT = (short*)(ws + WS_SLOT); int* IDX = (int*)(ws + WS_IDX); float* GATE = (float*)(ws + WS_GATE);
    LAS unsigned* sv = (LAS unsigned*)(lds + wave * 16384);
    for (int item = c + wave * G; item < NITEM; item += G * NWAVES) {
        const int b = item >> 4, e = item & 15;
        const float* src = AFFT + (size_t)item * T;
#pragma unroll 8
        for (int j = 0; j < 32; ++j) sv[j * 64 + lane] = __float_as_uint(src[j * 64 + lane]);
        LDS_WAIT(); asm volatile("" ::: "memory");
        unsigned pre = 0u;
        for (int bit = 30; bit >= 0; --bit) {
            const unsigned cand = pre | (1u << bit);
            int cnt = 0;
#pragma unroll 4
            for (int j = 0; j < 32; ++j) cnt += (int)__popcll(__ballot(sv[j * 64 + lane] >= cand));
            if (cnt >= CAP) pre = cand;
        }
        int ngt = 0;
#pragma unroll 4
        for (int j = 0; j < 32; ++j) ngt += (int)__popcll(__ballot(sv[j * 64 + lane] > pre));
        const int need_eq = CAP - ngt;
        const unsigned long long ltmask = (1ull << lane) - 1ull;
        int base_gt = 0, base_eq = 0;
#pragma unroll 2
        for (int j = 0; j < 32; ++j) {
            const unsigned vj = sv[j * 64 + lane];
            const bool gt = vj > pre, eq = vj == pre;
            const unsigned long long mg = __ballot(gt), me = __ballot(eq);
            const int pg = base_gt + (int)__popcll(mg & ltmask), pe = base_eq + (int)__popcll(me & ltmask);
            int sl = -1; if (gt) sl = pg; else if (eq && pe < need_eq) sl = ngt + pe;
            const int t = j * 64 + lane;
            SLOT[((size_t)b * T + t) * NE + e] = (short)sl;
            if (sl >= 0) { IDX[item * CAP + sl] = t; GATE[item * CAP + sl] = __uint_as_float(vj); }
            base_gt += (int)__popcll(mg); base_eq += (int)__popcll(me);
        }
        LDS_WAIT(); asm volatile("" ::: "memory");
    }
    if (wave >= 2) expert_weight_copies_w(a, (LAS float*)(lds + wave * 16384), lane, c * 6 + (wave - 2), G * 6, EWC_END - EWC_P6, EWC_END);
}

struct P8Row { u32x2 h[4]; unsigned y[4][4]; float wt[4]; unsigned long long rest; int sl; };
__device__ __forceinline__ f32x4 fp8x4_to_f32(unsigned w) { typedef float f2 __attribute__((ext_vector_type(2))); const f2 lo = __builtin_amdgcn_cvt_pk_f32_fp8((int)w, false), hi = __builtin_amdgcn_cvt_pk_f32_fp8((int)w, true); return (f32x4){lo.x, lo.y, hi.x, hi.y}; }
__device__ __forceinline__ int p8_slot(int row, int lane, const short* SLOT) { return (lane < NE) ? (int)SLOT[(size_t)row * NE + lane] : -1; }
__device__ __forceinline__ void p8_issue(P8Row& r, int row, int lane, int s_e, const unsigned char* Y, const bf16_t* H1) {
    const int b = row >> 11;
    unsigned long long mask = __ballot(s_e >= 0);
    const u32x2* hr = (const u32x2*)(H1 + (size_t)row * D) + lane;
#pragma unroll
    for (int j = 0; j < 4; ++j) r.h[j] = __builtin_nontemporal_load(hr + 64 * j);
#pragma unroll
    for (int q = 0; q < 4; ++q) {
        int e = 0, s = 0; r.wt[q] = 0.f;
        if (mask) { e = (int)__builtin_ctzll(mask); mask &= mask - 1ull; s = __builtin_amdgcn_readlane(s_e, e); r.wt[q] = 1.f; }
        const unsigned* yr = (const unsigned*)(Y + ((size_t)(b * NE + e) * CAP + s) * D) + lane;
#pragma unroll
        for (int j = 0; j < 4; ++j) r.y[q][j] = __builtin_nontemporal_load(yr + 64 * j);
    }
    r.rest = mask; r.sl = s_e;
}
__device__ __forceinline__ void p8_finish(P8Row& r, int row, int lane, const unsigned char* Y, const f32x4 (&gg)[4], float* out) {
    const int b = row >> 11;
    f32x4 ff[4];
#pragma unroll
    for (int j = 0; j < 4; ++j) ff[j] = (f32x4){0.f, 0.f, 0.f, 0.f};
#pragma unroll
    for (int q = 0; q < 4; ++q)
#pragma unroll
        for (int j = 0; j < 4; ++j) ff[j] += fp8x4_to_f32(r.y[q][j]) * r.wt[q];
    unsigned long long mask = r.rest;
    while (mask) {
        const int e = (int)__builtin_ctzll(mask); mask &= mask - 1ull; const int s = __builtin_amdgcn_readlane(r.sl, e);
        const unsigned* yr = (const unsigned*)(Y + ((size_t)(b * NE + e) * CAP + s) * D) + lane;
#pragma unroll
        for (int j = 0; j < 4; ++j) ff[j] += fp8x4_to_f32(yr[64 * j]);
    }
#pragma unroll
    for (int j = 0; j < 4; ++j) ff[j] = ff[j] * (1.0f / pg8::F8_Y);
    float s2 = 0.f;
#pragma unroll
    for (int j = 0; j < 4; ++j) s2 += (ff[j].x * ff[j].x + ff[j].y * ff[j].y) + (ff[j].z * ff[j].z + ff[j].w * ff[j].w);
    const float rstd = 1.0f / sqrtf(wave_sum(s2) * (1.f / D) + EPS);
    f32x4* orow = (f32x4*)(out + (size_t)row * D) + lane;
#pragma unroll
    for (int j = 0; j < 4; ++j) { const u32x2 hv = r.h[j]; const f32x4 h = (f32x4){bflo(hv.x), bfhi(hv.x), bflo(hv.y), bfhi(hv.y)};
        __builtin_nontemporal_store(h + gg[j] * (ff[j] * rstd), orow + 64 * j); }
}
__device__ __forceinline__ void p8_final(const Args& a, int vcu, int G) {
    const int tid = opaque_tid(), lane = tid & 63, wave = __builtin_amdgcn_readfirstlane(tid >> 6);
    unsigned char* ws = a.ws;
    const short* SLOT = (const short*)(ws + WS_SLOT); const unsigned char* Y = ws + WS_Y; const float* MOD = (const float*)(ws + WS_MOD); const bf16_t* H1 = (const bf16_t*)(ws + WS_H1);
    const int gw = vcu * NWAVES + wave, NGW = G * NWAVES;
    const int per = M / NGW;
    const int row0 = gw * per, rend = row0 + per;
    f32x4 gg[4];
    { const f32x4* npo = (const f32x4*)a.in[I_NPOST_FFN] + lane; const f32x4* g2 = (const f32x4*)(MOD + (size_t)(row0 >> 11) * NMOD + 5 * D) + lane;
#pragma unroll
      for (int j = 0; j < 4; ++j) gg[j] = g2[64 * j] * npo[64 * j]; }
    P8Row r0, r1, r2, r3;
    { const int s0 = p8_slot(row0, lane, SLOT), s1 = p8_slot(row0 + 1, lane, SLOT), s2 = p8_slot(row0 + 2, lane, SLOT), s3 = p8_slot(row0 + 3, lane, SLOT);
      p8_issue(r0, row0, lane, s0, Y, H1); p8_issue(r1, row0 + 1, lane, s1, Y, H1); p8_issue(r2, row0 + 2, lane, s2, Y, H1); p8_issue(r3, row0 + 3, lane, s3, Y, H1); }
    for (int row = row0; row < rend; row += 4) {
        const bool more = row + 4 < rend;
        int n0 = -1, n1 = -1, n2 = -1, n3 = -1;
        if (more) { n0 = p8_slot(row + 4, lane, SLOT); n1 = p8_slot(row + 5, lane, SLOT); n2 = p8_slot(row + 6, lane, SLOT); n3 = p8_slot(row + 7, lane, SLOT); }
        p8_finish(r0, row, lane, Y, gg, a.out);
        p8_finish(r1, row + 1, lane, Y, gg, a.out);
        if (more) { p8_issue(r0, row + 4, lane, n0, Y, H1); p8_issue(r1, row + 5, lane, n1, Y, H1); }
        p8_finish(r2, row + 2, lane, Y, gg, a.out);
        p8_finish(r3, row + 3, lane, Y, gg, a.out);
        if (more) { p8_issue(r2, row + 6, lane, n2, Y, H1); p8_issue(r3, row + 7, lane, n3, Y, H1); }
    }
}

__global__ void __launch_bounds__(NTHREADS, 2) fwd_kernel(Args args) {
    extern __shared__ __attribute__((aligned(16))) unsigned char lds_raw[];
    LAS unsigned char* lds = (LAS unsigned char*)lds_raw;
    volatile LAS unsigned* MISC = (volatile LAS unsigned*)(lds + MISC_OFF);
    const int tid = threadIdx.x;
    const int G = gridDim.x, c = blockIdx.x;
    const int vcu = (G % 8 == 0) ? (c % 8) * (G / 8) + c / 8 : c;
    unsigned char* ws = args.ws;
    gu32* ctl = (gu32*)(ws + WS_CTL);
    for (int u = tid; u < (LDS_BYTES - LDSCTL_OFF) / 4; u += NTHREADS) ((LAS unsigned*)(lds + LDSCTL_OFF))[u] = 0u;
    __syncthreads();
    XcdBarrier bar; bar.bar = (unsigned*)(ctl + CW_BAR); bar.x = 0; bar.st = nullptr;
    const int lo = args.ph_lo, hi = args.ph_hi;
    if (hi - lo > 1) bar = xcd_barrier_post((unsigned*)(ctl + CW_BAR), MISC + 8);
#ifndef PHMASK
#define PHMASK 0xff
#endif
#define IN(k) (((PHMASK >> (k)) & 1) && lo <= (k) && (k) < hi)
#define SEAM(k) do { if (IN(k) && IN((k) + 1)) xcd_barrier(bar); } while (0)
#ifndef PROBE_PHASE
#define PROBE_PHASE -1
#endif
#define PB(k) do { if (PROBE_PHASE == (k)) { if (tid == 0) { const unsigned long long t0_ = __builtin_amdgcn_s_memrealtime(); MISC[16] = (unsigned)t0_; MISC[17] = (unsigned)(t0_ >> 32); } } } while (0)
#define PE(k) do { if (PROBE_PHASE == (k)) { if (tid == 0) { const unsigned long long t0_ = ((unsigned long long)MISC[17] << 32) | MISC[16]; const unsigned long long t1_ = __builtin_amdgcn_s_memrealtime(); \
      while (__builtin_amdgcn_s_memrealtime() - t1_ < t1_ - t0_) __builtin_amdgcn_s_sleep(8); } __syncthreads(); } } while (0)

    PB(0); if (IN(0)) { p0_prologue(args, lds, vcu, G); } SEAM(0); PE(0);
    PB(1); if (IN(1)) { p1_xn(args, lds, c, G); inout_weight_copies(args, lds, vcu, G); } SEAM(1); PE(1);
    PB(2); if (IN(2)) {
        pg8::Gemm g{(const bf16_t*)(ws + WS_XN), (const bf16_t*)(ws + WS_WIN), D, nullptr};
        pg8::SchedProj S{G, c};
        pg8::EpiProj E{(bf16_t*)(ws + WS_Q), (bf16_t*)(ws + WS_K), (bf16_t*)(ws + WS_V), (bf16_t*)(ws + WS_GB), (bf16_t*)(ws + WS_U), (const float*)(ws + WS_TAB), (unsigned*)(ws + WS_CTL) + CW_KMAX};
        pg8::gemm_phase<pg8::EpiProj, pg8::SchedProj, true, true>(lds, g, S, E);
        if (c >= 128) expert_weight_copies(args, lds, c - 128, G - 128, 0, EWC_P2);
    } SEAM(2); PE(2);
    PB(3); if (IN(3)) { if (c & 1) expert_weight_copies(args, lds, vcu, G, EWC_P2, EWC_END - EWC_P6); p3_conv_attn(args, lds, c, vcu, G); if (!(c & 1)) expert_weight_copies(args, lds, vcu, G, EWC_P2, EWC_END - EWC_P6); } SEAM(3); PE(3);
    PB(4); if (IN(4)) {
        {
            const int p = c;
#ifndef NO_P4
            pg8::Gemm g{(const bf16_t*)(ws + WS_MIXIN), (const bf16_t*)(ws + WS_WOUT), D, nullptr};
            pg8::SchedPanel S{p, 4};
            pg8::EpiBf16 E{(bf16_t*)(ws + WS_MIX), D};
            pg8::gemm_phase<pg8::EpiBf16, pg8::SchedPanel, true, true>(lds, g, S, E);
#endif
            VM_WAIT(); __syncthreads();
#ifndef NO_P5
            p5_rows(args, lds, p);
#endif
            __syncthreads();
        }
    } SEAM(4); PE(4);
    PB(5); if (IN(5)) { p6_topk(args, lds, c, G); } SEAM(5); PE(5);
    PB(6); if (IN(6)) {
#pragma unroll 1
        for (int it = 0; it < 2; ++it) {
            {
                const int item = 2 * c + it;
                const int b = item >> 4, e = item & 15;
#ifndef NO_G1
                if (it == 0) PB(8);
                {
                    pg8::Gemm g{(const bf16_t*)(ws + WS_XN + (size_t)b * T * D), (const bf16_t*)(ws + WS_WGU + (size_t)e * 2048 * D), D, (const int*)(ws + WS_IDX) + item * CAP};
                    pg8::SchedPanel S{0, 8};
                    pg8::EpiGU8 E{ws + WS_HMID + (size_t)item * CAP * D};
                    pg8::gemm_phase<pg8::EpiGU8, pg8::SchedPanel, false, true, true, true, true>(lds, g, S, E);
                }
#endif
                VM_WAIT(); __syncthreads();
                if (it == 0) { PE(8); PB(9); }
#ifndef NO_G2
                {
                    pg8::Gemm g{(const bf16_t*)(ws + WS_HMID + (size_t)item * CAP * D), (const bf16_t*)(ws + WS_WDN + (size_t)e * D * D), D, nullptr};
                    pg8::SchedPanel S{0, 4};
                    LAS float* gl = (LAS float*)(lds + LDSCTL_OFF + 4096);
                    { const int t_ = opaque_tid(); if (t_ < CAP) gl[t_] = ((const float*)(ws + WS_GATE))[item * CAP + t_] * (pg8::F8_INV * pg8::F8_Y); }
                    __syncthreads();
                    pg8::EpiDown8 E{ws + WS_Y + (size_t)item * CAP * D, gl};
                    pg8::gemm_phase<pg8::EpiDown8, pg8::SchedPanel, false, true, false, true, true>(lds, g, S, E);
                }
#endif
                VM_WAIT(); __syncthreads();
                if (it == 0) PE(9);
            }
        }
    } SEAM(6); PE(6);
    PB(7); if (IN(7)) { p8_final(args, vcu, G); } PE(7);
#undef IN
#undef SEAM
}

extern "C" void kernel_launch(void* const* d_in, const int* in_sizes, int n_in, void* d_out, int out_size, void* d_ws, size_t ws_size, hipStream_t stream) {
    static int grid = 0;
    if (grid == 0) {
        if (n_in != 22 || in_sizes[0] != M * D || out_size != M * D || ws_size < WS_END) { fprintf(stderr, "kernel_launch: unexpected shapes (n_in %d, in0 %d, out %d, ws %zu)\n", n_in, n_in > 0 ? in_sizes[0] : -1, out_size, ws_size); grid = -1; return; }
        int dev = 0, cus = 0;
        if (hipGetDevice(&dev) != hipSuccess || hipDeviceGetAttribute(&cus, hipDeviceAttributeMultiprocessorCount, dev) != hipSuccess) { grid = -1; return; }
        if (hipFuncSetAttribute((const void*)fwd_kernel, hipFuncAttributeMaxDynamicSharedMemorySize, LDS_BYTES) != hipSuccess) { fprintf(stderr, "kernel_launch: hipFuncSetAttribute failed\n"); grid = -1; return; }
        (void)hipGetLastError();
        grid = cus;
        if (grid != 256) { fprintf(stderr, "kernel_launch: this kernel needs a 256-CU device (got %d)\n", cus); grid = -1; return; }
    }
    if (grid < 0) return;
    (void)hipMemsetAsync((char*)d_ws + WS_CTL, 0, CTL_ZERO_BYTES, stream);
    Args a{};
    for (int i = 0; i < 22; ++i) a.in[i] = (const float*)d_in[i];
    a.out = (float*)d_out; a.ws = (unsigned char*)d_ws;
    constexpr int NPH = 8;
    if (MK_N_LAUNCHES == 1) { a.ph_lo = 0; a.ph_hi = NPH; hipLaunchKernelGGL(fwd_kernel, dim3(grid), dim3(NTHREADS), LDS_BYTES, stream, a); }
    else { for (int k = 0; k < NPH; ++k) { a.ph_lo = k; a.ph_hi = k + 1; hipLaunchKernelGGL(fwd_kernel, dim3(grid), dim3(NTHREADS), LDS_BYTES, stream, a); } }
}
```

```cpp
#include <hip/hip_runtime.h>
#include <cstdio>
#include <cstdint>

#ifndef MK_N_LAUNCHES
#define MK_N_LAUNCHES 1
#endif

#define LAS __attribute__((address_space(3)))
#define GAS __attribute__((address_space(1)))
typedef unsigned short bf16_t;
typedef short bf16x8 __attribute__((ext_vector_type(8)));
typedef short s16x4 __attribute__((ext_vector_type(4)));
typedef float f32x4 __attribute__((ext_vector_type(4)));
typedef float f32x16 __attribute__((ext_vector_type(16)));
typedef unsigned u32x4 __attribute__((ext_vector_type(4)));
typedef unsigned u32x2 __attribute__((ext_vector_type(2)));

constexpr int NB = 32, T = 2048, D = 1024, TC = 256, M = NB * T, MC = NB * TC, MA = M + MC, TK = TC + T;
constexpr int NE = 16, CAP = 256, NITEM = NB * NE, NPROJ = 3072, NMOD = 6 * D;
constexpr float EPS = 1e-6f;
constexpr float C2 = 0.125f * 1.4426950408889634f;
constexpr float LAM_INIT = 0.2f;
constexpr int NWAVES = 8, NTHREADS = 512;

constexpr size_t MiB = 1u << 20;
constexpr size_t WS_CTL = 0, CTL_ZERO_BYTES = 1 * MiB;
constexpr size_t WS_MODP = 2 * MiB;
constexpr size_t WS_MOD = 16 * MiB;
constexpr size_t WS_TAB = 17 * MiB;
constexpr size_t WS_WIN = 18 * MiB;
constexpr size_t WS_WOUT = 24 * MiB;
constexpr size_t WS_WGU = 26 * MiB;
constexpr size_t WS_WDN = 90 * MiB;
constexpr size_t WS_AFFT = 122 * MiB;
constexpr size_t WS_SLOT = 126 * MiB;
constexpr size_t WS_IDX = 128 * MiB;
constexpr size_t WS_GATE = 129 * MiB;
constexpr size_t WS_XN = 130 * MiB;
constexpr size_t WS_Q = 274 * MiB;
constexpr size_t WS_K = 338 * MiB;
constexpr size_t WS_V = 410 * MiB;
constexpr size_t WS_GB = 482 * MiB;
constexpr size_t WS_U = 546 * MiB;
constexpr size_t WS_MIXIN = 610 * MiB;
constexpr size_t WS_MIX = 738 * MiB;
constexpr size_t WS_HMID = 274 * MiB;
constexpr size_t WS_Y = 610 * MiB;
constexpr size_t WS_H1 = 866 * MiB;
constexpr size_t WS_END = 994 * MiB;

__device__ __forceinline__ int opaque_tid() { int t = threadIdx.x; asm volatile("" : "+v"(t)); return t; }

namespace pg8 {
constexpr int BM = 256, BK = 64, HALF = 128, HTB = HALF * BK * 2, STAGE_BYTES = 8 * HTB;
__host__ __device__ __forceinline__ int lds_byte(int r, int c) { const int st = (r >> 4) * 2 + (c >> 5), rr = r & 15, cc = c & 31, ob = rr * 64 + cc * 2; return st * 1024 + (ob ^ (((ob >> 9) & 1) << 5)); }
__host__ __device__ __forceinline__ void stage_rc(int b, int& R, int& C) { const int st = b / 1024, sb = b % 1024, swz = sb ^ (((sb >> 9) & 1) << 5); R = (st >> 1) * 16 + swz / 64; C = (st & 1) * 32 + (swz % 64) / 2; }
__host__ __device__ __forceinline__ int perm32(int rho) { const int n = rho >> 4, i = rho & 15; return 8 * (i >> 2) + 4 * n + (i & 3); }

struct Unit { int pm, pn; };
struct Gemm { const bf16_t* A; const bf16_t* Bt; int K; const int* gidx; };

typedef float f32x2_t __attribute__((ext_vector_type(2))); typedef __bf16 bf16x2_t __attribute__((ext_vector_type(2)));
__device__ __forceinline__ unsigned cvt_pk_bf16(float lo, float hi) { const f32x2_t v = {lo, hi}; const bf16x2_t b = __builtin_convertvector(v, bf16x2_t); return __builtin_bit_cast(unsigned, b); }

struct EpiBf16 {
    static constexpr bool PERM = true, AFTER_DRAIN = false;
    bf16_t* O; int ldc;
    __device__ __forceinline__ void operator()(const f32x4 (&acc)[2][2][4][2], const Unit& u, int wr, int wc, int fr, int fq) const {
        const int row0 = u.pm * BM + wr * 64 + fr; const int col0 = u.pn * BM + wc * 32 + 8 * fq;
#pragma unroll
        for (int ai = 0; ai < 2; ++ai)
#pragma unroll
            for (int m = 0; m < 4; ++m) { bf16_t* rowp = O + (size_t)(row0 + ai * HALF + m * 16) * ldc + col0;
#pragma unroll
                for (int bj = 0; bj < 2; ++bj) { const f32x4 v0 = acc[ai][bj][m][0], v1 = acc[ai][bj][m][1];
                    u32x4 w; w.x = cvt_pk_bf16(v0[0], v0[1]); w.y = cvt_pk_bf16(v0[2], v0[3]); w.z = cvt_pk_bf16(v1[0], v1[1]); w.w = cvt_pk_bf16(v1[2], v1[3]);
                    *(u32x4*)(rowp + bj * HALF) = w; } }
    }
};

struct EpiProj {
    static constexpr bool PERM = true, AFTER_DRAIN = false;
    bf16_t *Q, *KA, *VA, *GB, *U; const float* tab;
    unsigned* kmaxh;
    __device__ __forceinline__ void operator()(const f32x4 (&acc)[2][2][4][2], const Unit& u, int wr, int wc, int fr, int fq) const {
        const int pn = u.pn; const bool ctx = u.pm >= 256;
        float km[2] = {0.f, 0.f};
#pragma unroll
        for (int ai = 0; ai < 2; ++ai)
#pragma unroll
            for (int m = 0; m < 4; ++m) {
                const int row = u.pm * BM + ai * HALF + wr * 64 + m * 16 + fr;
                int t, kvrow;
                if (!ctx) { const int b = row >> 11; t = row & 2047; kvrow = b * TK + TC + t; }
                else { const int rc = row - M; const int b = rc >> 8; t = 0; kvrow = b * TK + (rc & 255); }
                if (pn < 4) {
                    f32x4 cs0 = {1.f, 0.f, 1.f, 0.f}, cs1 = cs0, cs2 = cs0, cs3 = cs0;
                    if (!ctx) { const float* tp = tab + ((size_t)t * 32 + 16 * (wc & 1) + 4 * fq) * 2;
                        cs0 = *(const f32x4*)(tp); cs1 = *(const f32x4*)(tp + 4); }
                    (void)cs2; (void)cs3;
#pragma unroll
                    for (int bj = 0; bj < 2; ++bj) {
                        const f32x4 v0 = acc[ai][bj][m][0], v1 = acc[ai][bj][m][1];
                        float e0 = v0[0], o0 = v0[1], e1 = v0[2], o1 = v0[3], e2 = v1[0], o2 = v1[1], e3 = v1[2], o3 = v1[3];
                        if (pn >= 2) {
                            float ss = ((e0 * e0 + o0 * o0) + (e1 * e1 + o1 * o1)) + ((e2 * e2 + o2 * o2) + (e3 * e3 + o3 * o3));
                            ss += __shfl_xor(ss, 16); ss += __shfl_xor(ss, 32); km[bj] = fmaxf(km[bj], ss); }
                        float r0 = e0 * cs0[0] - o0 * cs0[1], s0 = o0 * cs0[0] + e0 * cs0[1];
                        float r1 = e1 * cs0[2] - o1 * cs0[3], s1 = o1 * cs0[2] + e1 * cs0[3];
                        float r2 = e2 * cs1[0] - o2 * cs1[1], s2 = o2 * cs1[0] + e2 * cs1[1];
                        float r3 = e3 * cs1[2] - o3 * cs1[3], s3 = o3 * cs1[2] + e3 * cs1[3];
                        const float sc = (pn < 2) ? C2 : 1.f;
                        u32x4 w; w.x = cvt_pk_bf16(r0 * sc, s0 * sc); w.y = cvt_pk_bf16(r1 * sc, s1 * sc); w.z = cvt_pk_bf16(r2 * sc, s2 * sc); w.w = cvt_pk_bf16(r3 * sc, s3 * sc);
                        const int col = (pn & 1) * 256 + bj * HALF + wc * 32 + 8 * fq;
                        bf16_t* dst = (pn < 2) ? (Q + (size_t)row * 512 + col) : (KA + (size_t)kvrow * 512 + col);
                        *(u32x4*)dst = w;
                    }
                } else if (pn < 8) {
#pragma unroll
                    for (int bj = 0; bj < 2; ++bj) {
                        const f32x4 v0 = acc[ai][bj][m][0], v1 = acc[ai][bj][m][1];
                        u32x4 w; w.x = cvt_pk_bf16(v0[0], v0[1]); w.y = cvt_pk_bf16(v0[2], v0[3]); w.z = cvt_pk_bf16(v1[0], v1[1]); w.w = cvt_pk_bf16(v1[2], v1[3]);
                        const int col = (pn & 1) * 256 + bj * HALF + wc * 32 + 8 * fq;
                        bf16_t* dst = (pn < 6) ? (VA + (size_t)kvrow * 512 + col) : (GB + (size_t)row * 512 + col);
                        *(u32x4*)dst = w;
                    }
                } else {
                    const f32x4 a0 = acc[ai][0][m][0], a1 = acc[ai][0][m][1], b0 = acc[ai][1][m][0], b1 = acc[ai][1][m][1];
                    u32x4 w; w.x = cvt_pk_bf16(a0[0] * b0[0], a0[1] * b0[1]); w.y = cvt_pk_bf16(a0[2] * b0[2], a0[3] * b0[3]);
                    w.z = cvt_pk_bf16(a1[0] * b1[0], a1[1] * b1[1]); w.w = cvt_pk_bf16(a1[2] * b1[2], a1[3] * b1[3]);
                    const int col = (pn - 8) * 128 + wc * 32 + 8 * fq;
                    *(u32x4*)(U + (size_t)row * 512 + col) = w;
                }
            }
        if (pn == 2 || pn == 3) {
            const int b = ctx ? (u.pm - 256) : (u.pm >> 3);
#pragma unroll
            for (int bj = 0; bj < 2; ++bj) { float v = km[bj];
#pragma unroll
                for (int d = 1; d < 16; d <<= 1) v = fmaxf(v, __shfl_xor(v, d));
                if (fr == 0 && fq == 0) atomicMax(kmaxh + ((b * 8 + (pn & 1) * 4 + bj * 2 + (wc >> 1)) * 2 + (wc & 1)), __float_as_uint(v)); }
        }
    }
};

struct EpiGU {
    static constexpr bool PERM = true, AFTER_DRAIN = false;
    bf16_t* H;
    __device__ __forceinline__ float silu(float x) const { return x * __builtin_amdgcn_rcpf(1.f + __expf(-x)); }
    __device__ __forceinline__ void operator()(const f32x4 (&acc)[2][2][4][2], const Unit& u, int wr, int wc, int fr, int fq) const {
#pragma unroll
        for (int ai = 0; ai < 2; ++ai)
#pragma unroll
            for (int m = 0; m < 4; ++m) {
                const int row = ai * HALF + wr * 64 + m * 16 + fr;
                const f32x4 a0 = acc[ai][0][m][0], a1 = acc[ai][0][m][1], b0 = acc[ai][1][m][0], b1 = acc[ai][1][m][1];
                u32x4 w; w.x = cvt_pk_bf16(silu(a0[0]) * b0[0], silu(a0[1]) * b0[1]); w.y = cvt_pk_bf16(silu(a0[2]) * b0[2], silu(a0[3]) * b0[3]);
                w.z = cvt_pk_bf16(silu(a1[0]) * b1[0], silu(a1[1]) * b1[1]); w.w = cvt_pk_bf16(silu(a1[2]) * b1[2], silu(a1[3]) * b1[3]);
                *(u32x4*)(H + (size_t)row * 1024 + u.pn * 128 + wc * 32 + 8 * fq) = w;
            }
    }
};
__device__ __forceinline__ unsigned pk4_fp8(float a, float b, float c, float d) { int w = 0; w = __builtin_amdgcn_cvt_pk_fp8_f32(a, b, w, false); w = __builtin_amdgcn_cvt_pk_fp8_f32(c, d, w, true); return (unsigned)w; }
constexpr float F8_ACT = 4.0f, F8_WGT = 64.0f, F8_INV = 1.0f / (4.0f * 64.0f);
struct EpiGU8 {
    static constexpr bool PERM = true, AFTER_DRAIN = false;
    unsigned char* H;
    __device__ __forceinline__ float hval(float g, float u) const {
        const float e = __builtin_amdgcn_exp2f(g * (-F8_INV * 1.4426950408889634f));
        const float r = __builtin_amdgcn_rcpf(1.f + e);
        return __builtin_amdgcn_fmed3f((g * u) * (r * (F8_INV * F8_INV * F8_ACT)), -448.f, 448.f); }
    __device__ __forceinline__ void row(const f32x4 (&acc)[2][2][4][2], const Unit& u, int ai, int m, int wr, int wc, int fr, int fq) const {
        unsigned off = (unsigned)((ai * HALF + wr * 64 + m * 16 + fr) * 1024 + u.pn * 128 + wc * 32 + 8 * fq);
        asm volatile("" : "+v"(off));
        const f32x4 a0 = acc[ai][0][m][0], a1 = acc[ai][0][m][1], b0 = acc[ai][1][m][0], b1 = acc[ai][1][m][1];
        u32x2 w; w.x = pk4_fp8(hval(a0[0], b0[0]), hval(a0[1], b0[1]), hval(a0[2], b0[2]), hval(a0[3], b0[3]));
        w.y = pk4_fp8(hval(a1[0], b1[0]), hval(a1[1], b1[1]), hval(a1[2], b1[2]), hval(a1[3], b1[3]));
        *(u32x2*)(H + off) = w;
    }
    __device__ __forceinline__ void operator()(const f32x4 (&acc)[2][2][4][2], const Unit& u, int wr, int wc, int fr, int fq) const {
#pragma unroll
        for (int ai = 0; ai < 2; ++ai)
#pragma unroll
            for (int m = 0; m < 4; ++m) row(acc, u, ai, m, wr, wc, fr, fq);
    }
};
struct EpiDown {
    static constexpr bool PERM = true, AFTER_DRAIN = false;
    bf16_t* Y; const float* gate; float scale;
    __device__ __forceinline__ void operator()(const f32x4 (&acc)[2][2][4][2], const Unit& u, int wr, int wc, int fr, int fq) const {
        asm volatile("" : "+v"(fr));
#pragma unroll
        for (int ai = 0; ai < 2; ++ai)
#pragma unroll
            for (int m = 0; m < 4; ++m) {
                const int row = ai * HALF + wr * 64 + m * 16 + fr; const float g = gate[row] * scale;
#pragma unroll
                for (int bj = 0; bj < 2; ++bj) { const f32x4 v0 = acc[ai][bj][m][0] * g, v1 = acc[ai][bj][m][1] * g;
                    u32x4 w; w.x = cvt_pk_bf16(v0[0], v0[1]); w.y = cvt_pk_bf16(v0[2], v0[3]); w.z = cvt_pk_bf16(v1[0], v1[1]); w.w = cvt_pk_bf16(v1[2], v1[3]);
                    *(u32x4*)(Y + (size_t)row * 1024 + u.pn * BM + bj * HALF + wc * 32 + 8 * fq) = w; }
            }
    }
};

constexpr float F8_Y = 64.0f;
struct EpiDown8 {
    static constexpr bool PERM = true, AFTER_DRAIN = false;
    unsigned char* Y; const LAS float* gl;
    __device__ __forceinline__ void row(const f32x4 (&acc)[2][2][4][2], const Unit& u, int ai, int m, int wr, int wc, int fr, int fq) const {
        unsigned off = (unsigned)((ai * HALF + wr * 64 + m * 16 + fr) * 1024 + u.pn * BM + wc * 32 + 8 * fq);
        asm volatile("" : "+v"(off));
        const float g = gl[ai * HALF + wr * 64 + m * 16 + fr];
#pragma unroll
        for (int bj = 0; bj < 2; ++bj) { f32x4 v0 = acc[ai][bj][m][0] * g, v1 = acc[ai][bj][m][1] * g;
#pragma unroll
            for (int i = 0; i < 4; ++i) { v0[i] = __builtin_amdgcn_fmed3f(v0[i], -448.f, 448.f); v1[i] = __builtin_amdgcn_fmed3f(v1[i], -448.f, 448.f); }
            u32x2 w; w.x = pk4_fp8(v0[0], v0[1], v0[2], v0[3]); w.y = pk4_fp8(v1[0], v1[1], v1[2], v1[3]);
            *(u32x2*)(Y + off + bj * HALF) = w; }
    }
    __device__ __forceinline__ void operator()(const f32x4 (&acc)[2][2][4][2], const Unit& u, int wr, int wc, int fr, int fq) const {
#pragma unroll
        for (int ai = 0; ai < 2; ++ai)
#pragma unroll
            for (int m = 0; m < 4; ++m) row(acc, u, ai, m, wr, wc, fr, fq);
    }
};

struct SchedProj {
    int G, c;
    __device__ __forceinline__ bool next(int i, Unit& u) const {
        if (i < 12) { const int x = c & 7, j = c >> 3, ja = j & 7, jb = j >> 3, r = i / 3, q = i - 3 * r;
            u.pm = x + 8 * (8 * r + ja); u.pn = 4 * q + jb; return true; }
        if (i == 12 && c < 128) { u.pm = 256 + (c >> 2); u.pn = 2 + (c & 3); return true; }
        return false;
    }
    __device__ __forceinline__ void a_ready(const Unit&) const {}
    __device__ __forceinline__ void done(const Unit&) const {}
};
struct SchedPanel {
    int pm, ntn;
    __device__ __forceinline__ bool next(int i, Unit& u) const { if (i >= ntn) return false; u.pm = pm; u.pn = i; return true; }
    __device__ __forceinline__ void a_ready(const Unit&) const {}
    __device__ __forceinline__ void done(const Unit&) const {}
};

typedef int i32x4v __attribute__((ext_vector_type(4)));
typedef int i32x8v __attribute__((ext_vector_type(8)));
__device__ __forceinline__ i32x8v cat8(bf16x8 a, bf16x8 b) { const i32x4v x = __builtin_bit_cast(i32x4v, a), y = __builtin_bit_cast(i32x4v, b); return __builtin_shufflevector(x, y, 0, 1, 2, 3, 4, 5, 6, 7); }
template <bool F8> struct Frag;
template <> struct Frag<false> { bf16x8 v[2]; __device__ __forceinline__ void set(bf16x8 a, bf16x8 b) { v[0] = a; v[1] = b; } };
template <> struct Frag<true> { i32x8v v; __device__ __forceinline__ void set(bf16x8 a, bf16x8 b) { v = cat8(a, b); } };
__device__ __forceinline__ f32x4 frag_mma(const Frag<false>& b, const Frag<false>& a, f32x4 c) { c = __builtin_amdgcn_mfma_f32_16x16x32_bf16(b.v[0], a.v[0], c, 0, 0, 0); return __builtin_amdgcn_mfma_f32_16x16x32_bf16(b.v[1], a.v[1], c, 0, 0, 0); }
__device__ __forceinline__ f32x4 frag_mma(const Frag<true>& b, const Frag<true>& a, f32x4 c) {
    const int sc1 = 0x7f7f7f7f;
    asm volatile("s_nop 1\n\tv_mfma_scale_f32_16x16x128_f8f6f4 %0, %1, %2, %0, %3, %3 op_sel_hi:[0,0,0]" : "+v"(c) : "v"(b.v), "v"(a.v), "v"(sc1));
    return c; }
template <class Epi, class Sched, bool ALIGN_EPI, bool SP2, bool GATHER = false, bool F8 = false, bool DEFER = false>
__device__ __forceinline__ void gemm_phase(LAS unsigned char* lds, const Gemm g, const Sched& S, const Epi& E) {
    const int tid = opaque_tid(), wid = __builtin_amdgcn_readfirstlane(tid >> 6), lane = tid & 63, wr = wid >> 2, wc = wid & 3, fr = lane & 15, fq = lane >> 4;
    const int K = g.K * (F8 ? 1 : 2), nt = K / 128;
    unsigned voffA[2][2], voffB[2];
#pragma unroll
    for (int i = 0; i < 2; ++i) { int R, C; stage_rc(tid * 16 + i * 8192, R, C); const int Rb = Epi::PERM ? ((R & ~31) + perm32(R & 31)) : R;
        if constexpr (GATHER) { voffA[0][i] = (unsigned)(g.gidx[R] * K + C * 2); voffA[1][i] = (unsigned)(g.gidx[HALF + R] * K + C * 2); }
        else { voffA[0][i] = (unsigned)(R * K + C * 2); voffA[1][i] = voffA[0][i]; }
        voffB[i] = (unsigned)(Rb * K + C * 2); }
    const size_t kstep = (size_t)(BK * 2);
    const size_t hstep = (size_t)HALF * K;
    const size_t hstepA = GATHER ? (size_t)0 : hstep;
    const size_t tstep = 2 * hstep;
    const unsigned ldsw = (unsigned)wid * 1024u;
    const int aoff = F8 ? lds_byte(wr * 64 + fr, (fq >> 1) * 32 + (fq & 1) * 16) : lds_byte(wr * 64 + fr, fq * 8), boff = F8 ? lds_byte(wc * 32 + fr, (fq >> 1) * 32 + (fq & 1) * 16) : lds_byte(wc * 32 + fr, fq * 8);
    const int aoff1 = F8 ? aoff + 16 : aoff + 1024, boff1 = F8 ? boff + 16 : boff + 1024;
#define PG8_SA(b, h) (((b) * 2 + (h)) * HTB)
#define PG8_SB(b, h) ((4 + (b) * 2 + (h)) * HTB)
#define PG8_STAGE(bufoff, gbase, voff) do { _Pragma("unroll") for (int _i = 0; _i < 2; ++_i) \
        __builtin_amdgcn_global_load_lds((const unsigned*)((const char*)(gbase) + (voff)[_i]), (LAS unsigned*)(lds + (bufoff) + ldsw + _i * 8192), 16, 0, 0); } while (0)
#define PG8_LDA(dst, b, h) do { _Pragma("unroll") for (int m = 0; m < 4; ++m) dst[m].set(*(const LAS bf16x8*)(lds + PG8_SA(b, h) + aoff + m * 2048), *(const LAS bf16x8*)(lds + PG8_SA(b, h) + aoff1 + m * 2048)); } while (0)
#define PG8_LDB(dst, b, h) do { _Pragma("unroll") for (int n = 0; n < 2; ++n) dst[n].set(*(const LAS bf16x8*)(lds + PG8_SB(b, h) + boff + n * 2048), *(const LAS bf16x8*)(lds + PG8_SB(b, h) + boff1 + n * 2048)); } while (0)
#define PG8_MMA(ai, bj, At, Bt) do { __builtin_amdgcn_s_setprio(1); _Pragma("unroll") for (int m = 0; m < 4; ++m) _Pragma("unroll") for (int n = 0; n < 2; ++n) \
        acc[ai][bj][m][n] = frag_mma(Bt[n], At[m], acc[ai][bj][m][n]); __builtin_amdgcn_s_setprio(0); } while (0)
#define PG8_MMA_E(ai, At, Bt) do { __builtin_amdgcn_s_setprio(1); _Pragma("unroll") for (int m = 0; m < 4; ++m) { \
        if constexpr (DEFER) { if (defer_now) { E.row(acc, pu, ai, m, wr, wc, fr, fq); \
            _Pragma("unroll") for (int n = 0; n < 2; ++n) { acc[ai][0][m][n] = (f32x4){0.f, 0.f, 0.f, 0.f}; acc[ai][1][m][n] = (f32x4){0.f, 0.f, 0.f, 0.f}; } } PG8_SCHED; } \
        _Pragma("unroll") for (int n = 0; n < 2; ++n) acc[ai][0][m][n] = frag_mma(Bt[n], At[m], acc[ai][0][m][n]); } __builtin_amdgcn_s_setprio(0); } while (0)
#define PG8_WAIT_V(n) asm volatile("s_waitcnt vmcnt(" #n ")" ::: "memory")
#define PG8_WAIT_L(n) asm volatile("s_waitcnt lgkmcnt(" #n ")" ::: "memory")
#define PG8_BAR __builtin_amdgcn_s_barrier()
#define PG8_SCHED __builtin_amdgcn_sched_barrier(0)
    Unit cur, nxt; int ui = 0;
    if (!S.next(0, cur)) return;
    f32x4 acc[2][2][4][2];
#pragma unroll
    for (int a = 0; a < 2; ++a)
#pragma unroll
        for (int b = 0; b < 2; ++b)
#pragma unroll
            for (int m = 0; m < 4; ++m)
#pragma unroll
                for (int n = 0; n < 2; ++n) acc[a][b][m][n] = (f32x4){0.f, 0.f, 0.f, 0.f};
    Frag<F8> At[4], B0[2], B1[2];
    bool pend = false; Unit pu = cur;
    const char* cA = (const char*)g.A + (size_t)cur.pm * tstep; const char* cB = (const char*)g.Bt + (size_t)cur.pn * tstep;
    S.a_ready(cur);
    if constexpr (SP2) {
        PG8_STAGE(PG8_SB(0, 0), cB, voffB); PG8_STAGE(PG8_SB(0, 1), cB + hstep, voffB); PG8_STAGE(PG8_SA(0, 0), cA, voffA[0]); PG8_STAGE(PG8_SA(0, 1), cA + hstepA, voffA[GATHER ? 1 : 0]);
        if (wr == 1) PG8_BAR;
        PG8_WAIT_V(2); PG8_BAR;
        PG8_STAGE(PG8_SB(1, 0), cB + kstep, voffB); PG8_STAGE(PG8_SA(1, 0), cA + kstep, voffA[0]); PG8_STAGE(PG8_SB(1, 1), cB + hstep + kstep, voffB);
        PG8_WAIT_V(6); PG8_BAR;
    } else {
        PG8_STAGE(PG8_SB(0, 0), cB, voffB); PG8_STAGE(PG8_SA(0, 0), cA, voffA[0]); PG8_STAGE(PG8_SB(0, 1), cB + hstep, voffB); PG8_STAGE(PG8_SA(0, 1), cA + hstepA, voffA[GATHER ? 1 : 0]);
        if (wr == 1) PG8_BAR;
        PG8_WAIT_V(4); PG8_BAR;
        PG8_STAGE(PG8_SB(1, 0), cB + kstep, voffB); PG8_STAGE(PG8_SA(1, 0), cA + kstep, voffA[0]); PG8_STAGE(PG8_SB(1, 1), cB + hstep + kstep, voffB);
        PG8_WAIT_V(6); PG8_BAR;
    }
    for (;;) {
        const bool has_next = S.next(ui + 1, nxt);
        const char* nA = has_next ? (const char*)g.A + (size_t)nxt.pm * tstep : cA; const char* nB = has_next ? (const char*)g.Bt + (size_t)nxt.pn * tstep : cB;
#pragma unroll 1
        for (int t = 0; t < nt; t += 2) {
            const bool last = (t == nt - 2);
            if constexpr (F8) { asm volatile("" : "+v"(voffA[0][0]), "+v"(voffA[0][1]), "+v"(voffB[0]), "+v"(voffB[1])); if constexpr (GATHER) asm volatile("" : "+v"(voffA[1][0]), "+v"(voffA[1][1])); }
            const char* a1 = cA + (size_t)(t + 1) * kstep;
            const char* a2 = last ? nA : cA + (size_t)(t + 2) * kstep; const char* b2 = last ? nB : cB + (size_t)(t + 2) * kstep;
            const char* a3 = a2 + kstep; const char* b3 = b2 + kstep;
            if (last && has_next) S.a_ready(nxt);
            if constexpr (SP2) {
            PG8_LDB(B0, 0, 0); PG8_LDB(B1, 0, 1); PG8_SCHED; PG8_LDA(At, 0, 0); PG8_STAGE(PG8_SA(1, 1), a1 + hstepA, voffA[GATHER ? 1 : 0]);
            bool defer_now = false; if constexpr (DEFER) defer_now = pend && t == 0;
            PG8_WAIT_V(8); PG8_WAIT_L(0); PG8_BAR; PG8_MMA_E(0, At, B0); PG8_MMA(0, 1, At, B1); PG8_BAR; PG8_SCHED;
            PG8_LDA(At, 0, 1); PG8_STAGE(PG8_SB(0, 0), b2, voffB); PG8_STAGE(PG8_SB(0, 1), b2 + hstep, voffB); PG8_STAGE(PG8_SA(0, 0), a2, voffA[0]);
            PG8_WAIT_V(8); PG8_WAIT_L(0); PG8_BAR; PG8_MMA_E(1, At, B0); PG8_MMA(1, 1, At, B1); PG8_BAR; PG8_SCHED;
            PG8_LDB(B0, 1, 0); PG8_LDB(B1, 1, 1); PG8_SCHED; PG8_LDA(At, 1, 0); PG8_STAGE(PG8_SA(0, 1), a2 + hstepA, voffA[GATHER ? 1 : 0]);
            PG8_WAIT_V(8); PG8_WAIT_L(0); PG8_BAR; PG8_MMA(0, 0, At, B0); PG8_MMA(0, 1, At, B1); PG8_BAR; PG8_SCHED;
            PG8_LDA(At, 1, 1); PG8_STAGE(PG8_SB(1, 0), b3, voffB); PG8_STAGE(PG8_SB(1, 1), b3 + hstep, voffB); PG8_STAGE(PG8_SA(1, 0), a3, voffA[0]);
            PG8_WAIT_V(8); PG8_WAIT_L(0); PG8_BAR; PG8_MMA(1, 0, At, B0); PG8_MMA(1, 1, At, B1); PG8_BAR; PG8_SCHED;
            } else {
            PG8_LDB(B0, 0, 0); PG8_SCHED; PG8_LDA(At, 0, 0); PG8_STAGE(PG8_SA(1, 1), a1 + hstepA, voffA[GATHER ? 1 : 0]);
            PG8_WAIT_L(8); PG8_BAR; PG8_WAIT_L(0); PG8_MMA(0, 0, At, B0); PG8_BAR; PG8_SCHED;
            PG8_LDB(B1, 0, 1); PG8_STAGE(PG8_SB(0, 0), b2, voffB);
            PG8_BAR; PG8_WAIT_L(0); PG8_MMA(0, 1, At, B1); PG8_BAR;
            PG8_LDA(At, 0, 1); PG8_STAGE(PG8_SA(0, 0), a2, voffA[0]);
            PG8_BAR; PG8_WAIT_L(0); PG8_MMA(1, 0, At, B0); PG8_BAR; PG8_SCHED;
            PG8_STAGE(PG8_SB(0, 1), b2 + hstep, voffB);
            PG8_WAIT_V(6); PG8_BAR; PG8_MMA(1, 1, At, B1); PG8_BAR;
            PG8_LDB(B0, 1, 0); PG8_SCHED; PG8_LDA(At, 1, 0); PG8_STAGE(PG8_SA(0, 1), a2 + hstepA, voffA[GATHER ? 1 : 0]);
            PG8_WAIT_L(8); PG8_BAR; PG8_WAIT_L(0); PG8_MMA(0, 0, At, B0); PG8_BAR; PG8_SCHED;
            PG8_LDB(B1, 1, 1); PG8_STAGE(PG8_SB(1, 0), b3, voffB);
            PG8_BAR; PG8_WAIT_L(0); PG8_MMA(0, 1, At, B1); PG8_BAR;
            PG8_LDA(At, 1, 1); PG8_STAGE(PG8_SA(1, 0), a3, voffA[0]);
            PG8_BAR; PG8_WAIT_L(0); PG8_MMA(1, 0, At, B0); PG8_BAR; PG8_SCHED;
            PG8_STAGE(PG8_SB(1, 1), b3 + hstep, voffB);
            PG8_WAIT_V(6); PG8_BAR; PG8_MMA(1, 1, At, B1); PG8_BAR;
            }
        }
        if (DEFER && has_next) { pend = true; pu = cur; cur = nxt; cA = nA; cB = nB; ++ui; continue; }
        if constexpr (ALIGN_EPI) { if (wr == 0) PG8_BAR; }
        if constexpr (F8) asm volatile("s_nop 15\n\ts_nop 7" ::: "memory");
        E(acc, cur, wr, wc, fr, fq); S.done(cur);
        if (!has_next) break;
#pragma unroll
        for (int a = 0; a < 2; ++a)
#pragma unroll
            for (int b = 0; b < 2; ++b)
#pragma unroll
                for (int m = 0; m < 4; ++m)
#pragma unroll
                    for (int n = 0; n < 2; ++n) acc[a][b][m][n] = (f32x4){0.f, 0.f, 0.f, 0.f};
        cur = nxt; cA = nA; cB = nB; ++ui;
        if constexpr (ALIGN_EPI) { if (wr == 1) PG8_BAR; }
    }
    PG8_WAIT_V(0);
    if constexpr (!ALIGN_EPI) { if (wr == 0) PG8_BAR; }
    PG8_BAR;
#undef PG8_SA
#undef PG8_SB
#undef PG8_STAGE
#undef PG8_LDA
#undef PG8_LDB
#undef PG8_MMA
#undef PG8_WAIT_V
#undef PG8_WAIT_L
#undef PG8_BAR
#undef PG8_SCHED
}
}

typedef GAS unsigned gu32;
#define RLX_AGENT __ATOMIC_RELAXED, __HIP_MEMORY_SCOPE_AGENT
#define LDS_WAIT() asm volatile("s_waitcnt lgkmcnt(0)" ::: "memory")
#define VM_WAIT() asm volatile("s_waitcnt vmcnt(0)" ::: "memory")
__device__ __forceinline__ unsigned pk2(float lo, float hi) { return pg8::cvt_pk_bf16(lo, hi); }
__device__ __forceinline__ float bf2f(unsigned short h) { return __uint_as_float((unsigned)h << 16); }
__device__ __forceinline__ float bflo(unsigned w) { return __uint_as_float(w << 16); }
__device__ __forceinline__ float bfhi(unsigned w) { return __uint_as_float(w & 0xffff0000u); }
__device__ __forceinline__ float wave_sum(float v) {
    v += __builtin_bit_cast(float, __builtin_amdgcn_update_dpp(0, __builtin_bit_cast(int, v), 0xB1, 0xf, 0xf, true));
    v += __builtin_bit_cast(float, __builtin_amdgcn_update_dpp(0, __builtin_bit_cast(int, v), 0x4E, 0xf, 0xf, true));
    v += __builtin_bit_cast(float, __builtin_amdgcn_update_dpp(0, __builtin_bit_cast(int, v), 0x141, 0xf, 0xf, true));
    v += __builtin_bit_cast(float, __builtin_amdgcn_update_dpp(0, __builtin_bit_cast(int, v), 0x140, 0xf, 0xf, true));
    v += __builtin_bit_cast(float, __builtin_amdgcn_update_dpp(0, __builtin_bit_cast(int, v), 0x142, 0xa, 0xf, false));
    v += __builtin_bit_cast(float, __builtin_amdgcn_update_dpp(0, __builtin_bit_cast(int, v), 0x143, 0xc, 0xf, false));
    return __builtin_bit_cast(float, __builtin_amdgcn_readlane(__builtin_bit_cast(int, v), 63));
}

#define XB_TMO      128
#define XB_XCNT(j)  (256  + 64 * (j))
#define XB_XSUB(j)  (1280 + 64 * (j))
#define XB_XGEN(j)  (2304 + 64 * (j))
#define XB_TOP      3328
#define XB_TOPGEN   3392
#define XCD_BAR_WORDS 3456
#define XB_SPIN_CAP (1u << 18)
__device__ __forceinline__ unsigned xb_ld(unsigned* p)              { return __hip_atomic_load(p, __ATOMIC_RELAXED, __HIP_MEMORY_SCOPE_AGENT); }
__device__ __forceinline__ unsigned xb_add(unsigned* p, unsigned v) { return __hip_atomic_fetch_add(p, v, __ATOMIC_RELAXED, __HIP_MEMORY_SCOPE_AGENT); }
__device__ __forceinline__ unsigned xb_xcc_id() { return (unsigned)__builtin_amdgcn_s_getreg((3 << 11) | 20) & 0xFu; }
#define XB_SPIN(cond, bar) do { unsigned _sp = 0; while (cond) { __builtin_amdgcn_s_sleep(1); \
    if ((++_sp & 255u) == 0u) { if (xb_ld(&(bar)[XB_TMO])) break; if (_sp > XB_SPIN_CAP) { atomicAdd(&(bar)[XB_TMO], 1u); break; } } } } while (0)
struct XcdBarrier { unsigned* bar; unsigned x; volatile LAS unsigned* st; };
__device__ __forceinline__ XcdBarrier xcd_barrier_post(unsigned* bar, volatile LAS unsigned* st) {
    XcdBarrier b; b.bar = bar; b.x = xb_xcc_id(); b.st = st;
    if (threadIdx.x == 0) (void)xb_add(&bar[XB_XCNT(b.x)], 1u);
    return b;
}
__device__ __forceinline__ void xcd_barrier_complete(unsigned* bar, unsigned x, unsigned& nloc, unsigned& nx) {
    const unsigned G = gridDim.x * gridDim.y * gridDim.z;
    unsigned sum, cnt, mine, sp = 0u;
    for (;;) {
        sum = 0u; cnt = 0u; mine = 0u;
#pragma unroll
        for (unsigned j = 0; j < 16; ++j) { const unsigned c = xb_ld(&bar[XB_XCNT(j)]); sum += c; cnt += (c > 0u) ? 1u : 0u; mine = (j == x) ? c : mine; }
        if (sum == G) break;
        __builtin_amdgcn_s_sleep(1);
        if ((++sp & 255u) == 0u) { if (xb_ld(&bar[XB_TMO])) break; if (sp > XB_SPIN_CAP) { atomicAdd(&bar[XB_TMO], 1u); break; } }
    }
    nloc = mine > 0u ? mine : 1u; nx = cnt > 0u ? cnt : 1u;
}
__device__ __forceinline__ void xcd_barrier(const XcdBarrier& b) {
    asm volatile("s_waitcnt vmcnt(0)" ::: "memory");
    __syncthreads();
    if (threadIdx.x == 0) {
        unsigned* bar = b.bar;
        __builtin_amdgcn_s_waitcnt(0);
        unsigned nloc = b.st[0], nx = b.st[1];
        if (nloc == 0u) { xcd_barrier_complete(bar, b.x, nloc, nx); b.st[0] = nloc; b.st[1] = nx; }
        const unsigned old = xb_add(&bar[XB_XSUB(b.x)], 1u);
        const unsigned gen = old / nloc;
        if (old + 1u == (gen + 1u) * nloc) {
            __builtin_amdgcn_fence(__ATOMIC_RELEASE, "agent");
            asm volatile("s_waitcnt vmcnt(0)" ::: "memory");
            const unsigned og = xb_add(&bar[XB_TOP], 1u);
            const unsigned tg = og / nx;
            if (og + 1u == (tg + 1u) * nx) xb_add(&bar[XB_TOPGEN], 1u);
            else XB_SPIN(xb_ld(&bar[XB_TOPGEN]) == tg, bar);
            __builtin_amdgcn_fence(__ATOMIC_ACQUIRE, "agent");
            xb_add(&bar[XB_XGEN(b.x)], 1u);
            asm volatile("s_waitcnt vmcnt(0)" ::: "memory");
        } else {
            XB_SPIN(xb_ld(&bar[XB_XGEN(b.x)]) == gen, bar);
            __builtin_amdgcn_fence(__ATOMIC_ACQUIRE, "agent");
            asm volatile("s_waitcnt vmcnt(0)" ::: "memory");
        }
    }
    __syncthreads();
}

constexpr int RING_BYTES = 131072;
constexpr int LDSCTL_OFF = RING_BYTES, MISC_OFF = LDSCTL_OFF + 320;
constexpr int LDS_BYTES = 147456;
constexpr int CW_BAR = 4096;
constexpr int CW_KMAX = 65536;

struct Args { const float* in[22]; float* out; unsigned char* ws; int ph_lo, ph_hi; };
enum { I_X = 0, I_C, I_CTX, I_CCTX, I_WADA, I_BADA, I_NPRE_MIX, I_NPOST_MIX, I_NPRE_FFN, I_NPOST_FFN, I_WIN, I_CONVW, I_LQ1, I_LK1, I_LQ2, I_LK2, I_SUBLN, I_WOUT, I_WROUTER, I_WGATE, I_WUP, I_WDOWN };

__device__ __forceinline__ int win_dest(int n) {
    if (n < 1024) { const int j = n & 63; const int p = ((j >> 5) << 5) + ((j & 15) << 1) + ((j >> 4) & 1); return (n & ~63) + p; }
    if (n < 1536) { const int dv = n & 127; return (n & ~127) + ((dv & 3) << 5) + (dv >> 2); }
    if (n < 2048) return n;
    int c = n - 2048; const int isx = c >= 512; c &= 511; return 2048 + ((c >> 7) << 8) + (isx << 7) + (c & 127);
}
template <int MODE>
__device__ __forceinline__ int tr_dest(int n) {
    if (MODE == 0) return n;
    if (MODE == 1) return win_dest(n);
    if (MODE == 2) return ((n >> 7) << 8) + (n & 127);
    return ((n >> 7) << 8) + 128 + (n & 127);
}
template <int MODE>
__device__ __forceinline__ void p0_transpose_item_f8(const float* W, int K, int N, unsigned char* WT, LAS float* scr, int item, int lane) {
    const int nblk = N / 32, kb = item / nblk, nb = item % nblk, k0 = 64 * kb, n0 = 32 * nb;
    f32x4 v[8];
#pragma unroll
    for (int i = 0; i < 8; ++i) v[i] = __builtin_nontemporal_load((const f32x4*)(W + (size_t)(k0 + 8 * i + (lane >> 3)) * N + n0 + 4 * (lane & 7)));
#pragma unroll
    for (int i = 0; i < 8; ++i) { LAS float* d = scr + (8 * i + (lane >> 3)) * 33 + 4 * (lane & 7); const f32x4 w = v[i] * pg8::F8_WGT; d[0] = w.x; d[1] = w.y; d[2] = w.z; d[3] = w.w; }
    LDS_WAIT(); asm volatile("" ::: "memory");
    const int c = lane & 7;
#pragma unroll
    for (int j = 0; j < 4; ++j) { const int n = (lane >> 3) + 8 * j; const LAS float* s = scr + (8 * c) * 33 + n;
        u32x2 o; o.x = pg8::pk4_fp8(s[0 * 33], s[1 * 33], s[2 * 33], s[3 * 33]); o.y = pg8::pk4_fp8(s[4 * 33], s[5 * 33], s[6 * 33], s[7 * 33]);
        *(GAS u32x2*)(WT + (size_t)tr_dest<MODE>(n0 + n) * K + k0 + 8 * c) = o; }
    LDS_WAIT(); asm volatile("" ::: "memory");
}
template <int MODE>
__device__ __forceinline__ void p0_transpose_item(const float* W, int K, int N, bf16_t* WT, LAS float* scr, int item, int lane) {
    const int nblk = N / 32, kb = item / nblk, nb = item % nblk, k0 = 64 * kb, n0 = 32 * nb;
#pragma unroll 8
    for (int i = 0; i < 32; ++i) { const int kk = 2 * i + (lane >> 5); scr[kk * 33 + (lane & 31)] = W[(size_t)(k0 + kk) * N + n0 + (lane & 31)]; }
    LDS_WAIT(); asm volatile("" ::: "memory");
    const int c = lane & 7;
#pragma unroll
    for (int j = 0; j < 4; ++j) { const int n = (lane >> 3) + 8 * j; const LAS float* s = scr + (8 * c) * 33 + n;
        u32x4 o; o.x = pk2(s[0 * 33], s[1 * 33]); o.y = pk2(s[2 * 33], s[3 * 33]); o.z = pk2(s[4 * 33], s[5 * 33]); o.w = pk2(s[6 * 33], s[7 * 33]);
        *(GAS u32x4*)(WT + (size_t)tr_dest<MODE>(n0 + n) * K + k0 + 8 * c) = o; }
    LDS_WAIT(); asm volatile("" ::: "memory");
}

__device__ __forceinline__ void p0_prologue(const Args& a, LAS unsigned char* lds, int vcu, int G) {
    const int tid = opaque_tid(), lane = tid & 63, wave = __builtin_amdgcn_readfirstlane(tid >> 6);
    LAS float* scr = (LAS float*)(lds + wave * 16384);
    const int gw = vcu * NWAVES + wave, NGW = G * NWAVES;
    unsigned char* ws = a.ws;
    if (gw < 96 * 16) {
        float* MODP = (float*)(ws + WS_MODP);
        const float* wada = a.in[I_WADA];
        for (int it = gw; it < 96 * 16; it += NGW) {
            const int cg = it % 96, kc = it / 96;
            for (int b = 0; b < 33; ++b) { const float v = (b < 32) ? a.in[I_C][b * D + kc * 64 + lane] : a.in[I_CCTX][kc * 64 + lane]; scr[b * 64 + lane] = v / (1.f + __expf(-v)); }
            LDS_WAIT(); asm volatile("" ::: "memory");
            float acc[33];
#pragma unroll
            for (int b = 0; b < 33; ++b) acc[b] = 0.f;
            const float* wp = wada + (size_t)(kc * 64) * NMOD + cg * 64 + lane;
#pragma unroll 2
            for (int k = 0; k < 64; k += 4) {
                const float w0 = __builtin_nontemporal_load(wp + (size_t)(k + 0) * NMOD), w1 = __builtin_nontemporal_load(wp + (size_t)(k + 1) * NMOD),
                            w2 = __builtin_nontemporal_load(wp + (size_t)(k + 2) * NMOD), w3 = __builtin_nontemporal_load(wp + (size_t)(k + 3) * NMOD);
#pragma unroll
                for (int b = 0; b < 33; ++b) { const f32x4 sv4 = *(const LAS f32x4*)(scr + b * 64 + k); acc[b] += (sv4.x * w0 + sv4.y * w1) + (sv4.z * w2 + sv4.w * w3); }
            }
#pragma unroll
            for (int b = 0; b < 33; ++b) MODP[((size_t)kc * 33 + b) * NMOD + cg * 64 + lane] = acc[b];
            LDS_WAIT(); asm volatile("" ::: "memory");
        }
    } else {
        float* tab = (float*)(ws + WS_TAB);
        const int nw = NGW - 96 * 16;
        for (int e = (gw - 96 * 16) * 64 + lane; e < T * 32; e += nw * 64) {
            const int t = e >> 5, i = e & 31;
            const float inv = powf(10000.0f, -(float)(2 * (i & 15)) / 32.0f);
            const float pos = (i < 16) ? (float)(t >> 6) : (float)(t & 63);
            const float ang = pos * inv;
            tab[2 * e] = cosf(ang); tab[2 * e + 1] = sinf(ang);
        }
    }
}
__device__ __forceinline__ void inout_weight_copies(const Args& a, LAS unsigned char* lds, int vcu, int G) {
    const int tid = opaque_tid(), lane = tid & 63, wave = __builtin_amdgcn_readfirstlane(tid >> 6);
    LAS float* scr = (LAS float*)(lds + 16384 + wave * 12288);
    const int gw = vcu * NWAVES + wave, NGW = G * NWAVES;
    unsigned char* ws = a.ws;
    constexpr int I_IN = (D / 64) * (NPROJ / 32), I_OUT = (D / 64) * (D / 32);
    constexpr int NITEMS = I_IN + I_OUT;
    bf16_t* Win_t = (bf16_t*)(ws + WS_WIN); bf16_t* Wout_t = (bf16_t*)(ws + WS_WOUT);
    for (int it = gw; it < NITEMS; it += NGW) {
        int r = it;
        if (r < I_IN) { p0_transpose_item<1>(a.in[I_WIN], D, NPROJ, Win_t, scr, r, lane); continue; } r -= I_IN;
        p0_transpose_item<0>(a.in[I_WOUT], D, D, Wout_t, scr, r, lane);
    }
}
constexpr int EWC_END = 24576, EWC_P6 = 7680, EWC_P2 = 5120;
__device__ __forceinline__ void expert_weight_copies_w(const Args& a, LAS float* scr, int lane, int gw, int NGW, int r_lo, int r_hi) {
    unsigned char* ws = a.ws;
    constexpr int I_EXP = (D / 64) * (D / 32);
    unsigned char* Wgu_t = ws + WS_WGU; unsigned char* Wdn_t = ws + WS_WDN;
    for (int r = r_lo + gw; r < r_hi; r += NGW) {
        const int e = r / (3 * I_EXP), q = (r % (3 * I_EXP)) / I_EXP, rr = r % I_EXP;
        if (q == 0) p0_transpose_item_f8<2>(a.in[I_WGATE] + (size_t)e * D * D, D, D, Wgu_t + (size_t)e * 2048 * D, scr, rr, lane);
        else if (q == 1) p0_transpose_item_f8<3>(a.in[I_WUP] + (size_t)e * D * D, D, D, Wgu_t + (size_t)e * 2048 * D, scr, rr, lane);
        else p0_transpose_item_f8<0>(a.in[I_WDOWN] + (size_t)e * D * D, D, D, Wdn_t + (size_t)e * D * D, scr, rr, lane);
    }
}
__device__ __forceinline__ void expert_weight_copies(const Args& a, LAS unsigned char* lds, int gw0  , int ngroups, int r_lo, int r_hi) {
    const int tid = opaque_tid(), lane = tid & 63, wave = __builtin_amdgcn_readfirstlane(tid >> 6);
    expert_weight_copies_w(a, (LAS float*)(lds + wave * 16384), lane, gw0 * NWAVES + wave, ngroups * NWAVES, r_lo, r_hi);
    __syncthreads();
}

struct RowF { f32x4 v[4]; };
__device__ __forceinline__ void row_load(RowF& r, const float* xrow, int lane) {
    const f32x4* xr = (const f32x4*)xrow + lane;
#pragma unroll
    for (int j = 0; j < 4; ++j) r.v[j] = __builtin_nontemporal_load(xr + 64 * j);
}
__device__ __forceinline__ void norm_mod_row(const RowF& r, bf16_t* orow, const f32x4 (&gain)[4], const LAS float* sc, const LAS float* sh, int lane) {
    float s = 0.f;
#pragma unroll
    for (int j = 0; j < 4; ++j) s += (r.v[j].x * r.v[j].x + r.v[j].y * r.v[j].y) + (r.v[j].z * r.v[j].z + r.v[j].w * r.v[j].w);
    const float rstd = 1.0f / sqrtf(wave_sum(s) * (1.f / D) + EPS);
    u32x2* o8 = (u32x2*)orow + lane;
#pragma unroll
    for (int j = 0; j < 4; ++j) { const f32x4 g = gain[j]; const f32x4 c1 = *(const LAS f32x4*)(sc + 4 * lane + 256 * j), h1 = *(const LAS f32x4*)(sh + 4 * lane + 256 * j);
        const f32x4 y = (r.v[j] * rstd) * g; const f32x4 z = y * (c1 + 1.0f) + h1;
        u32x2 w; w.x = pk2(z.x, z.y); w.y = pk2(z.z, z.w); o8[64 * j] = w; }
}
__device__ __forceinline__ void p1_xn(const Args& a, LAS unsigned char* lds, int c, int G) {
    const int tid = opaque_tid(), lane = tid & 63, wave = __builtin_amdgcn_readfirstlane(tid >> 6);
    unsigned char* ws = a.ws;
    const float* MODP = (const float*)(ws + WS_MODP); float* MOD = (float*)(ws + WS_MOD); const float* bada = a.in[I_BADA];
    { const int per = (33 * NMOD + G - 1) / G;
      for (int i = c * per + tid; i < (c + 1) * per && i < 33 * NMOD; i += NTHREADS) { const int r = i / NMOD, n = i - r * NMOD; float s = bada[n];
#pragma unroll
            for (int kc = 0; kc < 16; ++kc) s += MODP[((size_t)kc * 33 + r) * NMOD + n];
            MOD[i] = s; } }
    LAS float* sv = (LAS float*)lds;
    bf16_t* XN = (bf16_t*)(ws + WS_XN);
    const float* X = a.in[I_X]; const float* CTX = a.in[I_CTX];
    f32x4 gain[4];
#pragma unroll
    for (int j = 0; j < 4; ++j) gain[j] = ((const f32x4*)a.in[I_NPRE_MIX])[lane + 64 * j];
    for (int p = c; p < 256; p += G) {
        const int b = p >> 3;
        const int rbase = p * 256 + wave * 32;
        RowF a0, a1, a2, a3;
        row_load(a0, X + (size_t)rbase * D, lane); row_load(a1, X + (size_t)(rbase + 1) * D, lane); row_load(a2, X + (size_t)(rbase + 2) * D, lane); row_load(a3, X + (size_t)(rbase + 3) * D, lane);
        __syncthreads();
        for (int n = tid; n < 4096; n += NTHREADS) { const int r = (n < 2048) ? b : 32; const int col = n & 2047; float s = bada[col];
#pragma unroll
            for (int kc = 0; kc < 16; ++kc) s += MODP[((size_t)kc * 33 + r) * NMOD + col];
            sv[n] = s; }
        __syncthreads();
        const int crow = p * 32 + wave * 4;
        for (int i = 0; i < 8; ++i) {
            RowF n0, n1, n2, n3;
            const float* nx = (i + 1 < 8) ? X + (size_t)(rbase + 4 * (i + 1)) * D : CTX + (size_t)crow * D;
            row_load(n0, nx, lane); row_load(n1, nx + D, lane); row_load(n2, nx + 2 * D, lane); row_load(n3, nx + 3 * D, lane);
            bf16_t* orow = XN + (size_t)(rbase + 4 * i) * D;
            norm_mod_row(a0, orow, gain, sv + 1024, sv, lane);
            norm_mod_row(a1, orow + D, gain, sv + 1024, sv, lane);
            norm_mod_row(a2, orow + 2 * D, gain, sv + 1024, sv, lane);
            norm_mod_row(a3, orow + 3 * D, gain, sv + 1024, sv, lane);
            a0 = n0; a1 = n1; a2 = n2; a3 = n3;
        }
        { bf16_t* orow = XN + (size_t)(M + crow) * D;
          norm_mod_row(a0, orow, gain, sv + 3072, sv + 2048, lane);
          norm_mod_row(a1, orow + D, gain, sv + 3072, sv + 2048, lane);
          norm_mod_row(a2, orow + 2 * D, gain, sv + 3072, sv + 2048, lane);
          norm_mod_row(a3, orow + 3 * D, gain, sv + 3072, sv + 2048, lane); }
    }
}

__device__ __forceinline__ float half_sum32(float v, int hi) {
    v += __builtin_bit_cast(float, __builtin_amdgcn_update_dpp(0, __builtin_bit_cast(int, v), 0xB1, 0xf, 0xf, true));
    v += __builtin_bit_cast(float, __builtin_amdgcn_update_dpp(0, __builtin_bit_cast(int, v), 0x4E, 0xf, 0xf, true));
    v += __builtin_bit_cast(float, __builtin_amdgcn_update_dpp(0, __builtin_bit_cast(int, v), 0x141, 0xf, 0xf, true));
    v += __builtin_bit_cast(float, __builtin_amdgcn_update_dpp(0, __builtin_bit_cast(int, v), 0x140, 0xf, 0xf, true));
    v += __builtin_bit_cast(float, __builtin_amdgcn_update_dpp(0, __builtin_bit_cast(int, v), 0x142, 0xa, 0xf, false));
    const float s0 = __builtin_bit_cast(float, __builtin_amdgcn_readlane(__builtin_bit_cast(int, v), 31)), s1 = __builtin_bit_cast(float, __builtin_amdgcn_readlane(__builtin_bit_cast(int, v), 63));
    return hi ? s1 : s0;
}
namespace att {
constexpr int KP = 272, KBUF = 64 * KP, VBUF = 16384;
constexpr int OFF_K = 0, OFF_V = 2 * KBUF, OFF_WSF = OFF_V + 2 * VBUF, OFF_END = OFF_WSF + NWAVES * 256;
static_assert(OFF_WSF >= 65536 && OFF_END <= RING_BYTES, "attention LDS map");
constexpr int NT = TK / 64;
constexpr float THR = 8.0f;
__device__ __forceinline__ int crow(int r, int hi) { return (r & 3) + 8 * (r >> 2) + 4 * hi; }
__device__ __forceinline__ float max3f(float a, float b, float c) { float r; asm("v_max3_f32 %0, %1, %2, %3" : "=v"(r) : "v"(a), "v"(b), "v"(c)); return r; }
__device__ __forceinline__ float max2f(float a, float b) { float r; asm("v_max_f32_e32 %0, %1, %2" : "=v"(r) : "v"(a), "v"(b)); return r; }
__device__ __forceinline__ s16x4 vtr(const LAS unsigned char* p) { return __builtin_bit_cast(s16x4, __builtin_amdgcn_ds_read_tr16_b64_v4i16((LAS s16x4*)p)); }

#define ATT_BAR() asm volatile("s_waitcnt lgkmcnt(0)\n\ts_barrier" ::: "memory")
#define ATT_SB() __builtin_amdgcn_sched_barrier(0)
#define ATT_KLD(i, KF) KF = *(const LAS bf16x8*)(kb_ + ((i) & 1) * (32 * KP) + ((i) >> 1) * 32)
#define ATT_XSTEP(i, KC, KN) do { if ((i) + 2 < 8) { ATT_KLD((i) + 2, KN); } \
    if ((i) == 0) p0 = __builtin_amdgcn_mfma_f32_32x32x16_bf16(KC, qr[0], negref, 0, 0, 0); \
    else if ((i) == 1) p1 = __builtin_amdgcn_mfma_f32_32x32x16_bf16(KC, qr[0], negref, 0, 0, 0); \
    else if (((i) & 1) == 0) p0 = __builtin_amdgcn_mfma_f32_32x32x16_bf16(KC, qr[(i) >> 1], p0, 0, 0, 0); else p1 = __builtin_amdgcn_mfma_f32_32x32x16_bf16(KC, qr[(i) >> 1], p1, 0, 0, 0); ATT_SB(); } while (0)
#define ATT_X(kcur) do { \
    const LAS unsigned char* kb_ = lds + OFF_K + (kcur) * KBUF + koff; \
    bf16x8 ka_, kb2_, kc_; \
    ATT_KLD(0, ka_); ATT_KLD(1, kb2_); \
    ATT_SB(); \
    ATT_XSTEP(0, ka_, kc_); ATT_XSTEP(1, kb2_, ka_); ATT_XSTEP(2, kc_, kb2_); ATT_XSTEP(3, ka_, kc_); \
    ATT_XSTEP(4, kb2_, ka_); ATT_XSTEP(5, kc_, kb2_); ATT_XSTEP(6, ka_, kc_); ATT_XSTEP(7, kb2_, ka_); \
} while (0)
#define ATT_EXP2(i, PWN) do { \
    const float e0_ = __builtin_amdgcn_exp2f((i) < 8 ? p0[2 * ((i) & 7)] : p1[2 * ((i) & 7)]), e1_ = __builtin_amdgcn_exp2f((i) < 8 ? p0[2 * ((i) & 7) + 1] : p1[2 * ((i) & 7) + 1]); \
    sacc_ += e0_ + e1_; PWN[(i) >> 2][(i) & 3] = pk2(e0_, e1_); asm volatile("" : "+v"(PWN[(i) >> 2]), "+v"(sacc_)); } while (0)
#define ATT_VLD(i, LO, HI) do { LO = vtr(vb_ + ((i) & 3) * 4096 + ((i) >> 2) * 1024); HI = vtr(vb_ + ((i) & 3) * 4096 + ((i) >> 2) * 1024 + 512); } while (0)
#define ATT_VF(LO, HI) ((bf16x8){LO[0], LO[1], LO[2], LO[3], HI[0], HI[1], HI[2], HI[3]})
#define ATT_YSTEP(i, PWC, PWN, LC, HC, LN, HN) do { if ((i) + 2 < 16) { ATT_VLD((i) + 2, LN, HN); } \
    o[(i) & 3] = __builtin_amdgcn_mfma_f32_32x32x16_bf16(__builtin_bit_cast(bf16x8, PWC[(i) >> 2]), ATT_VF(LC, HC), o[(i) & 3], 0, 0, 0); \
    ATT_EXP2(i, PWN); ATT_SB(); } while (0)
#define ATT_Y(vcur, PWC, PWN) do { \
    const LAS unsigned char* vb_ = lds + OFF_V + (vcur) * VBUF + voff; \
    float sacc_ = 0.f; s16x4 la_, ha_, lb_, hb_, lc_, hc_; \
    ATT_VLD(0, la_, ha_); ATT_VLD(1, lb_, hb_); ATT_SB(); \
    ATT_YSTEP(0, PWC, PWN, la_, ha_, lc_, hc_); ATT_YSTEP(1, PWC, PWN, lb_, hb_, la_, ha_); ATT_YSTEP(2, PWC, PWN, lc_, hc_, lb_, hb_); \
    ATT_YSTEP(3, PWC, PWN, la_, ha_, lc_, hc_); ATT_YSTEP(4, PWC, PWN, lb_, hb_, la_, ha_); ATT_YSTEP(5, PWC, PWN, lc_, hc_, lb_, hb_); \
    ATT_YSTEP(6, PWC, PWN, la_, ha_, lc_, hc_); ATT_YSTEP(7, PWC, PWN, lb_, hb_, la_, ha_); ATT_YSTEP(8, PWC, PWN, lc_, hc_, lb_, hb_); \
    ATT_YSTEP(9, PWC, PWN, la_, ha_, lc_, hc_); ATT_YSTEP(10, PWC, PWN, lb_, hb_, la_, ha_); ATT_YSTEP(11, PWC, PWN, lc_, hc_, lb_, hb_); \
    ATT_YSTEP(12, PWC, PWN, la_, ha_, lc_, hc_); ATT_YSTEP(13, PWC, PWN, lb_, hb_, la_, ha_); ATT_YSTEP(14, PWC, PWN, lc_, hc_, lb_, hb_); \
    ATT_YSTEP(15, PWC, PWN, la_, ha_, lc_, hc_); \
    l_reg += sacc_; \
} while (0)
#define ATT_Y0(PWN) do { float sacc_ = 0.f; _Pragma("unroll") for (int i = 0; i < 16; ++i) ATT_EXP2(i, PWN); l_reg += sacc_; } while (0)
#define ATT_ZSTEP(i, PWC, LC, HC, LN, HN) do { if ((i) + 2 < 16) { ATT_VLD((i) + 2, LN, HN); } \
    o[(i) & 3] = __builtin_amdgcn_mfma_f32_32x32x16_bf16(__builtin_bit_cast(bf16x8, PWC[(i) >> 2]), ATT_VF(LC, HC), o[(i) & 3], 0, 0, 0); ATT_SB(); } while (0)
#define ATT_Z(vcur, PWC) do { \
    const LAS unsigned char* vb_ = lds + OFF_V + (vcur) * VBUF + voff; \
    s16x4 la_, ha_, lb_, hb_, lc_, hc_; \
    ATT_VLD(0, la_, ha_); ATT_VLD(1, lb_, hb_); ATT_SB(); \
    ATT_ZSTEP(0, PWC, la_, ha_, lc_, hc_); ATT_ZSTEP(1, PWC, lb_, hb_, la_, ha_); ATT_ZSTEP(2, PWC, lc_, hc_, lb_, hb_); \
    ATT_ZSTEP(3, PWC, la_, ha_, lc_, hc_); ATT_ZSTEP(4, PWC, lb_, hb_, la_, ha_); ATT_ZSTEP(5, PWC, lc_, hc_, lb_, hb_); \
    ATT_ZSTEP(6, PWC, la_, ha_, lc_, hc_); ATT_ZSTEP(7, PWC, lb_, hb_, la_, ha_); ATT_ZSTEP(8, PWC, lc_, hc_, lb_, hb_); \
    ATT_ZSTEP(9, PWC, la_, ha_, lc_, hc_); ATT_ZSTEP(10, PWC, lb_, hb_, la_, ha_); ATT_ZSTEP(11, PWC, lc_, hc_, lb_, hb_); \
    ATT_ZSTEP(12, PWC, la_, ha_, lc_, hc_); ATT_ZSTEP(13, PWC, lb_, hb_, la_, ha_); ATT_ZSTEP(14, PWC, lc_, hc_, lb_, hb_); \
    ATT_ZSTEP(15, PWC, la_, ha_, lc_, hc_); \
} while (0)
#define ATT_STAGE(j) do { \
    if ((j) + 1 < NT) { _Pragma("unroll") for (int i = 0; i < 2; ++i) *(LAS u32x4*)(lds + OFF_K + (((j) + 1) & 1) * KBUF + kdst[i]) = kr[i]; } \
    _Pragma("unroll") for (int i = 0; i < 2; ++i) *(LAS u32x4*)(lds + OFF_V + ((j) & 1) * VBUF + vdst[i]) = vr[i]; \
    if ((j) + 2 < NT) { _Pragma("unroll") for (int i = 0; i < 2; ++i) kr[i] = ATT_BLD(krs, gsrc[i], ((j) + 2) * (64 * 1024)); } \
    if ((j) + 1 < NT) { _Pragma("unroll") for (int i = 0; i < 2; ++i) vr[i] = ATT_BLD(vrs, gsrc[i], ((j) + 1) * (64 * 1024)); } } while (0)
#define ATT_BLD(rs, voff_, soff_) __builtin_bit_cast(u32x4, __builtin_amdgcn_raw_buffer_load_b128(rs, (int)(voff_), (int)(soff_), 0))

__device__ __forceinline__ void unit(LAS unsigned char* lds, int b, int h, int qb, const bf16_t* Q, const bf16_t* KA, const bf16_t* VA, bf16_t* MIXIN, const float* subg, float lam, const unsigned* KM) {
    const int tid = opaque_tid(), lane = tid & 63, r32 = lane & 31, hi = lane >> 5;
    const int wid = __builtin_amdgcn_readfirstlane(tid >> 6), w = wid & 3, m = wid >> 2;
    LAS float* wsf = (LAS float*)(lds + OFF_WSF) + wid * 64;
    const int rowQ = b * T + qb * 128 + w * 32;
    bf16x8 qr[4];
#pragma unroll
    for (int d0 = 0; d0 < 4; ++d0) qr[d0] = *(const bf16x8*)(Q + (size_t)(rowQ + r32) * 512 + h * 128 + m * 64 + d0 * 16 + hi * 8);
    const bf16_t* Kb = KA + (size_t)b * TK * 512 + h * 128; const bf16_t* Vb = VA + (size_t)b * TK * 512 + h * 128;
    const __amdgpu_buffer_rsrc_t krs = __builtin_amdgcn_make_buffer_rsrc((void*)Kb, 0, 0x7fffffff, 0x00020000), vrs = __builtin_amdgcn_make_buffer_rsrc((void*)Vb, 0, 0x7fffffff, 0x00020000);
    unsigned gsrc[2]; int kdst[2], vdst[2];
#pragma unroll
    for (int i = 0; i < 2; ++i) { const int cid = tid + 512 * i, kv = cid >> 4, c16 = cid & 15;
        gsrc[i] = (unsigned)(kv * 1024 + c16 * 16); kdst[i] = kv * KP + c16 * 16; vdst[i] = (c16 >> 2) * 4096 + (kv >> 4) * 1024 + (kv & 15) * 64 + (c16 & 3) * 16; }
    u32x4 kr[2], vr[2];
#pragma unroll
    for (int i = 0; i < 2; ++i) { kr[i] = ATT_BLD(krs, gsrc[i], 0); vr[i] = ATT_BLD(vrs, gsrc[i], 0); }
#pragma unroll
    for (int i = 0; i < 2; ++i) *(LAS u32x4*)(lds + OFF_K + kdst[i]) = kr[i];
#pragma unroll
    for (int i = 0; i < 2; ++i) kr[i] = ATT_BLD(krs, gsrc[i], 64 * 1024);
    ATT_BAR();
    f32x16 o[4];
#pragma unroll
    for (int d0 = 0; d0 < 4; ++d0) o[d0] = (f32x16){};
    float l_reg = 0.f;
    f32x16 p0, p1, negref;
    {
        const unsigned* km = KM + (b * 8 + h * 2 + m) * 2;
        const float kmax2 = __uint_as_float(km[0]) + __uint_as_float(km[1]);
        float ss = 0.f;
#pragma unroll
        for (int d0 = 0; d0 < 4; ++d0)
#pragma unroll
            for (int i = 0; i < 8; ++i) { const float v = bf2f((unsigned short)qr[d0][i]); ss += v * v; }
        ss += __shfl_xor(ss, 32);
        const float ref = sqrtf(ss * kmax2) * 1.02f;
#pragma unroll
        for (int r = 0; r < 16; ++r) negref[r] = -ref;
    }
    u32x4 pwA[4], pwB[4];
    const int koff = r32 * KP + m * 128 + hi * 16;
    const int voff = ((lane >> 4) & 1) * 32 + (lane & 3) * 8 + (4 * hi + ((lane & 15) >> 2)) * 64;
    ATT_X(0); ATT_STAGE(0); ATT_Y0(pwA); ATT_BAR();
    ATT_X(1); ATT_STAGE(1); ATT_Y(0, pwA, pwB); ATT_BAR();
    for (int j = 2; j < NT; j += 2) {
        ATT_X(0); ATT_STAGE(j); ATT_Y(1, pwB, pwA); ATT_BAR();
        ATT_X(1); ATT_STAGE(j + 1); ATT_Y(0, pwA, pwB); ATT_BAR();
    }
    ATT_Z(1, pwB); ATT_BAR();
    const float lsum_ = l_reg + __shfl_xor(l_reg, 32);
    if (hi == 0) wsf[32 + r32] = lsum_;
    LDS_WAIT();
    LAS float* ex = (LAS float*)lds + w * 4096 + 4 * r32;
    const f32x4 g4 = *(const f32x4*)(subg + 4 * r32) * (1.0f - LAM_INIT);
    bf16_t* dstb = MIXIN + (size_t)rowQ * 1024 + h * 128 + 4 * r32;
#define ATT_EPI(KEEP) do { \
    _Pragma("unroll") for (int rr = 0; rr < 8; ++rr) { const int r = 8 - (KEEP) + rr; const int q = crow(r, hi); const float rl = __builtin_amdgcn_rcpf(wsf[32 + q]); \
        *(LAS f32x4*)(ex + q * 128) = (f32x4){o[0][r] * rl, o[1][r] * rl, o[2][r] * rl, o[3][r] * rl}; } \
    ATT_BAR(); \
    _Pragma("unroll") for (int rr = 0; rr < 8; ++rr) { const int r = (KEEP) + rr; const int q = crow(r, hi); const float rl = __builtin_amdgcn_rcpf(wsf[32 + q]); \
        const f32x4 own = (f32x4){o[0][r] * rl, o[1][r] * rl, o[2][r] * rl, o[3][r] * rl}; const f32x4 oth = *(const LAS f32x4*)(ex + q * 128); \
        const f32x4 x = ((KEEP) == 0) ? (own - lam * oth) : (oth - lam * own); \
        const float ss = half_sum32((x[0] * x[0] + x[1] * x[1]) + (x[2] * x[2] + x[3] * x[3]), hi); \
        const float rstd = __builtin_amdgcn_rsqf(ss * (1.f / 128.f) + EPS); \
        u32x2 wv; wv.x = pk2(x[0] * rstd * g4[0], x[1] * rstd * g4[1]); wv.y = pk2(x[2] * rstd * g4[2], x[3] * rstd * g4[3]); \
        *(u32x2*)(dstb + (size_t)q * 1024) = wv; } } while (0)
    if (m == 0) ATT_EPI(0); else ATT_EPI(8);
#undef ATT_EPI
    ATT_BAR();
}
#undef ATT_BAR
#undef ATT_X
#undef ATT_EXP2
#undef ATT_Y
#undef ATT_Y0
#undef ATT_Z
#undef ATT_STAGE
#undef ATT_BLD
#undef ATT_SB
#undef ATT_KLD
#undef ATT_XSTEP
#undef ATT_VLD
#undef ATT_VF
#undef ATT_YSTEP
#undef ATT_ZSTEP
}

__device__ __forceinline__ void p3_conv_attn(const Args& a, LAS unsigned char* lds, int c, int vcu, int G) {
    const int tid = opaque_tid(), lane = tid & 63, wave = __builtin_amdgcn_readfirstlane(tid >> 6);
    unsigned char* ws = a.ws;
    const bf16_t* GB = (const bf16_t*)(ws + WS_GB); const bf16_t* U = (const bf16_t*)(ws + WS_U); bf16_t* MIXIN = (bf16_t*)(ws + WS_MIXIN);
    {
        const float* cw = a.in[I_CONVW]; float w0[8], w1[8], w2[8];
#pragma unroll
        for (int i = 0; i < 8; ++i) { w0[i] = cw[lane * 8 + i]; w1[i] = cw[512 + lane * 8 + i]; w2[i] = cw[1024 + lane * 8 + i]; }
        const int gw = vcu * NWAVES + wave, NGW = G * NWAVES;
        const int rlo = gw * (M / NGW), rhi = rlo + M / NGW, slo = rlo & ~(T - 1), shi = slo + T;
        struct CIn { u32x4 u[6], g[4]; };
        auto cload = [&](CIn& c, int row) {
            const u32x4 z = {0u, 0u, 0u, 0u};
#pragma unroll
            for (int k = 0; k < 6; ++k) { const int rr = row - 1 + k; c.u[k] = (rr >= slo && rr < shi) ? *(const u32x4*)(U + (size_t)rr * 512 + lane * 8) : z; }
#pragma unroll
            for (int k = 0; k < 4; ++k) c.g[k] = *(const u32x4*)(GB + (size_t)(row + k) * 512 + lane * 8);
        };
        CIn ca; cload(ca, rlo);
        for (int row = rlo; row < rhi; row += 4) {
            CIn cn = ca;
            if (row + 4 < rhi) cload(cn, row + 4);
#pragma unroll
            for (int k = 0; k < 4; ++k) {
                const u32x4 up = ca.u[k], uc = ca.u[k + 1], un = ca.u[k + 2], gb = ca.g[k];
                u32x4 o;
#pragma unroll
                for (int q = 0; q < 4; ++q) {
                    const float y0 = w0[2 * q] * bflo(up[q]) + w1[2 * q] * bflo(uc[q]) + w2[2 * q] * bflo(un[q]);
                    const float y1 = w0[2 * q + 1] * bfhi(up[q]) + w1[2 * q + 1] * bfhi(uc[q]) + w2[2 * q + 1] * bfhi(un[q]);
                    o[q] = pk2(bflo(gb[q]) * y0, bfhi(gb[q]) * y1);
                }
                *(u32x4*)(MIXIN + (size_t)(row + k) * 1024 + 512 + lane * 8) = o;
            }
            ca = cn;
        }
    }
    float lam;
    { const float p1 = a.in[I_LQ1][lane] * a.in[I_LK1][lane], p2 = a.in[I_LQ2][lane] * a.in[I_LK2][lane];
      lam = __expf(wave_sum(p1)) - __expf(wave_sum(p2)) + LAM_INIT; }
    const bf16_t* Q = (const bf16_t*)(ws + WS_Q); const bf16_t* KA = (const bf16_t*)(ws + WS_K); const bf16_t* VA = (const bf16_t*)(ws + WS_V);
    __syncthreads();
    for (int u = vcu * 8; u < 2048; u += G * 8) {
        const int x = (u >> 3) / 32, jj = (u >> 3) % 32;
        for (int i = 0; i < 8; ++i) {
            const int bh = 16 * x + 2 * i + (jj >> 4), qb = jj & 15;
            att::unit(lds, bh >> 2, bh & 3, qb, Q, KA, VA, MIXIN, a.in[I_SUBLN], lam, (const unsigned*)(ws + WS_CTL) + CW_KMAX);
        }
    }
}

struct P5In { f32x4 x[4]; u32x2 m[4]; };
__device__ __forceinline__ void p5_load(P5In& r, int row, int lane, const float* X, const bf16_t* MIX) {
    const f32x4* xr = (const f32x4*)(X + (size_t)row * D) + lane; const u32x2* mr = (const u32x2*)(MIX + (size_t)row * D) + lane;
#pragma unroll
    for (int j = 0; j < 4; ++j) { r.x[j] = __builtin_nontemporal_load(xr + 64 * j); r.m[j] = __builtin_nontemporal_load(mr + 64 * j); }
}
__device__ __forceinline__ float p5_resid(const P5In& r, f32x4 (&h)[4], int row, int lane, const LAS float* mv, const LAS f32x4* npm, bf16_t* H1) {
    f32x4 mx[4]; float s = 0.f;
#pragma unroll
    for (int j = 0; j < 4; ++j) { const u32x2 wv = r.m[j]; mx[j] = (f32x4){bflo(wv.x), bfhi(wv.x), bflo(wv.y), bfhi(wv.y)};
        s += (mx[j].x * mx[j].x + mx[j].y * mx[j].y) + (mx[j].z * mx[j].z + mx[j].w * mx[j].w); }
    const float rstd1 = 1.0f / sqrtf(wave_sum(s) * (1.f / D) + EPS);
    u32x2* hr = (u32x2*)(H1 + (size_t)row * D) + lane; float s2 = 0.f;
#pragma unroll
    for (int j = 0; j < 4; ++j) { const f32x4 g1 = *(const LAS f32x4*)(mv + 4 * lane + 256 * j);
        h[j] = r.x[j] + g1 * ((mx[j] * rstd1) * npm[64 * j]);
        u32x2 wv; wv.x = pk2(h[j].x, h[j].y); wv.y = pk2(h[j].z, h[j].w); __builtin_nontemporal_store(wv, hr + 64 * j);
        s2 += (h[j].x * h[j].x + h[j].y * h[j].y) + (h[j].z * h[j].z + h[j].w * h[j].w); }
    return 1.0f / sqrtf(wave_sum(s2) * (1.f / D) + EPS);
}
__device__ __forceinline__ void p5_rows(const Args& a, LAS unsigned char* lds, int p  ) {
    const int tid = opaque_tid(), lane = tid & 63, wave = __builtin_amdgcn_readfirstlane(tid >> 6);
    unsigned char* ws = a.ws;
    const int b = p >> 3;
    LAS float* wrt = (LAS float*)lds;
    LAS float* mv = (LAS float*)(lds + 65536);
    const float* wr = a.in[I_WROUTER];
    const bf16_t* MIX = (const bf16_t*)(ws + WS_MIX); unsigned char* XN2 = ws + WS_XN; float* AFFT = (float*)(ws + WS_AFFT); bf16_t* H1 = (bf16_t*)(ws + WS_H1);
    const float* X = a.in[I_X];
    const int rbase = p * 256 + wave * 32;
    P5In cA, cB;
    p5_load(cA, rbase, lane, X, MIX); p5_load(cB, rbase + 1, lane, X, MIX);
    for (int n = tid; n < D * NE; n += NTHREADS) { const int k = n >> 4, e = n & 15; wrt[e * D + k] = wr[n]; }
    const float* MOD = (const float*)(ws + WS_MOD) + (size_t)b * NMOD;
    for (int n = tid; n < 3 * D; n += NTHREADS) mv[n] = MOD[2 * D + n];
    for (int n = tid; n < D; n += NTHREADS) { mv[3 * D + n] = a.in[I_NPOST_MIX][n]; mv[4 * D + n] = a.in[I_NPRE_FFN][n]; }
    __syncthreads();
    const LAS f32x4* npm = (const LAS f32x4*)(mv + 3 * D) + lane; const LAS f32x4* npf = (const LAS f32x4*)(mv + 4 * D) + lane;
    for (int i = 0; i < 16; ++i) {
        const int rowA = rbase + 2 * i, rowB = rowA + 1;
        P5In nA, nB;
        if (i + 1 < 16) { p5_load(nA, rowA + 2, lane, X, MIX); p5_load(nB, rowB + 2, lane, X, MIX); }
        f32x4 hA[4], hB[4];
        const float rsA = p5_resid(cA, hA, rowA, lane, mv, npm, H1);
        const float rsB = p5_resid(cB, hB, rowB, lane, mv, npm, H1);
        unsigned* oA = (unsigned*)(XN2 + (size_t)rowA * D) + lane; unsigned* oB = (unsigned*)(XN2 + (size_t)rowB * D) + lane;
        typedef float f32x2v __attribute__((ext_vector_type(2)));
        f32x2v lg2[16];
#pragma unroll
        for (int e = 0; e < 16; ++e) lg2[e] = (f32x2v){0.f, 0.f};
#pragma unroll
        for (int j = 0; j < 4; ++j) { const f32x4 sh2 = *(const LAS f32x4*)(mv + 1024 + 4 * lane + 256 * j), sc2 = *(const LAS f32x4*)(mv + 2048 + 4 * lane + 256 * j);
            const f32x4 gn = npf[64 * j];
            const f32x4 zA = ((hA[j] * rsA) * gn) * (sc2 + 1.0f) + sh2, zB = ((hB[j] * rsB) * gn) * (sc2 + 1.0f) + sh2;
            { const f32x4 qa = zA * pg8::F8_ACT, qb = zB * pg8::F8_ACT; oA[64 * j] = pg8::pk4_fp8(qa.x, qa.y, qa.z, qa.w); oB[64 * j] = pg8::pk4_fp8(qb.x, qb.y, qb.z, qb.w); }
            const f32x2v zx = {zA.x, zB.x}, zy = {zA.y, zB.y}, zz = {zA.z, zB.z}, zw = {zA.w, zB.w};
#pragma unroll
            for (int e = 0; e < 16; ++e) { const f32x4 wq = *(const LAS f32x4*)(wrt + e * D + 4 * lane + 256 * j);
                lg2[e] = __builtin_elementwise_fma(zx, (f32x2v){wq.x, wq.x}, lg2[e]); lg2[e] = __builtin_elementwise_fma(zy, (f32x2v){wq.y, wq.y}, lg2[e]);
                lg2[e] = __builtin_elementwise_fma(zz, (f32x2v){wq.z, wq.z}, lg2[e]); lg2[e] = __builtin_elementwise_fma(zw, (f32x2v){wq.w, wq.w}, lg2[e]);
                if ((e & 3) == 3) __builtin_amdgcn_sched_barrier(0); } }
        float lg[32];
#pragma unroll
        for (int e = 0; e < 16; ++e) { lg[e] = lg2[e].x; lg[16 + e] = lg2[e].y; }
#pragma unroll
        for (int st = 0; st < 5; ++st) { const int d = 1 << st, cntv = 16 >> st; const bool up = (lane & d) != 0;
#pragma unroll
            for (int q = 0; q < 16; ++q) if (q < cntv) { const float send = up ? lg[2 * q] : lg[2 * q + 1], keep = up ? lg[2 * q + 1] : lg[2 * q]; lg[q] = keep + __shfl_xor(send, d); } }
        float lv = lg[0] + __shfl_xor(lg[0], 32);
        float mxl = lv;
#pragma unroll
        for (int d = 1; d < 16; d <<= 1) mxl = fmaxf(mxl, __shfl_xor(mxl, d));
        const float ev = __expf(lv - mxl); float se = ev;
#pragma unroll
        for (int d = 1; d < 16; d <<= 1) se += __shfl_xor(se, d);
        if (lane < 32) { const int row = (lane < 16) ? rowA : rowB; AFFT[((size_t)b * NE + (lane & 15)) * T + (row & (T - 1))] = ev / se; }
        cA = nA; cB = nB;
    }
}

__device__ __forceinline__ void p6_topk(const Args& a, LAS unsigned char* lds, int c, int G) {
    const int tid = opaque_tid(), lane = tid & 63, wave = __builtin_amdgcn_readfirstlane(tid >> 6);
    unsigned char* ws = a.ws;
    const float* AFFT = (const float*)(ws + WS_AFFT); short* SLOT = (short*)(ws + WS_SLOT); int* IDX = (int*)(ws + WS_IDX); float* GATE = (float*)(ws + WS_GATE);
    LAS unsigned* sv = (LAS unsigned*)(lds + wave * 16384);
    for (int item = c + wave * G; item < NITEM; item += G * NWAVES) {
        const int b = item >> 4, e = item & 15;
        const float* src = AFFT + (size_t)item * T;
#pragma unroll 8
        for (int j = 0; j < 32; ++j) sv[j * 64 + lane] = __float_as_uint(src[j * 64 + lane]);
        LDS_WAIT(); asm volatile("" ::: "memory");
        unsigned pre = 0u;
        for (int bit = 30; bit >= 0; --bit) {
            const unsigned cand = pre | (1u << bit);
            int cnt = 0;
#pragma unroll 4
            for (int j = 0; j < 32; ++j) cnt += (int)__popcll(__ballot(sv[j * 64 + lane] >= cand));
            if (cnt >= CAP) pre = cand;
        }
        int ngt = 0;
#pragma unroll 4
        for (int j = 0; j < 32; ++j) ngt += (int)__popcll(__ballot(sv[j * 64 + lane] > pre));
        const int need_eq = CAP - ngt;
        const unsigned long long ltmask = (1ull << lane) - 1ull;
        int base_gt = 0, base_eq = 0;
#pragma unroll 2
        for (int j = 0; j < 32; ++j) {
            const unsigned vj = sv[j * 64 + lane];
            const bool gt = vj > pre, eq = vj == pre;
            const unsigned long long mg = __ballot(gt), me = __ballot(eq);
            const int pg = base_gt + (int)__popcll(mg & ltmask), pe = base_eq + (int)__popcll(me & ltmask);
            int sl = -1; if (gt) sl = pg; else if (eq && pe < need_eq) sl = ngt + pe;
            const int t = j * 64 + lane;
            SLOT[((size_t)b * T + t) * NE + e] = (short)sl;
            if (sl >= 0) { IDX[item * CAP + sl] = t; GATE[item * CAP + sl] = __uint_as_float(vj); }
            base_gt += (int)__popcll(mg); base_eq += (int)__popcll(me);
        }
        LDS_WAIT(); asm volatile("" ::: "memory");
    }
    if (wave >= 2) expert_weight_copies_w(a, (LAS float*)(lds + wave * 16384), lane, c * 6 + (wave - 2), G * 6, EWC_END - EWC_P6, EWC_END);
}

struct P8Row { u32x2 h[4]; unsigned y[4][4]; float wt[4]; unsigned long long rest; int sl; };
__device__ __forceinline__ f32x4 fp8x4_to_f32(unsigned w) { typedef float f2 __attribute__((ext_vector_type(2))); const f2 lo = __builtin_amdgcn_cvt_pk_f32_fp8((int)w, false), hi = __builtin_amdgcn_cvt_pk_f32_fp8((int)w, true); return (f32x4){lo.x, lo.y, hi.x, hi.y}; }
__device__ __forceinline__ int p8_slot(int row, int lane, const short* SLOT) { return (lane < NE) ? (int)SLOT[(size_t)row * NE + lane] : -1; }
__device__ __forceinline__ void p8_issue(P8Row& r, int row, int lane, int s_e, const unsigned char* Y, const bf16_t* H1) {
    const int b = row >> 11;
    unsigned long long mask = __ballot(s_e >= 0);
    const u32x2* hr = (const u32x2*)(H1 + (size_t)row * D) + lane;
#pragma unroll
    for (int j = 0; j < 4; ++j) r.h[j] = __builtin_nontemporal_load(hr + 64 * j);
#pragma unroll
    for (int q = 0; q < 4; ++q) {
        int e = 0, s = 0; r.wt[q] = 0.f;
        if (mask) { e = (int)__builtin_ctzll(mask); mask &= mask - 1ull; s = __builtin_amdgcn_readlane(s_e, e); r.wt[q] = 1.f; }
        const unsigned* yr = (const unsigned*)(Y + ((size_t)(b * NE + e) * CAP + s) * D) + lane;
#pragma unroll
        for (int j = 0; j < 4; ++j) r.y[q][j] = __builtin_nontemporal_load(yr + 64 * j);
    }
    r.rest = mask; r.sl = s_e;
}
__device__ __forceinline__ void p8_finish(P8Row& r, int row, int lane, const unsigned char* Y, const f32x4 (&gg)[4], float* out) {
    const int b = row >> 11;
    f32x4 ff[4];
#pragma unroll
    for (int j = 0; j < 4; ++j) ff[j] = (f32x4){0.f, 0.f, 0.f, 0.f};
#pragma unroll
    for (int q = 0; q < 4; ++q)
#pragma unroll
        for (int j = 0; j < 4; ++j) ff[j] += fp8x4_to_f32(r.y[q][j]) * r.wt[q];
    unsigned long long mask = r.rest;
    while (mask) {
        const int e = (int)__builtin_ctzll(mask); mask &= mask - 1ull; const int s = __builtin_amdgcn_readlane(r.sl, e);
        const unsigned* yr = (const unsigned*)(Y + ((size_t)(b * NE + e) * CAP + s) * D) + lane;
#pragma unroll
        for (int j = 0; j < 4; ++j) ff[j] += fp8x4_to_f32(yr[64 * j]);
    }
#pragma unroll
    for (int j = 0; j < 4; ++j) ff[j] = ff[j] * (1.0f / pg8::F8_Y);
    float s2 = 0.f;
#pragma unroll
    for (int j = 0; j < 4; ++j) s2 += (ff[j].x * ff[j].x + ff[j].y * ff[j].y) + (ff[j].z * ff[j].z + ff[j].w * ff[j].w);
    const float rstd = 1.0f / sqrtf(wave_sum(s2) * (1.f / D) + EPS);
    f32x4* orow = (f32x4*)(out + (size_t)row * D) + lane;
#pragma unroll
    for (int j = 0; j < 4; ++j) { const u32x2 hv = r.h[j]; const f32x4 h = (f32x4){bflo(hv.x), bfhi(hv.x), bflo(hv.y), bfhi(hv.y)};
        __builtin_nontemporal_store(h + gg[j] * (ff[j] * rstd), orow + 64 * j); }
}
__device__ __forceinline__ void p8_final(const Args& a, int vcu, int G) {
    const int tid = opaque_tid(), lane = tid & 63, wave = __builtin_amdgcn_readfirstlane(tid >> 6);
    unsigned char* ws = a.ws;
    const short* SLOT = (const short*)(ws + WS_SLOT); const unsigned char* Y = ws + WS_Y; const float* MOD = (const float*)(ws + WS_MOD); const bf16_t* H1 = (const bf16_t*)(ws + WS_H1);
    const int gw = vcu * NWAVES + wave, NGW = G * NWAVES;
    const int per = M / NGW;
    const int row0 = gw * per, rend = row0 + per;
    f32x4 gg[4];
    { const f32x4* npo = (const f32x4*)a.in[I_NPOST_FFN] + lane; const f32x4* g2 = (const f32x4*)(MOD + (size_t)(row0 >> 11) * NMOD + 5 * D) + lane;
#pragma unroll
      for (int j = 0; j < 4; ++j) gg[j] = g2[64 * j] * npo[64 * j]; }
    P8Row r0, r1, r2, r3;
    { const int s0 = p8_slot(row0, lane, SLOT), s1 = p8_slot(row0 + 1, lane, SLOT), s2 = p8_slot(row0 + 2, lane, SLOT), s3 = p8_slot(row0 + 3, lane, SLOT);
      p8_issue(r0, row0, lane, s0, Y, H1); p8_issue(r1, row0 + 1, lane, s1, Y, H1); p8_issue(r2, row0 + 2, lane, s2, Y, H1); p8_issue(r3, row0 + 3, lane, s3, Y, H1); }
    for (int row = row0; row < rend; row += 4) {
        const bool more = row + 4 < rend;
        int n0 = -1, n1 = -1, n2 = -1, n3 = -1;
        if (more) { n0 = p8_slot(row + 4, lane, SLOT); n1 = p8_slot(row + 5, lane, SLOT); n2 = p8_slot(row + 6, lane, SLOT); n3 = p8_slot(row + 7, lane, SLOT); }
        p8_finish(r0, row, lane, Y, gg, a.out);
        p8_finish(r1, row + 1, lane, Y, gg, a.out);
        if (more) { p8_issue(r0, row + 4, lane, n0, Y, H1); p8_issue(r1, row + 5, lane, n1, Y, H1); }
        p8_finish(r2, row + 2, lane, Y, gg, a.out);
        p8_finish(r3, row + 3, lane, Y, gg, a.out);
        if (more) { p8_issue(r2, row + 6, lane, n2, Y, H1); p8_issue(r3, row + 7, lane, n3, Y, H1); }
    }
}

__global__ void __launch_bounds__(NTHREADS, 2) fwd_kernel(Args args) {
    extern __shared__ __attribute__((aligned(16))) unsigned char lds_raw[];
    LAS unsigned char* lds = (LAS unsigned char*)lds_raw;
    volatile LAS unsigned* MISC = (volatile LAS unsigned*)(lds + MISC_OFF);
    const int tid = threadIdx.x;
    const int G = gridDim.x, c = blockIdx.x;
    const int vcu = (G % 8 == 0) ? (c % 8) * (G / 8) + c / 8 : c;
    unsigned char* ws = args.ws;
    gu32* ctl = (gu32*)(ws + WS_CTL);
    for (int u = tid; u < (LDS_BYTES - LDSCTL_OFF) / 4; u += NTHREADS) ((LAS unsigned*)(lds + LDSCTL_OFF))[u] = 0u;
    __syncthreads();
    XcdBarrier bar; bar.bar = (unsigned*)(ctl + CW_BAR); bar.x = 0; bar.st = nullptr;
    const int lo = args.ph_lo, hi = args.ph_hi;
    if (hi - lo > 1) bar = xcd_barrier_post((unsigned*)(ctl + CW_BAR), MISC + 8);
#ifndef PHMASK
#define PHMASK 0xff
#endif
#define IN(k) (((PHMASK >> (k)) & 1) && lo <= (k) && (k) < hi)
#define SEAM(k) do { if (IN(k) && IN((k) + 1)) xcd_barrier(bar); } while (0)
#ifndef PROBE_PHASE
#define PROBE_PHASE -1
#endif
#define PB(k) do { if (PROBE_PHASE == (k)) { if (tid == 0) { const unsigned long long t0_ = __builtin_amdgcn_s_memrealtime(); MISC[16] = (unsigned)t0_; MISC[17] = (unsigned)(t0_ >> 32); } } } while (0)
#define PE(k) do { if (PROBE_PHASE == (k)) { if (tid == 0) { const unsigned long long t0_ = ((unsigned long long)MISC[17] << 32) | MISC[16]; const unsigned long long t1_ = __builtin_amdgcn_s_memrealtime(); \
      while (__builtin_amdgcn_s_memrealtime() - t1_ < t1_ - t0_) __builtin_amdgcn_s_sleep(8); } __syncthreads(); } } while (0)

    PB(0); if (IN(0)) { p0_prologue(args, lds, vcu, G); } SEAM(0); PE(0);
    PB(1); if (IN(1)) { p1_xn(args, lds, c, G); inout_weight_copies(args, lds, vcu, G); } SEAM(1); PE(1);
    PB(2); if (IN(2)) {
        pg8::Gemm g{(const bf16_t*)(ws + WS_XN), (const bf16_t*)(ws + WS_WIN), D, nullptr};
        pg8::SchedProj S{G, c};
        pg8::EpiProj E{(bf16_t*)(ws + WS_Q), (bf16_t*)(ws + WS_K), (bf16_t*)(ws + WS_V), (bf16_t*)(ws + WS_GB), (bf16_t*)(ws + WS_U), (const float*)(ws + WS_TAB), (unsigned*)(ws + WS_CTL) + CW_KMAX};
        pg8::gemm_phase<pg8::EpiProj, pg8::SchedProj, true, true>(lds, g, S, E);
        if (c >= 128) expert_weight_copies(args, lds, c - 128, G - 128, 0, EWC_P2);
    } SEAM(2); PE(2);
    PB(3); if (IN(3)) { if (c & 1) expert_weight_copies(args, lds, vcu, G, EWC_P2, EWC_END - EWC_P6); p3_conv_attn(args, lds, c, vcu, G); if (!(c & 1)) expert_weight_copies(args, lds, vcu, G, EWC_P2, EWC_END - EWC_P6); } SEAM(3); PE(3);
    PB(4); if (IN(4)) {
        {
            const int p = c;
#ifndef NO_P4
            pg8::Gemm g{(const bf16_t*)(ws + WS_MIXIN), (const bf16_t*)(ws + WS_WOUT), D, nullptr};
            pg8::SchedPanel S{p, 4};
            pg8::EpiBf16 E{(bf16_t*)(ws + WS_MIX), D};
            pg8::gemm_phase<pg8::EpiBf16, pg8::SchedPanel, true, true>(lds, g, S, E);
#endif
            VM_WAIT(); __syncthreads();
#ifndef NO_P5
            p5_rows(args, lds, p);
#endif
            __syncthreads();
        }
    } SEAM(4); PE(4);
    PB(5); if (IN(5)) { p6_topk(args, lds, c, G); } SEAM(5); PE(5);
    PB(6); if (IN(6)) {
#pragma unroll 1
        for (int it = 0; it < 2; ++it) {
            {
                const int item = 2 * c + it;
                const int b = item >> 4, e = item & 15;
#ifndef NO_G1
                if (it == 0) PB(8);
                {
                    pg8::Gemm g{(const bf16_t*)(ws + WS_XN + (size_t)b * T * D), (const bf16_t*)(ws + WS_WGU + (size_t)e * 2048 * D), D, (const int*)(ws + WS_IDX) + item * CAP};
                    pg8::SchedPanel S{0, 8};
                    pg8::EpiGU8 E{ws + WS_HMID + (size_t)item * CAP * D};
                    pg8::gemm_phase<pg8::EpiGU8, pg8::SchedPanel, false, true, true, true, true>(lds, g, S, E);
                }
#endif
                VM_WAIT(); __syncthreads();
                if (it == 0) { PE(8); PB(9); }
#ifndef NO_G2
                {
                    pg8::Gemm g{(const bf16_t*)(ws + WS_HMID + (size_t)item * CAP * D), (const bf16_t*)(ws + WS_WDN + (size_t)e * D * D), D, nullptr};
                    pg8::SchedPanel S{0, 4};
                    LAS float* gl = (LAS float*)(lds + LDSCTL_OFF + 4096);
                    { const int t_ = opaque_tid(); if (t_ < CAP) gl[t_] = ((const float*)(ws + WS_GATE))[item * CAP + t_] * (pg8::F8_INV * pg8::F8_Y); }
                    __syncthreads();
                    pg8::EpiDown8 E{ws + WS_Y + (size_t)item * CAP * D, gl};
                    pg8::gemm_phase<pg8::EpiDown8, pg8::SchedPanel, false, true, false, true, true>(lds, g, S, E);
                }
#endif
                VM_WAIT(); __syncthreads();
                if (it == 0) PE(9);
            }
        }
    } SEAM(6); PE(6);
    PB(7); if (IN(7)) { p8_final(args, vcu, G); } PE(7);
#undef IN
#undef SEAM
}

extern "C" void kernel_launch(void* const* d_in, const int* in_sizes, int n_in, void* d_out, int out_size, void* d_ws, size_t ws_size, hipStream_t stream) {
    static int grid = 0;
    if (grid == 0) {
        if (n_in != 22 || in_sizes[0] != M * D || out_size != M * D || ws_size < WS_END) { fprintf(stderr, "kernel_launch: unexpected shapes (n_in %d, in0 %d, out %d, ws %zu)\n", n_in, n_in > 0 ? in_sizes[0] : -1, out_size, ws_size); grid = -1; return; }
        int dev = 0, cus = 0;
        if (hipGetDevice(&dev) != hipSuccess || hipDeviceGetAttribute(&cus, hipDeviceAttributeMultiprocessorCount, dev) != hipSuccess) { grid = -1; return; }
        if (hipFuncSetAttribute((const void*)fwd_kernel, hipFuncAttributeMaxDynamicSharedMemorySize, LDS_BYTES) != hipSuccess) { fprintf(stderr, "kernel_launch: hipFuncSetAttribute failed\n"); grid = -1; return; }
        (void)hipGetLastError();
        grid = cus;
        if (grid != 256) { fprintf(stderr, "kernel_launch: this kernel needs a 256-CU device (got %d)\n", cus); grid = -1; return; }
    }
    if (grid < 0) return;
    (void)hipMemsetAsync((char*)d_ws + WS_CTL, 0, CTL_ZERO_BYTES, stream);
    Args a{};
    for (int i = 0; i < 22; ++i) a.in[i] = (const float*)d_in[i];
    a.out = (float*)d_out; a.ws = (unsigned char*)d_ws;
    constexpr int NPH = 8;
    if (MK_N_LAUNCHES == 1) { a.ph_lo = 0; a.ph_hi = NPH; hipLaunchKernelGGL(fwd_kernel, dim3(grid), dim3(NTHREADS), LDS_BYTES, stream, a); }
    else { for (int k = 0; k < NPH; ++k) { a.ph_lo = k; a.ph_hi = k + 1; hipLaunchKernelGGL(fwd_kernel, dim3(grid), dim3(NTHREADS), LDS_BYTES, stream, a); } }
}
```
